# Optimizing an MI355X kernel written in HIP

```python
import math
import jax, jax.numpy as jnp
from jax import lax
import numpy as np

D_MODEL = 1024
BATCH = 8
SEQ = 4096
DEPTH = 1

EPS = 1e-6
HG_HEADS = 4
HG_DK = 128
HG_DV = 128
HG_CHUNK = 64
HG_W = HG_HEADS * HG_DK
HG_VW = HG_HEADS * HG_DV
ATT_HEADS = 8
ATT_DH = 64
ATT_W = ATT_HEADS * ATT_DH
IDX_HEADS = 4
IDX_DH = 64
TOPK_MAX = 256
Q_BLOCK = 128
REL_BUCKETS = 32
REL_MAX_DIST = 128
PEER_HEADS = 8
PEER_NKEYS = 128
PEER_EXPERTS = PEER_NKEYS * PEER_NKEYS
PEER_QDIM = 256
PEER_HALF = PEER_QDIM // 2
PEER_TOPK = 16
PEER_TOKEN_BLOCK = 128
IN_SIZES = (HG_W, HG_W, HG_VW, HG_VW, ATT_W, ATT_DH, ATT_DH, IDX_HEADS * IDX_DH, IDX_DH, IDX_HEADS, D_MODEL, D_MODEL)
IN_WIDTH = sum(IN_SIZES)

kernel_name = "hybrid_hgrn2_dsa_peer_block"


def rmsnorm(x, g):
    xf = x.astype(jnp.float32)
    y = xf * lax.rsqrt(jnp.mean(xf * xf, axis=-1, keepdims=True) + EPS)
    return (y * g.astype(jnp.float32)).astype(x.dtype)


def layernorm(x, g, b):
    xf = x.astype(jnp.float32)
    mu = jnp.mean(xf, axis=-1, keepdims=True)
    var = jnp.mean(jnp.square(xf - mu), axis=-1, keepdims=True)
    y = (xf - mu) * lax.rsqrt(var + EPS)
    return (y * g.astype(jnp.float32) + b.astype(jnp.float32)).astype(x.dtype)


def split_cols(p, sizes):
    offs = np.cumsum(np.array(sizes))[:-1].tolist()
    return jnp.split(p, offs, axis=-1)


def t5_bucket(dist):
    n = jnp.maximum(dist, 0)
    max_exact = REL_BUCKETS // 2
    nf = jnp.maximum(n, 1).astype(jnp.float32)
    large = max_exact + (jnp.log(nf / max_exact) / math.log(REL_MAX_DIST / max_exact)
                         * (REL_BUCKETS - max_exact)).astype(jnp.int32)
    large = jnp.minimum(large, REL_BUCKETS - 1)
    return jnp.where(n < max_exact, n, large)


def hgrn2_mixer(q_raw, f_raw, i_raw, og_raw, lb, gn):
    B, S, _ = q_raw.shape
    H, DK, DV, C = HG_HEADS, HG_DK, HG_DV, HG_CHUNK
    n = S // C
    f32 = jnp.float32
    q = jax.nn.silu(q_raw.astype(f32))
    fg = lb + (1.0 - lb) * jax.nn.sigmoid(f_raw.astype(f32))
    k = 1.0 - fg
    logf = jnp.log(fg)
    v = i_raw.astype(f32)

    def to_chunks(a, d):
        return a.reshape(B, n, C, H, d).transpose(1, 0, 3, 2, 4)

    qc, kc, lc, vc = to_chunks(q, DK), to_chunks(k, DK), to_chunks(logf, DK), to_chunks(v, DV)
    tri = jnp.tril(jnp.ones((C, C), dtype=bool))[None, None, :, :, None]

    def step(state, inp):
        qb, kb, lfb, vb = inp
        b = jnp.cumsum(lfb, axis=2)
        inter = jnp.einsum('bhtd,bhde->bhte', qb * jnp.exp(b), state)
        diff = b[:, :, :, None, :] - b[:, :, None, :, :]
        decay = jnp.where(tri, jnp.exp(jnp.where(tri, diff, 0.0)), 0.0)
        A = jnp.einsum('bhtd,bhsd,bhtsd->bhts', qb, kb, decay)
        intra = jnp.einsum('bhts,bhse->bhte', A, vb)
        b_last = b[:, :, -1:, :]
        new_state = (jnp.exp(b_last[:, :, 0, :])[..., None] * state
                     + jnp.einsum('bhsd,bhse->bhde', kb * jnp.exp(b_last - b), vb))
        return new_state, inter + intra

    s0 = jnp.zeros((B, H, DK, DV), f32)
    _, o = lax.scan(step, s0, (qc, kc, lc, vc))
    o = o.transpose(1, 0, 3, 2, 4).reshape(B, S, H, DV)
    o = o * lax.rsqrt(jnp.mean(o * o, axis=-1, keepdims=True) + EPS) * gn.astype(f32)
    o = o.reshape(B, S, H * DV) * jax.nn.silu(og_raw.astype(f32))
    return o.astype(q_raw.dtype)


def dsa_mixer(q_raw, k_raw, v_raw, iq_raw, ik_raw, iw_raw, ik_g, ik_b, rel_table):
    B, S, _ = q_raw.shape
    f32 = jnp.float32
    nblk = S // Q_BLOCK
    ktop = min(TOPK_MAX, S // 4)
    ik = layernorm(ik_raw, ik_g, ik_b).astype(f32)
    iw = iw_raw.astype(f32) * (IDX_HEADS ** -0.5)
    qs = q_raw.reshape(B, nblk, Q_BLOCK, ATT_HEADS, ATT_DH).transpose(1, 0, 2, 3, 4)
    iqs = iq_raw.reshape(B, nblk, Q_BLOCK, IDX_HEADS, IDX_DH).transpose(1, 0, 2, 3, 4)
    iws = iw.reshape(B, nblk, Q_BLOCK, IDX_HEADS).transpose(1, 0, 2, 3)
    spos = jnp.arange(S)
    gather = jax.vmap(lambda tab, idx: tab[idx])

    def block(args):
        bi, qb, iqb, iwb = args
        tpos = bi * Q_BLOCK + jnp.arange(Q_BLOCK)
        rel = jnp.einsum('bqjd,bsd->bqjs', iqb.astype(f32), ik) * (IDX_DH ** -0.5)
        score = jnp.einsum('bqj,bqjs->bqs', iwb, jax.nn.relu(rel))
        causal = spos[None, :] <= tpos[:, None]
        score = jnp.where(causal[None], score, -jnp.inf)
        top_score, idx = lax.top_k(score, ktop)
        valid = jnp.isfinite(top_score)
        kg = gather(k_raw, idx)
        vg = gather(v_raw, idx)
        bias = rel_table[t5_bucket(tpos[None, :, None] - idx)].astype(f32)
        logits = (jnp.einsum('bqhd,bqkd->bqhk', qb, kg).astype(f32) * (ATT_DH ** -0.5)
                  + bias.transpose(0, 1, 3, 2))
        logits = jnp.where(valid[:, :, None, :], logits, -jnp.inf)
        p = jax.nn.softmax(logits, axis=-1)
        return jnp.einsum('bqhk,bqkd->bqhd', p.astype(vg.dtype), vg)

    o = lax.map(block, (jnp.arange(nblk), qs, iqs, iws))
    return o.transpose(1, 0, 2, 3, 4).reshape(B, S, ATT_W)


def peer_ffn(x, w_q, sub_keys, u, v):
    B, S, D = x.shape
    TB, H, K = PEER_TOKEN_BLOCK, PEER_HEADS, PEER_TOPK
    xt = x.reshape(B * S // TB, TB, D)

    def block(xb):
        q = (xb @ w_q).reshape(TB, H, 2, PEER_HALF)
        s = jnp.einsum('thpc,phnc->thpn', q, sub_keys).astype(jnp.float32)
        s1, i1 = lax.top_k(s[:, :, 0], K)
        s2, i2 = lax.top_k(s[:, :, 1], K)
        cand = (s1[..., :, None] + s2[..., None, :]).reshape(TB, H, K * K)
        cidx = (i1[..., :, None] * PEER_NKEYS + i2[..., None, :]).reshape(TB, H, K * K)
        top_s, pos = lax.top_k(cand, K)
        eidx = jnp.take_along_axis(cidx, pos, axis=-1).reshape(TB, H * K)
        g = jax.nn.softmax(top_s, axis=-1).reshape(TB, H * K)
        ug = u[eidx]
        vg = v[eidx]
        h = jnp.einsum('tkd,td->tk', ug, xb)
        a = jax.nn.gelu(h, approximate=False) * g.astype(h.dtype)
        return jnp.einsum('tk,tkd->td', a, vg)

    return lax.map(block, xt).reshape(B, S, D)


def setup_inputs(seed: int = 0) -> dict:
    key = jax.random.key(seed)
    ks = jax.random.split(key, 20)
    f32 = jnp.float32
    nrm = lambda k, shape, scale: jax.random.normal(k, shape, f32) * scale
    return {
        "x": nrm(ks[0], (BATCH, SEQ, D_MODEL), 1.0),
        "norm_mix": 1.0 + nrm(ks[1], (DEPTH, D_MODEL), 0.02),
        "w_in": nrm(ks[2], (DEPTH, D_MODEL, IN_WIDTH), D_MODEL ** -0.5),
        "hg_lb": nrm(ks[3], (DEPTH + 1, HG_W), 0.1),
        "hg_norm": 1.0 + nrm(ks[4], (DEPTH, HG_HEADS, HG_DV), 0.02),
        "idx_k_norm_g": 1.0 + nrm(ks[5], (DEPTH, IDX_DH), 0.02),
        "idx_k_norm_b": nrm(ks[6], (DEPTH, IDX_DH), 0.01),
        "rel_bias": nrm(ks[7], (REL_BUCKETS, ATT_HEADS), 0.1),
        "w_up_a": nrm(ks[8], (DEPTH, HG_VW, D_MODEL), HG_VW ** -0.5),
        "w_up_b": nrm(ks[9], (DEPTH, ATT_W, D_MODEL), ATT_W ** -0.5),
        "w_out": nrm(ks[10], (DEPTH, D_MODEL, D_MODEL), D_MODEL ** -0.5),
        "norm_ffn": 1.0 + nrm(ks[11], (DEPTH, D_MODEL), 0.02),
        "peer_wq": nrm(ks[12], (DEPTH, D_MODEL, PEER_HEADS * PEER_QDIM), D_MODEL ** -0.5),
        "peer_keys": nrm(ks[13], (DEPTH, 2, PEER_HEADS, PEER_NKEYS, PEER_HALF), PEER_HALF ** -0.5),
        "peer_u": nrm(ks[14], (DEPTH, PEER_EXPERTS, D_MODEL), D_MODEL ** -0.5),
        "peer_v": nrm(ks[15], (DEPTH, PEER_EXPERTS, D_MODEL), PEER_HEADS ** -0.5),
        "norm_final": 1.0 + nrm(ks[16], (D_MODEL,), 0.02),
    }


def reference(x, norm_mix, w_in, hg_lb, hg_norm, idx_k_norm_g, idx_k_norm_b, rel_bias,
              w_up_a, w_up_b, w_out, norm_ffn, peer_wq, peer_keys, peer_u, peer_v, norm_final):
    lb_all = jnp.cumsum(jax.nn.softmax(hg_lb.astype(jnp.float32), axis=0), axis=0)
    for l in range(DEPTH):
        xn = rmsnorm(x, norm_mix[l])
        proj = xn @ w_in[l]
        (hq, hf, hi, hog, aq, ak, av, iq, ik, iw, ga, gb) = split_cols(proj, IN_SIZES)
        ya = hgrn2_mixer(hq, hf, hi, hog, lb_all[l], hg_norm[l])
        yb = dsa_mixer(aq, ak, av, iq, ik, iw, idx_k_norm_g[l], idx_k_norm_b[l], rel_bias)
        h = jax.nn.sigmoid(ga) * (ya @ w_up_a[l]) + jax.nn.sigmoid(gb) * (yb @ w_up_b[l])
        x = x + h @ w_out[l]
        x = x + peer_ffn(rmsnorm(x, norm_ffn[l]), peer_wq[l], peer_keys[l], peer_u[l], peer_v[l])
    return rmsnorm(x, norm_final)
```

```cpp
#include <hip/hip_runtime.h>
#include <hip/hip_cooperative_groups.h>
#include <stdint.h>
#include <stdio.h>
namespace cg = cooperative_groups;

#ifndef ONE_LAUNCH
#define ONE_LAUNCH 0
#endif

typedef unsigned short bf16_t;
typedef __attribute__((ext_vector_type(8))) short bf16x8;
typedef __attribute__((ext_vector_type(4))) float f32x4;

#define NTHREADS 512
#define TOK 32768
#define SEQL 4096
#define DM 1024
#define EPSV 1e-6f
#define NPHASE 10

#define WS_WIN   ((size_t)0)
#define WS_WUPA  (WS_WIN  + (size_t)5120 * 1024 * 2)
#define WS_WUPB  (WS_WUPA + (size_t)1024 * 512 * 2)
#define WS_WOUT  (WS_WUPB + (size_t)1024 * 512 * 2)
#define WS_WQ    (WS_WOUT + (size_t)1024 * 1024 * 2)
#define WS_KEYS  (WS_WQ   + (size_t)2048 * 1024 * 2)
#define WS_LB    (WS_KEYS + (size_t)2 * 8 * 128 * 128 * 2)
#define WS_U     (WS_LB   + (size_t)4096)
#define WS_V     (WS_U    + (size_t)16384 * 1024 * 2)
#define WS_XN    (WS_V    + (size_t)16384 * 1024 * 2)
#define WS_PH    (WS_XN   + (size_t)TOK * 1024 * 2)
#define WS_PA    (WS_PH   + (size_t)TOK * 2048 * 2)
#define WS_PG    (WS_PA   + (size_t)TOK * 1024 * 2)
#define WS_EIDX  (WS_PG   + (size_t)TOK * 2048 * 2)
#define WS_GW    (WS_EIDX + (size_t)TOK * 128 * 4)
#define WS_END   (WS_GW   + (size_t)TOK * 128 * 4)

#define LDS_BYTES 147456

struct Params {
  const float* x; const float* norm_mix; const float* w_in; const float* hg_lb; const float* hg_norm;
  const float* ikg; const float* ikb; const float* rel_bias; const float* w_up_a; const float* w_up_b;
  const float* w_out; const float* norm_ffn; const float* peer_wq; const float* peer_keys;
  const float* peer_u; const float* peer_v; const float* norm_final;
  float* out; unsigned char* ws; int ph_lo, ph_hi;
};

__device__ __forceinline__ float bf2f(bf16_t u) { return __uint_as_float(((unsigned)u) << 16); }
__device__ __forceinline__ bf16_t f2bf(float f) {
  unsigned u = __float_as_uint(f);
  u += 0x7fffu + ((u >> 16) & 1u);
  return (bf16_t)(u >> 16);
}
__device__ __forceinline__ unsigned pack2(float a, float b) { return (unsigned)f2bf(a) | ((unsigned)f2bf(b) << 16); }
__device__ __forceinline__ float wave_sum(float v) {
#pragma unroll
  for (int o = 32; o > 0; o >>= 1) v += __shfl_xor(v, o);
  return v;
}
__device__ __forceinline__ float sigmoidf_(float x) { return 1.f / (1.f + __expf(-x)); }
__device__ __forceinline__ float siluf_(float x) { return x / (1.f + __expf(-x)); }

__device__ __forceinline__ void gemm_tile(const bf16_t* __restrict__ A, int lda, const bf16_t* __restrict__ Bt, int ldb,
                                          int nk, f32x4 (&acc)[4][4], unsigned char* smem) {
  const int tid = threadIdx.x, lane = tid & 63, w = tid >> 6, wm = w >> 1, wn = w & 1, l15 = lane & 15, g = lane >> 4;
  unsigned char* sA = smem;
  unsigned char* sB = smem + 32768;
  const int lr = tid >> 3, lc = tid & 7;
  const bf16_t* ga = A + (size_t)lr * lda + lc * 8;
  const bf16_t* gb = Bt + (size_t)lr * ldb + lc * 8;
  uint4 ra0, ra1, ra2, ra3, rb0, rb1;
  ra0 = *(const uint4*)(ga);
  ra1 = *(const uint4*)(ga + (size_t)64 * lda);
  ra2 = *(const uint4*)(ga + (size_t)128 * lda);
  ra3 = *(const uint4*)(ga + (size_t)192 * lda);
  rb0 = *(const uint4*)(gb);
  rb1 = *(const uint4*)(gb + (size_t)64 * ldb);
  const int sw = (lc ^ (lr & 7)) << 4;
  for (int kt = 0; kt < nk; ++kt) {
    __syncthreads();
    *(uint4*)(sA + (lr) * 128 + sw) = ra0;
    *(uint4*)(sA + (lr + 64) * 128 + sw) = ra1;
    *(uint4*)(sA + (lr + 128) * 128 + sw) = ra2;
    *(uint4*)(sA + (lr + 192) * 128 + sw) = ra3;
    *(uint4*)(sB + (lr) * 128 + sw) = rb0;
    *(uint4*)(sB + (lr + 64) * 128 + sw) = rb1;
    __syncthreads();
    if (kt + 1 < nk) {
      const int ko = (kt + 1) * 64;
      ra0 = *(const uint4*)(ga + ko);
      ra1 = *(const uint4*)(ga + (size_t)64 * lda + ko);
      ra2 = *(const uint4*)(ga + (size_t)128 * lda + ko);
      ra3 = *(const uint4*)(ga + (size_t)192 * lda + ko);
      rb0 = *(const uint4*)(gb + ko);
      rb1 = *(const uint4*)(gb + (size_t)64 * ldb + ko);
    }
#pragma unroll
    for (int ks = 0; ks < 2; ++ks) {
      bf16x8 a[4], b[4];
#pragma unroll
      for (int m = 0; m < 4; ++m) { const int r = wm * 64 + m * 16 + l15; a[m] = *(const bf16x8*)(sA + r * 128 + (((ks * 4 + g) ^ (r & 7)) << 4)); }
#pragma unroll
      for (int n = 0; n < 4; ++n) { const int r = wn * 64 + n * 16 + l15; b[n] = *(const bf16x8*)(sB + r * 128 + (((ks * 4 + g) ^ (r & 7)) << 4)); }
#pragma unroll
      for (int m = 0; m < 4; ++m)
#pragma unroll
        for (int n = 0; n < 4; ++n) acc[m][n] = __builtin_amdgcn_mfma_f32_16x16x32_bf16(a[m], b[n], acc[m][n], 0, 0, 0);
    }
  }
}

__device__ __forceinline__ void zero_acc(f32x4 (&acc)[4][4]) {
#pragma unroll
  for (int m = 0; m < 4; ++m)
#pragma unroll
    for (int n = 0; n < 4; ++n) acc[m][n] = (f32x4){0.f, 0.f, 0.f, 0.f};
}

__device__ __forceinline__ void transpose_tile(const float* __restrict__ src, int srcN, bf16_t* __restrict__ dst, int K, int n0, int k0,
                                               bool winmap, float* tile) {
  const int tid = threadIdx.x;
  const int nc = tid & 63, kr = tid >> 6;
  int ncol = n0 + nc; bool valid = true;
  if (winmap) { if (ncol >= 3072) ncol -= 60; else if (ncol >= 3012) valid = false; }
#pragma unroll
  for (int i = 0; i < 8; ++i) {
    const int k = kr + 8 * i;
    tile[k * 65 + nc] = valid ? src[(size_t)(k0 + k) * srcN + ncol] : 0.f;
  }
  __syncthreads();
#pragma unroll
  for (int i = 0; i < 8; ++i) {
    const int nr = kr + 8 * i;
    dst[(size_t)(n0 + nr) * K + k0 + nc] = f2bf(tile[nc * 65 + nr]);
  }
  __syncthreads();
}

__device__ __forceinline__ void convert_f32_bf16(const float* __restrict__ src, bf16_t* __restrict__ dst, size_t n4) {
  for (size_t i = (size_t)blockIdx.x * NTHREADS + threadIdx.x; i < n4; i += (size_t)gridDim.x * NTHREADS) {
    const float4 v = ((const float4*)src)[i];
    uint2 o; o.x = pack2(v.x, v.y); o.y = pack2(v.z, v.w);
    ((uint2*)dst)[i] = o;
  }
}

__device__ __forceinline__ void rmsnorm_rows(const float* __restrict__ src, const float* __restrict__ g, bf16_t* __restrict__ dst) {
  const int lane = threadIdx.x & 63, w = threadIdx.x >> 6;
  for (int row = blockIdx.x * 8 + w; row < TOK; row += gridDim.x * 8) {
    const float4* s4 = (const float4*)(src + (size_t)row * DM);
    float4 v[4]; float ss = 0.f;
#pragma unroll
    for (int i = 0; i < 4; ++i) { v[i] = s4[lane + 64 * i]; ss += v[i].x * v[i].x + v[i].y * v[i].y + v[i].z * v[i].z + v[i].w * v[i].w; }
    ss = wave_sum(ss);
    const float rstd = rsqrtf(ss * (1.f / DM) + EPSV);
#pragma unroll
    for (int i = 0; i < 4; ++i) {
      const float4 gg = ((const float4*)g)[lane + 64 * i];
      uint2 o; o.x = pack2(v[i].x * rstd * gg.x, v[i].y * rstd * gg.y); o.y = pack2(v[i].z * rstd * gg.z, v[i].w * rstd * gg.w);
      ((uint2*)(dst + (size_t)row * DM))[lane + 64 * i] = o;
    }
  }
}

__device__ __forceinline__ void phase_prep(const Params& p, unsigned char* smem) {
  unsigned char* ws = p.ws;
  float* tile = (float*)smem;
  const int n_win = 80 * 16, n_ua = 16 * 8, n_ub = 16 * 8, n_wo = 16 * 16, n_wq = 32 * 16;
  const int total = n_win + n_ua + n_ub + n_wo + n_wq;
  for (int it = blockIdx.x; it < total; it += gridDim.x) {
    int t = it;
    if (t < n_win) { transpose_tile(p.w_in, 5060, (bf16_t*)(ws + WS_WIN), 1024, (t >> 4) * 64, (t & 15) * 64, true, tile); continue; }
    t -= n_win;
    if (t < n_ua) { transpose_tile(p.w_up_a, 1024, (bf16_t*)(ws + WS_WUPA), 512, (t >> 3) * 64, (t & 7) * 64, false, tile); continue; }
    t -= n_ua;
    if (t < n_ub) { transpose_tile(p.w_up_b, 1024, (bf16_t*)(ws + WS_WUPB), 512, (t >> 3) * 64, (t & 7) * 64, false, tile); continue; }
    t -= n_ub;
    if (t < n_wo) { transpose_tile(p.w_out, 1024, (bf16_t*)(ws + WS_WOUT), 1024, (t >> 4) * 64, (t & 15) * 64, false, tile); continue; }
    t -= n_wo;
    transpose_tile(p.peer_wq, 2048, (bf16_t*)(ws + WS_WQ), 1024, (t >> 4) * 64, (t & 15) * 64, false, tile);
  }
  convert_f32_bf16(p.peer_u, (bf16_t*)(ws + WS_U), (size_t)16384 * 1024 / 4);
  convert_f32_bf16(p.peer_v, (bf16_t*)(ws + WS_V), (size_t)16384 * 1024 / 4);
  convert_f32_bf16(p.peer_keys, (bf16_t*)(ws + WS_KEYS), (size_t)2 * 8 * 128 * 128 / 4);
  if (blockIdx.x == 0) {
    const int i = threadIdx.x;
    const float a0 = p.hg_lb[i], a1 = p.hg_lb[512 + i];
    ((float*)(ws + WS_LB))[i] = 1.f / (1.f + expf(a1 - a0));
  }
  rmsnorm_rows(p.x, p.norm_mix, (bf16_t*)(ws + WS_XN));
}

__device__ __forceinline__ void phase_proj(const Params& p, unsigned char* smem) {
  unsigned char* ws = p.ws;
  const bf16_t* xn = (const bf16_t*)(ws + WS_XN);
  const bf16_t* wt = (const bf16_t*)(ws + WS_WIN);
  bf16_t* pH = (bf16_t*)(ws + WS_PH);
  bf16_t* pA = (bf16_t*)(ws + WS_PA);
  bf16_t* pG = (bf16_t*)(ws + WS_PG);
  const int tid = threadIdx.x, lane = tid & 63, w = tid >> 6, wm = w >> 1, wn = w & 1, l15 = lane & 15, g = lane >> 4;
  for (int tile = blockIdx.x; tile < 128 * 40; tile += gridDim.x) {
    const int tn = tile % 40, tm = tile / 40;
    f32x4 acc[4][4]; zero_acc(acc);
    gemm_tile(xn + (size_t)tm * 256 * 1024, 1024, wt + (size_t)tn * 128 * 1024, 1024, 16, acc, smem);
    const int rbase = tm * 256 + wm * 64 + 4 * g;
    const int cbase = tn * 128 + wn * 64 + l15;
    if (tn < 16) {
#pragma unroll
      for (int m = 0; m < 4; ++m)
#pragma unroll
        for (int n = 0; n < 4; ++n)
#pragma unroll
          for (int j = 0; j < 4; ++j) pH[(size_t)(rbase + m * 16 + j) * 2048 + cbase + n * 16] = f2bf(acc[m][n][j]);
    } else if (tn < 24) {
      if (tn == 23 && wn == 0) {
        float gam[4], bet[4];
#pragma unroll
        for (int n = 0; n < 4; ++n) { gam[n] = p.ikg[n * 16 + l15]; bet[n] = p.ikb[n * 16 + l15]; }
#pragma unroll
        for (int m = 0; m < 4; ++m)
#pragma unroll
          for (int j = 0; j < 4; ++j) {
            float s = acc[m][0][j] + acc[m][1][j] + acc[m][2][j] + acc[m][3][j];
            s += __shfl_xor(s, 1); s += __shfl_xor(s, 2); s += __shfl_xor(s, 4); s += __shfl_xor(s, 8);
            const float mu = s * (1.f / 64.f);
            float q = 0.f;
#pragma unroll
            for (int n = 0; n < 4; ++n) { const float d = acc[m][n][j] - mu; q += d * d; }
            q += __shfl_xor(q, 1); q += __shfl_xor(q, 2); q += __shfl_xor(q, 4); q += __shfl_xor(q, 8);
            const float rstd = rsqrtf(q * (1.f / 64.f) + EPSV);
#pragma unroll
            for (int n = 0; n < 4; ++n)
              pA[(size_t)(rbase + m * 16 + j) * 1024 + (cbase - 2048) + n * 16] = f2bf((acc[m][n][j] - mu) * rstd * gam[n] + bet[n]);
          }
      } else {
#pragma unroll
        for (int m = 0; m < 4; ++m)
#pragma unroll
          for (int n = 0; n < 4; ++n)
#pragma unroll
            for (int j = 0; j < 4; ++j) pA[(size_t)(rbase + m * 16 + j) * 1024 + (cbase - 2048) + n * 16] = f2bf(acc[m][n][j]);
      }
    } else {
#pragma unroll
      for (int m = 0; m < 4; ++m)
#pragma unroll
        for (int n = 0; n < 4; ++n)
#pragma unroll
          for (int j = 0; j < 4; ++j) pG[(size_t)(rbase + m * 16 + j) * 2048 + (cbase - 3072) + n * 16] = f2bf(sigmoidf_(acc[m][n][j]));
    }
  }
}

__device__ __forceinline__ void hgrn_item(const Params& p, unsigned char* smem, int bh) {
  unsigned char* ws = p.ws;
  const bf16_t* pH = (const bf16_t*)(ws + WS_PH);
  const float* lbp = (const float*)(ws + WS_LB);
  bf16_t* ya = (bf16_t*)(ws + WS_XN);
  bf16_t* Qt = (bf16_t*)smem;
  bf16_t* Kt = Qt + 64 * 136;
  bf16_t* KtT = Kt + 64 * 136;
  bf16_t* VT = KtT + 128 * 72;
  bf16_t* Am = VT + 128 * 72;
  bf16_t* ST = Am + 64 * 72;
  float* qtot = (float*)(ST + 128 * 136);
  float* eref = qtot + 512;
  float* elast = eref + 128;
  float* elr = elast + 128;
  float* red = elr + 128;
  const int tid = threadIdx.x, lane = tid & 63, w = tid >> 6, l15 = lane & 15, g = lane >> 4;
  const int b = bh >> 2, h = bh & 3;
  const int d = tid & 127, tq = tid >> 7;
  const float lbv = lbp[h * 128 + d];
  f32x4 S[8];
#pragma unroll
  for (int i = 0; i < 8; ++i) S[i] = (f32x4){0.f, 0.f, 0.f, 0.f};
  const float gnv = p.hg_norm[h * 128 + 16 * w + l15];

  for (int chunk = 0; chunk < 64; ++chunk) {
    const size_t row0 = (size_t)b * SEQL + chunk * 64;
    {
      const bf16_t* base = pH + (row0 + tq * 16) * 2048 + h * 128 + d;
      float lf[16], kk[16], qs[16];
      unsigned vv[8];
      float run = 0.f;
#pragma unroll
      for (int i = 0; i < 16; ++i) {
        const float fr = bf2f(base[(size_t)i * 2048 + 512]);
        const float qr = bf2f(base[(size_t)i * 2048]);
        const float sg = sigmoidf_(fr);
        const float fg = lbv + (1.f - lbv) * sg;
        run += __logf(fg);
        lf[i] = run; kk[i] = 1.f - fg; qs[i] = siluf_(qr);
      }
#pragma unroll
      for (int i = 0; i < 8; ++i) {
        const unsigned lo = base[(size_t)(2 * i) * 2048 + 1024], hi = base[(size_t)(2 * i + 1) * 2048 + 1024];
        vv[i] = lo | (hi << 16);
      }
      qtot[tq * 128 + d] = run;
      __syncthreads();
      const float q0 = qtot[d], q1 = qtot[128 + d], q2 = qtot[256 + d], q3 = qtot[384 + d];
      const float pre = (tq > 0 ? q0 : 0.f) + (tq > 1 ? q1 : 0.f) + (tq > 2 ? q2 : 0.f);
      const float bref = q0 + q1;
      const float blast = bref + q2 + q3;
      unsigned kp[8];
#pragma unroll
      for (int i = 0; i < 16; ++i) {
        const float bt = pre + lf[i];
        const float qt = qs[i] * __expf(bt - bref);
        const float kt = kk[i] * __expf(bref - bt);
        const int t = tq * 16 + i;
        Qt[t * 136 + d] = f2bf(qt);
        const bf16_t kb = f2bf(kt);
        Kt[t * 136 + d] = kb;
        if (i & 1) kp[i >> 1] |= ((unsigned)kb) << 16; else kp[i >> 1] = kb;
      }
      *(uint4*)(KtT + d * 72 + tq * 16) = make_uint4(kp[0], kp[1], kp[2], kp[3]);
      *(uint4*)(KtT + d * 72 + tq * 16 + 8) = make_uint4(kp[4], kp[5], kp[6], kp[7]);
      *(uint4*)(VT + d * 72 + tq * 16) = make_uint4(vv[0], vv[1], vv[2], vv[3]);
      *(uint4*)(VT + d * 72 + tq * 16 + 8) = make_uint4(vv[4], vv[5], vv[6], vv[7]);
      if (tq == 0) { eref[d] = __expf(bref); elast[d] = __expf(blast); elr[d] = __expf(blast - bref); }
    }
    __syncthreads();
    {
      const int e = 16 * w + l15;
#pragma unroll
      for (int dm = 0; dm < 8; ++dm) {
        const int d0 = 16 * dm + 4 * g;
        uint2 o;
        o.x = pack2(S[dm][0] * eref[d0], S[dm][1] * eref[d0 + 1]);
        o.y = pack2(S[dm][2] * eref[d0 + 2], S[dm][3] * eref[d0 + 3]);
        *(uint2*)(ST + e * 136 + d0) = o;
      }
#pragma unroll
      for (int tt = 0; tt < 2; ++tt) {
        const int tl = 2 * w + tt, sm = tl >> 2, tn = tl & 3;
        f32x4 acc = (f32x4){0.f, 0.f, 0.f, 0.f};
        if (tn >= sm) {
#pragma unroll
          for (int k0 = 0; k0 < 128; k0 += 32) {
            const bf16x8 a = *(const bf16x8*)(Kt + (sm * 16 + l15) * 136 + k0 + 8 * g);
            const bf16x8 bq = *(const bf16x8*)(Qt + (tn * 16 + l15) * 136 + k0 + 8 * g);
            acc = __builtin_amdgcn_mfma_f32_16x16x32_bf16(a, bq, acc, 0, 0, 0);
          }
        }
        const int t = tn * 16 + l15, s0 = sm * 16 + 4 * g;
        uint2 o;
        o.x = pack2(s0 + 0 <= t ? acc[0] : 0.f, s0 + 1 <= t ? acc[1] : 0.f);
        o.y = pack2(s0 + 2 <= t ? acc[2] : 0.f, s0 + 3 <= t ? acc[3] : 0.f);
        *(uint2*)(Am + t * 72 + s0) = o;
      }
    }
    __syncthreads();
    f32x4 o[4];
    {
#pragma unroll
      for (int tm = 0; tm < 4; ++tm) {
        f32x4 acc = (f32x4){0.f, 0.f, 0.f, 0.f};
#pragma unroll
        for (int k0 = 0; k0 < 128; k0 += 32) {
          const bf16x8 a = *(const bf16x8*)(Qt + (tm * 16 + l15) * 136 + k0 + 8 * g);
          const bf16x8 bb = *(const bf16x8*)(ST + (16 * w + l15) * 136 + k0 + 8 * g);
          acc = __builtin_amdgcn_mfma_f32_16x16x32_bf16(a, bb, acc, 0, 0, 0);
        }
#pragma unroll
        for (int k0 = 0; k0 < 64; k0 += 32) {
          const bf16x8 a = *(const bf16x8*)(Am + (tm * 16 + l15) * 72 + k0 + 8 * g);
          const bf16x8 bb = *(const bf16x8*)(VT + (16 * w + l15) * 72 + k0 + 8 * g);
          acc = __builtin_amdgcn_mfma_f32_16x16x32_bf16(a, bb, acc, 0, 0, 0);
        }
        o[tm] = acc;
#pragma unroll
        for (int j = 0; j < 4; ++j) {
          float ss = acc[j] * acc[j];
          ss += __shfl_xor(ss, 1); ss += __shfl_xor(ss, 2); ss += __shfl_xor(ss, 4); ss += __shfl_xor(ss, 8);
          if (l15 == 0) red[w * 64 + tm * 16 + 4 * g + j] = ss;
        }
      }
#pragma unroll
      for (int dm = 0; dm < 8; ++dm) {
        f32x4 acc = (f32x4){0.f, 0.f, 0.f, 0.f};
#pragma unroll
        for (int k0 = 0; k0 < 64; k0 += 32) {
          const bf16x8 a = *(const bf16x8*)(KtT + (dm * 16 + l15) * 72 + k0 + 8 * g);
          const bf16x8 bb = *(const bf16x8*)(VT + (16 * w + l15) * 72 + k0 + 8 * g);
          acc = __builtin_amdgcn_mfma_f32_16x16x32_bf16(a, bb, acc, 0, 0, 0);
        }
#pragma unroll
        for (int j = 0; j < 4; ++j) { const int dd = 16 * dm + 4 * g + j; S[dm][j] = elast[dd] * S[dm][j] + elr[dd] * acc[j]; }
      }
    }
    __syncthreads();
    {
      const int e = 16 * w + l15;
#pragma unroll
      for (int tm = 0; tm < 4; ++tm)
#pragma unroll
        for (int j = 0; j < 4; ++j) {
          const int t = tm * 16 + 4 * g + j;
          float tot = 0.f;
#pragma unroll
          for (int ww = 0; ww < 8; ++ww) tot += red[ww * 64 + t];
          const float rstd = rsqrtf(tot * (1.f / 128.f) + EPSV);
          const float og = bf2f(pH[(row0 + t) * 2048 + 1536 + h * 128 + e]);
          ya[(row0 + t) * 512 + h * 128 + e] = f2bf(o[tm][j] * rstd * gnv * siluf_(og));
        }
    }
  }
}

__device__ __forceinline__ unsigned sortable_key(float v) {
  unsigned bits = __float_as_uint(v);
  if (bits == 0x80000000u) bits = 0u;
  return (bits & 0x80000000u) ? ~bits : (bits | 0x80000000u);
}

__device__ __forceinline__ void dsa_item(const Params& p, unsigned char* smem, int item) {
  unsigned char* ws = p.ws;
  const bf16_t* pA = (const bf16_t*)(ws + WS_PA);
  bf16_t* yb = (bf16_t*)(ws + WS_XN) + (size_t)TOK * 512;
  unsigned* sc = (unsigned*)smem;
  unsigned* hist = sc + 8 * 4096;
  unsigned short* sel = (unsigned short*)(hist + 8 * 256);
  unsigned char* bkt = (unsigned char*)(sel + 8 * 256);
  const int tid = threadIdx.x, lane = tid & 63, w = tid >> 6, l15 = lane & 15, g = lane >> 4;
  const int b = item >> 9;
  const int r = item & 511;
  const int tb = (b & 1) ? 511 - r : r;
  const int t0 = tb * 8;
  const size_t tokbase = (size_t)b * SEQL;

  {
    bf16x8 af[2][2];
    float wq[2][4];
#pragma unroll
    for (int mt = 0; mt < 2; ++mt) {
      const int qrow = t0 + mt * 4 + (l15 >> 2), head = l15 & 3;
#pragma unroll
      for (int ks = 0; ks < 2; ++ks)
        af[mt][ks] = *(const bf16x8*)(pA + (tokbase + qrow) * 1024 + 640 + head * 64 + ks * 32 + 8 * g);
      const uint2 wr = *(const uint2*)(pA + (tokbase + t0 + mt * 4 + g) * 1024 + 960);
      wq[mt][0] = 0.5f * bf2f((bf16_t)(wr.x & 0xffff)); wq[mt][1] = 0.5f * bf2f((bf16_t)(wr.x >> 16));
      wq[mt][2] = 0.5f * bf2f((bf16_t)(wr.y & 0xffff)); wq[mt][3] = 0.5f * bf2f((bf16_t)(wr.y >> 16));
    }
    const int nkt = (t0 + 8 + 15) >> 4;
    for (int kt = w; kt < nkt; kt += 8) {
      const int s = kt * 16 + l15;
      const bf16_t* kr = pA + (tokbase + s) * 1024 + 896 + 8 * g;
      const bf16x8 b0 = *(const bf16x8*)kr;
      const bf16x8 b1 = *(const bf16x8*)(kr + 32);
#pragma unroll
      for (int mt = 0; mt < 2; ++mt) {
        f32x4 acc = (f32x4){0.f, 0.f, 0.f, 0.f};
        acc = __builtin_amdgcn_mfma_f32_16x16x32_bf16(af[mt][0], b0, acc, 0, 0, 0);
        acc = __builtin_amdgcn_mfma_f32_16x16x32_bf16(af[mt][1], b1, acc, 0, 0, 0);
        float v = 0.f;
#pragma unroll
        for (int j = 0; j < 4; ++j) v += wq[mt][j] * fmaxf(acc[j] * 0.125f, 0.f);
        const int t = t0 + mt * 4 + g;
        sc[(mt * 4 + g) * 4096 + s] = (s <= t) ? sortable_key(v) : 0u;
      }
    }
  }
  __syncthreads();
  const int t = t0 + w;
  const int n = t + 1;
  unsigned* row = sc + w * 4096;
  unsigned short* mysel = sel + w * 256;
  unsigned* myh = hist + w * 256;
  int cnt;
  const unsigned long long lt_mask = (1ull << lane) - 1ull;
  if (n <= 256) {
    for (int i = lane; i < n; i += 64) mysel[i] = (unsigned short)i;
    cnt = n;
  } else {
    unsigned prefix = 0u, krem = 256u;
#pragma unroll 1
    for (int pass = 0; pass < 4; ++pass) {
      const int shift = 24 - 8 * pass;
      const unsigned himask = (pass == 0) ? 0u : (0xFFFFFFFFu << (shift + 8));
#pragma unroll
      for (int i = 0; i < 4; ++i) myh[lane + 64 * i] = 0u;
      __threadfence_block();
      for (int i = lane; i < n; i += 64) {
        const unsigned u = row[i];
        if ((u & himask) == prefix) atomicAdd(&myh[(u >> shift) & 255u], 1u);
      }
      __threadfence_block();
      const uint4 c4 = *(const uint4*)(myh + 4 * lane);
      const unsigned c = c4.x + c4.y + c4.z + c4.w;
      unsigned s = c;
#pragma unroll
      for (int o = 1; o < 64; o <<= 1) { const unsigned tt = __shfl_down(s, o); if (lane + o < 64) s += tt; }
      const unsigned long long bal = __ballot(s >= krem);
      const int L = 63 - __clzll(bal);
      const unsigned sL = __shfl(s, L), cL = __shfl(c, L);
      const unsigned b3 = __shfl(c4.w, L), b2 = __shfl(c4.z, L), b1 = __shfl(c4.y, L);
      unsigned cum = sL - cL;
      unsigned digit;
      if (cum + b3 >= krem) digit = 3;
      else { cum += b3; if (cum + b2 >= krem) digit = 2; else { cum += b2; if (cum + b1 >= krem) digit = 1; else { cum += b1; digit = 0; } } }
      krem -= cum;
      prefix |= ((unsigned)(4 * L) + digit) << shift;
    }
    const unsigned T = prefix;
    unsigned base = 0u, eqtaken = 0u;
    for (int i0 = 0; i0 < n; i0 += 64) {
      const int i = i0 + lane;
      const bool valid = i < n;
      const unsigned u = valid ? row[i] : 0u;
      const bool gt = valid && (u > T);
      const bool eq = valid && (u == T);
      const unsigned long long beq = __ballot(eq);
      const unsigned eqrank = eqtaken + (unsigned)__popcll(beq & lt_mask);
      const bool take = gt || (eq && eqrank < krem);
      const unsigned long long bt = __ballot(take);
      const unsigned pos = base + (unsigned)__popcll(bt & lt_mask);
      if (take && pos < 256u) mysel[pos] = (unsigned short)i;
      base += (unsigned)__popcll(bt);
      eqtaken += (unsigned)__popcll(beq);
    }
    cnt = 256;
  }
  __threadfence_block();
  {
    const int ks = lane >> 3, dc = lane & 7;
    float* pl = (float*)row;
    float qf[8][8];
#pragma unroll
    for (int hh = 0; hh < 8; ++hh) {
      const uint4 qv = *(const uint4*)(pA + (tokbase + t) * 1024 + hh * 64 + dc * 8);
      qf[hh][0] = 0.125f * __uint_as_float(qv.x << 16); qf[hh][1] = 0.125f * __uint_as_float(qv.x & 0xffff0000u);
      qf[hh][2] = 0.125f * __uint_as_float(qv.y << 16); qf[hh][3] = 0.125f * __uint_as_float(qv.y & 0xffff0000u);
      qf[hh][4] = 0.125f * __uint_as_float(qv.z << 16); qf[hh][5] = 0.125f * __uint_as_float(qv.z & 0xffff0000u);
      qf[hh][6] = 0.125f * __uint_as_float(qv.w << 16); qf[hh][7] = 0.125f * __uint_as_float(qv.w & 0xffff0000u);
    }
    const int niter = (cnt + 7) >> 3;
    for (int it = 0; it < niter; ++it) {
      const int kk = it * 8 + ks;
      const bool valid = kk < cnt;
      const int s = valid ? (int)mysel[kk] : 0;
      const uint4 kv = *(const uint4*)(pA + (tokbase + s) * 1024 + 512 + dc * 8);
      float kf[8];
      kf[0] = __uint_as_float(kv.x << 16); kf[1] = __uint_as_float(kv.x & 0xffff0000u);
      kf[2] = __uint_as_float(kv.y << 16); kf[3] = __uint_as_float(kv.y & 0xffff0000u);
      kf[4] = __uint_as_float(kv.z << 16); kf[5] = __uint_as_float(kv.z & 0xffff0000u);
      kf[6] = __uint_as_float(kv.w << 16); kf[7] = __uint_as_float(kv.w & 0xffff0000u);
      float mine = 0.f;
#pragma unroll
      for (int hh = 0; hh < 8; ++hh) {
        float pp = 0.f;
#pragma unroll
        for (int i = 0; i < 8; ++i) pp += kf[i] * qf[hh][i];
        pp += __shfl_xor(pp, 1); pp += __shfl_xor(pp, 2); pp += __shfl_xor(pp, 4);
        if (dc == hh) mine = pp;
      }
      const int dist = t - s;
      const int bk = dist < 128 ? (int)bkt[dist] : 31;
      const float lg = valid ? (mine + p.rel_bias[bk * 8 + dc]) : -INFINITY;
      pl[kk * 8 + dc] = lg;
    }
    __threadfence_block();
    float inv;
    {
      const int hh = lane & 7, part = lane >> 3;
      float m = -INFINITY;
      for (int kk = part; kk < cnt; kk += 8) m = fmaxf(m, pl[kk * 8 + hh]);
      m = fmaxf(m, __shfl_xor(m, 8)); m = fmaxf(m, __shfl_xor(m, 16)); m = fmaxf(m, __shfl_xor(m, 32));
      float sum = 0.f;
      for (int kk = part; kk < niter * 8; kk += 8) {
        const float e = (kk < cnt) ? __expf(pl[kk * 8 + hh] - m) : 0.f;
        pl[kk * 8 + hh] = e;
        sum += e;
      }
      sum += __shfl_xor(sum, 8); sum += __shfl_xor(sum, 16); sum += __shfl_xor(sum, 32);
      inv = 1.f / sum;
    }
    __threadfence_block();
    float acc[8][8];
#pragma unroll
    for (int hh = 0; hh < 8; ++hh)
#pragma unroll
      for (int i = 0; i < 8; ++i) acc[hh][i] = 0.f;
    for (int it = 0; it < niter; ++it) {
      const int kk = it * 8 + ks;
      const bool valid = kk < cnt;
      const int s = valid ? (int)mysel[kk] : 0;
      const uint4 vv = *(const uint4*)(pA + (tokbase + s) * 1024 + 576 + dc * 8);
      float vf[8];
      vf[0] = __uint_as_float(vv.x << 16); vf[1] = __uint_as_float(vv.x & 0xffff0000u);
      vf[2] = __uint_as_float(vv.y << 16); vf[3] = __uint_as_float(vv.y & 0xffff0000u);
      vf[4] = __uint_as_float(vv.z << 16); vf[5] = __uint_as_float(vv.z & 0xffff0000u);
      vf[6] = __uint_as_float(vv.w << 16); vf[7] = __uint_as_float(vv.w & 0xffff0000u);
      const float4 p0 = *(const float4*)(pl + kk * 8);
      const float4 p1 = *(const float4*)(pl + kk * 8 + 4);
      const float pp[8] = {p0.x, p0.y, p0.z, p0.w, p1.x, p1.y, p1.z, p1.w};
#pragma unroll
      for (int hh = 0; hh < 8; ++hh)
#pragma unroll
        for (int i = 0; i < 8; ++i) acc[hh][i] += pp[hh] * vf[i];
    }
#pragma unroll
    for (int hh = 0; hh < 8; ++hh) {
      const float ih = __shfl(inv, hh);
#pragma unroll
      for (int i = 0; i < 8; ++i) {
        float v = acc[hh][i];
        v += __shfl_xor(v, 8); v += __shfl_xor(v, 16); v += __shfl_xor(v, 32);
        acc[hh][i] = v * ih;
      }
    }
    if (ks == 0) {
#pragma unroll
      for (int hh = 0; hh < 8; ++hh) {
        uint4 o;
        o.x = pack2(acc[hh][0], acc[hh][1]); o.y = pack2(acc[hh][2], acc[hh][3]);
        o.z = pack2(acc[hh][4], acc[hh][5]); o.w = pack2(acc[hh][6], acc[hh][7]);
        *(uint4*)(yb + (tokbase + t) * 512 + hh * 64 + dc * 8) = o;
      }
    }
  }
  __syncthreads();
}

__device__ __forceinline__ void phase_mix(const Params& p, unsigned char* smem) {
  const int G = gridDim.x;
  if (G >= 64) {
    if (blockIdx.x < 32) { hgrn_item(p, smem, blockIdx.x); return; }
    unsigned char* bkt = smem + 8 * 4096 * 4 + 8 * 256 * 4 + 8 * 256 * 2;
    if (threadIdx.x < 128) {
      const int nn = threadIdx.x;
      int v = nn;
      if (nn >= 16) { v = 16 + (int)(logf((float)nn * (1.f / 16.f)) / logf(8.f) * 16.f); if (v > 31) v = 31; }
      bkt[nn] = (unsigned char)v;
    }
    __syncthreads();
    for (int item = blockIdx.x - 32; item < 4096; item += G - 32) dsa_item(p, smem, item);
  } else {
    for (int bh = blockIdx.x; bh < 32; bh += G) { hgrn_item(p, smem, bh); __syncthreads(); }
    unsigned char* bkt = smem + 8 * 4096 * 4 + 8 * 256 * 4 + 8 * 256 * 2;
    __syncthreads();
    if (threadIdx.x < 128) {
      const int nn = threadIdx.x;
      int v = nn;
      if (nn >= 16) { v = 16 + (int)(logf((float)nn * (1.f / 16.f)) / logf(8.f) * 16.f); if (v > 31) v = 31; }
      bkt[nn] = (unsigned char)v;
    }
    __syncthreads();
    for (int item = blockIdx.x; item < 4096; item += G) dsa_item(p, smem, item);
  }
}

__device__ __forceinline__ void phase_up(const Params& p, unsigned char* smem) {
  unsigned char* ws = p.ws;
  const bf16_t* ya = (const bf16_t*)(ws + WS_XN);
  const bf16_t* yb = ya + (size_t)TOK * 512;
  const bf16_t* wa = (const bf16_t*)(ws + WS_WUPA);
  const bf16_t* wb = (const bf16_t*)(ws + WS_WUPB);
  const bf16_t* pG = (const bf16_t*)(ws + WS_PG);
  bf16_t* hb = (bf16_t*)(ws + WS_PH);
  const int tid = threadIdx.x, lane = tid & 63, w = tid >> 6, wm = w >> 1, wn = w & 1, l15 = lane & 15, g = lane >> 4;
  for (int tile = blockIdx.x; tile < 128 * 8; tile += gridDim.x) {
    const int tn = tile & 7, tm = tile >> 3;
    f32x4 acc[4][4]; zero_acc(acc);
    gemm_tile(ya + (size_t)tm * 256 * 512, 512, wa + (size_t)tn * 128 * 512, 512, 8, acc, smem);
    asm volatile("" ::: "memory");
    const int rbase = tm * 256 + wm * 64 + 4 * g;
    const int cbase = tn * 128 + wn * 64 + l15;
#pragma unroll
    for (int m = 0; m < 4; ++m)
#pragma unroll
      for (int n = 0; n < 4; ++n) {
#pragma unroll
        for (int j = 0; j < 4; ++j) {
          const size_t rr = (size_t)(rbase + m * 16 + j);
          hb[rr * 1024 + cbase + n * 16] = f2bf(acc[m][n][j] * bf2f(pG[rr * 2048 + cbase + n * 16]));
        }
        acc[m][n] = (f32x4){0.f, 0.f, 0.f, 0.f};
      }
    asm volatile("" ::: "memory");
    gemm_tile(yb + (size_t)tm * 256 * 512, 512, wb + (size_t)tn * 128 * 512, 512, 8, acc, smem);
    asm volatile("" ::: "memory");
#pragma unroll
    for (int m = 0; m < 4; ++m)
#pragma unroll
      for (int n = 0; n < 4; ++n)
#pragma unroll
        for (int j = 0; j < 4; ++j) {
          const size_t rr = (size_t)(rbase + m * 16 + j);
          const float v = bf2f(hb[rr * 1024 + cbase + n * 16]) + acc[m][n][j] * bf2f(pG[rr * 2048 + 1024 + cbase + n * 16]);
          hb[rr * 1024 + cbase + n * 16] = f2bf(v);
        }
  }
}

__device__ __forceinline__ void phase_out(const Params& p, unsigned char* smem) {
  unsigned char* ws = p.ws;
  const bf16_t* hb = (const bf16_t*)(ws + WS_PH);
  const bf16_t* wo = (const bf16_t*)(ws + WS_WOUT);
  const int tid = threadIdx.x, lane = tid & 63, w = tid >> 6, wm = w >> 1, wn = w & 1, l15 = lane & 15, g = lane >> 4;
  for (int tile = blockIdx.x; tile < 128 * 8; tile += gridDim.x) {
    const int tn = tile & 7, tm = tile >> 3;
    f32x4 acc[4][4]; zero_acc(acc);
    gemm_tile(hb + (size_t)tm * 256 * 1024, 1024, wo + (size_t)tn * 128 * 1024, 1024, 16, acc, smem);
    const int rbase = tm * 256 + wm * 64 + 4 * g;
    const int cbase = tn * 128 + wn * 64 + l15;
#pragma unroll
    for (int m = 0; m < 4; ++m)
#pragma unroll
      for (int n = 0; n < 4; ++n)
#pragma unroll
        for (int j = 0; j < 4; ++j) {
          const size_t idx = (size_t)(rbase + m * 16 + j) * 1024 + cbase + n * 16;
          p.out[idx] = p.x[idx] + acc[m][n][j];
        }
  }
}

__device__ __forceinline__ void phase_pq(const Params& p, unsigned char* smem) {
  unsigned char* ws = p.ws;
  const bf16_t* xn2 = (const bf16_t*)(ws + WS_XN);
  const bf16_t* wq = (const bf16_t*)(ws + WS_WQ);
  bf16_t* qp = (bf16_t*)(ws + WS_PG);
  const int tid = threadIdx.x, lane = tid & 63, w = tid >> 6, wm = w >> 1, wn = w & 1, l15 = lane & 15, g = lane >> 4;
  for (int tile = blockIdx.x; tile < 128 * 16; tile += gridDim.x) {
    const int tn = tile & 15, tm = tile >> 4;
    f32x4 acc[4][4]; zero_acc(acc);
    gemm_tile(xn2 + (size_t)tm * 256 * 1024, 1024, wq + (size_t)tn * 128 * 1024, 1024, 16, acc, smem);
    const int rbase = tm * 256 + wm * 64 + 4 * g;
    const int cbase = tn * 128 + wn * 64 + l15;
#pragma unroll
    for (int m = 0; m < 4; ++m)
#pragma unroll
      for (int n = 0; n < 4; ++n)
#pragma unroll
        for (int j = 0; j < 4; ++j) qp[(size_t)(rbase + m * 16 + j) * 2048 + cbase + n * 16] = f2bf(acc[m][n][j]);
  }
}

__device__ __forceinline__ void phase_pkeys(const Params& p, unsigned char* smem) {
  unsigned char* ws = p.ws;
  const bf16_t* qp = (const bf16_t*)(ws + WS_PG);
  const bf16_t* keys = (const bf16_t*)(ws + WS_KEYS);
  float* ps = (float*)(ws + WS_PA);
  int* pi = (int*)(ws + WS_PA) + (size_t)TOK * 256;
  float* sc = (float*)smem;
  const int tid = threadIdx.x, lane = tid & 63, w = tid >> 6, wm = w >> 1, wn = w & 1, l15 = lane & 15, g = lane >> 4;
  for (int tile = blockIdx.x; tile < 128 * 16; tile += gridDim.x) {
    const int hp = tile & 15, tm = tile >> 4;
    const int h = hp >> 1, ph = hp & 1;
    f32x4 acc[4][4]; zero_acc(acc);
    gemm_tile(qp + (size_t)tm * 256 * 2048 + hp * 128, 2048, keys + (size_t)(ph * 8 + h) * 128 * 128, 128, 2, acc, smem);
    __syncthreads();
#pragma unroll
    for (int m = 0; m < 4; ++m)
#pragma unroll
      for (int n = 0; n < 4; ++n)
#pragma unroll
        for (int j = 0; j < 4; ++j) sc[(wm * 64 + m * 16 + 4 * g + j) * 129 + wn * 64 + n * 16 + l15] = acc[m][n][j];
    __syncthreads();
    if (tid < 256) {
      float* rowp = sc + tid * 129;
      const size_t ob = ((size_t)(tm * 256 + tid) * 16 + hp) * 16;
#pragma unroll 1
      for (int k = 0; k < 16; ++k) {
        float best = -INFINITY; int bi = 0;
        for (int nn = 0; nn < 128; ++nn) { const float v = rowp[nn]; if (v > best) { best = v; bi = nn; } }
        rowp[bi] = -INFINITY;
        ps[ob + k] = best; pi[ob + k] = bi;
      }
    }
    __syncthreads();
  }
}

__device__ __forceinline__ void phase_pcomb(const Params& p, unsigned char* smem) {
  unsigned char* ws = p.ws;
  const float* ps = (const float*)(ws + WS_PA);
  const int* pi = (const int*)(ws + WS_PA) + (size_t)TOK * 256;
  int* eidx = (int*)(ws + WS_EIDX);
  float* gw = (float*)(ws + WS_GW);
  float* s2l = (float*)smem;
  unsigned short* i1l = (unsigned short*)(s2l + 512 * 17);
  unsigned short* i2l = i1l + 512 * 16;
  const int tid = threadIdx.x;
  for (int base = blockIdx.x * NTHREADS; base < TOK * 8; base += gridDim.x * NTHREADS) {
    const int th = base + tid;
    const size_t o1 = (size_t)th * 32;
    float s1[16];
#pragma unroll
    for (int a = 0; a < 16; ++a) {
      s1[a] = ps[o1 + a];
      s2l[tid * 17 + a] = ps[o1 + 16 + a];
      i1l[tid * 16 + a] = (unsigned short)pi[o1 + a];
      i2l[tid * 16 + a] = (unsigned short)pi[o1 + 16 + a];
    }
    float cur[16];
    const float s20 = s2l[tid * 17];
#pragma unroll
    for (int a = 0; a < 16; ++a) cur[a] = s1[a] + s20;
    unsigned long long ptr = 0ull;
    float tops[16]; int tope[16];
#pragma unroll
    for (int k = 0; k < 16; ++k) {
      float best = cur[0]; int ba = 0;
#pragma unroll
      for (int a = 1; a < 16; ++a) if (cur[a] > best) { best = cur[a]; ba = a; }
      const int bb = (int)((ptr >> (4 * ba)) & 15ull);
      tops[k] = best;
      tope[k] = (int)i1l[tid * 16 + ba] * 128 + (int)i2l[tid * 16 + bb];
      const int nb = bb + 1;
      const float ns2 = (nb < 16) ? s2l[tid * 17 + nb] : -INFINITY;
      if (nb < 16) ptr += (1ull << (4 * ba));
#pragma unroll
      for (int a = 0; a < 16; ++a) if (a == ba) cur[a] = s1[a] + ns2;
    }
    float m = tops[0];
    float sum = 0.f;
#pragma unroll
    for (int k = 0; k < 16; ++k) { tops[k] = __expf(tops[k] - m); sum += tops[k]; }
    const float inv = 1.f / sum;
#pragma unroll
    for (int k = 0; k < 16; ++k) { eidx[(size_t)th * 16 + k] = tope[k]; gw[(size_t)th * 16 + k] = tops[k] * inv; }
  }
}

__device__ __forceinline__ void cvt8(const uint4& v, float* f) {
  f[0] = __uint_as_float(v.x << 16); f[1] = __uint_as_float(v.x & 0xffff0000u);
  f[2] = __uint_as_float(v.y << 16); f[3] = __uint_as_float(v.y & 0xffff0000u);
  f[4] = __uint_as_float(v.z << 16); f[5] = __uint_as_float(v.z & 0xffff0000u);
  f[6] = __uint_as_float(v.w << 16); f[7] = __uint_as_float(v.w & 0xffff0000u);
}

__device__ __forceinline__ void phase_expert(const Params& p) {
  unsigned char* ws = p.ws;
  const bf16_t* xn2 = (const bf16_t*)(ws + WS_XN);
  const bf16_t* U = (const bf16_t*)(ws + WS_U);
  const bf16_t* V = (const bf16_t*)(ws + WS_V);
  const int* eidx = (const int*)(ws + WS_EIDX);
  const float* gw = (const float*)(ws + WS_GW);
  const int lane = threadIdx.x & 63, w = threadIdx.x >> 6;
  for (int tok = blockIdx.x * 8 + w; tok < TOK; tok += gridDim.x * 8) {
    float xf[16];
    {
      const uint4 xa = *(const uint4*)(xn2 + (size_t)tok * 1024 + lane * 8);
      const uint4 xb = *(const uint4*)(xn2 + (size_t)tok * 1024 + (lane + 64) * 8);
      cvt8(xa, xf); cvt8(xb, xf + 8);
    }
    const int e0 = eidx[(size_t)tok * 128 + lane], e1 = eidx[(size_t)tok * 128 + 64 + lane];
    const float g0 = gw[(size_t)tok * 128 + lane], g1 = gw[(size_t)tok * 128 + 64 + lane];
    float h0 = 0.f, h1 = 0.f;
#pragma unroll 1
    for (int half = 0; half < 2; ++half) {
      const int ev = half ? e1 : e0;
#pragma unroll 1
      for (int k0 = 0; k0 < 64; k0 += 8) {
        uint4 ua[8], ub[8];
#pragma unroll
        for (int j = 0; j < 8; ++j) {
          const int e = __builtin_amdgcn_readlane(ev, k0 + j);
          const bf16_t* ur = U + (size_t)e * 1024;
          ua[j] = *(const uint4*)(ur + lane * 8);
          ub[j] = *(const uint4*)(ur + (lane + 64) * 8);
        }
#pragma unroll
        for (int j = 0; j < 8; ++j) {
          float uf[16];
          cvt8(ua[j], uf); cvt8(ub[j], uf + 8);
          float pp = 0.f;
#pragma unroll
          for (int i = 0; i < 16; ++i) pp += uf[i] * xf[i];
          pp = wave_sum(pp);
          if (lane == k0 + j) { if (half) h1 = pp; else h0 = pp; }
        }
      }
    }
    const float a0 = 0.5f * h0 * (1.f + erff(h0 * 0.70710678118654752f)) * g0;
    const float a1 = 0.5f * h1 * (1.f + erff(h1 * 0.70710678118654752f)) * g1;
    float acc[16];
#pragma unroll
    for (int i = 0; i < 16; ++i) acc[i] = 0.f;
#pragma unroll 1
    for (int half = 0; half < 2; ++half) {
      const int ev = half ? e1 : e0;
      const int av = __float_as_int(half ? a1 : a0);
#pragma unroll 1
      for (int k0 = 0; k0 < 64; k0 += 8) {
        uint4 va[8], vb[8];
        float aa[8];
#pragma unroll
        for (int j = 0; j < 8; ++j) {
          const int e = __builtin_amdgcn_readlane(ev, k0 + j);
          aa[j] = __int_as_float(__builtin_amdgcn_readlane(av, k0 + j));
          const bf16_t* vr = V + (size_t)e * 1024;
          va[j] = *(const uint4*)(vr + lane * 8);
          vb[j] = *(const uint4*)(vr + (lane + 64) * 8);
        }
#pragma unroll
        for (int j = 0; j < 8; ++j) {
          float vf[16];
          cvt8(va[j], vf); cvt8(vb[j], vf + 8);
#pragma unroll
          for (int i = 0; i < 16; ++i) acc[i] += aa[j] * vf[i];
        }
      }
    }
    float* orow = p.out + (size_t)tok * 1024;
    float x2[16];
    {
      const float4 a = *(const float4*)(orow + lane * 8), b = *(const float4*)(orow + lane * 8 + 4);
      const float4 c = *(const float4*)(orow + (lane + 64) * 8), d = *(const float4*)(orow + (lane + 64) * 8 + 4);
      x2[0] = a.x + acc[0]; x2[1] = a.y + acc[1]; x2[2] = a.z + acc[2]; x2[3] = a.w + acc[3];
      x2[4] = b.x + acc[4]; x2[5] = b.y + acc[5]; x2[6] = b.z + acc[6]; x2[7] = b.w + acc[7];
      x2[8] = c.x + acc[8]; x2[9] = c.y + acc[9]; x2[10] = c.z + acc[10]; x2[11] = c.w + acc[11];
      x2[12] = d.x + acc[12]; x2[13] = d.y + acc[13]; x2[14] = d.z + acc[14]; x2[15] = d.w + acc[15];
    }
    float ss = 0.f;
#pragma unroll
    for (int i = 0; i < 16; ++i) ss += x2[i] * x2[i];
    ss = wave_sum(ss);
    const float rstd = rsqrtf(ss * (1.f / DM) + EPSV);
    const float* nf = p.norm_final;
    {
      const float4 ga = *(const float4*)(nf + lane * 8), gb = *(const float4*)(nf + lane * 8 + 4);
      const float4 gc = *(const float4*)(nf + (lane + 64) * 8), gd = *(const float4*)(nf + (lane + 64) * 8 + 4);
      *(float4*)(orow + lane * 8) = make_float4(x2[0] * rstd * ga.x, x2[1] * rstd * ga.y, x2[2] * rstd * ga.z, x2[3] * rstd * ga.w);
      *(float4*)(orow + lane * 8 + 4) = make_float4(x2[4] * rstd * gb.x, x2[5] * rstd * gb.y, x2[6] * rstd * gb.z, x2[7] * rstd * gb.w);
      *(float4*)(orow + (lane + 64) * 8) = make_float4(x2[8] * rstd * gc.x, x2[9] * rstd * gc.y, x2[10] * rstd * gc.z, x2[11] * rstd * gc.w);
      *(float4*)(orow + (lane + 64) * 8 + 4) = make_float4(x2[12] * rstd * gd.x, x2[13] * rstd * gd.y, x2[14] * rstd * gd.z, x2[15] * rstd * gd.w);
    }
  }
}

__global__ void __launch_bounds__(NTHREADS) hybrid_fwd(Params p) {
  extern __shared__ __attribute__((aligned(16))) unsigned char smem[];
#if ONE_LAUNCH
  cg::grid_group grid = cg::this_grid();
#define SEAM(k) do { if (p.ph_lo <= (k) && (k) + 1 < p.ph_hi) grid.sync(); } while (0)
#else
#define SEAM(k) do { } while (0)
#endif
#define IN(k) (p.ph_lo <= (k) && (k) < p.ph_hi)
  if (IN(0)) { phase_prep(p, smem); SEAM(0); }
  if (IN(1)) { phase_proj(p, smem); SEAM(1); }
  if (IN(2)) { phase_mix(p, smem); SEAM(2); }
  if (IN(3)) { phase_up(p, smem); SEAM(3); }
  if (IN(4)) { phase_out(p, smem); SEAM(4); }
  if (IN(5)) { rmsnorm_rows(p.out, p.norm_ffn, (bf16_t*)(p.ws + WS_XN)); SEAM(5); }
  if (IN(6)) { phase_pq(p, smem); SEAM(6); }
  if (IN(7)) { phase_pkeys(p, smem); SEAM(7); }
  if (IN(8)) { phase_pcomb(p, smem); SEAM(8); }
  if (IN(9)) { phase_expert(p); }
#undef IN
#undef SEAM
}

extern "C" void kernel_launch(void* const* d_in, const int* in_sizes, int n_in, void* d_out, int out_size, void* d_ws, size_t ws_size,
                              hipStream_t stream) {
  static int grid = 0;
  if (grid == 0) {
    if (n_in != 17 || ws_size < WS_END) {
      fprintf(stderr, "kernel_launch: unexpected n_in %d or ws_size %zu (need %zu)\n", n_in, ws_size, (size_t)WS_END);
      grid = -1; return;
    }
    int dev = 0, cus = 0, per_cu = 0;
    hipGetDevice(&dev);
    hipDeviceGetAttribute(&cus, hipDeviceAttributeMultiprocessorCount, dev);
    hipFuncSetAttribute((const void*)hybrid_fwd, hipFuncAttributeMaxDynamicSharedMemorySize, LDS_BYTES);
    hipOccupancyMaxActiveBlocksPerMultiprocessor(&per_cu, (const void*)hybrid_fwd, NTHREADS, LDS_BYTES);
    if (per_cu < 1) { fprintf(stderr, "kernel_launch: occupancy query says %d blocks/CU\n", per_cu); per_cu = 1; }
    (void)hipGetLastError();
    grid = cus;
  }
  if (grid < 0) return;
  Params p{};
  p.x = (const float*)d_in[0]; p.norm_mix = (const float*)d_in[1]; p.w_in = (const float*)d_in[2]; p.hg_lb = (const float*)d_in[3];
  p.hg_norm = (const float*)d_in[4]; p.ikg = (const float*)d_in[5]; p.ikb = (const float*)d_in[6]; p.rel_bias = (const float*)d_in[7];
  p.w_up_a = (const float*)d_in[8]; p.w_up_b = (const float*)d_in[9]; p.w_out = (const float*)d_in[10]; p.norm_ffn = (const float*)d_in[11];
  p.peer_wq = (const float*)d_in[12]; p.peer_keys = (const float*)d_in[13]; p.peer_u = (const float*)d_in[14]; p.peer_v = (const float*)d_in[15];
  p.norm_final = (const float*)d_in[16];
  p.out = (float*)d_out; p.ws = (unsigned char*)d_ws;
#if ONE_LAUNCH
  p.ph_lo = 0; p.ph_hi = NPHASE;
  void* args[] = {&p};
  hipError_t e = hipLaunchCooperativeKernel((const void*)hybrid_fwd, dim3(grid), dim3(NTHREADS), args, LDS_BYTES, stream);
  if (e != hipSuccess) fprintf(stderr, "cooperative launch failed: %s (grid %d)\n", hipGetErrorString(e), grid);
#else
  for (int ph = 0; ph < NPHASE; ++ph) {
    p.ph_lo = ph; p.ph_hi = ph + 1;
    hipLaunchKernelGGL(hybrid_fwd, dim3(grid), dim3(NTHREADS), LDS_BYTES, stream, p);
  }
#endif
}
```

```cpp
#include <hip/hip_runtime.h>
#include <hip/hip_cooperative_groups.h>
#include <stdint.h>
#include <stdio.h>
namespace cg = cooperative_groups;

#ifndef ONE_LAUNCH
#define ONE_LAUNCH 1
#endif

typedef unsigned short bf16_t;
typedef __attribute__((ext_vector_type(8))) short bf16x8;
typedef __attribute__((ext_vector_type(4))) float f32x4;

#define NTHREADS 512
#define TOK 32768
#define SEQL 4096
#define DM 1024
#define EPSV 1e-6f
#define NPHASE 10

#define WS_WIN   ((size_t)0)
#define WS_WUPA  (WS_WIN  + (size_t)5120 * 1024 * 2)
#define WS_WUPB  (WS_WUPA + (size_t)1024 * 512 * 2)
#define WS_WOUT  (WS_WUPB + (size_t)1024 * 512 * 2)
#define WS_WQ    (WS_WOUT + (size_t)1024 * 1024 * 2)
#define WS_KEYS  (WS_WQ   + (size_t)2048 * 1024 * 2)
#define WS_LB    (WS_KEYS + (size_t)2 * 8 * 128 * 128 * 2)
#define WS_U     (WS_LB   + (size_t)4096)
#define WS_V     (WS_U    + (size_t)16384 * 1024 * 2)
#define WS_XN    (WS_V    + (size_t)16384 * 1024 * 2)
#define WS_PH    (WS_XN   + (size_t)TOK * 1024 * 2)
#define WS_PA    (WS_PH   + (size_t)TOK * 2048 * 2)
#define WS_PG    (WS_PA   + (size_t)TOK * 1024 * 2)
#define WS_EIDX  (WS_PG   + (size_t)TOK * 2048 * 2)
#define WS_GW    (WS_EIDX + (size_t)TOK * 128 * 4)
#define WS_END   (WS_GW   + (size_t)TOK * 128 * 4)

#define LDS_BYTES 147456

struct Params {
  const float* x; const float* norm_mix; const float* w_in; const float* hg_lb; const float* hg_norm;
  const float* ikg; const float* ikb; const float* rel_bias; const float* w_up_a; const float* w_up_b;
  const float* w_out; const float* norm_ffn; const float* peer_wq; const float* peer_keys;
  const float* peer_u; const float* peer_v; const float* norm_final;
  float* out; unsigned char* ws; int ph_lo, ph_hi;
};

__device__ __forceinline__ float bf2f(bf16_t u) { return __uint_as_float(((unsigned)u) << 16); }
__device__ __forceinline__ bf16_t f2bf(float f) {
  unsigned u = __float_as_uint(f);
  u += 0x7fffu + ((u >> 16) & 1u);
  return (bf16_t)(u >> 16);
}
__device__ __forceinline__ unsigned pack2(float a, float b) { return (unsigned)f2bf(a) | ((unsigned)f2bf(b) << 16); }
__device__ __forceinline__ float wave_sum(float v) {
#pragma unroll
  for (int o = 32; o > 0; o >>= 1) v += __shfl_xor(v, o);
  return v;
}
__device__ __forceinline__ float sigmoidf_(float x) { return 1.f / (1.f + __expf(-x)); }
__device__ __forceinline__ float siluf_(float x) { return x / (1.f + __expf(-x)); }

__device__ __forceinline__ void gemm_tile(const bf16_t* __restrict__ A, int lda, const bf16_t* __restrict__ Bt, int ldb,
                                          int nk, f32x4 (&acc)[4][4], unsigned char* smem) {
  const int tid = threadIdx.x, lane = tid & 63, w = tid >> 6, wm = w >> 1, wn = w & 1, l15 = lane & 15, g = lane >> 4;
  unsigned char* sA = smem;
  unsigned char* sB = smem + 32768;
  const int lr = tid >> 3, lc = tid & 7;
  const bf16_t* ga = A + (size_t)lr * lda + lc * 8;
  const bf16_t* gb = Bt + (size_t)lr * ldb + lc * 8;
  uint4 ra0, ra1, ra2, ra3, rb0, rb1;
  ra0 = *(const uint4*)(ga);
  ra1 = *(const uint4*)(ga + (size_t)64 * lda);
  ra2 = *(const uint4*)(ga + (size_t)128 * lda);
  ra3 = *(const uint4*)(ga + (size_t)192 * lda);
  rb0 = *(const uint4*)(gb);
  rb1 = *(const uint4*)(gb + (size_t)64 * ldb);
  const int sw = (lc ^ (lr & 7)) << 4;
  for (int kt = 0; kt < nk; ++kt) {
    __syncthreads();
    *(uint4*)(sA + (lr) * 128 + sw) = ra0;
    *(uint4*)(sA + (lr + 64) * 128 + sw) = ra1;
    *(uint4*)(sA + (lr + 128) * 128 + sw) = ra2;
    *(uint4*)(sA + (lr + 192) * 128 + sw) = ra3;
    *(uint4*)(sB + (lr) * 128 + sw) = rb0;
    *(uint4*)(sB + (lr + 64) * 128 + sw) = rb1;
    __syncthreads();
    if (kt + 1 < nk) {
      const int ko = (kt + 1) * 64;
      ra0 = *(const uint4*)(ga + ko);
      ra1 = *(const uint4*)(ga + (size_t)64 * lda + ko);
      ra2 = *(const uint4*)(ga + (size_t)128 * lda + ko);
      ra3 = *(const uint4*)(ga + (size_t)192 * lda + ko);
      rb0 = *(const uint4*)(gb + ko);
      rb1 = *(const uint4*)(gb + (size_t)64 * ldb + ko);
    }
#pragma unroll
    for (int ks = 0; ks < 2; ++ks) {
      bf16x8 a[4], b[4];
#pragma unroll
      for (int m = 0; m < 4; ++m) { const int r = wm * 64 + m * 16 + l15; a[m] = *(const bf16x8*)(sA + r * 128 + (((ks * 4 + g) ^ (r & 7)) << 4)); }
#pragma unroll
      for (int n = 0; n < 4; ++n) { const int r = wn * 64 + n * 16 + l15; b[n] = *(const bf16x8*)(sB + r * 128 + (((ks * 4 + g) ^ (r & 7)) << 4)); }
#pragma unroll
      for (int m = 0; m < 4; ++m)
#pragma unroll
        for (int n = 0; n < 4; ++n) acc[m][n] = __builtin_amdgcn_mfma_f32_16x16x32_bf16(a[m], b[n], acc[m][n], 0, 0, 0);
    }
  }
}

__device__ __forceinline__ void zero_acc(f32x4 (&acc)[4][4]) {
#pragma unroll
  for (int m = 0; m < 4; ++m)
#pragma unroll
    for (int n = 0; n < 4; ++n) acc[m][n] = (f32x4){0.f, 0.f, 0.f, 0.f};
}

__device__ __forceinline__ void transpose_tile(const float* __restrict__ src, int srcN, bf16_t* __restrict__ dst, int K, int n0, int k0,
                                               bool winmap, float* tile) {
  const int tid = threadIdx.x;
  const int nc = tid & 63, kr = tid >> 6;
  int ncol = n0 + nc; bool valid = true;
  if (winmap) { if (ncol >= 3072) ncol -= 60; else if (ncol >= 3012) valid = false; }
#pragma unroll
  for (int i = 0; i < 8; ++i) {
    const int k = kr + 8 * i;
    tile[k * 65 + nc] = valid ? src[(size_t)(k0 + k) * srcN + ncol] : 0.f;
  }
  __syncthreads();
#pragma unroll
  for (int i = 0; i < 8; ++i) {
    const int nr = kr + 8 * i;
    dst[(size_t)(n0 + nr) * K + k0 + nc] = f2bf(tile[nc * 65 + nr]);
  }
  __syncthreads();
}

__device__ __forceinline__ void convert_f32_bf16(const float* __restrict__ src, bf16_t* __restrict__ dst, size_t n4) {
  for (size_t i = (size_t)blockIdx.x * NTHREADS + threadIdx.x; i < n4; i += (size_t)gridDim.x * NTHREADS) {
    const float4 v = ((const float4*)src)[i];
    uint2 o; o.x = pack2(v.x, v.y); o.y = pack2(v.z, v.w);
    ((uint2*)dst)[i] = o;
  }
}

__device__ __forceinline__ void rmsnorm_rows(const float* __restrict__ src, const float* __restrict__ g, bf16_t* __restrict__ dst) {
  const int lane = threadIdx.x & 63, w = threadIdx.x >> 6;
  for (int row = blockIdx.x * 8 + w; row < TOK; row += gridDim.x * 8) {
    const float4* s4 = (const float4*)(src + (size_t)row * DM);
    float4 v[4]; float ss = 0.f;
#pragma unroll
    for (int i = 0; i < 4; ++i) { v[i] = s4[lane + 64 * i]; ss += v[i].x * v[i].x + v[i].y * v[i].y + v[i].z * v[i].z + v[i].w * v[i].w; }
    ss = wave_sum(ss);
    const float rstd = rsqrtf(ss * (1.f / DM) + EPSV);
#pragma unroll
    for (int i = 0; i < 4; ++i) {
      const float4 gg = ((const float4*)g)[lane + 64 * i];
      uint2 o; o.x = pack2(v[i].x * rstd * gg.x, v[i].y * rstd * gg.y); o.y = pack2(v[i].z * rstd * gg.z, v[i].w * rstd * gg.w);
      ((uint2*)(dst + (size_t)row * DM))[lane + 64 * i] = o;
    }
  }
}

__device__ __forceinline__ void phase_prep(const Params& p, unsigned char* smem) {
  unsigned char* ws = p.ws;
  float* tile = (float*)smem;
  const int n_win = 80 * 16, n_ua = 16 * 8, n_ub = 16 * 8, n_wo = 16 * 16, n_wq = 32 * 16;
  const int total = n_win + n_ua + n_ub + n_wo + n_wq;
  for (int it = blockIdx.x; it < total; it += gridDim.x) {
    int t = it;
    if (t < n_win) { transpose_tile(p.w_in, 5060, (bf16_t*)(ws + WS_WIN), 1024, (t >> 4) * 64, (t & 15) * 64, true, tile); continue; }
    t -= n_win;
    if (t < n_ua) { transpose_tile(p.w_up_a, 1024, (bf16_t*)(ws + WS_WUPA), 512, (t >> 3) * 64, (t & 7) * 64, false, tile); continue; }
    t -= n_ua;
    if (t < n_ub) { transpose_tile(p.w_up_b, 1024, (bf16_t*)(ws + WS_WUPB), 512, (t >> 3) * 64, (t & 7) * 64, false, tile); continue; }
    t -= n_ub;
    if (t < n_wo) { transpose_tile(p.w_out, 1024, (bf16_t*)(ws + WS_WOUT), 1024, (t >> 4) * 64, (t & 15) * 64, false, tile); continue; }
    t -= n_wo;
    transpose_tile(p.peer_wq, 2048, (bf16_t*)(ws + WS_WQ), 1024, (t >> 4) * 64, (t & 15) * 64, false, tile);
  }
  convert_f32_bf16(p.peer_u, (bf16_t*)(ws + WS_U), (size_t)16384 * 1024 / 4);
  convert_f32_bf16(p.peer_v, (bf16_t*)(ws + WS_V), (size_t)16384 * 1024 / 4);
  convert_f32_bf16(p.peer_keys, (bf16_t*)(ws + WS_KEYS), (size_t)2 * 8 * 128 * 128 / 4);
  if (blockIdx.x == 0) {
    const int i = threadIdx.x;
    const float a0 = p.hg_lb[i], a1 = p.hg_lb[512 + i];
    ((float*)(ws + WS_LB))[i] = 1.f / (1.f + expf(a1 - a0));
  }
  rmsnorm_rows(p.x, p.norm_mix, (bf16_t*)(ws + WS_XN));
}

__device__ __forceinline__ void phase_proj(const Params& p, unsigned char* smem) {
  unsigned char* ws = p.ws;
  const bf16_t* xn = (const bf16_t*)(ws + WS_XN);
  const bf16_t* wt = (const bf16_t*)(ws + WS_WIN);
  bf16_t* pH = (bf16_t*)(ws + WS_PH);
  bf16_t* pA = (bf16_t*)(ws + WS_PA);
  bf16_t* pG = (bf16_t*)(ws + WS_PG);
  const int tid = threadIdx.x, lane = tid & 63, w = tid >> 6, wm = w >> 1, wn = w & 1, l15 = lane & 15, g = lane >> 4;
  for (int tile = blockIdx.x; tile < 128 * 40; tile += gridDim.x) {
    const int tn = tile % 40, tm = tile / 40;
    f32x4 acc[4][4]; zero_acc(acc);
    gemm_tile(xn + (size_t)tm * 256 * 1024, 1024, wt + (size_t)tn * 128 * 1024, 1024, 16, acc, smem);
    const int rbase = tm * 256 + wm * 64 + 4 * g;
    const int cbase = tn * 128 + wn * 64 + l15;
    if (tn < 16) {
#pragma unroll
      for (int m = 0; m < 4; ++m)
#pragma unroll
        for (int n = 0; n < 4; ++n)
#pragma unroll
          for (int j = 0; j < 4; ++j) pH[(size_t)(rbase + m * 16 + j) * 2048 + cbase + n * 16] = f2bf(acc[m][n][j]);
    } else if (tn < 24) {
      if (tn == 23 && wn == 0) {
        float gam[4], bet[4];
#pragma unroll
        for (int n = 0; n < 4; ++n) { gam[n] = p.ikg[n * 16 + l15]; bet[n] = p.ikb[n * 16 + l15]; }
#pragma unroll
        for (int m = 0; m < 4; ++m)
#pragma unroll
          for (int j = 0; j < 4; ++j) {
            float s = acc[m][0][j] + acc[m][1][j] + acc[m][2][j] + acc[m][3][j];
            s += __shfl_xor(s, 1); s += __shfl_xor(s, 2); s += __shfl_xor(s, 4); s += __shfl_xor(s, 8);
            const float mu = s * (1.f / 64.f);
            float q = 0.f;
#pragma unroll
            for (int n = 0; n < 4; ++n) { const float d = acc[m][n][j] - mu; q += d * d; }
            q += __shfl_xor(q, 1); q += __shfl_xor(q, 2); q += __shfl_xor(q, 4); q += __shfl_xor(q, 8);
            const float rstd = rsqrtf(q * (1.f / 64.f) + EPSV);
#pragma unroll
            for (int n = 0; n < 4; ++n)
              pA[(size_t)(rbase + m * 16 + j) * 1024 + (cbase - 2048) + n * 16] = f2bf((acc[m][n][j] - mu) * rstd * gam[n] + bet[n]);
          }
      } else {
#pragma unroll
        for (int m = 0; m < 4; ++m)
#pragma unroll
          for (int n = 0; n < 4; ++n)
#pragma unroll
            for (int j = 0; j < 4; ++j) pA[(size_t)(rbase + m * 16 + j) * 1024 + (cbase - 2048) + n * 16] = f2bf(acc[m][n][j]);
      }
    } else {
#pragma unroll
      for (int m = 0; m < 4; ++m)
#pragma unroll
        for (int n = 0; n < 4; ++n)
#pragma unroll
          for (int j = 0; j < 4; ++j) pG[(size_t)(rbase + m * 16 + j) * 2048 + (cbase - 3072) + n * 16] = f2bf(sigmoidf_(acc[m][n][j]));
    }
  }
}

__device__ __forceinline__ void hgrn_item(const Params& p, unsigned char* smem, int bh) {
  unsigned char* ws = p.ws;
  const bf16_t* pH = (const bf16_t*)(ws + WS_PH);
  const float* lbp = (const float*)(ws + WS_LB);
  bf16_t* ya = (bf16_t*)(ws + WS_XN);
  bf16_t* Qt = (bf16_t*)smem;
  bf16_t* Kt = Qt + 64 * 136;
  bf16_t* KtT = Kt + 64 * 136;
  bf16_t* VT = KtT + 128 * 72;
  bf16_t* Am = VT + 128 * 72;
  bf16_t* ST = Am + 64 * 72;
  float* qtot = (float*)(ST + 128 * 136);
  float* eref = qtot + 512;
  float* elast = eref + 128;
  float* elr = elast + 128;
  float* red = elr + 128;
  const int tid = threadIdx.x, lane = tid & 63, w = tid >> 6, l15 = lane & 15, g = lane >> 4;
  const int b = bh >> 2, h = bh & 3;
  const int d = tid & 127, tq = tid >> 7;
  const float lbv = lbp[h * 128 + d];
  f32x4 S[8];
#pragma unroll
  for (int i = 0; i < 8; ++i) S[i] = (f32x4){0.f, 0.f, 0.f, 0.f};
  const float gnv = p.hg_norm[h * 128 + 16 * w + l15];

  for (int chunk = 0; chunk < 64; ++chunk) {
    const size_t row0 = (size_t)b * SEQL + chunk * 64;
    {
      const bf16_t* base = pH + (row0 + tq * 16) * 2048 + h * 128 + d;
      float lf[16], kk[16], qs[16];
      unsigned vv[8];
      float run = 0.f;
#pragma unroll
      for (int i = 0; i < 16; ++i) {
        const float fr = bf2f(base[(size_t)i * 2048 + 512]);
        const float qr = bf2f(base[(size_t)i * 2048]);
        const float sg = sigmoidf_(fr);
        const float fg = lbv + (1.f - lbv) * sg;
        run += __logf(fg);
        lf[i] = run; kk[i] = 1.f - fg; qs[i] = siluf_(qr);
      }
#pragma unroll
      for (int i = 0; i < 8; ++i) {
        const unsigned lo = base[(size_t)(2 * i) * 2048 + 1024], hi = base[(size_t)(2 * i + 1) * 2048 + 1024];
        vv[i] = lo | (hi << 16);
      }
      qtot[tq * 128 + d] = run;
      __syncthreads();
      const float q0 = qtot[d], q1 = qtot[128 + d], q2 = qtot[256 + d], q3 = qtot[384 + d];
      const float pre = (tq > 0 ? q0 : 0.f) + (tq > 1 ? q1 : 0.f) + (tq > 2 ? q2 : 0.f);
      const float bref = q0 + q1;
      const float blast = bref + q2 + q3;
      unsigned kp[8];
#pragma unroll
      for (int i = 0; i < 16; ++i) {
        const float bt = pre + lf[i];
        const float qt = qs[i] * __expf(bt - bref);
        const float kt = kk[i] * __expf(bref - bt);
        const int t = tq * 16 + i;
        Qt[t * 136 + d] = f2bf(qt);
        const bf16_t kb = f2bf(kt);
        Kt[t * 136 + d] = kb;
        if (i & 1) kp[i >> 1] |= ((unsigned)kb) << 16; else kp[i >> 1] = kb;
      }
      *(uint4*)(KtT + d * 72 + tq * 16) = make_uint4(kp[0], kp[1], kp[2], kp[3]);
      *(uint4*)(KtT + d * 72 + tq * 16 + 8) = make_uint4(kp[4], kp[5], kp[6], kp[7]);
      *(uint4*)(VT + d * 72 + tq * 16) = make_uint4(vv[0], vv[1], vv[2], vv[3]);
      *(uint4*)(VT + d * 72 + tq * 16 + 8) = make_uint4(vv[4], vv[5], vv[6], vv[7]);
      if (tq == 0) { eref[d] = __expf(bref); elast[d] = __expf(blast); elr[d] = __expf(blast - bref); }
    }
    __syncthreads();
    {
      const int e = 16 * w + l15;
#pragma unroll
      for (int dm = 0; dm < 8; ++dm) {
        const int d0 = 16 * dm + 4 * g;
        uint2 o;
        o.x = pack2(S[dm][0] * eref[d0], S[dm][1] * eref[d0 + 1]);
        o.y = pack2(S[dm][2] * eref[d0 + 2], S[dm][3] * eref[d0 + 3]);
        *(uint2*)(ST + e * 136 + d0) = o;
      }
#pragma unroll
      for (int tt = 0; tt < 2; ++tt) {
        const int tl = 2 * w + tt, sm = tl >> 2, tn = tl & 3;
        f32x4 acc = (f32x4){0.f, 0.f, 0.f, 0.f};
        if (tn >= sm) {
#pragma unroll
          for (int k0 = 0; k0 < 128; k0 += 32) {
            const bf16x8 a = *(const bf16x8*)(Kt + (sm * 16 + l15) * 136 + k0 + 8 * g);
            const bf16x8 bq = *(const bf16x8*)(Qt + (tn * 16 + l15) * 136 + k0 + 8 * g);
            acc = __builtin_amdgcn_mfma_f32_16x16x32_bf16(a, bq, acc, 0, 0, 0);
          }
        }
        const int t = tn * 16 + l15, s0 = sm * 16 + 4 * g;
        uint2 o;
        o.x = pack2(s0 + 0 <= t ? acc[0] : 0.f, s0 + 1 <= t ? acc[1] : 0.f);
        o.y = pack2(s0 + 2 <= t ? acc[2] : 0.f, s0 + 3 <= t ? acc[3] : 0.f);
        *(uint2*)(Am + t * 72 + s0) = o;
      }
    }
    __syncthreads();
    f32x4 o[4];
    {
#pragma unroll
      for (int tm = 0; tm < 4; ++tm) {
        f32x4 acc = (f32x4){0.f, 0.f, 0.f, 0.f};
#pragma unroll
        for (int k0 = 0; k0 < 128; k0 += 32) {
          const bf16x8 a = *(const bf16x8*)(Qt + (tm * 16 + l15) * 136 + k0 + 8 * g);
          const bf16x8 bb = *(const bf16x8*)(ST + (16 * w + l15) * 136 + k0 + 8 * g);
          acc = __builtin_amdgcn_mfma_f32_16x16x32_bf16(a, bb, acc, 0, 0, 0);
        }
#pragma unroll
        for (int k0 = 0; k0 < 64; k0 += 32) {
          const bf16x8 a = *(const bf16x8*)(Am + (tm * 16 + l15) * 72 + k0 + 8 * g);
          const bf16x8 bb = *(const bf16x8*)(VT + (16 * w + l15) * 72 + k0 + 8 * g);
          acc = __builtin_amdgcn_mfma_f32_16x16x32_bf16(a, bb, acc, 0, 0, 0);
        }
        o[tm] = acc;
#pragma unroll
        for (int j = 0; j < 4; ++j) {
          float ss = acc[j] * acc[j];
          ss += __shfl_xor(ss, 1); ss += __shfl_xor(ss, 2); ss += __shfl_xor(ss, 4); ss += __shfl_xor(ss, 8);
          if (l15 == 0) red[w * 64 + tm * 16 + 4 * g + j] = ss;
        }
      }
#pragma unroll
      for (int dm = 0; dm < 8; ++dm) {
        f32x4 acc = (f32x4){0.f, 0.f, 0.f, 0.f};
#pragma unroll
        for (int k0 = 0; k0 < 64; k0 += 32) {
          const bf16x8 a = *(const bf16x8*)(KtT + (dm * 16 + l15) * 72 + k0 + 8 * g);
          const bf16x8 bb = *(const bf16x8*)(VT + (16 * w + l15) * 72 + k0 + 8 * g);
          acc = __builtin_amdgcn_mfma_f32_16x16x32_bf16(a, bb, acc, 0, 0, 0);
        }
#pragma unroll
        for (int j = 0; j < 4; ++j) { const int dd = 16 * dm + 4 * g + j; S[dm][j] = elast[dd] * S[dm][j] + elr[dd] * acc[j]; }
      }
    }
    __syncthreads();
    {
      const int e = 16 * w + l15;
#pragma unroll
      for (int tm = 0; tm < 4; ++tm)
#pragma unroll
        for (int j = 0; j < 4; ++j) {
          const int t = tm * 16 + 4 * g + j;
          float tot = 0.f;
#pragma unroll
          for (int ww = 0; ww < 8; ++ww) tot += red[ww * 64 + t];
          const float rstd = rsqrtf(tot * (1.f / 128.f) + EPSV);
          const float og = bf2f(pH[(row0 + t) * 2048 + 1536 + h * 128 + e]);
          ya[(row0 + t) * 512 + h * 128 + e] = f2bf(o[tm][j] * rstd * gnv * siluf_(og));
        }
    }
  }
}

__device__ __forceinline__ unsigned sortable_key(float v) {
  unsigned bits = __float_as_uint(v);
  if (bits == 0x80000000u) bits = 0u;
  return (bits & 0x80000000u) ? ~bits : (bits | 0x80000000u);
}

__device__ __forceinline__ void dsa_item(const Params& p, unsigned char* smem, int item) {
  unsigned char* ws = p.ws;
  const bf16_t* pA = (const bf16_t*)(ws + WS_PA);
  bf16_t* yb = (bf16_t*)(ws + WS_XN) + (size_t)TOK * 512;
  unsigned* sc = (unsigned*)smem;
  unsigned* hist = sc + 8 * 4096;
  unsigned short* sel = (unsigned short*)(hist + 8 * 256);
  unsigned char* bkt = (unsigned char*)(sel + 8 * 256);
  const int tid = threadIdx.x, lane = tid & 63, w = tid >> 6, l15 = lane & 15, g = lane >> 4;
  const int b = item >> 9;
  const int r = item & 511;
  const int tb = (b & 1) ? 511 - r : r;
  const int t0 = tb * 8;
  const size_t tokbase = (size_t)b * SEQL;

  {
    bf16x8 af[2][2];
    float wq[2][4];
#pragma unroll
    for (int mt = 0; mt < 2; ++mt) {
      const int qrow = t0 + mt * 4 + (l15 >> 2), head = l15 & 3;
#pragma unroll
      for (int ks = 0; ks < 2; ++ks)
        af[mt][ks] = *(const bf16x8*)(pA + (tokbase + qrow) * 1024 + 640 + head * 64 + ks * 32 + 8 * g);
      const uint2 wr = *(const uint2*)(pA + (tokbase + t0 + mt * 4 + g) * 1024 + 960);
      wq[mt][0] = 0.5f * bf2f((bf16_t)(wr.x & 0xffff)); wq[mt][1] = 0.5f * bf2f((bf16_t)(wr.x >> 16));
      wq[mt][2] = 0.5f * bf2f((bf16_t)(wr.y & 0xffff)); wq[mt][3] = 0.5f * bf2f((bf16_t)(wr.y >> 16));
    }
    const int nkt = (t0 + 8 + 15) >> 4;
    for (int kt = w; kt < nkt; kt += 8) {
      const int s = kt * 16 + l15;
      const bf16_t* kr = pA + (tokbase + s) * 1024 + 896 + 8 * g;
      const bf16x8 b0 = *(const bf16x8*)kr;
      const bf16x8 b1 = *(const bf16x8*)(kr + 32);
#pragma unroll
      for (int mt = 0; mt < 2; ++mt) {
        f32x4 acc = (f32x4){0.f, 0.f, 0.f, 0.f};
        acc = __builtin_amdgcn_mfma_f32_16x16x32_bf16(af[mt][0], b0, acc, 0, 0, 0);
        acc = __builtin_amdgcn_mfma_f32_16x16x32_bf16(af[mt][1], b1, acc, 0, 0, 0);
        float v = 0.f;
#pragma unroll
        for (int j = 0; j < 4; ++j) v += wq[mt][j] * fmaxf(acc[j] * 0.125f, 0.f);
        const int t = t0 + mt * 4 + g;
        sc[(mt * 4 + g) * 4096 + s] = (s <= t) ? sortable_key(v) : 0u;
      }
    }
  }
  __syncthreads();
  const int t = t0 + w;
  const int n = t + 1;
  unsigned* row = sc + w * 4096;
  unsigned short* mysel = sel + w * 256;
  unsigned* myh = hist + w * 256;
  int cnt;
  const unsigned long long lt_mask = (1ull << lane) - 1ull;
  if (n <= 256) {
    for (int i = lane; i < n; i += 64) mysel[i] = (unsigned short)i;
    cnt = n;
  } else {
    unsigned prefix = 0u, krem = 256u;
#pragma unroll 1
    for (int pass = 0; pass < 4; ++pass) {
      const int shift = 24 - 8 * pass;
      const unsigned himask = (pass == 0) ? 0u : (0xFFFFFFFFu << (shift + 8));
#pragma unroll
      for (int i = 0; i < 4; ++i) myh[lane + 64 * i] = 0u;
      __threadfence_block();
      for (int i = lane; i < n; i += 64) {
        const unsigned u = row[i];
        if ((u & himask) == prefix) atomicAdd(&myh[(u >> shift) & 255u], 1u);
      }
      __threadfence_block();
      const uint4 c4 = *(const uint4*)(myh + 4 * lane);
      const unsigned c = c4.x + c4.y + c4.z + c4.w;
      unsigned s = c;
#pragma unroll
      for (int o = 1; o < 64; o <<= 1) { const unsigned tt = __shfl_down(s, o); if (lane + o < 64) s += tt; }
      const unsigned long long bal = __ballot(s >= krem);
      const int L = 63 - __clzll(bal);
      const unsigned sL = __shfl(s, L), cL = __shfl(c, L);
      const unsigned b3 = __shfl(c4.w, L), b2 = __shfl(c4.z, L), b1 = __shfl(c4.y, L);
      unsigned cum = sL - cL;
      unsigned digit;
      if (cum + b3 >= krem) digit = 3;
      else { cum += b3; if (cum + b2 >= krem) digit = 2; else { cum += b2; if (cum + b1 >= krem) digit = 1; else { cum += b1; digit = 0; } } }
      krem -= cum;
      prefix |= ((unsigned)(4 * L) + digit) << shift;
    }
    const unsigned T = prefix;
    unsigned base = 0u, eqtaken = 0u;
    for (int i0 = 0; i0 < n; i0 += 64) {
      const int i = i0 + lane;
      const bool valid = i < n;
      const unsigned u = valid ? row[i] : 0u;
      const bool gt = valid && (u > T);
      const bool eq = valid && (u == T);
      const unsigned long long beq = __ballot(eq);
      const unsigned eqrank = eqtaken + (unsigned)__popcll(beq & lt_mask);
      const bool take = gt || (eq && eqrank < krem);
      const unsigned long long bt = __ballot(take);
      const unsigned pos = base + (unsigned)__popcll(bt & lt_mask);
      if (take && pos < 256u) mysel[pos] = (unsigned short)i;
      base += (unsigned)__popcll(bt);
      eqtaken += (unsigned)__popcll(beq);
    }
    cnt = 256;
  }
  __threadfence_block();
  {
    const int ks = lane >> 3, dc = lane & 7;
    float* pl = (float*)row;
    float qf[8][8];
#pragma unroll
    for (int hh = 0; hh < 8; ++hh) {
      const uint4 qv = *(const uint4*)(pA + (tokbase + t) * 1024 + hh * 64 + dc * 8);
      qf[hh][0] = 0.125f * __uint_as_float(qv.x << 16); qf[hh][1] = 0.125f * __uint_as_float(qv.x & 0xffff0000u);
      qf[hh][2] = 0.125f * __uint_as_float(qv.y << 16); qf[hh][3] = 0.125f * __uint_as_float(qv.y & 0xffff0000u);
      qf[hh][4] = 0.125f * __uint_as_float(qv.z << 16); qf[hh][5] = 0.125f * __uint_as_float(qv.z & 0xffff0000u);
      qf[hh][6] = 0.125f * __uint_as_float(qv.w << 16); qf[hh][7] = 0.125f * __uint_as_float(qv.w & 0xffff0000u);
    }
    const int niter = (cnt + 7) >> 3;
    for (int it = 0; it < niter; ++it) {
      const int kk = it * 8 + ks;
      const bool valid = kk < cnt;
      const int s = valid ? (int)mysel[kk] : 0;
      const uint4 kv = *(const uint4*)(pA + (tokbase + s) * 1024 + 512 + dc * 8);
      float kf[8];
      kf[0] = __uint_as_float(kv.x << 16); kf[1] = __uint_as_float(kv.x & 0xffff0000u);
      kf[2] = __uint_as_float(kv.y << 16); kf[3] = __uint_as_float(kv.y & 0xffff0000u);
      kf[4] = __uint_as_float(kv.z << 16); kf[5] = __uint_as_float(kv.z & 0xffff0000u);
      kf[6] = __uint_as_float(kv.w << 16); kf[7] = __uint_as_float(kv.w & 0xffff0000u);
      float mine = 0.f;
#pragma unroll
      for (int hh = 0; hh < 8; ++hh) {
        float pp = 0.f;
#pragma unroll
        for (int i = 0; i < 8; ++i) pp += kf[i] * qf[hh][i];
        pp += __shfl_xor(pp, 1); pp += __shfl_xor(pp, 2); pp += __shfl_xor(pp, 4);
        if (dc == hh) mine = pp;
      }
      const int dist = t - s;
      const int bk = dist < 128 ? (int)bkt[dist] : 31;
      const float lg = valid ? (mine + p.rel_bias[bk * 8 + dc]) : -INFINITY;
      pl[kk * 8 + dc] = lg;
    }
    __threadfence_block();
    float inv;
    {
      const int hh = lane & 7, part = lane >> 3;
      float m = -INFINITY;
      for (int kk = part; kk < cnt; kk += 8) m = fmaxf(m, pl[kk * 8 + hh]);
      m = fmaxf(m, __shfl_xor(m, 8)); m = fmaxf(m, __shfl_xor(m, 16)); m = fmaxf(m, __shfl_xor(m, 32));
      float sum = 0.f;
      for (int kk = part; kk < niter * 8; kk += 8) {
        const float e = (kk < cnt) ? __expf(pl[kk * 8 + hh] - m) : 0.f;
        pl[kk * 8 + hh] = e;
        sum += e;
      }
      sum += __shfl_xor(sum, 8); sum += __shfl_xor(sum, 16); sum += __shfl_xor(sum, 32);
      inv = 1.f / sum;
    }
    __threadfence_block();
    float acc[8][8];
#pragma unroll
    for (int hh = 0; hh < 8; ++hh)
#pragma unroll
      for (int i = 0; i < 8; ++i) acc[hh][i] = 0.f;
    for (int it = 0; it < niter; ++it) {
      const int kk = it * 8 + ks;
      const bool valid = kk < cnt;
      const int s = valid ? (int)mysel[kk] : 0;
      const uint4 vv = *(const uint4*)(pA + (tokbase + s) * 1024 + 576 + dc * 8);
      float vf[8];
      vf[0] = __uint_as_float(vv.x << 16); vf[1] = __uint_as_float(vv.x & 0xffff0000u);
      vf[2] = __uint_as_float(vv.y << 16); vf[3] = __uint_as_float(vv.y & 0xffff0000u);
      vf[4] = __uint_as_float(vv.z << 16); vf[5] = __uint_as_float(vv.z & 0xffff0000u);
      vf[6] = __uint_as_float(vv.w << 16); vf[7] = __uint_as_float(vv.w & 0xffff0000u);
      const float4 p0 = *(const float4*)(pl + kk * 8);
      const float4 p1 = *(const float4*)(pl + kk * 8 + 4);
      const float pp[8] = {p0.x, p0.y, p0.z, p0.w, p1.x, p1.y, p1.z, p1.w};
#pragma unroll
      for (int hh = 0; hh < 8; ++hh)
#pragma unroll
        for (int i = 0; i < 8; ++i) acc[hh][i] += pp[hh] * vf[i];
    }
#pragma unroll
    for (int hh = 0; hh < 8; ++hh) {
      const float ih = __shfl(inv, hh);
#pragma unroll
      for (int i = 0; i < 8; ++i) {
        float v = acc[hh][i];
        v += __shfl_xor(v, 8); v += __shfl_xor(v, 16); v += __shfl_xor(v, 32);
        acc[hh][i] = v * ih;
      }
    }
    if (ks == 0) {
#pragma unroll
      for (int hh = 0; hh < 8; ++hh) {
        uint4 o;
        o.x = pack2(acc[hh][0], acc[hh][1]); o.y = pack2(acc[hh][2], acc[hh][3]);
        o.z = pack2(acc[hh][4], acc[hh][5]); o.w = pack2(acc[hh][6], acc[hh][7]);
        *(uint4*)(yb + (tokbase + t) * 512 + hh * 64 + dc * 8) = o;
      }
    }
  }
  __syncthreads();
}

__device__ __forceinline__ void phase_mix(const Params& p, unsigned char* smem) {
  const int G = gridDim.x;
  if (G >= 64) {
    if (blockIdx.x < 32) { hgrn_item(p, smem, blockIdx.x); return; }
    unsigned char* bkt = smem + 8 * 4096 * 4 + 8 * 256 * 4 + 8 * 256 * 2;
    if (threadIdx.x < 128) {
      const int nn = threadIdx.x;
      int v = nn;
      if (nn >= 16) { v = 16 + (int)(logf((float)nn * (1.f / 16.f)) / logf(8.f) * 16.f); if (v > 31) v = 31; }
      bkt[nn] = (unsigned char)v;
    }
    __syncthreads();
    for (int item = blockIdx.x - 32; item < 4096; item += G - 32) dsa_item(p, smem, item);
  } else {
    for (int bh = blockIdx.x; bh < 32; bh += G) { hgrn_item(p, smem, bh); __syncthreads(); }
    unsigned char* bkt = smem + 8 * 4096 * 4 + 8 * 256 * 4 + 8 * 256 * 2;
    __syncthreads();
    if (threadIdx.x < 128) {
      const int nn = threadIdx.x;
      int v = nn;
      if (nn >= 16) { v = 16 + (int)(logf((float)nn * (1.f / 16.f)) / logf(8.f) * 16.f); if (v > 31) v = 31; }
      bkt[nn] = (unsigned char)v;
    }
    __syncthreads();
    for (int item = blockIdx.x; item < 4096; item += G) dsa_item(p, smem, item);
  }
}

__device__ __forceinline__ void phase_up(const Params& p, unsigned char* smem) {
  unsigned char* ws = p.ws;
  const bf16_t* ya = (const bf16_t*)(ws + WS_XN);
  const bf16_t* yb = ya + (size_t)TOK * 512;
  const bf16_t* wa = (const bf16_t*)(ws + WS_WUPA);
  const bf16_t* wb = (const bf16_t*)(ws + WS_WUPB);
  const bf16_t* pG = (const bf16_t*)(ws + WS_PG);
  bf16_t* hb = (bf16_t*)(ws + WS_PH);
  const int tid = threadIdx.x, lane = tid & 63, w = tid >> 6, wm = w >> 1, wn = w & 1, l15 = lane & 15, g = lane >> 4;
  for (int tile = blockIdx.x; tile < 128 * 8; tile += gridDim.x) {
    const int tn = tile & 7, tm = tile >> 3;
    f32x4 acc[4][4]; zero_acc(acc);
    gemm_tile(ya + (size_t)tm * 256 * 512, 512, wa + (size_t)tn * 128 * 512, 512, 8, acc, smem);
    asm volatile("" ::: "memory");
    const int rbase = tm * 256 + wm * 64 + 4 * g;
    const int cbase = tn * 128 + wn * 64 + l15;
#pragma unroll
    for (int m = 0; m < 4; ++m)
#pragma unroll
      for (int n = 0; n < 4; ++n) {
#pragma unroll
        for (int j = 0; j < 4; ++j) {
          const size_t rr = (size_t)(rbase + m * 16 + j);
          hb[rr * 1024 + cbase + n * 16] = f2bf(acc[m][n][j] * bf2f(pG[rr * 2048 + cbase + n * 16]));
        }
        acc[m][n] = (f32x4){0.f, 0.f, 0.f, 0.f};
      }
    asm volatile("" ::: "memory");
    gemm_tile(yb + (size_t)tm * 256 * 512, 512, wb + (size_t)tn * 128 * 512, 512, 8, acc, smem);
    asm volatile("" ::: "memory");
#pragma unroll
    for (int m = 0; m < 4; ++m)
#pragma unroll
      for (int n = 0; n < 4; ++n)
#pragma unroll
        for (int j = 0; j < 4; ++j) {
          const size_t rr = (size_t)(rbase + m * 16 + j);
          const float v = bf2f(hb[rr * 1024 + cbase + n * 16]) + acc[m][n][j] * bf2f(pG[rr * 2048 + 1024 + cbase + n * 16]);
          hb[rr * 1024 + cbase + n * 16] = f2bf(v);
        }
  }
}

__device__ __forceinline__ void phase_out(const Params& p, unsigned char* smem) {
  unsigned char* ws = p.ws;
  const bf16_t* hb = (const bf16_t*)(ws + WS_PH);
  const bf16_t* wo = (const bf16_t*)(ws + WS_WOUT);
  const int tid = threadIdx.x, lane = tid & 63, w = tid >> 6, wm = w >> 1, wn = w & 1, l15 = lane & 15, g = lane >> 4;
  for (int tile = blockIdx.x; tile < 128 * 8; tile += gridDim.x) {
    const int tn = tile & 7, tm = tile >> 3;
    f32x4 acc[4][4]; zero_acc(acc);
    gemm_tile(hb + (size_t)tm * 256 * 1024, 1024, wo + (size_t)tn * 128 * 1024, 1024, 16, acc, smem);
    const int rbase = tm * 256 + wm * 64 + 4 * g;
    const int cbase = tn * 128 + wn * 64 + l15;
#pragma unroll
    for (int m = 0; m < 4; ++m)
#pragma unroll
      for (int n = 0; n < 4; ++n)
#pragma unroll
        for (int j = 0; j < 4; ++j) {
          const size_t idx = (size_t)(rbase + m * 16 + j) * 1024 + cbase + n * 16;
          p.out[idx] = p.x[idx] + acc[m][n][j];
        }
  }
}

__device__ __forceinline__ void phase_pq(const Params& p, unsigned char* smem) {
  unsigned char* ws = p.ws;
  const bf16_t* xn2 = (const bf16_t*)(ws + WS_XN);
  const bf16_t* wq = (const bf16_t*)(ws + WS_WQ);
  bf16_t* qp = (bf16_t*)(ws + WS_PG);
  const int tid = threadIdx.x, lane = tid & 63, w = tid >> 6, wm = w >> 1, wn = w & 1, l15 = lane & 15, g = lane >> 4;
  for (int tile = blockIdx.x; tile < 128 * 16; tile += gridDim.x) {
    const int tn = tile & 15, tm = tile >> 4;
    f32x4 acc[4][4]; zero_acc(acc);
    gemm_tile(xn2 + (size_t)tm * 256 * 1024, 1024, wq + (size_t)tn * 128 * 1024, 1024, 16, acc, smem);
    const int rbase = tm * 256 + wm * 64 + 4 * g;
    const int cbase = tn * 128 + wn * 64 + l15;
#pragma unroll
    for (int m = 0; m < 4; ++m)
#pragma unroll
      for (int n = 0; n < 4; ++n)
#pragma unroll
        for (int j = 0; j < 4; ++j) qp[(size_t)(rbase + m * 16 + j) * 2048 + cbase + n * 16] = f2bf(acc[m][n][j]);
  }
}

__device__ __forceinline__ void phase_pkeys(const Params& p, unsigned char* smem) {
  unsigned char* ws = p.ws;
  const bf16_t* qp = (const bf16_t*)(ws + WS_PG);
  const bf16_t* keys = (const bf16_t*)(ws + WS_KEYS);
  float* ps = (float*)(ws + WS_PA);
  int* pi = (int*)(ws + WS_PA) + (size_t)TOK * 256;
  float* sc = (float*)smem;
  const int tid = threadIdx.x, lane = tid & 63, w = tid >> 6, wm = w >> 1, wn = w & 1, l15 = lane & 15, g = lane >> 4;
  for (int tile = blockIdx.x; tile < 128 * 16; tile += gridDim.x) {
    const int hp = tile & 15, tm = tile >> 4;
    const int h = hp >> 1, ph = hp & 1;
    f32x4 acc[4][4]; zero_acc(acc);
    gemm_tile(qp + (size_t)tm * 256 * 2048 + hp * 128, 2048, keys + (size_t)(ph * 8 + h) * 128 * 128, 128, 2, acc, smem);
    __syncthreads();
#pragma unroll
    for (int m = 0; m < 4; ++m)
#pragma unroll
      for (int n = 0; n < 4; ++n)
#pragma unroll
        for (int j = 0; j < 4; ++j) sc[(wm * 64 + m * 16 + 4 * g + j) * 129 + wn * 64 + n * 16 + l15] = acc[m][n][j];
    __syncthreads();
    if (tid < 256) {
      float* rowp = sc + tid * 129;
      const size_t ob = ((size_t)(tm * 256 + tid) * 16 + hp) * 16;
#pragma unroll 1
      for (int k = 0; k < 16; ++k) {
        float best = -INFINITY; int bi = 0;
        for (int nn = 0; nn < 128; ++nn) { const float v = rowp[nn]; if (v > best) { best = v; bi = nn; } }
        rowp[bi] = -INFINITY;
        ps[ob + k] = best; pi[ob + k] = bi;
      }
    }
    __syncthreads();
  }
}

__device__ __forceinline__ void phase_pcomb(const Params& p, unsigned char* smem) {
  unsigned char* ws = p.ws;
  const float* ps = (const float*)(ws + WS_PA);
  const int* pi = (const int*)(ws + WS_PA) + (size_t)TOK * 256;
  int* eidx = (int*)(ws + WS_EIDX);
  float* gw = (float*)(ws + WS_GW);
  float* s2l = (float*)smem;
  unsigned short* i1l = (unsigned short*)(s2l + 512 * 17);
  unsigned short* i2l = i1l + 512 * 16;
  const int tid = threadIdx.x;
  for (int base = blockIdx.x * NTHREADS; base < TOK * 8; base += gridDim.x * NTHREADS) {
    const int th = base + tid;
    const size_t o1 = (size_t)th * 32;
    float s1[16];
#pragma unroll
    for (int a = 0; a < 16; ++a) {
      s1[a] = ps[o1 + a];
      s2l[tid * 17 + a] = ps[o1 + 16 + a];
      i1l[tid * 16 + a] = (unsigned short)pi[o1 + a];
      i2l[tid * 16 + a] = (unsigned short)pi[o1 + 16 + a];
    }
    float cur[16];
    const float s20 = s2l[tid * 17];
#pragma unroll
    for (int a = 0; a < 16; ++a) cur[a] = s1[a] + s20;
    unsigned long long ptr = 0ull;
    float tops[16]; int tope[16];
#pragma unroll
    for (int k = 0; k < 16; ++k) {
      float best = cur[0]; int ba = 0;
#pragma unroll
      for (int a = 1; a < 16; ++a) if (cur[a] > best) { best = cur[a]; ba = a; }
      const int bb = (int)((ptr >> (4 * ba)) & 15ull);
      tops[k] = best;
      tope[k] = (int)i1l[tid * 16 + ba] * 128 + (int)i2l[tid * 16 + bb];
      const int nb = bb + 1;
      const float ns2 = (nb < 16) ? s2l[tid * 17 + nb] : -INFINITY;
      if (nb < 16) ptr += (1ull << (4 * ba));
#pragma unroll
      for (int a = 0; a < 16; ++a) if (a == ba) cur[a] = s1[a] + ns2;
    }
    float m = tops[0];
    float sum = 0.f;
#pragma unroll
    for (int k = 0; k < 16; ++k) { tops[k] = __expf(tops[k] - m); sum += tops[k]; }
    const float inv = 1.f / sum;
#pragma unroll
    for (int k = 0; k < 16; ++k) { eidx[(size_t)th * 16 + k] = tope[k]; gw[(size_t)th * 16 + k] = tops[k] * inv; }
  }
}

__device__ __forceinline__ void cvt8(const uint4& v, float* f) {
  f[0] = __uint_as_float(v.x << 16); f[1] = __uint_as_float(v.x & 0xffff0000u);
  f[2] = __uint_as_float(v.y << 16); f[3] = __uint_as_float(v.y & 0xffff0000u);
  f[4] = __uint_as_float(v.z << 16); f[5] = __uint_as_float(v.z & 0xffff0000u);
  f[6] = __uint_as_float(v.w << 16); f[7] = __uint_as_float(v.w & 0xffff0000u);
}

__device__ __forceinline__ void phase_expert(const Params& p) {
  unsigned char* ws = p.ws;
  const bf16_t* xn2 = (const bf16_t*)(ws + WS_XN);
  const bf16_t* U = (const bf16_t*)(ws + WS_U);
  const bf16_t* V = (const bf16_t*)(ws + WS_V);
  const int* eidx = (const int*)(ws + WS_EIDX);
  const float* gw = (const float*)(ws + WS_GW);
  const int lane = threadIdx.x & 63, w = threadIdx.x >> 6;
  for (int tok = blockIdx.x * 8 + w; tok < TOK; tok += gridDim.x * 8) {
    float xf[16];
    {
      const uint4 xa = *(const uint4*)(xn2 + (size_t)tok * 1024 + lane * 8);
      const uint4 xb = *(const uint4*)(xn2 + (size_t)tok * 1024 + (lane + 64) * 8);
      cvt8(xa, xf); cvt8(xb, xf + 8);
    }
    const int e0 = eidx[(size_t)tok * 128 + lane], e1 = eidx[(size_t)tok * 128 + 64 + lane];
    const float g0 = gw[(size_t)tok * 128 + lane], g1 = gw[(size_t)tok * 128 + 64 + lane];
    float h0 = 0.f, h1 = 0.f;
#pragma unroll 1
    for (int half = 0; half < 2; ++half) {
      const int ev = half ? e1 : e0;
#pragma unroll 1
      for (int k0 = 0; k0 < 64; k0 += 8) {
        uint4 ua[8], ub[8];
#pragma unroll
        for (int j = 0; j < 8; ++j) {
          const int e = __builtin_amdgcn_readlane(ev, k0 + j);
          const bf16_t* ur = U + (size_t)e * 1024;
          ua[j] = *(const uint4*)(ur + lane * 8);
          ub[j] = *(const uint4*)(ur + (lane + 64) * 8);
        }
#pragma unroll
        for (int j = 0; j < 8; ++j) {
          float uf[16];
          cvt8(ua[j], uf); cvt8(ub[j], uf + 8);
          float pp = 0.f;
#pragma unroll
          for (int i = 0; i < 16; ++i) pp += uf[i] * xf[i];
          pp = wave_sum(pp);
          if (lane == k0 + j) { if (half) h1 = pp; else h0 = pp; }
        }
      }
    }
    const float a0 = 0.5f * h0 * (1.f + erff(h0 * 0.70710678118654752f)) * g0;
    const float a1 = 0.5f * h1 * (1.f + erff(h1 * 0.70710678118654752f)) * g1;
    float acc[16];
#pragma unroll
    for (int i = 0; i < 16; ++i) acc[i] = 0.f;
#pragma unroll 1
    for (int half = 0; half < 2; ++half) {
      const int ev = half ? e1 : e0;
      const int av = __float_as_int(half ? a1 : a0);
#pragma unroll 1
      for (int k0 = 0; k0 < 64; k0 += 8) {
        uint4 va[8], vb[8];
        float aa[8];
#pragma unroll
        for (int j = 0; j < 8; ++j) {
          const int e = __builtin_amdgcn_readlane(ev, k0 + j);
          aa[j] = __int_as_float(__builtin_amdgcn_readlane(av, k0 + j));
          const bf16_t* vr = V + (size_t)e * 1024;
          va[j] = *(const uint4*)(vr + lane * 8);
          vb[j] = *(const uint4*)(vr + (lane + 64) * 8);
        }
#pragma unroll
        for (int j = 0; j < 8; ++j) {
          float vf[16];
          cvt8(va[j], vf); cvt8(vb[j], vf + 8);
#pragma unroll
          for (int i = 0; i < 16; ++i) acc[i] += aa[j] * vf[i];
        }
      }
    }
    float* orow = p.out + (size_t)tok * 1024;
    float x2[16];
    {
      const float4 a = *(const float4*)(orow + lane * 8), b = *(const float4*)(orow + lane * 8 + 4);
      const float4 c = *(const float4*)(orow + (lane + 64) * 8), d = *(const float4*)(orow + (lane + 64) * 8 + 4);
      x2[0] = a.x + acc[0]; x2[1] = a.y + acc[1]; x2[2] = a.z + acc[2]; x2[3] = a.w + acc[3];
      x2[4] = b.x + acc[4]; x2[5] = b.y + acc[5]; x2[6] = b.z + acc[6]; x2[7] = b.w + acc[7];
      x2[8] = c.x + acc[8]; x2[9] = c.y + acc[9]; x2[10] = c.z + acc[10]; x2[11] = c.w + acc[11];
      x2[12] = d.x + acc[12]; x2[13] = d.y + acc[13]; x2[14] = d.z + acc[14]; x2[15] = d.w + acc[15];
    }
    float ss = 0.f;
#pragma unroll
    for (int i = 0; i < 16; ++i) ss += x2[i] * x2[i];
    ss = wave_sum(ss);
    const float rstd = rsqrtf(ss * (1.f / DM) + EPSV);
    const float* nf = p.norm_final;
    {
      const float4 ga = *(const float4*)(nf + lane * 8), gb = *(const float4*)(nf + lane * 8 + 4);
      const float4 gc = *(const float4*)(nf + (lane + 64) * 8), gd = *(const float4*)(nf + (lane + 64) * 8 + 4);
      *(float4*)(orow + lane * 8) = make_float4(x2[0] * rstd * ga.x, x2[1] * rstd * ga.y, x2[2] * rstd * ga.z, x2[3] * rstd * ga.w);
      *(float4*)(orow + lane * 8 + 4) = make_float4(x2[4] * rstd * gb.x, x2[5] * rstd * gb.y, x2[6] * rstd * gb.z, x2[7] * rstd * gb.w);
      *(float4*)(orow + (lane + 64) * 8) = make_float4(x2[8] * rstd * gc.x, x2[9] * rstd * gc.y, x2[10] * rstd * gc.z, x2[11] * rstd * gc.w);
      *(float4*)(orow + (lane + 64) * 8 + 4) = make_float4(x2[12] * rstd * gd.x, x2[13] * rstd * gd.y, x2[14] * rstd * gd.z, x2[15] * rstd * gd.w);
    }
  }
}

__global__ void __launch_bounds__(NTHREADS) hybrid_fwd(Params p) {
  extern __shared__ __attribute__((aligned(16))) unsigned char smem[];
#if ONE_LAUNCH
  cg::grid_group grid = cg::this_grid();
#define SEAM(k) do { if (p.ph_lo <= (k) && (k) + 1 < p.ph_hi) grid.sync(); } while (0)
#else
#define SEAM(k) do { } while (0)
#endif
#define IN(k) (p.ph_lo <= (k) && (k) < p.ph_hi)
  if (IN(0)) { phase_prep(p, smem); SEAM(0); }
  if (IN(1)) { phase_proj(p, smem); SEAM(1); }
  if (IN(2)) { phase_mix(p, smem); SEAM(2); }
  if (IN(3)) { phase_up(p, smem); SEAM(3); }
  if (IN(4)) { phase_out(p, smem); SEAM(4); }
  if (IN(5)) { rmsnorm_rows(p.out, p.norm_ffn, (bf16_t*)(p.ws + WS_XN)); SEAM(5); }
  if (IN(6)) { phase_pq(p, smem); SEAM(6); }
  if (IN(7)) { phase_pkeys(p, smem); SEAM(7); }
  if (IN(8)) { phase_pcomb(p, smem); SEAM(8); }
  if (IN(9)) { phase_expert(p); }
#undef IN
#undef SEAM
}

extern "C" void kernel_launch(void* const* d_in, const int* in_sizes, int n_in, void* d_out, int out_size, void* d_ws, size_t ws_size,
                              hipStream_t stream) {
  static int grid = 0;
  if (grid == 0) {
    if (n_in != 17 || ws_size < WS_END) {
      fprintf(stderr, "kernel_launch: unexpected n_in %d or ws_size %zu (need %zu)\n", n_in, ws_size, (size_t)WS_END);
      grid = -1; return;
    }
    int dev = 0, cus = 0, per_cu = 0;
    hipGetDevice(&dev);
    hipDeviceGetAttribute(&cus, hipDeviceAttributeMultiprocessorCount, dev);
    hipFuncSetAttribute((const void*)hybrid_fwd, hipFuncAttributeMaxDynamicSharedMemorySize, LDS_BYTES);
    hipOccupancyMaxActiveBlocksPerMultiprocessor(&per_cu, (const void*)hybrid_fwd, NTHREADS, LDS_BYTES);
    if (per_cu < 1) { fprintf(stderr, "kernel_launch: occupancy query says %d blocks/CU\n", per_cu); per_cu = 1; }
    (void)hipGetLastError();
    grid = cus;
  }
  if (grid < 0) return;
  Params p{};
  p.x = (const float*)d_in[0]; p.norm_mix = (const float*)d_in[1]; p.w_in = (const float*)d_in[2]; p.hg_lb = (const float*)d_in[3];
  p.hg_norm = (const float*)d_in[4]; p.ikg = (const float*)d_in[5]; p.ikb = (const float*)d_in[6]; p.rel_bias = (const float*)d_in[7];
  p.w_up_a = (const float*)d_in[8]; p.w_up_b = (const float*)d_in[9]; p.w_out = (const float*)d_in[10]; p.norm_ffn = (const float*)d_in[11];
  p.peer_wq = (const float*)d_in[12]; p.peer_keys = (const float*)d_in[13]; p.peer_u = (const float*)d_in[14]; p.peer_v = (const float*)d_in[15];
  p.norm_final = (const float*)d_in[16];
  p.out = (float*)d_out; p.ws = (unsigned char*)d_ws;
#if ONE_LAUNCH
  p.ph_lo = 0; p.ph_hi = NPHASE;
  void* args[] = {&p};
  hipError_t e = hipLaunchCooperativeKernel((const void*)hybrid_fwd, dim3(grid), dim3(NTHREADS), args, LDS_BYTES, stream);
  if (e != hipSuccess) fprintf(stderr, "cooperative launch failed: %s (grid %d)\n", hipGetErrorString(e), grid);
#else
  for (int ph = 0; ph < NPHASE; ++ph) {
    p.ph_lo = ph; p.ph_hi = ph + 1;
    hipLaunchKernelGGL(hybrid_fwd, dim3(grid), dim3(NTHREADS), LDS_BYTES, stream, p);
  }
#endif
}
```

```cpp
#include <hip/hip_runtime.h>
#include <hip/hip_cooperative_groups.h>
#include <stdint.h>
#include <stdio.h>
namespace cg = cooperative_groups;

#ifndef ONE_LAUNCH
#define ONE_LAUNCH 1
#endif

typedef unsigned short bf16_t;
typedef __attribute__((ext_vector_type(8))) short bf16x8;
typedef __attribute__((ext_vector_type(4))) float f32x4;

#define NTHREADS 512
#define TOK 32768
#define SEQL 4096
#define DM 1024
#define EPSV 1e-6f
#define NPHASE 12

#define WS_WIN   ((size_t)0)
#define WS_WUPA  (WS_WIN  + (size_t)5120 * 1024 * 2)
#define WS_WUPB  (WS_WUPA + (size_t)1024 * 512 * 2)
#define WS_WOUT  (WS_WUPB + (size_t)1024 * 512 * 2)
#define WS_WQ    (WS_WOUT + (size_t)1024 * 1024 * 2)
#define WS_KEYS  (WS_WQ   + (size_t)2048 * 1024 * 2)
#define WS_LB    (WS_KEYS + (size_t)2 * 8 * 128 * 128 * 2)
#define WS_U     (WS_LB   + (size_t)4096)
#define WS_V     (WS_U    + (size_t)16384 * 1024 * 2)
#define WS_XN    (WS_V    + (size_t)16384 * 1024 * 2)
#define WS_PH    (WS_XN   + (size_t)TOK * 1024 * 2)
#define WS_PA    (WS_PH   + (size_t)TOK * 2048 * 2)
#define WS_PG    (WS_PA   + (size_t)TOK * 1024 * 2)
#define WS_EIDX  (WS_PG   + (size_t)TOK * 2048 * 2)
#define WS_GW    (WS_EIDX + (size_t)TOK * 128 * 4)
#define WS_SSQ   (WS_GW   + (size_t)TOK * 128 * 4)
#define WS_END   (WS_SSQ  + (size_t)TOK * 4)

#define LDS_BYTES 155648

struct Params {
  const float* x; const float* norm_mix; const float* w_in; const float* hg_lb; const float* hg_norm;
  const float* ikg; const float* ikb; const float* rel_bias; const float* w_up_a; const float* w_up_b;
  const float* w_out; const float* norm_ffn; const float* peer_wq; const float* peer_keys;
  const float* peer_u; const float* peer_v; const float* norm_final;
  float* out; unsigned char* ws; int ph_lo, ph_hi;
};

__device__ __forceinline__ float bf2f(bf16_t u) { return __uint_as_float(((unsigned)u) << 16); }
__device__ __forceinline__ bf16_t f2bf(float f) {
  unsigned u = __float_as_uint(f);
  u += 0x7fffu + ((u >> 16) & 1u);
  return (bf16_t)(u >> 16);
}
__device__ __forceinline__ unsigned pack2(float a, float b) { return (unsigned)f2bf(a) | ((unsigned)f2bf(b) << 16); }
__device__ __forceinline__ float wave_sum(float v) {
#pragma unroll
  for (int o = 32; o > 0; o >>= 1) v += __shfl_xor(v, o);
  return v;
}
__device__ __forceinline__ float sigmoidf_(float x) { return 1.f / (1.f + __expf(-x)); }
__device__ __forceinline__ float siluf_(float x) { return x / (1.f + __expf(-x)); }

__device__ __forceinline__ void gemm_tile(const bf16_t* __restrict__ A, int lda, const bf16_t* __restrict__ Bt, int ldb,
                                          int nk, f32x4 (&acc)[4][4], unsigned char* smem) {
  const int tid = threadIdx.x, lane = tid & 63, w = tid >> 6, wm = w >> 1, wn = w & 1, l15 = lane & 15, g = lane >> 4;
  unsigned char* sA = smem;
  unsigned char* sB = smem + 32768;
  const int lr = tid >> 3, lc = tid & 7;
  const bf16_t* ga = A + (size_t)lr * lda + lc * 8;
  const bf16_t* gb = Bt + (size_t)lr * ldb + lc * 8;
  uint4 ra0, ra1, ra2, ra3, rb0, rb1;
  ra0 = *(const uint4*)(ga);
  ra1 = *(const uint4*)(ga + (size_t)64 * lda);
  ra2 = *(const uint4*)(ga + (size_t)128 * lda);
  ra3 = *(const uint4*)(ga + (size_t)192 * lda);
  rb0 = *(const uint4*)(gb);
  rb1 = *(const uint4*)(gb + (size_t)64 * ldb);
  const int sw = (lc ^ (lr & 7)) << 4;
  for (int kt = 0; kt < nk; ++kt) {
    __syncthreads();
    *(uint4*)(sA + (lr) * 128 + sw) = ra0;
    *(uint4*)(sA + (lr + 64) * 128 + sw) = ra1;
    *(uint4*)(sA + (lr + 128) * 128 + sw) = ra2;
    *(uint4*)(sA + (lr + 192) * 128 + sw) = ra3;
    *(uint4*)(sB + (lr) * 128 + sw) = rb0;
    *(uint4*)(sB + (lr + 64) * 128 + sw) = rb1;
    __syncthreads();
    if (kt + 1 < nk) {
      const int ko = (kt + 1) * 64;
      ra0 = *(const uint4*)(ga + ko);
      ra1 = *(const uint4*)(ga + (size_t)64 * lda + ko);
      ra2 = *(const uint4*)(ga + (size_t)128 * lda + ko);
      ra3 = *(const uint4*)(ga + (size_t)192 * lda + ko);
      rb0 = *(const uint4*)(gb + ko);
      rb1 = *(const uint4*)(gb + (size_t)64 * ldb + ko);
    }
#pragma unroll
    for (int ks = 0; ks < 2; ++ks) {
      bf16x8 a[4], b[4];
#pragma unroll
      for (int m = 0; m < 4; ++m) { const int r = wm * 64 + m * 16 + l15; a[m] = *(const bf16x8*)(sA + r * 128 + (((ks * 4 + g) ^ (r & 7)) << 4)); }
#pragma unroll
      for (int n = 0; n < 4; ++n) { const int r = wn * 64 + n * 16 + l15; b[n] = *(const bf16x8*)(sB + r * 128 + (((ks * 4 + g) ^ (r & 7)) << 4)); }
#pragma unroll
      for (int m = 0; m < 4; ++m)
#pragma unroll
        for (int n = 0; n < 4; ++n) acc[m][n] = __builtin_amdgcn_mfma_f32_16x16x32_bf16(a[m], b[n], acc[m][n], 0, 0, 0);
    }
  }
}

__device__ __forceinline__ void zero_acc(f32x4 (&acc)[4][4]) {
#pragma unroll
  for (int m = 0; m < 4; ++m)
#pragma unroll
    for (int n = 0; n < 4; ++n) acc[m][n] = (f32x4){0.f, 0.f, 0.f, 0.f};
}

__device__ __forceinline__ void transpose_tile(const float* __restrict__ src, int srcN, bf16_t* __restrict__ dst, int K, int n0, int k0,
                                               bool winmap, float* tile) {
  const int tid = threadIdx.x;
  const int nc = tid & 63, kr = tid >> 6;
  int ncol = n0 + nc; bool valid = true;
  if (winmap) { if (ncol >= 3072) ncol -= 60; else if (ncol >= 3012) valid = false; }
#pragma unroll
  for (int i = 0; i < 8; ++i) {
    const int k = kr + 8 * i;
    tile[k * 65 + nc] = valid ? src[(size_t)(k0 + k) * srcN + ncol] : 0.f;
  }
  __syncthreads();
#pragma unroll
  for (int i = 0; i < 8; ++i) {
    const int nr = kr + 8 * i;
    dst[(size_t)(n0 + nr) * K + k0 + nc] = f2bf(tile[nc * 65 + nr]);
  }
  __syncthreads();
}

__device__ __forceinline__ void convert_f32_bf16(const float* __restrict__ src, bf16_t* __restrict__ dst, size_t n4) {
  for (size_t i = (size_t)blockIdx.x * NTHREADS + threadIdx.x; i < n4; i += (size_t)gridDim.x * NTHREADS) {
    const float4 v = ((const float4*)src)[i];
    uint2 o; o.x = pack2(v.x, v.y); o.y = pack2(v.z, v.w);
    ((uint2*)dst)[i] = o;
  }
}

__device__ __forceinline__ void rmsnorm_rows(const float* __restrict__ src, const float* __restrict__ g, bf16_t* __restrict__ dst) {
  const int lane = threadIdx.x & 63, w = threadIdx.x >> 6;
  for (int row = blockIdx.x * 8 + w; row < TOK; row += gridDim.x * 8) {
    const float4* s4 = (const float4*)(src + (size_t)row * DM);
    float4 v[4]; float ss = 0.f;
#pragma unroll
    for (int i = 0; i < 4; ++i) { v[i] = s4[lane + 64 * i]; ss += v[i].x * v[i].x + v[i].y * v[i].y + v[i].z * v[i].z + v[i].w * v[i].w; }
    ss = wave_sum(ss);
    const float rstd = rsqrtf(ss * (1.f / DM) + EPSV);
#pragma unroll
    for (int i = 0; i < 4; ++i) {
      const float4 gg = ((const float4*)g)[lane + 64 * i];
      uint2 o; o.x = pack2(v[i].x * rstd * gg.x, v[i].y * rstd * gg.y); o.y = pack2(v[i].z * rstd * gg.z, v[i].w * rstd * gg.w);
      ((uint2*)(dst + (size_t)row * DM))[lane + 64 * i] = o;
    }
  }
}

__device__ __forceinline__ void phase_prep(const Params& p, unsigned char* smem) {
  unsigned char* ws = p.ws;
  float* tile = (float*)smem;
  const int n_win = 80 * 16, n_ua = 16 * 8, n_ub = 16 * 8, n_wo = 16 * 16, n_wq = 32 * 16;
  const int total = n_win + n_ua + n_ub + n_wo + n_wq;
  for (int it = blockIdx.x; it < total; it += gridDim.x) {
    int t = it;
    if (t < n_win) { transpose_tile(p.w_in, 5060, (bf16_t*)(ws + WS_WIN), 1024, (t >> 4) * 64, (t & 15) * 64, true, tile); continue; }
    t -= n_win;
    if (t < n_ua) { transpose_tile(p.w_up_a, 1024, (bf16_t*)(ws + WS_WUPA), 512, (t >> 3) * 64, (t & 7) * 64, false, tile); continue; }
    t -= n_ua;
    if (t < n_ub) { transpose_tile(p.w_up_b, 1024, (bf16_t*)(ws + WS_WUPB), 512, (t >> 3) * 64, (t & 7) * 64, false, tile); continue; }
    t -= n_ub;
    if (t < n_wo) { transpose_tile(p.w_out, 1024, (bf16_t*)(ws + WS_WOUT), 1024, (t >> 4) * 64, (t & 15) * 64, false, tile); continue; }
    t -= n_wo;
    transpose_tile(p.peer_wq, 2048, (bf16_t*)(ws + WS_WQ), 1024, (t >> 4) * 64, (t & 15) * 64, false, tile);
  }
  convert_f32_bf16(p.peer_u, (bf16_t*)(ws + WS_U), (size_t)16384 * 1024 / 4);
  convert_f32_bf16(p.peer_v, (bf16_t*)(ws + WS_V), (size_t)16384 * 1024 / 4);
  convert_f32_bf16(p.peer_keys, (bf16_t*)(ws + WS_KEYS), (size_t)2 * 8 * 128 * 128 / 4);
  for (int i = blockIdx.x * NTHREADS + threadIdx.x; i < TOK; i += gridDim.x * NTHREADS) ((float*)(ws + WS_SSQ))[i] = 0.f;
  if (blockIdx.x == 0) {
    const int i = threadIdx.x;
    const float a0 = p.hg_lb[i], a1 = p.hg_lb[512 + i];
    ((float*)(ws + WS_LB))[i] = 1.f / (1.f + expf(a1 - a0));
  }
  rmsnorm_rows(p.x, p.norm_mix, (bf16_t*)(ws + WS_XN));
}

__device__ __forceinline__ void phase_proj(const Params& p, unsigned char* smem) {
  unsigned char* ws = p.ws;
  const bf16_t* xn = (const bf16_t*)(ws + WS_XN);
  const bf16_t* wt = (const bf16_t*)(ws + WS_WIN);
  bf16_t* pH = (bf16_t*)(ws + WS_PH);
  bf16_t* pA = (bf16_t*)(ws + WS_PA);
  bf16_t* pG = (bf16_t*)(ws + WS_PG);
  const int tid = threadIdx.x, lane = tid & 63, w = tid >> 6, wm = w >> 1, wn = w & 1, l15 = lane & 15, g = lane >> 4;
  for (int tile = blockIdx.x; tile < 128 * 40; tile += gridDim.x) {
    const int tn = tile % 40, tm = tile / 40;
    f32x4 acc[4][4]; zero_acc(acc);
    gemm_tile(xn + (size_t)tm * 256 * 1024, 1024, wt + (size_t)tn * 128 * 1024, 1024, 16, acc, smem);
    const int rbase = tm * 256 + wm * 64 + 4 * g;
    const int cbase = tn * 128 + wn * 64 + l15;
    if (tn < 16) {
#pragma unroll
      for (int m = 0; m < 4; ++m)
#pragma unroll
        for (int n = 0; n < 4; ++n)
#pragma unroll
          for (int j = 0; j < 4; ++j) pH[(size_t)(rbase + m * 16 + j) * 2048 + cbase + n * 16] = f2bf(acc[m][n][j]);
    } else if (tn < 24) {
      if (tn == 23 && wn == 0) {
        float gam[4], bet[4];
#pragma unroll
        for (int n = 0; n < 4; ++n) { gam[n] = p.ikg[n * 16 + l15]; bet[n] = p.ikb[n * 16 + l15]; }
#pragma unroll
        for (int m = 0; m < 4; ++m)
#pragma unroll
          for (int j = 0; j < 4; ++j) {
            float s = acc[m][0][j] + acc[m][1][j] + acc[m][2][j] + acc[m][3][j];
            s += __shfl_xor(s, 1); s += __shfl_xor(s, 2); s += __shfl_xor(s, 4); s += __shfl_xor(s, 8);
            const float mu = s * (1.f / 64.f);
            float q = 0.f;
#pragma unroll
            for (int n = 0; n < 4; ++n) { const float d = acc[m][n][j] - mu; q += d * d; }
            q += __shfl_xor(q, 1); q += __shfl_xor(q, 2); q += __shfl_xor(q, 4); q += __shfl_xor(q, 8);
            const float rstd = rsqrtf(q * (1.f / 64.f) + EPSV);
#pragma unroll
            for (int n = 0; n < 4; ++n)
              pA[(size_t)(rbase + m * 16 + j) * 1024 + (cbase - 2048) + n * 16] = f2bf((acc[m][n][j] - mu) * rstd * gam[n] + bet[n]);
          }
      } else {
#pragma unroll
        for (int m = 0; m < 4; ++m)
#pragma unroll
          for (int n = 0; n < 4; ++n)
#pragma unroll
            for (int j = 0; j < 4; ++j) pA[(size_t)(rbase + m * 16 + j) * 1024 + (cbase - 2048) + n * 16] = f2bf(acc[m][n][j]);
      }
    } else {
#pragma unroll
      for (int m = 0; m < 4; ++m)
#pragma unroll
        for (int n = 0; n < 4; ++n)
#pragma unroll
          for (int j = 0; j < 4; ++j) pG[(size_t)(rbase + m * 16 + j) * 2048 + (cbase - 3072) + n * 16] = f2bf(sigmoidf_(acc[m][n][j]));
    }
  }
}

__device__ __forceinline__ void hgrn_item(const Params& p, unsigned char* smem, int bh) {
  unsigned char* ws = p.ws;
  const bf16_t* pH = (const bf16_t*)(ws + WS_PH);
  const float* lbp = (const float*)(ws + WS_LB);
  bf16_t* ya = (bf16_t*)(ws + WS_XN);
  bf16_t* Qt = (bf16_t*)smem;
  bf16_t* Kt = Qt + 64 * 136;
  bf16_t* KtT = Kt + 64 * 136;
  bf16_t* VT = KtT + 128 * 72;
  bf16_t* Am = VT + 128 * 72;
  bf16_t* ST = Am + 64 * 72;
  float* qtot = (float*)(ST + 128 * 136);
  float* eref = qtot + 512;
  float* elast = eref + 128;
  float* elr = elast + 128;
  float* red = elr + 128;
  const int tid = threadIdx.x, lane = tid & 63, w = tid >> 6, l15 = lane & 15, g = lane >> 4;
  const int b = bh >> 2, h = bh & 3;
  const int d = tid & 127, tq = tid >> 7;
  const float lbv = lbp[h * 128 + d];
  f32x4 S[8];
#pragma unroll
  for (int i = 0; i < 8; ++i) S[i] = (f32x4){0.f, 0.f, 0.f, 0.f};
  const float gnv = p.hg_norm[h * 128 + 16 * w + l15];

  for (int chunk = 0; chunk < 64; ++chunk) {
    const size_t row0 = (size_t)b * SEQL + chunk * 64;
    {
      const bf16_t* base = pH + (row0 + tq * 16) * 2048 + h * 128 + d;
      float lf[16], kk[16], qs[16];
      unsigned vv[8];
      float run = 0.f;
#pragma unroll
      for (int i = 0; i < 16; ++i) {
        const float fr = bf2f(base[(size_t)i * 2048 + 512]);
        const float qr = bf2f(base[(size_t)i * 2048]);
        const float sg = sigmoidf_(fr);
        const float fg = lbv + (1.f - lbv) * sg;
        run += __logf(fg);
        lf[i] = run; kk[i] = 1.f - fg; qs[i] = siluf_(qr);
      }
#pragma unroll
      for (int i = 0; i < 8; ++i) {
        const unsigned lo = base[(size_t)(2 * i) * 2048 + 1024], hi = base[(size_t)(2 * i + 1) * 2048 + 1024];
        vv[i] = lo | (hi << 16);
      }
      qtot[tq * 128 + d] = run;
      __syncthreads();
      const float q0 = qtot[d], q1 = qtot[128 + d], q2 = qtot[256 + d], q3 = qtot[384 + d];
      const float pre = (tq > 0 ? q0 : 0.f) + (tq > 1 ? q1 : 0.f) + (tq > 2 ? q2 : 0.f);
      const float bref = q0 + q1;
      const float blast = bref + q2 + q3;
      unsigned kp[8];
#pragma unroll
      for (int i = 0; i < 16; ++i) {
        const float bt = pre + lf[i];
        const float qt = qs[i] * __expf(bt - bref);
        const float kt = kk[i] * __expf(bref - bt);
        const int t = tq * 16 + i;
        Qt[t * 136 + d] = f2bf(qt);
        const bf16_t kb = f2bf(kt);
        Kt[t * 136 + d] = kb;
        if (i & 1) kp[i >> 1] |= ((unsigned)kb) << 16; else kp[i >> 1] = kb;
      }
      *(uint4*)(KtT + d * 72 + tq * 16) = make_uint4(kp[0], kp[1], kp[2], kp[3]);
      *(uint4*)(KtT + d * 72 + tq * 16 + 8) = make_uint4(kp[4], kp[5], kp[6], kp[7]);
      *(uint4*)(VT + d * 72 + tq * 16) = make_uint4(vv[0], vv[1], vv[2], vv[3]);
      *(uint4*)(VT + d * 72 + tq * 16 + 8) = make_uint4(vv[4], vv[5], vv[6], vv[7]);
      if (tq == 0) { eref[d] = __expf(bref); elast[d] = __expf(blast); elr[d] = __expf(blast - bref); }
    }
    __syncthreads();
    bf16_t ogr[16];
#pragma unroll
    for (int tm = 0; tm < 4; ++tm)
#pragma unroll
      for (int j = 0; j < 4; ++j) ogr[tm * 4 + j] = pH[(row0 + tm * 16 + 4 * g + j) * 2048 + 1536 + h * 128 + 16 * w + l15];
    {
      const int e = 16 * w + l15;
#pragma unroll
      for (int dm = 0; dm < 8; ++dm) {
        const int d0 = 16 * dm + 4 * g;
        uint2 o;
        o.x = pack2(S[dm][0] * eref[d0], S[dm][1] * eref[d0 + 1]);
        o.y = pack2(S[dm][2] * eref[d0 + 2], S[dm][3] * eref[d0 + 3]);
        *(uint2*)(ST + e * 136 + d0) = o;
      }
#pragma unroll
      for (int tt = 0; tt < 2; ++tt) {
        const int tl = 2 * w + tt, sm = tl >> 2, tn = tl & 3;
        f32x4 acc = (f32x4){0.f, 0.f, 0.f, 0.f};
        if (tn >= sm) {
#pragma unroll
          for (int k0 = 0; k0 < 128; k0 += 32) {
            const bf16x8 a = *(const bf16x8*)(Kt + (sm * 16 + l15) * 136 + k0 + 8 * g);
            const bf16x8 bq = *(const bf16x8*)(Qt + (tn * 16 + l15) * 136 + k0 + 8 * g);
            acc = __builtin_amdgcn_mfma_f32_16x16x32_bf16(a, bq, acc, 0, 0, 0);
          }
        }
        const int t = tn * 16 + l15, s0 = sm * 16 + 4 * g;
        uint2 o;
        o.x = pack2(s0 + 0 <= t ? acc[0] : 0.f, s0 + 1 <= t ? acc[1] : 0.f);
        o.y = pack2(s0 + 2 <= t ? acc[2] : 0.f, s0 + 3 <= t ? acc[3] : 0.f);
        *(uint2*)(Am + t * 72 + s0) = o;
      }
    }
    __syncthreads();
    f32x4 o[4];
    {
#pragma unroll
      for (int tm = 0; tm < 4; ++tm) {
        f32x4 acc = (f32x4){0.f, 0.f, 0.f, 0.f};
#pragma unroll
        for (int k0 = 0; k0 < 128; k0 += 32) {
          const bf16x8 a = *(const bf16x8*)(Qt + (tm * 16 + l15) * 136 + k0 + 8 * g);
          const bf16x8 bb = *(const bf16x8*)(ST + (16 * w + l15) * 136 + k0 + 8 * g);
          acc = __builtin_amdgcn_mfma_f32_16x16x32_bf16(a, bb, acc, 0, 0, 0);
        }
#pragma unroll
        for (int k0 = 0; k0 < 64; k0 += 32) {
          const bf16x8 a = *(const bf16x8*)(Am + (tm * 16 + l15) * 72 + k0 + 8 * g);
          const bf16x8 bb = *(const bf16x8*)(VT + (16 * w + l15) * 72 + k0 + 8 * g);
          acc = __builtin_amdgcn_mfma_f32_16x16x32_bf16(a, bb, acc, 0, 0, 0);
        }
        o[tm] = acc;
#pragma unroll
        for (int j = 0; j < 4; ++j) {
          float ss = acc[j] * acc[j];
          ss += __shfl_xor(ss, 1); ss += __shfl_xor(ss, 2); ss += __shfl_xor(ss, 4); ss += __shfl_xor(ss, 8);
          if (l15 == 0) red[w * 64 + tm * 16 + 4 * g + j] = ss;
        }
      }
#pragma unroll
      for (int dm = 0; dm < 8; ++dm) {
        f32x4 acc = (f32x4){0.f, 0.f, 0.f, 0.f};
#pragma unroll
        for (int k0 = 0; k0 < 64; k0 += 32) {
          const bf16x8 a = *(const bf16x8*)(KtT + (dm * 16 + l15) * 72 + k0 + 8 * g);
          const bf16x8 bb = *(const bf16x8*)(VT + (16 * w + l15) * 72 + k0 + 8 * g);
          acc = __builtin_amdgcn_mfma_f32_16x16x32_bf16(a, bb, acc, 0, 0, 0);
        }
#pragma unroll
        for (int j = 0; j < 4; ++j) { const int dd = 16 * dm + 4 * g + j; S[dm][j] = elast[dd] * S[dm][j] + elr[dd] * acc[j]; }
      }
    }
    __syncthreads();
    {
      const int e = 16 * w + l15;
#pragma unroll
      for (int tm = 0; tm < 4; ++tm)
#pragma unroll
        for (int j = 0; j < 4; ++j) {
          const int t = tm * 16 + 4 * g + j;
          float tot = 0.f;
#pragma unroll
          for (int ww = 0; ww < 8; ++ww) tot += red[ww * 64 + t];
          const float rstd = rsqrtf(tot * (1.f / 128.f) + EPSV);
          const float og = bf2f(ogr[tm * 4 + j]);
          ya[(row0 + t) * 512 + h * 128 + e] = f2bf(o[tm][j] * rstd * gnv * siluf_(og));
        }
    }
  }
}

#define SCW 4100
#ifndef DSA_REP
#define DSA_REP 0
#endif
#define DSA_BKT_OFF (8 * SCW * 4 + 8 * 256 * 4 + 8 * 256 * 2 + 8 * 512 * 2)
__device__ __forceinline__ void cvt8(const uint4& v, float* f) {
  f[0] = __uint_as_float(v.x << 16); f[1] = __uint_as_float(v.x & 0xffff0000u);
  f[2] = __uint_as_float(v.y << 16); f[3] = __uint_as_float(v.y & 0xffff0000u);
  f[4] = __uint_as_float(v.z << 16); f[5] = __uint_as_float(v.z & 0xffff0000u);
  f[6] = __uint_as_float(v.w << 16); f[7] = __uint_as_float(v.w & 0xffff0000u);
}
__device__ __forceinline__ unsigned sortable_key(float v) {
  unsigned bits = __float_as_uint(v);
  if (bits == 0x80000000u) bits = 0u;
  return (bits & 0x80000000u) ? ~bits : (bits | 0x80000000u);
}

__device__ __forceinline__ void dsa_item(const Params& p, unsigned char* smem, int item) {
  unsigned char* ws = p.ws;
  const bf16_t* pA = (const bf16_t*)(ws + WS_PA);
  bf16_t* yb = (bf16_t*)(ws + WS_XN) + (size_t)TOK * 512;
  unsigned* sc = (unsigned*)smem;
  unsigned* hist = sc + 8 * SCW;
  unsigned short* sel = (unsigned short*)(hist + 8 * 256);
  unsigned short* cand = sel + 8 * 256;
  unsigned char* bkt = (unsigned char*)(cand + 8 * 512);
  const int tid = threadIdx.x, lane = tid & 63, w = tid >> 6, l15 = lane & 15, g = lane >> 4;
  const int b = item >> 9;
  const int r = item & 511;
  const int tb = (b & 1) ? 511 - r : r;
  const int t0 = tb * 8;
  const size_t tokbase = (size_t)b * SEQL;

  for (int rep_s = 0; rep_s < (DSA_REP == 1 ? 2 : 1); ++rep_s) {
    bf16x8 af[2][2];
    float wq[2][4];
#pragma unroll
    for (int mt = 0; mt < 2; ++mt) {
      const int qrow = t0 + mt * 4 + (l15 >> 2), head = l15 & 3;
#pragma unroll
      for (int ks = 0; ks < 2; ++ks)
        af[mt][ks] = *(const bf16x8*)(pA + (tokbase + qrow) * 1024 + 640 + head * 64 + ks * 32 + 8 * g);
      const uint2 wr = *(const uint2*)(pA + (tokbase + t0 + mt * 4 + g) * 1024 + 960);
      wq[mt][0] = 0.5f * bf2f((bf16_t)(wr.x & 0xffff)); wq[mt][1] = 0.5f * bf2f((bf16_t)(wr.x >> 16));
      wq[mt][2] = 0.5f * bf2f((bf16_t)(wr.y & 0xffff)); wq[mt][3] = 0.5f * bf2f((bf16_t)(wr.y >> 16));
    }
    const int nkt = (t0 + 8 + 15) >> 4;
    for (int kt0 = w; kt0 < nkt; kt0 += 32) {
      bf16x8 b0[4], b1[4];
#pragma unroll
      for (int u = 0; u < 4; ++u) {
        const int kt = kt0 + 8 * u;
        const int s = (kt < nkt ? kt : 0) * 16 + l15;
        const bf16_t* kr = pA + (tokbase + s) * 1024 + 896 + 8 * g;
        b0[u] = *(const bf16x8*)kr;
        b1[u] = *(const bf16x8*)(kr + 32);
      }
#pragma unroll
      for (int u = 0; u < 4; ++u) {
        const int kt = kt0 + 8 * u;
        if (kt < nkt) {
          const int s = kt * 16 + l15;
#pragma unroll
          for (int mt = 0; mt < 2; ++mt) {
            f32x4 acc = (f32x4){0.f, 0.f, 0.f, 0.f};
            acc = __builtin_amdgcn_mfma_f32_16x16x32_bf16(af[mt][0], b0[u], acc, 0, 0, 0);
            acc = __builtin_amdgcn_mfma_f32_16x16x32_bf16(af[mt][1], b1[u], acc, 0, 0, 0);
            float v = 0.f;
#pragma unroll
            for (int j = 0; j < 4; ++j) v += wq[mt][j] * fmaxf(acc[j] * 0.125f, 0.f);
            const int t = t0 + mt * 4 + g;
            unsigned vb = __float_as_uint(v); if (vb == 0x80000000u) vb = 0u;
            sc[(mt * 4 + g) * SCW + s] = vb;
          }
        }
      }
    }
  }
  __syncthreads();
  const int t = t0 + w;
  const int n = t + 1;
  unsigned* row = sc + w * SCW;
  const float* rowf = (const float*)row;
  unsigned short* mysel = sel + w * 256;
  unsigned short* mycand = cand + w * 512;
  unsigned* myh = hist + w * 256;
  int cnt;
  const unsigned long long lt_mask = (1ull << lane) - 1ull;
  for (int rep_t = 0; rep_t < (DSA_REP == 2 ? 2 : 1); ++rep_t)
  if (n <= 256) {
    for (int i = lane; i < n; i += 64) mysel[i] = (unsigned short)i;
    cnt = n;
  } else {
    cnt = 256;
    float mn = INFINITY, mx = -INFINITY;
    for (int i = lane; i < n; i += 64) { const float v = rowf[i]; mn = fminf(mn, v); mx = fmaxf(mx, v); }
#pragma unroll
    for (int o = 32; o > 0; o >>= 1) { mn = fminf(mn, __shfl_xor(mn, o)); mx = fmaxf(mx, __shfl_xor(mx, o)); }
    const float scale = (mx > mn) ? 255.99f / (mx - mn) : 0.f;
#pragma unroll
    for (int i = 0; i < 4; ++i) myh[lane + 64 * i] = 0u;
    __threadfence_block();
    for (int i = lane; i < n; i += 64) {
      const float v = rowf[i];
      int bn = (int)((v - mn) * scale); bn = bn > 255 ? 255 : bn;
      atomicAdd(&myh[bn], 1u);
    }
    __threadfence_block();
    unsigned cum; int bstar; unsigned mcount;
    {
      const uint4 c4 = *(const uint4*)(myh + 4 * lane);
      const unsigned c = c4.x + c4.y + c4.z + c4.w;
      unsigned sfx = c;
#pragma unroll
      for (int o = 1; o < 64; o <<= 1) { const unsigned tt = __shfl_down(sfx, o); if (lane + o < 64) sfx += tt; }
      const unsigned long long bal = __ballot(sfx >= 256u);
      const int L = 63 - __clzll(bal);
      const unsigned sL = __shfl(sfx, L), cL = __shfl(c, L);
      const unsigned b3 = __shfl(c4.w, L), b2 = __shfl(c4.z, L), b1 = __shfl(c4.y, L), b0 = __shfl(c4.x, L);
      cum = sL - cL;
      int digit;
      if (cum + b3 >= 256u) { digit = 3; mcount = b3; }
      else { cum += b3; if (cum + b2 >= 256u) { digit = 2; mcount = b2; } else { cum += b2; if (cum + b1 >= 256u) { digit = 1; mcount = b1; } else { cum += b1; digit = 0; mcount = b0; } } }
      bstar = 4 * L + digit;
    }
    const unsigned need = 256u - cum;
    if (mcount <= 512u) {
      unsigned base = 0u, cb = 0u;
      for (int i0 = 0; i0 < n; i0 += 64) {
        const int i = i0 + lane;
        const bool valid = i < n;
        const float v = valid ? rowf[i] : 0.f;
        int bn = (int)((v - mn) * scale); bn = bn > 255 ? 255 : bn;
        const bool gt = valid && (bn > bstar);
        const bool eq = valid && (bn == bstar);
        const unsigned long long bg = __ballot(gt), be = __ballot(eq);
        if (gt) mysel[base + (unsigned)__popcll(bg & lt_mask)] = (unsigned short)i;
        if (eq) mycand[cb + (unsigned)__popcll(be & lt_mask)] = (unsigned short)i;
        base += (unsigned)__popcll(bg); cb += (unsigned)__popcll(be);
      }
      __threadfence_block();
      const int m = (int)mcount;
      unsigned ck[8]; unsigned short ci[8];
#pragma unroll
      for (int q = 0; q < 8; ++q) {
        const int c = q * 64 + lane;
        ck[q] = 0u; ci[q] = 0;
        if (c < m) { ci[q] = mycand[c]; ck[q] = sortable_key(rowf[ci[q]]); }
      }
      unsigned T = 0u;
#pragma unroll 1
      for (int bit = 31; bit >= 0; --bit) {
        const unsigned trial = T | (1u << bit);
        unsigned cge = 0u;
#pragma unroll
        for (int q = 0; q < 8; ++q) cge += (unsigned)__popcll(__ballot(ck[q] >= trial));
        if (cge >= need) T = trial;
      }
      unsigned cgt = 0u;
#pragma unroll
      for (int q = 0; q < 8; ++q) cgt += (unsigned)__popcll(__ballot(ck[q] > T));
      const unsigned need_eq = need - cgt;
      unsigned pos0 = cum, eqtaken = 0u;
#pragma unroll
      for (int q = 0; q < 8; ++q) {
        const bool gt = ck[q] > T;
        const bool eq = ck[q] == T;
        const unsigned long long beq = __ballot(eq);
        const bool take = gt || (eq && (eqtaken + (unsigned)__popcll(beq & lt_mask)) < need_eq);
        const unsigned long long bt = __ballot(take);
        const unsigned pp = pos0 + (unsigned)__popcll(bt & lt_mask);
        if (take && pp < 256u) mysel[pp] = ci[q];
        pos0 += (unsigned)__popcll(bt);
        eqtaken += (unsigned)__popcll(beq);
      }
    } else {
      unsigned prefix = 0u, krem = 256u;
#pragma unroll 1
      for (int pass = 0; pass < 4; ++pass) {
        const int shift = 24 - 8 * pass;
        const unsigned himask = (pass == 0) ? 0u : (0xFFFFFFFFu << (shift + 8));
#pragma unroll
        for (int i = 0; i < 4; ++i) myh[lane + 64 * i] = 0u;
        __threadfence_block();
        for (int i = lane; i < n; i += 64) {
          const unsigned u = sortable_key(rowf[i]);
          if ((u & himask) == prefix) atomicAdd(&myh[(u >> shift) & 255u], 1u);
        }
        __threadfence_block();
        const uint4 c4 = *(const uint4*)(myh + 4 * lane);
        const unsigned c = c4.x + c4.y + c4.z + c4.w;
        unsigned sfx = c;
#pragma unroll
        for (int o = 1; o < 64; o <<= 1) { const unsigned tt = __shfl_down(sfx, o); if (lane + o < 64) sfx += tt; }
        const unsigned long long bal = __ballot(sfx >= krem);
        const int L = 63 - __clzll(bal);
        const unsigned sL = __shfl(sfx, L), cL = __shfl(c, L);
        const unsigned b3 = __shfl(c4.w, L), b2 = __shfl(c4.z, L), b1 = __shfl(c4.y, L);
        unsigned cum2 = sL - cL;
        unsigned digit;
        if (cum2 + b3 >= krem) digit = 3;
        else { cum2 += b3; if (cum2 + b2 >= krem) digit = 2; else { cum2 += b2; if (cum2 + b1 >= krem) digit = 1; else { cum2 += b1; digit = 0; } } }
        krem -= cum2;
        prefix |= ((unsigned)(4 * L) + digit) << shift;
      }
      const unsigned T = prefix;
      unsigned base = 0u, eqtaken = 0u;
      for (int i0 = 0; i0 < n; i0 += 64) {
        const int i = i0 + lane;
        const bool valid = i < n;
        const unsigned u = valid ? sortable_key(rowf[i]) : 0u;
        const bool gt = valid && (u > T);
        const bool eq = valid && (u == T);
        const unsigned long long beq = __ballot(eq);
        const unsigned eqrank = eqtaken + (unsigned)__popcll(beq & lt_mask);
        const bool take = gt || (eq && eqrank < krem);
        const unsigned long long bt = __ballot(take);
        const unsigned pos = base + (unsigned)__popcll(bt & lt_mask);
        if (take && pos < 256u) mysel[pos] = (unsigned short)i;
        base += (unsigned)__popcll(bt);
        eqtaken += (unsigned)__popcll(beq);
      }
    }
  }
  __threadfence_block();
  for (int rep_a = 0; rep_a < (DSA_REP == 3 ? 2 : 1); ++rep_a) {
    const int ks = lane >> 3, dc = lane & 7;
    float* pl = (float*)row;
    const int niter = (cnt + 7) >> 3;
    {
      const float* relb = (const float*)(bkt + 128);
      bf16x8 bq[2];
#pragma unroll
      for (int ks2 = 0; ks2 < 2; ++ks2) {
        bq[ks2] = (bf16x8){0, 0, 0, 0, 0, 0, 0, 0};
        if (l15 < 8) bq[ks2] = *(const bf16x8*)(pA + (tokbase + t) * 1024 + l15 * 64 + ks2 * 32 + 8 * g);
      }
      const int ntile = (cnt + 15) >> 4;
      for (int kt0 = 0; kt0 < ntile; kt0 += 4) {
        bf16x8 ka[4][2];
#pragma unroll
        for (int u = 0; u < 4; ++u) {
          const int kk = (kt0 + u) * 16 + l15;
          const int s = (kk < cnt) ? (int)mysel[kk] : 0;
          const bf16_t* kr = pA + (tokbase + s) * 1024 + 512 + 8 * g;
          ka[u][0] = *(const bf16x8*)kr;
          ka[u][1] = *(const bf16x8*)(kr + 32);
        }
#pragma unroll
        for (int u = 0; u < 4; ++u) {
          if (kt0 + u < ntile) {
            f32x4 acc = (f32x4){0.f, 0.f, 0.f, 0.f};
            acc = __builtin_amdgcn_mfma_f32_16x16x32_bf16(ka[u][0], bq[0], acc, 0, 0, 0);
            acc = __builtin_amdgcn_mfma_f32_16x16x32_bf16(ka[u][1], bq[1], acc, 0, 0, 0);
            if (l15 < 8) {
#pragma unroll
              for (int j = 0; j < 4; ++j) {
                const int key = (kt0 + u) * 16 + 4 * g + j;
                const bool valid = key < cnt;
                const int sj = valid ? (int)mysel[key] : 0;
                const int dist = t - sj;
                const int bk = dist < 128 ? (int)bkt[dist] : 31;
                pl[key * 8 + l15] = valid ? (acc[j] * 0.125f + relb[bk * 8 + l15]) : -INFINITY;
              }
            }
          }
        }
      }
    }
    __threadfence_block();
    float inv;
    {
      const int hh = lane & 7, part = lane >> 3;
      float m = -INFINITY;
      for (int kk = part; kk < cnt; kk += 8) m = fmaxf(m, pl[kk * 8 + hh]);
      m = fmaxf(m, __shfl_xor(m, 8)); m = fmaxf(m, __shfl_xor(m, 16)); m = fmaxf(m, __shfl_xor(m, 32));
      float sum = 0.f;
      for (int kk = part; kk < niter * 8; kk += 8) {
        const float e = (kk < cnt) ? __expf(pl[kk * 8 + hh] - m) : 0.f;
        pl[kk * 8 + hh] = e;
        sum += e;
      }
      sum += __shfl_xor(sum, 8); sum += __shfl_xor(sum, 16); sum += __shfl_xor(sum, 32);
      inv = 1.f / sum;
    }
    __threadfence_block();
    float acc[8][8];
#pragma unroll
    for (int hh = 0; hh < 8; ++hh)
#pragma unroll
      for (int i = 0; i < 8; ++i) acc[hh][i] = 0.f;
    for (int it0 = 0; it0 < niter; it0 += 8) {
      uint4 vv[8];
#pragma unroll
      for (int u = 0; u < 8; ++u) {
        const int kk = (it0 + u) * 8 + ks;
        const int s = (kk < cnt) ? (int)mysel[kk] : 0;
        vv[u] = *(const uint4*)(pA + (tokbase + s) * 1024 + 576 + dc * 8);
      }
#pragma unroll
      for (int u = 0; u < 8; ++u) {
        if (it0 + u < niter) {
          const int kk = (it0 + u) * 8 + ks;
          float vf[8];
          cvt8(vv[u], vf);
          const float4 p0 = *(const float4*)(pl + kk * 8);
          const float4 p1 = *(const float4*)(pl + kk * 8 + 4);
          const float pp[8] = {p0.x, p0.y, p0.z, p0.w, p1.x, p1.y, p1.z, p1.w};
#pragma unroll
          for (int hh = 0; hh < 8; ++hh)
#pragma unroll
            for (int i = 0; i < 8; ++i) acc[hh][i] += pp[hh] * vf[i];
        }
      }
    }
#pragma unroll
    for (int hh = 0; hh < 8; ++hh) {
      const float ih = __shfl(inv, hh);
#pragma unroll
      for (int i = 0; i < 8; ++i) {
        float v = acc[hh][i];
        v += __shfl_xor(v, 8); v += __shfl_xor(v, 16); v += __shfl_xor(v, 32);
        acc[hh][i] = v * ih;
      }
    }
    if (ks == 0) {
#pragma unroll
      for (int hh = 0; hh < 8; ++hh) {
        uint4 o;
        o.x = pack2(acc[hh][0], acc[hh][1]); o.y = pack2(acc[hh][2], acc[hh][3]);
        o.z = pack2(acc[hh][4], acc[hh][5]); o.w = pack2(acc[hh][6], acc[hh][7]);
        *(uint4*)(yb + (tokbase + t) * 512 + hh * 64 + dc * 8) = o;
      }
    }
  }
  __syncthreads();
}

__device__ __forceinline__ void phase_mix(const Params& p, unsigned char* smem) {
  const int G = gridDim.x;
  if (G >= 64) {
    if (blockIdx.x < 32) { hgrn_item(p, smem, blockIdx.x); return; }
    unsigned char* bkt = smem + DSA_BKT_OFF;
    if (threadIdx.x < 128) {
      const int nn = threadIdx.x;
      int v = nn;
      if (nn >= 16) { v = 16 + (int)(logf((float)nn * (1.f / 16.f)) / logf(8.f) * 16.f); if (v > 31) v = 31; }
      bkt[nn] = (unsigned char)v;
    }
    if (threadIdx.x >= 256) ((float*)(bkt + 128))[threadIdx.x - 256] = p.rel_bias[threadIdx.x - 256];
    __syncthreads();
    for (int item = blockIdx.x - 32; item < 4096; item += G - 32) dsa_item(p, smem, item);
  } else {
    for (int bh = blockIdx.x; bh < 32; bh += G) { hgrn_item(p, smem, bh); __syncthreads(); }
    unsigned char* bkt = smem + DSA_BKT_OFF;
    __syncthreads();
    if (threadIdx.x < 128) {
      const int nn = threadIdx.x;
      int v = nn;
      if (nn >= 16) { v = 16 + (int)(logf((float)nn * (1.f / 16.f)) / logf(8.f) * 16.f); if (v > 31) v = 31; }
      bkt[nn] = (unsigned char)v;
    }
    if (threadIdx.x >= 256) ((float*)(bkt + 128))[threadIdx.x - 256] = p.rel_bias[threadIdx.x - 256];
    __syncthreads();
    for (int item = blockIdx.x; item < 4096; item += G) dsa_item(p, smem, item);
  }
}

__device__ __forceinline__ void phase_up(const Params& p, unsigned char* smem) {
  unsigned char* ws = p.ws;
  const bf16_t* ya = (const bf16_t*)(ws + WS_XN);
  const bf16_t* yb = ya + (size_t)TOK * 512;
  const bf16_t* wa = (const bf16_t*)(ws + WS_WUPA);
  const bf16_t* wb = (const bf16_t*)(ws + WS_WUPB);
  const bf16_t* pG = (const bf16_t*)(ws + WS_PG);
  bf16_t* hb = (bf16_t*)(ws + WS_PH);
  const int tid = threadIdx.x, lane = tid & 63, w = tid >> 6, wm = w >> 1, wn = w & 1, l15 = lane & 15, g = lane >> 4;
  for (int tile = blockIdx.x; tile < 128 * 8; tile += gridDim.x) {
    const int tn = tile & 7, tm = tile >> 3;
    f32x4 acc[4][4]; zero_acc(acc);
    gemm_tile(ya + (size_t)tm * 256 * 512, 512, wa + (size_t)tn * 128 * 512, 512, 8, acc, smem);
    asm volatile("" ::: "memory");
    const int rbase = tm * 256 + wm * 64 + 4 * g;
    const int cbase = tn * 128 + wn * 64 + l15;
#pragma unroll
    for (int m = 0; m < 4; ++m) {
      bf16_t gt[16];
#pragma unroll
      for (int n = 0; n < 4; ++n)
#pragma unroll
        for (int j = 0; j < 4; ++j) gt[n * 4 + j] = pG[(size_t)(rbase + m * 16 + j) * 2048 + cbase + n * 16];
#pragma unroll
      for (int n = 0; n < 4; ++n) {
#pragma unroll
        for (int j = 0; j < 4; ++j) {
          const size_t rr = (size_t)(rbase + m * 16 + j);
          hb[rr * 1024 + cbase + n * 16] = f2bf(acc[m][n][j] * bf2f(gt[n * 4 + j]));
        }
        acc[m][n] = (f32x4){0.f, 0.f, 0.f, 0.f};
      }
    }
    asm volatile("" ::: "memory");
    gemm_tile(yb + (size_t)tm * 256 * 512, 512, wb + (size_t)tn * 128 * 512, 512, 8, acc, smem);
    asm volatile("" ::: "memory");
#pragma unroll
    for (int m = 0; m < 4; ++m) {
      bf16_t gt[16], ht[16];
#pragma unroll
      for (int n = 0; n < 4; ++n)
#pragma unroll
        for (int j = 0; j < 4; ++j) {
          const size_t rr = (size_t)(rbase + m * 16 + j);
          gt[n * 4 + j] = pG[rr * 2048 + 1024 + cbase + n * 16];
          ht[n * 4 + j] = hb[rr * 1024 + cbase + n * 16];
        }
#pragma unroll
      for (int n = 0; n < 4; ++n)
#pragma unroll
        for (int j = 0; j < 4; ++j) {
          const size_t rr = (size_t)(rbase + m * 16 + j);
          hb[rr * 1024 + cbase + n * 16] = f2bf(bf2f(ht[n * 4 + j]) + acc[m][n][j] * bf2f(gt[n * 4 + j]));
        }
    }
  }
}

__device__ __forceinline__ void phase_out(const Params& p, unsigned char* smem) {
  unsigned char* ws = p.ws;
  const bf16_t* hb = (const bf16_t*)(ws + WS_PH);
  const bf16_t* wo = (const bf16_t*)(ws + WS_WOUT);
  const int tid = threadIdx.x, lane = tid & 63, w = tid >> 6, wm = w >> 1, wn = w & 1, l15 = lane & 15, g = lane >> 4;
  for (int tile = blockIdx.x; tile < 128 * 8; tile += gridDim.x) {
    const int tn = tile & 7, tm = tile >> 3;
    f32x4 acc[4][4]; zero_acc(acc);
    gemm_tile(hb + (size_t)tm * 256 * 1024, 1024, wo + (size_t)tn * 128 * 1024, 1024, 16, acc, smem);
    const int rbase = tm * 256 + wm * 64 + 4 * g;
    const int cbase = tn * 128 + wn * 64 + l15;
#pragma unroll
    for (int m = 0; m < 4; ++m) {
      float xt[16];
#pragma unroll
      for (int n = 0; n < 4; ++n)
#pragma unroll
        for (int j = 0; j < 4; ++j) xt[n * 4 + j] = p.x[(size_t)(rbase + m * 16 + j) * 1024 + cbase + n * 16];
#pragma unroll
      for (int n = 0; n < 4; ++n)
#pragma unroll
        for (int j = 0; j < 4; ++j) p.out[(size_t)(rbase + m * 16 + j) * 1024 + cbase + n * 16] = xt[n * 4 + j] + acc[m][n][j];
    }
  }
}

__device__ __forceinline__ void phase_pq(const Params& p, unsigned char* smem) {
  unsigned char* ws = p.ws;
  const bf16_t* xn2 = (const bf16_t*)(ws + WS_XN);
  const bf16_t* wq = (const bf16_t*)(ws + WS_WQ);
  bf16_t* qp = (bf16_t*)(ws + WS_PG);
  const int tid = threadIdx.x, lane = tid & 63, w = tid >> 6, wm = w >> 1, wn = w & 1, l15 = lane & 15, g = lane >> 4;
  for (int tile = blockIdx.x; tile < 128 * 16; tile += gridDim.x) {
    const int tn = tile & 15, tm = tile >> 4;
    f32x4 acc[4][4]; zero_acc(acc);
    gemm_tile(xn2 + (size_t)tm * 256 * 1024, 1024, wq + (size_t)tn * 128 * 1024, 1024, 16, acc, smem);
    const int rbase = tm * 256 + wm * 64 + 4 * g;
    const int cbase = tn * 128 + wn * 64 + l15;
#pragma unroll
    for (int m = 0; m < 4; ++m)
#pragma unroll
      for (int n = 0; n < 4; ++n)
#pragma unroll
        for (int j = 0; j < 4; ++j) qp[(size_t)(rbase + m * 16 + j) * 2048 + cbase + n * 16] = f2bf(acc[m][n][j]);
  }
}

__device__ __forceinline__ void phase_pkeys(const Params& p, unsigned char* smem) {
  unsigned char* ws = p.ws;
  const bf16_t* qp = (const bf16_t*)(ws + WS_PG);
  const bf16_t* keys = (const bf16_t*)(ws + WS_KEYS);
  float* ps = (float*)(ws + WS_PA);
  int* pi = (int*)(ws + WS_PA) + (size_t)TOK * 256;
  float* sc = (float*)smem;
  const int tid = threadIdx.x, lane = tid & 63, w = tid >> 6, wm = w >> 1, wn = w & 1, l15 = lane & 15, g = lane >> 4;
  for (int tile = blockIdx.x; tile < 128 * 16; tile += gridDim.x) {
    const int hp = tile & 15, tm = tile >> 4;
    const int h = hp >> 1, ph = hp & 1;
    f32x4 acc[4][4]; zero_acc(acc);
    gemm_tile(qp + (size_t)tm * 256 * 2048 + hp * 128, 2048, keys + (size_t)(ph * 8 + h) * 128 * 128, 128, 2, acc, smem);
    __syncthreads();
#pragma unroll
    for (int m = 0; m < 4; ++m)
#pragma unroll
      for (int n = 0; n < 4; ++n)
#pragma unroll
        for (int j = 0; j < 4; ++j) sc[(wm * 64 + m * 16 + 4 * g + j) * 129 + wn * 64 + n * 16 + l15] = acc[m][n][j];
    __syncthreads();
    if (tid < 256) {
      float* rowp = sc + tid * 129;
      const size_t ob = ((size_t)(tm * 256 + tid) * 16 + hp) * 16;
#pragma unroll 1
      for (int k = 0; k < 16; ++k) {
        float best = -INFINITY; int bi = 0;
        for (int nn = 0; nn < 128; ++nn) { const float v = rowp[nn]; if (v > best) { best = v; bi = nn; } }
        rowp[bi] = -INFINITY;
        ps[ob + k] = best; pi[ob + k] = bi;
      }
    }
    __syncthreads();
  }
}

__device__ __forceinline__ void phase_pcomb(const Params& p, unsigned char* smem) {
  unsigned char* ws = p.ws;
  const float* ps = (const float*)(ws + WS_PA);
  const int* pi = (const int*)(ws + WS_PA) + (size_t)TOK * 256;
  int* eidx = (int*)(ws + WS_EIDX);
  float* gw = (float*)(ws + WS_GW);
  float* s2l = (float*)smem;
  unsigned short* i1l = (unsigned short*)(s2l + 512 * 17);
  unsigned short* i2l = i1l + 512 * 16;
  const int tid = threadIdx.x;
  for (int base = blockIdx.x * NTHREADS; base < TOK * 8; base += gridDim.x * NTHREADS) {
    const int th = base + tid;
    const size_t o1 = (size_t)th * 32;
    float s1[16];
#pragma unroll
    for (int a = 0; a < 16; ++a) {
      s1[a] = ps[o1 + a];
      s2l[tid * 17 + a] = ps[o1 + 16 + a];
      i1l[tid * 16 + a] = (unsigned short)pi[o1 + a];
      i2l[tid * 16 + a] = (unsigned short)pi[o1 + 16 + a];
    }
    float cur[16];
    const float s20 = s2l[tid * 17];
#pragma unroll
    for (int a = 0; a < 16; ++a) cur[a] = s1[a] + s20;
    unsigned long long ptr = 0ull;
    float tops[16]; int tope[16];
#pragma unroll
    for (int k = 0; k < 16; ++k) {
      float best = cur[0]; int ba = 0;
#pragma unroll
      for (int a = 1; a < 16; ++a) if (cur[a] > best) { best = cur[a]; ba = a; }
      const int bb = (int)((ptr >> (4 * ba)) & 15ull);
      tops[k] = best;
      tope[k] = (int)i1l[tid * 16 + ba] * 128 + (int)i2l[tid * 16 + bb];
      const int nb = bb + 1;
      const float ns2 = (nb < 16) ? s2l[tid * 17 + nb] : -INFINITY;
      if (nb < 16) ptr += (1ull << (4 * ba));
#pragma unroll
      for (int a = 0; a < 16; ++a) if (a == ba) cur[a] = s1[a] + ns2;
    }
    float m = tops[0];
    float sum = 0.f;
#pragma unroll
    for (int k = 0; k < 16; ++k) { tops[k] = __expf(tops[k] - m); sum += tops[k]; }
    const float inv = 1.f / sum;
#pragma unroll
    for (int k = 0; k < 16; ++k) { eidx[(size_t)th * 16 + k] = tope[k]; gw[(size_t)th * 16 + k] = tops[k] * inv; }
  }
}


__device__ __forceinline__ float reduce8(const float (&pv)[8], int lane) {
  const bool b5 = lane & 32, b4 = lane & 16, b3 = lane & 8;
  float v[4];
#pragma unroll
  for (int i = 0; i < 4; ++i) {
    const float keep = b5 ? pv[4 + i] : pv[i];
    const float send = b5 ? pv[i] : pv[4 + i];
    v[i] = keep + __shfl_xor(send, 32);
  }
  float u[2];
#pragma unroll
  for (int i = 0; i < 2; ++i) {
    const float keep = b4 ? v[2 + i] : v[i];
    const float send = b4 ? v[i] : v[2 + i];
    u[i] = keep + __shfl_xor(send, 16);
  }
  float x = (b3 ? u[1] : u[0]) + __shfl_xor(b3 ? u[0] : u[1], 8);
  x += __shfl_xor(x, 4); x += __shfl_xor(x, 2); x += __shfl_xor(x, 1);
  return x;
}

__device__ __forceinline__ void phase_pu(const Params& p) {
  unsigned char* ws = p.ws;
  const bf16_t* xn2 = (const bf16_t*)(ws + WS_XN);
  const bf16_t* U = (const bf16_t*)(ws + WS_U);
  const int* eidx = (const int*)(ws + WS_EIDX);
  const float* gw = (const float*)(ws + WS_GW);
  float* aw = (float*)(ws + WS_PA);
  const int lane = threadIdx.x & 63, w = threadIdx.x >> 6;
  const int G = gridDim.x;
  const bool sliced = (G % 8 == 0);
  const int grp0 = sliced ? (blockIdx.x & 7) : 0, ngrp = sliced ? 1 : 8;
  const int slot = sliced ? (blockIdx.x >> 3) * 8 + w : blockIdx.x * 8 + w;
  const int nslot = sliced ? (G >> 3) * 8 : G * 8;
  for (int tok = slot; tok < TOK; tok += nslot) {
    float xf[16];
    {
      const uint4 xa = *(const uint4*)(xn2 + (size_t)tok * 1024 + lane * 8);
      const uint4 xb = *(const uint4*)(xn2 + (size_t)tok * 1024 + (lane + 64) * 8);
      cvt8(xa, xf); cvt8(xb, xf + 8);
    }
    const int e0 = eidx[(size_t)tok * 128 + lane], e1 = eidx[(size_t)tok * 128 + 64 + lane];
    const float g0 = gw[(size_t)tok * 128 + lane], g1 = gw[(size_t)tok * 128 + 64 + lane];
    for (int gi = 0; gi < ngrp; ++gi) {
      const int grp = grp0 + gi;
      float h0 = 0.f, h1 = 0.f;
#pragma unroll 1
      for (int half = 0; half < 2; ++half) {
        const int ev = half ? e1 : e0;
        unsigned long long m = __ballot((ev >> 11) == grp);
        while (m) {
          int lid[8];
          int last = 0;
#pragma unroll
          for (int j = 0; j < 8; ++j) {
            if (m) { last = __builtin_ctzll(m); m &= m - 1; }
            lid[j] = last;
          }
          uint4 ua[8], ub[8];
#pragma unroll
          for (int j = 0; j < 8; ++j) {
            const int e = __builtin_amdgcn_readlane(ev, lid[j]);
            const bf16_t* ur = U + (size_t)e * 1024;
            ua[j] = *(const uint4*)(ur + lane * 8);
            ub[j] = *(const uint4*)(ur + (lane + 64) * 8);
          }
          float pv[8];
#pragma unroll
          for (int j = 0; j < 8; ++j) {
            float uf[16];
            cvt8(ua[j], uf); cvt8(ub[j], uf + 8);
            float pp = 0.f;
#pragma unroll
            for (int i = 0; i < 16; ++i) pp += uf[i] * xf[i];
            pv[j] = pp;
          }
          const float tot = reduce8(pv, lane);
#pragma unroll
          for (int j = 0; j < 8; ++j) {
            const float hj = __int_as_float(__builtin_amdgcn_readlane(__float_as_int(tot), 8 * j));
            if (lane == lid[j]) { if (half) h1 = hj; else h0 = hj; }
          }
        }
      }
      if ((e0 >> 11) == grp) aw[(size_t)tok * 128 + lane] = 0.5f * h0 * (1.f + erff(h0 * 0.70710678118654752f)) * g0;
      if ((e1 >> 11) == grp) aw[(size_t)tok * 128 + 64 + lane] = 0.5f * h1 * (1.f + erff(h1 * 0.70710678118654752f)) * g1;
    }
  }
}

__device__ __forceinline__ void phase_pv(const Params& p) {
  unsigned char* ws = p.ws;
  const bf16_t* V = (const bf16_t*)(ws + WS_V);
  const int* eidx = (const int*)(ws + WS_EIDX);
  const float* aw = (const float*)(ws + WS_PA);
  float* ssq = (float*)(ws + WS_SSQ);
  const int lane = threadIdx.x & 63, w = threadIdx.x >> 6;
  const int q = lane >> 4, c = lane & 15;
  const int G = gridDim.x;
  const bool sliced = (G % 8 == 0);
  const int grp0 = sliced ? (blockIdx.x & 7) : 0, ngrp = sliced ? 1 : 8;
  const int slot = sliced ? (blockIdx.x >> 3) * 8 + w : blockIdx.x * 8 + w;
  const int nslot = sliced ? (G >> 3) * 8 : G * 8;
  for (int tok = slot; tok < TOK; tok += nslot) {
    for (int gi = 0; gi < ngrp; ++gi) {
      const int grp = grp0 + gi;
      float acc[8];
#pragma unroll
      for (int i = 0; i < 8; ++i) acc[i] = 0.f;
#pragma unroll 1
      for (int it0 = 0; it0 < 32; it0 += 16) {
        int ee[16]; float aa[16];
#pragma unroll
        for (int u = 0; u < 16; ++u) {
          const int k = 4 * (it0 + u) + q;
          ee[u] = eidx[(size_t)tok * 128 + k];
          aa[u] = aw[(size_t)tok * 128 + k];
        }
        uint4 vv[16];
#pragma unroll
        for (int u = 0; u < 16; ++u) vv[u] = *(const uint4*)(V + (size_t)ee[u] * 1024 + grp * 128 + c * 8);
#pragma unroll
        for (int u = 0; u < 16; ++u) {
          float vf[8];
          cvt8(vv[u], vf);
#pragma unroll
          for (int i = 0; i < 8; ++i) acc[i] += aa[u] * vf[i];
        }
      }
#pragma unroll
      for (int i = 0; i < 8; ++i) { acc[i] += __shfl_xor(acc[i], 16); acc[i] += __shfl_xor(acc[i], 32); }
      float ss = 0.f;
      if (q == 0) {
        float* orow = p.out + (size_t)tok * 1024 + grp * 128 + c * 8;
        const float4 xa = *(const float4*)orow, xb = *(const float4*)(orow + 4);
        const float4 oa = make_float4(xa.x + acc[0], xa.y + acc[1], xa.z + acc[2], xa.w + acc[3]);
        const float4 ob = make_float4(xb.x + acc[4], xb.y + acc[5], xb.z + acc[6], xb.w + acc[7]);
        *(float4*)orow = oa; *(float4*)(orow + 4) = ob;
        ss = oa.x * oa.x + oa.y * oa.y + oa.z * oa.z + oa.w * oa.w + ob.x * ob.x + ob.y * ob.y + ob.z * ob.z + ob.w * ob.w;
      }
      ss += __shfl_xor(ss, 1); ss += __shfl_xor(ss, 2); ss += __shfl_xor(ss, 4); ss += __shfl_xor(ss, 8);
      if (lane == 0) atomicAdd(&ssq[tok], ss);
    }
  }
}

__device__ __forceinline__ void phase_final(const Params& p) {
  const float* ssq = (const float*)(p.ws + WS_SSQ);
  const int lane = threadIdx.x & 63, w = threadIdx.x >> 6;
  for (int row = blockIdx.x * 8 + w; row < TOK; row += gridDim.x * 8) {
    const float rstd = rsqrtf(ssq[row] * (1.f / DM) + EPSV);
    float4* o4 = (float4*)(p.out + (size_t)row * DM);
#pragma unroll
    for (int i = 0; i < 4; ++i) {
      float4 v = o4[lane + 64 * i];
      const float4 gg = ((const float4*)p.norm_final)[lane + 64 * i];
      v.x *= rstd * gg.x; v.y *= rstd * gg.y; v.z *= rstd * gg.z; v.w *= rstd * gg.w;
      o4[lane + 64 * i] = v;
    }
  }
}

__global__ void __launch_bounds__(NTHREADS) hybrid_fwd(Params p) {
  extern __shared__ __attribute__((aligned(16))) unsigned char smem[];
#if ONE_LAUNCH
  cg::grid_group grid = cg::this_grid();
#define SEAM(k) do { if (p.ph_lo <= (k) && (k) + 1 < p.ph_hi) grid.sync(); } while (0)
#else
#define SEAM(k) do { } while (0)
#endif
#define IN(k) (p.ph_lo <= (k) && (k) < p.ph_hi)
#ifndef REPEAT_PH
#define REPEAT_PH -1
#endif
#define REP(k, stmt) do { if (REPEAT_PH == (k)) { stmt; grid.sync(); } } while (0)
  if (IN(0)) { REP(0, phase_prep(p, smem)); phase_prep(p, smem); SEAM(0); }
  if (IN(1)) { REP(1, phase_proj(p, smem)); phase_proj(p, smem); SEAM(1); }
  if (IN(2)) { REP(2, phase_mix(p, smem)); phase_mix(p, smem); SEAM(2); }
  if (IN(3)) { REP(3, phase_up(p, smem)); phase_up(p, smem); SEAM(3); }
  if (IN(4)) { REP(4, phase_out(p, smem)); phase_out(p, smem); SEAM(4); }
  if (IN(5)) { REP(5, rmsnorm_rows(p.out, p.norm_ffn, (bf16_t*)(p.ws + WS_XN))); rmsnorm_rows(p.out, p.norm_ffn, (bf16_t*)(p.ws + WS_XN)); SEAM(5); }
  if (IN(6)) { REP(6, phase_pq(p, smem)); phase_pq(p, smem); SEAM(6); }
  if (IN(7)) { REP(7, phase_pkeys(p, smem)); phase_pkeys(p, smem); SEAM(7); }
  if (IN(8)) { REP(8, phase_pcomb(p, smem)); phase_pcomb(p, smem); SEAM(8); }
  if (IN(9)) { phase_pu(p); SEAM(9); }
  if (IN(10)) { phase_pv(p); SEAM(10); }
  if (IN(11)) { phase_final(p); }
#undef IN
#undef SEAM
}

extern "C" void kernel_launch(void* const* d_in, const int* in_sizes, int n_in, void* d_out, int out_size, void* d_ws, size_t ws_size,
                              hipStream_t stream) {
  static int grid = 0;
  if (grid == 0) {
    if (n_in != 17 || ws_size < WS_END) {
      fprintf(stderr, "kernel_launch: unexpected n_in %d or ws_size %zu (need %zu)\n", n_in, ws_size, (size_t)WS_END);
      grid = -1; return;
    }
    int dev = 0, cus = 0, per_cu = 0;
    hipGetDevice(&dev);
    hipDeviceGetAttribute(&cus, hipDeviceAttributeMultiprocessorCount, dev);
    hipFuncSetAttribute((const void*)hybrid_fwd, hipFuncAttributeMaxDynamicSharedMemorySize, LDS_BYTES);
    hipOccupancyMaxActiveBlocksPerMultiprocessor(&per_cu, (const void*)hybrid_fwd, NTHREADS, LDS_BYTES);
    if (per_cu < 1) { fprintf(stderr, "kernel_launch: occupancy query says %d blocks/CU\n", per_cu); per_cu = 1; }
    (void)hipGetLastError();
    grid = cus;
  }
  if (grid < 0) return;
  Params p{};
  p.x = (const float*)d_in[0]; p.norm_mix = (const float*)d_in[1]; p.w_in = (const float*)d_in[2]; p.hg_lb = (const float*)d_in[3];
  p.hg_norm = (const float*)d_in[4]; p.ikg = (const float*)d_in[5]; p.ikb = (const float*)d_in[6]; p.rel_bias = (const float*)d_in[7];
  p.w_up_a = (const float*)d_in[8]; p.w_up_b = (const float*)d_in[9]; p.w_out = (const float*)d_in[10]; p.norm_ffn = (const float*)d_in[11];
  p.peer_wq = (const float*)d_in[12]; p.peer_keys = (const float*)d_in[13]; p.peer_u = (const float*)d_in[14]; p.peer_v = (const float*)d_in[15];
  p.norm_final = (const float*)d_in[16];
  p.out = (float*)d_out; p.ws = (unsigned char*)d_ws;
#if ONE_LAUNCH
  p.ph_lo = 0; p.ph_hi = NPHASE;
  void* args[] = {&p};
  hipError_t e = hipLaunchCooperativeKernel((const void*)hybrid_fwd, dim3(grid), dim3(NTHREADS), args, LDS_BYTES, stream);
  if (e != hipSuccess) fprintf(stderr, "cooperative launch failed: %s (grid %d)\n", hipGetErrorString(e), grid);
#else
  for (int ph = 0; ph < NPHASE; ++ph) {
    p.ph_lo = ph; p.ph_hi = ph + 1;
    hipLaunchKernelGGL(hybrid_fwd, dim3(grid), dim3(NTHREADS), LDS_BYTES, stream, p);
  }
#endif
}
```

```cpp
#include <hip/hip_runtime.h>
#include <hip/hip_cooperative_groups.h>
#include <stdint.h>
#include <stdio.h>
namespace cg = cooperative_groups;

#ifndef ONE_LAUNCH
#define ONE_LAUNCH 1
#endif

typedef unsigned short bf16_t;
typedef __attribute__((ext_vector_type(8))) short bf16x8;
typedef __attribute__((ext_vector_type(4))) float f32x4;

#define NTHREADS 512
#define TOK 32768
#define SEQL 4096
#define DM 1024
#define EPSV 1e-6f
#define NPHASE 12

#define WS_WIN   ((size_t)0)
#define WS_WUPA  (WS_WIN  + (size_t)5120 * 1024 * 2)
#define WS_WUPB  (WS_WUPA + (size_t)1024 * 512 * 2)
#define WS_WOUT  (WS_WUPB + (size_t)1024 * 512 * 2)
#define WS_WQ    (WS_WOUT + (size_t)1024 * 1024 * 2)
#define WS_KEYS  (WS_WQ   + (size_t)2048 * 1024 * 2)
#define WS_LB    (WS_KEYS + (size_t)2 * 8 * 128 * 128 * 2)
#define WS_U     (WS_LB   + (size_t)4096)
#define WS_V     (WS_U    + (size_t)16384 * 1024 * 2)
#define WS_XN    (WS_V    + (size_t)16384 * 1024 * 2)
#define WS_PH    (WS_XN   + (size_t)TOK * 1024 * 2)
#define WS_PA    (WS_PH   + (size_t)TOK * 2048 * 2)
#define WS_PG    (WS_PA   + (size_t)TOK * 1024 * 2)
#define WS_EIDX  (WS_PG   + (size_t)TOK * 2048 * 2)
#define WS_GW    (WS_EIDX + (size_t)TOK * 128 * 4)
#define WS_SSQ   (WS_GW   + (size_t)TOK * 128 * 4)
#define WS_XCC   (WS_SSQ  + (size_t)TOK * 4)
#define WS_BAR   (WS_XCC  + (size_t)4096)
#define WS_END   (WS_BAR  + (size_t)16384)

#define LDS_BYTES 155648

struct Params {
  const float* x; const float* norm_mix; const float* w_in; const float* hg_lb; const float* hg_norm;
  const float* ikg; const float* ikb; const float* rel_bias; const float* w_up_a; const float* w_up_b;
  const float* w_out; const float* norm_ffn; const float* peer_wq; const float* peer_keys;
  const float* peer_u; const float* peer_v; const float* norm_final;
  float* out; unsigned char* ws; int ph_lo, ph_hi;
};

__device__ __forceinline__ float bf2f(bf16_t u) { return __uint_as_float(((unsigned)u) << 16); }
__device__ __forceinline__ bf16_t f2bf(float f) {
  unsigned u = __float_as_uint(f);
  u += 0x7fffu + ((u >> 16) & 1u);
  return (bf16_t)(u >> 16);
}
__device__ __forceinline__ unsigned pack2(float a, float b) { return (unsigned)f2bf(a) | ((unsigned)f2bf(b) << 16); }
__device__ __forceinline__ float wave_sum(float v) {
#pragma unroll
  for (int o = 32; o > 0; o >>= 1) v += __shfl_xor(v, o);
  return v;
}
__device__ __forceinline__ float sigmoidf_(float x) { return 1.f / (1.f + __expf(-x)); }
__device__ __forceinline__ float siluf_(float x) { return x / (1.f + __expf(-x)); }


#define XB_TMO      128
#define XB_XCNT(j)  (256  + 64 * (j))
#define XB_XSUB(j)  (1280 + 64 * (j))
#define XB_XGEN(j)  (2304 + 64 * (j))
#define XB_TOP      3328
#define XB_TOPGEN   3392
#define XCD_BAR_WORDS 3456
#define XB_SPIN_CAP (1u << 22)
#define LAS __attribute__((address_space(3)))
__device__ __forceinline__ unsigned xb_ld(unsigned* p)              { return __hip_atomic_load(p, __ATOMIC_RELAXED, __HIP_MEMORY_SCOPE_AGENT); }
__device__ __forceinline__ unsigned xb_add(unsigned* p, unsigned v) { return __hip_atomic_fetch_add(p, v, __ATOMIC_RELAXED, __HIP_MEMORY_SCOPE_AGENT); }
__device__ __forceinline__ unsigned xb_xcc_id() { return (unsigned)__builtin_amdgcn_s_getreg((3 << 11) | 20) & 0xFu; }
#define XB_SPIN(cond, bar) do { unsigned _sp = 0; while (cond) { __builtin_amdgcn_s_sleep(1); \
    if ((++_sp & 255u) == 0u) { if (xb_ld(&(bar)[XB_TMO])) break; if (_sp > XB_SPIN_CAP) { atomicAdd(&(bar)[XB_TMO], 1u); break; } } } } while (0)
struct XcdBarrier { unsigned* bar; unsigned x; volatile LAS unsigned* st; };
__device__ __forceinline__ XcdBarrier xcd_barrier_post(unsigned* bar, volatile LAS unsigned* st) {
  XcdBarrier b; b.bar = bar; b.x = xb_xcc_id(); b.st = st;
  if (threadIdx.x == 0) (void)xb_add(&bar[XB_XCNT(b.x)], 1u);
  return b;
}
__device__ __forceinline__ void xcd_barrier_complete(unsigned* bar, unsigned x, unsigned& nloc, unsigned& nx) {
  const unsigned G = gridDim.x * gridDim.y * gridDim.z;
  unsigned sum, cnt, mine, sp = 0u;
  for (;;) {
    sum = 0u; cnt = 0u; mine = 0u;
#pragma unroll
    for (unsigned j = 0; j < 16; ++j) { const unsigned c = xb_ld(&bar[XB_XCNT(j)]); sum += c; cnt += (c > 0u) ? 1u : 0u; mine = (j == x) ? c : mine; }
    if (sum == G) break;
    __builtin_amdgcn_s_sleep(1);
    if ((++sp & 255u) == 0u) { if (xb_ld(&bar[XB_TMO])) break; if (sp > XB_SPIN_CAP) { atomicAdd(&bar[XB_TMO], 1u); break; } }
  }
  nloc = mine > 0u ? mine : 1u; nx = cnt > 0u ? cnt : 1u;
}
__device__ __forceinline__ void xcd_barrier(const XcdBarrier& b) {
  asm volatile("s_waitcnt vmcnt(0)" ::: "memory");
  __syncthreads();
  if (threadIdx.x == 0) {
    unsigned* bar = b.bar;
    __builtin_amdgcn_s_waitcnt(0);
    unsigned nloc = b.st[0], nx = b.st[1];
    if (nloc == 0u) { xcd_barrier_complete(bar, b.x, nloc, nx); b.st[0] = nloc; b.st[1] = nx; }
    const unsigned old = xb_add(&bar[XB_XSUB(b.x)], 1u);
    const unsigned gen = old / nloc;
    if (old + 1u == (gen + 1u) * nloc) {
      __builtin_amdgcn_fence(__ATOMIC_RELEASE, "agent");
      asm volatile("s_waitcnt vmcnt(0)" ::: "memory");
      const unsigned og = xb_add(&bar[XB_TOP], 1u);
      const unsigned tg = og / nx;
      if (og + 1u == (tg + 1u) * nx) xb_add(&bar[XB_TOPGEN], 1u);
      else XB_SPIN(xb_ld(&bar[XB_TOPGEN]) == tg, bar);
      __builtin_amdgcn_fence(__ATOMIC_ACQUIRE, "agent");
      xb_add(&bar[XB_XGEN(b.x)], 1u);
      asm volatile("s_waitcnt vmcnt(0)" ::: "memory");
    } else {
      XB_SPIN(xb_ld(&bar[XB_XGEN(b.x)]) == gen, bar);
      __builtin_amdgcn_fence(__ATOMIC_ACQUIRE, "agent");
      asm volatile("s_waitcnt vmcnt(0)" ::: "memory");
    }
  }
  __syncthreads();
}

__device__ __forceinline__ void gemm_tile(const bf16_t* __restrict__ A, int lda, const bf16_t* __restrict__ Bt, int ldb,
                                          int nk, f32x4 (&acc)[4][4], unsigned char* smem) {
  const int tid = threadIdx.x, lane = tid & 63, w = tid >> 6, wm = w >> 1, wn = w & 1, l15 = lane & 15, g = lane >> 4;
  unsigned char* sA = smem;
  unsigned char* sB = smem + 32768;
  const int lr = tid >> 3, lc = tid & 7;
  const bf16_t* ga = A + (size_t)lr * lda + lc * 8;
  const bf16_t* gb = Bt + (size_t)lr * ldb + lc * 8;
  uint4 ra0, ra1, ra2, ra3, rb0, rb1;
  ra0 = *(const uint4*)(ga);
  ra1 = *(const uint4*)(ga + (size_t)64 * lda);
  ra2 = *(const uint4*)(ga + (size_t)128 * lda);
  ra3 = *(const uint4*)(ga + (size_t)192 * lda);
  rb0 = *(const uint4*)(gb);
  rb1 = *(const uint4*)(gb + (size_t)64 * ldb);
  const int sw = (lc ^ (lr & 7)) << 4;
  for (int kt = 0; kt < nk; ++kt) {
    __syncthreads();
    *(uint4*)(sA + (lr) * 128 + sw) = ra0;
    *(uint4*)(sA + (lr + 64) * 128 + sw) = ra1;
    *(uint4*)(sA + (lr + 128) * 128 + sw) = ra2;
    *(uint4*)(sA + (lr + 192) * 128 + sw) = ra3;
    *(uint4*)(sB + (lr) * 128 + sw) = rb0;
    *(uint4*)(sB + (lr + 64) * 128 + sw) = rb1;
    __syncthreads();
    if (kt + 1 < nk) {
      const int ko = (kt + 1) * 64;
      ra0 = *(const uint4*)(ga + ko);
      ra1 = *(const uint4*)(ga + (size_t)64 * lda + ko);
      ra2 = *(const uint4*)(ga + (size_t)128 * lda + ko);
      ra3 = *(const uint4*)(ga + (size_t)192 * lda + ko);
      rb0 = *(const uint4*)(gb + ko);
      rb1 = *(const uint4*)(gb + (size_t)64 * ldb + ko);
    }
#pragma unroll
    for (int ks = 0; ks < 2; ++ks) {
      bf16x8 a[4], b[4];
#pragma unroll
      for (int m = 0; m < 4; ++m) { const int r = wm * 64 + m * 16 + l15; a[m] = *(const bf16x8*)(sA + r * 128 + (((ks * 4 + g) ^ (r & 7)) << 4)); }
#pragma unroll
      for (int n = 0; n < 4; ++n) { const int r = wn * 64 + n * 16 + l15; b[n] = *(const bf16x8*)(sB + r * 128 + (((ks * 4 + g) ^ (r & 7)) << 4)); }
#pragma unroll
      for (int m = 0; m < 4; ++m)
#pragma unroll
        for (int n = 0; n < 4; ++n) acc[m][n] = __builtin_amdgcn_mfma_f32_16x16x32_bf16(a[m], b[n], acc[m][n], 0, 0, 0);
    }
  }
}

__device__ __forceinline__ void zero_acc(f32x4 (&acc)[4][4]) {
#pragma unroll
  for (int m = 0; m < 4; ++m)
#pragma unroll
    for (int n = 0; n < 4; ++n) acc[m][n] = (f32x4){0.f, 0.f, 0.f, 0.f};
}

__device__ __forceinline__ void transpose_tile(const float* __restrict__ src, int srcN, bf16_t* __restrict__ dst, int K, int n0, int k0,
                                               bool winmap, float* tile) {
  const int tid = threadIdx.x;
  const int nc = tid & 63, kr = tid >> 6;
  int ncol = n0 + nc; bool valid = true;
  if (winmap) { if (ncol >= 3072) ncol -= 60; else if (ncol >= 3012) valid = false; }
#pragma unroll
  for (int i = 0; i < 8; ++i) {
    const int k = kr + 8 * i;
    tile[k * 65 + nc] = valid ? src[(size_t)(k0 + k) * srcN + ncol] : 0.f;
  }
  __syncthreads();
#pragma unroll
  for (int i = 0; i < 8; ++i) {
    const int nr = kr + 8 * i;
    dst[(size_t)(n0 + nr) * K + k0 + nc] = f2bf(tile[nc * 65 + nr]);
  }
  __syncthreads();
}

__device__ __forceinline__ void convert_f32_bf16(const float* __restrict__ src, bf16_t* __restrict__ dst, size_t n4) {
  for (size_t i = (size_t)blockIdx.x * NTHREADS + threadIdx.x; i < n4; i += (size_t)gridDim.x * NTHREADS) {
    const float4 v = ((const float4*)src)[i];
    uint2 o; o.x = pack2(v.x, v.y); o.y = pack2(v.z, v.w);
    ((uint2*)dst)[i] = o;
  }
}

__device__ __forceinline__ void quantize_rows_u8(const float* __restrict__ src, unsigned char* __restrict__ dst, float* __restrict__ scale) {
  const int lane = threadIdx.x & 63, w = threadIdx.x >> 6;
  for (int row = blockIdx.x * 8 + w; row < 16384; row += gridDim.x * 8) {
    const float4* s4 = (const float4*)(src + (size_t)row * 1024) + lane * 4;
    float4 v[4];
    float am = 0.f;
#pragma unroll
    for (int i = 0; i < 4; ++i) { v[i] = s4[i]; am = fmaxf(am, fmaxf(fmaxf(fabsf(v[i].x), fabsf(v[i].y)), fmaxf(fabsf(v[i].z), fabsf(v[i].w)))); }
#pragma unroll
    for (int o = 32; o > 0; o >>= 1) am = fmaxf(am, __shfl_xor(am, o));
    const float inv = am > 0.f ? 127.f / am : 0.f;
    unsigned pk[4];
#pragma unroll
    for (int i = 0; i < 4; ++i) {
      const unsigned b0 = (unsigned)((int)rintf(v[i].x * inv) + 128), b1 = (unsigned)((int)rintf(v[i].y * inv) + 128);
      const unsigned b2 = (unsigned)((int)rintf(v[i].z * inv) + 128), b3 = (unsigned)((int)rintf(v[i].w * inv) + 128);
      pk[i] = (b0 & 255u) | ((b1 & 255u) << 8) | ((b2 & 255u) << 16) | ((b3 & 255u) << 24);
    }
    *(uint4*)(dst + (size_t)row * 1024 + lane * 16) = make_uint4(pk[0], pk[1], pk[2], pk[3]);
    if (lane == 0) scale[row] = am * (1.f / 127.f);
  }
}

__device__ __forceinline__ void rmsnorm_rows(const float* __restrict__ src, const float* __restrict__ g, bf16_t* __restrict__ dst) {
  const int lane = threadIdx.x & 63, w = threadIdx.x >> 6;
  for (int row = blockIdx.x * 8 + w; row < TOK; row += gridDim.x * 8) {
    const float4* s4 = (const float4*)(src + (size_t)row * DM);
    float4 v[4]; float ss = 0.f;
#pragma unroll
    for (int i = 0; i < 4; ++i) { v[i] = s4[lane + 64 * i]; ss += v[i].x * v[i].x + v[i].y * v[i].y + v[i].z * v[i].z + v[i].w * v[i].w; }
    ss = wave_sum(ss);
    const float rstd = rsqrtf(ss * (1.f / DM) + EPSV);
#pragma unroll
    for (int i = 0; i < 4; ++i) {
      const float4 gg = ((const float4*)g)[lane + 64 * i];
      uint2 o; o.x = pack2(v[i].x * rstd * gg.x, v[i].y * rstd * gg.y); o.y = pack2(v[i].z * rstd * gg.z, v[i].w * rstd * gg.w);
      ((uint2*)(dst + (size_t)row * DM))[lane + 64 * i] = o;
    }
  }
}

__device__ __forceinline__ void phase_prep(const Params& p, unsigned char* smem) {
  unsigned char* ws = p.ws;
  float* tile = (float*)smem;
  const int n_win = 80 * 16, n_ua = 16 * 8, n_ub = 16 * 8, n_wo = 16 * 16, n_wq = 32 * 16;
  const int total = n_win + n_ua + n_ub + n_wo + n_wq;
  for (int it = blockIdx.x; it < total; it += gridDim.x) {
    int t = it;
    if (t < n_win) { transpose_tile(p.w_in, 5060, (bf16_t*)(ws + WS_WIN), 1024, (t >> 4) * 64, (t & 15) * 64, true, tile); continue; }
    t -= n_win;
    if (t < n_ua) { transpose_tile(p.w_up_a, 1024, (bf16_t*)(ws + WS_WUPA), 512, (t >> 3) * 64, (t & 7) * 64, false, tile); continue; }
    t -= n_ua;
    if (t < n_ub) { transpose_tile(p.w_up_b, 1024, (bf16_t*)(ws + WS_WUPB), 512, (t >> 3) * 64, (t & 7) * 64, false, tile); continue; }
    t -= n_ub;
    if (t < n_wo) { transpose_tile(p.w_out, 1024, (bf16_t*)(ws + WS_WOUT), 1024, (t >> 4) * 64, (t & 15) * 64, false, tile); continue; }
    t -= n_wo;
    transpose_tile(p.peer_wq, 2048, (bf16_t*)(ws + WS_WQ), 1024, (t >> 4) * 64, (t & 15) * 64, false, tile);
  }
  quantize_rows_u8(p.peer_u, ws + WS_U, (float*)(ws + WS_U + (size_t)16384 * 1024));
  quantize_rows_u8(p.peer_v, ws + WS_V, (float*)(ws + WS_V + (size_t)16384 * 1024));
  convert_f32_bf16(p.peer_keys, (bf16_t*)(ws + WS_KEYS), (size_t)2 * 8 * 128 * 128 / 4);
  for (int i = blockIdx.x * NTHREADS + threadIdx.x; i < TOK; i += gridDim.x * NTHREADS) ((float*)(ws + WS_SSQ))[i] = 0.f;
  if (threadIdx.x == 0) ((int*)(ws + WS_XCC))[blockIdx.x] = (int)(__builtin_amdgcn_s_getreg((3 << 11) | 20) & 0xFu);
  if (blockIdx.x == 0) {
    const int i = threadIdx.x;
    const float a0 = p.hg_lb[i], a1 = p.hg_lb[512 + i];
    ((float*)(ws + WS_LB))[i] = 1.f / (1.f + expf(a1 - a0));
  }
  rmsnorm_rows(p.x, p.norm_mix, (bf16_t*)(ws + WS_XN));
}

__device__ __forceinline__ void phase_proj(const Params& p, unsigned char* smem) {
  unsigned char* ws = p.ws;
  const bf16_t* xn = (const bf16_t*)(ws + WS_XN);
  const bf16_t* wt = (const bf16_t*)(ws + WS_WIN);
  bf16_t* pH = (bf16_t*)(ws + WS_PH);
  bf16_t* pA = (bf16_t*)(ws + WS_PA);
  bf16_t* pG = (bf16_t*)(ws + WS_PG);
  const int tid = threadIdx.x, lane = tid & 63, w = tid >> 6, wm = w >> 1, wn = w & 1, l15 = lane & 15, g = lane >> 4;
  for (int tile = blockIdx.x; tile < 128 * 40; tile += gridDim.x) {
    const int tn = tile % 40, tm = tile / 40;
    f32x4 acc[4][4]; zero_acc(acc);
    gemm_tile(xn + (size_t)tm * 256 * 1024, 1024, wt + (size_t)tn * 128 * 1024, 1024, 16, acc, smem);
    const int rbase = tm * 256 + wm * 64 + 4 * g;
    const int cbase = tn * 128 + wn * 64 + l15;
    if (tn < 16) {
#pragma unroll
      for (int m = 0; m < 4; ++m)
#pragma unroll
        for (int n = 0; n < 4; ++n)
#pragma unroll
          for (int j = 0; j < 4; ++j) pH[(size_t)(rbase + m * 16 + j) * 2048 + cbase + n * 16] = f2bf(acc[m][n][j]);
    } else if (tn < 24) {
      if (tn == 23 && wn == 0) {
        float gam[4], bet[4];
#pragma unroll
        for (int n = 0; n < 4; ++n) { gam[n] = p.ikg[n * 16 + l15]; bet[n] = p.ikb[n * 16 + l15]; }
#pragma unroll
        for (int m = 0; m < 4; ++m)
#pragma unroll
          for (int j = 0; j < 4; ++j) {
            float s = acc[m][0][j] + acc[m][1][j] + acc[m][2][j] + acc[m][3][j];
            s += __shfl_xor(s, 1); s += __shfl_xor(s, 2); s += __shfl_xor(s, 4); s += __shfl_xor(s, 8);
            const float mu = s * (1.f / 64.f);
            float q = 0.f;
#pragma unroll
            for (int n = 0; n < 4; ++n) { const float d = acc[m][n][j] - mu; q += d * d; }
            q += __shfl_xor(q, 1); q += __shfl_xor(q, 2); q += __shfl_xor(q, 4); q += __shfl_xor(q, 8);
            const float rstd = rsqrtf(q * (1.f / 64.f) + EPSV);
#pragma unroll
            for (int n = 0; n < 4; ++n)
              pA[(size_t)(rbase + m * 16 + j) * 1024 + (cbase - 2048) + n * 16] = f2bf((acc[m][n][j] - mu) * rstd * gam[n] + bet[n]);
          }
      } else {
#pragma unroll
        for (int m = 0; m < 4; ++m)
#pragma unroll
          for (int n = 0; n < 4; ++n)
#pragma unroll
            for (int j = 0; j < 4; ++j) pA[(size_t)(rbase + m * 16 + j) * 1024 + (cbase - 2048) + n * 16] = f2bf(acc[m][n][j]);
      }
    } else {
#pragma unroll
      for (int m = 0; m < 4; ++m)
#pragma unroll
        for (int n = 0; n < 4; ++n)
#pragma unroll
          for (int j = 0; j < 4; ++j) pG[(size_t)(rbase + m * 16 + j) * 2048 + (cbase - 3072) + n * 16] = f2bf(sigmoidf_(acc[m][n][j]));
    }
  }
}

__device__ __forceinline__ void hgrn_item(const Params& p, unsigned char* smem, int bh) {
  unsigned char* ws = p.ws;
  const bf16_t* pH = (const bf16_t*)(ws + WS_PH);
  const float* lbp = (const float*)(ws + WS_LB);
  bf16_t* ya = (bf16_t*)(ws + WS_XN);
  bf16_t* Qt = (bf16_t*)smem;
  bf16_t* Kt = Qt + 64 * 136;
  bf16_t* KtT = Kt + 64 * 136;
  bf16_t* VT = KtT + 128 * 72;
  bf16_t* Am = VT + 128 * 72;
  bf16_t* ST = Am + 64 * 72;
  float* qtot = (float*)(ST + 128 * 136);
  float* eref = qtot + 512;
  float* elast = eref + 128;
  float* elr = elast + 128;
  float* red = elr + 128;
  const int tid = threadIdx.x, lane = tid & 63, w = tid >> 6, l15 = lane & 15, g = lane >> 4;
  const int b = bh >> 2, h = bh & 3;
  const int d = tid & 127, tq = tid >> 7;
  const float lbv = lbp[h * 128 + d];
  f32x4 S[8];
#pragma unroll
  for (int i = 0; i < 8; ++i) S[i] = (f32x4){0.f, 0.f, 0.f, 0.f};
  const float gnv = p.hg_norm[h * 128 + 16 * w + l15];

  for (int chunk = 0; chunk < 64; ++chunk) {
    const size_t row0 = (size_t)b * SEQL + chunk * 64;
    {
      const bf16_t* base = pH + (row0 + tq * 16) * 2048 + h * 128 + d;
      float lf[16], kk[16], qs[16];
      unsigned vv[8];
      float run = 0.f;
#pragma unroll
      for (int i = 0; i < 16; ++i) {
        const float fr = bf2f(base[(size_t)i * 2048 + 512]);
        const float qr = bf2f(base[(size_t)i * 2048]);
        const float sg = sigmoidf_(fr);
        const float fg = lbv + (1.f - lbv) * sg;
        run += __logf(fg);
        lf[i] = run; kk[i] = 1.f - fg; qs[i] = siluf_(qr);
      }
#pragma unroll
      for (int i = 0; i < 8; ++i) {
        const unsigned lo = base[(size_t)(2 * i) * 2048 + 1024], hi = base[(size_t)(2 * i + 1) * 2048 + 1024];
        vv[i] = lo | (hi << 16);
      }
      qtot[tq * 128 + d] = run;
      __syncthreads();
      const float q0 = qtot[d], q1 = qtot[128 + d], q2 = qtot[256 + d], q3 = qtot[384 + d];
      const float pre = (tq > 0 ? q0 : 0.f) + (tq > 1 ? q1 : 0.f) + (tq > 2 ? q2 : 0.f);
      const float bref = q0 + q1;
      const float blast = bref + q2 + q3;
      unsigned kp[8];
#pragma unroll
      for (int i = 0; i < 16; ++i) {
        const float bt = pre + lf[i];
        const float qt = qs[i] * __expf(bt - bref);
        const float kt = kk[i] * __expf(bref - bt);
        const int t = tq * 16 + i;
        Qt[t * 136 + d] = f2bf(qt);
        const bf16_t kb = f2bf(kt);
        Kt[t * 136 + d] = kb;
        if (i & 1) kp[i >> 1] |= ((unsigned)kb) << 16; else kp[i >> 1] = kb;
      }
      *(uint4*)(KtT + d * 72 + tq * 16) = make_uint4(kp[0], kp[1], kp[2], kp[3]);
      *(uint4*)(KtT + d * 72 + tq * 16 + 8) = make_uint4(kp[4], kp[5], kp[6], kp[7]);
      *(uint4*)(VT + d * 72 + tq * 16) = make_uint4(vv[0], vv[1], vv[2], vv[3]);
      *(uint4*)(VT + d * 72 + tq * 16 + 8) = make_uint4(vv[4], vv[5], vv[6], vv[7]);
      if (tq == 0) { eref[d] = __expf(bref); elast[d] = __expf(blast); elr[d] = __expf(blast - bref); }
    }
    __syncthreads();
    bf16_t ogr[16];
#pragma unroll
    for (int tm = 0; tm < 4; ++tm)
#pragma unroll
      for (int j = 0; j < 4; ++j) ogr[tm * 4 + j] = pH[(row0 + tm * 16 + 4 * g + j) * 2048 + 1536 + h * 128 + 16 * w + l15];
    {
      const int e = 16 * w + l15;
#pragma unroll
      for (int dm = 0; dm < 8; ++dm) {
        const int d0 = 16 * dm + 4 * g;
        uint2 o;
        o.x = pack2(S[dm][0] * eref[d0], S[dm][1] * eref[d0 + 1]);
        o.y = pack2(S[dm][2] * eref[d0 + 2], S[dm][3] * eref[d0 + 3]);
        *(uint2*)(ST + e * 136 + d0) = o;
      }
#pragma unroll
      for (int tt = 0; tt < 2; ++tt) {
        const int tl = 2 * w + tt, sm = tl >> 2, tn = tl & 3;
        f32x4 acc = (f32x4){0.f, 0.f, 0.f, 0.f};
        if (tn >= sm) {
#pragma unroll
          for (int k0 = 0; k0 < 128; k0 += 32) {
            const bf16x8 a = *(const bf16x8*)(Kt + (sm * 16 + l15) * 136 + k0 + 8 * g);
            const bf16x8 bq = *(const bf16x8*)(Qt + (tn * 16 + l15) * 136 + k0 + 8 * g);
            acc = __builtin_amdgcn_mfma_f32_16x16x32_bf16(a, bq, acc, 0, 0, 0);
          }
        }
        const int t = tn * 16 + l15, s0 = sm * 16 + 4 * g;
        uint2 o;
        o.x = pack2(s0 + 0 <= t ? acc[0] : 0.f, s0 + 1 <= t ? acc[1] : 0.f);
        o.y = pack2(s0 + 2 <= t ? acc[2] : 0.f, s0 + 3 <= t ? acc[3] : 0.f);
        *(uint2*)(Am + t * 72 + s0) = o;
      }
    }
    __syncthreads();
    f32x4 o[4];
    {
#pragma unroll
      for (int tm = 0; tm < 4; ++tm) {
        f32x4 acc = (f32x4){0.f, 0.f, 0.f, 0.f};
#pragma unroll
        for (int k0 = 0; k0 < 128; k0 += 32) {
          const bf16x8 a = *(const bf16x8*)(Qt + (tm * 16 + l15) * 136 + k0 + 8 * g);
          const bf16x8 bb = *(const bf16x8*)(ST + (16 * w + l15) * 136 + k0 + 8 * g);
          acc = __builtin_amdgcn_mfma_f32_16x16x32_bf16(a, bb, acc, 0, 0, 0);
        }
#pragma unroll
        for (int k0 = 0; k0 < 64; k0 += 32) {
          const bf16x8 a = *(const bf16x8*)(Am + (tm * 16 + l15) * 72 + k0 + 8 * g);
          const bf16x8 bb = *(const bf16x8*)(VT + (16 * w + l15) * 72 + k0 + 8 * g);
          acc = __builtin_amdgcn_mfma_f32_16x16x32_bf16(a, bb, acc, 0, 0, 0);
        }
        o[tm] = acc;
#pragma unroll
        for (int j = 0; j < 4; ++j) {
          float ss = acc[j] * acc[j];
          ss += __shfl_xor(ss, 1); ss += __shfl_xor(ss, 2); ss += __shfl_xor(ss, 4); ss += __shfl_xor(ss, 8);
          if (l15 == 0) red[w * 64 + tm * 16 + 4 * g + j] = ss;
        }
      }
#pragma unroll
      for (int dm = 0; dm < 8; ++dm) {
        f32x4 acc = (f32x4){0.f, 0.f, 0.f, 0.f};
#pragma unroll
        for (int k0 = 0; k0 < 64; k0 += 32) {
          const bf16x8 a = *(const bf16x8*)(KtT + (dm * 16 + l15) * 72 + k0 + 8 * g);
          const bf16x8 bb = *(const bf16x8*)(VT + (16 * w + l15) * 72 + k0 + 8 * g);
          acc = __builtin_amdgcn_mfma_f32_16x16x32_bf16(a, bb, acc, 0, 0, 0);
        }
#pragma unroll
        for (int j = 0; j < 4; ++j) { const int dd = 16 * dm + 4 * g + j; S[dm][j] = elast[dd] * S[dm][j] + elr[dd] * acc[j]; }
      }
    }
    __syncthreads();
    {
      const int e = 16 * w + l15;
#pragma unroll
      for (int tm = 0; tm < 4; ++tm)
#pragma unroll
        for (int j = 0; j < 4; ++j) {
          const int t = tm * 16 + 4 * g + j;
          float tot = 0.f;
#pragma unroll
          for (int ww = 0; ww < 8; ++ww) tot += red[ww * 64 + t];
          const float rstd = rsqrtf(tot * (1.f / 128.f) + EPSV);
          const float og = bf2f(ogr[tm * 4 + j]);
          ya[(row0 + t) * 512 + h * 128 + e] = f2bf(o[tm][j] * rstd * gnv * siluf_(og));
        }
    }
  }
}

#define SCW 4100
#ifndef DSA_REP
#define DSA_REP 0
#endif
#define DSA_BKT_OFF (8 * SCW * 4 + 8 * 256 * 4 + 8 * 256 * 2 + 8 * 512 * 2)
__device__ __forceinline__ void cvt8(const uint4& v, float* f) {
  f[0] = __uint_as_float(v.x << 16); f[1] = __uint_as_float(v.x & 0xffff0000u);
  f[2] = __uint_as_float(v.y << 16); f[3] = __uint_as_float(v.y & 0xffff0000u);
  f[4] = __uint_as_float(v.z << 16); f[5] = __uint_as_float(v.z & 0xffff0000u);
  f[6] = __uint_as_float(v.w << 16); f[7] = __uint_as_float(v.w & 0xffff0000u);
}
__device__ __forceinline__ unsigned sortable_key(float v) {
  unsigned bits = __float_as_uint(v);
  if (bits == 0x80000000u) bits = 0u;
  return (bits & 0x80000000u) ? ~bits : (bits | 0x80000000u);
}

__device__ __forceinline__ void dsa_item(const Params& p, unsigned char* smem, int item) {
  unsigned char* ws = p.ws;
  const bf16_t* pA = (const bf16_t*)(ws + WS_PA);
  bf16_t* yb = (bf16_t*)(ws + WS_XN) + (size_t)TOK * 512;
  unsigned* sc = (unsigned*)smem;
  unsigned* hist = sc + 8 * SCW;
  unsigned short* sel = (unsigned short*)(hist + 8 * 256);
  unsigned short* cand = sel + 8 * 256;
  unsigned char* bkt = (unsigned char*)(cand + 8 * 512);
  const int tid = threadIdx.x, lane = tid & 63, w = tid >> 6, l15 = lane & 15, g = lane >> 4;
  const int b = item >> 9;
  const int r = item & 511;
  const int tb = (b & 1) ? 511 - r : r;
  const int t0 = tb * 8;
  const size_t tokbase = (size_t)b * SEQL;

  for (int rep_s = 0; rep_s < (DSA_REP == 1 ? 2 : 1); ++rep_s) {
    bf16x8 af[2][2];
    float wq[2][4];
#pragma unroll
    for (int mt = 0; mt < 2; ++mt) {
      const int qrow = t0 + mt * 4 + (l15 >> 2), head = l15 & 3;
#pragma unroll
      for (int ks = 0; ks < 2; ++ks)
        af[mt][ks] = *(const bf16x8*)(pA + (tokbase + qrow) * 1024 + 640 + head * 64 + ks * 32 + 8 * g);
      const uint2 wr = *(const uint2*)(pA + (tokbase + t0 + mt * 4 + g) * 1024 + 960);
      wq[mt][0] = 0.5f * bf2f((bf16_t)(wr.x & 0xffff)); wq[mt][1] = 0.5f * bf2f((bf16_t)(wr.x >> 16));
      wq[mt][2] = 0.5f * bf2f((bf16_t)(wr.y & 0xffff)); wq[mt][3] = 0.5f * bf2f((bf16_t)(wr.y >> 16));
    }
    const int nkt = (t0 + 8 + 15) >> 4;
    for (int kt0 = w; kt0 < nkt; kt0 += 32) {
      bf16x8 b0[4], b1[4];
#pragma unroll
      for (int u = 0; u < 4; ++u) {
        const int kt = kt0 + 8 * u;
        const int s = (kt < nkt ? kt : 0) * 16 + l15;
        const bf16_t* kr = pA + (tokbase + s) * 1024 + 896 + 8 * g;
        b0[u] = *(const bf16x8*)kr;
        b1[u] = *(const bf16x8*)(kr + 32);
      }
#pragma unroll
      for (int u = 0; u < 4; ++u) {
        const int kt = kt0 + 8 * u;
        if (kt < nkt) {
          const int s = kt * 16 + l15;
#pragma unroll
          for (int mt = 0; mt < 2; ++mt) {
            f32x4 acc = (f32x4){0.f, 0.f, 0.f, 0.f};
            acc = __builtin_amdgcn_mfma_f32_16x16x32_bf16(af[mt][0], b0[u], acc, 0, 0, 0);
            acc = __builtin_amdgcn_mfma_f32_16x16x32_bf16(af[mt][1], b1[u], acc, 0, 0, 0);
            float v = 0.f;
#pragma unroll
            for (int j = 0; j < 4; ++j) v += wq[mt][j] * fmaxf(acc[j] * 0.125f, 0.f);
            const int t = t0 + mt * 4 + g;
            unsigned vb = __float_as_uint(v); if (vb == 0x80000000u) vb = 0u;
            sc[(mt * 4 + g) * SCW + s] = vb;
          }
        }
      }
    }
  }
  __syncthreads();
  const int t = t0 + w;
  const int n = t + 1;
  unsigned* row = sc + w * SCW;
  const float* rowf = (const float*)row;
  unsigned short* mysel = sel + w * 256;
  unsigned short* mycand = cand + w * 512;
  unsigned* myh = hist + w * 256;
  int cnt;
  const unsigned long long lt_mask = (1ull << lane) - 1ull;
  for (int rep_t = 0; rep_t < (DSA_REP == 2 ? 2 : 1); ++rep_t)
  if (n <= 256) {
    for (int i = lane; i < n; i += 64) mysel[i] = (unsigned short)i;
    cnt = n;
  } else {
    cnt = 256;
    float mn = INFINITY, mx = -INFINITY;
    for (int i = lane; i < n; i += 64) { const float v = rowf[i]; mn = fminf(mn, v); mx = fmaxf(mx, v); }
#pragma unroll
    for (int o = 32; o > 0; o >>= 1) { mn = fminf(mn, __shfl_xor(mn, o)); mx = fmaxf(mx, __shfl_xor(mx, o)); }
    const float scale = (mx > mn) ? 255.99f / (mx - mn) : 0.f;
#pragma unroll
    for (int i = 0; i < 4; ++i) myh[lane + 64 * i] = 0u;
    __threadfence_block();
    for (int i = lane; i < n; i += 64) {
      const float v = rowf[i];
      int bn = (int)((v - mn) * scale); bn = bn > 255 ? 255 : bn;
      atomicAdd(&myh[bn], 1u);
    }
    __threadfence_block();
    unsigned cum; int bstar; unsigned mcount;
    {
      const uint4 c4 = *(const uint4*)(myh + 4 * lane);
      const unsigned c = c4.x + c4.y + c4.z + c4.w;
      unsigned sfx = c;
#pragma unroll
      for (int o = 1; o < 64; o <<= 1) { const unsigned tt = __shfl_down(sfx, o); if (lane + o < 64) sfx += tt; }
      const unsigned long long bal = __ballot(sfx >= 256u);
      const int L = 63 - __clzll(bal);
      const unsigned sL = __shfl(sfx, L), cL = __shfl(c, L);
      const unsigned b3 = __shfl(c4.w, L), b2 = __shfl(c4.z, L), b1 = __shfl(c4.y, L), b0 = __shfl(c4.x, L);
      cum = sL - cL;
      int digit;
      if (cum + b3 >= 256u) { digit = 3; mcount = b3; }
      else { cum += b3; if (cum + b2 >= 256u) { digit = 2; mcount = b2; } else { cum += b2; if (cum + b1 >= 256u) { digit = 1; mcount = b1; } else { cum += b1; digit = 0; mcount = b0; } } }
      bstar = 4 * L + digit;
    }
    const unsigned need = 256u - cum;
    if (mcount <= 512u) {
      unsigned base = 0u, cb = 0u;
      for (int i0 = 0; i0 < n; i0 += 64) {
        const int i = i0 + lane;
        const bool valid = i < n;
        const float v = valid ? rowf[i] : 0.f;
        int bn = (int)((v - mn) * scale); bn = bn > 255 ? 255 : bn;
        const bool gt = valid && (bn > bstar);
        const bool eq = valid && (bn == bstar);
        const unsigned long long bg = __ballot(gt), be = __ballot(eq);
        if (gt) mysel[base + (unsigned)__popcll(bg & lt_mask)] = (unsigned short)i;
        if (eq) mycand[cb + (unsigned)__popcll(be & lt_mask)] = (unsigned short)i;
        base += (unsigned)__popcll(bg); cb += (unsigned)__popcll(be);
      }
      __threadfence_block();
      const int m = (int)mcount;
      unsigned ck[8]; unsigned short ci[8];
#pragma unroll
      for (int q = 0; q < 8; ++q) {
        const int c = q * 64 + lane;
        ck[q] = 0u; ci[q] = 0;
        if (c < m) { ci[q] = mycand[c]; ck[q] = sortable_key(rowf[ci[q]]); }
      }
      unsigned T = 0u;
#pragma unroll 1
      for (int bit = 31; bit >= 0; --bit) {
        const unsigned trial = T | (1u << bit);
        unsigned cge = 0u;
#pragma unroll
        for (int q = 0; q < 8; ++q) cge += (unsigned)__popcll(__ballot(ck[q] >= trial));
        if (cge >= need) T = trial;
      }
      unsigned cgt = 0u;
#pragma unroll
      for (int q = 0; q < 8; ++q) cgt += (unsigned)__popcll(__ballot(ck[q] > T));
      const unsigned need_eq = need - cgt;
      unsigned pos0 = cum, eqtaken = 0u;
#pragma unroll
      for (int q = 0; q < 8; ++q) {
        const bool gt = ck[q] > T;
        const bool eq = ck[q] == T;
        const unsigned long long beq = __ballot(eq);
        const bool take = gt || (eq && (eqtaken + (unsigned)__popcll(beq & lt_mask)) < need_eq);
        const unsigned long long bt = __ballot(take);
        const unsigned pp = pos0 + (unsigned)__popcll(bt & lt_mask);
        if (take && pp < 256u) mysel[pp] = ci[q];
        pos0 += (unsigned)__popcll(bt);
        eqtaken += (unsigned)__popcll(beq);
      }
    } else {
      unsigned prefix = 0u, krem = 256u;
#pragma unroll 1
      for (int pass = 0; pass < 4; ++pass) {
        const int shift = 24 - 8 * pass;
        const unsigned himask = (pass == 0) ? 0u : (0xFFFFFFFFu << (shift + 8));
#pragma unroll
        for (int i = 0; i < 4; ++i) myh[lane + 64 * i] = 0u;
        __threadfence_block();
        for (int i = lane; i < n; i += 64) {
          const unsigned u = sortable_key(rowf[i]);
          if ((u & himask) == prefix) atomicAdd(&myh[(u >> shift) & 255u], 1u);
        }
        __threadfence_block();
        const uint4 c4 = *(const uint4*)(myh + 4 * lane);
        const unsigned c = c4.x + c4.y + c4.z + c4.w;
        unsigned sfx = c;
#pragma unroll
        for (int o = 1; o < 64; o <<= 1) { const unsigned tt = __shfl_down(sfx, o); if (lane + o < 64) sfx += tt; }
        const unsigned long long bal = __ballot(sfx >= krem);
        const int L = 63 - __clzll(bal);
        const unsigned sL = __shfl(sfx, L), cL = __shfl(c, L);
        const unsigned b3 = __shfl(c4.w, L), b2 = __shfl(c4.z, L), b1 = __shfl(c4.y, L);
        unsigned cum2 = sL - cL;
        unsigned digit;
        if (cum2 + b3 >= krem) digit = 3;
        else { cum2 += b3; if (cum2 + b2 >= krem) digit = 2; else { cum2 += b2; if (cum2 + b1 >= krem) digit = 1; else { cum2 += b1; digit = 0; } } }
        krem -= cum2;
        prefix |= ((unsigned)(4 * L) + digit) << shift;
      }
      const unsigned T = prefix;
      unsigned base = 0u, eqtaken = 0u;
      for (int i0 = 0; i0 < n; i0 += 64) {
        const int i = i0 + lane;
        const bool valid = i < n;
        const unsigned u = valid ? sortable_key(rowf[i]) : 0u;
        const bool gt = valid && (u > T);
        const bool eq = valid && (u == T);
        const unsigned long long beq = __ballot(eq);
        const unsigned eqrank = eqtaken + (unsigned)__popcll(beq & lt_mask);
        const bool take = gt || (eq && eqrank < krem);
        const unsigned long long bt = __ballot(take);
        const unsigned pos = base + (unsigned)__popcll(bt & lt_mask);
        if (take && pos < 256u) mysel[pos] = (unsigned short)i;
        base += (unsigned)__popcll(bt);
        eqtaken += (unsigned)__popcll(beq);
      }
    }
  }
  __threadfence_block();
  for (int rep_a = 0; rep_a < (DSA_REP == 3 ? 2 : 1); ++rep_a) {
    const int ks = lane >> 3, dc = lane & 7;
    float* pl = (float*)row;
    const int niter = (cnt + 7) >> 3;
    {
      const float* relb = (const float*)(bkt + 128);
      bf16x8 bq[2];
#pragma unroll
      for (int ks2 = 0; ks2 < 2; ++ks2) {
        bq[ks2] = (bf16x8){0, 0, 0, 0, 0, 0, 0, 0};
        if (l15 < 8) bq[ks2] = *(const bf16x8*)(pA + (tokbase + t) * 1024 + l15 * 64 + ks2 * 32 + 8 * g);
      }
      const int ntile = (cnt + 15) >> 4;
      for (int kt0 = 0; kt0 < ntile; kt0 += 4) {
        bf16x8 ka[4][2];
#pragma unroll
        for (int u = 0; u < 4; ++u) {
          const int kk = (kt0 + u) * 16 + l15;
          const int s = (kk < cnt) ? (int)mysel[kk] : 0;
          const bf16_t* kr = pA + (tokbase + s) * 1024 + 512 + 8 * g;
          ka[u][0] = *(const bf16x8*)kr;
          ka[u][1] = *(const bf16x8*)(kr + 32);
        }
#pragma unroll
        for (int u = 0; u < 4; ++u) {
          if (kt0 + u < ntile) {
            f32x4 acc = (f32x4){0.f, 0.f, 0.f, 0.f};
            acc = __builtin_amdgcn_mfma_f32_16x16x32_bf16(ka[u][0], bq[0], acc, 0, 0, 0);
            acc = __builtin_amdgcn_mfma_f32_16x16x32_bf16(ka[u][1], bq[1], acc, 0, 0, 0);
            if (l15 < 8) {
#pragma unroll
              for (int j = 0; j < 4; ++j) {
                const int key = (kt0 + u) * 16 + 4 * g + j;
                const bool valid = key < cnt;
                const int sj = valid ? (int)mysel[key] : 0;
                const int dist = t - sj;
                const int bk = dist < 128 ? (int)bkt[dist] : 31;
                pl[key * 8 + l15] = valid ? (acc[j] * 0.125f + relb[bk * 8 + l15]) : -INFINITY;
              }
            }
          }
        }
      }
    }
    __threadfence_block();
    float inv;
    {
      const int hh = lane & 7, part = lane >> 3;
      float m = -INFINITY;
      for (int kk = part; kk < cnt; kk += 8) m = fmaxf(m, pl[kk * 8 + hh]);
      m = fmaxf(m, __shfl_xor(m, 8)); m = fmaxf(m, __shfl_xor(m, 16)); m = fmaxf(m, __shfl_xor(m, 32));
      float sum = 0.f;
      for (int kk = part; kk < niter * 8; kk += 8) {
        const float e = (kk < cnt) ? __expf(pl[kk * 8 + hh] - m) : 0.f;
        pl[kk * 8 + hh] = e;
        sum += e;
      }
      sum += __shfl_xor(sum, 8); sum += __shfl_xor(sum, 16); sum += __shfl_xor(sum, 32);
      inv = 1.f / sum;
    }
    __threadfence_block();
    float acc[8][8];
#pragma unroll
    for (int hh = 0; hh < 8; ++hh)
#pragma unroll
      for (int i = 0; i < 8; ++i) acc[hh][i] = 0.f;
    for (int it0 = 0; it0 < niter; it0 += 8) {
      uint4 vv[8];
#pragma unroll
      for (int u = 0; u < 8; ++u) {
        const int kk = (it0 + u) * 8 + ks;
        const int s = (kk < cnt) ? (int)mysel[kk] : 0;
        vv[u] = *(const uint4*)(pA + (tokbase + s) * 1024 + 576 + dc * 8);
      }
#pragma unroll
      for (int u = 0; u < 8; ++u) {
        if (it0 + u < niter) {
          const int kk = (it0 + u) * 8 + ks;
          float vf[8];
          cvt8(vv[u], vf);
          const float4 p0 = *(const float4*)(pl + kk * 8);
          const float4 p1 = *(const float4*)(pl + kk * 8 + 4);
          const float pp[8] = {p0.x, p0.y, p0.z, p0.w, p1.x, p1.y, p1.z, p1.w};
#pragma unroll
          for (int hh = 0; hh < 8; ++hh)
#pragma unroll
            for (int i = 0; i < 8; ++i) acc[hh][i] += pp[hh] * vf[i];
        }
      }
    }
#pragma unroll
    for (int hh = 0; hh < 8; ++hh) {
      const float ih = __shfl(inv, hh);
#pragma unroll
      for (int i = 0; i < 8; ++i) {
        float v = acc[hh][i];
        v += __shfl_xor(v, 8); v += __shfl_xor(v, 16); v += __shfl_xor(v, 32);
        acc[hh][i] = v * ih;
      }
    }
    if (ks == 0) {
#pragma unroll
      for (int hh = 0; hh < 8; ++hh) {
        uint4 o;
        o.x = pack2(acc[hh][0], acc[hh][1]); o.y = pack2(acc[hh][2], acc[hh][3]);
        o.z = pack2(acc[hh][4], acc[hh][5]); o.w = pack2(acc[hh][6], acc[hh][7]);
        *(uint4*)(yb + (tokbase + t) * 512 + hh * 64 + dc * 8) = o;
      }
    }
  }
  __syncthreads();
}

__device__ __forceinline__ void phase_mix(const Params& p, unsigned char* smem) {
  const int G = gridDim.x;
  if (G >= 64) {
    if (blockIdx.x < 32) { hgrn_item(p, smem, blockIdx.x); return; }
    unsigned char* bkt = smem + DSA_BKT_OFF;
    if (threadIdx.x < 128) {
      const int nn = threadIdx.x;
      int v = nn;
      if (nn >= 16) { v = 16 + (int)(logf((float)nn * (1.f / 16.f)) / logf(8.f) * 16.f); if (v > 31) v = 31; }
      bkt[nn] = (unsigned char)v;
    }
    if (threadIdx.x >= 256) ((float*)(bkt + 128))[threadIdx.x - 256] = p.rel_bias[threadIdx.x - 256];
    __syncthreads();
    for (int item = blockIdx.x - 32; item < 4096; item += G - 32) dsa_item(p, smem, item);
  } else {
    for (int bh = blockIdx.x; bh < 32; bh += G) { hgrn_item(p, smem, bh); __syncthreads(); }
    unsigned char* bkt = smem + DSA_BKT_OFF;
    __syncthreads();
    if (threadIdx.x < 128) {
      const int nn = threadIdx.x;
      int v = nn;
      if (nn >= 16) { v = 16 + (int)(logf((float)nn * (1.f / 16.f)) / logf(8.f) * 16.f); if (v > 31) v = 31; }
      bkt[nn] = (unsigned char)v;
    }
    if (threadIdx.x >= 256) ((float*)(bkt + 128))[threadIdx.x - 256] = p.rel_bias[threadIdx.x - 256];
    __syncthreads();
    for (int item = blockIdx.x; item < 4096; item += G) dsa_item(p, smem, item);
  }
}

__device__ __forceinline__ void phase_up(const Params& p, unsigned char* smem) {
  unsigned char* ws = p.ws;
  const bf16_t* ya = (const bf16_t*)(ws + WS_XN);
  const bf16_t* yb = ya + (size_t)TOK * 512;
  const bf16_t* wa = (const bf16_t*)(ws + WS_WUPA);
  const bf16_t* wb = (const bf16_t*)(ws + WS_WUPB);
  const bf16_t* pG = (const bf16_t*)(ws + WS_PG);
  bf16_t* hb = (bf16_t*)(ws + WS_PH);
  const int tid = threadIdx.x, lane = tid & 63, w = tid >> 6, wm = w >> 1, wn = w & 1, l15 = lane & 15, g = lane >> 4;
  for (int tile = blockIdx.x; tile < 128 * 8; tile += gridDim.x) {
    const int tn = tile & 7, tm = tile >> 3;
    f32x4 acc[4][4]; zero_acc(acc);
    gemm_tile(ya + (size_t)tm * 256 * 512, 512, wa + (size_t)tn * 128 * 512, 512, 8, acc, smem);
    asm volatile("" ::: "memory");
    const int rbase = tm * 256 + wm * 64 + 4 * g;
    const int cbase = tn * 128 + wn * 64 + l15;
#pragma unroll
    for (int m = 0; m < 4; ++m) {
      bf16_t gt[16];
#pragma unroll
      for (int n = 0; n < 4; ++n)
#pragma unroll
        for (int j = 0; j < 4; ++j) gt[n * 4 + j] = pG[(size_t)(rbase + m * 16 + j) * 2048 + cbase + n * 16];
#pragma unroll
      for (int n = 0; n < 4; ++n) {
#pragma unroll
        for (int j = 0; j < 4; ++j) {
          const size_t rr = (size_t)(rbase + m * 16 + j);
          hb[rr * 1024 + cbase + n * 16] = f2bf(acc[m][n][j] * bf2f(gt[n * 4 + j]));
        }
        acc[m][n] = (f32x4){0.f, 0.f, 0.f, 0.f};
      }
    }
    asm volatile("" ::: "memory");
    gemm_tile(yb + (size_t)tm * 256 * 512, 512, wb + (size_t)tn * 128 * 512, 512, 8, acc, smem);
    asm volatile("" ::: "memory");
#pragma unroll
    for (int m = 0; m < 4; ++m) {
      bf16_t gt[16], ht[16];
#pragma unroll
      for (int n = 0; n < 4; ++n)
#pragma unroll
        for (int j = 0; j < 4; ++j) {
          const size_t rr = (size_t)(rbase + m * 16 + j);
          gt[n * 4 + j] = pG[rr * 2048 + 1024 + cbase + n * 16];
          ht[n * 4 + j] = hb[rr * 1024 + cbase + n * 16];
        }
#pragma unroll
      for (int n = 0; n < 4; ++n)
#pragma unroll
        for (int j = 0; j < 4; ++j) {
          const size_t rr = (size_t)(rbase + m * 16 + j);
          hb[rr * 1024 + cbase + n * 16] = f2bf(bf2f(ht[n * 4 + j]) + acc[m][n][j] * bf2f(gt[n * 4 + j]));
        }
    }
  }
}

__device__ __forceinline__ void phase_out(const Params& p, unsigned char* smem) {
  unsigned char* ws = p.ws;
  const bf16_t* hb = (const bf16_t*)(ws + WS_PH);
  const bf16_t* wo = (const bf16_t*)(ws + WS_WOUT);
  const int tid = threadIdx.x, lane = tid & 63, w = tid >> 6, wm = w >> 1, wn = w & 1, l15 = lane & 15, g = lane >> 4;
  for (int tile = blockIdx.x; tile < 128 * 8; tile += gridDim.x) {
    const int tn = tile & 7, tm = tile >> 3;
    f32x4 acc[4][4]; zero_acc(acc);
    gemm_tile(hb + (size_t)tm * 256 * 1024, 1024, wo + (size_t)tn * 128 * 1024, 1024, 16, acc, smem);
    const int rbase = tm * 256 + wm * 64 + 4 * g;
    const int cbase = tn * 128 + wn * 64 + l15;
#pragma unroll
    for (int m = 0; m < 4; ++m) {
      float xt[16];
#pragma unroll
      for (int n = 0; n < 4; ++n)
#pragma unroll
        for (int j = 0; j < 4; ++j) xt[n * 4 + j] = p.x[(size_t)(rbase + m * 16 + j) * 1024 + cbase + n * 16];
#pragma unroll
      for (int n = 0; n < 4; ++n)
#pragma unroll
        for (int j = 0; j < 4; ++j) p.out[(size_t)(rbase + m * 16 + j) * 1024 + cbase + n * 16] = xt[n * 4 + j] + acc[m][n][j];
    }
  }
}

__device__ __forceinline__ void phase_pq(const Params& p, unsigned char* smem) {
  unsigned char* ws = p.ws;
  const bf16_t* xn2 = (const bf16_t*)(ws + WS_XN);
  const bf16_t* wq = (const bf16_t*)(ws + WS_WQ);
  bf16_t* qp = (bf16_t*)(ws + WS_PG);
  const int tid = threadIdx.x, lane = tid & 63, w = tid >> 6, wm = w >> 1, wn = w & 1, l15 = lane & 15, g = lane >> 4;
  for (int tile = blockIdx.x; tile < 128 * 16; tile += gridDim.x) {
    const int tn = tile & 15, tm = tile >> 4;
    f32x4 acc[4][4]; zero_acc(acc);
    gemm_tile(xn2 + (size_t)tm * 256 * 1024, 1024, wq + (size_t)tn * 128 * 1024, 1024, 16, acc, smem);
    const int rbase = tm * 256 + wm * 64 + 4 * g;
    const int cbase = tn * 128 + wn * 64 + l15;
#pragma unroll
    for (int m = 0; m < 4; ++m)
#pragma unroll
      for (int n = 0; n < 4; ++n)
#pragma unroll
        for (int j = 0; j < 4; ++j) qp[(size_t)(rbase + m * 16 + j) * 2048 + cbase + n * 16] = f2bf(acc[m][n][j]);
  }
}

__device__ __forceinline__ void phase_pkeys(const Params& p, unsigned char* smem) {
  unsigned char* ws = p.ws;
  const bf16_t* qp = (const bf16_t*)(ws + WS_PG);
  const bf16_t* keys = (const bf16_t*)(ws + WS_KEYS);
  float* ps = (float*)(ws + WS_PA);
  int* pi = (int*)(ws + WS_PA) + (size_t)TOK * 256;
  float* sc = (float*)smem;
  const int tid = threadIdx.x, lane = tid & 63, w = tid >> 6, wm = w >> 1, wn = w & 1, l15 = lane & 15, g = lane >> 4;
  for (int tile = blockIdx.x; tile < 128 * 16; tile += gridDim.x) {
    const int hp = tile & 15, tm = tile >> 4;
    const int h = hp >> 1, ph = hp & 1;
    f32x4 acc[4][4]; zero_acc(acc);
    gemm_tile(qp + (size_t)tm * 256 * 2048 + hp * 128, 2048, keys + (size_t)(ph * 8 + h) * 128 * 128, 128, 2, acc, smem);
    __syncthreads();
#pragma unroll
    for (int m = 0; m < 4; ++m)
#pragma unroll
      for (int n = 0; n < 4; ++n)
#pragma unroll
        for (int j = 0; j < 4; ++j) sc[(wm * 64 + m * 16 + 4 * g + j) * 129 + wn * 64 + n * 16 + l15] = acc[m][n][j];
    __syncthreads();
    if (tid < 256) {
      float* rowp = sc + tid * 129;
      const size_t ob = ((size_t)(tm * 256 + tid) * 16 + hp) * 16;
#pragma unroll 1
      for (int k = 0; k < 16; ++k) {
        float best = -INFINITY; int bi = 0;
        for (int nn = 0; nn < 128; ++nn) { const float v = rowp[nn]; if (v > best) { best = v; bi = nn; } }
        rowp[bi] = -INFINITY;
        ps[ob + k] = best; pi[ob + k] = bi;
      }
    }
    __syncthreads();
  }
}

__device__ __forceinline__ void phase_pcomb(const Params& p, unsigned char* smem) {
  unsigned char* ws = p.ws;
  const float* ps = (const float*)(ws + WS_PA);
  const int* pi = (const int*)(ws + WS_PA) + (size_t)TOK * 256;
  int* eidx = (int*)(ws + WS_EIDX);
  float* gw = (float*)(ws + WS_GW);
  float* s2l = (float*)smem;
  unsigned short* i1l = (unsigned short*)(s2l + 512 * 17);
  unsigned short* i2l = i1l + 512 * 16;
  const int tid = threadIdx.x;
  for (int base = blockIdx.x * NTHREADS; base < TOK * 8; base += gridDim.x * NTHREADS) {
    const int th = base + tid;
    const size_t o1 = (size_t)th * 32;
    float s1[16];
#pragma unroll
    for (int a = 0; a < 16; ++a) {
      s1[a] = ps[o1 + a];
      s2l[tid * 17 + a] = ps[o1 + 16 + a];
      i1l[tid * 16 + a] = (unsigned short)pi[o1 + a];
      i2l[tid * 16 + a] = (unsigned short)pi[o1 + 16 + a];
    }
    float cur[16];
    const float s20 = s2l[tid * 17];
#pragma unroll
    for (int a = 0; a < 16; ++a) cur[a] = s1[a] + s20;
    unsigned long long ptr = 0ull;
    float tops[16]; int tope[16];
#pragma unroll
    for (int k = 0; k < 16; ++k) {
      float best = cur[0]; int ba = 0;
#pragma unroll
      for (int a = 1; a < 16; ++a) if (cur[a] > best) { best = cur[a]; ba = a; }
      const int bb = (int)((ptr >> (4 * ba)) & 15ull);
      tops[k] = best;
      tope[k] = (int)i1l[tid * 16 + ba] * 128 + (int)i2l[tid * 16 + bb];
      const int nb = bb + 1;
      const float ns2 = (nb < 16) ? s2l[tid * 17 + nb] : -INFINITY;
      if (nb < 16) ptr += (1ull << (4 * ba));
#pragma unroll
      for (int a = 0; a < 16; ++a) if (a == ba) cur[a] = s1[a] + ns2;
    }
    float m = tops[0];
    float sum = 0.f;
#pragma unroll
    for (int k = 0; k < 16; ++k) { tops[k] = __expf(tops[k] - m); sum += tops[k]; }
    const float inv = 1.f / sum;
#pragma unroll
    for (int k = 0; k < 16; ++k) { eidx[(size_t)th * 16 + k] = tope[k]; gw[(size_t)th * 16 + k] = tops[k] * inv; }
  }
}


__device__ __forceinline__ float reduce8(const float (&pv)[8], int lane) {
  const bool b5 = lane & 32, b4 = lane & 16, b3 = lane & 8;
  float v[4];
#pragma unroll
  for (int i = 0; i < 4; ++i) {
    const float keep = b5 ? pv[4 + i] : pv[i];
    const float send = b5 ? pv[i] : pv[4 + i];
    v[i] = keep + __shfl_xor(send, 32);
  }
  float u[2];
#pragma unroll
  for (int i = 0; i < 2; ++i) {
    const float keep = b4 ? v[2 + i] : v[i];
    const float send = b4 ? v[i] : v[2 + i];
    u[i] = keep + __shfl_xor(send, 16);
  }
  float x = (b3 ? u[1] : u[0]) + __shfl_xor(b3 ? u[0] : u[1], 8);
  x += __shfl_xor(x, 4); x += __shfl_xor(x, 2); x += __shfl_xor(x, 1);
  return x;
}

__device__ __forceinline__ void cvt16u8(const uint4& v, float* f) {
  f[0] = (float)(v.x & 0xffu); f[1] = (float)((v.x >> 8) & 0xffu); f[2] = (float)((v.x >> 16) & 0xffu); f[3] = (float)(v.x >> 24);
  f[4] = (float)(v.y & 0xffu); f[5] = (float)((v.y >> 8) & 0xffu); f[6] = (float)((v.y >> 16) & 0xffu); f[7] = (float)(v.y >> 24);
  f[8] = (float)(v.z & 0xffu); f[9] = (float)((v.z >> 8) & 0xffu); f[10] = (float)((v.z >> 16) & 0xffu); f[11] = (float)(v.z >> 24);
  f[12] = (float)(v.w & 0xffu); f[13] = (float)((v.w >> 8) & 0xffu); f[14] = (float)((v.w >> 16) & 0xffu); f[15] = (float)(v.w >> 24);
}

__device__ __forceinline__ int team_index(const Params& p, unsigned char* smem) {
  int* sh = (int*)(smem + 8192);
  const int G = gridDim.x, tid = threadIdx.x;
  const int* tab = (const int*)(p.ws + WS_XCC);
  if (tid < 32) sh[tid] = 0;
  __syncthreads();
  const int mine = tab[blockIdx.x] & 15;
  for (int b = tid; b < G; b += NTHREADS) {
    const int x = tab[b] & 15;
    atomicAdd(&sh[x], 1);
    if (x == mine && b < (int)blockIdx.x) atomicAdd(&sh[16], 1);
  }
  __syncthreads();
  if (tid == 0) {
    int pre = 0;
    for (int j = 0; j < mine; ++j) pre += sh[j];
    sh[17] = pre + sh[16];
  }
  __syncthreads();
  const int r = sh[17];
  __syncthreads();
  return r;
}

__device__ __forceinline__ void phase_pu(const Params& p, unsigned char* smem) {
  unsigned char* ws = p.ws;
  const bf16_t* xn2 = (const bf16_t*)(ws + WS_XN);
  const unsigned char* U8 = ws + WS_U;
  const float* us = (const float*)(ws + WS_U + (size_t)16384 * 1024);
  const float* vs = (const float*)(ws + WS_V + (size_t)16384 * 1024);
  const int* eidx = (const int*)(ws + WS_EIDX);
  const float* gw = (const float*)(ws + WS_GW);
  float* aw = (float*)(ws + WS_PA);
  const int lane = threadIdx.x & 63, w = threadIdx.x >> 6;
  unsigned* lst = (unsigned*)smem + w * 128;
  const unsigned long long lt_mask = (1ull << lane) - 1ull;
  const int G = gridDim.x;
  const bool sliced = (G % 8 == 0);
  const int ti = sliced ? team_index(p, smem) : 0;
  const int tsz = G >> 3;
  const int grp0 = sliced ? (ti / tsz) : 0, ngrp = sliced ? 1 : 8;
  const int slot = sliced ? (ti % tsz) * 8 + w : blockIdx.x * 8 + w;
  const int nslot = sliced ? tsz * 8 : G * 8;
  uint4 xa, xb; int e0, e1;
  if (slot < TOK) {
    xa = *(const uint4*)(xn2 + (size_t)slot * 1024 + lane * 16);
    xb = *(const uint4*)(xn2 + (size_t)slot * 1024 + lane * 16 + 8);
    e0 = eidx[(size_t)slot * 128 + lane]; e1 = eidx[(size_t)slot * 128 + 64 + lane];
  }
  for (int tok = slot; tok < TOK; tok += nslot) {
    float xf[16];
    cvt8(xa, xf); cvt8(xb, xf + 8);
    const int ce0 = e0, ce1 = e1;
    {
      const int nt = tok + nslot;
      if (nt < TOK) {
        xa = *(const uint4*)(xn2 + (size_t)nt * 1024 + lane * 16);
        xb = *(const uint4*)(xn2 + (size_t)nt * 1024 + lane * 16 + 8);
        e0 = eidx[(size_t)nt * 128 + lane]; e1 = eidx[(size_t)nt * 128 + 64 + lane];
      }
    }
    float negsum = 0.f;
#pragma unroll
    for (int i = 0; i < 16; ++i) negsum += xf[i];
    negsum *= -128.f;
    for (int gi = 0; gi < ngrp; ++gi) {
      const int grp = grp0 + gi;
      const bool m0 = (ce0 >> 11) == grp, m1 = (ce1 >> 11) == grp;
      const unsigned long long b0 = __ballot(m0), b1 = __ballot(m1);
      const int c0 = __popcll(b0), n = c0 + __popcll(b1);
      if (m0) lst[__popcll(b0 & lt_mask)] = ((unsigned)lane << 14) | (unsigned)ce0;
      if (m1) lst[c0 + __popcll(b1 & lt_mask)] = ((unsigned)(lane + 64) << 14) | (unsigned)ce1;
      __threadfence_block();
      const unsigned le0 = (lane < n) ? lst[lane] : 0u;
      const unsigned le1 = (lane + 64 < n) ? lst[lane + 64] : 0u;
      __threadfence_block();
      float sc0 = 0.f, sc1 = 0.f, gv0 = 0.f, gv1 = 0.f, vv0 = 0.f, vv1 = 0.f;
      if (lane < n) { const int e = le0 & 16383; sc0 = us[e]; vv0 = vs[e]; gv0 = gw[(size_t)tok * 128 + (le0 >> 14)]; }
      if (lane + 64 < n) { const int e = le1 & 16383; sc1 = us[e]; vv1 = vs[e]; gv1 = gw[(size_t)tok * 128 + (le1 >> 14)]; }
      float h0 = 0.f, h1 = 0.f;
#pragma unroll 1
      for (int i0 = 0; i0 < n; i0 += 16) {
        uint4 ua[16];
#pragma unroll
        for (int j = 0; j < 16; ++j) {
          int idx = i0 + j; idx = idx < n ? idx : n - 1;
          const unsigned le = (idx < 64) ? (unsigned)__builtin_amdgcn_readlane((int)le0, idx) : (unsigned)__builtin_amdgcn_readlane((int)le1, idx - 64);
          ua[j] = *(const uint4*)(U8 + (size_t)(le & 16383u) * 1024 + lane * 16);
        }
        float pv[8], pw[8];
#pragma unroll
        for (int j = 0; j < 8; ++j) {
          float uf[16];
          cvt16u8(ua[j], uf);
          float pp = negsum;
#pragma unroll
          for (int i = 0; i < 16; ++i) pp += uf[i] * xf[i];
          pv[j] = pp;
        }
#pragma unroll
        for (int j = 0; j < 8; ++j) {
          float uf[16];
          cvt16u8(ua[8 + j], uf);
          float pp = negsum;
#pragma unroll
          for (int i = 0; i < 16; ++i) pp += uf[i] * xf[i];
          pw[j] = pp;
        }
        const float ta = reduce8(pv, lane);
        const float tb = reduce8(pw, lane);
#pragma unroll
        for (int j = 0; j < 8; ++j) {
          const float hj = __int_as_float(__builtin_amdgcn_readlane(__float_as_int(ta), 8 * j));
          const float hk = __int_as_float(__builtin_amdgcn_readlane(__float_as_int(tb), 8 * j));
          const int ia = i0 + j, ib = i0 + 8 + j;
          if (ia < 64) { if (lane == ia) h0 = hj; } else { if (lane == ia - 64) h1 = hj; }
          if (ib < 64) { if (lane == ib) h0 = hk; } else { if (lane == ib - 64) h1 = hk; }
        }
      }
      h0 *= sc0; h1 *= sc1;
      if (lane < n) aw[(size_t)tok * 128 + (le0 >> 14)] = 0.5f * h0 * (1.f + erff(h0 * 0.70710678118654752f)) * gv0 * vv0;
      if (lane + 64 < n) aw[(size_t)tok * 128 + (le1 >> 14)] = 0.5f * h1 * (1.f + erff(h1 * 0.70710678118654752f)) * gv1 * vv1;
    }
  }
}

__device__ __forceinline__ void phase_pv(const Params& p, unsigned char* smem) {
  unsigned char* ws = p.ws;
  const unsigned char* V8 = ws + WS_V;
  const int* eidx = (const int*)(ws + WS_EIDX);
  const float* aw = (const float*)(ws + WS_PA);
  float* ssq = (float*)(ws + WS_SSQ);
  const int lane = threadIdx.x & 63, w = threadIdx.x >> 6;
  const int q = lane >> 3, c = lane & 7;
  const int G = gridDim.x;
  const bool sliced = (G % 8 == 0);
  const int ti = sliced ? team_index(p, smem) : 0;
  const int tsz = G >> 3;
  const int grp0 = sliced ? (ti / tsz) : 0, ngrp = sliced ? 1 : 8;
  const int slot = sliced ? (ti % tsz) * 8 + w : blockIdx.x * 8 + w;
  const int nslot = sliced ? tsz * 8 : G * 8;
  int ee[16]; float aa[16];
  if (slot < TOK) {
    const int* ep = eidx + (size_t)slot * 128 + q;
    const float* ap = aw + (size_t)slot * 128 + q;
    asm volatile("" : "+v"(ep), "+v"(ap));
#pragma unroll
    for (int u = 0; u < 16; ++u) { ee[u] = ep[8 * u]; aa[u] = ap[8 * u]; }
  }
  for (int tok = slot; tok < TOK; tok += nslot) {
    int ce[16]; float ca[16];
    float suma = 0.f;
#pragma unroll
    for (int u = 0; u < 16; ++u) { ce[u] = ee[u]; ca[u] = aa[u]; suma += aa[u]; }
    for (int gi = 0; gi < ngrp; ++gi) {
      const int grp = grp0 + gi;
      uint4 vv[16];
#pragma unroll
      for (int u = 0; u < 16; ++u) vv[u] = *(const uint4*)(V8 + (size_t)ce[u] * 1024 + grp * 128 + c * 16);
      float* orow = p.out + (size_t)tok * 1024 + grp * 128 + c * 16;
      float4 x1v[4];
      if (q == 0) {
#pragma unroll
        for (int i = 0; i < 4; ++i) x1v[i] = *(const float4*)(orow + 4 * i);
      }
      if (gi == ngrp - 1) {
        const int nt = tok + nslot;
        if (nt < TOK) {
          const int* ep = eidx + (size_t)nt * 128 + q;
          const float* ap = aw + (size_t)nt * 128 + q;
          asm volatile("" : "+v"(ep), "+v"(ap));
#pragma unroll
          for (int u = 0; u < 16; ++u) { ee[u] = ep[8 * u]; aa[u] = ap[8 * u]; }
        }
      }
      float acc[16];
#pragma unroll
      for (int i = 0; i < 16; ++i) acc[i] = -128.f * suma;
#pragma unroll
      for (int u = 0; u < 16; ++u) {
        float vf[16];
        cvt16u8(vv[u], vf);
#pragma unroll
        for (int i = 0; i < 16; ++i) acc[i] += ca[u] * vf[i];
        __builtin_amdgcn_sched_barrier(0);
      }
#pragma unroll
      for (int i = 0; i < 16; ++i) { acc[i] += __shfl_xor(acc[i], 8); acc[i] += __shfl_xor(acc[i], 16); acc[i] += __shfl_xor(acc[i], 32); }
      float ss = 0.f;
      if (q == 0) {
#pragma unroll
        for (int i = 0; i < 4; ++i) {
          const float4 oa = make_float4(x1v[i].x + acc[4 * i], x1v[i].y + acc[4 * i + 1], x1v[i].z + acc[4 * i + 2], x1v[i].w + acc[4 * i + 3]);
          *(float4*)(orow + 4 * i) = oa;
          ss += oa.x * oa.x + oa.y * oa.y + oa.z * oa.z + oa.w * oa.w;
        }
      }
      ss += __shfl_xor(ss, 1); ss += __shfl_xor(ss, 2); ss += __shfl_xor(ss, 4);
      if (lane == 0) atomicAdd(&ssq[tok], ss);
    }
  }
}

__device__ __forceinline__ void phase_final(const Params& p) {
  const float* ssq = (const float*)(p.ws + WS_SSQ);
  const int lane = threadIdx.x & 63, w = threadIdx.x >> 6;
  for (int row = blockIdx.x * 8 + w; row < TOK; row += gridDim.x * 8) {
    const float rstd = rsqrtf(ssq[row] * (1.f / DM) + EPSV);
    float4* o4 = (float4*)(p.out + (size_t)row * DM);
#pragma unroll
    for (int i = 0; i < 4; ++i) {
      float4 v = o4[lane + 64 * i];
      const float4 gg = ((const float4*)p.norm_final)[lane + 64 * i];
      v.x *= rstd * gg.x; v.y *= rstd * gg.y; v.z *= rstd * gg.z; v.w *= rstd * gg.w;
      o4[lane + 64 * i] = v;
    }
  }
}

__global__ void __launch_bounds__(NTHREADS) hybrid_fwd(Params p) {
  extern __shared__ __attribute__((aligned(16))) unsigned char smem[];
#if ONE_LAUNCH
  cg::grid_group grid = cg::this_grid();
  volatile LAS unsigned* xst = (volatile LAS unsigned*)(smem + LDS_BYTES - 16);
  if (threadIdx.x == 0) { xst[0] = 0u; xst[1] = 0u; }
  __syncthreads();
  XcdBarrier xbar = xcd_barrier_post((unsigned*)(p.ws + WS_BAR), xst);
#define SEAM(k) do { if (p.ph_lo <= (k) && (k) + 1 < p.ph_hi) { if ((k) == 0) grid.sync(); else xcd_barrier(xbar); } } while (0)
#else
#define SEAM(k) do { } while (0)
#endif
#define IN(k) (p.ph_lo <= (k) && (k) < p.ph_hi)
#ifndef REPEAT_PH
#define REPEAT_PH -1
#endif
#define REP(k, stmt) do { if (REPEAT_PH == (k)) { stmt; grid.sync(); } } while (0)
  if (IN(0)) { REP(0, phase_prep(p, smem)); phase_prep(p, smem); SEAM(0); }
  if (IN(1)) { REP(1, phase_proj(p, smem)); phase_proj(p, smem); SEAM(1); }
  if (IN(2)) { REP(2, phase_mix(p, smem)); phase_mix(p, smem); SEAM(2); }
  if (IN(3)) { REP(3, phase_up(p, smem)); phase_up(p, smem); SEAM(3); }
  if (IN(4)) { REP(4, phase_out(p, smem)); phase_out(p, smem); SEAM(4); }
  if (IN(5)) { REP(5, rmsnorm_rows(p.out, p.norm_ffn, (bf16_t*)(p.ws + WS_XN))); rmsnorm_rows(p.out, p.norm_ffn, (bf16_t*)(p.ws + WS_XN)); SEAM(5); }
  if (IN(6)) { REP(6, phase_pq(p, smem)); phase_pq(p, smem); SEAM(6); }
  if (IN(7)) { REP(7, phase_pkeys(p, smem)); phase_pkeys(p, smem); SEAM(7); }
  if (IN(8)) { REP(8, phase_pcomb(p, smem)); phase_pcomb(p, smem); SEAM(8); }
  if (IN(9)) { phase_pu(p, smem); SEAM(9); }
  if (IN(10)) { phase_pv(p, smem); SEAM(10); }
  if (IN(11)) { phase_final(p); }
#undef IN
#undef SEAM
}

extern "C" void kernel_launch(void* const* d_in, const int* in_sizes, int n_in, void* d_out, int out_size, void* d_ws, size_t ws_size,
                              hipStream_t stream) {
  static int grid = 0;
  if (grid == 0) {
    if (n_in != 17 || ws_size < WS_END) {
      fprintf(stderr, "kernel_launch: unexpected n_in %d or ws_size %zu (need %zu)\n", n_in, ws_size, (size_t)WS_END);
      grid = -1; return;
    }
    int dev = 0, cus = 0, per_cu = 0;
    hipGetDevice(&dev);
    hipDeviceGetAttribute(&cus, hipDeviceAttributeMultiprocessorCount, dev);
    hipFuncSetAttribute((const void*)hybrid_fwd, hipFuncAttributeMaxDynamicSharedMemorySize, LDS_BYTES);
    hipOccupancyMaxActiveBlocksPerMultiprocessor(&per_cu, (const void*)hybrid_fwd, NTHREADS, LDS_BYTES);
    if (per_cu < 1) { fprintf(stderr, "kernel_launch: occupancy query says %d blocks/CU\n", per_cu); per_cu = 1; }
    (void)hipGetLastError();
    grid = cus;
  }
  if (grid < 0) return;
  Params p{};
  p.x = (const float*)d_in[0]; p.norm_mix = (const float*)d_in[1]; p.w_in = (const float*)d_in[2]; p.hg_lb = (const float*)d_in[3];
  p.hg_norm = (const float*)d_in[4]; p.ikg = (const float*)d_in[5]; p.ikb = (const float*)d_in[6]; p.rel_bias = (const float*)d_in[7];
  p.w_up_a = (const float*)d_in[8]; p.w_up_b = (const float*)d_in[9]; p.w_out = (const float*)d_in[10]; p.norm_ffn = (const float*)d_in[11];
  p.peer_wq = (const float*)d_in[12]; p.peer_keys = (const float*)d_in[13]; p.peer_u = (const float*)d_in[14]; p.peer_v = (const float*)d_in[15];
  p.norm_final = (const float*)d_in[16];
  p.out = (float*)d_out; p.ws = (unsigned char*)d_ws;
#if ONE_LAUNCH
  hipMemsetAsync((unsigned char*)d_ws + WS_BAR, 0, 16384, stream);
  p.ph_lo = 0; p.ph_hi = NPHASE;
  void* args[] = {&p};
  hipError_t e = hipLaunchCooperativeKernel((const void*)hybrid_fwd, dim3(grid), dim3(NTHREADS), args, LDS_BYTES, stream);
  if (e != hipSuccess) fprintf(stderr, "cooperative launch failed: %s (grid %d)\n", hipGetErrorString(e), grid);
#else
  for (int ph = 0; ph < NPHASE; ++ph) {
    p.ph_lo = ph; p.ph_hi = ph + 1;
    hipLaunchKernelGGL(hybrid_fwd, dim3(grid), dim3(NTHREADS), LDS_BYTES, stream, p);
  }
#endif
}
```

```cpp
#include <hip/hip_runtime.h>
#include <hip/hip_cooperative_groups.h>
#include <stdint.h>
#include <stdio.h>
namespace cg = cooperative_groups;

#ifndef ONE_LAUNCH
#define ONE_LAUNCH 1
#endif

typedef unsigned short bf16_t;
typedef __attribute__((ext_vector_type(8))) short bf16x8;
typedef __attribute__((ext_vector_type(4))) float f32x4;

#define NTHREADS 512
#define TOK 32768
#define SEQL 4096
#define DM 1024
#define EPSV 1e-6f
#define NPHASE 13

#define WS_WIN   ((size_t)0)
#define WS_WUPA  (WS_WIN  + (size_t)5120 * 1024 * 2)
#define WS_WUPB  (WS_WUPA + (size_t)1024 * 512 * 2)
#define WS_WOUT  (WS_WUPB + (size_t)1024 * 512 * 2)
#define WS_WQ    (WS_WOUT + (size_t)1024 * 1024 * 2)
#define WS_KEYS  (WS_WQ   + (size_t)2048 * 1024 * 2)
#define WS_LB    (WS_KEYS + (size_t)2 * 8 * 128 * 128 * 2)
#define WS_U     (WS_LB   + (size_t)4096)
#define WS_V     (WS_U    + (size_t)16384 * 1024 * 2)
#define WS_XN    (WS_V    + (size_t)16384 * 1024 * 2)
#define WS_PH    (WS_XN   + (size_t)TOK * 1024 * 2)
#define WS_PA    (WS_PH   + (size_t)TOK * 2048 * 2)
#define WS_PG    (WS_PA   + (size_t)TOK * 1024 * 2)
#define WS_EIDX  (WS_PG   + (size_t)TOK * 2048 * 2)
#define WS_GW    (WS_EIDX + (size_t)TOK * 128 * 4)
#define WS_SSQ   (WS_GW   + (size_t)TOK * 128 * 4)
#define WS_XCC   (WS_SSQ  + (size_t)TOK * 4)
#define WS_BAR   (WS_XCC  + (size_t)4096)
#define WS_END   (WS_BAR  + (size_t)16384)

#define LDS_BYTES 155648

struct Params {
  const float* x; const float* norm_mix; const float* w_in; const float* hg_lb; const float* hg_norm;
  const float* ikg; const float* ikb; const float* rel_bias; const float* w_up_a; const float* w_up_b;
  const float* w_out; const float* norm_ffn; const float* peer_wq; const float* peer_keys;
  const float* peer_u; const float* peer_v; const float* norm_final;
  float* out; unsigned char* ws; int ph_lo, ph_hi;
};

__device__ __forceinline__ float bf2f(bf16_t u) { return __uint_as_float(((unsigned)u) << 16); }
__device__ __forceinline__ bf16_t f2bf(float f) {
  unsigned u = __float_as_uint(f);
  u += 0x7fffu + ((u >> 16) & 1u);
  return (bf16_t)(u >> 16);
}
__device__ __forceinline__ unsigned pack2(float a, float b) { return (unsigned)f2bf(a) | ((unsigned)f2bf(b) << 16); }
__device__ __forceinline__ float wave_sum(float v) {
#pragma unroll
  for (int o = 32; o > 0; o >>= 1) v += __shfl_xor(v, o);
  return v;
}
__device__ __forceinline__ void lds_fence() { asm volatile("s_waitcnt lgkmcnt(0)" ::: "memory"); }
__device__ __forceinline__ float sigmoidf_(float x) { return 1.f / (1.f + __expf(-x)); }
__device__ __forceinline__ float siluf_(float x) { return x / (1.f + __expf(-x)); }


#define XB_TMO      128
#define XB_XCNT(j)  (256  + 64 * (j))
#define XB_XSUB(j)  (1280 + 64 * (j))
#define XB_XGEN(j)  (2304 + 64 * (j))
#define XB_TOP      3328
#define XB_TOPGEN   3392
#define XCD_BAR_WORDS 3456
#define XB_SPIN_CAP (1u << 22)
#define LAS __attribute__((address_space(3)))
__device__ __forceinline__ unsigned xb_ld(unsigned* p)              { return __hip_atomic_load(p, __ATOMIC_RELAXED, __HIP_MEMORY_SCOPE_AGENT); }
__device__ __forceinline__ unsigned xb_add(unsigned* p, unsigned v) { return __hip_atomic_fetch_add(p, v, __ATOMIC_RELAXED, __HIP_MEMORY_SCOPE_AGENT); }
__device__ __forceinline__ unsigned xb_xcc_id() { return (unsigned)__builtin_amdgcn_s_getreg((3 << 11) | 20) & 0xFu; }
#define XB_SPIN(cond, bar) do { unsigned _sp = 0; while (cond) { __builtin_amdgcn_s_sleep(1); \
    if ((++_sp & 255u) == 0u) { if (xb_ld(&(bar)[XB_TMO])) break; if (_sp > XB_SPIN_CAP) { atomicAdd(&(bar)[XB_TMO], 1u); break; } } } } while (0)
struct XcdBarrier { unsigned* bar; unsigned x; volatile LAS unsigned* st; };
__device__ __forceinline__ XcdBarrier xcd_barrier_post(unsigned* bar, volatile LAS unsigned* st) {
  XcdBarrier b; b.bar = bar; b.x = xb_xcc_id(); b.st = st;
  if (threadIdx.x == 0) (void)xb_add(&bar[XB_XCNT(b.x)], 1u);
  return b;
}
__device__ __forceinline__ void xcd_barrier_complete(unsigned* bar, unsigned x, unsigned& nloc, unsigned& nx) {
  const unsigned G = gridDim.x * gridDim.y * gridDim.z;
  unsigned sum, cnt, mine, sp = 0u;
  for (;;) {
    sum = 0u; cnt = 0u; mine = 0u;
#pragma unroll
    for (unsigned j = 0; j < 16; ++j) { const unsigned c = xb_ld(&bar[XB_XCNT(j)]); sum += c; cnt += (c > 0u) ? 1u : 0u; mine = (j == x) ? c : mine; }
    if (sum == G) break;
    __builtin_amdgcn_s_sleep(1);
    if ((++sp & 255u) == 0u) { if (xb_ld(&bar[XB_TMO])) break; if (sp > XB_SPIN_CAP) { atomicAdd(&bar[XB_TMO], 1u); break; } }
  }
  nloc = mine > 0u ? mine : 1u; nx = cnt > 0u ? cnt : 1u;
}
__device__ __forceinline__ void xcd_barrier(const XcdBarrier& b) {
  asm volatile("s_waitcnt vmcnt(0)" ::: "memory");
  __syncthreads();
  if (threadIdx.x == 0) {
    unsigned* bar = b.bar;
    __builtin_amdgcn_s_waitcnt(0);
    unsigned nloc = b.st[0], nx = b.st[1];
    if (nloc == 0u) { xcd_barrier_complete(bar, b.x, nloc, nx); b.st[0] = nloc; b.st[1] = nx; }
    const unsigned old = xb_add(&bar[XB_XSUB(b.x)], 1u);
    const unsigned gen = old / nloc;
    if (old + 1u == (gen + 1u) * nloc) {
      __builtin_amdgcn_fence(__ATOMIC_RELEASE, "agent");
      asm volatile("s_waitcnt vmcnt(0)" ::: "memory");
      const unsigned og = xb_add(&bar[XB_TOP], 1u);
      const unsigned tg = og / nx;
      if (og + 1u == (tg + 1u) * nx) xb_add(&bar[XB_TOPGEN], 1u);
      else XB_SPIN(xb_ld(&bar[XB_TOPGEN]) == tg, bar);
      __builtin_amdgcn_fence(__ATOMIC_ACQUIRE, "agent");
      xb_add(&bar[XB_XGEN(b.x)], 1u);
      asm volatile("s_waitcnt vmcnt(0)" ::: "memory");
    } else {
      XB_SPIN(xb_ld(&bar[XB_XGEN(b.x)]) == gen, bar);
      __builtin_amdgcn_fence(__ATOMIC_ACQUIRE, "agent");
      asm volatile("s_waitcnt vmcnt(0)" ::: "memory");
    }
  }
  __syncthreads();
}

namespace pg8 {
#define PG8_LAS __attribute__((address_space(3)))
typedef unsigned short bf16_t;
typedef short bf16x8 __attribute__((ext_vector_type(8)));
typedef float f32x4 __attribute__((ext_vector_type(4)));
typedef unsigned u32x4 __attribute__((ext_vector_type(4)));
constexpr int BM = 256, BK = 64, HALF = 128, HTB = HALF * BK * 2  , STAGE_BYTES = 8 * HTB, NXCD = 8, WGM = 8;

__host__ __device__ __forceinline__ int lds_byte(int r, int c) { const int st = (r >> 4) * 2 + (c >> 5), rr = r & 15, cc = c & 31, ob = rr * 64 + cc * 2; return st * 1024 + (ob ^ (((ob >> 9) & 1) << 5)); }
__host__ __device__ __forceinline__ void stage_rc(int b, int& R, int& C) { const int st = b / 1024, sb = b % 1024, swz = sb ^ (((sb >> 9) & 1) << 5); R = (st >> 1) * 16 + swz / 64; C = (st & 1) * 32 + (swz % 64) / 2; }
__host__ __device__ __forceinline__ int perm32(int rho) { const int n = rho >> 4, i = rho & 15; return 8 * (i >> 2) + 4 * n + (i & 3); }

struct Unit { int pm, pn; };
struct Gemm { const bf16_t* A; const bf16_t* Bt; int M, N, K; };

struct StaticOrder {
    int nM, nN, nwg, G, c;
    __host__ __device__ void init(int M, int N, int G_, int c_) { nM = M / BM; nN = N / BM; nwg = nM * nN; G = G_; c = c_; }
    __host__ __device__ bool next(int i, Unit& u) const {
        const long L = (long)i * G + c; if (L >= nwg) return false;
        int wgid = (int)L; { const int q = nwg / NXCD, r = nwg % NXCD, xcd = wgid % NXCD, off = wgid / NXCD; wgid = (xcd < r ? xcd * (q + 1) : r * (q + 1) + (xcd - r) * q) + off; }
        const int nig = WGM * nN, gid = wgid / nig, fm = gid * WGM, gsz = (nM - fm) < WGM ? (nM - fm) : WGM;
        u.pm = fm + ((wgid % nig) % gsz); u.pn = (wgid % nig) / gsz; return true;
    }
    __device__ __forceinline__ void a_ready(const Unit&) const {}
    __device__ __forceinline__ void done(const Unit&) const {}
};
__device__ __forceinline__ unsigned cvt_pk_bf16(float lo, float hi) { unsigned r; asm volatile("v_cvt_pk_bf16_f32 %0, %1, %2" : "=v"(r) : "v"(lo), "v"(hi)); return r; }
template <class Epi, class Sched, bool STAMP = false>
__device__ __forceinline__ void gemm_phase(PG8_LAS unsigned char* lds, const Gemm g, const Sched& S, const Epi& E, unsigned long long* stamps) {
    const int tid = threadIdx.x, wid = __builtin_amdgcn_readfirstlane(tid >> 6), lane = tid & 63, wr = wid >> 2, wc = wid & 3, fr = lane & 15, fq = lane >> 4;
    const int K = g.K, nt = K / BK;
    int ts_lo = 0, ts_hi = 0, nts = 0; const unsigned long long rt_entry = STAMP ? (unsigned long long)wall_clock64() : 0ull;
#define PG8_STAMP() do { if (STAMP && wid == 0 && nts < 64) { const unsigned long long _c = (unsigned long long)clock64(); \
        ts_lo = (lane == nts) ? (int)(unsigned)_c : ts_lo; ts_hi = (lane == nts) ? (int)(unsigned)(_c >> 32) : ts_hi; ++nts; } } while (0)
    PG8_STAMP();
    unsigned voffA[2], voffB[2];
#pragma unroll
    for (int i = 0; i < 2; ++i) { int R, C; stage_rc(tid * 16 + i * 8192, R, C); const int Rb = Epi::PERM ? ((R & ~31) + perm32(R & 31)) : R;
        voffA[i] = (unsigned)(R * K + C) * 2u; voffB[i] = (unsigned)(Rb * K + C) * 2u; }
    const size_t kstep = (size_t)(BK * 2);
    const size_t hstep = (size_t)HALF * K * 2;
    const size_t tstep = 2 * hstep;
    const unsigned ldsw = (unsigned)wid * 1024u;
    const int aoff = lds_byte(wr * 64 + fr, fq * 8), boff = lds_byte(wc * 32 + fr, fq * 8);
#define PG8_SA(b, h) (((b) * 2 + (h)) * HTB)
#define PG8_SB(b, h) ((4 + (b) * 2 + (h)) * HTB)
#define PG8_STAGE(bufoff, gbase, voff) do { _Pragma("unroll") for (int _i = 0; _i < 2; ++_i) \
        __builtin_amdgcn_global_load_lds((const unsigned*)((const char*)(gbase) + (voff)[_i]), (PG8_LAS unsigned*)(lds + (bufoff) + ldsw + _i * 8192), 16, 0, 0); } while (0)
#define PG8_LDA(dst, b, h) do { _Pragma("unroll") for (int m = 0; m < 4; ++m) _Pragma("unroll") for (int k = 0; k < 2; ++k) dst[m][k] = *(const PG8_LAS bf16x8*)(lds + PG8_SA(b, h) + aoff + m * 2048 + k * 1024); } while (0)
#define PG8_LDB(dst, b, h) do { _Pragma("unroll") for (int n = 0; n < 2; ++n) _Pragma("unroll") for (int k = 0; k < 2; ++k) dst[n][k] = *(const PG8_LAS bf16x8*)(lds + PG8_SB(b, h) + boff + n * 2048 + k * 1024); } while (0)
#define PG8_MMA(ai, bj, At, Bt) do { __builtin_amdgcn_s_setprio(1); _Pragma("unroll") for (int m = 0; m < 4; ++m) _Pragma("unroll") for (int n = 0; n < 2; ++n) _Pragma("unroll") for (int k = 0; k < 2; ++k) \
        acc[ai][bj][m][n] = __builtin_amdgcn_mfma_f32_16x16x32_bf16(Bt[n][k], At[m][k], acc[ai][bj][m][n], 0, 0, 0); __builtin_amdgcn_s_setprio(0); } while (0)
#define PG8_WAIT_V(n) asm volatile("s_waitcnt vmcnt(" #n ")" ::: "memory")
#define PG8_WAIT_L(n) asm volatile("s_waitcnt lgkmcnt(" #n ")" ::: "memory")
#define PG8_BAR __builtin_amdgcn_s_barrier()
#define PG8_SCHED __builtin_amdgcn_sched_barrier(0)
    Unit cur, nxt; int ui = 0;
    if (!S.next(0, cur)) return;
    f32x4 acc[2][2][4][2];
#pragma unroll
    for (int a = 0; a < 2; ++a)
#pragma unroll
        for (int b = 0; b < 2; ++b)
#pragma unroll
            for (int m = 0; m < 4; ++m)
#pragma unroll
                for (int n = 0; n < 2; ++n) acc[a][b][m][n] = (f32x4){0.f, 0.f, 0.f, 0.f};
    bf16x8 At[4][2], B0[2][2], B1[2][2];
    const char* cA = (const char*)g.A + (size_t)cur.pm * tstep; const char* cB = (const char*)g.Bt + (size_t)cur.pn * tstep;
    S.a_ready(cur);
    PG8_STAGE(PG8_SB(0, 0), cB, voffB); PG8_STAGE(PG8_SA(0, 0), cA, voffA); PG8_STAGE(PG8_SB(0, 1), cB + hstep, voffB); PG8_STAGE(PG8_SA(0, 1), cA + hstep, voffA);
    if (wr == 1) PG8_BAR;
    PG8_WAIT_V(4); PG8_BAR;
    PG8_STAGE(PG8_SB(1, 0), cB + kstep, voffB); PG8_STAGE(PG8_SA(1, 0), cA + kstep, voffA); PG8_STAGE(PG8_SB(1, 1), cB + hstep + kstep, voffB);
    PG8_WAIT_V(6); PG8_BAR;
    PG8_STAMP();
    for (;;) {
        const bool has_next = S.next(ui + 1, nxt);
        const char* nA = has_next ? (const char*)g.A + (size_t)nxt.pm * tstep : cA; const char* nB = has_next ? (const char*)g.Bt + (size_t)nxt.pn * tstep : cB;
        for (int t = 0; t < nt; t += 2) {
            const bool last = (t == nt - 2);
            const char* a1 = cA + (size_t)(t + 1) * kstep;
            const char* a2 = last ? nA : cA + (size_t)(t + 2) * kstep; const char* b2 = last ? nB : cB + (size_t)(t + 2) * kstep;
            const char* a3 = a2 + kstep; const char* b3 = b2 + kstep;
            if (last && has_next) S.a_ready(nxt);
            PG8_LDB(B0, 0, 0); PG8_SCHED; PG8_LDA(At, 0, 0); PG8_STAGE(PG8_SA(1, 1), a1 + hstep, voffA);
            PG8_WAIT_L(8); PG8_BAR; PG8_WAIT_L(0); PG8_MMA(0, 0, At, B0); PG8_BAR; PG8_SCHED;
            PG8_LDB(B1, 0, 1); PG8_STAGE(PG8_SB(0, 0), b2, voffB);
            PG8_BAR; PG8_WAIT_L(0); PG8_MMA(0, 1, At, B1); PG8_BAR;
            PG8_LDA(At, 0, 1); PG8_STAGE(PG8_SA(0, 0), a2, voffA);
            PG8_BAR; PG8_WAIT_L(0); PG8_MMA(1, 0, At, B0); PG8_BAR; PG8_SCHED;
            PG8_STAGE(PG8_SB(0, 1), b2 + hstep, voffB);
            PG8_WAIT_V(6); PG8_BAR; PG8_MMA(1, 1, At, B1); PG8_BAR;
            PG8_LDB(B0, 1, 0); PG8_SCHED; PG8_LDA(At, 1, 0); PG8_STAGE(PG8_SA(0, 1), a2 + hstep, voffA);
            PG8_WAIT_L(8); PG8_BAR; PG8_WAIT_L(0); PG8_MMA(0, 0, At, B0); PG8_BAR; PG8_SCHED;
            PG8_LDB(B1, 1, 1); PG8_STAGE(PG8_SB(1, 0), b3, voffB);
            PG8_BAR; PG8_WAIT_L(0); PG8_MMA(0, 1, At, B1); PG8_BAR;
            PG8_LDA(At, 1, 1); PG8_STAGE(PG8_SA(1, 0), a3, voffA);
            PG8_BAR; PG8_WAIT_L(0); PG8_MMA(1, 0, At, B0); PG8_BAR; PG8_SCHED;
            PG8_STAGE(PG8_SB(1, 1), b3 + hstep, voffB);
            PG8_WAIT_V(6); PG8_BAR; PG8_MMA(1, 1, At, B1); PG8_BAR;
        }
        PG8_STAMP();
        if constexpr (!Epi::AFTER_DRAIN) { E(acc, cur, wr, wc, fr, fq); S.done(cur); }
        PG8_STAMP();
        if (!has_next) break;
#pragma unroll
        for (int a = 0; a < 2; ++a)
#pragma unroll
            for (int b = 0; b < 2; ++b)
#pragma unroll
                for (int m = 0; m < 4; ++m)
#pragma unroll
                    for (int n = 0; n < 2; ++n) acc[a][b][m][n] = (f32x4){0.f, 0.f, 0.f, 0.f};
        cur = nxt; cA = nA; cB = nB; ++ui;
    }
    PG8_WAIT_V(0);
    if (wr == 0) PG8_BAR;
    PG8_BAR;
    if constexpr (Epi::AFTER_DRAIN) { E.fused(acc, cur, wr, wc, fr, fq, lds, wid, lane); S.done(cur); }
    PG8_STAMP();
    if (STAMP && wid == 0) { stamps[lane] = lane < nts ? (((unsigned long long)(unsigned)ts_hi << 32) | (unsigned)ts_lo) : 0ull;
        if (lane == 62) stamps[62] = rt_entry; if (lane == 63) stamps[63] = (unsigned long long)wall_clock64(); }
#undef PG8_STAMP
#undef PG8_SA
#undef PG8_SB
#undef PG8_STAGE
#undef PG8_LDA
#undef PG8_LDB
#undef PG8_MMA
#undef PG8_WAIT_V
#undef PG8_WAIT_L
#undef PG8_BAR
#undef PG8_SCHED
}
}

struct EpiProj {
  static constexpr bool PERM = true, AFTER_DRAIN = false;
  unsigned short* pH; unsigned short* pA; unsigned short* pG;
  __device__ __forceinline__ void operator()(const pg8::f32x4 (&acc)[2][2][4][2], const pg8::Unit& u, int wr, int wc, int fr, int fq) const {
    const int row0 = u.pm * 256 + wr * 64 + fr;
    unsigned short* base; int ldc, colt; bool sg = false;
    if (u.pn < 8) { base = pH; ldc = 2048; colt = u.pn * 256; }
    else if (u.pn < 12) { base = pA; ldc = 1024; colt = (u.pn - 8) * 256; }
    else { base = pG; ldc = 2048; colt = (u.pn - 12) * 256; sg = true; }
    const int col0 = colt + wc * 32 + 8 * fq;
#pragma unroll
    for (int ai = 0; ai < 2; ++ai)
#pragma unroll
      for (int m = 0; m < 4; ++m) {
        unsigned short* rowp = base + (size_t)(row0 + ai * 128 + m * 16) * ldc + col0;
#pragma unroll
        for (int bj = 0; bj < 2; ++bj) {
          pg8::f32x4 v0 = acc[ai][bj][m][0], v1 = acc[ai][bj][m][1];
          if (sg) {
#pragma unroll
            for (int j = 0; j < 4; ++j) { v0[j] = sigmoidf_(v0[j]); v1[j] = sigmoidf_(v1[j]); }
          }
          pg8::u32x4 w; w.x = pg8::cvt_pk_bf16(v0[0], v0[1]); w.y = pg8::cvt_pk_bf16(v0[2], v0[3]); w.z = pg8::cvt_pk_bf16(v1[0], v1[1]); w.w = pg8::cvt_pk_bf16(v1[2], v1[3]);
          *(pg8::u32x4*)(rowp + bj * 128) = w;
        }
      }
  }
};
template <int MODE> struct EpiGate {
  static constexpr bool PERM = true, AFTER_DRAIN = false;
  unsigned short* hb; const unsigned short* pG; int goff;
  __device__ __forceinline__ void operator()(const pg8::f32x4 (&acc)[2][2][4][2], const pg8::Unit& u, int wr, int wc, int fr, int fq) const {
    const int row0 = u.pm * 256 + wr * 64 + fr;
    const int col0 = u.pn * 256 + wc * 32 + 8 * fq;
#pragma unroll
    for (int ai = 0; ai < 2; ++ai)
#pragma unroll
      for (int m = 0; m < 4; ++m) {
        const size_t r = (size_t)(row0 + ai * 128 + m * 16);
        pg8::u32x4 gv[2], hv[2];
#pragma unroll
        for (int bj = 0; bj < 2; ++bj) {
          gv[bj] = *(const pg8::u32x4*)(pG + r * 2048 + goff + col0 + bj * 128);
          if (MODE == 1) hv[bj] = *(const pg8::u32x4*)(hb + r * 1024 + col0 + bj * 128);
        }
#pragma unroll
        for (int bj = 0; bj < 2; ++bj) {
          float o[8];
#pragma unroll
          for (int j = 0; j < 4; ++j) {
            const unsigned gw0 = gv[bj][j >> 1], gw1 = gv[bj][2 + (j >> 1)];
            const float g0 = (j & 1) ? __uint_as_float(gw0 & 0xffff0000u) : __uint_as_float(gw0 << 16);
            const float g1 = (j & 1) ? __uint_as_float(gw1 & 0xffff0000u) : __uint_as_float(gw1 << 16);
            o[j] = acc[ai][bj][m][0][j] * g0; o[4 + j] = acc[ai][bj][m][1][j] * g1;
            if (MODE == 1) {
              const unsigned hw0 = hv[bj][j >> 1], hw1 = hv[bj][2 + (j >> 1)];
              o[j] += (j & 1) ? __uint_as_float(hw0 & 0xffff0000u) : __uint_as_float(hw0 << 16);
              o[4 + j] += (j & 1) ? __uint_as_float(hw1 & 0xffff0000u) : __uint_as_float(hw1 << 16);
            }
          }
          pg8::u32x4 w; w.x = pg8::cvt_pk_bf16(o[0], o[1]); w.y = pg8::cvt_pk_bf16(o[2], o[3]); w.z = pg8::cvt_pk_bf16(o[4], o[5]); w.w = pg8::cvt_pk_bf16(o[6], o[7]);
          *(pg8::u32x4*)(hb + r * 1024 + col0 + bj * 128) = w;
        }
      }
  }
};
struct EpiResid {
  static constexpr bool PERM = false, AFTER_DRAIN = false;
  float* out; const float* x;
  __device__ __forceinline__ void operator()(const pg8::f32x4 (&acc)[2][2][4][2], const pg8::Unit& u, int wr, int wc, int fr, int fq) const {
    const int row0 = u.pm * 256 + wr * 64 + fr, col0 = u.pn * 256 + wc * 32 + 4 * fq;
#pragma unroll
    for (int ai = 0; ai < 2; ++ai)
#pragma unroll
      for (int m = 0; m < 4; ++m) {
        const size_t off = (size_t)(row0 + ai * 128 + m * 16) * 1024 + col0;
        pg8::f32x4 xv[2][2];
#pragma unroll
        for (int bj = 0; bj < 2; ++bj)
#pragma unroll
          for (int n = 0; n < 2; ++n) xv[bj][n] = *(const pg8::f32x4*)(x + off + bj * 128 + n * 16);
#pragma unroll
        for (int bj = 0; bj < 2; ++bj)
#pragma unroll
          for (int n = 0; n < 2; ++n) *(pg8::f32x4*)(out + off + bj * 128 + n * 16) = acc[ai][bj][m][n] + xv[bj][n];
      }
  }
};
struct EpiStoreBf16 {
  static constexpr bool PERM = true, AFTER_DRAIN = false;
  unsigned short* O; int ldc;
  __device__ __forceinline__ void operator()(const pg8::f32x4 (&acc)[2][2][4][2], const pg8::Unit& u, int wr, int wc, int fr, int fq) const {
    const int row0 = u.pm * 256 + wr * 64 + fr, col0 = u.pn * 256 + wc * 32 + 8 * fq;
#pragma unroll
    for (int ai = 0; ai < 2; ++ai)
#pragma unroll
      for (int m = 0; m < 4; ++m) {
        unsigned short* rowp = O + (size_t)(row0 + ai * 128 + m * 16) * ldc + col0;
#pragma unroll
        for (int bj = 0; bj < 2; ++bj) {
          const pg8::f32x4 v0 = acc[ai][bj][m][0], v1 = acc[ai][bj][m][1];
          pg8::u32x4 w; w.x = pg8::cvt_pk_bf16(v0[0], v0[1]); w.y = pg8::cvt_pk_bf16(v0[2], v0[3]); w.z = pg8::cvt_pk_bf16(v1[0], v1[1]); w.w = pg8::cvt_pk_bf16(v1[2], v1[3]);
          *(pg8::u32x4*)(rowp + bj * 128) = w;
        }
      }
  }
};

__device__ __forceinline__ void gemm_tile(const bf16_t* __restrict__ A, int lda, const bf16_t* __restrict__ Bt, int ldb,
                                          int nk, f32x4 (&acc)[4][4], unsigned char* smem) {
  const int tid = threadIdx.x, lane = tid & 63, w = tid >> 6, wm = w >> 1, wn = w & 1, l15 = lane & 15, g = lane >> 4;
  unsigned char* sA = smem;
  unsigned char* sB = smem + 32768;
  const int lr = tid >> 3, lc = tid & 7;
  const bf16_t* ga = A + (size_t)lr * lda + lc * 8;
  const bf16_t* gb = Bt + (size_t)lr * ldb + lc * 8;
  uint4 ra0, ra1, ra2, ra3, rb0, rb1;
  ra0 = *(const uint4*)(ga);
  ra1 = *(const uint4*)(ga + (size_t)64 * lda);
  ra2 = *(const uint4*)(ga + (size_t)128 * lda);
  ra3 = *(const uint4*)(ga + (size_t)192 * lda);
  rb0 = *(const uint4*)(gb);
  rb1 = *(const uint4*)(gb + (size_t)64 * ldb);
  const int sw = (lc ^ (lr & 7)) << 4;
  for (int kt = 0; kt < nk; ++kt) {
    __syncthreads();
    *(uint4*)(sA + (lr) * 128 + sw) = ra0;
    *(uint4*)(sA + (lr + 64) * 128 + sw) = ra1;
    *(uint4*)(sA + (lr + 128) * 128 + sw) = ra2;
    *(uint4*)(sA + (lr + 192) * 128 + sw) = ra3;
    *(uint4*)(sB + (lr) * 128 + sw) = rb0;
    *(uint4*)(sB + (lr + 64) * 128 + sw) = rb1;
    __syncthreads();
    if (kt + 1 < nk) {
      const int ko = (kt + 1) * 64;
      ra0 = *(const uint4*)(ga + ko);
      ra1 = *(const uint4*)(ga + (size_t)64 * lda + ko);
      ra2 = *(const uint4*)(ga + (size_t)128 * lda + ko);
      ra3 = *(const uint4*)(ga + (size_t)192 * lda + ko);
      rb0 = *(const uint4*)(gb + ko);
      rb1 = *(const uint4*)(gb + (size_t)64 * ldb + ko);
    }
#pragma unroll
    for (int ks = 0; ks < 2; ++ks) {
      bf16x8 a[4], b[4];
#pragma unroll
      for (int m = 0; m < 4; ++m) { const int r = wm * 64 + m * 16 + l15; a[m] = *(const bf16x8*)(sA + r * 128 + (((ks * 4 + g) ^ (r & 7)) << 4)); }
#pragma unroll
      for (int n = 0; n < 4; ++n) { const int r = wn * 64 + n * 16 + l15; b[n] = *(const bf16x8*)(sB + r * 128 + (((ks * 4 + g) ^ (r & 7)) << 4)); }
#pragma unroll
      for (int m = 0; m < 4; ++m)
#pragma unroll
        for (int n = 0; n < 4; ++n) acc[m][n] = __builtin_amdgcn_mfma_f32_16x16x32_bf16(a[m], b[n], acc[m][n], 0, 0, 0);
    }
  }
}

__device__ __forceinline__ void zero_acc(f32x4 (&acc)[4][4]) {
#pragma unroll
  for (int m = 0; m < 4; ++m)
#pragma unroll
    for (int n = 0; n < 4; ++n) acc[m][n] = (f32x4){0.f, 0.f, 0.f, 0.f};
}

__device__ __forceinline__ void transpose_tile(const float* __restrict__ src, int srcN, bf16_t* __restrict__ dst, int K, int n0, int k0,
                                               bool winmap, float* tile) {
  const int tid = threadIdx.x;
  const int nc = tid & 63, kr = tid >> 6;
  int ncol = n0 + nc; bool valid = true;
  if (winmap) { if (ncol >= 3072) ncol -= 60; else if (ncol >= 3012) valid = false; }
#pragma unroll
  for (int i = 0; i < 8; ++i) {
    const int k = kr + 8 * i;
    tile[k * 65 + nc] = valid ? src[(size_t)(k0 + k) * srcN + ncol] : 0.f;
  }
  __syncthreads();
#pragma unroll
  for (int i = 0; i < 8; ++i) {
    const int nr = kr + 8 * i;
    dst[(size_t)(n0 + nr) * K + k0 + nc] = f2bf(tile[nc * 65 + nr]);
  }
  __syncthreads();
}

__device__ __forceinline__ void convert_f32_bf16(const float* __restrict__ src, bf16_t* __restrict__ dst, size_t n4) {
  for (size_t i = (size_t)blockIdx.x * NTHREADS + threadIdx.x; i < n4; i += (size_t)gridDim.x * NTHREADS) {
    const float4 v = ((const float4*)src)[i];
    uint2 o; o.x = pack2(v.x, v.y); o.y = pack2(v.z, v.w);
    ((uint2*)dst)[i] = o;
  }
}

__device__ __forceinline__ void quantize_rows_u8(const float* __restrict__ src, unsigned char* __restrict__ dst, float* __restrict__ scale) {
  const int lane = threadIdx.x & 63, w = threadIdx.x >> 6;
  for (int row = blockIdx.x * 8 + w; row < 16384; row += gridDim.x * 8) {
    const float4* s4 = (const float4*)(src + (size_t)row * 1024) + lane * 4;
    float4 v[4];
    float am = 0.f;
#pragma unroll
    for (int i = 0; i < 4; ++i) { v[i] = s4[i]; am = fmaxf(am, fmaxf(fmaxf(fabsf(v[i].x), fabsf(v[i].y)), fmaxf(fabsf(v[i].z), fabsf(v[i].w)))); }
#pragma unroll
    for (int o = 32; o > 0; o >>= 1) am = fmaxf(am, __shfl_xor(am, o));
    const float inv = am > 0.f ? 127.f / am : 0.f;
    unsigned pk[4];
#pragma unroll
    for (int i = 0; i < 4; ++i) {
      const unsigned b0 = (unsigned)((int)rintf(v[i].x * inv) + 128), b1 = (unsigned)((int)rintf(v[i].y * inv) + 128);
      const unsigned b2 = (unsigned)((int)rintf(v[i].z * inv) + 128), b3 = (unsigned)((int)rintf(v[i].w * inv) + 128);
      pk[i] = (b0 & 255u) | ((b1 & 255u) << 8) | ((b2 & 255u) << 16) | ((b3 & 255u) << 24);
    }
    *(uint4*)(dst + (size_t)row * 1024 + lane * 16) = make_uint4(pk[0], pk[1], pk[2], pk[3]);
    if (lane == 0) scale[row] = am * (1.f / 127.f);
  }
}

__device__ __forceinline__ void rmsnorm_rows(const float* __restrict__ src, const float* __restrict__ g, bf16_t* __restrict__ dst) {
  const int lane = threadIdx.x & 63, w = threadIdx.x >> 6;
  for (int row = blockIdx.x * 8 + w; row < TOK; row += gridDim.x * 8) {
    const float4* s4 = (const float4*)(src + (size_t)row * DM);
    float4 v[4]; float ss = 0.f;
#pragma unroll
    for (int i = 0; i < 4; ++i) { v[i] = s4[lane + 64 * i]; ss += v[i].x * v[i].x + v[i].y * v[i].y + v[i].z * v[i].z + v[i].w * v[i].w; }
    ss = wave_sum(ss);
    const float rstd = rsqrtf(ss * (1.f / DM) + EPSV);
#pragma unroll
    for (int i = 0; i < 4; ++i) {
      const float4 gg = ((const float4*)g)[lane + 64 * i];
      uint2 o; o.x = pack2(v[i].x * rstd * gg.x, v[i].y * rstd * gg.y); o.y = pack2(v[i].z * rstd * gg.z, v[i].w * rstd * gg.w);
      ((uint2*)(dst + (size_t)row * DM))[lane + 64 * i] = o;
    }
  }
}

__device__ __forceinline__ void phase_prep(const Params& p, unsigned char* smem) {
  unsigned char* ws = p.ws;
  float* tile = (float*)smem;
  const int n_win = 80 * 16, n_ua = 16 * 8, n_ub = 16 * 8, n_wo = 16 * 16, n_wq = 32 * 16;
  const int total = n_win + n_ua + n_ub + n_wo + n_wq;
  for (int it = blockIdx.x; it < total; it += gridDim.x) {
    int t = it;
    if (t < n_win) { transpose_tile(p.w_in, 5060, (bf16_t*)(ws + WS_WIN), 1024, (t >> 4) * 64, (t & 15) * 64, true, tile); continue; }
    t -= n_win;
    if (t < n_ua) { transpose_tile(p.w_up_a, 1024, (bf16_t*)(ws + WS_WUPA), 512, (t >> 3) * 64, (t & 7) * 64, false, tile); continue; }
    t -= n_ua;
    if (t < n_ub) { transpose_tile(p.w_up_b, 1024, (bf16_t*)(ws + WS_WUPB), 512, (t >> 3) * 64, (t & 7) * 64, false, tile); continue; }
    t -= n_ub;
    if (t < n_wo) { transpose_tile(p.w_out, 1024, (bf16_t*)(ws + WS_WOUT), 1024, (t >> 4) * 64, (t & 15) * 64, false, tile); continue; }
    t -= n_wo;
    transpose_tile(p.peer_wq, 2048, (bf16_t*)(ws + WS_WQ), 1024, (t >> 4) * 64, (t & 15) * 64, false, tile);
  }
  quantize_rows_u8(p.peer_u, ws + WS_U, (float*)(ws + WS_U + (size_t)16384 * 1024));
  quantize_rows_u8(p.peer_v, ws + WS_V, (float*)(ws + WS_V + (size_t)16384 * 1024));
  convert_f32_bf16(p.peer_keys, (bf16_t*)(ws + WS_KEYS), (size_t)2 * 8 * 128 * 128 / 4);
  for (int i = blockIdx.x * NTHREADS + threadIdx.x; i < TOK; i += gridDim.x * NTHREADS) ((float*)(ws + WS_SSQ))[i] = 0.f;
  if (threadIdx.x == 0) ((int*)(ws + WS_XCC))[blockIdx.x] = (int)(__builtin_amdgcn_s_getreg((3 << 11) | 20) & 0xFu);
  if (blockIdx.x == 0) {
    const int i = threadIdx.x;
    const float a0 = p.hg_lb[i], a1 = p.hg_lb[512 + i];
    ((float*)(ws + WS_LB))[i] = 1.f / (1.f + expf(a1 - a0));
  }
  rmsnorm_rows(p.x, p.norm_mix, (bf16_t*)(ws + WS_XN));
}

__device__ __forceinline__ void phase_proj(const Params& p, unsigned char* smem) {
  unsigned char* ws = p.ws;
  const bf16_t* xn = (const bf16_t*)(ws + WS_XN);
  const bf16_t* wt = (const bf16_t*)(ws + WS_WIN);
  bf16_t* pH = (bf16_t*)(ws + WS_PH);
  bf16_t* pA = (bf16_t*)(ws + WS_PA);
  bf16_t* pG = (bf16_t*)(ws + WS_PG);
  const int tid = threadIdx.x, lane = tid & 63, w = tid >> 6, wm = w >> 1, wn = w & 1, l15 = lane & 15, g = lane >> 4;
  for (int tile = blockIdx.x; tile < 128 * 40; tile += gridDim.x) {
    const int tn = tile % 40, tm = tile / 40;
    f32x4 acc[4][4]; zero_acc(acc);
    gemm_tile(xn + (size_t)tm * 256 * 1024, 1024, wt + (size_t)tn * 128 * 1024, 1024, 16, acc, smem);
    const int rbase = tm * 256 + wm * 64 + 4 * g;
    const int cbase = tn * 128 + wn * 64 + l15;
    if (tn < 16) {
#pragma unroll
      for (int m = 0; m < 4; ++m)
#pragma unroll
        for (int n = 0; n < 4; ++n)
#pragma unroll
          for (int j = 0; j < 4; ++j) pH[(size_t)(rbase + m * 16 + j) * 2048 + cbase + n * 16] = f2bf(acc[m][n][j]);
    } else if (tn < 24) {
      if (tn == 23 && wn == 0) {
        float gam[4], bet[4];
#pragma unroll
        for (int n = 0; n < 4; ++n) { gam[n] = p.ikg[n * 16 + l15]; bet[n] = p.ikb[n * 16 + l15]; }
#pragma unroll
        for (int m = 0; m < 4; ++m)
#pragma unroll
          for (int j = 0; j < 4; ++j) {
            float s = acc[m][0][j] + acc[m][1][j] + acc[m][2][j] + acc[m][3][j];
            s += __shfl_xor(s, 1); s += __shfl_xor(s, 2); s += __shfl_xor(s, 4); s += __shfl_xor(s, 8);
            const float mu = s * (1.f / 64.f);
            float q = 0.f;
#pragma unroll
            for (int n = 0; n < 4; ++n) { const float d = acc[m][n][j] - mu; q += d * d; }
            q += __shfl_xor(q, 1); q += __shfl_xor(q, 2); q += __shfl_xor(q, 4); q += __shfl_xor(q, 8);
            const float rstd = rsqrtf(q * (1.f / 64.f) + EPSV);
#pragma unroll
            for (int n = 0; n < 4; ++n)
              pA[(size_t)(rbase + m * 16 + j) * 1024 + (cbase - 2048) + n * 16] = f2bf((acc[m][n][j] - mu) * rstd * gam[n] + bet[n]);
          }
      } else {
#pragma unroll
        for (int m = 0; m < 4; ++m)
#pragma unroll
          for (int n = 0; n < 4; ++n)
#pragma unroll
            for (int j = 0; j < 4; ++j) pA[(size_t)(rbase + m * 16 + j) * 1024 + (cbase - 2048) + n * 16] = f2bf(acc[m][n][j]);
      }
    } else {
#pragma unroll
      for (int m = 0; m < 4; ++m)
#pragma unroll
        for (int n = 0; n < 4; ++n)
#pragma unroll
          for (int j = 0; j < 4; ++j) pG[(size_t)(rbase + m * 16 + j) * 2048 + (cbase - 3072) + n * 16] = f2bf(sigmoidf_(acc[m][n][j]));
    }
  }
}

__device__ __forceinline__ void hgrn_item(const Params& p, unsigned char* smem, int bh) {
  unsigned char* ws = p.ws;
  const bf16_t* pH = (const bf16_t*)(ws + WS_PH);
  const float* lbp = (const float*)(ws + WS_LB);
  bf16_t* ya = (bf16_t*)(ws + WS_XN);
  bf16_t* Qt = (bf16_t*)smem;
  bf16_t* Kt = Qt + 64 * 136;
  bf16_t* KtT = Kt + 64 * 136;
  bf16_t* VT = KtT + 128 * 72;
  bf16_t* Am = VT + 128 * 72;
  bf16_t* ST = Am + 64 * 72;
  float* qtot = (float*)(ST + 128 * 136);
  float* eref = qtot + 512;
  float* elast = eref + 128;
  float* elr = elast + 128;
  float* red = elr + 128;
  const int tid = threadIdx.x, lane = tid & 63, w = tid >> 6, l15 = lane & 15, g = lane >> 4;
  const int b = bh >> 2, h = bh & 3;
  const int d = tid & 127, tq = tid >> 7;
  const float lbv = lbp[h * 128 + d];
  f32x4 S[8];
#pragma unroll
  for (int i = 0; i < 8; ++i) S[i] = (f32x4){0.f, 0.f, 0.f, 0.f};
  const float gnv = p.hg_norm[h * 128 + 16 * w + l15];

  for (int chunk = 0; chunk < 64; ++chunk) {
    const size_t row0 = (size_t)b * SEQL + chunk * 64;
    {
      const bf16_t* base = pH + (row0 + tq * 16) * 2048 + h * 128 + d;
      float lf[16], kk[16], qs[16];
      unsigned vv[8];
      float run = 0.f;
#pragma unroll
      for (int i = 0; i < 16; ++i) {
        const float fr = bf2f(base[(size_t)i * 2048 + 512]);
        const float qr = bf2f(base[(size_t)i * 2048]);
        const float sg = sigmoidf_(fr);
        const float fg = lbv + (1.f - lbv) * sg;
        run += __logf(fg);
        lf[i] = run; kk[i] = 1.f - fg; qs[i] = siluf_(qr);
      }
#pragma unroll
      for (int i = 0; i < 8; ++i) {
        const unsigned lo = base[(size_t)(2 * i) * 2048 + 1024], hi = base[(size_t)(2 * i + 1) * 2048 + 1024];
        vv[i] = lo | (hi << 16);
      }
      qtot[tq * 128 + d] = run;
      __syncthreads();
      const float q0 = qtot[d], q1 = qtot[128 + d], q2 = qtot[256 + d], q3 = qtot[384 + d];
      const float pre = (tq > 0 ? q0 : 0.f) + (tq > 1 ? q1 : 0.f) + (tq > 2 ? q2 : 0.f);
      const float bref = q0 + q1;
      const float blast = bref + q2 + q3;
      unsigned kp[8];
#pragma unroll
      for (int i = 0; i < 16; ++i) {
        const float bt = pre + lf[i];
        const float qt = qs[i] * __expf(bt - bref);
        const float kt = kk[i] * __expf(bref - bt);
        const int t = tq * 16 + i;
        Qt[t * 136 + d] = f2bf(qt);
        const bf16_t kb = f2bf(kt);
        Kt[t * 136 + d] = kb;
        if (i & 1) kp[i >> 1] |= ((unsigned)kb) << 16; else kp[i >> 1] = kb;
      }
      *(uint4*)(KtT + d * 72 + tq * 16) = make_uint4(kp[0], kp[1], kp[2], kp[3]);
      *(uint4*)(KtT + d * 72 + tq * 16 + 8) = make_uint4(kp[4], kp[5], kp[6], kp[7]);
      *(uint4*)(VT + d * 72 + tq * 16) = make_uint4(vv[0], vv[1], vv[2], vv[3]);
      *(uint4*)(VT + d * 72 + tq * 16 + 8) = make_uint4(vv[4], vv[5], vv[6], vv[7]);
      if (tq == 0) { eref[d] = __expf(bref); elast[d] = __expf(blast); elr[d] = __expf(blast - bref); }
    }
    __syncthreads();
    bf16_t ogr[16];
#pragma unroll
    for (int tm = 0; tm < 4; ++tm)
#pragma unroll
      for (int j = 0; j < 4; ++j) ogr[tm * 4 + j] = pH[(row0 + tm * 16 + 4 * g + j) * 2048 + 1536 + h * 128 + 16 * w + l15];
    {
      const int e = 16 * w + l15;
#pragma unroll
      for (int dm = 0; dm < 8; ++dm) {
        const int d0 = 16 * dm + 4 * g;
        uint2 o;
        o.x = pack2(S[dm][0] * eref[d0], S[dm][1] * eref[d0 + 1]);
        o.y = pack2(S[dm][2] * eref[d0 + 2], S[dm][3] * eref[d0 + 3]);
        *(uint2*)(ST + e * 136 + d0) = o;
      }
#pragma unroll
      for (int tt = 0; tt < 2; ++tt) {
        const int tl = 2 * w + tt, sm = tl >> 2, tn = tl & 3;
        f32x4 acc = (f32x4){0.f, 0.f, 0.f, 0.f};
        if (tn >= sm) {
#pragma unroll
          for (int k0 = 0; k0 < 128; k0 += 32) {
            const bf16x8 a = *(const bf16x8*)(Kt + (sm * 16 + l15) * 136 + k0 + 8 * g);
            const bf16x8 bq = *(const bf16x8*)(Qt + (tn * 16 + l15) * 136 + k0 + 8 * g);
            acc = __builtin_amdgcn_mfma_f32_16x16x32_bf16(a, bq, acc, 0, 0, 0);
          }
        }
        const int t = tn * 16 + l15, s0 = sm * 16 + 4 * g;
        uint2 o;
        o.x = pack2(s0 + 0 <= t ? acc[0] : 0.f, s0 + 1 <= t ? acc[1] : 0.f);
        o.y = pack2(s0 + 2 <= t ? acc[2] : 0.f, s0 + 3 <= t ? acc[3] : 0.f);
        *(uint2*)(Am + t * 72 + s0) = o;
      }
    }
    __syncthreads();
    f32x4 o[4];
    {
#pragma unroll
      for (int tm = 0; tm < 4; ++tm) {
        f32x4 acc = (f32x4){0.f, 0.f, 0.f, 0.f};
#pragma unroll
        for (int k0 = 0; k0 < 128; k0 += 32) {
          const bf16x8 a = *(const bf16x8*)(Qt + (tm * 16 + l15) * 136 + k0 + 8 * g);
          const bf16x8 bb = *(const bf16x8*)(ST + (16 * w + l15) * 136 + k0 + 8 * g);
          acc = __builtin_amdgcn_mfma_f32_16x16x32_bf16(a, bb, acc, 0, 0, 0);
        }
#pragma unroll
        for (int k0 = 0; k0 < 64; k0 += 32) {
          const bf16x8 a = *(const bf16x8*)(Am + (tm * 16 + l15) * 72 + k0 + 8 * g);
          const bf16x8 bb = *(const bf16x8*)(VT + (16 * w + l15) * 72 + k0 + 8 * g);
          acc = __builtin_amdgcn_mfma_f32_16x16x32_bf16(a, bb, acc, 0, 0, 0);
        }
        o[tm] = acc;
#pragma unroll
        for (int j = 0; j < 4; ++j) {
          float ss = acc[j] * acc[j];
          ss += __shfl_xor(ss, 1); ss += __shfl_xor(ss, 2); ss += __shfl_xor(ss, 4); ss += __shfl_xor(ss, 8);
          if (l15 == 0) red[w * 64 + tm * 16 + 4 * g + j] = ss;
        }
      }
#pragma unroll
      for (int dm = 0; dm < 8; ++dm) {
        f32x4 acc = (f32x4){0.f, 0.f, 0.f, 0.f};
#pragma unroll
        for (int k0 = 0; k0 < 64; k0 += 32) {
          const bf16x8 a = *(const bf16x8*)(KtT + (dm * 16 + l15) * 72 + k0 + 8 * g);
          const bf16x8 bb = *(const bf16x8*)(VT + (16 * w + l15) * 72 + k0 + 8 * g);
          acc = __builtin_amdgcn_mfma_f32_16x16x32_bf16(a, bb, acc, 0, 0, 0);
        }
#pragma unroll
        for (int j = 0; j < 4; ++j) { const int dd = 16 * dm + 4 * g + j; S[dm][j] = elast[dd] * S[dm][j] + elr[dd] * acc[j]; }
      }
    }
    __syncthreads();
    {
      const int e = 16 * w + l15;
#pragma unroll
      for (int tm = 0; tm < 4; ++tm)
#pragma unroll
        for (int j = 0; j < 4; ++j) {
          const int t = tm * 16 + 4 * g + j;
          float tot = 0.f;
#pragma unroll
          for (int ww = 0; ww < 8; ++ww) tot += red[ww * 64 + t];
          const float rstd = rsqrtf(tot * (1.f / 128.f) + EPSV);
          const float og = bf2f(ogr[tm * 4 + j]);
          ya[(row0 + t) * 512 + h * 128 + e] = f2bf(o[tm][j] * rstd * gnv * siluf_(og));
        }
    }
  }
}

#define SCW 4100
#ifndef DSA_REP
#define DSA_REP 0
#endif
#define DSA_BKT_OFF (8 * SCW * 4 + 8 * 256 * 4 + 8 * 256 * 2 + 8 * 512 * 2)
__device__ __forceinline__ void cvt8(const uint4& v, float* f) {
  f[0] = __uint_as_float(v.x << 16); f[1] = __uint_as_float(v.x & 0xffff0000u);
  f[2] = __uint_as_float(v.y << 16); f[3] = __uint_as_float(v.y & 0xffff0000u);
  f[4] = __uint_as_float(v.z << 16); f[5] = __uint_as_float(v.z & 0xffff0000u);
  f[6] = __uint_as_float(v.w << 16); f[7] = __uint_as_float(v.w & 0xffff0000u);
}
__device__ __forceinline__ unsigned sortable_key(float v) {
  unsigned bits = __float_as_uint(v);
  if (bits == 0x80000000u) bits = 0u;
  return (bits & 0x80000000u) ? ~bits : (bits | 0x80000000u);
}

__device__ __forceinline__ void dsa_item(const Params& p, unsigned char* smem, int item) {
  unsigned char* ws = p.ws;
  const bf16_t* pA = (const bf16_t*)(ws + WS_PA);
  bf16_t* yb = (bf16_t*)(ws + WS_XN) + (size_t)TOK * 512;
  unsigned* sc = (unsigned*)smem;
  unsigned* hist = sc + 8 * SCW;
  unsigned short* sel = (unsigned short*)(hist + 8 * 256);
  unsigned short* cand = sel + 8 * 256;
  unsigned char* bkt = (unsigned char*)(cand + 8 * 512);
  const int tid = threadIdx.x, lane = tid & 63, w = tid >> 6, l15 = lane & 15, g = lane >> 4;
  const int b = item >> 9;
  const int r = item & 511;
  const int tb = (b & 1) ? 511 - r : r;
  const int t0 = tb * 8;
  const size_t tokbase = (size_t)b * SEQL;

  for (int rep_s = 0; rep_s < (DSA_REP == 1 ? 2 : 1); ++rep_s) {
    bf16x8 af[2][2];
    float wq[2][4];
#pragma unroll
    for (int mt = 0; mt < 2; ++mt) {
      const int qrow = t0 + mt * 4 + (l15 >> 2), head = l15 & 3;
#pragma unroll
      for (int ks = 0; ks < 2; ++ks)
        af[mt][ks] = *(const bf16x8*)(pA + (tokbase + qrow) * 1024 + 640 + head * 64 + ks * 32 + 8 * g);
      const uint2 wr = *(const uint2*)(pA + (tokbase + t0 + mt * 4 + g) * 1024 + 960);
      wq[mt][0] = 0.5f * bf2f((bf16_t)(wr.x & 0xffff)); wq[mt][1] = 0.5f * bf2f((bf16_t)(wr.x >> 16));
      wq[mt][2] = 0.5f * bf2f((bf16_t)(wr.y & 0xffff)); wq[mt][3] = 0.5f * bf2f((bf16_t)(wr.y >> 16));
    }
    const int nkt = (t0 + 8 + 15) >> 4;
    for (int kt0 = w; kt0 < nkt; kt0 += 32) {
      bf16x8 b0[4], b1[4];
#pragma unroll
      for (int u = 0; u < 4; ++u) {
        const int kt = kt0 + 8 * u;
        const int s = (kt < nkt ? kt : 0) * 16 + l15;
        const bf16_t* kr = pA + (tokbase + s) * 1024 + 896 + 8 * g;
        b0[u] = *(const bf16x8*)kr;
        b1[u] = *(const bf16x8*)(kr + 32);
      }
#pragma unroll
      for (int u = 0; u < 4; ++u) {
        const int kt = kt0 + 8 * u;
        if (kt < nkt) {
          const int s = kt * 16 + l15;
#pragma unroll
          for (int mt = 0; mt < 2; ++mt) {
            f32x4 acc = (f32x4){0.f, 0.f, 0.f, 0.f};
            acc = __builtin_amdgcn_mfma_f32_16x16x32_bf16(af[mt][0], b0[u], acc, 0, 0, 0);
            acc = __builtin_amdgcn_mfma_f32_16x16x32_bf16(af[mt][1], b1[u], acc, 0, 0, 0);
            float v = 0.f;
#pragma unroll
            for (int j = 0; j < 4; ++j) v += wq[mt][j] * fmaxf(acc[j] * 0.125f, 0.f);
            const int t = t0 + mt * 4 + g;
            unsigned vb = __float_as_uint(v); if (vb == 0x80000000u) vb = 0u;
            sc[(mt * 4 + g) * SCW + s] = vb;
          }
        }
      }
    }
  }
  __syncthreads();
  const int t = t0 + w;
  const int n = t + 1;
  unsigned* row = sc + w * SCW;
  const float* rowf = (const float*)row;
  unsigned short* mysel = sel + w * 256;
  unsigned short* mycand = cand + w * 512;
  unsigned* myh = hist + w * 256;
  int cnt;
  const unsigned long long lt_mask = (1ull << lane) - 1ull;
  for (int rep_t = 0; rep_t < (DSA_REP == 2 ? 2 : 1); ++rep_t)
  if (n <= 256) {
    for (int i = lane; i < n; i += 64) mysel[i] = (unsigned short)i;
    cnt = n;
  } else {
    cnt = 256;
    float mn = INFINITY, mx = -INFINITY;
    for (int i = lane; i < n; i += 64) { const float v = rowf[i]; mn = fminf(mn, v); mx = fmaxf(mx, v); }
#pragma unroll
    for (int o = 32; o > 0; o >>= 1) { mn = fminf(mn, __shfl_xor(mn, o)); mx = fmaxf(mx, __shfl_xor(mx, o)); }
    const float scale = (mx > mn) ? 255.99f / (mx - mn) : 0.f;
#pragma unroll
    for (int i = 0; i < 4; ++i) myh[lane + 64 * i] = 0u;
    lds_fence();
    for (int i = lane; i < n; i += 64) {
      const float v = rowf[i];
      int bn = (int)((v - mn) * scale); bn = bn > 255 ? 255 : bn;
      atomicAdd(&myh[bn], 1u);
    }
    lds_fence();
    unsigned cum; int bstar; unsigned mcount;
    {
      const uint4 c4 = *(const uint4*)(myh + 4 * lane);
      const unsigned c = c4.x + c4.y + c4.z + c4.w;
      unsigned sfx = c;
#pragma unroll
      for (int o = 1; o < 64; o <<= 1) { const unsigned tt = __shfl_down(sfx, o); if (lane + o < 64) sfx += tt; }
      const unsigned long long bal = __ballot(sfx >= 256u);
      const int L = 63 - __clzll(bal);
      const unsigned sL = __shfl(sfx, L), cL = __shfl(c, L);
      const unsigned b3 = __shfl(c4.w, L), b2 = __shfl(c4.z, L), b1 = __shfl(c4.y, L), b0 = __shfl(c4.x, L);
      cum = sL - cL;
      int digit;
      if (cum + b3 >= 256u) { digit = 3; mcount = b3; }
      else { cum += b3; if (cum + b2 >= 256u) { digit = 2; mcount = b2; } else { cum += b2; if (cum + b1 >= 256u) { digit = 1; mcount = b1; } else { cum += b1; digit = 0; mcount = b0; } } }
      bstar = 4 * L + digit;
    }
    const unsigned need = 256u - cum;
    if (mcount <= 512u) {
      unsigned base = 0u, cb = 0u;
      for (int i0 = 0; i0 < n; i0 += 64) {
        const int i = i0 + lane;
        const bool valid = i < n;
        const float v = valid ? rowf[i] : 0.f;
        int bn = (int)((v - mn) * scale); bn = bn > 255 ? 255 : bn;
        const bool gt = valid && (bn > bstar);
        const bool eq = valid && (bn == bstar);
        const unsigned long long bg = __ballot(gt), be = __ballot(eq);
        if (gt) mysel[base + (unsigned)__popcll(bg & lt_mask)] = (unsigned short)i;
        if (eq) mycand[cb + (unsigned)__popcll(be & lt_mask)] = (unsigned short)i;
        base += (unsigned)__popcll(bg); cb += (unsigned)__popcll(be);
      }
      lds_fence();
      const int m = (int)mcount;
      unsigned ck[8]; unsigned short ci[8];
#pragma unroll
      for (int q = 0; q < 8; ++q) {
        const int c = q * 64 + lane;
        ck[q] = 0u; ci[q] = 0;
        if (c < m) { ci[q] = mycand[c]; ck[q] = sortable_key(rowf[ci[q]]); }
      }
      unsigned T = 0u;
#pragma unroll 1
      for (int bit = 31; bit >= 0; --bit) {
        const unsigned trial = T | (1u << bit);
        unsigned cge = 0u;
#pragma unroll
        for (int q = 0; q < 8; ++q) cge += (unsigned)__popcll(__ballot(ck[q] >= trial));
        if (cge >= need) T = trial;
      }
      unsigned cgt = 0u;
#pragma unroll
      for (int q = 0; q < 8; ++q) cgt += (unsigned)__popcll(__ballot(ck[q] > T));
      const unsigned need_eq = need - cgt;
      unsigned pos0 = cum, eqtaken = 0u;
#pragma unroll
      for (int q = 0; q < 8; ++q) {
        const bool gt = ck[q] > T;
        const bool eq = ck[q] == T;
        const unsigned long long beq = __ballot(eq);
        const bool take = gt || (eq && (eqtaken + (unsigned)__popcll(beq & lt_mask)) < need_eq);
        const unsigned long long bt = __ballot(take);
        const unsigned pp = pos0 + (unsigned)__popcll(bt & lt_mask);
        if (take && pp < 256u) mysel[pp] = ci[q];
        pos0 += (unsigned)__popcll(bt);
        eqtaken += (unsigned)__popcll(beq);
      }
    } else {
      unsigned prefix = 0u, krem = 256u;
#pragma unroll 1
      for (int pass = 0; pass < 4; ++pass) {
        const int shift = 24 - 8 * pass;
        const unsigned himask = (pass == 0) ? 0u : (0xFFFFFFFFu << (shift + 8));
#pragma unroll
        for (int i = 0; i < 4; ++i) myh[lane + 64 * i] = 0u;
        lds_fence();
        for (int i = lane; i < n; i += 64) {
          const unsigned u = sortable_key(rowf[i]);
          if ((u & himask) == prefix) atomicAdd(&myh[(u >> shift) & 255u], 1u);
        }
        lds_fence();
        const uint4 c4 = *(const uint4*)(myh + 4 * lane);
        const unsigned c = c4.x + c4.y + c4.z + c4.w;
        unsigned sfx = c;
#pragma unroll
        for (int o = 1; o < 64; o <<= 1) { const unsigned tt = __shfl_down(sfx, o); if (lane + o < 64) sfx += tt; }
        const unsigned long long bal = __ballot(sfx >= krem);
        const int L = 63 - __clzll(bal);
        const unsigned sL = __shfl(sfx, L), cL = __shfl(c, L);
        const unsigned b3 = __shfl(c4.w, L), b2 = __shfl(c4.z, L), b1 = __shfl(c4.y, L);
        unsigned cum2 = sL - cL;
        unsigned digit;
        if (cum2 + b3 >= krem) digit = 3;
        else { cum2 += b3; if (cum2 + b2 >= krem) digit = 2; else { cum2 += b2; if (cum2 + b1 >= krem) digit = 1; else { cum2 += b1; digit = 0; } } }
        krem -= cum2;
        prefix |= ((unsigned)(4 * L) + digit) << shift;
      }
      const unsigned T = prefix;
      unsigned base = 0u, eqtaken = 0u;
      for (int i0 = 0; i0 < n; i0 += 64) {
        const int i = i0 + lane;
        const bool valid = i < n;
        const unsigned u = valid ? sortable_key(rowf[i]) : 0u;
        const bool gt = valid && (u > T);
        const bool eq = valid && (u == T);
        const unsigned long long beq = __ballot(eq);
        const unsigned eqrank = eqtaken + (unsigned)__popcll(beq & lt_mask);
        const bool take = gt || (eq && eqrank < krem);
        const unsigned long long bt = __ballot(take);
        const unsigned pos = base + (unsigned)__popcll(bt & lt_mask);
        if (take && pos < 256u) mysel[pos] = (unsigned short)i;
        base += (unsigned)__popcll(bt);
        eqtaken += (unsigned)__popcll(beq);
      }
    }
  }
  lds_fence();
  for (int rep_a = 0; rep_a < (DSA_REP == 3 ? 2 : 1); ++rep_a) {
    const int ks = lane >> 3, dc = lane & 7;
    float* pl = (float*)row;
    const int niter = (cnt + 7) >> 3;
    {
      const float* relb = (const float*)(bkt + 128);
      bf16x8 bq[2];
#pragma unroll
      for (int ks2 = 0; ks2 < 2; ++ks2) {
        bq[ks2] = (bf16x8){0, 0, 0, 0, 0, 0, 0, 0};
        if (l15 < 8) bq[ks2] = *(const bf16x8*)(pA + (tokbase + t) * 1024 + l15 * 64 + ks2 * 32 + 8 * g);
      }
      const int ntile = (cnt + 15) >> 4;
      for (int kt0 = 0; kt0 < ntile; kt0 += 4) {
        bf16x8 ka[4][2];
#pragma unroll
        for (int u = 0; u < 4; ++u) {
          const int kk = (kt0 + u) * 16 + l15;
          const int s = (kk < cnt) ? (int)mysel[kk] : 0;
          const bf16_t* kr = pA + (tokbase + s) * 1024 + 512 + 8 * g;
          ka[u][0] = *(const bf16x8*)kr;
          ka[u][1] = *(const bf16x8*)(kr + 32);
        }
#pragma unroll
        for (int u = 0; u < 4; ++u) {
          if (kt0 + u < ntile) {
            f32x4 acc = (f32x4){0.f, 0.f, 0.f, 0.f};
            acc = __builtin_amdgcn_mfma_f32_16x16x32_bf16(ka[u][0], bq[0], acc, 0, 0, 0);
            acc = __builtin_amdgcn_mfma_f32_16x16x32_bf16(ka[u][1], bq[1], acc, 0, 0, 0);
            if (l15 < 8) {
#pragma unroll
              for (int j = 0; j < 4; ++j) {
                const int key = (kt0 + u) * 16 + 4 * g + j;
                const bool valid = key < cnt;
                const int sj = valid ? (int)mysel[key] : 0;
                const int dist = t - sj;
                const int bk = dist < 128 ? (int)bkt[dist] : 31;
                pl[key * 8 + l15] = valid ? (acc[j] * 0.125f + relb[bk * 8 + l15]) : -INFINITY;
              }
            }
          }
        }
      }
    }
    lds_fence();
    float inv;
    {
      const int hh = lane & 7, part = lane >> 3;
      float m = -INFINITY;
      for (int kk = part; kk < cnt; kk += 8) m = fmaxf(m, pl[kk * 8 + hh]);
      m = fmaxf(m, __shfl_xor(m, 8)); m = fmaxf(m, __shfl_xor(m, 16)); m = fmaxf(m, __shfl_xor(m, 32));
      float sum = 0.f;
      for (int kk = part; kk < niter * 8; kk += 8) {
        const float e = (kk < cnt) ? __expf(pl[kk * 8 + hh] - m) : 0.f;
        pl[kk * 8 + hh] = e;
        sum += e;
      }
      sum += __shfl_xor(sum, 8); sum += __shfl_xor(sum, 16); sum += __shfl_xor(sum, 32);
      inv = 1.f / sum;
    }
    lds_fence();
    float acc[8][8];
#pragma unroll
    for (int hh = 0; hh < 8; ++hh)
#pragma unroll
      for (int i = 0; i < 8; ++i) acc[hh][i] = 0.f;
    for (int it0 = 0; it0 < niter; it0 += 8) {
      uint4 vv[8];
#pragma unroll
      for (int u = 0; u < 8; ++u) {
        const int kk = (it0 + u) * 8 + ks;
        const int s = (kk < cnt) ? (int)mysel[kk] : 0;
        vv[u] = *(const uint4*)(pA + (tokbase + s) * 1024 + 576 + dc * 8);
      }
#pragma unroll
      for (int u = 0; u < 8; ++u) {
        if (it0 + u < niter) {
          const int kk = (it0 + u) * 8 + ks;
          float vf[8];
          cvt8(vv[u], vf);
          const float4 p0 = *(const float4*)(pl + kk * 8);
          const float4 p1 = *(const float4*)(pl + kk * 8 + 4);
          const float pp[8] = {p0.x, p0.y, p0.z, p0.w, p1.x, p1.y, p1.z, p1.w};
#pragma unroll
          for (int hh = 0; hh < 8; ++hh)
#pragma unroll
            for (int i = 0; i < 8; ++i) acc[hh][i] += pp[hh] * vf[i];
        }
      }
    }
#pragma unroll
    for (int hh = 0; hh < 8; ++hh) {
      const float ih = __shfl(inv, hh);
#pragma unroll
      for (int i = 0; i < 8; ++i) {
        float v = acc[hh][i];
        v += __shfl_xor(v, 8); v += __shfl_xor(v, 16); v += __shfl_xor(v, 32);
        acc[hh][i] = v * ih;
      }
    }
    if (ks == 0) {
#pragma unroll
      for (int hh = 0; hh < 8; ++hh) {
        uint4 o;
        o.x = pack2(acc[hh][0], acc[hh][1]); o.y = pack2(acc[hh][2], acc[hh][3]);
        o.z = pack2(acc[hh][4], acc[hh][5]); o.w = pack2(acc[hh][6], acc[hh][7]);
        *(uint4*)(yb + (tokbase + t) * 512 + hh * 64 + dc * 8) = o;
      }
    }
  }
  __syncthreads();
}

__device__ __forceinline__ void phase_mix(const Params& p, unsigned char* smem) {
  const int G = gridDim.x;
  if (G >= 64) {
    if (blockIdx.x < 32) { hgrn_item(p, smem, blockIdx.x); return; }
    unsigned char* bkt = smem + DSA_BKT_OFF;
    if (threadIdx.x < 128) {
      const int nn = threadIdx.x;
      int v = nn;
      if (nn >= 16) { v = 16 + (int)(logf((float)nn * (1.f / 16.f)) / logf(8.f) * 16.f); if (v > 31) v = 31; }
      bkt[nn] = (unsigned char)v;
    }
    if (threadIdx.x >= 256) ((float*)(bkt + 128))[threadIdx.x - 256] = p.rel_bias[threadIdx.x - 256];
    __syncthreads();
    for (int item = blockIdx.x - 32; item < 4096; item += G - 32) dsa_item(p, smem, item);
  } else {
    for (int bh = blockIdx.x; bh < 32; bh += G) { hgrn_item(p, smem, bh); __syncthreads(); }
    unsigned char* bkt = smem + DSA_BKT_OFF;
    __syncthreads();
    if (threadIdx.x < 128) {
      const int nn = threadIdx.x;
      int v = nn;
      if (nn >= 16) { v = 16 + (int)(logf((float)nn * (1.f / 16.f)) / logf(8.f) * 16.f); if (v > 31) v = 31; }
      bkt[nn] = (unsigned char)v;
    }
    if (threadIdx.x >= 256) ((float*)(bkt + 128))[threadIdx.x - 256] = p.rel_bias[threadIdx.x - 256];
    __syncthreads();
    for (int item = blockIdx.x; item < 4096; item += G) dsa_item(p, smem, item);
  }
}

__device__ __forceinline__ void phase_up(const Params& p, unsigned char* smem) {
  unsigned char* ws = p.ws;
  const bf16_t* ya = (const bf16_t*)(ws + WS_XN);
  const bf16_t* yb = ya + (size_t)TOK * 512;
  const bf16_t* wa = (const bf16_t*)(ws + WS_WUPA);
  const bf16_t* wb = (const bf16_t*)(ws + WS_WUPB);
  const bf16_t* pG = (const bf16_t*)(ws + WS_PG);
  bf16_t* hb = (bf16_t*)(ws + WS_PH);
  const int tid = threadIdx.x, lane = tid & 63, w = tid >> 6, wm = w >> 1, wn = w & 1, l15 = lane & 15, g = lane >> 4;
  for (int tile = blockIdx.x; tile < 128 * 8; tile += gridDim.x) {
    const int tn = tile & 7, tm = tile >> 3;
    f32x4 acc[4][4]; zero_acc(acc);
    gemm_tile(ya + (size_t)tm * 256 * 512, 512, wa + (size_t)tn * 128 * 512, 512, 8, acc, smem);
    asm volatile("" ::: "memory");
    const int rbase = tm * 256 + wm * 64 + 4 * g;
    const int cbase = tn * 128 + wn * 64 + l15;
#pragma unroll
    for (int m = 0; m < 4; ++m) {
      bf16_t gt[16];
#pragma unroll
      for (int n = 0; n < 4; ++n)
#pragma unroll
        for (int j = 0; j < 4; ++j) gt[n * 4 + j] = pG[(size_t)(rbase + m * 16 + j) * 2048 + cbase + n * 16];
#pragma unroll
      for (int n = 0; n < 4; ++n) {
#pragma unroll
        for (int j = 0; j < 4; ++j) {
          const size_t rr = (size_t)(rbase + m * 16 + j);
          hb[rr * 1024 + cbase + n * 16] = f2bf(acc[m][n][j] * bf2f(gt[n * 4 + j]));
        }
        acc[m][n] = (f32x4){0.f, 0.f, 0.f, 0.f};
      }
    }
    asm volatile("" ::: "memory");
    gemm_tile(yb + (size_t)tm * 256 * 512, 512, wb + (size_t)tn * 128 * 512, 512, 8, acc, smem);
    asm volatile("" ::: "memory");
#pragma unroll
    for (int m = 0; m < 4; ++m) {
      bf16_t gt[16], ht[16];
#pragma unroll
      for (int n = 0; n < 4; ++n)
#pragma unroll
        for (int j = 0; j < 4; ++j) {
          const size_t rr = (size_t)(rbase + m * 16 + j);
          gt[n * 4 + j] = pG[rr * 2048 + 1024 + cbase + n * 16];
          ht[n * 4 + j] = hb[rr * 1024 + cbase + n * 16];
        }
#pragma unroll
      for (int n = 0; n < 4; ++n)
#pragma unroll
        for (int j = 0; j < 4; ++j) {
          const size_t rr = (size_t)(rbase + m * 16 + j);
          hb[rr * 1024 + cbase + n * 16] = f2bf(bf2f(ht[n * 4 + j]) + acc[m][n][j] * bf2f(gt[n * 4 + j]));
        }
    }
  }
}

__device__ __forceinline__ void phase_out(const Params& p, unsigned char* smem) {
  unsigned char* ws = p.ws;
  const bf16_t* hb = (const bf16_t*)(ws + WS_PH);
  const bf16_t* wo = (const bf16_t*)(ws + WS_WOUT);
  const int tid = threadIdx.x, lane = tid & 63, w = tid >> 6, wm = w >> 1, wn = w & 1, l15 = lane & 15, g = lane >> 4;
  for (int tile = blockIdx.x; tile < 128 * 8; tile += gridDim.x) {
    const int tn = tile & 7, tm = tile >> 3;
    f32x4 acc[4][4]; zero_acc(acc);
    gemm_tile(hb + (size_t)tm * 256 * 1024, 1024, wo + (size_t)tn * 128 * 1024, 1024, 16, acc, smem);
    const int rbase = tm * 256 + wm * 64 + 4 * g;
    const int cbase = tn * 128 + wn * 64 + l15;
#pragma unroll
    for (int m = 0; m < 4; ++m) {
      float xt[16];
#pragma unroll
      for (int n = 0; n < 4; ++n)
#pragma unroll
        for (int j = 0; j < 4; ++j) xt[n * 4 + j] = p.x[(size_t)(rbase + m * 16 + j) * 1024 + cbase + n * 16];
#pragma unroll
      for (int n = 0; n < 4; ++n)
#pragma unroll
        for (int j = 0; j < 4; ++j) p.out[(size_t)(rbase + m * 16 + j) * 1024 + cbase + n * 16] = xt[n * 4 + j] + acc[m][n][j];
    }
  }
}

__device__ __forceinline__ void phase_pq(const Params& p, unsigned char* smem) {
  unsigned char* ws = p.ws;
  const bf16_t* xn2 = (const bf16_t*)(ws + WS_XN);
  const bf16_t* wq = (const bf16_t*)(ws + WS_WQ);
  bf16_t* qp = (bf16_t*)(ws + WS_PG);
  const int tid = threadIdx.x, lane = tid & 63, w = tid >> 6, wm = w >> 1, wn = w & 1, l15 = lane & 15, g = lane >> 4;
  for (int tile = blockIdx.x; tile < 128 * 16; tile += gridDim.x) {
    const int tn = tile & 15, tm = tile >> 4;
    f32x4 acc[4][4]; zero_acc(acc);
    gemm_tile(xn2 + (size_t)tm * 256 * 1024, 1024, wq + (size_t)tn * 128 * 1024, 1024, 16, acc, smem);
    const int rbase = tm * 256 + wm * 64 + 4 * g;
    const int cbase = tn * 128 + wn * 64 + l15;
#pragma unroll
    for (int m = 0; m < 4; ++m)
#pragma unroll
      for (int n = 0; n < 4; ++n)
#pragma unroll
        for (int j = 0; j < 4; ++j) qp[(size_t)(rbase + m * 16 + j) * 2048 + cbase + n * 16] = f2bf(acc[m][n][j]);
  }
}

__device__ __forceinline__ void phase_pkeys(const Params& p, unsigned char* smem) {
  unsigned char* ws = p.ws;
  const bf16_t* qp = (const bf16_t*)(ws + WS_PG);
  const bf16_t* keys = (const bf16_t*)(ws + WS_KEYS);
  float* ps = (float*)(ws + WS_PA);
  int* pi = (int*)(ws + WS_PA) + (size_t)TOK * 256;
  float* sc = (float*)smem;
  const int tid = threadIdx.x, lane = tid & 63, w = tid >> 6, wm = w >> 1, wn = w & 1, l15 = lane & 15, g = lane >> 4;
  for (int tile = blockIdx.x; tile < 128 * 16; tile += gridDim.x) {
    const int hp = tile & 15, tm = tile >> 4;
    const int h = hp >> 1, ph = hp & 1;
    f32x4 acc[4][4]; zero_acc(acc);
    gemm_tile(qp + (size_t)tm * 256 * 2048 + hp * 128, 2048, keys + (size_t)(ph * 8 + h) * 128 * 128, 128, 2, acc, smem);
    __syncthreads();
#pragma unroll
    for (int m = 0; m < 4; ++m)
#pragma unroll
      for (int n = 0; n < 4; ++n)
#pragma unroll
        for (int j = 0; j < 4; ++j) sc[(wm * 64 + m * 16 + 4 * g + j) * 129 + wn * 64 + n * 16 + l15] = acc[m][n][j];
    __syncthreads();
    if (tid < 256) {
      const int row = tid;
      const float* rowp = sc + row * 129;
      unsigned tv[16];
#pragma unroll
      for (int k = 0; k < 16; ++k) tv[k] = 0u;
#pragma unroll 8
      for (int nn = 0; nn < 128; ++nn) {
        const unsigned bits = __float_as_uint(rowp[nn]);
        unsigned key = (bits & 0x80000000u) ? ~bits : (bits | 0x80000000u);
        key = (key & ~127u) | (unsigned)(127 - nn);
#pragma unroll
        for (int k = 15; k >= 1; --k) {
          unsigned r;
          asm("v_med3_u32 %0, %1, %2, %3" : "=v"(r) : "v"(tv[k]), "v"(tv[k - 1]), "v"(key));
          tv[k] = r;
        }
        tv[0] = tv[0] > key ? tv[0] : key;
      }
      const size_t ob = ((size_t)(tm * 256 + row) * 16 + hp) * 16;
      float ov[16]; int oi[16];
#pragma unroll
      for (int k = 0; k < 16; ++k) { oi[k] = 127 - (int)(tv[k] & 127u); ov[k] = rowp[oi[k]]; }
#pragma unroll
      for (int k = 0; k < 16; k += 4) {
        *(float4*)(ps + ob + k) = make_float4(ov[k], ov[k + 1], ov[k + 2], ov[k + 3]);
        *(int4*)(pi + ob + k) = make_int4(oi[k], oi[k + 1], oi[k + 2], oi[k + 3]);
      }
    }
    __syncthreads();
  }
}

__device__ __forceinline__ void phase_pcomb(const Params& p, unsigned char* smem) {
  unsigned char* ws = p.ws;
  const float* ps = (const float*)(ws + WS_PA);
  const int* pi = (const int*)(ws + WS_PA) + (size_t)TOK * 256;
  int* eidx = (int*)(ws + WS_EIDX);
  float* gw = (float*)(ws + WS_GW);
  float* s2l = (float*)smem;
  unsigned short* i1l = (unsigned short*)(s2l + 512 * 17);
  unsigned short* i2l = i1l + 512 * 16;
  const int tid = threadIdx.x;
  for (int base = blockIdx.x * NTHREADS; base < TOK * 8; base += gridDim.x * NTHREADS) {
    const int th = base + tid;
    const size_t o1 = (size_t)th * 32;
    float s1[16];
#pragma unroll
    for (int a = 0; a < 16; ++a) {
      s1[a] = ps[o1 + a];
      s2l[tid * 17 + a] = ps[o1 + 16 + a];
      i1l[tid * 16 + a] = (unsigned short)pi[o1 + a];
      i2l[tid * 16 + a] = (unsigned short)pi[o1 + 16 + a];
    }
    float cur[16];
    const float s20 = s2l[tid * 17];
#pragma unroll
    for (int a = 0; a < 16; ++a) cur[a] = s1[a] + s20;
    unsigned long long ptr = 0ull;
    float tops[16]; int tope[16];
#pragma unroll
    for (int k = 0; k < 16; ++k) {
      float best = cur[0]; int ba = 0;
#pragma unroll
      for (int a = 1; a < 16; ++a) if (cur[a] > best) { best = cur[a]; ba = a; }
      const int bb = (int)((ptr >> (4 * ba)) & 15ull);
      tops[k] = best;
      tope[k] = (int)i1l[tid * 16 + ba] * 128 + (int)i2l[tid * 16 + bb];
      const int nb = bb + 1;
      const float ns2 = (nb < 16) ? s2l[tid * 17 + nb] : -INFINITY;
      if (nb < 16) ptr += (1ull << (4 * ba));
#pragma unroll
      for (int a = 0; a < 16; ++a) if (a == ba) cur[a] = s1[a] + ns2;
    }
    float m = tops[0];
    float sum = 0.f;
#pragma unroll
    for (int k = 0; k < 16; ++k) { tops[k] = __expf(tops[k] - m); sum += tops[k]; }
    const float inv = 1.f / sum;
#pragma unroll
    for (int k = 0; k < 16; ++k) { eidx[(size_t)th * 16 + k] = tope[k]; gw[(size_t)th * 16 + k] = tops[k] * inv; }
  }
}


__device__ __forceinline__ float reduce8(const float (&pv)[8], int lane) {
  const bool b5 = lane & 32, b4 = lane & 16, b3 = lane & 8;
  float v[4];
#pragma unroll
  for (int i = 0; i < 4; ++i) {
    const float keep = b5 ? pv[4 + i] : pv[i];
    const float send = b5 ? pv[i] : pv[4 + i];
    v[i] = keep + __shfl_xor(send, 32);
  }
  float u[2];
#pragma unroll
  for (int i = 0; i < 2; ++i) {
    const float keep = b4 ? v[2 + i] : v[i];
    const float send = b4 ? v[i] : v[2 + i];
    u[i] = keep + __shfl_xor(send, 16);
  }
  float x = (b3 ? u[1] : u[0]) + __shfl_xor(b3 ? u[0] : u[1], 8);
  x += __shfl_xor(x, 4); x += __shfl_xor(x, 2); x += __shfl_xor(x, 1);
  return x;
}

__device__ __forceinline__ void cvt16u8(const uint4& v, float* f) {
  f[0] = (float)(v.x & 0xffu); f[1] = (float)((v.x >> 8) & 0xffu); f[2] = (float)((v.x >> 16) & 0xffu); f[3] = (float)(v.x >> 24);
  f[4] = (float)(v.y & 0xffu); f[5] = (float)((v.y >> 8) & 0xffu); f[6] = (float)((v.y >> 16) & 0xffu); f[7] = (float)(v.y >> 24);
  f[8] = (float)(v.z & 0xffu); f[9] = (float)((v.z >> 8) & 0xffu); f[10] = (float)((v.z >> 16) & 0xffu); f[11] = (float)(v.z >> 24);
  f[12] = (float)(v.w & 0xffu); f[13] = (float)((v.w >> 8) & 0xffu); f[14] = (float)((v.w >> 16) & 0xffu); f[15] = (float)(v.w >> 24);
}

__device__ __forceinline__ int team_index(const Params& p, unsigned char* smem) {
  int* sh = (int*)(smem + 8192);
  const int G = gridDim.x, tid = threadIdx.x;
  const int* tab = (const int*)(p.ws + WS_XCC);
  if (tid < 32) sh[tid] = 0;
  __syncthreads();
  const int mine = tab[blockIdx.x] & 15;
  for (int b = tid; b < G; b += NTHREADS) {
    const int x = tab[b] & 15;
    atomicAdd(&sh[x], 1);
    if (x == mine && b < (int)blockIdx.x) atomicAdd(&sh[16], 1);
  }
  __syncthreads();
  if (tid == 0) {
    int pre = 0;
    for (int j = 0; j < mine; ++j) pre += sh[j];
    sh[17] = pre + sh[16];
  }
  __syncthreads();
  const int r = sh[17];
  __syncthreads();
  return r;
}

template <bool SL>
__device__ __forceinline__ void phase_pu_t(const Params& p, unsigned char* smem) {
  unsigned char* ws = p.ws;
  const bf16_t* xn2 = (const bf16_t*)(ws + WS_XN);
  const unsigned char* U8 = ws + WS_U;
  const float* us = (const float*)(ws + WS_U + (size_t)16384 * 1024);
  const float* vs = (const float*)(ws + WS_V + (size_t)16384 * 1024);
  const int* eidx = (const int*)(ws + WS_EIDX);
  const float* gw = (const float*)(ws + WS_GW);
  float* aw = (float*)(ws + WS_PA);
  const int lane = threadIdx.x & 63, w = threadIdx.x >> 6;
  unsigned* lst = (unsigned*)smem + w * 128;
  const unsigned long long lt_mask = (1ull << lane) - 1ull;
  const int G = gridDim.x;
  constexpr bool sliced = SL;
  const int ti = sliced ? team_index(p, smem) : 0;
  const int tsz = G >> 3;
  const int grp0 = sliced ? (ti / tsz) : 0;
  constexpr int ngrp = sliced ? 1 : 8;
  const int slot = sliced ? (ti % tsz) * 8 + w : blockIdx.x * 8 + w;
  const int nslot = sliced ? tsz * 8 : G * 8;
  uint4 xa, xb; int e0, e1;
  if (slot < TOK) {
    xa = *(const uint4*)(xn2 + (size_t)slot * 1024 + lane * 16);
    xb = *(const uint4*)(xn2 + (size_t)slot * 1024 + lane * 16 + 8);
    e0 = eidx[(size_t)slot * 128 + lane]; e1 = eidx[(size_t)slot * 128 + 64 + lane];
  }
  for (int tok = slot; tok < TOK; tok += nslot) {
    float xf[16];
    cvt8(xa, xf); cvt8(xb, xf + 8);
    const int ce0 = e0, ce1 = e1;
    float negsum = 0.f;
#pragma unroll
    for (int i = 0; i < 16; ++i) negsum += xf[i];
    negsum *= -128.f;
    for (int gi = 0; gi < ngrp; ++gi) {
      const int grp = grp0 + gi;
      const bool m0 = (ce0 >> 11) == grp, m1 = (ce1 >> 11) == grp;
      const unsigned long long b0 = __ballot(m0), b1 = __ballot(m1);
      const int c0 = __popcll(b0), n = c0 + __popcll(b1);
      if (m0) lst[__popcll(b0 & lt_mask)] = ((unsigned)lane << 14) | (unsigned)ce0;
      if (m1) lst[c0 + __popcll(b1 & lt_mask)] = ((unsigned)(lane + 64) << 14) | (unsigned)ce1;
      lds_fence();
      const unsigned le0 = (lane < n) ? lst[lane] : 0u;
      const unsigned le1 = (lane + 64 < n) ? lst[lane + 64] : 0u;
      lds_fence();
      float sc0 = 0.f, sc1 = 0.f, gv0 = 0.f, gv1 = 0.f, vv0 = 0.f, vv1 = 0.f;
      if (lane < n) { const int e = le0 & 16383; sc0 = us[e]; vv0 = vs[e]; gv0 = gw[(size_t)tok * 128 + (le0 >> 14)]; }
      if (lane + 64 < n) { const int e = le1 & 16383; sc1 = us[e]; vv1 = vs[e]; gv1 = gw[(size_t)tok * 128 + (le1 >> 14)]; }
      float h0 = 0.f, h1 = 0.f;
#define PU_BATCH(I0, PREFETCH_STMT) do { \
        const int i0_ = (I0); \
        const bool lo = i0_ < 64; \
        const int cur = (int)(lo ? le0 : le1); \
        const int base = i0_ & 63; \
        int last = (lo ? (n < 64 ? n : 64) : n - 64) - 1; last = last < 0 ? 0 : last; \
        uint4 ua[16]; \
        _Pragma("unroll") for (int j = 0; j < 16; ++j) { \
          int idx = base + j; idx = idx < last ? idx : last; \
          const unsigned le = (unsigned)__builtin_amdgcn_readlane(cur, idx); \
          ua[j] = *(const uint4*)(U8 + (size_t)(le & 16383u) * 1024 + lane * 16); \
        } \
        PREFETCH_STMT; \
        __builtin_amdgcn_sched_barrier(0); \
        float pv[8], pw[8]; \
        _Pragma("unroll") for (int j = 0; j < 8; ++j) { \
          float uf[16]; cvt16u8(ua[j], uf); float pp = negsum; \
          _Pragma("unroll") for (int i = 0; i < 16; ++i) pp += uf[i] * xf[i]; \
          pv[j] = pp; \
        } \
        _Pragma("unroll") for (int j = 0; j < 8; ++j) { \
          float uf[16]; cvt16u8(ua[8 + j], uf); float pp = negsum; \
          _Pragma("unroll") for (int i = 0; i < 16; ++i) pp += uf[i] * xf[i]; \
          pw[j] = pp; \
        } \
        const float ta = reduce8(pv, lane); \
        const float tb = reduce8(pw, lane); \
        float hn = 0.f; \
        _Pragma("unroll") for (int j = 0; j < 8; ++j) { \
          const float hj = __int_as_float(__builtin_amdgcn_readlane(__float_as_int(ta), 8 * j)); \
          const float hk = __int_as_float(__builtin_amdgcn_readlane(__float_as_int(tb), 8 * j)); \
          if (lane == base + j) hn = hj; \
          if (lane == base + 8 + j) hn = hk; \
        } \
        if (lane >= base && lane < base + 16) { if (lo) h0 = hn; else h1 = hn; } \
      } while (0)
      if (gi == ngrp - 1) {
        const int nt = (tok + nslot < TOK) ? tok + nslot : tok;
        PU_BATCH(0, { xa = *(const uint4*)(xn2 + (size_t)nt * 1024 + lane * 16);
                      xb = *(const uint4*)(xn2 + (size_t)nt * 1024 + lane * 16 + 8);
                      e0 = eidx[(size_t)nt * 128 + lane]; e1 = eidx[(size_t)nt * 128 + 64 + lane]; });
      } else {
        PU_BATCH(0, {});
      }
#pragma unroll 1
      for (int i0 = 16; i0 < n; i0 += 16) PU_BATCH(i0, {});
#undef PU_BATCH
      h0 *= sc0; h1 *= sc1;
      if (lane < n) aw[(size_t)tok * 128 + (le0 >> 14)] = 0.5f * h0 * (1.f + erff(h0 * 0.70710678118654752f)) * gv0 * vv0;
      if (lane + 64 < n) aw[(size_t)tok * 128 + (le1 >> 14)] = 0.5f * h1 * (1.f + erff(h1 * 0.70710678118654752f)) * gv1 * vv1;
    }
  }
}

template <bool SL>
__device__ __forceinline__ void phase_pv_t(const Params& p, unsigned char* smem) {
  unsigned char* ws = p.ws;
  const unsigned char* V8 = ws + WS_V;
  const int* eidx = (const int*)(ws + WS_EIDX);
  const float* aw = (const float*)(ws + WS_PA);
  float* ssq = (float*)(ws + WS_SSQ);
  const int lane = threadIdx.x & 63, w = threadIdx.x >> 6;
  const int q = lane >> 3, c = lane & 7;
  const int G = gridDim.x;
  constexpr bool sliced = SL;
  const int ti = sliced ? team_index(p, smem) : 0;
  const int tsz = G >> 3;
  const int grp0 = sliced ? (ti / tsz) : 0;
  constexpr int ngrp = sliced ? 1 : 8;
  const int slot = sliced ? (ti % tsz) * 8 + w : blockIdx.x * 8 + w;
  const int nslot = sliced ? tsz * 8 : G * 8;
  int ee[16]; float aa[16];
  if (slot < TOK) {
    unsigned bi = (unsigned)slot * 128u + (unsigned)q;
    asm volatile("" : "+v"(bi));
#pragma unroll
    for (int u = 0; u < 16; ++u) { ee[u] = eidx[bi + 8 * u]; aa[u] = aw[bi + 8 * u]; }
  }
  for (int tok = slot; tok < TOK; tok += nslot) {
    int ce[16]; float ca[16];
    float suma = 0.f;
#pragma unroll
    for (int u = 0; u < 16; ++u) { ce[u] = ee[u]; ca[u] = aa[u]; suma += aa[u]; }
    for (int gi = 0; gi < ngrp; ++gi) {
      const int grp = grp0 + gi;
      uint4 vv[16];
#pragma unroll
      for (int u = 0; u < 16; ++u) vv[u] = *(const uint4*)(V8 + (size_t)ce[u] * 1024 + grp * 128 + c * 16);
      float* orow = p.out + (size_t)tok * 1024 + grp * 128 + c * 16;
      float4 x1v[4];
#pragma unroll
      for (int i = 0; i < 4; ++i) x1v[i] = *(const float4*)(orow + 4 * i);
      if (gi == ngrp - 1) {
        const int nt = (tok + nslot < TOK) ? tok + nslot : tok;
        unsigned bi = (unsigned)nt * 128u + (unsigned)q;
        asm volatile("" : "+v"(bi));
#pragma unroll
        for (int u = 0; u < 16; ++u) { ee[u] = eidx[bi + 8 * u]; aa[u] = aw[bi + 8 * u]; }
      }
      __builtin_amdgcn_sched_barrier(0);
      float acc[16];
#pragma unroll
      for (int i = 0; i < 16; ++i) acc[i] = -128.f * suma;
#pragma unroll
      for (int u = 0; u < 16; ++u) {
        float vf[16];
        cvt16u8(vv[u], vf);
#pragma unroll
        for (int i = 0; i < 16; ++i) acc[i] += ca[u] * vf[i];
        __builtin_amdgcn_sched_barrier(0);
      }
#pragma unroll
      for (int i = 0; i < 16; ++i) { acc[i] += __shfl_xor(acc[i], 8); acc[i] += __shfl_xor(acc[i], 16); acc[i] += __shfl_xor(acc[i], 32); }
      float ss = 0.f;
      if (q == 0) {
#pragma unroll
        for (int i = 0; i < 4; ++i) {
          const float4 oa = make_float4(x1v[i].x + acc[4 * i], x1v[i].y + acc[4 * i + 1], x1v[i].z + acc[4 * i + 2], x1v[i].w + acc[4 * i + 3]);
          *(float4*)(orow + 4 * i) = oa;
          ss += oa.x * oa.x + oa.y * oa.y + oa.z * oa.z + oa.w * oa.w;
        }
      }
      ss += __shfl_xor(ss, 1); ss += __shfl_xor(ss, 2); ss += __shfl_xor(ss, 4);
      if (lane == 0) atomicAdd(&ssq[tok], ss);
    }
  }
}

__device__ __forceinline__ void phase_final(const Params& p) {
  const float* ssq = (const float*)(p.ws + WS_SSQ);
  const int lane = threadIdx.x & 63, w = threadIdx.x >> 6;
  for (int row = blockIdx.x * 8 + w; row < TOK; row += gridDim.x * 8) {
    const float rstd = rsqrtf(ssq[row] * (1.f / DM) + EPSV);
    float4* o4 = (float4*)(p.out + (size_t)row * DM);
#pragma unroll
    for (int i = 0; i < 4; ++i) {
      float4 v = o4[lane + 64 * i];
      const float4 gg = ((const float4*)p.norm_final)[lane + 64 * i];
      v.x *= rstd * gg.x; v.y *= rstd * gg.y; v.z *= rstd * gg.z; v.w *= rstd * gg.w;
      o4[lane + 64 * i] = v;
    }
  }
}


__device__ __forceinline__ void phase_proj8(const Params& p, unsigned char* smem) {
  unsigned char* ws = p.ws;
  pg8::Gemm g{(const pg8::bf16_t*)(ws + WS_XN), (const pg8::bf16_t*)(ws + WS_WIN), TOK, 5120, 1024};
  pg8::StaticOrder S; S.init(TOK, 5120, (int)gridDim.x, (int)blockIdx.x);
  EpiProj E{(unsigned short*)(ws + WS_PH), (unsigned short*)(ws + WS_PA), (unsigned short*)(ws + WS_PG)};
  pg8::gemm_phase<EpiProj, pg8::StaticOrder>((PG8_LAS unsigned char*)smem, g, S, E, nullptr);
}
__device__ __forceinline__ void phase_ikln(const Params& p) {
  bf16_t* pA = (bf16_t*)(p.ws + WS_PA);
  const int tid = threadIdx.x, sub = tid & 7;
  float gam[8], bet[8];
#pragma unroll
  for (int i = 0; i < 8; ++i) { gam[i] = p.ikg[sub * 8 + i]; bet[i] = p.ikb[sub * 8 + i]; }
  for (int row = blockIdx.x * 64 + (tid >> 3); row < TOK; row += gridDim.x * 64) {
    uint4* ptr = (uint4*)(pA + (size_t)row * 1024 + 896 + sub * 8);
    const uint4 raw = *ptr;
    float v[8];
    cvt8(raw, v);
    float s = 0.f;
#pragma unroll
    for (int i = 0; i < 8; ++i) s += v[i];
    s += __shfl_xor(s, 1); s += __shfl_xor(s, 2); s += __shfl_xor(s, 4);
    const float mu = s * (1.f / 64.f);
    float q = 0.f;
#pragma unroll
    for (int i = 0; i < 8; ++i) { const float d = v[i] - mu; q += d * d; }
    q += __shfl_xor(q, 1); q += __shfl_xor(q, 2); q += __shfl_xor(q, 4);
    const float rstd = rsqrtf(q * (1.f / 64.f) + EPSV);
    uint4 o;
    o.x = pack2((v[0] - mu) * rstd * gam[0] + bet[0], (v[1] - mu) * rstd * gam[1] + bet[1]);
    o.y = pack2((v[2] - mu) * rstd * gam[2] + bet[2], (v[3] - mu) * rstd * gam[3] + bet[3]);
    o.z = pack2((v[4] - mu) * rstd * gam[4] + bet[4], (v[5] - mu) * rstd * gam[5] + bet[5]);
    o.w = pack2((v[6] - mu) * rstd * gam[6] + bet[6], (v[7] - mu) * rstd * gam[7] + bet[7]);
    *ptr = o;
  }
}
__device__ __forceinline__ void phase_up8(const Params& p, unsigned char* smem) {
  unsigned char* ws = p.ws;
  const pg8::bf16_t* ya = (const pg8::bf16_t*)(ws + WS_XN);
  const pg8::bf16_t* yb = ya + (size_t)TOK * 512;
  pg8::StaticOrder S; S.init(TOK, 1024, (int)gridDim.x, (int)blockIdx.x);
  {
    pg8::Gemm g{ya, (const pg8::bf16_t*)(ws + WS_WUPA), TOK, 1024, 512};
    EpiGate<0> E{(unsigned short*)(ws + WS_PH), (const unsigned short*)(ws + WS_PG), 0};
    pg8::gemm_phase<EpiGate<0>, pg8::StaticOrder>((PG8_LAS unsigned char*)smem, g, S, E, nullptr);
  }
  {
    pg8::Gemm g{yb, (const pg8::bf16_t*)(ws + WS_WUPB), TOK, 1024, 512};
    EpiGate<1> E{(unsigned short*)(ws + WS_PH), (const unsigned short*)(ws + WS_PG), 1024};
    pg8::gemm_phase<EpiGate<1>, pg8::StaticOrder>((PG8_LAS unsigned char*)smem, g, S, E, nullptr);
  }
}
__device__ __forceinline__ void phase_out8(const Params& p, unsigned char* smem) {
  unsigned char* ws = p.ws;
  pg8::Gemm g{(const pg8::bf16_t*)(ws + WS_PH), (const pg8::bf16_t*)(ws + WS_WOUT), TOK, 1024, 1024};
  pg8::StaticOrder S; S.init(TOK, 1024, (int)gridDim.x, (int)blockIdx.x);
  EpiResid E{p.out, p.x};
  pg8::gemm_phase<EpiResid, pg8::StaticOrder>((PG8_LAS unsigned char*)smem, g, S, E, nullptr);
}
__device__ __forceinline__ void phase_pq8(const Params& p, unsigned char* smem) {
  unsigned char* ws = p.ws;
  pg8::Gemm g{(const pg8::bf16_t*)(ws + WS_XN), (const pg8::bf16_t*)(ws + WS_WQ), TOK, 2048, 1024};
  pg8::StaticOrder S; S.init(TOK, 2048, (int)gridDim.x, (int)blockIdx.x);
  EpiStoreBf16 E{(unsigned short*)(ws + WS_PG), 2048};
  pg8::gemm_phase<EpiStoreBf16, pg8::StaticOrder>((PG8_LAS unsigned char*)smem, g, S, E, nullptr);
}

__global__ void __launch_bounds__(NTHREADS) hybrid_fwd(Params p) {
  extern __shared__ __attribute__((aligned(16))) unsigned char smem[];
#if ONE_LAUNCH
  cg::grid_group grid = cg::this_grid();
  volatile LAS unsigned* xst = (volatile LAS unsigned*)(smem + LDS_BYTES - 16);
  if (threadIdx.x == 0) { xst[0] = 0u; xst[1] = 0u; }
  __syncthreads();
  XcdBarrier xbar = xcd_barrier_post((unsigned*)(p.ws + WS_BAR), xst);
#define SEAM(k) do { if (p.ph_lo <= (k) && (k) + 1 < p.ph_hi) { if ((k) == 0) grid.sync(); else xcd_barrier(xbar); } } while (0)
#else
#define SEAM(k) do { } while (0)
#endif
#define IN(k) (p.ph_lo <= (k) && (k) < p.ph_hi)
#ifndef REPEAT_PH
#define REPEAT_PH -1
#endif
#define REP(k, stmt) do { if (REPEAT_PH == (k)) { stmt; grid.sync(); } } while (0)
  if (IN(0)) { phase_prep(p, smem); SEAM(0); }
  if (IN(1)) { phase_proj8(p, smem); SEAM(1); }
  if (IN(2)) { phase_ikln(p); SEAM(2); }
  if (IN(3)) { phase_mix(p, smem); SEAM(3); }
  if (IN(4)) { phase_up8(p, smem); SEAM(4); }
  if (IN(5)) { phase_out8(p, smem); SEAM(5); }
  if (IN(6)) { rmsnorm_rows(p.out, p.norm_ffn, (bf16_t*)(p.ws + WS_XN)); SEAM(6); }
  if (IN(7)) { phase_pq8(p, smem); SEAM(7); }
  if (IN(8)) { phase_pkeys(p, smem); SEAM(8); }
  if (IN(9)) { phase_pcomb(p, smem); SEAM(9); }
  if (IN(10)) { if (gridDim.x % 8 == 0) phase_pu_t<true>(p, smem); else phase_pu_t<false>(p, smem); SEAM(10); }
  if (IN(11)) { if (gridDim.x % 8 == 0) phase_pv_t<true>(p, smem); else phase_pv_t<false>(p, smem); SEAM(11); }
  if (IN(12)) { phase_final(p); }
#undef IN
#undef SEAM
}

extern "C" void kernel_launch(void* const* d_in, const int* in_sizes, int n_in, void* d_out, int out_size, void* d_ws, size_t ws_size,
                              hipStream_t stream) {
  static int grid = 0;
  if (grid == 0) {
    if (n_in != 17 || ws_size < WS_END) {
      fprintf(stderr, "kernel_launch: unexpected n_in %d or ws_size %zu (need %zu)\n", n_in, ws_size, (size_t)WS_END);
      grid = -1; return;
    }
    int dev = 0, cus = 0, per_cu = 0;
    hipGetDevice(&dev);
    hipDeviceGetAttribute(&cus, hipDeviceAttributeMultiprocessorCount, dev);
    hipFuncSetAttribute((const void*)hybrid_fwd, hipFuncAttributeMaxDynamicSharedMemorySize, LDS_BYTES);
    hipOccupancyMaxActiveBlocksPerMultiprocessor(&per_cu, (const void*)hybrid_fwd, NTHREADS, LDS_BYTES);
    if (per_cu < 1) { fprintf(stderr, "kernel_launch: occupancy query says %d blocks/CU\n", per_cu); per_cu = 1; }
    (void)hipGetLastError();
    grid = cus;
  }
  if (grid < 0) return;
  Params p{};
  p.x = (const float*)d_in[0]; p.norm_mix = (const float*)d_in[1]; p.w_in = (const float*)d_in[2]; p.hg_lb = (const float*)d_in[3];
  p.hg_norm = (const float*)d_in[4]; p.ikg = (const float*)d_in[5]; p.ikb = (const float*)d_in[6]; p.rel_bias = (const float*)d_in[7];
  p.w_up_a = (const float*)d_in[8]; p.w_up_b = (const float*)d_in[9]; p.w_out = (const float*)d_in[10]; p.norm_ffn = (const float*)d_in[11];
  p.peer_wq = (const float*)d_in[12]; p.peer_keys = (const float*)d_in[13]; p.peer_u = (const float*)d_in[14]; p.peer_v = (const float*)d_in[15];
  p.norm_final = (const float*)d_in[16];
  p.out = (float*)d_out; p.ws = (unsigned char*)d_ws;
#if ONE_LAUNCH
  hipMemsetAsync((unsigned char*)d_ws + WS_BAR, 0, 16384, stream);
  p.ph_lo = 0; p.ph_hi = NPHASE;
  void* args[] = {&p};
  hipError_t e = hipLaunchCooperativeKernel((const void*)hybrid_fwd, dim3(grid), dim3(NTHREADS), args, LDS_BYTES, stream);
  if (e != hipSuccess) fprintf(stderr, "cooperative launch failed: %s (grid %d)\n", hipGetErrorString(e), grid);
#else
  for (int ph = 0; ph < NPHASE; ++ph) {
    p.ph_lo = ph; p.ph_hi = ph + 1;
    hipLaunchKernelGGL(hybrid_fwd, dim3(grid), dim3(NTHREADS), LDS_BYTES, stream, p);
  }
#endif
}
```

```cpp
#include <hip/hip_runtime.h>
#include <hip/hip_cooperative_groups.h>
#include <stdint.h>
#include <stdio.h>
namespace cg = cooperative_groups;

#ifndef ONE_LAUNCH
#define ONE_LAUNCH 1
#endif

typedef unsigned short bf16_t;
typedef __attribute__((ext_vector_type(8))) short bf16x8;
typedef __attribute__((ext_vector_type(4))) float f32x4;

#define NTHREADS 512
#define TOK 32768
#define SEQL 4096
#define DM 1024
#define EPSV 1e-6f
#define NPHASE 13

#define WS_WIN   ((size_t)0)
#define WS_WUPA  (WS_WIN  + (size_t)5120 * 1024 * 2)
#define WS_WUPB  (WS_WUPA + (size_t)1024 * 512 * 2)
#define WS_WOUT  (WS_WUPB + (size_t)1024 * 512 * 2)
#define WS_WQ    (WS_WOUT + (size_t)1024 * 1024 * 2)
#define WS_KEYS  (WS_WQ   + (size_t)2048 * 1024 * 2)
#define WS_LB    (WS_KEYS + (size_t)2 * 8 * 128 * 128 * 2)
#define WS_U     (WS_LB   + (size_t)4096)
#define WS_V     (WS_U    + (size_t)16384 * 1024 * 2)
#define WS_XN    (WS_V    + (size_t)16384 * 1024 * 2)
#define WS_PH    (WS_XN   + (size_t)TOK * 1024 * 2)
#define WS_PA    (WS_PH   + (size_t)TOK * 2048 * 2)
#define WS_PG    (WS_PA   + (size_t)TOK * 1024 * 2)
#define WS_EIDX  (WS_PG   + (size_t)TOK * 2048 * 2)
#define WS_GW    (WS_EIDX + (size_t)TOK * 128 * 4)
#define WS_SSQ   (WS_GW   + (size_t)TOK * 128 * 4)
#define WS_XCC   (WS_SSQ  + (size_t)TOK * 4)
#define WS_BAR   (WS_XCC  + (size_t)4096)
#define WS_END   (WS_BAR  + (size_t)16384)

#define LDS_BYTES 155648

struct Params {
  const float* x; const float* norm_mix; const float* w_in; const float* hg_lb; const float* hg_norm;
  const float* ikg; const float* ikb; const float* rel_bias; const float* w_up_a; const float* w_up_b;
  const float* w_out; const float* norm_ffn; const float* peer_wq; const float* peer_keys;
  const float* peer_u; const float* peer_v; const float* norm_final;
  float* out; unsigned char* ws; int ph_lo, ph_hi;
};

__device__ __forceinline__ float bf2f(bf16_t u) { return __uint_as_float(((unsigned)u) << 16); }
__device__ __forceinline__ bf16_t f2bf(float f) {
  unsigned u = __float_as_uint(f);
  u += 0x7fffu + ((u >> 16) & 1u);
  return (bf16_t)(u >> 16);
}
__device__ __forceinline__ unsigned pack2(float a, float b) { return (unsigned)f2bf(a) | ((unsigned)f2bf(b) << 16); }
__device__ __forceinline__ float wave_sum(float v) {
#pragma unroll
  for (int o = 32; o > 0; o >>= 1) v += __shfl_xor(v, o);
  return v;
}
__device__ __forceinline__ void lds_fence() { asm volatile("s_waitcnt lgkmcnt(0)" ::: "memory"); }
__device__ __forceinline__ float sigmoidf_(float x) { return 1.f / (1.f + __expf(-x)); }
__device__ __forceinline__ float siluf_(float x) { return x / (1.f + __expf(-x)); }


#define XB_TMO      128
#define XB_XCNT(j)  (256  + 64 * (j))
#define XB_XSUB(j)  (1280 + 64 * (j))
#define XB_XGEN(j)  (2304 + 64 * (j))
#define XB_TOP      3328
#define XB_TOPGEN   3392
#define XCD_BAR_WORDS 3456
#define XB_SPIN_CAP (1u << 22)
#define LAS __attribute__((address_space(3)))
__device__ __forceinline__ unsigned xb_ld(unsigned* p)              { return __hip_atomic_load(p, __ATOMIC_RELAXED, __HIP_MEMORY_SCOPE_AGENT); }
__device__ __forceinline__ unsigned xb_add(unsigned* p, unsigned v) { return __hip_atomic_fetch_add(p, v, __ATOMIC_RELAXED, __HIP_MEMORY_SCOPE_AGENT); }
__device__ __forceinline__ unsigned xb_xcc_id() { return (unsigned)__builtin_amdgcn_s_getreg((3 << 11) | 20) & 0xFu; }
#define XB_SPIN(cond, bar) do { unsigned _sp = 0; while (cond) { __builtin_amdgcn_s_sleep(1); \
    if ((++_sp & 255u) == 0u) { if (xb_ld(&(bar)[XB_TMO])) break; if (_sp > XB_SPIN_CAP) { atomicAdd(&(bar)[XB_TMO], 1u); break; } } } } while (0)
struct XcdBarrier { unsigned* bar; unsigned x; volatile LAS unsigned* st; };
__device__ __forceinline__ XcdBarrier xcd_barrier_post(unsigned* bar, volatile LAS unsigned* st) {
  XcdBarrier b; b.bar = bar; b.x = xb_xcc_id(); b.st = st;
  if (threadIdx.x == 0) (void)xb_add(&bar[XB_XCNT(b.x)], 1u);
  return b;
}
__device__ __forceinline__ void xcd_barrier_complete(unsigned* bar, unsigned x, unsigned& nloc, unsigned& nx) {
  const unsigned G = gridDim.x * gridDim.y * gridDim.z;
  unsigned sum, cnt, mine, sp = 0u;
  for (;;) {
    sum = 0u; cnt = 0u; mine = 0u;
#pragma unroll
    for (unsigned j = 0; j < 16; ++j) { const unsigned c = xb_ld(&bar[XB_XCNT(j)]); sum += c; cnt += (c > 0u) ? 1u : 0u; mine = (j == x) ? c : mine; }
    if (sum == G) break;
    __builtin_amdgcn_s_sleep(1);
    if ((++sp & 255u) == 0u) { if (xb_ld(&bar[XB_TMO])) break; if (sp > XB_SPIN_CAP) { atomicAdd(&bar[XB_TMO], 1u); break; } }
  }
  nloc = mine > 0u ? mine : 1u; nx = cnt > 0u ? cnt : 1u;
}
__device__ __forceinline__ void xcd_barrier(const XcdBarrier& b) {
  asm volatile("s_waitcnt vmcnt(0)" ::: "memory");
  __syncthreads();
  if (threadIdx.x == 0) {
    unsigned* bar = b.bar;
    __builtin_amdgcn_s_waitcnt(0);
    unsigned nloc = b.st[0], nx = b.st[1];
    if (nloc == 0u) { xcd_barrier_complete(bar, b.x, nloc, nx); b.st[0] = nloc; b.st[1] = nx; }
    const unsigned old = xb_add(&bar[XB_XSUB(b.x)], 1u);
    const unsigned gen = old / nloc;
    if (old + 1u == (gen + 1u) * nloc) {
      __builtin_amdgcn_fence(__ATOMIC_RELEASE, "agent");
      asm volatile("s_waitcnt vmcnt(0)" ::: "memory");
      const unsigned og = xb_add(&bar[XB_TOP], 1u);
      const unsigned tg = og / nx;
      if (og + 1u == (tg + 1u) * nx) xb_add(&bar[XB_TOPGEN], 1u);
      else XB_SPIN(xb_ld(&bar[XB_TOPGEN]) == tg, bar);
      __builtin_amdgcn_fence(__ATOMIC_ACQUIRE, "agent");
      xb_add(&bar[XB_XGEN(b.x)], 1u);
      asm volatile("s_waitcnt vmcnt(0)" ::: "memory");
    } else {
      XB_SPIN(xb_ld(&bar[XB_XGEN(b.x)]) == gen, bar);
      __builtin_amdgcn_fence(__ATOMIC_ACQUIRE, "agent");
      asm volatile("s_waitcnt vmcnt(0)" ::: "memory");
    }
  }
  __syncthreads();
}

namespace pg8 {
#define PG8_LAS __attribute__((address_space(3)))
typedef unsigned short bf16_t;
typedef short bf16x8 __attribute__((ext_vector_type(8)));
typedef float f32x4 __attribute__((ext_vector_type(4)));
typedef unsigned u32x4 __attribute__((ext_vector_type(4)));
constexpr int BM = 256, BK = 64, HALF = 128, HTB = HALF * BK * 2  , STAGE_BYTES = 8 * HTB, NXCD = 8, WGM = 8;

__host__ __device__ __forceinline__ int lds_byte(int r, int c) { const int st = (r >> 4) * 2 + (c >> 5), rr = r & 15, cc = c & 31, ob = rr * 64 + cc * 2; return st * 1024 + (ob ^ (((ob >> 9) & 1) << 5)); }
__host__ __device__ __forceinline__ void stage_rc(int b, int& R, int& C) { const int st = b / 1024, sb = b % 1024, swz = sb ^ (((sb >> 9) & 1) << 5); R = (st >> 1) * 16 + swz / 64; C = (st & 1) * 32 + (swz % 64) / 2; }
__host__ __device__ __forceinline__ int perm32(int rho) { const int n = rho >> 4, i = rho & 15; return 8 * (i >> 2) + 4 * n + (i & 3); }

struct Unit { int pm, pn; };
struct Gemm { const bf16_t* A; const bf16_t* Bt; int M, N, K; };

struct StaticOrder {
    int nM, nN, nwg, G, c;
    __host__ __device__ void init(int M, int N, int G_, int c_) { nM = M / BM; nN = N / BM; nwg = nM * nN; G = G_; c = c_; }
    __host__ __device__ bool next(int i, Unit& u) const {
        const long L = (long)i * G + c; if (L >= nwg) return false;
        int wgid = (int)L; { const int q = nwg / NXCD, r = nwg % NXCD, xcd = wgid % NXCD, off = wgid / NXCD; wgid = (xcd < r ? xcd * (q + 1) : r * (q + 1) + (xcd - r) * q) + off; }
        const int nig = WGM * nN, gid = wgid / nig, fm = gid * WGM, gsz = (nM - fm) < WGM ? (nM - fm) : WGM;
        u.pm = fm + ((wgid % nig) % gsz); u.pn = (wgid % nig) / gsz; return true;
    }
    __device__ __forceinline__ void a_ready(const Unit&) const {}
    __device__ __forceinline__ void done(const Unit&) const {}
};
__device__ __forceinline__ unsigned cvt_pk_bf16(float lo, float hi) { unsigned r; asm volatile("v_cvt_pk_bf16_f32 %0, %1, %2" : "=v"(r) : "v"(lo), "v"(hi)); return r; }
template <class Epi, class Sched, bool STAMP = false>
__device__ __forceinline__ void gemm_phase(PG8_LAS unsigned char* lds, const Gemm g, const Sched& S, const Epi& E, unsigned long long* stamps) {
    const int tid = threadIdx.x, wid = __builtin_amdgcn_readfirstlane(tid >> 6), lane = tid & 63, wr = wid >> 2, wc = wid & 3, fr = lane & 15, fq = lane >> 4;
    const int K = g.K, nt = K / BK;
    int ts_lo = 0, ts_hi = 0, nts = 0; const unsigned long long rt_entry = STAMP ? (unsigned long long)wall_clock64() : 0ull;
#define PG8_STAMP() do { if (STAMP && wid == 0 && nts < 64) { const unsigned long long _c = (unsigned long long)clock64(); \
        ts_lo = (lane == nts) ? (int)(unsigned)_c : ts_lo; ts_hi = (lane == nts) ? (int)(unsigned)(_c >> 32) : ts_hi; ++nts; } } while (0)
    PG8_STAMP();
    unsigned voffA[2], voffB[2];
#pragma unroll
    for (int i = 0; i < 2; ++i) { int R, C; stage_rc(tid * 16 + i * 8192, R, C); const int Rb = Epi::PERM ? ((R & ~31) + perm32(R & 31)) : R;
        voffA[i] = (unsigned)(R * K + C) * 2u; voffB[i] = (unsigned)(Rb * K + C) * 2u; }
    const size_t kstep = (size_t)(BK * 2);
    const size_t hstep = (size_t)HALF * K * 2;
    const size_t tstep = 2 * hstep;
    const unsigned ldsw = (unsigned)wid * 1024u;
    const int aoff = lds_byte(wr * 64 + fr, fq * 8), boff = lds_byte(wc * 32 + fr, fq * 8);
#define PG8_SA(b, h) (((b) * 2 + (h)) * HTB)
#define PG8_SB(b, h) ((4 + (b) * 2 + (h)) * HTB)
#define PG8_STAGE(bufoff, gbase, voff) do { _Pragma("unroll") for (int _i = 0; _i < 2; ++_i) \
        __builtin_amdgcn_global_load_lds((const unsigned*)((const char*)(gbase) + (voff)[_i]), (PG8_LAS unsigned*)(lds + (bufoff) + ldsw + _i * 8192), 16, 0, 0); } while (0)
#define PG8_LDA(dst, b, h) do { _Pragma("unroll") for (int m = 0; m < 4; ++m) _Pragma("unroll") for (int k = 0; k < 2; ++k) dst[m][k] = *(const PG8_LAS bf16x8*)(lds + PG8_SA(b, h) + aoff + m * 2048 + k * 1024); } while (0)
#define PG8_LDB(dst, b, h) do { _Pragma("unroll") for (int n = 0; n < 2; ++n) _Pragma("unroll") for (int k = 0; k < 2; ++k) dst[n][k] = *(const PG8_LAS bf16x8*)(lds + PG8_SB(b, h) + boff + n * 2048 + k * 1024); } while (0)
#define PG8_MMA(ai, bj, At, Bt) do { __builtin_amdgcn_s_setprio(1); _Pragma("unroll") for (int m = 0; m < 4; ++m) _Pragma("unroll") for (int n = 0; n < 2; ++n) _Pragma("unroll") for (int k = 0; k < 2; ++k) \
        acc[ai][bj][m][n] = __builtin_amdgcn_mfma_f32_16x16x32_bf16(Bt[n][k], At[m][k], acc[ai][bj][m][n], 0, 0, 0); __builtin_amdgcn_s_setprio(0); } while (0)
#define PG8_WAIT_V(n) asm volatile("s_waitcnt vmcnt(" #n ")" ::: "memory")
#define PG8_WAIT_L(n) asm volatile("s_waitcnt lgkmcnt(" #n ")" ::: "memory")
#define PG8_BAR __builtin_amdgcn_s_barrier()
#define PG8_SCHED __builtin_amdgcn_sched_barrier(0)
    Unit cur, nxt; int ui = 0;
    if (!S.next(0, cur)) return;
    f32x4 acc[2][2][4][2];
#pragma unroll
    for (int a = 0; a < 2; ++a)
#pragma unroll
        for (int b = 0; b < 2; ++b)
#pragma unroll
            for (int m = 0; m < 4; ++m)
#pragma unroll
                for (int n = 0; n < 2; ++n) acc[a][b][m][n] = (f32x4){0.f, 0.f, 0.f, 0.f};
    bf16x8 At[4][2], B0[2][2], B1[2][2];
    const char* cA = (const char*)g.A + (size_t)cur.pm * tstep; const char* cB = (const char*)g.Bt + (size_t)cur.pn * tstep;
    S.a_ready(cur);
    PG8_STAGE(PG8_SB(0, 0), cB, voffB); PG8_STAGE(PG8_SA(0, 0), cA, voffA); PG8_STAGE(PG8_SB(0, 1), cB + hstep, voffB); PG8_STAGE(PG8_SA(0, 1), cA + hstep, voffA);
    if (wr == 1) PG8_BAR;
    PG8_WAIT_V(4); PG8_BAR;
    PG8_STAGE(PG8_SB(1, 0), cB + kstep, voffB); PG8_STAGE(PG8_SA(1, 0), cA + kstep, voffA); PG8_STAGE(PG8_SB(1, 1), cB + hstep + kstep, voffB);
    PG8_WAIT_V(6); PG8_BAR;
    PG8_STAMP();
    for (;;) {
        const bool has_next = S.next(ui + 1, nxt);
        const char* nA = has_next ? (const char*)g.A + (size_t)nxt.pm * tstep : cA; const char* nB = has_next ? (const char*)g.Bt + (size_t)nxt.pn * tstep : cB;
        for (int t = 0; t < nt; t += 2) {
            const bool last = (t == nt - 2);
            const char* a1 = cA + (size_t)(t + 1) * kstep;
            const char* a2 = last ? nA : cA + (size_t)(t + 2) * kstep; const char* b2 = last ? nB : cB + (size_t)(t + 2) * kstep;
            const char* a3 = a2 + kstep; const char* b3 = b2 + kstep;
            if (last && has_next) S.a_ready(nxt);
            PG8_LDB(B0, 0, 0); PG8_SCHED; PG8_LDA(At, 0, 0); PG8_STAGE(PG8_SA(1, 1), a1 + hstep, voffA);
            PG8_WAIT_L(8); PG8_BAR; PG8_WAIT_L(0); PG8_MMA(0, 0, At, B0); PG8_BAR; PG8_SCHED;
            PG8_LDB(B1, 0, 1); PG8_STAGE(PG8_SB(0, 0), b2, voffB);
            PG8_BAR; PG8_WAIT_L(0); PG8_MMA(0, 1, At, B1); PG8_BAR;
            PG8_LDA(At, 0, 1); PG8_STAGE(PG8_SA(0, 0), a2, voffA);
            PG8_BAR; PG8_WAIT_L(0); PG8_MMA(1, 0, At, B0); PG8_BAR; PG8_SCHED;
            PG8_STAGE(PG8_SB(0, 1), b2 + hstep, voffB);
            PG8_WAIT_V(6); PG8_BAR; PG8_MMA(1, 1, At, B1); PG8_BAR;
            PG8_LDB(B0, 1, 0); PG8_SCHED; PG8_LDA(At, 1, 0); PG8_STAGE(PG8_SA(0, 1), a2 + hstep, voffA);
            PG8_WAIT_L(8); PG8_BAR; PG8_WAIT_L(0); PG8_MMA(0, 0, At, B0); PG8_BAR; PG8_SCHED;
            PG8_LDB(B1, 1, 1); PG8_STAGE(PG8_SB(1, 0), b3, voffB);
            PG8_BAR; PG8_WAIT_L(0); PG8_MMA(0, 1, At, B1); PG8_BAR;
            PG8_LDA(At, 1, 1); PG8_STAGE(PG8_SA(1, 0), a3, voffA);
            PG8_BAR; PG8_WAIT_L(0); PG8_MMA(1, 0, At, B0); PG8_BAR; PG8_SCHED;
            PG8_STAGE(PG8_SB(1, 1), b3 + hstep, voffB);
            PG8_WAIT_V(6); PG8_BAR; PG8_MMA(1, 1, At, B1); PG8_BAR;
        }
        PG8_STAMP();
        if constexpr (!Epi::AFTER_DRAIN) { E(acc, cur, wr, wc, fr, fq); S.done(cur); }
        PG8_STAMP();
        if (!has_next) break;
#pragma unroll
        for (int a = 0; a < 2; ++a)
#pragma unroll
            for (int b = 0; b < 2; ++b)
#pragma unroll
                for (int m = 0; m < 4; ++m)
#pragma unroll
                    for (int n = 0; n < 2; ++n) acc[a][b][m][n] = (f32x4){0.f, 0.f, 0.f, 0.f};
        cur = nxt; cA = nA; cB = nB; ++ui;
    }
    PG8_WAIT_V(0);
    if (wr == 0) PG8_BAR;
    PG8_BAR;
    if constexpr (Epi::AFTER_DRAIN) { E.fused(acc, cur, wr, wc, fr, fq, lds, wid, lane); S.done(cur); }
    PG8_STAMP();
    if (STAMP && wid == 0) { stamps[lane] = lane < nts ? (((unsigned long long)(unsigned)ts_hi << 32) | (unsigned)ts_lo) : 0ull;
        if (lane == 62) stamps[62] = rt_entry; if (lane == 63) stamps[63] = (unsigned long long)wall_clock64(); }
#undef PG8_STAMP
#undef PG8_SA
#undef PG8_SB
#undef PG8_STAGE
#undef PG8_LDA
#undef PG8_LDB
#undef PG8_MMA
#undef PG8_WAIT_V
#undef PG8_WAIT_L
#undef PG8_BAR
#undef PG8_SCHED
}
}

struct EpiProj {
  static constexpr bool PERM = true, AFTER_DRAIN = false;
  unsigned short* pH; unsigned short* pA; unsigned short* pG;
  __device__ __forceinline__ void operator()(const pg8::f32x4 (&acc)[2][2][4][2], const pg8::Unit& u, int wr, int wc, int fr, int fq) const {
    const int row0 = u.pm * 256 + wr * 64 + fr;
    unsigned short* base; int ldc, colt; bool sg = false;
    if (u.pn < 8) { base = pH; ldc = 2048; colt = u.pn * 256; }
    else if (u.pn < 12) { base = pA; ldc = 1024; colt = (u.pn - 8) * 256; }
    else { base = pG; ldc = 2048; colt = (u.pn - 12) * 256; sg = true; }
    const int col0 = colt + wc * 32 + 8 * fq;
#pragma unroll
    for (int ai = 0; ai < 2; ++ai)
#pragma unroll
      for (int m = 0; m < 4; ++m) {
        unsigned short* rowp = base + (size_t)(row0 + ai * 128 + m * 16) * ldc + col0;
#pragma unroll
        for (int bj = 0; bj < 2; ++bj) {
          pg8::f32x4 v0 = acc[ai][bj][m][0], v1 = acc[ai][bj][m][1];
          if (sg) {
#pragma unroll
            for (int j = 0; j < 4; ++j) { v0[j] = sigmoidf_(v0[j]); v1[j] = sigmoidf_(v1[j]); }
          }
          pg8::u32x4 w; w.x = pg8::cvt_pk_bf16(v0[0], v0[1]); w.y = pg8::cvt_pk_bf16(v0[2], v0[3]); w.z = pg8::cvt_pk_bf16(v1[0], v1[1]); w.w = pg8::cvt_pk_bf16(v1[2], v1[3]);
          *(pg8::u32x4*)(rowp + bj * 128) = w;
        }
      }
  }
};
template <int MODE> struct EpiGate {
  static constexpr bool PERM = true, AFTER_DRAIN = false;
  unsigned short* hb; const unsigned short* pG; int goff;
  __device__ __forceinline__ void operator()(const pg8::f32x4 (&acc)[2][2][4][2], const pg8::Unit& u, int wr, int wc, int fr, int fq) const {
    const int row0 = u.pm * 256 + wr * 64 + fr;
    const int col0 = u.pn * 256 + wc * 32 + 8 * fq;
#pragma unroll
    for (int ai = 0; ai < 2; ++ai)
#pragma unroll
      for (int m = 0; m < 4; ++m) {
        const size_t r = (size_t)(row0 + ai * 128 + m * 16);
        pg8::u32x4 gv[2], hv[2];
#pragma unroll
        for (int bj = 0; bj < 2; ++bj) {
          gv[bj] = *(const pg8::u32x4*)(pG + r * 2048 + goff + col0 + bj * 128);
          if (MODE == 1) hv[bj] = *(const pg8::u32x4*)(hb + r * 1024 + col0 + bj * 128);
        }
#pragma unroll
        for (int bj = 0; bj < 2; ++bj) {
          float o[8];
#pragma unroll
          for (int j = 0; j < 4; ++j) {
            const unsigned gw0 = gv[bj][j >> 1], gw1 = gv[bj][2 + (j >> 1)];
            const float g0 = (j & 1) ? __uint_as_float(gw0 & 0xffff0000u) : __uint_as_float(gw0 << 16);
            const float g1 = (j & 1) ? __uint_as_float(gw1 & 0xffff0000u) : __uint_as_float(gw1 << 16);
            o[j] = acc[ai][bj][m][0][j] * g0; o[4 + j] = acc[ai][bj][m][1][j] * g1;
            if (MODE == 1) {
              const unsigned hw0 = hv[bj][j >> 1], hw1 = hv[bj][2 + (j >> 1)];
              o[j] += (j & 1) ? __uint_as_float(hw0 & 0xffff0000u) : __uint_as_float(hw0 << 16);
              o[4 + j] += (j & 1) ? __uint_as_float(hw1 & 0xffff0000u) : __uint_as_float(hw1 << 16);
            }
          }
          pg8::u32x4 w; w.x = pg8::cvt_pk_bf16(o[0], o[1]); w.y = pg8::cvt_pk_bf16(o[2], o[3]); w.z = pg8::cvt_pk_bf16(o[4], o[5]); w.w = pg8::cvt_pk_bf16(o[6], o[7]);
          *(pg8::u32x4*)(hb + r * 1024 + col0 + bj * 128) = w;
        }
      }
  }
};
struct EpiResid {
  static constexpr bool PERM = false, AFTER_DRAIN = false;
  float* out; const float* x;
  __device__ __forceinline__ void operator()(const pg8::f32x4 (&acc)[2][2][4][2], const pg8::Unit& u, int wr, int wc, int fr, int fq) const {
    const int row0 = u.pm * 256 + wr * 64 + fr, col0 = u.pn * 256 + wc * 32 + 4 * fq;
#pragma unroll
    for (int ai = 0; ai < 2; ++ai)
#pragma unroll
      for (int m = 0; m < 4; ++m) {
        const size_t off = (size_t)(row0 + ai * 128 + m * 16) * 1024 + col0;
        pg8::f32x4 xv[2][2];
#pragma unroll
        for (int bj = 0; bj < 2; ++bj)
#pragma unroll
          for (int n = 0; n < 2; ++n) xv[bj][n] = *(const pg8::f32x4*)(x + off + bj * 128 + n * 16);
#pragma unroll
        for (int bj = 0; bj < 2; ++bj)
#pragma unroll
          for (int n = 0; n < 2; ++n) *(pg8::f32x4*)(out + off + bj * 128 + n * 16) = acc[ai][bj][m][n] + xv[bj][n];
      }
  }
};
struct EpiStoreBf16 {
  static constexpr bool PERM = true, AFTER_DRAIN = false;
  unsigned short* O; int ldc;
  __device__ __forceinline__ void operator()(const pg8::f32x4 (&acc)[2][2][4][2], const pg8::Unit& u, int wr, int wc, int fr, int fq) const {
    const int row0 = u.pm * 256 + wr * 64 + fr, col0 = u.pn * 256 + wc * 32 + 8 * fq;
#pragma unroll
    for (int ai = 0; ai < 2; ++ai)
#pragma unroll
      for (int m = 0; m < 4; ++m) {
        unsigned short* rowp = O + (size_t)(row0 + ai * 128 + m * 16) * ldc + col0;
#pragma unroll
        for (int bj = 0; bj < 2; ++bj) {
          const pg8::f32x4 v0 = acc[ai][bj][m][0], v1 = acc[ai][bj][m][1];
          pg8::u32x4 w; w.x = pg8::cvt_pk_bf16(v0[0], v0[1]); w.y = pg8::cvt_pk_bf16(v0[2], v0[3]); w.z = pg8::cvt_pk_bf16(v1[0], v1[1]); w.w = pg8::cvt_pk_bf16(v1[2], v1[3]);
          *(pg8::u32x4*)(rowp + bj * 128) = w;
        }
      }
  }
};

__device__ __forceinline__ void gemm_tile(const bf16_t* __restrict__ A, int lda, const bf16_t* __restrict__ Bt, int ldb,
                                          int nk, f32x4 (&acc)[4][4], unsigned char* smem) {
  const int tid = threadIdx.x, lane = tid & 63, w = tid >> 6, wm = w >> 1, wn = w & 1, l15 = lane & 15, g = lane >> 4;
  unsigned char* sA = smem;
  unsigned char* sB = smem + 32768;
  const int lr = tid >> 3, lc = tid & 7;
  const bf16_t* ga = A + (size_t)lr * lda + lc * 8;
  const bf16_t* gb = Bt + (size_t)lr * ldb + lc * 8;
  uint4 ra0, ra1, ra2, ra3, rb0, rb1;
  ra0 = *(const uint4*)(ga);
  ra1 = *(const uint4*)(ga + (size_t)64 * lda);
  ra2 = *(const uint4*)(ga + (size_t)128 * lda);
  ra3 = *(const uint4*)(ga + (size_t)192 * lda);
  rb0 = *(const uint4*)(gb);
  rb1 = *(const uint4*)(gb + (size_t)64 * ldb);
  const int sw = (lc ^ (lr & 7)) << 4;
  for (int kt = 0; kt < nk; ++kt) {
    __syncthreads();
    *(uint4*)(sA + (lr) * 128 + sw) = ra0;
    *(uint4*)(sA + (lr + 64) * 128 + sw) = ra1;
    *(uint4*)(sA + (lr + 128) * 128 + sw) = ra2;
    *(uint4*)(sA + (lr + 192) * 128 + sw) = ra3;
    *(uint4*)(sB + (lr) * 128 + sw) = rb0;
    *(uint4*)(sB + (lr + 64) * 128 + sw) = rb1;
    __syncthreads();
    if (kt + 1 < nk) {
      const int ko = (kt + 1) * 64;
      ra0 = *(const uint4*)(ga + ko);
      ra1 = *(const uint4*)(ga + (size_t)64 * lda + ko);
      ra2 = *(const uint4*)(ga + (size_t)128 * lda + ko);
      ra3 = *(const uint4*)(ga + (size_t)192 * lda + ko);
      rb0 = *(const uint4*)(gb + ko);
      rb1 = *(const uint4*)(gb + (size_t)64 * ldb + ko);
    }
#pragma unroll
    for (int ks = 0; ks < 2; ++ks) {
      bf16x8 a[4], b[4];
#pragma unroll
      for (int m = 0; m < 4; ++m) { const int r = wm * 64 + m * 16 + l15; a[m] = *(const bf16x8*)(sA + r * 128 + (((ks * 4 + g) ^ (r & 7)) << 4)); }
#pragma unroll
      for (int n = 0; n < 4; ++n) { const int r = wn * 64 + n * 16 + l15; b[n] = *(const bf16x8*)(sB + r * 128 + (((ks * 4 + g) ^ (r & 7)) << 4)); }
#pragma unroll
      for (int m = 0; m < 4; ++m)
#pragma unroll
        for (int n = 0; n < 4; ++n) acc[m][n] = __builtin_amdgcn_mfma_f32_16x16x32_bf16(a[m], b[n], acc[m][n], 0, 0, 0);
    }
  }
}

__device__ __forceinline__ void zero_acc(f32x4 (&acc)[4][4]) {
#pragma unroll
  for (int m = 0; m < 4; ++m)
#pragma unroll
    for (int n = 0; n < 4; ++n) acc[m][n] = (f32x4){0.f, 0.f, 0.f, 0.f};
}

__device__ __forceinline__ void transpose_tile(const float* __restrict__ src, int srcN, bf16_t* __restrict__ dst, int K, int n0, int k0,
                                               bool winmap, float* tile) {
  const int tid = threadIdx.x;
  const int nc = tid & 63, kr = tid >> 6;
  int ncol = n0 + nc; bool valid = true;
  if (winmap) { if (ncol >= 3072) ncol -= 60; else if (ncol >= 3012) valid = false; }
#pragma unroll
  for (int i = 0; i < 8; ++i) {
    const int k = kr + 8 * i;
    tile[k * 65 + nc] = valid ? src[(size_t)(k0 + k) * srcN + ncol] : 0.f;
  }
  __syncthreads();
#pragma unroll
  for (int i = 0; i < 8; ++i) {
    const int nr = kr + 8 * i;
    dst[(size_t)(n0 + nr) * K + k0 + nc] = f2bf(tile[nc * 65 + nr]);
  }
  __syncthreads();
}

__device__ __forceinline__ void convert_f32_bf16(const float* __restrict__ src, bf16_t* __restrict__ dst, size_t n4) {
  for (size_t i = (size_t)blockIdx.x * NTHREADS + threadIdx.x; i < n4; i += (size_t)gridDim.x * NTHREADS) {
    const float4 v = ((const float4*)src)[i];
    uint2 o; o.x = pack2(v.x, v.y); o.y = pack2(v.z, v.w);
    ((uint2*)dst)[i] = o;
  }
}

template <bool SLICE_MAJOR, bool SIGNED>
__device__ __forceinline__ void quantize_rows_u8(const float* __restrict__ src, unsigned char* __restrict__ dst, float* __restrict__ scale) {
  const int lane = threadIdx.x & 63, w = threadIdx.x >> 6;
  for (int row = blockIdx.x * 8 + w; row < 16384; row += gridDim.x * 8) {
    const float4* s4 = (const float4*)(src + (size_t)row * 1024) + lane * 4;
    float4 v[4];
    float am = 0.f;
#pragma unroll
    for (int i = 0; i < 4; ++i) { v[i] = s4[i]; am = fmaxf(am, fmaxf(fmaxf(fabsf(v[i].x), fabsf(v[i].y)), fmaxf(fabsf(v[i].z), fabsf(v[i].w)))); }
#pragma unroll
    for (int o = 32; o > 0; o >>= 1) am = fmaxf(am, __shfl_xor(am, o));
    const float inv = am > 0.f ? 127.f / am : 0.f;
    unsigned pk[4];
#pragma unroll
    for (int i = 0; i < 4; ++i) {
      const int ofs = SIGNED ? 0 : 128;
      const unsigned b0 = (unsigned)((int)rintf(v[i].x * inv) + ofs), b1 = (unsigned)((int)rintf(v[i].y * inv) + ofs);
      const unsigned b2 = (unsigned)((int)rintf(v[i].z * inv) + ofs), b3 = (unsigned)((int)rintf(v[i].w * inv) + ofs);
      pk[i] = (b0 & 255u) | ((b1 & 255u) << 8) | ((b2 & 255u) << 16) | ((b3 & 255u) << 24);
    }
    if (SLICE_MAJOR) *(uint4*)(dst + (size_t)(lane >> 3) * (16384 * 128) + (size_t)row * 128 + (lane & 7) * 16) = make_uint4(pk[0], pk[1], pk[2], pk[3]);
    else *(uint4*)(dst + (size_t)row * 1024 + lane * 16) = make_uint4(pk[0], pk[1], pk[2], pk[3]);
    if (lane == 0) scale[row] = am * (1.f / 127.f);
  }
}

#define WS_XQ (WS_PH + (size_t)TOK * 1024 * 2)
#define WS_XS (WS_XQ + (size_t)TOK * 1024)
__device__ __forceinline__ void rmsnorm_rows_q(const float* __restrict__ src, const float* __restrict__ g, bf16_t* __restrict__ dst,
                                               unsigned char* __restrict__ xq, float* __restrict__ xs) {
  const int lane = threadIdx.x & 63, w = threadIdx.x >> 6;
  for (int row = blockIdx.x * 8 + w; row < TOK; row += gridDim.x * 8) {
    const float4* s4 = (const float4*)(src + (size_t)row * DM) + lane * 4;
    const float4* g4 = (const float4*)g + lane * 4;
    float v[16]; float ss = 0.f;
#pragma unroll
    for (int i = 0; i < 4; ++i) { const float4 t = s4[i]; v[4 * i] = t.x; v[4 * i + 1] = t.y; v[4 * i + 2] = t.z; v[4 * i + 3] = t.w; ss += t.x * t.x + t.y * t.y + t.z * t.z + t.w * t.w; }
    ss = wave_sum(ss);
    const float rstd = rsqrtf(ss * (1.f / DM) + EPSV);
    float am = 0.f;
#pragma unroll
    for (int i = 0; i < 4; ++i) { const float4 gg = g4[i]; v[4 * i] *= rstd * gg.x; v[4 * i + 1] *= rstd * gg.y; v[4 * i + 2] *= rstd * gg.z; v[4 * i + 3] *= rstd * gg.w; }
#pragma unroll
    for (int i = 0; i < 16; ++i) am = fmaxf(am, fabsf(v[i]));
#pragma unroll
    for (int o = 32; o > 0; o >>= 1) am = fmaxf(am, __shfl_xor(am, o));
    const float inv = am > 0.f ? 127.f / am : 0.f;
    uint4 ob0, ob1;
    ob0.x = pack2(v[0], v[1]); ob0.y = pack2(v[2], v[3]); ob0.z = pack2(v[4], v[5]); ob0.w = pack2(v[6], v[7]);
    ob1.x = pack2(v[8], v[9]); ob1.y = pack2(v[10], v[11]); ob1.z = pack2(v[12], v[13]); ob1.w = pack2(v[14], v[15]);
    *(uint4*)(dst + (size_t)row * DM + lane * 16) = ob0;
    *(uint4*)(dst + (size_t)row * DM + lane * 16 + 8) = ob1;
    unsigned pk[4];
#pragma unroll
    for (int i = 0; i < 4; ++i) {
      const unsigned b0 = (unsigned)(int)rintf(v[4 * i] * inv) & 255u, b1 = (unsigned)(int)rintf(v[4 * i + 1] * inv) & 255u;
      const unsigned b2 = (unsigned)(int)rintf(v[4 * i + 2] * inv) & 255u, b3 = (unsigned)(int)rintf(v[4 * i + 3] * inv) & 255u;
      pk[i] = b0 | (b1 << 8) | (b2 << 16) | (b3 << 24);
    }
    *(uint4*)(xq + (size_t)row * 1024 + lane * 16) = make_uint4(pk[0], pk[1], pk[2], pk[3]);
    if (lane == 0) xs[row] = am * (1.f / 127.f);
  }
}

__device__ __forceinline__ void rmsnorm_rows(const float* __restrict__ src, const float* __restrict__ g, bf16_t* __restrict__ dst) {
  const int lane = threadIdx.x & 63, w = threadIdx.x >> 6;
  for (int row = blockIdx.x * 8 + w; row < TOK; row += gridDim.x * 8) {
    const float4* s4 = (const float4*)(src + (size_t)row * DM);
    float4 v[4]; float ss = 0.f;
#pragma unroll
    for (int i = 0; i < 4; ++i) { v[i] = s4[lane + 64 * i]; ss += v[i].x * v[i].x + v[i].y * v[i].y + v[i].z * v[i].z + v[i].w * v[i].w; }
    ss = wave_sum(ss);
    const float rstd = rsqrtf(ss * (1.f / DM) + EPSV);
#pragma unroll
    for (int i = 0; i < 4; ++i) {
      const float4 gg = ((const float4*)g)[lane + 64 * i];
      uint2 o; o.x = pack2(v[i].x * rstd * gg.x, v[i].y * rstd * gg.y); o.y = pack2(v[i].z * rstd * gg.z, v[i].w * rstd * gg.w);
      ((uint2*)(dst + (size_t)row * DM))[lane + 64 * i] = o;
    }
  }
}

__device__ __forceinline__ void phase_prep(const Params& p, unsigned char* smem) {
  unsigned char* ws = p.ws;
  float* tile = (float*)smem;
  const int n_win = 80 * 16, n_ua = 16 * 8, n_ub = 16 * 8, n_wo = 16 * 16, n_wq = 32 * 16;
  const int total = n_win + n_ua + n_ub + n_wo + n_wq;
  for (int it = blockIdx.x; it < total; it += gridDim.x) {
    int t = it;
    if (t < n_win) { transpose_tile(p.w_in, 5060, (bf16_t*)(ws + WS_WIN), 1024, (t >> 4) * 64, (t & 15) * 64, true, tile); continue; }
    t -= n_win;
    if (t < n_ua) { transpose_tile(p.w_up_a, 1024, (bf16_t*)(ws + WS_WUPA), 512, (t >> 3) * 64, (t & 7) * 64, false, tile); continue; }
    t -= n_ua;
    if (t < n_ub) { transpose_tile(p.w_up_b, 1024, (bf16_t*)(ws + WS_WUPB), 512, (t >> 3) * 64, (t & 7) * 64, false, tile); continue; }
    t -= n_ub;
    if (t < n_wo) { transpose_tile(p.w_out, 1024, (bf16_t*)(ws + WS_WOUT), 1024, (t >> 4) * 64, (t & 15) * 64, false, tile); continue; }
    t -= n_wo;
    transpose_tile(p.peer_wq, 2048, (bf16_t*)(ws + WS_WQ), 1024, (t >> 4) * 64, (t & 15) * 64, false, tile);
  }
  quantize_rows_u8<false, true>(p.peer_u, ws + WS_U, (float*)(ws + WS_U + (size_t)16384 * 1024));
  quantize_rows_u8<true, false>(p.peer_v, ws + WS_V, (float*)(ws + WS_V + (size_t)16384 * 1024));
  convert_f32_bf16(p.peer_keys, (bf16_t*)(ws + WS_KEYS), (size_t)2 * 8 * 128 * 128 / 4);
  for (int i = blockIdx.x * NTHREADS + threadIdx.x; i < TOK; i += gridDim.x * NTHREADS) ((float*)(ws + WS_SSQ))[i] = 0.f;
  if (threadIdx.x == 0) ((int*)(ws + WS_XCC))[blockIdx.x] = (int)(__builtin_amdgcn_s_getreg((3 << 11) | 20) & 0xFu);
  if (blockIdx.x == 0) {
    const int i = threadIdx.x;
    const float a0 = p.hg_lb[i], a1 = p.hg_lb[512 + i];
    ((float*)(ws + WS_LB))[i] = 1.f / (1.f + expf(a1 - a0));
  }
  rmsnorm_rows(p.x, p.norm_mix, (bf16_t*)(ws + WS_XN));
}

__device__ __forceinline__ void phase_proj(const Params& p, unsigned char* smem) {
  unsigned char* ws = p.ws;
  const bf16_t* xn = (const bf16_t*)(ws + WS_XN);
  const bf16_t* wt = (const bf16_t*)(ws + WS_WIN);
  bf16_t* pH = (bf16_t*)(ws + WS_PH);
  bf16_t* pA = (bf16_t*)(ws + WS_PA);
  bf16_t* pG = (bf16_t*)(ws + WS_PG);
  const int tid = threadIdx.x, lane = tid & 63, w = tid >> 6, wm = w >> 1, wn = w & 1, l15 = lane & 15, g = lane >> 4;
  for (int tile = blockIdx.x; tile < 128 * 40; tile += gridDim.x) {
    const int tn = tile % 40, tm = tile / 40;
    f32x4 acc[4][4]; zero_acc(acc);
    gemm_tile(xn + (size_t)tm * 256 * 1024, 1024, wt + (size_t)tn * 128 * 1024, 1024, 16, acc, smem);
    const int rbase = tm * 256 + wm * 64 + 4 * g;
    const int cbase = tn * 128 + wn * 64 + l15;
    if (tn < 16) {
#pragma unroll
      for (int m = 0; m < 4; ++m)
#pragma unroll
        for (int n = 0; n < 4; ++n)
#pragma unroll
          for (int j = 0; j < 4; ++j) pH[(size_t)(rbase + m * 16 + j) * 2048 + cbase + n * 16] = f2bf(acc[m][n][j]);
    } else if (tn < 24) {
      if (tn == 23 && wn == 0) {
        float gam[4], bet[4];
#pragma unroll
        for (int n = 0; n < 4; ++n) { gam[n] = p.ikg[n * 16 + l15]; bet[n] = p.ikb[n * 16 + l15]; }
#pragma unroll
        for (int m = 0; m < 4; ++m)
#pragma unroll
          for (int j = 0; j < 4; ++j) {
            float s = acc[m][0][j] + acc[m][1][j] + acc[m][2][j] + acc[m][3][j];
            s += __shfl_xor(s, 1); s += __shfl_xor(s, 2); s += __shfl_xor(s, 4); s += __shfl_xor(s, 8);
            const float mu = s * (1.f / 64.f);
            float q = 0.f;
#pragma unroll
            for (int n = 0; n < 4; ++n) { const float d = acc[m][n][j] - mu; q += d * d; }
            q += __shfl_xor(q, 1); q += __shfl_xor(q, 2); q += __shfl_xor(q, 4); q += __shfl_xor(q, 8);
            const float rstd = rsqrtf(q * (1.f / 64.f) + EPSV);
#pragma unroll
            for (int n = 0; n < 4; ++n)
              pA[(size_t)(rbase + m * 16 + j) * 1024 + (cbase - 2048) + n * 16] = f2bf((acc[m][n][j] - mu) * rstd * gam[n] + bet[n]);
          }
      } else {
#pragma unroll
        for (int m = 0; m < 4; ++m)
#pragma unroll
          for (int n = 0; n < 4; ++n)
#pragma unroll
            for (int j = 0; j < 4; ++j) pA[(size_t)(rbase + m * 16 + j) * 1024 + (cbase - 2048) + n * 16] = f2bf(acc[m][n][j]);
      }
    } else {
#pragma unroll
      for (int m = 0; m < 4; ++m)
#pragma unroll
        for (int n = 0; n < 4; ++n)
#pragma unroll
          for (int j = 0; j < 4; ++j) pG[(size_t)(rbase + m * 16 + j) * 2048 + (cbase - 3072) + n * 16] = f2bf(sigmoidf_(acc[m][n][j]));
    }
  }
}

__device__ __forceinline__ void hgrn_item(const Params& p, unsigned char* smem, int bh) {
  unsigned char* ws = p.ws;
  const bf16_t* pH = (const bf16_t*)(ws + WS_PH);
  const float* lbp = (const float*)(ws + WS_LB);
  bf16_t* ya = (bf16_t*)(ws + WS_XN);
  bf16_t* Qt = (bf16_t*)smem;
  bf16_t* Kt = Qt + 64 * 136;
  bf16_t* KtT = Kt + 64 * 136;
  bf16_t* VT = KtT + 128 * 72;
  bf16_t* Am = VT + 128 * 72;
  bf16_t* ST = Am + 64 * 72;
  float* qtot = (float*)(ST + 128 * 136);
  float* eref = qtot + 512;
  float* elast = eref + 128;
  float* elr = elast + 128;
  float* red = elr + 128;
  const int tid = threadIdx.x, lane = tid & 63, w = tid >> 6, l15 = lane & 15, g = lane >> 4;
  const int b = bh >> 2, h = bh & 3;
  const int d = tid & 127, tq = tid >> 7;
  const float lbv = lbp[h * 128 + d];
  f32x4 S[8];
#pragma unroll
  for (int i = 0; i < 8; ++i) S[i] = (f32x4){0.f, 0.f, 0.f, 0.f};
  const float gnv = p.hg_norm[h * 128 + 16 * w + l15];

  for (int chunk = 0; chunk < 64; ++chunk) {
    const size_t row0 = (size_t)b * SEQL + chunk * 64;
    {
      const bf16_t* base = pH + (row0 + tq * 16) * 2048 + h * 128 + d;
      float lf[16], kk[16], qs[16];
      unsigned vv[8];
      float run = 0.f;
#pragma unroll
      for (int i = 0; i < 16; ++i) {
        const float fr = bf2f(base[(size_t)i * 2048 + 512]);
        const float qr = bf2f(base[(size_t)i * 2048]);
        const float sg = sigmoidf_(fr);
        const float fg = lbv + (1.f - lbv) * sg;
        run += __logf(fg);
        lf[i] = run; kk[i] = 1.f - fg; qs[i] = siluf_(qr);
      }
#pragma unroll
      for (int i = 0; i < 8; ++i) {
        const unsigned lo = base[(size_t)(2 * i) * 2048 + 1024], hi = base[(size_t)(2 * i + 1) * 2048 + 1024];
        vv[i] = lo | (hi << 16);
      }
      qtot[tq * 128 + d] = run;
      __syncthreads();
      const float q0 = qtot[d], q1 = qtot[128 + d], q2 = qtot[256 + d], q3 = qtot[384 + d];
      const float pre = (tq > 0 ? q0 : 0.f) + (tq > 1 ? q1 : 0.f) + (tq > 2 ? q2 : 0.f);
      const float bref = q0 + q1;
      const float blast = bref + q2 + q3;
      unsigned kp[8];
#pragma unroll
      for (int i = 0; i < 16; ++i) {
        const float bt = pre + lf[i];
        const float qt = qs[i] * __expf(bt - bref);
        const float kt = kk[i] * __expf(bref - bt);
        const int t = tq * 16 + i;
        Qt[t * 136 + d] = f2bf(qt);
        const bf16_t kb = f2bf(kt);
        Kt[t * 136 + d] = kb;
        if (i & 1) kp[i >> 1] |= ((unsigned)kb) << 16; else kp[i >> 1] = kb;
      }
      *(uint4*)(KtT + d * 72 + tq * 16) = make_uint4(kp[0], kp[1], kp[2], kp[3]);
      *(uint4*)(KtT + d * 72 + tq * 16 + 8) = make_uint4(kp[4], kp[5], kp[6], kp[7]);
      *(uint4*)(VT + d * 72 + tq * 16) = make_uint4(vv[0], vv[1], vv[2], vv[3]);
      *(uint4*)(VT + d * 72 + tq * 16 + 8) = make_uint4(vv[4], vv[5], vv[6], vv[7]);
      if (tq == 0) { eref[d] = __expf(bref); elast[d] = __expf(blast); elr[d] = __expf(blast - bref); }
    }
    __syncthreads();
    bf16_t ogr[16];
#pragma unroll
    for (int tm = 0; tm < 4; ++tm)
#pragma unroll
      for (int j = 0; j < 4; ++j) ogr[tm * 4 + j] = pH[(row0 + tm * 16 + 4 * g + j) * 2048 + 1536 + h * 128 + 16 * w + l15];
    {
      const int e = 16 * w + l15;
#pragma unroll
      for (int dm = 0; dm < 8; ++dm) {
        const int d0 = 16 * dm + 4 * g;
        uint2 o;
        o.x = pack2(S[dm][0] * eref[d0], S[dm][1] * eref[d0 + 1]);
        o.y = pack2(S[dm][2] * eref[d0 + 2], S[dm][3] * eref[d0 + 3]);
        *(uint2*)(ST + e * 136 + d0) = o;
      }
#pragma unroll
      for (int tt = 0; tt < 2; ++tt) {
        const int tl = 2 * w + tt, sm = tl >> 2, tn = tl & 3;
        f32x4 acc = (f32x4){0.f, 0.f, 0.f, 0.f};
        if (tn >= sm) {
#pragma unroll
          for (int k0 = 0; k0 < 128; k0 += 32) {
            const bf16x8 a = *(const bf16x8*)(Kt + (sm * 16 + l15) * 136 + k0 + 8 * g);
            const bf16x8 bq = *(const bf16x8*)(Qt + (tn * 16 + l15) * 136 + k0 + 8 * g);
            acc = __builtin_amdgcn_mfma_f32_16x16x32_bf16(a, bq, acc, 0, 0, 0);
          }
        }
        const int t = tn * 16 + l15, s0 = sm * 16 + 4 * g;
        uint2 o;
        o.x = pack2(s0 + 0 <= t ? acc[0] : 0.f, s0 + 1 <= t ? acc[1] : 0.f);
        o.y = pack2(s0 + 2 <= t ? acc[2] : 0.f, s0 + 3 <= t ? acc[3] : 0.f);
        *(uint2*)(Am + t * 72 + s0) = o;
      }
    }
    __syncthreads();
    f32x4 o[4];
    {
#pragma unroll
      for (int tm = 0; tm < 4; ++tm) {
        f32x4 acc = (f32x4){0.f, 0.f, 0.f, 0.f};
#pragma unroll
        for (int k0 = 0; k0 < 128; k0 += 32) {
          const bf16x8 a = *(const bf16x8*)(Qt + (tm * 16 + l15) * 136 + k0 + 8 * g);
          const bf16x8 bb = *(const bf16x8*)(ST + (16 * w + l15) * 136 + k0 + 8 * g);
          acc = __builtin_amdgcn_mfma_f32_16x16x32_bf16(a, bb, acc, 0, 0, 0);
        }
#pragma unroll
        for (int k0 = 0; k0 < 64; k0 += 32) {
          const bf16x8 a = *(const bf16x8*)(Am + (tm * 16 + l15) * 72 + k0 + 8 * g);
          const bf16x8 bb = *(const bf16x8*)(VT + (16 * w + l15) * 72 + k0 + 8 * g);
          acc = __builtin_amdgcn_mfma_f32_16x16x32_bf16(a, bb, acc, 0, 0, 0);
        }
        o[tm] = acc;
#pragma unroll
        for (int j = 0; j < 4; ++j) {
          float ss = acc[j] * acc[j];
          ss += __shfl_xor(ss, 1); ss += __shfl_xor(ss, 2); ss += __shfl_xor(ss, 4); ss += __shfl_xor(ss, 8);
          if (l15 == 0) red[w * 64 + tm * 16 + 4 * g + j] = ss;
        }
      }
#pragma unroll
      for (int dm = 0; dm < 8; ++dm) {
        f32x4 acc = (f32x4){0.f, 0.f, 0.f, 0.f};
#pragma unroll
        for (int k0 = 0; k0 < 64; k0 += 32) {
          const bf16x8 a = *(const bf16x8*)(KtT + (dm * 16 + l15) * 72 + k0 + 8 * g);
          const bf16x8 bb = *(const bf16x8*)(VT + (16 * w + l15) * 72 + k0 + 8 * g);
          acc = __builtin_amdgcn_mfma_f32_16x16x32_bf16(a, bb, acc, 0, 0, 0);
        }
#pragma unroll
        for (int j = 0; j < 4; ++j) { const int dd = 16 * dm + 4 * g + j; S[dm][j] = elast[dd] * S[dm][j] + elr[dd] * acc[j]; }
      }
    }
    __syncthreads();
    {
      const int e = 16 * w + l15;
#pragma unroll
      for (int tm = 0; tm < 4; ++tm)
#pragma unroll
        for (int j = 0; j < 4; ++j) {
          const int t = tm * 16 + 4 * g + j;
          float tot = 0.f;
#pragma unroll
          for (int ww = 0; ww < 8; ++ww) tot += red[ww * 64 + t];
          const float rstd = rsqrtf(tot * (1.f / 128.f) + EPSV);
          const float og = bf2f(ogr[tm * 4 + j]);
          ya[(row0 + t) * 512 + h * 128 + e] = f2bf(o[tm][j] * rstd * gnv * siluf_(og));
        }
    }
  }
}

#define SCW 4100
#ifndef DSA_REP
#define DSA_REP 0
#endif
#define DSA_BKT_OFF (8 * SCW * 4 + 8 * 256 * 4 + 8 * 256 * 2 + 8 * 512 * 2)
__device__ __forceinline__ void cvt8(const uint4& v, float* f) {
  f[0] = __uint_as_float(v.x << 16); f[1] = __uint_as_float(v.x & 0xffff0000u);
  f[2] = __uint_as_float(v.y << 16); f[3] = __uint_as_float(v.y & 0xffff0000u);
  f[4] = __uint_as_float(v.z << 16); f[5] = __uint_as_float(v.z & 0xffff0000u);
  f[6] = __uint_as_float(v.w << 16); f[7] = __uint_as_float(v.w & 0xffff0000u);
}
__device__ __forceinline__ unsigned sortable_key(float v) {
  unsigned bits = __float_as_uint(v);
  if (bits == 0x80000000u) bits = 0u;
  return (bits & 0x80000000u) ? ~bits : (bits | 0x80000000u);
}

__device__ __forceinline__ void dsa_item(const Params& p, unsigned char* smem, int item) {
  unsigned char* ws = p.ws;
  const bf16_t* pA = (const bf16_t*)(ws + WS_PA);
  bf16_t* yb = (bf16_t*)(ws + WS_XN) + (size_t)TOK * 512;
  unsigned* sc = (unsigned*)smem;
  unsigned* hist = sc + 8 * SCW;
  unsigned short* sel = (unsigned short*)(hist + 8 * 256);
  unsigned short* cand = sel + 8 * 256;
  unsigned char* bkt = (unsigned char*)(cand + 8 * 512);
  const int tid = threadIdx.x, lane = tid & 63, w = tid >> 6, l15 = lane & 15, g = lane >> 4;
  const int b = item >> 9;
  const int r = item & 511;
  const int tb = (b & 1) ? 511 - r : r;
  const int t0 = tb * 8;
  const size_t tokbase = (size_t)b * SEQL;

  for (int rep_s = 0; rep_s < (DSA_REP == 1 ? 2 : 1); ++rep_s) {
    bf16x8 af[2][2];
    float wq[2][4];
#pragma unroll
    for (int mt = 0; mt < 2; ++mt) {
      const int qrow = t0 + mt * 4 + (l15 >> 2), head = l15 & 3;
#pragma unroll
      for (int ks = 0; ks < 2; ++ks)
        af[mt][ks] = *(const bf16x8*)(pA + (tokbase + qrow) * 1024 + 640 + head * 64 + ks * 32 + 8 * g);
      const uint2 wr = *(const uint2*)(pA + (tokbase + t0 + mt * 4 + g) * 1024 + 960);
      wq[mt][0] = 0.5f * bf2f((bf16_t)(wr.x & 0xffff)); wq[mt][1] = 0.5f * bf2f((bf16_t)(wr.x >> 16));
      wq[mt][2] = 0.5f * bf2f((bf16_t)(wr.y & 0xffff)); wq[mt][3] = 0.5f * bf2f((bf16_t)(wr.y >> 16));
    }
    const int nkt = (t0 + 8 + 15) >> 4;
    for (int kt0 = w; kt0 < nkt; kt0 += 32) {
      bf16x8 b0[4], b1[4];
#pragma unroll
      for (int u = 0; u < 4; ++u) {
        const int kt = kt0 + 8 * u;
        const int s = (kt < nkt ? kt : 0) * 16 + l15;
        const bf16_t* kr = pA + (tokbase + s) * 1024 + 896 + 8 * g;
        b0[u] = *(const bf16x8*)kr;
        b1[u] = *(const bf16x8*)(kr + 32);
      }
#pragma unroll
      for (int u = 0; u < 4; ++u) {
        const int kt = kt0 + 8 * u;
        if (kt < nkt) {
          const int s = kt * 16 + l15;
#pragma unroll
          for (int mt = 0; mt < 2; ++mt) {
            f32x4 acc = (f32x4){0.f, 0.f, 0.f, 0.f};
            acc = __builtin_amdgcn_mfma_f32_16x16x32_bf16(af[mt][0], b0[u], acc, 0, 0, 0);
            acc = __builtin_amdgcn_mfma_f32_16x16x32_bf16(af[mt][1], b1[u], acc, 0, 0, 0);
            float v = 0.f;
#pragma unroll
            for (int j = 0; j < 4; ++j) v += wq[mt][j] * fmaxf(acc[j] * 0.125f, 0.f);
            const int t = t0 + mt * 4 + g;
            unsigned vb = __float_as_uint(v); if (vb == 0x80000000u) vb = 0u;
            sc[(mt * 4 + g) * SCW + s] = vb;
          }
        }
      }
    }
  }
  __syncthreads();
  const int t = t0 + w;
  const int n = t + 1;
  unsigned* row = sc + w * SCW;
  const float* rowf = (const float*)row;
  unsigned short* mysel = sel + w * 256;
  unsigned short* mycand = cand + w * 512;
  unsigned* myh = hist + w * 256;
  int cnt;
  const unsigned long long lt_mask = (1ull << lane) - 1ull;
  for (int rep_t = 0; rep_t < (DSA_REP == 2 ? 2 : 1); ++rep_t)
  if (n <= 256) {
    for (int i = lane; i < n; i += 64) mysel[i] = (unsigned short)i;
    cnt = n;
  } else {
    cnt = 256;
    float mn = INFINITY, mx = -INFINITY;
    for (int i = lane; i < n; i += 64) { const float v = rowf[i]; mn = fminf(mn, v); mx = fmaxf(mx, v); }
#pragma unroll
    for (int o = 32; o > 0; o >>= 1) { mn = fminf(mn, __shfl_xor(mn, o)); mx = fmaxf(mx, __shfl_xor(mx, o)); }
    const float scale = (mx > mn) ? 255.99f / (mx - mn) : 0.f;
#pragma unroll
    for (int i = 0; i < 4; ++i) myh[lane + 64 * i] = 0u;
    lds_fence();
    for (int i = lane; i < n; i += 64) {
      const float v = rowf[i];
      int bn = (int)((v - mn) * scale); bn = bn > 255 ? 255 : bn;
      atomicAdd(&myh[bn], 1u);
    }
    lds_fence();
    unsigned cum; int bstar; unsigned mcount;
    {
      const uint4 c4 = *(const uint4*)(myh + 4 * lane);
      const unsigned c = c4.x + c4.y + c4.z + c4.w;
      unsigned sfx = c;
#pragma unroll
      for (int o = 1; o < 64; o <<= 1) { const unsigned tt = __shfl_down(sfx, o); if (lane + o < 64) sfx += tt; }
      const unsigned long long bal = __ballot(sfx >= 256u);
      const int L = 63 - __clzll(bal);
      const unsigned sL = __shfl(sfx, L), cL = __shfl(c, L);
      const unsigned b3 = __shfl(c4.w, L), b2 = __shfl(c4.z, L), b1 = __shfl(c4.y, L), b0 = __shfl(c4.x, L);
      cum = sL - cL;
      int digit;
      if (cum + b3 >= 256u) { digit = 3; mcount = b3; }
      else { cum += b3; if (cum + b2 >= 256u) { digit = 2; mcount = b2; } else { cum += b2; if (cum + b1 >= 256u) { digit = 1; mcount = b1; } else { cum += b1; digit = 0; mcount = b0; } } }
      bstar = 4 * L + digit;
    }
    const unsigned need = 256u - cum;
    if (mcount <= 512u) {
      unsigned base = 0u, cb = 0u;
      for (int i0 = 0; i0 < n; i0 += 64) {
        const int i = i0 + lane;
        const bool valid = i < n;
        const float v = valid ? rowf[i] : 0.f;
        int bn = (int)((v - mn) * scale); bn = bn > 255 ? 255 : bn;
        const bool gt = valid && (bn > bstar);
        const bool eq = valid && (bn == bstar);
        const unsigned long long bg = __ballot(gt), be = __ballot(eq);
        if (gt) mysel[base + (unsigned)__popcll(bg & lt_mask)] = (unsigned short)i;
        if (eq) mycand[cb + (unsigned)__popcll(be & lt_mask)] = (unsigned short)i;
        base += (unsigned)__popcll(bg); cb += (unsigned)__popcll(be);
      }
      lds_fence();
      const int m = (int)mcount;
      unsigned ck[8]; unsigned short ci[8];
#pragma unroll
      for (int q = 0; q < 8; ++q) {
        const int c = q * 64 + lane;
        ck[q] = 0u; ci[q] = 0;
        if (c < m) { ci[q] = mycand[c]; ck[q] = sortable_key(rowf[ci[q]]); }
      }
      unsigned T = 0u;
#pragma unroll 1
      for (int bit = 31; bit >= 0; --bit) {
        const unsigned trial = T | (1u << bit);
        unsigned cge = 0u;
#pragma unroll
        for (int q = 0; q < 8; ++q) cge += (unsigned)__popcll(__ballot(ck[q] >= trial));
        if (cge >= need) T = trial;
      }
      unsigned cgt = 0u;
#pragma unroll
      for (int q = 0; q < 8; ++q) cgt += (unsigned)__popcll(__ballot(ck[q] > T));
      const unsigned need_eq = need - cgt;
      unsigned pos0 = cum, eqtaken = 0u;
#pragma unroll
      for (int q = 0; q < 8; ++q) {
        const bool gt = ck[q] > T;
        const bool eq = ck[q] == T;
        const unsigned long long beq = __ballot(eq);
        const bool take = gt || (eq && (eqtaken + (unsigned)__popcll(beq & lt_mask)) < need_eq);
        const unsigned long long bt = __ballot(take);
        const unsigned pp = pos0 + (unsigned)__popcll(bt & lt_mask);
        if (take && pp < 256u) mysel[pp] = ci[q];
        pos0 += (unsigned)__popcll(bt);
        eqtaken += (unsigned)__popcll(beq);
      }
    } else {
      unsigned prefix = 0u, krem = 256u;
#pragma unroll 1
      for (int pass = 0; pass < 4; ++pass) {
        const int shift = 24 - 8 * pass;
        const unsigned himask = (pass == 0) ? 0u : (0xFFFFFFFFu << (shift + 8));
#pragma unroll
        for (int i = 0; i < 4; ++i) myh[lane + 64 * i] = 0u;
        lds_fence();
        for (int i = lane; i < n; i += 64) {
          const unsigned u = sortable_key(rowf[i]);
          if ((u & himask) == prefix) atomicAdd(&myh[(u >> shift) & 255u], 1u);
        }
        lds_fence();
        const uint4 c4 = *(const uint4*)(myh + 4 * lane);
        const unsigned c = c4.x + c4.y + c4.z + c4.w;
        unsigned sfx = c;
#pragma unroll
        for (int o = 1; o < 64; o <<= 1) { const unsigned tt = __shfl_down(sfx, o); if (lane + o < 64) sfx += tt; }
        const unsigned long long bal = __ballot(sfx >= krem);
        const int L = 63 - __clzll(bal);
        const unsigned sL = __shfl(sfx, L), cL = __shfl(c, L);
        const unsigned b3 = __shfl(c4.w, L), b2 = __shfl(c4.z, L), b1 = __shfl(c4.y, L);
        unsigned cum2 = sL - cL;
        unsigned digit;
        if (cum2 + b3 >= krem) digit = 3;
        else { cum2 += b3; if (cum2 + b2 >= krem) digit = 2; else { cum2 += b2; if (cum2 + b1 >= krem) digit = 1; else { cum2 += b1; digit = 0; } } }
        krem -= cum2;
        prefix |= ((unsigned)(4 * L) + digit) << shift;
      }
      const unsigned T = prefix;
      unsigned base = 0u, eqtaken = 0u;
      for (int i0 = 0; i0 < n; i0 += 64) {
        const int i = i0 + lane;
        const bool valid = i < n;
        const unsigned u = valid ? sortable_key(rowf[i]) : 0u;
        const bool gt = valid && (u > T);
        const bool eq = valid && (u == T);
        const unsigned long long beq = __ballot(eq);
        const unsigned eqrank = eqtaken + (unsigned)__popcll(beq & lt_mask);
        const bool take = gt || (eq && eqrank < krem);
        const unsigned long long bt = __ballot(take);
        const unsigned pos = base + (unsigned)__popcll(bt & lt_mask);
        if (take && pos < 256u) mysel[pos] = (unsigned short)i;
        base += (unsigned)__popcll(bt);
        eqtaken += (unsigned)__popcll(beq);
      }
    }
  }
  lds_fence();
  for (int rep_a = 0; rep_a < (DSA_REP == 3 ? 2 : 1); ++rep_a) {
    const int ks = lane >> 3, dc = lane & 7;
    float* pl = (float*)row;
    const int niter = (cnt + 7) >> 3;
    {
      const float* relb = (const float*)(bkt + 128);
      bf16x8 bq[2];
#pragma unroll
      for (int ks2 = 0; ks2 < 2; ++ks2) {
        bq[ks2] = (bf16x8){0, 0, 0, 0, 0, 0, 0, 0};
        if (l15 < 8) bq[ks2] = *(const bf16x8*)(pA + (tokbase + t) * 1024 + l15 * 64 + ks2 * 32 + 8 * g);
      }
      const int ntile = (cnt + 15) >> 4;
      for (int kt0 = 0; kt0 < ntile; kt0 += 4) {
        bf16x8 ka[4][2];
#pragma unroll
        for (int u = 0; u < 4; ++u) {
          const int kk = (kt0 + u) * 16 + l15;
          const int s = (kk < cnt) ? (int)mysel[kk] : 0;
          const bf16_t* kr = pA + (tokbase + s) * 1024 + 512 + 8 * g;
          ka[u][0] = *(const bf16x8*)kr;
          ka[u][1] = *(const bf16x8*)(kr + 32);
        }
#pragma unroll
        for (int u = 0; u < 4; ++u) {
          if (kt0 + u < ntile) {
            f32x4 acc = (f32x4){0.f, 0.f, 0.f, 0.f};
            acc = __builtin_amdgcn_mfma_f32_16x16x32_bf16(ka[u][0], bq[0], acc, 0, 0, 0);
            acc = __builtin_amdgcn_mfma_f32_16x16x32_bf16(ka[u][1], bq[1], acc, 0, 0, 0);
            if (l15 < 8) {
#pragma unroll
              for (int j = 0; j < 4; ++j) {
                const int key = (kt0 + u) * 16 + 4 * g + j;
                const bool valid = key < cnt;
                const int sj = valid ? (int)mysel[key] : 0;
                const int dist = t - sj;
                const int bk = dist < 128 ? (int)bkt[dist] : 31;
                pl[key * 8 + l15] = valid ? (acc[j] * 0.125f + relb[bk * 8 + l15]) : -INFINITY;
              }
            }
          }
        }
      }
    }
    lds_fence();
    float inv;
    {
      const int hh = lane & 7, part = lane >> 3;
      float m = -INFINITY;
      for (int kk = part; kk < cnt; kk += 8) m = fmaxf(m, pl[kk * 8 + hh]);
      m = fmaxf(m, __shfl_xor(m, 8)); m = fmaxf(m, __shfl_xor(m, 16)); m = fmaxf(m, __shfl_xor(m, 32));
      float sum = 0.f;
      for (int kk = part; kk < niter * 8; kk += 8) {
        const float e = (kk < cnt) ? __expf(pl[kk * 8 + hh] - m) : 0.f;
        pl[kk * 8 + hh] = e;
        sum += e;
      }
      sum += __shfl_xor(sum, 8); sum += __shfl_xor(sum, 16); sum += __shfl_xor(sum, 32);
      inv = 1.f / sum;
    }
    lds_fence();
    float acc[8][8];
#pragma unroll
    for (int hh = 0; hh < 8; ++hh)
#pragma unroll
      for (int i = 0; i < 8; ++i) acc[hh][i] = 0.f;
    for (int it0 = 0; it0 < niter; it0 += 8) {
      uint4 vv[8];
#pragma unroll
      for (int u = 0; u < 8; ++u) {
        const int kk = (it0 + u) * 8 + ks;
        const int s = (kk < cnt) ? (int)mysel[kk] : 0;
        vv[u] = *(const uint4*)(pA + (tokbase + s) * 1024 + 576 + dc * 8);
      }
#pragma unroll
      for (int u = 0; u < 8; ++u) {
        if (it0 + u < niter) {
          const int kk = (it0 + u) * 8 + ks;
          float vf[8];
          cvt8(vv[u], vf);
          const float4 p0 = *(const float4*)(pl + kk * 8);
          const float4 p1 = *(const float4*)(pl + kk * 8 + 4);
          const float pp[8] = {p0.x, p0.y, p0.z, p0.w, p1.x, p1.y, p1.z, p1.w};
#pragma unroll
          for (int hh = 0; hh < 8; ++hh)
#pragma unroll
            for (int i = 0; i < 8; ++i) acc[hh][i] += pp[hh] * vf[i];
        }
      }
    }
#pragma unroll
    for (int hh = 0; hh < 8; ++hh) {
      const float ih = __shfl(inv, hh);
#pragma unroll
      for (int i = 0; i < 8; ++i) {
        float v = acc[hh][i];
        v += __shfl_xor(v, 8); v += __shfl_xor(v, 16); v += __shfl_xor(v, 32);
        acc[hh][i] = v * ih;
      }
    }
    if (ks == 0) {
#pragma unroll
      for (int hh = 0; hh < 8; ++hh) {
        uint4 o;
        o.x = pack2(acc[hh][0], acc[hh][1]); o.y = pack2(acc[hh][2], acc[hh][3]);
        o.z = pack2(acc[hh][4], acc[hh][5]); o.w = pack2(acc[hh][6], acc[hh][7]);
        *(uint4*)(yb + (tokbase + t) * 512 + hh * 64 + dc * 8) = o;
      }
    }
  }
  __syncthreads();
}

__device__ __forceinline__ void phase_mix(const Params& p, unsigned char* smem, int mode = 0) {
  const int G = gridDim.x;
  if (G >= 64) {
    if (blockIdx.x < 32) { if (mode != 2) hgrn_item(p, smem, blockIdx.x); return; }
    if (mode == 1) return;
    unsigned char* bkt = smem + DSA_BKT_OFF;
    if (threadIdx.x < 128) {
      const int nn = threadIdx.x;
      int v = nn;
      if (nn >= 16) { v = 16 + (int)(logf((float)nn * (1.f / 16.f)) / logf(8.f) * 16.f); if (v > 31) v = 31; }
      bkt[nn] = (unsigned char)v;
    }
    if (threadIdx.x >= 256) ((float*)(bkt + 128))[threadIdx.x - 256] = p.rel_bias[threadIdx.x - 256];
    __syncthreads();
    for (int item = blockIdx.x - 32; item < 4096; item += G - 32) dsa_item(p, smem, item);
  } else {
    for (int bh = blockIdx.x; bh < 32; bh += G) { hgrn_item(p, smem, bh); __syncthreads(); }
    unsigned char* bkt = smem + DSA_BKT_OFF;
    __syncthreads();
    if (threadIdx.x < 128) {
      const int nn = threadIdx.x;
      int v = nn;
      if (nn >= 16) { v = 16 + (int)(logf((float)nn * (1.f / 16.f)) / logf(8.f) * 16.f); if (v > 31) v = 31; }
      bkt[nn] = (unsigned char)v;
    }
    if (threadIdx.x >= 256) ((float*)(bkt + 128))[threadIdx.x - 256] = p.rel_bias[threadIdx.x - 256];
    __syncthreads();
    for (int item = blockIdx.x; item < 4096; item += G) dsa_item(p, smem, item);
  }
}

__device__ __forceinline__ void phase_up(const Params& p, unsigned char* smem) {
  unsigned char* ws = p.ws;
  const bf16_t* ya = (const bf16_t*)(ws + WS_XN);
  const bf16_t* yb = ya + (size_t)TOK * 512;
  const bf16_t* wa = (const bf16_t*)(ws + WS_WUPA);
  const bf16_t* wb = (const bf16_t*)(ws + WS_WUPB);
  const bf16_t* pG = (const bf16_t*)(ws + WS_PG);
  bf16_t* hb = (bf16_t*)(ws + WS_PH);
  const int tid = threadIdx.x, lane = tid & 63, w = tid >> 6, wm = w >> 1, wn = w & 1, l15 = lane & 15, g = lane >> 4;
  for (int tile = blockIdx.x; tile < 128 * 8; tile += gridDim.x) {
    const int tn = tile & 7, tm = tile >> 3;
    f32x4 acc[4][4]; zero_acc(acc);
    gemm_tile(ya + (size_t)tm * 256 * 512, 512, wa + (size_t)tn * 128 * 512, 512, 8, acc, smem);
    asm volatile("" ::: "memory");
    const int rbase = tm * 256 + wm * 64 + 4 * g;
    const int cbase = tn * 128 + wn * 64 + l15;
#pragma unroll
    for (int m = 0; m < 4; ++m) {
      bf16_t gt[16];
#pragma unroll
      for (int n = 0; n < 4; ++n)
#pragma unroll
        for (int j = 0; j < 4; ++j) gt[n * 4 + j] = pG[(size_t)(rbase + m * 16 + j) * 2048 + cbase + n * 16];
#pragma unroll
      for (int n = 0; n < 4; ++n) {
#pragma unroll
        for (int j = 0; j < 4; ++j) {
          const size_t rr = (size_t)(rbase + m * 16 + j);
          hb[rr * 1024 + cbase + n * 16] = f2bf(acc[m][n][j] * bf2f(gt[n * 4 + j]));
        }
        acc[m][n] = (f32x4){0.f, 0.f, 0.f, 0.f};
      }
    }
    asm volatile("" ::: "memory");
    gemm_tile(yb + (size_t)tm * 256 * 512, 512, wb + (size_t)tn * 128 * 512, 512, 8, acc, smem);
    asm volatile("" ::: "memory");
#pragma unroll
    for (int m = 0; m < 4; ++m) {
      bf16_t gt[16], ht[16];
#pragma unroll
      for (int n = 0; n < 4; ++n)
#pragma unroll
        for (int j = 0; j < 4; ++j) {
          const size_t rr = (size_t)(rbase + m * 16 + j);
          gt[n * 4 + j] = pG[rr * 2048 + 1024 + cbase + n * 16];
          ht[n * 4 + j] = hb[rr * 1024 + cbase + n * 16];
        }
#pragma unroll
      for (int n = 0; n < 4; ++n)
#pragma unroll
        for (int j = 0; j < 4; ++j) {
          const size_t rr = (size_t)(rbase + m * 16 + j);
          hb[rr * 1024 + cbase + n * 16] = f2bf(bf2f(ht[n * 4 + j]) + acc[m][n][j] * bf2f(gt[n * 4 + j]));
        }
    }
  }
}

__device__ __forceinline__ void phase_out(const Params& p, unsigned char* smem) {
  unsigned char* ws = p.ws;
  const bf16_t* hb = (const bf16_t*)(ws + WS_PH);
  const bf16_t* wo = (const bf16_t*)(ws + WS_WOUT);
  const int tid = threadIdx.x, lane = tid & 63, w = tid >> 6, wm = w >> 1, wn = w & 1, l15 = lane & 15, g = lane >> 4;
  for (int tile = blockIdx.x; tile < 128 * 8; tile += gridDim.x) {
    const int tn = tile & 7, tm = tile >> 3;
    f32x4 acc[4][4]; zero_acc(acc);
    gemm_tile(hb + (size_t)tm * 256 * 1024, 1024, wo + (size_t)tn * 128 * 1024, 1024, 16, acc, smem);
    const int rbase = tm * 256 + wm * 64 + 4 * g;
    const int cbase = tn * 128 + wn * 64 + l15;
#pragma unroll
    for (int m = 0; m < 4; ++m) {
      float xt[16];
#pragma unroll
      for (int n = 0; n < 4; ++n)
#pragma unroll
        for (int j = 0; j < 4; ++j) xt[n * 4 + j] = p.x[(size_t)(rbase + m * 16 + j) * 1024 + cbase + n * 16];
#pragma unroll
      for (int n = 0; n < 4; ++n)
#pragma unroll
        for (int j = 0; j < 4; ++j) p.out[(size_t)(rbase + m * 16 + j) * 1024 + cbase + n * 16] = xt[n * 4 + j] + acc[m][n][j];
    }
  }
}

__device__ __forceinline__ void phase_pq(const Params& p, unsigned char* smem) {
  unsigned char* ws = p.ws;
  const bf16_t* xn2 = (const bf16_t*)(ws + WS_XN);
  const bf16_t* wq = (const bf16_t*)(ws + WS_WQ);
  bf16_t* qp = (bf16_t*)(ws + WS_PG);
  const int tid = threadIdx.x, lane = tid & 63, w = tid >> 6, wm = w >> 1, wn = w & 1, l15 = lane & 15, g = lane >> 4;
  for (int tile = blockIdx.x; tile < 128 * 16; tile += gridDim.x) {
    const int tn = tile & 15, tm = tile >> 4;
    f32x4 acc[4][4]; zero_acc(acc);
    gemm_tile(xn2 + (size_t)tm * 256 * 1024, 1024, wq + (size_t)tn * 128 * 1024, 1024, 16, acc, smem);
    const int rbase = tm * 256 + wm * 64 + 4 * g;
    const int cbase = tn * 128 + wn * 64 + l15;
#pragma unroll
    for (int m = 0; m < 4; ++m)
#pragma unroll
      for (int n = 0; n < 4; ++n)
#pragma unroll
        for (int j = 0; j < 4; ++j) qp[(size_t)(rbase + m * 16 + j) * 2048 + cbase + n * 16] = f2bf(acc[m][n][j]);
  }
}

__device__ __forceinline__ void phase_pkeys(const Params& p, unsigned char* smem) {
  unsigned char* ws = p.ws;
  const bf16_t* qp = (const bf16_t*)(ws + WS_PG);
  const bf16_t* keys = (const bf16_t*)(ws + WS_KEYS);
  float* ps = (float*)(ws + WS_PA);
  int* pi = (int*)(ws + WS_PA) + (size_t)TOK * 256;
  float* sc = (float*)smem;
  const int tid = threadIdx.x, lane = tid & 63, w = tid >> 6, wm = w >> 1, wn = w & 1, l15 = lane & 15, g = lane >> 4;
  for (int tile = blockIdx.x; tile < 128 * 16; tile += gridDim.x) {
    const int hp = tile & 15, tm = tile >> 4;
    const int h = hp >> 1, ph = hp & 1;
    f32x4 acc[4][4]; zero_acc(acc);
    gemm_tile(qp + (size_t)tm * 256 * 2048 + hp * 128, 2048, keys + (size_t)(ph * 8 + h) * 128 * 128, 128, 2, acc, smem);
    __syncthreads();
#pragma unroll
    for (int m = 0; m < 4; ++m)
#pragma unroll
      for (int n = 0; n < 4; ++n)
#pragma unroll
        for (int j = 0; j < 4; ++j) sc[(wm * 64 + m * 16 + 4 * g + j) * 129 + wn * 64 + n * 16 + l15] = acc[m][n][j];
    __syncthreads();
    if (tid < 256) {
      const int row = tid;
      const float* rowp = sc + row * 129;
      unsigned tv[16];
#pragma unroll
      for (int k = 0; k < 16; ++k) tv[k] = 0u;
#pragma unroll 8
      for (int nn = 0; nn < 128; ++nn) {
        const unsigned bits = __float_as_uint(rowp[nn]);
        unsigned key = (bits & 0x80000000u) ? ~bits : (bits | 0x80000000u);
        key = (key & ~127u) | (unsigned)(127 - nn);
#pragma unroll
        for (int k = 15; k >= 1; --k) {
          unsigned r;
          asm("v_med3_u32 %0, %1, %2, %3" : "=v"(r) : "v"(tv[k]), "v"(tv[k - 1]), "v"(key));
          tv[k] = r;
        }
        tv[0] = tv[0] > key ? tv[0] : key;
      }
      const size_t ob = ((size_t)(tm * 256 + row) * 16 + hp) * 16;
      float ov[16]; int oi[16];
#pragma unroll
      for (int k = 0; k < 16; ++k) { oi[k] = 127 - (int)(tv[k] & 127u); ov[k] = rowp[oi[k]]; }
#pragma unroll
      for (int k = 0; k < 16; k += 4) {
        *(float4*)(ps + ob + k) = make_float4(ov[k], ov[k + 1], ov[k + 2], ov[k + 3]);
        *(int4*)(pi + ob + k) = make_int4(oi[k], oi[k + 1], oi[k + 2], oi[k + 3]);
      }
    }
    __syncthreads();
  }
}

__device__ __forceinline__ void phase_pcomb(const Params& p, unsigned char* smem) {
  unsigned char* ws = p.ws;
  const float* ps = (const float*)(ws + WS_PA);
  const int* pi = (const int*)(ws + WS_PA) + (size_t)TOK * 256;
  int* eidx = (int*)(ws + WS_EIDX);
  float* gw = (float*)(ws + WS_GW);
  float* s2l = (float*)smem;
  unsigned short* i1l = (unsigned short*)(s2l + 512 * 17);
  unsigned short* i2l = i1l + 512 * 16;
  const int tid = threadIdx.x;
  for (int base = blockIdx.x * NTHREADS; base < TOK * 8; base += gridDim.x * NTHREADS) {
    const int th = base + tid;
    const size_t o1 = (size_t)th * 32;
    float s1[16];
#pragma unroll
    for (int a = 0; a < 16; ++a) {
      s1[a] = ps[o1 + a];
      s2l[tid * 17 + a] = ps[o1 + 16 + a];
      i1l[tid * 16 + a] = (unsigned short)pi[o1 + a];
      i2l[tid * 16 + a] = (unsigned short)pi[o1 + 16 + a];
    }
    float cur[16];
    const float s20 = s2l[tid * 17];
#pragma unroll
    for (int a = 0; a < 16; ++a) cur[a] = s1[a] + s20;
    unsigned long long ptr = 0ull;
    float tops[16]; int tope[16];
#pragma unroll
    for (int k = 0; k < 16; ++k) {
      float best = cur[0]; int ba = 0;
#pragma unroll
      for (int a = 1; a < 16; ++a) if (cur[a] > best) { best = cur[a]; ba = a; }
      const int bb = (int)((ptr >> (4 * ba)) & 15ull);
      tops[k] = best;
      tope[k] = (int)i1l[tid * 16 + ba] * 128 + (int)i2l[tid * 16 + bb];
      const int nb = bb + 1;
      const float ns2 = (nb < 16) ? s2l[tid * 17 + nb] : -INFINITY;
      if (nb < 16) ptr += (1ull << (4 * ba));
#pragma unroll
      for (int a = 0; a < 16; ++a) if (a == ba) cur[a] = s1[a] + ns2;
    }
    float m = tops[0];
    float sum = 0.f;
#pragma unroll
    for (int k = 0; k < 16; ++k) { tops[k] = __expf(tops[k] - m); sum += tops[k]; }
    const float inv = 1.f / sum;
#pragma unroll
    for (int k = 0; k < 16; ++k) { eidx[(size_t)th * 16 + k] = tope[k]; gw[(size_t)th * 16 + k] = tops[k] * inv; }
  }
}


__device__ __forceinline__ float reduce8(const float (&pv)[8], int lane) {
  const bool b5 = lane & 32, b4 = lane & 16, b3 = lane & 8;
  float v[4];
#pragma unroll
  for (int i = 0; i < 4; ++i) {
    const float keep = b5 ? pv[4 + i] : pv[i];
    const float send = b5 ? pv[i] : pv[4 + i];
    v[i] = keep + __shfl_xor(send, 32);
  }
  float u[2];
#pragma unroll
  for (int i = 0; i < 2; ++i) {
    const float keep = b4 ? v[2 + i] : v[i];
    const float send = b4 ? v[i] : v[2 + i];
    u[i] = keep + __shfl_xor(send, 16);
  }
  float x = (b3 ? u[1] : u[0]) + __shfl_xor(b3 ? u[0] : u[1], 8);
  x += __shfl_xor(x, 4); x += __shfl_xor(x, 2); x += __shfl_xor(x, 1);
  return x;
}

__device__ __forceinline__ void cvt16u8(const uint4& v, float* f) {
  f[0] = (float)(v.x & 0xffu); f[1] = (float)((v.x >> 8) & 0xffu); f[2] = (float)((v.x >> 16) & 0xffu); f[3] = (float)(v.x >> 24);
  f[4] = (float)(v.y & 0xffu); f[5] = (float)((v.y >> 8) & 0xffu); f[6] = (float)((v.y >> 16) & 0xffu); f[7] = (float)(v.y >> 24);
  f[8] = (float)(v.z & 0xffu); f[9] = (float)((v.z >> 8) & 0xffu); f[10] = (float)((v.z >> 16) & 0xffu); f[11] = (float)(v.z >> 24);
  f[12] = (float)(v.w & 0xffu); f[13] = (float)((v.w >> 8) & 0xffu); f[14] = (float)((v.w >> 16) & 0xffu); f[15] = (float)(v.w >> 24);
}

__device__ __forceinline__ int team_index(const Params& p, unsigned char* smem) {
  int* sh = (int*)(smem + 8192);
  const int G = gridDim.x, tid = threadIdx.x;
  const int* tab = (const int*)(p.ws + WS_XCC);
  if (tid < 32) sh[tid] = 0;
  __syncthreads();
  const int mine = tab[blockIdx.x] & 15;
  for (int b = tid; b < G; b += NTHREADS) {
    const int x = tab[b] & 15;
    atomicAdd(&sh[x], 1);
    if (x == mine && b < (int)blockIdx.x) atomicAdd(&sh[16], 1);
  }
  __syncthreads();
  if (tid == 0) {
    int pre = 0;
    for (int j = 0; j < mine; ++j) pre += sh[j];
    sh[17] = pre + sh[16];
  }
  __syncthreads();
  const int r = sh[17];
  __syncthreads();
  return r;
}

__device__ __forceinline__ int wave_sum_i32_dpp(int v) {
  v += __builtin_amdgcn_update_dpp(0, v, 0xB1, 0xf, 0xf, true);
  v += __builtin_amdgcn_update_dpp(0, v, 0x4E, 0xf, 0xf, true);
  v += __builtin_amdgcn_update_dpp(0, v, 0x141, 0xf, 0xf, true);
  v += __builtin_amdgcn_update_dpp(0, v, 0x140, 0xf, 0xf, true);
  return __builtin_amdgcn_readlane(v, 0) + __builtin_amdgcn_readlane(v, 16) + __builtin_amdgcn_readlane(v, 32) + __builtin_amdgcn_readlane(v, 48);
}

template <bool SL>
__device__ __forceinline__ void phase_pu_t(const Params& p, unsigned char* smem) {
  unsigned char* ws = p.ws;
  const unsigned char* XQ = ws + WS_XQ;
  const float* xs = (const float*)(ws + WS_XS);
  const unsigned char* U8 = ws + WS_U;
  const float* us = (const float*)(ws + WS_U + (size_t)16384 * 1024);
  const float* vs = (const float*)(ws + WS_V + (size_t)16384 * 1024);
  const int* eidx = (const int*)(ws + WS_EIDX);
  const float* gw = (const float*)(ws + WS_GW);
  float* aw = (float*)(ws + WS_PA);
  const int lane = threadIdx.x & 63, w = threadIdx.x >> 6;
  unsigned* lst = (unsigned*)smem + w * 128;
  const unsigned long long lt_mask = (1ull << lane) - 1ull;
  const int G = gridDim.x;
  constexpr bool sliced = SL;
  const int ti = sliced ? team_index(p, smem) : 0;
  const int tsz = G >> 3;
  const int grp0 = sliced ? (ti / tsz) : 0;
  constexpr int ngrp = sliced ? 1 : 8;
  const int slot = sliced ? (ti % tsz) * 8 + w : blockIdx.x * 8 + w;
  const int nslot = sliced ? tsz * 8 : G * 8;
  uint4 xa = make_uint4(0, 0, 0, 0); int e0 = 0, e1 = 0; float xsc = 0.f;
  if (slot < TOK) {
    xa = *(const uint4*)(XQ + (size_t)slot * 1024 + lane * 16);
    e0 = eidx[(size_t)slot * 128 + lane]; e1 = eidx[(size_t)slot * 128 + 64 + lane];
    xsc = xs[slot];
  }
  for (int tok = slot; tok < TOK; tok += nslot) {
    const uint4 cx = xa;
    const int ce0 = e0, ce1 = e1;
    const float cxs = xsc;
    for (int gi = 0; gi < ngrp; ++gi) {
      const int grp = grp0 + gi;
      const bool m0 = (ce0 >> 11) == grp, m1 = (ce1 >> 11) == grp;
      const unsigned long long b0 = __ballot(m0), b1 = __ballot(m1);
      const int c0 = __popcll(b0), n = c0 + __popcll(b1);
      if (m0) lst[__popcll(b0 & lt_mask)] = ((unsigned)lane << 14) | (unsigned)ce0;
      if (m1) lst[c0 + __popcll(b1 & lt_mask)] = ((unsigned)(lane + 64) << 14) | (unsigned)ce1;
      lds_fence();
      const unsigned le0 = (lane < n) ? lst[lane] : 0u;
      const unsigned le1 = (lane + 64 < n) ? lst[lane + 64] : 0u;
      lds_fence();
      float sc0 = 0.f, sc1 = 0.f, gv0 = 0.f, gv1 = 0.f, vv0 = 0.f, vv1 = 0.f;
      if (lane < n) { const int e = le0 & 16383; sc0 = us[e]; vv0 = vs[e]; gv0 = gw[(size_t)tok * 128 + (le0 >> 14)]; }
      if (lane + 64 < n) { const int e = le1 & 16383; sc1 = us[e]; vv1 = vs[e]; gv1 = gw[(size_t)tok * 128 + (le1 >> 14)]; }
      int h0i = 0, h1i = 0;
#define PU_BATCH(I0, PREFETCH_STMT) do { \
        const int i0_ = (I0); \
        const bool lo = i0_ < 64; \
        const int cur = (int)(lo ? le0 : le1); \
        const int base = i0_ & 63; \
        int last = (lo ? (n < 64 ? n : 64) : n - 64) - 1; last = last < 0 ? 0 : last; \
        uint4 ua[16]; \
        _Pragma("unroll") for (int j = 0; j < 16; ++j) { \
          int idx = base + j; idx = idx < last ? idx : last; \
          const unsigned le = (unsigned)__builtin_amdgcn_readlane(cur, idx); \
          ua[j] = *(const uint4*)(U8 + (size_t)(le & 16383u) * 1024 + lane * 16); \
        } \
        PREFETCH_STMT; \
        __builtin_amdgcn_sched_barrier(0); \
        int hn = 0; \
        _Pragma("unroll") for (int j = 0; j < 16; ++j) { \
          int d = __builtin_amdgcn_sdot4((int)ua[j].x, (int)cx.x, 0, false); \
          d = __builtin_amdgcn_sdot4((int)ua[j].y, (int)cx.y, d, false); \
          d = __builtin_amdgcn_sdot4((int)ua[j].z, (int)cx.z, d, false); \
          d = __builtin_amdgcn_sdot4((int)ua[j].w, (int)cx.w, d, false); \
          const int tot = wave_sum_i32_dpp(d); \
          if (lane == base + j) hn = tot; \
        } \
        if (lane >= base && lane < base + 16) { if (lo) h0i = hn; else h1i = hn; } \
      } while (0)
      if (gi == ngrp - 1) {
        const int nt = (tok + nslot < TOK) ? tok + nslot : tok;
        PU_BATCH(0, { xa = *(const uint4*)(XQ + (size_t)nt * 1024 + lane * 16);
                      e0 = eidx[(size_t)nt * 128 + lane]; e1 = eidx[(size_t)nt * 128 + 64 + lane]; xsc = xs[nt]; });
      } else {
        PU_BATCH(0, {});
      }
#pragma unroll 1
      for (int i0 = 16; i0 < n; i0 += 16) PU_BATCH(i0, {});
#undef PU_BATCH
      const float h0 = (float)h0i * sc0 * cxs, h1 = (float)h1i * sc1 * cxs;
      if (lane < n) aw[(size_t)tok * 128 + (le0 >> 14)] = 0.5f * h0 * (1.f + erff(h0 * 0.70710678118654752f)) * gv0 * vv0;
      if (lane + 64 < n) aw[(size_t)tok * 128 + (le1 >> 14)] = 0.5f * h1 * (1.f + erff(h1 * 0.70710678118654752f)) * gv1 * vv1;
    }
  }
}

template <bool SL>
__device__ __forceinline__ void phase_pv_t(const Params& p, unsigned char* smem) {
  unsigned char* ws = p.ws;
  const unsigned char* V8 = ws + WS_V;
  const int* eidx = (const int*)(ws + WS_EIDX);
  const float* aw = (const float*)(ws + WS_PA);
  float* ssq = (float*)(ws + WS_SSQ);
  const int lane = threadIdx.x & 63, w = threadIdx.x >> 6;
  const int q = lane >> 3, c = lane & 7;
  const int G = gridDim.x;
  constexpr bool sliced = SL;
  const int ti = sliced ? team_index(p, smem) : 0;
  const int tsz = G >> 3;
  const int grp0 = sliced ? (ti / tsz) : 0;
  constexpr int ngrp = sliced ? 1 : 8;
  const int slot = sliced ? (ti % tsz) * 8 + w : blockIdx.x * 8 + w;
  const int nslot = sliced ? tsz * 8 : G * 8;
  int ee[16]; float aa[16];
  if (slot < TOK) {
    unsigned bi = (unsigned)slot * 128u + (unsigned)q;
    asm volatile("" : "+v"(bi));
#pragma unroll
    for (int u = 0; u < 16; ++u) { ee[u] = eidx[bi + 8 * u]; aa[u] = aw[bi + 8 * u]; }
  }
  for (int tok = slot; tok < TOK; tok += nslot) {
    int ce[16]; float ca[16];
    float suma = 0.f;
#pragma unroll
    for (int u = 0; u < 16; ++u) { ce[u] = ee[u]; ca[u] = aa[u]; suma += aa[u]; }
    for (int gi = 0; gi < ngrp; ++gi) {
      const int grp = grp0 + gi;
      uint4 vv[16];
#pragma unroll
      for (int u = 0; u < 16; ++u) vv[u] = *(const uint4*)(V8 + (size_t)grp * (16384 * 128) + (size_t)ce[u] * 128 + c * 16);
      float* orow = p.out + (size_t)tok * 1024 + grp * 128 + c * 16;
      float4 x1v[4];
#pragma unroll
      for (int i = 0; i < 4; ++i) x1v[i] = *(const float4*)(orow + 4 * i);
      if (gi == ngrp - 1) {
        const int nt = (tok + nslot < TOK) ? tok + nslot : tok;
        unsigned bi = (unsigned)nt * 128u + (unsigned)q;
        asm volatile("" : "+v"(bi));
#pragma unroll
        for (int u = 0; u < 16; ++u) { ee[u] = eidx[bi + 8 * u]; aa[u] = aw[bi + 8 * u]; }
      }
      __builtin_amdgcn_sched_barrier(0);
      float acc[16];
#pragma unroll
      for (int i = 0; i < 16; ++i) acc[i] = -128.f * suma;
#pragma unroll
      for (int u = 0; u < 16; ++u) {
        float vf[16];
        cvt16u8(vv[u], vf);
#pragma unroll
        for (int i = 0; i < 16; ++i) acc[i] += ca[u] * vf[i];
        __builtin_amdgcn_sched_barrier(0);
      }
#pragma unroll
      for (int i = 0; i < 16; ++i) { acc[i] += __shfl_xor(acc[i], 8); acc[i] += __shfl_xor(acc[i], 16); acc[i] += __shfl_xor(acc[i], 32); }
      float ss = 0.f;
      if (q == 0) {
#pragma unroll
        for (int i = 0; i < 4; ++i) {
          const float4 oa = make_float4(x1v[i].x + acc[4 * i], x1v[i].y + acc[4 * i + 1], x1v[i].z + acc[4 * i + 2], x1v[i].w + acc[4 * i + 3]);
          *(float4*)(orow + 4 * i) = oa;
          ss += oa.x * oa.x + oa.y * oa.y + oa.z * oa.z + oa.w * oa.w;
        }
      }
      ss += __shfl_xor(ss, 1); ss += __shfl_xor(ss, 2); ss += __shfl_xor(ss, 4);
      if (lane == 0) atomicAdd(&ssq[tok], ss);
    }
  }
}

__device__ __forceinline__ void phase_final(const Params& p) {
  const float* ssq = (const float*)(p.ws + WS_SSQ);
  const int lane = threadIdx.x & 63, w = threadIdx.x >> 6;
  for (int row = blockIdx.x * 8 + w; row < TOK; row += gridDim.x * 8) {
    const float rstd = rsqrtf(ssq[row] * (1.f / DM) + EPSV);
    float4* o4 = (float4*)(p.out + (size_t)row * DM);
#pragma unroll
    for (int i = 0; i < 4; ++i) {
      float4 v = o4[lane + 64 * i];
      const float4 gg = ((const float4*)p.norm_final)[lane + 64 * i];
      v.x *= rstd * gg.x; v.y *= rstd * gg.y; v.z *= rstd * gg.z; v.w *= rstd * gg.w;
      o4[lane + 64 * i] = v;
    }
  }
}


__device__ __forceinline__ void phase_proj8(const Params& p, unsigned char* smem) {
  unsigned char* ws = p.ws;
  pg8::Gemm g{(const pg8::bf16_t*)(ws + WS_XN), (const pg8::bf16_t*)(ws + WS_WIN), TOK, 5120, 1024};
  pg8::StaticOrder S; S.init(TOK, 5120, (int)gridDim.x, (int)blockIdx.x);
  EpiProj E{(unsigned short*)(ws + WS_PH), (unsigned short*)(ws + WS_PA), (unsigned short*)(ws + WS_PG)};
  pg8::gemm_phase<EpiProj, pg8::StaticOrder>((PG8_LAS unsigned char*)smem, g, S, E, nullptr);
}
__device__ __forceinline__ void phase_ikln(const Params& p) {
  bf16_t* pA = (bf16_t*)(p.ws + WS_PA);
  const int tid = threadIdx.x, sub = tid & 7;
  float gam[8], bet[8];
#pragma unroll
  for (int i = 0; i < 8; ++i) { gam[i] = p.ikg[sub * 8 + i]; bet[i] = p.ikb[sub * 8 + i]; }
  for (int row = blockIdx.x * 64 + (tid >> 3); row < TOK; row += gridDim.x * 64) {
    uint4* ptr = (uint4*)(pA + (size_t)row * 1024 + 896 + sub * 8);
    const uint4 raw = *ptr;
    float v[8];
    cvt8(raw, v);
    float s = 0.f;
#pragma unroll
    for (int i = 0; i < 8; ++i) s += v[i];
    s += __shfl_xor(s, 1); s += __shfl_xor(s, 2); s += __shfl_xor(s, 4);
    const float mu = s * (1.f / 64.f);
    float q = 0.f;
#pragma unroll
    for (int i = 0; i < 8; ++i) { const float d = v[i] - mu; q += d * d; }
    q += __shfl_xor(q, 1); q += __shfl_xor(q, 2); q += __shfl_xor(q, 4);
    const float rstd = rsqrtf(q * (1.f / 64.f) + EPSV);
    uint4 o;
    o.x = pack2((v[0] - mu) * rstd * gam[0] + bet[0], (v[1] - mu) * rstd * gam[1] + bet[1]);
    o.y = pack2((v[2] - mu) * rstd * gam[2] + bet[2], (v[3] - mu) * rstd * gam[3] + bet[3]);
    o.z = pack2((v[4] - mu) * rstd * gam[4] + bet[4], (v[5] - mu) * rstd * gam[5] + bet[5]);
    o.w = pack2((v[6] - mu) * rstd * gam[6] + bet[6], (v[7] - mu) * rstd * gam[7] + bet[7]);
    *ptr = o;
  }
}
__device__ __forceinline__ void phase_up8(const Params& p, unsigned char* smem) {
  unsigned char* ws = p.ws;
  const pg8::bf16_t* ya = (const pg8::bf16_t*)(ws + WS_XN);
  const pg8::bf16_t* yb = ya + (size_t)TOK * 512;
  pg8::StaticOrder S; S.init(TOK, 1024, (int)gridDim.x, (int)blockIdx.x);
  {
    pg8::Gemm g{ya, (const pg8::bf16_t*)(ws + WS_WUPA), TOK, 1024, 512};
    EpiGate<0> E{(unsigned short*)(ws + WS_PH), (const unsigned short*)(ws + WS_PG), 0};
    pg8::gemm_phase<EpiGate<0>, pg8::StaticOrder>((PG8_LAS unsigned char*)smem, g, S, E, nullptr);
  }
  {
    pg8::Gemm g{yb, (const pg8::bf16_t*)(ws + WS_WUPB), TOK, 1024, 512};
    EpiGate<1> E{(unsigned short*)(ws + WS_PH), (const unsigned short*)(ws + WS_PG), 1024};
    pg8::gemm_phase<EpiGate<1>, pg8::StaticOrder>((PG8_LAS unsigned char*)smem, g, S, E, nullptr);
  }
}
__device__ __forceinline__ void phase_out8(const Params& p, unsigned char* smem) {
  unsigned char* ws = p.ws;
  pg8::Gemm g{(const pg8::bf16_t*)(ws + WS_PH), (const pg8::bf16_t*)(ws + WS_WOUT), TOK, 1024, 1024};
  pg8::StaticOrder S; S.init(TOK, 1024, (int)gridDim.x, (int)blockIdx.x);
  EpiResid E{p.out, p.x};
  pg8::gemm_phase<EpiResid, pg8::StaticOrder>((PG8_LAS unsigned char*)smem, g, S, E, nullptr);
}
__device__ __forceinline__ void phase_pq8(const Params& p, unsigned char* smem) {
  unsigned char* ws = p.ws;
  pg8::Gemm g{(const pg8::bf16_t*)(ws + WS_XN), (const pg8::bf16_t*)(ws + WS_WQ), TOK, 2048, 1024};
  pg8::StaticOrder S; S.init(TOK, 2048, (int)gridDim.x, (int)blockIdx.x);
  EpiStoreBf16 E{(unsigned short*)(ws + WS_PG), 2048};
  pg8::gemm_phase<EpiStoreBf16, pg8::StaticOrder>((PG8_LAS unsigned char*)smem, g, S, E, nullptr);
}

__global__ void __launch_bounds__(NTHREADS) hybrid_fwd(Params p) {
  extern __shared__ __attribute__((aligned(16))) unsigned char smem[];
#if ONE_LAUNCH
  cg::grid_group grid = cg::this_grid();
  volatile LAS unsigned* xst = (volatile LAS unsigned*)(smem + LDS_BYTES - 16);
  if (threadIdx.x == 0) { xst[0] = 0u; xst[1] = 0u; }
  __syncthreads();
  XcdBarrier xbar = xcd_barrier_post((unsigned*)(p.ws + WS_BAR), xst);
#define SEAM(k) do { if (p.ph_lo <= (k) && (k) + 1 < p.ph_hi) { if ((k) == 0) grid.sync(); else xcd_barrier(xbar); } } while (0)
#else
#define SEAM(k) do { } while (0)
#endif
#define IN(k) (p.ph_lo <= (k) && (k) < p.ph_hi)
#ifndef REPEAT_PH
#define REPEAT_PH -1
#endif
#define REP(k, stmt) do { if (REPEAT_PH == (k)) { stmt; grid.sync(); } } while (0)
  if (IN(0)) { phase_prep(p, smem); SEAM(0); }
  if (IN(1)) { phase_proj8(p, smem); SEAM(1); }
  if (IN(2)) { phase_ikln(p); SEAM(2); }
  if (IN(3)) { phase_mix(p, smem); SEAM(3); }
  if (IN(4)) { phase_up8(p, smem); SEAM(4); }
  if (IN(5)) { phase_out8(p, smem); SEAM(5); }
  if (IN(6)) { rmsnorm_rows_q(p.out, p.norm_ffn, (bf16_t*)(p.ws + WS_XN), p.ws + WS_XQ, (float*)(p.ws + WS_XS)); SEAM(6); }
  if (IN(7)) { phase_pq8(p, smem); SEAM(7); }
  if (IN(8)) { phase_pkeys(p, smem); SEAM(8); }
  if (IN(9)) { phase_pcomb(p, smem); SEAM(9); }
  if (IN(10)) { if (gridDim.x % 8 == 0) phase_pu_t<true>(p, smem); else phase_pu_t<false>(p, smem); SEAM(10); }
  if (IN(11)) { if (gridDim.x % 8 == 0) phase_pv_t<true>(p, smem); else phase_pv_t<false>(p, smem); SEAM(11); }
  if (IN(12)) { phase_final(p); }
#undef IN
#undef SEAM
}

extern "C" void kernel_launch(void* const* d_in, const int* in_sizes, int n_in, void* d_out, int out_size, void* d_ws, size_t ws_size,
                              hipStream_t stream) {
  static int grid = 0;
  if (grid == 0) {
    if (n_in != 17 || ws_size < WS_END) {
      fprintf(stderr, "kernel_launch: unexpected n_in %d or ws_size %zu (need %zu)\n", n_in, ws_size, (size_t)WS_END);
      grid = -1; return;
    }
    int dev = 0, cus = 0, per_cu = 0;
    hipGetDevice(&dev);
    hipDeviceGetAttribute(&cus, hipDeviceAttributeMultiprocessorCount, dev);
    hipFuncSetAttribute((const void*)hybrid_fwd, hipFuncAttributeMaxDynamicSharedMemorySize, LDS_BYTES);
    hipOccupancyMaxActiveBlocksPerMultiprocessor(&per_cu, (const void*)hybrid_fwd, NTHREADS, LDS_BYTES);
    if (per_cu < 1) { fprintf(stderr, "kernel_launch: occupancy query says %d blocks/CU\n", per_cu); per_cu = 1; }
    (void)hipGetLastError();
    grid = cus;
  }
  if (grid < 0) return;
  Params p{};
  p.x = (const float*)d_in[0]; p.norm_mix = (const float*)d_in[1]; p.w_in = (const float*)d_in[2]; p.hg_lb = (const float*)d_in[3];
  p.hg_norm = (const float*)d_in[4]; p.ikg = (const float*)d_in[5]; p.ikb = (const float*)d_in[6]; p.rel_bias = (const float*)d_in[7];
  p.w_up_a = (const float*)d_in[8]; p.w_up_b = (const float*)d_in[9]; p.w_out = (const float*)d_in[10]; p.norm_ffn = (const float*)d_in[11];
  p.peer_wq = (const float*)d_in[12]; p.peer_keys = (const float*)d_in[13]; p.peer_u = (const float*)d_in[14]; p.peer_v = (const float*)d_in[15];
  p.norm_final = (const float*)d_in[16];
  p.out = (float*)d_out; p.ws = (unsigned char*)d_ws;
#if ONE_LAUNCH
  hipMemsetAsync((unsigned char*)d_ws + WS_BAR, 0, 16384, stream);
  p.ph_lo = 0; p.ph_hi = NPHASE;
  void* args[] = {&p};
  hipError_t e = hipLaunchCooperativeKernel((const void*)hybrid_fwd, dim3(grid), dim3(NTHREADS), args, LDS_BYTES, stream);
  if (e != hipSuccess) fprintf(stderr, "cooperative launch failed: %s (grid %d)\n", hipGetErrorString(e), grid);
#else
  for (int ph = 0; ph < NPHASE; ++ph) {
    p.ph_lo = ph; p.ph_hi = ph + 1;
    hipLaunchKernelGGL(hybrid_fwd, dim3(grid), dim3(NTHREADS), LDS_BYTES, stream, p);
  }
#endif
}
```

```cpp
#include <hip/hip_runtime.h>
#include <hip/hip_cooperative_groups.h>
#include <stdint.h>
#include <stdio.h>
namespace cg = cooperative_groups;

#ifndef ONE_LAUNCH
#define ONE_LAUNCH 1
#endif

typedef unsigned short bf16_t;
typedef __attribute__((ext_vector_type(8))) short bf16x8;
typedef __attribute__((ext_vector_type(4))) float f32x4;

#define NTHREADS 512
#define TOK 32768
#define SEQL 4096
#define DM 1024
#define EPSV 1e-6f
#define NPHASE 13

#define WS_WIN   ((size_t)0)
#define WS_WUPA  (WS_WIN  + (size_t)5120 * 1024 * 2)
#define WS_WUPB  (WS_WUPA + (size_t)1024 * 512 * 2)
#define WS_WOUT  (WS_WUPB + (size_t)1024 * 512 * 2)
#define WS_WQ    (WS_WOUT + (size_t)1024 * 1024 * 2)
#define WS_KEYS  (WS_WQ   + (size_t)2048 * 1024 * 2)
#define WS_LB    (WS_KEYS + (size_t)2 * 8 * 128 * 128 * 2)
#define WS_U     (WS_LB   + (size_t)4096)
#define WS_V     (WS_U    + (size_t)16384 * 1024 * 2)
#define WS_XN    (WS_V    + (size_t)16384 * 1024 * 2)
#define WS_PH    (WS_XN   + (size_t)TOK * 1024 * 2)
#define WS_PA    (WS_PH   + (size_t)TOK * 2048 * 2)
#define WS_PG    (WS_PA   + (size_t)TOK * 1024 * 2)
#define WS_EIDX  (WS_PG   + (size_t)TOK * 2048 * 2)
#define WS_GW    (WS_EIDX + (size_t)TOK * 128 * 4)
#define WS_SSQ   (WS_GW   + (size_t)TOK * 128 * 4)
#define WS_XCC   (WS_SSQ  + (size_t)TOK * 4)
#define WS_BAR   (WS_XCC  + (size_t)4096)
#define WS_DEC   (WS_BAR  + (size_t)16384)
#define WS_END   (WS_DEC  + (size_t)2048 * 384 * 4)

#define LDS_BYTES 155648

struct Params {
  const float* x; const float* norm_mix; const float* w_in; const float* hg_lb; const float* hg_norm;
  const float* ikg; const float* ikb; const float* rel_bias; const float* w_up_a; const float* w_up_b;
  const float* w_out; const float* norm_ffn; const float* peer_wq; const float* peer_keys;
  const float* peer_u; const float* peer_v; const float* norm_final;
  float* out; unsigned char* ws; int ph_lo, ph_hi;
};

__device__ __forceinline__ float bf2f(bf16_t u) { return __uint_as_float(((unsigned)u) << 16); }
__device__ __forceinline__ bf16_t f2bf(float f) {
  unsigned u = __float_as_uint(f);
  u += 0x7fffu + ((u >> 16) & 1u);
  return (bf16_t)(u >> 16);
}
__device__ __forceinline__ unsigned pack2(float a, float b) { return (unsigned)f2bf(a) | ((unsigned)f2bf(b) << 16); }
__device__ __forceinline__ float wave_sum(float v) {
#pragma unroll
  for (int o = 32; o > 0; o >>= 1) v += __shfl_xor(v, o);
  return v;
}
__device__ __forceinline__ void lds_fence() { asm volatile("s_waitcnt lgkmcnt(0)" ::: "memory"); }

__device__ __forceinline__ float add_xor8(float v) { return v + __int_as_float(__builtin_amdgcn_update_dpp(0, __float_as_int(v), 0x128, 0xf, 0xf, true)); }
__device__ __forceinline__ float add_xor16(float v) { const auto r = __builtin_amdgcn_permlane16_swap(__float_as_uint(v), __float_as_uint(v), false, false); return __uint_as_float(r[0]) + __uint_as_float(r[1]); }
__device__ __forceinline__ float add_xor32(float v) { const auto r = __builtin_amdgcn_permlane32_swap(__float_as_uint(v), __float_as_uint(v), false, false); return __uint_as_float(r[0]) + __uint_as_float(r[1]); }
__device__ __forceinline__ float max_xor16(float v) { const auto r = __builtin_amdgcn_permlane16_swap(__float_as_uint(v), __float_as_uint(v), false, false); return fmaxf(__uint_as_float(r[0]), __uint_as_float(r[1])); }
__device__ __forceinline__ float max_xor32(float v) { const auto r = __builtin_amdgcn_permlane32_swap(__float_as_uint(v), __float_as_uint(v), false, false); return fmaxf(__uint_as_float(r[0]), __uint_as_float(r[1])); }
__device__ __forceinline__ float sigmoidf_(float x) { return 1.f / (1.f + __expf(-x)); }
__device__ __forceinline__ float siluf_(float x) { return x / (1.f + __expf(-x)); }


#define XB_TMO      128
#define XB_XCNT(j)  (256  + 64 * (j))
#define XB_XSUB(j)  (1280 + 64 * (j))
#define XB_XGEN(j)  (2304 + 64 * (j))
#define XB_TOP      3328
#define XB_TOPGEN   3392
#define XCD_BAR_WORDS 3456
#define XB_SPIN_CAP (1u << 22)
#define LAS __attribute__((address_space(3)))
__device__ __forceinline__ unsigned xb_ld(unsigned* p)              { return __hip_atomic_load(p, __ATOMIC_RELAXED, __HIP_MEMORY_SCOPE_AGENT); }
__device__ __forceinline__ unsigned xb_add(unsigned* p, unsigned v) { return __hip_atomic_fetch_add(p, v, __ATOMIC_RELAXED, __HIP_MEMORY_SCOPE_AGENT); }
__device__ __forceinline__ unsigned xb_xcc_id() { return (unsigned)__builtin_amdgcn_s_getreg((3 << 11) | 20) & 0xFu; }
#define XB_SPIN(cond, bar) do { unsigned _sp = 0; while (cond) { __builtin_amdgcn_s_sleep(1); \
    if ((++_sp & 255u) == 0u) { if (xb_ld(&(bar)[XB_TMO])) break; if (_sp > XB_SPIN_CAP) { atomicAdd(&(bar)[XB_TMO], 1u); break; } } } } while (0)
struct XcdBarrier { unsigned* bar; unsigned x; volatile LAS unsigned* st; };
__device__ __forceinline__ XcdBarrier xcd_barrier_post(unsigned* bar, volatile LAS unsigned* st) {
  XcdBarrier b; b.bar = bar; b.x = xb_xcc_id(); b.st = st;
  if (threadIdx.x == 0) (void)xb_add(&bar[XB_XCNT(b.x)], 1u);
  return b;
}
__device__ __forceinline__ void xcd_barrier_complete(unsigned* bar, unsigned x, unsigned& nloc, unsigned& nx) {
  const unsigned G = gridDim.x * gridDim.y * gridDim.z;
  unsigned sum, cnt, mine, sp = 0u;
  for (;;) {
    sum = 0u; cnt = 0u; mine = 0u;
#pragma unroll
    for (unsigned j = 0; j < 16; ++j) { const unsigned c = xb_ld(&bar[XB_XCNT(j)]); sum += c; cnt += (c > 0u) ? 1u : 0u; mine = (j == x) ? c : mine; }
    if (sum == G) break;
    __builtin_amdgcn_s_sleep(1);
    if ((++sp & 255u) == 0u) { if (xb_ld(&bar[XB_TMO])) break; if (sp > XB_SPIN_CAP) { atomicAdd(&bar[XB_TMO], 1u); break; } }
  }
  nloc = mine > 0u ? mine : 1u; nx = cnt > 0u ? cnt : 1u;
}
__device__ __forceinline__ void xcd_barrier(const XcdBarrier& b) {
  asm volatile("s_waitcnt vmcnt(0)" ::: "memory");
  __syncthreads();
  if (threadIdx.x == 0) {
    unsigned* bar = b.bar;
    __builtin_amdgcn_s_waitcnt(0);
    unsigned nloc = b.st[0], nx = b.st[1];
    if (nloc == 0u) { xcd_barrier_complete(bar, b.x, nloc, nx); b.st[0] = nloc; b.st[1] = nx; }
    const unsigned old = xb_add(&bar[XB_XSUB(b.x)], 1u);
    const unsigned gen = old / nloc;
    if (old + 1u == (gen + 1u) * nloc) {
      __builtin_amdgcn_fence(__ATOMIC_RELEASE, "agent");
      asm volatile("s_waitcnt vmcnt(0)" ::: "memory");
      const unsigned og = xb_add(&bar[XB_TOP], 1u);
      const unsigned tg = og / nx;
      if (og + 1u == (tg + 1u) * nx) xb_add(&bar[XB_TOPGEN], 1u);
      else XB_SPIN(xb_ld(&bar[XB_TOPGEN]) == tg, bar);
      __builtin_amdgcn_fence(__ATOMIC_ACQUIRE, "agent");
      xb_add(&bar[XB_XGEN(b.x)], 1u);
      asm volatile("s_waitcnt vmcnt(0)" ::: "memory");
    } else {
      XB_SPIN(xb_ld(&bar[XB_XGEN(b.x)]) == gen, bar);
      __builtin_amdgcn_fence(__ATOMIC_ACQUIRE, "agent");
      asm volatile("s_waitcnt vmcnt(0)" ::: "memory");
    }
  }
  __syncthreads();
}

namespace pg8 {
#define PG8_LAS __attribute__((address_space(3)))
typedef unsigned short bf16_t;
typedef short bf16x8 __attribute__((ext_vector_type(8)));
typedef float f32x4 __attribute__((ext_vector_type(4)));
typedef unsigned u32x4 __attribute__((ext_vector_type(4)));
constexpr int BM = 256, BK = 64, HALF = 128, HTB = HALF * BK * 2  , STAGE_BYTES = 8 * HTB, NXCD = 8, WGM = 8;

__host__ __device__ __forceinline__ int lds_byte(int r, int c) { const int st = (r >> 4) * 2 + (c >> 5), rr = r & 15, cc = c & 31, ob = rr * 64 + cc * 2; return st * 1024 + (ob ^ (((ob >> 9) & 1) << 5)); }
__host__ __device__ __forceinline__ void stage_rc(int b, int& R, int& C) { const int st = b / 1024, sb = b % 1024, swz = sb ^ (((sb >> 9) & 1) << 5); R = (st >> 1) * 16 + swz / 64; C = (st & 1) * 32 + (swz % 64) / 2; }
__host__ __device__ __forceinline__ int perm32(int rho) { const int n = rho >> 4, i = rho & 15; return 8 * (i >> 2) + 4 * n + (i & 3); }

struct Unit { int pm, pn; };
struct Gemm { const bf16_t* A; const bf16_t* Bt; int M, N, K; };

struct StaticOrder {
    int nM, nN, nwg, G, c;
    __host__ __device__ void init(int M, int N, int G_, int c_) { nM = M / BM; nN = N / BM; nwg = nM * nN; G = G_; c = c_; }
    __host__ __device__ bool next(int i, Unit& u) const {
        const long L = (long)i * G + c; if (L >= nwg) return false;
        int wgid = (int)L; { const int q = nwg / NXCD, r = nwg % NXCD, xcd = wgid % NXCD, off = wgid / NXCD; wgid = (xcd < r ? xcd * (q + 1) : r * (q + 1) + (xcd - r) * q) + off; }
        const int nig = WGM * nN, gid = wgid / nig, fm = gid * WGM, gsz = (nM - fm) < WGM ? (nM - fm) : WGM;
        u.pm = fm + ((wgid % nig) % gsz); u.pn = (wgid % nig) / gsz; return true;
    }
    __device__ __forceinline__ void a_ready(const Unit&) const {}
    __device__ __forceinline__ void done(const Unit&) const {}
};
__device__ __forceinline__ unsigned cvt_pk_bf16(float lo, float hi) { unsigned r; asm volatile("v_cvt_pk_bf16_f32 %0, %1, %2" : "=v"(r) : "v"(lo), "v"(hi)); return r; }
template <class Epi, class Sched, bool STAMP = false>
__device__ __forceinline__ void gemm_phase(PG8_LAS unsigned char* lds, const Gemm g, const Sched& S, const Epi& E, unsigned long long* stamps) {
    const int tid = threadIdx.x, wid = __builtin_amdgcn_readfirstlane(tid >> 6), lane = tid & 63, wr = wid >> 2, wc = wid & 3, fr = lane & 15, fq = lane >> 4;
    const int K = g.K, nt = K / BK;
    int ts_lo = 0, ts_hi = 0, nts = 0; const unsigned long long rt_entry = STAMP ? (unsigned long long)wall_clock64() : 0ull;
#define PG8_STAMP() do { if (STAMP && wid == 0 && nts < 64) { const unsigned long long _c = (unsigned long long)clock64(); \
        ts_lo = (lane == nts) ? (int)(unsigned)_c : ts_lo; ts_hi = (lane == nts) ? (int)(unsigned)(_c >> 32) : ts_hi; ++nts; } } while (0)
    PG8_STAMP();
    unsigned voffA[2], voffB[2];
#pragma unroll
    for (int i = 0; i < 2; ++i) { int R, C; stage_rc(tid * 16 + i * 8192, R, C); const int Rb = Epi::PERM ? ((R & ~31) + perm32(R & 31)) : R;
        voffA[i] = (unsigned)(R * K + C) * 2u; voffB[i] = (unsigned)(Rb * K + C) * 2u; }
    const size_t kstep = (size_t)(BK * 2);
    const size_t hstep = (size_t)HALF * K * 2;
    const size_t tstep = 2 * hstep;
    const unsigned ldsw = (unsigned)wid * 1024u;
    const int aoff = lds_byte(wr * 64 + fr, fq * 8), boff = lds_byte(wc * 32 + fr, fq * 8);
#define PG8_SA(b, h) (((b) * 2 + (h)) * HTB)
#define PG8_SB(b, h) ((4 + (b) * 2 + (h)) * HTB)
#define PG8_STAGE(bufoff, gbase, voff) do { _Pragma("unroll") for (int _i = 0; _i < 2; ++_i) \
        __builtin_amdgcn_global_load_lds((const unsigned*)((const char*)(gbase) + (voff)[_i]), (PG8_LAS unsigned*)(lds + (bufoff) + ldsw + _i * 8192), 16, 0, 0); } while (0)
#define PG8_LDA(dst, b, h) do { _Pragma("unroll") for (int m = 0; m < 4; ++m) _Pragma("unroll") for (int k = 0; k < 2; ++k) dst[m][k] = *(const PG8_LAS bf16x8*)(lds + PG8_SA(b, h) + aoff + m * 2048 + k * 1024); } while (0)
#define PG8_LDB(dst, b, h) do { _Pragma("unroll") for (int n = 0; n < 2; ++n) _Pragma("unroll") for (int k = 0; k < 2; ++k) dst[n][k] = *(const PG8_LAS bf16x8*)(lds + PG8_SB(b, h) + boff + n * 2048 + k * 1024); } while (0)
#define PG8_MMA(ai, bj, At, Bt) do { __builtin_amdgcn_s_setprio(1); _Pragma("unroll") for (int m = 0; m < 4; ++m) _Pragma("unroll") for (int n = 0; n < 2; ++n) _Pragma("unroll") for (int k = 0; k < 2; ++k) \
        acc[ai][bj][m][n] = __builtin_amdgcn_mfma_f32_16x16x32_bf16(Bt[n][k], At[m][k], acc[ai][bj][m][n], 0, 0, 0); __builtin_amdgcn_s_setprio(0); } while (0)
#define PG8_WAIT_V(n) asm volatile("s_waitcnt vmcnt(" #n ")" ::: "memory")
#define PG8_WAIT_L(n) asm volatile("s_waitcnt lgkmcnt(" #n ")" ::: "memory")
#define PG8_BAR __builtin_amdgcn_s_barrier()
#define PG8_SCHED __builtin_amdgcn_sched_barrier(0)
    Unit cur, nxt; int ui = 0;
    if (!S.next(0, cur)) return;
    f32x4 acc[2][2][4][2];
#pragma unroll
    for (int a = 0; a < 2; ++a)
#pragma unroll
        for (int b = 0; b < 2; ++b)
#pragma unroll
            for (int m = 0; m < 4; ++m)
#pragma unroll
                for (int n = 0; n < 2; ++n) acc[a][b][m][n] = (f32x4){0.f, 0.f, 0.f, 0.f};
    bf16x8 At[4][2], B0[2][2], B1[2][2];
    const char* cA = (const char*)g.A + (size_t)cur.pm * tstep; const char* cB = (const char*)g.Bt + (size_t)cur.pn * tstep;
    S.a_ready(cur);
    PG8_STAGE(PG8_SB(0, 0), cB, voffB); PG8_STAGE(PG8_SA(0, 0), cA, voffA); PG8_STAGE(PG8_SB(0, 1), cB + hstep, voffB); PG8_STAGE(PG8_SA(0, 1), cA + hstep, voffA);
    if (wr == 1) PG8_BAR;
    PG8_WAIT_V(4); PG8_BAR;
    PG8_STAGE(PG8_SB(1, 0), cB + kstep, voffB); PG8_STAGE(PG8_SA(1, 0), cA + kstep, voffA); PG8_STAGE(PG8_SB(1, 1), cB + hstep + kstep, voffB);
    PG8_WAIT_V(6); PG8_BAR;
    PG8_STAMP();
    for (;;) {
        const bool has_next = S.next(ui + 1, nxt);
        const char* nA = has_next ? (const char*)g.A + (size_t)nxt.pm * tstep : cA; const char* nB = has_next ? (const char*)g.Bt + (size_t)nxt.pn * tstep : cB;
        for (int t = 0; t < nt; t += 2) {
            const bool last = (t == nt - 2);
            const char* a1 = cA + (size_t)(t + 1) * kstep;
            const char* a2 = last ? nA : cA + (size_t)(t + 2) * kstep; const char* b2 = last ? nB : cB + (size_t)(t + 2) * kstep;
            const char* a3 = a2 + kstep; const char* b3 = b2 + kstep;
            if (last && has_next) S.a_ready(nxt);
            PG8_LDB(B0, 0, 0); PG8_SCHED; PG8_LDA(At, 0, 0); PG8_STAGE(PG8_SA(1, 1), a1 + hstep, voffA);
            PG8_WAIT_L(8); PG8_BAR; PG8_WAIT_L(0); PG8_MMA(0, 0, At, B0); PG8_BAR; PG8_SCHED;
            PG8_LDB(B1, 0, 1); PG8_STAGE(PG8_SB(0, 0), b2, voffB);
            PG8_BAR; PG8_WAIT_L(0); PG8_MMA(0, 1, At, B1); PG8_BAR;
            PG8_LDA(At, 0, 1); PG8_STAGE(PG8_SA(0, 0), a2, voffA);
            PG8_BAR; PG8_WAIT_L(0); PG8_MMA(1, 0, At, B0); PG8_BAR; PG8_SCHED;
            PG8_STAGE(PG8_SB(0, 1), b2 + hstep, voffB);
            PG8_WAIT_V(6); PG8_BAR; PG8_MMA(1, 1, At, B1); PG8_BAR;
            PG8_LDB(B0, 1, 0); PG8_SCHED; PG8_LDA(At, 1, 0); PG8_STAGE(PG8_SA(0, 1), a2 + hstep, voffA);
            PG8_WAIT_L(8); PG8_BAR; PG8_WAIT_L(0); PG8_MMA(0, 0, At, B0); PG8_BAR; PG8_SCHED;
            PG8_LDB(B1, 1, 1); PG8_STAGE(PG8_SB(1, 0), b3, voffB);
            PG8_BAR; PG8_WAIT_L(0); PG8_MMA(0, 1, At, B1); PG8_BAR;
            PG8_LDA(At, 1, 1); PG8_STAGE(PG8_SA(1, 0), a3, voffA);
            PG8_BAR; PG8_WAIT_L(0); PG8_MMA(1, 0, At, B0); PG8_BAR; PG8_SCHED;
            PG8_STAGE(PG8_SB(1, 1), b3 + hstep, voffB);
            PG8_WAIT_V(6); PG8_BAR; PG8_MMA(1, 1, At, B1); PG8_BAR;
        }
        PG8_STAMP();
        if constexpr (!Epi::AFTER_DRAIN) { E(acc, cur, wr, wc, fr, fq); S.done(cur); }
        PG8_STAMP();
        if (!has_next) break;
#pragma unroll
        for (int a = 0; a < 2; ++a)
#pragma unroll
            for (int b = 0; b < 2; ++b)
#pragma unroll
                for (int m = 0; m < 4; ++m)
#pragma unroll
                    for (int n = 0; n < 2; ++n) acc[a][b][m][n] = (f32x4){0.f, 0.f, 0.f, 0.f};
        cur = nxt; cA = nA; cB = nB; ++ui;
    }
    PG8_WAIT_V(0);
    if (wr == 0) PG8_BAR;
    PG8_BAR;
    if constexpr (Epi::AFTER_DRAIN) { E.fused(acc, cur, wr, wc, fr, fq, lds, wid, lane); S.done(cur); }
    PG8_STAMP();
    if (STAMP && wid == 0) { stamps[lane] = lane < nts ? (((unsigned long long)(unsigned)ts_hi << 32) | (unsigned)ts_lo) : 0ull;
        if (lane == 62) stamps[62] = rt_entry; if (lane == 63) stamps[63] = (unsigned long long)wall_clock64(); }
#undef PG8_STAMP
#undef PG8_SA
#undef PG8_SB
#undef PG8_STAGE
#undef PG8_LDA
#undef PG8_LDB
#undef PG8_MMA
#undef PG8_WAIT_V
#undef PG8_WAIT_L
#undef PG8_BAR
#undef PG8_SCHED
}
}

struct EpiProj {
  static constexpr bool PERM = true, AFTER_DRAIN = false;
  unsigned short* pH; unsigned short* pA; unsigned short* pG;
  __device__ __forceinline__ void operator()(const pg8::f32x4 (&acc)[2][2][4][2], const pg8::Unit& u, int wr, int wc, int fr, int fq) const {
    const int row0 = u.pm * 256 + wr * 64 + fr;
    unsigned short* base; int ldc, colt; bool sg = false;
    if (u.pn < 8) { base = pH; ldc = 2048; colt = u.pn * 256; }
    else if (u.pn < 12) { base = pA; ldc = 1024; colt = (u.pn - 8) * 256; }
    else { base = pG; ldc = 2048; colt = (u.pn - 12) * 256; sg = true; }
    const int col0 = colt + wc * 32 + 8 * fq;
#pragma unroll
    for (int ai = 0; ai < 2; ++ai)
#pragma unroll
      for (int m = 0; m < 4; ++m) {
        unsigned short* rowp = base + (size_t)(row0 + ai * 128 + m * 16) * ldc + col0;
#pragma unroll
        for (int bj = 0; bj < 2; ++bj) {
          pg8::f32x4 v0 = acc[ai][bj][m][0], v1 = acc[ai][bj][m][1];
          if (sg) {
#pragma unroll
            for (int j = 0; j < 4; ++j) { v0[j] = sigmoidf_(v0[j]); v1[j] = sigmoidf_(v1[j]); }
          }
          pg8::u32x4 w; w.x = pg8::cvt_pk_bf16(v0[0], v0[1]); w.y = pg8::cvt_pk_bf16(v0[2], v0[3]); w.z = pg8::cvt_pk_bf16(v1[0], v1[1]); w.w = pg8::cvt_pk_bf16(v1[2], v1[3]);
          *(pg8::u32x4*)(rowp + bj * 128) = w;
        }
      }
  }
};
template <int MODE> struct EpiGate {
  static constexpr bool PERM = true, AFTER_DRAIN = false;
  unsigned short* hb; const unsigned short* pG; int goff;
  __device__ __forceinline__ void operator()(const pg8::f32x4 (&acc)[2][2][4][2], const pg8::Unit& u, int wr, int wc, int fr, int fq) const {
    const int row0 = u.pm * 256 + wr * 64 + fr;
    const int col0 = u.pn * 256 + wc * 32 + 8 * fq;
#pragma unroll
    for (int ai = 0; ai < 2; ++ai)
#pragma unroll
      for (int m = 0; m < 4; ++m) {
        const size_t r = (size_t)(row0 + ai * 128 + m * 16);
        pg8::u32x4 gv[2], hv[2];
#pragma unroll
        for (int bj = 0; bj < 2; ++bj) {
          gv[bj] = *(const pg8::u32x4*)(pG + r * 2048 + goff + col0 + bj * 128);
          if (MODE == 1) hv[bj] = *(const pg8::u32x4*)(hb + r * 1024 + col0 + bj * 128);
        }
#pragma unroll
        for (int bj = 0; bj < 2; ++bj) {
          float o[8];
#pragma unroll
          for (int j = 0; j < 4; ++j) {
            const unsigned gw0 = gv[bj][j >> 1], gw1 = gv[bj][2 + (j >> 1)];
            const float g0 = (j & 1) ? __uint_as_float(gw0 & 0xffff0000u) : __uint_as_float(gw0 << 16);
            const float g1 = (j & 1) ? __uint_as_float(gw1 & 0xffff0000u) : __uint_as_float(gw1 << 16);
            o[j] = acc[ai][bj][m][0][j] * g0; o[4 + j] = acc[ai][bj][m][1][j] * g1;
            if (MODE == 1) {
              const unsigned hw0 = hv[bj][j >> 1], hw1 = hv[bj][2 + (j >> 1)];
              o[j] += (j & 1) ? __uint_as_float(hw0 & 0xffff0000u) : __uint_as_float(hw0 << 16);
              o[4 + j] += (j & 1) ? __uint_as_float(hw1 & 0xffff0000u) : __uint_as_float(hw1 << 16);
            }
          }
          pg8::u32x4 w; w.x = pg8::cvt_pk_bf16(o[0], o[1]); w.y = pg8::cvt_pk_bf16(o[2], o[3]); w.z = pg8::cvt_pk_bf16(o[4], o[5]); w.w = pg8::cvt_pk_bf16(o[6], o[7]);
          *(pg8::u32x4*)(hb + r * 1024 + col0 + bj * 128) = w;
        }
      }
  }
};
struct EpiResid {
  static constexpr bool PERM = false, AFTER_DRAIN = false;
  float* out; const float* x;
  __device__ __forceinline__ void operator()(const pg8::f32x4 (&acc)[2][2][4][2], const pg8::Unit& u, int wr, int wc, int fr, int fq) const {
    const int row0 = u.pm * 256 + wr * 64 + fr, col0 = u.pn * 256 + wc * 32 + 4 * fq;
#pragma unroll
    for (int ai = 0; ai < 2; ++ai)
#pragma unroll
      for (int m = 0; m < 4; ++m) {
        const size_t off = (size_t)(row0 + ai * 128 + m * 16) * 1024 + col0;
        pg8::f32x4 xv[2][2];
#pragma unroll
        for (int bj = 0; bj < 2; ++bj)
#pragma unroll
          for (int n = 0; n < 2; ++n) xv[bj][n] = *(const pg8::f32x4*)(x + off + bj * 128 + n * 16);
#pragma unroll
        for (int bj = 0; bj < 2; ++bj)
#pragma unroll
          for (int n = 0; n < 2; ++n) *(pg8::f32x4*)(out + off + bj * 128 + n * 16) = acc[ai][bj][m][n] + xv[bj][n];
      }
  }
};
struct EpiStoreBf16 {
  static constexpr bool PERM = true, AFTER_DRAIN = false;
  unsigned short* O; int ldc;
  __device__ __forceinline__ void operator()(const pg8::f32x4 (&acc)[2][2][4][2], const pg8::Unit& u, int wr, int wc, int fr, int fq) const {
    const int row0 = u.pm * 256 + wr * 64 + fr, col0 = u.pn * 256 + wc * 32 + 8 * fq;
#pragma unroll
    for (int ai = 0; ai < 2; ++ai)
#pragma unroll
      for (int m = 0; m < 4; ++m) {
        unsigned short* rowp = O + (size_t)(row0 + ai * 128 + m * 16) * ldc + col0;
#pragma unroll
        for (int bj = 0; bj < 2; ++bj) {
          const pg8::f32x4 v0 = acc[ai][bj][m][0], v1 = acc[ai][bj][m][1];
          pg8::u32x4 w; w.x = pg8::cvt_pk_bf16(v0[0], v0[1]); w.y = pg8::cvt_pk_bf16(v0[2], v0[3]); w.z = pg8::cvt_pk_bf16(v1[0], v1[1]); w.w = pg8::cvt_pk_bf16(v1[2], v1[3]);
          *(pg8::u32x4*)(rowp + bj * 128) = w;
        }
      }
  }
};

__device__ __forceinline__ void gemm_tile(const bf16_t* __restrict__ A, int lda, const bf16_t* __restrict__ Bt, int ldb,
                                          int nk, f32x4 (&acc)[4][4], unsigned char* smem) {
  const int tid = threadIdx.x, lane = tid & 63, w = tid >> 6, wm = w >> 1, wn = w & 1, l15 = lane & 15, g = lane >> 4;
  unsigned char* sA = smem;
  unsigned char* sB = smem + 32768;
  const int lr = tid >> 3, lc = tid & 7;
  const bf16_t* ga = A + (size_t)lr * lda + lc * 8;
  const bf16_t* gb = Bt + (size_t)lr * ldb + lc * 8;
  uint4 ra0, ra1, ra2, ra3, rb0, rb1;
  ra0 = *(const uint4*)(ga);
  ra1 = *(const uint4*)(ga + (size_t)64 * lda);
  ra2 = *(const uint4*)(ga + (size_t)128 * lda);
  ra3 = *(const uint4*)(ga + (size_t)192 * lda);
  rb0 = *(const uint4*)(gb);
  rb1 = *(const uint4*)(gb + (size_t)64 * ldb);
  const int sw = (lc ^ (lr & 7)) << 4;
  for (int kt = 0; kt < nk; ++kt) {
    __syncthreads();
    *(uint4*)(sA + (lr) * 128 + sw) = ra0;
    *(uint4*)(sA + (lr + 64) * 128 + sw) = ra1;
    *(uint4*)(sA + (lr + 128) * 128 + sw) = ra2;
    *(uint4*)(sA + (lr + 192) * 128 + sw) = ra3;
    *(uint4*)(sB + (lr) * 128 + sw) = rb0;
    *(uint4*)(sB + (lr + 64) * 128 + sw) = rb1;
    __syncthreads();
    if (kt + 1 < nk) {
      const int ko = (kt + 1) * 64;
      ra0 = *(const uint4*)(ga + ko);
      ra1 = *(const uint4*)(ga + (size_t)64 * lda + ko);
      ra2 = *(const uint4*)(ga + (size_t)128 * lda + ko);
      ra3 = *(const uint4*)(ga + (size_t)192 * lda + ko);
      rb0 = *(const uint4*)(gb + ko);
      rb1 = *(const uint4*)(gb + (size_t)64 * ldb + ko);
    }
#pragma unroll
    for (int ks = 0; ks < 2; ++ks) {
      bf16x8 a[4], b[4];
#pragma unroll
      for (int m = 0; m < 4; ++m) { const int r = wm * 64 + m * 16 + l15; a[m] = *(const bf16x8*)(sA + r * 128 + (((ks * 4 + g) ^ (r & 7)) << 4)); }
#pragma unroll
      for (int n = 0; n < 4; ++n) { const int r = wn * 64 + n * 16 + l15; b[n] = *(const bf16x8*)(sB + r * 128 + (((ks * 4 + g) ^ (r & 7)) << 4)); }
#pragma unroll
      for (int m = 0; m < 4; ++m)
#pragma unroll
        for (int n = 0; n < 4; ++n) acc[m][n] = __builtin_amdgcn_mfma_f32_16x16x32_bf16(a[m], b[n], acc[m][n], 0, 0, 0);
    }
  }
}

__device__ __forceinline__ void zero_acc(f32x4 (&acc)[4][4]) {
#pragma unroll
  for (int m = 0; m < 4; ++m)
#pragma unroll
    for (int n = 0; n < 4; ++n) acc[m][n] = (f32x4){0.f, 0.f, 0.f, 0.f};
}

__device__ __forceinline__ void transpose_tile(const float* __restrict__ src, int srcN, bf16_t* __restrict__ dst, int K, int n0, int k0,
                                               bool winmap, float* tile) {
  const int tid = threadIdx.x;
  const int nc = tid & 63, kr = tid >> 6;
  int ncol = n0 + nc; bool valid = true;
  if (winmap) { if (ncol >= 3072) ncol -= 60; else if (ncol >= 3012) valid = false; }
#pragma unroll
  for (int i = 0; i < 8; ++i) {
    const int k = kr + 8 * i;
    tile[k * 65 + nc] = valid ? src[(size_t)(k0 + k) * srcN + ncol] : 0.f;
  }
  __syncthreads();
#pragma unroll
  for (int i = 0; i < 8; ++i) {
    const int nr = kr + 8 * i;
    dst[(size_t)(n0 + nr) * K + k0 + nc] = f2bf(tile[nc * 65 + nr]);
  }
  __syncthreads();
}

__device__ __forceinline__ void convert_f32_bf16(const float* __restrict__ src, bf16_t* __restrict__ dst, size_t n4) {
  for (size_t i = (size_t)blockIdx.x * NTHREADS + threadIdx.x; i < n4; i += (size_t)gridDim.x * NTHREADS) {
    const float4 v = ((const float4*)src)[i];
    uint2 o; o.x = pack2(v.x, v.y); o.y = pack2(v.z, v.w);
    ((uint2*)dst)[i] = o;
  }
}

template <bool SLICE_MAJOR, bool SIGNED>
__device__ __forceinline__ void quantize_rows_u8(const float* __restrict__ src, unsigned char* __restrict__ dst, float* __restrict__ scale) {
  const int lane = threadIdx.x & 63, w = threadIdx.x >> 6;
  for (int row = blockIdx.x * 8 + w; row < 16384; row += gridDim.x * 8) {
    const float4* s4 = (const float4*)(src + (size_t)row * 1024) + lane * 4;
    float4 v[4];
    float am = 0.f;
#pragma unroll
    for (int i = 0; i < 4; ++i) { v[i] = s4[i]; am = fmaxf(am, fmaxf(fmaxf(fabsf(v[i].x), fabsf(v[i].y)), fmaxf(fabsf(v[i].z), fabsf(v[i].w)))); }
#pragma unroll
    for (int o = 32; o > 0; o >>= 1) am = fmaxf(am, __shfl_xor(am, o));
    const float inv = am > 0.f ? 127.f / am : 0.f;
    unsigned pk[4];
#pragma unroll
    for (int i = 0; i < 4; ++i) {
      const int ofs = SIGNED ? 0 : 128;
      const unsigned b0 = (unsigned)((int)rintf(v[i].x * inv) + ofs), b1 = (unsigned)((int)rintf(v[i].y * inv) + ofs);
      const unsigned b2 = (unsigned)((int)rintf(v[i].z * inv) + ofs), b3 = (unsigned)((int)rintf(v[i].w * inv) + ofs);
      pk[i] = (b0 & 255u) | ((b1 & 255u) << 8) | ((b2 & 255u) << 16) | ((b3 & 255u) << 24);
    }
    if (SLICE_MAJOR) *(uint4*)(dst + (size_t)(lane >> 3) * (16384 * 128) + (size_t)row * 128 + (lane & 7) * 16) = make_uint4(pk[0], pk[1], pk[2], pk[3]);
    else *(uint4*)(dst + (size_t)row * 1024 + lane * 16) = make_uint4(pk[0], pk[1], pk[2], pk[3]);
    if (lane == 0) scale[row] = am * (1.f / 127.f);
  }
}

#define WS_XQ (WS_PH + (size_t)TOK * 1024 * 2)
#define WS_XS (WS_XQ + (size_t)TOK * 1024)
__device__ __forceinline__ void rmsnorm_rows_q(const float* __restrict__ src, const float* __restrict__ g, bf16_t* __restrict__ dst,
                                               unsigned char* __restrict__ xq, float* __restrict__ xs) {
  const int lane = threadIdx.x & 63, w = threadIdx.x >> 6;
  for (int row = blockIdx.x * 8 + w; row < TOK; row += gridDim.x * 8) {
    const float4* s4 = (const float4*)(src + (size_t)row * DM) + lane * 4;
    const float4* g4 = (const float4*)g + lane * 4;
    float v[16]; float ss = 0.f;
#pragma unroll
    for (int i = 0; i < 4; ++i) { const float4 t = s4[i]; v[4 * i] = t.x; v[4 * i + 1] = t.y; v[4 * i + 2] = t.z; v[4 * i + 3] = t.w; ss += t.x * t.x + t.y * t.y + t.z * t.z + t.w * t.w; }
    ss = wave_sum(ss);
    const float rstd = rsqrtf(ss * (1.f / DM) + EPSV);
    float am = 0.f;
#pragma unroll
    for (int i = 0; i < 4; ++i) { const float4 gg = g4[i]; v[4 * i] *= rstd * gg.x; v[4 * i + 1] *= rstd * gg.y; v[4 * i + 2] *= rstd * gg.z; v[4 * i + 3] *= rstd * gg.w; }
#pragma unroll
    for (int i = 0; i < 16; ++i) am = fmaxf(am, fabsf(v[i]));
#pragma unroll
    for (int o = 32; o > 0; o >>= 1) am = fmaxf(am, __shfl_xor(am, o));
    const float inv = am > 0.f ? 127.f / am : 0.f;
    uint4 ob0, ob1;
    ob0.x = pack2(v[0], v[1]); ob0.y = pack2(v[2], v[3]); ob0.z = pack2(v[4], v[5]); ob0.w = pack2(v[6], v[7]);
    ob1.x = pack2(v[8], v[9]); ob1.y = pack2(v[10], v[11]); ob1.z = pack2(v[12], v[13]); ob1.w = pack2(v[14], v[15]);
    *(uint4*)(dst + (size_t)row * DM + lane * 16) = ob0;
    *(uint4*)(dst + (size_t)row * DM + lane * 16 + 8) = ob1;
    unsigned pk[4];
#pragma unroll
    for (int i = 0; i < 4; ++i) {
      const unsigned b0 = (unsigned)(int)rintf(v[4 * i] * inv) & 255u, b1 = (unsigned)(int)rintf(v[4 * i + 1] * inv) & 255u;
      const unsigned b2 = (unsigned)(int)rintf(v[4 * i + 2] * inv) & 255u, b3 = (unsigned)(int)rintf(v[4 * i + 3] * inv) & 255u;
      pk[i] = b0 | (b1 << 8) | (b2 << 16) | (b3 << 24);
    }
    *(uint4*)(xq + (size_t)row * 1024 + lane * 16) = make_uint4(pk[0], pk[1], pk[2], pk[3]);
    if (lane == 0) xs[row] = am * (1.f / 127.f);
  }
}

__device__ __forceinline__ void rmsnorm_rows(const float* __restrict__ src, const float* __restrict__ g, bf16_t* __restrict__ dst) {
  const int lane = threadIdx.x & 63, w = threadIdx.x >> 6;
  for (int row = blockIdx.x * 8 + w; row < TOK; row += gridDim.x * 8) {
    const float4* s4 = (const float4*)(src + (size_t)row * DM);
    float4 v[4]; float ss = 0.f;
#pragma unroll
    for (int i = 0; i < 4; ++i) { v[i] = s4[lane + 64 * i]; ss += v[i].x * v[i].x + v[i].y * v[i].y + v[i].z * v[i].z + v[i].w * v[i].w; }
    ss = wave_sum(ss);
    const float rstd = rsqrtf(ss * (1.f / DM) + EPSV);
#pragma unroll
    for (int i = 0; i < 4; ++i) {
      const float4 gg = ((const float4*)g)[lane + 64 * i];
      uint2 o; o.x = pack2(v[i].x * rstd * gg.x, v[i].y * rstd * gg.y); o.y = pack2(v[i].z * rstd * gg.z, v[i].w * rstd * gg.w);
      ((uint2*)(dst + (size_t)row * DM))[lane + 64 * i] = o;
    }
  }
}

__device__ __forceinline__ void phase_prep(const Params& p, unsigned char* smem) {
  unsigned char* ws = p.ws;
  float* tile = (float*)smem;
  const int n_win = 80 * 16, n_ua = 16 * 8, n_ub = 16 * 8, n_wo = 16 * 16, n_wq = 32 * 16;
  const int total = n_win + n_ua + n_ub + n_wo + n_wq;
  for (int it = blockIdx.x; it < total; it += gridDim.x) {
    int t = it;
    if (t < n_win) { transpose_tile(p.w_in, 5060, (bf16_t*)(ws + WS_WIN), 1024, (t >> 4) * 64, (t & 15) * 64, true, tile); continue; }
    t -= n_win;
    if (t < n_ua) { transpose_tile(p.w_up_a, 1024, (bf16_t*)(ws + WS_WUPA), 512, (t >> 3) * 64, (t & 7) * 64, false, tile); continue; }
    t -= n_ua;
    if (t < n_ub) { transpose_tile(p.w_up_b, 1024, (bf16_t*)(ws + WS_WUPB), 512, (t >> 3) * 64, (t & 7) * 64, false, tile); continue; }
    t -= n_ub;
    if (t < n_wo) { transpose_tile(p.w_out, 1024, (bf16_t*)(ws + WS_WOUT), 1024, (t >> 4) * 64, (t & 15) * 64, false, tile); continue; }
    t -= n_wo;
    transpose_tile(p.peer_wq, 2048, (bf16_t*)(ws + WS_WQ), 1024, (t >> 4) * 64, (t & 15) * 64, false, tile);
  }
  quantize_rows_u8<false, true>(p.peer_u, ws + WS_U, (float*)(ws + WS_U + (size_t)16384 * 1024));
  quantize_rows_u8<true, false>(p.peer_v, ws + WS_V, (float*)(ws + WS_V + (size_t)16384 * 1024));
  convert_f32_bf16(p.peer_keys, (bf16_t*)(ws + WS_KEYS), (size_t)2 * 8 * 128 * 128 / 4);
  for (int i = blockIdx.x * NTHREADS + threadIdx.x; i < TOK; i += gridDim.x * NTHREADS) ((float*)(ws + WS_SSQ))[i] = 0.f;
  if (threadIdx.x == 0) ((int*)(ws + WS_XCC))[blockIdx.x] = (int)(__builtin_amdgcn_s_getreg((3 << 11) | 20) & 0xFu);
  if (blockIdx.x == 0) {
    const int i = threadIdx.x;
    const float a0 = p.hg_lb[i], a1 = p.hg_lb[512 + i];
    ((float*)(ws + WS_LB))[i] = 1.f / (1.f + expf(a1 - a0));
  }
  rmsnorm_rows(p.x, p.norm_mix, (bf16_t*)(ws + WS_XN));
}

__device__ __forceinline__ void phase_proj(const Params& p, unsigned char* smem) {
  unsigned char* ws = p.ws;
  const bf16_t* xn = (const bf16_t*)(ws + WS_XN);
  const bf16_t* wt = (const bf16_t*)(ws + WS_WIN);
  bf16_t* pH = (bf16_t*)(ws + WS_PH);
  bf16_t* pA = (bf16_t*)(ws + WS_PA);
  bf16_t* pG = (bf16_t*)(ws + WS_PG);
  const int tid = threadIdx.x, lane = tid & 63, w = tid >> 6, wm = w >> 1, wn = w & 1, l15 = lane & 15, g = lane >> 4;
  for (int tile = blockIdx.x; tile < 128 * 40; tile += gridDim.x) {
    const int tn = tile % 40, tm = tile / 40;
    f32x4 acc[4][4]; zero_acc(acc);
    gemm_tile(xn + (size_t)tm * 256 * 1024, 1024, wt + (size_t)tn * 128 * 1024, 1024, 16, acc, smem);
    const int rbase = tm * 256 + wm * 64 + 4 * g;
    const int cbase = tn * 128 + wn * 64 + l15;
    if (tn < 16) {
#pragma unroll
      for (int m = 0; m < 4; ++m)
#pragma unroll
        for (int n = 0; n < 4; ++n)
#pragma unroll
          for (int j = 0; j < 4; ++j) pH[(size_t)(rbase + m * 16 + j) * 2048 + cbase + n * 16] = f2bf(acc[m][n][j]);
    } else if (tn < 24) {
      if (tn == 23 && wn == 0) {
        float gam[4], bet[4];
#pragma unroll
        for (int n = 0; n < 4; ++n) { gam[n] = p.ikg[n * 16 + l15]; bet[n] = p.ikb[n * 16 + l15]; }
#pragma unroll
        for (int m = 0; m < 4; ++m)
#pragma unroll
          for (int j = 0; j < 4; ++j) {
            float s = acc[m][0][j] + acc[m][1][j] + acc[m][2][j] + acc[m][3][j];
            s += __shfl_xor(s, 1); s += __shfl_xor(s, 2); s += __shfl_xor(s, 4); s += __shfl_xor(s, 8);
            const float mu = s * (1.f / 64.f);
            float q = 0.f;
#pragma unroll
            for (int n = 0; n < 4; ++n) { const float d = acc[m][n][j] - mu; q += d * d; }
            q += __shfl_xor(q, 1); q += __shfl_xor(q, 2); q += __shfl_xor(q, 4); q += __shfl_xor(q, 8);
            const float rstd = rsqrtf(q * (1.f / 64.f) + EPSV);
#pragma unroll
            for (int n = 0; n < 4; ++n)
              pA[(size_t)(rbase + m * 16 + j) * 1024 + (cbase - 2048) + n * 16] = f2bf((acc[m][n][j] - mu) * rstd * gam[n] + bet[n]);
          }
      } else {
#pragma unroll
        for (int m = 0; m < 4; ++m)
#pragma unroll
          for (int n = 0; n < 4; ++n)
#pragma unroll
            for (int j = 0; j < 4; ++j) pA[(size_t)(rbase + m * 16 + j) * 1024 + (cbase - 2048) + n * 16] = f2bf(acc[m][n][j]);
      }
    } else {
#pragma unroll
      for (int m = 0; m < 4; ++m)
#pragma unroll
        for (int n = 0; n < 4; ++n)
#pragma unroll
          for (int j = 0; j < 4; ++j) pG[(size_t)(rbase + m * 16 + j) * 2048 + (cbase - 3072) + n * 16] = f2bf(sigmoidf_(acc[m][n][j]));
    }
  }
}

__device__ __forceinline__ void hgrn_item(const Params& p, unsigned char* smem, int bh) {
  unsigned char* ws = p.ws;
  const bf16_t* pH = (const bf16_t*)(ws + WS_PH);
  const float* lbp = (const float*)(ws + WS_LB);
  bf16_t* ya = (bf16_t*)(ws + WS_XN);
  bf16_t* Qt = (bf16_t*)smem;
  bf16_t* Kt = Qt + 64 * 136;
  bf16_t* KtT = Kt + 64 * 136;
  bf16_t* VT = KtT + 128 * 72;
  bf16_t* Am = VT + 128 * 72;
  bf16_t* ST = Am + 64 * 72;
  float* qtot = (float*)(ST + 128 * 136);
  float* eref = qtot + 512;
  float* elast = eref + 128;
  float* elr = elast + 128;
  float* red = elr + 128;
  const int tid = threadIdx.x, lane = tid & 63, w = tid >> 6, l15 = lane & 15, g = lane >> 4;
  const int b = bh >> 2, h = bh & 3;
  const int d = tid & 127, tq = tid >> 7;
  const float lbv = lbp[h * 128 + d];
  f32x4 S[8];
#pragma unroll
  for (int i = 0; i < 8; ++i) S[i] = (f32x4){0.f, 0.f, 0.f, 0.f};
  const float gnv = p.hg_norm[h * 128 + 16 * w + l15];

  for (int chunk = 0; chunk < 64; ++chunk) {
    const size_t row0 = (size_t)b * SEQL + chunk * 64;
    {
      const bf16_t* base = pH + (row0 + tq * 16) * 2048 + h * 128 + d;
      float lf[16], kk[16], qs[16];
      unsigned vv[8];
      float run = 0.f;
#pragma unroll
      for (int i = 0; i < 16; ++i) {
        const float fr = bf2f(base[(size_t)i * 2048 + 512]);
        const float qr = bf2f(base[(size_t)i * 2048]);
        const float sg = sigmoidf_(fr);
        const float fg = lbv + (1.f - lbv) * sg;
        run += __logf(fg);
        lf[i] = run; kk[i] = 1.f - fg; qs[i] = siluf_(qr);
      }
#pragma unroll
      for (int i = 0; i < 8; ++i) {
        const unsigned lo = base[(size_t)(2 * i) * 2048 + 1024], hi = base[(size_t)(2 * i + 1) * 2048 + 1024];
        vv[i] = lo | (hi << 16);
      }
      qtot[tq * 128 + d] = run;
      __syncthreads();
      const float q0 = qtot[d], q1 = qtot[128 + d], q2 = qtot[256 + d], q3 = qtot[384 + d];
      const float pre = (tq > 0 ? q0 : 0.f) + (tq > 1 ? q1 : 0.f) + (tq > 2 ? q2 : 0.f);
      const float bref = q0 + q1;
      const float blast = bref + q2 + q3;
      unsigned kp[8];
#pragma unroll
      for (int i = 0; i < 16; ++i) {
        const float bt = pre + lf[i];
        const float qt = qs[i] * __expf(bt - bref);
        const float kt = kk[i] * __expf(bref - bt);
        const int t = tq * 16 + i;
        Qt[t * 136 + d] = f2bf(qt);
        const bf16_t kb = f2bf(kt);
        Kt[t * 136 + d] = kb;
        if (i & 1) kp[i >> 1] |= ((unsigned)kb) << 16; else kp[i >> 1] = kb;
      }
      *(uint4*)(KtT + d * 72 + tq * 16) = make_uint4(kp[0], kp[1], kp[2], kp[3]);
      *(uint4*)(KtT + d * 72 + tq * 16 + 8) = make_uint4(kp[4], kp[5], kp[6], kp[7]);
      *(uint4*)(VT + d * 72 + tq * 16) = make_uint4(vv[0], vv[1], vv[2], vv[3]);
      *(uint4*)(VT + d * 72 + tq * 16 + 8) = make_uint4(vv[4], vv[5], vv[6], vv[7]);
      if (tq == 0) { eref[d] = __expf(bref); elast[d] = __expf(blast); elr[d] = __expf(blast - bref); }
    }
    __syncthreads();
    bf16_t ogr[16];
#pragma unroll
    for (int tm = 0; tm < 4; ++tm)
#pragma unroll
      for (int j = 0; j < 4; ++j) ogr[tm * 4 + j] = pH[(row0 + tm * 16 + 4 * g + j) * 2048 + 1536 + h * 128 + 16 * w + l15];
    {
      const int e = 16 * w + l15;
#pragma unroll
      for (int dm = 0; dm < 8; ++dm) {
        const int d0 = 16 * dm + 4 * g;
        uint2 o;
        o.x = pack2(S[dm][0] * eref[d0], S[dm][1] * eref[d0 + 1]);
        o.y = pack2(S[dm][2] * eref[d0 + 2], S[dm][3] * eref[d0 + 3]);
        *(uint2*)(ST + e * 136 + d0) = o;
      }
#pragma unroll
      for (int tt = 0; tt < 2; ++tt) {
        const int tl = 2 * w + tt, sm = tl >> 2, tn = tl & 3;
        f32x4 acc = (f32x4){0.f, 0.f, 0.f, 0.f};
        if (tn >= sm) {
#pragma unroll
          for (int k0 = 0; k0 < 128; k0 += 32) {
            const bf16x8 a = *(const bf16x8*)(Kt + (sm * 16 + l15) * 136 + k0 + 8 * g);
            const bf16x8 bq = *(const bf16x8*)(Qt + (tn * 16 + l15) * 136 + k0 + 8 * g);
            acc = __builtin_amdgcn_mfma_f32_16x16x32_bf16(a, bq, acc, 0, 0, 0);
          }
        }
        const int t = tn * 16 + l15, s0 = sm * 16 + 4 * g;
        uint2 o;
        o.x = pack2(s0 + 0 <= t ? acc[0] : 0.f, s0 + 1 <= t ? acc[1] : 0.f);
        o.y = pack2(s0 + 2 <= t ? acc[2] : 0.f, s0 + 3 <= t ? acc[3] : 0.f);
        *(uint2*)(Am + t * 72 + s0) = o;
      }
    }
    __syncthreads();
    f32x4 o[4];
    {
#pragma unroll
      for (int tm = 0; tm < 4; ++tm) {
        f32x4 acc = (f32x4){0.f, 0.f, 0.f, 0.f};
#pragma unroll
        for (int k0 = 0; k0 < 128; k0 += 32) {
          const bf16x8 a = *(const bf16x8*)(Qt + (tm * 16 + l15) * 136 + k0 + 8 * g);
          const bf16x8 bb = *(const bf16x8*)(ST + (16 * w + l15) * 136 + k0 + 8 * g);
          acc = __builtin_amdgcn_mfma_f32_16x16x32_bf16(a, bb, acc, 0, 0, 0);
        }
#pragma unroll
        for (int k0 = 0; k0 < 64; k0 += 32) {
          const bf16x8 a = *(const bf16x8*)(Am + (tm * 16 + l15) * 72 + k0 + 8 * g);
          const bf16x8 bb = *(const bf16x8*)(VT + (16 * w + l15) * 72 + k0 + 8 * g);
          acc = __builtin_amdgcn_mfma_f32_16x16x32_bf16(a, bb, acc, 0, 0, 0);
        }
        o[tm] = acc;
#pragma unroll
        for (int j = 0; j < 4; ++j) {
          float ss = acc[j] * acc[j];
          ss += __shfl_xor(ss, 1); ss += __shfl_xor(ss, 2); ss += __shfl_xor(ss, 4); ss += __shfl_xor(ss, 8);
          if (l15 == 0) red[w * 64 + tm * 16 + 4 * g + j] = ss;
        }
      }
#pragma unroll
      for (int dm = 0; dm < 8; ++dm) {
        f32x4 acc = (f32x4){0.f, 0.f, 0.f, 0.f};
#pragma unroll
        for (int k0 = 0; k0 < 64; k0 += 32) {
          const bf16x8 a = *(const bf16x8*)(KtT + (dm * 16 + l15) * 72 + k0 + 8 * g);
          const bf16x8 bb = *(const bf16x8*)(VT + (16 * w + l15) * 72 + k0 + 8 * g);
          acc = __builtin_amdgcn_mfma_f32_16x16x32_bf16(a, bb, acc, 0, 0, 0);
        }
#pragma unroll
        for (int j = 0; j < 4; ++j) { const int dd = 16 * dm + 4 * g + j; S[dm][j] = elast[dd] * S[dm][j] + elr[dd] * acc[j]; }
      }
    }
    __syncthreads();
    {
      const int e = 16 * w + l15;
#pragma unroll
      for (int tm = 0; tm < 4; ++tm)
#pragma unroll
        for (int j = 0; j < 4; ++j) {
          const int t = tm * 16 + 4 * g + j;
          float tot = 0.f;
#pragma unroll
          for (int ww = 0; ww < 8; ++ww) tot += red[ww * 64 + t];
          const float rstd = rsqrtf(tot * (1.f / 128.f) + EPSV);
          const float og = bf2f(ogr[tm * 4 + j]);
          ya[(row0 + t) * 512 + h * 128 + e] = f2bf(o[tm][j] * rstd * gnv * siluf_(og));
        }
    }
  }
}


__device__ __forceinline__ void hgrn_h1_item(const Params& p, unsigned char* smem, int item) {
  unsigned char* ws = p.ws;
  bf16_t* pH = (bf16_t*)(ws + WS_PH);
  const float* lbp = (const float*)(ws + WS_LB);
  bf16_t* Qt = (bf16_t*)smem;
  bf16_t* Kt = Qt + 64 * 136;
  bf16_t* KtT = Kt + 64 * 136;
  bf16_t* VT = KtT + 128 * 72;
  bf16_t* Am = VT + 128 * 72;
  float* qtot = (float*)(Am + 64 * 72);
  const int tid = threadIdx.x, lane = tid & 63, w = tid >> 6, l15 = lane & 15, g = lane >> 4;
  const int bh = item >> 6, chunk = item & 63;
  const int b = bh >> 2, h = bh & 3;
  const int d = tid & 127, tq = tid >> 7;
  const float lbv = lbp[h * 128 + d];
  const size_t row0 = (size_t)b * SEQL + chunk * 64;
  float* dec = (float*)(ws + WS_DEC) + (size_t)item * 384;
  uint4* UU = (uint4*)p.out + ((size_t)item * 512 + tid) * 4;
  float4* OI = (float4*)((unsigned char*)p.out + ((size_t)64 << 20)) + ((size_t)item * 512 + tid) * 4;
  {
    const bf16_t* base = pH + (row0 + tq * 16) * 2048 + h * 128 + d;
    bf16_t fr_[16], qr_[16];
    unsigned vv[8];
#pragma unroll
    for (int i = 0; i < 16; ++i) { fr_[i] = base[(size_t)i * 2048 + 512]; qr_[i] = base[(size_t)i * 2048]; }
#pragma unroll
    for (int i = 0; i < 8; ++i) {
      const unsigned lo = base[(size_t)(2 * i) * 2048 + 1024], hi = base[(size_t)(2 * i + 1) * 2048 + 1024];
      vv[i] = lo | (hi << 16);
    }
    float lf[16], kk[16], qs[16];
    float run = 0.f;
#pragma unroll
    for (int i = 0; i < 16; ++i) {
      const float sg = sigmoidf_(bf2f(fr_[i]));
      const float fg = lbv + (1.f - lbv) * sg;
      run += __logf(fg);
      lf[i] = run; kk[i] = 1.f - fg; qs[i] = siluf_(bf2f(qr_[i]));
    }
    qtot[tq * 128 + d] = run;
    __syncthreads();
    const float q0 = qtot[d], q1 = qtot[128 + d], q2 = qtot[256 + d], q3 = qtot[384 + d];
    const float pre = (tq > 0 ? q0 : 0.f) + (tq > 1 ? q1 : 0.f) + (tq > 2 ? q2 : 0.f);
    const float bref = q0 + q1;
    const float blast = bref + q2 + q3;
    unsigned kp[8];
#pragma unroll
    for (int i = 0; i < 16; ++i) {
      const float bt = pre + lf[i];
      const float qt = qs[i] * __expf(bt - bref);
      const float kt = kk[i] * __expf(bref - bt);
      const int t = tq * 16 + i;
      Qt[t * 136 + d] = f2bf(qt);
      const bf16_t kb = f2bf(kt);
      Kt[t * 136 + d] = kb;
      if (i & 1) kp[i >> 1] |= ((unsigned)kb) << 16; else kp[i >> 1] = kb;
    }
    *(uint4*)(KtT + d * 72 + tq * 16) = make_uint4(kp[0], kp[1], kp[2], kp[3]);
    *(uint4*)(KtT + d * 72 + tq * 16 + 8) = make_uint4(kp[4], kp[5], kp[6], kp[7]);
    *(uint4*)(VT + d * 72 + tq * 16) = make_uint4(vv[0], vv[1], vv[2], vv[3]);
    *(uint4*)(VT + d * 72 + tq * 16 + 8) = make_uint4(vv[4], vv[5], vv[6], vv[7]);
    if (tq == 0) { dec[d] = __expf(bref); dec[128 + d] = __expf(blast); dec[256 + d] = __expf(blast - bref); }
  }
  __syncthreads();
  {
#pragma unroll
    for (int i = 0; i < 2; ++i) {
      const int idx = tid + 512 * i, r = idx >> 4, c = idx & 15;
      *(uint4*)(pH + (row0 + r) * 2048 + h * 128 + c * 8) = *(const uint4*)(Qt + r * 136 + c * 8);
    }
#pragma unroll
    for (int tt = 0; tt < 2; ++tt) {
      const int tl = 2 * w + tt, sm = tl >> 2, tn = tl & 3;
      f32x4 acc = (f32x4){0.f, 0.f, 0.f, 0.f};
      if (tn >= sm) {
#pragma unroll
        for (int k0 = 0; k0 < 128; k0 += 32) {
          const bf16x8 a = *(const bf16x8*)(Kt + (sm * 16 + l15) * 136 + k0 + 8 * g);
          const bf16x8 bq = *(const bf16x8*)(Qt + (tn * 16 + l15) * 136 + k0 + 8 * g);
          acc = __builtin_amdgcn_mfma_f32_16x16x32_bf16(a, bq, acc, 0, 0, 0);
        }
      }
      const int t = tn * 16 + l15, s0 = sm * 16 + 4 * g;
      uint2 o;
      o.x = pack2(s0 + 0 <= t ? acc[0] : 0.f, s0 + 1 <= t ? acc[1] : 0.f);
      o.y = pack2(s0 + 2 <= t ? acc[2] : 0.f, s0 + 3 <= t ? acc[3] : 0.f);
      *(uint2*)(Am + t * 72 + s0) = o;
    }
  }
  __syncthreads();
  {
#pragma unroll
    for (int tm = 0; tm < 4; ++tm) {
      f32x4 acc = (f32x4){0.f, 0.f, 0.f, 0.f};
#pragma unroll
      for (int k0 = 0; k0 < 64; k0 += 32) {
        const bf16x8 a = *(const bf16x8*)(Am + (tm * 16 + l15) * 72 + k0 + 8 * g);
        const bf16x8 bb = *(const bf16x8*)(VT + (16 * w + l15) * 72 + k0 + 8 * g);
        acc = __builtin_amdgcn_mfma_f32_16x16x32_bf16(a, bb, acc, 0, 0, 0);
      }
      OI[tm] = make_float4(acc[0], acc[1], acc[2], acc[3]);
    }
#pragma unroll
    for (int dp = 0; dp < 4; ++dp) {
      unsigned pk[4];
#pragma unroll
      for (int hh = 0; hh < 2; ++hh) {
        const int dm = dp * 2 + hh;
        f32x4 acc = (f32x4){0.f, 0.f, 0.f, 0.f};
#pragma unroll
        for (int k0 = 0; k0 < 64; k0 += 32) {
          const bf16x8 a = *(const bf16x8*)(KtT + (dm * 16 + l15) * 72 + k0 + 8 * g);
          const bf16x8 bb = *(const bf16x8*)(VT + (16 * w + l15) * 72 + k0 + 8 * g);
          acc = __builtin_amdgcn_mfma_f32_16x16x32_bf16(a, bb, acc, 0, 0, 0);
        }
        pk[hh * 2] = pack2(acc[0], acc[1]); pk[hh * 2 + 1] = pack2(acc[2], acc[3]);
      }
      UU[dp] = make_uint4(pk[0], pk[1], pk[2], pk[3]);
    }
  }
  __syncthreads();
}

__device__ __forceinline__ void hgrn_h2(const Params& p, unsigned char* smem, int bh) {
  unsigned char* ws = p.ws;
  const bf16_t* pH = (const bf16_t*)(ws + WS_PH);
  bf16_t* ya = (bf16_t*)(ws + WS_XN);
  bf16_t* Qt = (bf16_t*)smem;
  bf16_t* ST = Qt + 64 * 136;
  float* decl = (float*)(ST + 128 * 136);
  float* red = decl + 384;
  const int tid = threadIdx.x, lane = tid & 63, w = tid >> 6, l15 = lane & 15, g = lane >> 4;
  const int b = bh >> 2, h = bh & 3;
  f32x4 S[8];
#pragma unroll
  for (int i = 0; i < 8; ++i) S[i] = (f32x4){0.f, 0.f, 0.f, 0.f};
  const float gnv = p.hg_norm[h * 128 + 16 * w + l15];
  const int e = 16 * w + l15;
  uint4 uu0, uu1, uu2, uu3; float4 oi0, oi1, oi2, oi3; uint4 qraw0, qraw1; bf16_t ogr[16]; float dcv = 0.f;
#define H2_LOAD(CH) do { \
    const int item_ = bh * 64 + (CH); \
    const size_t row0_ = (size_t)b * SEQL + (size_t)(CH) * 64; \
    const uint4* UUp = (const uint4*)p.out + ((size_t)item_ * 512 + tid) * 4; \
    const float4* OIp = (const float4*)((const unsigned char*)p.out + ((size_t)64 << 20)) + ((size_t)item_ * 512 + tid) * 4; \
    uu0 = UUp[0]; uu1 = UUp[1]; uu2 = UUp[2]; uu3 = UUp[3]; oi0 = OIp[0]; oi1 = OIp[1]; oi2 = OIp[2]; oi3 = OIp[3]; \
    qraw0 = *(const uint4*)(pH + (row0_ + (tid >> 4)) * 2048 + h * 128 + (tid & 15) * 8); \
    qraw1 = *(const uint4*)(pH + (row0_ + 32 + (tid >> 4)) * 2048 + h * 128 + (tid & 15) * 8); \
    _Pragma("unroll") for (int tm = 0; tm < 4; ++tm) _Pragma("unroll") for (int j = 0; j < 4; ++j) \
      ogr[tm * 4 + j] = pH[(row0_ + tm * 16 + 4 * g + j) * 2048 + 1536 + h * 128 + e]; \
    if (tid < 384) dcv = ((const float*)(ws + WS_DEC))[(size_t)item_ * 384 + tid]; \
  } while (0)
  H2_LOAD(0);
  for (int chunk = 0; chunk < 64; ++chunk) {
    const size_t row0 = (size_t)b * SEQL + chunk * 64;
    const uint4 cu[4] = {uu0, uu1, uu2, uu3}; const float4 co[4] = {oi0, oi1, oi2, oi3}; bf16_t cog[16];
#pragma unroll
    for (int i = 0; i < 16; ++i) cog[i] = ogr[i];
    *(uint4*)(Qt + (tid >> 4) * 136 + (tid & 15) * 8) = qraw0;
    *(uint4*)(Qt + (32 + (tid >> 4)) * 136 + (tid & 15) * 8) = qraw1;
    if (tid < 384) decl[tid] = dcv;
    __syncthreads();
    if (chunk + 1 < 64) H2_LOAD(chunk + 1);
#pragma unroll
    for (int dm = 0; dm < 8; ++dm) {
      const int d0 = 16 * dm + 4 * g;
      uint2 o;
      o.x = pack2(S[dm][0] * decl[d0], S[dm][1] * decl[d0 + 1]);
      o.y = pack2(S[dm][2] * decl[d0 + 2], S[dm][3] * decl[d0 + 3]);
      *(uint2*)(ST + e * 136 + d0) = o;
    }
    __syncthreads();
    f32x4 o[4];
#pragma unroll
    for (int tm = 0; tm < 4; ++tm) {
      f32x4 acc = (f32x4){co[tm].x, co[tm].y, co[tm].z, co[tm].w};
#pragma unroll
      for (int k0 = 0; k0 < 128; k0 += 32) {
        const bf16x8 a = *(const bf16x8*)(Qt + (tm * 16 + l15) * 136 + k0 + 8 * g);
        const bf16x8 bb = *(const bf16x8*)(ST + (16 * w + l15) * 136 + k0 + 8 * g);
        acc = __builtin_amdgcn_mfma_f32_16x16x32_bf16(a, bb, acc, 0, 0, 0);
      }
      o[tm] = acc;
#pragma unroll
      for (int j = 0; j < 4; ++j) {
        float ss = acc[j] * acc[j];
        ss += __shfl_xor(ss, 1); ss += __shfl_xor(ss, 2); ss += __shfl_xor(ss, 4); ss += __shfl_xor(ss, 8);
        if (l15 == 0) red[w * 64 + tm * 16 + 4 * g + j] = ss;
      }
    }
#pragma unroll
    for (int dm = 0; dm < 8; ++dm) {
      const unsigned u01 = (dm & 1) ? cu[dm >> 1].z : cu[dm >> 1].x, u23 = (dm & 1) ? cu[dm >> 1].w : cu[dm >> 1].y;
      const float uv[4] = {__uint_as_float(u01 << 16), __uint_as_float(u01 & 0xffff0000u), __uint_as_float(u23 << 16), __uint_as_float(u23 & 0xffff0000u)};
#pragma unroll
      for (int j = 0; j < 4; ++j) { const int dd = 16 * dm + 4 * g + j; S[dm][j] = decl[128 + dd] * S[dm][j] + decl[256 + dd] * uv[j]; }
    }
    __syncthreads();
#pragma unroll
    for (int tm = 0; tm < 4; ++tm)
#pragma unroll
      for (int j = 0; j < 4; ++j) {
        const int t = tm * 16 + 4 * g + j;
        float tot = 0.f;
#pragma unroll
        for (int ww = 0; ww < 8; ++ww) tot += red[ww * 64 + t];
        const float rstd = rsqrtf(tot * (1.f / 128.f) + EPSV);
        ya[(row0 + t) * 512 + h * 128 + e] = f2bf(o[tm][j] * rstd * gnv * siluf_(bf2f(cog[tm * 4 + j])));
      }
  }
#undef H2_LOAD
}

#define SCW 4100
#ifndef DSA_REP
#define DSA_REP 0
#endif
#define DSA_BKT_OFF (8 * SCW * 4 + 8 * 256 * 4 + 8 * 256 * 2 + 8 * 512 * 2)
__device__ __forceinline__ void cvt8(const uint4& v, float* f) {
  f[0] = __uint_as_float(v.x << 16); f[1] = __uint_as_float(v.x & 0xffff0000u);
  f[2] = __uint_as_float(v.y << 16); f[3] = __uint_as_float(v.y & 0xffff0000u);
  f[4] = __uint_as_float(v.z << 16); f[5] = __uint_as_float(v.z & 0xffff0000u);
  f[6] = __uint_as_float(v.w << 16); f[7] = __uint_as_float(v.w & 0xffff0000u);
}
__device__ __forceinline__ unsigned sortable_key(float v) {
  unsigned bits = __float_as_uint(v);
  if (bits == 0x80000000u) bits = 0u;
  return (bits & 0x80000000u) ? ~bits : (bits | 0x80000000u);
}

__device__ __forceinline__ void dsa_item(const Params& p, unsigned char* smem, int item) {
  unsigned char* ws = p.ws;
  const bf16_t* pA = (const bf16_t*)(ws + WS_PA);
  bf16_t* yb = (bf16_t*)(ws + WS_XN) + (size_t)TOK * 512;
  unsigned* sc = (unsigned*)smem;
  unsigned* hist = sc + 8 * SCW;
  unsigned short* sel = (unsigned short*)(hist + 8 * 256);
  unsigned short* cand = sel + 8 * 256;
  unsigned char* bkt = (unsigned char*)(cand + 8 * 512);
  const int tid = threadIdx.x, lane = tid & 63, w = tid >> 6, l15 = lane & 15, g = lane >> 4;
  const int b = item >> 9;
  const int r = item & 511;
  const int tb = (b & 1) ? 511 - r : r;
  const int t0 = tb * 8;
  const size_t tokbase = (size_t)b * SEQL;

  for (int rep_s = 0; rep_s < (DSA_REP == 1 ? 2 : 1); ++rep_s) {
    bf16x8 af[2][2];
    float wq[2][4];
#pragma unroll
    for (int mt = 0; mt < 2; ++mt) {
      const int qrow = t0 + mt * 4 + (l15 >> 2), head = l15 & 3;
#pragma unroll
      for (int ks = 0; ks < 2; ++ks)
        af[mt][ks] = *(const bf16x8*)(pA + (tokbase + qrow) * 1024 + 640 + head * 64 + ks * 32 + 8 * g);
      const uint2 wr = *(const uint2*)(pA + (tokbase + t0 + mt * 4 + g) * 1024 + 960);
      wq[mt][0] = 0.5f * bf2f((bf16_t)(wr.x & 0xffff)); wq[mt][1] = 0.5f * bf2f((bf16_t)(wr.x >> 16));
      wq[mt][2] = 0.5f * bf2f((bf16_t)(wr.y & 0xffff)); wq[mt][3] = 0.5f * bf2f((bf16_t)(wr.y >> 16));
    }
    const int nkt = (t0 + 8 + 15) >> 4;
    for (int kt0 = w; kt0 < nkt; kt0 += 32) {
      bf16x8 b0[4], b1[4];
#pragma unroll
      for (int u = 0; u < 4; ++u) {
        const int kt = kt0 + 8 * u;
        const int s = (kt < nkt ? kt : 0) * 16 + l15;
        const bf16_t* kr = pA + (tokbase + s) * 1024 + 896 + 8 * g;
        b0[u] = *(const bf16x8*)kr;
        b1[u] = *(const bf16x8*)(kr + 32);
      }
#pragma unroll
      for (int u = 0; u < 4; ++u) {
        const int kt = kt0 + 8 * u;
        if (kt < nkt) {
          const int s = kt * 16 + l15;
#pragma unroll
          for (int mt = 0; mt < 2; ++mt) {
            f32x4 acc = (f32x4){0.f, 0.f, 0.f, 0.f};
            acc = __builtin_amdgcn_mfma_f32_16x16x32_bf16(af[mt][0], b0[u], acc, 0, 0, 0);
            acc = __builtin_amdgcn_mfma_f32_16x16x32_bf16(af[mt][1], b1[u], acc, 0, 0, 0);
            float v = 0.f;
#pragma unroll
            for (int j = 0; j < 4; ++j) v += wq[mt][j] * fmaxf(acc[j] * 0.125f, 0.f);
            const int t = t0 + mt * 4 + g;
            unsigned vb = __float_as_uint(v); if (vb == 0x80000000u) vb = 0u;
            sc[(mt * 4 + g) * SCW + s] = vb;
          }
        }
      }
    }
  }
  __syncthreads();
  const int t = t0 + w;
  const int n = t + 1;
  unsigned* row = sc + w * SCW;
  const float* rowf = (const float*)row;
  unsigned short* mysel = sel + w * 256;
  unsigned short* mycand = cand + w * 512;
  unsigned* myh = hist + w * 256;
  int cnt;
  const unsigned long long lt_mask = (1ull << lane) - 1ull;
  for (int rep_t = 0; rep_t < (DSA_REP == 2 ? 2 : 1); ++rep_t)
  if (n <= 256) {
    for (int i = lane; i < n; i += 64) mysel[i] = (unsigned short)i;
    cnt = n;
  } else {
    cnt = 256;
    float mn = INFINITY, mx = -INFINITY;
    for (int i = lane; i < n; i += 64) { const float v = rowf[i]; mn = fminf(mn, v); mx = fmaxf(mx, v); }
#pragma unroll
    for (int o = 32; o > 0; o >>= 1) { mn = fminf(mn, __shfl_xor(mn, o)); mx = fmaxf(mx, __shfl_xor(mx, o)); }
    const float scale = (mx > mn) ? 255.99f / (mx - mn) : 0.f;
#pragma unroll
    for (int i = 0; i < 4; ++i) myh[lane + 64 * i] = 0u;
    lds_fence();
    for (int i = lane; i < n; i += 64) {
      const float v = rowf[i];
      int bn = (int)((v - mn) * scale); bn = bn > 255 ? 255 : bn;
      atomicAdd(&myh[bn], 1u);
    }
    lds_fence();
    unsigned cum; int bstar; unsigned mcount;
    {
      const uint4 c4 = *(const uint4*)(myh + 4 * lane);
      const unsigned c = c4.x + c4.y + c4.z + c4.w;
      unsigned sfx = c;
#pragma unroll
      for (int o = 1; o < 64; o <<= 1) { const unsigned tt = __shfl_down(sfx, o); if (lane + o < 64) sfx += tt; }
      const unsigned long long bal = __ballot(sfx >= 256u);
      const int L = 63 - __clzll(bal);
      const unsigned sL = __shfl(sfx, L), cL = __shfl(c, L);
      const unsigned b3 = __shfl(c4.w, L), b2 = __shfl(c4.z, L), b1 = __shfl(c4.y, L), b0 = __shfl(c4.x, L);
      cum = sL - cL;
      int digit;
      if (cum + b3 >= 256u) { digit = 3; mcount = b3; }
      else { cum += b3; if (cum + b2 >= 256u) { digit = 2; mcount = b2; } else { cum += b2; if (cum + b1 >= 256u) { digit = 1; mcount = b1; } else { cum += b1; digit = 0; mcount = b0; } } }
      bstar = 4 * L + digit;
    }
    const unsigned need = 256u - cum;
    if (mcount <= 512u) {
      unsigned base = 0u, cb = 0u;
      for (int i0 = 0; i0 < n; i0 += 64) {
        const int i = i0 + lane;
        const bool valid = i < n;
        const float v = valid ? rowf[i] : 0.f;
        int bn = (int)((v - mn) * scale); bn = bn > 255 ? 255 : bn;
        const bool gt = valid && (bn > bstar);
        const bool eq = valid && (bn == bstar);
        const unsigned long long bg = __ballot(gt), be = __ballot(eq);
        if (gt) mysel[base + (unsigned)__popcll(bg & lt_mask)] = (unsigned short)i;
        if (eq) mycand[cb + (unsigned)__popcll(be & lt_mask)] = (unsigned short)i;
        base += (unsigned)__popcll(bg); cb += (unsigned)__popcll(be);
      }
      lds_fence();
      const int m = (int)mcount;
      unsigned ck[8]; unsigned short ci[8];
#pragma unroll
      for (int q = 0; q < 8; ++q) {
        const int c = q * 64 + lane;
        ck[q] = 0u; ci[q] = 0;
        if (c < m) { ci[q] = mycand[c]; ck[q] = sortable_key(rowf[ci[q]]); }
      }
      unsigned T = 0u;
#pragma unroll 1
      for (int bit = 31; bit >= 0; --bit) {
        const unsigned trial = T | (1u << bit);
        unsigned cge = 0u;
#pragma unroll
        for (int q = 0; q < 8; ++q) cge += (unsigned)__popcll(__ballot(ck[q] >= trial));
        if (cge >= need) T = trial;
      }
      unsigned cgt = 0u;
#pragma unroll
      for (int q = 0; q < 8; ++q) cgt += (unsigned)__popcll(__ballot(ck[q] > T));
      const unsigned need_eq = need - cgt;
      unsigned pos0 = cum, eqtaken = 0u;
#pragma unroll
      for (int q = 0; q < 8; ++q) {
        const bool gt = ck[q] > T;
        const bool eq = ck[q] == T;
        const unsigned long long beq = __ballot(eq);
        const bool take = gt || (eq && (eqtaken + (unsigned)__popcll(beq & lt_mask)) < need_eq);
        const unsigned long long bt = __ballot(take);
        const unsigned pp = pos0 + (unsigned)__popcll(bt & lt_mask);
        if (take && pp < 256u) mysel[pp] = ci[q];
        pos0 += (unsigned)__popcll(bt);
        eqtaken += (unsigned)__popcll(beq);
      }
    } else {
      unsigned prefix = 0u, krem = 256u;
#pragma unroll 1
      for (int pass = 0; pass < 4; ++pass) {
        const int shift = 24 - 8 * pass;
        const unsigned himask = (pass == 0) ? 0u : (0xFFFFFFFFu << (shift + 8));
#pragma unroll
        for (int i = 0; i < 4; ++i) myh[lane + 64 * i] = 0u;
        lds_fence();
        for (int i = lane; i < n; i += 64) {
          const unsigned u = sortable_key(rowf[i]);
          if ((u & himask) == prefix) atomicAdd(&myh[(u >> shift) & 255u], 1u);
        }
        lds_fence();
        const uint4 c4 = *(const uint4*)(myh + 4 * lane);
        const unsigned c = c4.x + c4.y + c4.z + c4.w;
        unsigned sfx = c;
#pragma unroll
        for (int o = 1; o < 64; o <<= 1) { const unsigned tt = __shfl_down(sfx, o); if (lane + o < 64) sfx += tt; }
        const unsigned long long bal = __ballot(sfx >= krem);
        const int L = 63 - __clzll(bal);
        const unsigned sL = __shfl(sfx, L), cL = __shfl(c, L);
        const unsigned b3 = __shfl(c4.w, L), b2 = __shfl(c4.z, L), b1 = __shfl(c4.y, L);
        unsigned cum2 = sL - cL;
        unsigned digit;
        if (cum2 + b3 >= krem) digit = 3;
        else { cum2 += b3; if (cum2 + b2 >= krem) digit = 2; else { cum2 += b2; if (cum2 + b1 >= krem) digit = 1; else { cum2 += b1; digit = 0; } } }
        krem -= cum2;
        prefix |= ((unsigned)(4 * L) + digit) << shift;
      }
      const unsigned T = prefix;
      unsigned base = 0u, eqtaken = 0u;
      for (int i0 = 0; i0 < n; i0 += 64) {
        const int i = i0 + lane;
        const bool valid = i < n;
        const unsigned u = valid ? sortable_key(rowf[i]) : 0u;
        const bool gt = valid && (u > T);
        const bool eq = valid && (u == T);
        const unsigned long long beq = __ballot(eq);
        const unsigned eqrank = eqtaken + (unsigned)__popcll(beq & lt_mask);
        const bool take = gt || (eq && eqrank < krem);
        const unsigned long long bt = __ballot(take);
        const unsigned pos = base + (unsigned)__popcll(bt & lt_mask);
        if (take && pos < 256u) mysel[pos] = (unsigned short)i;
        base += (unsigned)__popcll(bt);
        eqtaken += (unsigned)__popcll(beq);
      }
    }
  }
  lds_fence();
  {
    int lane_a = lane;
    asm volatile("" : "+v"(lane_a));
    const int l15 = lane_a & 15, g = lane_a >> 4;
    const int ks = lane_a >> 3, dc = lane_a & 7;
    float* pl = (float*)row;
    const float* relb = (const float*)(bkt + 128);
    const int niter = (cnt + 7) >> 3;
    bf16x8 bq0 = (bf16x8){0, 0, 0, 0, 0, 0, 0, 0}, bq1 = bq0;
    if (l15 < 8) {
      bq0 = *(const bf16x8*)(pA + (tokbase + t) * 1024 + l15 * 64 + 8 * g);
      bq1 = *(const bf16x8*)(pA + (tokbase + t) * 1024 + l15 * 64 + 32 + 8 * g);
    }
    float lg[16][4];
    {
      bf16x8 ka[8][2], kb[8][2];
#pragma unroll
      for (int u = 0; u < 8; ++u) {
        const int kk = u * 16 + l15;
        const int s = (kk < cnt) ? (int)mysel[kk] : 0;
        const bf16_t* kr = pA + (tokbase + s) * 1024 + 512 + 8 * g;
        ka[u][0] = *(const bf16x8*)kr;
        ka[u][1] = *(const bf16x8*)(kr + 32);
      }
#pragma unroll
      for (int u = 0; u < 8; ++u) {
        const int kk = (8 + u) * 16 + l15;
        const int s = (kk < cnt) ? (int)mysel[kk] : 0;
        const bf16_t* kr = pA + (tokbase + s) * 1024 + 512 + 8 * g;
        kb[u][0] = *(const bf16x8*)kr;
        kb[u][1] = *(const bf16x8*)(kr + 32);
      }
      __builtin_amdgcn_sched_barrier(0);
#pragma unroll
      for (int u = 0; u < 8; ++u) {
        f32x4 acc = (f32x4){0.f, 0.f, 0.f, 0.f};
        acc = __builtin_amdgcn_mfma_f32_16x16x32_bf16(ka[u][0], bq0, acc, 0, 0, 0);
        acc = __builtin_amdgcn_mfma_f32_16x16x32_bf16(ka[u][1], bq1, acc, 0, 0, 0);
        lg[u][0] = acc[0]; lg[u][1] = acc[1]; lg[u][2] = acc[2]; lg[u][3] = acc[3];
      }
#pragma unroll
      for (int u = 0; u < 8; ++u) {
        f32x4 acc = (f32x4){0.f, 0.f, 0.f, 0.f};
        acc = __builtin_amdgcn_mfma_f32_16x16x32_bf16(kb[u][0], bq0, acc, 0, 0, 0);
        acc = __builtin_amdgcn_mfma_f32_16x16x32_bf16(kb[u][1], bq1, acc, 0, 0, 0);
        lg[8 + u][0] = acc[0]; lg[8 + u][1] = acc[1]; lg[8 + u][2] = acc[2]; lg[8 + u][3] = acc[3];
      }
    }
    typedef unsigned u32x4_t __attribute__((ext_vector_type(4)));
    u32x4_t va[16];
#pragma unroll
    for (int u = 0; u < 16; ++u) {
      const int kk = u * 8 + ks;
      const int s = (kk < cnt) ? (int)mysel[kk] : 0;
      va[u] = *(const u32x4_t*)(pA + (tokbase + s) * 1024 + 576 + dc * 8);
    }
    __builtin_amdgcn_sched_barrier(0);
    const int hsel = l15 & 7;
    float m = -INFINITY;
#pragma unroll
    for (int u = 0; u < 16; ++u) {
      const uint2 s4 = *(const uint2*)(mysel + u * 16 + 4 * g);
      const int sj[4] = {(int)(s4.x & 0xffffu), (int)(s4.x >> 16), (int)(s4.y & 0xffffu), (int)(s4.y >> 16)};
#pragma unroll
      for (int j = 0; j < 4; ++j) {
        const int key = u * 16 + 4 * g + j;
        const bool valid = key < cnt;
        const int dist = valid ? t - sj[j] : 0;
        const int bk = dist < 128 ? (int)bkt[dist] : 31;
        lg[u][j] = valid ? (lg[u][j] * 0.125f + relb[bk * 8 + hsel]) : -INFINITY;
        m = fmaxf(m, lg[u][j]);
      }
    }
    m = max_xor16(m); m = max_xor32(m);
    float sum = 0.f;
#pragma unroll
    for (int u = 0; u < 16; ++u)
#pragma unroll
      for (int j = 0; j < 4; ++j) { lg[u][j] = __expf(lg[u][j] - m); sum += lg[u][j]; }
    sum = add_xor16(sum); sum = add_xor32(sum);
    const float inv = 1.f / sum;
    bf16x8 pa[8];
#pragma unroll
    for (int s8 = 0; s8 < 8; ++s8) {
      const unsigned w0 = pack2(lg[2 * s8][0] * inv, lg[2 * s8][1] * inv), w1 = pack2(lg[2 * s8][2] * inv, lg[2 * s8][3] * inv);
      const unsigned w2 = pack2(lg[2 * s8 + 1][0] * inv, lg[2 * s8 + 1][1] * inv), w3 = pack2(lg[2 * s8 + 1][2] * inv, lg[2 * s8 + 1][3] * inv);
      const u32x4_t wv = {w0, w1, w2, w3};
      pa[s8] = __builtin_bit_cast(bf16x8, wv);
    }
    unsigned char* vs_l = (unsigned char*)row;
#pragma unroll
    for (int u = 0; u < 16; ++u) *(u32x4_t*)(vs_l + (u * 8 + ks) * 128 + dc * 16) = va[u];
    lds_fence();
    u32x4_t vb[16];
#pragma unroll
    for (int u = 0; u < 16; ++u) {
      const int kk = (16 + u) * 8 + ks;
      const int s = (kk < cnt) ? (int)mysel[kk] : 0;
      vb[u] = *(const u32x4_t*)(pA + (tokbase + s) * 1024 + 576 + dc * 8);
    }
    __builtin_amdgcn_sched_barrier(0);
    f32x4 ov[4];
#pragma unroll
    for (int nt = 0; nt < 4; ++nt) ov[nt] = (f32x4){0.f, 0.f, 0.f, 0.f};
    typedef short v4s_t __attribute__((ext_vector_type(4)));
    const unsigned tr_lane = (unsigned)((l15 >> 2) * 128 + (l15 & 3) * 8);
#define PV_HALF(S0) do { \
      _Pragma("unroll") for (int s4_ = 0; s4_ < 4; ++s4_) { \
        _Pragma("unroll") for (int nt = 0; nt < 4; ++nt) { \
          const unsigned a0 = (unsigned)((s4_ * 32 + 4 * g) * 128 + nt * 32) + tr_lane; \
          const v4s_t b0 = __builtin_amdgcn_ds_read_tr16_b64_v4i16((__attribute__((address_space(3))) v4s_t*)(vs_l + a0)); \
          const v4s_t b1 = __builtin_amdgcn_ds_read_tr16_b64_v4i16((__attribute__((address_space(3))) v4s_t*)(vs_l + a0 + 16 * 128)); \
          const bf16x8 bb = (bf16x8){b0[0], b0[1], b0[2], b0[3], b1[0], b1[1], b1[2], b1[3]}; \
          ov[nt] = __builtin_amdgcn_mfma_f32_16x16x32_bf16(pa[(S0) + s4_], bb, ov[nt], 0, 0, 0); \
        } \
      } \
    } while (0)
    PV_HALF(0);
    lds_fence();
#pragma unroll
    for (int u = 0; u < 16; ++u) *(u32x4_t*)(vs_l + (u * 8 + ks) * 128 + dc * 16) = vb[u];
    lds_fence();
    PV_HALF(4);
#undef PV_HALF
    if (g < 2) {
#pragma unroll
      for (int nt = 0; nt < 4; ++nt)
#pragma unroll
        for (int j = 0; j < 4; ++j) yb[(tokbase + t) * 512 + (4 * g + j) * 64 + nt * 16 + l15] = f2bf(ov[nt][j]);
    }
    lds_fence();
  }
  __syncthreads();
}

__device__ __forceinline__ void phase_mix(const Params& p, unsigned char* smem, int mode = 0) {
  const int G = gridDim.x;
  if (G >= 64) {
    if (blockIdx.x < 32) { if (mode != 2) hgrn_h2(p, smem, blockIdx.x); return; }
    if (mode == 1) return;
    unsigned char* bkt = smem + DSA_BKT_OFF;
    if (threadIdx.x < 128) {
      const int nn = threadIdx.x;
      int v = nn;
      if (nn >= 16) { v = 16 + (int)(logf((float)nn * (1.f / 16.f)) / logf(8.f) * 16.f); if (v > 31) v = 31; }
      bkt[nn] = (unsigned char)v;
    }
    if (threadIdx.x >= 256) ((float*)(bkt + 128))[threadIdx.x - 256] = p.rel_bias[threadIdx.x - 256];
    __syncthreads();
    for (int item = blockIdx.x - 32; item < 4096; item += G - 32) dsa_item(p, smem, item);
  } else {
    for (int bh = blockIdx.x; bh < 32; bh += G) { hgrn_h2(p, smem, bh); __syncthreads(); }
    unsigned char* bkt = smem + DSA_BKT_OFF;
    __syncthreads();
    if (threadIdx.x < 128) {
      const int nn = threadIdx.x;
      int v = nn;
      if (nn >= 16) { v = 16 + (int)(logf((float)nn * (1.f / 16.f)) / logf(8.f) * 16.f); if (v > 31) v = 31; }
      bkt[nn] = (unsigned char)v;
    }
    if (threadIdx.x >= 256) ((float*)(bkt + 128))[threadIdx.x - 256] = p.rel_bias[threadIdx.x - 256];
    __syncthreads();
    for (int item = blockIdx.x; item < 4096; item += G) dsa_item(p, smem, item);
  }
}

__device__ __forceinline__ void phase_up(const Params& p, unsigned char* smem) {
  unsigned char* ws = p.ws;
  const bf16_t* ya = (const bf16_t*)(ws + WS_XN);
  const bf16_t* yb = ya + (size_t)TOK * 512;
  const bf16_t* wa = (const bf16_t*)(ws + WS_WUPA);
  const bf16_t* wb = (const bf16_t*)(ws + WS_WUPB);
  const bf16_t* pG = (const bf16_t*)(ws + WS_PG);
  bf16_t* hb = (bf16_t*)(ws + WS_PH);
  const int tid = threadIdx.x, lane = tid & 63, w = tid >> 6, wm = w >> 1, wn = w & 1, l15 = lane & 15, g = lane >> 4;
  for (int tile = blockIdx.x; tile < 128 * 8; tile += gridDim.x) {
    const int tn = tile & 7, tm = tile >> 3;
    f32x4 acc[4][4]; zero_acc(acc);
    gemm_tile(ya + (size_t)tm * 256 * 512, 512, wa + (size_t)tn * 128 * 512, 512, 8, acc, smem);
    asm volatile("" ::: "memory");
    const int rbase = tm * 256 + wm * 64 + 4 * g;
    const int cbase = tn * 128 + wn * 64 + l15;
#pragma unroll
    for (int m = 0; m < 4; ++m) {
      bf16_t gt[16];
#pragma unroll
      for (int n = 0; n < 4; ++n)
#pragma unroll
        for (int j = 0; j < 4; ++j) gt[n * 4 + j] = pG[(size_t)(rbase + m * 16 + j) * 2048 + cbase + n * 16];
#pragma unroll
      for (int n = 0; n < 4; ++n) {
#pragma unroll
        for (int j = 0; j < 4; ++j) {
          const size_t rr = (size_t)(rbase + m * 16 + j);
          hb[rr * 1024 + cbase + n * 16] = f2bf(acc[m][n][j] * bf2f(gt[n * 4 + j]));
        }
        acc[m][n] = (f32x4){0.f, 0.f, 0.f, 0.f};
      }
    }
    asm volatile("" ::: "memory");
    gemm_tile(yb + (size_t)tm * 256 * 512, 512, wb + (size_t)tn * 128 * 512, 512, 8, acc, smem);
    asm volatile("" ::: "memory");
#pragma unroll
    for (int m = 0; m < 4; ++m) {
      bf16_t gt[16], ht[16];
#pragma unroll
      for (int n = 0; n < 4; ++n)
#pragma unroll
        for (int j = 0; j < 4; ++j) {
          const size_t rr = (size_t)(rbase + m * 16 + j);
          gt[n * 4 + j] = pG[rr * 2048 + 1024 + cbase + n * 16];
          ht[n * 4 + j] = hb[rr * 1024 + cbase + n * 16];
        }
#pragma unroll
      for (int n = 0; n < 4; ++n)
#pragma unroll
        for (int j = 0; j < 4; ++j) {
          const size_t rr = (size_t)(rbase + m * 16 + j);
          hb[rr * 1024 + cbase + n * 16] = f2bf(bf2f(ht[n * 4 + j]) + acc[m][n][j] * bf2f(gt[n * 4 + j]));
        }
    }
  }
}

__device__ __forceinline__ void phase_out(const Params& p, unsigned char* smem) {
  unsigned char* ws = p.ws;
  const bf16_t* hb = (const bf16_t*)(ws + WS_PH);
  const bf16_t* wo = (const bf16_t*)(ws + WS_WOUT);
  const int tid = threadIdx.x, lane = tid & 63, w = tid >> 6, wm = w >> 1, wn = w & 1, l15 = lane & 15, g = lane >> 4;
  for (int tile = blockIdx.x; tile < 128 * 8; tile += gridDim.x) {
    const int tn = tile & 7, tm = tile >> 3;
    f32x4 acc[4][4]; zero_acc(acc);
    gemm_tile(hb + (size_t)tm * 256 * 1024, 1024, wo + (size_t)tn * 128 * 1024, 1024, 16, acc, smem);
    const int rbase = tm * 256 + wm * 64 + 4 * g;
    const int cbase = tn * 128 + wn * 64 + l15;
#pragma unroll
    for (int m = 0; m < 4; ++m) {
      float xt[16];
#pragma unroll
      for (int n = 0; n < 4; ++n)
#pragma unroll
        for (int j = 0; j < 4; ++j) xt[n * 4 + j] = p.x[(size_t)(rbase + m * 16 + j) * 1024 + cbase + n * 16];
#pragma unroll
      for (int n = 0; n < 4; ++n)
#pragma unroll
        for (int j = 0; j < 4; ++j) p.out[(size_t)(rbase + m * 16 + j) * 1024 + cbase + n * 16] = xt[n * 4 + j] + acc[m][n][j];
    }
  }
}

__device__ __forceinline__ void phase_pq(const Params& p, unsigned char* smem) {
  unsigned char* ws = p.ws;
  const bf16_t* xn2 = (const bf16_t*)(ws + WS_XN);
  const bf16_t* wq = (const bf16_t*)(ws + WS_WQ);
  bf16_t* qp = (bf16_t*)(ws + WS_PG);
  const int tid = threadIdx.x, lane = tid & 63, w = tid >> 6, wm = w >> 1, wn = w & 1, l15 = lane & 15, g = lane >> 4;
  for (int tile = blockIdx.x; tile < 128 * 16; tile += gridDim.x) {
    const int tn = tile & 15, tm = tile >> 4;
    f32x4 acc[4][4]; zero_acc(acc);
    gemm_tile(xn2 + (size_t)tm * 256 * 1024, 1024, wq + (size_t)tn * 128 * 1024, 1024, 16, acc, smem);
    const int rbase = tm * 256 + wm * 64 + 4 * g;
    const int cbase = tn * 128 + wn * 64 + l15;
#pragma unroll
    for (int m = 0; m < 4; ++m)
#pragma unroll
      for (int n = 0; n < 4; ++n)
#pragma unroll
        for (int j = 0; j < 4; ++j) qp[(size_t)(rbase + m * 16 + j) * 2048 + cbase + n * 16] = f2bf(acc[m][n][j]);
  }
}

__device__ __forceinline__ void phase_pkeys(const Params& p, unsigned char* smem) {
  unsigned char* ws = p.ws;
  const bf16_t* qp = (const bf16_t*)(ws + WS_PG);
  const bf16_t* keys = (const bf16_t*)(ws + WS_KEYS);
  float* ps = (float*)(ws + WS_PA);
  int* pi = (int*)(ws + WS_PA) + (size_t)TOK * 256;
  float* sc = (float*)smem;
  const int tid = threadIdx.x, lane = tid & 63, w = tid >> 6, wm = w >> 1, wn = w & 1, l15 = lane & 15, g = lane >> 4;
  for (int tile = blockIdx.x; tile < 128 * 16; tile += gridDim.x) {
    const int hp = tile & 15, tm = tile >> 4;
    const int h = hp >> 1, ph = hp & 1;
    f32x4 acc[4][4]; zero_acc(acc);
    gemm_tile(qp + (size_t)tm * 256 * 2048 + hp * 128, 2048, keys + (size_t)(ph * 8 + h) * 128 * 128, 128, 2, acc, smem);
    __syncthreads();
#pragma unroll
    for (int m = 0; m < 4; ++m)
#pragma unroll
      for (int n = 0; n < 4; ++n)
#pragma unroll
        for (int j = 0; j < 4; ++j) sc[(wm * 64 + m * 16 + 4 * g + j) * 129 + wn * 64 + n * 16 + l15] = acc[m][n][j];
    __syncthreads();
    if (tid < 256) {
      const int row = tid;
      const float* rowp = sc + row * 129;
      unsigned tv[16];
#pragma unroll
      for (int k = 0; k < 16; ++k) tv[k] = 0u;
#pragma unroll 8
      for (int nn = 0; nn < 128; ++nn) {
        const unsigned bits = __float_as_uint(rowp[nn]);
        unsigned key = (bits & 0x80000000u) ? ~bits : (bits | 0x80000000u);
        key = (key & ~127u) | (unsigned)(127 - nn);
#pragma unroll
        for (int k = 15; k >= 1; --k) {
          unsigned r;
          asm("v_med3_u32 %0, %1, %2, %3" : "=v"(r) : "v"(tv[k]), "v"(tv[k - 1]), "v"(key));
          tv[k] = r;
        }
        tv[0] = tv[0] > key ? tv[0] : key;
      }
      const size_t ob = ((size_t)(tm * 256 + row) * 16 + hp) * 16;
      float ov[16]; int oi[16];
#pragma unroll
      for (int k = 0; k < 16; ++k) { oi[k] = 127 - (int)(tv[k] & 127u); ov[k] = rowp[oi[k]]; }
#pragma unroll
      for (int k = 0; k < 16; k += 4) {
        *(float4*)(ps + ob + k) = make_float4(ov[k], ov[k + 1], ov[k + 2], ov[k + 3]);
        *(int4*)(pi + ob + k) = make_int4(oi[k], oi[k + 1], oi[k + 2], oi[k + 3]);
      }
    }
    __syncthreads();
  }
}

__device__ __forceinline__ void phase_pcomb(const Params& p, unsigned char* smem) {
  unsigned char* ws = p.ws;
  const float* ps = (const float*)(ws + WS_PA);
  const int* pi = (const int*)(ws + WS_PA) + (size_t)TOK * 256;
  int* eidx = (int*)(ws + WS_EIDX);
  float* gw = (float*)(ws + WS_GW);
  float* s2l = (float*)smem;
  unsigned short* i1l = (unsigned short*)(s2l + 512 * 17);
  unsigned short* i2l = i1l + 512 * 16;
  const int tid = threadIdx.x;
  for (int base = blockIdx.x * NTHREADS; base < TOK * 8; base += gridDim.x * NTHREADS) {
    const int th = base + tid;
    const size_t o1 = (size_t)th * 32;
    float s1[16];
#pragma unroll
    for (int a = 0; a < 16; ++a) {
      s1[a] = ps[o1 + a];
      s2l[tid * 17 + a] = ps[o1 + 16 + a];
      i1l[tid * 16 + a] = (unsigned short)pi[o1 + a];
      i2l[tid * 16 + a] = (unsigned short)pi[o1 + 16 + a];
    }
    float cur[16];
    const float s20 = s2l[tid * 17];
#pragma unroll
    for (int a = 0; a < 16; ++a) cur[a] = s1[a] + s20;
    unsigned long long ptr = 0ull;
    float tops[16]; int tope[16];
#pragma unroll
    for (int k = 0; k < 16; ++k) {
      float best = cur[0]; int ba = 0;
#pragma unroll
      for (int a = 1; a < 16; ++a) if (cur[a] > best) { best = cur[a]; ba = a; }
      const int bb = (int)((ptr >> (4 * ba)) & 15ull);
      tops[k] = best;
      tope[k] = (int)i1l[tid * 16 + ba] * 128 + (int)i2l[tid * 16 + bb];
      const int nb = bb + 1;
      const float ns2 = (nb < 16) ? s2l[tid * 17 + nb] : -INFINITY;
      if (nb < 16) ptr += (1ull << (4 * ba));
#pragma unroll
      for (int a = 0; a < 16; ++a) if (a == ba) cur[a] = s1[a] + ns2;
    }
    float m = tops[0];
    float sum = 0.f;
#pragma unroll
    for (int k = 0; k < 16; ++k) { tops[k] = __expf(tops[k] - m); sum += tops[k]; }
    const float inv = 1.f / sum;
#pragma unroll
    for (int k = 0; k < 16; ++k) { eidx[(size_t)th * 16 + k] = tope[k]; gw[(size_t)th * 16 + k] = tops[k] * inv; }
  }
}


__device__ __forceinline__ float reduce8(const float (&pv)[8], int lane) {
  const bool b5 = lane & 32, b4 = lane & 16, b3 = lane & 8;
  float v[4];
#pragma unroll
  for (int i = 0; i < 4; ++i) {
    const float keep = b5 ? pv[4 + i] : pv[i];
    const float send = b5 ? pv[i] : pv[4 + i];
    v[i] = keep + __shfl_xor(send, 32);
  }
  float u[2];
#pragma unroll
  for (int i = 0; i < 2; ++i) {
    const float keep = b4 ? v[2 + i] : v[i];
    const float send = b4 ? v[i] : v[2 + i];
    u[i] = keep + __shfl_xor(send, 16);
  }
  float x = (b3 ? u[1] : u[0]) + __shfl_xor(b3 ? u[0] : u[1], 8);
  x += __shfl_xor(x, 4); x += __shfl_xor(x, 2); x += __shfl_xor(x, 1);
  return x;
}

__device__ __forceinline__ void cvt16u8(const uint4& v, float* f) {
  f[0] = (float)(v.x & 0xffu); f[1] = (float)((v.x >> 8) & 0xffu); f[2] = (float)((v.x >> 16) & 0xffu); f[3] = (float)(v.x >> 24);
  f[4] = (float)(v.y & 0xffu); f[5] = (float)((v.y >> 8) & 0xffu); f[6] = (float)((v.y >> 16) & 0xffu); f[7] = (float)(v.y >> 24);
  f[8] = (float)(v.z & 0xffu); f[9] = (float)((v.z >> 8) & 0xffu); f[10] = (float)((v.z >> 16) & 0xffu); f[11] = (float)(v.z >> 24);
  f[12] = (float)(v.w & 0xffu); f[13] = (float)((v.w >> 8) & 0xffu); f[14] = (float)((v.w >> 16) & 0xffu); f[15] = (float)(v.w >> 24);
}

__device__ __forceinline__ int team_index(const Params& p, unsigned char* smem) {
  int* sh = (int*)(smem + 8192);
  const int G = gridDim.x, tid = threadIdx.x;
  const int* tab = (const int*)(p.ws + WS_XCC);
  if (tid < 32) sh[tid] = 0;
  __syncthreads();
  const int mine = tab[blockIdx.x] & 15;
  for (int b = tid; b < G; b += NTHREADS) {
    const int x = tab[b] & 15;
    atomicAdd(&sh[x], 1);
    if (x == mine && b < (int)blockIdx.x) atomicAdd(&sh[16], 1);
  }
  __syncthreads();
  if (tid == 0) {
    int pre = 0;
    for (int j = 0; j < mine; ++j) pre += sh[j];
    sh[17] = pre + sh[16];
  }
  __syncthreads();
  const int r = sh[17];
  __syncthreads();
  return r;
}

__device__ __forceinline__ int wave_sum_i32_dpp(int v) {
  v += __builtin_amdgcn_update_dpp(0, v, 0xB1, 0xf, 0xf, true);
  v += __builtin_amdgcn_update_dpp(0, v, 0x4E, 0xf, 0xf, true);
  v += __builtin_amdgcn_update_dpp(0, v, 0x141, 0xf, 0xf, true);
  v += __builtin_amdgcn_update_dpp(0, v, 0x140, 0xf, 0xf, true);
  return __builtin_amdgcn_readlane(v, 0) + __builtin_amdgcn_readlane(v, 16) + __builtin_amdgcn_readlane(v, 32) + __builtin_amdgcn_readlane(v, 48);
}

template <bool SL>
__device__ __forceinline__ void phase_pu_t(const Params& p, unsigned char* smem) {
  unsigned char* ws = p.ws;
  const unsigned char* XQ = ws + WS_XQ;
  const float* xs = (const float*)(ws + WS_XS);
  const unsigned char* U8 = ws + WS_U;
  const float* us = (const float*)(ws + WS_U + (size_t)16384 * 1024);
  const float* vs = (const float*)(ws + WS_V + (size_t)16384 * 1024);
  const int* eidx = (const int*)(ws + WS_EIDX);
  const float* gw = (const float*)(ws + WS_GW);
  float* aw = (float*)(ws + WS_PA);
  const int lane = threadIdx.x & 63, w = threadIdx.x >> 6;
  unsigned* lst = (unsigned*)smem + w * 128;
  const unsigned long long lt_mask = (1ull << lane) - 1ull;
  const int G = gridDim.x;
  constexpr bool sliced = SL;
  const int ti = sliced ? team_index(p, smem) : 0;
  const int tsz = G >> 3;
  const int grp0 = sliced ? (ti / tsz) : 0;
  constexpr int ngrp = sliced ? 1 : 8;
  const int slot = sliced ? (ti % tsz) * 8 + w : blockIdx.x * 8 + w;
  const int nslot = sliced ? tsz * 8 : G * 8;
  uint4 xa = make_uint4(0, 0, 0, 0); int e0 = 0, e1 = 0; float xsc = 0.f;
  if (slot < TOK) {
    xa = *(const uint4*)(XQ + (size_t)slot * 1024 + lane * 16);
    e0 = eidx[(size_t)slot * 128 + lane]; e1 = eidx[(size_t)slot * 128 + 64 + lane];
    xsc = xs[slot];
  }
  for (int tok = slot; tok < TOK; tok += nslot) {
    const uint4 cx = xa;
    const int ce0 = e0, ce1 = e1;
    const float cxs = xsc;
    for (int gi = 0; gi < ngrp; ++gi) {
      const int grp = grp0 + gi;
      const bool m0 = (ce0 >> 11) == grp, m1 = (ce1 >> 11) == grp;
      const unsigned long long b0 = __ballot(m0), b1 = __ballot(m1);
      const int c0 = __popcll(b0), n = c0 + __popcll(b1);
      if (m0) lst[__popcll(b0 & lt_mask)] = ((unsigned)lane << 14) | (unsigned)ce0;
      if (m1) lst[c0 + __popcll(b1 & lt_mask)] = ((unsigned)(lane + 64) << 14) | (unsigned)ce1;
      lds_fence();
      const unsigned le0 = (lane < n) ? lst[lane] : 0u;
      const unsigned le1 = (lane + 64 < n) ? lst[lane + 64] : 0u;
      lds_fence();
      float sc0 = 0.f, sc1 = 0.f, gv0 = 0.f, gv1 = 0.f, vv0 = 0.f, vv1 = 0.f;
      if (lane < n) { const int e = le0 & 16383; sc0 = us[e]; vv0 = vs[e]; gv0 = gw[(size_t)tok * 128 + (le0 >> 14)]; }
      if (lane + 64 < n) { const int e = le1 & 16383; sc1 = us[e]; vv1 = vs[e]; gv1 = gw[(size_t)tok * 128 + (le1 >> 14)]; }
      int h0i = 0, h1i = 0;
#define PU_BATCH(I0, PREFETCH_STMT) do { \
        const int i0_ = (I0); \
        const bool lo = i0_ < 64; \
        const int cur = (int)(lo ? le0 : le1); \
        const int base = i0_ & 63; \
        int last = (lo ? (n < 64 ? n : 64) : n - 64) - 1; last = last < 0 ? 0 : last; \
        uint4 ua[16]; \
        _Pragma("unroll") for (int j = 0; j < 16; ++j) { \
          int idx = base + j; idx = idx < last ? idx : last; \
          const unsigned le = (unsigned)__builtin_amdgcn_readlane(cur, idx); \
          ua[j] = *(const uint4*)(U8 + (size_t)(le & 16383u) * 1024 + lane * 16); \
        } \
        PREFETCH_STMT; \
        __builtin_amdgcn_sched_barrier(0); \
        int hn = 0; \
        _Pragma("unroll") for (int j = 0; j < 16; ++j) { \
          int d = __builtin_amdgcn_sdot4((int)ua[j].x, (int)cx.x, 0, false); \
          d = __builtin_amdgcn_sdot4((int)ua[j].y, (int)cx.y, d, false); \
          d = __builtin_amdgcn_sdot4((int)ua[j].z, (int)cx.z, d, false); \
          d = __builtin_amdgcn_sdot4((int)ua[j].w, (int)cx.w, d, false); \
          const int tot = wave_sum_i32_dpp(d); \
          if (lane == base + j) hn = tot; \
        } \
        if (lane >= base && lane < base + 16) { if (lo) h0i = hn; else h1i = hn; } \
      } while (0)
      if (gi == ngrp - 1) {
        const int nt = (tok + nslot < TOK) ? tok + nslot : tok;
        PU_BATCH(0, { xa = *(const uint4*)(XQ + (size_t)nt * 1024 + lane * 16);
                      e0 = eidx[(size_t)nt * 128 + lane]; e1 = eidx[(size_t)nt * 128 + 64 + lane]; xsc = xs[nt]; });
      } else {
        PU_BATCH(0, {});
      }
#pragma unroll 1
      for (int i0 = 16; i0 < n; i0 += 16) PU_BATCH(i0, {});
#undef PU_BATCH
      const float h0 = (float)h0i * sc0 * cxs, h1 = (float)h1i * sc1 * cxs;
      if (lane < n) aw[(size_t)tok * 128 + (le0 >> 14)] = 0.5f * h0 * (1.f + erff(h0 * 0.70710678118654752f)) * gv0 * vv0;
      if (lane + 64 < n) aw[(size_t)tok * 128 + (le1 >> 14)] = 0.5f * h1 * (1.f + erff(h1 * 0.70710678118654752f)) * gv1 * vv1;
    }
  }
}

template <bool SL>
__device__ __forceinline__ void phase_pv_t(const Params& p, unsigned char* smem) {
  unsigned char* ws = p.ws;
  const unsigned char* V8 = ws + WS_V;
  const int* eidx = (const int*)(ws + WS_EIDX);
  const float* aw = (const float*)(ws + WS_PA);
  float* ssq = (float*)(ws + WS_SSQ);
  const int lane = threadIdx.x & 63, w = threadIdx.x >> 6;
  const int q = lane >> 3, c = lane & 7;
  const int G = gridDim.x;
  constexpr bool sliced = SL;
  const int ti = sliced ? team_index(p, smem) : 0;
  const int tsz = G >> 3;
  const int grp0 = sliced ? (ti / tsz) : 0;
  constexpr int ngrp = sliced ? 1 : 8;
  const int slot = sliced ? (ti % tsz) * 8 + w : blockIdx.x * 8 + w;
  const int nslot = sliced ? tsz * 8 : G * 8;
  int ee[16]; float aa[16];
  if (slot < TOK) {
    unsigned bi = (unsigned)slot * 128u + (unsigned)q;
    asm volatile("" : "+v"(bi));
#pragma unroll
    for (int u = 0; u < 16; ++u) { ee[u] = eidx[bi + 8 * u]; aa[u] = aw[bi + 8 * u]; }
  }
  for (int tok = slot; tok < TOK; tok += nslot) {
    int ce[16]; float ca[16];
    float suma = 0.f;
#pragma unroll
    for (int u = 0; u < 16; ++u) { ce[u] = ee[u]; ca[u] = aa[u]; suma += aa[u]; }
    for (int gi = 0; gi < ngrp; ++gi) {
      const int grp = grp0 + gi;
      uint4 vv[16];
#pragma unroll
      for (int u = 0; u < 16; ++u) vv[u] = *(const uint4*)(V8 + (size_t)grp * (16384 * 128) + (size_t)ce[u] * 128 + c * 16);
      float* orow = p.out + (size_t)tok * 1024 + grp * 128 + c * 16;
      float4 x1v[4];
#pragma unroll
      for (int i = 0; i < 4; ++i) x1v[i] = *(const float4*)(orow + 4 * i);
      if (gi == ngrp - 1) {
        const int nt = (tok + nslot < TOK) ? tok + nslot : tok;
        unsigned bi = (unsigned)nt * 128u + (unsigned)q;
        asm volatile("" : "+v"(bi));
#pragma unroll
        for (int u = 0; u < 16; ++u) { ee[u] = eidx[bi + 8 * u]; aa[u] = aw[bi + 8 * u]; }
      }
      __builtin_amdgcn_sched_barrier(0);
      float acc[16];
#pragma unroll
      for (int i = 0; i < 16; ++i) acc[i] = -128.f * suma;
#pragma unroll
      for (int u = 0; u < 16; ++u) {
        float vf[16];
        cvt16u8(vv[u], vf);
#pragma unroll
        for (int i = 0; i < 16; ++i) acc[i] += ca[u] * vf[i];
        __builtin_amdgcn_sched_barrier(0);
      }
#pragma unroll
      for (int i = 0; i < 16; ++i) { acc[i] += __shfl_xor(acc[i], 8); acc[i] += __shfl_xor(acc[i], 16); acc[i] += __shfl_xor(acc[i], 32); }
      float ss = 0.f;
      if (q == 0) {
#pragma unroll
        for (int i = 0; i < 4; ++i) {
          const float4 oa = make_float4(x1v[i].x + acc[4 * i], x1v[i].y + acc[4 * i + 1], x1v[i].z + acc[4 * i + 2], x1v[i].w + acc[4 * i + 3]);
          *(float4*)(orow + 4 * i) = oa;
          ss += oa.x * oa.x + oa.y * oa.y + oa.z * oa.z + oa.w * oa.w;
        }
      }
      ss += __shfl_xor(ss, 1); ss += __shfl_xor(ss, 2); ss += __shfl_xor(ss, 4);
      if (lane == 0) atomicAdd(&ssq[tok], ss);
    }
  }
}

__device__ __forceinline__ void phase_final(const Params& p) {
  const float* ssq = (const float*)(p.ws + WS_SSQ);
  const int lane = threadIdx.x & 63, w = threadIdx.x >> 6;
  for (int row = blockIdx.x * 8 + w; row < TOK; row += gridDim.x * 8) {
    const float rstd = rsqrtf(ssq[row] * (1.f / DM) + EPSV);
    float4* o4 = (float4*)(p.out + (size_t)row * DM);
#pragma unroll
    for (int i = 0; i < 4; ++i) {
      float4 v = o4[lane + 64 * i];
      const float4 gg = ((const float4*)p.norm_final)[lane + 64 * i];
      v.x *= rstd * gg.x; v.y *= rstd * gg.y; v.z *= rstd * gg.z; v.w *= rstd * gg.w;
      o4[lane + 64 * i] = v;
    }
  }
}


__device__ __forceinline__ void phase_proj8(const Params& p, unsigned char* smem) {
  unsigned char* ws = p.ws;
  pg8::Gemm g{(const pg8::bf16_t*)(ws + WS_XN), (const pg8::bf16_t*)(ws + WS_WIN), TOK, 5120, 1024};
  pg8::StaticOrder S; S.init(TOK, 5120, (int)gridDim.x, (int)blockIdx.x);
  EpiProj E{(unsigned short*)(ws + WS_PH), (unsigned short*)(ws + WS_PA), (unsigned short*)(ws + WS_PG)};
  pg8::gemm_phase<EpiProj, pg8::StaticOrder>((PG8_LAS unsigned char*)smem, g, S, E, nullptr);
}
__device__ __forceinline__ void phase_ikln(const Params& p) {
  bf16_t* pA = (bf16_t*)(p.ws + WS_PA);
  const int tid = threadIdx.x, sub = tid & 7;
  float gam[8], bet[8];
#pragma unroll
  for (int i = 0; i < 8; ++i) { gam[i] = p.ikg[sub * 8 + i]; bet[i] = p.ikb[sub * 8 + i]; }
  for (int row = blockIdx.x * 64 + (tid >> 3); row < TOK; row += gridDim.x * 64) {
    uint4* ptr = (uint4*)(pA + (size_t)row * 1024 + 896 + sub * 8);
    const uint4 raw = *ptr;
    float v[8];
    cvt8(raw, v);
    float s = 0.f;
#pragma unroll
    for (int i = 0; i < 8; ++i) s += v[i];
    s += __shfl_xor(s, 1); s += __shfl_xor(s, 2); s += __shfl_xor(s, 4);
    const float mu = s * (1.f / 64.f);
    float q = 0.f;
#pragma unroll
    for (int i = 0; i < 8; ++i) { const float d = v[i] - mu; q += d * d; }
    q += __shfl_xor(q, 1); q += __shfl_xor(q, 2); q += __shfl_xor(q, 4);
    const float rstd = rsqrtf(q * (1.f / 64.f) + EPSV);
    uint4 o;
    o.x = pack2((v[0] - mu) * rstd * gam[0] + bet[0], (v[1] - mu) * rstd * gam[1] + bet[1]);
    o.y = pack2((v[2] - mu) * rstd * gam[2] + bet[2], (v[3] - mu) * rstd * gam[3] + bet[3]);
    o.z = pack2((v[4] - mu) * rstd * gam[4] + bet[4], (v[5] - mu) * rstd * gam[5] + bet[5]);
    o.w = pack2((v[6] - mu) * rstd * gam[6] + bet[6], (v[7] - mu) * rstd * gam[7] + bet[7]);
    *ptr = o;
  }
}
__device__ __forceinline__ void phase_up8(const Params& p, unsigned char* smem) {
  unsigned char* ws = p.ws;
  const pg8::bf16_t* ya = (const pg8::bf16_t*)(ws + WS_XN);
  const pg8::bf16_t* yb = ya + (size_t)TOK * 512;
  pg8::StaticOrder S; S.init(TOK, 1024, (int)gridDim.x, (int)blockIdx.x);
  {
    pg8::Gemm g{ya, (const pg8::bf16_t*)(ws + WS_WUPA), TOK, 1024, 512};
    EpiGate<0> E{(unsigned short*)(ws + WS_PH), (const unsigned short*)(ws + WS_PG), 0};
    pg8::gemm_phase<EpiGate<0>, pg8::StaticOrder>((PG8_LAS unsigned char*)smem, g, S, E, nullptr);
  }
  {
    pg8::Gemm g{yb, (const pg8::bf16_t*)(ws + WS_WUPB), TOK, 1024, 512};
    EpiGate<1> E{(unsigned short*)(ws + WS_PH), (const unsigned short*)(ws + WS_PG), 1024};
    pg8::gemm_phase<EpiGate<1>, pg8::StaticOrder>((PG8_LAS unsigned char*)smem, g, S, E, nullptr);
  }
}
__device__ __forceinline__ void phase_out8(const Params& p, unsigned char* smem) {
  unsigned char* ws = p.ws;
  pg8::Gemm g{(const pg8::bf16_t*)(ws + WS_PH), (const pg8::bf16_t*)(ws + WS_WOUT), TOK, 1024, 1024};
  pg8::StaticOrder S; S.init(TOK, 1024, (int)gridDim.x, (int)blockIdx.x);
  EpiResid E{p.out, p.x};
  pg8::gemm_phase<EpiResid, pg8::StaticOrder>((PG8_LAS unsigned char*)smem, g, S, E, nullptr);
}
__device__ __forceinline__ void phase_pq8(const Params& p, unsigned char* smem) {
  unsigned char* ws = p.ws;
  pg8::Gemm g{(const pg8::bf16_t*)(ws + WS_XN), (const pg8::bf16_t*)(ws + WS_WQ), TOK, 2048, 1024};
  pg8::StaticOrder S; S.init(TOK, 2048, (int)gridDim.x, (int)blockIdx.x);
  EpiStoreBf16 E{(unsigned short*)(ws + WS_PG), 2048};
  pg8::gemm_phase<EpiStoreBf16, pg8::StaticOrder>((PG8_LAS unsigned char*)smem, g, S, E, nullptr);
}

__global__ void __launch_bounds__(NTHREADS) hybrid_fwd(Params p) {
  extern __shared__ __attribute__((aligned(16))) unsigned char smem[];
#if ONE_LAUNCH
  cg::grid_group grid = cg::this_grid();
  volatile LAS unsigned* xst = (volatile LAS unsigned*)(smem + LDS_BYTES - 16);
  if (threadIdx.x == 0) { xst[0] = 0u; xst[1] = 0u; }
  __syncthreads();
  XcdBarrier xbar = xcd_barrier_post((unsigned*)(p.ws + WS_BAR), xst);
#define SEAM(k) do { if (p.ph_lo <= (k) && (k) + 1 < p.ph_hi) { if ((k) == 0) grid.sync(); else xcd_barrier(xbar); } } while (0)
#else
#define SEAM(k) do { } while (0)
#endif
#define IN(k) (p.ph_lo <= (k) && (k) < p.ph_hi)
#ifndef REPEAT_PH
#define REPEAT_PH -1
#endif
#define REP(k, stmt) do { if (REPEAT_PH == (k)) { stmt; grid.sync(); } } while (0)
  if (IN(0)) { phase_prep(p, smem); SEAM(0); }
  if (IN(1)) { phase_proj8(p, smem); SEAM(1); }
  if (IN(2)) { phase_ikln(p); for (int it = blockIdx.x; it < 2048; it += gridDim.x) hgrn_h1_item(p, smem, it); SEAM(2); }
  if (IN(3)) { phase_mix(p, smem); SEAM(3); }
  if (IN(4)) { phase_up8(p, smem); SEAM(4); }
  if (IN(5)) { phase_out8(p, smem); SEAM(5); }
  if (IN(6)) { rmsnorm_rows_q(p.out, p.norm_ffn, (bf16_t*)(p.ws + WS_XN), p.ws + WS_XQ, (float*)(p.ws + WS_XS)); SEAM(6); }
  if (IN(7)) { phase_pq8(p, smem); SEAM(7); }
  if (IN(8)) { phase_pkeys(p, smem); SEAM(8); }
  if (IN(9)) { phase_pcomb(p, smem); SEAM(9); }
  if (IN(10)) { if (gridDim.x % 8 == 0) phase_pu_t<true>(p, smem); else phase_pu_t<false>(p, smem); SEAM(10); }
  if (IN(11)) { if (gridDim.x % 8 == 0) phase_pv_t<true>(p, smem); else phase_pv_t<false>(p, smem); SEAM(11); }
  if (IN(12)) { phase_final(p); }
#undef IN
#undef SEAM
}

extern "C" void kernel_launch(void* const* d_in, const int* in_sizes, int n_in, void* d_out, int out_size, void* d_ws, size_t ws_size,
                              hipStream_t stream) {
  static int grid = 0;
  if (grid == 0) {
    if (n_in != 17 || ws_size < WS_END) {
      fprintf(stderr, "kernel_launch: unexpected n_in %d or ws_size %zu (need %zu)\n", n_in, ws_size, (size_t)WS_END);
      grid = -1; return;
    }
    int dev = 0, cus = 0, per_cu = 0;
    hipGetDevice(&dev);
    hipDeviceGetAttribute(&cus, hipDeviceAttributeMultiprocessorCount, dev);
    hipFuncSetAttribute((const void*)hybrid_fwd, hipFuncAttributeMaxDynamicSharedMemorySize, LDS_BYTES);
    hipOccupancyMaxActiveBlocksPerMultiprocessor(&per_cu, (const void*)hybrid_fwd, NTHREADS, LDS_BYTES);
    if (per_cu < 1) { fprintf(stderr, "kernel_launch: occupancy query says %d blocks/CU\n", per_cu); per_cu = 1; }
    (void)hipGetLastError();
    grid = cus;
  }
  if (grid < 0) return;
  Params p{};
  p.x = (const float*)d_in[0]; p.norm_mix = (const float*)d_in[1]; p.w_in = (const float*)d_in[2]; p.hg_lb = (const float*)d_in[3];
  p.hg_norm = (const float*)d_in[4]; p.ikg = (const float*)d_in[5]; p.ikb = (const float*)d_in[6]; p.rel_bias = (const float*)d_in[7];
  p.w_up_a = (const float*)d_in[8]; p.w_up_b = (const float*)d_in[9]; p.w_out = (const float*)d_in[10]; p.norm_ffn = (const float*)d_in[11];
  p.peer_wq = (const float*)d_in[12]; p.peer_keys = (const float*)d_in[13]; p.peer_u = (const float*)d_in[14]; p.peer_v = (const float*)d_in[15];
  p.norm_final = (const float*)d_in[16];
  p.out = (float*)d_out; p.ws = (unsigned char*)d_ws;
#if ONE_LAUNCH
  hipMemsetAsync((unsigned char*)d_ws + WS_BAR, 0, 16384, stream);
  p.ph_lo = 0; p.ph_hi = NPHASE;
  void* args[] = {&p};
  hipError_t e = hipLaunchCooperativeKernel((const void*)hybrid_fwd, dim3(grid), dim3(NTHREADS), args, LDS_BYTES, stream);
  if (e != hipSuccess) fprintf(stderr, "cooperative launch failed: %s (grid %d)\n", hipGetErrorString(e), grid);
#else
  for (int ph = 0; ph < NPHASE; ++ph) {
    p.ph_lo = ph; p.ph_hi = ph + 1;
    hipLaunchKernelGGL(hybrid_fwd, dim3(grid), dim3(NTHREADS), LDS_BYTES, stream, p);
  }
#endif
}
```

```cpp
#include <hip/hip_runtime.h>
#include <hip/hip_cooperative_groups.h>
#include <stdint.h>
#include <stdio.h>
namespace cg = cooperative_groups;

#ifndef ONE_LAUNCH
#define ONE_LAUNCH 1
#endif

typedef unsigned short bf16_t;
typedef __attribute__((ext_vector_type(8))) short bf16x8;
typedef __attribute__((ext_vector_type(4))) float f32x4;

#define NTHREADS 512
#define TOK 32768
#define SEQL 4096
#define DM 1024
#define EPSV 1e-6f
#define NPHASE 13

#define WS_WIN   ((size_t)0)
#define WS_WUPA  (WS_WIN  + (size_t)5120 * 1024 * 2)
#define WS_WUPB  (WS_WUPA + (size_t)1024 * 512 * 2)
#define WS_WOUT  (WS_WUPB + (size_t)1024 * 512 * 2)
#define WS_WQ    (WS_WOUT + (size_t)1024 * 1024 * 2)
#define WS_KEYS  (WS_WQ   + (size_t)2048 * 1024 * 2)
#define WS_LB    (WS_KEYS + (size_t)2 * 8 * 128 * 128 * 2)
#define WS_U     (WS_LB   + (size_t)4096)
#define WS_V     (WS_U    + (size_t)16384 * 1024 * 2)
#define WS_XN    (WS_V    + (size_t)16384 * 1024 * 2)
#define WS_PH    (WS_XN   + (size_t)TOK * 1024 * 2)
#define WS_PA    (WS_PH   + (size_t)TOK * 2048 * 2)
#define WS_PG    (WS_PA   + (size_t)TOK * 1024 * 2)
#define WS_EIDX  (WS_PG   + (size_t)TOK * 2048 * 2)
#define WS_GW    (WS_EIDX + (size_t)TOK * 128 * 4)
#define WS_SSQ   (WS_GW   + (size_t)TOK * 128 * 4)
#define WS_XCC   (WS_SSQ  + (size_t)TOK * 4)
#define WS_BAR   (WS_XCC  + (size_t)4096)
#define WS_DEC   (WS_BAR  + (size_t)16384)
#define WS_QCTR  (WS_DEC  + (size_t)2048 * 384 * 4)
#define WS_END   (WS_QCTR + (size_t)256)

#define LDS_BYTES 155648

struct Params {
  const float* x; const float* norm_mix; const float* w_in; const float* hg_lb; const float* hg_norm;
  const float* ikg; const float* ikb; const float* rel_bias; const float* w_up_a; const float* w_up_b;
  const float* w_out; const float* norm_ffn; const float* peer_wq; const float* peer_keys;
  const float* peer_u; const float* peer_v; const float* norm_final;
  float* out; unsigned char* ws; int ph_lo, ph_hi;
};

__device__ __forceinline__ float bf2f(bf16_t u) { return __uint_as_float(((unsigned)u) << 16); }
__device__ __forceinline__ bf16_t f2bf(float f) {
  unsigned u = __float_as_uint(f);
  u += 0x7fffu + ((u >> 16) & 1u);
  return (bf16_t)(u >> 16);
}
__device__ __forceinline__ unsigned pack2(float a, float b) { return (unsigned)f2bf(a) | ((unsigned)f2bf(b) << 16); }
__device__ __forceinline__ float wave_sum_slow(float v) {
#pragma unroll
  for (int o = 32; o > 0; o >>= 1) v += __shfl_xor(v, o);
  return v;
}
__device__ __forceinline__ void lds_fence() { asm volatile("s_waitcnt lgkmcnt(0)" ::: "memory"); }

__device__ __forceinline__ float add_xor8(float v) { return v + __int_as_float(__builtin_amdgcn_update_dpp(0, __float_as_int(v), 0x128, 0xf, 0xf, true)); }
__device__ __forceinline__ float add_xor16(float v) { const auto r = __builtin_amdgcn_permlane16_swap(__float_as_uint(v), __float_as_uint(v), false, false); return __uint_as_float(r[0]) + __uint_as_float(r[1]); }
__device__ __forceinline__ float add_xor32(float v) { const auto r = __builtin_amdgcn_permlane32_swap(__float_as_uint(v), __float_as_uint(v), false, false); return __uint_as_float(r[0]) + __uint_as_float(r[1]); }
__device__ __forceinline__ float max_xor16(float v) { const auto r = __builtin_amdgcn_permlane16_swap(__float_as_uint(v), __float_as_uint(v), false, false); return fmaxf(__uint_as_float(r[0]), __uint_as_float(r[1])); }
__device__ __forceinline__ float max_xor32(float v) { const auto r = __builtin_amdgcn_permlane32_swap(__float_as_uint(v), __float_as_uint(v), false, false); return fmaxf(__uint_as_float(r[0]), __uint_as_float(r[1])); }
__device__ __forceinline__ float wave_sum(float v) {
  v += __int_as_float(__builtin_amdgcn_update_dpp(0, __float_as_int(v), 0xB1, 0xf, 0xf, true));
  v += __int_as_float(__builtin_amdgcn_update_dpp(0, __float_as_int(v), 0x4E, 0xf, 0xf, true));
  v += __int_as_float(__builtin_amdgcn_update_dpp(0, __float_as_int(v), 0x141, 0xf, 0xf, true));
  v += __int_as_float(__builtin_amdgcn_update_dpp(0, __float_as_int(v), 0x140, 0xf, 0xf, true));
  return add_xor32(add_xor16(v));
}
__device__ __forceinline__ float sigmoidf_(float x) { return 1.f / (1.f + __expf(-x)); }
__device__ __forceinline__ float siluf_(float x) { return x / (1.f + __expf(-x)); }


#define XB_TMO      128
#define XB_XCNT(j)  (256  + 64 * (j))
#define XB_XSUB(j)  (1280 + 64 * (j))
#define XB_XGEN(j)  (2304 + 64 * (j))
#define XB_TOP      3328
#define XB_TOPGEN   3392
#define XCD_BAR_WORDS 3456
#define XB_SPIN_CAP (1u << 22)
#define LAS __attribute__((address_space(3)))
__device__ __forceinline__ unsigned xb_ld(unsigned* p)              { return __hip_atomic_load(p, __ATOMIC_RELAXED, __HIP_MEMORY_SCOPE_AGENT); }
__device__ __forceinline__ unsigned xb_add(unsigned* p, unsigned v) { return __hip_atomic_fetch_add(p, v, __ATOMIC_RELAXED, __HIP_MEMORY_SCOPE_AGENT); }
__device__ __forceinline__ unsigned xb_xcc_id() { return (unsigned)__builtin_amdgcn_s_getreg((3 << 11) | 20) & 0xFu; }
#define XB_SPIN(cond, bar) do { unsigned _sp = 0; while (cond) { __builtin_amdgcn_s_sleep(1); \
    if ((++_sp & 255u) == 0u) { if (xb_ld(&(bar)[XB_TMO])) break; if (_sp > XB_SPIN_CAP) { atomicAdd(&(bar)[XB_TMO], 1u); break; } } } } while (0)
struct XcdBarrier { unsigned* bar; unsigned x; volatile LAS unsigned* st; };
__device__ __forceinline__ XcdBarrier xcd_barrier_post(unsigned* bar, volatile LAS unsigned* st) {
  XcdBarrier b; b.bar = bar; b.x = xb_xcc_id(); b.st = st;
  if (threadIdx.x == 0) (void)xb_add(&bar[XB_XCNT(b.x)], 1u);
  return b;
}
__device__ __forceinline__ void xcd_barrier_complete(unsigned* bar, unsigned x, unsigned& nloc, unsigned& nx) {
  const unsigned G = gridDim.x * gridDim.y * gridDim.z;
  unsigned sum, cnt, mine, sp = 0u;
  for (;;) {
    sum = 0u; cnt = 0u; mine = 0u;
#pragma unroll
    for (unsigned j = 0; j < 16; ++j) { const unsigned c = xb_ld(&bar[XB_XCNT(j)]); sum += c; cnt += (c > 0u) ? 1u : 0u; mine = (j == x) ? c : mine; }
    if (sum == G) break;
    __builtin_amdgcn_s_sleep(1);
    if ((++sp & 255u) == 0u) { if (xb_ld(&bar[XB_TMO])) break; if (sp > XB_SPIN_CAP) { atomicAdd(&bar[XB_TMO], 1u); break; } }
  }
  nloc = mine > 0u ? mine : 1u; nx = cnt > 0u ? cnt : 1u;
}
__device__ __forceinline__ void xcd_barrier(const XcdBarrier& b) {
  asm volatile("s_waitcnt vmcnt(0)" ::: "memory");
  __syncthreads();
  if (threadIdx.x == 0) {
    unsigned* bar = b.bar;
    __builtin_amdgcn_s_waitcnt(0);
    unsigned nloc = b.st[0], nx = b.st[1];
    if (nloc == 0u) { xcd_barrier_complete(bar, b.x, nloc, nx); b.st[0] = nloc; b.st[1] = nx; }
    const unsigned old = xb_add(&bar[XB_XSUB(b.x)], 1u);
    const unsigned gen = old / nloc;
    if (old + 1u == (gen + 1u) * nloc) {
      __builtin_amdgcn_fence(__ATOMIC_RELEASE, "agent");
      asm volatile("s_waitcnt vmcnt(0)" ::: "memory");
      const unsigned og = xb_add(&bar[XB_TOP], 1u);
      const unsigned tg = og / nx;
      if (og + 1u == (tg + 1u) * nx) xb_add(&bar[XB_TOPGEN], 1u);
      else XB_SPIN(xb_ld(&bar[XB_TOPGEN]) == tg, bar);
      __builtin_amdgcn_fence(__ATOMIC_ACQUIRE, "agent");
      xb_add(&bar[XB_XGEN(b.x)], 1u);
      asm volatile("s_waitcnt vmcnt(0)" ::: "memory");
    } else {
      XB_SPIN(xb_ld(&bar[XB_XGEN(b.x)]) == gen, bar);
      __builtin_amdgcn_fence(__ATOMIC_ACQUIRE, "agent");
      asm volatile("s_waitcnt vmcnt(0)" ::: "memory");
    }
  }
  __syncthreads();
}

namespace pg8 {
#define PG8_LAS __attribute__((address_space(3)))
typedef unsigned short bf16_t;
typedef short bf16x8 __attribute__((ext_vector_type(8)));
typedef float f32x4 __attribute__((ext_vector_type(4)));
typedef unsigned u32x4 __attribute__((ext_vector_type(4)));
constexpr int BM = 256, BK = 64, HALF = 128, HTB = HALF * BK * 2  , STAGE_BYTES = 8 * HTB, NXCD = 8, WGM = 8;

__host__ __device__ __forceinline__ int lds_byte(int r, int c) { const int st = (r >> 4) * 2 + (c >> 5), rr = r & 15, cc = c & 31, ob = rr * 64 + cc * 2; return st * 1024 + (ob ^ (((ob >> 9) & 1) << 5)); }
__host__ __device__ __forceinline__ void stage_rc(int b, int& R, int& C) { const int st = b / 1024, sb = b % 1024, swz = sb ^ (((sb >> 9) & 1) << 5); R = (st >> 1) * 16 + swz / 64; C = (st & 1) * 32 + (swz % 64) / 2; }
__host__ __device__ __forceinline__ int perm32(int rho) { const int n = rho >> 4, i = rho & 15; return 8 * (i >> 2) + 4 * n + (i & 3); }

struct Unit { int pm, pn; };
struct Gemm { const bf16_t* A; const bf16_t* Bt; int M, N, K; };

struct StaticOrder {
    int nM, nN, nwg, G, c;
    __host__ __device__ void init(int M, int N, int G_, int c_) { nM = M / BM; nN = N / BM; nwg = nM * nN; G = G_; c = c_; }
    __host__ __device__ bool next(int i, Unit& u) const {
        const long L = (long)i * G + c; if (L >= nwg) return false;
        int wgid = (int)L; { const int q = nwg / NXCD, r = nwg % NXCD, xcd = wgid % NXCD, off = wgid / NXCD; wgid = (xcd < r ? xcd * (q + 1) : r * (q + 1) + (xcd - r) * q) + off; }
        const int nig = WGM * nN, gid = wgid / nig, fm = gid * WGM, gsz = (nM - fm) < WGM ? (nM - fm) : WGM;
        u.pm = fm + ((wgid % nig) % gsz); u.pn = (wgid % nig) / gsz; return true;
    }
    __device__ __forceinline__ void a_ready(const Unit&) const {}
    __device__ __forceinline__ void done(const Unit&) const {}
};
__device__ __forceinline__ unsigned cvt_pk_bf16(float lo, float hi) { unsigned r; asm volatile("v_cvt_pk_bf16_f32 %0, %1, %2" : "=v"(r) : "v"(lo), "v"(hi)); return r; }
template <class Epi, class Sched, bool STAMP = false>
__device__ __forceinline__ void gemm_phase(PG8_LAS unsigned char* lds, const Gemm g, const Sched& S, const Epi& E, unsigned long long* stamps) {
    const int tid = threadIdx.x, wid = __builtin_amdgcn_readfirstlane(tid >> 6), lane = tid & 63, wr = wid >> 2, wc = wid & 3, fr = lane & 15, fq = lane >> 4;
    const int K = g.K, nt = K / BK;
    int ts_lo = 0, ts_hi = 0, nts = 0; const unsigned long long rt_entry = STAMP ? (unsigned long long)wall_clock64() : 0ull;
#define PG8_STAMP() do { if (STAMP && wid == 0 && nts < 64) { const unsigned long long _c = (unsigned long long)clock64(); \
        ts_lo = (lane == nts) ? (int)(unsigned)_c : ts_lo; ts_hi = (lane == nts) ? (int)(unsigned)(_c >> 32) : ts_hi; ++nts; } } while (0)
    PG8_STAMP();
    unsigned voffA[2], voffB[2];
#pragma unroll
    for (int i = 0; i < 2; ++i) { int R, C; stage_rc(tid * 16 + i * 8192, R, C); const int Rb = Epi::PERM ? ((R & ~31) + perm32(R & 31)) : R;
        voffA[i] = (unsigned)(R * K + C) * 2u; voffB[i] = (unsigned)(Rb * K + C) * 2u; }
    const size_t kstep = (size_t)(BK * 2);
    const size_t hstep = (size_t)HALF * K * 2;
    const size_t tstep = 2 * hstep;
    const unsigned ldsw = (unsigned)wid * 1024u;
    const int aoff = lds_byte(wr * 64 + fr, fq * 8), boff = lds_byte(wc * 32 + fr, fq * 8);
#define PG8_SA(b, h) (((b) * 2 + (h)) * HTB)
#define PG8_SB(b, h) ((4 + (b) * 2 + (h)) * HTB)
#define PG8_STAGE(bufoff, gbase, voff) do { _Pragma("unroll") for (int _i = 0; _i < 2; ++_i) \
        __builtin_amdgcn_global_load_lds((const unsigned*)((const char*)(gbase) + (voff)[_i]), (PG8_LAS unsigned*)(lds + (bufoff) + ldsw + _i * 8192), 16, 0, 0); } while (0)
#define PG8_LDA(dst, b, h) do { _Pragma("unroll") for (int m = 0; m < 4; ++m) _Pragma("unroll") for (int k = 0; k < 2; ++k) dst[m][k] = *(const PG8_LAS bf16x8*)(lds + PG8_SA(b, h) + aoff + m * 2048 + k * 1024); } while (0)
#define PG8_LDB(dst, b, h) do { _Pragma("unroll") for (int n = 0; n < 2; ++n) _Pragma("unroll") for (int k = 0; k < 2; ++k) dst[n][k] = *(const PG8_LAS bf16x8*)(lds + PG8_SB(b, h) + boff + n * 2048 + k * 1024); } while (0)
#define PG8_MMA(ai, bj, At, Bt) do { __builtin_amdgcn_s_setprio(1); _Pragma("unroll") for (int m = 0; m < 4; ++m) _Pragma("unroll") for (int n = 0; n < 2; ++n) _Pragma("unroll") for (int k = 0; k < 2; ++k) \
        acc[ai][bj][m][n] = __builtin_amdgcn_mfma_f32_16x16x32_bf16(Bt[n][k], At[m][k], acc[ai][bj][m][n], 0, 0, 0); __builtin_amdgcn_s_setprio(0); } while (0)
#define PG8_WAIT_V(n) asm volatile("s_waitcnt vmcnt(" #n ")" ::: "memory")
#define PG8_WAIT_L(n) asm volatile("s_waitcnt lgkmcnt(" #n ")" ::: "memory")
#define PG8_BAR __builtin_amdgcn_s_barrier()
#define PG8_SCHED __builtin_amdgcn_sched_barrier(0)
    Unit cur, nxt; int ui = 0;
    if (!S.next(0, cur)) return;
    f32x4 acc[2][2][4][2];
#pragma unroll
    for (int a = 0; a < 2; ++a)
#pragma unroll
        for (int b = 0; b < 2; ++b)
#pragma unroll
            for (int m = 0; m < 4; ++m)
#pragma unroll
                for (int n = 0; n < 2; ++n) acc[a][b][m][n] = (f32x4){0.f, 0.f, 0.f, 0.f};
    bf16x8 At[4][2], B0[2][2], B1[2][2];
    const char* cA = (const char*)g.A + (size_t)cur.pm * tstep; const char* cB = (const char*)g.Bt + (size_t)cur.pn * tstep;
    S.a_ready(cur);
    PG8_STAGE(PG8_SB(0, 0), cB, voffB); PG8_STAGE(PG8_SA(0, 0), cA, voffA); PG8_STAGE(PG8_SB(0, 1), cB + hstep, voffB); PG8_STAGE(PG8_SA(0, 1), cA + hstep, voffA);
    if (wr == 1) PG8_BAR;
    PG8_WAIT_V(4); PG8_BAR;
    PG8_STAGE(PG8_SB(1, 0), cB + kstep, voffB); PG8_STAGE(PG8_SA(1, 0), cA + kstep, voffA); PG8_STAGE(PG8_SB(1, 1), cB + hstep + kstep, voffB);
    PG8_WAIT_V(6); PG8_BAR;
    PG8_STAMP();
    for (;;) {
        const bool has_next = S.next(ui + 1, nxt);
        const char* nA = has_next ? (const char*)g.A + (size_t)nxt.pm * tstep : cA; const char* nB = has_next ? (const char*)g.Bt + (size_t)nxt.pn * tstep : cB;
        for (int t = 0; t < nt; t += 2) {
            const bool last = (t == nt - 2);
            const char* a1 = cA + (size_t)(t + 1) * kstep;
            const char* a2 = last ? nA : cA + (size_t)(t + 2) * kstep; const char* b2 = last ? nB : cB + (size_t)(t + 2) * kstep;
            const char* a3 = a2 + kstep; const char* b3 = b2 + kstep;
            if (last && has_next) S.a_ready(nxt);
            PG8_LDB(B0, 0, 0); PG8_SCHED; PG8_LDA(At, 0, 0); PG8_STAGE(PG8_SA(1, 1), a1 + hstep, voffA);
            PG8_WAIT_L(8); PG8_BAR; PG8_WAIT_L(0); PG8_MMA(0, 0, At, B0); PG8_BAR; PG8_SCHED;
            PG8_LDB(B1, 0, 1); PG8_STAGE(PG8_SB(0, 0), b2, voffB);
            PG8_BAR; PG8_WAIT_L(0); PG8_MMA(0, 1, At, B1); PG8_BAR;
            PG8_LDA(At, 0, 1); PG8_STAGE(PG8_SA(0, 0), a2, voffA);
            PG8_BAR; PG8_WAIT_L(0); PG8_MMA(1, 0, At, B0); PG8_BAR; PG8_SCHED;
            PG8_STAGE(PG8_SB(0, 1), b2 + hstep, voffB);
            PG8_WAIT_V(6); PG8_BAR; PG8_MMA(1, 1, At, B1); PG8_BAR;
            PG8_LDB(B0, 1, 0); PG8_SCHED; PG8_LDA(At, 1, 0); PG8_STAGE(PG8_SA(0, 1), a2 + hstep, voffA);
            PG8_WAIT_L(8); PG8_BAR; PG8_WAIT_L(0); PG8_MMA(0, 0, At, B0); PG8_BAR; PG8_SCHED;
            PG8_LDB(B1, 1, 1); PG8_STAGE(PG8_SB(1, 0), b3, voffB);
            PG8_BAR; PG8_WAIT_L(0); PG8_MMA(0, 1, At, B1); PG8_BAR;
            PG8_LDA(At, 1, 1); PG8_STAGE(PG8_SA(1, 0), a3, voffA);
            PG8_BAR; PG8_WAIT_L(0); PG8_MMA(1, 0, At, B0); PG8_BAR; PG8_SCHED;
            PG8_STAGE(PG8_SB(1, 1), b3 + hstep, voffB);
            PG8_WAIT_V(6); PG8_BAR; PG8_MMA(1, 1, At, B1); PG8_BAR;
        }
        PG8_STAMP();
        if constexpr (!Epi::AFTER_DRAIN) { E(acc, cur, wr, wc, fr, fq); S.done(cur); }
        PG8_STAMP();
        if (!has_next) break;
#pragma unroll
        for (int a = 0; a < 2; ++a)
#pragma unroll
            for (int b = 0; b < 2; ++b)
#pragma unroll
                for (int m = 0; m < 4; ++m)
#pragma unroll
                    for (int n = 0; n < 2; ++n) acc[a][b][m][n] = (f32x4){0.f, 0.f, 0.f, 0.f};
        cur = nxt; cA = nA; cB = nB; ++ui;
    }
    PG8_WAIT_V(0);
    if (wr == 0) PG8_BAR;
    PG8_BAR;
    if constexpr (Epi::AFTER_DRAIN) { E.fused(acc, cur, wr, wc, fr, fq, lds, wid, lane); S.done(cur); }
    PG8_STAMP();
    if (STAMP && wid == 0) { stamps[lane] = lane < nts ? (((unsigned long long)(unsigned)ts_hi << 32) | (unsigned)ts_lo) : 0ull;
        if (lane == 62) stamps[62] = rt_entry; if (lane == 63) stamps[63] = (unsigned long long)wall_clock64(); }
#undef PG8_STAMP
#undef PG8_SA
#undef PG8_SB
#undef PG8_STAGE
#undef PG8_LDA
#undef PG8_LDB
#undef PG8_MMA
#undef PG8_WAIT_V
#undef PG8_WAIT_L
#undef PG8_BAR
#undef PG8_SCHED
}
}

struct EpiProj {
  static constexpr bool PERM = true, AFTER_DRAIN = false;
  unsigned short* pH; unsigned short* pA; unsigned short* pG;
  __device__ __forceinline__ void operator()(const pg8::f32x4 (&acc)[2][2][4][2], const pg8::Unit& u, int wr, int wc, int fr, int fq) const {
    const int row0 = u.pm * 256 + wr * 64 + fr;
    unsigned short* base; int ldc, colt; bool sg = false;
    if (u.pn < 8) { base = pH; ldc = 2048; colt = u.pn * 256; }
    else if (u.pn < 12) { base = pA; ldc = 1024; colt = (u.pn - 8) * 256; }
    else { base = pG; ldc = 2048; colt = (u.pn - 12) * 256; sg = true; }
    const int col0 = colt + wc * 32 + 8 * fq;
#pragma unroll
    for (int ai = 0; ai < 2; ++ai)
#pragma unroll
      for (int m = 0; m < 4; ++m) {
        unsigned short* rowp = base + (size_t)(row0 + ai * 128 + m * 16) * ldc + col0;
#pragma unroll
        for (int bj = 0; bj < 2; ++bj) {
          pg8::f32x4 v0 = acc[ai][bj][m][0], v1 = acc[ai][bj][m][1];
          if (sg) {
#pragma unroll
            for (int j = 0; j < 4; ++j) { v0[j] = sigmoidf_(v0[j]); v1[j] = sigmoidf_(v1[j]); }
          }
          pg8::u32x4 w; w.x = pg8::cvt_pk_bf16(v0[0], v0[1]); w.y = pg8::cvt_pk_bf16(v0[2], v0[3]); w.z = pg8::cvt_pk_bf16(v1[0], v1[1]); w.w = pg8::cvt_pk_bf16(v1[2], v1[3]);
          *(pg8::u32x4*)(rowp + bj * 128) = w;
        }
      }
  }
};
template <int MODE> struct EpiGate {
  static constexpr bool PERM = true, AFTER_DRAIN = false;
  unsigned short* hb; const unsigned short* pG; int goff;
  __device__ __forceinline__ void operator()(const pg8::f32x4 (&acc)[2][2][4][2], const pg8::Unit& u, int wr, int wc, int fr, int fq) const {
    const int row0 = u.pm * 256 + wr * 64 + fr;
    const int col0 = u.pn * 256 + wc * 32 + 8 * fq;
#pragma unroll
    for (int ai = 0; ai < 2; ++ai)
#pragma unroll
      for (int m = 0; m < 4; ++m) {
        const size_t r = (size_t)(row0 + ai * 128 + m * 16);
        pg8::u32x4 gv[2], hv[2];
#pragma unroll
        for (int bj = 0; bj < 2; ++bj) {
          gv[bj] = *(const pg8::u32x4*)(pG + r * 2048 + goff + col0 + bj * 128);
          if (MODE == 1) hv[bj] = *(const pg8::u32x4*)(hb + r * 1024 + col0 + bj * 128);
        }
#pragma unroll
        for (int bj = 0; bj < 2; ++bj) {
          float o[8];
#pragma unroll
          for (int j = 0; j < 4; ++j) {
            const unsigned gw0 = gv[bj][j >> 1], gw1 = gv[bj][2 + (j >> 1)];
            const float g0 = (j & 1) ? __uint_as_float(gw0 & 0xffff0000u) : __uint_as_float(gw0 << 16);
            const float g1 = (j & 1) ? __uint_as_float(gw1 & 0xffff0000u) : __uint_as_float(gw1 << 16);
            o[j] = acc[ai][bj][m][0][j] * g0; o[4 + j] = acc[ai][bj][m][1][j] * g1;
            if (MODE == 1) {
              const unsigned hw0 = hv[bj][j >> 1], hw1 = hv[bj][2 + (j >> 1)];
              o[j] += (j & 1) ? __uint_as_float(hw0 & 0xffff0000u) : __uint_as_float(hw0 << 16);
              o[4 + j] += (j & 1) ? __uint_as_float(hw1 & 0xffff0000u) : __uint_as_float(hw1 << 16);
            }
          }
          pg8::u32x4 w; w.x = pg8::cvt_pk_bf16(o[0], o[1]); w.y = pg8::cvt_pk_bf16(o[2], o[3]); w.z = pg8::cvt_pk_bf16(o[4], o[5]); w.w = pg8::cvt_pk_bf16(o[6], o[7]);
          *(pg8::u32x4*)(hb + r * 1024 + col0 + bj * 128) = w;
        }
      }
  }
};
struct EpiResid {
  static constexpr bool PERM = false, AFTER_DRAIN = false;
  float* out; const float* x;
  __device__ __forceinline__ void operator()(const pg8::f32x4 (&acc)[2][2][4][2], const pg8::Unit& u, int wr, int wc, int fr, int fq) const {
    const int row0 = u.pm * 256 + wr * 64 + fr, col0 = u.pn * 256 + wc * 32 + 4 * fq;
#pragma unroll
    for (int ai = 0; ai < 2; ++ai)
#pragma unroll
      for (int m = 0; m < 4; ++m) {
        const size_t off = (size_t)(row0 + ai * 128 + m * 16) * 1024 + col0;
        pg8::f32x4 xv[2][2];
#pragma unroll
        for (int bj = 0; bj < 2; ++bj)
#pragma unroll
          for (int n = 0; n < 2; ++n) xv[bj][n] = *(const pg8::f32x4*)(x + off + bj * 128 + n * 16);
#pragma unroll
        for (int bj = 0; bj < 2; ++bj)
#pragma unroll
          for (int n = 0; n < 2; ++n) *(pg8::f32x4*)(out + off + bj * 128 + n * 16) = acc[ai][bj][m][n] + xv[bj][n];
      }
  }
};
struct EpiStoreBf16 {
  static constexpr bool PERM = true, AFTER_DRAIN = false;
  unsigned short* O; int ldc;
  __device__ __forceinline__ void operator()(const pg8::f32x4 (&acc)[2][2][4][2], const pg8::Unit& u, int wr, int wc, int fr, int fq) const {
    const int row0 = u.pm * 256 + wr * 64 + fr, col0 = u.pn * 256 + wc * 32 + 8 * fq;
#pragma unroll
    for (int ai = 0; ai < 2; ++ai)
#pragma unroll
      for (int m = 0; m < 4; ++m) {
        unsigned short* rowp = O + (size_t)(row0 + ai * 128 + m * 16) * ldc + col0;
#pragma unroll
        for (int bj = 0; bj < 2; ++bj) {
          const pg8::f32x4 v0 = acc[ai][bj][m][0], v1 = acc[ai][bj][m][1];
          pg8::u32x4 w; w.x = pg8::cvt_pk_bf16(v0[0], v0[1]); w.y = pg8::cvt_pk_bf16(v0[2], v0[3]); w.z = pg8::cvt_pk_bf16(v1[0], v1[1]); w.w = pg8::cvt_pk_bf16(v1[2], v1[3]);
          *(pg8::u32x4*)(rowp + bj * 128) = w;
        }
      }
  }
};

__device__ __forceinline__ void gemm_tile(const bf16_t* __restrict__ A, int lda, const bf16_t* __restrict__ Bt, int ldb,
                                          int nk, f32x4 (&acc)[4][4], unsigned char* smem) {
  const int tid = threadIdx.x, lane = tid & 63, w = tid >> 6, wm = w >> 1, wn = w & 1, l15 = lane & 15, g = lane >> 4;
  unsigned char* sA = smem;
  unsigned char* sB = smem + 32768;
  const int lr = tid >> 3, lc = tid & 7;
  const bf16_t* ga = A + (size_t)lr * lda + lc * 8;
  const bf16_t* gb = Bt + (size_t)lr * ldb + lc * 8;
  uint4 ra0, ra1, ra2, ra3, rb0, rb1;
  ra0 = *(const uint4*)(ga);
  ra1 = *(const uint4*)(ga + (size_t)64 * lda);
  ra2 = *(const uint4*)(ga + (size_t)128 * lda);
  ra3 = *(const uint4*)(ga + (size_t)192 * lda);
  rb0 = *(const uint4*)(gb);
  rb1 = *(const uint4*)(gb + (size_t)64 * ldb);
  const int sw = (lc ^ (lr & 7)) << 4;
  for (int kt = 0; kt < nk; ++kt) {
    __syncthreads();
    *(uint4*)(sA + (lr) * 128 + sw) = ra0;
    *(uint4*)(sA + (lr + 64) * 128 + sw) = ra1;
    *(uint4*)(sA + (lr + 128) * 128 + sw) = ra2;
    *(uint4*)(sA + (lr + 192) * 128 + sw) = ra3;
    *(uint4*)(sB + (lr) * 128 + sw) = rb0;
    *(uint4*)(sB + (lr + 64) * 128 + sw) = rb1;
    __syncthreads();
    if (kt + 1 < nk) {
      const int ko = (kt + 1) * 64;
      ra0 = *(const uint4*)(ga + ko);
      ra1 = *(const uint4*)(ga + (size_t)64 * lda + ko);
      ra2 = *(const uint4*)(ga + (size_t)128 * lda + ko);
      ra3 = *(const uint4*)(ga + (size_t)192 * lda + ko);
      rb0 = *(const uint4*)(gb + ko);
      rb1 = *(const uint4*)(gb + (size_t)64 * ldb + ko);
    }
#pragma unroll
    for (int ks = 0; ks < 2; ++ks) {
      bf16x8 a[4], b[4];
#pragma unroll
      for (int m = 0; m < 4; ++m) { const int r = wm * 64 + m * 16 + l15; a[m] = *(const bf16x8*)(sA + r * 128 + (((ks * 4 + g) ^ (r & 7)) << 4)); }
#pragma unroll
      for (int n = 0; n < 4; ++n) { const int r = wn * 64 + n * 16 + l15; b[n] = *(const bf16x8*)(sB + r * 128 + (((ks * 4 + g) ^ (r & 7)) << 4)); }
#pragma unroll
      for (int m = 0; m < 4; ++m)
#pragma unroll
        for (int n = 0; n < 4; ++n) acc[m][n] = __builtin_amdgcn_mfma_f32_16x16x32_bf16(a[m], b[n], acc[m][n], 0, 0, 0);
    }
  }
}

__device__ __forceinline__ void zero_acc(f32x4 (&acc)[4][4]) {
#pragma unroll
  for (int m = 0; m < 4; ++m)
#pragma unroll
    for (int n = 0; n < 4; ++n) acc[m][n] = (f32x4){0.f, 0.f, 0.f, 0.f};
}

__device__ __forceinline__ void transpose_tile(const float* __restrict__ src, int srcN, bf16_t* __restrict__ dst, int K, int n0, int k0,
                                               bool winmap, float* tile) {
  const int tid = threadIdx.x;
  const int nc = tid & 63, kr = tid >> 6;
  int ncol = n0 + nc; bool valid = true;
  if (winmap) { if (ncol >= 3072) ncol -= 60; else if (ncol >= 3012) valid = false; }
#pragma unroll
  for (int i = 0; i < 8; ++i) {
    const int k = kr + 8 * i;
    tile[k * 65 + nc] = valid ? src[(size_t)(k0 + k) * srcN + ncol] : 0.f;
  }
  __syncthreads();
#pragma unroll
  for (int i = 0; i < 8; ++i) {
    const int nr = kr + 8 * i;
    dst[(size_t)(n0 + nr) * K + k0 + nc] = f2bf(tile[nc * 65 + nr]);
  }
  __syncthreads();
}

__device__ __forceinline__ void convert_f32_bf16(const float* __restrict__ src, bf16_t* __restrict__ dst, size_t n4) {
  for (size_t i = (size_t)blockIdx.x * NTHREADS + threadIdx.x; i < n4; i += (size_t)gridDim.x * NTHREADS) {
    const float4 v = ((const float4*)src)[i];
    uint2 o; o.x = pack2(v.x, v.y); o.y = pack2(v.z, v.w);
    ((uint2*)dst)[i] = o;
  }
}

template <bool SLICE_MAJOR, bool SIGNED>
__device__ __forceinline__ void quantize_rows_u8(const float* __restrict__ src, unsigned char* __restrict__ dst, float* __restrict__ scale) {
  const int lane = threadIdx.x & 63, w = threadIdx.x >> 6;
  for (int row = blockIdx.x * 8 + w; row < 16384; row += gridDim.x * 8) {
    const float4* s4 = (const float4*)(src + (size_t)row * 1024) + lane * 4;
    float4 v[4];
    float am = 0.f;
#pragma unroll
    for (int i = 0; i < 4; ++i) { v[i] = s4[i]; am = fmaxf(am, fmaxf(fmaxf(fabsf(v[i].x), fabsf(v[i].y)), fmaxf(fabsf(v[i].z), fabsf(v[i].w)))); }
#pragma unroll
    for (int o = 32; o > 0; o >>= 1) am = fmaxf(am, __shfl_xor(am, o));
    const float inv = am > 0.f ? 127.f / am : 0.f;
    unsigned pk[4];
#pragma unroll
    for (int i = 0; i < 4; ++i) {
      const int ofs = SIGNED ? 0 : 128;
      const unsigned b0 = (unsigned)((int)rintf(v[i].x * inv) + ofs), b1 = (unsigned)((int)rintf(v[i].y * inv) + ofs);
      const unsigned b2 = (unsigned)((int)rintf(v[i].z * inv) + ofs), b3 = (unsigned)((int)rintf(v[i].w * inv) + ofs);
      pk[i] = (b0 & 255u) | ((b1 & 255u) << 8) | ((b2 & 255u) << 16) | ((b3 & 255u) << 24);
    }
    if (SLICE_MAJOR) *(uint4*)(dst + (size_t)(lane >> 3) * (16384 * 128) + (size_t)row * 128 + (lane & 7) * 16) = make_uint4(pk[0], pk[1], pk[2], pk[3]);
    else *(uint4*)(dst + (size_t)row * 1024 + lane * 16) = make_uint4(pk[0], pk[1], pk[2], pk[3]);
    if (lane == 0) scale[row] = am * (1.f / 127.f);
  }
}

#define WS_XQ (WS_PH + (size_t)TOK * 1024 * 2)
#define WS_XS (WS_XQ + (size_t)TOK * 1024)
__device__ __forceinline__ void rmsnorm_rows_q(const float* __restrict__ src, const float* __restrict__ g, bf16_t* __restrict__ dst,
                                               unsigned char* __restrict__ xq, float* __restrict__ xs) {
  const int lane = threadIdx.x & 63, w = threadIdx.x >> 6;
  for (int row = blockIdx.x * 8 + w; row < TOK; row += gridDim.x * 8) {
    const float4* s4 = (const float4*)(src + (size_t)row * DM) + lane * 4;
    const float4* g4 = (const float4*)g + lane * 4;
    float v[16]; float ss = 0.f;
#pragma unroll
    for (int i = 0; i < 4; ++i) { const float4 t = s4[i]; v[4 * i] = t.x; v[4 * i + 1] = t.y; v[4 * i + 2] = t.z; v[4 * i + 3] = t.w; ss += t.x * t.x + t.y * t.y + t.z * t.z + t.w * t.w; }
    ss = wave_sum(ss);
    const float rstd = rsqrtf(ss * (1.f / DM) + EPSV);
    float am = 0.f;
#pragma unroll
    for (int i = 0; i < 4; ++i) { const float4 gg = g4[i]; v[4 * i] *= rstd * gg.x; v[4 * i + 1] *= rstd * gg.y; v[4 * i + 2] *= rstd * gg.z; v[4 * i + 3] *= rstd * gg.w; }
#pragma unroll
    for (int i = 0; i < 16; ++i) am = fmaxf(am, fabsf(v[i]));
#pragma unroll
    for (int o = 32; o > 0; o >>= 1) am = fmaxf(am, __shfl_xor(am, o));
    const float inv = am > 0.f ? 127.f / am : 0.f;
    uint4 ob0, ob1;
    ob0.x = pack2(v[0], v[1]); ob0.y = pack2(v[2], v[3]); ob0.z = pack2(v[4], v[5]); ob0.w = pack2(v[6], v[7]);
    ob1.x = pack2(v[8], v[9]); ob1.y = pack2(v[10], v[11]); ob1.z = pack2(v[12], v[13]); ob1.w = pack2(v[14], v[15]);
    *(uint4*)(dst + (size_t)row * DM + lane * 16) = ob0;
    *(uint4*)(dst + (size_t)row * DM + lane * 16 + 8) = ob1;
    unsigned pk[4];
#pragma unroll
    for (int i = 0; i < 4; ++i) {
      const unsigned b0 = (unsigned)(int)rintf(v[4 * i] * inv) & 255u, b1 = (unsigned)(int)rintf(v[4 * i + 1] * inv) & 255u;
      const unsigned b2 = (unsigned)(int)rintf(v[4 * i + 2] * inv) & 255u, b3 = (unsigned)(int)rintf(v[4 * i + 3] * inv) & 255u;
      pk[i] = b0 | (b1 << 8) | (b2 << 16) | (b3 << 24);
    }
    *(uint4*)(xq + (size_t)row * 1024 + lane * 16) = make_uint4(pk[0], pk[1], pk[2], pk[3]);
    if (lane == 0) xs[row] = am * (1.f / 127.f);
  }
}

__device__ __forceinline__ void rmsnorm_rows(const float* __restrict__ src, const float* __restrict__ g, bf16_t* __restrict__ dst) {
  const int lane = threadIdx.x & 63, w = threadIdx.x >> 6;
  for (int row = blockIdx.x * 8 + w; row < TOK; row += gridDim.x * 8) {
    const float4* s4 = (const float4*)(src + (size_t)row * DM);
    float4 v[4]; float ss = 0.f;
#pragma unroll
    for (int i = 0; i < 4; ++i) { v[i] = s4[lane + 64 * i]; ss += v[i].x * v[i].x + v[i].y * v[i].y + v[i].z * v[i].z + v[i].w * v[i].w; }
    ss = wave_sum(ss);
    const float rstd = rsqrtf(ss * (1.f / DM) + EPSV);
#pragma unroll
    for (int i = 0; i < 4; ++i) {
      const float4 gg = ((const float4*)g)[lane + 64 * i];
      uint2 o; o.x = pack2(v[i].x * rstd * gg.x, v[i].y * rstd * gg.y); o.y = pack2(v[i].z * rstd * gg.z, v[i].w * rstd * gg.w);
      ((uint2*)(dst + (size_t)row * DM))[lane + 64 * i] = o;
    }
  }
}

__device__ __forceinline__ void phase_prep(const Params& p, unsigned char* smem) {
  unsigned char* ws = p.ws;
  float* tile = (float*)smem;
  const int n_win = 80 * 16, n_ua = 16 * 8, n_ub = 16 * 8, n_wo = 16 * 16, n_wq = 32 * 16;
  const int total = n_win + n_ua + n_ub + n_wo + n_wq;
  for (int it = blockIdx.x; it < total; it += gridDim.x) {
    int t = it;
    if (t < n_win) { transpose_tile(p.w_in, 5060, (bf16_t*)(ws + WS_WIN), 1024, (t >> 4) * 64, (t & 15) * 64, true, tile); continue; }
    t -= n_win;
    if (t < n_ua) { transpose_tile(p.w_up_a, 1024, (bf16_t*)(ws + WS_WUPA), 512, (t >> 3) * 64, (t & 7) * 64, false, tile); continue; }
    t -= n_ua;
    if (t < n_ub) { transpose_tile(p.w_up_b, 1024, (bf16_t*)(ws + WS_WUPB), 512, (t >> 3) * 64, (t & 7) * 64, false, tile); continue; }
    t -= n_ub;
    if (t < n_wo) { transpose_tile(p.w_out, 1024, (bf16_t*)(ws + WS_WOUT), 1024, (t >> 4) * 64, (t & 15) * 64, false, tile); continue; }
    t -= n_wo;
    transpose_tile(p.peer_wq, 2048, (bf16_t*)(ws + WS_WQ), 1024, (t >> 4) * 64, (t & 15) * 64, false, tile);
  }
  quantize_rows_u8<false, true>(p.peer_u, ws + WS_U, (float*)(ws + WS_U + (size_t)16384 * 1024));
  quantize_rows_u8<true, false>(p.peer_v, ws + WS_V, (float*)(ws + WS_V + (size_t)16384 * 1024));
  convert_f32_bf16(p.peer_keys, (bf16_t*)(ws + WS_KEYS), (size_t)2 * 8 * 128 * 128 / 4);
  for (int i = blockIdx.x * NTHREADS + threadIdx.x; i < TOK; i += gridDim.x * NTHREADS) ((float*)(ws + WS_SSQ))[i] = 0.f;
  if (threadIdx.x == 0) ((int*)(ws + WS_XCC))[blockIdx.x] = (int)(__builtin_amdgcn_s_getreg((3 << 11) | 20) & 0xFu);
  if (blockIdx.x == 0 && threadIdx.x == 0) *(unsigned*)(ws + WS_QCTR) = 0u;
  if (blockIdx.x == 0) {
    const int i = threadIdx.x;
    const float a0 = p.hg_lb[i], a1 = p.hg_lb[512 + i];
    ((float*)(ws + WS_LB))[i] = 1.f / (1.f + expf(a1 - a0));
  }
  rmsnorm_rows(p.x, p.norm_mix, (bf16_t*)(ws + WS_XN));
}

__device__ __forceinline__ void phase_proj(const Params& p, unsigned char* smem) {
  unsigned char* ws = p.ws;
  const bf16_t* xn = (const bf16_t*)(ws + WS_XN);
  const bf16_t* wt = (const bf16_t*)(ws + WS_WIN);
  bf16_t* pH = (bf16_t*)(ws + WS_PH);
  bf16_t* pA = (bf16_t*)(ws + WS_PA);
  bf16_t* pG = (bf16_t*)(ws + WS_PG);
  const int tid = threadIdx.x, lane = tid & 63, w = tid >> 6, wm = w >> 1, wn = w & 1, l15 = lane & 15, g = lane >> 4;
  for (int tile = blockIdx.x; tile < 128 * 40; tile += gridDim.x) {
    const int tn = tile % 40, tm = tile / 40;
    f32x4 acc[4][4]; zero_acc(acc);
    gemm_tile(xn + (size_t)tm * 256 * 1024, 1024, wt + (size_t)tn * 128 * 1024, 1024, 16, acc, smem);
    const int rbase = tm * 256 + wm * 64 + 4 * g;
    const int cbase = tn * 128 + wn * 64 + l15;
    if (tn < 16) {
#pragma unroll
      for (int m = 0; m < 4; ++m)
#pragma unroll
        for (int n = 0; n < 4; ++n)
#pragma unroll
          for (int j = 0; j < 4; ++j) pH[(size_t)(rbase + m * 16 + j) * 2048 + cbase + n * 16] = f2bf(acc[m][n][j]);
    } else if (tn < 24) {
      if (tn == 23 && wn == 0) {
        float gam[4], bet[4];
#pragma unroll
        for (int n = 0; n < 4; ++n) { gam[n] = p.ikg[n * 16 + l15]; bet[n] = p.ikb[n * 16 + l15]; }
#pragma unroll
        for (int m = 0; m < 4; ++m)
#pragma unroll
          for (int j = 0; j < 4; ++j) {
            float s = acc[m][0][j] + acc[m][1][j] + acc[m][2][j] + acc[m][3][j];
            s += __shfl_xor(s, 1); s += __shfl_xor(s, 2); s += __shfl_xor(s, 4); s += __shfl_xor(s, 8);
            const float mu = s * (1.f / 64.f);
            float q = 0.f;
#pragma unroll
            for (int n = 0; n < 4; ++n) { const float d = acc[m][n][j] - mu; q += d * d; }
            q += __shfl_xor(q, 1); q += __shfl_xor(q, 2); q += __shfl_xor(q, 4); q += __shfl_xor(q, 8);
            const float rstd = rsqrtf(q * (1.f / 64.f) + EPSV);
#pragma unroll
            for (int n = 0; n < 4; ++n)
              pA[(size_t)(rbase + m * 16 + j) * 1024 + (cbase - 2048) + n * 16] = f2bf((acc[m][n][j] - mu) * rstd * gam[n] + bet[n]);
          }
      } else {
#pragma unroll
        for (int m = 0; m < 4; ++m)
#pragma unroll
          for (int n = 0; n < 4; ++n)
#pragma unroll
            for (int j = 0; j < 4; ++j) pA[(size_t)(rbase + m * 16 + j) * 1024 + (cbase - 2048) + n * 16] = f2bf(acc[m][n][j]);
      }
    } else {
#pragma unroll
      for (int m = 0; m < 4; ++m)
#pragma unroll
        for (int n = 0; n < 4; ++n)
#pragma unroll
          for (int j = 0; j < 4; ++j) pG[(size_t)(rbase + m * 16 + j) * 2048 + (cbase - 3072) + n * 16] = f2bf(sigmoidf_(acc[m][n][j]));
    }
  }
}

__device__ __forceinline__ void hgrn_item(const Params& p, unsigned char* smem, int bh) {
  unsigned char* ws = p.ws;
  const bf16_t* pH = (const bf16_t*)(ws + WS_PH);
  const float* lbp = (const float*)(ws + WS_LB);
  bf16_t* ya = (bf16_t*)(ws + WS_XN);
  bf16_t* Qt = (bf16_t*)smem;
  bf16_t* Kt = Qt + 64 * 136;
  bf16_t* KtT = Kt + 64 * 136;
  bf16_t* VT = KtT + 128 * 72;
  bf16_t* Am = VT + 128 * 72;
  bf16_t* ST = Am + 64 * 72;
  float* qtot = (float*)(ST + 128 * 136);
  float* eref = qtot + 512;
  float* elast = eref + 128;
  float* elr = elast + 128;
  float* red = elr + 128;
  const int tid = threadIdx.x, lane = tid & 63, w = tid >> 6, l15 = lane & 15, g = lane >> 4;
  const int b = bh >> 2, h = bh & 3;
  const int d = tid & 127, tq = tid >> 7;
  const float lbv = lbp[h * 128 + d];
  f32x4 S[8];
#pragma unroll
  for (int i = 0; i < 8; ++i) S[i] = (f32x4){0.f, 0.f, 0.f, 0.f};
  const float gnv = p.hg_norm[h * 128 + 16 * w + l15];

  for (int chunk = 0; chunk < 64; ++chunk) {
    const size_t row0 = (size_t)b * SEQL + chunk * 64;
    {
      const bf16_t* base = pH + (row0 + tq * 16) * 2048 + h * 128 + d;
      float lf[16], kk[16], qs[16];
      unsigned vv[8];
      float run = 0.f;
#pragma unroll
      for (int i = 0; i < 16; ++i) {
        const float fr = bf2f(base[(size_t)i * 2048 + 512]);
        const float qr = bf2f(base[(size_t)i * 2048]);
        const float sg = sigmoidf_(fr);
        const float fg = lbv + (1.f - lbv) * sg;
        run += __logf(fg);
        lf[i] = run; kk[i] = 1.f - fg; qs[i] = siluf_(qr);
      }
#pragma unroll
      for (int i = 0; i < 8; ++i) {
        const unsigned lo = base[(size_t)(2 * i) * 2048 + 1024], hi = base[(size_t)(2 * i + 1) * 2048 + 1024];
        vv[i] = lo | (hi << 16);
      }
      qtot[tq * 128 + d] = run;
      __syncthreads();
      const float q0 = qtot[d], q1 = qtot[128 + d], q2 = qtot[256 + d], q3 = qtot[384 + d];
      const float pre = (tq > 0 ? q0 : 0.f) + (tq > 1 ? q1 : 0.f) + (tq > 2 ? q2 : 0.f);
      const float bref = q0 + q1;
      const float blast = bref + q2 + q3;
      unsigned kp[8];
#pragma unroll
      for (int i = 0; i < 16; ++i) {
        const float bt = pre + lf[i];
        const float qt = qs[i] * __expf(bt - bref);
        const float kt = kk[i] * __expf(bref - bt);
        const int t = tq * 16 + i;
        Qt[t * 136 + d] = f2bf(qt);
        const bf16_t kb = f2bf(kt);
        Kt[t * 136 + d] = kb;
        if (i & 1) kp[i >> 1] |= ((unsigned)kb) << 16; else kp[i >> 1] = kb;
      }
      *(uint4*)(KtT + d * 72 + tq * 16) = make_uint4(kp[0], kp[1], kp[2], kp[3]);
      *(uint4*)(KtT + d * 72 + tq * 16 + 8) = make_uint4(kp[4], kp[5], kp[6], kp[7]);
      *(uint4*)(VT + d * 72 + tq * 16) = make_uint4(vv[0], vv[1], vv[2], vv[3]);
      *(uint4*)(VT + d * 72 + tq * 16 + 8) = make_uint4(vv[4], vv[5], vv[6], vv[7]);
      if (tq == 0) { eref[d] = __expf(bref); elast[d] = __expf(blast); elr[d] = __expf(blast - bref); }
    }
    __syncthreads();
    bf16_t ogr[16];
#pragma unroll
    for (int tm = 0; tm < 4; ++tm)
#pragma unroll
      for (int j = 0; j < 4; ++j) ogr[tm * 4 + j] = pH[(row0 + tm * 16 + 4 * g + j) * 2048 + 1536 + h * 128 + 16 * w + l15];
    {
      const int e = 16 * w + l15;
#pragma unroll
      for (int dm = 0; dm < 8; ++dm) {
        const int d0 = 16 * dm + 4 * g;
        uint2 o;
        o.x = pack2(S[dm][0] * eref[d0], S[dm][1] * eref[d0 + 1]);
        o.y = pack2(S[dm][2] * eref[d0 + 2], S[dm][3] * eref[d0 + 3]);
        *(uint2*)(ST + e * 136 + d0) = o;
      }
#pragma unroll
      for (int tt = 0; tt < 2; ++tt) {
        const int tl = 2 * w + tt, sm = tl >> 2, tn = tl & 3;
        f32x4 acc = (f32x4){0.f, 0.f, 0.f, 0.f};
        if (tn >= sm) {
#pragma unroll
          for (int k0 = 0; k0 < 128; k0 += 32) {
            const bf16x8 a = *(const bf16x8*)(Kt + (sm * 16 + l15) * 136 + k0 + 8 * g);
            const bf16x8 bq = *(const bf16x8*)(Qt + (tn * 16 + l15) * 136 + k0 + 8 * g);
            acc = __builtin_amdgcn_mfma_f32_16x16x32_bf16(a, bq, acc, 0, 0, 0);
          }
        }
        const int t = tn * 16 + l15, s0 = sm * 16 + 4 * g;
        uint2 o;
        o.x = pack2(s0 + 0 <= t ? acc[0] : 0.f, s0 + 1 <= t ? acc[1] : 0.f);
        o.y = pack2(s0 + 2 <= t ? acc[2] : 0.f, s0 + 3 <= t ? acc[3] : 0.f);
        *(uint2*)(Am + t * 72 + s0) = o;
      }
    }
    __syncthreads();
    f32x4 o[4];
    {
#pragma unroll
      for (int tm = 0; tm < 4; ++tm) {
        f32x4 acc = (f32x4){0.f, 0.f, 0.f, 0.f};
#pragma unroll
        for (int k0 = 0; k0 < 128; k0 += 32) {
          const bf16x8 a = *(const bf16x8*)(Qt + (tm * 16 + l15) * 136 + k0 + 8 * g);
          const bf16x8 bb = *(const bf16x8*)(ST + (16 * w + l15) * 136 + k0 + 8 * g);
          acc = __builtin_amdgcn_mfma_f32_16x16x32_bf16(a, bb, acc, 0, 0, 0);
        }
#pragma unroll
        for (int k0 = 0; k0 < 64; k0 += 32) {
          const bf16x8 a = *(const bf16x8*)(Am + (tm * 16 + l15) * 72 + k0 + 8 * g);
          const bf16x8 bb = *(const bf16x8*)(VT + (16 * w + l15) * 72 + k0 + 8 * g);
          acc = __builtin_amdgcn_mfma_f32_16x16x32_bf16(a, bb, acc, 0, 0, 0);
        }
        o[tm] = acc;
#pragma unroll
        for (int j = 0; j < 4; ++j) {
          float ss = acc[j] * acc[j];
          ss += __shfl_xor(ss, 1); ss += __shfl_xor(ss, 2); ss += __shfl_xor(ss, 4); ss += __shfl_xor(ss, 8);
          if (l15 == 0) red[w * 64 + tm * 16 + 4 * g + j] = ss;
        }
      }
#pragma unroll
      for (int dm = 0; dm < 8; ++dm) {
        f32x4 acc = (f32x4){0.f, 0.f, 0.f, 0.f};
#pragma unroll
        for (int k0 = 0; k0 < 64; k0 += 32) {
          const bf16x8 a = *(const bf16x8*)(KtT + (dm * 16 + l15) * 72 + k0 + 8 * g);
          const bf16x8 bb = *(const bf16x8*)(VT + (16 * w + l15) * 72 + k0 + 8 * g);
          acc = __builtin_amdgcn_mfma_f32_16x16x32_bf16(a, bb, acc, 0, 0, 0);
        }
#pragma unroll
        for (int j = 0; j < 4; ++j) { const int dd = 16 * dm + 4 * g + j; S[dm][j] = elast[dd] * S[dm][j] + elr[dd] * acc[j]; }
      }
    }
    __syncthreads();
    {
      const int e = 16 * w + l15;
#pragma unroll
      for (int tm = 0; tm < 4; ++tm)
#pragma unroll
        for (int j = 0; j < 4; ++j) {
          const int t = tm * 16 + 4 * g + j;
          float tot = 0.f;
#pragma unroll
          for (int ww = 0; ww < 8; ++ww) tot += red[ww * 64 + t];
          const float rstd = rsqrtf(tot * (1.f / 128.f) + EPSV);
          const float og = bf2f(ogr[tm * 4 + j]);
          ya[(row0 + t) * 512 + h * 128 + e] = f2bf(o[tm][j] * rstd * gnv * siluf_(og));
        }
    }
  }
}


__device__ __forceinline__ void hgrn_h1_item(const Params& p, unsigned char* smem, int item) {
  unsigned char* ws = p.ws;
  bf16_t* pH = (bf16_t*)(ws + WS_PH);
  const float* lbp = (const float*)(ws + WS_LB);
  bf16_t* Qt = (bf16_t*)smem;
  bf16_t* Kt = Qt + 64 * 136;
  bf16_t* KtT = Kt + 64 * 136;
  bf16_t* VT = KtT + 128 * 72;
  bf16_t* Am = VT + 128 * 72;
  float* qtot = (float*)(Am + 64 * 72);
  const int tid = threadIdx.x, lane = tid & 63, w = tid >> 6, l15 = lane & 15, g = lane >> 4;
  const int bh = item >> 6, chunk = item & 63;
  const int b = bh >> 2, h = bh & 3;
  const int d = tid & 127, tq = tid >> 7;
  const float lbv = lbp[h * 128 + d];
  const size_t row0 = (size_t)b * SEQL + chunk * 64;
  float* dec = (float*)(ws + WS_DEC) + (size_t)item * 384;
  uint4* UU = (uint4*)p.out + (size_t)item * 2048 + tid;
  float4* OI = (float4*)((unsigned char*)p.out + ((size_t)64 << 20)) + (size_t)item * 2048 + tid;
  {
    const bf16_t* base = pH + (row0 + tq * 16) * 2048 + h * 128 + d;
    bf16_t fr_[16], qr_[16];
    unsigned vv[8];
#pragma unroll
    for (int i = 0; i < 16; ++i) { fr_[i] = base[(size_t)i * 2048 + 512]; qr_[i] = base[(size_t)i * 2048]; }
#pragma unroll
    for (int i = 0; i < 8; ++i) {
      const unsigned lo = base[(size_t)(2 * i) * 2048 + 1024], hi = base[(size_t)(2 * i + 1) * 2048 + 1024];
      vv[i] = lo | (hi << 16);
    }
    float lf[16], kk[16], qs[16];
    float run = 0.f;
#pragma unroll
    for (int i = 0; i < 16; ++i) {
      const float sg = sigmoidf_(bf2f(fr_[i]));
      const float fg = lbv + (1.f - lbv) * sg;
      run += __logf(fg);
      lf[i] = run; kk[i] = 1.f - fg; qs[i] = siluf_(bf2f(qr_[i]));
    }
    qtot[tq * 128 + d] = run;
    __syncthreads();
    const float q0 = qtot[d], q1 = qtot[128 + d], q2 = qtot[256 + d], q3 = qtot[384 + d];
    const float pre = (tq > 0 ? q0 : 0.f) + (tq > 1 ? q1 : 0.f) + (tq > 2 ? q2 : 0.f);
    const float bref = q0 + q1;
    const float blast = bref + q2 + q3;
    unsigned kp[8];
#pragma unroll
    for (int i = 0; i < 16; ++i) {
      const float bt = pre + lf[i];
      const float qt = qs[i] * __expf(bt - bref);
      const float kt = kk[i] * __expf(bref - bt);
      const int t = tq * 16 + i;
      Qt[t * 136 + d] = f2bf(qt);
      const bf16_t kb = f2bf(kt);
      Kt[t * 136 + d] = kb;
      if (i & 1) kp[i >> 1] |= ((unsigned)kb) << 16; else kp[i >> 1] = kb;
    }
    *(uint4*)(KtT + d * 72 + tq * 16) = make_uint4(kp[0], kp[1], kp[2], kp[3]);
    *(uint4*)(KtT + d * 72 + tq * 16 + 8) = make_uint4(kp[4], kp[5], kp[6], kp[7]);
    *(uint4*)(VT + d * 72 + tq * 16) = make_uint4(vv[0], vv[1], vv[2], vv[3]);
    *(uint4*)(VT + d * 72 + tq * 16 + 8) = make_uint4(vv[4], vv[5], vv[6], vv[7]);
    if (tq == 0) { dec[d] = __expf(bref); dec[128 + d] = __expf(blast); dec[256 + d] = __expf(blast - bref); }
  }
  __syncthreads();
  {
#pragma unroll
    for (int i = 0; i < 2; ++i) {
      const int idx = tid + 512 * i, r = idx >> 4, c = idx & 15;
      *(uint4*)(pH + (row0 + r) * 2048 + h * 128 + c * 8) = *(const uint4*)(Qt + r * 136 + c * 8);
    }
#pragma unroll
    for (int tt = 0; tt < 2; ++tt) {
      const int tl = 2 * w + tt, sm = tl >> 2, tn = tl & 3;
      f32x4 acc = (f32x4){0.f, 0.f, 0.f, 0.f};
      if (tn >= sm) {
#pragma unroll
        for (int k0 = 0; k0 < 128; k0 += 32) {
          const bf16x8 a = *(const bf16x8*)(Kt + (sm * 16 + l15) * 136 + k0 + 8 * g);
          const bf16x8 bq = *(const bf16x8*)(Qt + (tn * 16 + l15) * 136 + k0 + 8 * g);
          acc = __builtin_amdgcn_mfma_f32_16x16x32_bf16(a, bq, acc, 0, 0, 0);
        }
      }
      const int t = tn * 16 + l15, s0 = sm * 16 + 4 * g;
      uint2 o;
      o.x = pack2(s0 + 0 <= t ? acc[0] : 0.f, s0 + 1 <= t ? acc[1] : 0.f);
      o.y = pack2(s0 + 2 <= t ? acc[2] : 0.f, s0 + 3 <= t ? acc[3] : 0.f);
      *(uint2*)(Am + t * 72 + s0) = o;
    }
  }
  __syncthreads();
  {
#pragma unroll
    for (int tm = 0; tm < 4; ++tm) {
      f32x4 acc = (f32x4){0.f, 0.f, 0.f, 0.f};
#pragma unroll
      for (int k0 = 0; k0 < 64; k0 += 32) {
        const bf16x8 a = *(const bf16x8*)(Am + (tm * 16 + l15) * 72 + k0 + 8 * g);
        const bf16x8 bb = *(const bf16x8*)(VT + (16 * w + l15) * 72 + k0 + 8 * g);
        acc = __builtin_amdgcn_mfma_f32_16x16x32_bf16(a, bb, acc, 0, 0, 0);
      }
      OI[tm * 512] = make_float4(acc[0], acc[1], acc[2], acc[3]);
    }
#pragma unroll
    for (int dp = 0; dp < 4; ++dp) {
      unsigned pk[4];
#pragma unroll
      for (int hh = 0; hh < 2; ++hh) {
        const int dm = dp * 2 + hh;
        f32x4 acc = (f32x4){0.f, 0.f, 0.f, 0.f};
#pragma unroll
        for (int k0 = 0; k0 < 64; k0 += 32) {
          const bf16x8 a = *(const bf16x8*)(KtT + (dm * 16 + l15) * 72 + k0 + 8 * g);
          const bf16x8 bb = *(const bf16x8*)(VT + (16 * w + l15) * 72 + k0 + 8 * g);
          acc = __builtin_amdgcn_mfma_f32_16x16x32_bf16(a, bb, acc, 0, 0, 0);
        }
        pk[hh * 2] = pack2(acc[0], acc[1]); pk[hh * 2 + 1] = pack2(acc[2], acc[3]);
      }
      UU[dp * 512] = make_uint4(pk[0], pk[1], pk[2], pk[3]);
    }
  }
  __syncthreads();
}

__device__ __forceinline__ void hgrn_h2(const Params& p, unsigned char* smem, int bh) {
  unsigned char* ws = p.ws;
  const bf16_t* pH = (const bf16_t*)(ws + WS_PH);
  bf16_t* ya = (bf16_t*)(ws + WS_XN);
  bf16_t* Qt = (bf16_t*)smem;
  bf16_t* ST = Qt + 64 * 136;
  float* decl = (float*)(ST + 128 * 136);
  float* red = decl + 384;
  const int tid = threadIdx.x, lane = tid & 63, w = tid >> 6, l15 = lane & 15, g = lane >> 4;
  const int b = bh >> 2, h = bh & 3;
  f32x4 S[8];
#pragma unroll
  for (int i = 0; i < 8; ++i) S[i] = (f32x4){0.f, 0.f, 0.f, 0.f};
  const float gnv = p.hg_norm[h * 128 + 16 * w + l15];
  const int e = 16 * w + l15;
  uint4 uu0, uu1, uu2, uu3; float4 oi0, oi1, oi2, oi3; uint4 qraw0, qraw1; bf16_t ogr[16]; float dcv = 0.f;
#define H2_LOAD(CH) do { \
    const int item_ = bh * 64 + (CH); \
    const size_t row0_ = (size_t)b * SEQL + (size_t)(CH) * 64; \
    const uint4* UUp = (const uint4*)p.out + (size_t)item_ * 2048 + tid; \
    const float4* OIp = (const float4*)((const unsigned char*)p.out + ((size_t)64 << 20)) + (size_t)item_ * 2048 + tid; \
    uu0 = UUp[0]; uu1 = UUp[512]; uu2 = UUp[1024]; uu3 = UUp[1536]; oi0 = OIp[0]; oi1 = OIp[512]; oi2 = OIp[1024]; oi3 = OIp[1536]; \
    qraw0 = *(const uint4*)(pH + (row0_ + (tid >> 4)) * 2048 + h * 128 + (tid & 15) * 8); \
    qraw1 = *(const uint4*)(pH + (row0_ + 32 + (tid >> 4)) * 2048 + h * 128 + (tid & 15) * 8); \
    _Pragma("unroll") for (int tm = 0; tm < 4; ++tm) _Pragma("unroll") for (int j = 0; j < 4; ++j) \
      ogr[tm * 4 + j] = pH[(row0_ + tm * 16 + 4 * g + j) * 2048 + 1536 + h * 128 + e]; \
    if (tid < 384) dcv = ((const float*)(ws + WS_DEC))[(size_t)item_ * 384 + tid]; \
  } while (0)
  H2_LOAD(0);
  for (int chunk = 0; chunk < 64; ++chunk) {
    const size_t row0 = (size_t)b * SEQL + chunk * 64;
    const uint4 cu[4] = {uu0, uu1, uu2, uu3}; const float4 co[4] = {oi0, oi1, oi2, oi3}; bf16_t cog[16];
#pragma unroll
    for (int i = 0; i < 16; ++i) cog[i] = ogr[i];
    *(uint4*)(Qt + (tid >> 4) * 136 + (tid & 15) * 8) = qraw0;
    *(uint4*)(Qt + (32 + (tid >> 4)) * 136 + (tid & 15) * 8) = qraw1;
    if (tid < 384) decl[tid] = dcv;
    __syncthreads();
    if (chunk + 1 < 64) H2_LOAD(chunk + 1);
#pragma unroll
    for (int dm = 0; dm < 8; ++dm) {
      const int d0 = 16 * dm + 4 * g;
      uint2 o;
      o.x = pack2(S[dm][0] * decl[d0], S[dm][1] * decl[d0 + 1]);
      o.y = pack2(S[dm][2] * decl[d0 + 2], S[dm][3] * decl[d0 + 3]);
      *(uint2*)(ST + e * 136 + d0) = o;
    }
    __syncthreads();
    f32x4 o[4];
#pragma unroll
    for (int tm = 0; tm < 4; ++tm) {
      f32x4 acc = (f32x4){co[tm].x, co[tm].y, co[tm].z, co[tm].w};
#pragma unroll
      for (int k0 = 0; k0 < 128; k0 += 32) {
        const bf16x8 a = *(const bf16x8*)(Qt + (tm * 16 + l15) * 136 + k0 + 8 * g);
        const bf16x8 bb = *(const bf16x8*)(ST + (16 * w + l15) * 136 + k0 + 8 * g);
        acc = __builtin_amdgcn_mfma_f32_16x16x32_bf16(a, bb, acc, 0, 0, 0);
      }
      o[tm] = acc;
#pragma unroll
      for (int j = 0; j < 4; ++j) {
        float ss = acc[j] * acc[j];
        ss += __shfl_xor(ss, 1); ss += __shfl_xor(ss, 2); ss += __shfl_xor(ss, 4); ss += __shfl_xor(ss, 8);
        if (l15 == 0) red[w * 64 + tm * 16 + 4 * g + j] = ss;
      }
    }
#pragma unroll
    for (int dm = 0; dm < 8; ++dm) {
      const unsigned u01 = (dm & 1) ? cu[dm >> 1].z : cu[dm >> 1].x, u23 = (dm & 1) ? cu[dm >> 1].w : cu[dm >> 1].y;
      const float uv[4] = {__uint_as_float(u01 << 16), __uint_as_float(u01 & 0xffff0000u), __uint_as_float(u23 << 16), __uint_as_float(u23 & 0xffff0000u)};
#pragma unroll
      for (int j = 0; j < 4; ++j) { const int dd = 16 * dm + 4 * g + j; S[dm][j] = decl[128 + dd] * S[dm][j] + decl[256 + dd] * uv[j]; }
    }
    __syncthreads();
#pragma unroll
    for (int tm = 0; tm < 4; ++tm)
#pragma unroll
      for (int j = 0; j < 4; ++j) {
        const int t = tm * 16 + 4 * g + j;
        float tot = 0.f;
#pragma unroll
        for (int ww = 0; ww < 8; ++ww) tot += red[ww * 64 + t];
        const float rstd = rsqrtf(tot * (1.f / 128.f) + EPSV);
        ya[(row0 + t) * 512 + h * 128 + e] = f2bf(o[tm][j] * rstd * gnv * siluf_(bf2f(cog[tm * 4 + j])));
      }
  }
#undef H2_LOAD
}

#define SCW 4100
#ifndef DSA_REP
#define DSA_REP 0
#endif
#define DSA_BKT_OFF (8 * SCW * 4 + 8 * 256 * 4 + 8 * 256 * 2 + 8 * 512 * 2)
__device__ __forceinline__ void cvt8(const uint4& v, float* f) {
  f[0] = __uint_as_float(v.x << 16); f[1] = __uint_as_float(v.x & 0xffff0000u);
  f[2] = __uint_as_float(v.y << 16); f[3] = __uint_as_float(v.y & 0xffff0000u);
  f[4] = __uint_as_float(v.z << 16); f[5] = __uint_as_float(v.z & 0xffff0000u);
  f[6] = __uint_as_float(v.w << 16); f[7] = __uint_as_float(v.w & 0xffff0000u);
}
__device__ __forceinline__ unsigned sortable_key(float v) {
  unsigned bits = __float_as_uint(v);
  if (bits == 0x80000000u) bits = 0u;
  return (bits & 0x80000000u) ? ~bits : (bits | 0x80000000u);
}

__device__ __forceinline__ void dsa_item(const Params& p, unsigned char* smem, int item) {
  unsigned char* ws = p.ws;
  const bf16_t* pA = (const bf16_t*)(ws + WS_PA);
  bf16_t* yb = (bf16_t*)(ws + WS_XN) + (size_t)TOK * 512;
  unsigned* sc = (unsigned*)smem;
  unsigned* hist = sc + 8 * SCW;
  unsigned short* sel = (unsigned short*)(hist + 8 * 256);
  unsigned short* cand = sel + 8 * 256;
  unsigned char* bkt = (unsigned char*)(cand + 8 * 512);
  unsigned* rmm = (unsigned*)(bkt + 128 + 1024);
  const int tid = threadIdx.x, lane = tid & 63, w = tid >> 6, l15 = lane & 15, g = lane >> 4;
  const int b = item >> 9;
  const int tb = item & 511;
  const int t0 = tb * 8;
  const size_t tokbase = (size_t)b * SEQL;

  for (int rep_s = 0; rep_s < (DSA_REP == 1 ? 2 : 1); ++rep_s) {
    bf16x8 af[2][2];
    float wq[2][4];
#pragma unroll
    for (int mt = 0; mt < 2; ++mt) {
      const int qrow = t0 + mt * 4 + (l15 >> 2), head = l15 & 3;
#pragma unroll
      for (int ks = 0; ks < 2; ++ks)
        af[mt][ks] = *(const bf16x8*)(pA + (tokbase + qrow) * 1024 + 640 + head * 64 + ks * 32 + 8 * g);
      const uint2 wr = *(const uint2*)(pA + (tokbase + t0 + mt * 4 + g) * 1024 + 960);
      wq[mt][0] = 0.5f * bf2f((bf16_t)(wr.x & 0xffff)); wq[mt][1] = 0.5f * bf2f((bf16_t)(wr.x >> 16));
      wq[mt][2] = 0.5f * bf2f((bf16_t)(wr.y & 0xffff)); wq[mt][3] = 0.5f * bf2f((bf16_t)(wr.y >> 16));
    }
    const int nkt = (t0 + 8 + 15) >> 4;
    unsigned kmin[2] = {0xFFFFFFFFu, 0xFFFFFFFFu}, kmax[2] = {0u, 0u};
    for (int kt0 = w; kt0 < nkt; kt0 += 64) {
      bf16x8 b0[8], b1[8];
#pragma unroll
      for (int u = 0; u < 8; ++u) {
        const int kt = kt0 + 8 * u;
        const int s = (kt < nkt ? kt : 0) * 16 + l15;
        const bf16_t* kr = pA + (tokbase + s) * 1024 + 896 + 8 * g;
        b0[u] = *(const bf16x8*)kr;
        b1[u] = *(const bf16x8*)(kr + 32);
      }
      __builtin_amdgcn_sched_barrier(0);
#pragma unroll
      for (int u = 0; u < 8; ++u) {
        const int kt = kt0 + 8 * u;
        if (kt < nkt) {
          const int s = kt * 16 + l15;
#pragma unroll
          for (int mt = 0; mt < 2; ++mt) {
            f32x4 acc = (f32x4){0.f, 0.f, 0.f, 0.f};
            acc = __builtin_amdgcn_mfma_f32_16x16x32_bf16(af[mt][0], b0[u], acc, 0, 0, 0);
            acc = __builtin_amdgcn_mfma_f32_16x16x32_bf16(af[mt][1], b1[u], acc, 0, 0, 0);
            float v = 0.f;
#pragma unroll
            for (int j = 0; j < 4; ++j) v += wq[mt][j] * fmaxf(acc[j] * 0.125f, 0.f);
            const int t = t0 + mt * 4 + g;
            unsigned vb = __float_as_uint(v); if (vb == 0x80000000u) vb = 0u;
            sc[(mt * 4 + g) * SCW + s] = vb;
            if (s <= t) {
              const unsigned key = (vb & 0x80000000u) ? ~vb : (vb | 0x80000000u);
              kmin[mt] = key < kmin[mt] ? key : kmin[mt];
              kmax[mt] = key > kmax[mt] ? key : kmax[mt];
            }
          }
        }
      }
    }
#pragma unroll
    for (int mt = 0; mt < 2; ++mt) {
      unsigned a = kmin[mt], bmx = kmax[mt];
#define DPP_MINMAX(CTRL) do { const unsigned a2 = (unsigned)__builtin_amdgcn_update_dpp((int)a, (int)a, CTRL, 0xf, 0xf, false); \
                               const unsigned b2 = (unsigned)__builtin_amdgcn_update_dpp((int)bmx, (int)bmx, CTRL, 0xf, 0xf, false); \
                               a = a2 < a ? a2 : a; bmx = b2 > bmx ? b2 : bmx; } while (0)
      DPP_MINMAX(0xB1); DPP_MINMAX(0x4E); DPP_MINMAX(0x141); DPP_MINMAX(0x140);
#undef DPP_MINMAX
      if (l15 == 0) { atomicMin(&rmm[mt * 4 + g], a); atomicMax(&rmm[8 + mt * 4 + g], bmx); }
    }
  }
  __syncthreads();
  const int t = t0 + w;
  const int n = t + 1;
  unsigned* row = sc + w * SCW;
  const float* rowf = (const float*)row;
  unsigned short* mysel = sel + w * 256;
  unsigned short* mycand = cand + w * 512;
  unsigned* myh = hist + w * 256;
  int cnt;
  const unsigned long long lt_mask = (1ull << lane) - 1ull;
  for (int rep_t = 0; rep_t < (DSA_REP == 2 ? 2 : 1); ++rep_t)
  if (n <= 256) {
    for (int i = lane; i < n; i += 64) mysel[i] = (unsigned short)i;
    cnt = n;
  } else {
    cnt = 256;
    float mn, mx;
    {
      const unsigned kmn = rmm[w], kmx = rmm[8 + w];
      mn = __uint_as_float((kmn & 0x80000000u) ? (kmn ^ 0x80000000u) : ~kmn);
      mx = __uint_as_float((kmx & 0x80000000u) ? (kmx ^ 0x80000000u) : ~kmx);
    }
    const float scale = (mx > mn) ? 255.99f / (mx - mn) : 0.f;
#pragma unroll
    for (int i = 0; i < 4; ++i) myh[lane + 64 * i] = 0u;
    lds_fence();
    for (int i0 = lane; i0 < n; i0 += 256) {
      float v4[4];
#pragma unroll
      for (int k = 0; k < 4; ++k) v4[k] = (i0 + 64 * k < n) ? rowf[i0 + 64 * k] : 0.f;
#pragma unroll
      for (int k = 0; k < 4; ++k) {
        if (i0 + 64 * k < n) {
          int bn = (int)((v4[k] - mn) * scale); bn = bn > 255 ? 255 : bn;
          atomicAdd(&myh[bn], 1u);
        }
      }
    }
    lds_fence();
    unsigned cum; int bstar; unsigned mcount;
    {
      const uint4 c4 = *(const uint4*)(myh + 4 * lane);
      const unsigned c = c4.x + c4.y + c4.z + c4.w;
      unsigned sfx = c;
#pragma unroll
      for (int o = 1; o < 64; o <<= 1) { const unsigned tt = __shfl_down(sfx, o); if (lane + o < 64) sfx += tt; }
      const unsigned long long bal = __ballot(sfx >= 256u);
      const int L = 63 - __clzll(bal);
      const unsigned sL = __shfl(sfx, L), cL = __shfl(c, L);
      const unsigned b3 = __shfl(c4.w, L), b2 = __shfl(c4.z, L), b1 = __shfl(c4.y, L), b0 = __shfl(c4.x, L);
      cum = sL - cL;
      int digit;
      if (cum + b3 >= 256u) { digit = 3; mcount = b3; }
      else { cum += b3; if (cum + b2 >= 256u) { digit = 2; mcount = b2; } else { cum += b2; if (cum + b1 >= 256u) { digit = 1; mcount = b1; } else { cum += b1; digit = 0; mcount = b0; } } }
      bstar = 4 * L + digit;
    }
    const unsigned need = 256u - cum;
    if (mcount <= 512u) {
      unsigned base = 0u, cb = 0u;
      for (int i0 = 0; i0 < n; i0 += 256) {
        float v4[4];
#pragma unroll
        for (int k = 0; k < 4; ++k) { const int i = i0 + 64 * k + lane; v4[k] = (i < n) ? rowf[i] : 0.f; }
#pragma unroll
        for (int k = 0; k < 4; ++k) {
          const int i = i0 + 64 * k + lane;
          const bool valid = i < n;
          int bn = (int)((v4[k] - mn) * scale); bn = bn > 255 ? 255 : bn;
          const bool gt = valid && (bn > bstar);
          const bool eq = valid && (bn == bstar);
          const unsigned long long bg = __ballot(gt), be = __ballot(eq);
          if (gt) mysel[base + (unsigned)__popcll(bg & lt_mask)] = (unsigned short)i;
          if (eq) mycand[cb + (unsigned)__popcll(be & lt_mask)] = (unsigned short)i;
          base += (unsigned)__popcll(bg); cb += (unsigned)__popcll(be);
        }
      }
      lds_fence();
      const int m = (int)mcount;
      unsigned ck[8]; unsigned short ci[8];
#pragma unroll
      for (int q = 0; q < 8; ++q) {
        const int c = q * 64 + lane;
        ck[q] = 0u; ci[q] = 0;
        if (c < m) { ci[q] = mycand[c]; ck[q] = sortable_key(rowf[ci[q]]); }
      }
      unsigned T = 0u;
      if (m <= 64) {
#pragma unroll 1
        for (int bit = 31; bit >= 0; --bit) {
          const unsigned trial = T | (1u << bit);
          if ((unsigned)__popcll(__ballot(ck[0] >= trial)) >= need) T = trial;
        }
      } else {
#pragma unroll 1
        for (int bit = 31; bit >= 0; --bit) {
          const unsigned trial = T | (1u << bit);
          unsigned cge = 0u;
#pragma unroll
          for (int q = 0; q < 8; ++q) cge += (unsigned)__popcll(__ballot(ck[q] >= trial));
          if (cge >= need) T = trial;
        }
      }
      unsigned cgt = 0u;
#pragma unroll
      for (int q = 0; q < 8; ++q) cgt += (unsigned)__popcll(__ballot(ck[q] > T));
      const unsigned need_eq = need - cgt;
      unsigned pos0 = cum, eqtaken = 0u;
#pragma unroll
      for (int q = 0; q < 8; ++q) {
        const bool gt = ck[q] > T;
        const bool eq = ck[q] == T;
        const unsigned long long beq = __ballot(eq);
        const bool take = gt || (eq && (eqtaken + (unsigned)__popcll(beq & lt_mask)) < need_eq);
        const unsigned long long bt = __ballot(take);
        const unsigned pp = pos0 + (unsigned)__popcll(bt & lt_mask);
        if (take && pp < 256u) mysel[pp] = ci[q];
        pos0 += (unsigned)__popcll(bt);
        eqtaken += (unsigned)__popcll(beq);
      }
    } else {
      unsigned prefix = 0u, krem = 256u;
#pragma unroll 1
      for (int pass = 0; pass < 4; ++pass) {
        const int shift = 24 - 8 * pass;
        const unsigned himask = (pass == 0) ? 0u : (0xFFFFFFFFu << (shift + 8));
#pragma unroll
        for (int i = 0; i < 4; ++i) myh[lane + 64 * i] = 0u;
        lds_fence();
        for (int i = lane; i < n; i += 64) {
          const unsigned u = sortable_key(rowf[i]);
          if ((u & himask) == prefix) atomicAdd(&myh[(u >> shift) & 255u], 1u);
        }
        lds_fence();
        const uint4 c4 = *(const uint4*)(myh + 4 * lane);
        const unsigned c = c4.x + c4.y + c4.z + c4.w;
        unsigned sfx = c;
#pragma unroll
        for (int o = 1; o < 64; o <<= 1) { const unsigned tt = __shfl_down(sfx, o); if (lane + o < 64) sfx += tt; }
        const unsigned long long bal = __ballot(sfx >= krem);
        const int L = 63 - __clzll(bal);
        const unsigned sL = __shfl(sfx, L), cL = __shfl(c, L);
        const unsigned b3 = __shfl(c4.w, L), b2 = __shfl(c4.z, L), b1 = __shfl(c4.y, L);
        unsigned cum2 = sL - cL;
        unsigned digit;
        if (cum2 + b3 >= krem) digit = 3;
        else { cum2 += b3; if (cum2 + b2 >= krem) digit = 2; else { cum2 += b2; if (cum2 + b1 >= krem) digit = 1; else { cum2 += b1; digit = 0; } } }
        krem -= cum2;
        prefix |= ((unsigned)(4 * L) + digit) << shift;
      }
      const unsigned T = prefix;
      unsigned base = 0u, eqtaken = 0u;
      for (int i0 = 0; i0 < n; i0 += 64) {
        const int i = i0 + lane;
        const bool valid = i < n;
        const unsigned u = valid ? sortable_key(rowf[i]) : 0u;
        const bool gt = valid && (u > T);
        const bool eq = valid && (u == T);
        const unsigned long long beq = __ballot(eq);
        const unsigned eqrank = eqtaken + (unsigned)__popcll(beq & lt_mask);
        const bool take = gt || (eq && eqrank < krem);
        const unsigned long long bt = __ballot(take);
        const unsigned pos = base + (unsigned)__popcll(bt & lt_mask);
        if (take && pos < 256u) mysel[pos] = (unsigned short)i;
        base += (unsigned)__popcll(bt);
        eqtaken += (unsigned)__popcll(beq);
      }
    }
  }
  lds_fence();
  if (lane == 0) { rmm[w] = 0xFFFFFFFFu; rmm[8 + w] = 0u; }
  {
    int lane_a = lane;
    asm volatile("" : "+v"(lane_a));
    const int l15 = lane_a & 15, g = lane_a >> 4;
    const int ks = lane_a >> 3, dc = lane_a & 7;
    float* pl = (float*)row;
    const float* relb = (const float*)(bkt + 128);
    const int niter = (cnt + 7) >> 3;
    bf16x8 bq0 = (bf16x8){0, 0, 0, 0, 0, 0, 0, 0}, bq1 = bq0;
    if (l15 < 8) {
      bq0 = *(const bf16x8*)(pA + (tokbase + t) * 1024 + l15 * 64 + 8 * g);
      bq1 = *(const bf16x8*)(pA + (tokbase + t) * 1024 + l15 * 64 + 32 + 8 * g);
    }
    float lg[16][4];
    {
      bf16x8 ka[8][2], kb[8][2];
#pragma unroll
      for (int u = 0; u < 8; ++u) {
        const int kk = u * 16 + l15;
        const int s = (kk < cnt) ? (int)mysel[kk] : 0;
        const bf16_t* kr = pA + (tokbase + s) * 1024 + 512 + 8 * g;
        ka[u][0] = *(const bf16x8*)kr;
        ka[u][1] = *(const bf16x8*)(kr + 32);
      }
#pragma unroll
      for (int u = 0; u < 8; ++u) {
        const int kk = (8 + u) * 16 + l15;
        const int s = (kk < cnt) ? (int)mysel[kk] : 0;
        const bf16_t* kr = pA + (tokbase + s) * 1024 + 512 + 8 * g;
        kb[u][0] = *(const bf16x8*)kr;
        kb[u][1] = *(const bf16x8*)(kr + 32);
      }
      __builtin_amdgcn_sched_barrier(0);
#pragma unroll
      for (int u = 0; u < 8; ++u) {
        f32x4 acc = (f32x4){0.f, 0.f, 0.f, 0.f};
        acc = __builtin_amdgcn_mfma_f32_16x16x32_bf16(ka[u][0], bq0, acc, 0, 0, 0);
        acc = __builtin_amdgcn_mfma_f32_16x16x32_bf16(ka[u][1], bq1, acc, 0, 0, 0);
        lg[u][0] = acc[0]; lg[u][1] = acc[1]; lg[u][2] = acc[2]; lg[u][3] = acc[3];
      }
#pragma unroll
      for (int u = 0; u < 8; ++u) {
        f32x4 acc = (f32x4){0.f, 0.f, 0.f, 0.f};
        acc = __builtin_amdgcn_mfma_f32_16x16x32_bf16(kb[u][0], bq0, acc, 0, 0, 0);
        acc = __builtin_amdgcn_mfma_f32_16x16x32_bf16(kb[u][1], bq1, acc, 0, 0, 0);
        lg[8 + u][0] = acc[0]; lg[8 + u][1] = acc[1]; lg[8 + u][2] = acc[2]; lg[8 + u][3] = acc[3];
      }
    }
    typedef unsigned u32x4_t __attribute__((ext_vector_type(4)));
    u32x4_t va[16];
#pragma unroll
    for (int u = 0; u < 16; ++u) {
      const int kk = u * 8 + ks;
      const int s = (kk < cnt) ? (int)mysel[kk] : 0;
      va[u] = *(const u32x4_t*)(pA + (tokbase + s) * 1024 + 576 + dc * 8);
    }
    __builtin_amdgcn_sched_barrier(0);
    const int hsel = l15 & 7;
    float m = -INFINITY;
#pragma unroll
    for (int u = 0; u < 16; ++u) {
      const uint2 s4 = *(const uint2*)(mysel + u * 16 + 4 * g);
      const int sj[4] = {(int)(s4.x & 0xffffu), (int)(s4.x >> 16), (int)(s4.y & 0xffffu), (int)(s4.y >> 16)};
#pragma unroll
      for (int j = 0; j < 4; ++j) {
        const int key = u * 16 + 4 * g + j;
        const bool valid = key < cnt;
        const int dist = valid ? t - sj[j] : 0;
        const int bk = dist < 128 ? (int)bkt[dist] : 31;
        lg[u][j] = valid ? (lg[u][j] * 0.125f + relb[bk * 8 + hsel]) : -INFINITY;
        m = fmaxf(m, lg[u][j]);
      }
    }
    m = max_xor16(m); m = max_xor32(m);
    float sum = 0.f;
#pragma unroll
    for (int u = 0; u < 16; ++u)
#pragma unroll
      for (int j = 0; j < 4; ++j) { lg[u][j] = __expf(lg[u][j] - m); sum += lg[u][j]; }
    sum = add_xor16(sum); sum = add_xor32(sum);
    const float inv = 1.f / sum;
    bf16x8 pa[8];
#pragma unroll
    for (int s8 = 0; s8 < 8; ++s8) {
      const unsigned w0 = pack2(lg[2 * s8][0] * inv, lg[2 * s8][1] * inv), w1 = pack2(lg[2 * s8][2] * inv, lg[2 * s8][3] * inv);
      const unsigned w2 = pack2(lg[2 * s8 + 1][0] * inv, lg[2 * s8 + 1][1] * inv), w3 = pack2(lg[2 * s8 + 1][2] * inv, lg[2 * s8 + 1][3] * inv);
      const u32x4_t wv = {w0, w1, w2, w3};
      pa[s8] = __builtin_bit_cast(bf16x8, wv);
    }
    unsigned char* vs_l = (unsigned char*)row;
#pragma unroll
    for (int u = 0; u < 16; ++u) *(u32x4_t*)(vs_l + (u * 8 + ks) * 128 + dc * 16) = va[u];
    lds_fence();
    u32x4_t vb[16];
#pragma unroll
    for (int u = 0; u < 16; ++u) {
      const int kk = (16 + u) * 8 + ks;
      const int s = (kk < cnt) ? (int)mysel[kk] : 0;
      vb[u] = *(const u32x4_t*)(pA + (tokbase + s) * 1024 + 576 + dc * 8);
    }
    __builtin_amdgcn_sched_barrier(0);
    f32x4 ov[4];
#pragma unroll
    for (int nt = 0; nt < 4; ++nt) ov[nt] = (f32x4){0.f, 0.f, 0.f, 0.f};
    typedef short v4s_t __attribute__((ext_vector_type(4)));
    const unsigned tr_lane = (unsigned)((l15 >> 2) * 128 + (l15 & 3) * 8);
#define PV_HALF(S0) do { \
      _Pragma("unroll") for (int s4_ = 0; s4_ < 4; ++s4_) { \
        _Pragma("unroll") for (int nt = 0; nt < 4; ++nt) { \
          const unsigned a0 = (unsigned)((s4_ * 32 + 4 * g) * 128 + nt * 32) + tr_lane; \
          const v4s_t b0 = __builtin_amdgcn_ds_read_tr16_b64_v4i16((__attribute__((address_space(3))) v4s_t*)(vs_l + a0)); \
          const v4s_t b1 = __builtin_amdgcn_ds_read_tr16_b64_v4i16((__attribute__((address_space(3))) v4s_t*)(vs_l + a0 + 16 * 128)); \
          const bf16x8 bb = (bf16x8){b0[0], b0[1], b0[2], b0[3], b1[0], b1[1], b1[2], b1[3]}; \
          ov[nt] = __builtin_amdgcn_mfma_f32_16x16x32_bf16(pa[(S0) + s4_], bb, ov[nt], 0, 0, 0); \
        } \
      } \
    } while (0)
    PV_HALF(0);
    lds_fence();
#pragma unroll
    for (int u = 0; u < 16; ++u) *(u32x4_t*)(vs_l + (u * 8 + ks) * 128 + dc * 16) = vb[u];
    lds_fence();
    PV_HALF(4);
#undef PV_HALF
    if (g < 2) {
#pragma unroll
      for (int nt = 0; nt < 4; ++nt)
#pragma unroll
        for (int j = 0; j < 4; ++j) yb[(tokbase + t) * 512 + (4 * g + j) * 64 + nt * 16 + l15] = f2bf(ov[nt][j]);
    }
    lds_fence();
  }
  __syncthreads();
}

__device__ __forceinline__ void phase_mix(const Params& p, unsigned char* smem, int mode = 0) {
  const int G = gridDim.x;
  if (mode != 2) { for (int bh = blockIdx.x; bh < 32; bh += G) { hgrn_h2(p, smem, bh); __syncthreads(); } }
  if (mode == 1) return;
  unsigned char* bkt = smem + DSA_BKT_OFF;
  volatile int* qslot = (volatile int*)(smem + LDS_BYTES - 32);
  unsigned* qctr = (unsigned*)(p.ws + WS_QCTR);
  if (threadIdx.x < 128) {
    const int nn = threadIdx.x;
    int v = nn;
    if (nn >= 16) { v = 16 + (int)(logf((float)nn * (1.f / 16.f)) / logf(8.f) * 16.f); if (v > 31) v = 31; }
    bkt[nn] = (unsigned char)v;
  }
  if (threadIdx.x >= 256) ((float*)(bkt + 128))[threadIdx.x - 256] = p.rel_bias[threadIdx.x - 256];
  if (threadIdx.x < 16) ((unsigned*)(bkt + 128 + 1024))[threadIdx.x] = threadIdx.x < 8 ? 0xFFFFFFFFu : 0u;
  if (threadIdx.x == 0) qslot[0] = (int)__hip_atomic_fetch_add(qctr, 1u, __ATOMIC_RELAXED, __HIP_MEMORY_SCOPE_AGENT);
  __syncthreads();
  int k = qslot[0];
  int par = 1;
  while (k < 4096) {
    if (threadIdx.x == 0) qslot[par] = (int)__hip_atomic_fetch_add(qctr, 1u, __ATOMIC_RELAXED, __HIP_MEMORY_SCOPE_AGENT);
    const int item = ((k & 7) << 9) | (511 - (k >> 3));
    dsa_item(p, smem, item);
    k = qslot[par];
    par ^= 1;
  }
}

__device__ __forceinline__ void phase_up(const Params& p, unsigned char* smem) {
  unsigned char* ws = p.ws;
  const bf16_t* ya = (const bf16_t*)(ws + WS_XN);
  const bf16_t* yb = ya + (size_t)TOK * 512;
  const bf16_t* wa = (const bf16_t*)(ws + WS_WUPA);
  const bf16_t* wb = (const bf16_t*)(ws + WS_WUPB);
  const bf16_t* pG = (const bf16_t*)(ws + WS_PG);
  bf16_t* hb = (bf16_t*)(ws + WS_PH);
  const int tid = threadIdx.x, lane = tid & 63, w = tid >> 6, wm = w >> 1, wn = w & 1, l15 = lane & 15, g = lane >> 4;
  for (int tile = blockIdx.x; tile < 128 * 8; tile += gridDim.x) {
    const int tn = tile & 7, tm = tile >> 3;
    f32x4 acc[4][4]; zero_acc(acc);
    gemm_tile(ya + (size_t)tm * 256 * 512, 512, wa + (size_t)tn * 128 * 512, 512, 8, acc, smem);
    asm volatile("" ::: "memory");
    const int rbase = tm * 256 + wm * 64 + 4 * g;
    const int cbase = tn * 128 + wn * 64 + l15;
#pragma unroll
    for (int m = 0; m < 4; ++m) {
      bf16_t gt[16];
#pragma unroll
      for (int n = 0; n < 4; ++n)
#pragma unroll
        for (int j = 0; j < 4; ++j) gt[n * 4 + j] = pG[(size_t)(rbase + m * 16 + j) * 2048 + cbase + n * 16];
#pragma unroll
      for (int n = 0; n < 4; ++n) {
#pragma unroll
        for (int j = 0; j < 4; ++j) {
          const size_t rr = (size_t)(rbase + m * 16 + j);
          hb[rr * 1024 + cbase + n * 16] = f2bf(acc[m][n][j] * bf2f(gt[n * 4 + j]));
        }
        acc[m][n] = (f32x4){0.f, 0.f, 0.f, 0.f};
      }
    }
    asm volatile("" ::: "memory");
    gemm_tile(yb + (size_t)tm * 256 * 512, 512, wb + (size_t)tn * 128 * 512, 512, 8, acc, smem);
    asm volatile("" ::: "memory");
#pragma unroll
    for (int m = 0; m < 4; ++m) {
      bf16_t gt[16], ht[16];
#pragma unroll
      for (int n = 0; n < 4; ++n)
#pragma unroll
        for (int j = 0; j < 4; ++j) {
          const size_t rr = (size_t)(rbase + m * 16 + j);
          gt[n * 4 + j] = pG[rr * 2048 + 1024 + cbase + n * 16];
          ht[n * 4 + j] = hb[rr * 1024 + cbase + n * 16];
        }
#pragma unroll
      for (int n = 0; n < 4; ++n)
#pragma unroll
        for (int j = 0; j < 4; ++j) {
          const size_t rr = (size_t)(rbase + m * 16 + j);
          hb[rr * 1024 + cbase + n * 16] = f2bf(bf2f(ht[n * 4 + j]) + acc[m][n][j] * bf2f(gt[n * 4 + j]));
        }
    }
  }
}

__device__ __forceinline__ void phase_out(const Params& p, unsigned char* smem) {
  unsigned char* ws = p.ws;
  const bf16_t* hb = (const bf16_t*)(ws + WS_PH);
  const bf16_t* wo = (const bf16_t*)(ws + WS_WOUT);
  const int tid = threadIdx.x, lane = tid & 63, w = tid >> 6, wm = w >> 1, wn = w & 1, l15 = lane & 15, g = lane >> 4;
  for (int tile = blockIdx.x; tile < 128 * 8; tile += gridDim.x) {
    const int tn = tile & 7, tm = tile >> 3;
    f32x4 acc[4][4]; zero_acc(acc);
    gemm_tile(hb + (size_t)tm * 256 * 1024, 1024, wo + (size_t)tn * 128 * 1024, 1024, 16, acc, smem);
    const int rbase = tm * 256 + wm * 64 + 4 * g;
    const int cbase = tn * 128 + wn * 64 + l15;
#pragma unroll
    for (int m = 0; m < 4; ++m) {
      float xt[16];
#pragma unroll
      for (int n = 0; n < 4; ++n)
#pragma unroll
        for (int j = 0; j < 4; ++j) xt[n * 4 + j] = p.x[(size_t)(rbase + m * 16 + j) * 1024 + cbase + n * 16];
#pragma unroll
      for (int n = 0; n < 4; ++n)
#pragma unroll
        for (int j = 0; j < 4; ++j) p.out[(size_t)(rbase + m * 16 + j) * 1024 + cbase + n * 16] = xt[n * 4 + j] + acc[m][n][j];
    }
  }
}

__device__ __forceinline__ void phase_pq(const Params& p, unsigned char* smem) {
  unsigned char* ws = p.ws;
  const bf16_t* xn2 = (const bf16_t*)(ws + WS_XN);
  const bf16_t* wq = (const bf16_t*)(ws + WS_WQ);
  bf16_t* qp = (bf16_t*)(ws + WS_PG);
  const int tid = threadIdx.x, lane = tid & 63, w = tid >> 6, wm = w >> 1, wn = w & 1, l15 = lane & 15, g = lane >> 4;
  for (int tile = blockIdx.x; tile < 128 * 16; tile += gridDim.x) {
    const int tn = tile & 15, tm = tile >> 4;
    f32x4 acc[4][4]; zero_acc(acc);
    gemm_tile(xn2 + (size_t)tm * 256 * 1024, 1024, wq + (size_t)tn * 128 * 1024, 1024, 16, acc, smem);
    const int rbase = tm * 256 + wm * 64 + 4 * g;
    const int cbase = tn * 128 + wn * 64 + l15;
#pragma unroll
    for (int m = 0; m < 4; ++m)
#pragma unroll
      for (int n = 0; n < 4; ++n)
#pragma unroll
        for (int j = 0; j < 4; ++j) qp[(size_t)(rbase + m * 16 + j) * 2048 + cbase + n * 16] = f2bf(acc[m][n][j]);
  }
}

__device__ __forceinline__ void phase_pkeys(const Params& p, unsigned char* smem) {
  unsigned char* ws = p.ws;
  const bf16_t* qp = (const bf16_t*)(ws + WS_PG);
  const bf16_t* keys = (const bf16_t*)(ws + WS_KEYS);
  float* ps = (float*)(ws + WS_PA);
  int* pi = (int*)(ws + WS_PA) + (size_t)TOK * 256;
  float* sc = (float*)smem;
  const int tid = threadIdx.x, lane = tid & 63, w = tid >> 6, wm = w >> 1, wn = w & 1, l15 = lane & 15, g = lane >> 4;
  for (int tile = blockIdx.x; tile < 128 * 16; tile += gridDim.x) {
    const int hp = tile & 15, tm = tile >> 4;
    const int h = hp >> 1, ph = hp & 1;
    f32x4 acc[4][4]; zero_acc(acc);
    gemm_tile(qp + (size_t)tm * 256 * 2048 + hp * 128, 2048, keys + (size_t)(ph * 8 + h) * 128 * 128, 128, 2, acc, smem);
    __syncthreads();
#pragma unroll
    for (int m = 0; m < 4; ++m)
#pragma unroll
      for (int n = 0; n < 4; ++n)
#pragma unroll
        for (int j = 0; j < 4; ++j) sc[(wm * 64 + m * 16 + 4 * g + j) * 129 + wn * 64 + n * 16 + l15] = acc[m][n][j];
    __syncthreads();
    if (tid < 256) {
      const int row = tid;
      const float* rowp = sc + row * 129;
      unsigned tv[16];
#pragma unroll
      for (int k = 0; k < 16; ++k) tv[k] = 0u;
#pragma unroll 8
      for (int nn = 0; nn < 128; ++nn) {
        const unsigned bits = __float_as_uint(rowp[nn]);
        unsigned key = (bits & 0x80000000u) ? ~bits : (bits | 0x80000000u);
        key = (key & ~127u) | (unsigned)(127 - nn);
#pragma unroll
        for (int k = 15; k >= 1; --k) {
          unsigned r;
          asm("v_med3_u32 %0, %1, %2, %3" : "=v"(r) : "v"(tv[k]), "v"(tv[k - 1]), "v"(key));
          tv[k] = r;
        }
        tv[0] = tv[0] > key ? tv[0] : key;
      }
      const size_t ob = ((size_t)(tm * 256 + row) * 16 + hp) * 16;
      float ov[16]; int oi[16];
#pragma unroll
      for (int k = 0; k < 16; ++k) { oi[k] = 127 - (int)(tv[k] & 127u); ov[k] = rowp[oi[k]]; }
#pragma unroll
      for (int k = 0; k < 16; k += 4) {
        *(float4*)(ps + ob + k) = make_float4(ov[k], ov[k + 1], ov[k + 2], ov[k + 3]);
        *(int4*)(pi + ob + k) = make_int4(oi[k], oi[k + 1], oi[k + 2], oi[k + 3]);
      }
    }
    __syncthreads();
  }
}

__device__ __forceinline__ void phase_pcomb(const Params& p, unsigned char* smem) {
  unsigned char* ws = p.ws;
  const float* ps = (const float*)(ws + WS_PA);
  const int* pi = (const int*)(ws + WS_PA) + (size_t)TOK * 256;
  int* eidx = (int*)(ws + WS_EIDX);
  float* gw = (float*)(ws + WS_GW);
  float* s2l = (float*)smem;
  unsigned short* i1l = (unsigned short*)(s2l + 512 * 17);
  unsigned short* i2l = i1l + 512 * 16;
  const int tid = threadIdx.x;
  for (int base = blockIdx.x * NTHREADS; base < TOK * 8; base += gridDim.x * NTHREADS) {
    const int th = base + tid;
    const size_t o1 = (size_t)th * 32;
    float s1[16];
#pragma unroll
    for (int a = 0; a < 16; ++a) {
      s1[a] = ps[o1 + a];
      s2l[tid * 17 + a] = ps[o1 + 16 + a];
      i1l[tid * 16 + a] = (unsigned short)pi[o1 + a];
      i2l[tid * 16 + a] = (unsigned short)pi[o1 + 16 + a];
    }
    float cur[16];
    const float s20 = s2l[tid * 17];
#pragma unroll
    for (int a = 0; a < 16; ++a) cur[a] = s1[a] + s20;
    unsigned long long ptr = 0ull;
    float tops[16]; int tope[16];
#pragma unroll
    for (int k = 0; k < 16; ++k) {
      float best = cur[0]; int ba = 0;
#pragma unroll
      for (int a = 1; a < 16; ++a) if (cur[a] > best) { best = cur[a]; ba = a; }
      const int bb = (int)((ptr >> (4 * ba)) & 15ull);
      tops[k] = best;
      tope[k] = (int)i1l[tid * 16 + ba] * 128 + (int)i2l[tid * 16 + bb];
      const int nb = bb + 1;
      const float ns2 = (nb < 16) ? s2l[tid * 17 + nb] : -INFINITY;
      if (nb < 16) ptr += (1ull << (4 * ba));
#pragma unroll
      for (int a = 0; a < 16; ++a) if (a == ba) cur[a] = s1[a] + ns2;
    }
    float m = tops[0];
    float sum = 0.f;
#pragma unroll
    for (int k = 0; k < 16; ++k) { tops[k] = __expf(tops[k] - m); sum += tops[k]; }
    const float inv = 1.f / sum;
#pragma unroll
    for (int k = 0; k < 16; ++k) { eidx[(size_t)th * 16 + k] = tope[k]; gw[(size_t)th * 16 + k] = tops[k] * inv; }
  }
}


__device__ __forceinline__ float reduce8(const float (&pv)[8], int lane) {
  const bool b5 = lane & 32, b4 = lane & 16, b3 = lane & 8;
  float v[4];
#pragma unroll
  for (int i = 0; i < 4; ++i) {
    const float keep = b5 ? pv[4 + i] : pv[i];
    const float send = b5 ? pv[i] : pv[4 + i];
    v[i] = keep + __shfl_xor(send, 32);
  }
  float u[2];
#pragma unroll
  for (int i = 0; i < 2; ++i) {
    const float keep = b4 ? v[2 + i] : v[i];
    const float send = b4 ? v[i] : v[2 + i];
    u[i] = keep + __shfl_xor(send, 16);
  }
  float x = (b3 ? u[1] : u[0]) + __shfl_xor(b3 ? u[0] : u[1], 8);
  x += __shfl_xor(x, 4); x += __shfl_xor(x, 2); x += __shfl_xor(x, 1);
  return x;
}

__device__ __forceinline__ void cvt16u8(const uint4& v, float* f) {
  f[0] = (float)(v.x & 0xffu); f[1] = (float)((v.x >> 8) & 0xffu); f[2] = (float)((v.x >> 16) & 0xffu); f[3] = (float)(v.x >> 24);
  f[4] = (float)(v.y & 0xffu); f[5] = (float)((v.y >> 8) & 0xffu); f[6] = (float)((v.y >> 16) & 0xffu); f[7] = (float)(v.y >> 24);
  f[8] = (float)(v.z & 0xffu); f[9] = (float)((v.z >> 8) & 0xffu); f[10] = (float)((v.z >> 16) & 0xffu); f[11] = (float)(v.z >> 24);
  f[12] = (float)(v.w & 0xffu); f[13] = (float)((v.w >> 8) & 0xffu); f[14] = (float)((v.w >> 16) & 0xffu); f[15] = (float)(v.w >> 24);
}

__device__ __forceinline__ int team_index(const Params& p, unsigned char* smem) {
  int* sh = (int*)(smem + 8192);
  const int G = gridDim.x, tid = threadIdx.x;
  const int* tab = (const int*)(p.ws + WS_XCC);
  if (tid < 32) sh[tid] = 0;
  __syncthreads();
  const int mine = tab[blockIdx.x] & 15;
  for (int b = tid; b < G; b += NTHREADS) {
    const int x = tab[b] & 15;
    atomicAdd(&sh[x], 1);
    if (x == mine && b < (int)blockIdx.x) atomicAdd(&sh[16], 1);
  }
  __syncthreads();
  if (tid == 0) {
    int pre = 0;
    for (int j = 0; j < mine; ++j) pre += sh[j];
    sh[17] = pre + sh[16];
  }
  __syncthreads();
  const int r = sh[17];
  __syncthreads();
  return r;
}

__device__ __forceinline__ int wave_sum_i32_dpp(int v) {
  v += __builtin_amdgcn_update_dpp(0, v, 0xB1, 0xf, 0xf, true);
  v += __builtin_amdgcn_update_dpp(0, v, 0x4E, 0xf, 0xf, true);
  v += __builtin_amdgcn_update_dpp(0, v, 0x141, 0xf, 0xf, true);
  v += __builtin_amdgcn_update_dpp(0, v, 0x140, 0xf, 0xf, true);
  return __builtin_amdgcn_readlane(v, 0) + __builtin_amdgcn_readlane(v, 16) + __builtin_amdgcn_readlane(v, 32) + __builtin_amdgcn_readlane(v, 48);
}

template <bool SL>
__device__ __forceinline__ void phase_pu_t(const Params& p, unsigned char* smem) {
  unsigned char* ws = p.ws;
  const unsigned char* XQ = ws + WS_XQ;
  const float* xs = (const float*)(ws + WS_XS);
  const unsigned char* U8 = ws + WS_U;
  const float* us = (const float*)(ws + WS_U + (size_t)16384 * 1024);
  const float* vs = (const float*)(ws + WS_V + (size_t)16384 * 1024);
  const int* eidx = (const int*)(ws + WS_EIDX);
  const float* gw = (const float*)(ws + WS_GW);
  float* aw = (float*)(ws + WS_PA);
  const int lane = threadIdx.x & 63, w = threadIdx.x >> 6;
  unsigned* lst = (unsigned*)smem + w * 128;
  const unsigned long long lt_mask = (1ull << lane) - 1ull;
  const int G = gridDim.x;
  constexpr bool sliced = SL;
  const int ti = sliced ? team_index(p, smem) : 0;
  const int tsz = G >> 3;
  const int grp0 = sliced ? (ti / tsz) : 0;
  constexpr int ngrp = sliced ? 1 : 8;
  const int slot = sliced ? (ti % tsz) * 8 + w : blockIdx.x * 8 + w;
  const int nslot = sliced ? tsz * 8 : G * 8;
  uint4 xa = make_uint4(0, 0, 0, 0); int e0 = 0, e1 = 0; float xsc = 0.f;
  if (slot < TOK) {
    xa = *(const uint4*)(XQ + (size_t)slot * 1024 + lane * 16);
    e0 = eidx[(size_t)slot * 128 + lane]; e1 = eidx[(size_t)slot * 128 + 64 + lane];
    xsc = xs[slot];
  }
  for (int tok = slot; tok < TOK; tok += nslot) {
    const uint4 cx = xa;
    const int ce0 = e0, ce1 = e1;
    const float cxs = xsc;
    for (int gi = 0; gi < ngrp; ++gi) {
      const int grp = grp0 + gi;
      const bool m0 = (ce0 >> 11) == grp, m1 = (ce1 >> 11) == grp;
      const unsigned long long b0 = __ballot(m0), b1 = __ballot(m1);
      const int c0 = __popcll(b0), n = c0 + __popcll(b1);
      if (m0) lst[__popcll(b0 & lt_mask)] = ((unsigned)lane << 14) | (unsigned)ce0;
      if (m1) lst[c0 + __popcll(b1 & lt_mask)] = ((unsigned)(lane + 64) << 14) | (unsigned)ce1;
      lds_fence();
      const unsigned le0 = (lane < n) ? lst[lane] : 0u;
      const unsigned le1 = (lane + 64 < n) ? lst[lane + 64] : 0u;
      lds_fence();
      float sc0 = 0.f, sc1 = 0.f, gv0 = 0.f, gv1 = 0.f, vv0 = 0.f, vv1 = 0.f;
      if (lane < n) { const int e = le0 & 16383; sc0 = us[e]; vv0 = vs[e]; gv0 = gw[(size_t)tok * 128 + (le0 >> 14)]; }
      if (lane + 64 < n) { const int e = le1 & 16383; sc1 = us[e]; vv1 = vs[e]; gv1 = gw[(size_t)tok * 128 + (le1 >> 14)]; }
      int h0i = 0, h1i = 0;
#define PU_BATCH(I0, PREFETCH_STMT) do { \
        const int i0_ = (I0); \
        const bool lo = i0_ < 64; \
        const int cur = (int)(lo ? le0 : le1); \
        const int base = i0_ & 63; \
        int last = (lo ? (n < 64 ? n : 64) : n - 64) - 1; last = last < 0 ? 0 : last; \
        uint4 ua[16]; \
        _Pragma("unroll") for (int j = 0; j < 16; ++j) { \
          int idx = base + j; idx = idx < last ? idx : last; \
          const unsigned le = (unsigned)__builtin_amdgcn_readlane(cur, idx); \
          ua[j] = *(const uint4*)(U8 + (size_t)(le & 16383u) * 1024 + lane * 16); \
        } \
        PREFETCH_STMT; \
        __builtin_amdgcn_sched_barrier(0); \
        int hn = 0; \
        _Pragma("unroll") for (int j = 0; j < 16; ++j) { \
          int d = __builtin_amdgcn_sdot4((int)ua[j].x, (int)cx.x, 0, false); \
          d = __builtin_amdgcn_sdot4((int)ua[j].y, (int)cx.y, d, false); \
          d = __builtin_amdgcn_sdot4((int)ua[j].z, (int)cx.z, d, false); \
          d = __builtin_amdgcn_sdot4((int)ua[j].w, (int)cx.w, d, false); \
          const int tot = wave_sum_i32_dpp(d); \
          if (lane == base + j) hn = tot; \
        } \
        if (lane >= base && lane < base + 16) { if (lo) h0i = hn; else h1i = hn; } \
      } while (0)
      if (gi == ngrp - 1) {
        const int nt = (tok + nslot < TOK) ? tok + nslot : tok;
        PU_BATCH(0, { xa = *(const uint4*)(XQ + (size_t)nt * 1024 + lane * 16);
                      e0 = eidx[(size_t)nt * 128 + lane]; e1 = eidx[(size_t)nt * 128 + 64 + lane]; xsc = xs[nt]; });
      } else {
        PU_BATCH(0, {});
      }
#pragma unroll 1
      for (int i0 = 16; i0 < n; i0 += 16) PU_BATCH(i0, {});
#undef PU_BATCH
      const float h0 = (float)h0i * sc0 * cxs, h1 = (float)h1i * sc1 * cxs;
      if (lane < n) aw[(size_t)tok * 128 + (le0 >> 14)] = 0.5f * h0 * (1.f + erff(h0 * 0.70710678118654752f)) * gv0 * vv0;
      if (lane + 64 < n) aw[(size_t)tok * 128 + (le1 >> 14)] = 0.5f * h1 * (1.f + erff(h1 * 0.70710678118654752f)) * gv1 * vv1;
    }
  }
}

template <bool SL>
__device__ __forceinline__ void phase_pv_t(const Params& p, unsigned char* smem) {
  unsigned char* ws = p.ws;
  const unsigned char* V8 = ws + WS_V;
  const int* eidx = (const int*)(ws + WS_EIDX);
  const float* aw = (const float*)(ws + WS_PA);
  float* ssq = (float*)(ws + WS_SSQ);
  const int lane = threadIdx.x & 63, w = threadIdx.x >> 6;
  const int q = lane >> 3, c = lane & 7;
  const int G = gridDim.x;
  constexpr bool sliced = SL;
  const int ti = sliced ? team_index(p, smem) : 0;
  const int tsz = G >> 3;
  const int grp0 = sliced ? (ti / tsz) : 0;
  constexpr int ngrp = sliced ? 1 : 8;
  const int slot = sliced ? (ti % tsz) * 8 + w : blockIdx.x * 8 + w;
  const int nslot = sliced ? tsz * 8 : G * 8;
  int ee[16]; float aa[16];
  if (slot < TOK) {
    unsigned bi = (unsigned)slot * 128u + (unsigned)q;
    asm volatile("" : "+v"(bi));
#pragma unroll
    for (int u = 0; u < 16; ++u) { ee[u] = eidx[bi + 8 * u]; aa[u] = aw[bi + 8 * u]; }
  }
  for (int tok = slot; tok < TOK; tok += nslot) {
    int ce[16]; float ca[16];
    float suma = 0.f;
#pragma unroll
    for (int u = 0; u < 16; ++u) { ce[u] = ee[u]; ca[u] = aa[u]; suma += aa[u]; }
    for (int gi = 0; gi < ngrp; ++gi) {
      const int grp = grp0 + gi;
      uint4 vv[16];
#pragma unroll
      for (int u = 0; u < 16; ++u) vv[u] = *(const uint4*)(V8 + (size_t)grp * (16384 * 128) + (size_t)ce[u] * 128 + c * 16);
      float* orow = p.out + (size_t)tok * 1024 + grp * 128 + c * 16;
      float4 x1v[4];
#pragma unroll
      for (int i = 0; i < 4; ++i) x1v[i] = *(const float4*)(orow + 4 * i);
      if (gi == ngrp - 1) {
        const int nt = (tok + nslot < TOK) ? tok + nslot : tok;
        unsigned bi = (unsigned)nt * 128u + (unsigned)q;
        asm volatile("" : "+v"(bi));
#pragma unroll
        for (int u = 0; u < 16; ++u) { ee[u] = eidx[bi + 8 * u]; aa[u] = aw[bi + 8 * u]; }
      }
      __builtin_amdgcn_sched_barrier(0);
      float acc[16];
#pragma unroll
      for (int i = 0; i < 16; ++i) acc[i] = -128.f * suma;
#pragma unroll
      for (int u = 0; u < 16; ++u) {
        float vf[16];
        cvt16u8(vv[u], vf);
#pragma unroll
        for (int i = 0; i < 16; ++i) acc[i] += ca[u] * vf[i];
        __builtin_amdgcn_sched_barrier(0);
      }
#pragma unroll
      for (int i = 0; i < 16; ++i) { acc[i] = add_xor8(acc[i]); acc[i] = add_xor16(acc[i]); acc[i] = add_xor32(acc[i]); }
      float ss = 0.f;
      if (q == 0) {
#pragma unroll
        for (int i = 0; i < 4; ++i) {
          const float4 oa = make_float4(x1v[i].x + acc[4 * i], x1v[i].y + acc[4 * i + 1], x1v[i].z + acc[4 * i + 2], x1v[i].w + acc[4 * i + 3]);
          *(float4*)(orow + 4 * i) = oa;
          ss += oa.x * oa.x + oa.y * oa.y + oa.z * oa.z + oa.w * oa.w;
        }
      }
      ss += __shfl_xor(ss, 1); ss += __shfl_xor(ss, 2); ss += __shfl_xor(ss, 4);
      if (lane == 0) atomicAdd(&ssq[tok], ss);
    }
  }
}

__device__ __forceinline__ void phase_final(const Params& p) {
  const float* ssq = (const float*)(p.ws + WS_SSQ);
  const int lane = threadIdx.x & 63, w = threadIdx.x >> 6;
  for (int row = blockIdx.x * 8 + w; row < TOK; row += gridDim.x * 8) {
    const float rstd = rsqrtf(ssq[row] * (1.f / DM) + EPSV);
    float4* o4 = (float4*)(p.out + (size_t)row * DM);
#pragma unroll
    for (int i = 0; i < 4; ++i) {
      float4 v = o4[lane + 64 * i];
      const float4 gg = ((const float4*)p.norm_final)[lane + 64 * i];
      v.x *= rstd * gg.x; v.y *= rstd * gg.y; v.z *= rstd * gg.z; v.w *= rstd * gg.w;
      o4[lane + 64 * i] = v;
    }
  }
}


__device__ __forceinline__ void phase_proj8(const Params& p, unsigned char* smem) {
  unsigned char* ws = p.ws;
  pg8::Gemm g{(const pg8::bf16_t*)(ws + WS_XN), (const pg8::bf16_t*)(ws + WS_WIN), TOK, 5120, 1024};
  pg8::StaticOrder S; S.init(TOK, 5120, (int)gridDim.x, (int)blockIdx.x);
  EpiProj E{(unsigned short*)(ws + WS_PH), (unsigned short*)(ws + WS_PA), (unsigned short*)(ws + WS_PG)};
  pg8::gemm_phase<EpiProj, pg8::StaticOrder>((PG8_LAS unsigned char*)smem, g, S, E, nullptr);
}
__device__ __forceinline__ void phase_ikln(const Params& p) {
  bf16_t* pA = (bf16_t*)(p.ws + WS_PA);
  const int tid = threadIdx.x, sub = tid & 7;
  float gam[8], bet[8];
#pragma unroll
  for (int i = 0; i < 8; ++i) { gam[i] = p.ikg[sub * 8 + i]; bet[i] = p.ikb[sub * 8 + i]; }
  for (int row = blockIdx.x * 64 + (tid >> 3); row < TOK; row += gridDim.x * 64) {
    uint4* ptr = (uint4*)(pA + (size_t)row * 1024 + 896 + sub * 8);
    const uint4 raw = *ptr;
    float v[8];
    cvt8(raw, v);
    float s = 0.f;
#pragma unroll
    for (int i = 0; i < 8; ++i) s += v[i];
    s += __shfl_xor(s, 1); s += __shfl_xor(s, 2); s += __shfl_xor(s, 4);
    const float mu = s * (1.f / 64.f);
    float q = 0.f;
#pragma unroll
    for (int i = 0; i < 8; ++i) { const float d = v[i] - mu; q += d * d; }
    q += __shfl_xor(q, 1); q += __shfl_xor(q, 2); q += __shfl_xor(q, 4);
    const float rstd = rsqrtf(q * (1.f / 64.f) + EPSV);
    uint4 o;
    o.x = pack2((v[0] - mu) * rstd * gam[0] + bet[0], (v[1] - mu) * rstd * gam[1] + bet[1]);
    o.y = pack2((v[2] - mu) * rstd * gam[2] + bet[2], (v[3] - mu) * rstd * gam[3] + bet[3]);
    o.z = pack2((v[4] - mu) * rstd * gam[4] + bet[4], (v[5] - mu) * rstd * gam[5] + bet[5]);
    o.w = pack2((v[6] - mu) * rstd * gam[6] + bet[6], (v[7] - mu) * rstd * gam[7] + bet[7]);
    *ptr = o;
  }
}
__device__ __forceinline__ void phase_up8(const Params& p, unsigned char* smem) {
  unsigned char* ws = p.ws;
  const pg8::bf16_t* ya = (const pg8::bf16_t*)(ws + WS_XN);
  const pg8::bf16_t* yb = ya + (size_t)TOK * 512;
  pg8::StaticOrder S; S.init(TOK, 1024, (int)gridDim.x, (int)blockIdx.x);
  {
    pg8::Gemm g{ya, (const pg8::bf16_t*)(ws + WS_WUPA), TOK, 1024, 512};
    EpiGate<0> E{(unsigned short*)(ws + WS_PH), (const unsigned short*)(ws + WS_PG), 0};
    pg8::gemm_phase<EpiGate<0>, pg8::StaticOrder>((PG8_LAS unsigned char*)smem, g, S, E, nullptr);
  }
  {
    pg8::Gemm g{yb, (const pg8::bf16_t*)(ws + WS_WUPB), TOK, 1024, 512};
    EpiGate<1> E{(unsigned short*)(ws + WS_PH), (const unsigned short*)(ws + WS_PG), 1024};
    pg8::gemm_phase<EpiGate<1>, pg8::StaticOrder>((PG8_LAS unsigned char*)smem, g, S, E, nullptr);
  }
}
__device__ __forceinline__ void phase_out8(const Params& p, unsigned char* smem) {
  unsigned char* ws = p.ws;
  pg8::Gemm g{(const pg8::bf16_t*)(ws + WS_PH), (const pg8::bf16_t*)(ws + WS_WOUT), TOK, 1024, 1024};
  pg8::StaticOrder S; S.init(TOK, 1024, (int)gridDim.x, (int)blockIdx.x);
  EpiResid E{p.out, p.x};
  pg8::gemm_phase<EpiResid, pg8::StaticOrder>((PG8_LAS unsigned char*)smem, g, S, E, nullptr);
}
__device__ __forceinline__ void phase_pq8(const Params& p, unsigned char* smem) {
  unsigned char* ws = p.ws;
  pg8::Gemm g{(const pg8::bf16_t*)(ws + WS_XN), (const pg8::bf16_t*)(ws + WS_WQ), TOK, 2048, 1024};
  pg8::StaticOrder S; S.init(TOK, 2048, (int)gridDim.x, (int)blockIdx.x);
  EpiStoreBf16 E{(unsigned short*)(ws + WS_PG), 2048};
  pg8::gemm_phase<EpiStoreBf16, pg8::StaticOrder>((PG8_LAS unsigned char*)smem, g, S, E, nullptr);
}

__global__ void __launch_bounds__(NTHREADS) hybrid_fwd(Params p) {
  extern __shared__ __attribute__((aligned(16))) unsigned char smem[];
#if ONE_LAUNCH
  cg::grid_group grid = cg::this_grid();
  volatile LAS unsigned* xst = (volatile LAS unsigned*)(smem + LDS_BYTES - 16);
  if (threadIdx.x == 0) { xst[0] = 0u; xst[1] = 0u; }
  __syncthreads();
  XcdBarrier xbar = xcd_barrier_post((unsigned*)(p.ws + WS_BAR), xst);
#define SEAM(k) do { if (p.ph_lo <= (k) && (k) + 1 < p.ph_hi) { if ((k) == 0) grid.sync(); else xcd_barrier(xbar); } } while (0)
#else
#define SEAM(k) do { } while (0)
#endif
#define IN(k) (p.ph_lo <= (k) && (k) < p.ph_hi)
#ifndef REPEAT_PH
#define REPEAT_PH -1
#endif
#define REP(k, stmt) do { if (REPEAT_PH == (k)) { stmt; grid.sync(); } } while (0)
  if (IN(0)) { phase_prep(p, smem); SEAM(0); }
  if (IN(1)) { phase_proj8(p, smem); SEAM(1); }
  if (IN(2)) { phase_ikln(p); for (int it = blockIdx.x; it < 2048; it += gridDim.x) hgrn_h1_item(p, smem, it); SEAM(2); }
  if (IN(3)) { phase_mix(p, smem); SEAM(3); }
  if (IN(4)) { phase_up8(p, smem); SEAM(4); }
  if (IN(5)) { phase_out8(p, smem); SEAM(5); }
  if (IN(6)) { rmsnorm_rows_q(p.out, p.norm_ffn, (bf16_t*)(p.ws + WS_XN), p.ws + WS_XQ, (float*)(p.ws + WS_XS)); SEAM(6); }
  if (IN(7)) { phase_pq8(p, smem); SEAM(7); }
  if (IN(8)) { phase_pkeys(p, smem); SEAM(8); }
  if (IN(9)) { phase_pcomb(p, smem); SEAM(9); }
  if (IN(10)) { if (gridDim.x % 8 == 0) phase_pu_t<true>(p, smem); else phase_pu_t<false>(p, smem); SEAM(10); }
  if (IN(11)) { if (gridDim.x % 8 == 0) phase_pv_t<true>(p, smem); else phase_pv_t<false>(p, smem); SEAM(11); }
  if (IN(12)) { phase_final(p); }
#undef IN
#undef SEAM
}

extern "C" void kernel_launch(void* const* d_in, const int* in_sizes, int n_in, void* d_out, int out_size, void* d_ws, size_t ws_size,
                              hipStream_t stream) {
  static int grid = 0;
  if (grid == 0) {
    if (n_in != 17 || ws_size < WS_END) {
      fprintf(stderr, "kernel_launch: unexpected n_in %d or ws_size %zu (need %zu)\n", n_in, ws_size, (size_t)WS_END);
      grid = -1; return;
    }
    int dev = 0, cus = 0, per_cu = 0;
    hipGetDevice(&dev);
    hipDeviceGetAttribute(&cus, hipDeviceAttributeMultiprocessorCount, dev);
    hipFuncSetAttribute((const void*)hybrid_fwd, hipFuncAttributeMaxDynamicSharedMemorySize, LDS_BYTES);
    hipOccupancyMaxActiveBlocksPerMultiprocessor(&per_cu, (const void*)hybrid_fwd, NTHREADS, LDS_BYTES);
    if (per_cu < 1) { fprintf(stderr, "kernel_launch: occupancy query says %d blocks/CU\n", per_cu); per_cu = 1; }
    (void)hipGetLastError();
    grid = cus;
  }
  if (grid < 0) return;
  Params p{};
  p.x = (const float*)d_in[0]; p.norm_mix = (const float*)d_in[1]; p.w_in = (const float*)d_in[2]; p.hg_lb = (const float*)d_in[3];
  p.hg_norm = (const float*)d_in[4]; p.ikg = (const float*)d_in[5]; p.ikb = (const float*)d_in[6]; p.rel_bias = (const float*)d_in[7];
  p.w_up_a = (const float*)d_in[8]; p.w_up_b = (const float*)d_in[9]; p.w_out = (const float*)d_in[10]; p.norm_ffn = (const float*)d_in[11];
  p.peer_wq = (const float*)d_in[12]; p.peer_keys = (const float*)d_in[13]; p.peer_u = (const float*)d_in[14]; p.peer_v = (const float*)d_in[15];
  p.norm_final = (const float*)d_in[16];
  p.out = (float*)d_out; p.ws = (unsigned char*)d_ws;
#if ONE_LAUNCH
  hipMemsetAsync((unsigned char*)d_ws + WS_BAR, 0, 16384, stream);
  p.ph_lo = 0; p.ph_hi = NPHASE;
  void* args[] = {&p};
  hipError_t e = hipLaunchCooperativeKernel((const void*)hybrid_fwd, dim3(grid), dim3(NTHREADS), args, LDS_BYTES, stream);
  if (e != hipSuccess) fprintf(stderr, "cooperative launch failed: %s (grid %d)\n", hipGetErrorString(e), grid);
#else
  for (int ph = 0; ph < NPHASE; ++ph) {
    p.ph_lo = ph; p.ph_hi = ph + 1;
    hipLaunchKernelGGL(hybrid_fwd, dim3(grid), dim3(NTHREADS), LDS_BYTES, stream, p);
  }
#endif
}
```

```cpp
#include <hip/hip_runtime.h>
#include <hip/hip_cooperative_groups.h>
#include <stdint.h>
#include <stdio.h>
namespace cg = cooperative_groups;

#ifndef ONE_LAUNCH
#define ONE_LAUNCH 1
#endif

typedef unsigned short bf16_t;
typedef __attribute__((ext_vector_type(8))) short bf16x8;
typedef __attribute__((ext_vector_type(4))) float f32x4;

#define NTHREADS 512
#define TOK 32768
#define SEQL 4096
#define DM 1024
#define EPSV 1e-6f
#define NPHASE 13

#define WS_WIN   ((size_t)0)
#define WS_WUPA  (WS_WIN  + (size_t)5120 * 1024 * 2)
#define WS_WUPB  (WS_WUPA + (size_t)1024 * 512 * 2)
#define WS_WOUT  (WS_WUPB + (size_t)1024 * 512 * 2)
#define WS_WQ    (WS_WOUT + (size_t)1024 * 1024 * 2)
#define WS_KEYS  (WS_WQ   + (size_t)2048 * 1024 * 2)
#define WS_LB    (WS_KEYS + (size_t)2 * 8 * 128 * 128 * 2)
#define WS_U     (WS_LB   + (size_t)4096)
#define WS_V     (WS_U    + (size_t)16384 * 1024 * 2)
#define WS_XN    (WS_V    + (size_t)16384 * 1024 * 2)
#define WS_PH    (WS_XN   + (size_t)TOK * 1024 * 2)
#define WS_PA    (WS_PH   + (size_t)TOK * 2048 * 2)
#define WS_PG    (WS_PA   + (size_t)TOK * 1024 * 2)
#define WS_EIDX  (WS_PG   + (size_t)TOK * 2048 * 2)
#define WS_GW    (WS_EIDX + (size_t)TOK * 128 * 4)
#define WS_SSQ   (WS_GW   + (size_t)TOK * 128 * 4)
#define WS_XCC   (WS_SSQ  + (size_t)TOK * 4)
#define WS_BAR   (WS_XCC  + (size_t)4096)
#define WS_DEC   (WS_BAR  + (size_t)16384)
#define WS_QCTR  (WS_DEC  + (size_t)2048 * 384 * 4)
#define WS_END   (WS_QCTR + (size_t)256)

#define LDS_BYTES 155648

struct Params {
  const float* x; const float* norm_mix; const float* w_in; const float* hg_lb; const float* hg_norm;
  const float* ikg; const float* ikb; const float* rel_bias; const float* w_up_a; const float* w_up_b;
  const float* w_out; const float* norm_ffn; const float* peer_wq; const float* peer_keys;
  const float* peer_u; const float* peer_v; const float* norm_final;
  float* out; unsigned char* ws; int ph_lo, ph_hi;
};

__device__ __forceinline__ float bf2f(bf16_t u) { return __uint_as_float(((unsigned)u) << 16); }
__device__ __forceinline__ bf16_t f2bf(float f) {
  unsigned u = __float_as_uint(f);
  u += 0x7fffu + ((u >> 16) & 1u);
  return (bf16_t)(u >> 16);
}
__device__ __forceinline__ unsigned pack2(float a, float b) { return (unsigned)f2bf(a) | ((unsigned)f2bf(b) << 16); }
__device__ __forceinline__ float wave_sum_slow(float v) {
#pragma unroll
  for (int o = 32; o > 0; o >>= 1) v += __shfl_xor(v, o);
  return v;
}
__device__ __forceinline__ void lds_fence() { asm volatile("s_waitcnt lgkmcnt(0)" ::: "memory"); }

__device__ __forceinline__ float add_xor8(float v) { return v + __int_as_float(__builtin_amdgcn_update_dpp(0, __float_as_int(v), 0x128, 0xf, 0xf, true)); }
__device__ __forceinline__ float add_xor16(float v) { const auto r = __builtin_amdgcn_permlane16_swap(__float_as_uint(v), __float_as_uint(v), false, false); return __uint_as_float(r[0]) + __uint_as_float(r[1]); }
__device__ __forceinline__ float add_xor32(float v) { const auto r = __builtin_amdgcn_permlane32_swap(__float_as_uint(v), __float_as_uint(v), false, false); return __uint_as_float(r[0]) + __uint_as_float(r[1]); }
__device__ __forceinline__ float max_xor16(float v) { const auto r = __builtin_amdgcn_permlane16_swap(__float_as_uint(v), __float_as_uint(v), false, false); return fmaxf(__uint_as_float(r[0]), __uint_as_float(r[1])); }
__device__ __forceinline__ float max_xor32(float v) { const auto r = __builtin_amdgcn_permlane32_swap(__float_as_uint(v), __float_as_uint(v), false, false); return fmaxf(__uint_as_float(r[0]), __uint_as_float(r[1])); }
__device__ __forceinline__ float wave_sum(float v) {
  v += __int_as_float(__builtin_amdgcn_update_dpp(0, __float_as_int(v), 0xB1, 0xf, 0xf, true));
  v += __int_as_float(__builtin_amdgcn_update_dpp(0, __float_as_int(v), 0x4E, 0xf, 0xf, true));
  v += __int_as_float(__builtin_amdgcn_update_dpp(0, __float_as_int(v), 0x141, 0xf, 0xf, true));
  v += __int_as_float(__builtin_amdgcn_update_dpp(0, __float_as_int(v), 0x140, 0xf, 0xf, true));
  return add_xor32(add_xor16(v));
}
__device__ __forceinline__ float sigmoidf_(float x) { return 1.f / (1.f + __expf(-x)); }
__device__ __forceinline__ float siluf_(float x) { return x / (1.f + __expf(-x)); }


#define XB_TMO      128
#define XB_XCNT(j)  (256  + 64 * (j))
#define XB_XSUB(j)  (1280 + 64 * (j))
#define XB_XGEN(j)  (2304 + 64 * (j))
#define XB_TOP      3328
#define XB_TOPGEN   3392
#define XCD_BAR_WORDS 3456
#define XB_SPIN_CAP (1u << 22)
#define LAS __attribute__((address_space(3)))
__device__ __forceinline__ unsigned xb_ld(unsigned* p)              { return __hip_atomic_load(p, __ATOMIC_RELAXED, __HIP_MEMORY_SCOPE_AGENT); }
__device__ __forceinline__ unsigned xb_add(unsigned* p, unsigned v) { return __hip_atomic_fetch_add(p, v, __ATOMIC_RELAXED, __HIP_MEMORY_SCOPE_AGENT); }
__device__ __forceinline__ unsigned xb_xcc_id() { return (unsigned)__builtin_amdgcn_s_getreg((3 << 11) | 20) & 0xFu; }
#define XB_SPIN(cond, bar) do { unsigned _sp = 0; while (cond) { __builtin_amdgcn_s_sleep(1); \
    if ((++_sp & 255u) == 0u) { if (xb_ld(&(bar)[XB_TMO])) break; if (_sp > XB_SPIN_CAP) { atomicAdd(&(bar)[XB_TMO], 1u); break; } } } } while (0)
struct XcdBarrier { unsigned* bar; unsigned x; volatile LAS unsigned* st; };
__device__ __forceinline__ XcdBarrier xcd_barrier_post(unsigned* bar, volatile LAS unsigned* st) {
  XcdBarrier b; b.bar = bar; b.x = xb_xcc_id(); b.st = st;
  if (threadIdx.x == 0) (void)xb_add(&bar[XB_XCNT(b.x)], 1u);
  return b;
}
__device__ __forceinline__ void xcd_barrier_complete(unsigned* bar, unsigned x, unsigned& nloc, unsigned& nx) {
  const unsigned G = gridDim.x * gridDim.y * gridDim.z;
  unsigned sum, cnt, mine, sp = 0u;
  for (;;) {
    sum = 0u; cnt = 0u; mine = 0u;
#pragma unroll
    for (unsigned j = 0; j < 16; ++j) { const unsigned c = xb_ld(&bar[XB_XCNT(j)]); sum += c; cnt += (c > 0u) ? 1u : 0u; mine = (j == x) ? c : mine; }
    if (sum == G) break;
    __builtin_amdgcn_s_sleep(1);
    if ((++sp & 255u) == 0u) { if (xb_ld(&bar[XB_TMO])) break; if (sp > XB_SPIN_CAP) { atomicAdd(&bar[XB_TMO], 1u); break; } }
  }
  nloc = mine > 0u ? mine : 1u; nx = cnt > 0u ? cnt : 1u;
}
__device__ __forceinline__ void xcd_barrier(const XcdBarrier& b) {
  asm volatile("s_waitcnt vmcnt(0)" ::: "memory");
  __syncthreads();
  if (threadIdx.x == 0) {
    unsigned* bar = b.bar;
    __builtin_amdgcn_s_waitcnt(0);
    unsigned nloc = b.st[0], nx = b.st[1];
    if (nloc == 0u) { xcd_barrier_complete(bar, b.x, nloc, nx); b.st[0] = nloc; b.st[1] = nx; }
    const unsigned old = xb_add(&bar[XB_XSUB(b.x)], 1u);
    const unsigned gen = old / nloc;
    if (old + 1u == (gen + 1u) * nloc) {
      __builtin_amdgcn_fence(__ATOMIC_RELEASE, "agent");
      asm volatile("s_waitcnt vmcnt(0)" ::: "memory");
      const unsigned og = xb_add(&bar[XB_TOP], 1u);
      const unsigned tg = og / nx;
      if (og + 1u == (tg + 1u) * nx) xb_add(&bar[XB_TOPGEN], 1u);
      else XB_SPIN(xb_ld(&bar[XB_TOPGEN]) == tg, bar);
      __builtin_amdgcn_fence(__ATOMIC_ACQUIRE, "agent");
      xb_add(&bar[XB_XGEN(b.x)], 1u);
      asm volatile("s_waitcnt vmcnt(0)" ::: "memory");
    } else {
      XB_SPIN(xb_ld(&bar[XB_XGEN(b.x)]) == gen, bar);
      __builtin_amdgcn_fence(__ATOMIC_ACQUIRE, "agent");
      asm volatile("s_waitcnt vmcnt(0)" ::: "memory");
    }
  }
  __syncthreads();
}

namespace pg8 {
#define PG8_LAS __attribute__((address_space(3)))
typedef unsigned short bf16_t;
typedef short bf16x8 __attribute__((ext_vector_type(8)));
typedef float f32x4 __attribute__((ext_vector_type(4)));
typedef unsigned u32x4 __attribute__((ext_vector_type(4)));
constexpr int BM = 256, BK = 64, HALF = 128, HTB = HALF * BK * 2  , STAGE_BYTES = 8 * HTB, NXCD = 8, WGM = 8;

__host__ __device__ __forceinline__ int lds_byte(int r, int c) { const int st = (r >> 4) * 2 + (c >> 5), rr = r & 15, cc = c & 31, ob = rr * 64 + cc * 2; return st * 1024 + (ob ^ (((ob >> 9) & 1) << 5)); }
__host__ __device__ __forceinline__ void stage_rc(int b, int& R, int& C) { const int st = b / 1024, sb = b % 1024, swz = sb ^ (((sb >> 9) & 1) << 5); R = (st >> 1) * 16 + swz / 64; C = (st & 1) * 32 + (swz % 64) / 2; }
__host__ __device__ __forceinline__ int perm32(int rho) { const int n = rho >> 4, i = rho & 15; return 8 * (i >> 2) + 4 * n + (i & 3); }

struct Unit { int pm, pn; };
struct Gemm { const bf16_t* A; const bf16_t* Bt; int M, N, K; };

struct StaticOrder {
    int nM, nN, nwg, G, c;
    __host__ __device__ void init(int M, int N, int G_, int c_) { nM = M / BM; nN = N / BM; nwg = nM * nN; G = G_; c = c_; }
    __host__ __device__ bool next(int i, Unit& u) const {
        const long L = (long)i * G + c; if (L >= nwg) return false;
        int wgid = (int)L; { const int q = nwg / NXCD, r = nwg % NXCD, xcd = wgid % NXCD, off = wgid / NXCD; wgid = (xcd < r ? xcd * (q + 1) : r * (q + 1) + (xcd - r) * q) + off; }
        const int nig = WGM * nN, gid = wgid / nig, fm = gid * WGM, gsz = (nM - fm) < WGM ? (nM - fm) : WGM;
        u.pm = fm + ((wgid % nig) % gsz); u.pn = (wgid % nig) / gsz; return true;
    }
    __device__ __forceinline__ void a_ready(const Unit&) const {}
    __device__ __forceinline__ void done(const Unit&) const {}
};
__device__ __forceinline__ unsigned cvt_pk_bf16(float lo, float hi) { unsigned r; asm volatile("v_cvt_pk_bf16_f32 %0, %1, %2" : "=v"(r) : "v"(lo), "v"(hi)); return r; }
template <class Epi, class Sched, bool STAMP = false>
__device__ __forceinline__ void gemm_phase(PG8_LAS unsigned char* lds, const Gemm g, const Sched& S, const Epi& E, unsigned long long* stamps) {
    const int tid = threadIdx.x, wid = __builtin_amdgcn_readfirstlane(tid >> 6), lane = tid & 63, wr = wid >> 2, wc = wid & 3, fr = lane & 15, fq = lane >> 4;
    const int K = g.K, nt = K / BK;
    int ts_lo = 0, ts_hi = 0, nts = 0; const unsigned long long rt_entry = STAMP ? (unsigned long long)wall_clock64() : 0ull;
#define PG8_STAMP() do { if (STAMP && wid == 0 && nts < 64) { const unsigned long long _c = (unsigned long long)clock64(); \
        ts_lo = (lane == nts) ? (int)(unsigned)_c : ts_lo; ts_hi = (lane == nts) ? (int)(unsigned)(_c >> 32) : ts_hi; ++nts; } } while (0)
    PG8_STAMP();
    unsigned voffA[2], voffB[2];
#pragma unroll
    for (int i = 0; i < 2; ++i) { int R, C; stage_rc(tid * 16 + i * 8192, R, C); const int Rb = Epi::PERM ? ((R & ~31) + perm32(R & 31)) : R;
        voffA[i] = (unsigned)(R * K + C) * 2u; voffB[i] = (unsigned)(Rb * K + C) * 2u; }
    const size_t kstep = (size_t)(BK * 2);
    const size_t hstep = (size_t)HALF * K * 2;
    const size_t tstep = 2 * hstep;
    const unsigned ldsw = (unsigned)wid * 1024u;
    const int aoff = lds_byte(wr * 64 + fr, fq * 8), boff = lds_byte(wc * 32 + fr, fq * 8);
#define PG8_SA(b, h) (((b) * 2 + (h)) * HTB)
#define PG8_SB(b, h) ((4 + (b) * 2 + (h)) * HTB)
#define PG8_STAGE(bufoff, gbase, voff) do { _Pragma("unroll") for (int _i = 0; _i < 2; ++_i) \
        __builtin_amdgcn_global_load_lds((const unsigned*)((const char*)(gbase) + (voff)[_i]), (PG8_LAS unsigned*)(lds + (bufoff) + ldsw + _i * 8192), 16, 0, 0); } while (0)
#define PG8_LDA(dst, b, h) do { _Pragma("unroll") for (int m = 0; m < 4; ++m) _Pragma("unroll") for (int k = 0; k < 2; ++k) dst[m][k] = *(const PG8_LAS bf16x8*)(lds + PG8_SA(b, h) + aoff + m * 2048 + k * 1024); } while (0)
#define PG8_LDB(dst, b, h) do { _Pragma("unroll") for (int n = 0; n < 2; ++n) _Pragma("unroll") for (int k = 0; k < 2; ++k) dst[n][k] = *(const PG8_LAS bf16x8*)(lds + PG8_SB(b, h) + boff + n * 2048 + k * 1024); } while (0)
#define PG8_MMA(ai, bj, At, Bt) do { __builtin_amdgcn_s_setprio(1); _Pragma("unroll") for (int m = 0; m < 4; ++m) _Pragma("unroll") for (int n = 0; n < 2; ++n) _Pragma("unroll") for (int k = 0; k < 2; ++k) \
        acc[ai][bj][m][n] = __builtin_amdgcn_mfma_f32_16x16x32_bf16(Bt[n][k], At[m][k], acc[ai][bj][m][n], 0, 0, 0); __builtin_amdgcn_s_setprio(0); } while (0)
#define PG8_WAIT_V(n) asm volatile("s_waitcnt vmcnt(" #n ")" ::: "memory")
#define PG8_WAIT_L(n) asm volatile("s_waitcnt lgkmcnt(" #n ")" ::: "memory")
#define PG8_BAR __builtin_amdgcn_s_barrier()
#define PG8_SCHED __builtin_amdgcn_sched_barrier(0)
    Unit cur, nxt; int ui = 0;
    if (!S.next(0, cur)) return;
    f32x4 acc[2][2][4][2];
#pragma unroll
    for (int a = 0; a < 2; ++a)
#pragma unroll
        for (int b = 0; b < 2; ++b)
#pragma unroll
            for (int m = 0; m < 4; ++m)
#pragma unroll
                for (int n = 0; n < 2; ++n) acc[a][b][m][n] = (f32x4){0.f, 0.f, 0.f, 0.f};
    bf16x8 At[4][2], B0[2][2], B1[2][2];
    const char* cA = (const char*)g.A + (size_t)cur.pm * tstep; const char* cB = (const char*)g.Bt + (size_t)cur.pn * tstep;
    S.a_ready(cur);
    PG8_STAGE(PG8_SB(0, 0), cB, voffB); PG8_STAGE(PG8_SA(0, 0), cA, voffA); PG8_STAGE(PG8_SB(0, 1), cB + hstep, voffB); PG8_STAGE(PG8_SA(0, 1), cA + hstep, voffA);
    if (wr == 1) PG8_BAR;
    PG8_WAIT_V(4); PG8_BAR;
    PG8_STAGE(PG8_SB(1, 0), cB + kstep, voffB); PG8_STAGE(PG8_SA(1, 0), cA + kstep, voffA); PG8_STAGE(PG8_SB(1, 1), cB + hstep + kstep, voffB);
    PG8_WAIT_V(6); PG8_BAR;
    PG8_STAMP();
    for (;;) {
        const bool has_next = S.next(ui + 1, nxt);
        const char* nA = has_next ? (const char*)g.A + (size_t)nxt.pm * tstep : cA; const char* nB = has_next ? (const char*)g.Bt + (size_t)nxt.pn * tstep : cB;
        for (int t = 0; t < nt; t += 2) {
            const bool last = (t == nt - 2);
            const char* a1 = cA + (size_t)(t + 1) * kstep;
            const char* a2 = last ? nA : cA + (size_t)(t + 2) * kstep; const char* b2 = last ? nB : cB + (size_t)(t + 2) * kstep;
            const char* a3 = a2 + kstep; const char* b3 = b2 + kstep;
            if (last && has_next) S.a_ready(nxt);
            PG8_LDB(B0, 0, 0); PG8_SCHED; PG8_LDA(At, 0, 0); PG8_STAGE(PG8_SA(1, 1), a1 + hstep, voffA);
            PG8_WAIT_L(8); PG8_BAR; PG8_WAIT_L(0); PG8_MMA(0, 0, At, B0); PG8_BAR; PG8_SCHED;
            PG8_LDB(B1, 0, 1); PG8_STAGE(PG8_SB(0, 0), b2, voffB);
            PG8_BAR; PG8_WAIT_L(0); PG8_MMA(0, 1, At, B1); PG8_BAR;
            PG8_LDA(At, 0, 1); PG8_STAGE(PG8_SA(0, 0), a2, voffA);
            PG8_BAR; PG8_WAIT_L(0); PG8_MMA(1, 0, At, B0); PG8_BAR; PG8_SCHED;
            PG8_STAGE(PG8_SB(0, 1), b2 + hstep, voffB);
            PG8_WAIT_V(6); PG8_BAR; PG8_MMA(1, 1, At, B1); PG8_BAR;
            PG8_LDB(B0, 1, 0); PG8_SCHED; PG8_LDA(At, 1, 0); PG8_STAGE(PG8_SA(0, 1), a2 + hstep, voffA);
            PG8_WAIT_L(8); PG8_BAR; PG8_WAIT_L(0); PG8_MMA(0, 0, At, B0); PG8_BAR; PG8_SCHED;
            PG8_LDB(B1, 1, 1); PG8_STAGE(PG8_SB(1, 0), b3, voffB);
            PG8_BAR; PG8_WAIT_L(0); PG8_MMA(0, 1, At, B1); PG8_BAR;
            PG8_LDA(At, 1, 1); PG8_STAGE(PG8_SA(1, 0), a3, voffA);
            PG8_BAR; PG8_WAIT_L(0); PG8_MMA(1, 0, At, B0); PG8_BAR; PG8_SCHED;
            PG8_STAGE(PG8_SB(1, 1), b3 + hstep, voffB);
            PG8_WAIT_V(6); PG8_BAR; PG8_MMA(1, 1, At, B1); PG8_BAR;
        }
        PG8_STAMP();
        if constexpr (!Epi::AFTER_DRAIN) { E(acc, cur, wr, wc, fr, fq); S.done(cur); }
        PG8_STAMP();
        if (!has_next) break;
#pragma unroll
        for (int a = 0; a < 2; ++a)
#pragma unroll
            for (int b = 0; b < 2; ++b)
#pragma unroll
                for (int m = 0; m < 4; ++m)
#pragma unroll
                    for (int n = 0; n < 2; ++n) acc[a][b][m][n] = (f32x4){0.f, 0.f, 0.f, 0.f};
        cur = nxt; cA = nA; cB = nB; ++ui;
    }
    PG8_WAIT_V(0);
    if (wr == 0) PG8_BAR;
    PG8_BAR;
    if constexpr (Epi::AFTER_DRAIN) { E.fused(acc, cur, wr, wc, fr, fq, lds, wid, lane); S.done(cur); }
    PG8_STAMP();
    if (STAMP && wid == 0) { stamps[lane] = lane < nts ? (((unsigned long long)(unsigned)ts_hi << 32) | (unsigned)ts_lo) : 0ull;
        if (lane == 62) stamps[62] = rt_entry; if (lane == 63) stamps[63] = (unsigned long long)wall_clock64(); }
#undef PG8_STAMP
#undef PG8_SA
#undef PG8_SB
#undef PG8_STAGE
#undef PG8_LDA
#undef PG8_LDB
#undef PG8_MMA
#undef PG8_WAIT_V
#undef PG8_WAIT_L
#undef PG8_BAR
#undef PG8_SCHED
}
}

struct EpiProj {
  static constexpr bool PERM = true, AFTER_DRAIN = false;
  unsigned short* pH; unsigned short* pA; unsigned short* pG;
  __device__ __forceinline__ void operator()(const pg8::f32x4 (&acc)[2][2][4][2], const pg8::Unit& u, int wr, int wc, int fr, int fq) const {
    const int row0 = u.pm * 256 + wr * 64 + fr;
    unsigned short* base; int ldc, colt; bool sg = false;
    if (u.pn < 8) { base = pH; ldc = 2048; colt = u.pn * 256; }
    else if (u.pn < 12) { base = pA; ldc = 1024; colt = (u.pn - 8) * 256; }
    else { base = pG; ldc = 2048; colt = (u.pn - 12) * 256; sg = true; }
    const int col0 = colt + wc * 32 + 8 * fq;
#pragma unroll
    for (int ai = 0; ai < 2; ++ai)
#pragma unroll
      for (int m = 0; m < 4; ++m) {
        unsigned short* rowp = base + (size_t)(row0 + ai * 128 + m * 16) * ldc + col0;
#pragma unroll
        for (int bj = 0; bj < 2; ++bj) {
          pg8::f32x4 v0 = acc[ai][bj][m][0], v1 = acc[ai][bj][m][1];
          if (sg) {
#pragma unroll
            for (int j = 0; j < 4; ++j) { v0[j] = sigmoidf_(v0[j]); v1[j] = sigmoidf_(v1[j]); }
          }
          pg8::u32x4 w; w.x = pg8::cvt_pk_bf16(v0[0], v0[1]); w.y = pg8::cvt_pk_bf16(v0[2], v0[3]); w.z = pg8::cvt_pk_bf16(v1[0], v1[1]); w.w = pg8::cvt_pk_bf16(v1[2], v1[3]);
          *(pg8::u32x4*)(rowp + bj * 128) = w;
        }
      }
  }
};
template <int MODE> struct EpiGate {
  static constexpr bool PERM = true, AFTER_DRAIN = false;
  unsigned short* hb; const unsigned short* pG; int goff;
  __device__ __forceinline__ void operator()(const pg8::f32x4 (&acc)[2][2][4][2], const pg8::Unit& u, int wr, int wc, int fr, int fq) const {
    const int row0 = u.pm * 256 + wr * 64 + fr;
    const int col0 = u.pn * 256 + wc * 32 + 8 * fq;
#pragma unroll
    for (int ai = 0; ai < 2; ++ai)
#pragma unroll
      for (int m = 0; m < 4; ++m) {
        const size_t r = (size_t)(row0 + ai * 128 + m * 16);
        pg8::u32x4 gv[2], hv[2];
#pragma unroll
        for (int bj = 0; bj < 2; ++bj) {
          gv[bj] = *(const pg8::u32x4*)(pG + r * 2048 + goff + col0 + bj * 128);
          if (MODE == 1) hv[bj] = *(const pg8::u32x4*)(hb + r * 1024 + col0 + bj * 128);
        }
#pragma unroll
        for (int bj = 0; bj < 2; ++bj) {
          float o[8];
#pragma unroll
          for (int j = 0; j < 4; ++j) {
            const unsigned gw0 = gv[bj][j >> 1], gw1 = gv[bj][2 + (j >> 1)];
            const float g0 = (j & 1) ? __uint_as_float(gw0 & 0xffff0000u) : __uint_as_float(gw0 << 16);
            const float g1 = (j & 1) ? __uint_as_float(gw1 & 0xffff0000u) : __uint_as_float(gw1 << 16);
            o[j] = acc[ai][bj][m][0][j] * g0; o[4 + j] = acc[ai][bj][m][1][j] * g1;
            if (MODE == 1) {
              const unsigned hw0 = hv[bj][j >> 1], hw1 = hv[bj][2 + (j >> 1)];
              o[j] += (j & 1) ? __uint_as_float(hw0 & 0xffff0000u) : __uint_as_float(hw0 << 16);
              o[4 + j] += (j & 1) ? __uint_as_float(hw1 & 0xffff0000u) : __uint_as_float(hw1 << 16);
            }
          }
          pg8::u32x4 w; w.x = pg8::cvt_pk_bf16(o[0], o[1]); w.y = pg8::cvt_pk_bf16(o[2], o[3]); w.z = pg8::cvt_pk_bf16(o[4], o[5]); w.w = pg8::cvt_pk_bf16(o[6], o[7]);
          *(pg8::u32x4*)(hb + r * 1024 + col0 + bj * 128) = w;
        }
      }
  }
};
struct EpiResid {
  static constexpr bool PERM = false, AFTER_DRAIN = false;
  float* out; const float* x;
  __device__ __forceinline__ void operator()(const pg8::f32x4 (&acc)[2][2][4][2], const pg8::Unit& u, int wr, int wc, int fr, int fq) const {
    const int row0 = u.pm * 256 + wr * 64 + fr, col0 = u.pn * 256 + wc * 32 + 4 * fq;
#pragma unroll
    for (int ai = 0; ai < 2; ++ai)
#pragma unroll
      for (int m = 0; m < 4; ++m) {
        const size_t off = (size_t)(row0 + ai * 128 + m * 16) * 1024 + col0;
        pg8::f32x4 xv[2][2];
#pragma unroll
        for (int bj = 0; bj < 2; ++bj)
#pragma unroll
          for (int n = 0; n < 2; ++n) xv[bj][n] = *(const pg8::f32x4*)(x + off + bj * 128 + n * 16);
#pragma unroll
        for (int bj = 0; bj < 2; ++bj)
#pragma unroll
          for (int n = 0; n < 2; ++n) *(pg8::f32x4*)(out + off + bj * 128 + n * 16) = acc[ai][bj][m][n] + xv[bj][n];
      }
  }
};
struct EpiStoreBf16 {
  static constexpr bool PERM = true, AFTER_DRAIN = false;
  unsigned short* O; int ldc;
  __device__ __forceinline__ void operator()(const pg8::f32x4 (&acc)[2][2][4][2], const pg8::Unit& u, int wr, int wc, int fr, int fq) const {
    const int row0 = u.pm * 256 + wr * 64 + fr, col0 = u.pn * 256 + wc * 32 + 8 * fq;
#pragma unroll
    for (int ai = 0; ai < 2; ++ai)
#pragma unroll
      for (int m = 0; m < 4; ++m) {
        unsigned short* rowp = O + (size_t)(row0 + ai * 128 + m * 16) * ldc + col0;
#pragma unroll
        for (int bj = 0; bj < 2; ++bj) {
          const pg8::f32x4 v0 = acc[ai][bj][m][0], v1 = acc[ai][bj][m][1];
          pg8::u32x4 w; w.x = pg8::cvt_pk_bf16(v0[0], v0[1]); w.y = pg8::cvt_pk_bf16(v0[2], v0[3]); w.z = pg8::cvt_pk_bf16(v1[0], v1[1]); w.w = pg8::cvt_pk_bf16(v1[2], v1[3]);
          *(pg8::u32x4*)(rowp + bj * 128) = w;
        }
      }
  }
};

__device__ __forceinline__ void gemm_tile(const bf16_t* __restrict__ A, int lda, const bf16_t* __restrict__ Bt, int ldb,
                                          int nk, f32x4 (&acc)[4][4], unsigned char* smem) {
  const int tid = threadIdx.x, lane = tid & 63, w = tid >> 6, wm = w >> 1, wn = w & 1, l15 = lane & 15, g = lane >> 4;
  unsigned char* sA = smem;
  unsigned char* sB = smem + 32768;
  const int lr = tid >> 3, lc = tid & 7;
  const bf16_t* ga = A + (size_t)lr * lda + lc * 8;
  const bf16_t* gb = Bt + (size_t)lr * ldb + lc * 8;
  uint4 ra0, ra1, ra2, ra3, rb0, rb1;
  ra0 = *(const uint4*)(ga);
  ra1 = *(const uint4*)(ga + (size_t)64 * lda);
  ra2 = *(const uint4*)(ga + (size_t)128 * lda);
  ra3 = *(const uint4*)(ga + (size_t)192 * lda);
  rb0 = *(const uint4*)(gb);
  rb1 = *(const uint4*)(gb + (size_t)64 * ldb);
  const int sw = (lc ^ (lr & 7)) << 4;
  for (int kt = 0; kt < nk; ++kt) {
    __syncthreads();
    *(uint4*)(sA + (lr) * 128 + sw) = ra0;
    *(uint4*)(sA + (lr + 64) * 128 + sw) = ra1;
    *(uint4*)(sA + (lr + 128) * 128 + sw) = ra2;
    *(uint4*)(sA + (lr + 192) * 128 + sw) = ra3;
    *(uint4*)(sB + (lr) * 128 + sw) = rb0;
    *(uint4*)(sB + (lr + 64) * 128 + sw) = rb1;
    __syncthreads();
    if (kt + 1 < nk) {
      const int ko = (kt + 1) * 64;
      ra0 = *(const uint4*)(ga + ko);
      ra1 = *(const uint4*)(ga + (size_t)64 * lda + ko);
      ra2 = *(const uint4*)(ga + (size_t)128 * lda + ko);
      ra3 = *(const uint4*)(ga + (size_t)192 * lda + ko);
      rb0 = *(const uint4*)(gb + ko);
      rb1 = *(const uint4*)(gb + (size_t)64 * ldb + ko);
    }
#pragma unroll
    for (int ks = 0; ks < 2; ++ks) {
      bf16x8 a[4], b[4];
#pragma unroll
      for (int m = 0; m < 4; ++m) { const int r = wm * 64 + m * 16 + l15; a[m] = *(const bf16x8*)(sA + r * 128 + (((ks * 4 + g) ^ (r & 7)) << 4)); }
#pragma unroll
      for (int n = 0; n < 4; ++n) { const int r = wn * 64 + n * 16 + l15; b[n] = *(const bf16x8*)(sB + r * 128 + (((ks * 4 + g) ^ (r & 7)) << 4)); }
#pragma unroll
      for (int m = 0; m < 4; ++m)
#pragma unroll
        for (int n = 0; n < 4; ++n) acc[m][n] = __builtin_amdgcn_mfma_f32_16x16x32_bf16(a[m], b[n], acc[m][n], 0, 0, 0);
    }
  }
}

__device__ __forceinline__ void zero_acc(f32x4 (&acc)[4][4]) {
#pragma unroll
  for (int m = 0; m < 4; ++m)
#pragma unroll
    for (int n = 0; n < 4; ++n) acc[m][n] = (f32x4){0.f, 0.f, 0.f, 0.f};
}

__device__ __forceinline__ void transpose_tile(const float* __restrict__ src, int srcN, bf16_t* __restrict__ dst, int K, int n0, int k0,
                                               bool winmap, float* tile) {
  const int tid = threadIdx.x;
  const int nc = tid & 63, kr = tid >> 6;
  int ncol = n0 + nc; bool valid = true;
  if (winmap) { if (ncol >= 3072) ncol -= 60; else if (ncol >= 3012) valid = false; }
#pragma unroll
  for (int i = 0; i < 8; ++i) {
    const int k = kr + 8 * i;
    tile[k * 65 + nc] = valid ? src[(size_t)(k0 + k) * srcN + ncol] : 0.f;
  }
  __syncthreads();
#pragma unroll
  for (int i = 0; i < 8; ++i) {
    const int nr = kr + 8 * i;
    dst[(size_t)(n0 + nr) * K + k0 + nc] = f2bf(tile[nc * 65 + nr]);
  }
  __syncthreads();
}

__device__ __forceinline__ void convert_f32_bf16(const float* __restrict__ src, bf16_t* __restrict__ dst, size_t n4) {
  for (size_t i = (size_t)blockIdx.x * NTHREADS + threadIdx.x; i < n4; i += (size_t)gridDim.x * NTHREADS) {
    const float4 v = ((const float4*)src)[i];
    uint2 o; o.x = pack2(v.x, v.y); o.y = pack2(v.z, v.w);
    ((uint2*)dst)[i] = o;
  }
}

template <bool SLICE_MAJOR, bool SIGNED>
__device__ __forceinline__ void quantize_rows_u8(const float* __restrict__ src, unsigned char* __restrict__ dst, float* __restrict__ scale, int row_lo, int row_hi) {
  const int lane = threadIdx.x & 63, w = threadIdx.x >> 6;
  for (int row = row_lo + w; row < row_hi; row += 8) {
    const float4* s4 = (const float4*)(src + (size_t)row * 1024) + lane * 4;
    float4 v[4];
    float am = 0.f;
#pragma unroll
    for (int i = 0; i < 4; ++i) { v[i] = s4[i]; am = fmaxf(am, fmaxf(fmaxf(fabsf(v[i].x), fabsf(v[i].y)), fmaxf(fabsf(v[i].z), fabsf(v[i].w)))); }
#pragma unroll
    for (int o = 32; o > 0; o >>= 1) am = fmaxf(am, __shfl_xor(am, o));
    const float inv = am > 0.f ? 127.f / am : 0.f;
    unsigned pk[4];
#pragma unroll
    for (int i = 0; i < 4; ++i) {
      const int ofs = SIGNED ? 0 : 128;
      const unsigned b0 = (unsigned)((int)rintf(v[i].x * inv) + ofs), b1 = (unsigned)((int)rintf(v[i].y * inv) + ofs);
      const unsigned b2 = (unsigned)((int)rintf(v[i].z * inv) + ofs), b3 = (unsigned)((int)rintf(v[i].w * inv) + ofs);
      pk[i] = (b0 & 255u) | ((b1 & 255u) << 8) | ((b2 & 255u) << 16) | ((b3 & 255u) << 24);
    }
    if (SLICE_MAJOR) *(uint4*)(dst + (size_t)(lane >> 3) * (16384 * 128) + (size_t)row * 128 + (lane & 7) * 16) = make_uint4(pk[0], pk[1], pk[2], pk[3]);
    else *(uint4*)(dst + (size_t)row * 1024 + lane * 16) = make_uint4(pk[0], pk[1], pk[2], pk[3]);
    if (lane == 0) scale[row] = am * (1.f / 127.f);
  }
}

#define WS_XQ (WS_PH + (size_t)TOK * 1024 * 2)
#define WS_XS (WS_XQ + (size_t)TOK * 1024)
__device__ __forceinline__ void rmsnorm_rows_q(const float* __restrict__ src, const float* __restrict__ g, bf16_t* __restrict__ dst,
                                               unsigned char* __restrict__ xq, float* __restrict__ xs) {
  const int lane = threadIdx.x & 63, w = threadIdx.x >> 6;
  for (int row = blockIdx.x * 8 + w; row < TOK; row += gridDim.x * 8) {
    const float4* s4 = (const float4*)(src + (size_t)row * DM) + lane * 4;
    const float4* g4 = (const float4*)g + lane * 4;
    float v[16]; float ss = 0.f;
#pragma unroll
    for (int i = 0; i < 4; ++i) { const float4 t = s4[i]; v[4 * i] = t.x; v[4 * i + 1] = t.y; v[4 * i + 2] = t.z; v[4 * i + 3] = t.w; ss += t.x * t.x + t.y * t.y + t.z * t.z + t.w * t.w; }
    ss = wave_sum(ss);
    const float rstd = rsqrtf(ss * (1.f / DM) + EPSV);
    float am = 0.f;
#pragma unroll
    for (int i = 0; i < 4; ++i) { const float4 gg = g4[i]; v[4 * i] *= rstd * gg.x; v[4 * i + 1] *= rstd * gg.y; v[4 * i + 2] *= rstd * gg.z; v[4 * i + 3] *= rstd * gg.w; }
#pragma unroll
    for (int i = 0; i < 16; ++i) am = fmaxf(am, fabsf(v[i]));
#pragma unroll
    for (int o = 32; o > 0; o >>= 1) am = fmaxf(am, __shfl_xor(am, o));
    const float inv = am > 0.f ? 127.f / am : 0.f;
    uint4 ob0, ob1;
    ob0.x = pack2(v[0], v[1]); ob0.y = pack2(v[2], v[3]); ob0.z = pack2(v[4], v[5]); ob0.w = pack2(v[6], v[7]);
    ob1.x = pack2(v[8], v[9]); ob1.y = pack2(v[10], v[11]); ob1.z = pack2(v[12], v[13]); ob1.w = pack2(v[14], v[15]);
    *(uint4*)(dst + (size_t)row * DM + lane * 16) = ob0;
    *(uint4*)(dst + (size_t)row * DM + lane * 16 + 8) = ob1;
    unsigned pk[4];
#pragma unroll
    for (int i = 0; i < 4; ++i) {
      const unsigned b0 = (unsigned)(int)rintf(v[4 * i] * inv) & 255u, b1 = (unsigned)(int)rintf(v[4 * i + 1] * inv) & 255u;
      const unsigned b2 = (unsigned)(int)rintf(v[4 * i + 2] * inv) & 255u, b3 = (unsigned)(int)rintf(v[4 * i + 3] * inv) & 255u;
      pk[i] = b0 | (b1 << 8) | (b2 << 16) | (b3 << 24);
    }
    *(uint4*)(xq + (size_t)row * 1024 + lane * 16) = make_uint4(pk[0], pk[1], pk[2], pk[3]);
    if (lane == 0) xs[row] = am * (1.f / 127.f);
  }
}

__device__ __forceinline__ void rmsnorm_rows(const float* __restrict__ src, const float* __restrict__ g, bf16_t* __restrict__ dst) {
  const int lane = threadIdx.x & 63, w = threadIdx.x >> 6;
  for (int row = blockIdx.x * 8 + w; row < TOK; row += gridDim.x * 8) {
    const float4* s4 = (const float4*)(src + (size_t)row * DM);
    float4 v[4]; float ss = 0.f;
#pragma unroll
    for (int i = 0; i < 4; ++i) { v[i] = s4[lane + 64 * i]; ss += v[i].x * v[i].x + v[i].y * v[i].y + v[i].z * v[i].z + v[i].w * v[i].w; }
    ss = wave_sum(ss);
    const float rstd = rsqrtf(ss * (1.f / DM) + EPSV);
#pragma unroll
    for (int i = 0; i < 4; ++i) {
      const float4 gg = ((const float4*)g)[lane + 64 * i];
      uint2 o; o.x = pack2(v[i].x * rstd * gg.x, v[i].y * rstd * gg.y); o.y = pack2(v[i].z * rstd * gg.z, v[i].w * rstd * gg.w);
      ((uint2*)(dst + (size_t)row * DM))[lane + 64 * i] = o;
    }
  }
}

__device__ __forceinline__ void phase_prep(const Params& p, unsigned char* smem) {
  unsigned char* ws = p.ws;
  float* tile = (float*)smem;
  const int n_win = 80 * 16, n_ua = 16 * 8, n_ub = 16 * 8, n_wo = 16 * 16, n_wq = 32 * 16;
  const int total = n_win + n_ua + n_ub + n_wo + n_wq;
  for (int it = blockIdx.x; it < total; it += gridDim.x) {
    int t = it;
    if (t < n_win) { transpose_tile(p.w_in, 5060, (bf16_t*)(ws + WS_WIN), 1024, (t >> 4) * 64, (t & 15) * 64, true, tile); continue; }
    t -= n_win;
    if (t < n_ua) { transpose_tile(p.w_up_a, 1024, (bf16_t*)(ws + WS_WUPA), 512, (t >> 3) * 64, (t & 7) * 64, false, tile); continue; }
    t -= n_ua;
    if (t < n_ub) { transpose_tile(p.w_up_b, 1024, (bf16_t*)(ws + WS_WUPB), 512, (t >> 3) * 64, (t & 7) * 64, false, tile); continue; }
    t -= n_ub;
    if (t < n_wo) { transpose_tile(p.w_out, 1024, (bf16_t*)(ws + WS_WOUT), 1024, (t >> 4) * 64, (t & 15) * 64, false, tile); continue; }
    t -= n_wo;
    transpose_tile(p.peer_wq, 2048, (bf16_t*)(ws + WS_WQ), 1024, (t >> 4) * 64, (t & 15) * 64, false, tile);
  }
  convert_f32_bf16(p.peer_keys, (bf16_t*)(ws + WS_KEYS), (size_t)2 * 8 * 128 * 128 / 4);
  for (int i = blockIdx.x * NTHREADS + threadIdx.x; i < TOK; i += gridDim.x * NTHREADS) ((float*)(ws + WS_SSQ))[i] = 0.f;
  if (threadIdx.x == 0) ((int*)(ws + WS_XCC))[blockIdx.x] = (int)(__builtin_amdgcn_s_getreg((3 << 11) | 20) & 0xFu);
  if (blockIdx.x == 0 && threadIdx.x == 0) *(unsigned*)(ws + WS_QCTR) = 0u;
  if (blockIdx.x == 0) {
    const int i = threadIdx.x;
    const float a0 = p.hg_lb[i], a1 = p.hg_lb[512 + i];
    ((float*)(ws + WS_LB))[i] = 1.f / (1.f + expf(a1 - a0));
  }
  rmsnorm_rows(p.x, p.norm_mix, (bf16_t*)(ws + WS_XN));
}

__device__ __forceinline__ void phase_proj(const Params& p, unsigned char* smem) {
  unsigned char* ws = p.ws;
  const bf16_t* xn = (const bf16_t*)(ws + WS_XN);
  const bf16_t* wt = (const bf16_t*)(ws + WS_WIN);
  bf16_t* pH = (bf16_t*)(ws + WS_PH);
  bf16_t* pA = (bf16_t*)(ws + WS_PA);
  bf16_t* pG = (bf16_t*)(ws + WS_PG);
  const int tid = threadIdx.x, lane = tid & 63, w = tid >> 6, wm = w >> 1, wn = w & 1, l15 = lane & 15, g = lane >> 4;
  for (int tile = blockIdx.x; tile < 128 * 40; tile += gridDim.x) {
    const int tn = tile % 40, tm = tile / 40;
    f32x4 acc[4][4]; zero_acc(acc);
    gemm_tile(xn + (size_t)tm * 256 * 1024, 1024, wt + (size_t)tn * 128 * 1024, 1024, 16, acc, smem);
    const int rbase = tm * 256 + wm * 64 + 4 * g;
    const int cbase = tn * 128 + wn * 64 + l15;
    if (tn < 16) {
#pragma unroll
      for (int m = 0; m < 4; ++m)
#pragma unroll
        for (int n = 0; n < 4; ++n)
#pragma unroll
          for (int j = 0; j < 4; ++j) pH[(size_t)(rbase + m * 16 + j) * 2048 + cbase + n * 16] = f2bf(acc[m][n][j]);
    } else if (tn < 24) {
      if (tn == 23 && wn == 0) {
        float gam[4], bet[4];
#pragma unroll
        for (int n = 0; n < 4; ++n) { gam[n] = p.ikg[n * 16 + l15]; bet[n] = p.ikb[n * 16 + l15]; }
#pragma unroll
        for (int m = 0; m < 4; ++m)
#pragma unroll
          for (int j = 0; j < 4; ++j) {
            float s = acc[m][0][j] + acc[m][1][j] + acc[m][2][j] + acc[m][3][j];
            s += __shfl_xor(s, 1); s += __shfl_xor(s, 2); s += __shfl_xor(s, 4); s += __shfl_xor(s, 8);
            const float mu = s * (1.f / 64.f);
            float q = 0.f;
#pragma unroll
            for (int n = 0; n < 4; ++n) { const float d = acc[m][n][j] - mu; q += d * d; }
            q += __shfl_xor(q, 1); q += __shfl_xor(q, 2); q += __shfl_xor(q, 4); q += __shfl_xor(q, 8);
            const float rstd = rsqrtf(q * (1.f / 64.f) + EPSV);
#pragma unroll
            for (int n = 0; n < 4; ++n)
              pA[(size_t)(rbase + m * 16 + j) * 1024 + (cbase - 2048) + n * 16] = f2bf((acc[m][n][j] - mu) * rstd * gam[n] + bet[n]);
          }
      } else {
#pragma unroll
        for (int m = 0; m < 4; ++m)
#pragma unroll
          for (int n = 0; n < 4; ++n)
#pragma unroll
            for (int j = 0; j < 4; ++j) pA[(size_t)(rbase + m * 16 + j) * 1024 + (cbase - 2048) + n * 16] = f2bf(acc[m][n][j]);
      }
    } else {
#pragma unroll
      for (int m = 0; m < 4; ++m)
#pragma unroll
        for (int n = 0; n < 4; ++n)
#pragma unroll
          for (int j = 0; j < 4; ++j) pG[(size_t)(rbase + m * 16 + j) * 2048 + (cbase - 3072) + n * 16] = f2bf(sigmoidf_(acc[m][n][j]));
    }
  }
}

__device__ __forceinline__ void hgrn_item(const Params& p, unsigned char* smem, int bh) {
  unsigned char* ws = p.ws;
  const bf16_t* pH = (const bf16_t*)(ws + WS_PH);
  const float* lbp = (const float*)(ws + WS_LB);
  bf16_t* ya = (bf16_t*)(ws + WS_XN);
  bf16_t* Qt = (bf16_t*)smem;
  bf16_t* Kt = Qt + 64 * 136;
  bf16_t* KtT = Kt + 64 * 136;
  bf16_t* VT = KtT + 128 * 72;
  bf16_t* Am = VT + 128 * 72;
  bf16_t* ST = Am + 64 * 72;
  float* qtot = (float*)(ST + 128 * 136);
  float* eref = qtot + 512;
  float* elast = eref + 128;
  float* elr = elast + 128;
  float* red = elr + 128;
  const int tid = threadIdx.x, lane = tid & 63, w = tid >> 6, l15 = lane & 15, g = lane >> 4;
  const int b = bh >> 2, h = bh & 3;
  const int d = tid & 127, tq = tid >> 7;
  const float lbv = lbp[h * 128 + d];
  f32x4 S[8];
#pragma unroll
  for (int i = 0; i < 8; ++i) S[i] = (f32x4){0.f, 0.f, 0.f, 0.f};
  const float gnv = p.hg_norm[h * 128 + 16 * w + l15];

  for (int chunk = 0; chunk < 64; ++chunk) {
    const size_t row0 = (size_t)b * SEQL + chunk * 64;
    {
      const bf16_t* base = pH + (row0 + tq * 16) * 2048 + h * 128 + d;
      float lf[16], kk[16], qs[16];
      unsigned vv[8];
      float run = 0.f;
#pragma unroll
      for (int i = 0; i < 16; ++i) {
        const float fr = bf2f(base[(size_t)i * 2048 + 512]);
        const float qr = bf2f(base[(size_t)i * 2048]);
        const float sg = sigmoidf_(fr);
        const float fg = lbv + (1.f - lbv) * sg;
        run += __logf(fg);
        lf[i] = run; kk[i] = 1.f - fg; qs[i] = siluf_(qr);
      }
#pragma unroll
      for (int i = 0; i < 8; ++i) {
        const unsigned lo = base[(size_t)(2 * i) * 2048 + 1024], hi = base[(size_t)(2 * i + 1) * 2048 + 1024];
        vv[i] = lo | (hi << 16);
      }
      qtot[tq * 128 + d] = run;
      __syncthreads();
      const float q0 = qtot[d], q1 = qtot[128 + d], q2 = qtot[256 + d], q3 = qtot[384 + d];
      const float pre = (tq > 0 ? q0 : 0.f) + (tq > 1 ? q1 : 0.f) + (tq > 2 ? q2 : 0.f);
      const float bref = q0 + q1;
      const float blast = bref + q2 + q3;
      unsigned kp[8];
#pragma unroll
      for (int i = 0; i < 16; ++i) {
        const float bt = pre + lf[i];
        const float qt = qs[i] * __expf(bt - bref);
        const float kt = kk[i] * __expf(bref - bt);
        const int t = tq * 16 + i;
        Qt[t * 136 + d] = f2bf(qt);
        const bf16_t kb = f2bf(kt);
        Kt[t * 136 + d] = kb;
        if (i & 1) kp[i >> 1] |= ((unsigned)kb) << 16; else kp[i >> 1] = kb;
      }
      *(uint4*)(KtT + d * 72 + tq * 16) = make_uint4(kp[0], kp[1], kp[2], kp[3]);
      *(uint4*)(KtT + d * 72 + tq * 16 + 8) = make_uint4(kp[4], kp[5], kp[6], kp[7]);
      *(uint4*)(VT + d * 72 + tq * 16) = make_uint4(vv[0], vv[1], vv[2], vv[3]);
      *(uint4*)(VT + d * 72 + tq * 16 + 8) = make_uint4(vv[4], vv[5], vv[6], vv[7]);
      if (tq == 0) { eref[d] = __expf(bref); elast[d] = __expf(blast); elr[d] = __expf(blast - bref); }
    }
    __syncthreads();
    bf16_t ogr[16];
#pragma unroll
    for (int tm = 0; tm < 4; ++tm)
#pragma unroll
      for (int j = 0; j < 4; ++j) ogr[tm * 4 + j] = pH[(row0 + tm * 16 + 4 * g + j) * 2048 + 1536 + h * 128 + 16 * w + l15];
    {
      const int e = 16 * w + l15;
#pragma unroll
      for (int dm = 0; dm < 8; ++dm) {
        const int d0 = 16 * dm + 4 * g;
        uint2 o;
        o.x = pack2(S[dm][0] * eref[d0], S[dm][1] * eref[d0 + 1]);
        o.y = pack2(S[dm][2] * eref[d0 + 2], S[dm][3] * eref[d0 + 3]);
        *(uint2*)(ST + e * 136 + d0) = o;
      }
#pragma unroll
      for (int tt = 0; tt < 2; ++tt) {
        const int tl = 2 * w + tt, sm = tl >> 2, tn = tl & 3;
        f32x4 acc = (f32x4){0.f, 0.f, 0.f, 0.f};
        if (tn >= sm) {
#pragma unroll
          for (int k0 = 0; k0 < 128; k0 += 32) {
            const bf16x8 a = *(const bf16x8*)(Kt + (sm * 16 + l15) * 136 + k0 + 8 * g);
            const bf16x8 bq = *(const bf16x8*)(Qt + (tn * 16 + l15) * 136 + k0 + 8 * g);
            acc = __builtin_amdgcn_mfma_f32_16x16x32_bf16(a, bq, acc, 0, 0, 0);
          }
        }
        const int t = tn * 16 + l15, s0 = sm * 16 + 4 * g;
        uint2 o;
        o.x = pack2(s0 + 0 <= t ? acc[0] : 0.f, s0 + 1 <= t ? acc[1] : 0.f);
        o.y = pack2(s0 + 2 <= t ? acc[2] : 0.f, s0 + 3 <= t ? acc[3] : 0.f);
        *(uint2*)(Am + t * 72 + s0) = o;
      }
    }
    __syncthreads();
    f32x4 o[4];
    {
#pragma unroll
      for (int tm = 0; tm < 4; ++tm) {
        f32x4 acc = (f32x4){0.f, 0.f, 0.f, 0.f};
#pragma unroll
        for (int k0 = 0; k0 < 128; k0 += 32) {
          const bf16x8 a = *(const bf16x8*)(Qt + (tm * 16 + l15) * 136 + k0 + 8 * g);
          const bf16x8 bb = *(const bf16x8*)(ST + (16 * w + l15) * 136 + k0 + 8 * g);
          acc = __builtin_amdgcn_mfma_f32_16x16x32_bf16(a, bb, acc, 0, 0, 0);
        }
#pragma unroll
        for (int k0 = 0; k0 < 64; k0 += 32) {
          const bf16x8 a = *(const bf16x8*)(Am + (tm * 16 + l15) * 72 + k0 + 8 * g);
          const bf16x8 bb = *(const bf16x8*)(VT + (16 * w + l15) * 72 + k0 + 8 * g);
          acc = __builtin_amdgcn_mfma_f32_16x16x32_bf16(a, bb, acc, 0, 0, 0);
        }
        o[tm] = acc;
#pragma unroll
        for (int j = 0; j < 4; ++j) {
          float ss = acc[j] * acc[j];
          ss += __shfl_xor(ss, 1); ss += __shfl_xor(ss, 2); ss += __shfl_xor(ss, 4); ss += __shfl_xor(ss, 8);
          if (l15 == 0) red[w * 64 + tm * 16 + 4 * g + j] = ss;
        }
      }
#pragma unroll
      for (int dm = 0; dm < 8; ++dm) {
        f32x4 acc = (f32x4){0.f, 0.f, 0.f, 0.f};
#pragma unroll
        for (int k0 = 0; k0 < 64; k0 += 32) {
          const bf16x8 a = *(const bf16x8*)(KtT + (dm * 16 + l15) * 72 + k0 + 8 * g);
          const bf16x8 bb = *(const bf16x8*)(VT + (16 * w + l15) * 72 + k0 + 8 * g);
          acc = __builtin_amdgcn_mfma_f32_16x16x32_bf16(a, bb, acc, 0, 0, 0);
        }
#pragma unroll
        for (int j = 0; j < 4; ++j) { const int dd = 16 * dm + 4 * g + j; S[dm][j] = elast[dd] * S[dm][j] + elr[dd] * acc[j]; }
      }
    }
    __syncthreads();
    {
      const int e = 16 * w + l15;
#pragma unroll
      for (int tm = 0; tm < 4; ++tm)
#pragma unroll
        for (int j = 0; j < 4; ++j) {
          const int t = tm * 16 + 4 * g + j;
          float tot = 0.f;
#pragma unroll
          for (int ww = 0; ww < 8; ++ww) tot += red[ww * 64 + t];
          const float rstd = rsqrtf(tot * (1.f / 128.f) + EPSV);
          const float og = bf2f(ogr[tm * 4 + j]);
          ya[(row0 + t) * 512 + h * 128 + e] = f2bf(o[tm][j] * rstd * gnv * siluf_(og));
        }
    }
  }
}


__device__ __forceinline__ void hgrn_h1_all(const Params& p, unsigned char* smem) {
  unsigned char* ws = p.ws;
  bf16_t* pH = (bf16_t*)(ws + WS_PH);
  const float* lbp = (const float*)(ws + WS_LB);
  bf16_t* Qt = (bf16_t*)smem;
  bf16_t* Kt = Qt + 64 * 136;
  bf16_t* KtT = Kt + 64 * 136;
  bf16_t* VT = KtT + 128 * 72;
  bf16_t* Am = VT + 128 * 72;
  float* qtot = (float*)(Am + 64 * 72);
  const int tid = threadIdx.x, lane = tid & 63, w = tid >> 6, l15 = lane & 15, g = lane >> 4;
  const int d = tid & 127, tq = tid >> 7;
  const int G = gridDim.x;
  if ((int)blockIdx.x >= 2048) return;
  bf16_t fr_[16], qr_[16]; unsigned short vr_[16];
#define H1_LOAD(IT) do { \
    const int bh_ = (IT) >> 6, ch_ = (IT) & 63; \
    const bf16_t* base_ = pH + ((size_t)(bh_ >> 2) * SEQL + ch_ * 64 + tq * 16) * 2048 + (bh_ & 3) * 128 + d; \
    _Pragma("unroll") for (int i = 0; i < 16; ++i) { fr_[i] = base_[(size_t)i * 2048 + 512]; qr_[i] = base_[(size_t)i * 2048]; vr_[i] = base_[(size_t)i * 2048 + 1024]; } \
  } while (0)
  H1_LOAD((int)blockIdx.x);
  for (int item = blockIdx.x; item < 2048; item += G) {
    const int bh = item >> 6, chunk = item & 63;
    const int b = bh >> 2, h = bh & 3;
    const float lbv = lbp[h * 128 + d];
    const size_t row0 = (size_t)b * SEQL + chunk * 64;
    float* dec = (float*)(ws + WS_DEC) + (size_t)item * 384;
    uint4* UU = (uint4*)p.out + (size_t)item * 2048 + tid;
    float4* OI = (float4*)((unsigned char*)p.out + ((size_t)64 << 20)) + (size_t)item * 2048 + tid;
    {
      unsigned vv[8];
#pragma unroll
      for (int i = 0; i < 8; ++i) vv[i] = (unsigned)vr_[2 * i] | ((unsigned)vr_[2 * i + 1] << 16);
      float lf[16], kk[16], qs[16];
      float run = 0.f;
#pragma unroll
      for (int i = 0; i < 16; ++i) {
        const float sg = sigmoidf_(bf2f(fr_[i]));
        const float fg = lbv + (1.f - lbv) * sg;
        run += __logf(fg);
        lf[i] = run; kk[i] = 1.f - fg; qs[i] = siluf_(bf2f(qr_[i]));
      }
      qtot[tq * 128 + d] = run;
      __syncthreads();
      { const int nit = (item + G < 2048) ? item + G : item; H1_LOAD(nit); }
      const float q0 = qtot[d], q1 = qtot[128 + d], q2 = qtot[256 + d], q3 = qtot[384 + d];
      const float pre = (tq > 0 ? q0 : 0.f) + (tq > 1 ? q1 : 0.f) + (tq > 2 ? q2 : 0.f);
      const float bref = q0 + q1;
      const float blast = bref + q2 + q3;
      unsigned kp[8];
#pragma unroll
      for (int i = 0; i < 16; ++i) {
        const float bt = pre + lf[i];
        const float qt = qs[i] * __expf(bt - bref);
        const float kt = kk[i] * __expf(bref - bt);
        const int t = tq * 16 + i;
        Qt[t * 136 + d] = f2bf(qt);
        const bf16_t kb = f2bf(kt);
        Kt[t * 136 + d] = kb;
        if (i & 1) kp[i >> 1] |= ((unsigned)kb) << 16; else kp[i >> 1] = kb;
      }
      *(uint4*)(KtT + d * 72 + tq * 16) = make_uint4(kp[0], kp[1], kp[2], kp[3]);
      *(uint4*)(KtT + d * 72 + tq * 16 + 8) = make_uint4(kp[4], kp[5], kp[6], kp[7]);
      *(uint4*)(VT + d * 72 + tq * 16) = make_uint4(vv[0], vv[1], vv[2], vv[3]);
      *(uint4*)(VT + d * 72 + tq * 16 + 8) = make_uint4(vv[4], vv[5], vv[6], vv[7]);
      if (tq == 0) { dec[d] = __expf(bref); dec[128 + d] = __expf(blast); dec[256 + d] = __expf(blast - bref); }
    }
    __syncthreads();
    {
  #pragma unroll
      for (int i = 0; i < 2; ++i) {
        const int idx = tid + 512 * i, r = idx >> 4, c = idx & 15;
        *(uint4*)(pH + (row0 + r) * 2048 + h * 128 + c * 8) = *(const uint4*)(Qt + r * 136 + c * 8);
      }
  #pragma unroll
      for (int tt = 0; tt < 2; ++tt) {
        const int tl = 2 * w + tt, sm = tl >> 2, tn = tl & 3;
        f32x4 acc = (f32x4){0.f, 0.f, 0.f, 0.f};
        if (tn >= sm) {
  #pragma unroll
          for (int k0 = 0; k0 < 128; k0 += 32) {
            const bf16x8 a = *(const bf16x8*)(Kt + (sm * 16 + l15) * 136 + k0 + 8 * g);
            const bf16x8 bq = *(const bf16x8*)(Qt + (tn * 16 + l15) * 136 + k0 + 8 * g);
            acc = __builtin_amdgcn_mfma_f32_16x16x32_bf16(a, bq, acc, 0, 0, 0);
          }
        }
        const int t = tn * 16 + l15, s0 = sm * 16 + 4 * g;
        uint2 o;
        o.x = pack2(s0 + 0 <= t ? acc[0] : 0.f, s0 + 1 <= t ? acc[1] : 0.f);
        o.y = pack2(s0 + 2 <= t ? acc[2] : 0.f, s0 + 3 <= t ? acc[3] : 0.f);
        *(uint2*)(Am + t * 72 + s0) = o;
      }
    }
    __syncthreads();
    {
  #pragma unroll
      for (int tm = 0; tm < 4; ++tm) {
        f32x4 acc = (f32x4){0.f, 0.f, 0.f, 0.f};
  #pragma unroll
        for (int k0 = 0; k0 < 64; k0 += 32) {
          const bf16x8 a = *(const bf16x8*)(Am + (tm * 16 + l15) * 72 + k0 + 8 * g);
          const bf16x8 bb = *(const bf16x8*)(VT + (16 * w + l15) * 72 + k0 + 8 * g);
          acc = __builtin_amdgcn_mfma_f32_16x16x32_bf16(a, bb, acc, 0, 0, 0);
        }
        OI[tm * 512] = make_float4(acc[0], acc[1], acc[2], acc[3]);
      }
  #pragma unroll
      for (int dp = 0; dp < 4; ++dp) {
        unsigned pk[4];
  #pragma unroll
        for (int hh = 0; hh < 2; ++hh) {
          const int dm = dp * 2 + hh;
          f32x4 acc = (f32x4){0.f, 0.f, 0.f, 0.f};
  #pragma unroll
          for (int k0 = 0; k0 < 64; k0 += 32) {
            const bf16x8 a = *(const bf16x8*)(KtT + (dm * 16 + l15) * 72 + k0 + 8 * g);
            const bf16x8 bb = *(const bf16x8*)(VT + (16 * w + l15) * 72 + k0 + 8 * g);
            acc = __builtin_amdgcn_mfma_f32_16x16x32_bf16(a, bb, acc, 0, 0, 0);
          }
          pk[hh * 2] = pack2(acc[0], acc[1]); pk[hh * 2 + 1] = pack2(acc[2], acc[3]);
        }
        UU[dp * 512] = make_uint4(pk[0], pk[1], pk[2], pk[3]);
      }
    }
    __syncthreads();
  }
#undef H1_LOAD
}

__device__ __forceinline__ void hgrn_h2(const Params& p, unsigned char* smem, int bh) {
  unsigned char* ws = p.ws;
  const bf16_t* pH = (const bf16_t*)(ws + WS_PH);
  bf16_t* ya = (bf16_t*)(ws + WS_XN);
  bf16_t* Qt = (bf16_t*)smem;
  bf16_t* ST = Qt + 64 * 136;
  float* decl = (float*)(ST + 128 * 136);
  float* red = decl + 384;
  const int tid = threadIdx.x, lane = tid & 63, w = tid >> 6, l15 = lane & 15, g = lane >> 4;
  const int b = bh >> 2, h = bh & 3;
  f32x4 S[8];
#pragma unroll
  for (int i = 0; i < 8; ++i) S[i] = (f32x4){0.f, 0.f, 0.f, 0.f};
  const float gnv = p.hg_norm[h * 128 + 16 * w + l15];
  const int e = 16 * w + l15;
  uint4 uu0, uu1, uu2, uu3; float4 oi0, oi1, oi2, oi3; uint4 qraw0, qraw1; bf16_t ogr[16]; float dcv = 0.f;
#define H2_LOAD(CH) do { \
    const int item_ = bh * 64 + (CH); \
    const size_t row0_ = (size_t)b * SEQL + (size_t)(CH) * 64; \
    const uint4* UUp = (const uint4*)p.out + (size_t)item_ * 2048 + tid; \
    const float4* OIp = (const float4*)((const unsigned char*)p.out + ((size_t)64 << 20)) + (size_t)item_ * 2048 + tid; \
    uu0 = UUp[0]; uu1 = UUp[512]; uu2 = UUp[1024]; uu3 = UUp[1536]; oi0 = OIp[0]; oi1 = OIp[512]; oi2 = OIp[1024]; oi3 = OIp[1536]; \
    qraw0 = *(const uint4*)(pH + (row0_ + (tid >> 4)) * 2048 + h * 128 + (tid & 15) * 8); \
    qraw1 = *(const uint4*)(pH + (row0_ + 32 + (tid >> 4)) * 2048 + h * 128 + (tid & 15) * 8); \
    _Pragma("unroll") for (int tm = 0; tm < 4; ++tm) _Pragma("unroll") for (int j = 0; j < 4; ++j) \
      ogr[tm * 4 + j] = pH[(row0_ + tm * 16 + 4 * g + j) * 2048 + 1536 + h * 128 + e]; \
    if (tid < 384) dcv = ((const float*)(ws + WS_DEC))[(size_t)item_ * 384 + tid]; \
  } while (0)
  H2_LOAD(0);
  for (int chunk = 0; chunk < 64; ++chunk) {
    const size_t row0 = (size_t)b * SEQL + chunk * 64;
    const uint4 cu[4] = {uu0, uu1, uu2, uu3}; const float4 co[4] = {oi0, oi1, oi2, oi3}; bf16_t cog[16];
#pragma unroll
    for (int i = 0; i < 16; ++i) cog[i] = ogr[i];
    *(uint4*)(Qt + (tid >> 4) * 136 + (tid & 15) * 8) = qraw0;
    *(uint4*)(Qt + (32 + (tid >> 4)) * 136 + (tid & 15) * 8) = qraw1;
    if (tid < 384) decl[tid] = dcv;
    __syncthreads();
    if (chunk + 1 < 64) H2_LOAD(chunk + 1);
#pragma unroll
    for (int dm = 0; dm < 8; ++dm) {
      const int d0 = 16 * dm + 4 * g;
      uint2 o;
      o.x = pack2(S[dm][0] * decl[d0], S[dm][1] * decl[d0 + 1]);
      o.y = pack2(S[dm][2] * decl[d0 + 2], S[dm][3] * decl[d0 + 3]);
      *(uint2*)(ST + e * 136 + d0) = o;
    }
    __syncthreads();
    f32x4 o[4];
#pragma unroll
    for (int tm = 0; tm < 4; ++tm) {
      f32x4 acc = (f32x4){co[tm].x, co[tm].y, co[tm].z, co[tm].w};
#pragma unroll
      for (int k0 = 0; k0 < 128; k0 += 32) {
        const bf16x8 a = *(const bf16x8*)(Qt + (tm * 16 + l15) * 136 + k0 + 8 * g);
        const bf16x8 bb = *(const bf16x8*)(ST + (16 * w + l15) * 136 + k0 + 8 * g);
        acc = __builtin_amdgcn_mfma_f32_16x16x32_bf16(a, bb, acc, 0, 0, 0);
      }
      o[tm] = acc;
#pragma unroll
      for (int j = 0; j < 4; ++j) {
        float ss = acc[j] * acc[j];
        ss += __shfl_xor(ss, 1); ss += __shfl_xor(ss, 2); ss += __shfl_xor(ss, 4); ss += __shfl_xor(ss, 8);
        if (l15 == 0) red[w * 64 + tm * 16 + 4 * g + j] = ss;
      }
    }
#pragma unroll
    for (int dm = 0; dm < 8; ++dm) {
      const unsigned u01 = (dm & 1) ? cu[dm >> 1].z : cu[dm >> 1].x, u23 = (dm & 1) ? cu[dm >> 1].w : cu[dm >> 1].y;
      const float uv[4] = {__uint_as_float(u01 << 16), __uint_as_float(u01 & 0xffff0000u), __uint_as_float(u23 << 16), __uint_as_float(u23 & 0xffff0000u)};
#pragma unroll
      for (int j = 0; j < 4; ++j) { const int dd = 16 * dm + 4 * g + j; S[dm][j] = decl[128 + dd] * S[dm][j] + decl[256 + dd] * uv[j]; }
    }
    __syncthreads();
#pragma unroll
    for (int tm = 0; tm < 4; ++tm)
#pragma unroll
      for (int j = 0; j < 4; ++j) {
        const int t = tm * 16 + 4 * g + j;
        float tot = 0.f;
#pragma unroll
        for (int ww = 0; ww < 8; ++ww) tot += red[ww * 64 + t];
        const float rstd = rsqrtf(tot * (1.f / 128.f) + EPSV);
        ya[(row0 + t) * 512 + h * 128 + e] = f2bf(o[tm][j] * rstd * gnv * siluf_(bf2f(cog[tm * 4 + j])));
      }
  }
#undef H2_LOAD
}

#define SCW 4100
#ifndef DSA_REP
#define DSA_REP 0
#endif
#define DSA_BKT_OFF (8 * SCW * 4 + 8 * 256 * 4 + 8 * 256 * 2 + 8 * 512 * 2)
__device__ __forceinline__ void cvt8(const uint4& v, float* f) {
  f[0] = __uint_as_float(v.x << 16); f[1] = __uint_as_float(v.x & 0xffff0000u);
  f[2] = __uint_as_float(v.y << 16); f[3] = __uint_as_float(v.y & 0xffff0000u);
  f[4] = __uint_as_float(v.z << 16); f[5] = __uint_as_float(v.z & 0xffff0000u);
  f[6] = __uint_as_float(v.w << 16); f[7] = __uint_as_float(v.w & 0xffff0000u);
}
__device__ __forceinline__ unsigned sortable_key(float v) {
  unsigned bits = __float_as_uint(v);
  if (bits == 0x80000000u) bits = 0u;
  return (bits & 0x80000000u) ? ~bits : (bits | 0x80000000u);
}

__device__ __forceinline__ void dsa_item(const Params& p, unsigned char* smem, int item) {
  unsigned char* ws = p.ws;
  const bf16_t* pA = (const bf16_t*)(ws + WS_PA);
  bf16_t* yb = (bf16_t*)(ws + WS_XN) + (size_t)TOK * 512;
  unsigned* sc = (unsigned*)smem;
  unsigned* hist = sc + 8 * SCW;
  unsigned short* sel = (unsigned short*)(hist + 8 * 256);
  unsigned short* cand = sel + 8 * 256;
  unsigned char* bkt = (unsigned char*)(cand + 8 * 512);
  unsigned* rmm = (unsigned*)(bkt + 128 + 1024);
  const int tid = threadIdx.x, lane = tid & 63, w = tid >> 6, l15 = lane & 15, g = lane >> 4;
  const int b = item >> 9;
  const int tb = item & 511;
  const int t0 = tb * 8;
  const size_t tokbase = (size_t)b * SEQL;

  for (int rep_s = 0; rep_s < (DSA_REP == 1 ? 2 : 1); ++rep_s) {
    bf16x8 af[2][2];
    float wq[2][4];
#pragma unroll
    for (int mt = 0; mt < 2; ++mt) {
      const int qrow = t0 + mt * 4 + (l15 >> 2), head = l15 & 3;
#pragma unroll
      for (int ks = 0; ks < 2; ++ks)
        af[mt][ks] = *(const bf16x8*)(pA + (tokbase + qrow) * 1024 + 640 + head * 64 + ks * 32 + 8 * g);
      const uint2 wr = *(const uint2*)(pA + (tokbase + t0 + mt * 4 + g) * 1024 + 960);
      wq[mt][0] = 0.5f * bf2f((bf16_t)(wr.x & 0xffff)); wq[mt][1] = 0.5f * bf2f((bf16_t)(wr.x >> 16));
      wq[mt][2] = 0.5f * bf2f((bf16_t)(wr.y & 0xffff)); wq[mt][3] = 0.5f * bf2f((bf16_t)(wr.y >> 16));
    }
    const int nkt = (t0 + 8 + 15) >> 4;
    unsigned kmin[2] = {0xFFFFFFFFu, 0xFFFFFFFFu}, kmax[2] = {0u, 0u};
    for (int kt0 = w; kt0 < nkt; kt0 += 64) {
      bf16x8 b0[8], b1[8];
#pragma unroll
      for (int u = 0; u < 8; ++u) {
        const int kt = kt0 + 8 * u;
        const int s = (kt < nkt ? kt : 0) * 16 + l15;
        const bf16_t* kr = pA + (tokbase + s) * 1024 + 896 + 8 * g;
        b0[u] = *(const bf16x8*)kr;
        b1[u] = *(const bf16x8*)(kr + 32);
      }
      __builtin_amdgcn_sched_barrier(0);
#pragma unroll
      for (int u = 0; u < 8; ++u) {
        const int kt = kt0 + 8 * u;
        if (kt < nkt) {
          const int s = kt * 16 + l15;
#pragma unroll
          for (int mt = 0; mt < 2; ++mt) {
            f32x4 acc = (f32x4){0.f, 0.f, 0.f, 0.f};
            acc = __builtin_amdgcn_mfma_f32_16x16x32_bf16(af[mt][0], b0[u], acc, 0, 0, 0);
            acc = __builtin_amdgcn_mfma_f32_16x16x32_bf16(af[mt][1], b1[u], acc, 0, 0, 0);
            float v = 0.f;
#pragma unroll
            for (int j = 0; j < 4; ++j) v += wq[mt][j] * fmaxf(acc[j] * 0.125f, 0.f);
            const int t = t0 + mt * 4 + g;
            unsigned vb = __float_as_uint(v); if (vb == 0x80000000u) vb = 0u;
            sc[(mt * 4 + g) * SCW + s] = vb;
            if (s <= t) {
              const unsigned key = (vb & 0x80000000u) ? ~vb : (vb | 0x80000000u);
              kmin[mt] = key < kmin[mt] ? key : kmin[mt];
              kmax[mt] = key > kmax[mt] ? key : kmax[mt];
            }
          }
        }
      }
    }
#pragma unroll
    for (int mt = 0; mt < 2; ++mt) {
      unsigned a = kmin[mt], bmx = kmax[mt];
#define DPP_MINMAX(CTRL) do { const unsigned a2 = (unsigned)__builtin_amdgcn_update_dpp((int)a, (int)a, CTRL, 0xf, 0xf, false); \
                               const unsigned b2 = (unsigned)__builtin_amdgcn_update_dpp((int)bmx, (int)bmx, CTRL, 0xf, 0xf, false); \
                               a = a2 < a ? a2 : a; bmx = b2 > bmx ? b2 : bmx; } while (0)
      DPP_MINMAX(0xB1); DPP_MINMAX(0x4E); DPP_MINMAX(0x141); DPP_MINMAX(0x140);
#undef DPP_MINMAX
      if (l15 == 0) { atomicMin(&rmm[mt * 4 + g], a); atomicMax(&rmm[8 + mt * 4 + g], bmx); }
    }
  }
  __syncthreads();
  const int t = t0 + w;
  const int n = t + 1;
  unsigned* row = sc + w * SCW;
  const float* rowf = (const float*)row;
  unsigned short* mysel = sel + w * 256;
  unsigned short* mycand = cand + w * 512;
  unsigned* myh = hist + w * 256;
  int cnt;
  const unsigned long long lt_mask = (1ull << lane) - 1ull;
  for (int rep_t = 0; rep_t < (DSA_REP == 2 ? 2 : 1); ++rep_t)
  if (n <= 256) {
    for (int i = lane; i < n; i += 64) mysel[i] = (unsigned short)i;
    cnt = n;
  } else {
    cnt = 256;
    float mn, mx;
    {
      const unsigned kmn = rmm[w], kmx = rmm[8 + w];
      mn = __uint_as_float((kmn & 0x80000000u) ? (kmn ^ 0x80000000u) : ~kmn);
      mx = __uint_as_float((kmx & 0x80000000u) ? (kmx ^ 0x80000000u) : ~kmx);
    }
    const float scale = (mx > mn) ? 255.99f / (mx - mn) : 0.f;
#pragma unroll
    for (int i = 0; i < 4; ++i) myh[lane + 64 * i] = 0u;
    lds_fence();
    for (int i0 = lane; i0 < n; i0 += 256) {
      float v4[4];
#pragma unroll
      for (int k = 0; k < 4; ++k) v4[k] = (i0 + 64 * k < n) ? rowf[i0 + 64 * k] : 0.f;
#pragma unroll
      for (int k = 0; k < 4; ++k) {
        if (i0 + 64 * k < n) {
          int bn = (int)((v4[k] - mn) * scale); bn = bn > 255 ? 255 : bn;
          atomicAdd(&myh[bn], 1u);
        }
      }
    }
    lds_fence();
    unsigned cum; int bstar; unsigned mcount;
    {
      const uint4 c4 = *(const uint4*)(myh + 4 * lane);
      const unsigned c = c4.x + c4.y + c4.z + c4.w;
      unsigned sfx = c;
#pragma unroll
      for (int o = 1; o < 64; o <<= 1) { const unsigned tt = __shfl_down(sfx, o); if (lane + o < 64) sfx += tt; }
      const unsigned long long bal = __ballot(sfx >= 256u);
      const int L = 63 - __clzll(bal);
      const unsigned sL = __shfl(sfx, L), cL = __shfl(c, L);
      const unsigned b3 = __shfl(c4.w, L), b2 = __shfl(c4.z, L), b1 = __shfl(c4.y, L), b0 = __shfl(c4.x, L);
      cum = sL - cL;
      int digit;
      if (cum + b3 >= 256u) { digit = 3; mcount = b3; }
      else { cum += b3; if (cum + b2 >= 256u) { digit = 2; mcount = b2; } else { cum += b2; if (cum + b1 >= 256u) { digit = 1; mcount = b1; } else { cum += b1; digit = 0; mcount = b0; } } }
      bstar = 4 * L + digit;
    }
    const unsigned need = 256u - cum;
    if (mcount <= 512u) {
      unsigned base = 0u, cb = 0u;
      for (int i0 = 0; i0 < n; i0 += 256) {
        float v4[4];
#pragma unroll
        for (int k = 0; k < 4; ++k) { const int i = i0 + 64 * k + lane; v4[k] = (i < n) ? rowf[i] : 0.f; }
#pragma unroll
        for (int k = 0; k < 4; ++k) {
          const int i = i0 + 64 * k + lane;
          const bool valid = i < n;
          int bn = (int)((v4[k] - mn) * scale); bn = bn > 255 ? 255 : bn;
          const bool gt = valid && (bn > bstar);
          const bool eq = valid && (bn == bstar);
          const unsigned long long bg = __ballot(gt), be = __ballot(eq);
          if (gt) mysel[base + (unsigned)__popcll(bg & lt_mask)] = (unsigned short)i;
          if (eq) mycand[cb + (unsigned)__popcll(be & lt_mask)] = (unsigned short)i;
          base += (unsigned)__popcll(bg); cb += (unsigned)__popcll(be);
        }
      }
      lds_fence();
      const int m = (int)mcount;
      unsigned ck[8]; unsigned short ci[8];
#pragma unroll
      for (int q = 0; q < 8; ++q) {
        const int c = q * 64 + lane;
        ck[q] = 0u; ci[q] = 0;
        if (c < m) { ci[q] = mycand[c]; ck[q] = sortable_key(rowf[ci[q]]); }
      }
      unsigned T = 0u;
      if (m <= 64) {
#pragma unroll 1
        for (int bit = 31; bit >= 0; --bit) {
          const unsigned trial = T | (1u << bit);
          if ((unsigned)__popcll(__ballot(ck[0] >= trial)) >= need) T = trial;
        }
      } else {
#pragma unroll 1
        for (int bit = 31; bit >= 0; --bit) {
          const unsigned trial = T | (1u << bit);
          unsigned cge = 0u;
#pragma unroll
          for (int q = 0; q < 8; ++q) cge += (unsigned)__popcll(__ballot(ck[q] >= trial));
          if (cge >= need) T = trial;
        }
      }
      unsigned cgt = 0u;
#pragma unroll
      for (int q = 0; q < 8; ++q) cgt += (unsigned)__popcll(__ballot(ck[q] > T));
      const unsigned need_eq = need - cgt;
      unsigned pos0 = cum, eqtaken = 0u;
#pragma unroll
      for (int q = 0; q < 8; ++q) {
        const bool gt = ck[q] > T;
        const bool eq = ck[q] == T;
        const unsigned long long beq = __ballot(eq);
        const bool take = gt || (eq && (eqtaken + (unsigned)__popcll(beq & lt_mask)) < need_eq);
        const unsigned long long bt = __ballot(take);
        const unsigned pp = pos0 + (unsigned)__popcll(bt & lt_mask);
        if (take && pp < 256u) mysel[pp] = ci[q];
        pos0 += (unsigned)__popcll(bt);
        eqtaken += (unsigned)__popcll(beq);
      }
    } else {
      unsigned prefix = 0u, krem = 256u;
#pragma unroll 1
      for (int pass = 0; pass < 4; ++pass) {
        const int shift = 24 - 8 * pass;
        const unsigned himask = (pass == 0) ? 0u : (0xFFFFFFFFu << (shift + 8));
#pragma unroll
        for (int i = 0; i < 4; ++i) myh[lane + 64 * i] = 0u;
        lds_fence();
        for (int i = lane; i < n; i += 64) {
          const unsigned u = sortable_key(rowf[i]);
          if ((u & himask) == prefix) atomicAdd(&myh[(u >> shift) & 255u], 1u);
        }
        lds_fence();
        const uint4 c4 = *(const uint4*)(myh + 4 * lane);
        const unsigned c = c4.x + c4.y + c4.z + c4.w;
        unsigned sfx = c;
#pragma unroll
        for (int o = 1; o < 64; o <<= 1) { const unsigned tt = __shfl_down(sfx, o); if (lane + o < 64) sfx += tt; }
        const unsigned long long bal = __ballot(sfx >= krem);
        const int L = 63 - __clzll(bal);
        const unsigned sL = __shfl(sfx, L), cL = __shfl(c, L);
        const unsigned b3 = __shfl(c4.w, L), b2 = __shfl(c4.z, L), b1 = __shfl(c4.y, L);
        unsigned cum2 = sL - cL;
        unsigned digit;
        if (cum2 + b3 >= krem) digit = 3;
        else { cum2 += b3; if (cum2 + b2 >= krem) digit = 2; else { cum2 += b2; if (cum2 + b1 >= krem) digit = 1; else { cum2 += b1; digit = 0; } } }
        krem -= cum2;
        prefix |= ((unsigned)(4 * L) + digit) << shift;
      }
      const unsigned T = prefix;
      unsigned base = 0u, eqtaken = 0u;
      for (int i0 = 0; i0 < n; i0 += 64) {
        const int i = i0 + lane;
        const bool valid = i < n;
        const unsigned u = valid ? sortable_key(rowf[i]) : 0u;
        const bool gt = valid && (u > T);
        const bool eq = valid && (u == T);
        const unsigned long long beq = __ballot(eq);
        const unsigned eqrank = eqtaken + (unsigned)__popcll(beq & lt_mask);
        const bool take = gt || (eq && eqrank < krem);
        const unsigned long long bt = __ballot(take);
        const unsigned pos = base + (unsigned)__popcll(bt & lt_mask);
        if (take && pos < 256u) mysel[pos] = (unsigned short)i;
        base += (unsigned)__popcll(bt);
        eqtaken += (unsigned)__popcll(beq);
      }
    }
  }
  lds_fence();
  if (lane == 0) { rmm[w] = 0xFFFFFFFFu; rmm[8 + w] = 0u; }
  {
    int lane_a = lane;
    asm volatile("" : "+v"(lane_a));
    const int l15 = lane_a & 15, g = lane_a >> 4;
    const int ks = lane_a >> 3, dc = lane_a & 7;
    float* pl = (float*)row;
    const float* relb = (const float*)(bkt + 128);
    const int niter = (cnt + 7) >> 3;
    bf16x8 bq0 = (bf16x8){0, 0, 0, 0, 0, 0, 0, 0}, bq1 = bq0;
    if (l15 < 8) {
      bq0 = *(const bf16x8*)(pA + (tokbase + t) * 1024 + l15 * 64 + 8 * g);
      bq1 = *(const bf16x8*)(pA + (tokbase + t) * 1024 + l15 * 64 + 32 + 8 * g);
    }
    float lg[16][4];
    {
      bf16x8 ka[8][2], kb[8][2];
#pragma unroll
      for (int u = 0; u < 8; ++u) {
        const int kk = u * 16 + l15;
        const int s = (kk < cnt) ? (int)mysel[kk] : 0;
        const bf16_t* kr = pA + (tokbase + s) * 1024 + 512 + 8 * g;
        ka[u][0] = *(const bf16x8*)kr;
        ka[u][1] = *(const bf16x8*)(kr + 32);
      }
#pragma unroll
      for (int u = 0; u < 8; ++u) {
        const int kk = (8 + u) * 16 + l15;
        const int s = (kk < cnt) ? (int)mysel[kk] : 0;
        const bf16_t* kr = pA + (tokbase + s) * 1024 + 512 + 8 * g;
        kb[u][0] = *(const bf16x8*)kr;
        kb[u][1] = *(const bf16x8*)(kr + 32);
      }
      __builtin_amdgcn_sched_barrier(0);
#pragma unroll
      for (int u = 0; u < 8; ++u) {
        f32x4 acc = (f32x4){0.f, 0.f, 0.f, 0.f};
        acc = __builtin_amdgcn_mfma_f32_16x16x32_bf16(ka[u][0], bq0, acc, 0, 0, 0);
        acc = __builtin_amdgcn_mfma_f32_16x16x32_bf16(ka[u][1], bq1, acc, 0, 0, 0);
        lg[u][0] = acc[0]; lg[u][1] = acc[1]; lg[u][2] = acc[2]; lg[u][3] = acc[3];
      }
#pragma unroll
      for (int u = 0; u < 8; ++u) {
        f32x4 acc = (f32x4){0.f, 0.f, 0.f, 0.f};
        acc = __builtin_amdgcn_mfma_f32_16x16x32_bf16(kb[u][0], bq0, acc, 0, 0, 0);
        acc = __builtin_amdgcn_mfma_f32_16x16x32_bf16(kb[u][1], bq1, acc, 0, 0, 0);
        lg[8 + u][0] = acc[0]; lg[8 + u][1] = acc[1]; lg[8 + u][2] = acc[2]; lg[8 + u][3] = acc[3];
      }
    }
    typedef unsigned u32x4_t __attribute__((ext_vector_type(4)));
    u32x4_t va[16];
#pragma unroll
    for (int u = 0; u < 16; ++u) {
      const int kk = u * 8 + ks;
      const int s = (kk < cnt) ? (int)mysel[kk] : 0;
      va[u] = *(const u32x4_t*)(pA + (tokbase + s) * 1024 + 576 + dc * 8);
    }
    __builtin_amdgcn_sched_barrier(0);
    const int hsel = l15 & 7;
    float m = -INFINITY;
#pragma unroll
    for (int u = 0; u < 16; ++u) {
      const uint2 s4 = *(const uint2*)(mysel + u * 16 + 4 * g);
      const int sj[4] = {(int)(s4.x & 0xffffu), (int)(s4.x >> 16), (int)(s4.y & 0xffffu), (int)(s4.y >> 16)};
#pragma unroll
      for (int j = 0; j < 4; ++j) {
        const int key = u * 16 + 4 * g + j;
        const bool valid = key < cnt;
        const int dist = valid ? t - sj[j] : 0;
        const int bk = dist < 128 ? (int)bkt[dist] : 31;
        lg[u][j] = valid ? (lg[u][j] * 0.125f + relb[bk * 8 + hsel]) : -INFINITY;
        m = fmaxf(m, lg[u][j]);
      }
    }
    m = max_xor16(m); m = max_xor32(m);
    float sum = 0.f;
#pragma unroll
    for (int u = 0; u < 16; ++u)
#pragma unroll
      for (int j = 0; j < 4; ++j) { lg[u][j] = __expf(lg[u][j] - m); sum += lg[u][j]; }
    sum = add_xor16(sum); sum = add_xor32(sum);
    const float inv = 1.f / sum;
    bf16x8 pa[8];
#pragma unroll
    for (int s8 = 0; s8 < 8; ++s8) {
      const unsigned w0 = pack2(lg[2 * s8][0] * inv, lg[2 * s8][1] * inv), w1 = pack2(lg[2 * s8][2] * inv, lg[2 * s8][3] * inv);
      const unsigned w2 = pack2(lg[2 * s8 + 1][0] * inv, lg[2 * s8 + 1][1] * inv), w3 = pack2(lg[2 * s8 + 1][2] * inv, lg[2 * s8 + 1][3] * inv);
      const u32x4_t wv = {w0, w1, w2, w3};
      pa[s8] = __builtin_bit_cast(bf16x8, wv);
    }
    unsigned char* vs_l = (unsigned char*)row;
#pragma unroll
    for (int u = 0; u < 16; ++u) *(u32x4_t*)(vs_l + (u * 8 + ks) * 128 + dc * 16) = va[u];
    lds_fence();
    u32x4_t vb[16];
#pragma unroll
    for (int u = 0; u < 16; ++u) {
      const int kk = (16 + u) * 8 + ks;
      const int s = (kk < cnt) ? (int)mysel[kk] : 0;
      vb[u] = *(const u32x4_t*)(pA + (tokbase + s) * 1024 + 576 + dc * 8);
    }
    __builtin_amdgcn_sched_barrier(0);
    f32x4 ov[4];
#pragma unroll
    for (int nt = 0; nt < 4; ++nt) ov[nt] = (f32x4){0.f, 0.f, 0.f, 0.f};
    typedef short v4s_t __attribute__((ext_vector_type(4)));
    const unsigned tr_lane = (unsigned)((l15 >> 2) * 128 + (l15 & 3) * 8);
#define PV_HALF(S0) do { \
      _Pragma("unroll") for (int s4_ = 0; s4_ < 4; ++s4_) { \
        _Pragma("unroll") for (int nt = 0; nt < 4; ++nt) { \
          const unsigned a0 = (unsigned)((s4_ * 32 + 4 * g) * 128 + nt * 32) + tr_lane; \
          const v4s_t b0 = __builtin_amdgcn_ds_read_tr16_b64_v4i16((__attribute__((address_space(3))) v4s_t*)(vs_l + a0)); \
          const v4s_t b1 = __builtin_amdgcn_ds_read_tr16_b64_v4i16((__attribute__((address_space(3))) v4s_t*)(vs_l + a0 + 16 * 128)); \
          const bf16x8 bb = (bf16x8){b0[0], b0[1], b0[2], b0[3], b1[0], b1[1], b1[2], b1[3]}; \
          ov[nt] = __builtin_amdgcn_mfma_f32_16x16x32_bf16(pa[(S0) + s4_], bb, ov[nt], 0, 0, 0); \
        } \
      } \
    } while (0)
    PV_HALF(0);
    lds_fence();
#pragma unroll
    for (int u = 0; u < 16; ++u) *(u32x4_t*)(vs_l + (u * 8 + ks) * 128 + dc * 16) = vb[u];
    lds_fence();
    PV_HALF(4);
#undef PV_HALF
    if (g < 2) {
#pragma unroll
      for (int nt = 0; nt < 4; ++nt)
#pragma unroll
        for (int j = 0; j < 4; ++j) yb[(tokbase + t) * 512 + (4 * g + j) * 64 + nt * 16 + l15] = f2bf(ov[nt][j]);
    }
    lds_fence();
  }
  __syncthreads();
}

__device__ __forceinline__ void phase_mix(const Params& p, unsigned char* smem, int mode = 0) {
  const int G = gridDim.x;
  if (mode != 2) { for (int bh = blockIdx.x; bh < 32; bh += G) { hgrn_h2(p, smem, bh); __syncthreads(); } }
  if (mode == 1) return;
  unsigned char* bkt = smem + DSA_BKT_OFF;
  volatile int* qslot = (volatile int*)(smem + LDS_BYTES - 32);
  unsigned* qctr = (unsigned*)(p.ws + WS_QCTR);
  if (threadIdx.x < 128) {
    const int nn = threadIdx.x;
    int v = nn;
    if (nn >= 16) { v = 16 + (int)(logf((float)nn * (1.f / 16.f)) / logf(8.f) * 16.f); if (v > 31) v = 31; }
    bkt[nn] = (unsigned char)v;
  }
  if (threadIdx.x >= 256) ((float*)(bkt + 128))[threadIdx.x - 256] = p.rel_bias[threadIdx.x - 256];
  if (threadIdx.x < 16) ((unsigned*)(bkt + 128 + 1024))[threadIdx.x] = threadIdx.x < 8 ? 0xFFFFFFFFu : 0u;
  if (threadIdx.x == 0) qslot[0] = (int)__hip_atomic_fetch_add(qctr, 1u, __ATOMIC_RELAXED, __HIP_MEMORY_SCOPE_AGENT);
  __syncthreads();
  int k = qslot[0];
  int par = 1;
  while (k < 4096 + 256) {
    if (threadIdx.x == 0) qslot[par] = (int)__hip_atomic_fetch_add(qctr, 1u, __ATOMIC_RELAXED, __HIP_MEMORY_SCOPE_AGENT);
    const int kq = k / 17, kr = k - kq * 17;
    if (kr < 16) {
      const int kd = kq * 16 + kr;
      const int item = ((kd & 7) << 9) | (511 - (kd >> 3));
      dsa_item(p, smem, item);
    } else {
      const int r0 = kq * 64;
      quantize_rows_u8<false, true>(p.peer_u, p.ws + WS_U, (float*)(p.ws + WS_U + (size_t)16384 * 1024), r0, r0 + 64);
      quantize_rows_u8<true, false>(p.peer_v, p.ws + WS_V, (float*)(p.ws + WS_V + (size_t)16384 * 1024), r0, r0 + 64);
      __syncthreads();
    }
    k = qslot[par];
    par ^= 1;
  }
}

__device__ __forceinline__ void phase_up(const Params& p, unsigned char* smem) {
  unsigned char* ws = p.ws;
  const bf16_t* ya = (const bf16_t*)(ws + WS_XN);
  const bf16_t* yb = ya + (size_t)TOK * 512;
  const bf16_t* wa = (const bf16_t*)(ws + WS_WUPA);
  const bf16_t* wb = (const bf16_t*)(ws + WS_WUPB);
  const bf16_t* pG = (const bf16_t*)(ws + WS_PG);
  bf16_t* hb = (bf16_t*)(ws + WS_PH);
  const int tid = threadIdx.x, lane = tid & 63, w = tid >> 6, wm = w >> 1, wn = w & 1, l15 = lane & 15, g = lane >> 4;
  for (int tile = blockIdx.x; tile < 128 * 8; tile += gridDim.x) {
    const int tn = tile & 7, tm = tile >> 3;
    f32x4 acc[4][4]; zero_acc(acc);
    gemm_tile(ya + (size_t)tm * 256 * 512, 512, wa + (size_t)tn * 128 * 512, 512, 8, acc, smem);
    asm volatile("" ::: "memory");
    const int rbase = tm * 256 + wm * 64 + 4 * g;
    const int cbase = tn * 128 + wn * 64 + l15;
#pragma unroll
    for (int m = 0; m < 4; ++m) {
      bf16_t gt[16];
#pragma unroll
      for (int n = 0; n < 4; ++n)
#pragma unroll
        for (int j = 0; j < 4; ++j) gt[n * 4 + j] = pG[(size_t)(rbase + m * 16 + j) * 2048 + cbase + n * 16];
#pragma unroll
      for (int n = 0; n < 4; ++n) {
#pragma unroll
        for (int j = 0; j < 4; ++j) {
          const size_t rr = (size_t)(rbase + m * 16 + j);
          hb[rr * 1024 + cbase + n * 16] = f2bf(acc[m][n][j] * bf2f(gt[n * 4 + j]));
        }
        acc[m][n] = (f32x4){0.f, 0.f, 0.f, 0.f};
      }
    }
    asm volatile("" ::: "memory");
    gemm_tile(yb + (size_t)tm * 256 * 512, 512, wb + (size_t)tn * 128 * 512, 512, 8, acc, smem);
    asm volatile("" ::: "memory");
#pragma unroll
    for (int m = 0; m < 4; ++m) {
      bf16_t gt[16], ht[16];
#pragma unroll
      for (int n = 0; n < 4; ++n)
#pragma unroll
        for (int j = 0; j < 4; ++j) {
          const size_t rr = (size_t)(rbase + m * 16 + j);
          gt[n * 4 + j] = pG[rr * 2048 + 1024 + cbase + n * 16];
          ht[n * 4 + j] = hb[rr * 1024 + cbase + n * 16];
        }
#pragma unroll
      for (int n = 0; n < 4; ++n)
#pragma unroll
        for (int j = 0; j < 4; ++j) {
          const size_t rr = (size_t)(rbase + m * 16 + j);
          hb[rr * 1024 + cbase + n * 16] = f2bf(bf2f(ht[n * 4 + j]) + acc[m][n][j] * bf2f(gt[n * 4 + j]));
        }
    }
  }
}

__device__ __forceinline__ void phase_out(const Params& p, unsigned char* smem) {
  unsigned char* ws = p.ws;
  const bf16_t* hb = (const bf16_t*)(ws + WS_PH);
  const bf16_t* wo = (const bf16_t*)(ws + WS_WOUT);
  const int tid = threadIdx.x, lane = tid & 63, w = tid >> 6, wm = w >> 1, wn = w & 1, l15 = lane & 15, g = lane >> 4;
  for (int tile = blockIdx.x; tile < 128 * 8; tile += gridDim.x) {
    const int tn = tile & 7, tm = tile >> 3;
    f32x4 acc[4][4]; zero_acc(acc);
    gemm_tile(hb + (size_t)tm * 256 * 1024, 1024, wo + (size_t)tn * 128 * 1024, 1024, 16, acc, smem);
    const int rbase = tm * 256 + wm * 64 + 4 * g;
    const int cbase = tn * 128 + wn * 64 + l15;
#pragma unroll
    for (int m = 0; m < 4; ++m) {
      float xt[16];
#pragma unroll
      for (int n = 0; n < 4; ++n)
#pragma unroll
        for (int j = 0; j < 4; ++j) xt[n * 4 + j] = p.x[(size_t)(rbase + m * 16 + j) * 1024 + cbase + n * 16];
#pragma unroll
      for (int n = 0; n < 4; ++n)
#pragma unroll
        for (int j = 0; j < 4; ++j) p.out[(size_t)(rbase + m * 16 + j) * 1024 + cbase + n * 16] = xt[n * 4 + j] + acc[m][n][j];
    }
  }
}

__device__ __forceinline__ void phase_pq(const Params& p, unsigned char* smem) {
  unsigned char* ws = p.ws;
  const bf16_t* xn2 = (const bf16_t*)(ws + WS_XN);
  const bf16_t* wq = (const bf16_t*)(ws + WS_WQ);
  bf16_t* qp = (bf16_t*)(ws + WS_PG);
  const int tid = threadIdx.x, lane = tid & 63, w = tid >> 6, wm = w >> 1, wn = w & 1, l15 = lane & 15, g = lane >> 4;
  for (int tile = blockIdx.x; tile < 128 * 16; tile += gridDim.x) {
    const int tn = tile & 15, tm = tile >> 4;
    f32x4 acc[4][4]; zero_acc(acc);
    gemm_tile(xn2 + (size_t)tm * 256 * 1024, 1024, wq + (size_t)tn * 128 * 1024, 1024, 16, acc, smem);
    const int rbase = tm * 256 + wm * 64 + 4 * g;
    const int cbase = tn * 128 + wn * 64 + l15;
#pragma unroll
    for (int m = 0; m < 4; ++m)
#pragma unroll
      for (int n = 0; n < 4; ++n)
#pragma unroll
        for (int j = 0; j < 4; ++j) qp[(size_t)(rbase + m * 16 + j) * 2048 + cbase + n * 16] = f2bf(acc[m][n][j]);
  }
}

__device__ __forceinline__ void phase_pkeys(const Params& p, unsigned char* smem) {
  unsigned char* ws = p.ws;
  const bf16_t* qp = (const bf16_t*)(ws + WS_PG);
  const bf16_t* keys = (const bf16_t*)(ws + WS_KEYS);
  float* ps = (float*)(ws + WS_PA);
  int* pi = (int*)(ws + WS_PA) + (size_t)TOK * 256;
  float* sc = (float*)smem;
  const int tid = threadIdx.x, lane = tid & 63, w = tid >> 6, wm = w >> 1, wn = w & 1, l15 = lane & 15, g = lane >> 4;
  for (int tile = blockIdx.x; tile < 128 * 16; tile += gridDim.x) {
    const int hp = tile & 15, tm = tile >> 4;
    const int h = hp >> 1, ph = hp & 1;
    f32x4 acc[4][4]; zero_acc(acc);
    gemm_tile(qp + (size_t)tm * 256 * 2048 + hp * 128, 2048, keys + (size_t)(ph * 8 + h) * 128 * 128, 128, 2, acc, smem);
    __syncthreads();
#pragma unroll
    for (int m = 0; m < 4; ++m)
#pragma unroll
      for (int n = 0; n < 4; ++n)
#pragma unroll
        for (int j = 0; j < 4; ++j) sc[(wm * 64 + m * 16 + 4 * g + j) * 129 + wn * 64 + n * 16 + l15] = acc[m][n][j];
    __syncthreads();
    if (tid < 256) {
      const int row = tid;
      const float* rowp = sc + row * 129;
      unsigned tv[16];
#pragma unroll
      for (int k = 0; k < 16; ++k) tv[k] = 0u;
#pragma unroll 8
      for (int nn = 0; nn < 128; ++nn) {
        const unsigned bits = __float_as_uint(rowp[nn]);
        unsigned key = (bits & 0x80000000u) ? ~bits : (bits | 0x80000000u);
        key = (key & ~127u) | (unsigned)(127 - nn);
#pragma unroll
        for (int k = 15; k >= 1; --k) {
          unsigned r;
          asm("v_med3_u32 %0, %1, %2, %3" : "=v"(r) : "v"(tv[k]), "v"(tv[k - 1]), "v"(key));
          tv[k] = r;
        }
        tv[0] = tv[0] > key ? tv[0] : key;
      }
      const size_t ob = ((size_t)(tm * 256 + row) * 16 + hp) * 16;
      float ov[16]; int oi[16];
#pragma unroll
      for (int k = 0; k < 16; ++k) { oi[k] = 127 - (int)(tv[k] & 127u); ov[k] = rowp[oi[k]]; }
#pragma unroll
      for (int k = 0; k < 16; k += 4) {
        *(float4*)(ps + ob + k) = make_float4(ov[k], ov[k + 1], ov[k + 2], ov[k + 3]);
        *(int4*)(pi + ob + k) = make_int4(oi[k], oi[k + 1], oi[k + 2], oi[k + 3]);
      }
    }
    __syncthreads();
  }
}

__device__ __forceinline__ void phase_pcomb(const Params& p, unsigned char* smem) {
  unsigned char* ws = p.ws;
  const float* ps = (const float*)(ws + WS_PA);
  const int* pi = (const int*)(ws + WS_PA) + (size_t)TOK * 256;
  int* eidx = (int*)(ws + WS_EIDX);
  float* gw = (float*)(ws + WS_GW);
  float* s2l = (float*)smem;
  unsigned short* i1l = (unsigned short*)(s2l + 512 * 17);
  unsigned short* i2l = i1l + 512 * 16;
  const int tid = threadIdx.x;
  for (int base = blockIdx.x * NTHREADS; base < TOK * 8; base += gridDim.x * NTHREADS) {
    const int th = base + tid;
    const size_t o1 = (size_t)th * 32;
    float s1[16];
#pragma unroll
    for (int a = 0; a < 16; ++a) {
      s1[a] = ps[o1 + a];
      s2l[tid * 17 + a] = ps[o1 + 16 + a];
      i1l[tid * 16 + a] = (unsigned short)pi[o1 + a];
      i2l[tid * 16 + a] = (unsigned short)pi[o1 + 16 + a];
    }
    float cur[16];
    const float s20 = s2l[tid * 17];
#pragma unroll
    for (int a = 0; a < 16; ++a) cur[a] = s1[a] + s20;
    unsigned long long ptr = 0ull;
    float tops[16]; int tope[16];
#pragma unroll
    for (int k = 0; k < 16; ++k) {
      float best = cur[0]; int ba = 0;
#pragma unroll
      for (int a = 1; a < 16; ++a) if (cur[a] > best) { best = cur[a]; ba = a; }
      const int bb = (int)((ptr >> (4 * ba)) & 15ull);
      tops[k] = best;
      tope[k] = (int)i1l[tid * 16 + ba] * 128 + (int)i2l[tid * 16 + bb];
      const int nb = bb + 1;
      const float ns2 = (nb < 16) ? s2l[tid * 17 + nb] : -INFINITY;
      if (nb < 16) ptr += (1ull << (4 * ba));
#pragma unroll
      for (int a = 0; a < 16; ++a) if (a == ba) cur[a] = s1[a] + ns2;
    }
    float m = tops[0];
    float sum = 0.f;
#pragma unroll
    for (int k = 0; k < 16; ++k) { tops[k] = __expf(tops[k] - m); sum += tops[k]; }
    const float inv = 1.f / sum;
#pragma unroll
    for (int k = 0; k < 16; ++k) { eidx[(size_t)th * 16 + k] = tope[k]; gw[(size_t)th * 16 + k] = tops[k] * inv; }
  }
}


__device__ __forceinline__ float reduce8(const float (&pv)[8], int lane) {
  const bool b5 = lane & 32, b4 = lane & 16, b3 = lane & 8;
  float v[4];
#pragma unroll
  for (int i = 0; i < 4; ++i) {
    const float keep = b5 ? pv[4 + i] : pv[i];
    const float send = b5 ? pv[i] : pv[4 + i];
    v[i] = keep + __shfl_xor(send, 32);
  }
  float u[2];
#pragma unroll
  for (int i = 0; i < 2; ++i) {
    const float keep = b4 ? v[2 + i] : v[i];
    const float send = b4 ? v[i] : v[2 + i];
    u[i] = keep + __shfl_xor(send, 16);
  }
  float x = (b3 ? u[1] : u[0]) + __shfl_xor(b3 ? u[0] : u[1], 8);
  x += __shfl_xor(x, 4); x += __shfl_xor(x, 2); x += __shfl_xor(x, 1);
  return x;
}

__device__ __forceinline__ void cvt16u8(const uint4& v, float* f) {
  f[0] = (float)(v.x & 0xffu); f[1] = (float)((v.x >> 8) & 0xffu); f[2] = (float)((v.x >> 16) & 0xffu); f[3] = (float)(v.x >> 24);
  f[4] = (float)(v.y & 0xffu); f[5] = (float)((v.y >> 8) & 0xffu); f[6] = (float)((v.y >> 16) & 0xffu); f[7] = (float)(v.y >> 24);
  f[8] = (float)(v.z & 0xffu); f[9] = (float)((v.z >> 8) & 0xffu); f[10] = (float)((v.z >> 16) & 0xffu); f[11] = (float)(v.z >> 24);
  f[12] = (float)(v.w & 0xffu); f[13] = (float)((v.w >> 8) & 0xffu); f[14] = (float)((v.w >> 16) & 0xffu); f[15] = (float)(v.w >> 24);
}

__device__ __forceinline__ int team_index(const Params& p, unsigned char* smem) {
  int* sh = (int*)(smem + 8192);
  const int G = gridDim.x, tid = threadIdx.x;
  const int* tab = (const int*)(p.ws + WS_XCC);
  if (tid < 32) sh[tid] = 0;
  __syncthreads();
  const int mine = tab[blockIdx.x] & 15;
  for (int b = tid; b < G; b += NTHREADS) {
    const int x = tab[b] & 15;
    atomicAdd(&sh[x], 1);
    if (x == mine && b < (int)blockIdx.x) atomicAdd(&sh[16], 1);
  }
  __syncthreads();
  if (tid == 0) {
    int pre = 0;
    for (int j = 0; j < mine; ++j) pre += sh[j];
    sh[17] = pre + sh[16];
  }
  __syncthreads();
  const int r = sh[17];
  __syncthreads();
  return r;
}

__device__ __forceinline__ int wave_sum_i32_dpp(int v) {
  v += __builtin_amdgcn_update_dpp(0, v, 0xB1, 0xf, 0xf, true);
  v += __builtin_amdgcn_update_dpp(0, v, 0x4E, 0xf, 0xf, true);
  v += __builtin_amdgcn_update_dpp(0, v, 0x141, 0xf, 0xf, true);
  v += __builtin_amdgcn_update_dpp(0, v, 0x140, 0xf, 0xf, true);
  return __builtin_amdgcn_readlane(v, 0) + __builtin_amdgcn_readlane(v, 16) + __builtin_amdgcn_readlane(v, 32) + __builtin_amdgcn_readlane(v, 48);
}

__device__ __forceinline__ void phase_pu(const Params& p) {
  unsigned char* ws = p.ws;
  const unsigned char* XQ = ws + WS_XQ;
  const float* xs = (const float*)(ws + WS_XS);
  const unsigned char* U8 = ws + WS_U;
  const float* us = (const float*)(ws + WS_U + (size_t)16384 * 1024);
  const float* vs = (const float*)(ws + WS_V + (size_t)16384 * 1024);
  const int* eidx = (const int*)(ws + WS_EIDX);
  const float* gw = (const float*)(ws + WS_GW);
  float* aw = (float*)(ws + WS_PA);
  const int lane = threadIdx.x & 63, w = threadIdx.x >> 6;
  const int slot = blockIdx.x * 8 + w, nslot = gridDim.x * 8;
  if (slot >= TOK) return;
  typedef unsigned u32x4_t __attribute__((ext_vector_type(4)));
  u32x4_t cx = *(const u32x4_t*)(XQ + (size_t)slot * 1024 + lane * 16);
  int ce0 = eidx[(size_t)slot * 128 + lane], ce1 = eidx[(size_t)slot * 128 + 64 + lane];
  float cxs = xs[slot];
  u32x4_t nx = cx; int ne0 = ce0, ne1 = ce1; float nxs = cxs;
  u32x4_t ra[16], rb[16];
#define PU_ISSUE(BUF, EV, LB) do { _Pragma("unroll") for (int j = 0; j < 16; ++j) { \
      const int e_ = __builtin_amdgcn_readlane((EV), (LB) + j); \
      BUF[j] = *(const u32x4_t*)(U8 + (size_t)e_ * 1024 + lane * 16); } } while (0)
#define PU_REDUCE(BUF, LB, HREG) do { int hn_ = 0; _Pragma("unroll") for (int j = 0; j < 16; ++j) { \
      int d_ = __builtin_amdgcn_sdot4((int)BUF[j].x, (int)cx.x, 0, false); \
      d_ = __builtin_amdgcn_sdot4((int)BUF[j].y, (int)cx.y, d_, false); \
      d_ = __builtin_amdgcn_sdot4((int)BUF[j].z, (int)cx.z, d_, false); \
      d_ = __builtin_amdgcn_sdot4((int)BUF[j].w, (int)cx.w, d_, false); \
      const int tot_ = wave_sum_i32_dpp(d_); \
      if (lane == (LB) + j) hn_ = tot_; } \
      if (lane >= (LB) && lane < (LB) + 16) HREG = hn_; } while (0)
  PU_ISSUE(ra, ce0, 0);
  for (int tok = slot; tok < TOK; tok += nslot) {
    const int nt = (tok + nslot < TOK) ? tok + nslot : tok;
    const float us0 = us[ce0], us1 = us[ce1], vs0 = vs[ce0], vs1 = vs[ce1];
    const float g0 = gw[(size_t)tok * 128 + lane], g1 = gw[(size_t)tok * 128 + 64 + lane];
    nx = *(const u32x4_t*)(XQ + (size_t)nt * 1024 + lane * 16);
    ne0 = eidx[(size_t)nt * 128 + lane]; ne1 = eidx[(size_t)nt * 128 + 64 + lane];
    nxs = xs[nt];
    int h0i = 0, h1i = 0;
    PU_ISSUE(rb, ce0, 16); __builtin_amdgcn_sched_barrier(0); PU_REDUCE(ra, 0, h0i);  __builtin_amdgcn_sched_barrier(0);
    PU_ISSUE(ra, ce0, 32); __builtin_amdgcn_sched_barrier(0); PU_REDUCE(rb, 16, h0i); __builtin_amdgcn_sched_barrier(0);
    PU_ISSUE(rb, ce0, 48); __builtin_amdgcn_sched_barrier(0); PU_REDUCE(ra, 32, h0i); __builtin_amdgcn_sched_barrier(0);
    PU_ISSUE(ra, ce1, 0);  __builtin_amdgcn_sched_barrier(0); PU_REDUCE(rb, 48, h0i); __builtin_amdgcn_sched_barrier(0);
    PU_ISSUE(rb, ce1, 16); __builtin_amdgcn_sched_barrier(0); PU_REDUCE(ra, 0, h1i);  __builtin_amdgcn_sched_barrier(0);
    PU_ISSUE(ra, ce1, 32); __builtin_amdgcn_sched_barrier(0); PU_REDUCE(rb, 16, h1i); __builtin_amdgcn_sched_barrier(0);
    PU_ISSUE(rb, ce1, 48); __builtin_amdgcn_sched_barrier(0); PU_REDUCE(ra, 32, h1i); __builtin_amdgcn_sched_barrier(0);
    PU_ISSUE(ra, ne0, 0);  __builtin_amdgcn_sched_barrier(0); PU_REDUCE(rb, 48, h1i); __builtin_amdgcn_sched_barrier(0);
    const float h0 = (float)h0i * us0 * cxs, h1 = (float)h1i * us1 * cxs;
    aw[(size_t)tok * 128 + lane] = 0.5f * h0 * (1.f + erff(h0 * 0.70710678118654752f)) * g0 * vs0;
    aw[(size_t)tok * 128 + 64 + lane] = 0.5f * h1 * (1.f + erff(h1 * 0.70710678118654752f)) * g1 * vs1;
    cx = nx; ce0 = ne0; ce1 = ne1; cxs = nxs;
  }
#undef PU_ISSUE
#undef PU_REDUCE
}

template <bool SL>
__device__ __forceinline__ void phase_pv_t(const Params& p, unsigned char* smem) {
  unsigned char* ws = p.ws;
  const unsigned char* V8 = ws + WS_V;
  const int* eidx = (const int*)(ws + WS_EIDX);
  const float* aw = (const float*)(ws + WS_PA);
  float* ssq = (float*)(ws + WS_SSQ);
  const int lane = threadIdx.x & 63, w = threadIdx.x >> 6;
  const int q = lane >> 3, c = lane & 7;
  const int G = gridDim.x;
  constexpr bool sliced = SL;
  const int ti = sliced ? team_index(p, smem) : 0;
  const int tsz = G >> 3;
  const int grp0 = sliced ? (ti / tsz) : 0;
  constexpr int ngrp = sliced ? 1 : 8;
  const int slot = sliced ? (ti % tsz) * 8 + w : blockIdx.x * 8 + w;
  const int nslot = sliced ? tsz * 8 : G * 8;
  int ee[16]; float aa[16];
  if (slot < TOK) {
    unsigned bi = (unsigned)slot * 128u + (unsigned)q;
    asm volatile("" : "+v"(bi));
#pragma unroll
    for (int u = 0; u < 16; ++u) { ee[u] = eidx[bi + 8 * u]; aa[u] = aw[bi + 8 * u]; }
  }
  for (int tok = slot; tok < TOK; tok += nslot) {
    int ce[16]; float ca[16];
    float suma = 0.f;
#pragma unroll
    for (int u = 0; u < 16; ++u) { ce[u] = ee[u]; ca[u] = aa[u]; suma += aa[u]; }
    for (int gi = 0; gi < ngrp; ++gi) {
      const int grp = grp0 + gi;
      uint4 vv[16];
#pragma unroll
      for (int u = 0; u < 16; ++u) vv[u] = *(const uint4*)(V8 + (size_t)grp * (16384 * 128) + (size_t)ce[u] * 128 + c * 16);
      float* orow = p.out + (size_t)tok * 1024 + grp * 128 + c * 16;
      float4 x1v[4];
#pragma unroll
      for (int i = 0; i < 4; ++i) x1v[i] = *(const float4*)(orow + 4 * i);
      if (gi == ngrp - 1) {
        const int nt = (tok + nslot < TOK) ? tok + nslot : tok;
        unsigned bi = (unsigned)nt * 128u + (unsigned)q;
        asm volatile("" : "+v"(bi));
#pragma unroll
        for (int u = 0; u < 16; ++u) { ee[u] = eidx[bi + 8 * u]; aa[u] = aw[bi + 8 * u]; }
      }
      __builtin_amdgcn_sched_barrier(0);
      float acc[16];
#pragma unroll
      for (int i = 0; i < 16; ++i) acc[i] = -128.f * suma;
#pragma unroll
      for (int u = 0; u < 16; ++u) {
        float vf[16];
        cvt16u8(vv[u], vf);
#pragma unroll
        for (int i = 0; i < 16; ++i) acc[i] += ca[u] * vf[i];
        __builtin_amdgcn_sched_barrier(0);
      }
#pragma unroll
      for (int i = 0; i < 16; ++i) { acc[i] = add_xor8(acc[i]); acc[i] = add_xor16(acc[i]); acc[i] = add_xor32(acc[i]); }
      float ss = 0.f;
      if (q == 0) {
#pragma unroll
        for (int i = 0; i < 4; ++i) {
          const float4 oa = make_float4(x1v[i].x + acc[4 * i], x1v[i].y + acc[4 * i + 1], x1v[i].z + acc[4 * i + 2], x1v[i].w + acc[4 * i + 3]);
          *(float4*)(orow + 4 * i) = oa;
          ss += oa.x * oa.x + oa.y * oa.y + oa.z * oa.z + oa.w * oa.w;
        }
      }
      ss += __shfl_xor(ss, 1); ss += __shfl_xor(ss, 2); ss += __shfl_xor(ss, 4);
      if (lane == 0) atomicAdd(&ssq[tok], ss);
    }
  }
}

__device__ __forceinline__ void phase_final(const Params& p) {
  const float* ssq = (const float*)(p.ws + WS_SSQ);
  const int lane = threadIdx.x & 63, w = threadIdx.x >> 6;
  for (int row = blockIdx.x * 8 + w; row < TOK; row += gridDim.x * 8) {
    const float rstd = rsqrtf(ssq[row] * (1.f / DM) + EPSV);
    float4* o4 = (float4*)(p.out + (size_t)row * DM);
#pragma unroll
    for (int i = 0; i < 4; ++i) {
      float4 v = o4[lane + 64 * i];
      const float4 gg = ((const float4*)p.norm_final)[lane + 64 * i];
      v.x *= rstd * gg.x; v.y *= rstd * gg.y; v.z *= rstd * gg.z; v.w *= rstd * gg.w;
      o4[lane + 64 * i] = v;
    }
  }
}


__device__ __forceinline__ void phase_proj8(const Params& p, unsigned char* smem) {
  unsigned char* ws = p.ws;
  pg8::Gemm g{(const pg8::bf16_t*)(ws + WS_XN), (const pg8::bf16_t*)(ws + WS_WIN), TOK, 5120, 1024};
  pg8::StaticOrder S; S.init(TOK, 5120, (int)gridDim.x, (int)blockIdx.x);
  EpiProj E{(unsigned short*)(ws + WS_PH), (unsigned short*)(ws + WS_PA), (unsigned short*)(ws + WS_PG)};
  pg8::gemm_phase<EpiProj, pg8::StaticOrder>((PG8_LAS unsigned char*)smem, g, S, E, nullptr);
}
__device__ __forceinline__ void phase_ikln(const Params& p) {
  bf16_t* pA = (bf16_t*)(p.ws + WS_PA);
  const int tid = threadIdx.x, sub = tid & 7;
  float gam[8], bet[8];
#pragma unroll
  for (int i = 0; i < 8; ++i) { gam[i] = p.ikg[sub * 8 + i]; bet[i] = p.ikb[sub * 8 + i]; }
  for (int row = blockIdx.x * 64 + (tid >> 3); row < TOK; row += gridDim.x * 64) {
    uint4* ptr = (uint4*)(pA + (size_t)row * 1024 + 896 + sub * 8);
    const uint4 raw = *ptr;
    float v[8];
    cvt8(raw, v);
    float s = 0.f;
#pragma unroll
    for (int i = 0; i < 8; ++i) s += v[i];
    s += __shfl_xor(s, 1); s += __shfl_xor(s, 2); s += __shfl_xor(s, 4);
    const float mu = s * (1.f / 64.f);
    float q = 0.f;
#pragma unroll
    for (int i = 0; i < 8; ++i) { const float d = v[i] - mu; q += d * d; }
    q += __shfl_xor(q, 1); q += __shfl_xor(q, 2); q += __shfl_xor(q, 4);
    const float rstd = rsqrtf(q * (1.f / 64.f) + EPSV);
    uint4 o;
    o.x = pack2((v[0] - mu) * rstd * gam[0] + bet[0], (v[1] - mu) * rstd * gam[1] + bet[1]);
    o.y = pack2((v[2] - mu) * rstd * gam[2] + bet[2], (v[3] - mu) * rstd * gam[3] + bet[3]);
    o.z = pack2((v[4] - mu) * rstd * gam[4] + bet[4], (v[5] - mu) * rstd * gam[5] + bet[5]);
    o.w = pack2((v[6] - mu) * rstd * gam[6] + bet[6], (v[7] - mu) * rstd * gam[7] + bet[7]);
    *ptr = o;
  }
}
__device__ __forceinline__ void phase_up8(const Params& p, unsigned char* smem) {
  unsigned char* ws = p.ws;
  const pg8::bf16_t* ya = (const pg8::bf16_t*)(ws + WS_XN);
  const pg8::bf16_t* yb = ya + (size_t)TOK * 512;
  pg8::StaticOrder S; S.init(TOK, 1024, (int)gridDim.x, (int)blockIdx.x);
  {
    pg8::Gemm g{ya, (const pg8::bf16_t*)(ws + WS_WUPA), TOK, 1024, 512};
    EpiGate<0> E{(unsigned short*)(ws + WS_PH), (const unsigned short*)(ws + WS_PG), 0};
    pg8::gemm_phase<EpiGate<0>, pg8::StaticOrder>((PG8_LAS unsigned char*)smem, g, S, E, nullptr);
  }
  {
    pg8::Gemm g{yb, (const pg8::bf16_t*)(ws + WS_WUPB), TOK, 1024, 512};
    EpiGate<1> E{(unsigned short*)(ws + WS_PH), (const unsigned short*)(ws + WS_PG), 1024};
    pg8::gemm_phase<EpiGate<1>, pg8::StaticOrder>((PG8_LAS unsigned char*)smem, g, S, E, nullptr);
  }
}
__device__ __forceinline__ void phase_out8(const Params& p, unsigned char* smem) {
  unsigned char* ws = p.ws;
  pg8::Gemm g{(const pg8::bf16_t*)(ws + WS_PH), (const pg8::bf16_t*)(ws + WS_WOUT), TOK, 1024, 1024};
  pg8::StaticOrder S; S.init(TOK, 1024, (int)gridDim.x, (int)blockIdx.x);
  EpiResid E{p.out, p.x};
  pg8::gemm_phase<EpiResid, pg8::StaticOrder>((PG8_LAS unsigned char*)smem, g, S, E, nullptr);
}
__device__ __forceinline__ void phase_pq8(const Params& p, unsigned char* smem) {
  unsigned char* ws = p.ws;
  pg8::Gemm g{(const pg8::bf16_t*)(ws + WS_XN), (const pg8::bf16_t*)(ws + WS_WQ), TOK, 2048, 1024};
  pg8::StaticOrder S; S.init(TOK, 2048, (int)gridDim.x, (int)blockIdx.x);
  EpiStoreBf16 E{(unsigned short*)(ws + WS_PG), 2048};
  pg8::gemm_phase<EpiStoreBf16, pg8::StaticOrder>((PG8_LAS unsigned char*)smem, g, S, E, nullptr);
}

__global__ void __launch_bounds__(NTHREADS) hybrid_fwd(Params p) {
  extern __shared__ __attribute__((aligned(16))) unsigned char smem[];
#if ONE_LAUNCH
  cg::grid_group grid = cg::this_grid();
  volatile LAS unsigned* xst = (volatile LAS unsigned*)(smem + LDS_BYTES - 16);
  if (threadIdx.x == 0) { xst[0] = 0u; xst[1] = 0u; }
  __syncthreads();
  XcdBarrier xbar = xcd_barrier_post((unsigned*)(p.ws + WS_BAR), xst);
#define SEAM(k) do { if (p.ph_lo <= (k) && (k) + 1 < p.ph_hi) { if ((k) == 0) grid.sync(); else xcd_barrier(xbar); } } while (0)
#else
#define SEAM(k) do { } while (0)
#endif
#define IN(k) (p.ph_lo <= (k) && (k) < p.ph_hi)
#ifndef REPEAT_PH
#define REPEAT_PH -1
#endif
#define REP(k, stmt) do { if (REPEAT_PH == (k)) { stmt; grid.sync(); } } while (0)
  if (IN(0)) { phase_prep(p, smem); SEAM(0); }
  if (IN(1)) { phase_proj8(p, smem); SEAM(1); }
  if (IN(2)) { phase_ikln(p); hgrn_h1_all(p, smem); SEAM(2); }
  if (IN(3)) { phase_mix(p, smem); SEAM(3); }
  if (IN(4)) { phase_up8(p, smem); SEAM(4); }
  if (IN(5)) { phase_out8(p, smem); SEAM(5); }
  if (IN(6)) { rmsnorm_rows_q(p.out, p.norm_ffn, (bf16_t*)(p.ws + WS_XN), p.ws + WS_XQ, (float*)(p.ws + WS_XS)); SEAM(6); }
  if (IN(7)) { phase_pq8(p, smem); SEAM(7); }
  if (IN(8)) { phase_pkeys(p, smem); SEAM(8); }
  if (IN(9)) { phase_pcomb(p, smem); SEAM(9); }
  if (IN(10)) { phase_pu(p); SEAM(10); }
  if (IN(11)) { if (gridDim.x % 8 == 0) phase_pv_t<true>(p, smem); else phase_pv_t<false>(p, smem); SEAM(11); }
  if (IN(12)) { phase_final(p); }
#undef IN
#undef SEAM
}

extern "C" void kernel_launch(void* const* d_in, const int* in_sizes, int n_in, void* d_out, int out_size, void* d_ws, size_t ws_size,
                              hipStream_t stream) {
  static int grid = 0;
  if (grid == 0) {
    if (n_in != 17 || ws_size < WS_END) {
      fprintf(stderr, "kernel_launch: unexpected n_in %d or ws_size %zu (need %zu)\n", n_in, ws_size, (size_t)WS_END);
      grid = -1; return;
    }
    int dev = 0, cus = 0, per_cu = 0;
    hipGetDevice(&dev);
    hipDeviceGetAttribute(&cus, hipDeviceAttributeMultiprocessorCount, dev);
    hipFuncSetAttribute((const void*)hybrid_fwd, hipFuncAttributeMaxDynamicSharedMemorySize, LDS_BYTES);
    hipOccupancyMaxActiveBlocksPerMultiprocessor(&per_cu, (const void*)hybrid_fwd, NTHREADS, LDS_BYTES);
    if (per_cu < 1) { fprintf(stderr, "kernel_launch: occupancy query says %d blocks/CU\n", per_cu); per_cu = 1; }
    (void)hipGetLastError();
    grid = cus;
  }
  if (grid < 0) return;
  Params p{};
  p.x = (const float*)d_in[0]; p.norm_mix = (const float*)d_in[1]; p.w_in = (const float*)d_in[2]; p.hg_lb = (const float*)d_in[3];
  p.hg_norm = (const float*)d_in[4]; p.ikg = (const float*)d_in[5]; p.ikb = (const float*)d_in[6]; p.rel_bias = (const float*)d_in[7];
  p.w_up_a = (const float*)d_in[8]; p.w_up_b = (const float*)d_in[9]; p.w_out = (const float*)d_in[10]; p.norm_ffn = (const float*)d_in[11];
  p.peer_wq = (const float*)d_in[12]; p.peer_keys = (const float*)d_in[13]; p.peer_u = (const float*)d_in[14]; p.peer_v = (const float*)d_in[15];
  p.norm_final = (const float*)d_in[16];
  p.out = (float*)d_out; p.ws = (unsigned char*)d_ws;
#if ONE_LAUNCH
  hipMemsetAsync((unsigned char*)d_ws + WS_BAR, 0, 16384, stream);
  p.ph_lo = 0; p.ph_hi = NPHASE;
  void* args[] = {&p};
  hipError_t e = hipLaunchCooperativeKernel((const void*)hybrid_fwd, dim3(grid), dim3(NTHREADS), args, LDS_BYTES, stream);
  if (e != hipSuccess) fprintf(stderr, "cooperative launch failed: %s (grid %d)\n", hipGetErrorString(e), grid);
#else
  for (int ph = 0; ph < NPHASE; ++ph) {
    p.ph_lo = ph; p.ph_hi = ph + 1;
    hipLaunchKernelGGL(hybrid_fwd, dim3(grid), dim3(NTHREADS), LDS_BYTES, stream, p);
  }
#endif
}
```

```cpp
#include <hip/hip_runtime.h>
#include <hip/hip_cooperative_groups.h>
#include <stdint.h>
#include <stdio.h>
namespace cg = cooperative_groups;

#ifndef ONE_LAUNCH
#define ONE_LAUNCH 1
#endif

typedef unsigned short bf16_t;
typedef __attribute__((ext_vector_type(8))) short bf16x8;
typedef __attribute__((ext_vector_type(4))) float f32x4;

#define NTHREADS 512
#define TOK 32768
#define SEQL 4096
#define DM 1024
#define EPSV 1e-6f
#define NPHASE 13

#define WS_WIN   ((size_t)0)
#define WS_WUPA  (WS_WIN  + (size_t)5120 * 1024 * 2)
#define WS_WUPB  (WS_WUPA + (size_t)1024 * 512 * 2)
#define WS_WOUT  (WS_WUPB + (size_t)1024 * 512 * 2)
#define WS_WQ    (WS_WOUT + (size_t)1024 * 1024 * 2)
#define WS_KEYS  (WS_WQ   + (size_t)2048 * 1024 * 2)
#define WS_LB    (WS_KEYS + (size_t)2 * 8 * 128 * 128 * 2)
#define WS_U     (WS_LB   + (size_t)4096)
#define WS_V     (WS_U    + (size_t)16384 * 1024 * 2)
#define WS_XN    (WS_V    + (size_t)16384 * 1024 * 2)
#define WS_PH    (WS_XN   + (size_t)TOK * 1024 * 2)
#define WS_PA    (WS_PH   + (size_t)TOK * 2048 * 2)
#define WS_PG    (WS_PA   + (size_t)TOK * 1024 * 2)
#define WS_EIDX  (WS_PG   + (size_t)TOK * 2048 * 2)
#define WS_GW    (WS_EIDX + (size_t)TOK * 128 * 4)
#define WS_SSQ   (WS_GW   + (size_t)TOK * 128 * 4)
#define WS_XCC   (WS_SSQ  + (size_t)TOK * 4)
#define WS_BAR   (WS_XCC  + (size_t)4096)
#define WS_DEC   (WS_BAR  + (size_t)16384)
#define WS_QCTR  (WS_DEC  + (size_t)2048 * 384 * 4)
#define WS_END   (WS_QCTR + (size_t)1024)

#define LDS_BYTES 155648

struct Params {
  const float* x; const float* norm_mix; const float* w_in; const float* hg_lb; const float* hg_norm;
  const float* ikg; const float* ikb; const float* rel_bias; const float* w_up_a; const float* w_up_b;
  const float* w_out; const float* norm_ffn; const float* peer_wq; const float* peer_keys;
  const float* peer_u; const float* peer_v; const float* norm_final;
  float* out; unsigned char* ws; int ph_lo, ph_hi;
};

__device__ __forceinline__ float bf2f(bf16_t u) { return __uint_as_float(((unsigned)u) << 16); }
__device__ __forceinline__ bf16_t f2bf(float f) {
  unsigned u = __float_as_uint(f);
  u += 0x7fffu + ((u >> 16) & 1u);
  return (bf16_t)(u >> 16);
}
__device__ __forceinline__ unsigned pack2(float a, float b) { return (unsigned)f2bf(a) | ((unsigned)f2bf(b) << 16); }
__device__ __forceinline__ float wave_sum_slow(float v) {
#pragma unroll
  for (int o = 32; o > 0; o >>= 1) v += __shfl_xor(v, o);
  return v;
}
__device__ __forceinline__ void lds_fence() { asm volatile("s_waitcnt lgkmcnt(0)" ::: "memory"); }

__device__ __forceinline__ float add_xor8(float v) { return v + __int_as_float(__builtin_amdgcn_update_dpp(0, __float_as_int(v), 0x128, 0xf, 0xf, true)); }
__device__ __forceinline__ float add_xor16(float v) { const auto r = __builtin_amdgcn_permlane16_swap(__float_as_uint(v), __float_as_uint(v), false, false); return __uint_as_float(r[0]) + __uint_as_float(r[1]); }
__device__ __forceinline__ float add_xor32(float v) { const auto r = __builtin_amdgcn_permlane32_swap(__float_as_uint(v), __float_as_uint(v), false, false); return __uint_as_float(r[0]) + __uint_as_float(r[1]); }
__device__ __forceinline__ float max_xor16(float v) { const auto r = __builtin_amdgcn_permlane16_swap(__float_as_uint(v), __float_as_uint(v), false, false); return fmaxf(__uint_as_float(r[0]), __uint_as_float(r[1])); }
__device__ __forceinline__ float max_xor32(float v) { const auto r = __builtin_amdgcn_permlane32_swap(__float_as_uint(v), __float_as_uint(v), false, false); return fmaxf(__uint_as_float(r[0]), __uint_as_float(r[1])); }
__device__ __forceinline__ float wave_sum(float v) {
  v += __int_as_float(__builtin_amdgcn_update_dpp(0, __float_as_int(v), 0xB1, 0xf, 0xf, true));
  v += __int_as_float(__builtin_amdgcn_update_dpp(0, __float_as_int(v), 0x4E, 0xf, 0xf, true));
  v += __int_as_float(__builtin_amdgcn_update_dpp(0, __float_as_int(v), 0x141, 0xf, 0xf, true));
  v += __int_as_float(__builtin_amdgcn_update_dpp(0, __float_as_int(v), 0x140, 0xf, 0xf, true));
  return add_xor32(add_xor16(v));
}
__device__ __forceinline__ float sigmoidf_(float x) { return 1.f / (1.f + __expf(-x)); }
__device__ __forceinline__ float siluf_(float x) { return x / (1.f + __expf(-x)); }


#define XB_TMO      128
#define XB_XCNT(j)  (256  + 64 * (j))
#define XB_XSUB(j)  (1280 + 64 * (j))
#define XB_XGEN(j)  (2304 + 64 * (j))
#define XB_TOP      3328
#define XB_TOPGEN   3392
#define XCD_BAR_WORDS 3456
#define XB_SPIN_CAP (1u << 22)
#define LAS __attribute__((address_space(3)))
__device__ __forceinline__ unsigned xb_ld(unsigned* p)              { return __hip_atomic_load(p, __ATOMIC_RELAXED, __HIP_MEMORY_SCOPE_AGENT); }
__device__ __forceinline__ unsigned xb_add(unsigned* p, unsigned v) { return __hip_atomic_fetch_add(p, v, __ATOMIC_RELAXED, __HIP_MEMORY_SCOPE_AGENT); }
__device__ __forceinline__ unsigned xb_xcc_id() { return (unsigned)__builtin_amdgcn_s_getreg((3 << 11) | 20) & 0xFu; }
#define XB_SPIN(cond, bar) do { unsigned _sp = 0; while (cond) { __builtin_amdgcn_s_sleep(1); \
    if ((++_sp & 255u) == 0u) { if (xb_ld(&(bar)[XB_TMO])) break; if (_sp > XB_SPIN_CAP) { atomicAdd(&(bar)[XB_TMO], 1u); break; } } } } while (0)
struct XcdBarrier { unsigned* bar; unsigned x; volatile LAS unsigned* st; };
__device__ __forceinline__ XcdBarrier xcd_barrier_post(unsigned* bar, volatile LAS unsigned* st) {
  XcdBarrier b; b.bar = bar; b.x = xb_xcc_id(); b.st = st;
  if (threadIdx.x == 0) (void)xb_add(&bar[XB_XCNT(b.x)], 1u);
  return b;
}
__device__ __forceinline__ void xcd_barrier_complete(unsigned* bar, unsigned x, unsigned& nloc, unsigned& nx) {
  const unsigned G = gridDim.x * gridDim.y * gridDim.z;
  unsigned sum, cnt, mine, sp = 0u;
  for (;;) {
    sum = 0u; cnt = 0u; mine = 0u;
#pragma unroll
    for (unsigned j = 0; j < 16; ++j) { const unsigned c = xb_ld(&bar[XB_XCNT(j)]); sum += c; cnt += (c > 0u) ? 1u : 0u; mine = (j == x) ? c : mine; }
    if (sum == G) break;
    __builtin_amdgcn_s_sleep(1);
    if ((++sp & 255u) == 0u) { if (xb_ld(&bar[XB_TMO])) break; if (sp > XB_SPIN_CAP) { atomicAdd(&bar[XB_TMO], 1u); break; } }
  }
  nloc = mine > 0u ? mine : 1u; nx = cnt > 0u ? cnt : 1u;
}
__device__ __forceinline__ void xcd_barrier(const XcdBarrier& b) {
  asm volatile("s_waitcnt vmcnt(0)" ::: "memory");
  __syncthreads();
  if (threadIdx.x == 0) {
    unsigned* bar = b.bar;
    __builtin_amdgcn_s_waitcnt(0);
    unsigned nloc = b.st[0], nx = b.st[1];
    if (nloc == 0u) { xcd_barrier_complete(bar, b.x, nloc, nx); b.st[0] = nloc; b.st[1] = nx; }
    const unsigned old = xb_add(&bar[XB_XSUB(b.x)], 1u);
    const unsigned gen = old / nloc;
    if (old + 1u == (gen + 1u) * nloc) {
      __builtin_amdgcn_fence(__ATOMIC_RELEASE, "agent");
      asm volatile("s_waitcnt vmcnt(0)" ::: "memory");
      const unsigned og = xb_add(&bar[XB_TOP], 1u);
      const unsigned tg = og / nx;
      if (og + 1u == (tg + 1u) * nx) xb_add(&bar[XB_TOPGEN], 1u);
      else XB_SPIN(xb_ld(&bar[XB_TOPGEN]) == tg, bar);
      __builtin_amdgcn_fence(__ATOMIC_ACQUIRE, "agent");
      xb_add(&bar[XB_XGEN(b.x)], 1u);
      asm volatile("s_waitcnt vmcnt(0)" ::: "memory");
    } else {
      XB_SPIN(xb_ld(&bar[XB_XGEN(b.x)]) == gen, bar);
      __builtin_amdgcn_fence(__ATOMIC_ACQUIRE, "agent");
      asm volatile("s_waitcnt vmcnt(0)" ::: "memory");
    }
  }
  __syncthreads();
}

namespace pg8 {
#define PG8_LAS __attribute__((address_space(3)))
typedef unsigned short bf16_t;
typedef short bf16x8 __attribute__((ext_vector_type(8)));
typedef float f32x4 __attribute__((ext_vector_type(4)));
typedef unsigned u32x4 __attribute__((ext_vector_type(4)));
constexpr int BM = 256, BK = 64, HALF = 128, HTB = HALF * BK * 2  , STAGE_BYTES = 8 * HTB, NXCD = 8, WGM = 8;

__host__ __device__ __forceinline__ int lds_byte(int r, int c) { const int st = (r >> 4) * 2 + (c >> 5), rr = r & 15, cc = c & 31, ob = rr * 64 + cc * 2; return st * 1024 + (ob ^ (((ob >> 9) & 1) << 5)); }
__host__ __device__ __forceinline__ void stage_rc(int b, int& R, int& C) { const int st = b / 1024, sb = b % 1024, swz = sb ^ (((sb >> 9) & 1) << 5); R = (st >> 1) * 16 + swz / 64; C = (st & 1) * 32 + (swz % 64) / 2; }
__host__ __device__ __forceinline__ int perm32(int rho) { const int n = rho >> 4, i = rho & 15; return 8 * (i >> 2) + 4 * n + (i & 3); }

struct Unit { int pm, pn; };
struct Gemm { const bf16_t* A; const bf16_t* Bt; int M, N, K; };

struct StaticOrder {
    int nM, nN, nwg, G, c;
    __host__ __device__ void init(int M, int N, int G_, int c_) { nM = M / BM; nN = N / BM; nwg = nM * nN; G = G_; c = c_; }
    __host__ __device__ bool next(int i, Unit& u) const {
        const long L = (long)i * G + c; if (L >= nwg) return false;
        int wgid = (int)L; { const int q = nwg / NXCD, r = nwg % NXCD, xcd = wgid % NXCD, off = wgid / NXCD; wgid = (xcd < r ? xcd * (q + 1) : r * (q + 1) + (xcd - r) * q) + off; }
        const int nig = WGM * nN, gid = wgid / nig, fm = gid * WGM, gsz = (nM - fm) < WGM ? (nM - fm) : WGM;
        u.pm = fm + ((wgid % nig) % gsz); u.pn = (wgid % nig) / gsz; return true;
    }
    __device__ __forceinline__ void a_ready(const Unit&) const {}
    __device__ __forceinline__ void done(const Unit&) const {}
};
__device__ __forceinline__ unsigned cvt_pk_bf16(float lo, float hi) { unsigned r; asm volatile("v_cvt_pk_bf16_f32 %0, %1, %2" : "=v"(r) : "v"(lo), "v"(hi)); return r; }
template <class Epi, class Sched, bool STAMP = false>
__device__ __forceinline__ void gemm_phase(PG8_LAS unsigned char* lds, const Gemm g, const Sched& S, const Epi& E, unsigned long long* stamps) {
    const int tid = threadIdx.x, wid = __builtin_amdgcn_readfirstlane(tid >> 6), lane = tid & 63, wr = wid >> 2, wc = wid & 3, fr = lane & 15, fq = lane >> 4;
    const int K = g.K, nt = K / BK;
    int ts_lo = 0, ts_hi = 0, nts = 0; const unsigned long long rt_entry = STAMP ? (unsigned long long)wall_clock64() : 0ull;
#define PG8_STAMP() do { if (STAMP && wid == 0 && nts < 64) { const unsigned long long _c = (unsigned long long)clock64(); \
        ts_lo = (lane == nts) ? (int)(unsigned)_c : ts_lo; ts_hi = (lane == nts) ? (int)(unsigned)(_c >> 32) : ts_hi; ++nts; } } while (0)
    PG8_STAMP();
    unsigned voffA[2], voffB[2];
#pragma unroll
    for (int i = 0; i < 2; ++i) { int R, C; stage_rc(tid * 16 + i * 8192, R, C); const int Rb = Epi::PERM ? ((R & ~31) + perm32(R & 31)) : R;
        voffA[i] = (unsigned)(R * K + C) * 2u; voffB[i] = (unsigned)(Rb * K + C) * 2u; }
    const size_t kstep = (size_t)(BK * 2);
    const size_t hstep = (size_t)HALF * K * 2;
    const size_t tstep = 2 * hstep;
    const unsigned ldsw = (unsigned)wid * 1024u;
    const int aoff = lds_byte(wr * 64 + fr, fq * 8), boff = lds_byte(wc * 32 + fr, fq * 8);
#define PG8_SA(b, h) (((b) * 2 + (h)) * HTB)
#define PG8_SB(b, h) ((4 + (b) * 2 + (h)) * HTB)
#define PG8_STAGE(bufoff, gbase, voff) do { _Pragma("unroll") for (int _i = 0; _i < 2; ++_i) \
        __builtin_amdgcn_global_load_lds((const unsigned*)((const char*)(gbase) + (voff)[_i]), (PG8_LAS unsigned*)(lds + (bufoff) + ldsw + _i * 8192), 16, 0, 0); } while (0)
#define PG8_LDA(dst, b, h) do { _Pragma("unroll") for (int m = 0; m < 4; ++m) _Pragma("unroll") for (int k = 0; k < 2; ++k) dst[m][k] = *(const PG8_LAS bf16x8*)(lds + PG8_SA(b, h) + aoff + m * 2048 + k * 1024); } while (0)
#define PG8_LDB(dst, b, h) do { _Pragma("unroll") for (int n = 0; n < 2; ++n) _Pragma("unroll") for (int k = 0; k < 2; ++k) dst[n][k] = *(const PG8_LAS bf16x8*)(lds + PG8_SB(b, h) + boff + n * 2048 + k * 1024); } while (0)
#define PG8_MMA(ai, bj, At, Bt) do { __builtin_amdgcn_s_setprio(1); _Pragma("unroll") for (int m = 0; m < 4; ++m) _Pragma("unroll") for (int n = 0; n < 2; ++n) _Pragma("unroll") for (int k = 0; k < 2; ++k) \
        acc[ai][bj][m][n] = __builtin_amdgcn_mfma_f32_16x16x32_bf16(Bt[n][k], At[m][k], acc[ai][bj][m][n], 0, 0, 0); __builtin_amdgcn_s_setprio(0); } while (0)
#define PG8_WAIT_V(n) asm volatile("s_waitcnt vmcnt(" #n ")" ::: "memory")
#define PG8_WAIT_L(n) asm volatile("s_waitcnt lgkmcnt(" #n ")" ::: "memory")
#define PG8_BAR __builtin_amdgcn_s_barrier()
#define PG8_SCHED __builtin_amdgcn_sched_barrier(0)
    Unit cur, nxt; int ui = 0;
    if (!S.next(0, cur)) return;
    f32x4 acc[2][2][4][2];
#pragma unroll
    for (int a = 0; a < 2; ++a)
#pragma unroll
        for (int b = 0; b < 2; ++b)
#pragma unroll
            for (int m = 0; m < 4; ++m)
#pragma unroll
                for (int n = 0; n < 2; ++n) acc[a][b][m][n] = (f32x4){0.f, 0.f, 0.f, 0.f};
    bf16x8 At[4][2], B0[2][2], B1[2][2];
    const char* cA = (const char*)g.A + (size_t)cur.pm * tstep; const char* cB = (const char*)g.Bt + (size_t)cur.pn * tstep;
    S.a_ready(cur);
    PG8_STAGE(PG8_SB(0, 0), cB, voffB); PG8_STAGE(PG8_SA(0, 0), cA, voffA); PG8_STAGE(PG8_SB(0, 1), cB + hstep, voffB); PG8_STAGE(PG8_SA(0, 1), cA + hstep, voffA);
    if (wr == 1) PG8_BAR;
    PG8_WAIT_V(4); PG8_BAR;
    PG8_STAGE(PG8_SB(1, 0), cB + kstep, voffB); PG8_STAGE(PG8_SA(1, 0), cA + kstep, voffA); PG8_STAGE(PG8_SB(1, 1), cB + hstep + kstep, voffB);
    PG8_WAIT_V(6); PG8_BAR;
    PG8_STAMP();
    for (;;) {
        const bool has_next = S.next(ui + 1, nxt);
        const char* nA = has_next ? (const char*)g.A + (size_t)nxt.pm * tstep : cA; const char* nB = has_next ? (const char*)g.Bt + (size_t)nxt.pn * tstep : cB;
        for (int t = 0; t < nt; t += 2) {
            const bool last = (t == nt - 2);
            const char* a1 = cA + (size_t)(t + 1) * kstep;
            const char* a2 = last ? nA : cA + (size_t)(t + 2) * kstep; const char* b2 = last ? nB : cB + (size_t)(t + 2) * kstep;
            const char* a3 = a2 + kstep; const char* b3 = b2 + kstep;
            if (last && has_next) S.a_ready(nxt);
            PG8_LDB(B0, 0, 0); PG8_SCHED; PG8_LDA(At, 0, 0); PG8_STAGE(PG8_SA(1, 1), a1 + hstep, voffA);
            PG8_WAIT_L(8); PG8_BAR; PG8_WAIT_L(0); PG8_MMA(0, 0, At, B0); PG8_BAR; PG8_SCHED;
            PG8_LDB(B1, 0, 1); PG8_STAGE(PG8_SB(0, 0), b2, voffB);
            PG8_BAR; PG8_WAIT_L(0); PG8_MMA(0, 1, At, B1); PG8_BAR;
            PG8_LDA(At, 0, 1); PG8_STAGE(PG8_SA(0, 0), a2, voffA);
            PG8_BAR; PG8_WAIT_L(0); PG8_MMA(1, 0, At, B0); PG8_BAR; PG8_SCHED;
            PG8_STAGE(PG8_SB(0, 1), b2 + hstep, voffB);
            PG8_WAIT_V(6); PG8_BAR; PG8_MMA(1, 1, At, B1); PG8_BAR;
            PG8_LDB(B0, 1, 0); PG8_SCHED; PG8_LDA(At, 1, 0); PG8_STAGE(PG8_SA(0, 1), a2 + hstep, voffA);
            PG8_WAIT_L(8); PG8_BAR; PG8_WAIT_L(0); PG8_MMA(0, 0, At, B0); PG8_BAR; PG8_SCHED;
            PG8_LDB(B1, 1, 1); PG8_STAGE(PG8_SB(1, 0), b3, voffB);
            PG8_BAR; PG8_WAIT_L(0); PG8_MMA(0, 1, At, B1); PG8_BAR;
            PG8_LDA(At, 1, 1); PG8_STAGE(PG8_SA(1, 0), a3, voffA);
            PG8_BAR; PG8_WAIT_L(0); PG8_MMA(1, 0, At, B0); PG8_BAR; PG8_SCHED;
            PG8_STAGE(PG8_SB(1, 1), b3 + hstep, voffB);
            PG8_WAIT_V(6); PG8_BAR; PG8_MMA(1, 1, At, B1); PG8_BAR;
        }
        PG8_STAMP();
        if constexpr (!Epi::AFTER_DRAIN) { E(acc, cur, wr, wc, fr, fq); S.done(cur); }
        PG8_STAMP();
        if (!has_next) break;
#pragma unroll
        for (int a = 0; a < 2; ++a)
#pragma unroll
            for (int b = 0; b < 2; ++b)
#pragma unroll
                for (int m = 0; m < 4; ++m)
#pragma unroll
                    for (int n = 0; n < 2; ++n) acc[a][b][m][n] = (f32x4){0.f, 0.f, 0.f, 0.f};
        cur = nxt; cA = nA; cB = nB; ++ui;
    }
    PG8_WAIT_V(0);
    if (wr == 0) PG8_BAR;
    PG8_BAR;
    if constexpr (Epi::AFTER_DRAIN) { E.fused(acc, cur, wr, wc, fr, fq, lds, wid, lane); S.done(cur); }
    PG8_STAMP();
    if (STAMP && wid == 0) { stamps[lane] = lane < nts ? (((unsigned long long)(unsigned)ts_hi << 32) | (unsigned)ts_lo) : 0ull;
        if (lane == 62) stamps[62] = rt_entry; if (lane == 63) stamps[63] = (unsigned long long)wall_clock64(); }
#undef PG8_STAMP
#undef PG8_SA
#undef PG8_SB
#undef PG8_STAGE
#undef PG8_LDA
#undef PG8_LDB
#undef PG8_MMA
#undef PG8_WAIT_V
#undef PG8_WAIT_L
#undef PG8_BAR
#undef PG8_SCHED
}
}

struct EpiProj {
  static constexpr bool PERM = true, AFTER_DRAIN = false;
  unsigned short* pH; unsigned short* pA; unsigned short* pG;
  __device__ __forceinline__ void operator()(const pg8::f32x4 (&acc)[2][2][4][2], const pg8::Unit& u, int wr, int wc, int fr, int fq) const {
    const int row0 = u.pm * 256 + wr * 64 + fr;
    unsigned short* base; int ldc, colt; bool sg = false;
    if (u.pn < 8) { base = pH; ldc = 2048; colt = u.pn * 256; }
    else if (u.pn < 12) { base = pA; ldc = 1024; colt = (u.pn - 8) * 256; }
    else { base = pG; ldc = 2048; colt = (u.pn - 12) * 256; sg = true; }
    const int col0 = colt + wc * 32 + 8 * fq;
#pragma unroll
    for (int ai = 0; ai < 2; ++ai)
#pragma unroll
      for (int m = 0; m < 4; ++m) {
        unsigned short* rowp = base + (size_t)(row0 + ai * 128 + m * 16) * ldc + col0;
#pragma unroll
        for (int bj = 0; bj < 2; ++bj) {
          pg8::f32x4 v0 = acc[ai][bj][m][0], v1 = acc[ai][bj][m][1];
          if (sg) {
#pragma unroll
            for (int j = 0; j < 4; ++j) { v0[j] = sigmoidf_(v0[j]); v1[j] = sigmoidf_(v1[j]); }
          }
          pg8::u32x4 w; w.x = pg8::cvt_pk_bf16(v0[0], v0[1]); w.y = pg8::cvt_pk_bf16(v0[2], v0[3]); w.z = pg8::cvt_pk_bf16(v1[0], v1[1]); w.w = pg8::cvt_pk_bf16(v1[2], v1[3]);
          *(pg8::u32x4*)(rowp + bj * 128) = w;
        }
      }
  }
};
template <int MODE> struct EpiGate {
  static constexpr bool PERM = true, AFTER_DRAIN = false;
  unsigned short* hb; const unsigned short* pG; int goff;
  __device__ __forceinline__ void operator()(const pg8::f32x4 (&acc)[2][2][4][2], const pg8::Unit& u, int wr, int wc, int fr, int fq) const {
    const int row0 = u.pm * 256 + wr * 64 + fr;
    const int col0 = u.pn * 256 + wc * 32 + 8 * fq;
#pragma unroll
    for (int ai = 0; ai < 2; ++ai)
#pragma unroll
      for (int m = 0; m < 4; ++m) {
        const size_t r = (size_t)(row0 + ai * 128 + m * 16);
        pg8::u32x4 gv[2], hv[2];
#pragma unroll
        for (int bj = 0; bj < 2; ++bj) {
          gv[bj] = *(const pg8::u32x4*)(pG + r * 2048 + goff + col0 + bj * 128);
          if (MODE == 1) hv[bj] = *(const pg8::u32x4*)(hb + r * 1024 + col0 + bj * 128);
        }
#pragma unroll
        for (int bj = 0; bj < 2; ++bj) {
          float o[8];
#pragma unroll
          for (int j = 0; j < 4; ++j) {
            const unsigned gw0 = gv[bj][j >> 1], gw1 = gv[bj][2 + (j >> 1)];
            const float g0 = (j & 1) ? __uint_as_float(gw0 & 0xffff0000u) : __uint_as_float(gw0 << 16);
            const float g1 = (j & 1) ? __uint_as_float(gw1 & 0xffff0000u) : __uint_as_float(gw1 << 16);
            o[j] = acc[ai][bj][m][0][j] * g0; o[4 + j] = acc[ai][bj][m][1][j] * g1;
            if (MODE == 1) {
              const unsigned hw0 = hv[bj][j >> 1], hw1 = hv[bj][2 + (j >> 1)];
              o[j] += (j & 1) ? __uint_as_float(hw0 & 0xffff0000u) : __uint_as_float(hw0 << 16);
              o[4 + j] += (j & 1) ? __uint_as_float(hw1 & 0xffff0000u) : __uint_as_float(hw1 << 16);
            }
          }
          pg8::u32x4 w; w.x = pg8::cvt_pk_bf16(o[0], o[1]); w.y = pg8::cvt_pk_bf16(o[2], o[3]); w.z = pg8::cvt_pk_bf16(o[4], o[5]); w.w = pg8::cvt_pk_bf16(o[6], o[7]);
          *(pg8::u32x4*)(hb + r * 1024 + col0 + bj * 128) = w;
        }
      }
  }
};
struct EpiResid {
  static constexpr bool PERM = false, AFTER_DRAIN = false;
  float* out; const float* x;
  __device__ __forceinline__ void operator()(const pg8::f32x4 (&acc)[2][2][4][2], const pg8::Unit& u, int wr, int wc, int fr, int fq) const {
    const int row0 = u.pm * 256 + wr * 64 + fr, col0 = u.pn * 256 + wc * 32 + 4 * fq;
#pragma unroll
    for (int ai = 0; ai < 2; ++ai)
#pragma unroll
      for (int m = 0; m < 4; ++m) {
        const size_t off = (size_t)(row0 + ai * 128 + m * 16) * 1024 + col0;
        pg8::f32x4 xv[2][2];
#pragma unroll
        for (int bj = 0; bj < 2; ++bj)
#pragma unroll
          for (int n = 0; n < 2; ++n) xv[bj][n] = *(const pg8::f32x4*)(x + off + bj * 128 + n * 16);
#pragma unroll
        for (int bj = 0; bj < 2; ++bj)
#pragma unroll
          for (int n = 0; n < 2; ++n) *(pg8::f32x4*)(out + off + bj * 128 + n * 16) = acc[ai][bj][m][n] + xv[bj][n];
      }
  }
};
struct EpiStoreBf16 {
  static constexpr bool PERM = true, AFTER_DRAIN = false;
  unsigned short* O; int ldc;
  __device__ __forceinline__ void operator()(const pg8::f32x4 (&acc)[2][2][4][2], const pg8::Unit& u, int wr, int wc, int fr, int fq) const {
    const int row0 = u.pm * 256 + wr * 64 + fr, col0 = u.pn * 256 + wc * 32 + 8 * fq;
#pragma unroll
    for (int ai = 0; ai < 2; ++ai)
#pragma unroll
      for (int m = 0; m < 4; ++m) {
        unsigned short* rowp = O + (size_t)(row0 + ai * 128 + m * 16) * ldc + col0;
#pragma unroll
        for (int bj = 0; bj < 2; ++bj) {
          const pg8::f32x4 v0 = acc[ai][bj][m][0], v1 = acc[ai][bj][m][1];
          pg8::u32x4 w; w.x = pg8::cvt_pk_bf16(v0[0], v0[1]); w.y = pg8::cvt_pk_bf16(v0[2], v0[3]); w.z = pg8::cvt_pk_bf16(v1[0], v1[1]); w.w = pg8::cvt_pk_bf16(v1[2], v1[3]);
          *(pg8::u32x4*)(rowp + bj * 128) = w;
        }
      }
  }
};

__device__ __forceinline__ void gemm_tile(const bf16_t* __restrict__ A, int lda, const bf16_t* __restrict__ Bt, int ldb,
                                          int nk, f32x4 (&acc)[4][4], unsigned char* smem) {
  const int tid = threadIdx.x, lane = tid & 63, w = tid >> 6, wm = w >> 1, wn = w & 1, l15 = lane & 15, g = lane >> 4;
  unsigned char* sA = smem;
  unsigned char* sB = smem + 32768;
  const int lr = tid >> 3, lc = tid & 7;
  const bf16_t* ga = A + (size_t)lr * lda + lc * 8;
  const bf16_t* gb = Bt + (size_t)lr * ldb + lc * 8;
  uint4 ra0, ra1, ra2, ra3, rb0, rb1;
  ra0 = *(const uint4*)(ga);
  ra1 = *(const uint4*)(ga + (size_t)64 * lda);
  ra2 = *(const uint4*)(ga + (size_t)128 * lda);
  ra3 = *(const uint4*)(ga + (size_t)192 * lda);
  rb0 = *(const uint4*)(gb);
  rb1 = *(const uint4*)(gb + (size_t)64 * ldb);
  const int sw = (lc ^ (lr & 7)) << 4;
  for (int kt = 0; kt < nk; ++kt) {
    __syncthreads();
    *(uint4*)(sA + (lr) * 128 + sw) = ra0;
    *(uint4*)(sA + (lr + 64) * 128 + sw) = ra1;
    *(uint4*)(sA + (lr + 128) * 128 + sw) = ra2;
    *(uint4*)(sA + (lr + 192) * 128 + sw) = ra3;
    *(uint4*)(sB + (lr) * 128 + sw) = rb0;
    *(uint4*)(sB + (lr + 64) * 128 + sw) = rb1;
    __syncthreads();
    if (kt + 1 < nk) {
      const int ko = (kt + 1) * 64;
      ra0 = *(const uint4*)(ga + ko);
      ra1 = *(const uint4*)(ga + (size_t)64 * lda + ko);
      ra2 = *(const uint4*)(ga + (size_t)128 * lda + ko);
      ra3 = *(const uint4*)(ga + (size_t)192 * lda + ko);
      rb0 = *(const uint4*)(gb + ko);
      rb1 = *(const uint4*)(gb + (size_t)64 * ldb + ko);
    }
#pragma unroll
    for (int ks = 0; ks < 2; ++ks) {
      bf16x8 a[4], b[4];
#pragma unroll
      for (int m = 0; m < 4; ++m) { const int r = wm * 64 + m * 16 + l15; a[m] = *(const bf16x8*)(sA + r * 128 + (((ks * 4 + g) ^ (r & 7)) << 4)); }
#pragma unroll
      for (int n = 0; n < 4; ++n) { const int r = wn * 64 + n * 16 + l15; b[n] = *(const bf16x8*)(sB + r * 128 + (((ks * 4 + g) ^ (r & 7)) << 4)); }
#pragma unroll
      for (int m = 0; m < 4; ++m)
#pragma unroll
        for (int n = 0; n < 4; ++n) acc[m][n] = __builtin_amdgcn_mfma_f32_16x16x32_bf16(a[m], b[n], acc[m][n], 0, 0, 0);
    }
  }
}

__device__ __forceinline__ void zero_acc(f32x4 (&acc)[4][4]) {
#pragma unroll
  for (int m = 0; m < 4; ++m)
#pragma unroll
    for (int n = 0; n < 4; ++n) acc[m][n] = (f32x4){0.f, 0.f, 0.f, 0.f};
}

__device__ __forceinline__ void transpose_tile(const float* __restrict__ src, int srcN, bf16_t* __restrict__ dst, int K, int n0, int k0,
                                               bool winmap, float* tile) {
  const int tid = threadIdx.x;
  const int nc = tid & 63, kr = tid >> 6;
  int ncol = n0 + nc; bool valid = true;
  if (winmap) { if (ncol >= 3072) ncol -= 60; else if (ncol >= 3012) valid = false; }
#pragma unroll
  for (int i = 0; i < 8; ++i) {
    const int k = kr + 8 * i;
    tile[k * 65 + nc] = valid ? src[(size_t)(k0 + k) * srcN + ncol] : 0.f;
  }
  __syncthreads();
#pragma unroll
  for (int i = 0; i < 8; ++i) {
    const int nr = kr + 8 * i;
    dst[(size_t)(n0 + nr) * K + k0 + nc] = f2bf(tile[nc * 65 + nr]);
  }
  __syncthreads();
}

__device__ __forceinline__ void convert_f32_bf16(const float* __restrict__ src, bf16_t* __restrict__ dst, size_t n4) {
  for (size_t i = (size_t)blockIdx.x * NTHREADS + threadIdx.x; i < n4; i += (size_t)gridDim.x * NTHREADS) {
    const float4 v = ((const float4*)src)[i];
    uint2 o; o.x = pack2(v.x, v.y); o.y = pack2(v.z, v.w);
    ((uint2*)dst)[i] = o;
  }
}

template <bool SLICE_MAJOR, bool SIGNED>
__device__ __forceinline__ void quantize_rows_u8(const float* __restrict__ src, unsigned char* __restrict__ dst, float* __restrict__ scale, int row_lo, int row_hi) {
  const int lane = threadIdx.x & 63, w = threadIdx.x >> 6;
  for (int row = row_lo + w; row < row_hi; row += 8) {
    const float4* s4 = (const float4*)(src + (size_t)row * 1024) + lane * 4;
    float4 v[4];
    float am = 0.f;
#pragma unroll
    for (int i = 0; i < 4; ++i) { v[i] = s4[i]; am = fmaxf(am, fmaxf(fmaxf(fabsf(v[i].x), fabsf(v[i].y)), fmaxf(fabsf(v[i].z), fabsf(v[i].w)))); }
#pragma unroll
    for (int o = 32; o > 0; o >>= 1) am = fmaxf(am, __shfl_xor(am, o));
    const float inv = am > 0.f ? 127.f / am : 0.f;
    unsigned pk[4];
#pragma unroll
    for (int i = 0; i < 4; ++i) {
      const int ofs = SIGNED ? 0 : 128;
      const unsigned b0 = (unsigned)((int)rintf(v[i].x * inv) + ofs), b1 = (unsigned)((int)rintf(v[i].y * inv) + ofs);
      const unsigned b2 = (unsigned)((int)rintf(v[i].z * inv) + ofs), b3 = (unsigned)((int)rintf(v[i].w * inv) + ofs);
      pk[i] = (b0 & 255u) | ((b1 & 255u) << 8) | ((b2 & 255u) << 16) | ((b3 & 255u) << 24);
    }
    if (SLICE_MAJOR) *(uint4*)(dst + (size_t)(lane >> 3) * (16384 * 128) + (size_t)row * 128 + (lane & 7) * 16) = make_uint4(pk[0], pk[1], pk[2], pk[3]);
    else *(uint4*)(dst + (size_t)row * 1024 + lane * 16) = make_uint4(pk[0], pk[1], pk[2], pk[3]);
    if (lane == 0) scale[row] = am * (1.f / 127.f);
  }
}

#define WS_XQ (WS_PH + (size_t)TOK * 1024 * 2)
#define WS_XS (WS_XQ + (size_t)TOK * 1024)
__device__ __forceinline__ void rmsnorm_rows_q(const float* __restrict__ src, const float* __restrict__ g, bf16_t* __restrict__ dst,
                                               unsigned char* __restrict__ xq, float* __restrict__ xs) {
  const int lane = threadIdx.x & 63, w = threadIdx.x >> 6;
  for (int row = blockIdx.x * 8 + w; row < TOK; row += gridDim.x * 8) {
    const float4* s4 = (const float4*)(src + (size_t)row * DM) + lane * 4;
    const float4* g4 = (const float4*)g + lane * 4;
    float v[16]; float ss = 0.f;
#pragma unroll
    for (int i = 0; i < 4; ++i) { const float4 t = s4[i]; v[4 * i] = t.x; v[4 * i + 1] = t.y; v[4 * i + 2] = t.z; v[4 * i + 3] = t.w; ss += t.x * t.x + t.y * t.y + t.z * t.z + t.w * t.w; }
    ss = wave_sum(ss);
    const float rstd = rsqrtf(ss * (1.f / DM) + EPSV);
    float am = 0.f;
#pragma unroll
    for (int i = 0; i < 4; ++i) { const float4 gg = g4[i]; v[4 * i] *= rstd * gg.x; v[4 * i + 1] *= rstd * gg.y; v[4 * i + 2] *= rstd * gg.z; v[4 * i + 3] *= rstd * gg.w; }
#pragma unroll
    for (int i = 0; i < 16; ++i) am = fmaxf(am, fabsf(v[i]));
#pragma unroll
    for (int o = 32; o > 0; o >>= 1) am = fmaxf(am, __shfl_xor(am, o));
    const float inv = am > 0.f ? 127.f / am : 0.f;
    uint4 ob0, ob1;
    ob0.x = pack2(v[0], v[1]); ob0.y = pack2(v[2], v[3]); ob0.z = pack2(v[4], v[5]); ob0.w = pack2(v[6], v[7]);
    ob1.x = pack2(v[8], v[9]); ob1.y = pack2(v[10], v[11]); ob1.z = pack2(v[12], v[13]); ob1.w = pack2(v[14], v[15]);
    *(uint4*)(dst + (size_t)row * DM + lane * 16) = ob0;
    *(uint4*)(dst + (size_t)row * DM + lane * 16 + 8) = ob1;
    unsigned pk[4];
#pragma unroll
    for (int i = 0; i < 4; ++i) {
      const unsigned b0 = (unsigned)(int)rintf(v[4 * i] * inv) & 255u, b1 = (unsigned)(int)rintf(v[4 * i + 1] * inv) & 255u;
      const unsigned b2 = (unsigned)(int)rintf(v[4 * i + 2] * inv) & 255u, b3 = (unsigned)(int)rintf(v[4 * i + 3] * inv) & 255u;
      pk[i] = b0 | (b1 << 8) | (b2 << 16) | (b3 << 24);
    }
    *(uint4*)(xq + (size_t)row * 1024 + lane * 16) = make_uint4(pk[0], pk[1], pk[2], pk[3]);
    if (lane == 0) xs[row] = am * (1.f / 127.f);
  }
}

__device__ __forceinline__ void rmsnorm_rows(const float* __restrict__ src, const float* __restrict__ g, bf16_t* __restrict__ dst) {
  const int lane = threadIdx.x & 63, w = threadIdx.x >> 6;
  for (int row = blockIdx.x * 8 + w; row < TOK; row += gridDim.x * 8) {
    const float4* s4 = (const float4*)(src + (size_t)row * DM);
    float4 v[4]; float ss = 0.f;
#pragma unroll
    for (int i = 0; i < 4; ++i) { v[i] = s4[lane + 64 * i]; ss += v[i].x * v[i].x + v[i].y * v[i].y + v[i].z * v[i].z + v[i].w * v[i].w; }
    ss = wave_sum(ss);
    const float rstd = rsqrtf(ss * (1.f / DM) + EPSV);
#pragma unroll
    for (int i = 0; i < 4; ++i) {
      const float4 gg = ((const float4*)g)[lane + 64 * i];
      uint2 o; o.x = pack2(v[i].x * rstd * gg.x, v[i].y * rstd * gg.y); o.y = pack2(v[i].z * rstd * gg.z, v[i].w * rstd * gg.w);
      ((uint2*)(dst + (size_t)row * DM))[lane + 64 * i] = o;
    }
  }
}

__device__ __forceinline__ void phase_prep(const Params& p, unsigned char* smem) {
  unsigned char* ws = p.ws;
  float* tile = (float*)smem;
  const int n_win = 80 * 16, n_ua = 16 * 8, n_ub = 16 * 8, n_wo = 16 * 16, n_wq = 32 * 16;
  const int total = n_win + n_ua + n_ub + n_wo + n_wq;
  for (int it = blockIdx.x; it < total; it += gridDim.x) {
    int t = it;
    if (t < n_win) { transpose_tile(p.w_in, 5060, (bf16_t*)(ws + WS_WIN), 1024, (t >> 4) * 64, (t & 15) * 64, true, tile); continue; }
    t -= n_win;
    if (t < n_ua) { transpose_tile(p.w_up_a, 1024, (bf16_t*)(ws + WS_WUPA), 512, (t >> 3) * 64, (t & 7) * 64, false, tile); continue; }
    t -= n_ua;
    if (t < n_ub) { transpose_tile(p.w_up_b, 1024, (bf16_t*)(ws + WS_WUPB), 512, (t >> 3) * 64, (t & 7) * 64, false, tile); continue; }
    t -= n_ub;
    if (t < n_wo) { transpose_tile(p.w_out, 1024, (bf16_t*)(ws + WS_WOUT), 1024, (t >> 4) * 64, (t & 15) * 64, false, tile); continue; }
    t -= n_wo;
    transpose_tile(p.peer_wq, 2048, (bf16_t*)(ws + WS_WQ), 1024, (t >> 4) * 64, (t & 15) * 64, false, tile);
  }
  convert_f32_bf16(p.peer_keys, (bf16_t*)(ws + WS_KEYS), (size_t)2 * 8 * 128 * 128 / 4);
  for (int i = blockIdx.x * NTHREADS + threadIdx.x; i < TOK; i += gridDim.x * NTHREADS) ((float*)(ws + WS_SSQ))[i] = 0.f;
  if (threadIdx.x == 0) ((int*)(ws + WS_XCC))[blockIdx.x] = (int)(__builtin_amdgcn_s_getreg((3 << 11) | 20) & 0xFu);
  if (blockIdx.x == 0 && threadIdx.x < 8) ((unsigned*)(ws + WS_QCTR))[16 * threadIdx.x] = 0u;
  if (blockIdx.x == 0) {
    const int i = threadIdx.x;
    const float a0 = p.hg_lb[i], a1 = p.hg_lb[512 + i];
    ((float*)(ws + WS_LB))[i] = 1.f / (1.f + expf(a1 - a0));
  }
  rmsnorm_rows(p.x, p.norm_mix, (bf16_t*)(ws + WS_XN));
}

__device__ __forceinline__ void phase_proj(const Params& p, unsigned char* smem) {
  unsigned char* ws = p.ws;
  const bf16_t* xn = (const bf16_t*)(ws + WS_XN);
  const bf16_t* wt = (const bf16_t*)(ws + WS_WIN);
  bf16_t* pH = (bf16_t*)(ws + WS_PH);
  bf16_t* pA = (bf16_t*)(ws + WS_PA);
  bf16_t* pG = (bf16_t*)(ws + WS_PG);
  const int tid = threadIdx.x, lane = tid & 63, w = tid >> 6, wm = w >> 1, wn = w & 1, l15 = lane & 15, g = lane >> 4;
  for (int tile = blockIdx.x; tile < 128 * 40; tile += gridDim.x) {
    const int tn = tile % 40, tm = tile / 40;
    f32x4 acc[4][4]; zero_acc(acc);
    gemm_tile(xn + (size_t)tm * 256 * 1024, 1024, wt + (size_t)tn * 128 * 1024, 1024, 16, acc, smem);
    const int rbase = tm * 256 + wm * 64 + 4 * g;
    const int cbase = tn * 128 + wn * 64 + l15;
    if (tn < 16) {
#pragma unroll
      for (int m = 0; m < 4; ++m)
#pragma unroll
        for (int n = 0; n < 4; ++n)
#pragma unroll
          for (int j = 0; j < 4; ++j) pH[(size_t)(rbase + m * 16 + j) * 2048 + cbase + n * 16] = f2bf(acc[m][n][j]);
    } else if (tn < 24) {
      if (tn == 23 && wn == 0) {
        float gam[4], bet[4];
#pragma unroll
        for (int n = 0; n < 4; ++n) { gam[n] = p.ikg[n * 16 + l15]; bet[n] = p.ikb[n * 16 + l15]; }
#pragma unroll
        for (int m = 0; m < 4; ++m)
#pragma unroll
          for (int j = 0; j < 4; ++j) {
            float s = acc[m][0][j] + acc[m][1][j] + acc[m][2][j] + acc[m][3][j];
            s += __shfl_xor(s, 1); s += __shfl_xor(s, 2); s += __shfl_xor(s, 4); s += __shfl_xor(s, 8);
            const float mu = s * (1.f / 64.f);
            float q = 0.f;
#pragma unroll
            for (int n = 0; n < 4; ++n) { const float d = acc[m][n][j] - mu; q += d * d; }
            q += __shfl_xor(q, 1); q += __shfl_xor(q, 2); q += __shfl_xor(q, 4); q += __shfl_xor(q, 8);
            const float rstd = rsqrtf(q * (1.f / 64.f) + EPSV);
#pragma unroll
            for (int n = 0; n < 4; ++n)
              pA[(size_t)(rbase + m * 16 + j) * 1024 + (cbase - 2048) + n * 16] = f2bf((acc[m][n][j] - mu) * rstd * gam[n] + bet[n]);
          }
      } else {
#pragma unroll
        for (int m = 0; m < 4; ++m)
#pragma unroll
          for (int n = 0; n < 4; ++n)
#pragma unroll
            for (int j = 0; j < 4; ++j) pA[(size_t)(rbase + m * 16 + j) * 1024 + (cbase - 2048) + n * 16] = f2bf(acc[m][n][j]);
      }
    } else {
#pragma unroll
      for (int m = 0; m < 4; ++m)
#pragma unroll
        for (int n = 0; n < 4; ++n)
#pragma unroll
          for (int j = 0; j < 4; ++j) pG[(size_t)(rbase + m * 16 + j) * 2048 + (cbase - 3072) + n * 16] = f2bf(sigmoidf_(acc[m][n][j]));
    }
  }
}

__device__ __forceinline__ void hgrn_item(const Params& p, unsigned char* smem, int bh) {
  unsigned char* ws = p.ws;
  const bf16_t* pH = (const bf16_t*)(ws + WS_PH);
  const float* lbp = (const float*)(ws + WS_LB);
  bf16_t* ya = (bf16_t*)(ws + WS_XN);
  bf16_t* Qt = (bf16_t*)smem;
  bf16_t* Kt = Qt + 64 * 136;
  bf16_t* KtT = Kt + 64 * 136;
  bf16_t* VT = KtT + 128 * 72;
  bf16_t* Am = VT + 128 * 72;
  bf16_t* ST = Am + 64 * 72;
  float* qtot = (float*)(ST + 128 * 136);
  float* eref = qtot + 512;
  float* elast = eref + 128;
  float* elr = elast + 128;
  float* red = elr + 128;
  const int tid = threadIdx.x, lane = tid & 63, w = tid >> 6, l15 = lane & 15, g = lane >> 4;
  const int b = bh >> 2, h = bh & 3;
  const int d = tid & 127, tq = tid >> 7;
  const float lbv = lbp[h * 128 + d];
  f32x4 S[8];
#pragma unroll
  for (int i = 0; i < 8; ++i) S[i] = (f32x4){0.f, 0.f, 0.f, 0.f};
  const float gnv = p.hg_norm[h * 128 + 16 * w + l15];

  for (int chunk = 0; chunk < 64; ++chunk) {
    const size_t row0 = (size_t)b * SEQL + chunk * 64;
    {
      const bf16_t* base = pH + (row0 + tq * 16) * 2048 + h * 128 + d;
      float lf[16], kk[16], qs[16];
      unsigned vv[8];
      float run = 0.f;
#pragma unroll
      for (int i = 0; i < 16; ++i) {
        const float fr = bf2f(base[(size_t)i * 2048 + 512]);
        const float qr = bf2f(base[(size_t)i * 2048]);
        const float sg = sigmoidf_(fr);
        const float fg = lbv + (1.f - lbv) * sg;
        run += __logf(fg);
        lf[i] = run; kk[i] = 1.f - fg; qs[i] = siluf_(qr);
      }
#pragma unroll
      for (int i = 0; i < 8; ++i) {
        const unsigned lo = base[(size_t)(2 * i) * 2048 + 1024], hi = base[(size_t)(2 * i + 1) * 2048 + 1024];
        vv[i] = lo | (hi << 16);
      }
      qtot[tq * 128 + d] = run;
      __syncthreads();
      const float q0 = qtot[d], q1 = qtot[128 + d], q2 = qtot[256 + d], q3 = qtot[384 + d];
      const float pre = (tq > 0 ? q0 : 0.f) + (tq > 1 ? q1 : 0.f) + (tq > 2 ? q2 : 0.f);
      const float bref = q0 + q1;
      const float blast = bref + q2 + q3;
      unsigned kp[8];
#pragma unroll
      for (int i = 0; i < 16; ++i) {
        const float bt = pre + lf[i];
        const float qt = qs[i] * __expf(bt - bref);
        const float kt = kk[i] * __expf(bref - bt);
        const int t = tq * 16 + i;
        Qt[t * 136 + d] = f2bf(qt);
        const bf16_t kb = f2bf(kt);
        Kt[t * 136 + d] = kb;
        if (i & 1) kp[i >> 1] |= ((unsigned)kb) << 16; else kp[i >> 1] = kb;
      }
      *(uint4*)(KtT + d * 72 + tq * 16) = make_uint4(kp[0], kp[1], kp[2], kp[3]);
      *(uint4*)(KtT + d * 72 + tq * 16 + 8) = make_uint4(kp[4], kp[5], kp[6], kp[7]);
      *(uint4*)(VT + d * 72 + tq * 16) = make_uint4(vv[0], vv[1], vv[2], vv[3]);
      *(uint4*)(VT + d * 72 + tq * 16 + 8) = make_uint4(vv[4], vv[5], vv[6], vv[7]);
      if (tq == 0) { eref[d] = __expf(bref); elast[d] = __expf(blast); elr[d] = __expf(blast - bref); }
    }
    __syncthreads();
    bf16_t ogr[16];
#pragma unroll
    for (int tm = 0; tm < 4; ++tm)
#pragma unroll
      for (int j = 0; j < 4; ++j) ogr[tm * 4 + j] = pH[(row0 + tm * 16 + 4 * g + j) * 2048 + 1536 + h * 128 + 16 * w + l15];
    {
      const int e = 16 * w + l15;
#pragma unroll
      for (int dm = 0; dm < 8; ++dm) {
        const int d0 = 16 * dm + 4 * g;
        uint2 o;
        o.x = pack2(S[dm][0] * eref[d0], S[dm][1] * eref[d0 + 1]);
        o.y = pack2(S[dm][2] * eref[d0 + 2], S[dm][3] * eref[d0 + 3]);
        *(uint2*)(ST + e * 136 + d0) = o;
      }
#pragma unroll
      for (int tt = 0; tt < 2; ++tt) {
        const int tl = 2 * w + tt, sm = tl >> 2, tn = tl & 3;
        f32x4 acc = (f32x4){0.f, 0.f, 0.f, 0.f};
        if (tn >= sm) {
#pragma unroll
          for (int k0 = 0; k0 < 128; k0 += 32) {
            const bf16x8 a = *(const bf16x8*)(Kt + (sm * 16 + l15) * 136 + k0 + 8 * g);
            const bf16x8 bq = *(const bf16x8*)(Qt + (tn * 16 + l15) * 136 + k0 + 8 * g);
            acc = __builtin_amdgcn_mfma_f32_16x16x32_bf16(a, bq, acc, 0, 0, 0);
          }
        }
        const int t = tn * 16 + l15, s0 = sm * 16 + 4 * g;
        uint2 o;
        o.x = pack2(s0 + 0 <= t ? acc[0] : 0.f, s0 + 1 <= t ? acc[1] : 0.f);
        o.y = pack2(s0 + 2 <= t ? acc[2] : 0.f, s0 + 3 <= t ? acc[3] : 0.f);
        *(uint2*)(Am + t * 72 + s0) = o;
      }
    }
    __syncthreads();
    f32x4 o[4];
    {
#pragma unroll
      for (int tm = 0; tm < 4; ++tm) {
        f32x4 acc = (f32x4){0.f, 0.f, 0.f, 0.f};
#pragma unroll
        for (int k0 = 0; k0 < 128; k0 += 32) {
          const bf16x8 a = *(const bf16x8*)(Qt + (tm * 16 + l15) * 136 + k0 + 8 * g);
          const bf16x8 bb = *(const bf16x8*)(ST + (16 * w + l15) * 136 + k0 + 8 * g);
          acc = __builtin_amdgcn_mfma_f32_16x16x32_bf16(a, bb, acc, 0, 0, 0);
        }
#pragma unroll
        for (int k0 = 0; k0 < 64; k0 += 32) {
          const bf16x8 a = *(const bf16x8*)(Am + (tm * 16 + l15) * 72 + k0 + 8 * g);
          const bf16x8 bb = *(const bf16x8*)(VT + (16 * w + l15) * 72 + k0 + 8 * g);
          acc = __builtin_amdgcn_mfma_f32_16x16x32_bf16(a, bb, acc, 0, 0, 0);
        }
        o[tm] = acc;
#pragma unroll
        for (int j = 0; j < 4; ++j) {
          float ss = acc[j] * acc[j];
          ss += __shfl_xor(ss, 1); ss += __shfl_xor(ss, 2); ss += __shfl_xor(ss, 4); ss += __shfl_xor(ss, 8);
          if (l15 == 0) red[w * 64 + tm * 16 + 4 * g + j] = ss;
        }
      }
#pragma unroll
      for (int dm = 0; dm < 8; ++dm) {
        f32x4 acc = (f32x4){0.f, 0.f, 0.f, 0.f};
#pragma unroll
        for (int k0 = 0; k0 < 64; k0 += 32) {
          const bf16x8 a = *(const bf16x8*)(KtT + (dm * 16 + l15) * 72 + k0 + 8 * g);
          const bf16x8 bb = *(const bf16x8*)(VT + (16 * w + l15) * 72 + k0 + 8 * g);
          acc = __builtin_amdgcn_mfma_f32_16x16x32_bf16(a, bb, acc, 0, 0, 0);
        }
#pragma unroll
        for (int j = 0; j < 4; ++j) { const int dd = 16 * dm + 4 * g + j; S[dm][j] = elast[dd] * S[dm][j] + elr[dd] * acc[j]; }
      }
    }
    __syncthreads();
    {
      const int e = 16 * w + l15;
#pragma unroll
      for (int tm = 0; tm < 4; ++tm)
#pragma unroll
        for (int j = 0; j < 4; ++j) {
          const int t = tm * 16 + 4 * g + j;
          float tot = 0.f;
#pragma unroll
          for (int ww = 0; ww < 8; ++ww) tot += red[ww * 64 + t];
          const float rstd = rsqrtf(tot * (1.f / 128.f) + EPSV);
          const float og = bf2f(ogr[tm * 4 + j]);
          ya[(row0 + t) * 512 + h * 128 + e] = f2bf(o[tm][j] * rstd * gnv * siluf_(og));
        }
    }
  }
}


__device__ __forceinline__ void hgrn_h1_all(const Params& p, unsigned char* smem) {
  unsigned char* ws = p.ws;
  bf16_t* pH = (bf16_t*)(ws + WS_PH);
  const float* lbp = (const float*)(ws + WS_LB);
  bf16_t* Qt = (bf16_t*)smem;
  bf16_t* Kt = Qt + 64 * 136;
  bf16_t* KtT = Kt + 64 * 136;
  bf16_t* VT = KtT + 128 * 72;
  bf16_t* Am = VT + 128 * 72;
  float* qtot = (float*)(Am + 64 * 72);
  const int tid = threadIdx.x, lane = tid & 63, w = tid >> 6, l15 = lane & 15, g = lane >> 4;
  const int d = tid & 127, tq = tid >> 7;
  const int G = gridDim.x;
  if ((int)blockIdx.x >= 2048) return;
  bf16_t fr_[16], qr_[16]; unsigned short vr_[16];
#define H1_LOAD(IT) do { \
    const int bh_ = (IT) >> 6, ch_ = (IT) & 63; \
    const bf16_t* base_ = pH + ((size_t)(bh_ >> 2) * SEQL + ch_ * 64 + tq * 16) * 2048 + (bh_ & 3) * 128 + d; \
    _Pragma("unroll") for (int i = 0; i < 16; ++i) { fr_[i] = base_[(size_t)i * 2048 + 512]; qr_[i] = base_[(size_t)i * 2048]; vr_[i] = base_[(size_t)i * 2048 + 1024]; } \
  } while (0)
  H1_LOAD((int)blockIdx.x);
  for (int item = blockIdx.x; item < 2048; item += G) {
    const int bh = item >> 6, chunk = item & 63;
    const int b = bh >> 2, h = bh & 3;
    const float lbv = lbp[h * 128 + d];
    const size_t row0 = (size_t)b * SEQL + chunk * 64;
    float* dec = (float*)(ws + WS_DEC) + (size_t)item * 384;
    uint4* UU = (uint4*)p.out + (size_t)item * 2048 + tid;
    float4* OI = (float4*)((unsigned char*)p.out + ((size_t)64 << 20)) + (size_t)item * 2048 + tid;
    {
      unsigned vv[8];
#pragma unroll
      for (int i = 0; i < 8; ++i) vv[i] = (unsigned)vr_[2 * i] | ((unsigned)vr_[2 * i + 1] << 16);
      float lf[16], kk[16], qs[16];
      float run = 0.f;
#pragma unroll
      for (int i = 0; i < 16; ++i) {
        const float sg = sigmoidf_(bf2f(fr_[i]));
        const float fg = lbv + (1.f - lbv) * sg;
        run += __logf(fg);
        lf[i] = run; kk[i] = 1.f - fg; qs[i] = siluf_(bf2f(qr_[i]));
      }
      qtot[tq * 128 + d] = run;
      __syncthreads();
      { const int nit = (item + G < 2048) ? item + G : item; H1_LOAD(nit); }
      const float q0 = qtot[d], q1 = qtot[128 + d], q2 = qtot[256 + d], q3 = qtot[384 + d];
      const float pre = (tq > 0 ? q0 : 0.f) + (tq > 1 ? q1 : 0.f) + (tq > 2 ? q2 : 0.f);
      const float bref = q0 + q1;
      const float blast = bref + q2 + q3;
      unsigned kp[8];
#pragma unroll
      for (int i = 0; i < 16; ++i) {
        const float bt = pre + lf[i];
        const float qt = qs[i] * __expf(bt - bref);
        const float kt = kk[i] * __expf(bref - bt);
        const int t = tq * 16 + i;
        Qt[t * 136 + d] = f2bf(qt);
        const bf16_t kb = f2bf(kt);
        Kt[t * 136 + d] = kb;
        if (i & 1) kp[i >> 1] |= ((unsigned)kb) << 16; else kp[i >> 1] = kb;
      }
      *(uint4*)(KtT + d * 72 + tq * 16) = make_uint4(kp[0], kp[1], kp[2], kp[3]);
      *(uint4*)(KtT + d * 72 + tq * 16 + 8) = make_uint4(kp[4], kp[5], kp[6], kp[7]);
      *(uint4*)(VT + d * 72 + tq * 16) = make_uint4(vv[0], vv[1], vv[2], vv[3]);
      *(uint4*)(VT + d * 72 + tq * 16 + 8) = make_uint4(vv[4], vv[5], vv[6], vv[7]);
      if (tq == 0) { dec[d] = __expf(bref); dec[128 + d] = __expf(blast); dec[256 + d] = __expf(blast - bref); }
    }
    __syncthreads();
    {
  #pragma unroll
      for (int i = 0; i < 2; ++i) {
        const int idx = tid + 512 * i, r = idx >> 4, c = idx & 15;
        *(uint4*)(pH + (row0 + r) * 2048 + h * 128 + c * 8) = *(const uint4*)(Qt + r * 136 + c * 8);
      }
  #pragma unroll
      for (int tt = 0; tt < 2; ++tt) {
        const int tl = 2 * w + tt, sm = tl >> 2, tn = tl & 3;
        f32x4 acc = (f32x4){0.f, 0.f, 0.f, 0.f};
        if (tn >= sm) {
  #pragma unroll
          for (int k0 = 0; k0 < 128; k0 += 32) {
            const bf16x8 a = *(const bf16x8*)(Kt + (sm * 16 + l15) * 136 + k0 + 8 * g);
            const bf16x8 bq = *(const bf16x8*)(Qt + (tn * 16 + l15) * 136 + k0 + 8 * g);
            acc = __builtin_amdgcn_mfma_f32_16x16x32_bf16(a, bq, acc, 0, 0, 0);
          }
        }
        const int t = tn * 16 + l15, s0 = sm * 16 + 4 * g;
        uint2 o;
        o.x = pack2(s0 + 0 <= t ? acc[0] : 0.f, s0 + 1 <= t ? acc[1] : 0.f);
        o.y = pack2(s0 + 2 <= t ? acc[2] : 0.f, s0 + 3 <= t ? acc[3] : 0.f);
        *(uint2*)(Am + t * 72 + s0) = o;
      }
    }
    __syncthreads();
    {
  #pragma unroll
      for (int tm = 0; tm < 4; ++tm) {
        f32x4 acc = (f32x4){0.f, 0.f, 0.f, 0.f};
  #pragma unroll
        for (int k0 = 0; k0 < 64; k0 += 32) {
          const bf16x8 a = *(const bf16x8*)(Am + (tm * 16 + l15) * 72 + k0 + 8 * g);
          const bf16x8 bb = *(const bf16x8*)(VT + (16 * w + l15) * 72 + k0 + 8 * g);
          acc = __builtin_amdgcn_mfma_f32_16x16x32_bf16(a, bb, acc, 0, 0, 0);
        }
        OI[tm * 512] = make_float4(acc[0], acc[1], acc[2], acc[3]);
      }
  #pragma unroll
      for (int dp = 0; dp < 4; ++dp) {
        unsigned pk[4];
  #pragma unroll
        for (int hh = 0; hh < 2; ++hh) {
          const int dm = dp * 2 + hh;
          f32x4 acc = (f32x4){0.f, 0.f, 0.f, 0.f};
  #pragma unroll
          for (int k0 = 0; k0 < 64; k0 += 32) {
            const bf16x8 a = *(const bf16x8*)(KtT + (dm * 16 + l15) * 72 + k0 + 8 * g);
            const bf16x8 bb = *(const bf16x8*)(VT + (16 * w + l15) * 72 + k0 + 8 * g);
            acc = __builtin_amdgcn_mfma_f32_16x16x32_bf16(a, bb, acc, 0, 0, 0);
          }
          pk[hh * 2] = pack2(acc[0], acc[1]); pk[hh * 2 + 1] = pack2(acc[2], acc[3]);
        }
        UU[dp * 512] = make_uint4(pk[0], pk[1], pk[2], pk[3]);
      }
    }
    __syncthreads();
  }
#undef H1_LOAD
}

__device__ __forceinline__ void hgrn_h2(const Params& p, unsigned char* smem, int bh) {
  unsigned char* ws = p.ws;
  const bf16_t* pH = (const bf16_t*)(ws + WS_PH);
  bf16_t* ya = (bf16_t*)(ws + WS_XN);
  bf16_t* Qt = (bf16_t*)smem;
  bf16_t* ST = Qt + 64 * 136;
  float* decl = (float*)(ST + 128 * 136);
  float* red = decl + 384;
  const int tid = threadIdx.x, lane = tid & 63, w = tid >> 6, l15 = lane & 15, g = lane >> 4;
  const int b = bh >> 2, h = bh & 3;
  f32x4 S[8];
#pragma unroll
  for (int i = 0; i < 8; ++i) S[i] = (f32x4){0.f, 0.f, 0.f, 0.f};
  const float gnv = p.hg_norm[h * 128 + 16 * w + l15];
  const int e = 16 * w + l15;
  uint4 uu0, uu1, uu2, uu3; float4 oi0, oi1, oi2, oi3; uint4 qraw0, qraw1; bf16_t ogr[16]; float dcv = 0.f;
#define H2_LOAD(CH) do { \
    const int item_ = bh * 64 + (CH); \
    const size_t row0_ = (size_t)b * SEQL + (size_t)(CH) * 64; \
    const uint4* UUp = (const uint4*)p.out + (size_t)item_ * 2048 + tid; \
    const float4* OIp = (const float4*)((const unsigned char*)p.out + ((size_t)64 << 20)) + (size_t)item_ * 2048 + tid; \
    uu0 = UUp[0]; uu1 = UUp[512]; uu2 = UUp[1024]; uu3 = UUp[1536]; oi0 = OIp[0]; oi1 = OIp[512]; oi2 = OIp[1024]; oi3 = OIp[1536]; \
    qraw0 = *(const uint4*)(pH + (row0_ + (tid >> 4)) * 2048 + h * 128 + (tid & 15) * 8); \
    qraw1 = *(const uint4*)(pH + (row0_ + 32 + (tid >> 4)) * 2048 + h * 128 + (tid & 15) * 8); \
    _Pragma("unroll") for (int tm = 0; tm < 4; ++tm) _Pragma("unroll") for (int j = 0; j < 4; ++j) \
      ogr[tm * 4 + j] = pH[(row0_ + tm * 16 + 4 * g + j) * 2048 + 1536 + h * 128 + e]; \
    if (tid < 384) dcv = ((const float*)(ws + WS_DEC))[(size_t)item_ * 384 + tid]; \
  } while (0)
  H2_LOAD(0);
  for (int chunk = 0; chunk < 64; ++chunk) {
    const size_t row0 = (size_t)b * SEQL + chunk * 64;
    const uint4 cu[4] = {uu0, uu1, uu2, uu3}; const float4 co[4] = {oi0, oi1, oi2, oi3}; bf16_t cog[16];
#pragma unroll
    for (int i = 0; i < 16; ++i) cog[i] = ogr[i];
    *(uint4*)(Qt + (tid >> 4) * 136 + (tid & 15) * 8) = qraw0;
    *(uint4*)(Qt + (32 + (tid >> 4)) * 136 + (tid & 15) * 8) = qraw1;
    if (tid < 384) decl[tid] = dcv;
    __syncthreads();
    if (chunk + 1 < 64) H2_LOAD(chunk + 1);
#pragma unroll
    for (int dm = 0; dm < 8; ++dm) {
      const int d0 = 16 * dm + 4 * g;
      uint2 o;
      o.x = pack2(S[dm][0] * decl[d0], S[dm][1] * decl[d0 + 1]);
      o.y = pack2(S[dm][2] * decl[d0 + 2], S[dm][3] * decl[d0 + 3]);
      *(uint2*)(ST + e * 136 + d0) = o;
    }
    __syncthreads();
    f32x4 o[4];
#pragma unroll
    for (int tm = 0; tm < 4; ++tm) {
      f32x4 acc = (f32x4){co[tm].x, co[tm].y, co[tm].z, co[tm].w};
#pragma unroll
      for (int k0 = 0; k0 < 128; k0 += 32) {
        const bf16x8 a = *(const bf16x8*)(Qt + (tm * 16 + l15) * 136 + k0 + 8 * g);
        const bf16x8 bb = *(const bf16x8*)(ST + (16 * w + l15) * 136 + k0 + 8 * g);
        acc = __builtin_amdgcn_mfma_f32_16x16x32_bf16(a, bb, acc, 0, 0, 0);
      }
      o[tm] = acc;
#pragma unroll
      for (int j = 0; j < 4; ++j) {
        float ss = acc[j] * acc[j];
        ss += __shfl_xor(ss, 1); ss += __shfl_xor(ss, 2); ss += __shfl_xor(ss, 4); ss += __shfl_xor(ss, 8);
        if (l15 == 0) red[w * 64 + tm * 16 + 4 * g + j] = ss;
      }
    }
#pragma unroll
    for (int dm = 0; dm < 8; ++dm) {
      const unsigned u01 = (dm & 1) ? cu[dm >> 1].z : cu[dm >> 1].x, u23 = (dm & 1) ? cu[dm >> 1].w : cu[dm >> 1].y;
      const float uv[4] = {__uint_as_float(u01 << 16), __uint_as_float(u01 & 0xffff0000u), __uint_as_float(u23 << 16), __uint_as_float(u23 & 0xffff0000u)};
#pragma unroll
      for (int j = 0; j < 4; ++j) { const int dd = 16 * dm + 4 * g + j; S[dm][j] = decl[128 + dd] * S[dm][j] + decl[256 + dd] * uv[j]; }
    }
    __syncthreads();
#pragma unroll
    for (int tm = 0; tm < 4; ++tm)
#pragma unroll
      for (int j = 0; j < 4; ++j) {
        const int t = tm * 16 + 4 * g + j;
        float tot = 0.f;
#pragma unroll
        for (int ww = 0; ww < 8; ++ww) tot += red[ww * 64 + t];
        const float rstd = rsqrtf(tot * (1.f / 128.f) + EPSV);
        ya[(row0 + t) * 512 + h * 128 + e] = f2bf(o[tm][j] * rstd * gnv * siluf_(bf2f(cog[tm * 4 + j])));
      }
  }
#undef H2_LOAD
}

__device__ __forceinline__ int team_index(const Params& p, unsigned char* smem) {
  int* sh = (int*)(smem + 8192);
  const int G = gridDim.x, tid = threadIdx.x;
  const int* tab = (const int*)(p.ws + WS_XCC);
  if (tid < 32) sh[tid] = 0;
  __syncthreads();
  const int mine = tab[blockIdx.x] & 15;
  for (int b = tid; b < G; b += NTHREADS) {
    const int x = tab[b] & 15;
    atomicAdd(&sh[x], 1);
    if (x == mine && b < (int)blockIdx.x) atomicAdd(&sh[16], 1);
  }
  __syncthreads();
  if (tid == 0) {
    int pre = 0;
    for (int j = 0; j < mine; ++j) pre += sh[j];
    sh[17] = pre + sh[16];
  }
  __syncthreads();
  const int r = sh[17];
  __syncthreads();
  return r;
}

#define SCW 4100
#ifndef DSA_REP
#define DSA_REP 0
#endif
#define DSA_BKT_OFF (8 * SCW * 4 + 8 * 256 * 4 + 8 * 256 * 2 + 8 * 512 * 2)
__device__ __forceinline__ void cvt8(const uint4& v, float* f) {
  f[0] = __uint_as_float(v.x << 16); f[1] = __uint_as_float(v.x & 0xffff0000u);
  f[2] = __uint_as_float(v.y << 16); f[3] = __uint_as_float(v.y & 0xffff0000u);
  f[4] = __uint_as_float(v.z << 16); f[5] = __uint_as_float(v.z & 0xffff0000u);
  f[6] = __uint_as_float(v.w << 16); f[7] = __uint_as_float(v.w & 0xffff0000u);
}
__device__ __forceinline__ unsigned sortable_key(float v) {
  unsigned bits = __float_as_uint(v);
  if (bits == 0x80000000u) bits = 0u;
  return (bits & 0x80000000u) ? ~bits : (bits | 0x80000000u);
}

__device__ __forceinline__ void dsa_item(const Params& p, unsigned char* smem, int item) {
  unsigned char* ws = p.ws;
  const bf16_t* pA = (const bf16_t*)(ws + WS_PA);
  bf16_t* yb = (bf16_t*)(ws + WS_XN) + (size_t)TOK * 512;
  unsigned* sc = (unsigned*)smem;
  unsigned* hist = sc + 8 * SCW;
  unsigned short* sel = (unsigned short*)(hist + 8 * 256);
  unsigned short* cand = sel + 8 * 256;
  unsigned char* bkt = (unsigned char*)(cand + 8 * 512);
  unsigned* rmm = (unsigned*)(bkt + 128 + 1024);
  const int tid = threadIdx.x, lane = tid & 63, w = tid >> 6, l15 = lane & 15, g = lane >> 4;
  const int b = item >> 9;
  const int tb = item & 511;
  const int t0 = tb * 8;
  const size_t tokbase = (size_t)b * SEQL;

  for (int rep_s = 0; rep_s < (DSA_REP == 1 ? 2 : 1); ++rep_s) {
    bf16x8 af[2][2];
    float wq[2][4];
#pragma unroll
    for (int mt = 0; mt < 2; ++mt) {
      const int qrow = t0 + mt * 4 + (l15 >> 2), head = l15 & 3;
#pragma unroll
      for (int ks = 0; ks < 2; ++ks)
        af[mt][ks] = *(const bf16x8*)(pA + (tokbase + qrow) * 1024 + 640 + head * 64 + ks * 32 + 8 * g);
      const uint2 wr = *(const uint2*)(pA + (tokbase + t0 + mt * 4 + g) * 1024 + 960);
      wq[mt][0] = 0.5f * bf2f((bf16_t)(wr.x & 0xffff)); wq[mt][1] = 0.5f * bf2f((bf16_t)(wr.x >> 16));
      wq[mt][2] = 0.5f * bf2f((bf16_t)(wr.y & 0xffff)); wq[mt][3] = 0.5f * bf2f((bf16_t)(wr.y >> 16));
    }
    const int nkt = (t0 + 8 + 15) >> 4;
    unsigned kmin[2] = {0xFFFFFFFFu, 0xFFFFFFFFu}, kmax[2] = {0u, 0u};
    for (int kt0 = w; kt0 < nkt; kt0 += 64) {
      bf16x8 b0[8], b1[8];
#pragma unroll
      for (int u = 0; u < 8; ++u) {
        const int kt = kt0 + 8 * u;
        const int s = (kt < nkt ? kt : 0) * 16 + l15;
        const bf16_t* kr = pA + (tokbase + s) * 1024 + 896 + 8 * g;
        b0[u] = *(const bf16x8*)kr;
        b1[u] = *(const bf16x8*)(kr + 32);
      }
      __builtin_amdgcn_sched_barrier(0);
      f32x4 sacc[8][2];
#pragma unroll
      for (int u = 0; u < 8; ++u)
#pragma unroll
        for (int mt = 0; mt < 2; ++mt) {
          f32x4 acc = (f32x4){0.f, 0.f, 0.f, 0.f};
          acc = __builtin_amdgcn_mfma_f32_16x16x32_bf16(af[mt][0], b0[u], acc, 0, 0, 0);
          sacc[u][mt] = __builtin_amdgcn_mfma_f32_16x16x32_bf16(af[mt][1], b1[u], acc, 0, 0, 0);
        }
#pragma unroll
      for (int u = 0; u < 8; ++u) {
        const int kt = kt0 + 8 * u;
        if (kt < nkt) {
          const int s = kt * 16 + l15;
#pragma unroll
          for (int mt = 0; mt < 2; ++mt) {
            float v = 0.f;
#pragma unroll
            for (int j = 0; j < 4; ++j) v += wq[mt][j] * fmaxf(sacc[u][mt][j] * 0.125f, 0.f);
            const int t = t0 + mt * 4 + g;
            unsigned vb = __float_as_uint(v); if (vb == 0x80000000u) vb = 0u;
            sc[(mt * 4 + g) * SCW + s] = vb;
            if (s <= t) {
              const unsigned key = (vb & 0x80000000u) ? ~vb : (vb | 0x80000000u);
              kmin[mt] = key < kmin[mt] ? key : kmin[mt];
              kmax[mt] = key > kmax[mt] ? key : kmax[mt];
            }
          }
        }
      }
    }
#pragma unroll
    for (int mt = 0; mt < 2; ++mt) {
      unsigned a = kmin[mt], bmx = kmax[mt];
#define DPP_MINMAX(CTRL) do { const unsigned a2 = (unsigned)__builtin_amdgcn_update_dpp((int)a, (int)a, CTRL, 0xf, 0xf, false); \
                               const unsigned b2 = (unsigned)__builtin_amdgcn_update_dpp((int)bmx, (int)bmx, CTRL, 0xf, 0xf, false); \
                               a = a2 < a ? a2 : a; bmx = b2 > bmx ? b2 : bmx; } while (0)
      DPP_MINMAX(0xB1); DPP_MINMAX(0x4E); DPP_MINMAX(0x141); DPP_MINMAX(0x140);
#undef DPP_MINMAX
      if (l15 == 0) { atomicMin(&rmm[mt * 4 + g], a); atomicMax(&rmm[8 + mt * 4 + g], bmx); }
    }
  }
  __syncthreads();
  const int t = t0 + w;
  const int n = t + 1;
  unsigned* row = sc + w * SCW;
  const float* rowf = (const float*)row;
  unsigned short* mysel = sel + w * 256;
  unsigned short* mycand = cand + w * 512;
  unsigned* myh = hist + w * 256;
  int cnt;
  const unsigned long long lt_mask = (1ull << lane) - 1ull;
  for (int rep_t = 0; rep_t < (DSA_REP == 2 ? 2 : 1); ++rep_t)
  if (n <= 256) {
    for (int i = lane; i < n; i += 64) mysel[i] = (unsigned short)i;
    cnt = n;
  } else {
    cnt = 256;
    float mn, mx;
    {
      const unsigned kmn = rmm[w], kmx = rmm[8 + w];
      mn = __uint_as_float((kmn & 0x80000000u) ? (kmn ^ 0x80000000u) : ~kmn);
      mx = __uint_as_float((kmx & 0x80000000u) ? (kmx ^ 0x80000000u) : ~kmx);
    }
    const float scale = (mx > mn) ? 255.99f / (mx - mn) : 0.f;
#pragma unroll
    for (int i = 0; i < 4; ++i) myh[lane + 64 * i] = 0u;
    lds_fence();
    for (int i0 = lane; i0 < n; i0 += 256) {
      float v4[4];
#pragma unroll
      for (int k = 0; k < 4; ++k) v4[k] = (i0 + 64 * k < n) ? rowf[i0 + 64 * k] : 0.f;
#pragma unroll
      for (int k = 0; k < 4; ++k) {
        if (i0 + 64 * k < n) {
          int bn = (int)((v4[k] - mn) * scale); bn = bn > 255 ? 255 : bn;
          atomicAdd(&myh[bn], 1u);
        }
      }
    }
    lds_fence();
    unsigned cum; int bstar; unsigned mcount;
    {
      const uint4 c4 = *(const uint4*)(myh + 4 * lane);
      const unsigned c = c4.x + c4.y + c4.z + c4.w;
      unsigned sfx = c;
#pragma unroll
      for (int o = 1; o < 64; o <<= 1) { const unsigned tt = __shfl_down(sfx, o); if (lane + o < 64) sfx += tt; }
      const unsigned long long bal = __ballot(sfx >= 256u);
      const int L = 63 - __clzll(bal);
      const unsigned sL = __shfl(sfx, L), cL = __shfl(c, L);
      const unsigned b3 = __shfl(c4.w, L), b2 = __shfl(c4.z, L), b1 = __shfl(c4.y, L), b0 = __shfl(c4.x, L);
      cum = sL - cL;
      int digit;
      if (cum + b3 >= 256u) { digit = 3; mcount = b3; }
      else { cum += b3; if (cum + b2 >= 256u) { digit = 2; mcount = b2; } else { cum += b2; if (cum + b1 >= 256u) { digit = 1; mcount = b1; } else { cum += b1; digit = 0; mcount = b0; } } }
      bstar = 4 * L + digit;
    }
    const unsigned need = 256u - cum;
    if (mcount <= 512u) {
      unsigned base = 0u, cb = 0u;
      for (int i0 = 0; i0 < n; i0 += 256) {
        float v4[4];
#pragma unroll
        for (int k = 0; k < 4; ++k) { const int i = i0 + 64 * k + lane; v4[k] = (i < n) ? rowf[i] : 0.f; }
#pragma unroll
        for (int k = 0; k < 4; ++k) {
          const int i = i0 + 64 * k + lane;
          const bool valid = i < n;
          int bn = (int)((v4[k] - mn) * scale); bn = bn > 255 ? 255 : bn;
          const bool gt = valid && (bn > bstar);
          const bool eq = valid && (bn == bstar);
          const unsigned long long bg = __ballot(gt), be = __ballot(eq);
          if (gt) mysel[base + (unsigned)__popcll(bg & lt_mask)] = (unsigned short)i;
          if (eq) mycand[cb + (unsigned)__popcll(be & lt_mask)] = (unsigned short)i;
          base += (unsigned)__popcll(bg); cb += (unsigned)__popcll(be);
        }
      }
      lds_fence();
      const int m = (int)mcount;
      unsigned ck[8]; unsigned short ci[8];
#pragma unroll
      for (int q = 0; q < 8; ++q) {
        const int c = q * 64 + lane;
        ck[q] = 0u; ci[q] = 0;
        if (c < m) { ci[q] = mycand[c]; ck[q] = sortable_key(rowf[ci[q]]); }
      }
      unsigned T = 0u;
      if (m <= 64) {
#pragma unroll 1
        for (int bit = 31; bit >= 0; --bit) {
          const unsigned trial = T | (1u << bit);
          if ((unsigned)__popcll(__ballot(ck[0] >= trial)) >= need) T = trial;
        }
      } else {
#pragma unroll 1
        for (int bit = 31; bit >= 0; --bit) {
          const unsigned trial = T | (1u << bit);
          unsigned cge = 0u;
#pragma unroll
          for (int q = 0; q < 8; ++q) cge += (unsigned)__popcll(__ballot(ck[q] >= trial));
          if (cge >= need) T = trial;
        }
      }
      unsigned cgt = 0u;
#pragma unroll
      for (int q = 0; q < 8; ++q) cgt += (unsigned)__popcll(__ballot(ck[q] > T));
      const unsigned need_eq = need - cgt;
      unsigned pos0 = cum, eqtaken = 0u;
#pragma unroll
      for (int q = 0; q < 8; ++q) {
        const bool gt = ck[q] > T;
        const bool eq = ck[q] == T;
        const unsigned long long beq = __ballot(eq);
        const bool take = gt || (eq && (eqtaken + (unsigned)__popcll(beq & lt_mask)) < need_eq);
        const unsigned long long bt = __ballot(take);
        const unsigned pp = pos0 + (unsigned)__popcll(bt & lt_mask);
        if (take && pp < 256u) mysel[pp] = ci[q];
        pos0 += (unsigned)__popcll(bt);
        eqtaken += (unsigned)__popcll(beq);
      }
    } else {
      unsigned prefix = 0u, krem = 256u;
#pragma unroll 1
      for (int pass = 0; pass < 4; ++pass) {
        const int shift = 24 - 8 * pass;
        const unsigned himask = (pass == 0) ? 0u : (0xFFFFFFFFu << (shift + 8));
#pragma unroll
        for (int i = 0; i < 4; ++i) myh[lane + 64 * i] = 0u;
        lds_fence();
        for (int i = lane; i < n; i += 64) {
          const unsigned u = sortable_key(rowf[i]);
          if ((u & himask) == prefix) atomicAdd(&myh[(u >> shift) & 255u], 1u);
        }
        lds_fence();
        const uint4 c4 = *(const uint4*)(myh + 4 * lane);
        const unsigned c = c4.x + c4.y + c4.z + c4.w;
        unsigned sfx = c;
#pragma unroll
        for (int o = 1; o < 64; o <<= 1) { const unsigned tt = __shfl_down(sfx, o); if (lane + o < 64) sfx += tt; }
        const unsigned long long bal = __ballot(sfx >= krem);
        const int L = 63 - __clzll(bal);
        const unsigned sL = __shfl(sfx, L), cL = __shfl(c, L);
        const unsigned b3 = __shfl(c4.w, L), b2 = __shfl(c4.z, L), b1 = __shfl(c4.y, L);
        unsigned cum2 = sL - cL;
        unsigned digit;
        if (cum2 + b3 >= krem) digit = 3;
        else { cum2 += b3; if (cum2 + b2 >= krem) digit = 2; else { cum2 += b2; if (cum2 + b1 >= krem) digit = 1; else { cum2 += b1; digit = 0; } } }
        krem -= cum2;
        prefix |= ((unsigned)(4 * L) + digit) << shift;
      }
      const unsigned T = prefix;
      unsigned base = 0u, eqtaken = 0u;
      for (int i0 = 0; i0 < n; i0 += 64) {
        const int i = i0 + lane;
        const bool valid = i < n;
        const unsigned u = valid ? sortable_key(rowf[i]) : 0u;
        const bool gt = valid && (u > T);
        const bool eq = valid && (u == T);
        const unsigned long long beq = __ballot(eq);
        const unsigned eqrank = eqtaken + (unsigned)__popcll(beq & lt_mask);
        const bool take = gt || (eq && eqrank < krem);
        const unsigned long long bt = __ballot(take);
        const unsigned pos = base + (unsigned)__popcll(bt & lt_mask);
        if (take && pos < 256u) mysel[pos] = (unsigned short)i;
        base += (unsigned)__popcll(bt);
        eqtaken += (unsigned)__popcll(beq);
      }
    }
  }
  lds_fence();
  if (lane == 0) { rmm[w] = 0xFFFFFFFFu; rmm[8 + w] = 0u; }
  {
    int lane_a = lane;
    asm volatile("" : "+v"(lane_a));
    const int l15 = lane_a & 15, g = lane_a >> 4;
    const int ks = lane_a >> 3, dc = lane_a & 7;
    float* pl = (float*)row;
    const float* relb = (const float*)(bkt + 128);
    const int niter = (cnt + 7) >> 3;
    bf16x8 bq0 = (bf16x8){0, 0, 0, 0, 0, 0, 0, 0}, bq1 = bq0;
    if (l15 < 8) {
      bq0 = *(const bf16x8*)(pA + (tokbase + t) * 1024 + l15 * 64 + 8 * g);
      bq1 = *(const bf16x8*)(pA + (tokbase + t) * 1024 + l15 * 64 + 32 + 8 * g);
    }
    float lg[16][4];
    {
      bf16x8 ka[8][2], kb[8][2];
#pragma unroll
      for (int u = 0; u < 8; ++u) {
        const int kk = u * 16 + l15;
        const int s = (kk < cnt) ? (int)mysel[kk] : 0;
        const bf16_t* kr = pA + (tokbase + s) * 1024 + 512 + 8 * g;
        ka[u][0] = *(const bf16x8*)kr;
        ka[u][1] = *(const bf16x8*)(kr + 32);
      }
#pragma unroll
      for (int u = 0; u < 8; ++u) {
        const int kk = (8 + u) * 16 + l15;
        const int s = (kk < cnt) ? (int)mysel[kk] : 0;
        const bf16_t* kr = pA + (tokbase + s) * 1024 + 512 + 8 * g;
        kb[u][0] = *(const bf16x8*)kr;
        kb[u][1] = *(const bf16x8*)(kr + 32);
      }
      __builtin_amdgcn_sched_barrier(0);
#pragma unroll
      for (int u = 0; u < 8; ++u) {
        f32x4 acc = (f32x4){0.f, 0.f, 0.f, 0.f};
        acc = __builtin_amdgcn_mfma_f32_16x16x32_bf16(ka[u][0], bq0, acc, 0, 0, 0);
        acc = __builtin_amdgcn_mfma_f32_16x16x32_bf16(ka[u][1], bq1, acc, 0, 0, 0);
        lg[u][0] = acc[0]; lg[u][1] = acc[1]; lg[u][2] = acc[2]; lg[u][3] = acc[3];
      }
#pragma unroll
      for (int u = 0; u < 8; ++u) {
        f32x4 acc = (f32x4){0.f, 0.f, 0.f, 0.f};
        acc = __builtin_amdgcn_mfma_f32_16x16x32_bf16(kb[u][0], bq0, acc, 0, 0, 0);
        acc = __builtin_amdgcn_mfma_f32_16x16x32_bf16(kb[u][1], bq1, acc, 0, 0, 0);
        lg[8 + u][0] = acc[0]; lg[8 + u][1] = acc[1]; lg[8 + u][2] = acc[2]; lg[8 + u][3] = acc[3];
      }
    }
    typedef unsigned u32x4_t __attribute__((ext_vector_type(4)));
    u32x4_t va[16];
#pragma unroll
    for (int u = 0; u < 16; ++u) {
      const int kk = u * 8 + ks;
      const int s = (kk < cnt) ? (int)mysel[kk] : 0;
      va[u] = *(const u32x4_t*)(pA + (tokbase + s) * 1024 + 576 + dc * 8);
    }
    __builtin_amdgcn_sched_barrier(0);
    const int hsel = l15 & 7;
    float m = -INFINITY;
#pragma unroll
    for (int u = 0; u < 16; ++u) {
      const uint2 s4 = *(const uint2*)(mysel + u * 16 + 4 * g);
      const int sj[4] = {(int)(s4.x & 0xffffu), (int)(s4.x >> 16), (int)(s4.y & 0xffffu), (int)(s4.y >> 16)};
#pragma unroll
      for (int j = 0; j < 4; ++j) {
        const int key = u * 16 + 4 * g + j;
        const bool valid = key < cnt;
        const int dist = valid ? t - sj[j] : 0;
        const int bk = dist < 128 ? (int)bkt[dist] : 31;
        lg[u][j] = valid ? (lg[u][j] * 0.125f + relb[bk * 8 + hsel]) : -INFINITY;
        m = fmaxf(m, lg[u][j]);
      }
    }
    m = max_xor16(m); m = max_xor32(m);
    float sum = 0.f;
#pragma unroll
    for (int u = 0; u < 16; ++u)
#pragma unroll
      for (int j = 0; j < 4; ++j) { lg[u][j] = __expf(lg[u][j] - m); sum += lg[u][j]; }
    sum = add_xor16(sum); sum = add_xor32(sum);
    const float inv = 1.f / sum;
    bf16x8 pa[8];
#pragma unroll
    for (int s8 = 0; s8 < 8; ++s8) {
      const unsigned w0 = pack2(lg[2 * s8][0] * inv, lg[2 * s8][1] * inv), w1 = pack2(lg[2 * s8][2] * inv, lg[2 * s8][3] * inv);
      const unsigned w2 = pack2(lg[2 * s8 + 1][0] * inv, lg[2 * s8 + 1][1] * inv), w3 = pack2(lg[2 * s8 + 1][2] * inv, lg[2 * s8 + 1][3] * inv);
      const u32x4_t wv = {w0, w1, w2, w3};
      pa[s8] = __builtin_bit_cast(bf16x8, wv);
    }
    unsigned char* vs_l = (unsigned char*)row;
#pragma unroll
    for (int u = 0; u < 16; ++u) *(u32x4_t*)(vs_l + (u * 8 + ks) * 128 + dc * 16) = va[u];
    lds_fence();
    u32x4_t vb[16];
#pragma unroll
    for (int u = 0; u < 16; ++u) {
      const int kk = (16 + u) * 8 + ks;
      const int s = (kk < cnt) ? (int)mysel[kk] : 0;
      vb[u] = *(const u32x4_t*)(pA + (tokbase + s) * 1024 + 576 + dc * 8);
    }
    __builtin_amdgcn_sched_barrier(0);
    f32x4 ov[4];
#pragma unroll
    for (int nt = 0; nt < 4; ++nt) ov[nt] = (f32x4){0.f, 0.f, 0.f, 0.f};
    typedef short v4s_t __attribute__((ext_vector_type(4)));
    const unsigned tr_lane = (unsigned)((l15 >> 2) * 128 + (l15 & 3) * 8);
#define PV_HALF(S0) do { \
      _Pragma("unroll") for (int s4_ = 0; s4_ < 4; ++s4_) { \
        _Pragma("unroll") for (int nt = 0; nt < 4; ++nt) { \
          const unsigned a0 = (unsigned)((s4_ * 32 + 4 * g) * 128 + nt * 32) + tr_lane; \
          const v4s_t b0 = __builtin_amdgcn_ds_read_tr16_b64_v4i16((__attribute__((address_space(3))) v4s_t*)(vs_l + a0)); \
          const v4s_t b1 = __builtin_amdgcn_ds_read_tr16_b64_v4i16((__attribute__((address_space(3))) v4s_t*)(vs_l + a0 + 16 * 128)); \
          const bf16x8 bb = (bf16x8){b0[0], b0[1], b0[2], b0[3], b1[0], b1[1], b1[2], b1[3]}; \
          ov[nt] = __builtin_amdgcn_mfma_f32_16x16x32_bf16(pa[(S0) + s4_], bb, ov[nt], 0, 0, 0); \
        } \
      } \
    } while (0)
    PV_HALF(0);
    lds_fence();
#pragma unroll
    for (int u = 0; u < 16; ++u) *(u32x4_t*)(vs_l + (u * 8 + ks) * 128 + dc * 16) = vb[u];
    lds_fence();
    PV_HALF(4);
#undef PV_HALF
    if (g < 2) {
#pragma unroll
      for (int nt = 0; nt < 4; ++nt)
#pragma unroll
        for (int j = 0; j < 4; ++j) yb[(tokbase + t) * 512 + (4 * g + j) * 64 + nt * 16 + l15] = f2bf(ov[nt][j]);
    }
    lds_fence();
  }
  __syncthreads();
}

__device__ __forceinline__ void phase_mix(const Params& p, unsigned char* smem, int mode = 0) {
  const int G = gridDim.x;
  if (mode != 2) { for (int bh = blockIdx.x; bh < 32; bh += G) { hgrn_h2(p, smem, bh); __syncthreads(); } }
  if (mode == 1) return;
  unsigned char* bkt = smem + DSA_BKT_OFF;
  volatile int* qslot = (volatile int*)(smem + LDS_BYTES - 32);
  unsigned* qctr = (unsigned*)(p.ws + WS_QCTR);
  if (threadIdx.x < 128) {
    const int nn = threadIdx.x;
    int v = nn;
    if (nn >= 16) { v = 16 + (int)(logf((float)nn * (1.f / 16.f)) / logf(8.f) * 16.f); if (v > 31) v = 31; }
    bkt[nn] = (unsigned char)v;
  }
  if (threadIdx.x >= 256) ((float*)(bkt + 128))[threadIdx.x - 256] = p.rel_bias[threadIdx.x - 256];
  if (threadIdx.x < 16) ((unsigned*)(bkt + 128 + 1024))[threadIdx.x] = threadIdx.x < 8 ? 0xFFFFFFFFu : 0u;
  const int my_team = (G % 8 == 0) ? team_index(p, smem) / (G >> 3) : (int)(blockIdx.x & 7);
  constexpr int QN = 544;
#define Q_FETCH(SLOT) do { if (threadIdx.x == 0) { int tm_ = q_team, kk_ = -1; \
      for (int tries_ = 0; tries_ < 8; ++tries_) { \
        const unsigned v_ = __hip_atomic_fetch_add(qctr + 16 * tm_, 1u, __ATOMIC_RELAXED, __HIP_MEMORY_SCOPE_AGENT); \
        if (v_ < (unsigned)QN) { kk_ = (tm_ << 16) | (int)v_; break; } \
        tm_ = (tm_ + 1) & 7; } \
      q_team = tm_; qslot[SLOT] = kk_; } } while (0)
  int q_team = my_team;
  Q_FETCH(0);
  __syncthreads();
  int k = qslot[0];
  int par = 1;
  while (k >= 0) {
    Q_FETCH(par);
    const int bt = k >> 16, kl = k & 0xffff;
    const int kq = kl / 17, kr = kl - kq * 17;
    if (kr < 16) {
      const int tb = 511 - (kq * 16 + kr);
      dsa_item(p, smem, (bt << 9) | tb);
    } else {
      const int r0 = (bt * 32 + kq) * 64;
      quantize_rows_u8<false, true>(p.peer_u, p.ws + WS_U, (float*)(p.ws + WS_U + (size_t)16384 * 1024), r0, r0 + 64);
      quantize_rows_u8<true, false>(p.peer_v, p.ws + WS_V, (float*)(p.ws + WS_V + (size_t)16384 * 1024), r0, r0 + 64);
      __syncthreads();
    }
    k = qslot[par];
    par ^= 1;
  }
#undef Q_FETCH
}

__device__ __forceinline__ void phase_up(const Params& p, unsigned char* smem) {
  unsigned char* ws = p.ws;
  const bf16_t* ya = (const bf16_t*)(ws + WS_XN);
  const bf16_t* yb = ya + (size_t)TOK * 512;
  const bf16_t* wa = (const bf16_t*)(ws + WS_WUPA);
  const bf16_t* wb = (const bf16_t*)(ws + WS_WUPB);
  const bf16_t* pG = (const bf16_t*)(ws + WS_PG);
  bf16_t* hb = (bf16_t*)(ws + WS_PH);
  const int tid = threadIdx.x, lane = tid & 63, w = tid >> 6, wm = w >> 1, wn = w & 1, l15 = lane & 15, g = lane >> 4;
  for (int tile = blockIdx.x; tile < 128 * 8; tile += gridDim.x) {
    const int tn = tile & 7, tm = tile >> 3;
    f32x4 acc[4][4]; zero_acc(acc);
    gemm_tile(ya + (size_t)tm * 256 * 512, 512, wa + (size_t)tn * 128 * 512, 512, 8, acc, smem);
    asm volatile("" ::: "memory");
    const int rbase = tm * 256 + wm * 64 + 4 * g;
    const int cbase = tn * 128 + wn * 64 + l15;
#pragma unroll
    for (int m = 0; m < 4; ++m) {
      bf16_t gt[16];
#pragma unroll
      for (int n = 0; n < 4; ++n)
#pragma unroll
        for (int j = 0; j < 4; ++j) gt[n * 4 + j] = pG[(size_t)(rbase + m * 16 + j) * 2048 + cbase + n * 16];
#pragma unroll
      for (int n = 0; n < 4; ++n) {
#pragma unroll
        for (int j = 0; j < 4; ++j) {
          const size_t rr = (size_t)(rbase + m * 16 + j);
          hb[rr * 1024 + cbase + n * 16] = f2bf(acc[m][n][j] * bf2f(gt[n * 4 + j]));
        }
        acc[m][n] = (f32x4){0.f, 0.f, 0.f, 0.f};
      }
    }
    asm volatile("" ::: "memory");
    gemm_tile(yb + (size_t)tm * 256 * 512, 512, wb + (size_t)tn * 128 * 512, 512, 8, acc, smem);
    asm volatile("" ::: "memory");
#pragma unroll
    for (int m = 0; m < 4; ++m) {
      bf16_t gt[16], ht[16];
#pragma unroll
      for (int n = 0; n < 4; ++n)
#pragma unroll
        for (int j = 0; j < 4; ++j) {
          const size_t rr = (size_t)(rbase + m * 16 + j);
          gt[n * 4 + j] = pG[rr * 2048 + 1024 + cbase + n * 16];
          ht[n * 4 + j] = hb[rr * 1024 + cbase + n * 16];
        }
#pragma unroll
      for (int n = 0; n < 4; ++n)
#pragma unroll
        for (int j = 0; j < 4; ++j) {
          const size_t rr = (size_t)(rbase + m * 16 + j);
          hb[rr * 1024 + cbase + n * 16] = f2bf(bf2f(ht[n * 4 + j]) + acc[m][n][j] * bf2f(gt[n * 4 + j]));
        }
    }
  }
}

__device__ __forceinline__ void phase_out(const Params& p, unsigned char* smem) {
  unsigned char* ws = p.ws;
  const bf16_t* hb = (const bf16_t*)(ws + WS_PH);
  const bf16_t* wo = (const bf16_t*)(ws + WS_WOUT);
  const int tid = threadIdx.x, lane = tid & 63, w = tid >> 6, wm = w >> 1, wn = w & 1, l15 = lane & 15, g = lane >> 4;
  for (int tile = blockIdx.x; tile < 128 * 8; tile += gridDim.x) {
    const int tn = tile & 7, tm = tile >> 3;
    f32x4 acc[4][4]; zero_acc(acc);
    gemm_tile(hb + (size_t)tm * 256 * 1024, 1024, wo + (size_t)tn * 128 * 1024, 1024, 16, acc, smem);
    const int rbase = tm * 256 + wm * 64 + 4 * g;
    const int cbase = tn * 128 + wn * 64 + l15;
#pragma unroll
    for (int m = 0; m < 4; ++m) {
      float xt[16];
#pragma unroll
      for (int n = 0; n < 4; ++n)
#pragma unroll
        for (int j = 0; j < 4; ++j) xt[n * 4 + j] = p.x[(size_t)(rbase + m * 16 + j) * 1024 + cbase + n * 16];
#pragma unroll
      for (int n = 0; n < 4; ++n)
#pragma unroll
        for (int j = 0; j < 4; ++j) p.out[(size_t)(rbase + m * 16 + j) * 1024 + cbase + n * 16] = xt[n * 4 + j] + acc[m][n][j];
    }
  }
}

__device__ __forceinline__ void phase_pq(const Params& p, unsigned char* smem) {
  unsigned char* ws = p.ws;
  const bf16_t* xn2 = (const bf16_t*)(ws + WS_XN);
  const bf16_t* wq = (const bf16_t*)(ws + WS_WQ);
  bf16_t* qp = (bf16_t*)(ws + WS_PG);
  const int tid = threadIdx.x, lane = tid & 63, w = tid >> 6, wm = w >> 1, wn = w & 1, l15 = lane & 15, g = lane >> 4;
  for (int tile = blockIdx.x; tile < 128 * 16; tile += gridDim.x) {
    const int tn = tile & 15, tm = tile >> 4;
    f32x4 acc[4][4]; zero_acc(acc);
    gemm_tile(xn2 + (size_t)tm * 256 * 1024, 1024, wq + (size_t)tn * 128 * 1024, 1024, 16, acc, smem);
    const int rbase = tm * 256 + wm * 64 + 4 * g;
    const int cbase = tn * 128 + wn * 64 + l15;
#pragma unroll
    for (int m = 0; m < 4; ++m)
#pragma unroll
      for (int n = 0; n < 4; ++n)
#pragma unroll
        for (int j = 0; j < 4; ++j) qp[(size_t)(rbase + m * 16 + j) * 2048 + cbase + n * 16] = f2bf(acc[m][n][j]);
  }
}

__device__ __forceinline__ void phase_pkeys(const Params& p, unsigned char* smem) {
  unsigned char* ws = p.ws;
  const bf16_t* qp = (const bf16_t*)(ws + WS_PG);
  const bf16_t* keys = (const bf16_t*)(ws + WS_KEYS);
  float* ps = (float*)(ws + WS_PA);
  int* pi = (int*)(ws + WS_PA) + (size_t)TOK * 256;
  float* sc = (float*)smem;
  const int tid = threadIdx.x, lane = tid & 63, w = tid >> 6, wm = w >> 1, wn = w & 1, l15 = lane & 15, g = lane >> 4;
  for (int tile = blockIdx.x; tile < 128 * 16; tile += gridDim.x) {
    const int hp = tile & 15, tm = tile >> 4;
    const int h = hp >> 1, ph = hp & 1;
    f32x4 acc[4][4]; zero_acc(acc);
    gemm_tile(qp + (size_t)tm * 256 * 2048 + hp * 128, 2048, keys + (size_t)(ph * 8 + h) * 128 * 128, 128, 2, acc, smem);
    __syncthreads();
#pragma unroll
    for (int m = 0; m < 4; ++m)
#pragma unroll
      for (int n = 0; n < 4; ++n)
#pragma unroll
        for (int j = 0; j < 4; ++j) sc[(wm * 64 + m * 16 + 4 * g + j) * 129 + wn * 64 + n * 16 + l15] = acc[m][n][j];
    __syncthreads();
    if (tid < 256) {
      const int row = tid;
      const float* rowp = sc + row * 129;
      unsigned tv[16];
#pragma unroll
      for (int k = 0; k < 16; ++k) tv[k] = 0u;
#pragma unroll 8
      for (int nn = 0; nn < 128; ++nn) {
        const unsigned bits = __float_as_uint(rowp[nn]);
        unsigned key = (bits & 0x80000000u) ? ~bits : (bits | 0x80000000u);
        key = (key & ~127u) | (unsigned)(127 - nn);
#pragma unroll
        for (int k = 15; k >= 1; --k) {
          unsigned r;
          asm("v_med3_u32 %0, %1, %2, %3" : "=v"(r) : "v"(tv[k]), "v"(tv[k - 1]), "v"(key));
          tv[k] = r;
        }
        tv[0] = tv[0] > key ? tv[0] : key;
      }
      const size_t ob = ((size_t)(tm * 256 + row) * 16 + hp) * 16;
      float ov[16]; int oi[16];
#pragma unroll
      for (int k = 0; k < 16; ++k) { oi[k] = 127 - (int)(tv[k] & 127u); ov[k] = rowp[oi[k]]; }
#pragma unroll
      for (int k = 0; k < 16; k += 4) {
        *(float4*)(ps + ob + k) = make_float4(ov[k], ov[k + 1], ov[k + 2], ov[k + 3]);
        *(int4*)(pi + ob + k) = make_int4(oi[k], oi[k + 1], oi[k + 2], oi[k + 3]);
      }
    }
    __syncthreads();
  }
}

__device__ __forceinline__ void phase_pcomb(const Params& p, unsigned char* smem) {
  unsigned char* ws = p.ws;
  const float* ps = (const float*)(ws + WS_PA);
  const int* pi = (const int*)(ws + WS_PA) + (size_t)TOK * 256;
  int* eidx = (int*)(ws + WS_EIDX);
  float* gw = (float*)(ws + WS_GW);
  float* s2l = (float*)smem;
  unsigned short* i1l = (unsigned short*)(s2l + 512 * 17);
  unsigned short* i2l = i1l + 512 * 16;
  const int tid = threadIdx.x;
  for (int base = blockIdx.x * NTHREADS; base < TOK * 8; base += gridDim.x * NTHREADS) {
    const int th = base + tid;
    const size_t o1 = (size_t)th * 32;
    float s1[16];
#pragma unroll
    for (int a = 0; a < 16; ++a) {
      s1[a] = ps[o1 + a];
      s2l[tid * 17 + a] = ps[o1 + 16 + a];
      i1l[tid * 16 + a] = (unsigned short)pi[o1 + a];
      i2l[tid * 16 + a] = (unsigned short)pi[o1 + 16 + a];
    }
    float cur[16];
    const float s20 = s2l[tid * 17];
#pragma unroll
    for (int a = 0; a < 16; ++a) cur[a] = s1[a] + s20;
    unsigned long long ptr = 0ull;
    float tops[16]; int tope[16];
#pragma unroll
    for (int k = 0; k < 16; ++k) {
      float best = cur[0]; int ba = 0;
#pragma unroll
      for (int a = 1; a < 16; ++a) if (cur[a] > best) { best = cur[a]; ba = a; }
      const int bb = (int)((ptr >> (4 * ba)) & 15ull);
      tops[k] = best;
      tope[k] = (int)i1l[tid * 16 + ba] * 128 + (int)i2l[tid * 16 + bb];
      const int nb = bb + 1;
      const float ns2 = (nb < 16) ? s2l[tid * 17 + nb] : -INFINITY;
      if (nb < 16) ptr += (1ull << (4 * ba));
#pragma unroll
      for (int a = 0; a < 16; ++a) if (a == ba) cur[a] = s1[a] + ns2;
    }
    float m = tops[0];
    float sum = 0.f;
#pragma unroll
    for (int k = 0; k < 16; ++k) { tops[k] = __expf(tops[k] - m); sum += tops[k]; }
    const float inv = 1.f / sum;
#pragma unroll
    for (int k = 0; k < 16; ++k) { eidx[(size_t)th * 16 + k] = tope[k]; gw[(size_t)th * 16 + k] = tops[k] * inv; }
  }
}


__device__ __forceinline__ float reduce8(const float (&pv)[8], int lane) {
  const bool b5 = lane & 32, b4 = lane & 16, b3 = lane & 8;
  float v[4];
#pragma unroll
  for (int i = 0; i < 4; ++i) {
    const float keep = b5 ? pv[4 + i] : pv[i];
    const float send = b5 ? pv[i] : pv[4 + i];
    v[i] = keep + __shfl_xor(send, 32);
  }
  float u[2];
#pragma unroll
  for (int i = 0; i < 2; ++i) {
    const float keep = b4 ? v[2 + i] : v[i];
    const float send = b4 ? v[i] : v[2 + i];
    u[i] = keep + __shfl_xor(send, 16);
  }
  float x = (b3 ? u[1] : u[0]) + __shfl_xor(b3 ? u[0] : u[1], 8);
  x += __shfl_xor(x, 4); x += __shfl_xor(x, 2); x += __shfl_xor(x, 1);
  return x;
}

__device__ __forceinline__ void cvt16u8(const uint4& v, float* f) {
  f[0] = (float)(v.x & 0xffu); f[1] = (float)((v.x >> 8) & 0xffu); f[2] = (float)((v.x >> 16) & 0xffu); f[3] = (float)(v.x >> 24);
  f[4] = (float)(v.y & 0xffu); f[5] = (float)((v.y >> 8) & 0xffu); f[6] = (float)((v.y >> 16) & 0xffu); f[7] = (float)(v.y >> 24);
  f[8] = (float)(v.z & 0xffu); f[9] = (float)((v.z >> 8) & 0xffu); f[10] = (float)((v.z >> 16) & 0xffu); f[11] = (float)(v.z >> 24);
  f[12] = (float)(v.w & 0xffu); f[13] = (float)((v.w >> 8) & 0xffu); f[14] = (float)((v.w >> 16) & 0xffu); f[15] = (float)(v.w >> 24);
}

__device__ __forceinline__ int wave_sum_i32_dpp(int v) {
  v += __builtin_amdgcn_update_dpp(0, v, 0xB1, 0xf, 0xf, true);
  v += __builtin_amdgcn_update_dpp(0, v, 0x4E, 0xf, 0xf, true);
  v += __builtin_amdgcn_update_dpp(0, v, 0x141, 0xf, 0xf, true);
  v += __builtin_amdgcn_update_dpp(0, v, 0x140, 0xf, 0xf, true);
  return __builtin_amdgcn_readlane(v, 0) + __builtin_amdgcn_readlane(v, 16) + __builtin_amdgcn_readlane(v, 32) + __builtin_amdgcn_readlane(v, 48);
}

__device__ __forceinline__ int reduce8_i32_scatter(const int (&d)[8], int lane) {
  const bool b0 = lane & 1, b1 = lane & 2, b2 = lane & 4;
  int v[4];
#pragma unroll
  for (int i = 0; i < 4; ++i) {
    const int keep = b0 ? d[2 * i + 1] : d[2 * i];
    const int send = b0 ? d[2 * i] : d[2 * i + 1];
    v[i] = keep + __builtin_amdgcn_update_dpp(0, send, 0xB1, 0xf, 0xf, true);
  }
  int u[2];
#pragma unroll
  for (int i = 0; i < 2; ++i) {
    const int keep = b1 ? v[2 * i + 1] : v[2 * i];
    const int send = b1 ? v[2 * i] : v[2 * i + 1];
    u[i] = keep + __builtin_amdgcn_update_dpp(0, send, 0x4E, 0xf, 0xf, true);
  }
  int x;
  {
    const int keep = b2 ? u[1] : u[0];
    const int send = b2 ? u[0] : u[1];
    int t = __builtin_amdgcn_update_dpp(0, send, 0x141, 0xf, 0xf, true);
    t = __builtin_amdgcn_update_dpp(0, t, 0x1B, 0xf, 0xf, true);
    x = keep + t;
  }
  x += __builtin_amdgcn_update_dpp(0, x, 0x128, 0xf, 0xf, true);
  { const auto r = __builtin_amdgcn_permlane16_swap((unsigned)x, (unsigned)x, false, false); x = (int)r[0] + (int)r[1]; }
  { const auto r = __builtin_amdgcn_permlane32_swap((unsigned)x, (unsigned)x, false, false); x = (int)r[0] + (int)r[1]; }
  return x;
}

__device__ __forceinline__ void phase_pu(const Params& p, unsigned char* smem) {
  unsigned char* ws = p.ws;
  const unsigned char* XQ = ws + WS_XQ;
  const float* xs = (const float*)(ws + WS_XS);
  const unsigned char* U8 = ws + WS_U;
  const float* us = (const float*)(ws + WS_U + (size_t)16384 * 1024);
  const float* vs = (const float*)(ws + WS_V + (size_t)16384 * 1024);
  const int* eidx = (const int*)(ws + WS_EIDX);
  const float* gw = (const float*)(ws + WS_GW);
  float* aw = (float*)(ws + WS_PA);
  const int lane = threadIdx.x & 63, w = threadIdx.x >> 6;
  const unsigned long long lt_mask = (1ull << lane) - 1ull;
  const int G = gridDim.x;
  const bool sliced = (G % 8 == 0);
  const int ti = sliced ? team_index(p, smem) : 0;
  const int tsz = sliced ? (G >> 3) : G;
  const int grp_lo = sliced ? ti / tsz : 0, grp_hi = sliced ? grp_lo + 1 : 8;
  const int slot = (sliced ? (ti % tsz) : (int)blockIdx.x) * 8 + w;
  const int nslot = tsz * 8;
  unsigned* lst = (unsigned*)smem + 4096 + w * 128;
  typedef unsigned u32x4_t __attribute__((ext_vector_type(4)));
  if (slot >= TOK) return;
  for (int grp = grp_lo; grp < grp_hi; ++grp) {
#define PU_LIST(E0, E1, N, L0, L1) do { \
      const bool m0_ = ((E0) >> 11) == grp, m1_ = ((E1) >> 11) == grp; \
      const unsigned long long b0_ = __ballot(m0_), b1_ = __ballot(m1_); \
      const int c0_ = __popcll(b0_); N = c0_ + __popcll(b1_); \
      if (m0_) lst[__popcll(b0_ & lt_mask)] = ((unsigned)lane << 14) | (unsigned)(E0); \
      if (m1_) lst[c0_ + __popcll(b1_ & lt_mask)] = ((unsigned)(lane + 64) << 14) | (unsigned)(E1); \
      lds_fence(); \
      L0 = (lane < N) ? lst[lane] : 0u; L1 = (lane + 64 < N) ? lst[lane + 64] : 0u; \
      lds_fence(); } while (0)
#define PU_ISSUE(BUF, L0, N, I0) do { int last_ = ((N) < 64 ? (N) : 64) - 1; last_ = last_ < 0 ? 0 : last_; \
      _Pragma("unroll") for (int j = 0; j < 8; ++j) { int idx_ = (I0) + j; idx_ = idx_ < last_ ? idx_ : last_; \
        const unsigned le_ = (unsigned)__builtin_amdgcn_readlane((int)(L0), idx_); \
        BUF[j] = *(const u32x4_t*)(U8 + (size_t)(le_ & 16383u) * 1024 + lane * 16); } } while (0)
#define PU_REDUCE(BUF, X, I0, HREG) do { int dd_[8]; _Pragma("unroll") for (int j = 0; j < 8; ++j) { \
        int d_ = __builtin_amdgcn_sdot4((int)BUF[j].x, (int)(X).x, 0, false); \
        d_ = __builtin_amdgcn_sdot4((int)BUF[j].y, (int)(X).y, d_, false); \
        d_ = __builtin_amdgcn_sdot4((int)BUF[j].z, (int)(X).z, d_, false); \
        dd_[j] = __builtin_amdgcn_sdot4((int)BUF[j].w, (int)(X).w, d_, false); } \
      const int tot_ = reduce8_i32_scatter(dd_, lane);     \
      if (lane >= (I0) && lane < (I0) + 8) HREG = tot_; } while (0)
    u32x4_t cx = *(const u32x4_t*)(XQ + (size_t)slot * 1024 + lane * 16);
    int ce0 = eidx[(size_t)slot * 128 + lane], ce1 = eidx[(size_t)slot * 128 + 64 + lane];
    float cxs = xs[slot];
    int cn; unsigned cl0, cl1;
    PU_LIST(ce0, ce1, cn, cl0, cl1);
    u32x4_t ra[8], rb[8], rc[8];
    PU_ISSUE(ra, cl0, cn, 0);
    PU_ISSUE(rb, cl0, cn, 8);
    int t1 = (slot + nslot < TOK) ? slot + nslot : slot;
    u32x4_t nx = *(const u32x4_t*)(XQ + (size_t)t1 * 1024 + lane * 16);
    int ne0 = eidx[(size_t)t1 * 128 + lane], ne1 = eidx[(size_t)t1 * 128 + 64 + lane];
    float nxs = xs[t1];
    for (int tok = slot; tok < TOK; tok += nslot) {
      float sc0 = 0.f, sc1 = 0.f, gv0 = 0.f, gv1 = 0.f, vv0 = 0.f, vv1 = 0.f;
      if (lane < cn) { const int e = cl0 & 16383; sc0 = us[e]; vv0 = vs[e]; gv0 = gw[(size_t)tok * 128 + (cl0 >> 14)]; }
      if (lane + 64 < cn) { const int e = cl1 & 16383; sc1 = us[e]; vv1 = vs[e]; gv1 = gw[(size_t)tok * 128 + (cl1 >> 14)]; }
      int nn; unsigned nl0, nl1;
      PU_LIST(ne0, ne1, nn, nl0, nl1);
      const u32x4_t x1 = nx; const int xe0 = ne0, xe1 = ne1; const float xs1 = nxs;
      const int t2a = tok + nslot, t2 = (t2a + nslot < TOK) ? t2a + nslot : ((t2a < TOK) ? t2a : tok);
      nx = *(const u32x4_t*)(XQ + (size_t)t2 * 1024 + lane * 16);
      ne0 = eidx[(size_t)t2 * 128 + lane]; ne1 = eidx[(size_t)t2 * 128 + 64 + lane];
      nxs = xs[t2];
      int h0i = 0, h1i = 0;
      PU_ISSUE(rc, cl0, cn, 16); __builtin_amdgcn_sched_barrier(0); PU_REDUCE(ra, cx, 0, h0i);  __builtin_amdgcn_sched_barrier(0);
      PU_ISSUE(ra, nl0, nn, 0);  __builtin_amdgcn_sched_barrier(0); PU_REDUCE(rb, cx, 8, h0i);  __builtin_amdgcn_sched_barrier(0);
      PU_ISSUE(rb, nl0, nn, 8);  __builtin_amdgcn_sched_barrier(0); PU_REDUCE(rc, cx, 16, h0i); __builtin_amdgcn_sched_barrier(0);
      if (cn > 24) {
        for (int i0 = 24; i0 < cn; i0 += 8) {
          u32x4_t rd[8];
          const bool lo = i0 < 64;
          const unsigned lsrc = lo ? cl0 : cl1;
          const int nsrc = lo ? cn : cn - 64;
          PU_ISSUE(rd, lsrc, nsrc, i0 & 63);
          if (lo) { PU_REDUCE(rd, cx, i0, h0i); } else { PU_REDUCE(rd, cx, i0 - 64, h1i); }
        }
      }
      const float h0 = (float)h0i * sc0 * cxs, h1 = (float)h1i * sc1 * cxs;
      if (lane < cn) aw[(size_t)tok * 128 + (cl0 >> 14)] = 0.5f * h0 * (1.f + erff(h0 * 0.70710678118654752f)) * gv0 * vv0;
      if (lane + 64 < cn) aw[(size_t)tok * 128 + (cl1 >> 14)] = 0.5f * h1 * (1.f + erff(h1 * 0.70710678118654752f)) * gv1 * vv1;
      cx = x1; ce0 = xe0; ce1 = xe1; cxs = xs1; cn = nn; cl0 = nl0; cl1 = nl1;
    }
#undef PU_LIST
#undef PU_ISSUE
#undef PU_REDUCE
  }
}

template <bool SL>
__device__ __forceinline__ void phase_pv_t(const Params& p, unsigned char* smem) {
  unsigned char* ws = p.ws;
  const unsigned char* V8 = ws + WS_V;
  const int* eidx = (const int*)(ws + WS_EIDX);
  const float* aw = (const float*)(ws + WS_PA);
  float* ssq = (float*)(ws + WS_SSQ);
  const int lane = threadIdx.x & 63, w = threadIdx.x >> 6;
  const int q = lane >> 3, c = lane & 7;
  const int G = gridDim.x;
  constexpr bool sliced = SL;
  const int ti = sliced ? team_index(p, smem) : 0;
  const int tsz = G >> 3;
  const int grp0 = sliced ? (ti / tsz) : 0;
  constexpr int ngrp = sliced ? 1 : 8;
  const int slot = sliced ? (ti % tsz) * 8 + w : blockIdx.x * 8 + w;
  const int nslot = sliced ? tsz * 8 : G * 8;
  int ee[16]; float aa[16];
  if (slot < TOK) {
    unsigned bi = (unsigned)slot * 128u + (unsigned)q;
    asm volatile("" : "+v"(bi));
#pragma unroll
    for (int u = 0; u < 16; ++u) { ee[u] = eidx[bi + 8 * u]; aa[u] = aw[bi + 8 * u]; }
  }
  for (int tok = slot; tok < TOK; tok += nslot) {
    int ce[16]; float ca[16];
    float suma = 0.f;
#pragma unroll
    for (int u = 0; u < 16; ++u) { ce[u] = ee[u]; ca[u] = aa[u]; suma += aa[u]; }
    for (int gi = 0; gi < ngrp; ++gi) {
      const int grp = grp0 + gi;
      uint4 vv[16];
#pragma unroll
      for (int u = 0; u < 16; ++u) vv[u] = *(const uint4*)(V8 + (size_t)grp * (16384 * 128) + (size_t)ce[u] * 128 + c * 16);
      float* orow = p.out + (size_t)tok * 1024 + grp * 128 + c * 16;
      float4 x1v[4];
#pragma unroll
      for (int i = 0; i < 4; ++i) x1v[i] = *(const float4*)(orow + 4 * i);
      if (gi == ngrp - 1) {
        const int nt = (tok + nslot < TOK) ? tok + nslot : tok;
        unsigned bi = (unsigned)nt * 128u + (unsigned)q;
        asm volatile("" : "+v"(bi));
#pragma unroll
        for (int u = 0; u < 16; ++u) { ee[u] = eidx[bi + 8 * u]; aa[u] = aw[bi + 8 * u]; }
      }
      __builtin_amdgcn_sched_barrier(0);
      float acc[16];
#pragma unroll
      for (int i = 0; i < 16; ++i) acc[i] = -128.f * suma;
#pragma unroll
      for (int u = 0; u < 16; ++u) {
        float vf[16];
        cvt16u8(vv[u], vf);
#pragma unroll
        for (int i = 0; i < 16; ++i) acc[i] += ca[u] * vf[i];
        __builtin_amdgcn_sched_barrier(0);
      }
#pragma unroll
      for (int i = 0; i < 16; ++i) { acc[i] = add_xor8(acc[i]); acc[i] = add_xor16(acc[i]); acc[i] = add_xor32(acc[i]); }
      float ss = 0.f;
      if (q == 0) {
#pragma unroll
        for (int i = 0; i < 4; ++i) {
          const float4 oa = make_float4(x1v[i].x + acc[4 * i], x1v[i].y + acc[4 * i + 1], x1v[i].z + acc[4 * i + 2], x1v[i].w + acc[4 * i + 3]);
          *(float4*)(orow + 4 * i) = oa;
          ss += oa.x * oa.x + oa.y * oa.y + oa.z * oa.z + oa.w * oa.w;
        }
      }
      ss += __shfl_xor(ss, 1); ss += __shfl_xor(ss, 2); ss += __shfl_xor(ss, 4);
      if (lane == 0) atomicAdd(&ssq[tok], ss);
    }
  }
}

__device__ __forceinline__ void phase_final(const Params& p) {
  const float* ssq = (const float*)(p.ws + WS_SSQ);
  const int lane = threadIdx.x & 63, w = threadIdx.x >> 6;
  for (int row = blockIdx.x * 8 + w; row < TOK; row += gridDim.x * 8) {
    const float rstd = rsqrtf(ssq[row] * (1.f / DM) + EPSV);
    float4* o4 = (float4*)(p.out + (size_t)row * DM);
#pragma unroll
    for (int i = 0; i < 4; ++i) {
      float4 v = o4[lane + 64 * i];
      const float4 gg = ((const float4*)p.norm_final)[lane + 64 * i];
      v.x *= rstd * gg.x; v.y *= rstd * gg.y; v.z *= rstd * gg.z; v.w *= rstd * gg.w;
      o4[lane + 64 * i] = v;
    }
  }
}


__device__ __forceinline__ void phase_proj8(const Params& p, unsigned char* smem) {
  unsigned char* ws = p.ws;
  pg8::Gemm g{(const pg8::bf16_t*)(ws + WS_XN), (const pg8::bf16_t*)(ws + WS_WIN), TOK, 5120, 1024};
  pg8::StaticOrder S; S.init(TOK, 5120, (int)gridDim.x, (int)blockIdx.x);
  EpiProj E{(unsigned short*)(ws + WS_PH), (unsigned short*)(ws + WS_PA), (unsigned short*)(ws + WS_PG)};
  pg8::gemm_phase<EpiProj, pg8::StaticOrder>((PG8_LAS unsigned char*)smem, g, S, E, nullptr);
}
__device__ __forceinline__ void phase_ikln(const Params& p) {
  bf16_t* pA = (bf16_t*)(p.ws + WS_PA);
  const int tid = threadIdx.x, sub = tid & 7;
  float gam[8], bet[8];
#pragma unroll
  for (int i = 0; i < 8; ++i) { gam[i] = p.ikg[sub * 8 + i]; bet[i] = p.ikb[sub * 8 + i]; }
  for (int row = blockIdx.x * 64 + (tid >> 3); row < TOK; row += gridDim.x * 64) {
    uint4* ptr = (uint4*)(pA + (size_t)row * 1024 + 896 + sub * 8);
    const uint4 raw = *ptr;
    float v[8];
    cvt8(raw, v);
    float s = 0.f;
#pragma unroll
    for (int i = 0; i < 8; ++i) s += v[i];
    s += __shfl_xor(s, 1); s += __shfl_xor(s, 2); s += __shfl_xor(s, 4);
    const float mu = s * (1.f / 64.f);
    float q = 0.f;
#pragma unroll
    for (int i = 0; i < 8; ++i) { const float d = v[i] - mu; q += d * d; }
    q += __shfl_xor(q, 1); q += __shfl_xor(q, 2); q += __shfl_xor(q, 4);
    const float rstd = rsqrtf(q * (1.f / 64.f) + EPSV);
    uint4 o;
    o.x = pack2((v[0] - mu) * rstd * gam[0] + bet[0], (v[1] - mu) * rstd * gam[1] + bet[1]);
    o.y = pack2((v[2] - mu) * rstd * gam[2] + bet[2], (v[3] - mu) * rstd * gam[3] + bet[3]);
    o.z = pack2((v[4] - mu) * rstd * gam[4] + bet[4], (v[5] - mu) * rstd * gam[5] + bet[5]);
    o.w = pack2((v[6] - mu) * rstd * gam[6] + bet[6], (v[7] - mu) * rstd * gam[7] + bet[7]);
    *ptr = o;
  }
}
__device__ __forceinline__ void phase_up8(const Params& p, unsigned char* smem) {
  unsigned char* ws = p.ws;
  const pg8::bf16_t* ya = (const pg8::bf16_t*)(ws + WS_XN);
  const pg8::bf16_t* yb = ya + (size_t)TOK * 512;
  pg8::StaticOrder S; S.init(TOK, 1024, (int)gridDim.x, (int)blockIdx.x);
  {
    pg8::Gemm g{ya, (const pg8::bf16_t*)(ws + WS_WUPA), TOK, 1024, 512};
    EpiGate<0> E{(unsigned short*)(ws + WS_PH), (const unsigned short*)(ws + WS_PG), 0};
    pg8::gemm_phase<EpiGate<0>, pg8::StaticOrder>((PG8_LAS unsigned char*)smem, g, S, E, nullptr);
  }
  {
    pg8::Gemm g{yb, (const pg8::bf16_t*)(ws + WS_WUPB), TOK, 1024, 512};
    EpiGate<1> E{(unsigned short*)(ws + WS_PH), (const unsigned short*)(ws + WS_PG), 1024};
    pg8::gemm_phase<EpiGate<1>, pg8::StaticOrder>((PG8_LAS unsigned char*)smem, g, S, E, nullptr);
  }
}
__device__ __forceinline__ void phase_out8(const Params& p, unsigned char* smem) {
  unsigned char* ws = p.ws;
  pg8::Gemm g{(const pg8::bf16_t*)(ws + WS_PH), (const pg8::bf16_t*)(ws + WS_WOUT), TOK, 1024, 1024};
  pg8::StaticOrder S; S.init(TOK, 1024, (int)gridDim.x, (int)blockIdx.x);
  EpiResid E{p.out, p.x};
  pg8::gemm_phase<EpiResid, pg8::StaticOrder>((PG8_LAS unsigned char*)smem, g, S, E, nullptr);
}
__device__ __forceinline__ void phase_pq8(const Params& p, unsigned char* smem) {
  unsigned char* ws = p.ws;
  pg8::Gemm g{(const pg8::bf16_t*)(ws + WS_XN), (const pg8::bf16_t*)(ws + WS_WQ), TOK, 2048, 1024};
  pg8::StaticOrder S; S.init(TOK, 2048, (int)gridDim.x, (int)blockIdx.x);
  EpiStoreBf16 E{(unsigned short*)(ws + WS_PG), 2048};
  pg8::gemm_phase<EpiStoreBf16, pg8::StaticOrder>((PG8_LAS unsigned char*)smem, g, S, E, nullptr);
}

__global__ void __launch_bounds__(NTHREADS) hybrid_fwd(Params p) {
  extern __shared__ __attribute__((aligned(16))) unsigned char smem[];
#if ONE_LAUNCH
  cg::grid_group grid = cg::this_grid();
  volatile LAS unsigned* xst = (volatile LAS unsigned*)(smem + LDS_BYTES - 16);
  if (threadIdx.x == 0) { xst[0] = 0u; xst[1] = 0u; }
  __syncthreads();
  XcdBarrier xbar = xcd_barrier_post((unsigned*)(p.ws + WS_BAR), xst);
#define SEAM(k) do { if (p.ph_lo <= (k) && (k) + 1 < p.ph_hi) { if (p.ph_hi > NPHASE) grid.sync(); else xcd_barrier(xbar); } } while (0)
#else
#define SEAM(k) do { } while (0)
#endif
#define IN(k) (p.ph_lo <= (k) && (k) < p.ph_hi)
#ifndef REPEAT_PH
#define REPEAT_PH -1
#endif
#define REP(k, stmt) do { if (REPEAT_PH == (k)) { stmt; grid.sync(); } } while (0)
  if (IN(0)) { phase_prep(p, smem); SEAM(0); }
  if (IN(1)) { phase_proj8(p, smem); SEAM(1); }
  if (IN(2)) { phase_ikln(p); hgrn_h1_all(p, smem); SEAM(2); }
  if (IN(3)) { phase_mix(p, smem); SEAM(3); }
  if (IN(4)) { phase_up8(p, smem); SEAM(4); }
  if (IN(5)) { phase_out8(p, smem); SEAM(5); }
  if (IN(6)) { rmsnorm_rows_q(p.out, p.norm_ffn, (bf16_t*)(p.ws + WS_XN), p.ws + WS_XQ, (float*)(p.ws + WS_XS)); SEAM(6); }
  if (IN(7)) { phase_pq8(p, smem); SEAM(7); }
  if (IN(8)) { phase_pkeys(p, smem); SEAM(8); }
  if (IN(9)) { phase_pcomb(p, smem); SEAM(9); }
  if (IN(10)) { phase_pu(p, smem); SEAM(10); }
  if (IN(11)) { if (gridDim.x % 8 == 0) phase_pv_t<true>(p, smem); else phase_pv_t<false>(p, smem); SEAM(11); }
  if (IN(12)) { phase_final(p); }
#undef IN
#undef SEAM
}

extern "C" void kernel_launch(void* const* d_in, const int* in_sizes, int n_in, void* d_out, int out_size, void* d_ws, size_t ws_size,
                              hipStream_t stream) {
  static int grid = 0;
  if (grid == 0) {
    if (n_in != 17 || ws_size < WS_END) {
      fprintf(stderr, "kernel_launch: unexpected n_in %d or ws_size %zu (need %zu)\n", n_in, ws_size, (size_t)WS_END);
      grid = -1; return;
    }
    int dev = 0, cus = 0, per_cu = 0;
    hipGetDevice(&dev);
    hipDeviceGetAttribute(&cus, hipDeviceAttributeMultiprocessorCount, dev);
    hipFuncSetAttribute((const void*)hybrid_fwd, hipFuncAttributeMaxDynamicSharedMemorySize, LDS_BYTES);
    hipOccupancyMaxActiveBlocksPerMultiprocessor(&per_cu, (const void*)hybrid_fwd, NTHREADS, LDS_BYTES);
    if (per_cu < 1) { fprintf(stderr, "kernel_launch: occupancy query says %d blocks/CU\n", per_cu); per_cu = 1; }
    (void)hipGetLastError();
    grid = cus;
  }
  if (grid < 0) return;
  Params p{};
  p.x = (const float*)d_in[0]; p.norm_mix = (const float*)d_in[1]; p.w_in = (const float*)d_in[2]; p.hg_lb = (const float*)d_in[3];
  p.hg_norm = (const float*)d_in[4]; p.ikg = (const float*)d_in[5]; p.ikb = (const float*)d_in[6]; p.rel_bias = (const float*)d_in[7];
  p.w_up_a = (const float*)d_in[8]; p.w_up_b = (const float*)d_in[9]; p.w_out = (const float*)d_in[10]; p.norm_ffn = (const float*)d_in[11];
  p.peer_wq = (const float*)d_in[12]; p.peer_keys = (const float*)d_in[13]; p.peer_u = (const float*)d_in[14]; p.peer_v = (const float*)d_in[15];
  p.norm_final = (const float*)d_in[16];
  p.out = (float*)d_out; p.ws = (unsigned char*)d_ws;
#if ONE_LAUNCH
  hipMemsetAsync((unsigned char*)d_ws + WS_BAR, 0, 16384, stream);
  p.ph_lo = 0; p.ph_hi = NPHASE;
  void* args[] = {&p};
  hipError_t e = hipLaunchCooperativeKernel((const void*)hybrid_fwd, dim3(grid), dim3(NTHREADS), args, LDS_BYTES, stream);
  if (e != hipSuccess) fprintf(stderr, "cooperative launch failed: %s (grid %d)\n", hipGetErrorString(e), grid);
#else
  for (int ph = 0; ph < NPHASE; ++ph) {
    p.ph_lo = ph; p.ph_hi = ph + 1;
    hipLaunchKernelGGL(hybrid_fwd, dim3(grid), dim3(NTHREADS), LDS_BYTES, stream, p);
  }
#endif
}
```

```cpp
#include <hip/hip_runtime.h>
#include <hip/hip_cooperative_groups.h>
#include <stdint.h>
#include <stdio.h>
namespace cg = cooperative_groups;

#ifndef ONE_LAUNCH
#define ONE_LAUNCH 1
#endif

typedef unsigned short bf16_t;
typedef __attribute__((ext_vector_type(8))) short bf16x8;
typedef __attribute__((ext_vector_type(4))) float f32x4;

#define NTHREADS 512
#define TOK 32768
#define SEQL 4096
#define DM 1024
#define EPSV 1e-6f
#define NPHASE 13

#define WS_WIN   ((size_t)0)
#define WS_WUPA  (WS_WIN  + (size_t)5120 * 1024 * 2)
#define WS_WUPB  (WS_WUPA + (size_t)1024 * 512 * 2)
#define WS_WOUT  (WS_WUPB + (size_t)1024 * 512 * 2)
#define WS_WQ    (WS_WOUT + (size_t)1024 * 1024 * 2)
#define WS_KEYS  (WS_WQ   + (size_t)2048 * 1024 * 2)
#define WS_LB    (WS_KEYS + (size_t)2 * 8 * 128 * 128 * 2)
#define WS_U     (WS_LB   + (size_t)4096)
#define WS_V     (WS_U    + (size_t)16384 * 1024 * 2)
#define WS_XN    (WS_V    + (size_t)16384 * 1024 * 2)
#define WS_PH    (WS_XN   + (size_t)TOK * 1024 * 2)
#define WS_PA    (WS_PH   + (size_t)TOK * 2048 * 2)
#define WS_PG    (WS_PA   + (size_t)TOK * 1024 * 2)
#define WS_EIDX  (WS_PG   + (size_t)TOK * 2048 * 2)
#define WS_GW    (WS_EIDX + (size_t)TOK * 128 * 4)
#define WS_SSQ   (WS_GW   + (size_t)TOK * 128 * 4)
#define WS_XCC   (WS_SSQ  + (size_t)TOK * 4)
#define WS_BAR   (WS_XCC  + (size_t)4096)
#define WS_DEC   (WS_BAR  + (size_t)16384)
#define WS_QCTR  (WS_DEC  + (size_t)2048 * 384 * 4)
#define WS_END   (WS_QCTR + (size_t)1024)

#define WS_KC (WS_EIDX)
#define WS_VC (WS_KC + (size_t)TOK * 128)
#define WS_IKC (WS_VC + (size_t)TOK * 128)
#define LDS_BYTES 155648

struct Params {
  const float* x; const float* norm_mix; const float* w_in; const float* hg_lb; const float* hg_norm;
  const float* ikg; const float* ikb; const float* rel_bias; const float* w_up_a; const float* w_up_b;
  const float* w_out; const float* norm_ffn; const float* peer_wq; const float* peer_keys;
  const float* peer_u; const float* peer_v; const float* norm_final;
  float* out; unsigned char* ws; int ph_lo, ph_hi;
};

__device__ __forceinline__ float bf2f(bf16_t u) { return __uint_as_float(((unsigned)u) << 16); }
typedef float f32x2_cv __attribute__((ext_vector_type(2)));
typedef __bf16 bf16x2_cv __attribute__((ext_vector_type(2)));
__device__ __forceinline__ unsigned pack2(float a, float b) {
  const f32x2_cv v = {a, b};
  return __builtin_bit_cast(unsigned, __builtin_convertvector(v, bf16x2_cv));
}
__device__ __forceinline__ bf16_t f2bf(float f) { return (bf16_t)(pack2(f, f) & 0xffffu); }
__device__ __forceinline__ float wave_sum_slow(float v) {
#pragma unroll
  for (int o = 32; o > 0; o >>= 1) v += __shfl_xor(v, o);
  return v;
}
__device__ __forceinline__ void lds_fence() { asm volatile("s_waitcnt lgkmcnt(0)" ::: "memory"); }

__device__ __forceinline__ float add_xor8(float v) { return v + __int_as_float(__builtin_amdgcn_update_dpp(0, __float_as_int(v), 0x128, 0xf, 0xf, true)); }
__device__ __forceinline__ float add_xor16(float v) { const auto r = __builtin_amdgcn_permlane16_swap(__float_as_uint(v), __float_as_uint(v), false, false); return __uint_as_float(r[0]) + __uint_as_float(r[1]); }
__device__ __forceinline__ float add_xor32(float v) { const auto r = __builtin_amdgcn_permlane32_swap(__float_as_uint(v), __float_as_uint(v), false, false); return __uint_as_float(r[0]) + __uint_as_float(r[1]); }
__device__ __forceinline__ float max_xor16(float v) { const auto r = __builtin_amdgcn_permlane16_swap(__float_as_uint(v), __float_as_uint(v), false, false); return fmaxf(__uint_as_float(r[0]), __uint_as_float(r[1])); }
__device__ __forceinline__ float max_xor32(float v) { const auto r = __builtin_amdgcn_permlane32_swap(__float_as_uint(v), __float_as_uint(v), false, false); return fmaxf(__uint_as_float(r[0]), __uint_as_float(r[1])); }
__device__ __forceinline__ float wave_sum(float v) {
  v += __int_as_float(__builtin_amdgcn_update_dpp(0, __float_as_int(v), 0xB1, 0xf, 0xf, true));
  v += __int_as_float(__builtin_amdgcn_update_dpp(0, __float_as_int(v), 0x4E, 0xf, 0xf, true));
  v += __int_as_float(__builtin_amdgcn_update_dpp(0, __float_as_int(v), 0x141, 0xf, 0xf, true));
  v += __int_as_float(__builtin_amdgcn_update_dpp(0, __float_as_int(v), 0x140, 0xf, 0xf, true));
  return add_xor32(add_xor16(v));
}
__device__ __forceinline__ float sigmoidf_(float x) { return 1.f / (1.f + __expf(-x)); }
__device__ __forceinline__ float siluf_(float x) { return x / (1.f + __expf(-x)); }


#define XB_TMO      128
#define XB_XCNT(j)  (256  + 64 * (j))
#define XB_XSUB(j)  (1280 + 64 * (j))
#define XB_XGEN(j)  (2304 + 64 * (j))
#define XB_TOP      3328
#define XB_TOPGEN   3392
#define XCD_BAR_WORDS 3456
#define XB_SPIN_CAP (1u << 22)
#define LAS __attribute__((address_space(3)))
__device__ __forceinline__ unsigned xb_ld(unsigned* p)              { return __hip_atomic_load(p, __ATOMIC_RELAXED, __HIP_MEMORY_SCOPE_AGENT); }
__device__ __forceinline__ unsigned xb_add(unsigned* p, unsigned v) { return __hip_atomic_fetch_add(p, v, __ATOMIC_RELAXED, __HIP_MEMORY_SCOPE_AGENT); }
__device__ __forceinline__ unsigned xb_xcc_id() { return (unsigned)__builtin_amdgcn_s_getreg((3 << 11) | 20) & 0xFu; }
#define XB_SPIN(cond, bar) do { unsigned _sp = 0; while (cond) { __builtin_amdgcn_s_sleep(1); \
    if ((++_sp & 255u) == 0u) { if (xb_ld(&(bar)[XB_TMO])) break; if (_sp > XB_SPIN_CAP) { atomicAdd(&(bar)[XB_TMO], 1u); break; } } } } while (0)
struct XcdBarrier { unsigned* bar; unsigned x; volatile LAS unsigned* st; };
__device__ __forceinline__ XcdBarrier xcd_barrier_post(unsigned* bar, volatile LAS unsigned* st) {
  XcdBarrier b; b.bar = bar; b.x = xb_xcc_id(); b.st = st;
  if (threadIdx.x == 0) (void)xb_add(&bar[XB_XCNT(b.x)], 1u);
  return b;
}
__device__ __forceinline__ void xcd_barrier_complete(unsigned* bar, unsigned x, unsigned& nloc, unsigned& nx) {
  const unsigned G = gridDim.x * gridDim.y * gridDim.z;
  unsigned sum, cnt, mine, sp = 0u;
  for (;;) {
    sum = 0u; cnt = 0u; mine = 0u;
#pragma unroll
    for (unsigned j = 0; j < 16; ++j) { const unsigned c = xb_ld(&bar[XB_XCNT(j)]); sum += c; cnt += (c > 0u) ? 1u : 0u; mine = (j == x) ? c : mine; }
    if (sum == G) break;
    __builtin_amdgcn_s_sleep(1);
    if ((++sp & 255u) == 0u) { if (xb_ld(&bar[XB_TMO])) break; if (sp > XB_SPIN_CAP) { atomicAdd(&bar[XB_TMO], 1u); break; } }
  }
  nloc = mine > 0u ? mine : 1u; nx = cnt > 0u ? cnt : 1u;
}
__device__ __forceinline__ void xcd_barrier(const XcdBarrier& b) {
  asm volatile("s_waitcnt vmcnt(0)" ::: "memory");
  __syncthreads();
  if (threadIdx.x == 0) {
    unsigned* bar = b.bar;
    __builtin_amdgcn_s_waitcnt(0);
    unsigned nloc = b.st[0], nx = b.st[1];
    if (nloc == 0u) { xcd_barrier_complete(bar, b.x, nloc, nx); b.st[0] = nloc; b.st[1] = nx; }
    const unsigned old = xb_add(&bar[XB_XSUB(b.x)], 1u);
    const unsigned gen = old / nloc;
    if (old + 1u == (gen + 1u) * nloc) {
      __builtin_amdgcn_fence(__ATOMIC_RELEASE, "agent");
      asm volatile("s_waitcnt vmcnt(0)" ::: "memory");
      const unsigned og = xb_add(&bar[XB_TOP], 1u);
      const unsigned tg = og / nx;
      if (og + 1u == (tg + 1u) * nx) xb_add(&bar[XB_TOPGEN], 1u);
      else XB_SPIN(xb_ld(&bar[XB_TOPGEN]) == tg, bar);
      __builtin_amdgcn_fence(__ATOMIC_ACQUIRE, "agent");
      xb_add(&bar[XB_XGEN(b.x)], 1u);
      asm volatile("s_waitcnt vmcnt(0)" ::: "memory");
    } else {
      XB_SPIN(xb_ld(&bar[XB_XGEN(b.x)]) == gen, bar);
      __builtin_amdgcn_fence(__ATOMIC_ACQUIRE, "agent");
      asm volatile("s_waitcnt vmcnt(0)" ::: "memory");
    }
  }
  __syncthreads();
}

namespace pg8 {
#define PG8_LAS __attribute__((address_space(3)))
typedef unsigned short bf16_t;
typedef short bf16x8 __attribute__((ext_vector_type(8)));
typedef float f32x4 __attribute__((ext_vector_type(4)));
typedef unsigned u32x4 __attribute__((ext_vector_type(4)));
constexpr int BM = 256, BK = 64, HALF = 128, HTB = HALF * BK * 2  , STAGE_BYTES = 8 * HTB, NXCD = 8, WGM = 8;

__host__ __device__ __forceinline__ int lds_byte(int r, int c) { const int st = (r >> 4) * 2 + (c >> 5), rr = r & 15, cc = c & 31, ob = rr * 64 + cc * 2; return st * 1024 + (ob ^ (((ob >> 9) & 1) << 5)); }
__host__ __device__ __forceinline__ void stage_rc(int b, int& R, int& C) { const int st = b / 1024, sb = b % 1024, swz = sb ^ (((sb >> 9) & 1) << 5); R = (st >> 1) * 16 + swz / 64; C = (st & 1) * 32 + (swz % 64) / 2; }
__host__ __device__ __forceinline__ int perm32(int rho) { const int n = rho >> 4, i = rho & 15; return 8 * (i >> 2) + 4 * n + (i & 3); }

struct Unit { int pm, pn; };
struct Gemm { const bf16_t* A; const bf16_t* Bt; int M, N, K; };

struct StaticOrder {
    int nM, nN, nwg, G, c;
    __host__ __device__ void init(int M, int N, int G_, int c_) { nM = M / BM; nN = N / BM; nwg = nM * nN; G = G_; c = c_; }
    __host__ __device__ bool next(int i, Unit& u) const {
        const long L = (long)i * G + c; if (L >= nwg) return false;
        int wgid = (int)L; { const int q = nwg / NXCD, r = nwg % NXCD, xcd = wgid % NXCD, off = wgid / NXCD; wgid = (xcd < r ? xcd * (q + 1) : r * (q + 1) + (xcd - r) * q) + off; }
        const int nig = WGM * nN, gid = wgid / nig, fm = gid * WGM, gsz = (nM - fm) < WGM ? (nM - fm) : WGM;
        u.pm = fm + ((wgid % nig) % gsz); u.pn = (wgid % nig) / gsz; return true;
    }
    __device__ __forceinline__ void a_ready(const Unit&) const {}
    __device__ __forceinline__ void done(const Unit&) const {}
};
__device__ __forceinline__ unsigned cvt_pk_bf16(float lo, float hi) { unsigned r; asm volatile("v_cvt_pk_bf16_f32 %0, %1, %2" : "=v"(r) : "v"(lo), "v"(hi)); return r; }
template <class Epi, class Sched, bool STAMP = false>
__device__ __forceinline__ void gemm_phase(PG8_LAS unsigned char* lds, const Gemm g, const Sched& S, const Epi& E, unsigned long long* stamps) {
    const int tid = threadIdx.x, wid = __builtin_amdgcn_readfirstlane(tid >> 6), lane = tid & 63, wr = wid >> 2, wc = wid & 3, fr = lane & 15, fq = lane >> 4;
    const int K = g.K, nt = K / BK;
    int ts_lo = 0, ts_hi = 0, nts = 0; const unsigned long long rt_entry = STAMP ? (unsigned long long)wall_clock64() : 0ull;
#define PG8_STAMP() do { if (STAMP && wid == 0 && nts < 64) { const unsigned long long _c = (unsigned long long)clock64(); \
        ts_lo = (lane == nts) ? (int)(unsigned)_c : ts_lo; ts_hi = (lane == nts) ? (int)(unsigned)(_c >> 32) : ts_hi; ++nts; } } while (0)
    PG8_STAMP();
    unsigned voffA[2], voffB[2];
#pragma unroll
    for (int i = 0; i < 2; ++i) { int R, C; stage_rc(tid * 16 + i * 8192, R, C); const int Rb = Epi::PERM ? ((R & ~31) + perm32(R & 31)) : R;
        voffA[i] = (unsigned)(R * K + C) * 2u; voffB[i] = (unsigned)(Rb * K + C) * 2u; }
    const size_t kstep = (size_t)(BK * 2);
    const size_t hstep = (size_t)HALF * K * 2;
    const size_t tstep = 2 * hstep;
    const unsigned ldsw = (unsigned)wid * 1024u;
    const int aoff = lds_byte(wr * 64 + fr, fq * 8), boff = lds_byte(wc * 32 + fr, fq * 8);
#define PG8_SA(b, h) (((b) * 2 + (h)) * HTB)
#define PG8_SB(b, h) ((4 + (b) * 2 + (h)) * HTB)
#define PG8_STAGE(bufoff, gbase, voff) do { _Pragma("unroll") for (int _i = 0; _i < 2; ++_i) \
        __builtin_amdgcn_global_load_lds((const unsigned*)((const char*)(gbase) + (voff)[_i]), (PG8_LAS unsigned*)(lds + (bufoff) + ldsw + _i * 8192), 16, 0, 0); } while (0)
#define PG8_LDA(dst, b, h) do { _Pragma("unroll") for (int m = 0; m < 4; ++m) _Pragma("unroll") for (int k = 0; k < 2; ++k) dst[m][k] = *(const PG8_LAS bf16x8*)(lds + PG8_SA(b, h) + aoff + m * 2048 + k * 1024); } while (0)
#define PG8_LDB(dst, b, h) do { _Pragma("unroll") for (int n = 0; n < 2; ++n) _Pragma("unroll") for (int k = 0; k < 2; ++k) dst[n][k] = *(const PG8_LAS bf16x8*)(lds + PG8_SB(b, h) + boff + n * 2048 + k * 1024); } while (0)
#define PG8_MMA(ai, bj, At, Bt) do { __builtin_amdgcn_s_setprio(1); _Pragma("unroll") for (int m = 0; m < 4; ++m) _Pragma("unroll") for (int n = 0; n < 2; ++n) _Pragma("unroll") for (int k = 0; k < 2; ++k) \
        acc[ai][bj][m][n] = __builtin_amdgcn_mfma_f32_16x16x32_bf16(Bt[n][k], At[m][k], acc[ai][bj][m][n], 0, 0, 0); __builtin_amdgcn_s_setprio(0); } while (0)
#define PG8_WAIT_V(n) asm volatile("s_waitcnt vmcnt(" #n ")" ::: "memory")
#define PG8_WAIT_L(n) asm volatile("s_waitcnt lgkmcnt(" #n ")" ::: "memory")
#define PG8_BAR __builtin_amdgcn_s_barrier()
#define PG8_SCHED __builtin_amdgcn_sched_barrier(0)
    Unit cur, nxt; int ui = 0;
    if (!S.next(0, cur)) return;
    f32x4 acc[2][2][4][2];
#pragma unroll
    for (int a = 0; a < 2; ++a)
#pragma unroll
        for (int b = 0; b < 2; ++b)
#pragma unroll
            for (int m = 0; m < 4; ++m)
#pragma unroll
                for (int n = 0; n < 2; ++n) acc[a][b][m][n] = (f32x4){0.f, 0.f, 0.f, 0.f};
    bf16x8 At[4][2], B0[2][2], B1[2][2];
    const char* cA = (const char*)g.A + (size_t)cur.pm * tstep; const char* cB = (const char*)g.Bt + (size_t)cur.pn * tstep;
    S.a_ready(cur);
    PG8_STAGE(PG8_SB(0, 0), cB, voffB); PG8_STAGE(PG8_SA(0, 0), cA, voffA); PG8_STAGE(PG8_SB(0, 1), cB + hstep, voffB); PG8_STAGE(PG8_SA(0, 1), cA + hstep, voffA);
    if (wr == 1) PG8_BAR;
    PG8_WAIT_V(4); PG8_BAR;
    PG8_STAGE(PG8_SB(1, 0), cB + kstep, voffB); PG8_STAGE(PG8_SA(1, 0), cA + kstep, voffA); PG8_STAGE(PG8_SB(1, 1), cB + hstep + kstep, voffB);
    PG8_WAIT_V(6); PG8_BAR;
    PG8_STAMP();
    for (;;) {
        const bool has_next = S.next(ui + 1, nxt);
        const char* nA = has_next ? (const char*)g.A + (size_t)nxt.pm * tstep : cA; const char* nB = has_next ? (const char*)g.Bt + (size_t)nxt.pn * tstep : cB;
        for (int t = 0; t < nt; t += 2) {
            const bool last = (t == nt - 2);
            const char* a1 = cA + (size_t)(t + 1) * kstep;
            const char* a2 = last ? nA : cA + (size_t)(t + 2) * kstep; const char* b2 = last ? nB : cB + (size_t)(t + 2) * kstep;
            const char* a3 = a2 + kstep; const char* b3 = b2 + kstep;
            if (last && has_next) S.a_ready(nxt);
            PG8_LDB(B0, 0, 0); PG8_SCHED; PG8_LDA(At, 0, 0); PG8_STAGE(PG8_SA(1, 1), a1 + hstep, voffA);
            PG8_WAIT_L(8); PG8_BAR; PG8_WAIT_L(0); PG8_MMA(0, 0, At, B0); PG8_BAR; PG8_SCHED;
            PG8_LDB(B1, 0, 1); PG8_STAGE(PG8_SB(0, 0), b2, voffB);
            PG8_BAR; PG8_WAIT_L(0); PG8_MMA(0, 1, At, B1); PG8_BAR;
            PG8_LDA(At, 0, 1); PG8_STAGE(PG8_SA(0, 0), a2, voffA);
            PG8_BAR; PG8_WAIT_L(0); PG8_MMA(1, 0, At, B0); PG8_BAR; PG8_SCHED;
            PG8_STAGE(PG8_SB(0, 1), b2 + hstep, voffB);
            PG8_WAIT_V(6); PG8_BAR; PG8_MMA(1, 1, At, B1); PG8_BAR;
            PG8_LDB(B0, 1, 0); PG8_SCHED; PG8_LDA(At, 1, 0); PG8_STAGE(PG8_SA(0, 1), a2 + hstep, voffA);
            PG8_WAIT_L(8); PG8_BAR; PG8_WAIT_L(0); PG8_MMA(0, 0, At, B0); PG8_BAR; PG8_SCHED;
            PG8_LDB(B1, 1, 1); PG8_STAGE(PG8_SB(1, 0), b3, voffB);
            PG8_BAR; PG8_WAIT_L(0); PG8_MMA(0, 1, At, B1); PG8_BAR;
            PG8_LDA(At, 1, 1); PG8_STAGE(PG8_SA(1, 0), a3, voffA);
            PG8_BAR; PG8_WAIT_L(0); PG8_MMA(1, 0, At, B0); PG8_BAR; PG8_SCHED;
            PG8_STAGE(PG8_SB(1, 1), b3 + hstep, voffB);
            PG8_WAIT_V(6); PG8_BAR; PG8_MMA(1, 1, At, B1); PG8_BAR;
        }
        PG8_STAMP();
        if constexpr (!Epi::AFTER_DRAIN) { E(acc, cur, wr, wc, fr, fq); S.done(cur); }
        PG8_STAMP();
        if (!has_next) break;
#pragma unroll
        for (int a = 0; a < 2; ++a)
#pragma unroll
            for (int b = 0; b < 2; ++b)
#pragma unroll
                for (int m = 0; m < 4; ++m)
#pragma unroll
                    for (int n = 0; n < 2; ++n) acc[a][b][m][n] = (f32x4){0.f, 0.f, 0.f, 0.f};
        cur = nxt; cA = nA; cB = nB; ++ui;
    }
    PG8_WAIT_V(0);
    if (wr == 0) PG8_BAR;
    PG8_BAR;
    if constexpr (Epi::AFTER_DRAIN) { E.fused(acc, cur, wr, wc, fr, fq, lds, wid, lane); S.done(cur); }
    PG8_STAMP();
    if (STAMP && wid == 0) { stamps[lane] = lane < nts ? (((unsigned long long)(unsigned)ts_hi << 32) | (unsigned)ts_lo) : 0ull;
        if (lane == 62) stamps[62] = rt_entry; if (lane == 63) stamps[63] = (unsigned long long)wall_clock64(); }
#undef PG8_STAMP
#undef PG8_SA
#undef PG8_SB
#undef PG8_STAGE
#undef PG8_LDA
#undef PG8_LDB
#undef PG8_MMA
#undef PG8_WAIT_V
#undef PG8_WAIT_L
#undef PG8_BAR
#undef PG8_SCHED
}
}

struct EpiProj {
  static constexpr bool PERM = true, AFTER_DRAIN = false;
  unsigned short* pH; unsigned short* pA; unsigned short* pG; unsigned short* kc; unsigned short* vc; unsigned short* ikc;
  __device__ __forceinline__ void operator()(const pg8::f32x4 (&acc)[2][2][4][2], const pg8::Unit& u, int wr, int wc, int fr, int fq) const {
    const int row0 = u.pm * 256 + wr * 64 + fr;
    unsigned short* base; int ldc, colt; bool sg = false;
    if (u.pn < 8) { base = pH; ldc = 2048; colt = u.pn * 256; }
    else if (u.pn < 12) { base = pA; ldc = 1024; colt = (u.pn - 8) * 256; }
    else { base = pG; ldc = 2048; colt = (u.pn - 12) * 256; sg = true; }
    const int col0 = colt + wc * 32 + 8 * fq;
#pragma unroll
    for (int ai = 0; ai < 2; ++ai)
#pragma unroll
      for (int m = 0; m < 4; ++m) {
        unsigned short* rowp = base + (size_t)(row0 + ai * 128 + m * 16) * ldc + col0;
#pragma unroll
        for (int bj = 0; bj < 2; ++bj) {
          pg8::f32x4 v0 = acc[ai][bj][m][0], v1 = acc[ai][bj][m][1];
          if (sg) {
#pragma unroll
            for (int j = 0; j < 4; ++j) { v0[j] = sigmoidf_(v0[j]); v1[j] = sigmoidf_(v1[j]); }
          }
          pg8::u32x4 w; w.x = pg8::cvt_pk_bf16(v0[0], v0[1]); w.y = pg8::cvt_pk_bf16(v0[2], v0[3]); w.z = pg8::cvt_pk_bf16(v1[0], v1[1]); w.w = pg8::cvt_pk_bf16(v1[2], v1[3]);
          unsigned short* dst = rowp + bj * 128;
          if (u.pn == 10 || u.pn == 11) {
            const int cs = col0 + bj * 128;
            const size_t r = (size_t)(row0 + ai * 128 + m * 16);
            if (cs >= 512 && cs < 576) dst = kc + r * 64 + (cs - 512);
            else if (cs >= 576 && cs < 640) dst = vc + r * 64 + (cs - 576);
            else if (cs >= 896 && cs < 960) dst = ikc + r * 64 + (cs - 896);
          }
          *(pg8::u32x4*)dst = w;
        }
      }
  }
};
template <int MODE> struct EpiGate {
  static constexpr bool PERM = true, AFTER_DRAIN = false;
  unsigned short* hb; const unsigned short* pG; int goff;
  __device__ __forceinline__ void operator()(const pg8::f32x4 (&acc)[2][2][4][2], const pg8::Unit& u, int wr, int wc, int fr, int fq) const {
    const int row0 = u.pm * 256 + wr * 64 + fr;
    const int col0 = u.pn * 256 + wc * 32 + 8 * fq;
#pragma unroll
    for (int ai = 0; ai < 2; ++ai)
#pragma unroll
      for (int m = 0; m < 4; ++m) {
        const size_t r = (size_t)(row0 + ai * 128 + m * 16);
        pg8::u32x4 gv[2], hv[2];
#pragma unroll
        for (int bj = 0; bj < 2; ++bj) {
          gv[bj] = *(const pg8::u32x4*)(pG + r * 2048 + goff + col0 + bj * 128);
          if (MODE == 1) hv[bj] = *(const pg8::u32x4*)(hb + r * 1024 + col0 + bj * 128);
        }
#pragma unroll
        for (int bj = 0; bj < 2; ++bj) {
          float o[8];
#pragma unroll
          for (int j = 0; j < 4; ++j) {
            const unsigned gw0 = gv[bj][j >> 1], gw1 = gv[bj][2 + (j >> 1)];
            const float g0 = (j & 1) ? __uint_as_float(gw0 & 0xffff0000u) : __uint_as_float(gw0 << 16);
            const float g1 = (j & 1) ? __uint_as_float(gw1 & 0xffff0000u) : __uint_as_float(gw1 << 16);
            o[j] = acc[ai][bj][m][0][j] * g0; o[4 + j] = acc[ai][bj][m][1][j] * g1;
            if (MODE == 1) {
              const unsigned hw0 = hv[bj][j >> 1], hw1 = hv[bj][2 + (j >> 1)];
              o[j] += (j & 1) ? __uint_as_float(hw0 & 0xffff0000u) : __uint_as_float(hw0 << 16);
              o[4 + j] += (j & 1) ? __uint_as_float(hw1 & 0xffff0000u) : __uint_as_float(hw1 << 16);
            }
          }
          pg8::u32x4 w; w.x = pg8::cvt_pk_bf16(o[0], o[1]); w.y = pg8::cvt_pk_bf16(o[2], o[3]); w.z = pg8::cvt_pk_bf16(o[4], o[5]); w.w = pg8::cvt_pk_bf16(o[6], o[7]);
          *(pg8::u32x4*)(hb + r * 1024 + col0 + bj * 128) = w;
        }
      }
  }
};
struct EpiResid {
  static constexpr bool PERM = false, AFTER_DRAIN = false;
  float* out; const float* x;
  __device__ __forceinline__ void operator()(const pg8::f32x4 (&acc)[2][2][4][2], const pg8::Unit& u, int wr, int wc, int fr, int fq) const {
    const int row0 = u.pm * 256 + wr * 64 + fr, col0 = u.pn * 256 + wc * 32 + 4 * fq;
#pragma unroll
    for (int ai = 0; ai < 2; ++ai)
#pragma unroll
      for (int m = 0; m < 4; ++m) {
        const size_t off = (size_t)(row0 + ai * 128 + m * 16) * 1024 + col0;
        pg8::f32x4 xv[2][2];
#pragma unroll
        for (int bj = 0; bj < 2; ++bj)
#pragma unroll
          for (int n = 0; n < 2; ++n) xv[bj][n] = *(const pg8::f32x4*)(x + off + bj * 128 + n * 16);
#pragma unroll
        for (int bj = 0; bj < 2; ++bj)
#pragma unroll
          for (int n = 0; n < 2; ++n) *(pg8::f32x4*)(out + off + bj * 128 + n * 16) = acc[ai][bj][m][n] + xv[bj][n];
      }
  }
};
struct EpiStoreBf16 {
  static constexpr bool PERM = true, AFTER_DRAIN = false;
  unsigned short* O; int ldc;
  __device__ __forceinline__ void operator()(const pg8::f32x4 (&acc)[2][2][4][2], const pg8::Unit& u, int wr, int wc, int fr, int fq) const {
    const int row0 = u.pm * 256 + wr * 64 + fr, col0 = u.pn * 256 + wc * 32 + 8 * fq;
#pragma unroll
    for (int ai = 0; ai < 2; ++ai)
#pragma unroll
      for (int m = 0; m < 4; ++m) {
        unsigned short* rowp = O + (size_t)(row0 + ai * 128 + m * 16) * ldc + col0;
#pragma unroll
        for (int bj = 0; bj < 2; ++bj) {
          const pg8::f32x4 v0 = acc[ai][bj][m][0], v1 = acc[ai][bj][m][1];
          pg8::u32x4 w; w.x = pg8::cvt_pk_bf16(v0[0], v0[1]); w.y = pg8::cvt_pk_bf16(v0[2], v0[3]); w.z = pg8::cvt_pk_bf16(v1[0], v1[1]); w.w = pg8::cvt_pk_bf16(v1[2], v1[3]);
          *(pg8::u32x4*)(rowp + bj * 128) = w;
        }
      }
  }
};

__device__ __forceinline__ void gemm_tile(const bf16_t* __restrict__ A, int lda, const bf16_t* __restrict__ Bt, int ldb,
                                          int nk, f32x4 (&acc)[4][4], unsigned char* smem) {
  const int tid = threadIdx.x, lane = tid & 63, w = tid >> 6, wm = w >> 1, wn = w & 1, l15 = lane & 15, g = lane >> 4;
  unsigned char* sA = smem;
  unsigned char* sB = smem + 32768;
  const int lr = tid >> 3, lc = tid & 7;
  const bf16_t* ga = A + (size_t)lr * lda + lc * 8;
  const bf16_t* gb = Bt + (size_t)lr * ldb + lc * 8;
  uint4 ra0, ra1, ra2, ra3, rb0, rb1;
  ra0 = *(const uint4*)(ga);
  ra1 = *(const uint4*)(ga + (size_t)64 * lda);
  ra2 = *(const uint4*)(ga + (size_t)128 * lda);
  ra3 = *(const uint4*)(ga + (size_t)192 * lda);
  rb0 = *(const uint4*)(gb);
  rb1 = *(const uint4*)(gb + (size_t)64 * ldb);
  const int sw = (lc ^ (lr & 7)) << 4;
  for (int kt = 0; kt < nk; ++kt) {
    __syncthreads();
    *(uint4*)(sA + (lr) * 128 + sw) = ra0;
    *(uint4*)(sA + (lr + 64) * 128 + sw) = ra1;
    *(uint4*)(sA + (lr + 128) * 128 + sw) = ra2;
    *(uint4*)(sA + (lr + 192) * 128 + sw) = ra3;
    *(uint4*)(sB + (lr) * 128 + sw) = rb0;
    *(uint4*)(sB + (lr + 64) * 128 + sw) = rb1;
    __syncthreads();
    if (kt + 1 < nk) {
      const int ko = (kt + 1) * 64;
      ra0 = *(const uint4*)(ga + ko);
      ra1 = *(const uint4*)(ga + (size_t)64 * lda + ko);
      ra2 = *(const uint4*)(ga + (size_t)128 * lda + ko);
      ra3 = *(const uint4*)(ga + (size_t)192 * lda + ko);
      rb0 = *(const uint4*)(gb + ko);
      rb1 = *(const uint4*)(gb + (size_t)64 * ldb + ko);
    }
#pragma unroll
    for (int ks = 0; ks < 2; ++ks) {
      bf16x8 a[4], b[4];
#pragma unroll
      for (int m = 0; m < 4; ++m) { const int r = wm * 64 + m * 16 + l15; a[m] = *(const bf16x8*)(sA + r * 128 + (((ks * 4 + g) ^ (r & 7)) << 4)); }
#pragma unroll
      for (int n = 0; n < 4; ++n) { const int r = wn * 64 + n * 16 + l15; b[n] = *(const bf16x8*)(sB + r * 128 + (((ks * 4 + g) ^ (r & 7)) << 4)); }
#pragma unroll
      for (int m = 0; m < 4; ++m)
#pragma unroll
        for (int n = 0; n < 4; ++n) acc[m][n] = __builtin_amdgcn_mfma_f32_16x16x32_bf16(a[m], b[n], acc[m][n], 0, 0, 0);
    }
  }
}

__device__ __forceinline__ void zero_acc(f32x4 (&acc)[4][4]) {
#pragma unroll
  for (int m = 0; m < 4; ++m)
#pragma unroll
    for (int n = 0; n < 4; ++n) acc[m][n] = (f32x4){0.f, 0.f, 0.f, 0.f};
}

__device__ __forceinline__ void transpose_tile(const float* __restrict__ src, int srcN, bf16_t* __restrict__ dst, int K, int n0, int k0,
                                               bool winmap, float* tile) {
  const int tid = threadIdx.x;
  const int nc = tid & 63, kr = tid >> 6;
  int ncol = n0 + nc; bool valid = true;
  if (winmap) { if (ncol >= 3072) ncol -= 60; else if (ncol >= 3012) valid = false; }
#pragma unroll
  for (int i = 0; i < 8; ++i) {
    const int k = kr + 8 * i;
    tile[k * 65 + nc] = valid ? src[(size_t)(k0 + k) * srcN + ncol] : 0.f;
  }
  __syncthreads();
#pragma unroll
  for (int i = 0; i < 8; ++i) {
    const int nr = kr + 8 * i;
    dst[(size_t)(n0 + nr) * K + k0 + nc] = f2bf(tile[nc * 65 + nr]);
  }
  __syncthreads();
}

__device__ __forceinline__ void convert_f32_bf16(const float* __restrict__ src, bf16_t* __restrict__ dst, size_t n4) {
  for (size_t i = (size_t)blockIdx.x * NTHREADS + threadIdx.x; i < n4; i += (size_t)gridDim.x * NTHREADS) {
    const float4 v = ((const float4*)src)[i];
    uint2 o; o.x = pack2(v.x, v.y); o.y = pack2(v.z, v.w);
    ((uint2*)dst)[i] = o;
  }
}

template <bool SLICE_MAJOR, bool SIGNED>
__device__ __forceinline__ void quantize_rows_u8(const float* __restrict__ src, unsigned char* __restrict__ dst, float* __restrict__ scale, int row_lo, int row_hi) {
  const int lane = threadIdx.x & 63, w = threadIdx.x >> 6;
  for (int row = row_lo + w; row < row_hi; row += 8) {
    const float4* s4 = (const float4*)(src + (size_t)row * 1024) + lane * 4;
    float4 v[4];
    float am = 0.f;
#pragma unroll
    for (int i = 0; i < 4; ++i) { v[i] = s4[i]; am = fmaxf(am, fmaxf(fmaxf(fabsf(v[i].x), fabsf(v[i].y)), fmaxf(fabsf(v[i].z), fabsf(v[i].w)))); }
#pragma unroll
    for (int o = 32; o > 0; o >>= 1) am = fmaxf(am, __shfl_xor(am, o));
    const float inv = am > 0.f ? 127.f / am : 0.f;
    unsigned pk[4];
#pragma unroll
    for (int i = 0; i < 4; ++i) {
      const int ofs = SIGNED ? 0 : 128;
      const unsigned b0 = (unsigned)((int)rintf(v[i].x * inv) + ofs), b1 = (unsigned)((int)rintf(v[i].y * inv) + ofs);
      const unsigned b2 = (unsigned)((int)rintf(v[i].z * inv) + ofs), b3 = (unsigned)((int)rintf(v[i].w * inv) + ofs);
      pk[i] = (b0 & 255u) | ((b1 & 255u) << 8) | ((b2 & 255u) << 16) | ((b3 & 255u) << 24);
    }
    if (SLICE_MAJOR) *(uint4*)(dst + (size_t)(lane >> 3) * (16384 * 128) + (size_t)row * 128 + (lane & 7) * 16) = make_uint4(pk[0], pk[1], pk[2], pk[3]);
    else *(uint4*)(dst + (size_t)row * 1024 + lane * 16) = make_uint4(pk[0], pk[1], pk[2], pk[3]);
    if (lane == 0) scale[row] = am * (1.f / 127.f);
  }
}

#define WS_XQ (WS_PH + (size_t)TOK * 1024 * 2)
#define WS_XS (WS_XQ + (size_t)TOK * 1024)
__device__ __forceinline__ void rmsnorm_rows_q(const float* __restrict__ src, const float* __restrict__ g, bf16_t* __restrict__ dst,
                                               unsigned char* __restrict__ xq, float* __restrict__ xs) {
  const int lane = threadIdx.x & 63, w = threadIdx.x >> 6;
  for (int row = blockIdx.x * 8 + w; row < TOK; row += gridDim.x * 8) {
    const float4* s4 = (const float4*)(src + (size_t)row * DM) + lane * 4;
    const float4* g4 = (const float4*)g + lane * 4;
    float v[16]; float ss = 0.f;
#pragma unroll
    for (int i = 0; i < 4; ++i) { const float4 t = s4[i]; v[4 * i] = t.x; v[4 * i + 1] = t.y; v[4 * i + 2] = t.z; v[4 * i + 3] = t.w; ss += t.x * t.x + t.y * t.y + t.z * t.z + t.w * t.w; }
    ss = wave_sum(ss);
    const float rstd = rsqrtf(ss * (1.f / DM) + EPSV);
    float am = 0.f;
#pragma unroll
    for (int i = 0; i < 4; ++i) { const float4 gg = g4[i]; v[4 * i] *= rstd * gg.x; v[4 * i + 1] *= rstd * gg.y; v[4 * i + 2] *= rstd * gg.z; v[4 * i + 3] *= rstd * gg.w; }
#pragma unroll
    for (int i = 0; i < 16; ++i) am = fmaxf(am, fabsf(v[i]));
#pragma unroll
    for (int o = 32; o > 0; o >>= 1) am = fmaxf(am, __shfl_xor(am, o));
    const float inv = am > 0.f ? 127.f / am : 0.f;
    uint4 ob0, ob1;
    ob0.x = pack2(v[0], v[1]); ob0.y = pack2(v[2], v[3]); ob0.z = pack2(v[4], v[5]); ob0.w = pack2(v[6], v[7]);
    ob1.x = pack2(v[8], v[9]); ob1.y = pack2(v[10], v[11]); ob1.z = pack2(v[12], v[13]); ob1.w = pack2(v[14], v[15]);
    *(uint4*)(dst + (size_t)row * DM + lane * 16) = ob0;
    *(uint4*)(dst + (size_t)row * DM + lane * 16 + 8) = ob1;
    unsigned pk[4];
#pragma unroll
    for (int i = 0; i < 4; ++i) {
      const unsigned b0 = (unsigned)(int)rintf(v[4 * i] * inv) & 255u, b1 = (unsigned)(int)rintf(v[4 * i + 1] * inv) & 255u;
      const unsigned b2 = (unsigned)(int)rintf(v[4 * i + 2] * inv) & 255u, b3 = (unsigned)(int)rintf(v[4 * i + 3] * inv) & 255u;
      pk[i] = b0 | (b1 << 8) | (b2 << 16) | (b3 << 24);
    }
    *(uint4*)(xq + (size_t)row * 1024 + lane * 16) = make_uint4(pk[0], pk[1], pk[2], pk[3]);
    if (lane == 0) xs[row] = am * (1.f / 127.f);
  }
}

__device__ __forceinline__ void rmsnorm_rows(const float* __restrict__ src, const float* __restrict__ g, bf16_t* __restrict__ dst) {
  const int lane = threadIdx.x & 63, w = threadIdx.x >> 6;
  for (int row = blockIdx.x * 8 + w; row < TOK; row += gridDim.x * 8) {
    const float4* s4 = (const float4*)(src + (size_t)row * DM);
    float4 v[4]; float ss = 0.f;
#pragma unroll
    for (int i = 0; i < 4; ++i) { v[i] = s4[lane + 64 * i]; ss += v[i].x * v[i].x + v[i].y * v[i].y + v[i].z * v[i].z + v[i].w * v[i].w; }
    ss = wave_sum(ss);
    const float rstd = rsqrtf(ss * (1.f / DM) + EPSV);
#pragma unroll
    for (int i = 0; i < 4; ++i) {
      const float4 gg = ((const float4*)g)[lane + 64 * i];
      uint2 o; o.x = pack2(v[i].x * rstd * gg.x, v[i].y * rstd * gg.y); o.y = pack2(v[i].z * rstd * gg.z, v[i].w * rstd * gg.w);
      ((uint2*)(dst + (size_t)row * DM))[lane + 64 * i] = o;
    }
  }
}

__device__ __forceinline__ void phase_prep(const Params& p, unsigned char* smem) {
  unsigned char* ws = p.ws;
  float* tile = (float*)smem;
  const int n_win = 80 * 16, n_ua = 16 * 8, n_ub = 16 * 8, n_wo = 16 * 16, n_wq = 32 * 16;
  const int total = n_win + n_ua + n_ub + n_wo + n_wq;
  for (int it = blockIdx.x; it < total; it += gridDim.x) {
    int t = it;
    if (t < n_win) { transpose_tile(p.w_in, 5060, (bf16_t*)(ws + WS_WIN), 1024, (t >> 4) * 64, (t & 15) * 64, true, tile); continue; }
    t -= n_win;
    if (t < n_ua) { transpose_tile(p.w_up_a, 1024, (bf16_t*)(ws + WS_WUPA), 512, (t >> 3) * 64, (t & 7) * 64, false, tile); continue; }
    t -= n_ua;
    if (t < n_ub) { transpose_tile(p.w_up_b, 1024, (bf16_t*)(ws + WS_WUPB), 512, (t >> 3) * 64, (t & 7) * 64, false, tile); continue; }
    t -= n_ub;
    if (t < n_wo) { transpose_tile(p.w_out, 1024, (bf16_t*)(ws + WS_WOUT), 1024, (t >> 4) * 64, (t & 15) * 64, false, tile); continue; }
    t -= n_wo;
    transpose_tile(p.peer_wq, 2048, (bf16_t*)(ws + WS_WQ), 1024, (t >> 4) * 64, (t & 15) * 64, false, tile);
  }
  convert_f32_bf16(p.peer_keys, (bf16_t*)(ws + WS_KEYS), (size_t)2 * 8 * 128 * 128 / 4);
  for (int i = blockIdx.x * NTHREADS + threadIdx.x; i < TOK; i += gridDim.x * NTHREADS) ((float*)(ws + WS_SSQ))[i] = 0.f;
  if (threadIdx.x == 0) ((int*)(ws + WS_XCC))[blockIdx.x] = (int)(__builtin_amdgcn_s_getreg((3 << 11) | 20) & 0xFu);
  if (blockIdx.x == 0 && threadIdx.x < 8) ((unsigned*)(ws + WS_QCTR))[16 * threadIdx.x] = 0u;
  if (blockIdx.x == 0) {
    const int i = threadIdx.x;
    const float a0 = p.hg_lb[i], a1 = p.hg_lb[512 + i];
    ((float*)(ws + WS_LB))[i] = 1.f / (1.f + expf(a1 - a0));
  }
  rmsnorm_rows(p.x, p.norm_mix, (bf16_t*)(ws + WS_XN));
}

__device__ __forceinline__ void phase_proj(const Params& p, unsigned char* smem) {
  unsigned char* ws = p.ws;
  const bf16_t* xn = (const bf16_t*)(ws + WS_XN);
  const bf16_t* wt = (const bf16_t*)(ws + WS_WIN);
  bf16_t* pH = (bf16_t*)(ws + WS_PH);
  bf16_t* pA = (bf16_t*)(ws + WS_PA);
  bf16_t* pG = (bf16_t*)(ws + WS_PG);
  const int tid = threadIdx.x, lane = tid & 63, w = tid >> 6, wm = w >> 1, wn = w & 1, l15 = lane & 15, g = lane >> 4;
  for (int tile = blockIdx.x; tile < 128 * 40; tile += gridDim.x) {
    const int tn = tile % 40, tm = tile / 40;
    f32x4 acc[4][4]; zero_acc(acc);
    gemm_tile(xn + (size_t)tm * 256 * 1024, 1024, wt + (size_t)tn * 128 * 1024, 1024, 16, acc, smem);
    const int rbase = tm * 256 + wm * 64 + 4 * g;
    const int cbase = tn * 128 + wn * 64 + l15;
    if (tn < 16) {
#pragma unroll
      for (int m = 0; m < 4; ++m)
#pragma unroll
        for (int n = 0; n < 4; ++n)
#pragma unroll
          for (int j = 0; j < 4; ++j) pH[(size_t)(rbase + m * 16 + j) * 2048 + cbase + n * 16] = f2bf(acc[m][n][j]);
    } else if (tn < 24) {
      if (tn == 23 && wn == 0) {
        float gam[4], bet[4];
#pragma unroll
        for (int n = 0; n < 4; ++n) { gam[n] = p.ikg[n * 16 + l15]; bet[n] = p.ikb[n * 16 + l15]; }
#pragma unroll
        for (int m = 0; m < 4; ++m)
#pragma unroll
          for (int j = 0; j < 4; ++j) {
            float s = acc[m][0][j] + acc[m][1][j] + acc[m][2][j] + acc[m][3][j];
            s += __shfl_xor(s, 1); s += __shfl_xor(s, 2); s += __shfl_xor(s, 4); s += __shfl_xor(s, 8);
            const float mu = s * (1.f / 64.f);
            float q = 0.f;
#pragma unroll
            for (int n = 0; n < 4; ++n) { const float d = acc[m][n][j] - mu; q += d * d; }
            q += __shfl_xor(q, 1); q += __shfl_xor(q, 2); q += __shfl_xor(q, 4); q += __shfl_xor(q, 8);
            const float rstd = rsqrtf(q * (1.f / 64.f) + EPSV);
#pragma unroll
            for (int n = 0; n < 4; ++n)
              pA[(size_t)(rbase + m * 16 + j) * 1024 + (cbase - 2048) + n * 16] = f2bf((acc[m][n][j] - mu) * rstd * gam[n] + bet[n]);
          }
      } else {
#pragma unroll
        for (int m = 0; m < 4; ++m)
#pragma unroll
          for (int n = 0; n < 4; ++n)
#pragma unroll
            for (int j = 0; j < 4; ++j) pA[(size_t)(rbase + m * 16 + j) * 1024 + (cbase - 2048) + n * 16] = f2bf(acc[m][n][j]);
      }
    } else {
#pragma unroll
      for (int m = 0; m < 4; ++m)
#pragma unroll
        for (int n = 0; n < 4; ++n)
#pragma unroll
          for (int j = 0; j < 4; ++j) pG[(size_t)(rbase + m * 16 + j) * 2048 + (cbase - 3072) + n * 16] = f2bf(sigmoidf_(acc[m][n][j]));
    }
  }
}

__device__ __forceinline__ void hgrn_item(const Params& p, unsigned char* smem, int bh) {
  unsigned char* ws = p.ws;
  const bf16_t* pH = (const bf16_t*)(ws + WS_PH);
  const float* lbp = (const float*)(ws + WS_LB);
  bf16_t* ya = (bf16_t*)(ws + WS_XN);
  bf16_t* Qt = (bf16_t*)smem;
  bf16_t* Kt = Qt + 64 * 136;
  bf16_t* KtT = Kt + 64 * 136;
  bf16_t* VT = KtT + 128 * 72;
  bf16_t* Am = VT + 128 * 72;
  bf16_t* ST = Am + 64 * 72;
  float* qtot = (float*)(ST + 128 * 136);
  float* eref = qtot + 512;
  float* elast = eref + 128;
  float* elr = elast + 128;
  float* red = elr + 128;
  const int tid = threadIdx.x, lane = tid & 63, w = tid >> 6, l15 = lane & 15, g = lane >> 4;
  const int b = bh >> 2, h = bh & 3;
  const int d = tid & 127, tq = tid >> 7;
  const float lbv = lbp[h * 128 + d];
  f32x4 S[8];
#pragma unroll
  for (int i = 0; i < 8; ++i) S[i] = (f32x4){0.f, 0.f, 0.f, 0.f};
  const float gnv = p.hg_norm[h * 128 + 16 * w + l15];

  for (int chunk = 0; chunk < 64; ++chunk) {
    const size_t row0 = (size_t)b * SEQL + chunk * 64;
    {
      const bf16_t* base = pH + (row0 + tq * 16) * 2048 + h * 128 + d;
      float lf[16], kk[16], qs[16];
      unsigned vv[8];
      float run = 0.f;
#pragma unroll
      for (int i = 0; i < 16; ++i) {
        const float fr = bf2f(base[(size_t)i * 2048 + 512]);
        const float qr = bf2f(base[(size_t)i * 2048]);
        const float sg = sigmoidf_(fr);
        const float fg = lbv + (1.f - lbv) * sg;
        run += __logf(fg);
        lf[i] = run; kk[i] = 1.f - fg; qs[i] = siluf_(qr);
      }
#pragma unroll
      for (int i = 0; i < 8; ++i) {
        const unsigned lo = base[(size_t)(2 * i) * 2048 + 1024], hi = base[(size_t)(2 * i + 1) * 2048 + 1024];
        vv[i] = lo | (hi << 16);
      }
      qtot[tq * 128 + d] = run;
      __syncthreads();
      const float q0 = qtot[d], q1 = qtot[128 + d], q2 = qtot[256 + d], q3 = qtot[384 + d];
      const float pre = (tq > 0 ? q0 : 0.f) + (tq > 1 ? q1 : 0.f) + (tq > 2 ? q2 : 0.f);
      const float bref = q0 + q1;
      const float blast = bref + q2 + q3;
      unsigned kp[8];
#pragma unroll
      for (int i = 0; i < 16; ++i) {
        const float bt = pre + lf[i];
        const float qt = qs[i] * __expf(bt - bref);
        const float kt = kk[i] * __expf(bref - bt);
        const int t = tq * 16 + i;
        Qt[t * 136 + d] = f2bf(qt);
        const bf16_t kb = f2bf(kt);
        Kt[t * 136 + d] = kb;
        if (i & 1) kp[i >> 1] |= ((unsigned)kb) << 16; else kp[i >> 1] = kb;
      }
      *(uint4*)(KtT + d * 72 + tq * 16) = make_uint4(kp[0], kp[1], kp[2], kp[3]);
      *(uint4*)(KtT + d * 72 + tq * 16 + 8) = make_uint4(kp[4], kp[5], kp[6], kp[7]);
      *(uint4*)(VT + d * 72 + tq * 16) = make_uint4(vv[0], vv[1], vv[2], vv[3]);
      *(uint4*)(VT + d * 72 + tq * 16 + 8) = make_uint4(vv[4], vv[5], vv[6], vv[7]);
      if (tq == 0) { eref[d] = __expf(bref); elast[d] = __expf(blast); elr[d] = __expf(blast - bref); }
    }
    __syncthreads();
    bf16_t ogr[16];
#pragma unroll
    for (int tm = 0; tm < 4; ++tm)
#pragma unroll
      for (int j = 0; j < 4; ++j) ogr[tm * 4 + j] = pH[(row0 + tm * 16 + 4 * g + j) * 2048 + 1536 + h * 128 + 16 * w + l15];
    {
      const int e = 16 * w + l15;
#pragma unroll
      for (int dm = 0; dm < 8; ++dm) {
        const int d0 = 16 * dm + 4 * g;
        uint2 o;
        o.x = pack2(S[dm][0] * eref[d0], S[dm][1] * eref[d0 + 1]);
        o.y = pack2(S[dm][2] * eref[d0 + 2], S[dm][3] * eref[d0 + 3]);
        *(uint2*)(ST + e * 136 + d0) = o;
      }
#pragma unroll
      for (int tt = 0; tt < 2; ++tt) {
        const int tl = 2 * w + tt, sm = tl >> 2, tn = tl & 3;
        f32x4 acc = (f32x4){0.f, 0.f, 0.f, 0.f};
        if (tn >= sm) {
#pragma unroll
          for (int k0 = 0; k0 < 128; k0 += 32) {
            const bf16x8 a = *(const bf16x8*)(Kt + (sm * 16 + l15) * 136 + k0 + 8 * g);
            const bf16x8 bq = *(const bf16x8*)(Qt + (tn * 16 + l15) * 136 + k0 + 8 * g);
            acc = __builtin_amdgcn_mfma_f32_16x16x32_bf16(a, bq, acc, 0, 0, 0);
          }
        }
        const int t = tn * 16 + l15, s0 = sm * 16 + 4 * g;
        uint2 o;
        o.x = pack2(s0 + 0 <= t ? acc[0] : 0.f, s0 + 1 <= t ? acc[1] : 0.f);
        o.y = pack2(s0 + 2 <= t ? acc[2] : 0.f, s0 + 3 <= t ? acc[3] : 0.f);
        *(uint2*)(Am + t * 72 + s0) = o;
      }
    }
    __syncthreads();
    f32x4 o[4];
    {
#pragma unroll
      for (int tm = 0; tm < 4; ++tm) {
        f32x4 acc = (f32x4){0.f, 0.f, 0.f, 0.f};
#pragma unroll
        for (int k0 = 0; k0 < 128; k0 += 32) {
          const bf16x8 a = *(const bf16x8*)(Qt + (tm * 16 + l15) * 136 + k0 + 8 * g);
          const bf16x8 bb = *(const bf16x8*)(ST + (16 * w + l15) * 136 + k0 + 8 * g);
          acc = __builtin_amdgcn_mfma_f32_16x16x32_bf16(a, bb, acc, 0, 0, 0);
        }
#pragma unroll
        for (int k0 = 0; k0 < 64; k0 += 32) {
          const bf16x8 a = *(const bf16x8*)(Am + (tm * 16 + l15) * 72 + k0 + 8 * g);
          const bf16x8 bb = *(const bf16x8*)(VT + (16 * w + l15) * 72 + k0 + 8 * g);
          acc = __builtin_amdgcn_mfma_f32_16x16x32_bf16(a, bb, acc, 0, 0, 0);
        }
        o[tm] = acc;
#pragma unroll
        for (int j = 0; j < 4; ++j) {
          float ss = acc[j] * acc[j];
          ss += __shfl_xor(ss, 1); ss += __shfl_xor(ss, 2); ss += __shfl_xor(ss, 4); ss += __shfl_xor(ss, 8);
          if (l15 == 0) red[w * 64 + tm * 16 + 4 * g + j] = ss;
        }
      }
#pragma unroll
      for (int dm = 0; dm < 8; ++dm) {
        f32x4 acc = (f32x4){0.f, 0.f, 0.f, 0.f};
#pragma unroll
        for (int k0 = 0; k0 < 64; k0 += 32) {
          const bf16x8 a = *(const bf16x8*)(KtT + (dm * 16 + l15) * 72 + k0 + 8 * g);
          const bf16x8 bb = *(const bf16x8*)(VT + (16 * w + l15) * 72 + k0 + 8 * g);
          acc = __builtin_amdgcn_mfma_f32_16x16x32_bf16(a, bb, acc, 0, 0, 0);
        }
#pragma unroll
        for (int j = 0; j < 4; ++j) { const int dd = 16 * dm + 4 * g + j; S[dm][j] = elast[dd] * S[dm][j] + elr[dd] * acc[j]; }
      }
    }
    __syncthreads();
    {
      const int e = 16 * w + l15;
#pragma unroll
      for (int tm = 0; tm < 4; ++tm)
#pragma unroll
        for (int j = 0; j < 4; ++j) {
          const int t = tm * 16 + 4 * g + j;
          float tot = 0.f;
#pragma unroll
          for (int ww = 0; ww < 8; ++ww) tot += red[ww * 64 + t];
          const float rstd = rsqrtf(tot * (1.f / 128.f) + EPSV);
          const float og = bf2f(ogr[tm * 4 + j]);
          ya[(row0 + t) * 512 + h * 128 + e] = f2bf(o[tm][j] * rstd * gnv * siluf_(og));
        }
    }
  }
}


__device__ __forceinline__ void hgrn_h1_all(const Params& p, unsigned char* smem) {
  unsigned char* ws = p.ws;
  bf16_t* pH = (bf16_t*)(ws + WS_PH);
  const float* lbp = (const float*)(ws + WS_LB);
  bf16_t* Qt = (bf16_t*)smem;
  bf16_t* Kt = Qt + 64 * 136;
  bf16_t* KtT = Kt + 64 * 136;
  bf16_t* VT = KtT + 128 * 72;
  bf16_t* Am = VT + 128 * 72;
  float* qtot = (float*)(Am + 64 * 72);
  const int tid = threadIdx.x, lane = tid & 63, w = tid >> 6, l15 = lane & 15, g = lane >> 4;
  const int d = tid & 127, tq = tid >> 7;
  const int G = gridDim.x;
  if ((int)blockIdx.x >= 2048) return;
  bf16_t fr_[16], qr_[16]; unsigned short vr_[16];
#define H1_LOAD(IT) do { \
    const int bh_ = (IT) >> 6, ch_ = (IT) & 63; \
    const bf16_t* base_ = pH + ((size_t)(bh_ >> 2) * SEQL + ch_ * 64 + tq * 16) * 2048 + (bh_ & 3) * 128 + d; \
    _Pragma("unroll") for (int i = 0; i < 16; ++i) { fr_[i] = base_[(size_t)i * 2048 + 512]; qr_[i] = base_[(size_t)i * 2048]; vr_[i] = base_[(size_t)i * 2048 + 1024]; } \
  } while (0)
  H1_LOAD((int)blockIdx.x);
  for (int item = blockIdx.x; item < 2048; item += G) {
    const int bh = item >> 6, chunk = item & 63;
    const int b = bh >> 2, h = bh & 3;
    const float lbv = lbp[h * 128 + d];
    const size_t row0 = (size_t)b * SEQL + chunk * 64;
    float* dec = (float*)(ws + WS_DEC) + (size_t)item * 384;
    uint4* UU = (uint4*)p.out + (size_t)item * 2048 + tid;
    float4* OI = (float4*)((unsigned char*)p.out + ((size_t)64 << 20)) + (size_t)item * 2048 + tid;
    {
      unsigned vv[8];
#pragma unroll
      for (int i = 0; i < 8; ++i) vv[i] = (unsigned)vr_[2 * i] | ((unsigned)vr_[2 * i + 1] << 16);
      float lf[16], kk[16], qs[16];
      float run = 0.f;
#pragma unroll
      for (int i = 0; i < 16; ++i) {
        const float sg = sigmoidf_(bf2f(fr_[i]));
        const float fg = lbv + (1.f - lbv) * sg;
        run += __logf(fg);
        lf[i] = run; kk[i] = 1.f - fg; qs[i] = siluf_(bf2f(qr_[i]));
      }
      qtot[tq * 128 + d] = run;
      __syncthreads();
      { const int nit = (item + G < 2048) ? item + G : item; H1_LOAD(nit); }
      const float q0 = qtot[d], q1 = qtot[128 + d], q2 = qtot[256 + d], q3 = qtot[384 + d];
      const float pre = (tq > 0 ? q0 : 0.f) + (tq > 1 ? q1 : 0.f) + (tq > 2 ? q2 : 0.f);
      const float bref = q0 + q1;
      const float blast = bref + q2 + q3;
      unsigned kp[8];
#pragma unroll
      for (int i = 0; i < 16; ++i) {
        const float bt = pre + lf[i];
        const float qt = qs[i] * __expf(bt - bref);
        const float kt = kk[i] * __expf(bref - bt);
        const int t = tq * 16 + i;
        Qt[t * 136 + d] = f2bf(qt);
        const bf16_t kb = f2bf(kt);
        Kt[t * 136 + d] = kb;
        if (i & 1) kp[i >> 1] |= ((unsigned)kb) << 16; else kp[i >> 1] = kb;
      }
      *(uint4*)(KtT + d * 72 + tq * 16) = make_uint4(kp[0], kp[1], kp[2], kp[3]);
      *(uint4*)(KtT + d * 72 + tq * 16 + 8) = make_uint4(kp[4], kp[5], kp[6], kp[7]);
      *(uint4*)(VT + d * 72 + tq * 16) = make_uint4(vv[0], vv[1], vv[2], vv[3]);
      *(uint4*)(VT + d * 72 + tq * 16 + 8) = make_uint4(vv[4], vv[5], vv[6], vv[7]);
      if (tq == 0) { dec[d] = __expf(bref); dec[128 + d] = __expf(blast); dec[256 + d] = __expf(blast - bref); }
    }
    __syncthreads();
    {
  #pragma unroll
      for (int i = 0; i < 2; ++i) {
        const int idx = tid + 512 * i, r = idx >> 4, c = idx & 15;
        *(uint4*)(pH + (row0 + r) * 2048 + h * 128 + c * 8) = *(const uint4*)(Qt + r * 136 + c * 8);
      }
  #pragma unroll
      for (int tt = 0; tt < 2; ++tt) {
        const int tl = 2 * w + tt, sm = tl >> 2, tn = tl & 3;
        f32x4 acc = (f32x4){0.f, 0.f, 0.f, 0.f};
        if (tn >= sm) {
  #pragma unroll
          for (int k0 = 0; k0 < 128; k0 += 32) {
            const bf16x8 a = *(const bf16x8*)(Kt + (sm * 16 + l15) * 136 + k0 + 8 * g);
            const bf16x8 bq = *(const bf16x8*)(Qt + (tn * 16 + l15) * 136 + k0 + 8 * g);
            acc = __builtin_amdgcn_mfma_f32_16x16x32_bf16(a, bq, acc, 0, 0, 0);
          }
        }
        const int t = tn * 16 + l15, s0 = sm * 16 + 4 * g;
        uint2 o;
        o.x = pack2(s0 + 0 <= t ? acc[0] : 0.f, s0 + 1 <= t ? acc[1] : 0.f);
        o.y = pack2(s0 + 2 <= t ? acc[2] : 0.f, s0 + 3 <= t ? acc[3] : 0.f);
        *(uint2*)(Am + t * 72 + s0) = o;
      }
    }
    __syncthreads();
    {
  #pragma unroll
      for (int tm = 0; tm < 4; ++tm) {
        f32x4 acc = (f32x4){0.f, 0.f, 0.f, 0.f};
  #pragma unroll
        for (int k0 = 0; k0 < 64; k0 += 32) {
          const bf16x8 a = *(const bf16x8*)(Am + (tm * 16 + l15) * 72 + k0 + 8 * g);
          const bf16x8 bb = *(const bf16x8*)(VT + (16 * w + l15) * 72 + k0 + 8 * g);
          acc = __builtin_amdgcn_mfma_f32_16x16x32_bf16(a, bb, acc, 0, 0, 0);
        }
        OI[tm * 512] = make_float4(acc[0], acc[1], acc[2], acc[3]);
      }
  #pragma unroll
      for (int dp = 0; dp < 4; ++dp) {
        unsigned pk[4];
  #pragma unroll
        for (int hh = 0; hh < 2; ++hh) {
          const int dm = dp * 2 + hh;
          f32x4 acc = (f32x4){0.f, 0.f, 0.f, 0.f};
  #pragma unroll
          for (int k0 = 0; k0 < 64; k0 += 32) {
            const bf16x8 a = *(const bf16x8*)(KtT + (dm * 16 + l15) * 72 + k0 + 8 * g);
            const bf16x8 bb = *(const bf16x8*)(VT + (16 * w + l15) * 72 + k0 + 8 * g);
            acc = __builtin_amdgcn_mfma_f32_16x16x32_bf16(a, bb, acc, 0, 0, 0);
          }
          pk[hh * 2] = pack2(acc[0], acc[1]); pk[hh * 2 + 1] = pack2(acc[2], acc[3]);
        }
        UU[dp * 512] = make_uint4(pk[0], pk[1], pk[2], pk[3]);
      }
    }
    __syncthreads();
  }
#undef H1_LOAD
}

__device__ __forceinline__ void hgrn_h2(const Params& p, unsigned char* smem, int bh) {
  unsigned char* ws = p.ws;
  const bf16_t* pH = (const bf16_t*)(ws + WS_PH);
  bf16_t* ya = (bf16_t*)(ws + WS_XN);
  bf16_t* Qt = (bf16_t*)smem;
  bf16_t* ST = Qt + 64 * 136;
  float* decl = (float*)(ST + 128 * 136);
  float* red = decl + 384;
  const int tid = threadIdx.x, lane = tid & 63, w = tid >> 6, l15 = lane & 15, g = lane >> 4;
  const int b = bh >> 2, h = bh & 3;
  f32x4 S[8];
#pragma unroll
  for (int i = 0; i < 8; ++i) S[i] = (f32x4){0.f, 0.f, 0.f, 0.f};
  const float gnv = p.hg_norm[h * 128 + 16 * w + l15];
  const int e = 16 * w + l15;
  uint4 uu0, uu1, uu2, uu3; float4 oi0, oi1, oi2, oi3; uint4 qraw0, qraw1; bf16_t ogr[16]; float dcv = 0.f;
#define H2_LOAD(CH) do { \
    const int item_ = bh * 64 + (CH); \
    const size_t row0_ = (size_t)b * SEQL + (size_t)(CH) * 64; \
    const uint4* UUp = (const uint4*)p.out + (size_t)item_ * 2048 + tid; \
    const float4* OIp = (const float4*)((const unsigned char*)p.out + ((size_t)64 << 20)) + (size_t)item_ * 2048 + tid; \
    uu0 = UUp[0]; uu1 = UUp[512]; uu2 = UUp[1024]; uu3 = UUp[1536]; oi0 = OIp[0]; oi1 = OIp[512]; oi2 = OIp[1024]; oi3 = OIp[1536]; \
    qraw0 = *(const uint4*)(pH + (row0_ + (tid >> 4)) * 2048 + h * 128 + (tid & 15) * 8); \
    qraw1 = *(const uint4*)(pH + (row0_ + 32 + (tid >> 4)) * 2048 + h * 128 + (tid & 15) * 8); \
    _Pragma("unroll") for (int tm = 0; tm < 4; ++tm) _Pragma("unroll") for (int j = 0; j < 4; ++j) \
      ogr[tm * 4 + j] = pH[(row0_ + tm * 16 + 4 * g + j) * 2048 + 1536 + h * 128 + e]; \
    if (tid < 384) dcv = ((const float*)(ws + WS_DEC))[(size_t)item_ * 384 + tid]; \
  } while (0)
  H2_LOAD(0);
  for (int chunk = 0; chunk < 64; ++chunk) {
    const size_t row0 = (size_t)b * SEQL + chunk * 64;
    const uint4 cu[4] = {uu0, uu1, uu2, uu3}; const float4 co[4] = {oi0, oi1, oi2, oi3}; bf16_t cog[16];
#pragma unroll
    for (int i = 0; i < 16; ++i) cog[i] = ogr[i];
    *(uint4*)(Qt + (tid >> 4) * 136 + (tid & 15) * 8) = qraw0;
    *(uint4*)(Qt + (32 + (tid >> 4)) * 136 + (tid & 15) * 8) = qraw1;
    if (tid < 384) decl[tid] = dcv;
    __syncthreads();
    if (chunk + 1 < 64) H2_LOAD(chunk + 1);
#pragma unroll
    for (int dm = 0; dm < 8; ++dm) {
      const int d0 = 16 * dm + 4 * g;
      uint2 o;
      o.x = pack2(S[dm][0] * decl[d0], S[dm][1] * decl[d0 + 1]);
      o.y = pack2(S[dm][2] * decl[d0 + 2], S[dm][3] * decl[d0 + 3]);
      *(uint2*)(ST + e * 136 + d0) = o;
    }
    __syncthreads();
    f32x4 o[4];
#pragma unroll
    for (int tm = 0; tm < 4; ++tm) {
      f32x4 acc = (f32x4){co[tm].x, co[tm].y, co[tm].z, co[tm].w};
#pragma unroll
      for (int k0 = 0; k0 < 128; k0 += 32) {
        const bf16x8 a = *(const bf16x8*)(Qt + (tm * 16 + l15) * 136 + k0 + 8 * g);
        const bf16x8 bb = *(const bf16x8*)(ST + (16 * w + l15) * 136 + k0 + 8 * g);
        acc = __builtin_amdgcn_mfma_f32_16x16x32_bf16(a, bb, acc, 0, 0, 0);
      }
      o[tm] = acc;
#pragma unroll
      for (int j = 0; j < 4; ++j) {
        float ss = acc[j] * acc[j];
        ss += __shfl_xor(ss, 1); ss += __shfl_xor(ss, 2); ss += __shfl_xor(ss, 4); ss += __shfl_xor(ss, 8);
        if (l15 == 0) red[w * 64 + tm * 16 + 4 * g + j] = ss;
      }
    }
#pragma unroll
    for (int dm = 0; dm < 8; ++dm) {
      const unsigned u01 = (dm & 1) ? cu[dm >> 1].z : cu[dm >> 1].x, u23 = (dm & 1) ? cu[dm >> 1].w : cu[dm >> 1].y;
      const float uv[4] = {__uint_as_float(u01 << 16), __uint_as_float(u01 & 0xffff0000u), __uint_as_float(u23 << 16), __uint_as_float(u23 & 0xffff0000u)};
#pragma unroll
      for (int j = 0; j < 4; ++j) { const int dd = 16 * dm + 4 * g + j; S[dm][j] = decl[128 + dd] * S[dm][j] + decl[256 + dd] * uv[j]; }
    }
    __syncthreads();
#pragma unroll
    for (int tm = 0; tm < 4; ++tm)
#pragma unroll
      for (int j = 0; j < 4; ++j) {
        const int t = tm * 16 + 4 * g + j;
        float tot = 0.f;
#pragma unroll
        for (int ww = 0; ww < 8; ++ww) tot += red[ww * 64 + t];
        const float rstd = rsqrtf(tot * (1.f / 128.f) + EPSV);
        ya[(row0 + t) * 512 + h * 128 + e] = f2bf(o[tm][j] * rstd * gnv * siluf_(bf2f(cog[tm * 4 + j])));
      }
  }
#undef H2_LOAD
}

__device__ __forceinline__ int team_index(const Params& p, unsigned char* smem) {
  int* sh = (int*)(smem + 8192);
  const int G = gridDim.x, tid = threadIdx.x;
  const int* tab = (const int*)(p.ws + WS_XCC);
  if (tid < 32) sh[tid] = 0;
  __syncthreads();
  const int mine = tab[blockIdx.x] & 15;
  for (int b = tid; b < G; b += NTHREADS) {
    const int x = tab[b] & 15;
    atomicAdd(&sh[x], 1);
    if (x == mine && b < (int)blockIdx.x) atomicAdd(&sh[16], 1);
  }
  __syncthreads();
  if (tid == 0) {
    int pre = 0;
    for (int j = 0; j < mine; ++j) pre += sh[j];
    sh[17] = pre + sh[16];
  }
  __syncthreads();
  const int r = sh[17];
  __syncthreads();
  return r;
}

#define SCW 4100
#ifndef DSA_REP
#define DSA_REP 0
#endif
#define DSA_BKT_OFF (8 * SCW * 4 + 8 * 256 * 4 + 8 * 256 * 2 + 8 * 512 * 2)
__device__ __forceinline__ void cvt8(const uint4& v, float* f) {
  f[0] = __uint_as_float(v.x << 16); f[1] = __uint_as_float(v.x & 0xffff0000u);
  f[2] = __uint_as_float(v.y << 16); f[3] = __uint_as_float(v.y & 0xffff0000u);
  f[4] = __uint_as_float(v.z << 16); f[5] = __uint_as_float(v.z & 0xffff0000u);
  f[6] = __uint_as_float(v.w << 16); f[7] = __uint_as_float(v.w & 0xffff0000u);
}
__device__ __forceinline__ unsigned sortable_key(float v) {
  unsigned bits = __float_as_uint(v);
  if (bits == 0x80000000u) bits = 0u;
  return (bits & 0x80000000u) ? ~bits : (bits | 0x80000000u);
}

__device__ __forceinline__ void dsa_item(const Params& p, unsigned char* smem, int item) {
  unsigned char* ws = p.ws;
  const bf16_t* pA = (const bf16_t*)(ws + WS_PA);
  const bf16_t* kc = (const bf16_t*)(ws + WS_KC);
  const bf16_t* vc = (const bf16_t*)(ws + WS_VC);
  const bf16_t* ikc = (const bf16_t*)(ws + WS_IKC);
  bf16_t* yb = (bf16_t*)(ws + WS_XN) + (size_t)TOK * 512;
  unsigned* sc = (unsigned*)smem;
  unsigned* hist = sc + 8 * SCW;
  unsigned short* sel = (unsigned short*)(hist + 8 * 256);
  unsigned short* cand = sel + 8 * 256;
  unsigned char* bkt = (unsigned char*)(cand + 8 * 512);
  unsigned* rmm = (unsigned*)(bkt + 128 + 1024);
  const int tid = threadIdx.x, lane = tid & 63, w = tid >> 6, l15 = lane & 15, g = lane >> 4;
  const int b = item >> 9;
  const int tb = item & 511;
  const int t0 = tb * 8;
  const size_t tokbase = (size_t)b * SEQL;

  for (int rep_s = 0; rep_s < (DSA_REP == 1 ? 2 : 1); ++rep_s) {
    bf16x8 af[2][2];
    float wq[2][4];
#pragma unroll
    for (int mt = 0; mt < 2; ++mt) {
      const int qrow = t0 + mt * 4 + (l15 >> 2), head = l15 & 3;
#pragma unroll
      for (int ks = 0; ks < 2; ++ks)
        af[mt][ks] = *(const bf16x8*)(pA + (tokbase + qrow) * 1024 + 640 + head * 64 + ks * 32 + 8 * g);
      const uint2 wr = *(const uint2*)(pA + (tokbase + t0 + mt * 4 + g) * 1024 + 960);
      wq[mt][0] = 0.5f * bf2f((bf16_t)(wr.x & 0xffff)); wq[mt][1] = 0.5f * bf2f((bf16_t)(wr.x >> 16));
      wq[mt][2] = 0.5f * bf2f((bf16_t)(wr.y & 0xffff)); wq[mt][3] = 0.5f * bf2f((bf16_t)(wr.y >> 16));
    }
    const int nkt = (t0 + 8 + 15) >> 4;
    unsigned kmin[2] = {0xFFFFFFFFu, 0xFFFFFFFFu}, kmax[2] = {0u, 0u};
    for (int kt0 = w; kt0 < nkt; kt0 += 64) {
      bf16x8 b0[8], b1[8];
#pragma unroll
      for (int u = 0; u < 8; ++u) {
        const int kt = kt0 + 8 * u;
        const int s = (kt < nkt ? kt : 0) * 16 + l15;
        const bf16_t* kr = ikc + (tokbase + s) * 64 + 8 * g;
        b0[u] = *(const bf16x8*)kr;
        b1[u] = *(const bf16x8*)(kr + 32);
      }
      __builtin_amdgcn_sched_barrier(0);
      f32x4 sacc[8][2];
#pragma unroll
      for (int u = 0; u < 8; ++u)
#pragma unroll
        for (int mt = 0; mt < 2; ++mt) {
          f32x4 acc = (f32x4){0.f, 0.f, 0.f, 0.f};
          acc = __builtin_amdgcn_mfma_f32_16x16x32_bf16(af[mt][0], b0[u], acc, 0, 0, 0);
          sacc[u][mt] = __builtin_amdgcn_mfma_f32_16x16x32_bf16(af[mt][1], b1[u], acc, 0, 0, 0);
        }
#pragma unroll
      for (int u = 0; u < 8; ++u) {
        const int kt = kt0 + 8 * u;
        if (kt < nkt) {
          const int s = kt * 16 + l15;
#pragma unroll
          for (int mt = 0; mt < 2; ++mt) {
            float v = 0.f;
#pragma unroll
            for (int j = 0; j < 4; ++j) v += wq[mt][j] * fmaxf(sacc[u][mt][j] * 0.125f, 0.f);
            const int t = t0 + mt * 4 + g;
            unsigned vb = __float_as_uint(v); if (vb == 0x80000000u) vb = 0u;
            sc[(mt * 4 + g) * SCW + s] = vb;
            if (s <= t) {
              const unsigned key = (vb & 0x80000000u) ? ~vb : (vb | 0x80000000u);
              kmin[mt] = key < kmin[mt] ? key : kmin[mt];
              kmax[mt] = key > kmax[mt] ? key : kmax[mt];
            }
          }
        }
      }
    }
#pragma unroll
    for (int mt = 0; mt < 2; ++mt) {
      unsigned a = kmin[mt], bmx = kmax[mt];
#define DPP_MINMAX(CTRL) do { const unsigned a2 = (unsigned)__builtin_amdgcn_update_dpp((int)a, (int)a, CTRL, 0xf, 0xf, false); \
                               const unsigned b2 = (unsigned)__builtin_amdgcn_update_dpp((int)bmx, (int)bmx, CTRL, 0xf, 0xf, false); \
                               a = a2 < a ? a2 : a; bmx = b2 > bmx ? b2 : bmx; } while (0)
      DPP_MINMAX(0xB1); DPP_MINMAX(0x4E); DPP_MINMAX(0x141); DPP_MINMAX(0x140);
#undef DPP_MINMAX
      if (l15 == 0) { atomicMin(&rmm[mt * 4 + g], a); atomicMax(&rmm[8 + mt * 4 + g], bmx); }
    }
  }
  __syncthreads();
  const int t = t0 + w;
  const int n = t + 1;
  unsigned* row = sc + w * SCW;
  const float* rowf = (const float*)row;
  unsigned short* mysel = sel + w * 256;
  unsigned short* mycand = cand + w * 512;
  unsigned* myh = hist + w * 256;
  int cnt;
  const unsigned long long lt_mask = (1ull << lane) - 1ull;
  for (int rep_t = 0; rep_t < (DSA_REP == 2 ? 2 : 1); ++rep_t)
  if (n <= 256) {
    for (int i = lane; i < n; i += 64) mysel[i] = (unsigned short)i;
    cnt = n;
  } else {
    cnt = 256;
    float mn, mx;
    {
      const unsigned kmn = rmm[w], kmx = rmm[8 + w];
      mn = __uint_as_float((kmn & 0x80000000u) ? (kmn ^ 0x80000000u) : ~kmn);
      mx = __uint_as_float((kmx & 0x80000000u) ? (kmx ^ 0x80000000u) : ~kmx);
    }
    const float scale = (mx > mn) ? 255.99f / (mx - mn) : 0.f;
#pragma unroll
    for (int i = 0; i < 4; ++i) myh[lane + 64 * i] = 0u;
    lds_fence();
    for (int i0 = lane; i0 < n; i0 += 256) {
      float v4[4];
#pragma unroll
      for (int k = 0; k < 4; ++k) v4[k] = (i0 + 64 * k < n) ? rowf[i0 + 64 * k] : 0.f;
#pragma unroll
      for (int k = 0; k < 4; ++k) {
        if (i0 + 64 * k < n) {
          int bn = (int)((v4[k] - mn) * scale); bn = bn > 255 ? 255 : bn;
          atomicAdd(&myh[bn], 1u);
        }
      }
    }
    lds_fence();
    unsigned cum; int bstar; unsigned mcount;
    {
      const uint4 c4 = *(const uint4*)(myh + 4 * lane);
      const unsigned c = c4.x + c4.y + c4.z + c4.w;
      unsigned sfx = c;
#pragma unroll
      for (int o = 1; o < 64; o <<= 1) { const unsigned tt = __shfl_down(sfx, o); if (lane + o < 64) sfx += tt; }
      const unsigned long long bal = __ballot(sfx >= 256u);
      const int L = 63 - __clzll(bal);
      const unsigned sL = __shfl(sfx, L), cL = __shfl(c, L);
      const unsigned b3 = __shfl(c4.w, L), b2 = __shfl(c4.z, L), b1 = __shfl(c4.y, L), b0 = __shfl(c4.x, L);
      cum = sL - cL;
      int digit;
      if (cum + b3 >= 256u) { digit = 3; mcount = b3; }
      else { cum += b3; if (cum + b2 >= 256u) { digit = 2; mcount = b2; } else { cum += b2; if (cum + b1 >= 256u) { digit = 1; mcount = b1; } else { cum += b1; digit = 0; mcount = b0; } } }
      bstar = 4 * L + digit;
    }
    const unsigned need = 256u - cum;
    if (mcount <= 512u) {
      unsigned base = 0u, cb = 0u;
      for (int i0 = 0; i0 < n; i0 += 256) {
        float v4[4];
#pragma unroll
        for (int k = 0; k < 4; ++k) { const int i = i0 + 64 * k + lane; v4[k] = (i < n) ? rowf[i] : 0.f; }
#pragma unroll
        for (int k = 0; k < 4; ++k) {
          const int i = i0 + 64 * k + lane;
          const bool valid = i < n;
          int bn = (int)((v4[k] - mn) * scale); bn = bn > 255 ? 255 : bn;
          const bool gt = valid && (bn > bstar);
          const bool eq = valid && (bn == bstar);
          const unsigned long long bg = __ballot(gt), be = __ballot(eq);
          if (gt) mysel[base + (unsigned)__popcll(bg & lt_mask)] = (unsigned short)i;
          if (eq) mycand[cb + (unsigned)__popcll(be & lt_mask)] = (unsigned short)i;
          base += (unsigned)__popcll(bg); cb += (unsigned)__popcll(be);
        }
      }
      lds_fence();
      const int m = (int)mcount;
      unsigned ck[8]; unsigned short ci[8];
#pragma unroll
      for (int q = 0; q < 8; ++q) {
        const int c = q * 64 + lane;
        ck[q] = 0u; ci[q] = 0;
        if (c < m) { ci[q] = mycand[c]; ck[q] = sortable_key(rowf[ci[q]]); }
      }
      unsigned T = 0u;
      if (m <= 64) {
#pragma unroll 1
        for (int bit = 31; bit >= 0; --bit) {
          const unsigned trial = T | (1u << bit);
          if ((unsigned)__popcll(__ballot(ck[0] >= trial)) >= need) T = trial;
        }
      } else {
#pragma unroll 1
        for (int bit = 31; bit >= 0; --bit) {
          const unsigned trial = T | (1u << bit);
          unsigned cge = 0u;
#pragma unroll
          for (int q = 0; q < 8; ++q) cge += (unsigned)__popcll(__ballot(ck[q] >= trial));
          if (cge >= need) T = trial;
        }
      }
      unsigned cgt = 0u;
#pragma unroll
      for (int q = 0; q < 8; ++q) cgt += (unsigned)__popcll(__ballot(ck[q] > T));
      const unsigned need_eq = need - cgt;
      unsigned pos0 = cum, eqtaken = 0u;
#pragma unroll
      for (int q = 0; q < 8; ++q) {
        const bool gt = ck[q] > T;
        const bool eq = ck[q] == T;
        const unsigned long long beq = __ballot(eq);
        const bool take = gt || (eq && (eqtaken + (unsigned)__popcll(beq & lt_mask)) < need_eq);
        const unsigned long long bt = __ballot(take);
        const unsigned pp = pos0 + (unsigned)__popcll(bt & lt_mask);
        if (take && pp < 256u) mysel[pp] = ci[q];
        pos0 += (unsigned)__popcll(bt);
        eqtaken += (unsigned)__popcll(beq);
      }
    } else {
      unsigned prefix = 0u, krem = 256u;
#pragma unroll 1
      for (int pass = 0; pass < 4; ++pass) {
        const int shift = 24 - 8 * pass;
        const unsigned himask = (pass == 0) ? 0u : (0xFFFFFFFFu << (shift + 8));
#pragma unroll
        for (int i = 0; i < 4; ++i) myh[lane + 64 * i] = 0u;
        lds_fence();
        for (int i = lane; i < n; i += 64) {
          const unsigned u = sortable_key(rowf[i]);
          if ((u & himask) == prefix) atomicAdd(&myh[(u >> shift) & 255u], 1u);
        }
        lds_fence();
        const uint4 c4 = *(const uint4*)(myh + 4 * lane);
        const unsigned c = c4.x + c4.y + c4.z + c4.w;
        unsigned sfx = c;
#pragma unroll
        for (int o = 1; o < 64; o <<= 1) { const unsigned tt = __shfl_down(sfx, o); if (lane + o < 64) sfx += tt; }
        const unsigned long long bal = __ballot(sfx >= krem);
        const int L = 63 - __clzll(bal);
        const unsigned sL = __shfl(sfx, L), cL = __shfl(c, L);
        const unsigned b3 = __shfl(c4.w, L), b2 = __shfl(c4.z, L), b1 = __shfl(c4.y, L);
        unsigned cum2 = sL - cL;
        unsigned digit;
        if (cum2 + b3 >= krem) digit = 3;
        else { cum2 += b3; if (cum2 + b2 >= krem) digit = 2; else { cum2 += b2; if (cum2 + b1 >= krem) digit = 1; else { cum2 += b1; digit = 0; } } }
        krem -= cum2;
        prefix |= ((unsigned)(4 * L) + digit) << shift;
      }
      const unsigned T = prefix;
      unsigned base = 0u, eqtaken = 0u;
      for (int i0 = 0; i0 < n; i0 += 64) {
        const int i = i0 + lane;
        const bool valid = i < n;
        const unsigned u = valid ? sortable_key(rowf[i]) : 0u;
        const bool gt = valid && (u > T);
        const bool eq = valid && (u == T);
        const unsigned long long beq = __ballot(eq);
        const unsigned eqrank = eqtaken + (unsigned)__popcll(beq & lt_mask);
        const bool take = gt || (eq && eqrank < krem);
        const unsigned long long bt = __ballot(take);
        const unsigned pos = base + (unsigned)__popcll(bt & lt_mask);
        if (take && pos < 256u) mysel[pos] = (unsigned short)i;
        base += (unsigned)__popcll(bt);
        eqtaken += (unsigned)__popcll(beq);
      }
    }
  }
  lds_fence();
  if (lane == 0) { rmm[w] = 0xFFFFFFFFu; rmm[8 + w] = 0u; }
  {
    int lane_a = lane;
    asm volatile("" : "+v"(lane_a));
    const int l15 = lane_a & 15, g = lane_a >> 4;
    const int ks = lane_a >> 3, dc = lane_a & 7;
    float* pl = (float*)row;
    const float* relb = (const float*)(bkt + 128);
    const int niter = (cnt + 7) >> 3;
    bf16x8 bq0 = (bf16x8){0, 0, 0, 0, 0, 0, 0, 0}, bq1 = bq0;
    if (l15 < 8) {
      bq0 = *(const bf16x8*)(pA + (tokbase + t) * 1024 + l15 * 64 + 8 * g);
      bq1 = *(const bf16x8*)(pA + (tokbase + t) * 1024 + l15 * 64 + 32 + 8 * g);
    }
    float lg[16][4];
    {
      bf16x8 ka[8][2], kb[8][2];
#pragma unroll
      for (int u = 0; u < 8; ++u) {
        const int kk = u * 16 + l15;
        const int s = (kk < cnt) ? (int)mysel[kk] : 0;
        const bf16_t* kr = kc + (tokbase + s) * 64 + 8 * g;
        ka[u][0] = *(const bf16x8*)kr;
        ka[u][1] = *(const bf16x8*)(kr + 32);
      }
#pragma unroll
      for (int u = 0; u < 8; ++u) {
        const int kk = (8 + u) * 16 + l15;
        const int s = (kk < cnt) ? (int)mysel[kk] : 0;
        const bf16_t* kr = kc + (tokbase + s) * 64 + 8 * g;
        kb[u][0] = *(const bf16x8*)kr;
        kb[u][1] = *(const bf16x8*)(kr + 32);
      }
      __builtin_amdgcn_sched_barrier(0);
#pragma unroll
      for (int u = 0; u < 8; ++u) {
        f32x4 acc = (f32x4){0.f, 0.f, 0.f, 0.f};
        acc = __builtin_amdgcn_mfma_f32_16x16x32_bf16(ka[u][0], bq0, acc, 0, 0, 0);
        acc = __builtin_amdgcn_mfma_f32_16x16x32_bf16(ka[u][1], bq1, acc, 0, 0, 0);
        lg[u][0] = acc[0]; lg[u][1] = acc[1]; lg[u][2] = acc[2]; lg[u][3] = acc[3];
      }
#pragma unroll
      for (int u = 0; u < 8; ++u) {
        f32x4 acc = (f32x4){0.f, 0.f, 0.f, 0.f};
        acc = __builtin_amdgcn_mfma_f32_16x16x32_bf16(kb[u][0], bq0, acc, 0, 0, 0);
        acc = __builtin_amdgcn_mfma_f32_16x16x32_bf16(kb[u][1], bq1, acc, 0, 0, 0);
        lg[8 + u][0] = acc[0]; lg[8 + u][1] = acc[1]; lg[8 + u][2] = acc[2]; lg[8 + u][3] = acc[3];
      }
    }
    typedef unsigned u32x4_t __attribute__((ext_vector_type(4)));
    u32x4_t va[16];
#pragma unroll
    for (int u = 0; u < 16; ++u) {
      const int kk = u * 8 + ks;
      const int s = (kk < cnt) ? (int)mysel[kk] : 0;
      va[u] = *(const u32x4_t*)(vc + (tokbase + s) * 64 + dc * 8);
    }
    __builtin_amdgcn_sched_barrier(0);
    const int hsel = l15 & 7;
    float m = -INFINITY;
#pragma unroll
    for (int u = 0; u < 16; ++u) {
      const uint2 s4 = *(const uint2*)(mysel + u * 16 + 4 * g);
      const int sj[4] = {(int)(s4.x & 0xffffu), (int)(s4.x >> 16), (int)(s4.y & 0xffffu), (int)(s4.y >> 16)};
#pragma unroll
      for (int j = 0; j < 4; ++j) {
        const int key = u * 16 + 4 * g + j;
        const bool valid = key < cnt;
        const int dist = valid ? t - sj[j] : 0;
        const int bk = dist < 128 ? (int)bkt[dist] : 31;
        lg[u][j] = valid ? (lg[u][j] * 0.125f + relb[bk * 8 + hsel]) : -INFINITY;
        m = fmaxf(m, lg[u][j]);
      }
    }
    m = max_xor16(m); m = max_xor32(m);
    float sum = 0.f;
#pragma unroll
    for (int u = 0; u < 16; ++u)
#pragma unroll
      for (int j = 0; j < 4; ++j) { lg[u][j] = __expf(lg[u][j] - m); sum += lg[u][j]; }
    sum = add_xor16(sum); sum = add_xor32(sum);
    const float inv = 1.f / sum;
    bf16x8 pa[8];
#pragma unroll
    for (int s8 = 0; s8 < 8; ++s8) {
      const unsigned w0 = pack2(lg[2 * s8][0] * inv, lg[2 * s8][1] * inv), w1 = pack2(lg[2 * s8][2] * inv, lg[2 * s8][3] * inv);
      const unsigned w2 = pack2(lg[2 * s8 + 1][0] * inv, lg[2 * s8 + 1][1] * inv), w3 = pack2(lg[2 * s8 + 1][2] * inv, lg[2 * s8 + 1][3] * inv);
      const u32x4_t wv = {w0, w1, w2, w3};
      pa[s8] = __builtin_bit_cast(bf16x8, wv);
    }
    unsigned char* vs_l = (unsigned char*)row;
#pragma unroll
    for (int u = 0; u < 16; ++u) *(u32x4_t*)(vs_l + (u * 8 + ks) * 128 + dc * 16) = va[u];
    lds_fence();
    u32x4_t vb[16];
#pragma unroll
    for (int u = 0; u < 16; ++u) {
      const int kk = (16 + u) * 8 + ks;
      const int s = (kk < cnt) ? (int)mysel[kk] : 0;
      vb[u] = *(const u32x4_t*)(vc + (tokbase + s) * 64 + dc * 8);
    }
    __builtin_amdgcn_sched_barrier(0);
    f32x4 ov[4];
#pragma unroll
    for (int nt = 0; nt < 4; ++nt) ov[nt] = (f32x4){0.f, 0.f, 0.f, 0.f};
    typedef short v4s_t __attribute__((ext_vector_type(4)));
    const unsigned tr_lane = (unsigned)((l15 >> 2) * 128 + (l15 & 3) * 8);
#define PV_HALF(S0) do { \
      _Pragma("unroll") for (int s4_ = 0; s4_ < 4; ++s4_) { \
        _Pragma("unroll") for (int nt = 0; nt < 4; ++nt) { \
          const unsigned a0 = (unsigned)((s4_ * 32 + 4 * g) * 128 + nt * 32) + tr_lane; \
          const v4s_t b0 = __builtin_amdgcn_ds_read_tr16_b64_v4i16((__attribute__((address_space(3))) v4s_t*)(vs_l + a0)); \
          const v4s_t b1 = __builtin_amdgcn_ds_read_tr16_b64_v4i16((__attribute__((address_space(3))) v4s_t*)(vs_l + a0 + 16 * 128)); \
          const bf16x8 bb = (bf16x8){b0[0], b0[1], b0[2], b0[3], b1[0], b1[1], b1[2], b1[3]}; \
          ov[nt] = __builtin_amdgcn_mfma_f32_16x16x32_bf16(pa[(S0) + s4_], bb, ov[nt], 0, 0, 0); \
        } \
      } \
    } while (0)
    PV_HALF(0);
    lds_fence();
#pragma unroll
    for (int u = 0; u < 16; ++u) *(u32x4_t*)(vs_l + (u * 8 + ks) * 128 + dc * 16) = vb[u];
    lds_fence();
    PV_HALF(4);
#undef PV_HALF
    if (g < 2) {
#pragma unroll
      for (int nt = 0; nt < 4; ++nt)
#pragma unroll
        for (int j = 0; j < 4; ++j) yb[(tokbase + t) * 512 + (4 * g + j) * 64 + nt * 16 + l15] = f2bf(ov[nt][j]);
    }
    lds_fence();
  }
  __syncthreads();
}

__device__ __forceinline__ void phase_mix(const Params& p, unsigned char* smem, int mode = 0) {
  const int G = gridDim.x;
  if (mode != 2) { for (int bh = blockIdx.x; bh < 32; bh += G) { hgrn_h2(p, smem, bh); __syncthreads(); } }
  if (mode == 1) return;
  unsigned char* bkt = smem + DSA_BKT_OFF;
  volatile int* qslot = (volatile int*)(smem + LDS_BYTES - 32);
  unsigned* qctr = (unsigned*)(p.ws + WS_QCTR);
  if (threadIdx.x < 128) {
    const int nn = threadIdx.x;
    int v = nn;
    if (nn >= 16) { v = 16 + (int)(logf((float)nn * (1.f / 16.f)) / logf(8.f) * 16.f); if (v > 31) v = 31; }
    bkt[nn] = (unsigned char)v;
  }
  if (threadIdx.x >= 256) ((float*)(bkt + 128))[threadIdx.x - 256] = p.rel_bias[threadIdx.x - 256];
  if (threadIdx.x < 16) ((unsigned*)(bkt + 128 + 1024))[threadIdx.x] = threadIdx.x < 8 ? 0xFFFFFFFFu : 0u;
  const int my_team = (G % 8 == 0) ? team_index(p, smem) / (G >> 3) : (int)(blockIdx.x & 7);
  constexpr int QN = 544;
#define Q_FETCH(SLOT) do { if (threadIdx.x == 0) { int tm_ = q_team, kk_ = -1; \
      for (int tries_ = 0; tries_ < 8; ++tries_) { \
        const unsigned v_ = __hip_atomic_fetch_add(qctr + 16 * tm_, 1u, __ATOMIC_RELAXED, __HIP_MEMORY_SCOPE_AGENT); \
        if (v_ < (unsigned)QN) { kk_ = (tm_ << 16) | (int)v_; break; } \
        tm_ = (tm_ + 1) & 7; } \
      q_team = tm_; qslot[SLOT] = kk_; } } while (0)
  int q_team = my_team;
  Q_FETCH(0);
  __syncthreads();
  int k = qslot[0];
  int par = 1;
  while (k >= 0) {
    Q_FETCH(par);
    const int bt = k >> 16, kl = k & 0xffff;
    const int kq = kl / 17, kr = kl - kq * 17;
    if (kr < 16) {
      const int tb = 511 - (kq * 16 + kr);
      dsa_item(p, smem, (bt << 9) | tb);
    } else {
      const int r0 = (bt * 32 + kq) * 64;
      quantize_rows_u8<false, true>(p.peer_u, p.ws + WS_U, (float*)(p.ws + WS_U + (size_t)16384 * 1024), r0, r0 + 64);
      quantize_rows_u8<true, false>(p.peer_v, p.ws + WS_V, (float*)(p.ws + WS_V + (size_t)16384 * 1024), r0, r0 + 64);
      __syncthreads();
    }
    k = qslot[par];
    par ^= 1;
  }
#undef Q_FETCH
}

__device__ __forceinline__ void phase_up(const Params& p, unsigned char* smem) {
  unsigned char* ws = p.ws;
  const bf16_t* ya = (const bf16_t*)(ws + WS_XN);
  const bf16_t* yb = ya + (size_t)TOK * 512;
  const bf16_t* wa = (const bf16_t*)(ws + WS_WUPA);
  const bf16_t* wb = (const bf16_t*)(ws + WS_WUPB);
  const bf16_t* pG = (const bf16_t*)(ws + WS_PG);
  bf16_t* hb = (bf16_t*)(ws + WS_PH);
  const int tid = threadIdx.x, lane = tid & 63, w = tid >> 6, wm = w >> 1, wn = w & 1, l15 = lane & 15, g = lane >> 4;
  for (int tile = blockIdx.x; tile < 128 * 8; tile += gridDim.x) {
    const int tn = tile & 7, tm = tile >> 3;
    f32x4 acc[4][4]; zero_acc(acc);
    gemm_tile(ya + (size_t)tm * 256 * 512, 512, wa + (size_t)tn * 128 * 512, 512, 8, acc, smem);
    asm volatile("" ::: "memory");
    const int rbase = tm * 256 + wm * 64 + 4 * g;
    const int cbase = tn * 128 + wn * 64 + l15;
#pragma unroll
    for (int m = 0; m < 4; ++m) {
      bf16_t gt[16];
#pragma unroll
      for (int n = 0; n < 4; ++n)
#pragma unroll
        for (int j = 0; j < 4; ++j) gt[n * 4 + j] = pG[(size_t)(rbase + m * 16 + j) * 2048 + cbase + n * 16];
#pragma unroll
      for (int n = 0; n < 4; ++n) {
#pragma unroll
        for (int j = 0; j < 4; ++j) {
          const size_t rr = (size_t)(rbase + m * 16 + j);
          hb[rr * 1024 + cbase + n * 16] = f2bf(acc[m][n][j] * bf2f(gt[n * 4 + j]));
        }
        acc[m][n] = (f32x4){0.f, 0.f, 0.f, 0.f};
      }
    }
    asm volatile("" ::: "memory");
    gemm_tile(yb + (size_t)tm * 256 * 512, 512, wb + (size_t)tn * 128 * 512, 512, 8, acc, smem);
    asm volatile("" ::: "memory");
#pragma unroll
    for (int m = 0; m < 4; ++m) {
      bf16_t gt[16], ht[16];
#pragma unroll
      for (int n = 0; n < 4; ++n)
#pragma unroll
        for (int j = 0; j < 4; ++j) {
          const size_t rr = (size_t)(rbase + m * 16 + j);
          gt[n * 4 + j] = pG[rr * 2048 + 1024 + cbase + n * 16];
          ht[n * 4 + j] = hb[rr * 1024 + cbase + n * 16];
        }
#pragma unroll
      for (int n = 0; n < 4; ++n)
#pragma unroll
        for (int j = 0; j < 4; ++j) {
          const size_t rr = (size_t)(rbase + m * 16 + j);
          hb[rr * 1024 + cbase + n * 16] = f2bf(bf2f(ht[n * 4 + j]) + acc[m][n][j] * bf2f(gt[n * 4 + j]));
        }
    }
  }
}

__device__ __forceinline__ void phase_out(const Params& p, unsigned char* smem) {
  unsigned char* ws = p.ws;
  const bf16_t* hb = (const bf16_t*)(ws + WS_PH);
  const bf16_t* wo = (const bf16_t*)(ws + WS_WOUT);
  const int tid = threadIdx.x, lane = tid & 63, w = tid >> 6, wm = w >> 1, wn = w & 1, l15 = lane & 15, g = lane >> 4;
  for (int tile = blockIdx.x; tile < 128 * 8; tile += gridDim.x) {
    const int tn = tile & 7, tm = tile >> 3;
    f32x4 acc[4][4]; zero_acc(acc);
    gemm_tile(hb + (size_t)tm * 256 * 1024, 1024, wo + (size_t)tn * 128 * 1024, 1024, 16, acc, smem);
    const int rbase = tm * 256 + wm * 64 + 4 * g;
    const int cbase = tn * 128 + wn * 64 + l15;
#pragma unroll
    for (int m = 0; m < 4; ++m) {
      float xt[16];
#pragma unroll
      for (int n = 0; n < 4; ++n)
#pragma unroll
        for (int j = 0; j < 4; ++j) xt[n * 4 + j] = p.x[(size_t)(rbase + m * 16 + j) * 1024 + cbase + n * 16];
#pragma unroll
      for (int n = 0; n < 4; ++n)
#pragma unroll
        for (int j = 0; j < 4; ++j) p.out[(size_t)(rbase + m * 16 + j) * 1024 + cbase + n * 16] = xt[n * 4 + j] + acc[m][n][j];
    }
  }
}

__device__ __forceinline__ void phase_pq(const Params& p, unsigned char* smem) {
  unsigned char* ws = p.ws;
  const bf16_t* xn2 = (const bf16_t*)(ws + WS_XN);
  const bf16_t* wq = (const bf16_t*)(ws + WS_WQ);
  bf16_t* qp = (bf16_t*)(ws + WS_PG);
  const int tid = threadIdx.x, lane = tid & 63, w = tid >> 6, wm = w >> 1, wn = w & 1, l15 = lane & 15, g = lane >> 4;
  for (int tile = blockIdx.x; tile < 128 * 16; tile += gridDim.x) {
    const int tn = tile & 15, tm = tile >> 4;
    f32x4 acc[4][4]; zero_acc(acc);
    gemm_tile(xn2 + (size_t)tm * 256 * 1024, 1024, wq + (size_t)tn * 128 * 1024, 1024, 16, acc, smem);
    const int rbase = tm * 256 + wm * 64 + 4 * g;
    const int cbase = tn * 128 + wn * 64 + l15;
#pragma unroll
    for (int m = 0; m < 4; ++m)
#pragma unroll
      for (int n = 0; n < 4; ++n)
#pragma unroll
        for (int j = 0; j < 4; ++j) qp[(size_t)(rbase + m * 16 + j) * 2048 + cbase + n * 16] = f2bf(acc[m][n][j]);
  }
}

__device__ __forceinline__ void phase_pkeys(const Params& p, unsigned char* smem) {
  unsigned char* ws = p.ws;
  const bf16_t* qp = (const bf16_t*)(ws + WS_PG);
  const bf16_t* keys = (const bf16_t*)(ws + WS_KEYS);
  float* ps = (float*)(ws + WS_PA);
  int* pi = (int*)(ws + WS_PA) + (size_t)TOK * 256;
  float* sc = (float*)smem;
  const int tid = threadIdx.x, lane = tid & 63, w = tid >> 6, wm = w >> 1, wn = w & 1, l15 = lane & 15, g = lane >> 4;
  for (int tile = blockIdx.x; tile < 128 * 16; tile += gridDim.x) {
    const int hp = tile & 15, tm = tile >> 4;
    const int h = hp >> 1, ph = hp & 1;
    f32x4 acc[4][4]; zero_acc(acc);
    gemm_tile(qp + (size_t)tm * 256 * 2048 + hp * 128, 2048, keys + (size_t)(ph * 8 + h) * 128 * 128, 128, 2, acc, smem);
    __syncthreads();
#pragma unroll
    for (int m = 0; m < 4; ++m)
#pragma unroll
      for (int n = 0; n < 4; ++n)
#pragma unroll
        for (int j = 0; j < 4; ++j) sc[(wm * 64 + m * 16 + 4 * g + j) * 129 + wn * 64 + n * 16 + l15] = acc[m][n][j];
    __syncthreads();
    if (tid < 256) {
      const int row = tid;
      const float* rowp = sc + row * 129;
      unsigned tv[16];
#pragma unroll
      for (int k = 0; k < 16; ++k) tv[k] = 0u;
#pragma unroll 8
      for (int nn = 0; nn < 128; ++nn) {
        const unsigned bits = __float_as_uint(rowp[nn]);
        unsigned key = (bits & 0x80000000u) ? ~bits : (bits | 0x80000000u);
        key = (key & ~127u) | (unsigned)(127 - nn);
#pragma unroll
        for (int k = 15; k >= 1; --k) {
          unsigned r;
          asm("v_med3_u32 %0, %1, %2, %3" : "=v"(r) : "v"(tv[k]), "v"(tv[k - 1]), "v"(key));
          tv[k] = r;
        }
        tv[0] = tv[0] > key ? tv[0] : key;
      }
      const size_t ob = ((size_t)(tm * 256 + row) * 16 + hp) * 16;
      float ov[16]; int oi[16];
#pragma unroll
      for (int k = 0; k < 16; ++k) { oi[k] = 127 - (int)(tv[k] & 127u); ov[k] = rowp[oi[k]]; }
#pragma unroll
      for (int k = 0; k < 16; k += 4) {
        *(float4*)(ps + ob + k) = make_float4(ov[k], ov[k + 1], ov[k + 2], ov[k + 3]);
        *(int4*)(pi + ob + k) = make_int4(oi[k], oi[k + 1], oi[k + 2], oi[k + 3]);
      }
    }
    __syncthreads();
  }
}

__device__ __forceinline__ void phase_pcomb(const Params& p, unsigned char* smem) {
  unsigned char* ws = p.ws;
  const float* ps = (const float*)(ws + WS_PA);
  const int* pi = (const int*)(ws + WS_PA) + (size_t)TOK * 256;
  int* eidx = (int*)(ws + WS_EIDX);
  float* gw = (float*)(ws + WS_GW);
  float* s2l = (float*)smem;
  unsigned short* i1l = (unsigned short*)(s2l + 512 * 17);
  unsigned short* i2l = i1l + 512 * 16;
  const int tid = threadIdx.x;
  for (int base = blockIdx.x * NTHREADS; base < TOK * 8; base += gridDim.x * NTHREADS) {
    const int th = base + tid;
    const size_t o1 = (size_t)th * 32;
    float s1[16];
#pragma unroll
    for (int a = 0; a < 16; ++a) {
      s1[a] = ps[o1 + a];
      s2l[tid * 17 + a] = ps[o1 + 16 + a];
      i1l[tid * 16 + a] = (unsigned short)pi[o1 + a];
      i2l[tid * 16 + a] = (unsigned short)pi[o1 + 16 + a];
    }
    float cur[16];
    const float s20 = s2l[tid * 17];
#pragma unroll
    for (int a = 0; a < 16; ++a) cur[a] = s1[a] + s20;
    unsigned long long ptr = 0ull;
    float tops[16]; int tope[16];
#pragma unroll
    for (int k = 0; k < 16; ++k) {
      float best = cur[0]; int ba = 0;
#pragma unroll
      for (int a = 1; a < 16; ++a) if (cur[a] > best) { best = cur[a]; ba = a; }
      const int bb = (int)((ptr >> (4 * ba)) & 15ull);
      tops[k] = best;
      tope[k] = (int)i1l[tid * 16 + ba] * 128 + (int)i2l[tid * 16 + bb];
      const int nb = bb + 1;
      const float ns2 = (nb < 16) ? s2l[tid * 17 + nb] : -INFINITY;
      if (nb < 16) ptr += (1ull << (4 * ba));
#pragma unroll
      for (int a = 0; a < 16; ++a) if (a == ba) cur[a] = s1[a] + ns2;
    }
    float m = tops[0];
    float sum = 0.f;
#pragma unroll
    for (int k = 0; k < 16; ++k) { tops[k] = __expf(tops[k] - m); sum += tops[k]; }
    const float inv = 1.f / sum;
#pragma unroll
    for (int k = 0; k < 16; ++k) { eidx[(size_t)th * 16 + k] = tope[k]; gw[(size_t)th * 16 + k] = tops[k] * inv; }
  }
}


__device__ __forceinline__ float reduce8(const float (&pv)[8], int lane) {
  const bool b5 = lane & 32, b4 = lane & 16, b3 = lane & 8;
  float v[4];
#pragma unroll
  for (int i = 0; i < 4; ++i) {
    const float keep = b5 ? pv[4 + i] : pv[i];
    const float send = b5 ? pv[i] : pv[4 + i];
    v[i] = keep + __shfl_xor(send, 32);
  }
  float u[2];
#pragma unroll
  for (int i = 0; i < 2; ++i) {
    const float keep = b4 ? v[2 + i] : v[i];
    const float send = b4 ? v[i] : v[2 + i];
    u[i] = keep + __shfl_xor(send, 16);
  }
  float x = (b3 ? u[1] : u[0]) + __shfl_xor(b3 ? u[0] : u[1], 8);
  x += __shfl_xor(x, 4); x += __shfl_xor(x, 2); x += __shfl_xor(x, 1);
  return x;
}

__device__ __forceinline__ void cvt16u8(const uint4& v, float* f) {
  f[0] = (float)(v.x & 0xffu); f[1] = (float)((v.x >> 8) & 0xffu); f[2] = (float)((v.x >> 16) & 0xffu); f[3] = (float)(v.x >> 24);
  f[4] = (float)(v.y & 0xffu); f[5] = (float)((v.y >> 8) & 0xffu); f[6] = (float)((v.y >> 16) & 0xffu); f[7] = (float)(v.y >> 24);
  f[8] = (float)(v.z & 0xffu); f[9] = (float)((v.z >> 8) & 0xffu); f[10] = (float)((v.z >> 16) & 0xffu); f[11] = (float)(v.z >> 24);
  f[12] = (float)(v.w & 0xffu); f[13] = (float)((v.w >> 8) & 0xffu); f[14] = (float)((v.w >> 16) & 0xffu); f[15] = (float)(v.w >> 24);
}

__device__ __forceinline__ int wave_sum_i32_dpp(int v) {
  v += __builtin_amdgcn_update_dpp(0, v, 0xB1, 0xf, 0xf, true);
  v += __builtin_amdgcn_update_dpp(0, v, 0x4E, 0xf, 0xf, true);
  v += __builtin_amdgcn_update_dpp(0, v, 0x141, 0xf, 0xf, true);
  v += __builtin_amdgcn_update_dpp(0, v, 0x140, 0xf, 0xf, true);
  return __builtin_amdgcn_readlane(v, 0) + __builtin_amdgcn_readlane(v, 16) + __builtin_amdgcn_readlane(v, 32) + __builtin_amdgcn_readlane(v, 48);
}

__device__ __forceinline__ int reduce8_i32_scatter(const int (&d)[8], int lane) {
  const bool b0 = lane & 1, b1 = lane & 2, b2 = lane & 4;
  int v[4];
#pragma unroll
  for (int i = 0; i < 4; ++i) {
    const int keep = b0 ? d[2 * i + 1] : d[2 * i];
    const int send = b0 ? d[2 * i] : d[2 * i + 1];
    v[i] = keep + __builtin_amdgcn_update_dpp(0, send, 0xB1, 0xf, 0xf, true);
  }
  int u[2];
#pragma unroll
  for (int i = 0; i < 2; ++i) {
    const int keep = b1 ? v[2 * i + 1] : v[2 * i];
    const int send = b1 ? v[2 * i] : v[2 * i + 1];
    u[i] = keep + __builtin_amdgcn_update_dpp(0, send, 0x4E, 0xf, 0xf, true);
  }
  int x;
  {
    const int keep = b2 ? u[1] : u[0];
    const int send = b2 ? u[0] : u[1];
    int t = __builtin_amdgcn_update_dpp(0, send, 0x141, 0xf, 0xf, true);
    t = __builtin_amdgcn_update_dpp(0, t, 0x1B, 0xf, 0xf, true);
    x = keep + t;
  }
  x += __builtin_amdgcn_update_dpp(0, x, 0x128, 0xf, 0xf, true);
  { const auto r = __builtin_amdgcn_permlane16_swap((unsigned)x, (unsigned)x, false, false); x = (int)r[0] + (int)r[1]; }
  { const auto r = __builtin_amdgcn_permlane32_swap((unsigned)x, (unsigned)x, false, false); x = (int)r[0] + (int)r[1]; }
  return x;
}

__device__ __forceinline__ void phase_pu(const Params& p, unsigned char* smem) {
  unsigned char* ws = p.ws;
  const unsigned char* XQ = ws + WS_XQ;
  const float* xs = (const float*)(ws + WS_XS);
  const unsigned char* U8 = ws + WS_U;
  const float* us = (const float*)(ws + WS_U + (size_t)16384 * 1024);
  const float* vs = (const float*)(ws + WS_V + (size_t)16384 * 1024);
  const int* eidx = (const int*)(ws + WS_EIDX);
  const float* gw = (const float*)(ws + WS_GW);
  float* aw = (float*)(ws + WS_PA);
  const int lane = threadIdx.x & 63, w = threadIdx.x >> 6;
  const unsigned long long lt_mask = (1ull << lane) - 1ull;
  const int G = gridDim.x;
  const bool sliced = (G % 8 == 0);
  const int ti = sliced ? team_index(p, smem) : 0;
  const int tsz = sliced ? (G >> 3) : G;
  const int grp_lo = sliced ? ti / tsz : 0, grp_hi = sliced ? grp_lo + 1 : 8;
  const int slot = (sliced ? (ti % tsz) : (int)blockIdx.x) * 8 + w;
  const int nslot = tsz * 8;
  unsigned* lst = (unsigned*)smem + 4096 + w * 128;
  typedef unsigned u32x4_t __attribute__((ext_vector_type(4)));
  if (slot >= TOK) return;
  for (int grp = grp_lo; grp < grp_hi; ++grp) {
#define PU_LIST(E0, E1, N, L0, L1) do { \
      const bool m0_ = ((E0) >> 11) == grp, m1_ = ((E1) >> 11) == grp; \
      const unsigned long long b0_ = __ballot(m0_), b1_ = __ballot(m1_); \
      const int c0_ = __popcll(b0_); N = c0_ + __popcll(b1_); \
      if (m0_) lst[__popcll(b0_ & lt_mask)] = ((unsigned)lane << 14) | (unsigned)(E0); \
      if (m1_) lst[c0_ + __popcll(b1_ & lt_mask)] = ((unsigned)(lane + 64) << 14) | (unsigned)(E1); \
      lds_fence(); \
      L0 = (lane < N) ? lst[lane] : 0u; L1 = (lane + 64 < N) ? lst[lane + 64] : 0u; \
      lds_fence(); } while (0)
#define PU_ISSUE(BUF, L0, N, I0) do { int last_ = ((N) < 64 ? (N) : 64) - 1; last_ = last_ < 0 ? 0 : last_; \
      _Pragma("unroll") for (int j = 0; j < 8; ++j) { int idx_ = (I0) + j; idx_ = idx_ < last_ ? idx_ : last_; \
        const unsigned le_ = (unsigned)__builtin_amdgcn_readlane((int)(L0), idx_); \
        BUF[j] = *(const u32x4_t*)(U8 + (size_t)(le_ & 16383u) * 1024 + lane * 16); } } while (0)
#define PU_REDUCE(BUF, X, I0, HREG) do { int dd_[8]; _Pragma("unroll") for (int j = 0; j < 8; ++j) { \
        int d_ = __builtin_amdgcn_sdot4((int)BUF[j].x, (int)(X).x, 0, false); \
        d_ = __builtin_amdgcn_sdot4((int)BUF[j].y, (int)(X).y, d_, false); \
        d_ = __builtin_amdgcn_sdot4((int)BUF[j].z, (int)(X).z, d_, false); \
        dd_[j] = __builtin_amdgcn_sdot4((int)BUF[j].w, (int)(X).w, d_, false); } \
      const int tot_ = reduce8_i32_scatter(dd_, lane);     \
      if (lane >= (I0) && lane < (I0) + 8) HREG = tot_; } while (0)
    u32x4_t cx = *(const u32x4_t*)(XQ + (size_t)slot * 1024 + lane * 16);
    int ce0 = eidx[(size_t)slot * 128 + lane], ce1 = eidx[(size_t)slot * 128 + 64 + lane];
    float cxs = xs[slot];
    int cn; unsigned cl0, cl1;
    PU_LIST(ce0, ce1, cn, cl0, cl1);
    u32x4_t ra[8], rb[8], rc[8];
    PU_ISSUE(ra, cl0, cn, 0);
    PU_ISSUE(rb, cl0, cn, 8);
    int t1 = (slot + nslot < TOK) ? slot + nslot : slot;
    u32x4_t nx = *(const u32x4_t*)(XQ + (size_t)t1 * 1024 + lane * 16);
    int ne0 = eidx[(size_t)t1 * 128 + lane], ne1 = eidx[(size_t)t1 * 128 + 64 + lane];
    float nxs = xs[t1];
    for (int tok = slot; tok < TOK; tok += nslot) {
      float sc0 = 0.f, sc1 = 0.f, gv0 = 0.f, gv1 = 0.f, vv0 = 0.f, vv1 = 0.f;
      if (lane < cn) { const int e = cl0 & 16383; sc0 = us[e]; vv0 = vs[e]; gv0 = gw[(size_t)tok * 128 + (cl0 >> 14)]; }
      if (lane + 64 < cn) { const int e = cl1 & 16383; sc1 = us[e]; vv1 = vs[e]; gv1 = gw[(size_t)tok * 128 + (cl1 >> 14)]; }
      int nn; unsigned nl0, nl1;
      PU_LIST(ne0, ne1, nn, nl0, nl1);
      const u32x4_t x1 = nx; const int xe0 = ne0, xe1 = ne1; const float xs1 = nxs;
      const int t2a = tok + nslot, t2 = (t2a + nslot < TOK) ? t2a + nslot : ((t2a < TOK) ? t2a : tok);
      nx = *(const u32x4_t*)(XQ + (size_t)t2 * 1024 + lane * 16);
      ne0 = eidx[(size_t)t2 * 128 + lane]; ne1 = eidx[(size_t)t2 * 128 + 64 + lane];
      nxs = xs[t2];
      int h0i = 0, h1i = 0;
      PU_ISSUE(rc, cl0, cn, 16); __builtin_amdgcn_sched_barrier(0); PU_REDUCE(ra, cx, 0, h0i);  __builtin_amdgcn_sched_barrier(0);
      PU_ISSUE(ra, nl0, nn, 0);  __builtin_amdgcn_sched_barrier(0); PU_REDUCE(rb, cx, 8, h0i);  __builtin_amdgcn_sched_barrier(0);
      PU_ISSUE(rb, nl0, nn, 8);  __builtin_amdgcn_sched_barrier(0); PU_REDUCE(rc, cx, 16, h0i); __builtin_amdgcn_sched_barrier(0);
      if (cn > 24) {
        for (int i0 = 24; i0 < cn; i0 += 8) {
          u32x4_t rd[8];
          const bool lo = i0 < 64;
          const unsigned lsrc = lo ? cl0 : cl1;
          const int nsrc = lo ? cn : cn - 64;
          PU_ISSUE(rd, lsrc, nsrc, i0 & 63);
          if (lo) { PU_REDUCE(rd, cx, i0, h0i); } else { PU_REDUCE(rd, cx, i0 - 64, h1i); }
        }
      }
      const float h0 = (float)h0i * sc0 * cxs, h1 = (float)h1i * sc1 * cxs;
      if (lane < cn) aw[(size_t)tok * 128 + (cl0 >> 14)] = 0.5f * h0 * (1.f + erff(h0 * 0.70710678118654752f)) * gv0 * vv0;
      if (lane + 64 < cn) aw[(size_t)tok * 128 + (cl1 >> 14)] = 0.5f * h1 * (1.f + erff(h1 * 0.70710678118654752f)) * gv1 * vv1;
      cx = x1; ce0 = xe0; ce1 = xe1; cxs = xs1; cn = nn; cl0 = nl0; cl1 = nl1;
    }
#undef PU_LIST
#undef PU_ISSUE
#undef PU_REDUCE
  }
}

template <bool SL>
__device__ __forceinline__ void phase_pv_t(const Params& p, unsigned char* smem) {
  unsigned char* ws = p.ws;
  const unsigned char* V8 = ws + WS_V;
  const int* eidx = (const int*)(ws + WS_EIDX);
  const float* aw = (const float*)(ws + WS_PA);
  float* ssq = (float*)(ws + WS_SSQ);
  const int lane = threadIdx.x & 63, w = threadIdx.x >> 6;
  const int q = lane >> 3, c = lane & 7;
  const int G = gridDim.x;
  constexpr bool sliced = SL;
  const int ti = sliced ? team_index(p, smem) : 0;
  const int tsz = G >> 3;
  const int grp0 = sliced ? (ti / tsz) : 0;
  constexpr int ngrp = sliced ? 1 : 8;
  const int slot = sliced ? (ti % tsz) * 8 + w : blockIdx.x * 8 + w;
  const int nslot = sliced ? tsz * 8 : G * 8;
  int ee[16]; float aa[16];
  if (slot < TOK) {
    unsigned bi = (unsigned)slot * 128u + (unsigned)q;
    asm volatile("" : "+v"(bi));
#pragma unroll
    for (int u = 0; u < 16; ++u) { ee[u] = eidx[bi + 8 * u]; aa[u] = aw[bi + 8 * u]; }
  }
  for (int tok = slot; tok < TOK; tok += nslot) {
    int ce[16]; float ca[16];
    float suma = 0.f;
#pragma unroll
    for (int u = 0; u < 16; ++u) { ce[u] = ee[u]; ca[u] = aa[u]; suma += aa[u]; }
    for (int gi = 0; gi < ngrp; ++gi) {
      const int grp = grp0 + gi;
      uint4 vv[16];
#pragma unroll
      for (int u = 0; u < 16; ++u) vv[u] = *(const uint4*)(V8 + (size_t)grp * (16384 * 128) + (size_t)ce[u] * 128 + c * 16);
      float* orow = p.out + (size_t)tok * 1024 + grp * 128 + c * 16;
      float4 x1v[4];
#pragma unroll
      for (int i = 0; i < 4; ++i) x1v[i] = *(const float4*)(orow + 4 * i);
      if (gi == ngrp - 1) {
        const int nt = (tok + nslot < TOK) ? tok + nslot : tok;
        unsigned bi = (unsigned)nt * 128u + (unsigned)q;
        asm volatile("" : "+v"(bi));
#pragma unroll
        for (int u = 0; u < 16; ++u) { ee[u] = eidx[bi + 8 * u]; aa[u] = aw[bi + 8 * u]; }
      }
      __builtin_amdgcn_sched_barrier(0);
      float acc[16];
#pragma unroll
      for (int i = 0; i < 16; ++i) acc[i] = -128.f * suma;
#pragma unroll
      for (int u = 0; u < 16; ++u) {
        float vf[16];
        cvt16u8(vv[u], vf);
#pragma unroll
        for (int i = 0; i < 16; ++i) acc[i] += ca[u] * vf[i];
        __builtin_amdgcn_sched_barrier(0);
      }
#pragma unroll
      for (int i = 0; i < 16; ++i) { acc[i] = add_xor8(acc[i]); acc[i] = add_xor16(acc[i]); acc[i] = add_xor32(acc[i]); }
      float ss = 0.f;
      if (q == 0) {
#pragma unroll
        for (int i = 0; i < 4; ++i) {
          const float4 oa = make_float4(x1v[i].x + acc[4 * i], x1v[i].y + acc[4 * i + 1], x1v[i].z + acc[4 * i + 2], x1v[i].w + acc[4 * i + 3]);
          *(float4*)(orow + 4 * i) = oa;
          ss += oa.x * oa.x + oa.y * oa.y + oa.z * oa.z + oa.w * oa.w;
        }
      }
      ss += __shfl_xor(ss, 1); ss += __shfl_xor(ss, 2); ss += __shfl_xor(ss, 4);
      if (lane == 0) atomicAdd(&ssq[tok], ss);
    }
  }
}

__device__ __forceinline__ void phase_final(const Params& p) {
  const float* ssq = (const float*)(p.ws + WS_SSQ);
  const int lane = threadIdx.x & 63, w = threadIdx.x >> 6;
  for (int row = blockIdx.x * 8 + w; row < TOK; row += gridDim.x * 8) {
    const float rstd = rsqrtf(ssq[row] * (1.f / DM) + EPSV);
    float4* o4 = (float4*)(p.out + (size_t)row * DM);
#pragma unroll
    for (int i = 0; i < 4; ++i) {
      float4 v = o4[lane + 64 * i];
      const float4 gg = ((const float4*)p.norm_final)[lane + 64 * i];
      v.x *= rstd * gg.x; v.y *= rstd * gg.y; v.z *= rstd * gg.z; v.w *= rstd * gg.w;
      o4[lane + 64 * i] = v;
    }
  }
}


__device__ __forceinline__ void phase_proj8(const Params& p, unsigned char* smem) {
  unsigned char* ws = p.ws;
  pg8::Gemm g{(const pg8::bf16_t*)(ws + WS_XN), (const pg8::bf16_t*)(ws + WS_WIN), TOK, 5120, 1024};
  pg8::StaticOrder S; S.init(TOK, 5120, (int)gridDim.x, (int)blockIdx.x);
  EpiProj E{(unsigned short*)(ws + WS_PH), (unsigned short*)(ws + WS_PA), (unsigned short*)(ws + WS_PG),
            (unsigned short*)(ws + WS_KC), (unsigned short*)(ws + WS_VC), (unsigned short*)(ws + WS_IKC)};
  pg8::gemm_phase<EpiProj, pg8::StaticOrder>((PG8_LAS unsigned char*)smem, g, S, E, nullptr);
}
__device__ __forceinline__ void phase_ikln(const Params& p) {
  bf16_t* ikc = (bf16_t*)(p.ws + WS_IKC);
  const int tid = threadIdx.x, sub = tid & 7;
  float gam[8], bet[8];
#pragma unroll
  for (int i = 0; i < 8; ++i) { gam[i] = p.ikg[sub * 8 + i]; bet[i] = p.ikb[sub * 8 + i]; }
  for (int row = blockIdx.x * 64 + (tid >> 3); row < TOK; row += gridDim.x * 64) {
    uint4* ptr = (uint4*)(ikc + (size_t)row * 64 + sub * 8);
    const uint4 raw = *ptr;
    float v[8];
    cvt8(raw, v);
    float s = 0.f;
#pragma unroll
    for (int i = 0; i < 8; ++i) s += v[i];
    s += __shfl_xor(s, 1); s += __shfl_xor(s, 2); s += __shfl_xor(s, 4);
    const float mu = s * (1.f / 64.f);
    float q = 0.f;
#pragma unroll
    for (int i = 0; i < 8; ++i) { const float d = v[i] - mu; q += d * d; }
    q += __shfl_xor(q, 1); q += __shfl_xor(q, 2); q += __shfl_xor(q, 4);
    const float rstd = rsqrtf(q * (1.f / 64.f) + EPSV);
    uint4 o;
    o.x = pack2((v[0] - mu) * rstd * gam[0] + bet[0], (v[1] - mu) * rstd * gam[1] + bet[1]);
    o.y = pack2((v[2] - mu) * rstd * gam[2] + bet[2], (v[3] - mu) * rstd * gam[3] + bet[3]);
    o.z = pack2((v[4] - mu) * rstd * gam[4] + bet[4], (v[5] - mu) * rstd * gam[5] + bet[5]);
    o.w = pack2((v[6] - mu) * rstd * gam[6] + bet[6], (v[7] - mu) * rstd * gam[7] + bet[7]);
    *ptr = o;
  }
}
__device__ __forceinline__ void phase_up8(const Params& p, unsigned char* smem) {
  unsigned char* ws = p.ws;
  const pg8::bf16_t* ya = (const pg8::bf16_t*)(ws + WS_XN);
  const pg8::bf16_t* yb = ya + (size_t)TOK * 512;
  pg8::StaticOrder S; S.init(TOK, 1024, (int)gridDim.x, (int)blockIdx.x);
  {
    pg8::Gemm g{ya, (const pg8::bf16_t*)(ws + WS_WUPA), TOK, 1024, 512};
    EpiGate<0> E{(unsigned short*)(ws + WS_PH), (const unsigned short*)(ws + WS_PG), 0};
    pg8::gemm_phase<EpiGate<0>, pg8::StaticOrder>((PG8_LAS unsigned char*)smem, g, S, E, nullptr);
  }
  {
    pg8::Gemm g{yb, (const pg8::bf16_t*)(ws + WS_WUPB), TOK, 1024, 512};
    EpiGate<1> E{(unsigned short*)(ws + WS_PH), (const unsigned short*)(ws + WS_PG), 1024};
    pg8::gemm_phase<EpiGate<1>, pg8::StaticOrder>((PG8_LAS unsigned char*)smem, g, S, E, nullptr);
  }
}
__device__ __forceinline__ void phase_out8(const Params& p, unsigned char* smem) {
  unsigned char* ws = p.ws;
  pg8::Gemm g{(const pg8::bf16_t*)(ws + WS_PH), (const pg8::bf16_t*)(ws + WS_WOUT), TOK, 1024, 1024};
  pg8::StaticOrder S; S.init(TOK, 1024, (int)gridDim.x, (int)blockIdx.x);
  EpiResid E{p.out, p.x};
  pg8::gemm_phase<EpiResid, pg8::StaticOrder>((PG8_LAS unsigned char*)smem, g, S, E, nullptr);
}
__device__ __forceinline__ void phase_pq8(const Params& p, unsigned char* smem) {
  unsigned char* ws = p.ws;
  pg8::Gemm g{(const pg8::bf16_t*)(ws + WS_XN), (const pg8::bf16_t*)(ws + WS_WQ), TOK, 2048, 1024};
  pg8::StaticOrder S; S.init(TOK, 2048, (int)gridDim.x, (int)blockIdx.x);
  EpiStoreBf16 E{(unsigned short*)(ws + WS_PG), 2048};
  pg8::gemm_phase<EpiStoreBf16, pg8::StaticOrder>((PG8_LAS unsigned char*)smem, g, S, E, nullptr);
}

__global__ void __launch_bounds__(NTHREADS) hybrid_fwd(Params p) {
  extern __shared__ __attribute__((aligned(16))) unsigned char smem[];
#if ONE_LAUNCH
  cg::grid_group grid = cg::this_grid();
  volatile LAS unsigned* xst = (volatile LAS unsigned*)(smem + LDS_BYTES - 16);
  if (threadIdx.x == 0) { xst[0] = 0u; xst[1] = 0u; }
  __syncthreads();
  XcdBarrier xbar = xcd_barrier_post((unsigned*)(p.ws + WS_BAR), xst);
#define SEAM(k) do { if (p.ph_lo <= (k) && (k) + 1 < p.ph_hi) { if (p.ph_hi > NPHASE) grid.sync(); else xcd_barrier(xbar); } } while (0)
#else
#define SEAM(k) do { } while (0)
#endif
#define IN(k) (p.ph_lo <= (k) && (k) < p.ph_hi)
#ifndef REPEAT_PH
#define REPEAT_PH -1
#endif
#define REP(k, stmt) do { if (REPEAT_PH == (k)) { stmt; grid.sync(); } } while (0)
  if (IN(0)) { phase_prep(p, smem); SEAM(0); }
  if (IN(1)) { phase_proj8(p, smem); SEAM(1); }
  if (IN(2)) { phase_ikln(p); hgrn_h1_all(p, smem); SEAM(2); }
  if (IN(3)) { phase_mix(p, smem); SEAM(3); }
  if (IN(4)) { phase_up8(p, smem); SEAM(4); }
  if (IN(5)) { phase_out8(p, smem); SEAM(5); }
  if (IN(6)) { rmsnorm_rows_q(p.out, p.norm_ffn, (bf16_t*)(p.ws + WS_XN), p.ws + WS_XQ, (float*)(p.ws + WS_XS)); SEAM(6); }
  if (IN(7)) { phase_pq8(p, smem); SEAM(7); }
  if (IN(8)) { phase_pkeys(p, smem); SEAM(8); }
  if (IN(9)) { phase_pcomb(p, smem); SEAM(9); }
  if (IN(10)) { phase_pu(p, smem); SEAM(10); }
  if (IN(11)) { if (gridDim.x % 8 == 0) phase_pv_t<true>(p, smem); else phase_pv_t<false>(p, smem); SEAM(11); }
  if (IN(12)) { phase_final(p); }
#undef IN
#undef SEAM
}

extern "C" void kernel_launch(void* const* d_in, const int* in_sizes, int n_in, void* d_out, int out_size, void* d_ws, size_t ws_size,
                              hipStream_t stream) {
  static int grid = 0;
  if (grid == 0) {
    if (n_in != 17 || ws_size < WS_END) {
      fprintf(stderr, "kernel_launch: unexpected n_in %d or ws_size %zu (need %zu)\n", n_in, ws_size, (size_t)WS_END);
      grid = -1; return;
    }
    int dev = 0, cus = 0, per_cu = 0;
    hipGetDevice(&dev);
    hipDeviceGetAttribute(&cus, hipDeviceAttributeMultiprocessorCount, dev);
    hipFuncSetAttribute((const void*)hybrid_fwd, hipFuncAttributeMaxDynamicSharedMemorySize, LDS_BYTES);
    hipOccupancyMaxActiveBlocksPerMultiprocessor(&per_cu, (const void*)hybrid_fwd, NTHREADS, LDS_BYTES);
    if (per_cu < 1) { fprintf(stderr, "kernel_launch: occupancy query says %d blocks/CU\n", per_cu); per_cu = 1; }
    (void)hipGetLastError();
    grid = cus;
  }
  if (grid < 0) return;
  Params p{};
  p.x = (const float*)d_in[0]; p.norm_mix = (const float*)d_in[1]; p.w_in = (const float*)d_in[2]; p.hg_lb = (const float*)d_in[3];
  p.hg_norm = (const float*)d_in[4]; p.ikg = (const float*)d_in[5]; p.ikb = (const float*)d_in[6]; p.rel_bias = (const float*)d_in[7];
  p.w_up_a = (const float*)d_in[8]; p.w_up_b = (const float*)d_in[9]; p.w_out = (const float*)d_in[10]; p.norm_ffn = (const float*)d_in[11];
  p.peer_wq = (const float*)d_in[12]; p.peer_keys = (const float*)d_in[13]; p.peer_u = (const float*)d_in[14]; p.peer_v = (const float*)d_in[15];
  p.norm_final = (const float*)d_in[16];
  p.out = (float*)d_out; p.ws = (unsigned char*)d_ws;
#if ONE_LAUNCH
  hipMemsetAsync((unsigned char*)d_ws + WS_BAR, 0, 16384, stream);
  p.ph_lo = 0; p.ph_hi = NPHASE;
  void* args[] = {&p};
  hipError_t e = hipLaunchCooperativeKernel((const void*)hybrid_fwd, dim3(grid), dim3(NTHREADS), args, LDS_BYTES, stream);
  if (e != hipSuccess) fprintf(stderr, "cooperative launch failed: %s (grid %d)\n", hipGetErrorString(e), grid);
#else
  for (int ph = 0; ph < NPHASE; ++ph) {
    p.ph_lo = ph; p.ph_hi = ph + 1;
    hipLaunchKernelGGL(hybrid_fwd, dim3(grid), dim3(NTHREADS), LDS_BYTES, stream, p);
  }
#endif
}
```

```cpp
#include <hip/hip_runtime.h>
#include <hip/hip_cooperative_groups.h>
#include <stdint.h>
#include <stdio.h>
namespace cg = cooperative_groups;

#ifndef ONE_LAUNCH
#define ONE_LAUNCH 1
#endif

typedef unsigned short bf16_t;
typedef __attribute__((ext_vector_type(8))) short bf16x8;
typedef __attribute__((ext_vector_type(4))) float f32x4;

#define NTHREADS 512
#define TOK 32768
#define SEQL 4096
#define DM 1024
#define EPSV 1e-6f
#define NPHASE 13

#define WS_WIN   ((size_t)0)
#define WS_WUPA  (WS_WIN  + (size_t)5120 * 1024 * 2)
#define WS_WUPB  (WS_WUPA + (size_t)1024 * 512 * 2)
#define WS_WOUT  (WS_WUPB + (size_t)1024 * 512 * 2)
#define WS_WQ    (WS_WOUT + (size_t)1024 * 1024 * 2)
#define WS_KEYS  (WS_WQ   + (size_t)2048 * 1024 * 2)
#define WS_LB    (WS_KEYS + (size_t)2 * 8 * 128 * 128 * 2)
#define WS_U     (WS_LB   + (size_t)4096)
#define WS_V     (WS_U    + (size_t)16384 * 1024 * 2)
#define WS_XN    (WS_V    + (size_t)16384 * 1024 * 2)
#define WS_PH    (WS_XN   + (size_t)TOK * 1024 * 2)
#define WS_PA    (WS_PH   + (size_t)TOK * 2048 * 2)
#define WS_PG    (WS_PA   + (size_t)TOK * 1024 * 2)
#define WS_EIDX  (WS_PG   + (size_t)TOK * 2048 * 2)
#define WS_GW    (WS_EIDX + (size_t)TOK * 128 * 4)
#define WS_SSQ   (WS_GW   + (size_t)TOK * 128 * 4)
#define WS_XCC   (WS_SSQ  + (size_t)TOK * 4)
#define WS_BAR   (WS_XCC  + (size_t)4096)
#define WS_DEC   (WS_BAR  + (size_t)16384)
#define WS_QCTR  (WS_DEC  + (size_t)2048 * 384 * 4)
#define WS_END   (WS_QCTR + (size_t)1024)

#define WS_KC (WS_EIDX)
#define WS_VC (WS_KC + (size_t)TOK * 128)
#define WS_IKC (WS_VC + (size_t)TOK * 128)
#define LDS_BYTES 155648

struct Params {
  const float* x; const float* norm_mix; const float* w_in; const float* hg_lb; const float* hg_norm;
  const float* ikg; const float* ikb; const float* rel_bias; const float* w_up_a; const float* w_up_b;
  const float* w_out; const float* norm_ffn; const float* peer_wq; const float* peer_keys;
  const float* peer_u; const float* peer_v; const float* norm_final;
  float* out; unsigned char* ws; int ph_lo, ph_hi;
};

__device__ __forceinline__ float bf2f(bf16_t u) { return __uint_as_float(((unsigned)u) << 16); }
typedef float f32x2_cv __attribute__((ext_vector_type(2)));
typedef __bf16 bf16x2_cv __attribute__((ext_vector_type(2)));
__device__ __forceinline__ unsigned pack2(float a, float b) {
  const f32x2_cv v = {a, b};
  return __builtin_bit_cast(unsigned, __builtin_convertvector(v, bf16x2_cv));
}
__device__ __forceinline__ bf16_t f2bf(float f) { return (bf16_t)(pack2(f, f) & 0xffffu); }
__device__ __forceinline__ float wave_sum_slow(float v) {
#pragma unroll
  for (int o = 32; o > 0; o >>= 1) v += __shfl_xor(v, o);
  return v;
}
__device__ __forceinline__ void lds_fence() { asm volatile("s_waitcnt lgkmcnt(0)" ::: "memory"); }

__device__ __forceinline__ float add_xor8(float v) { return v + __int_as_float(__builtin_amdgcn_update_dpp(0, __float_as_int(v), 0x128, 0xf, 0xf, true)); }
__device__ __forceinline__ float add_xor16(float v) { const auto r = __builtin_amdgcn_permlane16_swap(__float_as_uint(v), __float_as_uint(v), false, false); return __uint_as_float(r[0]) + __uint_as_float(r[1]); }
__device__ __forceinline__ float add_xor32(float v) { const auto r = __builtin_amdgcn_permlane32_swap(__float_as_uint(v), __float_as_uint(v), false, false); return __uint_as_float(r[0]) + __uint_as_float(r[1]); }
__device__ __forceinline__ float max_xor16(float v) { const auto r = __builtin_amdgcn_permlane16_swap(__float_as_uint(v), __float_as_uint(v), false, false); return fmaxf(__uint_as_float(r[0]), __uint_as_float(r[1])); }
__device__ __forceinline__ float max_xor32(float v) { const auto r = __builtin_amdgcn_permlane32_swap(__float_as_uint(v), __float_as_uint(v), false, false); return fmaxf(__uint_as_float(r[0]), __uint_as_float(r[1])); }
__device__ __forceinline__ float wave_sum(float v) {
  v += __int_as_float(__builtin_amdgcn_update_dpp(0, __float_as_int(v), 0xB1, 0xf, 0xf, true));
  v += __int_as_float(__builtin_amdgcn_update_dpp(0, __float_as_int(v), 0x4E, 0xf, 0xf, true));
  v += __int_as_float(__builtin_amdgcn_update_dpp(0, __float_as_int(v), 0x141, 0xf, 0xf, true));
  v += __int_as_float(__builtin_amdgcn_update_dpp(0, __float_as_int(v), 0x140, 0xf, 0xf, true));
  return add_xor32(add_xor16(v));
}
__device__ __forceinline__ float sigmoidf_(float x) { return 1.f / (1.f + __expf(-x)); }
__device__ __forceinline__ float siluf_(float x) { return x / (1.f + __expf(-x)); }


#define XB_TMO      128
#define XB_XCNT(j)  (256  + 64 * (j))
#define XB_XSUB(j)  (1280 + 64 * (j))
#define XB_XGEN(j)  (2304 + 64 * (j))
#define XB_TOP      3328
#define XB_TOPGEN   3392
#define XCD_BAR_WORDS 3456
#define XB_SPIN_CAP (1u << 22)
#define LAS __attribute__((address_space(3)))
__device__ __forceinline__ unsigned xb_ld(unsigned* p)              { return __hip_atomic_load(p, __ATOMIC_RELAXED, __HIP_MEMORY_SCOPE_AGENT); }
__device__ __forceinline__ unsigned xb_add(unsigned* p, unsigned v) { return __hip_atomic_fetch_add(p, v, __ATOMIC_RELAXED, __HIP_MEMORY_SCOPE_AGENT); }
__device__ __forceinline__ unsigned xb_xcc_id() { return (unsigned)__builtin_amdgcn_s_getreg((3 << 11) | 20) & 0xFu; }
#define XB_SPIN(cond, bar) do { unsigned _sp = 0; while (cond) { __builtin_amdgcn_s_sleep(1); \
    if ((++_sp & 255u) == 0u) { if (xb_ld(&(bar)[XB_TMO])) break; if (_sp > XB_SPIN_CAP) { atomicAdd(&(bar)[XB_TMO], 1u); break; } } } } while (0)
struct XcdBarrier { unsigned* bar; unsigned x; volatile LAS unsigned* st; };
__device__ __forceinline__ XcdBarrier xcd_barrier_post(unsigned* bar, volatile LAS unsigned* st) {
  XcdBarrier b; b.bar = bar; b.x = xb_xcc_id(); b.st = st;
  if (threadIdx.x == 0) (void)xb_add(&bar[XB_XCNT(b.x)], 1u);
  return b;
}
__device__ __forceinline__ void xcd_barrier_complete(unsigned* bar, unsigned x, unsigned& nloc, unsigned& nx) {
  const unsigned G = gridDim.x * gridDim.y * gridDim.z;
  unsigned sum, cnt, mine, sp = 0u;
  for (;;) {
    sum = 0u; cnt = 0u; mine = 0u;
#pragma unroll
    for (unsigned j = 0; j < 16; ++j) { const unsigned c = xb_ld(&bar[XB_XCNT(j)]); sum += c; cnt += (c > 0u) ? 1u : 0u; mine = (j == x) ? c : mine; }
    if (sum == G) break;
    __builtin_amdgcn_s_sleep(1);
    if ((++sp & 255u) == 0u) { if (xb_ld(&bar[XB_TMO])) break; if (sp > XB_SPIN_CAP) { atomicAdd(&bar[XB_TMO], 1u); break; } }
  }
  nloc = mine > 0u ? mine : 1u; nx = cnt > 0u ? cnt : 1u;
}
__device__ __forceinline__ void xcd_barrier(const XcdBarrier& b) {
  asm volatile("s_waitcnt vmcnt(0)" ::: "memory");
  __syncthreads();
  if (threadIdx.x == 0) {
    unsigned* bar = b.bar;
    __builtin_amdgcn_s_waitcnt(0);
    unsigned nloc = b.st[0], nx = b.st[1];
    if (nloc == 0u) { xcd_barrier_complete(bar, b.x, nloc, nx); b.st[0] = nloc; b.st[1] = nx; }
    const unsigned old = xb_add(&bar[XB_XSUB(b.x)], 1u);
    const unsigned gen = old / nloc;
    if (old + 1u == (gen + 1u) * nloc) {
      __builtin_amdgcn_fence(__ATOMIC_RELEASE, "agent");
      asm volatile("s_waitcnt vmcnt(0)" ::: "memory");
      const unsigned og = xb_add(&bar[XB_TOP], 1u);
      const unsigned tg = og / nx;
      if (og + 1u == (tg + 1u) * nx) xb_add(&bar[XB_TOPGEN], 1u);
      else XB_SPIN(xb_ld(&bar[XB_TOPGEN]) == tg, bar);
      __builtin_amdgcn_fence(__ATOMIC_ACQUIRE, "agent");
      xb_add(&bar[XB_XGEN(b.x)], 1u);
      asm volatile("s_waitcnt vmcnt(0)" ::: "memory");
    } else {
      XB_SPIN(xb_ld(&bar[XB_XGEN(b.x)]) == gen, bar);
      __builtin_amdgcn_fence(__ATOMIC_ACQUIRE, "agent");
      asm volatile("s_waitcnt vmcnt(0)" ::: "memory");
    }
  }
  __syncthreads();
}

namespace pg8 {
#define PG8_LAS __attribute__((address_space(3)))
typedef unsigned short bf16_t;
typedef short bf16x8 __attribute__((ext_vector_type(8)));
typedef float f32x4 __attribute__((ext_vector_type(4)));
typedef unsigned u32x4 __attribute__((ext_vector_type(4)));
constexpr int BM = 256, BK = 64, HALF = 128, HTB = HALF * BK * 2  , STAGE_BYTES = 8 * HTB, NXCD = 8, WGM = 8;

__host__ __device__ __forceinline__ int lds_byte(int r, int c) { const int st = (r >> 4) * 2 + (c >> 5), rr = r & 15, cc = c & 31, ob = rr * 64 + cc * 2; return st * 1024 + (ob ^ (((ob >> 9) & 1) << 5)); }
__host__ __device__ __forceinline__ void stage_rc(int b, int& R, int& C) { const int st = b / 1024, sb = b % 1024, swz = sb ^ (((sb >> 9) & 1) << 5); R = (st >> 1) * 16 + swz / 64; C = (st & 1) * 32 + (swz % 64) / 2; }
__host__ __device__ __forceinline__ int perm32(int rho) { const int n = rho >> 4, i = rho & 15; return 8 * (i >> 2) + 4 * n + (i & 3); }

struct Unit { int pm, pn; };
struct Gemm { const bf16_t* A; const bf16_t* Bt; int M, N, K; };

struct StaticOrder {
    int nM, nN, nwg, G, c;
    __host__ __device__ void init(int M, int N, int G_, int c_) { nM = M / BM; nN = N / BM; nwg = nM * nN; G = G_; c = c_; }
    __host__ __device__ bool next(int i, Unit& u) const {
        const long L = (long)i * G + c; if (L >= nwg) return false;
        int wgid = (int)L; { const int q = nwg / NXCD, r = nwg % NXCD, xcd = wgid % NXCD, off = wgid / NXCD; wgid = (xcd < r ? xcd * (q + 1) : r * (q + 1) + (xcd - r) * q) + off; }
        const int nig = WGM * nN, gid = wgid / nig, fm = gid * WGM, gsz = (nM - fm) < WGM ? (nM - fm) : WGM;
        u.pm = fm + ((wgid % nig) % gsz); u.pn = (wgid % nig) / gsz; return true;
    }
    __device__ __forceinline__ void a_ready(const Unit&) const {}
    __device__ __forceinline__ void done(const Unit&) const {}
};
__device__ __forceinline__ unsigned cvt_pk_bf16(float lo, float hi) { unsigned r; asm volatile("v_cvt_pk_bf16_f32 %0, %1, %2" : "=v"(r) : "v"(lo), "v"(hi)); return r; }
template <class Epi, class Sched, bool STAMP = false>
__device__ __forceinline__ void gemm_phase(PG8_LAS unsigned char* lds, const Gemm g, const Sched& S, const Epi& E, unsigned long long* stamps) {
    const int tid = threadIdx.x, wid = __builtin_amdgcn_readfirstlane(tid >> 6), lane = tid & 63, wr = wid >> 2, wc = wid & 3, fr = lane & 15, fq = lane >> 4;
    const int K = g.K, nt = K / BK;
    int ts_lo = 0, ts_hi = 0, nts = 0; const unsigned long long rt_entry = STAMP ? (unsigned long long)wall_clock64() : 0ull;
#define PG8_STAMP() do { if (STAMP && wid == 0 && nts < 64) { const unsigned long long _c = (unsigned long long)clock64(); \
        ts_lo = (lane == nts) ? (int)(unsigned)_c : ts_lo; ts_hi = (lane == nts) ? (int)(unsigned)(_c >> 32) : ts_hi; ++nts; } } while (0)
    PG8_STAMP();
    unsigned voffA[2], voffB[2];
#pragma unroll
    for (int i = 0; i < 2; ++i) { int R, C; stage_rc(tid * 16 + i * 8192, R, C); const int Rb = Epi::PERM ? ((R & ~31) + perm32(R & 31)) : R;
        voffA[i] = (unsigned)(R * K + C) * 2u; voffB[i] = (unsigned)(Rb * K + C) * 2u; }
    const size_t kstep = (size_t)(BK * 2);
    const size_t hstep = (size_t)HALF * K * 2;
    const size_t tstep = 2 * hstep;
    const unsigned ldsw = (unsigned)wid * 1024u;
    const int aoff = lds_byte(wr * 64 + fr, fq * 8), boff = lds_byte(wc * 32 + fr, fq * 8);
#define PG8_SA(b, h) (((b) * 2 + (h)) * HTB)
#define PG8_SB(b, h) ((4 + (b) * 2 + (h)) * HTB)
#define PG8_STAGE(bufoff, gbase, voff) do { _Pragma("unroll") for (int _i = 0; _i < 2; ++_i) \
        __builtin_amdgcn_global_load_lds((const unsigned*)((const char*)(gbase) + (voff)[_i]), (PG8_LAS unsigned*)(lds + (bufoff) + ldsw + _i * 8192), 16, 0, 0); } while (0)
#define PG8_LDA(dst, b, h) do { _Pragma("unroll") for (int m = 0; m < 4; ++m) _Pragma("unroll") for (int k = 0; k < 2; ++k) dst[m][k] = *(const PG8_LAS bf16x8*)(lds + PG8_SA(b, h) + aoff + m * 2048 + k * 1024); } while (0)
#define PG8_LDB(dst, b, h) do { _Pragma("unroll") for (int n = 0; n < 2; ++n) _Pragma("unroll") for (int k = 0; k < 2; ++k) dst[n][k] = *(const PG8_LAS bf16x8*)(lds + PG8_SB(b, h) + boff + n * 2048 + k * 1024); } while (0)
#define PG8_MMA(ai, bj, At, Bt) do { __builtin_amdgcn_s_setprio(1); _Pragma("unroll") for (int m = 0; m < 4; ++m) _Pragma("unroll") for (int n = 0; n < 2; ++n) _Pragma("unroll") for (int k = 0; k < 2; ++k) \
        acc[ai][bj][m][n] = __builtin_amdgcn_mfma_f32_16x16x32_bf16(Bt[n][k], At[m][k], acc[ai][bj][m][n], 0, 0, 0); __builtin_amdgcn_s_setprio(0); } while (0)
#define PG8_WAIT_V(n) asm volatile("s_waitcnt vmcnt(" #n ")" ::: "memory")
#define PG8_WAIT_L(n) asm volatile("s_waitcnt lgkmcnt(" #n ")" ::: "memory")
#define PG8_BAR __builtin_amdgcn_s_barrier()
#define PG8_SCHED __builtin_amdgcn_sched_barrier(0)
    Unit cur, nxt; int ui = 0;
    if (!S.next(0, cur)) return;
    f32x4 acc[2][2][4][2];
#pragma unroll
    for (int a = 0; a < 2; ++a)
#pragma unroll
        for (int b = 0; b < 2; ++b)
#pragma unroll
            for (int m = 0; m < 4; ++m)
#pragma unroll
                for (int n = 0; n < 2; ++n) acc[a][b][m][n] = (f32x4){0.f, 0.f, 0.f, 0.f};
    bf16x8 At[4][2], B0[2][2], B1[2][2];
    const char* cA = (const char*)g.A + (size_t)cur.pm * tstep; const char* cB = (const char*)g.Bt + (size_t)cur.pn * tstep;
    S.a_ready(cur);
    PG8_STAGE(PG8_SB(0, 0), cB, voffB); PG8_STAGE(PG8_SA(0, 0), cA, voffA); PG8_STAGE(PG8_SB(0, 1), cB + hstep, voffB); PG8_STAGE(PG8_SA(0, 1), cA + hstep, voffA);
    if (wr == 1) PG8_BAR;
    PG8_WAIT_V(4); PG8_BAR;
    PG8_STAGE(PG8_SB(1, 0), cB + kstep, voffB); PG8_STAGE(PG8_SA(1, 0), cA + kstep, voffA); PG8_STAGE(PG8_SB(1, 1), cB + hstep + kstep, voffB);
    PG8_WAIT_V(6); PG8_BAR;
    PG8_STAMP();
    for (;;) {
        const bool has_next = S.next(ui + 1, nxt);
        const char* nA = has_next ? (const char*)g.A + (size_t)nxt.pm * tstep : cA; const char* nB = has_next ? (const char*)g.Bt + (size_t)nxt.pn * tstep : cB;
        for (int t = 0; t < nt; t += 2) {
            const bool last = (t == nt - 2);
            const char* a1 = cA + (size_t)(t + 1) * kstep;
            const char* a2 = last ? nA : cA + (size_t)(t + 2) * kstep; const char* b2 = last ? nB : cB + (size_t)(t + 2) * kstep;
            const char* a3 = a2 + kstep; const char* b3 = b2 + kstep;
            if (last && has_next) S.a_ready(nxt);
            PG8_LDB(B0, 0, 0); PG8_SCHED; PG8_LDA(At, 0, 0); PG8_STAGE(PG8_SA(1, 1), a1 + hstep, voffA);
            PG8_WAIT_L(8); PG8_BAR; PG8_WAIT_L(0); PG8_MMA(0, 0, At, B0); PG8_BAR; PG8_SCHED;
            PG8_LDB(B1, 0, 1); PG8_STAGE(PG8_SB(0, 0), b2, voffB);
            PG8_BAR; PG8_WAIT_L(0); PG8_MMA(0, 1, At, B1); PG8_BAR;
            PG8_LDA(At, 0, 1); PG8_STAGE(PG8_SA(0, 0), a2, voffA);
            PG8_BAR; PG8_WAIT_L(0); PG8_MMA(1, 0, At, B0); PG8_BAR; PG8_SCHED;
            PG8_STAGE(PG8_SB(0, 1), b2 + hstep, voffB);
            PG8_WAIT_V(6); PG8_BAR; PG8_MMA(1, 1, At, B1); PG8_BAR;
            PG8_LDB(B0, 1, 0); PG8_SCHED; PG8_LDA(At, 1, 0); PG8_STAGE(PG8_SA(0, 1), a2 + hstep, voffA);
            PG8_WAIT_L(8); PG8_BAR; PG8_WAIT_L(0); PG8_MMA(0, 0, At, B0); PG8_BAR; PG8_SCHED;
            PG8_LDB(B1, 1, 1); PG8_STAGE(PG8_SB(1, 0), b3, voffB);
            PG8_BAR; PG8_WAIT_L(0); PG8_MMA(0, 1, At, B1); PG8_BAR;
            PG8_LDA(At, 1, 1); PG8_STAGE(PG8_SA(1, 0), a3, voffA);
            PG8_BAR; PG8_WAIT_L(0); PG8_MMA(1, 0, At, B0); PG8_BAR; PG8_SCHED;
            PG8_STAGE(PG8_SB(1, 1), b3 + hstep, voffB);
            PG8_WAIT_V(6); PG8_BAR; PG8_MMA(1, 1, At, B1); PG8_BAR;
        }
        PG8_STAMP();
        if constexpr (!Epi::AFTER_DRAIN) { E(acc, cur, wr, wc, fr, fq); S.done(cur); }
        PG8_STAMP();
        if (!has_next) break;
#pragma unroll
        for (int a = 0; a < 2; ++a)
#pragma unroll
            for (int b = 0; b < 2; ++b)
#pragma unroll
                for (int m = 0; m < 4; ++m)
#pragma unroll
                    for (int n = 0; n < 2; ++n) acc[a][b][m][n] = (f32x4){0.f, 0.f, 0.f, 0.f};
        cur = nxt; cA = nA; cB = nB; ++ui;
    }
    PG8_WAIT_V(0);
    if (wr == 0) PG8_BAR;
    PG8_BAR;
    if constexpr (Epi::AFTER_DRAIN) { E.fused(acc, cur, wr, wc, fr, fq, lds, wid, lane); S.done(cur); }
    PG8_STAMP();
    if (STAMP && wid == 0) { stamps[lane] = lane < nts ? (((unsigned long long)(unsigned)ts_hi << 32) | (unsigned)ts_lo) : 0ull;
        if (lane == 62) stamps[62] = rt_entry; if (lane == 63) stamps[63] = (unsigned long long)wall_clock64(); }
#undef PG8_STAMP
#undef PG8_SA
#undef PG8_SB
#undef PG8_STAGE
#undef PG8_LDA
#undef PG8_LDB
#undef PG8_MMA
#undef PG8_WAIT_V
#undef PG8_WAIT_L
#undef PG8_BAR
#undef PG8_SCHED
}
}

struct EpiProj {
  static constexpr bool PERM = true, AFTER_DRAIN = false;
  unsigned short* pH; unsigned short* pA; unsigned short* pG; unsigned short* kc; unsigned short* vc; unsigned short* ikc;
  __device__ __forceinline__ void operator()(const pg8::f32x4 (&acc)[2][2][4][2], const pg8::Unit& u, int wr, int wc, int fr, int fq) const {
    const int row0 = u.pm * 256 + wr * 64 + fr;
    unsigned short* base; int ldc, colt; bool sg = false;
    if (u.pn < 8) { base = pH; ldc = 2048; colt = u.pn * 256; }
    else if (u.pn < 12) { base = pA; ldc = 1024; colt = (u.pn - 8) * 256; }
    else { base = pG; ldc = 2048; colt = (u.pn - 12) * 256; sg = true; }
    const int col0 = colt + wc * 32 + 8 * fq;
#pragma unroll
    for (int ai = 0; ai < 2; ++ai)
#pragma unroll
      for (int m = 0; m < 4; ++m) {
        unsigned short* rowp = base + (size_t)(row0 + ai * 128 + m * 16) * ldc + col0;
#pragma unroll
        for (int bj = 0; bj < 2; ++bj) {
          pg8::f32x4 v0 = acc[ai][bj][m][0], v1 = acc[ai][bj][m][1];
          if (sg) {
#pragma unroll
            for (int j = 0; j < 4; ++j) { v0[j] = sigmoidf_(v0[j]); v1[j] = sigmoidf_(v1[j]); }
          }
          pg8::u32x4 w; w.x = pg8::cvt_pk_bf16(v0[0], v0[1]); w.y = pg8::cvt_pk_bf16(v0[2], v0[3]); w.z = pg8::cvt_pk_bf16(v1[0], v1[1]); w.w = pg8::cvt_pk_bf16(v1[2], v1[3]);
          unsigned short* dst = rowp + bj * 128;
          if (u.pn == 10 || u.pn == 11) {
            const int cs = col0 + bj * 128;
            const size_t r = (size_t)(row0 + ai * 128 + m * 16);
            if (cs >= 512 && cs < 576) dst = kc + r * 64 + (cs - 512);
            else if (cs >= 576 && cs < 640) dst = vc + r * 64 + (cs - 576);
            else if (cs >= 896 && cs < 960) dst = ikc + r * 64 + (cs - 896);
          }
          *(pg8::u32x4*)dst = w;
        }
      }
  }
};
template <int MODE> struct EpiGate {
  static constexpr bool PERM = true, AFTER_DRAIN = false;
  unsigned short* hb; const unsigned short* pG; int goff;
  __device__ __forceinline__ void operator()(const pg8::f32x4 (&acc)[2][2][4][2], const pg8::Unit& u, int wr, int wc, int fr, int fq) const {
    const int row0 = u.pm * 256 + wr * 64 + fr;
    const int col0 = u.pn * 256 + wc * 32 + 8 * fq;
#pragma unroll
    for (int ai = 0; ai < 2; ++ai)
#pragma unroll
      for (int m = 0; m < 4; ++m) {
        const size_t r = (size_t)(row0 + ai * 128 + m * 16);
        pg8::u32x4 gv[2], hv[2];
#pragma unroll
        for (int bj = 0; bj < 2; ++bj) {
          gv[bj] = *(const pg8::u32x4*)(pG + r * 2048 + goff + col0 + bj * 128);
          if (MODE == 1) hv[bj] = *(const pg8::u32x4*)(hb + r * 1024 + col0 + bj * 128);
        }
#pragma unroll
        for (int bj = 0; bj < 2; ++bj) {
          float o[8];
#pragma unroll
          for (int j = 0; j < 4; ++j) {
            const unsigned gw0 = gv[bj][j >> 1], gw1 = gv[bj][2 + (j >> 1)];
            const float g0 = (j & 1) ? __uint_as_float(gw0 & 0xffff0000u) : __uint_as_float(gw0 << 16);
            const float g1 = (j & 1) ? __uint_as_float(gw1 & 0xffff0000u) : __uint_as_float(gw1 << 16);
            o[j] = acc[ai][bj][m][0][j] * g0; o[4 + j] = acc[ai][bj][m][1][j] * g1;
            if (MODE == 1) {
              const unsigned hw0 = hv[bj][j >> 1], hw1 = hv[bj][2 + (j >> 1)];
              o[j] += (j & 1) ? __uint_as_float(hw0 & 0xffff0000u) : __uint_as_float(hw0 << 16);
              o[4 + j] += (j & 1) ? __uint_as_float(hw1 & 0xffff0000u) : __uint_as_float(hw1 << 16);
            }
          }
          pg8::u32x4 w; w.x = pg8::cvt_pk_bf16(o[0], o[1]); w.y = pg8::cvt_pk_bf16(o[2], o[3]); w.z = pg8::cvt_pk_bf16(o[4], o[5]); w.w = pg8::cvt_pk_bf16(o[6], o[7]);
          *(pg8::u32x4*)(hb + r * 1024 + col0 + bj * 128) = w;
        }
      }
  }
};
struct EpiResid {
  static constexpr bool PERM = false, AFTER_DRAIN = false;
  float* out; const float* x;
  __device__ __forceinline__ void operator()(const pg8::f32x4 (&acc)[2][2][4][2], const pg8::Unit& u, int wr, int wc, int fr, int fq) const {
    const int row0 = u.pm * 256 + wr * 64 + fr, col0 = u.pn * 256 + wc * 32 + 4 * fq;
#pragma unroll
    for (int ai = 0; ai < 2; ++ai)
#pragma unroll
      for (int m = 0; m < 4; ++m) {
        const size_t off = (size_t)(row0 + ai * 128 + m * 16) * 1024 + col0;
        pg8::f32x4 xv[2][2];
#pragma unroll
        for (int bj = 0; bj < 2; ++bj)
#pragma unroll
          for (int n = 0; n < 2; ++n) xv[bj][n] = *(const pg8::f32x4*)(x + off + bj * 128 + n * 16);
#pragma unroll
        for (int bj = 0; bj < 2; ++bj)
#pragma unroll
          for (int n = 0; n < 2; ++n) *(pg8::f32x4*)(out + off + bj * 128 + n * 16) = acc[ai][bj][m][n] + xv[bj][n];
      }
  }
};
struct EpiStoreBf16 {
  static constexpr bool PERM = true, AFTER_DRAIN = false;
  unsigned short* O; int ldc;
  __device__ __forceinline__ void operator()(const pg8::f32x4 (&acc)[2][2][4][2], const pg8::Unit& u, int wr, int wc, int fr, int fq) const {
    const int row0 = u.pm * 256 + wr * 64 + fr, col0 = u.pn * 256 + wc * 32 + 8 * fq;
#pragma unroll
    for (int ai = 0; ai < 2; ++ai)
#pragma unroll
      for (int m = 0; m < 4; ++m) {
        unsigned short* rowp = O + (size_t)(row0 + ai * 128 + m * 16) * ldc + col0;
#pragma unroll
        for (int bj = 0; bj < 2; ++bj) {
          const pg8::f32x4 v0 = acc[ai][bj][m][0], v1 = acc[ai][bj][m][1];
          pg8::u32x4 w; w.x = pg8::cvt_pk_bf16(v0[0], v0[1]); w.y = pg8::cvt_pk_bf16(v0[2], v0[3]); w.z = pg8::cvt_pk_bf16(v1[0], v1[1]); w.w = pg8::cvt_pk_bf16(v1[2], v1[3]);
          *(pg8::u32x4*)(rowp + bj * 128) = w;
        }
      }
  }
};

__device__ __forceinline__ void gemm_tile(const bf16_t* __restrict__ A, int lda, const bf16_t* __restrict__ Bt, int ldb,
                                          int nk, f32x4 (&acc)[4][4], unsigned char* smem) {
  const int tid = threadIdx.x, lane = tid & 63, w = tid >> 6, wm = w >> 1, wn = w & 1, l15 = lane & 15, g = lane >> 4;
  unsigned char* sA = smem;
  unsigned char* sB = smem + 32768;
  const int lr = tid >> 3, lc = tid & 7;
  const bf16_t* ga = A + (size_t)lr * lda + lc * 8;
  const bf16_t* gb = Bt + (size_t)lr * ldb + lc * 8;
  uint4 ra0, ra1, ra2, ra3, rb0, rb1;
  ra0 = *(const uint4*)(ga);
  ra1 = *(const uint4*)(ga + (size_t)64 * lda);
  ra2 = *(const uint4*)(ga + (size_t)128 * lda);
  ra3 = *(const uint4*)(ga + (size_t)192 * lda);
  rb0 = *(const uint4*)(gb);
  rb1 = *(const uint4*)(gb + (size_t)64 * ldb);
  const int sw = (lc ^ (lr & 7)) << 4;
  for (int kt = 0; kt < nk; ++kt) {
    __syncthreads();
    *(uint4*)(sA + (lr) * 128 + sw) = ra0;
    *(uint4*)(sA + (lr + 64) * 128 + sw) = ra1;
    *(uint4*)(sA + (lr + 128) * 128 + sw) = ra2;
    *(uint4*)(sA + (lr + 192) * 128 + sw) = ra3;
    *(uint4*)(sB + (lr) * 128 + sw) = rb0;
    *(uint4*)(sB + (lr + 64) * 128 + sw) = rb1;
    __syncthreads();
    if (kt + 1 < nk) {
      const int ko = (kt + 1) * 64;
      ra0 = *(const uint4*)(ga + ko);
      ra1 = *(const uint4*)(ga + (size_t)64 * lda + ko);
      ra2 = *(const uint4*)(ga + (size_t)128 * lda + ko);
      ra3 = *(const uint4*)(ga + (size_t)192 * lda + ko);
      rb0 = *(const uint4*)(gb + ko);
      rb1 = *(const uint4*)(gb + (size_t)64 * ldb + ko);
    }
#pragma unroll
    for (int ks = 0; ks < 2; ++ks) {
      bf16x8 a[4], b[4];
#pragma unroll
      for (int m = 0; m < 4; ++m) { const int r = wm * 64 + m * 16 + l15; a[m] = *(const bf16x8*)(sA + r * 128 + (((ks * 4 + g) ^ (r & 7)) << 4)); }
#pragma unroll
      for (int n = 0; n < 4; ++n) { const int r = wn * 64 + n * 16 + l15; b[n] = *(const bf16x8*)(sB + r * 128 + (((ks * 4 + g) ^ (r & 7)) << 4)); }
#pragma unroll
      for (int m = 0; m < 4; ++m)
#pragma unroll
        for (int n = 0; n < 4; ++n) acc[m][n] = __builtin_amdgcn_mfma_f32_16x16x32_bf16(a[m], b[n], acc[m][n], 0, 0, 0);
    }
  }
}

__device__ __forceinline__ void zero_acc(f32x4 (&acc)[4][4]) {
#pragma unroll
  for (int m = 0; m < 4; ++m)
#pragma unroll
    for (int n = 0; n < 4; ++n) acc[m][n] = (f32x4){0.f, 0.f, 0.f, 0.f};
}

__device__ __forceinline__ void transpose_tile(const float* __restrict__ src, int srcN, bf16_t* __restrict__ dst, int K, int n0, int k0,
                                               bool winmap, float* tile) {
  const int tid = threadIdx.x;
  const int nc = tid & 63, kr = tid >> 6;
  int ncol = n0 + nc; bool valid = true;
  if (winmap) { if (ncol >= 3072) ncol -= 60; else if (ncol >= 3012) valid = false; }
#pragma unroll
  for (int i = 0; i < 8; ++i) {
    const int k = kr + 8 * i;
    tile[k * 65 + nc] = valid ? src[(size_t)(k0 + k) * srcN + ncol] : 0.f;
  }
  __syncthreads();
#pragma unroll
  for (int i = 0; i < 8; ++i) {
    const int nr = kr + 8 * i;
    dst[(size_t)(n0 + nr) * K + k0 + nc] = f2bf(tile[nc * 65 + nr]);
  }
  __syncthreads();
}

__device__ __forceinline__ void convert_f32_bf16(const float* __restrict__ src, bf16_t* __restrict__ dst, size_t n4) {
  for (size_t i = (size_t)blockIdx.x * NTHREADS + threadIdx.x; i < n4; i += (size_t)gridDim.x * NTHREADS) {
    const float4 v = ((const float4*)src)[i];
    uint2 o; o.x = pack2(v.x, v.y); o.y = pack2(v.z, v.w);
    ((uint2*)dst)[i] = o;
  }
}

template <bool SLICE_MAJOR, bool SIGNED>
__device__ __forceinline__ void quantize_rows_u8(const float* __restrict__ src, unsigned char* __restrict__ dst, float* __restrict__ scale, int row_lo, int row_hi) {
  const int lane = threadIdx.x & 63, w = threadIdx.x >> 6;
  for (int row = row_lo + w; row < row_hi; row += 8) {
    const float4* s4 = (const float4*)(src + (size_t)row * 1024) + lane * 4;
    float4 v[4];
    float am = 0.f;
#pragma unroll
    for (int i = 0; i < 4; ++i) { v[i] = s4[i]; am = fmaxf(am, fmaxf(fmaxf(fabsf(v[i].x), fabsf(v[i].y)), fmaxf(fabsf(v[i].z), fabsf(v[i].w)))); }
#pragma unroll
    for (int o = 32; o > 0; o >>= 1) am = fmaxf(am, __shfl_xor(am, o));
    const float inv = am > 0.f ? 127.f / am : 0.f;
    unsigned pk[4];
#pragma unroll
    for (int i = 0; i < 4; ++i) {
      const int ofs = SIGNED ? 0 : 128;
      const unsigned b0 = (unsigned)((int)rintf(v[i].x * inv) + ofs), b1 = (unsigned)((int)rintf(v[i].y * inv) + ofs);
      const unsigned b2 = (unsigned)((int)rintf(v[i].z * inv) + ofs), b3 = (unsigned)((int)rintf(v[i].w * inv) + ofs);
      pk[i] = (b0 & 255u) | ((b1 & 255u) << 8) | ((b2 & 255u) << 16) | ((b3 & 255u) << 24);
    }
    if (SLICE_MAJOR) *(uint4*)(dst + (size_t)(lane >> 3) * (16384 * 128) + (size_t)row * 128 + (lane & 7) * 16) = make_uint4(pk[0], pk[1], pk[2], pk[3]);
    else *(uint4*)(dst + (size_t)row * 1024 + lane * 16) = make_uint4(pk[0], pk[1], pk[2], pk[3]);
    if (lane == 0) scale[row] = am * (1.f / 127.f);
  }
}

#define WS_XQ (WS_PH + (size_t)TOK * 1024 * 2)
#define WS_XS (WS_XQ + (size_t)TOK * 1024)
__device__ __forceinline__ void rmsnorm_rows_q(const float* __restrict__ src, const float* __restrict__ g, bf16_t* __restrict__ dst,
                                               unsigned char* __restrict__ xq, float* __restrict__ xs) {
  const int lane = threadIdx.x & 63, w = threadIdx.x >> 6;
  for (int row = blockIdx.x * 8 + w; row < TOK; row += gridDim.x * 8) {
    const float4* s4 = (const float4*)(src + (size_t)row * DM) + lane * 4;
    const float4* g4 = (const float4*)g + lane * 4;
    float v[16]; float ss = 0.f;
#pragma unroll
    for (int i = 0; i < 4; ++i) { const float4 t = s4[i]; v[4 * i] = t.x; v[4 * i + 1] = t.y; v[4 * i + 2] = t.z; v[4 * i + 3] = t.w; ss += t.x * t.x + t.y * t.y + t.z * t.z + t.w * t.w; }
    ss = wave_sum(ss);
    const float rstd = rsqrtf(ss * (1.f / DM) + EPSV);
    float am = 0.f;
#pragma unroll
    for (int i = 0; i < 4; ++i) { const float4 gg = g4[i]; v[4 * i] *= rstd * gg.x; v[4 * i + 1] *= rstd * gg.y; v[4 * i + 2] *= rstd * gg.z; v[4 * i + 3] *= rstd * gg.w; }
#pragma unroll
    for (int i = 0; i < 16; ++i) am = fmaxf(am, fabsf(v[i]));
#pragma unroll
    for (int o = 32; o > 0; o >>= 1) am = fmaxf(am, __shfl_xor(am, o));
    const float inv = am > 0.f ? 127.f / am : 0.f;
    uint4 ob0, ob1;
    ob0.x = pack2(v[0], v[1]); ob0.y = pack2(v[2], v[3]); ob0.z = pack2(v[4], v[5]); ob0.w = pack2(v[6], v[7]);
    ob1.x = pack2(v[8], v[9]); ob1.y = pack2(v[10], v[11]); ob1.z = pack2(v[12], v[13]); ob1.w = pack2(v[14], v[15]);
    *(uint4*)(dst + (size_t)row * DM + lane * 16) = ob0;
    *(uint4*)(dst + (size_t)row * DM + lane * 16 + 8) = ob1;
    unsigned pk[4];
#pragma unroll
    for (int i = 0; i < 4; ++i) {
      const unsigned b0 = (unsigned)(int)rintf(v[4 * i] * inv) & 255u, b1 = (unsigned)(int)rintf(v[4 * i + 1] * inv) & 255u;
      const unsigned b2 = (unsigned)(int)rintf(v[4 * i + 2] * inv) & 255u, b3 = (unsigned)(int)rintf(v[4 * i + 3] * inv) & 255u;
      pk[i] = b0 | (b1 << 8) | (b2 << 16) | (b3 << 24);
    }
    *(uint4*)(xq + (size_t)row * 1024 + lane * 16) = make_uint4(pk[0], pk[1], pk[2], pk[3]);
    if (lane == 0) xs[row] = am * (1.f / 127.f);
  }
}

__device__ __forceinline__ void rmsnorm_rows(const float* __restrict__ src, const float* __restrict__ g, bf16_t* __restrict__ dst) {
  const int lane = threadIdx.x & 63, w = threadIdx.x >> 6;
  for (int row = blockIdx.x * 8 + w; row < TOK; row += gridDim.x * 8) {
    const float4* s4 = (const float4*)(src + (size_t)row * DM);
    float4 v[4]; float ss = 0.f;
#pragma unroll
    for (int i = 0; i < 4; ++i) { v[i] = s4[lane + 64 * i]; ss += v[i].x * v[i].x + v[i].y * v[i].y + v[i].z * v[i].z + v[i].w * v[i].w; }
    ss = wave_sum(ss);
    const float rstd = rsqrtf(ss * (1.f / DM) + EPSV);
#pragma unroll
    for (int i = 0; i < 4; ++i) {
      const float4 gg = ((const float4*)g)[lane + 64 * i];
      uint2 o; o.x = pack2(v[i].x * rstd * gg.x, v[i].y * rstd * gg.y); o.y = pack2(v[i].z * rstd * gg.z, v[i].w * rstd * gg.w);
      ((uint2*)(dst + (size_t)row * DM))[lane + 64 * i] = o;
    }
  }
}

__device__ __forceinline__ void phase_prep(const Params& p, unsigned char* smem) {
  unsigned char* ws = p.ws;
  float* tile = (float*)smem;
  const int n_win = 80 * 16, n_ua = 16 * 8, n_ub = 16 * 8, n_wo = 16 * 16, n_wq = 32 * 16;
  const int total = n_win + n_ua + n_ub + n_wo + n_wq;
  for (int it = blockIdx.x; it < total; it += gridDim.x) {
    int t = it;
    if (t < n_win) { transpose_tile(p.w_in, 5060, (bf16_t*)(ws + WS_WIN), 1024, (t >> 4) * 64, (t & 15) * 64, true, tile); continue; }
    t -= n_win;
    if (t < n_ua) { transpose_tile(p.w_up_a, 1024, (bf16_t*)(ws + WS_WUPA), 512, (t >> 3) * 64, (t & 7) * 64, false, tile); continue; }
    t -= n_ua;
    if (t < n_ub) { transpose_tile(p.w_up_b, 1024, (bf16_t*)(ws + WS_WUPB), 512, (t >> 3) * 64, (t & 7) * 64, false, tile); continue; }
    t -= n_ub;
    if (t < n_wo) { transpose_tile(p.w_out, 1024, (bf16_t*)(ws + WS_WOUT), 1024, (t >> 4) * 64, (t & 15) * 64, false, tile); continue; }
    t -= n_wo;
    transpose_tile(p.peer_wq, 2048, (bf16_t*)(ws + WS_WQ), 1024, (t >> 4) * 64, (t & 15) * 64, false, tile);
  }
  convert_f32_bf16(p.peer_keys, (bf16_t*)(ws + WS_KEYS), (size_t)2 * 8 * 128 * 128 / 4);
  for (int i = blockIdx.x * NTHREADS + threadIdx.x; i < TOK; i += gridDim.x * NTHREADS) ((float*)(ws + WS_SSQ))[i] = 0.f;
  if (threadIdx.x == 0) ((int*)(ws + WS_XCC))[blockIdx.x] = (int)(__builtin_amdgcn_s_getreg((3 << 11) | 20) & 0xFu);
  if (blockIdx.x == 0 && threadIdx.x < 8) ((unsigned*)(ws + WS_QCTR))[16 * threadIdx.x] = 0u;
  if (blockIdx.x == 0) {
    const int i = threadIdx.x;
    const float a0 = p.hg_lb[i], a1 = p.hg_lb[512 + i];
    ((float*)(ws + WS_LB))[i] = 1.f / (1.f + expf(a1 - a0));
  }
  rmsnorm_rows(p.x, p.norm_mix, (bf16_t*)(ws + WS_XN));
}

__device__ __forceinline__ void phase_proj(const Params& p, unsigned char* smem) {
  unsigned char* ws = p.ws;
  const bf16_t* xn = (const bf16_t*)(ws + WS_XN);
  const bf16_t* wt = (const bf16_t*)(ws + WS_WIN);
  bf16_t* pH = (bf16_t*)(ws + WS_PH);
  bf16_t* pA = (bf16_t*)(ws + WS_PA);
  bf16_t* pG = (bf16_t*)(ws + WS_PG);
  const int tid = threadIdx.x, lane = tid & 63, w = tid >> 6, wm = w >> 1, wn = w & 1, l15 = lane & 15, g = lane >> 4;
  for (int tile = blockIdx.x; tile < 128 * 40; tile += gridDim.x) {
    const int tn = tile % 40, tm = tile / 40;
    f32x4 acc[4][4]; zero_acc(acc);
    gemm_tile(xn + (size_t)tm * 256 * 1024, 1024, wt + (size_t)tn * 128 * 1024, 1024, 16, acc, smem);
    const int rbase = tm * 256 + wm * 64 + 4 * g;
    const int cbase = tn * 128 + wn * 64 + l15;
    if (tn < 16) {
#pragma unroll
      for (int m = 0; m < 4; ++m)
#pragma unroll
        for (int n = 0; n < 4; ++n)
#pragma unroll
          for (int j = 0; j < 4; ++j) pH[(size_t)(rbase + m * 16 + j) * 2048 + cbase + n * 16] = f2bf(acc[m][n][j]);
    } else if (tn < 24) {
      if (tn == 23 && wn == 0) {
        float gam[4], bet[4];
#pragma unroll
        for (int n = 0; n < 4; ++n) { gam[n] = p.ikg[n * 16 + l15]; bet[n] = p.ikb[n * 16 + l15]; }
#pragma unroll
        for (int m = 0; m < 4; ++m)
#pragma unroll
          for (int j = 0; j < 4; ++j) {
            float s = acc[m][0][j] + acc[m][1][j] + acc[m][2][j] + acc[m][3][j];
            s += __shfl_xor(s, 1); s += __shfl_xor(s, 2); s += __shfl_xor(s, 4); s += __shfl_xor(s, 8);
            const float mu = s * (1.f / 64.f);
            float q = 0.f;
#pragma unroll
            for (int n = 0; n < 4; ++n) { const float d = acc[m][n][j] - mu; q += d * d; }
            q += __shfl_xor(q, 1); q += __shfl_xor(q, 2); q += __shfl_xor(q, 4); q += __shfl_xor(q, 8);
            const float rstd = rsqrtf(q * (1.f / 64.f) + EPSV);
#pragma unroll
            for (int n = 0; n < 4; ++n)
              pA[(size_t)(rbase + m * 16 + j) * 1024 + (cbase - 2048) + n * 16] = f2bf((acc[m][n][j] - mu) * rstd * gam[n] + bet[n]);
          }
      } else {
#pragma unroll
        for (int m = 0; m < 4; ++m)
#pragma unroll
          for (int n = 0; n < 4; ++n)
#pragma unroll
            for (int j = 0; j < 4; ++j) pA[(size_t)(rbase + m * 16 + j) * 1024 + (cbase - 2048) + n * 16] = f2bf(acc[m][n][j]);
      }
    } else {
#pragma unroll
      for (int m = 0; m < 4; ++m)
#pragma unroll
        for (int n = 0; n < 4; ++n)
#pragma unroll
          for (int j = 0; j < 4; ++j) pG[(size_t)(rbase + m * 16 + j) * 2048 + (cbase - 3072) + n * 16] = f2bf(sigmoidf_(acc[m][n][j]));
    }
  }
}

__device__ __forceinline__ void hgrn_item(const Params& p, unsigned char* smem, int bh) {
  unsigned char* ws = p.ws;
  const bf16_t* pH = (const bf16_t*)(ws + WS_PH);
  const float* lbp = (const float*)(ws + WS_LB);
  bf16_t* ya = (bf16_t*)(ws + WS_XN);
  bf16_t* Qt = (bf16_t*)smem;
  bf16_t* Kt = Qt + 64 * 136;
  bf16_t* KtT = Kt + 64 * 136;
  bf16_t* VT = KtT + 128 * 72;
  bf16_t* Am = VT + 128 * 72;
  bf16_t* ST = Am + 64 * 72;
  float* qtot = (float*)(ST + 128 * 136);
  float* eref = qtot + 512;
  float* elast = eref + 128;
  float* elr = elast + 128;
  float* red = elr + 128;
  const int tid = threadIdx.x, lane = tid & 63, w = tid >> 6, l15 = lane & 15, g = lane >> 4;
  const int b = bh >> 2, h = bh & 3;
  const int d = tid & 127, tq = tid >> 7;
  const float lbv = lbp[h * 128 + d];
  f32x4 S[8];
#pragma unroll
  for (int i = 0; i < 8; ++i) S[i] = (f32x4){0.f, 0.f, 0.f, 0.f};
  const float gnv = p.hg_norm[h * 128 + 16 * w + l15];

  for (int chunk = 0; chunk < 64; ++chunk) {
    const size_t row0 = (size_t)b * SEQL + chunk * 64;
    {
      const bf16_t* base = pH + (row0 + tq * 16) * 2048 + h * 128 + d;
      float lf[16], kk[16], qs[16];
      unsigned vv[8];
      float run = 0.f;
#pragma unroll
      for (int i = 0; i < 16; ++i) {
        const float fr = bf2f(base[(size_t)i * 2048 + 512]);
        const float qr = bf2f(base[(size_t)i * 2048]);
        const float sg = sigmoidf_(fr);
        const float fg = lbv + (1.f - lbv) * sg;
        run += __logf(fg);
        lf[i] = run; kk[i] = 1.f - fg; qs[i] = siluf_(qr);
      }
#pragma unroll
      for (int i = 0; i < 8; ++i) {
        const unsigned lo = base[(size_t)(2 * i) * 2048 + 1024], hi = base[(size_t)(2 * i + 1) * 2048 + 1024];
        vv[i] = lo | (hi << 16);
      }
      qtot[tq * 128 + d] = run;
      __syncthreads();
      const float q0 = qtot[d], q1 = qtot[128 + d], q2 = qtot[256 + d], q3 = qtot[384 + d];
      const float pre = (tq > 0 ? q0 : 0.f) + (tq > 1 ? q1 : 0.f) + (tq > 2 ? q2 : 0.f);
      const float bref = q0 + q1;
      const float blast = bref + q2 + q3;
      unsigned kp[8];
#pragma unroll
      for (int i = 0; i < 16; ++i) {
        const float bt = pre + lf[i];
        const float qt = qs[i] * __expf(bt - bref);
        const float kt = kk[i] * __expf(bref - bt);
        const int t = tq * 16 + i;
        Qt[t * 136 + d] = f2bf(qt);
        const bf16_t kb = f2bf(kt);
        Kt[t * 136 + d] = kb;
        if (i & 1) kp[i >> 1] |= ((unsigned)kb) << 16; else kp[i >> 1] = kb;
      }
      *(uint4*)(KtT + d * 72 + tq * 16) = make_uint4(kp[0], kp[1], kp[2], kp[3]);
      *(uint4*)(KtT + d * 72 + tq * 16 + 8) = make_uint4(kp[4], kp[5], kp[6], kp[7]);
      *(uint4*)(VT + d * 72 + tq * 16) = make_uint4(vv[0], vv[1], vv[2], vv[3]);
      *(uint4*)(VT + d * 72 + tq * 16 + 8) = make_uint4(vv[4], vv[5], vv[6], vv[7]);
      if (tq == 0) { eref[d] = __expf(bref); elast[d] = __expf(blast); elr[d] = __expf(blast - bref); }
    }
    __syncthreads();
    bf16_t ogr[16];
#pragma unroll
    for (int tm = 0; tm < 4; ++tm)
#pragma unroll
      for (int j = 0; j < 4; ++j) ogr[tm * 4 + j] = pH[(row0 + tm * 16 + 4 * g + j) * 2048 + 1536 + h * 128 + 16 * w + l15];
    {
      const int e = 16 * w + l15;
#pragma unroll
      for (int dm = 0; dm < 8; ++dm) {
        const int d0 = 16 * dm + 4 * g;
        uint2 o;
        o.x = pack2(S[dm][0] * eref[d0], S[dm][1] * eref[d0 + 1]);
        o.y = pack2(S[dm][2] * eref[d0 + 2], S[dm][3] * eref[d0 + 3]);
        *(uint2*)(ST + e * 136 + d0) = o;
      }
#pragma unroll
      for (int tt = 0; tt < 2; ++tt) {
        const int tl = 2 * w + tt, sm = tl >> 2, tn = tl & 3;
        f32x4 acc = (f32x4){0.f, 0.f, 0.f, 0.f};
        if (tn >= sm) {
#pragma unroll
          for (int k0 = 0; k0 < 128; k0 += 32) {
            const bf16x8 a = *(const bf16x8*)(Kt + (sm * 16 + l15) * 136 + k0 + 8 * g);
            const bf16x8 bq = *(const bf16x8*)(Qt + (tn * 16 + l15) * 136 + k0 + 8 * g);
            acc = __builtin_amdgcn_mfma_f32_16x16x32_bf16(a, bq, acc, 0, 0, 0);
          }
        }
        const int t = tn * 16 + l15, s0 = sm * 16 + 4 * g;
        uint2 o;
        o.x = pack2(s0 + 0 <= t ? acc[0] : 0.f, s0 + 1 <= t ? acc[1] : 0.f);
        o.y = pack2(s0 + 2 <= t ? acc[2] : 0.f, s0 + 3 <= t ? acc[3] : 0.f);
        *(uint2*)(Am + t * 72 + s0) = o;
      }
    }
    __syncthreads();
    f32x4 o[4];
    {
#pragma unroll
      for (int tm = 0; tm < 4; ++tm) {
        f32x4 acc = (f32x4){0.f, 0.f, 0.f, 0.f};
#pragma unroll
        for (int k0 = 0; k0 < 128; k0 += 32) {
          const bf16x8 a = *(const bf16x8*)(Qt + (tm * 16 + l15) * 136 + k0 + 8 * g);
          const bf16x8 bb = *(const bf16x8*)(ST + (16 * w + l15) * 136 + k0 + 8 * g);
          acc = __builtin_amdgcn_mfma_f32_16x16x32_bf16(a, bb, acc, 0, 0, 0);
        }
#pragma unroll
        for (int k0 = 0; k0 < 64; k0 += 32) {
          const bf16x8 a = *(const bf16x8*)(Am + (tm * 16 + l15) * 72 + k0 + 8 * g);
          const bf16x8 bb = *(const bf16x8*)(VT + (16 * w + l15) * 72 + k0 + 8 * g);
          acc = __builtin_amdgcn_mfma_f32_16x16x32_bf16(a, bb, acc, 0, 0, 0);
        }
        o[tm] = acc;
#pragma unroll
        for (int j = 0; j < 4; ++j) {
          float ss = acc[j] * acc[j];
          ss += __shfl_xor(ss, 1); ss += __shfl_xor(ss, 2); ss += __shfl_xor(ss, 4); ss += __shfl_xor(ss, 8);
          if (l15 == 0) red[w * 64 + tm * 16 + 4 * g + j] = ss;
        }
      }
#pragma unroll
      for (int dm = 0; dm < 8; ++dm) {
        f32x4 acc = (f32x4){0.f, 0.f, 0.f, 0.f};
#pragma unroll
        for (int k0 = 0; k0 < 64; k0 += 32) {
          const bf16x8 a = *(const bf16x8*)(KtT + (dm * 16 + l15) * 72 + k0 + 8 * g);
          const bf16x8 bb = *(const bf16x8*)(VT + (16 * w + l15) * 72 + k0 + 8 * g);
          acc = __builtin_amdgcn_mfma_f32_16x16x32_bf16(a, bb, acc, 0, 0, 0);
        }
#pragma unroll
        for (int j = 0; j < 4; ++j) { const int dd = 16 * dm + 4 * g + j; S[dm][j] = elast[dd] * S[dm][j] + elr[dd] * acc[j]; }
      }
    }
    __syncthreads();
    {
      const int e = 16 * w + l15;
#pragma unroll
      for (int tm = 0; tm < 4; ++tm)
#pragma unroll
        for (int j = 0; j < 4; ++j) {
          const int t = tm * 16 + 4 * g + j;
          float tot = 0.f;
#pragma unroll
          for (int ww = 0; ww < 8; ++ww) tot += red[ww * 64 + t];
          const float rstd = rsqrtf(tot * (1.f / 128.f) + EPSV);
          const float og = bf2f(ogr[tm * 4 + j]);
          ya[(row0 + t) * 512 + h * 128 + e] = f2bf(o[tm][j] * rstd * gnv * siluf_(og));
        }
    }
  }
}


__device__ __forceinline__ void hgrn_h1_all(const Params& p, unsigned char* smem) {
  unsigned char* ws = p.ws;
  bf16_t* pH = (bf16_t*)(ws + WS_PH);
  const float* lbp = (const float*)(ws + WS_LB);
  bf16_t* Qt = (bf16_t*)smem;
  bf16_t* Kt = Qt + 64 * 136;
  bf16_t* KtT = Kt + 64 * 136;
  bf16_t* VT = KtT + 128 * 72;
  bf16_t* Am = VT + 128 * 72;
  float* qtot = (float*)(Am + 64 * 72);
  const int tid = threadIdx.x, lane = tid & 63, w = tid >> 6, l15 = lane & 15, g = lane >> 4;
  const int d = tid & 127, tq = tid >> 7;
  const int G = gridDim.x;
  if ((int)blockIdx.x >= 2048) return;
  bf16_t fr_[16], qr_[16]; unsigned short vr_[16];
#define H1_LOAD(IT) do { \
    const int bh_ = (IT) >> 6, ch_ = (IT) & 63; \
    const bf16_t* base_ = pH + ((size_t)(bh_ >> 2) * SEQL + ch_ * 64 + tq * 16) * 2048 + (bh_ & 3) * 128 + d; \
    _Pragma("unroll") for (int i = 0; i < 16; ++i) { fr_[i] = base_[(size_t)i * 2048 + 512]; qr_[i] = base_[(size_t)i * 2048]; vr_[i] = base_[(size_t)i * 2048 + 1024]; } \
  } while (0)
  H1_LOAD((int)blockIdx.x);
  for (int item = blockIdx.x; item < 2048; item += G) {
    const int bh = item >> 6, chunk = item & 63;
    const int b = bh >> 2, h = bh & 3;
    const float lbv = lbp[h * 128 + d];
    const size_t row0 = (size_t)b * SEQL + chunk * 64;
    float* dec = (float*)(ws + WS_DEC) + (size_t)item * 384;
    uint4* UU = (uint4*)p.out + (size_t)item * 2048 + tid;
    float4* OI = (float4*)((unsigned char*)p.out + ((size_t)64 << 20)) + (size_t)item * 2048 + tid;
    {
      unsigned vv[8];
#pragma unroll
      for (int i = 0; i < 8; ++i) vv[i] = (unsigned)vr_[2 * i] | ((unsigned)vr_[2 * i + 1] << 16);
      float lf[16], kk[16], qs[16];
      float run = 0.f;
#pragma unroll
      for (int i = 0; i < 16; ++i) {
        const float sg = sigmoidf_(bf2f(fr_[i]));
        const float fg = lbv + (1.f - lbv) * sg;
        run += __logf(fg);
        lf[i] = run; kk[i] = 1.f - fg; qs[i] = siluf_(bf2f(qr_[i]));
      }
      qtot[tq * 128 + d] = run;
      __syncthreads();
      { const int nit = (item + G < 2048) ? item + G : item; H1_LOAD(nit); }
      const float q0 = qtot[d], q1 = qtot[128 + d], q2 = qtot[256 + d], q3 = qtot[384 + d];
      const float pre = (tq > 0 ? q0 : 0.f) + (tq > 1 ? q1 : 0.f) + (tq > 2 ? q2 : 0.f);
      const float bref = q0 + q1;
      const float blast = bref + q2 + q3;
      unsigned kp[8];
#pragma unroll
      for (int i = 0; i < 16; ++i) {
        const float bt = pre + lf[i];
        const float qt = qs[i] * __expf(bt - bref);
        const float kt = kk[i] * __expf(bref - bt);
        const int t = tq * 16 + i;
        Qt[t * 136 + d] = f2bf(qt);
        const bf16_t kb = f2bf(kt);
        Kt[t * 136 + d] = kb;
        if (i & 1) kp[i >> 1] |= ((unsigned)kb) << 16; else kp[i >> 1] = kb;
      }
      *(uint4*)(KtT + d * 72 + tq * 16) = make_uint4(kp[0], kp[1], kp[2], kp[3]);
      *(uint4*)(KtT + d * 72 + tq * 16 + 8) = make_uint4(kp[4], kp[5], kp[6], kp[7]);
      *(uint4*)(VT + d * 72 + tq * 16) = make_uint4(vv[0], vv[1], vv[2], vv[3]);
      *(uint4*)(VT + d * 72 + tq * 16 + 8) = make_uint4(vv[4], vv[5], vv[6], vv[7]);
      if (tq == 0) { dec[d] = __expf(bref); dec[128 + d] = __expf(blast); dec[256 + d] = __expf(blast - bref); }
    }
    __syncthreads();
    {
  #pragma unroll
      for (int i = 0; i < 2; ++i) {
        const int idx = tid + 512 * i, r = idx >> 4, c = idx & 15;
        *(uint4*)(pH + (row0 + r) * 2048 + h * 128 + c * 8) = *(const uint4*)(Qt + r * 136 + c * 8);
      }
  #pragma unroll
      for (int tt = 0; tt < 2; ++tt) {
        const int tl = 2 * w + tt, sm = tl >> 2, tn = tl & 3;
        f32x4 acc = (f32x4){0.f, 0.f, 0.f, 0.f};
        if (tn >= sm) {
  #pragma unroll
          for (int k0 = 0; k0 < 128; k0 += 32) {
            const bf16x8 a = *(const bf16x8*)(Kt + (sm * 16 + l15) * 136 + k0 + 8 * g);
            const bf16x8 bq = *(const bf16x8*)(Qt + (tn * 16 + l15) * 136 + k0 + 8 * g);
            acc = __builtin_amdgcn_mfma_f32_16x16x32_bf16(a, bq, acc, 0, 0, 0);
          }
        }
        const int t = tn * 16 + l15, s0 = sm * 16 + 4 * g;
        uint2 o;
        o.x = pack2(s0 + 0 <= t ? acc[0] : 0.f, s0 + 1 <= t ? acc[1] : 0.f);
        o.y = pack2(s0 + 2 <= t ? acc[2] : 0.f, s0 + 3 <= t ? acc[3] : 0.f);
        *(uint2*)(Am + t * 72 + s0) = o;
      }
    }
    __syncthreads();
    {
  #pragma unroll
      for (int tm = 0; tm < 4; ++tm) {
        f32x4 acc = (f32x4){0.f, 0.f, 0.f, 0.f};
  #pragma unroll
        for (int k0 = 0; k0 < 64; k0 += 32) {
          const bf16x8 a = *(const bf16x8*)(Am + (tm * 16 + l15) * 72 + k0 + 8 * g);
          const bf16x8 bb = *(const bf16x8*)(VT + (16 * w + l15) * 72 + k0 + 8 * g);
          acc = __builtin_amdgcn_mfma_f32_16x16x32_bf16(a, bb, acc, 0, 0, 0);
        }
        OI[tm * 512] = make_float4(acc[0], acc[1], acc[2], acc[3]);
      }
  #pragma unroll
      for (int dp = 0; dp < 4; ++dp) {
        unsigned pk[4];
  #pragma unroll
        for (int hh = 0; hh < 2; ++hh) {
          const int dm = dp * 2 + hh;
          f32x4 acc = (f32x4){0.f, 0.f, 0.f, 0.f};
  #pragma unroll
          for (int k0 = 0; k0 < 64; k0 += 32) {
            const bf16x8 a = *(const bf16x8*)(KtT + (dm * 16 + l15) * 72 + k0 + 8 * g);
            const bf16x8 bb = *(const bf16x8*)(VT + (16 * w + l15) * 72 + k0 + 8 * g);
            acc = __builtin_amdgcn_mfma_f32_16x16x32_bf16(a, bb, acc, 0, 0, 0);
          }
          pk[hh * 2] = pack2(acc[0], acc[1]); pk[hh * 2 + 1] = pack2(acc[2], acc[3]);
        }
        UU[dp * 512] = make_uint4(pk[0], pk[1], pk[2], pk[3]);
      }
    }
    __syncthreads();
  }
#undef H1_LOAD
}

__device__ __forceinline__ void hgrn_h2(const Params& p, unsigned char* smem, int bh) {
  unsigned char* ws = p.ws;
  const bf16_t* pH = (const bf16_t*)(ws + WS_PH);
  bf16_t* ya = (bf16_t*)(ws + WS_XN);
  bf16_t* Qt = (bf16_t*)smem;
  bf16_t* ST = Qt + 64 * 136;
  float* decl = (float*)(ST + 128 * 136);
  float* red = decl + 384;
  const int tid = threadIdx.x, lane = tid & 63, w = tid >> 6, l15 = lane & 15, g = lane >> 4;
  const int b = bh >> 2, h = bh & 3;
  f32x4 S[8];
#pragma unroll
  for (int i = 0; i < 8; ++i) S[i] = (f32x4){0.f, 0.f, 0.f, 0.f};
  const float gnv = p.hg_norm[h * 128 + 16 * w + l15];
  const int e = 16 * w + l15;
  uint4 uu0, uu1, uu2, uu3; float4 oi0, oi1, oi2, oi3; uint4 qraw0, qraw1; bf16_t ogr[16]; float dcv = 0.f;
#define H2_LOAD(CH) do { \
    const int item_ = bh * 64 + (CH); \
    const size_t row0_ = (size_t)b * SEQL + (size_t)(CH) * 64; \
    const uint4* UUp = (const uint4*)p.out + (size_t)item_ * 2048 + tid; \
    const float4* OIp = (const float4*)((const unsigned char*)p.out + ((size_t)64 << 20)) + (size_t)item_ * 2048 + tid; \
    uu0 = UUp[0]; uu1 = UUp[512]; uu2 = UUp[1024]; uu3 = UUp[1536]; oi0 = OIp[0]; oi1 = OIp[512]; oi2 = OIp[1024]; oi3 = OIp[1536]; \
    qraw0 = *(const uint4*)(pH + (row0_ + (tid >> 4)) * 2048 + h * 128 + (tid & 15) * 8); \
    qraw1 = *(const uint4*)(pH + (row0_ + 32 + (tid >> 4)) * 2048 + h * 128 + (tid & 15) * 8); \
    _Pragma("unroll") for (int tm = 0; tm < 4; ++tm) _Pragma("unroll") for (int j = 0; j < 4; ++j) \
      ogr[tm * 4 + j] = pH[(row0_ + tm * 16 + 4 * g + j) * 2048 + 1536 + h * 128 + e]; \
    if (tid < 384) dcv = ((const float*)(ws + WS_DEC))[(size_t)item_ * 384 + tid]; \
  } while (0)
  H2_LOAD(0);
  for (int chunk = 0; chunk < 64; ++chunk) {
    const size_t row0 = (size_t)b * SEQL + chunk * 64;
    const uint4 cu[4] = {uu0, uu1, uu2, uu3}; const float4 co[4] = {oi0, oi1, oi2, oi3}; bf16_t cog[16];
#pragma unroll
    for (int i = 0; i < 16; ++i) cog[i] = ogr[i];
    *(uint4*)(Qt + (tid >> 4) * 136 + (tid & 15) * 8) = qraw0;
    *(uint4*)(Qt + (32 + (tid >> 4)) * 136 + (tid & 15) * 8) = qraw1;
    if (tid < 384) decl[tid] = dcv;
    __syncthreads();
    if (chunk + 1 < 64) H2_LOAD(chunk + 1);
#pragma unroll
    for (int dm = 0; dm < 8; ++dm) {
      const int d0 = 16 * dm + 4 * g;
      uint2 o;
      o.x = pack2(S[dm][0] * decl[d0], S[dm][1] * decl[d0 + 1]);
      o.y = pack2(S[dm][2] * decl[d0 + 2], S[dm][3] * decl[d0 + 3]);
      *(uint2*)(ST + e * 136 + d0) = o;
    }
    __syncthreads();
    f32x4 o[4];
#pragma unroll
    for (int tm = 0; tm < 4; ++tm) {
      f32x4 acc = (f32x4){co[tm].x, co[tm].y, co[tm].z, co[tm].w};
#pragma unroll
      for (int k0 = 0; k0 < 128; k0 += 32) {
        const bf16x8 a = *(const bf16x8*)(Qt + (tm * 16 + l15) * 136 + k0 + 8 * g);
        const bf16x8 bb = *(const bf16x8*)(ST + (16 * w + l15) * 136 + k0 + 8 * g);
        acc = __builtin_amdgcn_mfma_f32_16x16x32_bf16(a, bb, acc, 0, 0, 0);
      }
      o[tm] = acc;
#pragma unroll
      for (int j = 0; j < 4; ++j) {
        float ss = acc[j] * acc[j];
        ss += __int_as_float(__builtin_amdgcn_update_dpp(0, __float_as_int(ss), 0xB1, 0xf, 0xf, true));
        ss += __int_as_float(__builtin_amdgcn_update_dpp(0, __float_as_int(ss), 0x4E, 0xf, 0xf, true));
        ss += __int_as_float(__builtin_amdgcn_update_dpp(0, __float_as_int(ss), 0x141, 0xf, 0xf, true));
        ss += __int_as_float(__builtin_amdgcn_update_dpp(0, __float_as_int(ss), 0x140, 0xf, 0xf, true));
        if (l15 == 0) red[w * 64 + tm * 16 + 4 * g + j] = ss;
      }
    }
#pragma unroll
    for (int dm = 0; dm < 8; ++dm) {
      const unsigned u01 = (dm & 1) ? cu[dm >> 1].z : cu[dm >> 1].x, u23 = (dm & 1) ? cu[dm >> 1].w : cu[dm >> 1].y;
      const float uv[4] = {__uint_as_float(u01 << 16), __uint_as_float(u01 & 0xffff0000u), __uint_as_float(u23 << 16), __uint_as_float(u23 & 0xffff0000u)};
#pragma unroll
      for (int j = 0; j < 4; ++j) { const int dd = 16 * dm + 4 * g + j; S[dm][j] = decl[128 + dd] * S[dm][j] + decl[256 + dd] * uv[j]; }
    }
    __syncthreads();
    if (tid < 64) {
      float tot = 0.f;
#pragma unroll
      for (int ww = 0; ww < 8; ++ww) tot += red[ww * 64 + tid];
      red[512 + tid] = rsqrtf(tot * (1.f / 128.f) + EPSV);
    }
    __syncthreads();
#pragma unroll
    for (int tm = 0; tm < 4; ++tm)
#pragma unroll
      for (int j = 0; j < 4; ++j) {
        const int t = tm * 16 + 4 * g + j;
        const float rstd = red[512 + t];
        ya[(row0 + t) * 512 + h * 128 + e] = f2bf(o[tm][j] * rstd * gnv * siluf_(bf2f(cog[tm * 4 + j])));
      }
  }
#undef H2_LOAD
}

__device__ __forceinline__ int team_index(const Params& p, unsigned char* smem) {
  int* sh = (int*)(smem + 8192);
  const int G = gridDim.x, tid = threadIdx.x;
  const int* tab = (const int*)(p.ws + WS_XCC);
  if (tid < 32) sh[tid] = 0;
  __syncthreads();
  const int mine = tab[blockIdx.x] & 15;
  for (int b = tid; b < G; b += NTHREADS) {
    const int x = tab[b] & 15;
    atomicAdd(&sh[x], 1);
    if (x == mine && b < (int)blockIdx.x) atomicAdd(&sh[16], 1);
  }
  __syncthreads();
  if (tid == 0) {
    int pre = 0;
    for (int j = 0; j < mine; ++j) pre += sh[j];
    sh[17] = pre + sh[16];
  }
  __syncthreads();
  const int r = sh[17];
  __syncthreads();
  return r;
}

#define SCW 4100
#ifndef DSA_REP
#define DSA_REP 0
#endif
#define DSA_BKT_OFF (8 * SCW * 4 + 8 * 256 * 4 + 8 * 256 * 2 + 8 * 512 * 2)
__device__ __forceinline__ void cvt8(const uint4& v, float* f) {
  f[0] = __uint_as_float(v.x << 16); f[1] = __uint_as_float(v.x & 0xffff0000u);
  f[2] = __uint_as_float(v.y << 16); f[3] = __uint_as_float(v.y & 0xffff0000u);
  f[4] = __uint_as_float(v.z << 16); f[5] = __uint_as_float(v.z & 0xffff0000u);
  f[6] = __uint_as_float(v.w << 16); f[7] = __uint_as_float(v.w & 0xffff0000u);
}
__device__ __forceinline__ unsigned sortable_key(float v) {
  unsigned bits = __float_as_uint(v);
  if (bits == 0x80000000u) bits = 0u;
  return (bits & 0x80000000u) ? ~bits : (bits | 0x80000000u);
}

__device__ __forceinline__ void dsa_item(const Params& p, unsigned char* smem, int item) {
  unsigned char* ws = p.ws;
  const bf16_t* pA = (const bf16_t*)(ws + WS_PA);
  const bf16_t* kc = (const bf16_t*)(ws + WS_KC);
  const bf16_t* vc = (const bf16_t*)(ws + WS_VC);
  const bf16_t* ikc = (const bf16_t*)(ws + WS_IKC);
  bf16_t* yb = (bf16_t*)(ws + WS_XN) + (size_t)TOK * 512;
  unsigned* sc = (unsigned*)smem;
  unsigned* hist = sc + 8 * SCW;
  unsigned short* sel = (unsigned short*)(hist + 8 * 256);
  unsigned short* cand = sel + 8 * 256;
  unsigned char* bkt = (unsigned char*)(cand + 8 * 512);
  unsigned* rmm = (unsigned*)(bkt + 128 + 1024);
  const int tid = threadIdx.x, lane = tid & 63, w = tid >> 6, l15 = lane & 15, g = lane >> 4;
  const int b = item >> 9;
  const int tb = item & 511;
  const int t0 = tb * 8;
  const size_t tokbase = (size_t)b * SEQL;

  for (int rep_s = 0; rep_s < (DSA_REP == 1 ? 2 : 1); ++rep_s) {
    bf16x8 af[2][2];
    float wq[2][4];
#pragma unroll
    for (int mt = 0; mt < 2; ++mt) {
      const int qrow = t0 + mt * 4 + (l15 >> 2), head = l15 & 3;
#pragma unroll
      for (int ks = 0; ks < 2; ++ks)
        af[mt][ks] = *(const bf16x8*)(pA + (tokbase + qrow) * 1024 + 640 + head * 64 + ks * 32 + 8 * g);
      const uint2 wr = *(const uint2*)(pA + (tokbase + t0 + mt * 4 + g) * 1024 + 960);
      wq[mt][0] = 0.5f * bf2f((bf16_t)(wr.x & 0xffff)); wq[mt][1] = 0.5f * bf2f((bf16_t)(wr.x >> 16));
      wq[mt][2] = 0.5f * bf2f((bf16_t)(wr.y & 0xffff)); wq[mt][3] = 0.5f * bf2f((bf16_t)(wr.y >> 16));
    }
    const int nkt = (t0 + 8 + 15) >> 4;
    unsigned kmin[2] = {0xFFFFFFFFu, 0xFFFFFFFFu}, kmax[2] = {0u, 0u};
    for (int kt0 = w; kt0 < nkt; kt0 += 64) {
      bf16x8 b0[8], b1[8];
#pragma unroll
      for (int u = 0; u < 8; ++u) {
        const int kt = kt0 + 8 * u;
        const int s = (kt < nkt ? kt : 0) * 16 + l15;
        const bf16_t* kr = ikc + (tokbase + s) * 64 + 8 * g;
        b0[u] = *(const bf16x8*)kr;
        b1[u] = *(const bf16x8*)(kr + 32);
      }
      __builtin_amdgcn_sched_barrier(0);
      f32x4 sacc[8][2];
#pragma unroll
      for (int u = 0; u < 8; ++u)
#pragma unroll
        for (int mt = 0; mt < 2; ++mt) {
          f32x4 acc = (f32x4){0.f, 0.f, 0.f, 0.f};
          acc = __builtin_amdgcn_mfma_f32_16x16x32_bf16(af[mt][0], b0[u], acc, 0, 0, 0);
          sacc[u][mt] = __builtin_amdgcn_mfma_f32_16x16x32_bf16(af[mt][1], b1[u], acc, 0, 0, 0);
        }
#pragma unroll
      for (int u = 0; u < 8; ++u) {
        const int kt = kt0 + 8 * u;
        if (kt < nkt) {
          const int s = kt * 16 + l15;
#pragma unroll
          for (int mt = 0; mt < 2; ++mt) {
            float v = 0.f;
#pragma unroll
            for (int j = 0; j < 4; ++j) v += wq[mt][j] * fmaxf(sacc[u][mt][j] * 0.125f, 0.f);
            const int t = t0 + mt * 4 + g;
            unsigned vb = __float_as_uint(v); if (vb == 0x80000000u) vb = 0u;
            sc[(mt * 4 + g) * SCW + s] = vb;
            if (s <= t) {
              const unsigned key = (vb & 0x80000000u) ? ~vb : (vb | 0x80000000u);
              kmin[mt] = key < kmin[mt] ? key : kmin[mt];
              kmax[mt] = key > kmax[mt] ? key : kmax[mt];
            }
          }
        }
      }
    }
#pragma unroll
    for (int mt = 0; mt < 2; ++mt) {
      unsigned a = kmin[mt], bmx = kmax[mt];
#define DPP_MINMAX(CTRL) do { const unsigned a2 = (unsigned)__builtin_amdgcn_update_dpp((int)a, (int)a, CTRL, 0xf, 0xf, false); \
                               const unsigned b2 = (unsigned)__builtin_amdgcn_update_dpp((int)bmx, (int)bmx, CTRL, 0xf, 0xf, false); \
                               a = a2 < a ? a2 : a; bmx = b2 > bmx ? b2 : bmx; } while (0)
      DPP_MINMAX(0xB1); DPP_MINMAX(0x4E); DPP_MINMAX(0x141); DPP_MINMAX(0x140);
#undef DPP_MINMAX
      if (l15 == 0) { atomicMin(&rmm[mt * 4 + g], a); atomicMax(&rmm[8 + mt * 4 + g], bmx); }
    }
  }
  __syncthreads();
  const int t = t0 + w;
  const int n = t + 1;
  unsigned* row = sc + w * SCW;
  const float* rowf = (const float*)row;
  unsigned short* mysel = sel + w * 256;
  unsigned short* mycand = cand + w * 512;
  unsigned* myh = hist + w * 256;
  int cnt;
  const unsigned long long lt_mask = (1ull << lane) - 1ull;
  for (int rep_t = 0; rep_t < (DSA_REP == 2 ? 2 : 1); ++rep_t)
  if (n <= 256) {
    for (int i = lane; i < n; i += 64) mysel[i] = (unsigned short)i;
    cnt = n;
  } else {
    cnt = 256;
    float mn, mx;
    {
      const unsigned kmn = rmm[w], kmx = rmm[8 + w];
      mn = __uint_as_float((kmn & 0x80000000u) ? (kmn ^ 0x80000000u) : ~kmn);
      mx = __uint_as_float((kmx & 0x80000000u) ? (kmx ^ 0x80000000u) : ~kmx);
    }
    const float scale = (mx > mn) ? 255.99f / (mx - mn) : 0.f;
#pragma unroll
    for (int i = 0; i < 4; ++i) myh[lane + 64 * i] = 0u;
    lds_fence();
    for (int i0 = lane; i0 < n; i0 += 256) {
      float v4[4];
#pragma unroll
      for (int k = 0; k < 4; ++k) v4[k] = (i0 + 64 * k < n) ? rowf[i0 + 64 * k] : 0.f;
#pragma unroll
      for (int k = 0; k < 4; ++k) {
        if (i0 + 64 * k < n) {
          int bn = (int)((v4[k] - mn) * scale); bn = bn > 255 ? 255 : bn;
          atomicAdd(&myh[bn], 1u);
        }
      }
    }
    lds_fence();
    unsigned cum; int bstar; unsigned mcount;
    {
      const uint4 c4 = *(const uint4*)(myh + 4 * lane);
      const unsigned c = c4.x + c4.y + c4.z + c4.w;
      unsigned sfx = c;
#pragma unroll
      for (int o = 1; o < 64; o <<= 1) { const unsigned tt = __shfl_down(sfx, o); if (lane + o < 64) sfx += tt; }
      const unsigned long long bal = __ballot(sfx >= 256u);
      const int L = 63 - __clzll(bal);
      const unsigned sL = __shfl(sfx, L), cL = __shfl(c, L);
      const unsigned b3 = __shfl(c4.w, L), b2 = __shfl(c4.z, L), b1 = __shfl(c4.y, L), b0 = __shfl(c4.x, L);
      cum = sL - cL;
      int digit;
      if (cum + b3 >= 256u) { digit = 3; mcount = b3; }
      else { cum += b3; if (cum + b2 >= 256u) { digit = 2; mcount = b2; } else { cum += b2; if (cum + b1 >= 256u) { digit = 1; mcount = b1; } else { cum += b1; digit = 0; mcount = b0; } } }
      bstar = 4 * L + digit;
    }
    const unsigned need = 256u - cum;
    if (mcount <= 512u) {
      unsigned base = 0u, cb = 0u;
      for (int i0 = 0; i0 < n; i0 += 256) {
        float v4[4];
#pragma unroll
        for (int k = 0; k < 4; ++k) { const int i = i0 + 64 * k + lane; v4[k] = (i < n) ? rowf[i] : 0.f; }
#pragma unroll
        for (int k = 0; k < 4; ++k) {
          const int i = i0 + 64 * k + lane;
          const bool valid = i < n;
          int bn = (int)((v4[k] - mn) * scale); bn = bn > 255 ? 255 : bn;
          const bool gt = valid && (bn > bstar);
          const bool eq = valid && (bn == bstar);
          const unsigned long long bg = __ballot(gt), be = __ballot(eq);
          if (gt) mysel[base + (unsigned)__popcll(bg & lt_mask)] = (unsigned short)i;
          if (eq) mycand[cb + (unsigned)__popcll(be & lt_mask)] = (unsigned short)i;
          base += (unsigned)__popcll(bg); cb += (unsigned)__popcll(be);
        }
      }
      lds_fence();
      const int m = (int)mcount;
      unsigned ck[8]; unsigned short ci[8];
#pragma unroll
      for (int q = 0; q < 8; ++q) {
        const int c = q * 64 + lane;
        ck[q] = 0u; ci[q] = 0;
        if (c < m) { ci[q] = mycand[c]; ck[q] = sortable_key(rowf[ci[q]]); }
      }
      unsigned T = 0u;
      if (m <= 64) {
#pragma unroll 1
        for (int bit = 31; bit >= 0; --bit) {
          const unsigned trial = T | (1u << bit);
          if ((unsigned)__popcll(__ballot(ck[0] >= trial)) >= need) T = trial;
        }
      } else {
#pragma unroll 1
        for (int bit = 31; bit >= 0; --bit) {
          const unsigned trial = T | (1u << bit);
          unsigned cge = 0u;
#pragma unroll
          for (int q = 0; q < 8; ++q) cge += (unsigned)__popcll(__ballot(ck[q] >= trial));
          if (cge >= need) T = trial;
        }
      }
      unsigned cgt = 0u;
#pragma unroll
      for (int q = 0; q < 8; ++q) cgt += (unsigned)__popcll(__ballot(ck[q] > T));
      const unsigned need_eq = need - cgt;
      unsigned pos0 = cum, eqtaken = 0u;
#pragma unroll
      for (int q = 0; q < 8; ++q) {
        const bool gt = ck[q] > T;
        const bool eq = ck[q] == T;
        const unsigned long long beq = __ballot(eq);
        const bool take = gt || (eq && (eqtaken + (unsigned)__popcll(beq & lt_mask)) < need_eq);
        const unsigned long long bt = __ballot(take);
        const unsigned pp = pos0 + (unsigned)__popcll(bt & lt_mask);
        if (take && pp < 256u) mysel[pp] = ci[q];
        pos0 += (unsigned)__popcll(bt);
        eqtaken += (unsigned)__popcll(beq);
      }
    } else {
      unsigned prefix = 0u, krem = 256u;
#pragma unroll 1
      for (int pass = 0; pass < 4; ++pass) {
        const int shift = 24 - 8 * pass;
        const unsigned himask = (pass == 0) ? 0u : (0xFFFFFFFFu << (shift + 8));
#pragma unroll
        for (int i = 0; i < 4; ++i) myh[lane + 64 * i] = 0u;
        lds_fence();
        for (int i = lane; i < n; i += 64) {
          const unsigned u = sortable_key(rowf[i]);
          if ((u & himask) == prefix) atomicAdd(&myh[(u >> shift) & 255u], 1u);
        }
        lds_fence();
        const uint4 c4 = *(const uint4*)(myh + 4 * lane);
        const unsigned c = c4.x + c4.y + c4.z + c4.w;
        unsigned sfx = c;
#pragma unroll
        for (int o = 1; o < 64; o <<= 1) { const unsigned tt = __shfl_down(sfx, o); if (lane + o < 64) sfx += tt; }
        const unsigned long long bal = __ballot(sfx >= krem);
        const int L = 63 - __clzll(bal);
        const unsigned sL = __shfl(sfx, L), cL = __shfl(c, L);
        const unsigned b3 = __shfl(c4.w, L), b2 = __shfl(c4.z, L), b1 = __shfl(c4.y, L);
        unsigned cum2 = sL - cL;
        unsigned digit;
        if (cum2 + b3 >= krem) digit = 3;
        else { cum2 += b3; if (cum2 + b2 >= krem) digit = 2; else { cum2 += b2; if (cum2 + b1 >= krem) digit = 1; else { cum2 += b1; digit = 0; } } }
        krem -= cum2;
        prefix |= ((unsigned)(4 * L) + digit) << shift;
      }
      const unsigned T = prefix;
      unsigned base = 0u, eqtaken = 0u;
      for (int i0 = 0; i0 < n; i0 += 64) {
        const int i = i0 + lane;
        const bool valid = i < n;
        const unsigned u = valid ? sortable_key(rowf[i]) : 0u;
        const bool gt = valid && (u > T);
        const bool eq = valid && (u == T);
        const unsigned long long beq = __ballot(eq);
        const unsigned eqrank = eqtaken + (unsigned)__popcll(beq & lt_mask);
        const bool take = gt || (eq && eqrank < krem);
        const unsigned long long bt = __ballot(take);
        const unsigned pos = base + (unsigned)__popcll(bt & lt_mask);
        if (take && pos < 256u) mysel[pos] = (unsigned short)i;
        base += (unsigned)__popcll(bt);
        eqtaken += (unsigned)__popcll(beq);
      }
    }
  }
  lds_fence();
  if (lane == 0) { rmm[w] = 0xFFFFFFFFu; rmm[8 + w] = 0u; }
  {
    int lane_a = lane;
    asm volatile("" : "+v"(lane_a));
    const int l15 = lane_a & 15, g = lane_a >> 4;
    const int ks = lane_a >> 3, dc = lane_a & 7;
    float* pl = (float*)row;
    const float* relb = (const float*)(bkt + 128);
    const int niter = (cnt + 7) >> 3;
    bf16x8 bq0 = (bf16x8){0, 0, 0, 0, 0, 0, 0, 0}, bq1 = bq0;
    if (l15 < 8) {
      bq0 = *(const bf16x8*)(pA + (tokbase + t) * 1024 + l15 * 64 + 8 * g);
      bq1 = *(const bf16x8*)(pA + (tokbase + t) * 1024 + l15 * 64 + 32 + 8 * g);
    }
    float lg[16][4];
    {
      bf16x8 ka[8][2], kb[8][2];
#pragma unroll
      for (int u = 0; u < 8; ++u) {
        const int kk = u * 16 + l15;
        const int s = (kk < cnt) ? (int)mysel[kk] : 0;
        const bf16_t* kr = kc + (tokbase + s) * 64 + 8 * g;
        ka[u][0] = *(const bf16x8*)kr;
        ka[u][1] = *(const bf16x8*)(kr + 32);
      }
#pragma unroll
      for (int u = 0; u < 8; ++u) {
        const int kk = (8 + u) * 16 + l15;
        const int s = (kk < cnt) ? (int)mysel[kk] : 0;
        const bf16_t* kr = kc + (tokbase + s) * 64 + 8 * g;
        kb[u][0] = *(const bf16x8*)kr;
        kb[u][1] = *(const bf16x8*)(kr + 32);
      }
      __builtin_amdgcn_sched_barrier(0);
#pragma unroll
      for (int u = 0; u < 8; ++u) {
        f32x4 acc = (f32x4){0.f, 0.f, 0.f, 0.f};
        acc = __builtin_amdgcn_mfma_f32_16x16x32_bf16(ka[u][0], bq0, acc, 0, 0, 0);
        acc = __builtin_amdgcn_mfma_f32_16x16x32_bf16(ka[u][1], bq1, acc, 0, 0, 0);
        lg[u][0] = acc[0]; lg[u][1] = acc[1]; lg[u][2] = acc[2]; lg[u][3] = acc[3];
      }
#pragma unroll
      for (int u = 0; u < 8; ++u) {
        f32x4 acc = (f32x4){0.f, 0.f, 0.f, 0.f};
        acc = __builtin_amdgcn_mfma_f32_16x16x32_bf16(kb[u][0], bq0, acc, 0, 0, 0);
        acc = __builtin_amdgcn_mfma_f32_16x16x32_bf16(kb[u][1], bq1, acc, 0, 0, 0);
        lg[8 + u][0] = acc[0]; lg[8 + u][1] = acc[1]; lg[8 + u][2] = acc[2]; lg[8 + u][3] = acc[3];
      }
    }
    typedef unsigned u32x4_t __attribute__((ext_vector_type(4)));
    u32x4_t va[16];
#pragma unroll
    for (int u = 0; u < 16; ++u) {
      const int kk = u * 8 + ks;
      const int s = (kk < cnt) ? (int)mysel[kk] : 0;
      va[u] = *(const u32x4_t*)(vc + (tokbase + s) * 64 + dc * 8);
    }
    __builtin_amdgcn_sched_barrier(0);
    const int hsel = l15 & 7;
    float m = -INFINITY;
#pragma unroll
    for (int u = 0; u < 16; ++u) {
      const uint2 s4 = *(const uint2*)(mysel + u * 16 + 4 * g);
      const int sj[4] = {(int)(s4.x & 0xffffu), (int)(s4.x >> 16), (int)(s4.y & 0xffffu), (int)(s4.y >> 16)};
#pragma unroll
      for (int j = 0; j < 4; ++j) {
        const int key = u * 16 + 4 * g + j;
        const bool valid = key < cnt;
        const int dist = valid ? t - sj[j] : 0;
        const int bk = dist < 128 ? (int)bkt[dist] : 31;
        lg[u][j] = valid ? (lg[u][j] * 0.125f + relb[bk * 8 + hsel]) : -INFINITY;
        m = fmaxf(m, lg[u][j]);
      }
    }
    m = max_xor16(m); m = max_xor32(m);
    float sum = 0.f;
#pragma unroll
    for (int u = 0; u < 16; ++u)
#pragma unroll
      for (int j = 0; j < 4; ++j) { lg[u][j] = __expf(lg[u][j] - m); sum += lg[u][j]; }
    sum = add_xor16(sum); sum = add_xor32(sum);
    const float inv = 1.f / sum;
    bf16x8 pa[8];
#pragma unroll
    for (int s8 = 0; s8 < 8; ++s8) {
      const unsigned w0 = pack2(lg[2 * s8][0] * inv, lg[2 * s8][1] * inv), w1 = pack2(lg[2 * s8][2] * inv, lg[2 * s8][3] * inv);
      const unsigned w2 = pack2(lg[2 * s8 + 1][0] * inv, lg[2 * s8 + 1][1] * inv), w3 = pack2(lg[2 * s8 + 1][2] * inv, lg[2 * s8 + 1][3] * inv);
      const u32x4_t wv = {w0, w1, w2, w3};
      pa[s8] = __builtin_bit_cast(bf16x8, wv);
    }
    unsigned char* vs_l = (unsigned char*)row;
#pragma unroll
    for (int u = 0; u < 16; ++u) *(u32x4_t*)(vs_l + (u * 8 + ks) * 128 + dc * 16) = va[u];
    lds_fence();
    u32x4_t vb[16];
#pragma unroll
    for (int u = 0; u < 16; ++u) {
      const int kk = (16 + u) * 8 + ks;
      const int s = (kk < cnt) ? (int)mysel[kk] : 0;
      vb[u] = *(const u32x4_t*)(vc + (tokbase + s) * 64 + dc * 8);
    }
    __builtin_amdgcn_sched_barrier(0);
    f32x4 ov[4];
#pragma unroll
    for (int nt = 0; nt < 4; ++nt) ov[nt] = (f32x4){0.f, 0.f, 0.f, 0.f};
    typedef short v4s_t __attribute__((ext_vector_type(4)));
    const unsigned tr_lane = (unsigned)((l15 >> 2) * 128 + (l15 & 3) * 8);
#define PV_HALF(S0) do { \
      _Pragma("unroll") for (int s4_ = 0; s4_ < 4; ++s4_) { \
        _Pragma("unroll") for (int nt = 0; nt < 4; ++nt) { \
          const unsigned a0 = (unsigned)((s4_ * 32 + 4 * g) * 128 + nt * 32) + tr_lane; \
          const v4s_t b0 = __builtin_amdgcn_ds_read_tr16_b64_v4i16((__attribute__((address_space(3))) v4s_t*)(vs_l + a0)); \
          const v4s_t b1 = __builtin_amdgcn_ds_read_tr16_b64_v4i16((__attribute__((address_space(3))) v4s_t*)(vs_l + a0 + 16 * 128)); \
          const bf16x8 bb = (bf16x8){b0[0], b0[1], b0[2], b0[3], b1[0], b1[1], b1[2], b1[3]}; \
          ov[nt] = __builtin_amdgcn_mfma_f32_16x16x32_bf16(pa[(S0) + s4_], bb, ov[nt], 0, 0, 0); \
        } \
      } \
    } while (0)
    PV_HALF(0);
    lds_fence();
#pragma unroll
    for (int u = 0; u < 16; ++u) *(u32x4_t*)(vs_l + (u * 8 + ks) * 128 + dc * 16) = vb[u];
    lds_fence();
    PV_HALF(4);
#undef PV_HALF
    if (g < 2) {
#pragma unroll
      for (int nt = 0; nt < 4; ++nt)
#pragma unroll
        for (int j = 0; j < 4; ++j) yb[(tokbase + t) * 512 + (4 * g + j) * 64 + nt * 16 + l15] = f2bf(ov[nt][j]);
    }
    lds_fence();
  }
  __syncthreads();
}

__device__ __forceinline__ void phase_mix(const Params& p, unsigned char* smem, int mode = 0) {
  const int G = gridDim.x;
  if (mode != 2) { for (int bh = blockIdx.x; bh < 32; bh += G) { hgrn_h2(p, smem, bh); __syncthreads(); } }
  if (mode == 1) return;
  unsigned char* bkt = smem + DSA_BKT_OFF;
  volatile int* qslot = (volatile int*)(smem + LDS_BYTES - 32);
  unsigned* qctr = (unsigned*)(p.ws + WS_QCTR);
  if (threadIdx.x < 128) {
    const int nn = threadIdx.x;
    int v = nn;
    if (nn >= 16) { v = 16 + (int)(logf((float)nn * (1.f / 16.f)) / logf(8.f) * 16.f); if (v > 31) v = 31; }
    bkt[nn] = (unsigned char)v;
  }
  if (threadIdx.x >= 256) ((float*)(bkt + 128))[threadIdx.x - 256] = p.rel_bias[threadIdx.x - 256];
  if (threadIdx.x < 16) ((unsigned*)(bkt + 128 + 1024))[threadIdx.x] = threadIdx.x < 8 ? 0xFFFFFFFFu : 0u;
  const int my_team = (G % 8 == 0) ? team_index(p, smem) / (G >> 3) : (int)(blockIdx.x & 7);
  constexpr int QN = 544;
#define Q_FETCH(SLOT) do { if (threadIdx.x == 0) { int tm_ = q_team, kk_ = -1; \
      for (int tries_ = 0; tries_ < 8; ++tries_) { \
        const unsigned v_ = __hip_atomic_fetch_add(qctr + 16 * tm_, 1u, __ATOMIC_RELAXED, __HIP_MEMORY_SCOPE_AGENT); \
        if (v_ < (unsigned)QN) { kk_ = (tm_ << 16) | (int)v_; break; } \
        tm_ = (tm_ + 1) & 7; } \
      q_team = tm_; qslot[SLOT] = kk_; } } while (0)
  int q_team = my_team;
  Q_FETCH(0);
  __syncthreads();
  int k = qslot[0];
  int par = 1;
  while (k >= 0) {
    Q_FETCH(par);
    const int bt = k >> 16, kl = k & 0xffff;
    const int kq = kl / 17, kr = kl - kq * 17;
    if (kr < 16) {
      const int tb = 511 - (kq * 16 + kr);
      dsa_item(p, smem, (bt << 9) | tb);
    } else {
      const int r0 = (bt * 32 + kq) * 64;
      quantize_rows_u8<false, true>(p.peer_u, p.ws + WS_U, (float*)(p.ws + WS_U + (size_t)16384 * 1024), r0, r0 + 64);
      quantize_rows_u8<true, false>(p.peer_v, p.ws + WS_V, (float*)(p.ws + WS_V + (size_t)16384 * 1024), r0, r0 + 64);
      __syncthreads();
    }
    k = qslot[par];
    par ^= 1;
  }
#undef Q_FETCH
}

__device__ __forceinline__ void phase_up(const Params& p, unsigned char* smem) {
  unsigned char* ws = p.ws;
  const bf16_t* ya = (const bf16_t*)(ws + WS_XN);
  const bf16_t* yb = ya + (size_t)TOK * 512;
  const bf16_t* wa = (const bf16_t*)(ws + WS_WUPA);
  const bf16_t* wb = (const bf16_t*)(ws + WS_WUPB);
  const bf16_t* pG = (const bf16_t*)(ws + WS_PG);
  bf16_t* hb = (bf16_t*)(ws + WS_PH);
  const int tid = threadIdx.x, lane = tid & 63, w = tid >> 6, wm = w >> 1, wn = w & 1, l15 = lane & 15, g = lane >> 4;
  for (int tile = blockIdx.x; tile < 128 * 8; tile += gridDim.x) {
    const int tn = tile & 7, tm = tile >> 3;
    f32x4 acc[4][4]; zero_acc(acc);
    gemm_tile(ya + (size_t)tm * 256 * 512, 512, wa + (size_t)tn * 128 * 512, 512, 8, acc, smem);
    asm volatile("" ::: "memory");
    const int rbase = tm * 256 + wm * 64 + 4 * g;
    const int cbase = tn * 128 + wn * 64 + l15;
#pragma unroll
    for (int m = 0; m < 4; ++m) {
      bf16_t gt[16];
#pragma unroll
      for (int n = 0; n < 4; ++n)
#pragma unroll
        for (int j = 0; j < 4; ++j) gt[n * 4 + j] = pG[(size_t)(rbase + m * 16 + j) * 2048 + cbase + n * 16];
#pragma unroll
      for (int n = 0; n < 4; ++n) {
#pragma unroll
        for (int j = 0; j < 4; ++j) {
          const size_t rr = (size_t)(rbase + m * 16 + j);
          hb[rr * 1024 + cbase + n * 16] = f2bf(acc[m][n][j] * bf2f(gt[n * 4 + j]));
        }
        acc[m][n] = (f32x4){0.f, 0.f, 0.f, 0.f};
      }
    }
    asm volatile("" ::: "memory");
    gemm_tile(yb + (size_t)tm * 256 * 512, 512, wb + (size_t)tn * 128 * 512, 512, 8, acc, smem);
    asm volatile("" ::: "memory");
#pragma unroll
    for (int m = 0; m < 4; ++m) {
      bf16_t gt[16], ht[16];
#pragma unroll
      for (int n = 0; n < 4; ++n)
#pragma unroll
        for (int j = 0; j < 4; ++j) {
          const size_t rr = (size_t)(rbase + m * 16 + j);
          gt[n * 4 + j] = pG[rr * 2048 + 1024 + cbase + n * 16];
          ht[n * 4 + j] = hb[rr * 1024 + cbase + n * 16];
        }
#pragma unroll
      for (int n = 0; n < 4; ++n)
#pragma unroll
        for (int j = 0; j < 4; ++j) {
          const size_t rr = (size_t)(rbase + m * 16 + j);
          hb[rr * 1024 + cbase + n * 16] = f2bf(bf2f(ht[n * 4 + j]) + acc[m][n][j] * bf2f(gt[n * 4 + j]));
        }
    }
  }
}

__device__ __forceinline__ void phase_out(const Params& p, unsigned char* smem) {
  unsigned char* ws = p.ws;
  const bf16_t* hb = (const bf16_t*)(ws + WS_PH);
  const bf16_t* wo = (const bf16_t*)(ws + WS_WOUT);
  const int tid = threadIdx.x, lane = tid & 63, w = tid >> 6, wm = w >> 1, wn = w & 1, l15 = lane & 15, g = lane >> 4;
  for (int tile = blockIdx.x; tile < 128 * 8; tile += gridDim.x) {
    const int tn = tile & 7, tm = tile >> 3;
    f32x4 acc[4][4]; zero_acc(acc);
    gemm_tile(hb + (size_t)tm * 256 * 1024, 1024, wo + (size_t)tn * 128 * 1024, 1024, 16, acc, smem);
    const int rbase = tm * 256 + wm * 64 + 4 * g;
    const int cbase = tn * 128 + wn * 64 + l15;
#pragma unroll
    for (int m = 0; m < 4; ++m) {
      float xt[16];
#pragma unroll
      for (int n = 0; n < 4; ++n)
#pragma unroll
        for (int j = 0; j < 4; ++j) xt[n * 4 + j] = p.x[(size_t)(rbase + m * 16 + j) * 1024 + cbase + n * 16];
#pragma unroll
      for (int n = 0; n < 4; ++n)
#pragma unroll
        for (int j = 0; j < 4; ++j) p.out[(size_t)(rbase + m * 16 + j) * 1024 + cbase + n * 16] = xt[n * 4 + j] + acc[m][n][j];
    }
  }
}

__device__ __forceinline__ void phase_pq(const Params& p, unsigned char* smem) {
  unsigned char* ws = p.ws;
  const bf16_t* xn2 = (const bf16_t*)(ws + WS_XN);
  const bf16_t* wq = (const bf16_t*)(ws + WS_WQ);
  bf16_t* qp = (bf16_t*)(ws + WS_PG);
  const int tid = threadIdx.x, lane = tid & 63, w = tid >> 6, wm = w >> 1, wn = w & 1, l15 = lane & 15, g = lane >> 4;
  for (int tile = blockIdx.x; tile < 128 * 16; tile += gridDim.x) {
    const int tn = tile & 15, tm = tile >> 4;
    f32x4 acc[4][4]; zero_acc(acc);
    gemm_tile(xn2 + (size_t)tm * 256 * 1024, 1024, wq + (size_t)tn * 128 * 1024, 1024, 16, acc, smem);
    const int rbase = tm * 256 + wm * 64 + 4 * g;
    const int cbase = tn * 128 + wn * 64 + l15;
#pragma unroll
    for (int m = 0; m < 4; ++m)
#pragma unroll
      for (int n = 0; n < 4; ++n)
#pragma unroll
        for (int j = 0; j < 4; ++j) qp[(size_t)(rbase + m * 16 + j) * 2048 + cbase + n * 16] = f2bf(acc[m][n][j]);
  }
}

__device__ __forceinline__ void phase_pkeys(const Params& p, unsigned char* smem) {
  unsigned char* ws = p.ws;
  const bf16_t* qp = (const bf16_t*)(ws + WS_PG);
  const bf16_t* keys = (const bf16_t*)(ws + WS_KEYS);
  float* ps = (float*)(ws + WS_PA);
  int* pi = (int*)(ws + WS_PA) + (size_t)TOK * 256;
  float* sc = (float*)smem;
  const int tid = threadIdx.x, lane = tid & 63, w = tid >> 6, wm = w >> 1, wn = w & 1, l15 = lane & 15, g = lane >> 4;
  for (int tile = blockIdx.x; tile < 128 * 16; tile += gridDim.x) {
    const int hp = tile & 15, tm = tile >> 4;
    const int h = hp >> 1, ph = hp & 1;
    f32x4 acc[4][4]; zero_acc(acc);
    gemm_tile(qp + (size_t)tm * 256 * 2048 + hp * 128, 2048, keys + (size_t)(ph * 8 + h) * 128 * 128, 128, 2, acc, smem);
    __syncthreads();
#pragma unroll
    for (int m = 0; m < 4; ++m)
#pragma unroll
      for (int n = 0; n < 4; ++n)
#pragma unroll
        for (int j = 0; j < 4; ++j) sc[(wm * 64 + m * 16 + 4 * g + j) * 129 + wn * 64 + n * 16 + l15] = acc[m][n][j];
    __syncthreads();
    if (tid < 256) {
      const int row = tid;
      const float* rowp = sc + row * 129;
      unsigned tv[16];
#pragma unroll
      for (int k = 0; k < 16; ++k) tv[k] = 0u;
#pragma unroll 8
      for (int nn = 0; nn < 128; ++nn) {
        const unsigned bits = __float_as_uint(rowp[nn]);
        unsigned key = (bits & 0x80000000u) ? ~bits : (bits | 0x80000000u);
        key = (key & ~127u) | (unsigned)(127 - nn);
#pragma unroll
        for (int k = 15; k >= 1; --k) {
          unsigned r;
          asm("v_med3_u32 %0, %1, %2, %3" : "=v"(r) : "v"(tv[k]), "v"(tv[k - 1]), "v"(key));
          tv[k] = r;
        }
        tv[0] = tv[0] > key ? tv[0] : key;
      }
      const size_t ob = ((size_t)(tm * 256 + row) * 16 + hp) * 16;
      float ov[16]; int oi[16];
#pragma unroll
      for (int k = 0; k < 16; ++k) { oi[k] = 127 - (int)(tv[k] & 127u); ov[k] = rowp[oi[k]]; }
#pragma unroll
      for (int k = 0; k < 16; k += 4) {
        *(float4*)(ps + ob + k) = make_float4(ov[k], ov[k + 1], ov[k + 2], ov[k + 3]);
        *(int4*)(pi + ob + k) = make_int4(oi[k], oi[k + 1], oi[k + 2], oi[k + 3]);
      }
    }
    __syncthreads();
  }
}

__device__ __forceinline__ void phase_pcomb(const Params& p, unsigned char* smem) {
  unsigned char* ws = p.ws;
  const float* ps = (const float*)(ws + WS_PA);
  const int* pi = (const int*)(ws + WS_PA) + (size_t)TOK * 256;
  int* eidx = (int*)(ws + WS_EIDX);
  float* gw = (float*)(ws + WS_GW);
  float* s2l = (float*)smem;
  unsigned short* i1l = (unsigned short*)(s2l + 512 * 17);
  unsigned short* i2l = i1l + 512 * 16;
  const int tid = threadIdx.x;
  for (int base = blockIdx.x * NTHREADS; base < TOK * 8; base += gridDim.x * NTHREADS) {
    const int th = base + tid;
    const size_t o1 = (size_t)th * 32;
    float s1[16];
#pragma unroll
    for (int a = 0; a < 16; ++a) {
      s1[a] = ps[o1 + a];
      s2l[tid * 17 + a] = ps[o1 + 16 + a];
      i1l[tid * 16 + a] = (unsigned short)pi[o1 + a];
      i2l[tid * 16 + a] = (unsigned short)pi[o1 + 16 + a];
    }
    float cur[16];
    const float s20 = s2l[tid * 17];
#pragma unroll
    for (int a = 0; a < 16; ++a) cur[a] = s1[a] + s20;
    unsigned long long ptr = 0ull;
    float tops[16]; int tope[16];
#pragma unroll
    for (int k = 0; k < 16; ++k) {
      float best = cur[0]; int ba = 0;
#pragma unroll
      for (int a = 1; a < 16; ++a) if (cur[a] > best) { best = cur[a]; ba = a; }
      const int bb = (int)((ptr >> (4 * ba)) & 15ull);
      tops[k] = best;
      tope[k] = (int)i1l[tid * 16 + ba] * 128 + (int)i2l[tid * 16 + bb];
      const int nb = bb + 1;
      const float ns2 = (nb < 16) ? s2l[tid * 17 + nb] : -INFINITY;
      if (nb < 16) ptr += (1ull << (4 * ba));
#pragma unroll
      for (int a = 0; a < 16; ++a) if (a == ba) cur[a] = s1[a] + ns2;
    }
    float m = tops[0];
    float sum = 0.f;
#pragma unroll
    for (int k = 0; k < 16; ++k) { tops[k] = __expf(tops[k] - m); sum += tops[k]; }
    const float inv = 1.f / sum;
#pragma unroll
    for (int k = 0; k < 16; ++k) { eidx[(size_t)th * 16 + k] = tope[k]; gw[(size_t)th * 16 + k] = tops[k] * inv; }
  }
}


__device__ __forceinline__ float reduce8(const float (&pv)[8], int lane) {
  const bool b5 = lane & 32, b4 = lane & 16, b3 = lane & 8;
  float v[4];
#pragma unroll
  for (int i = 0; i < 4; ++i) {
    const float keep = b5 ? pv[4 + i] : pv[i];
    const float send = b5 ? pv[i] : pv[4 + i];
    v[i] = keep + __shfl_xor(send, 32);
  }
  float u[2];
#pragma unroll
  for (int i = 0; i < 2; ++i) {
    const float keep = b4 ? v[2 + i] : v[i];
    const float send = b4 ? v[i] : v[2 + i];
    u[i] = keep + __shfl_xor(send, 16);
  }
  float x = (b3 ? u[1] : u[0]) + __shfl_xor(b3 ? u[0] : u[1], 8);
  x += __shfl_xor(x, 4); x += __shfl_xor(x, 2); x += __shfl_xor(x, 1);
  return x;
}

__device__ __forceinline__ void cvt16u8(const uint4& v, float* f) {
  f[0] = (float)(v.x & 0xffu); f[1] = (float)((v.x >> 8) & 0xffu); f[2] = (float)((v.x >> 16) & 0xffu); f[3] = (float)(v.x >> 24);
  f[4] = (float)(v.y & 0xffu); f[5] = (float)((v.y >> 8) & 0xffu); f[6] = (float)((v.y >> 16) & 0xffu); f[7] = (float)(v.y >> 24);
  f[8] = (float)(v.z & 0xffu); f[9] = (float)((v.z >> 8) & 0xffu); f[10] = (float)((v.z >> 16) & 0xffu); f[11] = (float)(v.z >> 24);
  f[12] = (float)(v.w & 0xffu); f[13] = (float)((v.w >> 8) & 0xffu); f[14] = (float)((v.w >> 16) & 0xffu); f[15] = (float)(v.w >> 24);
}

__device__ __forceinline__ int wave_sum_i32_dpp(int v) {
  v += __builtin_amdgcn_update_dpp(0, v, 0xB1, 0xf, 0xf, true);
  v += __builtin_amdgcn_update_dpp(0, v, 0x4E, 0xf, 0xf, true);
  v += __builtin_amdgcn_update_dpp(0, v, 0x141, 0xf, 0xf, true);
  v += __builtin_amdgcn_update_dpp(0, v, 0x140, 0xf, 0xf, true);
  return __builtin_amdgcn_readlane(v, 0) + __builtin_amdgcn_readlane(v, 16) + __builtin_amdgcn_readlane(v, 32) + __builtin_amdgcn_readlane(v, 48);
}

__device__ __forceinline__ int reduce8_i32_scatter(const int (&d)[8], int lane) {
  const bool b0 = lane & 1, b1 = lane & 2, b2 = lane & 4;
  int v[4];
#pragma unroll
  for (int i = 0; i < 4; ++i) {
    const int keep = b0 ? d[2 * i + 1] : d[2 * i];
    const int send = b0 ? d[2 * i] : d[2 * i + 1];
    v[i] = keep + __builtin_amdgcn_update_dpp(0, send, 0xB1, 0xf, 0xf, true);
  }
  int u[2];
#pragma unroll
  for (int i = 0; i < 2; ++i) {
    const int keep = b1 ? v[2 * i + 1] : v[2 * i];
    const int send = b1 ? v[2 * i] : v[2 * i + 1];
    u[i] = keep + __builtin_amdgcn_update_dpp(0, send, 0x4E, 0xf, 0xf, true);
  }
  int x;
  {
    const int keep = b2 ? u[1] : u[0];
    const int send = b2 ? u[0] : u[1];
    int t = __builtin_amdgcn_update_dpp(0, send, 0x141, 0xf, 0xf, true);
    t = __builtin_amdgcn_update_dpp(0, t, 0x1B, 0xf, 0xf, true);
    x = keep + t;
  }
  x += __builtin_amdgcn_update_dpp(0, x, 0x128, 0xf, 0xf, true);
  { const auto r = __builtin_amdgcn_permlane16_swap((unsigned)x, (unsigned)x, false, false); x = (int)r[0] + (int)r[1]; }
  { const auto r = __builtin_amdgcn_permlane32_swap((unsigned)x, (unsigned)x, false, false); x = (int)r[0] + (int)r[1]; }
  return x;
}

__device__ __forceinline__ void phase_pu(const Params& p, unsigned char* smem) {
  unsigned char* ws = p.ws;
  const unsigned char* XQ = ws + WS_XQ;
  const float* xs = (const float*)(ws + WS_XS);
  const unsigned char* U8 = ws + WS_U;
  const float* us = (const float*)(ws + WS_U + (size_t)16384 * 1024);
  const float* vs = (const float*)(ws + WS_V + (size_t)16384 * 1024);
  const int* eidx = (const int*)(ws + WS_EIDX);
  const float* gw = (const float*)(ws + WS_GW);
  float* aw = (float*)(ws + WS_PA);
  const int lane = threadIdx.x & 63, w = threadIdx.x >> 6;
  const unsigned long long lt_mask = (1ull << lane) - 1ull;
  const int G = gridDim.x;
  const bool sliced = (G % 8 == 0);
  const int ti = sliced ? team_index(p, smem) : 0;
  const int tsz = sliced ? (G >> 3) : G;
  const int grp_lo = sliced ? ti / tsz : 0, grp_hi = sliced ? grp_lo + 1 : 8;
  const int slot = (sliced ? (ti % tsz) : (int)blockIdx.x) * 8 + w;
  const int nslot = tsz * 8;
  unsigned* lst = (unsigned*)smem + 4096 + w * 128;
  typedef unsigned u32x4_t __attribute__((ext_vector_type(4)));
  if (slot >= TOK) return;
  for (int grp = grp_lo; grp < grp_hi; ++grp) {
#define PU_LIST(E0, E1, N, L0, L1) do { \
      const bool m0_ = ((E0) >> 11) == grp, m1_ = ((E1) >> 11) == grp; \
      const unsigned long long b0_ = __ballot(m0_), b1_ = __ballot(m1_); \
      const int c0_ = __popcll(b0_); N = c0_ + __popcll(b1_); \
      if (m0_) lst[__popcll(b0_ & lt_mask)] = ((unsigned)lane << 14) | (unsigned)(E0); \
      if (m1_) lst[c0_ + __popcll(b1_ & lt_mask)] = ((unsigned)(lane + 64) << 14) | (unsigned)(E1); \
      lds_fence(); \
      L0 = (lane < N) ? lst[lane] : 0u; L1 = (lane + 64 < N) ? lst[lane + 64] : 0u; \
      lds_fence(); } while (0)
#define PU_ISSUE(BUF, L0, N, I0) do { int last_ = ((N) < 64 ? (N) : 64) - 1; last_ = last_ < 0 ? 0 : last_; \
      _Pragma("unroll") for (int j = 0; j < 8; ++j) { int idx_ = (I0) + j; idx_ = idx_ < last_ ? idx_ : last_; \
        const unsigned le_ = (unsigned)__builtin_amdgcn_readlane((int)(L0), idx_); \
        BUF[j] = *(const u32x4_t*)(U8 + (size_t)(le_ & 16383u) * 1024 + lane * 16); } } while (0)
#define PU_REDUCE(BUF, X, I0, HREG) do { int dd_[8]; _Pragma("unroll") for (int j = 0; j < 8; ++j) { \
        int d_ = __builtin_amdgcn_sdot4((int)BUF[j].x, (int)(X).x, 0, false); \
        d_ = __builtin_amdgcn_sdot4((int)BUF[j].y, (int)(X).y, d_, false); \
        d_ = __builtin_amdgcn_sdot4((int)BUF[j].z, (int)(X).z, d_, false); \
        dd_[j] = __builtin_amdgcn_sdot4((int)BUF[j].w, (int)(X).w, d_, false); } \
      const int tot_ = reduce8_i32_scatter(dd_, lane);     \
      if (lane >= (I0) && lane < (I0) + 8) HREG = tot_; } while (0)
    u32x4_t cx = *(const u32x4_t*)(XQ + (size_t)slot * 1024 + lane * 16);
    int ce0 = eidx[(size_t)slot * 128 + lane], ce1 = eidx[(size_t)slot * 128 + 64 + lane];
    float cxs = xs[slot];
    int cn; unsigned cl0, cl1;
    PU_LIST(ce0, ce1, cn, cl0, cl1);
    u32x4_t ra[8], rb[8], rc[8];
    PU_ISSUE(ra, cl0, cn, 0);
    PU_ISSUE(rb, cl0, cn, 8);
    int t1 = (slot + nslot < TOK) ? slot + nslot : slot;
    u32x4_t nx = *(const u32x4_t*)(XQ + (size_t)t1 * 1024 + lane * 16);
    int ne0 = eidx[(size_t)t1 * 128 + lane], ne1 = eidx[(size_t)t1 * 128 + 64 + lane];
    float nxs = xs[t1];
    for (int tok = slot; tok < TOK; tok += nslot) {
      float sc0 = 0.f, sc1 = 0.f, gv0 = 0.f, gv1 = 0.f, vv0 = 0.f, vv1 = 0.f;
      if (lane < cn) { const int e = cl0 & 16383; sc0 = us[e]; vv0 = vs[e]; gv0 = gw[(size_t)tok * 128 + (cl0 >> 14)]; }
      if (lane + 64 < cn) { const int e = cl1 & 16383; sc1 = us[e]; vv1 = vs[e]; gv1 = gw[(size_t)tok * 128 + (cl1 >> 14)]; }
      int nn; unsigned nl0, nl1;
      PU_LIST(ne0, ne1, nn, nl0, nl1);
      const u32x4_t x1 = nx; const int xe0 = ne0, xe1 = ne1; const float xs1 = nxs;
      const int t2a = tok + nslot, t2 = (t2a + nslot < TOK) ? t2a + nslot : ((t2a < TOK) ? t2a : tok);
      nx = *(const u32x4_t*)(XQ + (size_t)t2 * 1024 + lane * 16);
      ne0 = eidx[(size_t)t2 * 128 + lane]; ne1 = eidx[(size_t)t2 * 128 + 64 + lane];
      nxs = xs[t2];
      int h0i = 0, h1i = 0;
      const bool third = cn > 16;
      if (third) { PU_ISSUE(rc, cl0, cn, 16); }
      __builtin_amdgcn_sched_barrier(0); PU_REDUCE(ra, cx, 0, h0i);  __builtin_amdgcn_sched_barrier(0);
      PU_ISSUE(ra, nl0, nn, 0);  __builtin_amdgcn_sched_barrier(0); PU_REDUCE(rb, cx, 8, h0i);  __builtin_amdgcn_sched_barrier(0);
      PU_ISSUE(rb, nl0, nn, 8);  __builtin_amdgcn_sched_barrier(0);
      if (third) { PU_REDUCE(rc, cx, 16, h0i); }
      __builtin_amdgcn_sched_barrier(0);
      if (cn > 24) {
        for (int i0 = 24; i0 < cn; i0 += 8) {
          u32x4_t rd[8];
          const bool lo = i0 < 64;
          const unsigned lsrc = lo ? cl0 : cl1;
          const int nsrc = lo ? cn : cn - 64;
          PU_ISSUE(rd, lsrc, nsrc, i0 & 63);
          if (lo) { PU_REDUCE(rd, cx, i0, h0i); } else { PU_REDUCE(rd, cx, i0 - 64, h1i); }
        }
      }
      const float h0 = (float)h0i * sc0 * cxs, h1 = (float)h1i * sc1 * cxs;
      if (lane < cn) aw[(size_t)tok * 128 + (cl0 >> 14)] = 0.5f * h0 * (1.f + erff(h0 * 0.70710678118654752f)) * gv0 * vv0;
      if (lane + 64 < cn) aw[(size_t)tok * 128 + (cl1 >> 14)] = 0.5f * h1 * (1.f + erff(h1 * 0.70710678118654752f)) * gv1 * vv1;
      cx = x1; ce0 = xe0; ce1 = xe1; cxs = xs1; cn = nn; cl0 = nl0; cl1 = nl1;
    }
#undef PU_LIST
#undef PU_ISSUE
#undef PU_REDUCE
  }
}

template <bool SL>
__device__ __forceinline__ void phase_pv_t(const Params& p, unsigned char* smem) {
  unsigned char* ws = p.ws;
  const unsigned char* V8 = ws + WS_V;
  const int* eidx = (const int*)(ws + WS_EIDX);
  const float* aw = (const float*)(ws + WS_PA);
  float* ssq = (float*)(ws + WS_SSQ);
  const int lane = threadIdx.x & 63, w = threadIdx.x >> 6;
  const int q = lane >> 3, c = lane & 7;
  const int G = gridDim.x;
  constexpr bool sliced = SL;
  const int ti = sliced ? team_index(p, smem) : 0;
  const int tsz = G >> 3;
  const int grp0 = sliced ? (ti / tsz) : 0;
  constexpr int ngrp = sliced ? 1 : 8;
  const int slot = sliced ? (ti % tsz) * 8 + w : blockIdx.x * 8 + w;
  const int nslot = sliced ? tsz * 8 : G * 8;
  int ee[16]; float aa[16];
  if (slot < TOK) {
    unsigned bi = (unsigned)slot * 128u + 16u * (unsigned)q;
    asm volatile("" : "+v"(bi));
#pragma unroll
    for (int u4 = 0; u4 < 4; ++u4) {
      const int4 e4 = *(const int4*)(eidx + bi + 4 * u4); const float4 a4 = *(const float4*)(aw + bi + 4 * u4);
      ee[4 * u4] = e4.x; ee[4 * u4 + 1] = e4.y; ee[4 * u4 + 2] = e4.z; ee[4 * u4 + 3] = e4.w;
      aa[4 * u4] = a4.x; aa[4 * u4 + 1] = a4.y; aa[4 * u4 + 2] = a4.z; aa[4 * u4 + 3] = a4.w;
    }
  }
  for (int tok = slot; tok < TOK; tok += nslot) {
    int ce[16]; float ca[16];
    float suma = 0.f;
#pragma unroll
    for (int u = 0; u < 16; ++u) { ce[u] = ee[u]; ca[u] = aa[u]; suma += aa[u]; }
    for (int gi = 0; gi < ngrp; ++gi) {
      const int grp = grp0 + gi;
      uint4 vv[16];
#pragma unroll
      for (int u = 0; u < 16; ++u) vv[u] = *(const uint4*)(V8 + (size_t)grp * (16384 * 128) + (size_t)ce[u] * 128 + c * 16);
      float* orow = p.out + (size_t)tok * 1024 + grp * 128 + c * 16;
      float4 x1v[4];
#pragma unroll
      for (int i = 0; i < 4; ++i) x1v[i] = *(const float4*)(orow + 4 * i);
      if (gi == ngrp - 1) {
        const int nt = (tok + nslot < TOK) ? tok + nslot : tok;
        unsigned bi = (unsigned)nt * 128u + 16u * (unsigned)q;
        asm volatile("" : "+v"(bi));
#pragma unroll
        for (int u4 = 0; u4 < 4; ++u4) {
          const int4 e4 = *(const int4*)(eidx + bi + 4 * u4); const float4 a4 = *(const float4*)(aw + bi + 4 * u4);
          ee[4 * u4] = e4.x; ee[4 * u4 + 1] = e4.y; ee[4 * u4 + 2] = e4.z; ee[4 * u4 + 3] = e4.w;
          aa[4 * u4] = a4.x; aa[4 * u4 + 1] = a4.y; aa[4 * u4 + 2] = a4.z; aa[4 * u4 + 3] = a4.w;
        }
      }
      __builtin_amdgcn_sched_barrier(0);
      float acc[16];
#pragma unroll
      for (int i = 0; i < 16; ++i) acc[i] = -128.f * suma;
#pragma unroll
      for (int u = 0; u < 16; ++u) {
        float vf[16];
        cvt16u8(vv[u], vf);
#pragma unroll
        for (int i = 0; i < 16; ++i) acc[i] += ca[u] * vf[i];
        __builtin_amdgcn_sched_barrier(0);
      }
#pragma unroll
      for (int i = 0; i < 16; ++i) { acc[i] = add_xor8(acc[i]); acc[i] = add_xor16(acc[i]); acc[i] = add_xor32(acc[i]); }
      float ss = 0.f;
      if (q == 0) {
#pragma unroll
        for (int i = 0; i < 4; ++i) {
          const float4 oa = make_float4(x1v[i].x + acc[4 * i], x1v[i].y + acc[4 * i + 1], x1v[i].z + acc[4 * i + 2], x1v[i].w + acc[4 * i + 3]);
          *(float4*)(orow + 4 * i) = oa;
          ss += oa.x * oa.x + oa.y * oa.y + oa.z * oa.z + oa.w * oa.w;
        }
      }
      ss += __shfl_xor(ss, 1); ss += __shfl_xor(ss, 2); ss += __shfl_xor(ss, 4);
      if (lane == 0) atomicAdd(&ssq[tok], ss);
    }
  }
}

__device__ __forceinline__ void phase_final(const Params& p) {
  const float* ssq = (const float*)(p.ws + WS_SSQ);
  const int lane = threadIdx.x & 63, w = threadIdx.x >> 6;
  for (int row = blockIdx.x * 8 + w; row < TOK; row += gridDim.x * 8) {
    const float rstd = rsqrtf(ssq[row] * (1.f / DM) + EPSV);
    float4* o4 = (float4*)(p.out + (size_t)row * DM);
#pragma unroll
    for (int i = 0; i < 4; ++i) {
      float4 v = o4[lane + 64 * i];
      const float4 gg = ((const float4*)p.norm_final)[lane + 64 * i];
      v.x *= rstd * gg.x; v.y *= rstd * gg.y; v.z *= rstd * gg.z; v.w *= rstd * gg.w;
      o4[lane + 64 * i] = v;
    }
  }
}


__device__ __forceinline__ void phase_proj8(const Params& p, unsigned char* smem) {
  unsigned char* ws = p.ws;
  pg8::Gemm g{(const pg8::bf16_t*)(ws + WS_XN), (const pg8::bf16_t*)(ws + WS_WIN), TOK, 5120, 1024};
  pg8::StaticOrder S; S.init(TOK, 5120, (int)gridDim.x, (int)blockIdx.x);
  EpiProj E{(unsigned short*)(ws + WS_PH), (unsigned short*)(ws + WS_PA), (unsigned short*)(ws + WS_PG),
            (unsigned short*)(ws + WS_KC), (unsigned short*)(ws + WS_VC), (unsigned short*)(ws + WS_IKC)};
  pg8::gemm_phase<EpiProj, pg8::StaticOrder>((PG8_LAS unsigned char*)smem, g, S, E, nullptr);
}
__device__ __forceinline__ void phase_ikln(const Params& p) {
  bf16_t* ikc = (bf16_t*)(p.ws + WS_IKC);
  const int tid = threadIdx.x, sub = tid & 7;
  float gam[8], bet[8];
#pragma unroll
  for (int i = 0; i < 8; ++i) { gam[i] = p.ikg[sub * 8 + i]; bet[i] = p.ikb[sub * 8 + i]; }
  for (int row = blockIdx.x * 64 + (tid >> 3); row < TOK; row += gridDim.x * 64) {
    uint4* ptr = (uint4*)(ikc + (size_t)row * 64 + sub * 8);
    const uint4 raw = *ptr;
    float v[8];
    cvt8(raw, v);
    float s = 0.f;
#pragma unroll
    for (int i = 0; i < 8; ++i) s += v[i];
    s += __shfl_xor(s, 1); s += __shfl_xor(s, 2); s += __shfl_xor(s, 4);
    const float mu = s * (1.f / 64.f);
    float q = 0.f;
#pragma unroll
    for (int i = 0; i < 8; ++i) { const float d = v[i] - mu; q += d * d; }
    q += __shfl_xor(q, 1); q += __shfl_xor(q, 2); q += __shfl_xor(q, 4);
    const float rstd = rsqrtf(q * (1.f / 64.f) + EPSV);
    uint4 o;
    o.x = pack2((v[0] - mu) * rstd * gam[0] + bet[0], (v[1] - mu) * rstd * gam[1] + bet[1]);
    o.y = pack2((v[2] - mu) * rstd * gam[2] + bet[2], (v[3] - mu) * rstd * gam[3] + bet[3]);
    o.z = pack2((v[4] - mu) * rstd * gam[4] + bet[4], (v[5] - mu) * rstd * gam[5] + bet[5]);
    o.w = pack2((v[6] - mu) * rstd * gam[6] + bet[6], (v[7] - mu) * rstd * gam[7] + bet[7]);
    *ptr = o;
  }
}
__device__ __forceinline__ void phase_up8(const Params& p, unsigned char* smem) {
  unsigned char* ws = p.ws;
  const pg8::bf16_t* ya = (const pg8::bf16_t*)(ws + WS_XN);
  const pg8::bf16_t* yb = ya + (size_t)TOK * 512;
  pg8::StaticOrder S; S.init(TOK, 1024, (int)gridDim.x, (int)blockIdx.x);
  {
    pg8::Gemm g{ya, (const pg8::bf16_t*)(ws + WS_WUPA), TOK, 1024, 512};
    EpiGate<0> E{(unsigned short*)(ws + WS_PH), (const unsigned short*)(ws + WS_PG), 0};
    pg8::gemm_phase<EpiGate<0>, pg8::StaticOrder>((PG8_LAS unsigned char*)smem, g, S, E, nullptr);
  }
  {
    pg8::Gemm g{yb, (const pg8::bf16_t*)(ws + WS_WUPB), TOK, 1024, 512};
    EpiGate<1> E{(unsigned short*)(ws + WS_PH), (const unsigned short*)(ws + WS_PG), 1024};
    pg8::gemm_phase<EpiGate<1>, pg8::StaticOrder>((PG8_LAS unsigned char*)smem, g, S, E, nullptr);
  }
}
__device__ __forceinline__ void phase_out8(const Params& p, unsigned char* smem) {
  unsigned char* ws = p.ws;
  pg8::Gemm g{(const pg8::bf16_t*)(ws + WS_PH), (const pg8::bf16_t*)(ws + WS_WOUT), TOK, 1024, 1024};
  pg8::StaticOrder S; S.init(TOK, 1024, (int)gridDim.x, (int)blockIdx.x);
  EpiResid E{p.out, p.x};
  pg8::gemm_phase<EpiResid, pg8::StaticOrder>((PG8_LAS unsigned char*)smem, g, S, E, nullptr);
}
__device__ __forceinline__ void phase_pq8(const Params& p, unsigned char* smem) {
  unsigned char* ws = p.ws;
  pg8::Gemm g{(const pg8::bf16_t*)(ws + WS_XN), (const pg8::bf16_t*)(ws + WS_WQ), TOK, 2048, 1024};
  pg8::StaticOrder S; S.init(TOK, 2048, (int)gridDim.x, (int)blockIdx.x);
  EpiStoreBf16 E{(unsigned short*)(ws + WS_PG), 2048};
  pg8::gemm_phase<EpiStoreBf16, pg8::StaticOrder>((PG8_LAS unsigned char*)smem, g, S, E, nullptr);
}

__global__ void __launch_bounds__(NTHREADS) hybrid_fwd(Params p) {
  extern __shared__ __attribute__((aligned(16))) unsigned char smem[];
#if ONE_LAUNCH
  cg::grid_group grid = cg::this_grid();
  volatile LAS unsigned* xst = (volatile LAS unsigned*)(smem + LDS_BYTES - 16);
  if (threadIdx.x == 0) { xst[0] = 0u; xst[1] = 0u; }
  __syncthreads();
  XcdBarrier xbar = xcd_barrier_post((unsigned*)(p.ws + WS_BAR), xst);
#define SEAM(k) do { if (p.ph_lo <= (k) && (k) + 1 < p.ph_hi) { if (p.ph_hi > NPHASE) grid.sync(); else xcd_barrier(xbar); } } while (0)
#else
#define SEAM(k) do { } while (0)
#endif
#define IN(k) (p.ph_lo <= (k) && (k) < p.ph_hi)
#ifndef REPEAT_PH
#define REPEAT_PH -1
#endif
#define REP(k, stmt) do { if (REPEAT_PH == (k)) { stmt; grid.sync(); } } while (0)
  if (IN(0)) { phase_prep(p, smem); SEAM(0); }
  if (IN(1)) { phase_proj8(p, smem); SEAM(1); }
  if (IN(2)) { phase_ikln(p); hgrn_h1_all(p, smem); SEAM(2); }
  if (IN(3)) { phase_mix(p, smem); SEAM(3); }
  if (IN(4)) { phase_up8(p, smem); SEAM(4); }
  if (IN(5)) { phase_out8(p, smem); SEAM(5); }
  if (IN(6)) { rmsnorm_rows_q(p.out, p.norm_ffn, (bf16_t*)(p.ws + WS_XN), p.ws + WS_XQ, (float*)(p.ws + WS_XS)); SEAM(6); }
  if (IN(7)) { phase_pq8(p, smem); SEAM(7); }
  if (IN(8)) { phase_pkeys(p, smem); SEAM(8); }
  if (IN(9)) { phase_pcomb(p, smem); SEAM(9); }
  if (IN(10)) { phase_pu(p, smem); SEAM(10); }
  if (IN(11)) { if (gridDim.x % 8 == 0) phase_pv_t<true>(p, smem); else phase_pv_t<false>(p, smem); SEAM(11); }
  if (IN(12)) { phase_final(p); }
#undef IN
#undef SEAM
}

extern "C" void kernel_launch(void* const* d_in, const int* in_sizes, int n_in, void* d_out, int out_size, void* d_ws, size_t ws_size,
                              hipStream_t stream) {
  static int grid = 0;
  if (grid == 0) {
    if (n_in != 17 || ws_size < WS_END) {
      fprintf(stderr, "kernel_launch: unexpected n_in %d or ws_size %zu (need %zu)\n", n_in, ws_size, (size_t)WS_END);
      grid = -1; return;
    }
    int dev = 0, cus = 0, per_cu = 0;
    hipGetDevice(&dev);
    hipDeviceGetAttribute(&cus, hipDeviceAttributeMultiprocessorCount, dev);
    hipFuncSetAttribute((const void*)hybrid_fwd, hipFuncAttributeMaxDynamicSharedMemorySize, LDS_BYTES);
    hipOccupancyMaxActiveBlocksPerMultiprocessor(&per_cu, (const void*)hybrid_fwd, NTHREADS, LDS_BYTES);
    if (per_cu < 1) { fprintf(stderr, "kernel_launch: occupancy query says %d blocks/CU\n", per_cu); per_cu = 1; }
    (void)hipGetLastError();
    grid = cus;
  }
  if (grid < 0) return;
  Params p{};
  p.x = (const float*)d_in[0]; p.norm_mix = (const float*)d_in[1]; p.w_in = (const float*)d_in[2]; p.hg_lb = (const float*)d_in[3];
  p.hg_norm = (const float*)d_in[4]; p.ikg = (const float*)d_in[5]; p.ikb = (const float*)d_in[6]; p.rel_bias = (const float*)d_in[7];
  p.w_up_a = (const float*)d_in[8]; p.w_up_b = (const float*)d_in[9]; p.w_out = (const float*)d_in[10]; p.norm_ffn = (const float*)d_in[11];
  p.peer_wq = (const float*)d_in[12]; p.peer_keys = (const float*)d_in[13]; p.peer_u = (const float*)d_in[14]; p.peer_v = (const float*)d_in[15];
  p.norm_final = (const float*)d_in[16];
  p.out = (float*)d_out; p.ws = (unsigned char*)d_ws;
#if ONE_LAUNCH
  hipMemsetAsync((unsigned char*)d_ws + WS_BAR, 0, 16384, stream);
  p.ph_lo = 0; p.ph_hi = NPHASE;
  void* args[] = {&p};
  hipError_t e = hipLaunchCooperativeKernel((const void*)hybrid_fwd, dim3(grid), dim3(NTHREADS), args, LDS_BYTES, stream);
  if (e != hipSuccess) fprintf(stderr, "cooperative launch failed: %s (grid %d)\n", hipGetErrorString(e), grid);
#else
  for (int ph = 0; ph < NPHASE; ++ph) {
    p.ph_lo = ph; p.ph_hi = ph + 1;
    hipLaunchKernelGGL(hybrid_fwd, dim3(grid), dim3(NTHREADS), LDS_BYTES, stream, p);
  }
#endif
}
```

```cpp
#include <hip/hip_runtime.h>
#include <hip/hip_cooperative_groups.h>
#include <stdint.h>
#include <stdio.h>
namespace cg = cooperative_groups;

#ifndef ONE_LAUNCH
#define ONE_LAUNCH 1
#endif

typedef unsigned short bf16_t;
typedef __attribute__((ext_vector_type(8))) short bf16x8;
typedef __attribute__((ext_vector_type(4))) float f32x4;

#define NTHREADS 512
#define TOK 32768
#define SEQL 4096
#define DM 1024
#define EPSV 1e-6f
#define NPHASE 12

#define WS_WIN   ((size_t)0)
#define WS_WUPA  (WS_WIN  + (size_t)5120 * 1024 * 2)
#define WS_WUPB  (WS_WUPA + (size_t)1024 * 512 * 2)
#define WS_WOUT  (WS_WUPB + (size_t)1024 * 512 * 2)
#define WS_WQ    (WS_WOUT + (size_t)1024 * 1024 * 2)
#define WS_KEYS  (WS_WQ   + (size_t)2048 * 1024 * 2)
#define WS_LB    (WS_KEYS + (size_t)2 * 8 * 128 * 128 * 2)
#define WS_U     (WS_LB   + (size_t)4096)
#define WS_V     (WS_U    + (size_t)16384 * 1024 * 2)
#define WS_XN    (WS_V    + (size_t)16384 * 1024 * 2)
#define WS_PH    (WS_XN   + (size_t)TOK * 1024 * 2)
#define WS_PA    (WS_PH   + (size_t)TOK * 2048 * 2)
#define WS_PG    (WS_PA   + (size_t)TOK * 1024 * 2)
#define WS_EIDX  (WS_PG   + (size_t)TOK * 2048 * 2)
#define WS_GW    (WS_EIDX + (size_t)TOK * 128 * 4)
#define WS_SSQ   (WS_GW   + (size_t)TOK * 128 * 4)
#define WS_XCC   (WS_SSQ  + (size_t)TOK * 4)
#define WS_BAR   (WS_XCC  + (size_t)4096)
#define WS_DEC   (WS_BAR  + (size_t)16384)
#define WS_QCTR  (WS_DEC  + (size_t)2048 * 384 * 4)
#define WS_END   (WS_QCTR + (size_t)1024)

#define WS_KC (WS_EIDX)
#define WS_VC (WS_KC + (size_t)TOK * 128)
#define WS_IKC (WS_VC + (size_t)TOK * 128)
#define LDS_BYTES 155648

struct Params {
  const float* x; const float* norm_mix; const float* w_in; const float* hg_lb; const float* hg_norm;
  const float* ikg; const float* ikb; const float* rel_bias; const float* w_up_a; const float* w_up_b;
  const float* w_out; const float* norm_ffn; const float* peer_wq; const float* peer_keys;
  const float* peer_u; const float* peer_v; const float* norm_final;
  float* out; unsigned char* ws; int ph_lo, ph_hi;
};

__device__ __forceinline__ float bf2f(bf16_t u) { return __uint_as_float(((unsigned)u) << 16); }
typedef float f32x2_cv __attribute__((ext_vector_type(2)));
typedef __bf16 bf16x2_cv __attribute__((ext_vector_type(2)));
__device__ __forceinline__ unsigned pack2(float a, float b) {
  const f32x2_cv v = {a, b};
  return __builtin_bit_cast(unsigned, __builtin_convertvector(v, bf16x2_cv));
}
__device__ __forceinline__ bf16_t f2bf(float f) { return (bf16_t)(pack2(f, f) & 0xffffu); }
__device__ __forceinline__ float wave_sum_slow(float v) {
#pragma unroll
  for (int o = 32; o > 0; o >>= 1) v += __shfl_xor(v, o);
  return v;
}
__device__ __forceinline__ void lds_fence() { asm volatile("s_waitcnt lgkmcnt(0)" ::: "memory"); }

__device__ __forceinline__ float add_xor8(float v) { return v + __int_as_float(__builtin_amdgcn_update_dpp(0, __float_as_int(v), 0x128, 0xf, 0xf, true)); }
__device__ __forceinline__ float add_xor16(float v) { const auto r = __builtin_amdgcn_permlane16_swap(__float_as_uint(v), __float_as_uint(v), false, false); return __uint_as_float(r[0]) + __uint_as_float(r[1]); }
__device__ __forceinline__ float add_xor32(float v) { const auto r = __builtin_amdgcn_permlane32_swap(__float_as_uint(v), __float_as_uint(v), false, false); return __uint_as_float(r[0]) + __uint_as_float(r[1]); }
__device__ __forceinline__ float max_xor16(float v) { const auto r = __builtin_amdgcn_permlane16_swap(__float_as_uint(v), __float_as_uint(v), false, false); return fmaxf(__uint_as_float(r[0]), __uint_as_float(r[1])); }
__device__ __forceinline__ float max_xor32(float v) { const auto r = __builtin_amdgcn_permlane32_swap(__float_as_uint(v), __float_as_uint(v), false, false); return fmaxf(__uint_as_float(r[0]), __uint_as_float(r[1])); }
__device__ __forceinline__ float wave_sum(float v) {
  v += __int_as_float(__builtin_amdgcn_update_dpp(0, __float_as_int(v), 0xB1, 0xf, 0xf, true));
  v += __int_as_float(__builtin_amdgcn_update_dpp(0, __float_as_int(v), 0x4E, 0xf, 0xf, true));
  v += __int_as_float(__builtin_amdgcn_update_dpp(0, __float_as_int(v), 0x141, 0xf, 0xf, true));
  v += __int_as_float(__builtin_amdgcn_update_dpp(0, __float_as_int(v), 0x140, 0xf, 0xf, true));
  return add_xor32(add_xor16(v));
}
__device__ __forceinline__ float sigmoidf_(float x) { return 1.f / (1.f + __expf(-x)); }
__device__ __forceinline__ float siluf_(float x) { return x / (1.f + __expf(-x)); }


#define XB_TMO      128
#define XB_XCNT(j)  (256  + 64 * (j))
#define XB_XSUB(j)  (1280 + 64 * (j))
#define XB_XGEN(j)  (2304 + 64 * (j))
#define XB_TOP      3328
#define XB_TOPGEN   3392
#define XCD_BAR_WORDS 3456
#define XB_SPIN_CAP (1u << 22)
#define LAS __attribute__((address_space(3)))
__device__ __forceinline__ unsigned xb_ld(unsigned* p)              { return __hip_atomic_load(p, __ATOMIC_RELAXED, __HIP_MEMORY_SCOPE_AGENT); }
__device__ __forceinline__ unsigned xb_add(unsigned* p, unsigned v) { return __hip_atomic_fetch_add(p, v, __ATOMIC_RELAXED, __HIP_MEMORY_SCOPE_AGENT); }
__device__ __forceinline__ unsigned xb_xcc_id() { return (unsigned)__builtin_amdgcn_s_getreg((3 << 11) | 20) & 0xFu; }
#define XB_SPIN(cond, bar) do { unsigned _sp = 0; while (cond) { __builtin_amdgcn_s_sleep(1); \
    if ((++_sp & 255u) == 0u) { if (xb_ld(&(bar)[XB_TMO])) break; if (_sp > XB_SPIN_CAP) { atomicAdd(&(bar)[XB_TMO], 1u); break; } } } } while (0)
struct XcdBarrier { unsigned* bar; unsigned x; volatile LAS unsigned* st; };
__device__ __forceinline__ XcdBarrier xcd_barrier_post(unsigned* bar, volatile LAS unsigned* st) {
  XcdBarrier b; b.bar = bar; b.x = xb_xcc_id(); b.st = st;
  if (threadIdx.x == 0) (void)xb_add(&bar[XB_XCNT(b.x)], 1u);
  return b;
}
__device__ __forceinline__ void xcd_barrier_complete(unsigned* bar, unsigned x, unsigned& nloc, unsigned& nx) {
  const unsigned G = gridDim.x * gridDim.y * gridDim.z;
  unsigned sum, cnt, mine, sp = 0u;
  for (;;) {
    sum = 0u; cnt = 0u; mine = 0u;
#pragma unroll
    for (unsigned j = 0; j < 16; ++j) { const unsigned c = xb_ld(&bar[XB_XCNT(j)]); sum += c; cnt += (c > 0u) ? 1u : 0u; mine = (j == x) ? c : mine; }
    if (sum == G) break;
    __builtin_amdgcn_s_sleep(1);
    if ((++sp & 255u) == 0u) { if (xb_ld(&bar[XB_TMO])) break; if (sp > XB_SPIN_CAP) { atomicAdd(&bar[XB_TMO], 1u); break; } }
  }
  nloc = mine > 0u ? mine : 1u; nx = cnt > 0u ? cnt : 1u;
}
__device__ __forceinline__ void xcd_barrier(const XcdBarrier& b) {
  asm volatile("s_waitcnt vmcnt(0)" ::: "memory");
  __syncthreads();
  if (threadIdx.x == 0) {
    unsigned* bar = b.bar;
    __builtin_amdgcn_s_waitcnt(0);
    unsigned nloc = b.st[0], nx = b.st[1];
    if (nloc == 0u) { xcd_barrier_complete(bar, b.x, nloc, nx); b.st[0] = nloc; b.st[1] = nx; }
    const unsigned old = xb_add(&bar[XB_XSUB(b.x)], 1u);
    const unsigned gen = old / nloc;
    if (old + 1u == (gen + 1u) * nloc) {
      __builtin_amdgcn_fence(__ATOMIC_RELEASE, "agent");
      asm volatile("s_waitcnt vmcnt(0)" ::: "memory");
      const unsigned og = xb_add(&bar[XB_TOP], 1u);
      const unsigned tg = og / nx;
      if (og + 1u == (tg + 1u) * nx) xb_add(&bar[XB_TOPGEN], 1u);
      else XB_SPIN(xb_ld(&bar[XB_TOPGEN]) == tg, bar);
      __builtin_amdgcn_fence(__ATOMIC_ACQUIRE, "agent");
      xb_add(&bar[XB_XGEN(b.x)], 1u);
      asm volatile("s_waitcnt vmcnt(0)" ::: "memory");
    } else {
      XB_SPIN(xb_ld(&bar[XB_XGEN(b.x)]) == gen, bar);
      __builtin_amdgcn_fence(__ATOMIC_ACQUIRE, "agent");
      asm volatile("s_waitcnt vmcnt(0)" ::: "memory");
    }
  }
  __syncthreads();
}

namespace pg8 {
#define PG8_LAS __attribute__((address_space(3)))
typedef unsigned short bf16_t;
typedef short bf16x8 __attribute__((ext_vector_type(8)));
typedef float f32x4 __attribute__((ext_vector_type(4)));
typedef unsigned u32x4 __attribute__((ext_vector_type(4)));
constexpr int BM = 256, BK = 64, HALF = 128, HTB = HALF * BK * 2  , STAGE_BYTES = 8 * HTB, NXCD = 8, WGM = 8;

__host__ __device__ __forceinline__ int lds_byte(int r, int c) { const int st = (r >> 4) * 2 + (c >> 5), rr = r & 15, cc = c & 31, ob = rr * 64 + cc * 2; return st * 1024 + (ob ^ (((ob >> 9) & 1) << 5)); }
__host__ __device__ __forceinline__ void stage_rc(int b, int& R, int& C) { const int st = b / 1024, sb = b % 1024, swz = sb ^ (((sb >> 9) & 1) << 5); R = (st >> 1) * 16 + swz / 64; C = (st & 1) * 32 + (swz % 64) / 2; }
__host__ __device__ __forceinline__ int perm32(int rho) { const int n = rho >> 4, i = rho & 15; return 8 * (i >> 2) + 4 * n + (i & 3); }

struct Unit { int pm, pn; };
struct Gemm { const bf16_t* A; const bf16_t* Bt; int M, N, K; };

struct StaticOrder {
    int nM, nN, nwg, G, c;
    __host__ __device__ void init(int M, int N, int G_, int c_) { nM = M / BM; nN = N / BM; nwg = nM * nN; G = G_; c = c_; }
    __host__ __device__ bool next(int i, Unit& u) const {
        const long L = (long)i * G + c; if (L >= nwg) return false;
        int wgid = (int)L; { const int q = nwg / NXCD, r = nwg % NXCD, xcd = wgid % NXCD, off = wgid / NXCD; wgid = (xcd < r ? xcd * (q + 1) : r * (q + 1) + (xcd - r) * q) + off; }
        const int nig = WGM * nN, gid = wgid / nig, fm = gid * WGM, gsz = (nM - fm) < WGM ? (nM - fm) : WGM;
        u.pm = fm + ((wgid % nig) % gsz); u.pn = (wgid % nig) / gsz; return true;
    }
    __device__ __forceinline__ void a_ready(const Unit&) const {}
    __device__ __forceinline__ void done(const Unit&) const {}
};
__device__ __forceinline__ unsigned cvt_pk_bf16(float lo, float hi) { unsigned r; asm volatile("v_cvt_pk_bf16_f32 %0, %1, %2" : "=v"(r) : "v"(lo), "v"(hi)); return r; }
template <class Epi, class Sched, bool STAMP = false>
__device__ __forceinline__ void gemm_phase(PG8_LAS unsigned char* lds, const Gemm g, const Sched& S, const Epi& E, unsigned long long* stamps) {
    const int tid = threadIdx.x, wid = __builtin_amdgcn_readfirstlane(tid >> 6), lane = tid & 63, wr = wid >> 2, wc = wid & 3, fr = lane & 15, fq = lane >> 4;
    const int K = g.K, nt = K / BK;
    int ts_lo = 0, ts_hi = 0, nts = 0; const unsigned long long rt_entry = STAMP ? (unsigned long long)wall_clock64() : 0ull;
#define PG8_STAMP() do { if (STAMP && wid == 0 && nts < 64) { const unsigned long long _c = (unsigned long long)clock64(); \
        ts_lo = (lane == nts) ? (int)(unsigned)_c : ts_lo; ts_hi = (lane == nts) ? (int)(unsigned)(_c >> 32) : ts_hi; ++nts; } } while (0)
    PG8_STAMP();
    unsigned voffA[2], voffB[2];
#pragma unroll
    for (int i = 0; i < 2; ++i) { int R, C; stage_rc(tid * 16 + i * 8192, R, C); const int Rb = Epi::PERM ? ((R & ~31) + perm32(R & 31)) : R;
        voffA[i] = (unsigned)(R * K + C) * 2u; voffB[i] = (unsigned)(Rb * K + C) * 2u; }
    const size_t kstep = (size_t)(BK * 2);
    const size_t hstep = (size_t)HALF * K * 2;
    const size_t tstep = 2 * hstep;
    const unsigned ldsw = (unsigned)wid * 1024u;
    const int aoff = lds_byte(wr * 64 + fr, fq * 8), boff = lds_byte(wc * 32 + fr, fq * 8);
#define PG8_SA(b, h) (((b) * 2 + (h)) * HTB)
#define PG8_SB(b, h) ((4 + (b) * 2 + (h)) * HTB)
#define PG8_STAGE(bufoff, gbase, voff) do { _Pragma("unroll") for (int _i = 0; _i < 2; ++_i) \
        __builtin_amdgcn_global_load_lds((const unsigned*)((const char*)(gbase) + (voff)[_i]), (PG8_LAS unsigned*)(lds + (bufoff) + ldsw + _i * 8192), 16, 0, 0); } while (0)
#define PG8_LDA(dst, b, h) do { _Pragma("unroll") for (int m = 0; m < 4; ++m) _Pragma("unroll") for (int k = 0; k < 2; ++k) dst[m][k] = *(const PG8_LAS bf16x8*)(lds + PG8_SA(b, h) + aoff + m * 2048 + k * 1024); } while (0)
#define PG8_LDB(dst, b, h) do { _Pragma("unroll") for (int n = 0; n < 2; ++n) _Pragma("unroll") for (int k = 0; k < 2; ++k) dst[n][k] = *(const PG8_LAS bf16x8*)(lds + PG8_SB(b, h) + boff + n * 2048 + k * 1024); } while (0)
#define PG8_MMA(ai, bj, At, Bt) do { __builtin_amdgcn_s_setprio(1); _Pragma("unroll") for (int m = 0; m < 4; ++m) _Pragma("unroll") for (int n = 0; n < 2; ++n) _Pragma("unroll") for (int k = 0; k < 2; ++k) \
        acc[ai][bj][m][n] = __builtin_amdgcn_mfma_f32_16x16x32_bf16(Bt[n][k], At[m][k], acc[ai][bj][m][n], 0, 0, 0); __builtin_amdgcn_s_setprio(0); } while (0)
#define PG8_WAIT_V(n) asm volatile("s_waitcnt vmcnt(" #n ")" ::: "memory")
#define PG8_WAIT_L(n) asm volatile("s_waitcnt lgkmcnt(" #n ")" ::: "memory")
#define PG8_BAR __builtin_amdgcn_s_barrier()
#define PG8_SCHED __builtin_amdgcn_sched_barrier(0)
    Unit cur, nxt; int ui = 0;
    if (!S.next(0, cur)) return;
    f32x4 acc[2][2][4][2];
#pragma unroll
    for (int a = 0; a < 2; ++a)
#pragma unroll
        for (int b = 0; b < 2; ++b)
#pragma unroll
            for (int m = 0; m < 4; ++m)
#pragma unroll
                for (int n = 0; n < 2; ++n) acc[a][b][m][n] = (f32x4){0.f, 0.f, 0.f, 0.f};
    bf16x8 At[4][2], B0[2][2], B1[2][2];
    const char* cA = (const char*)g.A + (size_t)cur.pm * tstep; const char* cB = (const char*)g.Bt + (size_t)cur.pn * tstep;
    S.a_ready(cur);
    PG8_STAGE(PG8_SB(0, 0), cB, voffB); PG8_STAGE(PG8_SA(0, 0), cA, voffA); PG8_STAGE(PG8_SB(0, 1), cB + hstep, voffB); PG8_STAGE(PG8_SA(0, 1), cA + hstep, voffA);
    if (wr == 1) PG8_BAR;
    PG8_WAIT_V(4); PG8_BAR;
    PG8_STAGE(PG8_SB(1, 0), cB + kstep, voffB); PG8_STAGE(PG8_SA(1, 0), cA + kstep, voffA); PG8_STAGE(PG8_SB(1, 1), cB + hstep + kstep, voffB);
    PG8_WAIT_V(6); PG8_BAR;
    PG8_STAMP();
    for (;;) {
        const bool has_next = S.next(ui + 1, nxt);
        const char* nA = has_next ? (const char*)g.A + (size_t)nxt.pm * tstep : cA; const char* nB = has_next ? (const char*)g.Bt + (size_t)nxt.pn * tstep : cB;
        for (int t = 0; t < nt; t += 2) {
            const bool last = (t == nt - 2);
            const char* a1 = cA + (size_t)(t + 1) * kstep;
            const char* a2 = last ? nA : cA + (size_t)(t + 2) * kstep; const char* b2 = last ? nB : cB + (size_t)(t + 2) * kstep;
            const char* a3 = a2 + kstep; const char* b3 = b2 + kstep;
            if (last && has_next) S.a_ready(nxt);
            PG8_LDB(B0, 0, 0); PG8_SCHED; PG8_LDA(At, 0, 0); PG8_STAGE(PG8_SA(1, 1), a1 + hstep, voffA);
            PG8_WAIT_L(8); PG8_BAR; PG8_WAIT_L(0); PG8_MMA(0, 0, At, B0); PG8_BAR; PG8_SCHED;
            PG8_LDB(B1, 0, 1); PG8_STAGE(PG8_SB(0, 0), b2, voffB);
            PG8_BAR; PG8_WAIT_L(0); PG8_MMA(0, 1, At, B1); PG8_BAR;
            PG8_LDA(At, 0, 1); PG8_STAGE(PG8_SA(0, 0), a2, voffA);
            PG8_BAR; PG8_WAIT_L(0); PG8_MMA(1, 0, At, B0); PG8_BAR; PG8_SCHED;
            PG8_STAGE(PG8_SB(0, 1), b2 + hstep, voffB);
            PG8_WAIT_V(6); PG8_BAR; PG8_MMA(1, 1, At, B1); PG8_BAR;
            PG8_LDB(B0, 1, 0); PG8_SCHED; PG8_LDA(At, 1, 0); PG8_STAGE(PG8_SA(0, 1), a2 + hstep, voffA);
            PG8_WAIT_L(8); PG8_BAR; PG8_WAIT_L(0); PG8_MMA(0, 0, At, B0); PG8_BAR; PG8_SCHED;
            PG8_LDB(B1, 1, 1); PG8_STAGE(PG8_SB(1, 0), b3, voffB);
            PG8_BAR; PG8_WAIT_L(0); PG8_MMA(0, 1, At, B1); PG8_BAR;
            PG8_LDA(At, 1, 1); PG8_STAGE(PG8_SA(1, 0), a3, voffA);
            PG8_BAR; PG8_WAIT_L(0); PG8_MMA(1, 0, At, B0); PG8_BAR; PG8_SCHED;
            PG8_STAGE(PG8_SB(1, 1), b3 + hstep, voffB);
            PG8_WAIT_V(6); PG8_BAR; PG8_MMA(1, 1, At, B1); PG8_BAR;
        }
        PG8_STAMP();
        if constexpr (!Epi::AFTER_DRAIN) { E(acc, cur, wr, wc, fr, fq); S.done(cur); }
        PG8_STAMP();
        if (!has_next) break;
#pragma unroll
        for (int a = 0; a < 2; ++a)
#pragma unroll
            for (int b = 0; b < 2; ++b)
#pragma unroll
                for (int m = 0; m < 4; ++m)
#pragma unroll
                    for (int n = 0; n < 2; ++n) acc[a][b][m][n] = (f32x4){0.f, 0.f, 0.f, 0.f};
        cur = nxt; cA = nA; cB = nB; ++ui;
    }
    PG8_WAIT_V(0);
    if (wr == 0) PG8_BAR;
    PG8_BAR;
    if constexpr (Epi::AFTER_DRAIN) { E.fused(acc, cur, wr, wc, fr, fq, lds, wid, lane); S.done(cur); }
    PG8_STAMP();
    if (STAMP && wid == 0) { stamps[lane] = lane < nts ? (((unsigned long long)(unsigned)ts_hi << 32) | (unsigned)ts_lo) : 0ull;
        if (lane == 62) stamps[62] = rt_entry; if (lane == 63) stamps[63] = (unsigned long long)wall_clock64(); }
#undef PG8_STAMP
#undef PG8_SA
#undef PG8_SB
#undef PG8_STAGE
#undef PG8_LDA
#undef PG8_LDB
#undef PG8_MMA
#undef PG8_WAIT_V
#undef PG8_WAIT_L
#undef PG8_BAR
#undef PG8_SCHED
}
}

struct EpiProj {
  static constexpr bool PERM = true, AFTER_DRAIN = false;
  unsigned short* pH; unsigned short* pA; unsigned short* pG; unsigned short* kc; unsigned short* vc; unsigned short* ikc;
  __device__ __forceinline__ void operator()(const pg8::f32x4 (&acc)[2][2][4][2], const pg8::Unit& u, int wr, int wc, int fr, int fq) const {
    const int row0 = u.pm * 256 + wr * 64 + fr;
    unsigned short* base; int ldc, colt; bool sg = false;
    if (u.pn < 8) { base = pH; ldc = 2048; colt = u.pn * 256; }
    else if (u.pn < 12) { base = pA; ldc = 1024; colt = (u.pn - 8) * 256; }
    else { base = pG; ldc = 2048; colt = (u.pn - 12) * 256; sg = true; }
    const int col0 = colt + wc * 32 + 8 * fq;
#pragma unroll
    for (int ai = 0; ai < 2; ++ai)
#pragma unroll
      for (int m = 0; m < 4; ++m) {
        unsigned short* rowp = base + (size_t)(row0 + ai * 128 + m * 16) * ldc + col0;
#pragma unroll
        for (int bj = 0; bj < 2; ++bj) {
          pg8::f32x4 v0 = acc[ai][bj][m][0], v1 = acc[ai][bj][m][1];
          if (sg) {
#pragma unroll
            for (int j = 0; j < 4; ++j) { v0[j] = sigmoidf_(v0[j]); v1[j] = sigmoidf_(v1[j]); }
          }
          pg8::u32x4 w; w.x = pg8::cvt_pk_bf16(v0[0], v0[1]); w.y = pg8::cvt_pk_bf16(v0[2], v0[3]); w.z = pg8::cvt_pk_bf16(v1[0], v1[1]); w.w = pg8::cvt_pk_bf16(v1[2], v1[3]);
          unsigned short* dst = rowp + bj * 128;
          if (u.pn == 10 || u.pn == 11) {
            const int cs = col0 + bj * 128;
            const size_t r = (size_t)(row0 + ai * 128 + m * 16);
            if (cs >= 512 && cs < 576) dst = kc + r * 64 + (cs - 512);
            else if (cs >= 576 && cs < 640) dst = vc + r * 64 + (cs - 576);
            else if (cs >= 896 && cs < 960) dst = ikc + r * 64 + (cs - 896);
          }
          *(pg8::u32x4*)dst = w;
        }
      }
  }
};
template <int MODE> struct EpiGate {
  static constexpr bool PERM = true, AFTER_DRAIN = false;
  unsigned short* hb; const unsigned short* pG; int goff;
  __device__ __forceinline__ void operator()(const pg8::f32x4 (&acc)[2][2][4][2], const pg8::Unit& u, int wr, int wc, int fr, int fq) const {
    const int row0 = u.pm * 256 + wr * 64 + fr;
    const int col0 = u.pn * 256 + wc * 32 + 8 * fq;
#pragma unroll
    for (int ai = 0; ai < 2; ++ai)
#pragma unroll
      for (int m = 0; m < 4; ++m) {
        const size_t r = (size_t)(row0 + ai * 128 + m * 16);
        pg8::u32x4 gv[2], hv[2];
#pragma unroll
        for (int bj = 0; bj < 2; ++bj) {
          gv[bj] = *(const pg8::u32x4*)(pG + r * 2048 + goff + col0 + bj * 128);
          if (MODE == 1) hv[bj] = *(const pg8::u32x4*)(hb + r * 1024 + col0 + bj * 128);
        }
#pragma unroll
        for (int bj = 0; bj < 2; ++bj) {
          float o[8];
#pragma unroll
          for (int j = 0; j < 4; ++j) {
            const unsigned gw0 = gv[bj][j >> 1], gw1 = gv[bj][2 + (j >> 1)];
            const float g0 = (j & 1) ? __uint_as_float(gw0 & 0xffff0000u) : __uint_as_float(gw0 << 16);
            const float g1 = (j & 1) ? __uint_as_float(gw1 & 0xffff0000u) : __uint_as_float(gw1 << 16);
            o[j] = acc[ai][bj][m][0][j] * g0; o[4 + j] = acc[ai][bj][m][1][j] * g1;
            if (MODE == 1) {
              const unsigned hw0 = hv[bj][j >> 1], hw1 = hv[bj][2 + (j >> 1)];
              o[j] += (j & 1) ? __uint_as_float(hw0 & 0xffff0000u) : __uint_as_float(hw0 << 16);
              o[4 + j] += (j & 1) ? __uint_as_float(hw1 & 0xffff0000u) : __uint_as_float(hw1 << 16);
            }
          }
          pg8::u32x4 w; w.x = pg8::cvt_pk_bf16(o[0], o[1]); w.y = pg8::cvt_pk_bf16(o[2], o[3]); w.z = pg8::cvt_pk_bf16(o[4], o[5]); w.w = pg8::cvt_pk_bf16(o[6], o[7]);
          *(pg8::u32x4*)(hb + r * 1024 + col0 + bj * 128) = w;
        }
      }
  }
};
struct EpiResid {
  static constexpr bool PERM = false, AFTER_DRAIN = false;
  float* out; const float* x;
  __device__ __forceinline__ void operator()(const pg8::f32x4 (&acc)[2][2][4][2], const pg8::Unit& u, int wr, int wc, int fr, int fq) const {
    const int row0 = u.pm * 256 + wr * 64 + fr, col0 = u.pn * 256 + wc * 32 + 4 * fq;
#pragma unroll
    for (int ai = 0; ai < 2; ++ai)
#pragma unroll
      for (int m = 0; m < 4; ++m) {
        const size_t off = (size_t)(row0 + ai * 128 + m * 16) * 1024 + col0;
        pg8::f32x4 xv[2][2];
#pragma unroll
        for (int bj = 0; bj < 2; ++bj)
#pragma unroll
          for (int n = 0; n < 2; ++n) xv[bj][n] = *(const pg8::f32x4*)(x + off + bj * 128 + n * 16);
#pragma unroll
        for (int bj = 0; bj < 2; ++bj)
#pragma unroll
          for (int n = 0; n < 2; ++n) *(pg8::f32x4*)(out + off + bj * 128 + n * 16) = acc[ai][bj][m][n] + xv[bj][n];
      }
  }
};
struct EpiStoreBf16 {
  static constexpr bool PERM = true, AFTER_DRAIN = false;
  unsigned short* O; int ldc;
  __device__ __forceinline__ void operator()(const pg8::f32x4 (&acc)[2][2][4][2], const pg8::Unit& u, int wr, int wc, int fr, int fq) const {
    const int row0 = u.pm * 256 + wr * 64 + fr, col0 = u.pn * 256 + wc * 32 + 8 * fq;
#pragma unroll
    for (int ai = 0; ai < 2; ++ai)
#pragma unroll
      for (int m = 0; m < 4; ++m) {
        unsigned short* rowp = O + (size_t)(row0 + ai * 128 + m * 16) * ldc + col0;
#pragma unroll
        for (int bj = 0; bj < 2; ++bj) {
          const pg8::f32x4 v0 = acc[ai][bj][m][0], v1 = acc[ai][bj][m][1];
          pg8::u32x4 w; w.x = pg8::cvt_pk_bf16(v0[0], v0[1]); w.y = pg8::cvt_pk_bf16(v0[2], v0[3]); w.z = pg8::cvt_pk_bf16(v1[0], v1[1]); w.w = pg8::cvt_pk_bf16(v1[2], v1[3]);
          *(pg8::u32x4*)(rowp + bj * 128) = w;
        }
      }
  }
};

__device__ __forceinline__ void gemm_tile(const bf16_t* __restrict__ A, int lda, const bf16_t* __restrict__ Bt, int ldb,
                                          int nk, f32x4 (&acc)[4][4], unsigned char* smem) {
  const int tid = threadIdx.x, lane = tid & 63, w = tid >> 6, wm = w >> 1, wn = w & 1, l15 = lane & 15, g = lane >> 4;
  unsigned char* sA = smem;
  unsigned char* sB = smem + 32768;
  const int lr = tid >> 3, lc = tid & 7;
  const bf16_t* ga = A + (size_t)lr * lda + lc * 8;
  const bf16_t* gb = Bt + (size_t)lr * ldb + lc * 8;
  uint4 ra0, ra1, ra2, ra3, rb0, rb1;
  ra0 = *(const uint4*)(ga);
  ra1 = *(const uint4*)(ga + (size_t)64 * lda);
  ra2 = *(const uint4*)(ga + (size_t)128 * lda);
  ra3 = *(const uint4*)(ga + (size_t)192 * lda);
  rb0 = *(const uint4*)(gb);
  rb1 = *(const uint4*)(gb + (size_t)64 * ldb);
  const int sw = (lc ^ (lr & 7)) << 4;
  for (int kt = 0; kt < nk; ++kt) {
    __syncthreads();
    *(uint4*)(sA + (lr) * 128 + sw) = ra0;
    *(uint4*)(sA + (lr + 64) * 128 + sw) = ra1;
    *(uint4*)(sA + (lr + 128) * 128 + sw) = ra2;
    *(uint4*)(sA + (lr + 192) * 128 + sw) = ra3;
    *(uint4*)(sB + (lr) * 128 + sw) = rb0;
    *(uint4*)(sB + (lr + 64) * 128 + sw) = rb1;
    __syncthreads();
    if (kt + 1 < nk) {
      const int ko = (kt + 1) * 64;
      ra0 = *(const uint4*)(ga + ko);
      ra1 = *(const uint4*)(ga + (size_t)64 * lda + ko);
      ra2 = *(const uint4*)(ga + (size_t)128 * lda + ko);
      ra3 = *(const uint4*)(ga + (size_t)192 * lda + ko);
      rb0 = *(const uint4*)(gb + ko);
      rb1 = *(const uint4*)(gb + (size_t)64 * ldb + ko);
    }
#pragma unroll
    for (int ks = 0; ks < 2; ++ks) {
      bf16x8 a[4], b[4];
#pragma unroll
      for (int m = 0; m < 4; ++m) { const int r = wm * 64 + m * 16 + l15; a[m] = *(const bf16x8*)(sA + r * 128 + (((ks * 4 + g) ^ (r & 7)) << 4)); }
#pragma unroll
      for (int n = 0; n < 4; ++n) { const int r = wn * 64 + n * 16 + l15; b[n] = *(const bf16x8*)(sB + r * 128 + (((ks * 4 + g) ^ (r & 7)) << 4)); }
#pragma unroll
      for (int m = 0; m < 4; ++m)
#pragma unroll
        for (int n = 0; n < 4; ++n) acc[m][n] = __builtin_amdgcn_mfma_f32_16x16x32_bf16(a[m], b[n], acc[m][n], 0, 0, 0);
    }
  }
}

__device__ __forceinline__ void zero_acc(f32x4 (&acc)[4][4]) {
#pragma unroll
  for (int m = 0; m < 4; ++m)
#pragma unroll
    for (int n = 0; n < 4; ++n) acc[m][n] = (f32x4){0.f, 0.f, 0.f, 0.f};
}

__device__ __forceinline__ void transpose_tile(const float* __restrict__ src, int srcN, bf16_t* __restrict__ dst, int K, int n0, int k0,
                                               bool winmap, float* tile) {
  const int tid = threadIdx.x;
  const int nc = tid & 63, kr = tid >> 6;
  int ncol = n0 + nc; bool valid = true;
  if (winmap) { if (ncol >= 3072) ncol -= 60; else if (ncol >= 3012) valid = false; }
#pragma unroll
  for (int i = 0; i < 8; ++i) {
    const int k = kr + 8 * i;
    tile[k * 65 + nc] = valid ? src[(size_t)(k0 + k) * srcN + ncol] : 0.f;
  }
  __syncthreads();
#pragma unroll
  for (int i = 0; i < 8; ++i) {
    const int nr = kr + 8 * i;
    dst[(size_t)(n0 + nr) * K + k0 + nc] = f2bf(tile[nc * 65 + nr]);
  }
  __syncthreads();
}

__device__ __forceinline__ void convert_f32_bf16(const float* __restrict__ src, bf16_t* __restrict__ dst, size_t n4) {
  for (size_t i = (size_t)blockIdx.x * NTHREADS + threadIdx.x; i < n4; i += (size_t)gridDim.x * NTHREADS) {
    const float4 v = ((const float4*)src)[i];
    uint2 o; o.x = pack2(v.x, v.y); o.y = pack2(v.z, v.w);
    ((uint2*)dst)[i] = o;
  }
}

template <bool SLICE_MAJOR, bool SIGNED>
__device__ __forceinline__ void quantize_rows_u8(const float* __restrict__ src, unsigned char* __restrict__ dst, float* __restrict__ scale, int row_lo, int row_hi) {
  const int lane = threadIdx.x & 63, w = threadIdx.x >> 6;
  for (int row = row_lo + w; row < row_hi; row += 8) {
    const float4* s4 = (const float4*)(src + (size_t)row * 1024) + lane * 4;
    float4 v[4];
    float am = 0.f;
#pragma unroll
    for (int i = 0; i < 4; ++i) { v[i] = s4[i]; am = fmaxf(am, fmaxf(fmaxf(fabsf(v[i].x), fabsf(v[i].y)), fmaxf(fabsf(v[i].z), fabsf(v[i].w)))); }
#pragma unroll
    for (int o = 32; o > 0; o >>= 1) am = fmaxf(am, __shfl_xor(am, o));
    const float inv = am > 0.f ? 127.f / am : 0.f;
    unsigned pk[4];
#pragma unroll
    for (int i = 0; i < 4; ++i) {
      const int ofs = SIGNED ? 0 : 128;
      const unsigned b0 = (unsigned)((int)rintf(v[i].x * inv) + ofs), b1 = (unsigned)((int)rintf(v[i].y * inv) + ofs);
      const unsigned b2 = (unsigned)((int)rintf(v[i].z * inv) + ofs), b3 = (unsigned)((int)rintf(v[i].w * inv) + ofs);
      pk[i] = (b0 & 255u) | ((b1 & 255u) << 8) | ((b2 & 255u) << 16) | ((b3 & 255u) << 24);
    }
    if (SLICE_MAJOR) *(uint4*)(dst + (size_t)(lane >> 3) * (16384 * 128) + (size_t)row * 128 + (lane & 7) * 16) = make_uint4(pk[0], pk[1], pk[2], pk[3]);
    else *(uint4*)(dst + (size_t)row * 1024 + lane * 16) = make_uint4(pk[0], pk[1], pk[2], pk[3]);
    if (lane == 0) scale[row] = am * (1.f / 127.f);
  }
}

#define WS_XQ (WS_PH + (size_t)TOK * 1024 * 2)
#define WS_XS (WS_XQ + (size_t)TOK * 1024)
__device__ __forceinline__ void rmsnorm_rows_q(const float* __restrict__ src, const float* __restrict__ g, bf16_t* __restrict__ dst,
                                               unsigned char* __restrict__ xq, float* __restrict__ xs) {
  const int lane = threadIdx.x & 63, w = threadIdx.x >> 6;
  for (int row = blockIdx.x * 8 + w; row < TOK; row += gridDim.x * 8) {
    const float4* s4 = (const float4*)(src + (size_t)row * DM) + lane * 4;
    const float4* g4 = (const float4*)g + lane * 4;
    float v[16]; float ss = 0.f;
#pragma unroll
    for (int i = 0; i < 4; ++i) { const float4 t = s4[i]; v[4 * i] = t.x; v[4 * i + 1] = t.y; v[4 * i + 2] = t.z; v[4 * i + 3] = t.w; ss += t.x * t.x + t.y * t.y + t.z * t.z + t.w * t.w; }
    ss = wave_sum(ss);
    const float rstd = rsqrtf(ss * (1.f / DM) + EPSV);
    float am = 0.f;
#pragma unroll
    for (int i = 0; i < 4; ++i) { const float4 gg = g4[i]; v[4 * i] *= rstd * gg.x; v[4 * i + 1] *= rstd * gg.y; v[4 * i + 2] *= rstd * gg.z; v[4 * i + 3] *= rstd * gg.w; }
#pragma unroll
    for (int i = 0; i < 16; ++i) am = fmaxf(am, fabsf(v[i]));
#pragma unroll
    for (int o = 32; o > 0; o >>= 1) am = fmaxf(am, __shfl_xor(am, o));
    const float inv = am > 0.f ? 127.f / am : 0.f;
    uint4 ob0, ob1;
    ob0.x = pack2(v[0], v[1]); ob0.y = pack2(v[2], v[3]); ob0.z = pack2(v[4], v[5]); ob0.w = pack2(v[6], v[7]);
    ob1.x = pack2(v[8], v[9]); ob1.y = pack2(v[10], v[11]); ob1.z = pack2(v[12], v[13]); ob1.w = pack2(v[14], v[15]);
    *(uint4*)(dst + (size_t)row * DM + lane * 16) = ob0;
    *(uint4*)(dst + (size_t)row * DM + lane * 16 + 8) = ob1;
    unsigned pk[4];
#pragma unroll
    for (int i = 0; i < 4; ++i) {
      const unsigned b0 = (unsigned)(int)rintf(v[4 * i] * inv) & 255u, b1 = (unsigned)(int)rintf(v[4 * i + 1] * inv) & 255u;
      const unsigned b2 = (unsigned)(int)rintf(v[4 * i + 2] * inv) & 255u, b3 = (unsigned)(int)rintf(v[4 * i + 3] * inv) & 255u;
      pk[i] = b0 | (b1 << 8) | (b2 << 16) | (b3 << 24);
    }
    *(uint4*)(xq + (size_t)row * 1024 + lane * 16) = make_uint4(pk[0], pk[1], pk[2], pk[3]);
    if (lane == 0) xs[row] = am * (1.f / 127.f);
  }
}

__device__ __forceinline__ void rmsnorm_rows(const float* __restrict__ src, const float* __restrict__ g, bf16_t* __restrict__ dst) {
  const int lane = threadIdx.x & 63, w = threadIdx.x >> 6;
  for (int row = blockIdx.x * 8 + w; row < TOK; row += gridDim.x * 8) {
    const float4* s4 = (const float4*)(src + (size_t)row * DM);
    float4 v[4]; float ss = 0.f;
#pragma unroll
    for (int i = 0; i < 4; ++i) { v[i] = s4[lane + 64 * i]; ss += v[i].x * v[i].x + v[i].y * v[i].y + v[i].z * v[i].z + v[i].w * v[i].w; }
    ss = wave_sum(ss);
    const float rstd = rsqrtf(ss * (1.f / DM) + EPSV);
#pragma unroll
    for (int i = 0; i < 4; ++i) {
      const float4 gg = ((const float4*)g)[lane + 64 * i];
      uint2 o; o.x = pack2(v[i].x * rstd * gg.x, v[i].y * rstd * gg.y); o.y = pack2(v[i].z * rstd * gg.z, v[i].w * rstd * gg.w);
      ((uint2*)(dst + (size_t)row * DM))[lane + 64 * i] = o;
    }
  }
}

__device__ __forceinline__ void phase_prep(const Params& p, unsigned char* smem) {
  unsigned char* ws = p.ws;
  float* tile = (float*)smem;
  const int n_win = 80 * 16, n_ua = 16 * 8, n_ub = 16 * 8, n_wo = 16 * 16, n_wq = 32 * 16;
  const int total = n_win + n_ua + n_ub + n_wo + n_wq;
  for (int it = blockIdx.x; it < total; it += gridDim.x) {
    int t = it;
    if (t < n_win) { transpose_tile(p.w_in, 5060, (bf16_t*)(ws + WS_WIN), 1024, (t >> 4) * 64, (t & 15) * 64, true, tile); continue; }
    t -= n_win;
    if (t < n_ua) { transpose_tile(p.w_up_a, 1024, (bf16_t*)(ws + WS_WUPA), 512, (t >> 3) * 64, (t & 7) * 64, false, tile); continue; }
    t -= n_ua;
    if (t < n_ub) { transpose_tile(p.w_up_b, 1024, (bf16_t*)(ws + WS_WUPB), 512, (t >> 3) * 64, (t & 7) * 64, false, tile); continue; }
    t -= n_ub;
    if (t < n_wo) { transpose_tile(p.w_out, 1024, (bf16_t*)(ws + WS_WOUT), 1024, (t >> 4) * 64, (t & 15) * 64, false, tile); continue; }
    t -= n_wo;
    transpose_tile(p.peer_wq, 2048, (bf16_t*)(ws + WS_WQ), 1024, (t >> 4) * 64, (t & 15) * 64, false, tile);
  }
  convert_f32_bf16(p.peer_keys, (bf16_t*)(ws + WS_KEYS), (size_t)2 * 8 * 128 * 128 / 4);
  for (int i = blockIdx.x * NTHREADS + threadIdx.x; i < TOK; i += gridDim.x * NTHREADS) ((float*)(ws + WS_SSQ))[i] = 0.f;
  if (threadIdx.x == 0) ((int*)(ws + WS_XCC))[blockIdx.x] = (int)(__builtin_amdgcn_s_getreg((3 << 11) | 20) & 0xFu);
  if (blockIdx.x == 0 && threadIdx.x < 8) ((unsigned*)(ws + WS_QCTR))[16 * threadIdx.x] = 0u;
  if (blockIdx.x == 0) {
    const int i = threadIdx.x;
    const float a0 = p.hg_lb[i], a1 = p.hg_lb[512 + i];
    ((float*)(ws + WS_LB))[i] = 1.f / (1.f + expf(a1 - a0));
  }
  rmsnorm_rows(p.x, p.norm_mix, (bf16_t*)(ws + WS_XN));
}

__device__ __forceinline__ void phase_proj(const Params& p, unsigned char* smem) {
  unsigned char* ws = p.ws;
  const bf16_t* xn = (const bf16_t*)(ws + WS_XN);
  const bf16_t* wt = (const bf16_t*)(ws + WS_WIN);
  bf16_t* pH = (bf16_t*)(ws + WS_PH);
  bf16_t* pA = (bf16_t*)(ws + WS_PA);
  bf16_t* pG = (bf16_t*)(ws + WS_PG);
  const int tid = threadIdx.x, lane = tid & 63, w = tid >> 6, wm = w >> 1, wn = w & 1, l15 = lane & 15, g = lane >> 4;
  for (int tile = blockIdx.x; tile < 128 * 40; tile += gridDim.x) {
    const int tn = tile % 40, tm = tile / 40;
    f32x4 acc[4][4]; zero_acc(acc);
    gemm_tile(xn + (size_t)tm * 256 * 1024, 1024, wt + (size_t)tn * 128 * 1024, 1024, 16, acc, smem);
    const int rbase = tm * 256 + wm * 64 + 4 * g;
    const int cbase = tn * 128 + wn * 64 + l15;
    if (tn < 16) {
#pragma unroll
      for (int m = 0; m < 4; ++m)
#pragma unroll
        for (int n = 0; n < 4; ++n)
#pragma unroll
          for (int j = 0; j < 4; ++j) pH[(size_t)(rbase + m * 16 + j) * 2048 + cbase + n * 16] = f2bf(acc[m][n][j]);
    } else if (tn < 24) {
      if (tn == 23 && wn == 0) {
        float gam[4], bet[4];
#pragma unroll
        for (int n = 0; n < 4; ++n) { gam[n] = p.ikg[n * 16 + l15]; bet[n] = p.ikb[n * 16 + l15]; }
#pragma unroll
        for (int m = 0; m < 4; ++m)
#pragma unroll
          for (int j = 0; j < 4; ++j) {
            float s = acc[m][0][j] + acc[m][1][j] + acc[m][2][j] + acc[m][3][j];
            s += __shfl_xor(s, 1); s += __shfl_xor(s, 2); s += __shfl_xor(s, 4); s += __shfl_xor(s, 8);
            const float mu = s * (1.f / 64.f);
            float q = 0.f;
#pragma unroll
            for (int n = 0; n < 4; ++n) { const float d = acc[m][n][j] - mu; q += d * d; }
            q += __shfl_xor(q, 1); q += __shfl_xor(q, 2); q += __shfl_xor(q, 4); q += __shfl_xor(q, 8);
            const float rstd = rsqrtf(q * (1.f / 64.f) + EPSV);
#pragma unroll
            for (int n = 0; n < 4; ++n)
              pA[(size_t)(rbase + m * 16 + j) * 1024 + (cbase - 2048) + n * 16] = f2bf((acc[m][n][j] - mu) * rstd * gam[n] + bet[n]);
          }
      } else {
#pragma unroll
        for (int m = 0; m < 4; ++m)
#pragma unroll
          for (int n = 0; n < 4; ++n)
#pragma unroll
            for (int j = 0; j < 4; ++j) pA[(size_t)(rbase + m * 16 + j) * 1024 + (cbase - 2048) + n * 16] = f2bf(acc[m][n][j]);
      }
    } else {
#pragma unroll
      for (int m = 0; m < 4; ++m)
#pragma unroll
        for (int n = 0; n < 4; ++n)
#pragma unroll
          for (int j = 0; j < 4; ++j) pG[(size_t)(rbase + m * 16 + j) * 2048 + (cbase - 3072) + n * 16] = f2bf(sigmoidf_(acc[m][n][j]));
    }
  }
}

__device__ __forceinline__ void hgrn_item(const Params& p, unsigned char* smem, int bh) {
  unsigned char* ws = p.ws;
  const bf16_t* pH = (const bf16_t*)(ws + WS_PH);
  const float* lbp = (const float*)(ws + WS_LB);
  bf16_t* ya = (bf16_t*)(ws + WS_XN);
  bf16_t* Qt = (bf16_t*)smem;
  bf16_t* Kt = Qt + 64 * 136;
  bf16_t* KtT = Kt + 64 * 136;
  bf16_t* VT = KtT + 128 * 72;
  bf16_t* Am = VT + 128 * 72;
  bf16_t* ST = Am + 64 * 72;
  float* qtot = (float*)(ST + 128 * 136);
  float* eref = qtot + 512;
  float* elast = eref + 128;
  float* elr = elast + 128;
  float* red = elr + 128;
  const int tid = threadIdx.x, lane = tid & 63, w = tid >> 6, l15 = lane & 15, g = lane >> 4;
  const int b = bh >> 2, h = bh & 3;
  const int d = tid & 127, tq = tid >> 7;
  const float lbv = lbp[h * 128 + d];
  f32x4 S[8];
#pragma unroll
  for (int i = 0; i < 8; ++i) S[i] = (f32x4){0.f, 0.f, 0.f, 0.f};
  const float gnv = p.hg_norm[h * 128 + 16 * w + l15];

  for (int chunk = 0; chunk < 64; ++chunk) {
    const size_t row0 = (size_t)b * SEQL + chunk * 64;
    {
      const bf16_t* base = pH + (row0 + tq * 16) * 2048 + h * 128 + d;
      float lf[16], kk[16], qs[16];
      unsigned vv[8];
      float run = 0.f;
#pragma unroll
      for (int i = 0; i < 16; ++i) {
        const float fr = bf2f(base[(size_t)i * 2048 + 512]);
        const float qr = bf2f(base[(size_t)i * 2048]);
        const float sg = sigmoidf_(fr);
        const float fg = lbv + (1.f - lbv) * sg;
        run += __logf(fg);
        lf[i] = run; kk[i] = 1.f - fg; qs[i] = siluf_(qr);
      }
#pragma unroll
      for (int i = 0; i < 8; ++i) {
        const unsigned lo = base[(size_t)(2 * i) * 2048 + 1024], hi = base[(size_t)(2 * i + 1) * 2048 + 1024];
        vv[i] = lo | (hi << 16);
      }
      qtot[tq * 128 + d] = run;
      __syncthreads();
      const float q0 = qtot[d], q1 = qtot[128 + d], q2 = qtot[256 + d], q3 = qtot[384 + d];
      const float pre = (tq > 0 ? q0 : 0.f) + (tq > 1 ? q1 : 0.f) + (tq > 2 ? q2 : 0.f);
      const float bref = q0 + q1;
      const float blast = bref + q2 + q3;
      unsigned kp[8];
#pragma unroll
      for (int i = 0; i < 16; ++i) {
        const float bt = pre + lf[i];
        const float qt = qs[i] * __expf(bt - bref);
        const float kt = kk[i] * __expf(bref - bt);
        const int t = tq * 16 + i;
        Qt[t * 136 + d] = f2bf(qt);
        const bf16_t kb = f2bf(kt);
        Kt[t * 136 + d] = kb;
        if (i & 1) kp[i >> 1] |= ((unsigned)kb) << 16; else kp[i >> 1] = kb;
      }
      *(uint4*)(KtT + d * 72 + tq * 16) = make_uint4(kp[0], kp[1], kp[2], kp[3]);
      *(uint4*)(KtT + d * 72 + tq * 16 + 8) = make_uint4(kp[4], kp[5], kp[6], kp[7]);
      *(uint4*)(VT + d * 72 + tq * 16) = make_uint4(vv[0], vv[1], vv[2], vv[3]);
      *(uint4*)(VT + d * 72 + tq * 16 + 8) = make_uint4(vv[4], vv[5], vv[6], vv[7]);
      if (tq == 0) { eref[d] = __expf(bref); elast[d] = __expf(blast); elr[d] = __expf(blast - bref); }
    }
    __syncthreads();
    bf16_t ogr[16];
#pragma unroll
    for (int tm = 0; tm < 4; ++tm)
#pragma unroll
      for (int j = 0; j < 4; ++j) ogr[tm * 4 + j] = pH[(row0 + tm * 16 + 4 * g + j) * 2048 + 1536 + h * 128 + 16 * w + l15];
    {
      const int e = 16 * w + l15;
#pragma unroll
      for (int dm = 0; dm < 8; ++dm) {
        const int d0 = 16 * dm + 4 * g;
        uint2 o;
        o.x = pack2(S[dm][0] * eref[d0], S[dm][1] * eref[d0 + 1]);
        o.y = pack2(S[dm][2] * eref[d0 + 2], S[dm][3] * eref[d0 + 3]);
        *(uint2*)(ST + e * 136 + d0) = o;
      }
#pragma unroll
      for (int tt = 0; tt < 2; ++tt) {
        const int tl = 2 * w + tt, sm = tl >> 2, tn = tl & 3;
        f32x4 acc = (f32x4){0.f, 0.f, 0.f, 0.f};
        if (tn >= sm) {
#pragma unroll
          for (int k0 = 0; k0 < 128; k0 += 32) {
            const bf16x8 a = *(const bf16x8*)(Kt + (sm * 16 + l15) * 136 + k0 + 8 * g);
            const bf16x8 bq = *(const bf16x8*)(Qt + (tn * 16 + l15) * 136 + k0 + 8 * g);
            acc = __builtin_amdgcn_mfma_f32_16x16x32_bf16(a, bq, acc, 0, 0, 0);
          }
        }
        const int t = tn * 16 + l15, s0 = sm * 16 + 4 * g;
        uint2 o;
        o.x = pack2(s0 + 0 <= t ? acc[0] : 0.f, s0 + 1 <= t ? acc[1] : 0.f);
        o.y = pack2(s0 + 2 <= t ? acc[2] : 0.f, s0 + 3 <= t ? acc[3] : 0.f);
        *(uint2*)(Am + t * 72 + s0) = o;
      }
    }
    __syncthreads();
    f32x4 o[4];
    {
#pragma unroll
      for (int tm = 0; tm < 4; ++tm) {
        f32x4 acc = (f32x4){0.f, 0.f, 0.f, 0.f};
#pragma unroll
        for (int k0 = 0; k0 < 128; k0 += 32) {
          const bf16x8 a = *(const bf16x8*)(Qt + (tm * 16 + l15) * 136 + k0 + 8 * g);
          const bf16x8 bb = *(const bf16x8*)(ST + (16 * w + l15) * 136 + k0 + 8 * g);
          acc = __builtin_amdgcn_mfma_f32_16x16x32_bf16(a, bb, acc, 0, 0, 0);
        }
#pragma unroll
        for (int k0 = 0; k0 < 64; k0 += 32) {
          const bf16x8 a = *(const bf16x8*)(Am + (tm * 16 + l15) * 72 + k0 + 8 * g);
          const bf16x8 bb = *(const bf16x8*)(VT + (16 * w + l15) * 72 + k0 + 8 * g);
          acc = __builtin_amdgcn_mfma_f32_16x16x32_bf16(a, bb, acc, 0, 0, 0);
        }
        o[tm] = acc;
#pragma unroll
        for (int j = 0; j < 4; ++j) {
          float ss = acc[j] * acc[j];
          ss += __shfl_xor(ss, 1); ss += __shfl_xor(ss, 2); ss += __shfl_xor(ss, 4); ss += __shfl_xor(ss, 8);
          if (l15 == 0) red[w * 64 + tm * 16 + 4 * g + j] = ss;
        }
      }
#pragma unroll
      for (int dm = 0; dm < 8; ++dm) {
        f32x4 acc = (f32x4){0.f, 0.f, 0.f, 0.f};
#pragma unroll
        for (int k0 = 0; k0 < 64; k0 += 32) {
          const bf16x8 a = *(const bf16x8*)(KtT + (dm * 16 + l15) * 72 + k0 + 8 * g);
          const bf16x8 bb = *(const bf16x8*)(VT + (16 * w + l15) * 72 + k0 + 8 * g);
          acc = __builtin_amdgcn_mfma_f32_16x16x32_bf16(a, bb, acc, 0, 0, 0);
        }
#pragma unroll
        for (int j = 0; j < 4; ++j) { const int dd = 16 * dm + 4 * g + j; S[dm][j] = elast[dd] * S[dm][j] + elr[dd] * acc[j]; }
      }
    }
    __syncthreads();
    {
      const int e = 16 * w + l15;
#pragma unroll
      for (int tm = 0; tm < 4; ++tm)
#pragma unroll
        for (int j = 0; j < 4; ++j) {
          const int t = tm * 16 + 4 * g + j;
          float tot = 0.f;
#pragma unroll
          for (int ww = 0; ww < 8; ++ww) tot += red[ww * 64 + t];
          const float rstd = rsqrtf(tot * (1.f / 128.f) + EPSV);
          const float og = bf2f(ogr[tm * 4 + j]);
          ya[(row0 + t) * 512 + h * 128 + e] = f2bf(o[tm][j] * rstd * gnv * siluf_(og));
        }
    }
  }
}


__device__ __forceinline__ void hgrn_h1_all(const Params& p, unsigned char* smem) {
  unsigned char* ws = p.ws;
  bf16_t* pH = (bf16_t*)(ws + WS_PH);
  const float* lbp = (const float*)(ws + WS_LB);
  bf16_t* Qt = (bf16_t*)smem;
  bf16_t* Kt = Qt + 64 * 136;
  bf16_t* KtT = Kt + 64 * 136;
  bf16_t* VT = KtT + 128 * 72;
  bf16_t* Am = VT + 128 * 72;
  float* qtot = (float*)(Am + 64 * 72);
  const int tid = threadIdx.x, lane = tid & 63, w = tid >> 6, l15 = lane & 15, g = lane >> 4;
  const int d = tid & 127, tq = tid >> 7;
  const int G = gridDim.x;
  if ((int)blockIdx.x >= 2048) return;
  bf16_t fr_[16], qr_[16]; unsigned short vr_[16];
#define H1_LOAD(IT) do { \
    const int bh_ = (IT) >> 6, ch_ = (IT) & 63; \
    const bf16_t* base_ = pH + ((size_t)(bh_ >> 2) * SEQL + ch_ * 64 + tq * 16) * 2048 + (bh_ & 3) * 128 + d; \
    _Pragma("unroll") for (int i = 0; i < 16; ++i) { fr_[i] = base_[(size_t)i * 2048 + 512]; qr_[i] = base_[(size_t)i * 2048]; vr_[i] = base_[(size_t)i * 2048 + 1024]; } \
  } while (0)
  H1_LOAD((int)blockIdx.x);
  for (int item = blockIdx.x; item < 2048; item += G) {
    const int bh = item >> 6, chunk = item & 63;
    const int b = bh >> 2, h = bh & 3;
    const float lbv = lbp[h * 128 + d];
    const size_t row0 = (size_t)b * SEQL + chunk * 64;
    float* dec = (float*)(ws + WS_DEC) + (size_t)item * 384;
    uint4* UU = (uint4*)p.out + (size_t)item * 2048 + tid;
    float4* OI = (float4*)((unsigned char*)p.out + ((size_t)64 << 20)) + (size_t)item * 2048 + tid;
    {
      unsigned vv[8];
#pragma unroll
      for (int i = 0; i < 8; ++i) vv[i] = (unsigned)vr_[2 * i] | ((unsigned)vr_[2 * i + 1] << 16);
      float lf[16], kk[16], qs[16];
      float run = 0.f;
#pragma unroll
      for (int i = 0; i < 16; ++i) {
        const float sg = sigmoidf_(bf2f(fr_[i]));
        const float fg = lbv + (1.f - lbv) * sg;
        run += __logf(fg);
        lf[i] = run; kk[i] = 1.f - fg; qs[i] = siluf_(bf2f(qr_[i]));
      }
      qtot[tq * 128 + d] = run;
      __syncthreads();
      { const int nit = (item + G < 2048) ? item + G : item; H1_LOAD(nit); }
      const float q0 = qtot[d], q1 = qtot[128 + d], q2 = qtot[256 + d], q3 = qtot[384 + d];
      const float pre = (tq > 0 ? q0 : 0.f) + (tq > 1 ? q1 : 0.f) + (tq > 2 ? q2 : 0.f);
      const float bref = q0 + q1;
      const float blast = bref + q2 + q3;
      unsigned kp[8];
#pragma unroll
      for (int i = 0; i < 16; ++i) {
        const float bt = pre + lf[i];
        const float qt = qs[i] * __expf(bt - bref);
        const float kt = kk[i] * __expf(bref - bt);
        const int t = tq * 16 + i;
        Qt[t * 136 + d] = f2bf(qt);
        const bf16_t kb = f2bf(kt);
        Kt[t * 136 + d] = kb;
        if (i & 1) kp[i >> 1] |= ((unsigned)kb) << 16; else kp[i >> 1] = kb;
      }
      *(uint4*)(KtT + d * 72 + tq * 16) = make_uint4(kp[0], kp[1], kp[2], kp[3]);
      *(uint4*)(KtT + d * 72 + tq * 16 + 8) = make_uint4(kp[4], kp[5], kp[6], kp[7]);
      *(uint4*)(VT + d * 72 + tq * 16) = make_uint4(vv[0], vv[1], vv[2], vv[3]);
      *(uint4*)(VT + d * 72 + tq * 16 + 8) = make_uint4(vv[4], vv[5], vv[6], vv[7]);
      if (tq == 0) { dec[d] = __expf(bref); dec[128 + d] = __expf(blast); dec[256 + d] = __expf(blast - bref); }
    }
    __syncthreads();
    {
  #pragma unroll
      for (int i = 0; i < 2; ++i) {
        const int idx = tid + 512 * i, r = idx >> 4, c = idx & 15;
        *(uint4*)(pH + (row0 + r) * 2048 + h * 128 + c * 8) = *(const uint4*)(Qt + r * 136 + c * 8);
      }
  #pragma unroll
      for (int tt = 0; tt < 2; ++tt) {
        const int tl = 2 * w + tt, sm = tl >> 2, tn = tl & 3;
        f32x4 acc = (f32x4){0.f, 0.f, 0.f, 0.f};
        if (tn >= sm) {
  #pragma unroll
          for (int k0 = 0; k0 < 128; k0 += 32) {
            const bf16x8 a = *(const bf16x8*)(Kt + (sm * 16 + l15) * 136 + k0 + 8 * g);
            const bf16x8 bq = *(const bf16x8*)(Qt + (tn * 16 + l15) * 136 + k0 + 8 * g);
            acc = __builtin_amdgcn_mfma_f32_16x16x32_bf16(a, bq, acc, 0, 0, 0);
          }
        }
        const int t = tn * 16 + l15, s0 = sm * 16 + 4 * g;
        uint2 o;
        o.x = pack2(s0 + 0 <= t ? acc[0] : 0.f, s0 + 1 <= t ? acc[1] : 0.f);
        o.y = pack2(s0 + 2 <= t ? acc[2] : 0.f, s0 + 3 <= t ? acc[3] : 0.f);
        *(uint2*)(Am + t * 72 + s0) = o;
      }
    }
    __syncthreads();
    {
  #pragma unroll
      for (int tm = 0; tm < 4; ++tm) {
        f32x4 acc = (f32x4){0.f, 0.f, 0.f, 0.f};
  #pragma unroll
        for (int k0 = 0; k0 < 64; k0 += 32) {
          const bf16x8 a = *(const bf16x8*)(Am + (tm * 16 + l15) * 72 + k0 + 8 * g);
          const bf16x8 bb = *(const bf16x8*)(VT + (16 * w + l15) * 72 + k0 + 8 * g);
          acc = __builtin_amdgcn_mfma_f32_16x16x32_bf16(a, bb, acc, 0, 0, 0);
        }
        OI[tm * 512] = make_float4(acc[0], acc[1], acc[2], acc[3]);
      }
  #pragma unroll
      for (int dp = 0; dp < 4; ++dp) {
        unsigned pk[4];
  #pragma unroll
        for (int hh = 0; hh < 2; ++hh) {
          const int dm = dp * 2 + hh;
          f32x4 acc = (f32x4){0.f, 0.f, 0.f, 0.f};
  #pragma unroll
          for (int k0 = 0; k0 < 64; k0 += 32) {
            const bf16x8 a = *(const bf16x8*)(KtT + (dm * 16 + l15) * 72 + k0 + 8 * g);
            const bf16x8 bb = *(const bf16x8*)(VT + (16 * w + l15) * 72 + k0 + 8 * g);
            acc = __builtin_amdgcn_mfma_f32_16x16x32_bf16(a, bb, acc, 0, 0, 0);
          }
          pk[hh * 2] = pack2(acc[0], acc[1]); pk[hh * 2 + 1] = pack2(acc[2], acc[3]);
        }
        UU[dp * 512] = make_uint4(pk[0], pk[1], pk[2], pk[3]);
      }
    }
    __syncthreads();
  }
#undef H1_LOAD
}

__device__ __forceinline__ void hgrn_h2(const Params& p, unsigned char* smem, int bh) {
  unsigned char* ws = p.ws;
  const bf16_t* pH = (const bf16_t*)(ws + WS_PH);
  bf16_t* ya = (bf16_t*)(ws + WS_XN);
  bf16_t* Qt = (bf16_t*)smem;
  bf16_t* ST = Qt + 64 * 136;
  float* decl = (float*)(ST + 128 * 136);
  float* red = decl + 384;
  const int tid = threadIdx.x, lane = tid & 63, w = tid >> 6, l15 = lane & 15, g = lane >> 4;
  const int b = bh >> 2, h = bh & 3;
  f32x4 S[8];
#pragma unroll
  for (int i = 0; i < 8; ++i) S[i] = (f32x4){0.f, 0.f, 0.f, 0.f};
  const float gnv = p.hg_norm[h * 128 + 16 * w + l15];
  const int e = 16 * w + l15;
  uint4 uu0, uu1, uu2, uu3; float4 oi0, oi1, oi2, oi3; uint4 qraw0, qraw1; bf16_t ogr[16]; float dcv = 0.f;
#define H2_LOAD(CH) do { \
    const int item_ = bh * 64 + (CH); \
    const size_t row0_ = (size_t)b * SEQL + (size_t)(CH) * 64; \
    const uint4* UUp = (const uint4*)p.out + (size_t)item_ * 2048 + tid; \
    const float4* OIp = (const float4*)((const unsigned char*)p.out + ((size_t)64 << 20)) + (size_t)item_ * 2048 + tid; \
    uu0 = UUp[0]; uu1 = UUp[512]; uu2 = UUp[1024]; uu3 = UUp[1536]; oi0 = OIp[0]; oi1 = OIp[512]; oi2 = OIp[1024]; oi3 = OIp[1536]; \
    qraw0 = *(const uint4*)(pH + (row0_ + (tid >> 4)) * 2048 + h * 128 + (tid & 15) * 8); \
    qraw1 = *(const uint4*)(pH + (row0_ + 32 + (tid >> 4)) * 2048 + h * 128 + (tid & 15) * 8); \
    _Pragma("unroll") for (int tm = 0; tm < 4; ++tm) _Pragma("unroll") for (int j = 0; j < 4; ++j) \
      ogr[tm * 4 + j] = pH[(row0_ + tm * 16 + 4 * g + j) * 2048 + 1536 + h * 128 + e]; \
    if (tid < 384) dcv = ((const float*)(ws + WS_DEC))[(size_t)item_ * 384 + tid]; \
  } while (0)
  H2_LOAD(0);
  for (int chunk = 0; chunk < 64; ++chunk) {
    const size_t row0 = (size_t)b * SEQL + chunk * 64;
    const uint4 cu[4] = {uu0, uu1, uu2, uu3}; const float4 co[4] = {oi0, oi1, oi2, oi3}; bf16_t cog[16];
#pragma unroll
    for (int i = 0; i < 16; ++i) cog[i] = ogr[i];
    *(uint4*)(Qt + (tid >> 4) * 136 + (tid & 15) * 8) = qraw0;
    *(uint4*)(Qt + (32 + (tid >> 4)) * 136 + (tid & 15) * 8) = qraw1;
    if (tid < 384) decl[tid] = dcv;
    __syncthreads();
    if (chunk + 1 < 64) H2_LOAD(chunk + 1);
#pragma unroll
    for (int dm = 0; dm < 8; ++dm) {
      const int d0 = 16 * dm + 4 * g;
      uint2 o;
      o.x = pack2(S[dm][0] * decl[d0], S[dm][1] * decl[d0 + 1]);
      o.y = pack2(S[dm][2] * decl[d0 + 2], S[dm][3] * decl[d0 + 3]);
      *(uint2*)(ST + e * 136 + d0) = o;
    }
    __syncthreads();
    f32x4 o[4];
#pragma unroll
    for (int tm = 0; tm < 4; ++tm) {
      f32x4 acc = (f32x4){co[tm].x, co[tm].y, co[tm].z, co[tm].w};
#pragma unroll
      for (int k0 = 0; k0 < 128; k0 += 32) {
        const bf16x8 a = *(const bf16x8*)(Qt + (tm * 16 + l15) * 136 + k0 + 8 * g);
        const bf16x8 bb = *(const bf16x8*)(ST + (16 * w + l15) * 136 + k0 + 8 * g);
        acc = __builtin_amdgcn_mfma_f32_16x16x32_bf16(a, bb, acc, 0, 0, 0);
      }
      o[tm] = acc;
#pragma unroll
      for (int j = 0; j < 4; ++j) {
        float ss = acc[j] * acc[j];
        ss += __int_as_float(__builtin_amdgcn_update_dpp(0, __float_as_int(ss), 0xB1, 0xf, 0xf, true));
        ss += __int_as_float(__builtin_amdgcn_update_dpp(0, __float_as_int(ss), 0x4E, 0xf, 0xf, true));
        ss += __int_as_float(__builtin_amdgcn_update_dpp(0, __float_as_int(ss), 0x141, 0xf, 0xf, true));
        ss += __int_as_float(__builtin_amdgcn_update_dpp(0, __float_as_int(ss), 0x140, 0xf, 0xf, true));
        if (l15 == 0) red[w * 64 + tm * 16 + 4 * g + j] = ss;
      }
    }
#pragma unroll
    for (int dm = 0; dm < 8; ++dm) {
      const unsigned u01 = (dm & 1) ? cu[dm >> 1].z : cu[dm >> 1].x, u23 = (dm & 1) ? cu[dm >> 1].w : cu[dm >> 1].y;
      const float uv[4] = {__uint_as_float(u01 << 16), __uint_as_float(u01 & 0xffff0000u), __uint_as_float(u23 << 16), __uint_as_float(u23 & 0xffff0000u)};
#pragma unroll
      for (int j = 0; j < 4; ++j) { const int dd = 16 * dm + 4 * g + j; S[dm][j] = decl[128 + dd] * S[dm][j] + decl[256 + dd] * uv[j]; }
    }
    __syncthreads();
    if (tid < 64) {
      float tot = 0.f;
#pragma unroll
      for (int ww = 0; ww < 8; ++ww) tot += red[ww * 64 + tid];
      red[512 + tid] = rsqrtf(tot * (1.f / 128.f) + EPSV);
    }
    __syncthreads();
#pragma unroll
    for (int tm = 0; tm < 4; ++tm)
#pragma unroll
      for (int j = 0; j < 4; ++j) {
        const int t = tm * 16 + 4 * g + j;
        const float rstd = red[512 + t];
        ya[(row0 + t) * 512 + h * 128 + e] = f2bf(o[tm][j] * rstd * gnv * siluf_(bf2f(cog[tm * 4 + j])));
      }
  }
#undef H2_LOAD
}

__device__ __forceinline__ int team_index(const Params& p, unsigned char* smem) {
  int* sh = (int*)(smem + 8192);
  const int G = gridDim.x, tid = threadIdx.x;
  const int* tab = (const int*)(p.ws + WS_XCC);
  if (tid < 32) sh[tid] = 0;
  __syncthreads();
  const int mine = tab[blockIdx.x] & 15;
  for (int b = tid; b < G; b += NTHREADS) {
    const int x = tab[b] & 15;
    atomicAdd(&sh[x], 1);
    if (x == mine && b < (int)blockIdx.x) atomicAdd(&sh[16], 1);
  }
  __syncthreads();
  if (tid == 0) {
    int pre = 0;
    for (int j = 0; j < mine; ++j) pre += sh[j];
    sh[17] = pre + sh[16];
  }
  __syncthreads();
  const int r = sh[17];
  __syncthreads();
  return r;
}

#define SCW 4100
#ifndef DSA_REP
#define DSA_REP 0
#endif
#define DSA_BKT_OFF (8 * SCW * 4 + 8 * 256 * 4 + 8 * 256 * 2 + 8 * 512 * 2)
__device__ __forceinline__ void cvt8(const uint4& v, float* f) {
  f[0] = __uint_as_float(v.x << 16); f[1] = __uint_as_float(v.x & 0xffff0000u);
  f[2] = __uint_as_float(v.y << 16); f[3] = __uint_as_float(v.y & 0xffff0000u);
  f[4] = __uint_as_float(v.z << 16); f[5] = __uint_as_float(v.z & 0xffff0000u);
  f[6] = __uint_as_float(v.w << 16); f[7] = __uint_as_float(v.w & 0xffff0000u);
}
__device__ __forceinline__ unsigned sortable_key(float v) {
  unsigned bits = __float_as_uint(v);
  if (bits == 0x80000000u) bits = 0u;
  return (bits & 0x80000000u) ? ~bits : (bits | 0x80000000u);
}

__device__ __forceinline__ void dsa_item(const Params& p, unsigned char* smem, int item) {
  unsigned char* ws = p.ws;
  const bf16_t* pA = (const bf16_t*)(ws + WS_PA);
  const bf16_t* kc = (const bf16_t*)(ws + WS_KC);
  const bf16_t* vc = (const bf16_t*)(ws + WS_VC);
  const bf16_t* ikc = (const bf16_t*)(ws + WS_IKC);
  bf16_t* yb = (bf16_t*)(ws + WS_XN) + (size_t)TOK * 512;
  unsigned* sc = (unsigned*)smem;
  unsigned* hist = sc + 8 * SCW;
  unsigned short* sel = (unsigned short*)(hist + 8 * 256);
  unsigned short* cand = sel + 8 * 256;
  unsigned char* bkt = (unsigned char*)(cand + 8 * 512);
  unsigned* rmm = (unsigned*)(bkt + 128 + 1024);
  const int tid = threadIdx.x, lane = tid & 63, w = tid >> 6, l15 = lane & 15, g = lane >> 4;
  const int b = item >> 9;
  const int tb = item & 511;
  const int t0 = tb * 8;
  const size_t tokbase = (size_t)b * SEQL;

  for (int rep_s = 0; rep_s < (DSA_REP == 1 ? 2 : 1); ++rep_s) {
    bf16x8 af[2][2];
    float wq[2][4];
#pragma unroll
    for (int mt = 0; mt < 2; ++mt) {
      const int qrow = t0 + mt * 4 + (l15 >> 2), head = l15 & 3;
#pragma unroll
      for (int ks = 0; ks < 2; ++ks)
        af[mt][ks] = *(const bf16x8*)(pA + (tokbase + qrow) * 1024 + 640 + head * 64 + ks * 32 + 8 * g);
      const uint2 wr = *(const uint2*)(pA + (tokbase + t0 + mt * 4 + g) * 1024 + 960);
      wq[mt][0] = 0.5f * bf2f((bf16_t)(wr.x & 0xffff)); wq[mt][1] = 0.5f * bf2f((bf16_t)(wr.x >> 16));
      wq[mt][2] = 0.5f * bf2f((bf16_t)(wr.y & 0xffff)); wq[mt][3] = 0.5f * bf2f((bf16_t)(wr.y >> 16));
    }
    const int nkt = (t0 + 8 + 15) >> 4;
    unsigned kmin[2] = {0xFFFFFFFFu, 0xFFFFFFFFu}, kmax[2] = {0u, 0u};
    for (int kt0 = w; kt0 < nkt; kt0 += 64) {
      bf16x8 b0[8], b1[8];
#pragma unroll
      for (int u = 0; u < 8; ++u) {
        const int kt = kt0 + 8 * u;
        const int s = (kt < nkt ? kt : 0) * 16 + l15;
        const bf16_t* kr = ikc + (tokbase + s) * 64 + 8 * g;
        b0[u] = *(const bf16x8*)kr;
        b1[u] = *(const bf16x8*)(kr + 32);
      }
      __builtin_amdgcn_sched_barrier(0);
      f32x4 sacc[8][2];
#pragma unroll
      for (int u = 0; u < 8; ++u)
#pragma unroll
        for (int mt = 0; mt < 2; ++mt) {
          f32x4 acc = (f32x4){0.f, 0.f, 0.f, 0.f};
          acc = __builtin_amdgcn_mfma_f32_16x16x32_bf16(af[mt][0], b0[u], acc, 0, 0, 0);
          sacc[u][mt] = __builtin_amdgcn_mfma_f32_16x16x32_bf16(af[mt][1], b1[u], acc, 0, 0, 0);
        }
#pragma unroll
      for (int u = 0; u < 8; ++u) {
        const int kt = kt0 + 8 * u;
        if (kt < nkt) {
          const int s = kt * 16 + l15;
#pragma unroll
          for (int mt = 0; mt < 2; ++mt) {
            float v = 0.f;
#pragma unroll
            for (int j = 0; j < 4; ++j) v += wq[mt][j] * fmaxf(sacc[u][mt][j] * 0.125f, 0.f);
            const int t = t0 + mt * 4 + g;
            unsigned vb = __float_as_uint(v); if (vb == 0x80000000u) vb = 0u;
            sc[(mt * 4 + g) * SCW + s] = vb;
            if (s <= t) {
              const unsigned key = (vb & 0x80000000u) ? ~vb : (vb | 0x80000000u);
              kmin[mt] = key < kmin[mt] ? key : kmin[mt];
              kmax[mt] = key > kmax[mt] ? key : kmax[mt];
            }
          }
        }
      }
    }
#pragma unroll
    for (int mt = 0; mt < 2; ++mt) {
      unsigned a = kmin[mt], bmx = kmax[mt];
#define DPP_MINMAX(CTRL) do { const unsigned a2 = (unsigned)__builtin_amdgcn_update_dpp((int)a, (int)a, CTRL, 0xf, 0xf, false); \
                               const unsigned b2 = (unsigned)__builtin_amdgcn_update_dpp((int)bmx, (int)bmx, CTRL, 0xf, 0xf, false); \
                               a = a2 < a ? a2 : a; bmx = b2 > bmx ? b2 : bmx; } while (0)
      DPP_MINMAX(0xB1); DPP_MINMAX(0x4E); DPP_MINMAX(0x141); DPP_MINMAX(0x140);
#undef DPP_MINMAX
      if (l15 == 0) { atomicMin(&rmm[mt * 4 + g], a); atomicMax(&rmm[8 + mt * 4 + g], bmx); }
    }
  }
  __syncthreads();
  const int t = t0 + w;
  const int n = t + 1;
  unsigned* row = sc + w * SCW;
  const float* rowf = (const float*)row;
  unsigned short* mysel = sel + w * 256;
  unsigned short* mycand = cand + w * 512;
  unsigned* myh = hist + w * 256;
  int cnt;
  const unsigned long long lt_mask = (1ull << lane) - 1ull;
  for (int rep_t = 0; rep_t < (DSA_REP == 2 ? 2 : 1); ++rep_t)
  if (n <= 256) {
    for (int i = lane; i < n; i += 64) mysel[i] = (unsigned short)i;
    cnt = n;
  } else {
    cnt = 256;
    float mn, mx;
    {
      const unsigned kmn = rmm[w], kmx = rmm[8 + w];
      mn = __uint_as_float((kmn & 0x80000000u) ? (kmn ^ 0x80000000u) : ~kmn);
      mx = __uint_as_float((kmx & 0x80000000u) ? (kmx ^ 0x80000000u) : ~kmx);
    }
    const float scale = (mx > mn) ? 255.99f / (mx - mn) : 0.f;
#pragma unroll
    for (int i = 0; i < 4; ++i) myh[lane + 64 * i] = 0u;
    lds_fence();
    for (int i0 = lane; i0 < n; i0 += 256) {
      float v4[4];
#pragma unroll
      for (int k = 0; k < 4; ++k) v4[k] = (i0 + 64 * k < n) ? rowf[i0 + 64 * k] : 0.f;
#pragma unroll
      for (int k = 0; k < 4; ++k) {
        if (i0 + 64 * k < n) {
          int bn = (int)((v4[k] - mn) * scale); bn = bn > 255 ? 255 : bn;
          atomicAdd(&myh[bn], 1u);
        }
      }
    }
    lds_fence();
    unsigned cum; int bstar; unsigned mcount;
    {
      const uint4 c4 = *(const uint4*)(myh + 4 * lane);
      const unsigned c = c4.x + c4.y + c4.z + c4.w;
      unsigned sfx = c;
#pragma unroll
      for (int o = 1; o < 64; o <<= 1) { const unsigned tt = __shfl_down(sfx, o); if (lane + o < 64) sfx += tt; }
      const unsigned long long bal = __ballot(sfx >= 256u);
      const int L = 63 - __clzll(bal);
      const unsigned sL = __shfl(sfx, L), cL = __shfl(c, L);
      const unsigned b3 = __shfl(c4.w, L), b2 = __shfl(c4.z, L), b1 = __shfl(c4.y, L), b0 = __shfl(c4.x, L);
      cum = sL - cL;
      int digit;
      if (cum + b3 >= 256u) { digit = 3; mcount = b3; }
      else { cum += b3; if (cum + b2 >= 256u) { digit = 2; mcount = b2; } else { cum += b2; if (cum + b1 >= 256u) { digit = 1; mcount = b1; } else { cum += b1; digit = 0; mcount = b0; } } }
      bstar = 4 * L + digit;
    }
    const unsigned need = 256u - cum;
    if (mcount <= 512u) {
      unsigned base = 0u, cb = 0u;
      for (int i0 = 0; i0 < n; i0 += 256) {
        float v4[4];
#pragma unroll
        for (int k = 0; k < 4; ++k) { const int i = i0 + 64 * k + lane; v4[k] = (i < n) ? rowf[i] : 0.f; }
#pragma unroll
        for (int k = 0; k < 4; ++k) {
          const int i = i0 + 64 * k + lane;
          const bool valid = i < n;
          int bn = (int)((v4[k] - mn) * scale); bn = bn > 255 ? 255 : bn;
          const bool gt = valid && (bn > bstar);
          const bool eq = valid && (bn == bstar);
          const unsigned long long bg = __ballot(gt), be = __ballot(eq);
          if (gt) mysel[base + (unsigned)__popcll(bg & lt_mask)] = (unsigned short)i;
          if (eq) mycand[cb + (unsigned)__popcll(be & lt_mask)] = (unsigned short)i;
          base += (unsigned)__popcll(bg); cb += (unsigned)__popcll(be);
        }
      }
      lds_fence();
      const int m = (int)mcount;
      unsigned ck[8]; unsigned short ci[8];
#pragma unroll
      for (int q = 0; q < 8; ++q) {
        const int c = q * 64 + lane;
        ck[q] = 0u; ci[q] = 0;
        if (c < m) { ci[q] = mycand[c]; ck[q] = sortable_key(rowf[ci[q]]); }
      }
      unsigned T = 0u;
      if (m <= 64) {
#pragma unroll 1
        for (int bit = 31; bit >= 0; --bit) {
          const unsigned trial = T | (1u << bit);
          if ((unsigned)__popcll(__ballot(ck[0] >= trial)) >= need) T = trial;
        }
      } else {
#pragma unroll 1
        for (int bit = 31; bit >= 0; --bit) {
          const unsigned trial = T | (1u << bit);
          unsigned cge = 0u;
#pragma unroll
          for (int q = 0; q < 8; ++q) cge += (unsigned)__popcll(__ballot(ck[q] >= trial));
          if (cge >= need) T = trial;
        }
      }
      unsigned cgt = 0u;
#pragma unroll
      for (int q = 0; q < 8; ++q) cgt += (unsigned)__popcll(__ballot(ck[q] > T));
      const unsigned need_eq = need - cgt;
      unsigned pos0 = cum, eqtaken = 0u;
#pragma unroll
      for (int q = 0; q < 8; ++q) {
        const bool gt = ck[q] > T;
        const bool eq = ck[q] == T;
        const unsigned long long beq = __ballot(eq);
        const bool take = gt || (eq && (eqtaken + (unsigned)__popcll(beq & lt_mask)) < need_eq);
        const unsigned long long bt = __ballot(take);
        const unsigned pp = pos0 + (unsigned)__popcll(bt & lt_mask);
        if (take && pp < 256u) mysel[pp] = ci[q];
        pos0 += (unsigned)__popcll(bt);
        eqtaken += (unsigned)__popcll(beq);
      }
    } else {
      unsigned prefix = 0u, krem = 256u;
#pragma unroll 1
      for (int pass = 0; pass < 4; ++pass) {
        const int shift = 24 - 8 * pass;
        const unsigned himask = (pass == 0) ? 0u : (0xFFFFFFFFu << (shift + 8));
#pragma unroll
        for (int i = 0; i < 4; ++i) myh[lane + 64 * i] = 0u;
        lds_fence();
        for (int i = lane; i < n; i += 64) {
          const unsigned u = sortable_key(rowf[i]);
          if ((u & himask) == prefix) atomicAdd(&myh[(u >> shift) & 255u], 1u);
        }
        lds_fence();
        const uint4 c4 = *(const uint4*)(myh + 4 * lane);
        const unsigned c = c4.x + c4.y + c4.z + c4.w;
        unsigned sfx = c;
#pragma unroll
        for (int o = 1; o < 64; o <<= 1) { const unsigned tt = __shfl_down(sfx, o); if (lane + o < 64) sfx += tt; }
        const unsigned long long bal = __ballot(sfx >= krem);
        const int L = 63 - __clzll(bal);
        const unsigned sL = __shfl(sfx, L), cL = __shfl(c, L);
        const unsigned b3 = __shfl(c4.w, L), b2 = __shfl(c4.z, L), b1 = __shfl(c4.y, L);
        unsigned cum2 = sL - cL;
        unsigned digit;
        if (cum2 + b3 >= krem) digit = 3;
        else { cum2 += b3; if (cum2 + b2 >= krem) digit = 2; else { cum2 += b2; if (cum2 + b1 >= krem) digit = 1; else { cum2 += b1; digit = 0; } } }
        krem -= cum2;
        prefix |= ((unsigned)(4 * L) + digit) << shift;
      }
      const unsigned T = prefix;
      unsigned base = 0u, eqtaken = 0u;
      for (int i0 = 0; i0 < n; i0 += 64) {
        const int i = i0 + lane;
        const bool valid = i < n;
        const unsigned u = valid ? sortable_key(rowf[i]) : 0u;
        const bool gt = valid && (u > T);
        const bool eq = valid && (u == T);
        const unsigned long long beq = __ballot(eq);
        const unsigned eqrank = eqtaken + (unsigned)__popcll(beq & lt_mask);
        const bool take = gt || (eq && eqrank < krem);
        const unsigned long long bt = __ballot(take);
        const unsigned pos = base + (unsigned)__popcll(bt & lt_mask);
        if (take && pos < 256u) mysel[pos] = (unsigned short)i;
        base += (unsigned)__popcll(bt);
        eqtaken += (unsigned)__popcll(beq);
      }
    }
  }
  lds_fence();
  if (lane == 0) { rmm[w] = 0xFFFFFFFFu; rmm[8 + w] = 0u; }
  {
    int lane_a = lane;
    asm volatile("" : "+v"(lane_a));
    const int l15 = lane_a & 15, g = lane_a >> 4;
    const int ks = lane_a >> 3, dc = lane_a & 7;
    float* pl = (float*)row;
    const float* relb = (const float*)(bkt + 128);
    const int niter = (cnt + 7) >> 3;
    bf16x8 bq0 = (bf16x8){0, 0, 0, 0, 0, 0, 0, 0}, bq1 = bq0;
    if (l15 < 8) {
      bq0 = *(const bf16x8*)(pA + (tokbase + t) * 1024 + l15 * 64 + 8 * g);
      bq1 = *(const bf16x8*)(pA + (tokbase + t) * 1024 + l15 * 64 + 32 + 8 * g);
    }
    float lg[16][4];
    {
      bf16x8 ka[8][2], kb[8][2];
#pragma unroll
      for (int u = 0; u < 8; ++u) {
        const int kk = u * 16 + l15;
        const int s = (kk < cnt) ? (int)mysel[kk] : 0;
        const bf16_t* kr = kc + (tokbase + s) * 64 + 8 * g;
        ka[u][0] = *(const bf16x8*)kr;
        ka[u][1] = *(const bf16x8*)(kr + 32);
      }
#pragma unroll
      for (int u = 0; u < 8; ++u) {
        const int kk = (8 + u) * 16 + l15;
        const int s = (kk < cnt) ? (int)mysel[kk] : 0;
        const bf16_t* kr = kc + (tokbase + s) * 64 + 8 * g;
        kb[u][0] = *(const bf16x8*)kr;
        kb[u][1] = *(const bf16x8*)(kr + 32);
      }
      __builtin_amdgcn_sched_barrier(0);
#pragma unroll
      for (int u = 0; u < 8; ++u) {
        f32x4 acc = (f32x4){0.f, 0.f, 0.f, 0.f};
        acc = __builtin_amdgcn_mfma_f32_16x16x32_bf16(ka[u][0], bq0, acc, 0, 0, 0);
        acc = __builtin_amdgcn_mfma_f32_16x16x32_bf16(ka[u][1], bq1, acc, 0, 0, 0);
        lg[u][0] = acc[0]; lg[u][1] = acc[1]; lg[u][2] = acc[2]; lg[u][3] = acc[3];
      }
#pragma unroll
      for (int u = 0; u < 8; ++u) {
        f32x4 acc = (f32x4){0.f, 0.f, 0.f, 0.f};
        acc = __builtin_amdgcn_mfma_f32_16x16x32_bf16(kb[u][0], bq0, acc, 0, 0, 0);
        acc = __builtin_amdgcn_mfma_f32_16x16x32_bf16(kb[u][1], bq1, acc, 0, 0, 0);
        lg[8 + u][0] = acc[0]; lg[8 + u][1] = acc[1]; lg[8 + u][2] = acc[2]; lg[8 + u][3] = acc[3];
      }
    }
    typedef unsigned u32x4_t __attribute__((ext_vector_type(4)));
    u32x4_t va[16];
#pragma unroll
    for (int u = 0; u < 16; ++u) {
      const int kk = u * 8 + ks;
      const int s = (kk < cnt) ? (int)mysel[kk] : 0;
      va[u] = *(const u32x4_t*)(vc + (tokbase + s) * 64 + dc * 8);
    }
    __builtin_amdgcn_sched_barrier(0);
    const int hsel = l15 & 7;
    float m = -INFINITY;
#pragma unroll
    for (int u = 0; u < 16; ++u) {
      const uint2 s4 = *(const uint2*)(mysel + u * 16 + 4 * g);
      const int sj[4] = {(int)(s4.x & 0xffffu), (int)(s4.x >> 16), (int)(s4.y & 0xffffu), (int)(s4.y >> 16)};
#pragma unroll
      for (int j = 0; j < 4; ++j) {
        const int key = u * 16 + 4 * g + j;
        const bool valid = key < cnt;
        const int dist = valid ? t - sj[j] : 0;
        const int bk = dist < 128 ? (int)bkt[dist] : 31;
        lg[u][j] = valid ? (lg[u][j] * 0.125f + relb[bk * 8 + hsel]) : -INFINITY;
        m = fmaxf(m, lg[u][j]);
      }
    }
    m = max_xor16(m); m = max_xor32(m);
    float sum = 0.f;
#pragma unroll
    for (int u = 0; u < 16; ++u)
#pragma unroll
      for (int j = 0; j < 4; ++j) { lg[u][j] = __expf(lg[u][j] - m); sum += lg[u][j]; }
    sum = add_xor16(sum); sum = add_xor32(sum);
    const float inv = 1.f / sum;
    bf16x8 pa[8];
#pragma unroll
    for (int s8 = 0; s8 < 8; ++s8) {
      const unsigned w0 = pack2(lg[2 * s8][0] * inv, lg[2 * s8][1] * inv), w1 = pack2(lg[2 * s8][2] * inv, lg[2 * s8][3] * inv);
      const unsigned w2 = pack2(lg[2 * s8 + 1][0] * inv, lg[2 * s8 + 1][1] * inv), w3 = pack2(lg[2 * s8 + 1][2] * inv, lg[2 * s8 + 1][3] * inv);
      const u32x4_t wv = {w0, w1, w2, w3};
      pa[s8] = __builtin_bit_cast(bf16x8, wv);
    }
    unsigned char* vs_l = (unsigned char*)row;
#pragma unroll
    for (int u = 0; u < 16; ++u) *(u32x4_t*)(vs_l + (u * 8 + ks) * 128 + dc * 16) = va[u];
    lds_fence();
    u32x4_t vb[16];
#pragma unroll
    for (int u = 0; u < 16; ++u) {
      const int kk = (16 + u) * 8 + ks;
      const int s = (kk < cnt) ? (int)mysel[kk] : 0;
      vb[u] = *(const u32x4_t*)(vc + (tokbase + s) * 64 + dc * 8);
    }
    __builtin_amdgcn_sched_barrier(0);
    f32x4 ov[4];
#pragma unroll
    for (int nt = 0; nt < 4; ++nt) ov[nt] = (f32x4){0.f, 0.f, 0.f, 0.f};
    typedef short v4s_t __attribute__((ext_vector_type(4)));
    const unsigned tr_lane = (unsigned)((l15 >> 2) * 128 + (l15 & 3) * 8);
#define PV_HALF(S0) do { \
      _Pragma("unroll") for (int s4_ = 0; s4_ < 4; ++s4_) { \
        _Pragma("unroll") for (int nt = 0; nt < 4; ++nt) { \
          const unsigned a0 = (unsigned)((s4_ * 32 + 4 * g) * 128 + nt * 32) + tr_lane; \
          const v4s_t b0 = __builtin_amdgcn_ds_read_tr16_b64_v4i16((__attribute__((address_space(3))) v4s_t*)(vs_l + a0)); \
          const v4s_t b1 = __builtin_amdgcn_ds_read_tr16_b64_v4i16((__attribute__((address_space(3))) v4s_t*)(vs_l + a0 + 16 * 128)); \
          const bf16x8 bb = (bf16x8){b0[0], b0[1], b0[2], b0[3], b1[0], b1[1], b1[2], b1[3]}; \
          ov[nt] = __builtin_amdgcn_mfma_f32_16x16x32_bf16(pa[(S0) + s4_], bb, ov[nt], 0, 0, 0); \
        } \
      } \
    } while (0)
    PV_HALF(0);
    lds_fence();
#pragma unroll
    for (int u = 0; u < 16; ++u) *(u32x4_t*)(vs_l + (u * 8 + ks) * 128 + dc * 16) = vb[u];
    lds_fence();
    PV_HALF(4);
#undef PV_HALF
    if (g < 2) {
#pragma unroll
      for (int nt = 0; nt < 4; ++nt)
#pragma unroll
        for (int j = 0; j < 4; ++j) yb[(tokbase + t) * 512 + (4 * g + j) * 64 + nt * 16 + l15] = f2bf(ov[nt][j]);
    }
    lds_fence();
  }
  __syncthreads();
}

__device__ __forceinline__ void phase_mix(const Params& p, unsigned char* smem, int mode = 0) {
  const int G = gridDim.x;
  if (mode != 2) { for (int bh = blockIdx.x; bh < 32; bh += G) { hgrn_h2(p, smem, bh); __syncthreads(); } }
  if (mode == 1) return;
  unsigned char* bkt = smem + DSA_BKT_OFF;
  volatile int* qslot = (volatile int*)(smem + LDS_BYTES - 32);
  unsigned* qctr = (unsigned*)(p.ws + WS_QCTR);
  if (threadIdx.x < 128) {
    const int nn = threadIdx.x;
    int v = nn;
    if (nn >= 16) { v = 16 + (int)(logf((float)nn * (1.f / 16.f)) / logf(8.f) * 16.f); if (v > 31) v = 31; }
    bkt[nn] = (unsigned char)v;
  }
  if (threadIdx.x >= 256) ((float*)(bkt + 128))[threadIdx.x - 256] = p.rel_bias[threadIdx.x - 256];
  if (threadIdx.x < 16) ((unsigned*)(bkt + 128 + 1024))[threadIdx.x] = threadIdx.x < 8 ? 0xFFFFFFFFu : 0u;
  const int my_team = (G % 8 == 0) ? team_index(p, smem) / (G >> 3) : (int)(blockIdx.x & 7);
  constexpr int QN = 544;
#define Q_FETCH(SLOT) do { if (threadIdx.x == 0) { int tm_ = q_team, kk_ = -1; \
      for (int tries_ = 0; tries_ < 8; ++tries_) { \
        const unsigned v_ = __hip_atomic_fetch_add(qctr + 16 * tm_, 1u, __ATOMIC_RELAXED, __HIP_MEMORY_SCOPE_AGENT); \
        if (v_ < (unsigned)QN) { kk_ = (tm_ << 16) | (int)v_; break; } \
        tm_ = (tm_ + 1) & 7; } \
      q_team = tm_; qslot[SLOT] = kk_; } } while (0)
  int q_team = my_team;
  Q_FETCH(0);
  __syncthreads();
  int k = qslot[0];
  int par = 1;
  while (k >= 0) {
    Q_FETCH(par);
    const int bt = k >> 16, kl = k & 0xffff;
    const int kq = kl / 17, kr = kl - kq * 17;
    if (kr < 16) {
      const int tb = 511 - (kq * 16 + kr);
      dsa_item(p, smem, (bt << 9) | tb);
    } else {
      const int r0 = (bt * 32 + kq) * 64;
      quantize_rows_u8<false, true>(p.peer_u, p.ws + WS_U, (float*)(p.ws + WS_U + (size_t)16384 * 1024), r0, r0 + 64);
      quantize_rows_u8<true, false>(p.peer_v, p.ws + WS_V, (float*)(p.ws + WS_V + (size_t)16384 * 1024), r0, r0 + 64);
      __syncthreads();
    }
    k = qslot[par];
    par ^= 1;
  }
#undef Q_FETCH
}

__device__ __forceinline__ void phase_up(const Params& p, unsigned char* smem) {
  unsigned char* ws = p.ws;
  const bf16_t* ya = (const bf16_t*)(ws + WS_XN);
  const bf16_t* yb = ya + (size_t)TOK * 512;
  const bf16_t* wa = (const bf16_t*)(ws + WS_WUPA);
  const bf16_t* wb = (const bf16_t*)(ws + WS_WUPB);
  const bf16_t* pG = (const bf16_t*)(ws + WS_PG);
  bf16_t* hb = (bf16_t*)(ws + WS_PH);
  const int tid = threadIdx.x, lane = tid & 63, w = tid >> 6, wm = w >> 1, wn = w & 1, l15 = lane & 15, g = lane >> 4;
  for (int tile = blockIdx.x; tile < 128 * 8; tile += gridDim.x) {
    const int tn = tile & 7, tm = tile >> 3;
    f32x4 acc[4][4]; zero_acc(acc);
    gemm_tile(ya + (size_t)tm * 256 * 512, 512, wa + (size_t)tn * 128 * 512, 512, 8, acc, smem);
    asm volatile("" ::: "memory");
    const int rbase = tm * 256 + wm * 64 + 4 * g;
    const int cbase = tn * 128 + wn * 64 + l15;
#pragma unroll
    for (int m = 0; m < 4; ++m) {
      bf16_t gt[16];
#pragma unroll
      for (int n = 0; n < 4; ++n)
#pragma unroll
        for (int j = 0; j < 4; ++j) gt[n * 4 + j] = pG[(size_t)(rbase + m * 16 + j) * 2048 + cbase + n * 16];
#pragma unroll
      for (int n = 0; n < 4; ++n) {
#pragma unroll
        for (int j = 0; j < 4; ++j) {
          const size_t rr = (size_t)(rbase + m * 16 + j);
          hb[rr * 1024 + cbase + n * 16] = f2bf(acc[m][n][j] * bf2f(gt[n * 4 + j]));
        }
        acc[m][n] = (f32x4){0.f, 0.f, 0.f, 0.f};
      }
    }
    asm volatile("" ::: "memory");
    gemm_tile(yb + (size_t)tm * 256 * 512, 512, wb + (size_t)tn * 128 * 512, 512, 8, acc, smem);
    asm volatile("" ::: "memory");
#pragma unroll
    for (int m = 0; m < 4; ++m) {
      bf16_t gt[16], ht[16];
#pragma unroll
      for (int n = 0; n < 4; ++n)
#pragma unroll
        for (int j = 0; j < 4; ++j) {
          const size_t rr = (size_t)(rbase + m * 16 + j);
          gt[n * 4 + j] = pG[rr * 2048 + 1024 + cbase + n * 16];
          ht[n * 4 + j] = hb[rr * 1024 + cbase + n * 16];
        }
#pragma unroll
      for (int n = 0; n < 4; ++n)
#pragma unroll
        for (int j = 0; j < 4; ++j) {
          const size_t rr = (size_t)(rbase + m * 16 + j);
          hb[rr * 1024 + cbase + n * 16] = f2bf(bf2f(ht[n * 4 + j]) + acc[m][n][j] * bf2f(gt[n * 4 + j]));
        }
    }
  }
}

__device__ __forceinline__ void phase_out(const Params& p, unsigned char* smem) {
  unsigned char* ws = p.ws;
  const bf16_t* hb = (const bf16_t*)(ws + WS_PH);
  const bf16_t* wo = (const bf16_t*)(ws + WS_WOUT);
  const int tid = threadIdx.x, lane = tid & 63, w = tid >> 6, wm = w >> 1, wn = w & 1, l15 = lane & 15, g = lane >> 4;
  for (int tile = blockIdx.x; tile < 128 * 8; tile += gridDim.x) {
    const int tn = tile & 7, tm = tile >> 3;
    f32x4 acc[4][4]; zero_acc(acc);
    gemm_tile(hb + (size_t)tm * 256 * 1024, 1024, wo + (size_t)tn * 128 * 1024, 1024, 16, acc, smem);
    const int rbase = tm * 256 + wm * 64 + 4 * g;
    const int cbase = tn * 128 + wn * 64 + l15;
#pragma unroll
    for (int m = 0; m < 4; ++m) {
      float xt[16];
#pragma unroll
      for (int n = 0; n < 4; ++n)
#pragma unroll
        for (int j = 0; j < 4; ++j) xt[n * 4 + j] = p.x[(size_t)(rbase + m * 16 + j) * 1024 + cbase + n * 16];
#pragma unroll
      for (int n = 0; n < 4; ++n)
#pragma unroll
        for (int j = 0; j < 4; ++j) p.out[(size_t)(rbase + m * 16 + j) * 1024 + cbase + n * 16] = xt[n * 4 + j] + acc[m][n][j];
    }
  }
}

__device__ __forceinline__ void phase_pq(const Params& p, unsigned char* smem) {
  unsigned char* ws = p.ws;
  const bf16_t* xn2 = (const bf16_t*)(ws + WS_XN);
  const bf16_t* wq = (const bf16_t*)(ws + WS_WQ);
  bf16_t* qp = (bf16_t*)(ws + WS_PG);
  const int tid = threadIdx.x, lane = tid & 63, w = tid >> 6, wm = w >> 1, wn = w & 1, l15 = lane & 15, g = lane >> 4;
  for (int tile = blockIdx.x; tile < 128 * 16; tile += gridDim.x) {
    const int tn = tile & 15, tm = tile >> 4;
    f32x4 acc[4][4]; zero_acc(acc);
    gemm_tile(xn2 + (size_t)tm * 256 * 1024, 1024, wq + (size_t)tn * 128 * 1024, 1024, 16, acc, smem);
    const int rbase = tm * 256 + wm * 64 + 4 * g;
    const int cbase = tn * 128 + wn * 64 + l15;
#pragma unroll
    for (int m = 0; m < 4; ++m)
#pragma unroll
      for (int n = 0; n < 4; ++n)
#pragma unroll
        for (int j = 0; j < 4; ++j) qp[(size_t)(rbase + m * 16 + j) * 2048 + cbase + n * 16] = f2bf(acc[m][n][j]);
  }
}

__device__ __forceinline__ void phase_pkeys(const Params& p, unsigned char* smem) {
  unsigned char* ws = p.ws;
  const bf16_t* qp = (const bf16_t*)(ws + WS_PG);
  const bf16_t* keys = (const bf16_t*)(ws + WS_KEYS);
  int* eidx = (int*)(ws + WS_EIDX);
  float* gw = (float*)(ws + WS_GW);
  float* sc = (float*)smem;
  float* s2l = (float*)smem;
  unsigned short* i1l = (unsigned short*)(s2l + 256 * 17);
  unsigned short* i2l = i1l + 256 * 16;
  const int tid = threadIdx.x, lane = tid & 63, w = tid >> 6, wm = w >> 1, wn = w & 1, l15 = lane & 15, g = lane >> 4;
  for (int item = blockIdx.x; item < 128 * 8; item += gridDim.x) {
    const int h = item & 7, tm = item >> 3;
    float s1[16], s2v[16]; int i1[16], i2[16];
#pragma unroll
    for (int ph = 0; ph < 2; ++ph) {
      const int hp = h * 2 + ph;
      f32x4 acc[4][4]; zero_acc(acc);
      gemm_tile(qp + (size_t)tm * 256 * 2048 + hp * 128, 2048, keys + (size_t)(ph * 8 + h) * 128 * 128, 128, 2, acc, smem);
      __syncthreads();
#pragma unroll
      for (int m = 0; m < 4; ++m)
#pragma unroll
        for (int n = 0; n < 4; ++n)
#pragma unroll
          for (int j = 0; j < 4; ++j) sc[(wm * 64 + m * 16 + 4 * g + j) * 129 + wn * 64 + n * 16 + l15] = acc[m][n][j];
      __syncthreads();
      if (tid < 256) {
        const float* rowp = sc + tid * 129;
        unsigned tv[16];
#pragma unroll
        for (int k = 0; k < 16; ++k) tv[k] = 0u;
#pragma unroll 8
        for (int nn = 0; nn < 128; ++nn) {
          const unsigned bits = __float_as_uint(rowp[nn]);
          unsigned key = (bits & 0x80000000u) ? ~bits : (bits | 0x80000000u);
          key = (key & ~127u) | (unsigned)(127 - nn);
#pragma unroll
          for (int k = 15; k >= 1; --k) {
            unsigned r;
            asm("v_med3_u32 %0, %1, %2, %3" : "=v"(r) : "v"(tv[k]), "v"(tv[k - 1]), "v"(key));
            tv[k] = r;
          }
          tv[0] = tv[0] > key ? tv[0] : key;
        }
#pragma unroll
        for (int k = 0; k < 16; ++k) {
          const int col = 127 - (int)(tv[k] & 127u);
          const float val = rowp[col];
          if (ph == 0) { i1[k] = col; s1[k] = val; } else { i2[k] = col; s2v[k] = val; }
        }
      }
      __syncthreads();
    }
    if (tid < 256) {
#pragma unroll
      for (int a = 0; a < 16; ++a) { s2l[tid * 17 + a] = s2v[a]; i1l[tid * 16 + a] = (unsigned short)i1[a]; i2l[tid * 16 + a] = (unsigned short)i2[a]; }
      float cur[16];
#pragma unroll
      for (int a = 0; a < 16; ++a) cur[a] = s1[a] + s2v[0];
      unsigned long long ptr = 0ull;
      float tops[16]; int tope[16];
#pragma unroll
      for (int k = 0; k < 16; ++k) {
        float best = cur[0]; int ba = 0;
#pragma unroll
        for (int a = 1; a < 16; ++a) if (cur[a] > best) { best = cur[a]; ba = a; }
        const int bb = (int)((ptr >> (4 * ba)) & 15ull);
        tops[k] = best;
        tope[k] = (int)i1l[tid * 16 + ba] * 128 + (int)i2l[tid * 16 + bb];
        const int nb = bb + 1;
        const float ns2 = (nb < 16) ? s2l[tid * 17 + nb] : -INFINITY;
        if (nb < 16) ptr += (1ull << (4 * ba));
#pragma unroll
        for (int a = 0; a < 16; ++a) if (a == ba) cur[a] = s1[a] + ns2;
      }
      const float m = tops[0];
      float sum = 0.f;
#pragma unroll
      for (int k = 0; k < 16; ++k) { tops[k] = __expf(tops[k] - m); sum += tops[k]; }
      const float inv = 1.f / sum;
      const size_t ob = ((size_t)(tm * 256 + tid) * 8 + h) * 16;
#pragma unroll
      for (int k = 0; k < 16; k += 4) {
        *(int4*)(eidx + ob + k) = make_int4(tope[k], tope[k + 1], tope[k + 2], tope[k + 3]);
        *(float4*)(gw + ob + k) = make_float4(tops[k] * inv, tops[k + 1] * inv, tops[k + 2] * inv, tops[k + 3] * inv);
      }
    }
    __syncthreads();
  }
}

__device__ __forceinline__ void phase_pcomb(const Params& p, unsigned char* smem) {
  unsigned char* ws = p.ws;
  const float* ps = (const float*)(ws + WS_PA);
  const int* pi = (const int*)(ws + WS_PA) + (size_t)TOK * 256;
  int* eidx = (int*)(ws + WS_EIDX);
  float* gw = (float*)(ws + WS_GW);
  float* s2l = (float*)smem;
  unsigned short* i1l = (unsigned short*)(s2l + 512 * 17);
  unsigned short* i2l = i1l + 512 * 16;
  const int tid = threadIdx.x;
  for (int base = blockIdx.x * NTHREADS; base < TOK * 8; base += gridDim.x * NTHREADS) {
    const int th = base + tid;
    const size_t o1 = (size_t)th * 32;
    float s1[16];
#pragma unroll
    for (int a = 0; a < 16; ++a) {
      s1[a] = ps[o1 + a];
      s2l[tid * 17 + a] = ps[o1 + 16 + a];
      i1l[tid * 16 + a] = (unsigned short)pi[o1 + a];
      i2l[tid * 16 + a] = (unsigned short)pi[o1 + 16 + a];
    }
    float cur[16];
    const float s20 = s2l[tid * 17];
#pragma unroll
    for (int a = 0; a < 16; ++a) cur[a] = s1[a] + s20;
    unsigned long long ptr = 0ull;
    float tops[16]; int tope[16];
#pragma unroll
    for (int k = 0; k < 16; ++k) {
      float best = cur[0]; int ba = 0;
#pragma unroll
      for (int a = 1; a < 16; ++a) if (cur[a] > best) { best = cur[a]; ba = a; }
      const int bb = (int)((ptr >> (4 * ba)) & 15ull);
      tops[k] = best;
      tope[k] = (int)i1l[tid * 16 + ba] * 128 + (int)i2l[tid * 16 + bb];
      const int nb = bb + 1;
      const float ns2 = (nb < 16) ? s2l[tid * 17 + nb] : -INFINITY;
      if (nb < 16) ptr += (1ull << (4 * ba));
#pragma unroll
      for (int a = 0; a < 16; ++a) if (a == ba) cur[a] = s1[a] + ns2;
    }
    float m = tops[0];
    float sum = 0.f;
#pragma unroll
    for (int k = 0; k < 16; ++k) { tops[k] = __expf(tops[k] - m); sum += tops[k]; }
    const float inv = 1.f / sum;
#pragma unroll
    for (int k = 0; k < 16; ++k) { eidx[(size_t)th * 16 + k] = tope[k]; gw[(size_t)th * 16 + k] = tops[k] * inv; }
  }
}


__device__ __forceinline__ float reduce8(const float (&pv)[8], int lane) {
  const bool b5 = lane & 32, b4 = lane & 16, b3 = lane & 8;
  float v[4];
#pragma unroll
  for (int i = 0; i < 4; ++i) {
    const float keep = b5 ? pv[4 + i] : pv[i];
    const float send = b5 ? pv[i] : pv[4 + i];
    v[i] = keep + __shfl_xor(send, 32);
  }
  float u[2];
#pragma unroll
  for (int i = 0; i < 2; ++i) {
    const float keep = b4 ? v[2 + i] : v[i];
    const float send = b4 ? v[i] : v[2 + i];
    u[i] = keep + __shfl_xor(send, 16);
  }
  float x = (b3 ? u[1] : u[0]) + __shfl_xor(b3 ? u[0] : u[1], 8);
  x += __shfl_xor(x, 4); x += __shfl_xor(x, 2); x += __shfl_xor(x, 1);
  return x;
}

__device__ __forceinline__ void cvt16u8(const uint4& v, float* f) {
  f[0] = (float)(v.x & 0xffu); f[1] = (float)((v.x >> 8) & 0xffu); f[2] = (float)((v.x >> 16) & 0xffu); f[3] = (float)(v.x >> 24);
  f[4] = (float)(v.y & 0xffu); f[5] = (float)((v.y >> 8) & 0xffu); f[6] = (float)((v.y >> 16) & 0xffu); f[7] = (float)(v.y >> 24);
  f[8] = (float)(v.z & 0xffu); f[9] = (float)((v.z >> 8) & 0xffu); f[10] = (float)((v.z >> 16) & 0xffu); f[11] = (float)(v.z >> 24);
  f[12] = (float)(v.w & 0xffu); f[13] = (float)((v.w >> 8) & 0xffu); f[14] = (float)((v.w >> 16) & 0xffu); f[15] = (float)(v.w >> 24);
}

__device__ __forceinline__ int wave_sum_i32_dpp(int v) {
  v += __builtin_amdgcn_update_dpp(0, v, 0xB1, 0xf, 0xf, true);
  v += __builtin_amdgcn_update_dpp(0, v, 0x4E, 0xf, 0xf, true);
  v += __builtin_amdgcn_update_dpp(0, v, 0x141, 0xf, 0xf, true);
  v += __builtin_amdgcn_update_dpp(0, v, 0x140, 0xf, 0xf, true);
  return __builtin_amdgcn_readlane(v, 0) + __builtin_amdgcn_readlane(v, 16) + __builtin_amdgcn_readlane(v, 32) + __builtin_amdgcn_readlane(v, 48);
}

__device__ __forceinline__ int reduce8_i32_scatter(const int (&d)[8], int lane) {
  const bool b0 = lane & 1, b1 = lane & 2, b2 = lane & 4;
  int v[4];
#pragma unroll
  for (int i = 0; i < 4; ++i) {
    const int keep = b0 ? d[2 * i + 1] : d[2 * i];
    const int send = b0 ? d[2 * i] : d[2 * i + 1];
    v[i] = keep + __builtin_amdgcn_update_dpp(0, send, 0xB1, 0xf, 0xf, true);
  }
  int u[2];
#pragma unroll
  for (int i = 0; i < 2; ++i) {
    const int keep = b1 ? v[2 * i + 1] : v[2 * i];
    const int send = b1 ? v[2 * i] : v[2 * i + 1];
    u[i] = keep + __builtin_amdgcn_update_dpp(0, send, 0x4E, 0xf, 0xf, true);
  }
  int x;
  {
    const int keep = b2 ? u[1] : u[0];
    const int send = b2 ? u[0] : u[1];
    int t = __builtin_amdgcn_update_dpp(0, send, 0x141, 0xf, 0xf, true);
    t = __builtin_amdgcn_update_dpp(0, t, 0x1B, 0xf, 0xf, true);
    x = keep + t;
  }
  x += __builtin_amdgcn_update_dpp(0, x, 0x128, 0xf, 0xf, true);
  { const auto r = __builtin_amdgcn_permlane16_swap((unsigned)x, (unsigned)x, false, false); x = (int)r[0] + (int)r[1]; }
  { const auto r = __builtin_amdgcn_permlane32_swap((unsigned)x, (unsigned)x, false, false); x = (int)r[0] + (int)r[1]; }
  return x;
}

__device__ __forceinline__ void phase_pu(const Params& p, unsigned char* smem) {
  unsigned char* ws = p.ws;
  const unsigned char* XQ = ws + WS_XQ;
  const float* xs = (const float*)(ws + WS_XS);
  const unsigned char* U8 = ws + WS_U;
  const float* us = (const float*)(ws + WS_U + (size_t)16384 * 1024);
  const float* vs = (const float*)(ws + WS_V + (size_t)16384 * 1024);
  const int* eidx = (const int*)(ws + WS_EIDX);
  const float* gw = (const float*)(ws + WS_GW);
  float* aw = (float*)(ws + WS_PA);
  const int lane = threadIdx.x & 63, w = threadIdx.x >> 6;
  const unsigned long long lt_mask = (1ull << lane) - 1ull;
  const int G = gridDim.x;
  const bool sliced = (G % 8 == 0);
  const int ti = sliced ? team_index(p, smem) : 0;
  const int tsz = sliced ? (G >> 3) : G;
  const int grp_lo = sliced ? ti / tsz : 0, grp_hi = sliced ? grp_lo + 1 : 8;
  const int slot = (sliced ? (ti % tsz) : (int)blockIdx.x) * 8 + w;
  const int nslot = tsz * 8;
  unsigned* lst = (unsigned*)smem + 4096 + w * 128;
  typedef unsigned u32x4_t __attribute__((ext_vector_type(4)));
  if (slot >= TOK) return;
  for (int grp = grp_lo; grp < grp_hi; ++grp) {
#define PU_LIST(E0, E1, N, L0, L1) do { \
      const bool m0_ = ((E0) >> 11) == grp, m1_ = ((E1) >> 11) == grp; \
      const unsigned long long b0_ = __ballot(m0_), b1_ = __ballot(m1_); \
      const int c0_ = __popcll(b0_); N = c0_ + __popcll(b1_); \
      if (m0_) lst[__popcll(b0_ & lt_mask)] = ((unsigned)lane << 14) | (unsigned)(E0); \
      if (m1_) lst[c0_ + __popcll(b1_ & lt_mask)] = ((unsigned)(lane + 64) << 14) | (unsigned)(E1); \
      lds_fence(); \
      L0 = (lane < N) ? lst[lane] : 0u; L1 = (lane + 64 < N) ? lst[lane + 64] : 0u; \
      lds_fence(); } while (0)
#define PU_ISSUE(BUF, L0, N, I0) do { int last_ = ((N) < 64 ? (N) : 64) - 1; last_ = last_ < 0 ? 0 : last_; \
      _Pragma("unroll") for (int j = 0; j < 8; ++j) { int idx_ = (I0) + j; idx_ = idx_ < last_ ? idx_ : last_; \
        const unsigned le_ = (unsigned)__builtin_amdgcn_readlane((int)(L0), idx_); \
        BUF[j] = *(const u32x4_t*)(U8 + (size_t)(le_ & 16383u) * 1024 + lane * 16); } } while (0)
#define PU_REDUCE(BUF, X, I0, HREG) do { int dd_[8]; _Pragma("unroll") for (int j = 0; j < 8; ++j) { \
        int d_ = __builtin_amdgcn_sdot4((int)BUF[j].x, (int)(X).x, 0, false); \
        d_ = __builtin_amdgcn_sdot4((int)BUF[j].y, (int)(X).y, d_, false); \
        d_ = __builtin_amdgcn_sdot4((int)BUF[j].z, (int)(X).z, d_, false); \
        dd_[j] = __builtin_amdgcn_sdot4((int)BUF[j].w, (int)(X).w, d_, false); } \
      const int tot_ = reduce8_i32_scatter(dd_, lane);     \
      if (lane >= (I0) && lane < (I0) + 8) HREG = tot_; } while (0)
    u32x4_t cx = *(const u32x4_t*)(XQ + (size_t)slot * 1024 + lane * 16);
    int ce0 = eidx[(size_t)slot * 128 + lane], ce1 = eidx[(size_t)slot * 128 + 64 + lane];
    float cxs = xs[slot];
    int cn; unsigned cl0, cl1;
    PU_LIST(ce0, ce1, cn, cl0, cl1);
    u32x4_t ra[8], rb[8], rc[8];
    PU_ISSUE(ra, cl0, cn, 0);
    PU_ISSUE(rb, cl0, cn, 8);
    int t1 = (slot + nslot < TOK) ? slot + nslot : slot;
    u32x4_t nx = *(const u32x4_t*)(XQ + (size_t)t1 * 1024 + lane * 16);
    int ne0 = eidx[(size_t)t1 * 128 + lane], ne1 = eidx[(size_t)t1 * 128 + 64 + lane];
    float nxs = xs[t1];
    for (int tok = slot; tok < TOK; tok += nslot) {
      float sc0 = 0.f, sc1 = 0.f, gv0 = 0.f, gv1 = 0.f, vv0 = 0.f, vv1 = 0.f;
      if (lane < cn) { const int e = cl0 & 16383; sc0 = us[e]; vv0 = vs[e]; gv0 = gw[(size_t)tok * 128 + (cl0 >> 14)]; }
      if (lane + 64 < cn) { const int e = cl1 & 16383; sc1 = us[e]; vv1 = vs[e]; gv1 = gw[(size_t)tok * 128 + (cl1 >> 14)]; }
      int nn; unsigned nl0, nl1;
      PU_LIST(ne0, ne1, nn, nl0, nl1);
      const u32x4_t x1 = nx; const int xe0 = ne0, xe1 = ne1; const float xs1 = nxs;
      const int t2a = tok + nslot, t2 = (t2a + nslot < TOK) ? t2a + nslot : ((t2a < TOK) ? t2a : tok);
      nx = *(const u32x4_t*)(XQ + (size_t)t2 * 1024 + lane * 16);
      ne0 = eidx[(size_t)t2 * 128 + lane]; ne1 = eidx[(size_t)t2 * 128 + 64 + lane];
      nxs = xs[t2];
      int h0i = 0, h1i = 0;
      const bool third = cn > 16;
      if (third) { PU_ISSUE(rc, cl0, cn, 16); }
      __builtin_amdgcn_sched_barrier(0); PU_REDUCE(ra, cx, 0, h0i);  __builtin_amdgcn_sched_barrier(0);
      PU_ISSUE(ra, nl0, nn, 0);  __builtin_amdgcn_sched_barrier(0); PU_REDUCE(rb, cx, 8, h0i);  __builtin_amdgcn_sched_barrier(0);
      PU_ISSUE(rb, nl0, nn, 8);  __builtin_amdgcn_sched_barrier(0);
      if (third) { PU_REDUCE(rc, cx, 16, h0i); }
      __builtin_amdgcn_sched_barrier(0);
      if (cn > 24) {
        for (int i0 = 24; i0 < cn; i0 += 8) {
          u32x4_t rd[8];
          const bool lo = i0 < 64;
          const unsigned lsrc = lo ? cl0 : cl1;
          const int nsrc = lo ? cn : cn - 64;
          PU_ISSUE(rd, lsrc, nsrc, i0 & 63);
          if (lo) { PU_REDUCE(rd, cx, i0, h0i); } else { PU_REDUCE(rd, cx, i0 - 64, h1i); }
        }
      }
      const float h0 = (float)h0i * sc0 * cxs, h1 = (float)h1i * sc1 * cxs;
      if (lane < cn) aw[(size_t)tok * 128 + (cl0 >> 14)] = 0.5f * h0 * (1.f + erff(h0 * 0.70710678118654752f)) * gv0 * vv0;
      if (lane + 64 < cn) aw[(size_t)tok * 128 + (cl1 >> 14)] = 0.5f * h1 * (1.f + erff(h1 * 0.70710678118654752f)) * gv1 * vv1;
      cx = x1; ce0 = xe0; ce1 = xe1; cxs = xs1; cn = nn; cl0 = nl0; cl1 = nl1;
    }
#undef PU_LIST
#undef PU_ISSUE
#undef PU_REDUCE
  }
}

template <bool SL>
__device__ __forceinline__ void phase_pv_t(const Params& p, unsigned char* smem) {
  unsigned char* ws = p.ws;
  const unsigned char* V8 = ws + WS_V;
  const int* eidx = (const int*)(ws + WS_EIDX);
  const float* aw = (const float*)(ws + WS_PA);
  float* ssq = (float*)(ws + WS_SSQ);
  const int lane = threadIdx.x & 63, w = threadIdx.x >> 6;
  const int q = lane >> 3, c = lane & 7;
  const int G = gridDim.x;
  constexpr bool sliced = SL;
  const int ti = sliced ? team_index(p, smem) : 0;
  const int tsz = G >> 3;
  const int grp0 = sliced ? (ti / tsz) : 0;
  constexpr int ngrp = sliced ? 1 : 8;
  const int slot = sliced ? (ti % tsz) * 8 + w : blockIdx.x * 8 + w;
  const int nslot = sliced ? tsz * 8 : G * 8;
  int ee[16]; float aa[16];
  if (slot < TOK) {
    unsigned bi = (unsigned)slot * 128u + 16u * (unsigned)q;
    asm volatile("" : "+v"(bi));
#pragma unroll
    for (int u4 = 0; u4 < 4; ++u4) {
      const int4 e4 = *(const int4*)(eidx + bi + 4 * u4); const float4 a4 = *(const float4*)(aw + bi + 4 * u4);
      ee[4 * u4] = e4.x; ee[4 * u4 + 1] = e4.y; ee[4 * u4 + 2] = e4.z; ee[4 * u4 + 3] = e4.w;
      aa[4 * u4] = a4.x; aa[4 * u4 + 1] = a4.y; aa[4 * u4 + 2] = a4.z; aa[4 * u4 + 3] = a4.w;
    }
  }
  for (int tok = slot; tok < TOK; tok += nslot) {
    int ce[16]; float ca[16];
    float suma = 0.f;
#pragma unroll
    for (int u = 0; u < 16; ++u) { ce[u] = ee[u]; ca[u] = aa[u]; suma += aa[u]; }
    for (int gi = 0; gi < ngrp; ++gi) {
      const int grp = grp0 + gi;
      uint4 vv[16];
#pragma unroll
      for (int u = 0; u < 16; ++u) vv[u] = *(const uint4*)(V8 + (size_t)grp * (16384 * 128) + (size_t)ce[u] * 128 + c * 16);
      float* orow = p.out + (size_t)tok * 1024 + grp * 128 + c * 16;
      float4 x1v[4];
#pragma unroll
      for (int i = 0; i < 4; ++i) x1v[i] = *(const float4*)(orow + 4 * i);
      if (gi == ngrp - 1) {
        const int nt = (tok + nslot < TOK) ? tok + nslot : tok;
        unsigned bi = (unsigned)nt * 128u + 16u * (unsigned)q;
        asm volatile("" : "+v"(bi));
#pragma unroll
        for (int u4 = 0; u4 < 4; ++u4) {
          const int4 e4 = *(const int4*)(eidx + bi + 4 * u4); const float4 a4 = *(const float4*)(aw + bi + 4 * u4);
          ee[4 * u4] = e4.x; ee[4 * u4 + 1] = e4.y; ee[4 * u4 + 2] = e4.z; ee[4 * u4 + 3] = e4.w;
          aa[4 * u4] = a4.x; aa[4 * u4 + 1] = a4.y; aa[4 * u4 + 2] = a4.z; aa[4 * u4 + 3] = a4.w;
        }
      }
      __builtin_amdgcn_sched_barrier(0);
      float acc[16];
#pragma unroll
      for (int i = 0; i < 16; ++i) acc[i] = -128.f * suma;
#pragma unroll
      for (int u = 0; u < 16; ++u) {
        float vf[16];
        cvt16u8(vv[u], vf);
#pragma unroll
        for (int i = 0; i < 16; ++i) acc[i] += ca[u] * vf[i];
        __builtin_amdgcn_sched_barrier(0);
      }
#pragma unroll
      for (int i = 0; i < 16; ++i) { acc[i] = add_xor8(acc[i]); acc[i] = add_xor16(acc[i]); acc[i] = add_xor32(acc[i]); }
      float ss = 0.f;
      if (q == 0) {
#pragma unroll
        for (int i = 0; i < 4; ++i) {
          const float4 oa = make_float4(x1v[i].x + acc[4 * i], x1v[i].y + acc[4 * i + 1], x1v[i].z + acc[4 * i + 2], x1v[i].w + acc[4 * i + 3]);
          *(float4*)(orow + 4 * i) = oa;
          ss += oa.x * oa.x + oa.y * oa.y + oa.z * oa.z + oa.w * oa.w;
        }
      }
      ss += __shfl_xor(ss, 1); ss += __shfl_xor(ss, 2); ss += __shfl_xor(ss, 4);
      if (lane == 0) atomicAdd(&ssq[tok], ss);
    }
  }
}

__device__ __forceinline__ void phase_final(const Params& p) {
  const float* ssq = (const float*)(p.ws + WS_SSQ);
  const int lane = threadIdx.x & 63, w = threadIdx.x >> 6;
  for (int row = blockIdx.x * 8 + w; row < TOK; row += gridDim.x * 8) {
    const float rstd = rsqrtf(ssq[row] * (1.f / DM) + EPSV);
    float4* o4 = (float4*)(p.out + (size_t)row * DM);
#pragma unroll
    for (int i = 0; i < 4; ++i) {
      float4 v = o4[lane + 64 * i];
      const float4 gg = ((const float4*)p.norm_final)[lane + 64 * i];
      v.x *= rstd * gg.x; v.y *= rstd * gg.y; v.z *= rstd * gg.z; v.w *= rstd * gg.w;
      o4[lane + 64 * i] = v;
    }
  }
}


__device__ __forceinline__ void phase_proj8(const Params& p, unsigned char* smem) {
  unsigned char* ws = p.ws;
  pg8::Gemm g{(const pg8::bf16_t*)(ws + WS_XN), (const pg8::bf16_t*)(ws + WS_WIN), TOK, 5120, 1024};
  pg8::StaticOrder S; S.init(TOK, 5120, (int)gridDim.x, (int)blockIdx.x);
  EpiProj E{(unsigned short*)(ws + WS_PH), (unsigned short*)(ws + WS_PA), (unsigned short*)(ws + WS_PG),
            (unsigned short*)(ws + WS_KC), (unsigned short*)(ws + WS_VC), (unsigned short*)(ws + WS_IKC)};
  pg8::gemm_phase<EpiProj, pg8::StaticOrder>((PG8_LAS unsigned char*)smem, g, S, E, nullptr);
}
__device__ __forceinline__ void phase_ikln(const Params& p) {
  bf16_t* ikc = (bf16_t*)(p.ws + WS_IKC);
  const int tid = threadIdx.x, sub = tid & 7;
  float gam[8], bet[8];
#pragma unroll
  for (int i = 0; i < 8; ++i) { gam[i] = p.ikg[sub * 8 + i]; bet[i] = p.ikb[sub * 8 + i]; }
  for (int row = blockIdx.x * 64 + (tid >> 3); row < TOK; row += gridDim.x * 64) {
    uint4* ptr = (uint4*)(ikc + (size_t)row * 64 + sub * 8);
    const uint4 raw = *ptr;
    float v[8];
    cvt8(raw, v);
    float s = 0.f;
#pragma unroll
    for (int i = 0; i < 8; ++i) s += v[i];
    s += __shfl_xor(s, 1); s += __shfl_xor(s, 2); s += __shfl_xor(s, 4);
    const float mu = s * (1.f / 64.f);
    float q = 0.f;
#pragma unroll
    for (int i = 0; i < 8; ++i) { const float d = v[i] - mu; q += d * d; }
    q += __shfl_xor(q, 1); q += __shfl_xor(q, 2); q += __shfl_xor(q, 4);
    const float rstd = rsqrtf(q * (1.f / 64.f) + EPSV);
    uint4 o;
    o.x = pack2((v[0] - mu) * rstd * gam[0] + bet[0], (v[1] - mu) * rstd * gam[1] + bet[1]);
    o.y = pack2((v[2] - mu) * rstd * gam[2] + bet[2], (v[3] - mu) * rstd * gam[3] + bet[3]);
    o.z = pack2((v[4] - mu) * rstd * gam[4] + bet[4], (v[5] - mu) * rstd * gam[5] + bet[5]);
    o.w = pack2((v[6] - mu) * rstd * gam[6] + bet[6], (v[7] - mu) * rstd * gam[7] + bet[7]);
    *ptr = o;
  }
}
__device__ __forceinline__ void phase_up8(const Params& p, unsigned char* smem) {
  unsigned char* ws = p.ws;
  const pg8::bf16_t* ya = (const pg8::bf16_t*)(ws + WS_XN);
  const pg8::bf16_t* yb = ya + (size_t)TOK * 512;
  pg8::StaticOrder S; S.init(TOK, 1024, (int)gridDim.x, (int)blockIdx.x);
  {
    pg8::Gemm g{ya, (const pg8::bf16_t*)(ws + WS_WUPA), TOK, 1024, 512};
    EpiGate<0> E{(unsigned short*)(ws + WS_PH), (const unsigned short*)(ws + WS_PG), 0};
    pg8::gemm_phase<EpiGate<0>, pg8::StaticOrder>((PG8_LAS unsigned char*)smem, g, S, E, nullptr);
  }
  {
    pg8::Gemm g{yb, (const pg8::bf16_t*)(ws + WS_WUPB), TOK, 1024, 512};
    EpiGate<1> E{(unsigned short*)(ws + WS_PH), (const unsigned short*)(ws + WS_PG), 1024};
    pg8::gemm_phase<EpiGate<1>, pg8::StaticOrder>((PG8_LAS unsigned char*)smem, g, S, E, nullptr);
  }
}
__device__ __forceinline__ void phase_out8(const Params& p, unsigned char* smem) {
  unsigned char* ws = p.ws;
  pg8::Gemm g{(const pg8::bf16_t*)(ws + WS_PH), (const pg8::bf16_t*)(ws + WS_WOUT), TOK, 1024, 1024};
  pg8::StaticOrder S; S.init(TOK, 1024, (int)gridDim.x, (int)blockIdx.x);
  EpiResid E{p.out, p.x};
  pg8::gemm_phase<EpiResid, pg8::StaticOrder>((PG8_LAS unsigned char*)smem, g, S, E, nullptr);
}
__device__ __forceinline__ void phase_pq8(const Params& p, unsigned char* smem) {
  unsigned char* ws = p.ws;
  pg8::Gemm g{(const pg8::bf16_t*)(ws + WS_XN), (const pg8::bf16_t*)(ws + WS_WQ), TOK, 2048, 1024};
  pg8::StaticOrder S; S.init(TOK, 2048, (int)gridDim.x, (int)blockIdx.x);
  EpiStoreBf16 E{(unsigned short*)(ws + WS_PG), 2048};
  pg8::gemm_phase<EpiStoreBf16, pg8::StaticOrder>((PG8_LAS unsigned char*)smem, g, S, E, nullptr);
}

__global__ void __launch_bounds__(NTHREADS) hybrid_fwd(Params p) {
  extern __shared__ __attribute__((aligned(16))) unsigned char smem[];
#if ONE_LAUNCH
  cg::grid_group grid = cg::this_grid();
  volatile LAS unsigned* xst = (volatile LAS unsigned*)(smem + LDS_BYTES - 16);
  if (threadIdx.x == 0) { xst[0] = 0u; xst[1] = 0u; }
  __syncthreads();
  XcdBarrier xbar = xcd_barrier_post((unsigned*)(p.ws + WS_BAR), xst);
#define SEAM(k) do { if (p.ph_lo <= (k) && (k) + 1 < p.ph_hi) { if (p.ph_hi > NPHASE) grid.sync(); else xcd_barrier(xbar); } } while (0)
#else
#define SEAM(k) do { } while (0)
#endif
#define IN(k) (p.ph_lo <= (k) && (k) < p.ph_hi)
#ifndef REPEAT_PH
#define REPEAT_PH -1
#endif
#define REP(k, stmt) do { if (REPEAT_PH == (k)) { stmt; grid.sync(); } } while (0)
  if (IN(0)) { phase_prep(p, smem); SEAM(0); }
  if (IN(1)) { phase_proj8(p, smem); SEAM(1); }
  if (IN(2)) { phase_ikln(p); hgrn_h1_all(p, smem); SEAM(2); }
  if (IN(3)) { phase_mix(p, smem); SEAM(3); }
  if (IN(4)) { phase_up8(p, smem); SEAM(4); }
  if (IN(5)) { phase_out8(p, smem); SEAM(5); }
  if (IN(6)) { rmsnorm_rows_q(p.out, p.norm_ffn, (bf16_t*)(p.ws + WS_XN), p.ws + WS_XQ, (float*)(p.ws + WS_XS)); SEAM(6); }
  if (IN(7)) { phase_pq8(p, smem); SEAM(7); }
  if (IN(8)) { phase_pkeys(p, smem); SEAM(8); }
  if (IN(9)) { phase_pu(p, smem); SEAM(9); }
  if (IN(10)) { if (gridDim.x % 8 == 0) phase_pv_t<true>(p, smem); else phase_pv_t<false>(p, smem); SEAM(10); }
  if (IN(11)) { phase_final(p); }
#undef IN
#undef SEAM
}

extern "C" void kernel_launch(void* const* d_in, const int* in_sizes, int n_in, void* d_out, int out_size, void* d_ws, size_t ws_size,
                              hipStream_t stream) {
  static int grid = 0;
  if (grid == 0) {
    if (n_in != 17 || ws_size < WS_END) {
      fprintf(stderr, "kernel_launch: unexpected n_in %d or ws_size %zu (need %zu)\n", n_in, ws_size, (size_t)WS_END);
      grid = -1; return;
    }
    int dev = 0, cus = 0, per_cu = 0;
    hipGetDevice(&dev);
    hipDeviceGetAttribute(&cus, hipDeviceAttributeMultiprocessorCount, dev);
    hipFuncSetAttribute((const void*)hybrid_fwd, hipFuncAttributeMaxDynamicSharedMemorySize, LDS_BYTES);
    hipOccupancyMaxActiveBlocksPerMultiprocessor(&per_cu, (const void*)hybrid_fwd, NTHREADS, LDS_BYTES);
    if (per_cu < 1) { fprintf(stderr, "kernel_launch: occupancy query says %d blocks/CU\n", per_cu); per_cu = 1; }
    (void)hipGetLastError();
    grid = cus;
  }
  if (grid < 0) return;
  Params p{};
  p.x = (const float*)d_in[0]; p.norm_mix = (const float*)d_in[1]; p.w_in = (const float*)d_in[2]; p.hg_lb = (const float*)d_in[3];
  p.hg_norm = (const float*)d_in[4]; p.ikg = (const float*)d_in[5]; p.ikb = (const float*)d_in[6]; p.rel_bias = (const float*)d_in[7];
  p.w_up_a = (const float*)d_in[8]; p.w_up_b = (const float*)d_in[9]; p.w_out = (const float*)d_in[10]; p.norm_ffn = (const float*)d_in[11];
  p.peer_wq = (const float*)d_in[12]; p.peer_keys = (const float*)d_in[13]; p.peer_u = (const float*)d_in[14]; p.peer_v = (const float*)d_in[15];
  p.norm_final = (const float*)d_in[16];
  p.out = (float*)d_out; p.ws = (unsigned char*)d_ws;
#if ONE_LAUNCH
  hipMemsetAsync((unsigned char*)d_ws + WS_BAR, 0, 16384, stream);
  p.ph_lo = 0; p.ph_hi = NPHASE;
  void* args[] = {&p};
  hipError_t e = hipLaunchCooperativeKernel((const void*)hybrid_fwd, dim3(grid), dim3(NTHREADS), args, LDS_BYTES, stream);
  if (e != hipSuccess) fprintf(stderr, "cooperative launch failed: %s (grid %d)\n", hipGetErrorString(e), grid);
#else
  for (int ph = 0; ph < NPHASE; ++ph) {
    p.ph_lo = ph; p.ph_hi = ph + 1;
    hipLaunchKernelGGL(hybrid_fwd, dim3(grid), dim3(NTHREADS), LDS_BYTES, stream, p);
  }
#endif
}
```

```cpp
#include <hip/hip_runtime.h>
#include <hip/hip_cooperative_groups.h>
#include <stdint.h>
#include <stdio.h>
namespace cg = cooperative_groups;

#ifndef ONE_LAUNCH
#define ONE_LAUNCH 1
#endif

typedef unsigned short bf16_t;
typedef __attribute__((ext_vector_type(8))) short bf16x8;
typedef __attribute__((ext_vector_type(4))) float f32x4;

#define NTHREADS 512
#define TOK 32768
#define SEQL 4096
#define DM 1024
#define EPSV 1e-6f
#define NPHASE 12

#define WS_WIN   ((size_t)0)
#define WS_WUPA  (WS_WIN  + (size_t)5120 * 1024 * 2)
#define WS_WUPB  (WS_WUPA + (size_t)1024 * 512 * 2)
#define WS_WOUT  (WS_WUPB + (size_t)1024 * 512 * 2)
#define WS_WQ    (WS_WOUT + (size_t)1024 * 1024 * 2)
#define WS_KEYS  (WS_WQ   + (size_t)2048 * 1024 * 2)
#define WS_LB    (WS_KEYS + (size_t)2 * 8 * 128 * 128 * 2)
#define WS_U     (WS_LB   + (size_t)4096)
#define WS_V     (WS_U    + (size_t)16384 * 1024 * 2)
#define WS_XN    (WS_V    + (size_t)16384 * 1024 * 2)
#define WS_PH    (WS_XN   + (size_t)TOK * 1024 * 2)
#define WS_PA    (WS_PH   + (size_t)TOK * 2048 * 2)
#define WS_PG    (WS_PA   + (size_t)TOK * 1024 * 2)
#define WS_EIDX  (WS_PG   + (size_t)TOK * 2048 * 2)
#define WS_GW    (WS_EIDX + (size_t)TOK * 128 * 4)
#define WS_SSQ   (WS_GW   + (size_t)TOK * 128 * 4)
#define WS_XCC   (WS_SSQ  + (size_t)TOK * 4)
#define WS_BAR   (WS_XCC  + (size_t)4096)
#define WS_DEC   (WS_BAR  + (size_t)16384)
#define WS_QCTR  (WS_DEC  + (size_t)2048 * 384 * 4)
#define WS_END   (WS_QCTR + (size_t)1024)

#define WS_KC (WS_EIDX)
#define WS_VC (WS_KC + (size_t)TOK * 128)
#define WS_IKC (WS_VC + (size_t)TOK * 128)
#define LDS_BYTES 155648

struct Params {
  const float* x; const float* norm_mix; const float* w_in; const float* hg_lb; const float* hg_norm;
  const float* ikg; const float* ikb; const float* rel_bias; const float* w_up_a; const float* w_up_b;
  const float* w_out; const float* norm_ffn; const float* peer_wq; const float* peer_keys;
  const float* peer_u; const float* peer_v; const float* norm_final;
  float* out; unsigned char* ws; int ph_lo, ph_hi;
};

__device__ __forceinline__ float bf2f(bf16_t u) { return __uint_as_float(((unsigned)u) << 16); }
typedef float f32x2_cv __attribute__((ext_vector_type(2)));
typedef __bf16 bf16x2_cv __attribute__((ext_vector_type(2)));
__device__ __forceinline__ unsigned pack2(float a, float b) {
  const f32x2_cv v = {a, b};
  return __builtin_bit_cast(unsigned, __builtin_convertvector(v, bf16x2_cv));
}
__device__ __forceinline__ bf16_t f2bf(float f) { return (bf16_t)(pack2(f, f) & 0xffffu); }
__device__ __forceinline__ float wave_sum_slow(float v) {
#pragma unroll
  for (int o = 32; o > 0; o >>= 1) v += __shfl_xor(v, o);
  return v;
}
__device__ __forceinline__ void lds_fence() { asm volatile("s_waitcnt lgkmcnt(0)" ::: "memory"); }

__device__ __forceinline__ float add_xor8(float v) { return v + __int_as_float(__builtin_amdgcn_update_dpp(0, __float_as_int(v), 0x128, 0xf, 0xf, true)); }
__device__ __forceinline__ float add_xor16(float v) { const auto r = __builtin_amdgcn_permlane16_swap(__float_as_uint(v), __float_as_uint(v), false, false); return __uint_as_float(r[0]) + __uint_as_float(r[1]); }
__device__ __forceinline__ float add_xor32(float v) { const auto r = __builtin_amdgcn_permlane32_swap(__float_as_uint(v), __float_as_uint(v), false, false); return __uint_as_float(r[0]) + __uint_as_float(r[1]); }
__device__ __forceinline__ float max_xor16(float v) { const auto r = __builtin_amdgcn_permlane16_swap(__float_as_uint(v), __float_as_uint(v), false, false); return fmaxf(__uint_as_float(r[0]), __uint_as_float(r[1])); }
__device__ __forceinline__ float max_xor32(float v) { const auto r = __builtin_amdgcn_permlane32_swap(__float_as_uint(v), __float_as_uint(v), false, false); return fmaxf(__uint_as_float(r[0]), __uint_as_float(r[1])); }
__device__ __forceinline__ float wave_sum(float v) {
  v += __int_as_float(__builtin_amdgcn_update_dpp(0, __float_as_int(v), 0xB1, 0xf, 0xf, true));
  v += __int_as_float(__builtin_amdgcn_update_dpp(0, __float_as_int(v), 0x4E, 0xf, 0xf, true));
  v += __int_as_float(__builtin_amdgcn_update_dpp(0, __float_as_int(v), 0x141, 0xf, 0xf, true));
  v += __int_as_float(__builtin_amdgcn_update_dpp(0, __float_as_int(v), 0x140, 0xf, 0xf, true));
  return add_xor32(add_xor16(v));
}
__device__ __forceinline__ float sigmoidf_(float x) { return 1.f / (1.f + __expf(-x)); }
__device__ __forceinline__ float siluf_(float x) { return x / (1.f + __expf(-x)); }


#define XB_TMO      128
#define XB_XCNT(j)  (256  + 64 * (j))
#define XB_XSUB(j)  (1280 + 64 * (j))
#define XB_XGEN(j)  (2304 + 64 * (j))
#define XB_TOP      3328
#define XB_TOPGEN   3392
#define XCD_BAR_WORDS 3456
#define XB_SPIN_CAP (1u << 22)
#define LAS __attribute__((address_space(3)))
__device__ __forceinline__ unsigned xb_ld(unsigned* p)              { return __hip_atomic_load(p, __ATOMIC_RELAXED, __HIP_MEMORY_SCOPE_AGENT); }
__device__ __forceinline__ unsigned xb_add(unsigned* p, unsigned v) { return __hip_atomic_fetch_add(p, v, __ATOMIC_RELAXED, __HIP_MEMORY_SCOPE_AGENT); }
__device__ __forceinline__ unsigned xb_xcc_id() { return (unsigned)__builtin_amdgcn_s_getreg((3 << 11) | 20) & 0xFu; }
#define XB_SPIN(cond, bar) do { unsigned _sp = 0; while (cond) { __builtin_amdgcn_s_sleep(1); \
    if ((++_sp & 255u) == 0u) { if (xb_ld(&(bar)[XB_TMO])) break; if (_sp > XB_SPIN_CAP) { atomicAdd(&(bar)[XB_TMO], 1u); break; } } } } while (0)
struct XcdBarrier { unsigned* bar; unsigned x; volatile LAS unsigned* st; };
__device__ __forceinline__ XcdBarrier xcd_barrier_post(unsigned* bar, volatile LAS unsigned* st) {
  XcdBarrier b; b.bar = bar; b.x = xb_xcc_id(); b.st = st;
  if (threadIdx.x == 0) (void)xb_add(&bar[XB_XCNT(b.x)], 1u);
  return b;
}
__device__ __forceinline__ void xcd_barrier_complete(unsigned* bar, unsigned x, unsigned& nloc, unsigned& nx) {
  const unsigned G = gridDim.x * gridDim.y * gridDim.z;
  unsigned sum, cnt, mine, sp = 0u;
  for (;;) {
    sum = 0u; cnt = 0u; mine = 0u;
#pragma unroll
    for (unsigned j = 0; j < 16; ++j) { const unsigned c = xb_ld(&bar[XB_XCNT(j)]); sum += c; cnt += (c > 0u) ? 1u : 0u; mine = (j == x) ? c : mine; }
    if (sum == G) break;
    __builtin_amdgcn_s_sleep(1);
    if ((++sp & 255u) == 0u) { if (xb_ld(&bar[XB_TMO])) break; if (sp > XB_SPIN_CAP) { atomicAdd(&bar[XB_TMO], 1u); break; } }
  }
  nloc = mine > 0u ? mine : 1u; nx = cnt > 0u ? cnt : 1u;
}
__device__ __forceinline__ void xcd_barrier(const XcdBarrier& b) {
  asm volatile("s_waitcnt vmcnt(0)" ::: "memory");
  __syncthreads();
  if (threadIdx.x == 0) {
    unsigned* bar = b.bar;
    __builtin_amdgcn_s_waitcnt(0);
    unsigned nloc = b.st[0], nx = b.st[1];
    if (nloc == 0u) { xcd_barrier_complete(bar, b.x, nloc, nx); b.st[0] = nloc; b.st[1] = nx; }
    const unsigned old = xb_add(&bar[XB_XSUB(b.x)], 1u);
    const unsigned gen = old / nloc;
    if (old + 1u == (gen + 1u) * nloc) {
      __builtin_amdgcn_fence(__ATOMIC_RELEASE, "agent");
      asm volatile("s_waitcnt vmcnt(0)" ::: "memory");
      const unsigned og = xb_add(&bar[XB_TOP], 1u);
      const unsigned tg = og / nx;
      if (og + 1u == (tg + 1u) * nx) xb_add(&bar[XB_TOPGEN], 1u);
      else XB_SPIN(xb_ld(&bar[XB_TOPGEN]) == tg, bar);
      __builtin_amdgcn_fence(__ATOMIC_ACQUIRE, "agent");
      xb_add(&bar[XB_XGEN(b.x)], 1u);
      asm volatile("s_waitcnt vmcnt(0)" ::: "memory");
    } else {
      XB_SPIN(xb_ld(&bar[XB_XGEN(b.x)]) == gen, bar);
      __builtin_amdgcn_fence(__ATOMIC_ACQUIRE, "agent");
      asm volatile("s_waitcnt vmcnt(0)" ::: "memory");
    }
  }
  __syncthreads();
}

namespace pg8 {
#define PG8_LAS __attribute__((address_space(3)))
typedef unsigned short bf16_t;
typedef short bf16x8 __attribute__((ext_vector_type(8)));
typedef float f32x4 __attribute__((ext_vector_type(4)));
typedef unsigned u32x4 __attribute__((ext_vector_type(4)));
constexpr int BM = 256, BK = 64, HALF = 128, HTB = HALF * BK * 2  , STAGE_BYTES = 8 * HTB, NXCD = 8, WGM = 8;

__host__ __device__ __forceinline__ int lds_byte(int r, int c) { const int st = (r >> 4) * 2 + (c >> 5), rr = r & 15, cc = c & 31, ob = rr * 64 + cc * 2; return st * 1024 + (ob ^ (((ob >> 9) & 1) << 5)); }
__host__ __device__ __forceinline__ void stage_rc(int b, int& R, int& C) { const int st = b / 1024, sb = b % 1024, swz = sb ^ (((sb >> 9) & 1) << 5); R = (st >> 1) * 16 + swz / 64; C = (st & 1) * 32 + (swz % 64) / 2; }
__host__ __device__ __forceinline__ int perm32(int rho) { const int n = rho >> 4, i = rho & 15; return 8 * (i >> 2) + 4 * n + (i & 3); }

struct Unit { int pm, pn; };
struct Gemm { const bf16_t* A; const bf16_t* Bt; int M, N, K; };

struct StaticOrder {
    int nM, nN, nwg, G, c;
    __host__ __device__ void init(int M, int N, int G_, int c_) { nM = M / BM; nN = N / BM; nwg = nM * nN; G = G_; c = c_; }
    __host__ __device__ bool next(int i, Unit& u) const {
        const long L = (long)i * G + c; if (L >= nwg) return false;
        int wgid = (int)L; { const int q = nwg / NXCD, r = nwg % NXCD, xcd = wgid % NXCD, off = wgid / NXCD; wgid = (xcd < r ? xcd * (q + 1) : r * (q + 1) + (xcd - r) * q) + off; }
        const int nig = WGM * nN, gid = wgid / nig, fm = gid * WGM, gsz = (nM - fm) < WGM ? (nM - fm) : WGM;
        u.pm = fm + ((wgid % nig) % gsz); u.pn = (wgid % nig) / gsz; return true;
    }
    __device__ __forceinline__ void a_ready(const Unit&) const {}
    __device__ __forceinline__ void done(const Unit&) const {}
};
__device__ __forceinline__ unsigned cvt_pk_bf16(float lo, float hi) { unsigned r; asm volatile("v_cvt_pk_bf16_f32 %0, %1, %2" : "=v"(r) : "v"(lo), "v"(hi)); return r; }
template <class Epi, class Sched, bool STAMP = false>
__device__ __forceinline__ void gemm_phase(PG8_LAS unsigned char* lds, const Gemm g, const Sched& S, const Epi& E, unsigned long long* stamps) {
    const int tid = threadIdx.x, wid = __builtin_amdgcn_readfirstlane(tid >> 6), lane = tid & 63, wr = wid >> 2, wc = wid & 3, fr = lane & 15, fq = lane >> 4;
    const int K = g.K, nt = K / BK;
    int ts_lo = 0, ts_hi = 0, nts = 0; const unsigned long long rt_entry = STAMP ? (unsigned long long)wall_clock64() : 0ull;
#define PG8_STAMP() do { if (STAMP && wid == 0 && nts < 64) { const unsigned long long _c = (unsigned long long)clock64(); \
        ts_lo = (lane == nts) ? (int)(unsigned)_c : ts_lo; ts_hi = (lane == nts) ? (int)(unsigned)(_c >> 32) : ts_hi; ++nts; } } while (0)
    PG8_STAMP();
    unsigned voffA[2], voffB[2];
#pragma unroll
    for (int i = 0; i < 2; ++i) { int R, C; stage_rc(tid * 16 + i * 8192, R, C); const int Rb = Epi::PERM ? ((R & ~31) + perm32(R & 31)) : R;
        voffA[i] = (unsigned)(R * K + C) * 2u; voffB[i] = (unsigned)(Rb * K + C) * 2u; }
    const size_t kstep = (size_t)(BK * 2);
    const size_t hstep = (size_t)HALF * K * 2;
    const size_t tstep = 2 * hstep;
    const unsigned ldsw = (unsigned)wid * 1024u;
    const int aoff = lds_byte(wr * 64 + fr, fq * 8), boff = lds_byte(wc * 32 + fr, fq * 8);
#define PG8_SA(b, h) (((b) * 2 + (h)) * HTB)
#define PG8_SB(b, h) ((4 + (b) * 2 + (h)) * HTB)
#define PG8_STAGE(bufoff, gbase, voff) do { _Pragma("unroll") for (int _i = 0; _i < 2; ++_i) \
        __builtin_amdgcn_global_load_lds((const unsigned*)((const char*)(gbase) + (voff)[_i]), (PG8_LAS unsigned*)(lds + (bufoff) + ldsw + _i * 8192), 16, 0, 0); } while (0)
#define PG8_LDA(dst, b, h) do { _Pragma("unroll") for (int m = 0; m < 4; ++m) _Pragma("unroll") for (int k = 0; k < 2; ++k) dst[m][k] = *(const PG8_LAS bf16x8*)(lds + PG8_SA(b, h) + aoff + m * 2048 + k * 1024); } while (0)
#define PG8_LDB(dst, b, h) do { _Pragma("unroll") for (int n = 0; n < 2; ++n) _Pragma("unroll") for (int k = 0; k < 2; ++k) dst[n][k] = *(const PG8_LAS bf16x8*)(lds + PG8_SB(b, h) + boff + n * 2048 + k * 1024); } while (0)
#define PG8_MMA(ai, bj, At, Bt) do { __builtin_amdgcn_s_setprio(1); _Pragma("unroll") for (int m = 0; m < 4; ++m) _Pragma("unroll") for (int n = 0; n < 2; ++n) _Pragma("unroll") for (int k = 0; k < 2; ++k) \
        acc[ai][bj][m][n] = __builtin_amdgcn_mfma_f32_16x16x32_bf16(Bt[n][k], At[m][k], acc[ai][bj][m][n], 0, 0, 0); __builtin_amdgcn_s_setprio(0); } while (0)
#define PG8_WAIT_V(n) asm volatile("s_waitcnt vmcnt(" #n ")" ::: "memory")
#define PG8_WAIT_L(n) asm volatile("s_waitcnt lgkmcnt(" #n ")" ::: "memory")
#define PG8_BAR __builtin_amdgcn_s_barrier()
#define PG8_SCHED __builtin_amdgcn_sched_barrier(0)
    Unit cur, nxt; int ui = 0;
    if (!S.next(0, cur)) return;
    f32x4 acc[2][2][4][2];
#pragma unroll
    for (int a = 0; a < 2; ++a)
#pragma unroll
        for (int b = 0; b < 2; ++b)
#pragma unroll
            for (int m = 0; m < 4; ++m)
#pragma unroll
                for (int n = 0; n < 2; ++n) acc[a][b][m][n] = (f32x4){0.f, 0.f, 0.f, 0.f};
    bf16x8 At[4][2], B0[2][2], B1[2][2];
    const char* cA = (const char*)g.A + (size_t)cur.pm * tstep; const char* cB = (const char*)g.Bt + (size_t)cur.pn * tstep;
    S.a_ready(cur);
    PG8_STAGE(PG8_SB(0, 0), cB, voffB); PG8_STAGE(PG8_SA(0, 0), cA, voffA); PG8_STAGE(PG8_SB(0, 1), cB + hstep, voffB); PG8_STAGE(PG8_SA(0, 1), cA + hstep, voffA);
    if (wr == 1) PG8_BAR;
    PG8_WAIT_V(4); PG8_BAR;
    PG8_STAGE(PG8_SB(1, 0), cB + kstep, voffB); PG8_STAGE(PG8_SA(1, 0), cA + kstep, voffA); PG8_STAGE(PG8_SB(1, 1), cB + hstep + kstep, voffB);
    PG8_WAIT_V(6); PG8_BAR;
    PG8_STAMP();
    for (;;) {
        const bool has_next = S.next(ui + 1, nxt);
        const char* nA = has_next ? (const char*)g.A + (size_t)nxt.pm * tstep : cA; const char* nB = has_next ? (const char*)g.Bt + (size_t)nxt.pn * tstep : cB;
        for (int t = 0; t < nt; t += 2) {
            const bool last = (t == nt - 2);
            const char* a1 = cA + (size_t)(t + 1) * kstep;
            const char* a2 = last ? nA : cA + (size_t)(t + 2) * kstep; const char* b2 = last ? nB : cB + (size_t)(t + 2) * kstep;
            const char* a3 = a2 + kstep; const char* b3 = b2 + kstep;
            if (last && has_next) S.a_ready(nxt);
            PG8_LDB(B0, 0, 0); PG8_SCHED; PG8_LDA(At, 0, 0); PG8_STAGE(PG8_SA(1, 1), a1 + hstep, voffA);
            PG8_WAIT_L(8); PG8_BAR; PG8_WAIT_L(0); PG8_MMA(0, 0, At, B0); PG8_BAR; PG8_SCHED;
            PG8_LDB(B1, 0, 1); PG8_STAGE(PG8_SB(0, 0), b2, voffB);
            PG8_BAR; PG8_WAIT_L(0); PG8_MMA(0, 1, At, B1); PG8_BAR;
            PG8_LDA(At, 0, 1); PG8_STAGE(PG8_SA(0, 0), a2, voffA);
            PG8_BAR; PG8_WAIT_L(0); PG8_MMA(1, 0, At, B0); PG8_BAR; PG8_SCHED;
            PG8_STAGE(PG8_SB(0, 1), b2 + hstep, voffB);
            PG8_WAIT_V(6); PG8_BAR; PG8_MMA(1, 1, At, B1); PG8_BAR;
            PG8_LDB(B0, 1, 0); PG8_SCHED; PG8_LDA(At, 1, 0); PG8_STAGE(PG8_SA(0, 1), a2 + hstep, voffA);
            PG8_WAIT_L(8); PG8_BAR; PG8_WAIT_L(0); PG8_MMA(0, 0, At, B0); PG8_BAR; PG8_SCHED;
            PG8_LDB(B1, 1, 1); PG8_STAGE(PG8_SB(1, 0), b3, voffB);
            PG8_BAR; PG8_WAIT_L(0); PG8_MMA(0, 1, At, B1); PG8_BAR;
            PG8_LDA(At, 1, 1); PG8_STAGE(PG8_SA(1, 0), a3, voffA);
            PG8_BAR; PG8_WAIT_L(0); PG8_MMA(1, 0, At, B0); PG8_BAR; PG8_SCHED;
            PG8_STAGE(PG8_SB(1, 1), b3 + hstep, voffB);
            PG8_WAIT_V(6); PG8_BAR; PG8_MMA(1, 1, At, B1); PG8_BAR;
        }
        PG8_STAMP();
        if constexpr (!Epi::AFTER_DRAIN) { E(acc, cur, wr, wc, fr, fq); S.done(cur); }
        PG8_STAMP();
        if (!has_next) break;
#pragma unroll
        for (int a = 0; a < 2; ++a)
#pragma unroll
            for (int b = 0; b < 2; ++b)
#pragma unroll
                for (int m = 0; m < 4; ++m)
#pragma unroll
                    for (int n = 0; n < 2; ++n) acc[a][b][m][n] = (f32x4){0.f, 0.f, 0.f, 0.f};
        cur = nxt; cA = nA; cB = nB; ++ui;
    }
    PG8_WAIT_V(0);
    if (wr == 0) PG8_BAR;
    PG8_BAR;
    if constexpr (Epi::AFTER_DRAIN) { E.fused(acc, cur, wr, wc, fr, fq, lds, wid, lane); S.done(cur); }
    PG8_STAMP();
    if (STAMP && wid == 0) { stamps[lane] = lane < nts ? (((unsigned long long)(unsigned)ts_hi << 32) | (unsigned)ts_lo) : 0ull;
        if (lane == 62) stamps[62] = rt_entry; if (lane == 63) stamps[63] = (unsigned long long)wall_clock64(); }
#undef PG8_STAMP
#undef PG8_SA
#undef PG8_SB
#undef PG8_STAGE
#undef PG8_LDA
#undef PG8_LDB
#undef PG8_MMA
#undef PG8_WAIT_V
#undef PG8_WAIT_L
#undef PG8_BAR
#undef PG8_SCHED
}
}

struct EpiProj {
  static constexpr bool PERM = true, AFTER_DRAIN = false;
  unsigned short* pH; unsigned short* pA; unsigned short* pG; unsigned short* kc; unsigned short* vc; unsigned short* ikc;
  __device__ __forceinline__ void operator()(const pg8::f32x4 (&acc)[2][2][4][2], const pg8::Unit& u, int wr, int wc, int fr, int fq) const {
    const int row0 = u.pm * 256 + wr * 64 + fr;
    unsigned short* base; int ldc, colt; bool sg = false;
    if (u.pn < 8) { base = pH; ldc = 2048; colt = u.pn * 256; }
    else if (u.pn < 12) { base = pA; ldc = 1024; colt = (u.pn - 8) * 256; }
    else { base = pG; ldc = 2048; colt = (u.pn - 12) * 256; sg = true; }
    const int col0 = colt + wc * 32 + 8 * fq;
#pragma unroll
    for (int ai = 0; ai < 2; ++ai)
#pragma unroll
      for (int m = 0; m < 4; ++m) {
        unsigned short* rowp = base + (size_t)(row0 + ai * 128 + m * 16) * ldc + col0;
#pragma unroll
        for (int bj = 0; bj < 2; ++bj) {
          pg8::f32x4 v0 = acc[ai][bj][m][0], v1 = acc[ai][bj][m][1];
          if (sg) {
#pragma unroll
            for (int j = 0; j < 4; ++j) { v0[j] = sigmoidf_(v0[j]); v1[j] = sigmoidf_(v1[j]); }
          }
          pg8::u32x4 w; w.x = pg8::cvt_pk_bf16(v0[0], v0[1]); w.y = pg8::cvt_pk_bf16(v0[2], v0[3]); w.z = pg8::cvt_pk_bf16(v1[0], v1[1]); w.w = pg8::cvt_pk_bf16(v1[2], v1[3]);
          unsigned short* dst = rowp + bj * 128;
          if (u.pn == 10 || u.pn == 11) {
            const int cs = col0 + bj * 128;
            const size_t r = (size_t)(row0 + ai * 128 + m * 16);
            if (cs >= 512 && cs < 576) dst = kc + r * 64 + (cs - 512);
            else if (cs >= 576 && cs < 640) dst = vc + r * 64 + (cs - 576);
            else if (cs >= 896 && cs < 960) dst = ikc + r * 64 + (cs - 896);
          }
          *(pg8::u32x4*)dst = w;
        }
      }
  }
};
template <int MODE> struct EpiGate {
  static constexpr bool PERM = true, AFTER_DRAIN = false;
  unsigned short* hb; const unsigned short* pG; int goff;
  __device__ __forceinline__ void operator()(const pg8::f32x4 (&acc)[2][2][4][2], const pg8::Unit& u, int wr, int wc, int fr, int fq) const {
    const int row0 = u.pm * 256 + wr * 64 + fr;
    const int col0 = u.pn * 256 + wc * 32 + 8 * fq;
#pragma unroll
    for (int ai = 0; ai < 2; ++ai)
#pragma unroll
      for (int m = 0; m < 4; ++m) {
        const size_t r = (size_t)(row0 + ai * 128 + m * 16);
        pg8::u32x4 gv[2], hv[2];
#pragma unroll
        for (int bj = 0; bj < 2; ++bj) {
          gv[bj] = *(const pg8::u32x4*)(pG + r * 2048 + goff + col0 + bj * 128);
          if (MODE == 1) hv[bj] = *(const pg8::u32x4*)(hb + r * 1024 + col0 + bj * 128);
        }
#pragma unroll
        for (int bj = 0; bj < 2; ++bj) {
          float o[8];
#pragma unroll
          for (int j = 0; j < 4; ++j) {
            const unsigned gw0 = gv[bj][j >> 1], gw1 = gv[bj][2 + (j >> 1)];
            const float g0 = (j & 1) ? __uint_as_float(gw0 & 0xffff0000u) : __uint_as_float(gw0 << 16);
            const float g1 = (j & 1) ? __uint_as_float(gw1 & 0xffff0000u) : __uint_as_float(gw1 << 16);
            o[j] = acc[ai][bj][m][0][j] * g0; o[4 + j] = acc[ai][bj][m][1][j] * g1;
            if (MODE == 1) {
              const unsigned hw0 = hv[bj][j >> 1], hw1 = hv[bj][2 + (j >> 1)];
              o[j] += (j & 1) ? __uint_as_float(hw0 & 0xffff0000u) : __uint_as_float(hw0 << 16);
              o[4 + j] += (j & 1) ? __uint_as_float(hw1 & 0xffff0000u) : __uint_as_float(hw1 << 16);
            }
          }
          pg8::u32x4 w; w.x = pg8::cvt_pk_bf16(o[0], o[1]); w.y = pg8::cvt_pk_bf16(o[2], o[3]); w.z = pg8::cvt_pk_bf16(o[4], o[5]); w.w = pg8::cvt_pk_bf16(o[6], o[7]);
          *(pg8::u32x4*)(hb + r * 1024 + col0 + bj * 128) = w;
        }
      }
  }
};
struct EpiResid {
  static constexpr bool PERM = false, AFTER_DRAIN = false;
  float* out; const float* x;
  __device__ __forceinline__ void operator()(const pg8::f32x4 (&acc)[2][2][4][2], const pg8::Unit& u, int wr, int wc, int fr, int fq) const {
    const int row0 = u.pm * 256 + wr * 64 + fr, col0 = u.pn * 256 + wc * 32 + 4 * fq;
#pragma unroll
    for (int ai = 0; ai < 2; ++ai)
#pragma unroll
      for (int m = 0; m < 4; ++m) {
        const size_t off = (size_t)(row0 + ai * 128 + m * 16) * 1024 + col0;
        pg8::f32x4 xv[2][2];
#pragma unroll
        for (int bj = 0; bj < 2; ++bj)
#pragma unroll
          for (int n = 0; n < 2; ++n) xv[bj][n] = *(const pg8::f32x4*)(x + off + bj * 128 + n * 16);
#pragma unroll
        for (int bj = 0; bj < 2; ++bj)
#pragma unroll
          for (int n = 0; n < 2; ++n) *(pg8::f32x4*)(out + off + bj * 128 + n * 16) = acc[ai][bj][m][n] + xv[bj][n];
      }
  }
};
struct EpiStoreBf16 {
  static constexpr bool PERM = true, AFTER_DRAIN = false;
  unsigned short* O; int ldc;
  __device__ __forceinline__ void operator()(const pg8::f32x4 (&acc)[2][2][4][2], const pg8::Unit& u, int wr, int wc, int fr, int fq) const {
    const int row0 = u.pm * 256 + wr * 64 + fr, col0 = u.pn * 256 + wc * 32 + 8 * fq;
#pragma unroll
    for (int ai = 0; ai < 2; ++ai)
#pragma unroll
      for (int m = 0; m < 4; ++m) {
        unsigned short* rowp = O + (size_t)(row0 + ai * 128 + m * 16) * ldc + col0;
#pragma unroll
        for (int bj = 0; bj < 2; ++bj) {
          const pg8::f32x4 v0 = acc[ai][bj][m][0], v1 = acc[ai][bj][m][1];
          pg8::u32x4 w; w.x = pg8::cvt_pk_bf16(v0[0], v0[1]); w.y = pg8::cvt_pk_bf16(v0[2], v0[3]); w.z = pg8::cvt_pk_bf16(v1[0], v1[1]); w.w = pg8::cvt_pk_bf16(v1[2], v1[3]);
          *(pg8::u32x4*)(rowp + bj * 128) = w;
        }
      }
  }
};

__device__ __forceinline__ void gemm_tile(const bf16_t* __restrict__ A, int lda, const bf16_t* __restrict__ Bt, int ldb,
                                          int nk, f32x4 (&acc)[4][4], unsigned char* smem) {
  const int tid = threadIdx.x, lane = tid & 63, w = tid >> 6, wm = w >> 1, wn = w & 1, l15 = lane & 15, g = lane >> 4;
  unsigned char* sA = smem;
  unsigned char* sB = smem + 32768;
  const int lr = tid >> 3, lc = tid & 7;
  const bf16_t* ga = A + (size_t)lr * lda + lc * 8;
  const bf16_t* gb = Bt + (size_t)lr * ldb + lc * 8;
  uint4 ra0, ra1, ra2, ra3, rb0, rb1;
  ra0 = *(const uint4*)(ga);
  ra1 = *(const uint4*)(ga + (size_t)64 * lda);
  ra2 = *(const uint4*)(ga + (size_t)128 * lda);
  ra3 = *(const uint4*)(ga + (size_t)192 * lda);
  rb0 = *(const uint4*)(gb);
  rb1 = *(const uint4*)(gb + (size_t)64 * ldb);
  const int sw = (lc ^ (lr & 7)) << 4;
  for (int kt = 0; kt < nk; ++kt) {
    __syncthreads();
    *(uint4*)(sA + (lr) * 128 + sw) = ra0;
    *(uint4*)(sA + (lr + 64) * 128 + sw) = ra1;
    *(uint4*)(sA + (lr + 128) * 128 + sw) = ra2;
    *(uint4*)(sA + (lr + 192) * 128 + sw) = ra3;
    *(uint4*)(sB + (lr) * 128 + sw) = rb0;
    *(uint4*)(sB + (lr + 64) * 128 + sw) = rb1;
    __syncthreads();
    if (kt + 1 < nk) {
      const int ko = (kt + 1) * 64;
      ra0 = *(const uint4*)(ga + ko);
      ra1 = *(const uint4*)(ga + (size_t)64 * lda + ko);
      ra2 = *(const uint4*)(ga + (size_t)128 * lda + ko);
      ra3 = *(const uint4*)(ga + (size_t)192 * lda + ko);
      rb0 = *(const uint4*)(gb + ko);
      rb1 = *(const uint4*)(gb + (size_t)64 * ldb + ko);
    }
#pragma unroll
    for (int ks = 0; ks < 2; ++ks) {
      bf16x8 a[4], b[4];
#pragma unroll
      for (int m = 0; m < 4; ++m) { const int r = wm * 64 + m * 16 + l15; a[m] = *(const bf16x8*)(sA + r * 128 + (((ks * 4 + g) ^ (r & 7)) << 4)); }
#pragma unroll
      for (int n = 0; n < 4; ++n) { const int r = wn * 64 + n * 16 + l15; b[n] = *(const bf16x8*)(sB + r * 128 + (((ks * 4 + g) ^ (r & 7)) << 4)); }
#pragma unroll
      for (int m = 0; m < 4; ++m)
#pragma unroll
        for (int n = 0; n < 4; ++n) acc[m][n] = __builtin_amdgcn_mfma_f32_16x16x32_bf16(a[m], b[n], acc[m][n], 0, 0, 0);
    }
  }
}

__device__ __forceinline__ void zero_acc(f32x4 (&acc)[4][4]) {
#pragma unroll
  for (int m = 0; m < 4; ++m)
#pragma unroll
    for (int n = 0; n < 4; ++n) acc[m][n] = (f32x4){0.f, 0.f, 0.f, 0.f};
}

__device__ __forceinline__ void transpose_tile(const float* __restrict__ src, int srcN, bf16_t* __restrict__ dst, int K, int n0, int k0,
                                               bool winmap, float* tile) {
  const int tid = threadIdx.x;
  const int nc = tid & 63, kr = tid >> 6;
  int ncol = n0 + nc; bool valid = true;
  if (winmap) { if (ncol >= 3072) ncol -= 60; else if (ncol >= 3012) valid = false; }
#pragma unroll
  for (int i = 0; i < 8; ++i) {
    const int k = kr + 8 * i;
    tile[k * 65 + nc] = valid ? src[(size_t)(k0 + k) * srcN + ncol] : 0.f;
  }
  __syncthreads();
#pragma unroll
  for (int i = 0; i < 8; ++i) {
    const int nr = kr + 8 * i;
    dst[(size_t)(n0 + nr) * K + k0 + nc] = f2bf(tile[nc * 65 + nr]);
  }
  __syncthreads();
}

__device__ __forceinline__ void convert_f32_bf16(const float* __restrict__ src, bf16_t* __restrict__ dst, size_t n4) {
  for (size_t i = (size_t)blockIdx.x * NTHREADS + threadIdx.x; i < n4; i += (size_t)gridDim.x * NTHREADS) {
    const float4 v = ((const float4*)src)[i];
    uint2 o; o.x = pack2(v.x, v.y); o.y = pack2(v.z, v.w);
    ((uint2*)dst)[i] = o;
  }
}

template <bool SLICE_MAJOR, bool SIGNED>
__device__ __forceinline__ void quantize_rows_u8(const float* __restrict__ src, unsigned char* __restrict__ dst, float* __restrict__ scale, int row_lo, int row_hi) {
  const int lane = threadIdx.x & 63, w = threadIdx.x >> 6;
  for (int row = row_lo + w; row < row_hi; row += 8) {
    const float4* s4 = (const float4*)(src + (size_t)row * 1024) + lane * 4;
    float4 v[4];
    float am = 0.f;
#pragma unroll
    for (int i = 0; i < 4; ++i) { v[i] = s4[i]; am = fmaxf(am, fmaxf(fmaxf(fabsf(v[i].x), fabsf(v[i].y)), fmaxf(fabsf(v[i].z), fabsf(v[i].w)))); }
#pragma unroll
    for (int o = 32; o > 0; o >>= 1) am = fmaxf(am, __shfl_xor(am, o));
    const float inv = am > 0.f ? 127.f / am : 0.f;
    unsigned pk[4];
#pragma unroll
    for (int i = 0; i < 4; ++i) {
      const int ofs = SIGNED ? 0 : 128;
      const unsigned b0 = (unsigned)((int)rintf(v[i].x * inv) + ofs), b1 = (unsigned)((int)rintf(v[i].y * inv) + ofs);
      const unsigned b2 = (unsigned)((int)rintf(v[i].z * inv) + ofs), b3 = (unsigned)((int)rintf(v[i].w * inv) + ofs);
      pk[i] = (b0 & 255u) | ((b1 & 255u) << 8) | ((b2 & 255u) << 16) | ((b3 & 255u) << 24);
    }
    if (SLICE_MAJOR) *(uint4*)(dst + (size_t)(lane >> 3) * (16384 * 128) + (size_t)row * 128 + (lane & 7) * 16) = make_uint4(pk[0], pk[1], pk[2], pk[3]);
    else *(uint4*)(dst + (size_t)row * 1024 + lane * 16) = make_uint4(pk[0], pk[1], pk[2], pk[3]);
    if (lane == 0) scale[row] = am * (1.f / 127.f);
  }
}

#define WS_XQ (WS_PH + (size_t)TOK * 1024 * 2)
#define WS_XS (WS_XQ + (size_t)TOK * 1024)
__device__ __forceinline__ void rmsnorm_rows_q(const float* __restrict__ src, const float* __restrict__ g, bf16_t* __restrict__ dst,
                                               unsigned char* __restrict__ xq, float* __restrict__ xs) {
  const int lane = threadIdx.x & 63, w = threadIdx.x >> 6;
  for (int row = blockIdx.x * 8 + w; row < TOK; row += gridDim.x * 8) {
    const float4* s4 = (const float4*)(src + (size_t)row * DM) + lane * 4;
    const float4* g4 = (const float4*)g + lane * 4;
    float v[16]; float ss = 0.f;
#pragma unroll
    for (int i = 0; i < 4; ++i) { const float4 t = s4[i]; v[4 * i] = t.x; v[4 * i + 1] = t.y; v[4 * i + 2] = t.z; v[4 * i + 3] = t.w; ss += t.x * t.x + t.y * t.y + t.z * t.z + t.w * t.w; }
    ss = wave_sum(ss);
    const float rstd = rsqrtf(ss * (1.f / DM) + EPSV);
    float am = 0.f;
#pragma unroll
    for (int i = 0; i < 4; ++i) { const float4 gg = g4[i]; v[4 * i] *= rstd * gg.x; v[4 * i + 1] *= rstd * gg.y; v[4 * i + 2] *= rstd * gg.z; v[4 * i + 3] *= rstd * gg.w; }
#pragma unroll
    for (int i = 0; i < 16; ++i) am = fmaxf(am, fabsf(v[i]));
#pragma unroll
    for (int o = 32; o > 0; o >>= 1) am = fmaxf(am, __shfl_xor(am, o));
    const float inv = am > 0.f ? 127.f / am : 0.f;
    uint4 ob0, ob1;
    ob0.x = pack2(v[0], v[1]); ob0.y = pack2(v[2], v[3]); ob0.z = pack2(v[4], v[5]); ob0.w = pack2(v[6], v[7]);
    ob1.x = pack2(v[8], v[9]); ob1.y = pack2(v[10], v[11]); ob1.z = pack2(v[12], v[13]); ob1.w = pack2(v[14], v[15]);
    *(uint4*)(dst + (size_t)row * DM + lane * 16) = ob0;
    *(uint4*)(dst + (size_t)row * DM + lane * 16 + 8) = ob1;
    unsigned pk[4];
#pragma unroll
    for (int i = 0; i < 4; ++i) {
      const unsigned b0 = (unsigned)(int)rintf(v[4 * i] * inv) & 255u, b1 = (unsigned)(int)rintf(v[4 * i + 1] * inv) & 255u;
      const unsigned b2 = (unsigned)(int)rintf(v[4 * i + 2] * inv) & 255u, b3 = (unsigned)(int)rintf(v[4 * i + 3] * inv) & 255u;
      pk[i] = b0 | (b1 << 8) | (b2 << 16) | (b3 << 24);
    }
    *(uint4*)(xq + (size_t)row * 1024 + lane * 16) = make_uint4(pk[0], pk[1], pk[2], pk[3]);
    if (lane == 0) xs[row] = am * (1.f / 127.f);
  }
}

__device__ __forceinline__ void rmsnorm_rows(const float* __restrict__ src, const float* __restrict__ g, bf16_t* __restrict__ dst) {
  const int lane = threadIdx.x & 63, w = threadIdx.x >> 6;
  for (int row = blockIdx.x * 8 + w; row < TOK; row += gridDim.x * 8) {
    const float4* s4 = (const float4*)(src + (size_t)row * DM);
    float4 v[4]; float ss = 0.f;
#pragma unroll
    for (int i = 0; i < 4; ++i) { v[i] = s4[lane + 64 * i]; ss += v[i].x * v[i].x + v[i].y * v[i].y + v[i].z * v[i].z + v[i].w * v[i].w; }
    ss = wave_sum(ss);
    const float rstd = rsqrtf(ss * (1.f / DM) + EPSV);
#pragma unroll
    for (int i = 0; i < 4; ++i) {
      const float4 gg = ((const float4*)g)[lane + 64 * i];
      uint2 o; o.x = pack2(v[i].x * rstd * gg.x, v[i].y * rstd * gg.y); o.y = pack2(v[i].z * rstd * gg.z, v[i].w * rstd * gg.w);
      ((uint2*)(dst + (size_t)row * DM))[lane + 64 * i] = o;
    }
  }
}

__device__ __forceinline__ void phase_prep(const Params& p, unsigned char* smem) {
  unsigned char* ws = p.ws;
  float* tile = (float*)smem;
  const int n_win = 80 * 16, n_ua = 16 * 8, n_ub = 16 * 8, n_wo = 16 * 16, n_wq = 32 * 16;
  const int total = n_win + n_ua + n_ub + n_wo + n_wq;
  for (int it = blockIdx.x; it < total; it += gridDim.x) {
    int t = it;
    if (t < n_win) { transpose_tile(p.w_in, 5060, (bf16_t*)(ws + WS_WIN), 1024, (t >> 4) * 64, (t & 15) * 64, true, tile); continue; }
    t -= n_win;
    if (t < n_ua) { transpose_tile(p.w_up_a, 1024, (bf16_t*)(ws + WS_WUPA), 512, (t >> 3) * 64, (t & 7) * 64, false, tile); continue; }
    t -= n_ua;
    if (t < n_ub) { transpose_tile(p.w_up_b, 1024, (bf16_t*)(ws + WS_WUPB), 512, (t >> 3) * 64, (t & 7) * 64, false, tile); continue; }
    t -= n_ub;
    if (t < n_wo) { transpose_tile(p.w_out, 1024, (bf16_t*)(ws + WS_WOUT), 1024, (t >> 4) * 64, (t & 15) * 64, false, tile); continue; }
    t -= n_wo;
    transpose_tile(p.peer_wq, 2048, (bf16_t*)(ws + WS_WQ), 1024, (t >> 4) * 64, (t & 15) * 64, false, tile);
  }
  convert_f32_bf16(p.peer_keys, (bf16_t*)(ws + WS_KEYS), (size_t)2 * 8 * 128 * 128 / 4);
  for (int i = blockIdx.x * NTHREADS + threadIdx.x; i < TOK; i += gridDim.x * NTHREADS) ((float*)(ws + WS_SSQ))[i] = 0.f;
  if (threadIdx.x == 0) ((int*)(ws + WS_XCC))[blockIdx.x] = (int)(__builtin_amdgcn_s_getreg((3 << 11) | 20) & 0xFu);
  if (blockIdx.x == 0 && threadIdx.x < 8) ((unsigned*)(ws + WS_QCTR))[16 * threadIdx.x] = 0u;
  if (blockIdx.x == 0) {
    const int i = threadIdx.x;
    const float a0 = p.hg_lb[i], a1 = p.hg_lb[512 + i];
    ((float*)(ws + WS_LB))[i] = 1.f / (1.f + expf(a1 - a0));
  }
  rmsnorm_rows(p.x, p.norm_mix, (bf16_t*)(ws + WS_XN));
}

__device__ __forceinline__ void hgrn_h1_all(const Params& p, unsigned char* smem) {
  unsigned char* ws = p.ws;
  bf16_t* pH = (bf16_t*)(ws + WS_PH);
  const float* lbp = (const float*)(ws + WS_LB);
  bf16_t* Qt = (bf16_t*)smem;
  bf16_t* Kt = Qt + 64 * 136;
  bf16_t* KtT = Kt + 64 * 136;
  bf16_t* VT = KtT + 128 * 72;
  bf16_t* Am = VT + 128 * 72;
  float* qtot = (float*)(Am + 64 * 72);
  const int tid = threadIdx.x, lane = tid & 63, w = tid >> 6, l15 = lane & 15, g = lane >> 4;
  const int d = tid & 127, tq = tid >> 7;
  const int G = gridDim.x;
  if ((int)blockIdx.x >= 2048) return;
  bf16_t fr_[16], qr_[16]; unsigned short vr_[16];
#define H1_LOAD(IT) do { \
    const int bh_ = (IT) >> 6, ch_ = (IT) & 63; \
    const bf16_t* base_ = pH + ((size_t)(bh_ >> 2) * SEQL + ch_ * 64 + tq * 16) * 2048 + (bh_ & 3) * 128 + d; \
    _Pragma("unroll") for (int i = 0; i < 16; ++i) { fr_[i] = base_[(size_t)i * 2048 + 512]; qr_[i] = base_[(size_t)i * 2048]; vr_[i] = base_[(size_t)i * 2048 + 1024]; } \
  } while (0)
  H1_LOAD((int)blockIdx.x);
  for (int item = blockIdx.x; item < 2048; item += G) {
    const int bh = item >> 6, chunk = item & 63;
    const int b = bh >> 2, h = bh & 3;
    const float lbv = lbp[h * 128 + d];
    const size_t row0 = (size_t)b * SEQL + chunk * 64;
    float* dec = (float*)(ws + WS_DEC) + (size_t)item * 384;
    uint4* UU = (uint4*)p.out + (size_t)item * 2048 + tid;
    float4* OI = (float4*)((unsigned char*)p.out + ((size_t)64 << 20)) + (size_t)item * 2048 + tid;
    {
      unsigned vv[8];
#pragma unroll
      for (int i = 0; i < 8; ++i) vv[i] = (unsigned)vr_[2 * i] | ((unsigned)vr_[2 * i + 1] << 16);
      float lf[16], kk[16], qs[16];
      float run = 0.f;
#pragma unroll
      for (int i = 0; i < 16; ++i) {
        const float sg = sigmoidf_(bf2f(fr_[i]));
        const float fg = lbv + (1.f - lbv) * sg;
        run += __logf(fg);
        lf[i] = run; kk[i] = 1.f - fg; qs[i] = siluf_(bf2f(qr_[i]));
      }
      qtot[tq * 128 + d] = run;
      __syncthreads();
      { const int nit = (item + G < 2048) ? item + G : item; H1_LOAD(nit); }
      const float q0 = qtot[d], q1 = qtot[128 + d], q2 = qtot[256 + d], q3 = qtot[384 + d];
      const float pre = (tq > 0 ? q0 : 0.f) + (tq > 1 ? q1 : 0.f) + (tq > 2 ? q2 : 0.f);
      const float bref = q0 + q1;
      const float blast = bref + q2 + q3;
      unsigned kp[8];
#pragma unroll
      for (int i = 0; i < 16; ++i) {
        const float bt = pre + lf[i];
        const float qt = qs[i] * __expf(bt - bref);
        const float kt = kk[i] * __expf(bref - bt);
        const int t = tq * 16 + i;
        Qt[t * 136 + d] = f2bf(qt);
        const bf16_t kb = f2bf(kt);
        Kt[t * 136 + d] = kb;
        if (i & 1) kp[i >> 1] |= ((unsigned)kb) << 16; else kp[i >> 1] = kb;
      }
      *(uint4*)(KtT + d * 72 + tq * 16) = make_uint4(kp[0], kp[1], kp[2], kp[3]);
      *(uint4*)(KtT + d * 72 + tq * 16 + 8) = make_uint4(kp[4], kp[5], kp[6], kp[7]);
      *(uint4*)(VT + d * 72 + tq * 16) = make_uint4(vv[0], vv[1], vv[2], vv[3]);
      *(uint4*)(VT + d * 72 + tq * 16 + 8) = make_uint4(vv[4], vv[5], vv[6], vv[7]);
      if (tq == 0) { dec[d] = __expf(bref); dec[128 + d] = __expf(blast); dec[256 + d] = __expf(blast - bref); }
    }
    __syncthreads();
    {
  #pragma unroll
      for (int i = 0; i < 2; ++i) {
        const int idx = tid + 512 * i, r = idx >> 4, c = idx & 15;
        *(uint4*)(pH + (row0 + r) * 2048 + h * 128 + c * 8) = *(const uint4*)(Qt + r * 136 + c * 8);
      }
  #pragma unroll
      for (int tt = 0; tt < 2; ++tt) {
        const int tl = 2 * w + tt, sm = tl >> 2, tn = tl & 3;
        f32x4 acc = (f32x4){0.f, 0.f, 0.f, 0.f};
        if (tn >= sm) {
  #pragma unroll
          for (int k0 = 0; k0 < 128; k0 += 32) {
            const bf16x8 a = *(const bf16x8*)(Kt + (sm * 16 + l15) * 136 + k0 + 8 * g);
            const bf16x8 bq = *(const bf16x8*)(Qt + (tn * 16 + l15) * 136 + k0 + 8 * g);
            acc = __builtin_amdgcn_mfma_f32_16x16x32_bf16(a, bq, acc, 0, 0, 0);
          }
        }
        const int t = tn * 16 + l15, s0 = sm * 16 + 4 * g;
        uint2 o;
        o.x = pack2(s0 + 0 <= t ? acc[0] : 0.f, s0 + 1 <= t ? acc[1] : 0.f);
        o.y = pack2(s0 + 2 <= t ? acc[2] : 0.f, s0 + 3 <= t ? acc[3] : 0.f);
        *(uint2*)(Am + t * 72 + s0) = o;
      }
    }
    __syncthreads();
    {
  #pragma unroll
      for (int tm = 0; tm < 4; ++tm) {
        f32x4 acc = (f32x4){0.f, 0.f, 0.f, 0.f};
  #pragma unroll
        for (int k0 = 0; k0 < 64; k0 += 32) {
          const bf16x8 a = *(const bf16x8*)(Am + (tm * 16 + l15) * 72 + k0 + 8 * g);
          const bf16x8 bb = *(const bf16x8*)(VT + (16 * w + l15) * 72 + k0 + 8 * g);
          acc = __builtin_amdgcn_mfma_f32_16x16x32_bf16(a, bb, acc, 0, 0, 0);
        }
        OI[tm * 512] = make_float4(acc[0], acc[1], acc[2], acc[3]);
      }
  #pragma unroll
      for (int dp = 0; dp < 4; ++dp) {
        unsigned pk[4];
  #pragma unroll
        for (int hh = 0; hh < 2; ++hh) {
          const int dm = dp * 2 + hh;
          f32x4 acc = (f32x4){0.f, 0.f, 0.f, 0.f};
  #pragma unroll
          for (int k0 = 0; k0 < 64; k0 += 32) {
            const bf16x8 a = *(const bf16x8*)(KtT + (dm * 16 + l15) * 72 + k0 + 8 * g);
            const bf16x8 bb = *(const bf16x8*)(VT + (16 * w + l15) * 72 + k0 + 8 * g);
            acc = __builtin_amdgcn_mfma_f32_16x16x32_bf16(a, bb, acc, 0, 0, 0);
          }
          pk[hh * 2] = pack2(acc[0], acc[1]); pk[hh * 2 + 1] = pack2(acc[2], acc[3]);
        }
        UU[dp * 512] = make_uint4(pk[0], pk[1], pk[2], pk[3]);
      }
    }
    __syncthreads();
  }
#undef H1_LOAD
}

__device__ __forceinline__ void hgrn_h2(const Params& p, unsigned char* smem, int bh) {
  unsigned char* ws = p.ws;
  const bf16_t* pH = (const bf16_t*)(ws + WS_PH);
  bf16_t* ya = (bf16_t*)(ws + WS_XN);
  bf16_t* Qt = (bf16_t*)smem;
  bf16_t* ST = Qt + 64 * 136;
  float* decl = (float*)(ST + 128 * 136);
  float* red = decl + 384;
  const int tid = threadIdx.x, lane = tid & 63, w = tid >> 6, l15 = lane & 15, g = lane >> 4;
  const int b = bh >> 2, h = bh & 3;
  f32x4 S[8];
#pragma unroll
  for (int i = 0; i < 8; ++i) S[i] = (f32x4){0.f, 0.f, 0.f, 0.f};
  const float gnv = p.hg_norm[h * 128 + 16 * w + l15];
  const int e = 16 * w + l15;
  uint4 uu0, uu1, uu2, uu3; float4 oi0, oi1, oi2, oi3; uint4 qraw0, qraw1; bf16_t ogr[16]; float dcv = 0.f;
#define H2_LOAD(CH) do { \
    const int item_ = bh * 64 + (CH); \
    const size_t row0_ = (size_t)b * SEQL + (size_t)(CH) * 64; \
    const uint4* UUp = (const uint4*)p.out + (size_t)item_ * 2048 + tid; \
    const float4* OIp = (const float4*)((const unsigned char*)p.out + ((size_t)64 << 20)) + (size_t)item_ * 2048 + tid; \
    uu0 = UUp[0]; uu1 = UUp[512]; uu2 = UUp[1024]; uu3 = UUp[1536]; oi0 = OIp[0]; oi1 = OIp[512]; oi2 = OIp[1024]; oi3 = OIp[1536]; \
    qraw0 = *(const uint4*)(pH + (row0_ + (tid >> 4)) * 2048 + h * 128 + (tid & 15) * 8); \
    qraw1 = *(const uint4*)(pH + (row0_ + 32 + (tid >> 4)) * 2048 + h * 128 + (tid & 15) * 8); \
    _Pragma("unroll") for (int tm = 0; tm < 4; ++tm) _Pragma("unroll") for (int j = 0; j < 4; ++j) \
      ogr[tm * 4 + j] = pH[(row0_ + tm * 16 + 4 * g + j) * 2048 + 1536 + h * 128 + e]; \
    if (tid < 384) dcv = ((const float*)(ws + WS_DEC))[(size_t)item_ * 384 + tid]; \
  } while (0)
  H2_LOAD(0);
  for (int chunk = 0; chunk < 64; ++chunk) {
    const size_t row0 = (size_t)b * SEQL + chunk * 64;
    const uint4 cu[4] = {uu0, uu1, uu2, uu3}; const float4 co[4] = {oi0, oi1, oi2, oi3}; bf16_t cog[16];
#pragma unroll
    for (int i = 0; i < 16; ++i) cog[i] = ogr[i];
    *(uint4*)(Qt + (tid >> 4) * 136 + (tid & 15) * 8) = qraw0;
    *(uint4*)(Qt + (32 + (tid >> 4)) * 136 + (tid & 15) * 8) = qraw1;
    if (tid < 384) decl[tid] = dcv;
    __syncthreads();
    if (chunk + 1 < 64) H2_LOAD(chunk + 1);
#pragma unroll
    for (int dm = 0; dm < 8; ++dm) {
      const int d0 = 16 * dm + 4 * g;
      uint2 o;
      o.x = pack2(S[dm][0] * decl[d0], S[dm][1] * decl[d0 + 1]);
      o.y = pack2(S[dm][2] * decl[d0 + 2], S[dm][3] * decl[d0 + 3]);
      *(uint2*)(ST + e * 136 + d0) = o;
    }
    __syncthreads();
    f32x4 o[4];
#pragma unroll
    for (int tm = 0; tm < 4; ++tm) {
      f32x4 acc = (f32x4){co[tm].x, co[tm].y, co[tm].z, co[tm].w};
#pragma unroll
      for (int k0 = 0; k0 < 128; k0 += 32) {
        const bf16x8 a = *(const bf16x8*)(Qt + (tm * 16 + l15) * 136 + k0 + 8 * g);
        const bf16x8 bb = *(const bf16x8*)(ST + (16 * w + l15) * 136 + k0 + 8 * g);
        acc = __builtin_amdgcn_mfma_f32_16x16x32_bf16(a, bb, acc, 0, 0, 0);
      }
      o[tm] = acc;
#pragma unroll
      for (int j = 0; j < 4; ++j) {
        float ss = acc[j] * acc[j];
        ss += __int_as_float(__builtin_amdgcn_update_dpp(0, __float_as_int(ss), 0xB1, 0xf, 0xf, true));
        ss += __int_as_float(__builtin_amdgcn_update_dpp(0, __float_as_int(ss), 0x4E, 0xf, 0xf, true));
        ss += __int_as_float(__builtin_amdgcn_update_dpp(0, __float_as_int(ss), 0x141, 0xf, 0xf, true));
        ss += __int_as_float(__builtin_amdgcn_update_dpp(0, __float_as_int(ss), 0x140, 0xf, 0xf, true));
        if (l15 == 0) red[w * 64 + tm * 16 + 4 * g + j] = ss;
      }
    }
#pragma unroll
    for (int dm = 0; dm < 8; ++dm) {
      const unsigned u01 = (dm & 1) ? cu[dm >> 1].z : cu[dm >> 1].x, u23 = (dm & 1) ? cu[dm >> 1].w : cu[dm >> 1].y;
      const float uv[4] = {__uint_as_float(u01 << 16), __uint_as_float(u01 & 0xffff0000u), __uint_as_float(u23 << 16), __uint_as_float(u23 & 0xffff0000u)};
#pragma unroll
      for (int j = 0; j < 4; ++j) { const int dd = 16 * dm + 4 * g + j; S[dm][j] = decl[128 + dd] * S[dm][j] + decl[256 + dd] * uv[j]; }
    }
    __syncthreads();
    if (tid < 64) {
      float tot = 0.f;
#pragma unroll
      for (int ww = 0; ww < 8; ++ww) tot += red[ww * 64 + tid];
      red[512 + tid] = rsqrtf(tot * (1.f / 128.f) + EPSV);
    }
    __syncthreads();
#pragma unroll
    for (int tm = 0; tm < 4; ++tm)
#pragma unroll
      for (int j = 0; j < 4; ++j) {
        const int t = tm * 16 + 4 * g + j;
        const float rstd = red[512 + t];
        ya[(row0 + t) * 512 + h * 128 + e] = f2bf(o[tm][j] * rstd * gnv * siluf_(bf2f(cog[tm * 4 + j])));
      }
  }
#undef H2_LOAD
}

__device__ __forceinline__ int team_index(const Params& p, unsigned char* smem) {
  int* sh = (int*)(smem + 8192);
  const int G = gridDim.x, tid = threadIdx.x;
  const int* tab = (const int*)(p.ws + WS_XCC);
  if (tid < 32) sh[tid] = 0;
  __syncthreads();
  const int mine = tab[blockIdx.x] & 15;
  for (int b = tid; b < G; b += NTHREADS) {
    const int x = tab[b] & 15;
    atomicAdd(&sh[x], 1);
    if (x == mine && b < (int)blockIdx.x) atomicAdd(&sh[16], 1);
  }
  __syncthreads();
  if (tid == 0) {
    int pre = 0;
    for (int j = 0; j < mine; ++j) pre += sh[j];
    sh[17] = pre + sh[16];
  }
  __syncthreads();
  const int r = sh[17];
  __syncthreads();
  return r;
}

#define SCW 4100
#ifndef DSA_REP
#define DSA_REP 0
#endif
#define DSA_BKT_OFF (8 * SCW * 4 + 8 * 256 * 4 + 8 * 256 * 2 + 8 * 512 * 2)
__device__ __forceinline__ void cvt8(const uint4& v, float* f) {
  f[0] = __uint_as_float(v.x << 16); f[1] = __uint_as_float(v.x & 0xffff0000u);
  f[2] = __uint_as_float(v.y << 16); f[3] = __uint_as_float(v.y & 0xffff0000u);
  f[4] = __uint_as_float(v.z << 16); f[5] = __uint_as_float(v.z & 0xffff0000u);
  f[6] = __uint_as_float(v.w << 16); f[7] = __uint_as_float(v.w & 0xffff0000u);
}
__device__ __forceinline__ unsigned sortable_key(float v) {
  unsigned bits = __float_as_uint(v);
  if (bits == 0x80000000u) bits = 0u;
  return (bits & 0x80000000u) ? ~bits : (bits | 0x80000000u);
}

__device__ __forceinline__ void dsa_item(const Params& p, unsigned char* smem, int item) {
  unsigned char* ws = p.ws;
  const bf16_t* pA = (const bf16_t*)(ws + WS_PA);
  const bf16_t* kc = (const bf16_t*)(ws + WS_KC);
  const bf16_t* vc = (const bf16_t*)(ws + WS_VC);
  const bf16_t* ikc = (const bf16_t*)(ws + WS_IKC);
  bf16_t* yb = (bf16_t*)(ws + WS_XN) + (size_t)TOK * 512;
  unsigned* sc = (unsigned*)smem;
  unsigned* hist = sc + 8 * SCW;
  unsigned short* sel = (unsigned short*)(hist + 8 * 256);
  unsigned short* cand = sel + 8 * 256;
  unsigned char* bkt = (unsigned char*)(cand + 8 * 512);
  unsigned* rmm = (unsigned*)(bkt + 128 + 1024);
  const int tid = threadIdx.x, lane = tid & 63, w = tid >> 6, l15 = lane & 15, g = lane >> 4;
  const int b = item >> 9;
  const int tb = item & 511;
  const int t0 = tb * 8;
  const size_t tokbase = (size_t)b * SEQL;

  for (int rep_s = 0; rep_s < (DSA_REP == 1 ? 2 : 1); ++rep_s) {
    bf16x8 af[2][2];
    float wq[2][4];
#pragma unroll
    for (int mt = 0; mt < 2; ++mt) {
      const int qrow = t0 + mt * 4 + (l15 >> 2), head = l15 & 3;
#pragma unroll
      for (int ks = 0; ks < 2; ++ks)
        af[mt][ks] = *(const bf16x8*)(pA + (tokbase + qrow) * 1024 + 640 + head * 64 + ks * 32 + 8 * g);
      const uint2 wr = *(const uint2*)(pA + (tokbase + t0 + mt * 4 + g) * 1024 + 960);
      wq[mt][0] = 0.5f * bf2f((bf16_t)(wr.x & 0xffff)); wq[mt][1] = 0.5f * bf2f((bf16_t)(wr.x >> 16));
      wq[mt][2] = 0.5f * bf2f((bf16_t)(wr.y & 0xffff)); wq[mt][3] = 0.5f * bf2f((bf16_t)(wr.y >> 16));
    }
    const int nkt = (t0 + 8 + 15) >> 4;
    unsigned kmin[2] = {0xFFFFFFFFu, 0xFFFFFFFFu}, kmax[2] = {0u, 0u};
    for (int kt0 = w; kt0 < nkt; kt0 += 64) {
      bf16x8 b0[8], b1[8];
#pragma unroll
      for (int u = 0; u < 8; ++u) {
        const int kt = kt0 + 8 * u;
        const int s = (kt < nkt ? kt : 0) * 16 + l15;
        const bf16_t* kr = ikc + (tokbase + s) * 64 + 8 * g;
        b0[u] = *(const bf16x8*)kr;
        b1[u] = *(const bf16x8*)(kr + 32);
      }
      __builtin_amdgcn_sched_barrier(0);
      f32x4 sacc[8][2];
#pragma unroll
      for (int u = 0; u < 8; ++u)
#pragma unroll
        for (int mt = 0; mt < 2; ++mt) {
          f32x4 acc = (f32x4){0.f, 0.f, 0.f, 0.f};
          acc = __builtin_amdgcn_mfma_f32_16x16x32_bf16(af[mt][0], b0[u], acc, 0, 0, 0);
          sacc[u][mt] = __builtin_amdgcn_mfma_f32_16x16x32_bf16(af[mt][1], b1[u], acc, 0, 0, 0);
        }
#pragma unroll
      for (int u = 0; u < 8; ++u) {
        const int kt = kt0 + 8 * u;
        if (kt < nkt) {
          const int s = kt * 16 + l15;
#pragma unroll
          for (int mt = 0; mt < 2; ++mt) {
            float v = 0.f;
#pragma unroll
            for (int j = 0; j < 4; ++j) v += wq[mt][j] * fmaxf(sacc[u][mt][j] * 0.125f, 0.f);
            const int t = t0 + mt * 4 + g;
            unsigned vb = __float_as_uint(v); if (vb == 0x80000000u) vb = 0u;
            sc[(mt * 4 + g) * SCW + s] = vb;
            if (s <= t) {
              const unsigned key = (vb & 0x80000000u) ? ~vb : (vb | 0x80000000u);
              kmin[mt] = key < kmin[mt] ? key : kmin[mt];
              kmax[mt] = key > kmax[mt] ? key : kmax[mt];
            }
          }
        }
      }
    }
#pragma unroll
    for (int mt = 0; mt < 2; ++mt) {
      unsigned a = kmin[mt], bmx = kmax[mt];
#define DPP_MINMAX(CTRL) do { const unsigned a2 = (unsigned)__builtin_amdgcn_update_dpp((int)a, (int)a, CTRL, 0xf, 0xf, false); \
                               const unsigned b2 = (unsigned)__builtin_amdgcn_update_dpp((int)bmx, (int)bmx, CTRL, 0xf, 0xf, false); \
                               a = a2 < a ? a2 : a; bmx = b2 > bmx ? b2 : bmx; } while (0)
      DPP_MINMAX(0xB1); DPP_MINMAX(0x4E); DPP_MINMAX(0x141); DPP_MINMAX(0x140);
#undef DPP_MINMAX
      if (l15 == 0) { atomicMin(&rmm[mt * 4 + g], a); atomicMax(&rmm[8 + mt * 4 + g], bmx); }
    }
  }
  __syncthreads();
  const int t = t0 + w;
  const int n = t + 1;
  unsigned* row = sc + w * SCW;
  const float* rowf = (const float*)row;
  unsigned short* mysel = sel + w * 256;
  unsigned short* mycand = cand + w * 512;
  unsigned* myh = hist + w * 256;
  int cnt;
  const unsigned long long lt_mask = (1ull << lane) - 1ull;
  for (int rep_t = 0; rep_t < (DSA_REP == 2 ? 2 : 1); ++rep_t)
  if (n <= 256) {
    for (int i = lane; i < n; i += 64) mysel[i] = (unsigned short)i;
    cnt = n;
  } else {
    cnt = 256;
    float mn, mx;
    {
      const unsigned kmn = rmm[w], kmx = rmm[8 + w];
      mn = __uint_as_float((kmn & 0x80000000u) ? (kmn ^ 0x80000000u) : ~kmn);
      mx = __uint_as_float((kmx & 0x80000000u) ? (kmx ^ 0x80000000u) : ~kmx);
    }
    const float scale = (mx > mn) ? 255.99f / (mx - mn) : 0.f;
#pragma unroll
    for (int i = 0; i < 4; ++i) myh[lane + 64 * i] = 0u;
    lds_fence();
    for (int i0 = lane; i0 < n; i0 += 256) {
      float v4[4];
#pragma unroll
      for (int k = 0; k < 4; ++k) v4[k] = (i0 + 64 * k < n) ? rowf[i0 + 64 * k] : 0.f;
#pragma unroll
      for (int k = 0; k < 4; ++k) {
        if (i0 + 64 * k < n) {
          int bn = (int)((v4[k] - mn) * scale); bn = bn > 255 ? 255 : bn;
          atomicAdd(&myh[bn], 1u);
        }
      }
    }
    lds_fence();
    unsigned cum; int bstar; unsigned mcount;
    {
      const uint4 c4 = *(const uint4*)(myh + 4 * lane);
      const unsigned c = c4.x + c4.y + c4.z + c4.w;
      unsigned sfx = c;
#pragma unroll
      for (int o = 1; o < 64; o <<= 1) { const unsigned tt = __shfl_down(sfx, o); if (lane + o < 64) sfx += tt; }
      const unsigned long long bal = __ballot(sfx >= 256u);
      const int L = 63 - __clzll(bal);
      const unsigned sL = __shfl(sfx, L), cL = __shfl(c, L);
      const unsigned b3 = __shfl(c4.w, L), b2 = __shfl(c4.z, L), b1 = __shfl(c4.y, L), b0 = __shfl(c4.x, L);
      cum = sL - cL;
      int digit;
      if (cum + b3 >= 256u) { digit = 3; mcount = b3; }
      else { cum += b3; if (cum + b2 >= 256u) { digit = 2; mcount = b2; } else { cum += b2; if (cum + b1 >= 256u) { digit = 1; mcount = b1; } else { cum += b1; digit = 0; mcount = b0; } } }
      bstar = 4 * L + digit;
    }
    const unsigned need = 256u - cum;
    if (mcount <= 512u) {
      unsigned base = 0u, cb = 0u;
      for (int i0 = 0; i0 < n; i0 += 256) {
        float v4[4];
#pragma unroll
        for (int k = 0; k < 4; ++k) { const int i = i0 + 64 * k + lane; v4[k] = (i < n) ? rowf[i] : 0.f; }
#pragma unroll
        for (int k = 0; k < 4; ++k) {
          const int i = i0 + 64 * k + lane;
          const bool valid = i < n;
          int bn = (int)((v4[k] - mn) * scale); bn = bn > 255 ? 255 : bn;
          const bool gt = valid && (bn > bstar);
          const bool eq = valid && (bn == bstar);
          const unsigned long long bg = __ballot(gt), be = __ballot(eq);
          if (gt) mysel[base + (unsigned)__popcll(bg & lt_mask)] = (unsigned short)i;
          if (eq) mycand[cb + (unsigned)__popcll(be & lt_mask)] = (unsigned short)i;
          base += (unsigned)__popcll(bg); cb += (unsigned)__popcll(be);
        }
      }
      lds_fence();
      const int m = (int)mcount;
      unsigned ck[8]; unsigned short ci[8];
#pragma unroll
      for (int q = 0; q < 8; ++q) {
        const int c = q * 64 + lane;
        ck[q] = 0u; ci[q] = 0;
        if (c < m) { ci[q] = mycand[c]; ck[q] = sortable_key(rowf[ci[q]]); }
      }
      unsigned T = 0u;
      if (m <= 64) {
#pragma unroll 1
        for (int bit = 31; bit >= 0; --bit) {
          const unsigned trial = T | (1u << bit);
          if ((unsigned)__popcll(__ballot(ck[0] >= trial)) >= need) T = trial;
        }
      } else {
#pragma unroll 1
        for (int bit = 31; bit >= 0; --bit) {
          const unsigned trial = T | (1u << bit);
          unsigned cge = 0u;
#pragma unroll
          for (int q = 0; q < 8; ++q) cge += (unsigned)__popcll(__ballot(ck[q] >= trial));
          if (cge >= need) T = trial;
        }
      }
      unsigned cgt = 0u;
#pragma unroll
      for (int q = 0; q < 8; ++q) cgt += (unsigned)__popcll(__ballot(ck[q] > T));
      const unsigned need_eq = need - cgt;
      unsigned pos0 = cum, eqtaken = 0u;
#pragma unroll
      for (int q = 0; q < 8; ++q) {
        const bool gt = ck[q] > T;
        const bool eq = ck[q] == T;
        const unsigned long long beq = __ballot(eq);
        const bool take = gt || (eq && (eqtaken + (unsigned)__popcll(beq & lt_mask)) < need_eq);
        const unsigned long long bt = __ballot(take);
        const unsigned pp = pos0 + (unsigned)__popcll(bt & lt_mask);
        if (take && pp < 256u) mysel[pp] = ci[q];
        pos0 += (unsigned)__popcll(bt);
        eqtaken += (unsigned)__popcll(beq);
      }
    } else {
      unsigned prefix = 0u, krem = 256u;
#pragma unroll 1
      for (int pass = 0; pass < 4; ++pass) {
        const int shift = 24 - 8 * pass;
        const unsigned himask = (pass == 0) ? 0u : (0xFFFFFFFFu << (shift + 8));
#pragma unroll
        for (int i = 0; i < 4; ++i) myh[lane + 64 * i] = 0u;
        lds_fence();
        for (int i = lane; i < n; i += 64) {
          const unsigned u = sortable_key(rowf[i]);
          if ((u & himask) == prefix) atomicAdd(&myh[(u >> shift) & 255u], 1u);
        }
        lds_fence();
        const uint4 c4 = *(const uint4*)(myh + 4 * lane);
        const unsigned c = c4.x + c4.y + c4.z + c4.w;
        unsigned sfx = c;
#pragma unroll
        for (int o = 1; o < 64; o <<= 1) { const unsigned tt = __shfl_down(sfx, o); if (lane + o < 64) sfx += tt; }
        const unsigned long long bal = __ballot(sfx >= krem);
        const int L = 63 - __clzll(bal);
        const unsigned sL = __shfl(sfx, L), cL = __shfl(c, L);
        const unsigned b3 = __shfl(c4.w, L), b2 = __shfl(c4.z, L), b1 = __shfl(c4.y, L);
        unsigned cum2 = sL - cL;
        unsigned digit;
        if (cum2 + b3 >= krem) digit = 3;
        else { cum2 += b3; if (cum2 + b2 >= krem) digit = 2; else { cum2 += b2; if (cum2 + b1 >= krem) digit = 1; else { cum2 += b1; digit = 0; } } }
        krem -= cum2;
        prefix |= ((unsigned)(4 * L) + digit) << shift;
      }
      const unsigned T = prefix;
      unsigned base = 0u, eqtaken = 0u;
      for (int i0 = 0; i0 < n; i0 += 64) {
        const int i = i0 + lane;
        const bool valid = i < n;
        const unsigned u = valid ? sortable_key(rowf[i]) : 0u;
        const bool gt = valid && (u > T);
        const bool eq = valid && (u == T);
        const unsigned long long beq = __ballot(eq);
        const unsigned eqrank = eqtaken + (unsigned)__popcll(beq & lt_mask);
        const bool take = gt || (eq && eqrank < krem);
        const unsigned long long bt = __ballot(take);
        const unsigned pos = base + (unsigned)__popcll(bt & lt_mask);
        if (take && pos < 256u) mysel[pos] = (unsigned short)i;
        base += (unsigned)__popcll(bt);
        eqtaken += (unsigned)__popcll(beq);
      }
    }
  }
  lds_fence();
  if (lane == 0) { rmm[w] = 0xFFFFFFFFu; rmm[8 + w] = 0u; }
  {
    int lane_a = lane;
    asm volatile("" : "+v"(lane_a));
    const int l15 = lane_a & 15, g = lane_a >> 4;
    const int ks = lane_a >> 3, dc = lane_a & 7;
    float* pl = (float*)row;
    const float* relb = (const float*)(bkt + 128);
    const int niter = (cnt + 7) >> 3;
    bf16x8 bq0 = (bf16x8){0, 0, 0, 0, 0, 0, 0, 0}, bq1 = bq0;
    if (l15 < 8) {
      bq0 = *(const bf16x8*)(pA + (tokbase + t) * 1024 + l15 * 64 + 8 * g);
      bq1 = *(const bf16x8*)(pA + (tokbase + t) * 1024 + l15 * 64 + 32 + 8 * g);
    }
    float lg[16][4];
    {
      bf16x8 ka[8][2], kb[8][2];
#pragma unroll
      for (int u = 0; u < 8; ++u) {
        const int kk = u * 16 + l15;
        const int s = (kk < cnt) ? (int)mysel[kk] : 0;
        const bf16_t* kr = kc + (tokbase + s) * 64 + 8 * g;
        ka[u][0] = *(const bf16x8*)kr;
        ka[u][1] = *(const bf16x8*)(kr + 32);
      }
#pragma unroll
      for (int u = 0; u < 8; ++u) {
        const int kk = (8 + u) * 16 + l15;
        const int s = (kk < cnt) ? (int)mysel[kk] : 0;
        const bf16_t* kr = kc + (tokbase + s) * 64 + 8 * g;
        kb[u][0] = *(const bf16x8*)kr;
        kb[u][1] = *(const bf16x8*)(kr + 32);
      }
      __builtin_amdgcn_sched_barrier(0);
#pragma unroll
      for (int u = 0; u < 8; ++u) {
        f32x4 acc = (f32x4){0.f, 0.f, 0.f, 0.f};
        acc = __builtin_amdgcn_mfma_f32_16x16x32_bf16(ka[u][0], bq0, acc, 0, 0, 0);
        acc = __builtin_amdgcn_mfma_f32_16x16x32_bf16(ka[u][1], bq1, acc, 0, 0, 0);
        lg[u][0] = acc[0]; lg[u][1] = acc[1]; lg[u][2] = acc[2]; lg[u][3] = acc[3];
      }
#pragma unroll
      for (int u = 0; u < 8; ++u) {
        f32x4 acc = (f32x4){0.f, 0.f, 0.f, 0.f};
        acc = __builtin_amdgcn_mfma_f32_16x16x32_bf16(kb[u][0], bq0, acc, 0, 0, 0);
        acc = __builtin_amdgcn_mfma_f32_16x16x32_bf16(kb[u][1], bq1, acc, 0, 0, 0);
        lg[8 + u][0] = acc[0]; lg[8 + u][1] = acc[1]; lg[8 + u][2] = acc[2]; lg[8 + u][3] = acc[3];
      }
    }
    typedef unsigned u32x4_t __attribute__((ext_vector_type(4)));
    u32x4_t va[16];
#pragma unroll
    for (int u = 0; u < 16; ++u) {
      const int kk = u * 8 + ks;
      const int s = (kk < cnt) ? (int)mysel[kk] : 0;
      va[u] = *(const u32x4_t*)(vc + (tokbase + s) * 64 + dc * 8);
    }
    __builtin_amdgcn_sched_barrier(0);
    const int hsel = l15 & 7;
    float m = -INFINITY;
#pragma unroll
    for (int u = 0; u < 16; ++u) {
      const uint2 s4 = *(const uint2*)(mysel + u * 16 + 4 * g);
      const int sj[4] = {(int)(s4.x & 0xffffu), (int)(s4.x >> 16), (int)(s4.y & 0xffffu), (int)(s4.y >> 16)};
#pragma unroll
      for (int j = 0; j < 4; ++j) {
        const int key = u * 16 + 4 * g + j;
        const bool valid = key < cnt;
        const int dist = valid ? t - sj[j] : 0;
        const int bk = dist < 128 ? (int)bkt[dist] : 31;
        lg[u][j] = valid ? (lg[u][j] * 0.125f + relb[bk * 8 + hsel]) : -INFINITY;
        m = fmaxf(m, lg[u][j]);
      }
    }
    m = max_xor16(m); m = max_xor32(m);
    float sum = 0.f;
#pragma unroll
    for (int u = 0; u < 16; ++u)
#pragma unroll
      for (int j = 0; j < 4; ++j) { lg[u][j] = __expf(lg[u][j] - m); sum += lg[u][j]; }
    sum = add_xor16(sum); sum = add_xor32(sum);
    const float inv = 1.f / sum;
    bf16x8 pa[8];
#pragma unroll
    for (int s8 = 0; s8 < 8; ++s8) {
      const unsigned w0 = pack2(lg[2 * s8][0] * inv, lg[2 * s8][1] * inv), w1 = pack2(lg[2 * s8][2] * inv, lg[2 * s8][3] * inv);
      const unsigned w2 = pack2(lg[2 * s8 + 1][0] * inv, lg[2 * s8 + 1][1] * inv), w3 = pack2(lg[2 * s8 + 1][2] * inv, lg[2 * s8 + 1][3] * inv);
      const u32x4_t wv = {w0, w1, w2, w3};
      pa[s8] = __builtin_bit_cast(bf16x8, wv);
    }
    unsigned char* vs_l = (unsigned char*)row;
#pragma unroll
    for (int u = 0; u < 16; ++u) *(u32x4_t*)(vs_l + (u * 8 + ks) * 128 + dc * 16) = va[u];
    lds_fence();
    u32x4_t vb[16];
#pragma unroll
    for (int u = 0; u < 16; ++u) {
      const int kk = (16 + u) * 8 + ks;
      const int s = (kk < cnt) ? (int)mysel[kk] : 0;
      vb[u] = *(const u32x4_t*)(vc + (tokbase + s) * 64 + dc * 8);
    }
    __builtin_amdgcn_sched_barrier(0);
    f32x4 ov[4];
#pragma unroll
    for (int nt = 0; nt < 4; ++nt) ov[nt] = (f32x4){0.f, 0.f, 0.f, 0.f};
    typedef short v4s_t __attribute__((ext_vector_type(4)));
    const unsigned tr_lane = (unsigned)((l15 >> 2) * 128 + (l15 & 3) * 8);
#define PV_HALF(S0) do { \
      _Pragma("unroll") for (int s4_ = 0; s4_ < 4; ++s4_) { \
        _Pragma("unroll") for (int nt = 0; nt < 4; ++nt) { \
          const unsigned a0 = (unsigned)((s4_ * 32 + 4 * g) * 128 + nt * 32) + tr_lane; \
          const v4s_t b0 = __builtin_amdgcn_ds_read_tr16_b64_v4i16((__attribute__((address_space(3))) v4s_t*)(vs_l + a0)); \
          const v4s_t b1 = __builtin_amdgcn_ds_read_tr16_b64_v4i16((__attribute__((address_space(3))) v4s_t*)(vs_l + a0 + 16 * 128)); \
          const bf16x8 bb = (bf16x8){b0[0], b0[1], b0[2], b0[3], b1[0], b1[1], b1[2], b1[3]}; \
          ov[nt] = __builtin_amdgcn_mfma_f32_16x16x32_bf16(pa[(S0) + s4_], bb, ov[nt], 0, 0, 0); \
        } \
      } \
    } while (0)
    PV_HALF(0);
    lds_fence();
#pragma unroll
    for (int u = 0; u < 16; ++u) *(u32x4_t*)(vs_l + (u * 8 + ks) * 128 + dc * 16) = vb[u];
    lds_fence();
    PV_HALF(4);
#undef PV_HALF
    if (g < 2) {
#pragma unroll
      for (int nt = 0; nt < 4; ++nt)
#pragma unroll
        for (int j = 0; j < 4; ++j) yb[(tokbase + t) * 512 + (4 * g + j) * 64 + nt * 16 + l15] = f2bf(ov[nt][j]);
    }
    lds_fence();
  }
  __syncthreads();
}

__device__ __forceinline__ void phase_mix(const Params& p, unsigned char* smem, int mode = 0) {
  const int G = gridDim.x;
  if (mode != 2) { for (int bh = blockIdx.x; bh < 32; bh += G) { hgrn_h2(p, smem, bh); __syncthreads(); } }
  if (mode == 1) return;
  unsigned char* bkt = smem + DSA_BKT_OFF;
  volatile int* qslot = (volatile int*)(smem + LDS_BYTES - 32);
  unsigned* qctr = (unsigned*)(p.ws + WS_QCTR);
  if (threadIdx.x < 128) {
    const int nn = threadIdx.x;
    int v = nn;
    if (nn >= 16) { v = 16 + (int)(logf((float)nn * (1.f / 16.f)) / logf(8.f) * 16.f); if (v > 31) v = 31; }
    bkt[nn] = (unsigned char)v;
  }
  if (threadIdx.x >= 256) ((float*)(bkt + 128))[threadIdx.x - 256] = p.rel_bias[threadIdx.x - 256];
  if (threadIdx.x < 16) ((unsigned*)(bkt + 128 + 1024))[threadIdx.x] = threadIdx.x < 8 ? 0xFFFFFFFFu : 0u;
  const int my_team = (G % 8 == 0) ? team_index(p, smem) / (G >> 3) : (int)(blockIdx.x & 7);
  constexpr int QN = 544;
#define Q_FETCH(SLOT) do { if (threadIdx.x == 0) { int tm_ = q_team, kk_ = -1; \
      for (int tries_ = 0; tries_ < 8; ++tries_) { \
        const unsigned v_ = __hip_atomic_fetch_add(qctr + 16 * tm_, 1u, __ATOMIC_RELAXED, __HIP_MEMORY_SCOPE_AGENT); \
        if (v_ < (unsigned)QN) { kk_ = (tm_ << 16) | (int)v_; break; } \
        tm_ = (tm_ + 1) & 7; } \
      q_team = tm_; qslot[SLOT] = kk_; } } while (0)
  int q_team = my_team;
  Q_FETCH(0);
  __syncthreads();
  int k = qslot[0];
  int par = 1;
  while (k >= 0) {
    Q_FETCH(par);
    const int bt = k >> 16, kl = k & 0xffff;
    const int kq = kl / 17, kr = kl - kq * 17;
    if (kr < 16) {
      const int tb = 511 - (kq * 16 + kr);
      dsa_item(p, smem, (bt << 9) | tb);
    } else {
      const int r0 = (bt * 32 + kq) * 64;
      quantize_rows_u8<false, true>(p.peer_u, p.ws + WS_U, (float*)(p.ws + WS_U + (size_t)16384 * 1024), r0, r0 + 64);
      quantize_rows_u8<true, false>(p.peer_v, p.ws + WS_V, (float*)(p.ws + WS_V + (size_t)16384 * 1024), r0, r0 + 64);
      __syncthreads();
    }
    k = qslot[par];
    par ^= 1;
  }
#undef Q_FETCH
}

__device__ __forceinline__ void phase_pkeys(const Params& p, unsigned char* smem) {
  unsigned char* ws = p.ws;
  const bf16_t* qp = (const bf16_t*)(ws + WS_PG);
  const bf16_t* keys = (const bf16_t*)(ws + WS_KEYS);
  int* eidx = (int*)(ws + WS_EIDX);
  float* gw = (float*)(ws + WS_GW);
  float* sc = (float*)smem;
  float* s2l = (float*)smem;
  unsigned short* i1l = (unsigned short*)(s2l + 256 * 17);
  unsigned short* i2l = i1l + 256 * 16;
  const int tid = threadIdx.x, lane = tid & 63, w = tid >> 6, wm = w >> 1, wn = w & 1, l15 = lane & 15, g = lane >> 4;
  for (int item = blockIdx.x; item < 128 * 8; item += gridDim.x) {
    const int h = item & 7, tm = item >> 3;
    float s1[16], s2v[16]; int i1[16], i2[16];
#pragma unroll
    for (int ph = 0; ph < 2; ++ph) {
      const int hp = h * 2 + ph;
      f32x4 acc[4][4]; zero_acc(acc);
      gemm_tile(qp + (size_t)tm * 256 * 2048 + hp * 128, 2048, keys + (size_t)(ph * 8 + h) * 128 * 128, 128, 2, acc, smem);
      __syncthreads();
#pragma unroll
      for (int m = 0; m < 4; ++m)
#pragma unroll
        for (int n = 0; n < 4; ++n)
#pragma unroll
          for (int j = 0; j < 4; ++j) sc[(wm * 64 + m * 16 + 4 * g + j) * 129 + wn * 64 + n * 16 + l15] = acc[m][n][j];
      __syncthreads();
      if (tid < 256) {
        const float* rowp = sc + tid * 129;
        unsigned tv[16];
#pragma unroll
        for (int k = 0; k < 16; ++k) tv[k] = 0u;
#pragma unroll 8
        for (int nn = 0; nn < 128; ++nn) {
          const unsigned bits = __float_as_uint(rowp[nn]);
          unsigned key = (bits & 0x80000000u) ? ~bits : (bits | 0x80000000u);
          key = (key & ~127u) | (unsigned)(127 - nn);
#pragma unroll
          for (int k = 15; k >= 1; --k) {
            unsigned r;
            asm("v_med3_u32 %0, %1, %2, %3" : "=v"(r) : "v"(tv[k]), "v"(tv[k - 1]), "v"(key));
            tv[k] = r;
          }
          tv[0] = tv[0] > key ? tv[0] : key;
        }
#pragma unroll
        for (int k = 0; k < 16; ++k) {
          const int col = 127 - (int)(tv[k] & 127u);
          const float val = rowp[col];
          if (ph == 0) { i1[k] = col; s1[k] = val; } else { i2[k] = col; s2v[k] = val; }
        }
      }
      __syncthreads();
    }
    if (tid < 256) {
#pragma unroll
      for (int a = 0; a < 16; ++a) { s2l[tid * 17 + a] = s2v[a]; i1l[tid * 16 + a] = (unsigned short)i1[a]; i2l[tid * 16 + a] = (unsigned short)i2[a]; }
      float cur[16];
#pragma unroll
      for (int a = 0; a < 16; ++a) cur[a] = s1[a] + s2v[0];
      unsigned long long ptr = 0ull;
      float tops[16]; int tope[16];
#pragma unroll
      for (int k = 0; k < 16; ++k) {
        float best = cur[0]; int ba = 0;
#pragma unroll
        for (int a = 1; a < 16; ++a) if (cur[a] > best) { best = cur[a]; ba = a; }
        const int bb = (int)((ptr >> (4 * ba)) & 15ull);
        tops[k] = best;
        tope[k] = (int)i1l[tid * 16 + ba] * 128 + (int)i2l[tid * 16 + bb];
        const int nb = bb + 1;
        const float ns2 = (nb < 16) ? s2l[tid * 17 + nb] : -INFINITY;
        if (nb < 16) ptr += (1ull << (4 * ba));
#pragma unroll
        for (int a = 0; a < 16; ++a) if (a == ba) cur[a] = s1[a] + ns2;
      }
      const float m = tops[0];
      float sum = 0.f;
#pragma unroll
      for (int k = 0; k < 16; ++k) { tops[k] = __expf(tops[k] - m); sum += tops[k]; }
      const float inv = 1.f / sum;
      const size_t ob = ((size_t)(tm * 256 + tid) * 8 + h) * 16;
#pragma unroll
      for (int k = 0; k < 16; k += 4) {
        *(int4*)(eidx + ob + k) = make_int4(tope[k], tope[k + 1], tope[k + 2], tope[k + 3]);
        *(float4*)(gw + ob + k) = make_float4(tops[k] * inv, tops[k + 1] * inv, tops[k + 2] * inv, tops[k + 3] * inv);
      }
    }
    __syncthreads();
  }
}


__device__ __forceinline__ float reduce8(const float (&pv)[8], int lane) {
  const bool b5 = lane & 32, b4 = lane & 16, b3 = lane & 8;
  float v[4];
#pragma unroll
  for (int i = 0; i < 4; ++i) {
    const float keep = b5 ? pv[4 + i] : pv[i];
    const float send = b5 ? pv[i] : pv[4 + i];
    v[i] = keep + __shfl_xor(send, 32);
  }
  float u[2];
#pragma unroll
  for (int i = 0; i < 2; ++i) {
    const float keep = b4 ? v[2 + i] : v[i];
    const float send = b4 ? v[i] : v[2 + i];
    u[i] = keep + __shfl_xor(send, 16);
  }
  float x = (b3 ? u[1] : u[0]) + __shfl_xor(b3 ? u[0] : u[1], 8);
  x += __shfl_xor(x, 4); x += __shfl_xor(x, 2); x += __shfl_xor(x, 1);
  return x;
}

__device__ __forceinline__ void cvt16u8(const uint4& v, float* f) {
  f[0] = (float)(v.x & 0xffu); f[1] = (float)((v.x >> 8) & 0xffu); f[2] = (float)((v.x >> 16) & 0xffu); f[3] = (float)(v.x >> 24);
  f[4] = (float)(v.y & 0xffu); f[5] = (float)((v.y >> 8) & 0xffu); f[6] = (float)((v.y >> 16) & 0xffu); f[7] = (float)(v.y >> 24);
  f[8] = (float)(v.z & 0xffu); f[9] = (float)((v.z >> 8) & 0xffu); f[10] = (float)((v.z >> 16) & 0xffu); f[11] = (float)(v.z >> 24);
  f[12] = (float)(v.w & 0xffu); f[13] = (float)((v.w >> 8) & 0xffu); f[14] = (float)((v.w >> 16) & 0xffu); f[15] = (float)(v.w >> 24);
}

__device__ __forceinline__ int wave_sum_i32_dpp(int v) {
  v += __builtin_amdgcn_update_dpp(0, v, 0xB1, 0xf, 0xf, true);
  v += __builtin_amdgcn_update_dpp(0, v, 0x4E, 0xf, 0xf, true);
  v += __builtin_amdgcn_update_dpp(0, v, 0x141, 0xf, 0xf, true);
  v += __builtin_amdgcn_update_dpp(0, v, 0x140, 0xf, 0xf, true);
  return __builtin_amdgcn_readlane(v, 0) + __builtin_amdgcn_readlane(v, 16) + __builtin_amdgcn_readlane(v, 32) + __builtin_amdgcn_readlane(v, 48);
}

__device__ __forceinline__ int reduce8_i32_scatter(const int (&d)[8], int lane) {
  const bool b0 = lane & 1, b1 = lane & 2, b2 = lane & 4;
  int v[4];
#pragma unroll
  for (int i = 0; i < 4; ++i) {
    const int keep = b0 ? d[2 * i + 1] : d[2 * i];
    const int send = b0 ? d[2 * i] : d[2 * i + 1];
    v[i] = keep + __builtin_amdgcn_update_dpp(0, send, 0xB1, 0xf, 0xf, true);
  }
  int u[2];
#pragma unroll
  for (int i = 0; i < 2; ++i) {
    const int keep = b1 ? v[2 * i + 1] : v[2 * i];
    const int send = b1 ? v[2 * i] : v[2 * i + 1];
    u[i] = keep + __builtin_amdgcn_update_dpp(0, send, 0x4E, 0xf, 0xf, true);
  }
  int x;
  {
    const int keep = b2 ? u[1] : u[0];
    const int send = b2 ? u[0] : u[1];
    int t = __builtin_amdgcn_update_dpp(0, send, 0x141, 0xf, 0xf, true);
    t = __builtin_amdgcn_update_dpp(0, t, 0x1B, 0xf, 0xf, true);
    x = keep + t;
  }
  x += __builtin_amdgcn_update_dpp(0, x, 0x128, 0xf, 0xf, true);
  { const auto r = __builtin_amdgcn_permlane16_swap((unsigned)x, (unsigned)x, false, false); x = (int)r[0] + (int)r[1]; }
  { const auto r = __builtin_amdgcn_permlane32_swap((unsigned)x, (unsigned)x, false, false); x = (int)r[0] + (int)r[1]; }
  return x;
}

__device__ __forceinline__ void phase_pu(const Params& p, unsigned char* smem) {
  unsigned char* ws = p.ws;
  const unsigned char* XQ = ws + WS_XQ;
  const float* xs = (const float*)(ws + WS_XS);
  const unsigned char* U8 = ws + WS_U;
  const float* us = (const float*)(ws + WS_U + (size_t)16384 * 1024);
  const float* vs = (const float*)(ws + WS_V + (size_t)16384 * 1024);
  const int* eidx = (const int*)(ws + WS_EIDX);
  const float* gw = (const float*)(ws + WS_GW);
  float* aw = (float*)(ws + WS_PA);
  const int lane = threadIdx.x & 63, w = threadIdx.x >> 6;
  const unsigned long long lt_mask = (1ull << lane) - 1ull;
  const int G = gridDim.x;
  const bool sliced = (G % 8 == 0);
  const int ti = sliced ? team_index(p, smem) : 0;
  const int tsz = sliced ? (G >> 3) : G;
  const int grp_lo = sliced ? ti / tsz : 0, grp_hi = sliced ? grp_lo + 1 : 8;
  const int slot = (sliced ? (ti % tsz) : (int)blockIdx.x) * 8 + w;
  const int nslot = tsz * 8;
  unsigned* lst = (unsigned*)smem + 4096 + w * 128;
  typedef unsigned u32x4_t __attribute__((ext_vector_type(4)));
  if (slot >= TOK) return;
  for (int grp = grp_lo; grp < grp_hi; ++grp) {
#define PU_LIST(E0, E1, N, L0, L1) do { \
      const bool m0_ = ((E0) >> 11) == grp, m1_ = ((E1) >> 11) == grp; \
      const unsigned long long b0_ = __ballot(m0_), b1_ = __ballot(m1_); \
      const int c0_ = __popcll(b0_); N = c0_ + __popcll(b1_); \
      if (m0_) lst[__popcll(b0_ & lt_mask)] = ((unsigned)lane << 14) | (unsigned)(E0); \
      if (m1_) lst[c0_ + __popcll(b1_ & lt_mask)] = ((unsigned)(lane + 64) << 14) | (unsigned)(E1); \
      lds_fence(); \
      L0 = (lane < N) ? lst[lane] : 0u; L1 = (lane + 64 < N) ? lst[lane + 64] : 0u; \
      lds_fence(); } while (0)
#define PU_ISSUE(BUF, L0, N, I0) do { int last_ = ((N) < 64 ? (N) : 64) - 1; last_ = last_ < 0 ? 0 : last_; \
      _Pragma("unroll") for (int j = 0; j < 8; ++j) { int idx_ = (I0) + j; idx_ = idx_ < last_ ? idx_ : last_; \
        const unsigned le_ = (unsigned)__builtin_amdgcn_readlane((int)(L0), idx_); \
        BUF[j] = *(const u32x4_t*)(U8 + (size_t)(le_ & 16383u) * 1024 + lane * 16); } } while (0)
#define PU_REDUCE(BUF, X, I0, HREG) do { int dd_[8]; _Pragma("unroll") for (int j = 0; j < 8; ++j) { \
        int d_ = __builtin_amdgcn_sdot4((int)BUF[j].x, (int)(X).x, 0, false); \
        d_ = __builtin_amdgcn_sdot4((int)BUF[j].y, (int)(X).y, d_, false); \
        d_ = __builtin_amdgcn_sdot4((int)BUF[j].z, (int)(X).z, d_, false); \
        dd_[j] = __builtin_amdgcn_sdot4((int)BUF[j].w, (int)(X).w, d_, false); } \
      const int tot_ = reduce8_i32_scatter(dd_, lane);     \
      if (lane >= (I0) && lane < (I0) + 8) HREG = tot_; } while (0)
    u32x4_t cx = *(const u32x4_t*)(XQ + (size_t)slot * 1024 + lane * 16);
    int ce0 = eidx[(size_t)slot * 128 + lane], ce1 = eidx[(size_t)slot * 128 + 64 + lane];
    float cxs = xs[slot];
    int cn; unsigned cl0, cl1;
    PU_LIST(ce0, ce1, cn, cl0, cl1);
    u32x4_t ra[8], rb[8], rc[8];
    PU_ISSUE(ra, cl0, cn, 0);
    PU_ISSUE(rb, cl0, cn, 8);
    int t1 = (slot + nslot < TOK) ? slot + nslot : slot;
    u32x4_t nx = *(const u32x4_t*)(XQ + (size_t)t1 * 1024 + lane * 16);
    int ne0 = eidx[(size_t)t1 * 128 + lane], ne1 = eidx[(size_t)t1 * 128 + 64 + lane];
    float nxs = xs[t1];
    for (int tok = slot; tok < TOK; tok += nslot) {
      float sc0 = 0.f, sc1 = 0.f, gv0 = 0.f, gv1 = 0.f, vv0 = 0.f, vv1 = 0.f;
      if (lane < cn) { const int e = cl0 & 16383; sc0 = us[e]; vv0 = vs[e]; gv0 = gw[(size_t)tok * 128 + (cl0 >> 14)]; }
      if (lane + 64 < cn) { const int e = cl1 & 16383; sc1 = us[e]; vv1 = vs[e]; gv1 = gw[(size_t)tok * 128 + (cl1 >> 14)]; }
      int nn; unsigned nl0, nl1;
      PU_LIST(ne0, ne1, nn, nl0, nl1);
      const u32x4_t x1 = nx; const int xe0 = ne0, xe1 = ne1; const float xs1 = nxs;
      const int t2a = tok + nslot, t2 = (t2a + nslot < TOK) ? t2a + nslot : ((t2a < TOK) ? t2a : tok);
      nx = *(const u32x4_t*)(XQ + (size_t)t2 * 1024 + lane * 16);
      ne0 = eidx[(size_t)t2 * 128 + lane]; ne1 = eidx[(size_t)t2 * 128 + 64 + lane];
      nxs = xs[t2];
      int h0i = 0, h1i = 0;
      const bool third = cn > 16;
      if (third) { PU_ISSUE(rc, cl0, cn, 16); }
      __builtin_amdgcn_sched_barrier(0); PU_REDUCE(ra, cx, 0, h0i);  __builtin_amdgcn_sched_barrier(0);
      PU_ISSUE(ra, nl0, nn, 0);  __builtin_amdgcn_sched_barrier(0); PU_REDUCE(rb, cx, 8, h0i);  __builtin_amdgcn_sched_barrier(0);
      PU_ISSUE(rb, nl0, nn, 8);  __builtin_amdgcn_sched_barrier(0);
      if (third) { PU_REDUCE(rc, cx, 16, h0i); }
      __builtin_amdgcn_sched_barrier(0);
      if (cn > 24) {
        for (int i0 = 24; i0 < cn; i0 += 8) {
          u32x4_t rd[8];
          const bool lo = i0 < 64;
          const unsigned lsrc = lo ? cl0 : cl1;
          const int nsrc = lo ? cn : cn - 64;
          PU_ISSUE(rd, lsrc, nsrc, i0 & 63);
          if (lo) { PU_REDUCE(rd, cx, i0, h0i); } else { PU_REDUCE(rd, cx, i0 - 64, h1i); }
        }
      }
      const float h0 = (float)h0i * sc0 * cxs, h1 = (float)h1i * sc1 * cxs;
      if (lane < cn) aw[(size_t)tok * 128 + (cl0 >> 14)] = 0.5f * h0 * (1.f + erff(h0 * 0.70710678118654752f)) * gv0 * vv0;
      if (lane + 64 < cn) aw[(size_t)tok * 128 + (cl1 >> 14)] = 0.5f * h1 * (1.f + erff(h1 * 0.70710678118654752f)) * gv1 * vv1;
      cx = x1; ce0 = xe0; ce1 = xe1; cxs = xs1; cn = nn; cl0 = nl0; cl1 = nl1;
    }
#undef PU_LIST
#undef PU_ISSUE
#undef PU_REDUCE
  }
}

template <bool SL>
__device__ __forceinline__ void phase_pv_t(const Params& p, unsigned char* smem) {
  unsigned char* ws = p.ws;
  const unsigned char* V8 = ws + WS_V;
  const int* eidx = (const int*)(ws + WS_EIDX);
  const float* aw = (const float*)(ws + WS_PA);
  float* ssq = (float*)(ws + WS_SSQ);
  const int lane = threadIdx.x & 63, w = threadIdx.x >> 6;
  const int q = lane >> 3, c = lane & 7;
  const int G = gridDim.x;
  constexpr bool sliced = SL;
  const int ti = sliced ? team_index(p, smem) : 0;
  const int tsz = G >> 3;
  const int grp0 = sliced ? (ti / tsz) : 0;
  constexpr int ngrp = sliced ? 1 : 8;
  const int slot = sliced ? (ti % tsz) * 8 + w : blockIdx.x * 8 + w;
  const int nslot = sliced ? tsz * 8 : G * 8;
  int ee[16]; float aa[16];
  if (slot < TOK) {
    unsigned bi = (unsigned)slot * 128u + 16u * (unsigned)q;
    asm volatile("" : "+v"(bi));
#pragma unroll
    for (int u4 = 0; u4 < 4; ++u4) {
      const int4 e4 = *(const int4*)(eidx + bi + 4 * u4); const float4 a4 = *(const float4*)(aw + bi + 4 * u4);
      ee[4 * u4] = e4.x; ee[4 * u4 + 1] = e4.y; ee[4 * u4 + 2] = e4.z; ee[4 * u4 + 3] = e4.w;
      aa[4 * u4] = a4.x; aa[4 * u4 + 1] = a4.y; aa[4 * u4 + 2] = a4.z; aa[4 * u4 + 3] = a4.w;
    }
  }
  for (int tok = slot; tok < TOK; tok += nslot) {
    int ce[16]; float ca[16];
    float suma = 0.f;
#pragma unroll
    for (int u = 0; u < 16; ++u) { ce[u] = ee[u]; ca[u] = aa[u]; suma += aa[u]; }
    for (int gi = 0; gi < ngrp; ++gi) {
      const int grp = grp0 + gi;
      uint4 vv[16];
#pragma unroll
      for (int u = 0; u < 16; ++u) vv[u] = *(const uint4*)(V8 + (size_t)grp * (16384 * 128) + (size_t)ce[u] * 128 + c * 16);
      float* orow = p.out + (size_t)tok * 1024 + grp * 128 + c * 16;
      float4 x1v[4];
#pragma unroll
      for (int i = 0; i < 4; ++i) x1v[i] = *(const float4*)(orow + 4 * i);
      if (gi == ngrp - 1) {
        const int nt = (tok + nslot < TOK) ? tok + nslot : tok;
        unsigned bi = (unsigned)nt * 128u + 16u * (unsigned)q;
        asm volatile("" : "+v"(bi));
#pragma unroll
        for (int u4 = 0; u4 < 4; ++u4) {
          const int4 e4 = *(const int4*)(eidx + bi + 4 * u4); const float4 a4 = *(const float4*)(aw + bi + 4 * u4);
          ee[4 * u4] = e4.x; ee[4 * u4 + 1] = e4.y; ee[4 * u4 + 2] = e4.z; ee[4 * u4 + 3] = e4.w;
          aa[4 * u4] = a4.x; aa[4 * u4 + 1] = a4.y; aa[4 * u4 + 2] = a4.z; aa[4 * u4 + 3] = a4.w;
        }
      }
      __builtin_amdgcn_sched_barrier(0);
      float acc[16];
#pragma unroll
      for (int i = 0; i < 16; ++i) acc[i] = -128.f * suma;
#pragma unroll
      for (int u = 0; u < 16; ++u) {
        float vf[16];
        cvt16u8(vv[u], vf);
#pragma unroll
        for (int i = 0; i < 16; ++i) acc[i] += ca[u] * vf[i];
        __builtin_amdgcn_sched_barrier(0);
      }
#pragma unroll
      for (int i = 0; i < 16; ++i) { acc[i] = add_xor8(acc[i]); acc[i] = add_xor16(acc[i]); acc[i] = add_xor32(acc[i]); }
      float ss = 0.f;
      if (q == 0) {
#pragma unroll
        for (int i = 0; i < 4; ++i) {
          const float4 oa = make_float4(x1v[i].x + acc[4 * i], x1v[i].y + acc[4 * i + 1], x1v[i].z + acc[4 * i + 2], x1v[i].w + acc[4 * i + 3]);
          *(float4*)(orow + 4 * i) = oa;
          ss += oa.x * oa.x + oa.y * oa.y + oa.z * oa.z + oa.w * oa.w;
        }
      }
      ss += __shfl_xor(ss, 1); ss += __shfl_xor(ss, 2); ss += __shfl_xor(ss, 4);
      if (lane == 0) atomicAdd(&ssq[tok], ss);
    }
  }
}

__device__ __forceinline__ void phase_final(const Params& p) {
  const float* ssq = (const float*)(p.ws + WS_SSQ);
  const int lane = threadIdx.x & 63, w = threadIdx.x >> 6;
  for (int row = blockIdx.x * 8 + w; row < TOK; row += gridDim.x * 8) {
    const float rstd = rsqrtf(ssq[row] * (1.f / DM) + EPSV);
    float4* o4 = (float4*)(p.out + (size_t)row * DM);
#pragma unroll
    for (int i = 0; i < 4; ++i) {
      float4 v = o4[lane + 64 * i];
      const float4 gg = ((const float4*)p.norm_final)[lane + 64 * i];
      v.x *= rstd * gg.x; v.y *= rstd * gg.y; v.z *= rstd * gg.z; v.w *= rstd * gg.w;
      o4[lane + 64 * i] = v;
    }
  }
}


__device__ __forceinline__ void phase_proj8(const Params& p, unsigned char* smem) {
  unsigned char* ws = p.ws;
  pg8::Gemm g{(const pg8::bf16_t*)(ws + WS_XN), (const pg8::bf16_t*)(ws + WS_WIN), TOK, 5120, 1024};
  pg8::StaticOrder S; S.init(TOK, 5120, (int)gridDim.x, (int)blockIdx.x);
  EpiProj E{(unsigned short*)(ws + WS_PH), (unsigned short*)(ws + WS_PA), (unsigned short*)(ws + WS_PG),
            (unsigned short*)(ws + WS_KC), (unsigned short*)(ws + WS_VC), (unsigned short*)(ws + WS_IKC)};
  pg8::gemm_phase<EpiProj, pg8::StaticOrder>((PG8_LAS unsigned char*)smem, g, S, E, nullptr);
}
__device__ __forceinline__ void phase_ikln(const Params& p) {
  bf16_t* ikc = (bf16_t*)(p.ws + WS_IKC);
  const int tid = threadIdx.x, sub = tid & 7;
  float gam[8], bet[8];
#pragma unroll
  for (int i = 0; i < 8; ++i) { gam[i] = p.ikg[sub * 8 + i]; bet[i] = p.ikb[sub * 8 + i]; }
  for (int row = blockIdx.x * 64 + (tid >> 3); row < TOK; row += gridDim.x * 64) {
    uint4* ptr = (uint4*)(ikc + (size_t)row * 64 + sub * 8);
    const uint4 raw = *ptr;
    float v[8];
    cvt8(raw, v);
    float s = 0.f;
#pragma unroll
    for (int i = 0; i < 8; ++i) s += v[i];
    s += __shfl_xor(s, 1); s += __shfl_xor(s, 2); s += __shfl_xor(s, 4);
    const float mu = s * (1.f / 64.f);
    float q = 0.f;
#pragma unroll
    for (int i = 0; i < 8; ++i) { const float d = v[i] - mu; q += d * d; }
    q += __shfl_xor(q, 1); q += __shfl_xor(q, 2); q += __shfl_xor(q, 4);
    const float rstd = rsqrtf(q * (1.f / 64.f) + EPSV);
    uint4 o;
    o.x = pack2((v[0] - mu) * rstd * gam[0] + bet[0], (v[1] - mu) * rstd * gam[1] + bet[1]);
    o.y = pack2((v[2] - mu) * rstd * gam[2] + bet[2], (v[3] - mu) * rstd * gam[3] + bet[3]);
    o.z = pack2((v[4] - mu) * rstd * gam[4] + bet[4], (v[5] - mu) * rstd * gam[5] + bet[5]);
    o.w = pack2((v[6] - mu) * rstd * gam[6] + bet[6], (v[7] - mu) * rstd * gam[7] + bet[7]);
    *ptr = o;
  }
}
__device__ __forceinline__ void phase_up8(const Params& p, unsigned char* smem) {
  unsigned char* ws = p.ws;
  const pg8::bf16_t* ya = (const pg8::bf16_t*)(ws + WS_XN);
  const pg8::bf16_t* yb = ya + (size_t)TOK * 512;
  pg8::StaticOrder S; S.init(TOK, 1024, (int)gridDim.x, (int)blockIdx.x);
  {
    pg8::Gemm g{ya, (const pg8::bf16_t*)(ws + WS_WUPA), TOK, 1024, 512};
    EpiGate<0> E{(unsigned short*)(ws + WS_PH), (const unsigned short*)(ws + WS_PG), 0};
    pg8::gemm_phase<EpiGate<0>, pg8::StaticOrder>((PG8_LAS unsigned char*)smem, g, S, E, nullptr);
  }
  {
    pg8::Gemm g{yb, (const pg8::bf16_t*)(ws + WS_WUPB), TOK, 1024, 512};
    EpiGate<1> E{(unsigned short*)(ws + WS_PH), (const unsigned short*)(ws + WS_PG), 1024};
    pg8::gemm_phase<EpiGate<1>, pg8::StaticOrder>((PG8_LAS unsigned char*)smem, g, S, E, nullptr);
  }
}
__device__ __forceinline__ void phase_out8(const Params& p, unsigned char* smem) {
  unsigned char* ws = p.ws;
  pg8::Gemm g{(const pg8::bf16_t*)(ws + WS_PH), (const pg8::bf16_t*)(ws + WS_WOUT), TOK, 1024, 1024};
  pg8::StaticOrder S; S.init(TOK, 1024, (int)gridDim.x, (int)blockIdx.x);
  EpiResid E{p.out, p.x};
  pg8::gemm_phase<EpiResid, pg8::StaticOrder>((PG8_LAS unsigned char*)smem, g, S, E, nullptr);
}
__device__ __forceinline__ void phase_pq8(const Params& p, unsigned char* smem) {
  unsigned char* ws = p.ws;
  pg8::Gemm g{(const pg8::bf16_t*)(ws + WS_XN), (const pg8::bf16_t*)(ws + WS_WQ), TOK, 2048, 1024};
  pg8::StaticOrder S; S.init(TOK, 2048, (int)gridDim.x, (int)blockIdx.x);
  EpiStoreBf16 E{(unsigned short*)(ws + WS_PG), 2048};
  pg8::gemm_phase<EpiStoreBf16, pg8::StaticOrder>((PG8_LAS unsigned char*)smem, g, S, E, nullptr);
}

__global__ void __launch_bounds__(NTHREADS) hybrid_fwd(Params p) {
  extern __shared__ __attribute__((aligned(16))) unsigned char smem[];
#if ONE_LAUNCH
  cg::grid_group grid = cg::this_grid();
  volatile LAS unsigned* xst = (volatile LAS unsigned*)(smem + LDS_BYTES - 16);
  if (threadIdx.x == 0) { xst[0] = 0u; xst[1] = 0u; }
  __syncthreads();
  XcdBarrier xbar = xcd_barrier_post((unsigned*)(p.ws + WS_BAR), xst);
#define SEAM(k) do { if (p.ph_lo <= (k) && (k) + 1 < p.ph_hi) { if (p.ph_hi > NPHASE) grid.sync(); else xcd_barrier(xbar); } } while (0)
#else
#define SEAM(k) do { } while (0)
#endif
#define IN(k) (p.ph_lo <= (k) && (k) < p.ph_hi)
#ifndef REPEAT_PH
#define REPEAT_PH -1
#endif
#define REP(k, stmt) do { if (REPEAT_PH == (k)) { stmt; grid.sync(); } } while (0)
  if (IN(0)) { phase_prep(p, smem); SEAM(0); }
  if (IN(1)) { phase_proj8(p, smem); SEAM(1); }
  if (IN(2)) { phase_ikln(p); hgrn_h1_all(p, smem); SEAM(2); }
  if (IN(3)) { phase_mix(p, smem); SEAM(3); }
  if (IN(4)) { phase_up8(p, smem); SEAM(4); }
  if (IN(5)) { phase_out8(p, smem); SEAM(5); }
  if (IN(6)) { rmsnorm_rows_q(p.out, p.norm_ffn, (bf16_t*)(p.ws + WS_XN), p.ws + WS_XQ, (float*)(p.ws + WS_XS)); SEAM(6); }
  if (IN(7)) { phase_pq8(p, smem); SEAM(7); }
  if (IN(8)) { phase_pkeys(p, smem); SEAM(8); }
  if (IN(9)) { phase_pu(p, smem); SEAM(9); }
  if (IN(10)) { if (gridDim.x % 8 == 0) phase_pv_t<true>(p, smem); else phase_pv_t<false>(p, smem); SEAM(10); }
  if (IN(11)) { phase_final(p); }
#undef IN
#undef SEAM
}

extern "C" void kernel_launch(void* const* d_in, const int* in_sizes, int n_in, void* d_out, int out_size, void* d_ws, size_t ws_size,
                              hipStream_t stream) {
  static int grid = 0;
  if (grid == 0) {
    if (n_in != 17 || ws_size < WS_END) {
      fprintf(stderr, "kernel_launch: unexpected n_in %d or ws_size %zu (need %zu)\n", n_in, ws_size, (size_t)WS_END);
      grid = -1; return;
    }
    int dev = 0, cus = 0, per_cu = 0;
    hipGetDevice(&dev);
    hipDeviceGetAttribute(&cus, hipDeviceAttributeMultiprocessorCount, dev);
    hipFuncSetAttribute((const void*)hybrid_fwd, hipFuncAttributeMaxDynamicSharedMemorySize, LDS_BYTES);
    hipOccupancyMaxActiveBlocksPerMultiprocessor(&per_cu, (const void*)hybrid_fwd, NTHREADS, LDS_BYTES);
    if (per_cu < 1) { fprintf(stderr, "kernel_launch: occupancy query says %d blocks/CU\n", per_cu); per_cu = 1; }
    (void)hipGetLastError();
    grid = cus;
  }
  if (grid < 0) return;
  Params p{};
  p.x = (const float*)d_in[0]; p.norm_mix = (const float*)d_in[1]; p.w_in = (const float*)d_in[2]; p.hg_lb = (const float*)d_in[3];
  p.hg_norm = (const float*)d_in[4]; p.ikg = (const float*)d_in[5]; p.ikb = (const float*)d_in[6]; p.rel_bias = (const float*)d_in[7];
  p.w_up_a = (const float*)d_in[8]; p.w_up_b = (const float*)d_in[9]; p.w_out = (const float*)d_in[10]; p.norm_ffn = (const float*)d_in[11];
  p.peer_wq = (const float*)d_in[12]; p.peer_keys = (const float*)d_in[13]; p.peer_u = (const float*)d_in[14]; p.peer_v = (const float*)d_in[15];
  p.norm_final = (const float*)d_in[16];
  p.out = (float*)d_out; p.ws = (unsigned char*)d_ws;
#if ONE_LAUNCH
  hipMemsetAsync((unsigned char*)d_ws + WS_BAR, 0, 16384, stream);
  p.ph_lo = 0; p.ph_hi = NPHASE;
  void* args[] = {&p};
  hipError_t e = hipLaunchCooperativeKernel((const void*)hybrid_fwd, dim3(grid), dim3(NTHREADS), args, LDS_BYTES, stream);
  if (e != hipSuccess) fprintf(stderr, "cooperative launch failed: %s (grid %d)\n", hipGetErrorString(e), grid);
#else
  for (int ph = 0; ph < NPHASE; ++ph) {
    p.ph_lo = ph; p.ph_hi = ph + 1;
    hipLaunchKernelGGL(hybrid_fwd, dim3(grid), dim3(NTHREADS), LDS_BYTES, stream, p);
  }
#endif
}
```

```cpp
#include <hip/hip_runtime.h>
#include <hip/hip_cooperative_groups.h>
#include <stdint.h>
#include <stdio.h>
namespace cg = cooperative_groups;

#ifndef ONE_LAUNCH
#define ONE_LAUNCH 1
#endif

typedef unsigned short bf16_t;
typedef __attribute__((ext_vector_type(8))) short bf16x8;
typedef __attribute__((ext_vector_type(4))) float f32x4;

#define NTHREADS 512
#define TOK 32768
#define SEQL 4096
#define DM 1024
#define EPSV 1e-6f
#define NPHASE 12

#define WS_WIN   ((size_t)0)
#define WS_WUPA  (WS_WIN  + (size_t)5120 * 1024 * 2)
#define WS_WUPB  (WS_WUPA + (size_t)1024 * 512 * 2)
#define WS_WOUT  (WS_WUPB + (size_t)1024 * 512 * 2)
#define WS_WQ    (WS_WOUT + (size_t)1024 * 1024 * 2)
#define WS_KEYS  (WS_WQ   + (size_t)2048 * 1024 * 2)
#define WS_LB    (WS_KEYS + (size_t)2 * 8 * 128 * 128 * 2)
#define WS_U     (WS_LB   + (size_t)4096)
#define WS_V     (WS_U    + (size_t)16384 * 1024 * 2)
#define WS_XN    (WS_V    + (size_t)16384 * 1024 * 2)
#define WS_PH    (WS_XN   + (size_t)TOK * 1024 * 2)
#define WS_PA    (WS_PH   + (size_t)TOK * 2048 * 2)
#define WS_PG    (WS_PA   + (size_t)TOK * 1024 * 2)
#define WS_EIDX  (WS_PG   + (size_t)TOK * 2048 * 2)
#define WS_GW    (WS_EIDX + (size_t)TOK * 128 * 4)
#define WS_SSQ   (WS_GW   + (size_t)TOK * 128 * 4)
#define WS_XCC   (WS_SSQ  + (size_t)TOK * 4)
#define WS_BAR   (WS_XCC  + (size_t)4096)
#define WS_DEC   (WS_BAR  + (size_t)16384)
#define WS_QCTR  (WS_DEC  + (size_t)2048 * 384 * 4)
#define WS_END   (WS_QCTR + (size_t)1024)

#define WS_KC (WS_EIDX)
#define WS_VC (WS_KC + (size_t)TOK * 128)
#define WS_IKC (WS_VC + (size_t)TOK * 128)
#define LDS_BYTES 155648

struct Params {
  const float* x; const float* norm_mix; const float* w_in; const float* hg_lb; const float* hg_norm;
  const float* ikg; const float* ikb; const float* rel_bias; const float* w_up_a; const float* w_up_b;
  const float* w_out; const float* norm_ffn; const float* peer_wq; const float* peer_keys;
  const float* peer_u; const float* peer_v; const float* norm_final;
  float* out; unsigned char* ws; int ph_lo, ph_hi;
};

__device__ __forceinline__ float bf2f(bf16_t u) { return __uint_as_float(((unsigned)u) << 16); }
typedef float f32x2_cv __attribute__((ext_vector_type(2)));
typedef __bf16 bf16x2_cv __attribute__((ext_vector_type(2)));
__device__ __forceinline__ unsigned pack2(float a, float b) {
  const f32x2_cv v = {a, b};
  return __builtin_bit_cast(unsigned, __builtin_convertvector(v, bf16x2_cv));
}
__device__ __forceinline__ bf16_t f2bf(float f) { return (bf16_t)(pack2(f, f) & 0xffffu); }
__device__ __forceinline__ float wave_sum_slow(float v) {
#pragma unroll
  for (int o = 32; o > 0; o >>= 1) v += __shfl_xor(v, o);
  return v;
}
__device__ __forceinline__ void lds_fence() { asm volatile("s_waitcnt lgkmcnt(0)" ::: "memory"); }

__device__ __forceinline__ float add_xor8(float v) { return v + __int_as_float(__builtin_amdgcn_update_dpp(0, __float_as_int(v), 0x128, 0xf, 0xf, true)); }
__device__ __forceinline__ float add_xor16(float v) { const auto r = __builtin_amdgcn_permlane16_swap(__float_as_uint(v), __float_as_uint(v), false, false); return __uint_as_float(r[0]) + __uint_as_float(r[1]); }
__device__ __forceinline__ float add_xor32(float v) { const auto r = __builtin_amdgcn_permlane32_swap(__float_as_uint(v), __float_as_uint(v), false, false); return __uint_as_float(r[0]) + __uint_as_float(r[1]); }
__device__ __forceinline__ float max_xor16(float v) { const auto r = __builtin_amdgcn_permlane16_swap(__float_as_uint(v), __float_as_uint(v), false, false); return fmaxf(__uint_as_float(r[0]), __uint_as_float(r[1])); }
__device__ __forceinline__ float max_xor32(float v) { const auto r = __builtin_amdgcn_permlane32_swap(__float_as_uint(v), __float_as_uint(v), false, false); return fmaxf(__uint_as_float(r[0]), __uint_as_float(r[1])); }
__device__ __forceinline__ float wave_sum(float v) {
  v += __int_as_float(__builtin_amdgcn_update_dpp(0, __float_as_int(v), 0xB1, 0xf, 0xf, true));
  v += __int_as_float(__builtin_amdgcn_update_dpp(0, __float_as_int(v), 0x4E, 0xf, 0xf, true));
  v += __int_as_float(__builtin_amdgcn_update_dpp(0, __float_as_int(v), 0x141, 0xf, 0xf, true));
  v += __int_as_float(__builtin_amdgcn_update_dpp(0, __float_as_int(v), 0x140, 0xf, 0xf, true));
  return add_xor32(add_xor16(v));
}
__device__ __forceinline__ float sigmoidf_(float x) { return 1.f / (1.f + __expf(-x)); }
__device__ __forceinline__ float siluf_(float x) { return x / (1.f + __expf(-x)); }


#define XB_TMO      128
#define XB_XCNT(j)  (256  + 64 * (j))
#define XB_XSUB(j)  (1280 + 64 * (j))
#define XB_XGEN(j)  (2304 + 64 * (j))
#define XB_TOP      3328
#define XB_TOPGEN   3392
#define XCD_BAR_WORDS 3456
#define XB_SPIN_CAP (1u << 22)
#define LAS __attribute__((address_space(3)))
__device__ __forceinline__ unsigned xb_ld(unsigned* p)              { return __hip_atomic_load(p, __ATOMIC_RELAXED, __HIP_MEMORY_SCOPE_AGENT); }
__device__ __forceinline__ unsigned xb_add(unsigned* p, unsigned v) { return __hip_atomic_fetch_add(p, v, __ATOMIC_RELAXED, __HIP_MEMORY_SCOPE_AGENT); }
__device__ __forceinline__ unsigned xb_xcc_id() { return (unsigned)__builtin_amdgcn_s_getreg((3 << 11) | 20) & 0xFu; }
#define XB_SPIN(cond, bar) do { unsigned _sp = 0; while (cond) { __builtin_amdgcn_s_sleep(1); \
    if ((++_sp & 255u) == 0u) { if (xb_ld(&(bar)[XB_TMO])) break; if (_sp > XB_SPIN_CAP) { atomicAdd(&(bar)[XB_TMO], 1u); break; } } } } while (0)
struct XcdBarrier { unsigned* bar; unsigned x; volatile LAS unsigned* st; };
__device__ __forceinline__ XcdBarrier xcd_barrier_post(unsigned* bar, volatile LAS unsigned* st) {
  XcdBarrier b; b.bar = bar; b.x = xb_xcc_id(); b.st = st;
  if (threadIdx.x == 0) (void)xb_add(&bar[XB_XCNT(b.x)], 1u);
  return b;
}
__device__ __forceinline__ void xcd_barrier_complete(unsigned* bar, unsigned x, unsigned& nloc, unsigned& nx) {
  const unsigned G = gridDim.x * gridDim.y * gridDim.z;
  unsigned sum, cnt, mine, sp = 0u;
  for (;;) {
    sum = 0u; cnt = 0u; mine = 0u;
#pragma unroll
    for (unsigned j = 0; j < 16; ++j) { const unsigned c = xb_ld(&bar[XB_XCNT(j)]); sum += c; cnt += (c > 0u) ? 1u : 0u; mine = (j == x) ? c : mine; }
    if (sum == G) break;
    __builtin_amdgcn_s_sleep(1);
    if ((++sp & 255u) == 0u) { if (xb_ld(&bar[XB_TMO])) break; if (sp > XB_SPIN_CAP) { atomicAdd(&bar[XB_TMO], 1u); break; } }
  }
  nloc = mine > 0u ? mine : 1u; nx = cnt > 0u ? cnt : 1u;
}
__device__ __forceinline__ void xcd_barrier(const XcdBarrier& b) {
  asm volatile("s_waitcnt vmcnt(0)" ::: "memory");
  __syncthreads();
  if (threadIdx.x == 0) {
    unsigned* bar = b.bar;
    __builtin_amdgcn_s_waitcnt(0);
    unsigned nloc = b.st[0], nx = b.st[1];
    if (nloc == 0u) { xcd_barrier_complete(bar, b.x, nloc, nx); b.st[0] = nloc; b.st[1] = nx; }
    const unsigned old = xb_add(&bar[XB_XSUB(b.x)], 1u);
    const unsigned gen = old / nloc;
    if (old + 1u == (gen + 1u) * nloc) {
      __builtin_amdgcn_fence(__ATOMIC_RELEASE, "agent");
      asm volatile("s_waitcnt vmcnt(0)" ::: "memory");
      const unsigned og = xb_add(&bar[XB_TOP], 1u);
      const unsigned tg = og / nx;
      if (og + 1u == (tg + 1u) * nx) xb_add(&bar[XB_TOPGEN], 1u);
      else XB_SPIN(xb_ld(&bar[XB_TOPGEN]) == tg, bar);
      __builtin_amdgcn_fence(__ATOMIC_ACQUIRE, "agent");
      xb_add(&bar[XB_XGEN(b.x)], 1u);
      asm volatile("s_waitcnt vmcnt(0)" ::: "memory");
    } else {
      XB_SPIN(xb_ld(&bar[XB_XGEN(b.x)]) == gen, bar);
      __builtin_amdgcn_fence(__ATOMIC_ACQUIRE, "agent");
      asm volatile("s_waitcnt vmcnt(0)" ::: "memory");
    }
  }
  __syncthreads();
}

namespace pg8 {
#define PG8_LAS __attribute__((address_space(3)))
typedef unsigned short bf16_t;
typedef short bf16x8 __attribute__((ext_vector_type(8)));
typedef float f32x4 __attribute__((ext_vector_type(4)));
typedef unsigned u32x4 __attribute__((ext_vector_type(4)));
constexpr int BM = 256, BK = 64, HALF = 128, HTB = HALF * BK * 2  , STAGE_BYTES = 8 * HTB, NXCD = 8, WGM = 8;

__host__ __device__ __forceinline__ int lds_byte(int r, int c) { const int st = (r >> 4) * 2 + (c >> 5), rr = r & 15, cc = c & 31, ob = rr * 64 + cc * 2; return st * 1024 + (ob ^ (((ob >> 9) & 1) << 5)); }
__host__ __device__ __forceinline__ void stage_rc(int b, int& R, int& C) { const int st = b / 1024, sb = b % 1024, swz = sb ^ (((sb >> 9) & 1) << 5); R = (st >> 1) * 16 + swz / 64; C = (st & 1) * 32 + (swz % 64) / 2; }
__host__ __device__ __forceinline__ int perm32(int rho) { const int n = rho >> 4, i = rho & 15; return 8 * (i >> 2) + 4 * n + (i & 3); }

struct Unit { int pm, pn; };
struct Gemm { const bf16_t* A; const bf16_t* Bt; int M, N, K; };

struct StaticOrder {
    int nM, nN, nwg, G, c;
    __host__ __device__ void init(int M, int N, int G_, int c_) { nM = M / BM; nN = N / BM; nwg = nM * nN; G = G_; c = c_; }
    __host__ __device__ bool next(int i, Unit& u) const {
        const long L = (long)i * G + c; if (L >= nwg) return false;
        int wgid = (int)L; { const int q = nwg / NXCD, r = nwg % NXCD, xcd = wgid % NXCD, off = wgid / NXCD; wgid = (xcd < r ? xcd * (q + 1) : r * (q + 1) + (xcd - r) * q) + off; }
        const int nig = WGM * nN, gid = wgid / nig, fm = gid * WGM, gsz = (nM - fm) < WGM ? (nM - fm) : WGM;
        u.pm = fm + ((wgid % nig) % gsz); u.pn = (wgid % nig) / gsz; return true;
    }
    __device__ __forceinline__ void a_ready(const Unit&) const {}
    __device__ __forceinline__ void done(const Unit&) const {}
};
__device__ __forceinline__ unsigned cvt_pk_bf16(float lo, float hi) { unsigned r; asm volatile("v_cvt_pk_bf16_f32 %0, %1, %2" : "=v"(r) : "v"(lo), "v"(hi)); return r; }
template <class Epi, class Sched, bool STAMP = false>
__device__ __forceinline__ void gemm_phase(PG8_LAS unsigned char* lds, const Gemm g, const Sched& S, const Epi& E, unsigned long long* stamps) {
    const int tid = threadIdx.x, wid = __builtin_amdgcn_readfirstlane(tid >> 6), lane = tid & 63, wr = wid >> 2, wc = wid & 3, fr = lane & 15, fq = lane >> 4;
    const int K = g.K, nt = K / BK;
    int ts_lo = 0, ts_hi = 0, nts = 0; const unsigned long long rt_entry = STAMP ? (unsigned long long)wall_clock64() : 0ull;
#define PG8_STAMP() do { if (STAMP && wid == 0 && nts < 64) { const unsigned long long _c = (unsigned long long)clock64(); \
        ts_lo = (lane == nts) ? (int)(unsigned)_c : ts_lo; ts_hi = (lane == nts) ? (int)(unsigned)(_c >> 32) : ts_hi; ++nts; } } while (0)
    PG8_STAMP();
    unsigned voffA[2], voffB[2];
#pragma unroll
    for (int i = 0; i < 2; ++i) { int R, C; stage_rc(tid * 16 + i * 8192, R, C); const int Rb = Epi::PERM ? ((R & ~31) + perm32(R & 31)) : R;
        voffA[i] = (unsigned)(R * K + C) * 2u; voffB[i] = (unsigned)(Rb * K + C) * 2u; }
    const size_t kstep = (size_t)(BK * 2);
    const size_t hstep = (size_t)HALF * K * 2;
    const size_t tstep = 2 * hstep;
    const unsigned ldsw = (unsigned)wid * 1024u;
    const int aoff = lds_byte(wr * 64 + fr, fq * 8), boff = lds_byte(wc * 32 + fr, fq * 8);
#define PG8_SA(b, h) (((b) * 2 + (h)) * HTB)
#define PG8_SB(b, h) ((4 + (b) * 2 + (h)) * HTB)
#define PG8_STAGE(bufoff, gbase, voff) do { _Pragma("unroll") for (int _i = 0; _i < 2; ++_i) \
        __builtin_amdgcn_global_load_lds((const unsigned*)((const char*)(gbase) + (voff)[_i]), (PG8_LAS unsigned*)(lds + (bufoff) + ldsw + _i * 8192), 16, 0, 0); } while (0)
#define PG8_LDA(dst, b, h) do { _Pragma("unroll") for (int m = 0; m < 4; ++m) _Pragma("unroll") for (int k = 0; k < 2; ++k) dst[m][k] = *(const PG8_LAS bf16x8*)(lds + PG8_SA(b, h) + aoff + m * 2048 + k * 1024); } while (0)
#define PG8_LDB(dst, b, h) do { _Pragma("unroll") for (int n = 0; n < 2; ++n) _Pragma("unroll") for (int k = 0; k < 2; ++k) dst[n][k] = *(const PG8_LAS bf16x8*)(lds + PG8_SB(b, h) + boff + n * 2048 + k * 1024); } while (0)
#define PG8_MMA(ai, bj, At, Bt) do { __builtin_amdgcn_s_setprio(1); _Pragma("unroll") for (int m = 0; m < 4; ++m) _Pragma("unroll") for (int n = 0; n < 2; ++n) _Pragma("unroll") for (int k = 0; k < 2; ++k) \
        acc[ai][bj][m][n] = __builtin_amdgcn_mfma_f32_16x16x32_bf16(Bt[n][k], At[m][k], acc[ai][bj][m][n], 0, 0, 0); __builtin_amdgcn_s_setprio(0); } while (0)
#define PG8_WAIT_V(n) asm volatile("s_waitcnt vmcnt(" #n ")" ::: "memory")
#define PG8_WAIT_L(n) asm volatile("s_waitcnt lgkmcnt(" #n ")" ::: "memory")
#define PG8_BAR __builtin_amdgcn_s_barrier()
#define PG8_SCHED __builtin_amdgcn_sched_barrier(0)
    Unit cur, nxt; int ui = 0;
    if (!S.next(0, cur)) return;
    f32x4 acc[2][2][4][2];
#pragma unroll
    for (int a = 0; a < 2; ++a)
#pragma unroll
        for (int b = 0; b < 2; ++b)
#pragma unroll
            for (int m = 0; m < 4; ++m)
#pragma unroll
                for (int n = 0; n < 2; ++n) acc[a][b][m][n] = (f32x4){0.f, 0.f, 0.f, 0.f};
    bf16x8 At[4][2], B0[2][2], B1[2][2];
    const char* cA = (const char*)g.A + (size_t)cur.pm * tstep; const char* cB = (const char*)g.Bt + (size_t)cur.pn * tstep;
    S.a_ready(cur);
    PG8_STAGE(PG8_SB(0, 0), cB, voffB); PG8_STAGE(PG8_SA(0, 0), cA, voffA); PG8_STAGE(PG8_SB(0, 1), cB + hstep, voffB); PG8_STAGE(PG8_SA(0, 1), cA + hstep, voffA);
    if (wr == 1) PG8_BAR;
    PG8_WAIT_V(4); PG8_BAR;
    PG8_STAGE(PG8_SB(1, 0), cB + kstep, voffB); PG8_STAGE(PG8_SA(1, 0), cA + kstep, voffA); PG8_STAGE(PG8_SB(1, 1), cB + hstep + kstep, voffB);
    PG8_WAIT_V(6); PG8_BAR;
    PG8_STAMP();
    for (;;) {
        const bool has_next = S.next(ui + 1, nxt);
        const char* nA = has_next ? (const char*)g.A + (size_t)nxt.pm * tstep : cA; const char* nB = has_next ? (const char*)g.Bt + (size_t)nxt.pn * tstep : cB;
        for (int t = 0; t < nt; t += 2) {
            const bool last = (t == nt - 2);
            const char* a1 = cA + (size_t)(t + 1) * kstep;
            const char* a2 = last ? nA : cA + (size_t)(t + 2) * kstep; const char* b2 = last ? nB : cB + (size_t)(t + 2) * kstep;
            const char* a3 = a2 + kstep; const char* b3 = b2 + kstep;
            if (last && has_next) S.a_ready(nxt);
            PG8_LDB(B0, 0, 0); PG8_SCHED; PG8_LDA(At, 0, 0); PG8_STAGE(PG8_SA(1, 1), a1 + hstep, voffA);
            PG8_WAIT_L(8); PG8_BAR; PG8_WAIT_L(0); PG8_MMA(0, 0, At, B0); PG8_BAR; PG8_SCHED;
            PG8_LDB(B1, 0, 1); PG8_STAGE(PG8_SB(0, 0), b2, voffB);
            PG8_BAR; PG8_WAIT_L(0); PG8_MMA(0, 1, At, B1); PG8_BAR;
            PG8_LDA(At, 0, 1); PG8_STAGE(PG8_SA(0, 0), a2, voffA);
            PG8_BAR; PG8_WAIT_L(0); PG8_MMA(1, 0, At, B0); PG8_BAR; PG8_SCHED;
            PG8_STAGE(PG8_SB(0, 1), b2 + hstep, voffB);
            PG8_WAIT_V(6); PG8_BAR; PG8_MMA(1, 1, At, B1); PG8_BAR;
            PG8_LDB(B0, 1, 0); PG8_SCHED; PG8_LDA(At, 1, 0); PG8_STAGE(PG8_SA(0, 1), a2 + hstep, voffA);
            PG8_WAIT_L(8); PG8_BAR; PG8_WAIT_L(0); PG8_MMA(0, 0, At, B0); PG8_BAR; PG8_SCHED;
            PG8_LDB(B1, 1, 1); PG8_STAGE(PG8_SB(1, 0), b3, voffB);
            PG8_BAR; PG8_WAIT_L(0); PG8_MMA(0, 1, At, B1); PG8_BAR;
            PG8_LDA(At, 1, 1); PG8_STAGE(PG8_SA(1, 0), a3, voffA);
            PG8_BAR; PG8_WAIT_L(0); PG8_MMA(1, 0, At, B0); PG8_BAR; PG8_SCHED;
            PG8_STAGE(PG8_SB(1, 1), b3 + hstep, voffB);
            PG8_WAIT_V(6); PG8_BAR; PG8_MMA(1, 1, At, B1); PG8_BAR;
        }
        PG8_STAMP();
        if constexpr (!Epi::AFTER_DRAIN) { E(acc, cur, wr, wc, fr, fq); S.done(cur); }
        PG8_STAMP();
        if (!has_next) break;
#pragma unroll
        for (int a = 0; a < 2; ++a)
#pragma unroll
            for (int b = 0; b < 2; ++b)
#pragma unroll
                for (int m = 0; m < 4; ++m)
#pragma unroll
                    for (int n = 0; n < 2; ++n) acc[a][b][m][n] = (f32x4){0.f, 0.f, 0.f, 0.f};
        cur = nxt; cA = nA; cB = nB; ++ui;
    }
    PG8_WAIT_V(0);
    if (wr == 0) PG8_BAR;
    PG8_BAR;
    if constexpr (Epi::AFTER_DRAIN) { E.fused(acc, cur, wr, wc, fr, fq, lds, wid, lane); S.done(cur); }
    PG8_STAMP();
    if (STAMP && wid == 0) { stamps[lane] = lane < nts ? (((unsigned long long)(unsigned)ts_hi << 32) | (unsigned)ts_lo) : 0ull;
        if (lane == 62) stamps[62] = rt_entry; if (lane == 63) stamps[63] = (unsigned long long)wall_clock64(); }
#undef PG8_STAMP
#undef PG8_SA
#undef PG8_SB
#undef PG8_STAGE
#undef PG8_LDA
#undef PG8_LDB
#undef PG8_MMA
#undef PG8_WAIT_V
#undef PG8_WAIT_L
#undef PG8_BAR
#undef PG8_SCHED
}
}

struct EpiProj {
  static constexpr bool PERM = true, AFTER_DRAIN = false;
  unsigned short* pH; unsigned short* pA; unsigned short* pG; unsigned short* kc; unsigned short* vc; unsigned short* ikc;
  __device__ __forceinline__ void operator()(const pg8::f32x4 (&acc)[2][2][4][2], const pg8::Unit& u, int wr, int wc, int fr, int fq) const {
    const int row0 = u.pm * 256 + wr * 64 + fr;
    unsigned short* base; int ldc, colt; bool sg = false;
    if (u.pn < 8) { base = pH; ldc = 2048; colt = u.pn * 256; }
    else if (u.pn < 12) { base = pA; ldc = 1024; colt = (u.pn - 8) * 256; }
    else { base = pG; ldc = 2048; colt = (u.pn - 12) * 256; sg = true; }
    const int col0 = colt + wc * 32 + 8 * fq;
#pragma unroll
    for (int ai = 0; ai < 2; ++ai)
#pragma unroll
      for (int m = 0; m < 4; ++m) {
        unsigned short* rowp = base + (size_t)(row0 + ai * 128 + m * 16) * ldc + col0;
#pragma unroll
        for (int bj = 0; bj < 2; ++bj) {
          pg8::f32x4 v0 = acc[ai][bj][m][0], v1 = acc[ai][bj][m][1];
          if (sg) {
#pragma unroll
            for (int j = 0; j < 4; ++j) { v0[j] = sigmoidf_(v0[j]); v1[j] = sigmoidf_(v1[j]); }
          }
          pg8::u32x4 w; w.x = pg8::cvt_pk_bf16(v0[0], v0[1]); w.y = pg8::cvt_pk_bf16(v0[2], v0[3]); w.z = pg8::cvt_pk_bf16(v1[0], v1[1]); w.w = pg8::cvt_pk_bf16(v1[2], v1[3]);
          unsigned short* dst = rowp + bj * 128;
          if (u.pn == 10 || u.pn == 11) {
            const int cs = col0 + bj * 128;
            const size_t r = (size_t)(row0 + ai * 128 + m * 16);
            if (cs >= 512 && cs < 576) dst = kc + r * 64 + (cs - 512);
            else if (cs >= 576 && cs < 640) dst = vc + r * 64 + (cs - 576);
            else if (cs >= 896 && cs < 960) dst = ikc + r * 64 + (cs - 896);
          }
          *(pg8::u32x4*)dst = w;
        }
      }
  }
};
template <int MODE> struct EpiGate {
  static constexpr bool PERM = true, AFTER_DRAIN = false;
  unsigned short* hb; const unsigned short* pG; int goff;
  __device__ __forceinline__ void operator()(const pg8::f32x4 (&acc)[2][2][4][2], const pg8::Unit& u, int wr, int wc, int fr, int fq) const {
    const int row0 = u.pm * 256 + wr * 64 + fr;
    const int col0 = u.pn * 256 + wc * 32 + 8 * fq;
#pragma unroll
    for (int ai = 0; ai < 2; ++ai)
#pragma unroll
      for (int m = 0; m < 4; ++m) {
        const size_t r = (size_t)(row0 + ai * 128 + m * 16);
        pg8::u32x4 gv[2], hv[2];
#pragma unroll
        for (int bj = 0; bj < 2; ++bj) {
          gv[bj] = *(const pg8::u32x4*)(pG + r * 2048 + goff + col0 + bj * 128);
          if (MODE == 1) hv[bj] = *(const pg8::u32x4*)(hb + r * 1024 + col0 + bj * 128);
        }
#pragma unroll
        for (int bj = 0; bj < 2; ++bj) {
          float o[8];
#pragma unroll
          for (int j = 0; j < 4; ++j) {
            const unsigned gw0 = gv[bj][j >> 1], gw1 = gv[bj][2 + (j >> 1)];
            const float g0 = (j & 1) ? __uint_as_float(gw0 & 0xffff0000u) : __uint_as_float(gw0 << 16);
            const float g1 = (j & 1) ? __uint_as_float(gw1 & 0xffff0000u) : __uint_as_float(gw1 << 16);
            o[j] = acc[ai][bj][m][0][j] * g0; o[4 + j] = acc[ai][bj][m][1][j] * g1;
            if (MODE == 1) {
              const unsigned hw0 = hv[bj][j >> 1], hw1 = hv[bj][2 + (j >> 1)];
              o[j] += (j & 1) ? __uint_as_float(hw0 & 0xffff0000u) : __uint_as_float(hw0 << 16);
              o[4 + j] += (j & 1) ? __uint_as_float(hw1 & 0xffff0000u) : __uint_as_float(hw1 << 16);
            }
          }
          pg8::u32x4 w; w.x = pg8::cvt_pk_bf16(o[0], o[1]); w.y = pg8::cvt_pk_bf16(o[2], o[3]); w.z = pg8::cvt_pk_bf16(o[4], o[5]); w.w = pg8::cvt_pk_bf16(o[6], o[7]);
          *(pg8::u32x4*)(hb + r * 1024 + col0 + bj * 128) = w;
        }
      }
  }
};
struct EpiResid {
  static constexpr bool PERM = false, AFTER_DRAIN = false;
  float* out; const float* x;
  __device__ __forceinline__ void operator()(const pg8::f32x4 (&acc)[2][2][4][2], const pg8::Unit& u, int wr, int wc, int fr, int fq) const {
    const int row0 = u.pm * 256 + wr * 64 + fr, col0 = u.pn * 256 + wc * 32 + 4 * fq;
#pragma unroll
    for (int ai = 0; ai < 2; ++ai)
#pragma unroll
      for (int m = 0; m < 4; ++m) {
        const size_t off = (size_t)(row0 + ai * 128 + m * 16) * 1024 + col0;
        pg8::f32x4 xv[2][2];
#pragma unroll
        for (int bj = 0; bj < 2; ++bj)
#pragma unroll
          for (int n = 0; n < 2; ++n) xv[bj][n] = *(const pg8::f32x4*)(x + off + bj * 128 + n * 16);
#pragma unroll
        for (int bj = 0; bj < 2; ++bj)
#pragma unroll
          for (int n = 0; n < 2; ++n) *(pg8::f32x4*)(out + off + bj * 128 + n * 16) = acc[ai][bj][m][n] + xv[bj][n];
      }
  }
};
struct EpiStoreBf16 {
  static constexpr bool PERM = true, AFTER_DRAIN = false;
  unsigned short* O; int ldc;
  __device__ __forceinline__ void operator()(const pg8::f32x4 (&acc)[2][2][4][2], const pg8::Unit& u, int wr, int wc, int fr, int fq) const {
    const int row0 = u.pm * 256 + wr * 64 + fr, col0 = u.pn * 256 + wc * 32 + 8 * fq;
#pragma unroll
    for (int ai = 0; ai < 2; ++ai)
#pragma unroll
      for (int m = 0; m < 4; ++m) {
        unsigned short* rowp = O + (size_t)(row0 + ai * 128 + m * 16) * ldc + col0;
#pragma unroll
        for (int bj = 0; bj < 2; ++bj) {
          const pg8::f32x4 v0 = acc[ai][bj][m][0], v1 = acc[ai][bj][m][1];
          pg8::u32x4 w; w.x = pg8::cvt_pk_bf16(v0[0], v0[1]); w.y = pg8::cvt_pk_bf16(v0[2], v0[3]); w.z = pg8::cvt_pk_bf16(v1[0], v1[1]); w.w = pg8::cvt_pk_bf16(v1[2], v1[3]);
          *(pg8::u32x4*)(rowp + bj * 128) = w;
        }
      }
  }
};

__device__ __forceinline__ void gemm_tile(const bf16_t* __restrict__ A, int lda, const bf16_t* __restrict__ Bt, int ldb,
                                          int nk, f32x4 (&acc)[4][4], unsigned char* smem) {
  const int tid = threadIdx.x, lane = tid & 63, w = tid >> 6, wm = w >> 1, wn = w & 1, l15 = lane & 15, g = lane >> 4;
  unsigned char* sA = smem;
  unsigned char* sB = smem + 32768;
  const int lr = tid >> 3, lc = tid & 7;
  const bf16_t* ga = A + (size_t)lr * lda + lc * 8;
  const bf16_t* gb = Bt + (size_t)lr * ldb + lc * 8;
  uint4 ra0, ra1, ra2, ra3, rb0, rb1;
  ra0 = *(const uint4*)(ga);
  ra1 = *(const uint4*)(ga + (size_t)64 * lda);
  ra2 = *(const uint4*)(ga + (size_t)128 * lda);
  ra3 = *(const uint4*)(ga + (size_t)192 * lda);
  rb0 = *(const uint4*)(gb);
  rb1 = *(const uint4*)(gb + (size_t)64 * ldb);
  const int sw = (lc ^ (lr & 7)) << 4;
  for (int kt = 0; kt < nk; ++kt) {
    __syncthreads();
    *(uint4*)(sA + (lr) * 128 + sw) = ra0;
    *(uint4*)(sA + (lr + 64) * 128 + sw) = ra1;
    *(uint4*)(sA + (lr + 128) * 128 + sw) = ra2;
    *(uint4*)(sA + (lr + 192) * 128 + sw) = ra3;
    *(uint4*)(sB + (lr) * 128 + sw) = rb0;
    *(uint4*)(sB + (lr + 64) * 128 + sw) = rb1;
    __syncthreads();
    if (kt + 1 < nk) {
      const int ko = (kt + 1) * 64;
      ra0 = *(const uint4*)(ga + ko);
      ra1 = *(const uint4*)(ga + (size_t)64 * lda + ko);
      ra2 = *(const uint4*)(ga + (size_t)128 * lda + ko);
      ra3 = *(const uint4*)(ga + (size_t)192 * lda + ko);
      rb0 = *(const uint4*)(gb + ko);
      rb1 = *(const uint4*)(gb + (size_t)64 * ldb + ko);
    }
#pragma unroll
    for (int ks = 0; ks < 2; ++ks) {
      bf16x8 a[4], b[4];
#pragma unroll
      for (int m = 0; m < 4; ++m) { const int r = wm * 64 + m * 16 + l15; a[m] = *(const bf16x8*)(sA + r * 128 + (((ks * 4 + g) ^ (r & 7)) << 4)); }
#pragma unroll
      for (int n = 0; n < 4; ++n) { const int r = wn * 64 + n * 16 + l15; b[n] = *(const bf16x8*)(sB + r * 128 + (((ks * 4 + g) ^ (r & 7)) << 4)); }
#pragma unroll
      for (int m = 0; m < 4; ++m)
#pragma unroll
        for (int n = 0; n < 4; ++n) acc[m][n] = __builtin_amdgcn_mfma_f32_16x16x32_bf16(a[m], b[n], acc[m][n], 0, 0, 0);
    }
  }
}

__device__ __forceinline__ void zero_acc(f32x4 (&acc)[4][4]) {
#pragma unroll
  for (int m = 0; m < 4; ++m)
#pragma unroll
    for (int n = 0; n < 4; ++n) acc[m][n] = (f32x4){0.f, 0.f, 0.f, 0.f};
}

__device__ __forceinline__ void transpose_tile(const float* __restrict__ src, int srcN, bf16_t* __restrict__ dst, int K, int n0, int k0,
                                               bool winmap, float* tile) {
  const int tid = threadIdx.x;
  const int nc = tid & 63, kr = tid >> 6;
  int ncol = n0 + nc; bool valid = true;
  if (winmap) { if (ncol >= 3072) ncol -= 60; else if (ncol >= 3012) valid = false; }
#pragma unroll
  for (int i = 0; i < 8; ++i) {
    const int k = kr + 8 * i;
    tile[k * 65 + nc] = valid ? src[(size_t)(k0 + k) * srcN + ncol] : 0.f;
  }
  __syncthreads();
#pragma unroll
  for (int i = 0; i < 8; ++i) {
    const int nr = kr + 8 * i;
    dst[(size_t)(n0 + nr) * K + k0 + nc] = f2bf(tile[nc * 65 + nr]);
  }
  __syncthreads();
}

__device__ __forceinline__ void convert_f32_bf16(const float* __restrict__ src, bf16_t* __restrict__ dst, size_t n4) {
  for (size_t i = (size_t)blockIdx.x * NTHREADS + threadIdx.x; i < n4; i += (size_t)gridDim.x * NTHREADS) {
    const float4 v = ((const float4*)src)[i];
    uint2 o; o.x = pack2(v.x, v.y); o.y = pack2(v.z, v.w);
    ((uint2*)dst)[i] = o;
  }
}

template <bool SLICE_MAJOR, bool SIGNED>
__device__ __forceinline__ void quantize_rows_u8(const float* __restrict__ src, unsigned char* __restrict__ dst, float* __restrict__ scale, int row_lo, int row_hi) {
  const int lane = threadIdx.x & 63, w = threadIdx.x >> 6;
  for (int row = row_lo + w; row < row_hi; row += 8) {
    const float4* s4 = (const float4*)(src + (size_t)row * 1024) + lane * 4;
    float4 v[4];
    float am = 0.f;
#pragma unroll
    for (int i = 0; i < 4; ++i) { v[i] = s4[i]; am = fmaxf(am, fmaxf(fmaxf(fabsf(v[i].x), fabsf(v[i].y)), fmaxf(fabsf(v[i].z), fabsf(v[i].w)))); }
#pragma unroll
    for (int o = 32; o > 0; o >>= 1) am = fmaxf(am, __shfl_xor(am, o));
    const float inv = am > 0.f ? 127.f / am : 0.f;
    unsigned pk[4];
#pragma unroll
    for (int i = 0; i < 4; ++i) {
      const int ofs = SIGNED ? 0 : 128;
      const unsigned b0 = (unsigned)((int)rintf(v[i].x * inv) + ofs), b1 = (unsigned)((int)rintf(v[i].y * inv) + ofs);
      const unsigned b2 = (unsigned)((int)rintf(v[i].z * inv) + ofs), b3 = (unsigned)((int)rintf(v[i].w * inv) + ofs);
      pk[i] = (b0 & 255u) | ((b1 & 255u) << 8) | ((b2 & 255u) << 16) | ((b3 & 255u) << 24);
    }
    if (SLICE_MAJOR) *(uint4*)(dst + (size_t)(lane >> 3) * (16384 * 128) + (size_t)row * 128 + (lane & 7) * 16) = make_uint4(pk[0], pk[1], pk[2], pk[3]);
    else *(uint4*)(dst + (size_t)row * 1024 + lane * 16) = make_uint4(pk[0], pk[1], pk[2], pk[3]);
    if (lane == 0) scale[row] = am * (1.f / 127.f);
  }
}

#define WS_XQ (WS_PH + (size_t)TOK * 1024 * 2)
#define WS_XS (WS_XQ + (size_t)TOK * 1024)
__device__ __forceinline__ void rmsnorm_rows_q(const float* __restrict__ src, const float* __restrict__ g, bf16_t* __restrict__ dst,
                                               unsigned char* __restrict__ xq, float* __restrict__ xs) {
  const int lane = threadIdx.x & 63, w = threadIdx.x >> 6;
  for (int row = blockIdx.x * 8 + w; row < TOK; row += gridDim.x * 8) {
    const float4* s4 = (const float4*)(src + (size_t)row * DM) + lane * 4;
    const float4* g4 = (const float4*)g + lane * 4;
    float v[16]; float ss = 0.f;
#pragma unroll
    for (int i = 0; i < 4; ++i) { const float4 t = s4[i]; v[4 * i] = t.x; v[4 * i + 1] = t.y; v[4 * i + 2] = t.z; v[4 * i + 3] = t.w; ss += t.x * t.x + t.y * t.y + t.z * t.z + t.w * t.w; }
    ss = wave_sum(ss);
    const float rstd = rsqrtf(ss * (1.f / DM) + EPSV);
    float am = 0.f;
#pragma unroll
    for (int i = 0; i < 4; ++i) { const float4 gg = g4[i]; v[4 * i] *= rstd * gg.x; v[4 * i + 1] *= rstd * gg.y; v[4 * i + 2] *= rstd * gg.z; v[4 * i + 3] *= rstd * gg.w; }
#pragma unroll
    for (int i = 0; i < 16; ++i) am = fmaxf(am, fabsf(v[i]));
#pragma unroll
    for (int o = 32; o > 0; o >>= 1) am = fmaxf(am, __shfl_xor(am, o));
    const float inv = am > 0.f ? 127.f / am : 0.f;
    uint4 ob0, ob1;
    ob0.x = pack2(v[0], v[1]); ob0.y = pack2(v[2], v[3]); ob0.z = pack2(v[4], v[5]); ob0.w = pack2(v[6], v[7]);
    ob1.x = pack2(v[8], v[9]); ob1.y = pack2(v[10], v[11]); ob1.z = pack2(v[12], v[13]); ob1.w = pack2(v[14], v[15]);
    *(uint4*)(dst + (size_t)row * DM + lane * 16) = ob0;
    *(uint4*)(dst + (size_t)row * DM + lane * 16 + 8) = ob1;
    unsigned pk[4];
#pragma unroll
    for (int i = 0; i < 4; ++i) {
      const unsigned b0 = (unsigned)(int)rintf(v[4 * i] * inv) & 255u, b1 = (unsigned)(int)rintf(v[4 * i + 1] * inv) & 255u;
      const unsigned b2 = (unsigned)(int)rintf(v[4 * i + 2] * inv) & 255u, b3 = (unsigned)(int)rintf(v[4 * i + 3] * inv) & 255u;
      pk[i] = b0 | (b1 << 8) | (b2 << 16) | (b3 << 24);
    }
    *(uint4*)(xq + (size_t)row * 1024 + lane * 16) = make_uint4(pk[0], pk[1], pk[2], pk[3]);
    if (lane == 0) xs[row] = am * (1.f / 127.f);
  }
}

__device__ __forceinline__ void rmsnorm_rows(const float* __restrict__ src, const float* __restrict__ g, bf16_t* __restrict__ dst) {
  const int lane = threadIdx.x & 63, w = threadIdx.x >> 6;
  for (int row = blockIdx.x * 8 + w; row < TOK; row += gridDim.x * 8) {
    const float4* s4 = (const float4*)(src + (size_t)row * DM);
    float4 v[4]; float ss = 0.f;
#pragma unroll
    for (int i = 0; i < 4; ++i) { v[i] = s4[lane + 64 * i]; ss += v[i].x * v[i].x + v[i].y * v[i].y + v[i].z * v[i].z + v[i].w * v[i].w; }
    ss = wave_sum(ss);
    const float rstd = rsqrtf(ss * (1.f / DM) + EPSV);
#pragma unroll
    for (int i = 0; i < 4; ++i) {
      const float4 gg = ((const float4*)g)[lane + 64 * i];
      uint2 o; o.x = pack2(v[i].x * rstd * gg.x, v[i].y * rstd * gg.y); o.y = pack2(v[i].z * rstd * gg.z, v[i].w * rstd * gg.w);
      ((uint2*)(dst + (size_t)row * DM))[lane + 64 * i] = o;
    }
  }
}

__device__ __forceinline__ void phase_prep(const Params& p, unsigned char* smem) {
  unsigned char* ws = p.ws;
  float* tile = (float*)smem;
  const int n_win = 80 * 16, n_ua = 16 * 8, n_ub = 16 * 8, n_wo = 16 * 16, n_wq = 32 * 16;
  const int total = n_win + n_ua + n_ub + n_wo + n_wq;
  for (int it = blockIdx.x; it < total; it += gridDim.x) {
    int t = it;
    if (t < n_win) { transpose_tile(p.w_in, 5060, (bf16_t*)(ws + WS_WIN), 1024, (t >> 4) * 64, (t & 15) * 64, true, tile); continue; }
    t -= n_win;
    if (t < n_ua) { transpose_tile(p.w_up_a, 1024, (bf16_t*)(ws + WS_WUPA), 512, (t >> 3) * 64, (t & 7) * 64, false, tile); continue; }
    t -= n_ua;
    if (t < n_ub) { transpose_tile(p.w_up_b, 1024, (bf16_t*)(ws + WS_WUPB), 512, (t >> 3) * 64, (t & 7) * 64, false, tile); continue; }
    t -= n_ub;
    if (t < n_wo) { transpose_tile(p.w_out, 1024, (bf16_t*)(ws + WS_WOUT), 1024, (t >> 4) * 64, (t & 15) * 64, false, tile); continue; }
    t -= n_wo;
    transpose_tile(p.peer_wq, 2048, (bf16_t*)(ws + WS_WQ), 1024, (t >> 4) * 64, (t & 15) * 64, false, tile);
  }
  convert_f32_bf16(p.peer_keys, (bf16_t*)(ws + WS_KEYS), (size_t)2 * 8 * 128 * 128 / 4);
  for (int i = blockIdx.x * NTHREADS + threadIdx.x; i < TOK; i += gridDim.x * NTHREADS) ((float*)(ws + WS_SSQ))[i] = 0.f;
  if (threadIdx.x == 0) ((int*)(ws + WS_XCC))[blockIdx.x] = (int)(__builtin_amdgcn_s_getreg((3 << 11) | 20) & 0xFu);
  if (blockIdx.x == 0 && threadIdx.x < 8) ((unsigned*)(ws + WS_QCTR))[16 * threadIdx.x] = 0u;
  if (blockIdx.x == 0) {
    const int i = threadIdx.x;
    const float a0 = p.hg_lb[i], a1 = p.hg_lb[512 + i];
    ((float*)(ws + WS_LB))[i] = 1.f / (1.f + expf(a1 - a0));
  }
  rmsnorm_rows(p.x, p.norm_mix, (bf16_t*)(ws + WS_XN));
}

__device__ __forceinline__ void hgrn_h1_all(const Params& p, unsigned char* smem) {
  unsigned char* ws = p.ws;
  bf16_t* pH = (bf16_t*)(ws + WS_PH);
  const float* lbp = (const float*)(ws + WS_LB);
  bf16_t* Qt = (bf16_t*)smem;
  bf16_t* Kt = Qt + 64 * 136;
  bf16_t* KtT = Kt + 64 * 136;
  bf16_t* VT = KtT + 128 * 72;
  bf16_t* Am = VT + 128 * 72;
  float* qtot = (float*)(Am + 64 * 72);
  const int tid = threadIdx.x, lane = tid & 63, w = tid >> 6, l15 = lane & 15, g = lane >> 4;
  const int d = tid & 127, tq = tid >> 7;
  const int G = gridDim.x;
  if ((int)blockIdx.x >= 2048) return;
  bf16_t fr_[16], qr_[16]; unsigned short vr_[16];
#define H1_LOAD(IT) do { \
    const int bh_ = (IT) >> 6, ch_ = (IT) & 63; \
    const bf16_t* base_ = pH + ((size_t)(bh_ >> 2) * SEQL + ch_ * 64 + tq * 16) * 2048 + (bh_ & 3) * 128 + d; \
    _Pragma("unroll") for (int i = 0; i < 16; ++i) { fr_[i] = base_[(size_t)i * 2048 + 512]; qr_[i] = base_[(size_t)i * 2048]; vr_[i] = base_[(size_t)i * 2048 + 1024]; } \
  } while (0)
  H1_LOAD((int)blockIdx.x);
  for (int item = blockIdx.x; item < 2048; item += G) {
    const int bh = item >> 6, chunk = item & 63;
    const int b = bh >> 2, h = bh & 3;
    const float lbv = lbp[h * 128 + d];
    const size_t row0 = (size_t)b * SEQL + chunk * 64;
    float* dec = (float*)(ws + WS_DEC) + (size_t)item * 384;
    uint4* UU = (uint4*)p.out + (size_t)item * 2048 + tid;
    float4* OI = (float4*)((unsigned char*)p.out + ((size_t)64 << 20)) + (size_t)item * 2048 + tid;
    {
      unsigned vv[8];
#pragma unroll
      for (int i = 0; i < 8; ++i) vv[i] = (unsigned)vr_[2 * i] | ((unsigned)vr_[2 * i + 1] << 16);
      float lf[16], kk[16], qs[16];
      float run = 0.f;
#pragma unroll
      for (int i = 0; i < 16; ++i) {
        const float sg = sigmoidf_(bf2f(fr_[i]));
        const float fg = lbv + (1.f - lbv) * sg;
        run += __logf(fg);
        lf[i] = run; kk[i] = 1.f - fg; qs[i] = siluf_(bf2f(qr_[i]));
      }
      qtot[tq * 128 + d] = run;
      __syncthreads();
      { const int nit = (item + G < 2048) ? item + G : item; H1_LOAD(nit); }
      const float q0 = qtot[d], q1 = qtot[128 + d], q2 = qtot[256 + d], q3 = qtot[384 + d];
      const float pre = (tq > 0 ? q0 : 0.f) + (tq > 1 ? q1 : 0.f) + (tq > 2 ? q2 : 0.f);
      const float bref = q0 + q1;
      const float blast = bref + q2 + q3;
      unsigned kp[8];
#pragma unroll
      for (int i = 0; i < 16; ++i) {
        const float bt = pre + lf[i];
        const float qt = qs[i] * __expf(bt - bref);
        const float kt = kk[i] * __expf(bref - bt);
        const int t = tq * 16 + i;
        Qt[t * 136 + d] = f2bf(qt);
        const bf16_t kb = f2bf(kt);
        Kt[t * 136 + d] = kb;
        if (i & 1) kp[i >> 1] |= ((unsigned)kb) << 16; else kp[i >> 1] = kb;
      }
      *(uint4*)(KtT + d * 72 + tq * 16) = make_uint4(kp[0], kp[1], kp[2], kp[3]);
      *(uint4*)(KtT + d * 72 + tq * 16 + 8) = make_uint4(kp[4], kp[5], kp[6], kp[7]);
      *(uint4*)(VT + d * 72 + tq * 16) = make_uint4(vv[0], vv[1], vv[2], vv[3]);
      *(uint4*)(VT + d * 72 + tq * 16 + 8) = make_uint4(vv[4], vv[5], vv[6], vv[7]);
      if (tq == 0) { dec[d] = __expf(bref); dec[128 + d] = __expf(blast); dec[256 + d] = __expf(blast - bref); }
    }
    __syncthreads();
    {
  #pragma unroll
      for (int i = 0; i < 2; ++i) {
        const int idx = tid + 512 * i, r = idx >> 4, c = idx & 15;
        *(uint4*)(pH + (row0 + r) * 2048 + h * 128 + c * 8) = *(const uint4*)(Qt + r * 136 + c * 8);
      }
  #pragma unroll
      for (int tt = 0; tt < 2; ++tt) {
        const int tl = 2 * w + tt, sm = tl >> 2, tn = tl & 3;
        f32x4 acc = (f32x4){0.f, 0.f, 0.f, 0.f};
        if (tn >= sm) {
  #pragma unroll
          for (int k0 = 0; k0 < 128; k0 += 32) {
            const bf16x8 a = *(const bf16x8*)(Kt + (sm * 16 + l15) * 136 + k0 + 8 * g);
            const bf16x8 bq = *(const bf16x8*)(Qt + (tn * 16 + l15) * 136 + k0 + 8 * g);
            acc = __builtin_amdgcn_mfma_f32_16x16x32_bf16(a, bq, acc, 0, 0, 0);
          }
        }
        const int t = tn * 16 + l15, s0 = sm * 16 + 4 * g;
        uint2 o;
        o.x = pack2(s0 + 0 <= t ? acc[0] : 0.f, s0 + 1 <= t ? acc[1] : 0.f);
        o.y = pack2(s0 + 2 <= t ? acc[2] : 0.f, s0 + 3 <= t ? acc[3] : 0.f);
        *(uint2*)(Am + t * 72 + s0) = o;
      }
    }
    __syncthreads();
    {
  #pragma unroll
      for (int tm = 0; tm < 4; ++tm) {
        f32x4 acc = (f32x4){0.f, 0.f, 0.f, 0.f};
  #pragma unroll
        for (int k0 = 0; k0 < 64; k0 += 32) {
          const bf16x8 a = *(const bf16x8*)(Am + (tm * 16 + l15) * 72 + k0 + 8 * g);
          const bf16x8 bb = *(const bf16x8*)(VT + (16 * w + l15) * 72 + k0 + 8 * g);
          acc = __builtin_amdgcn_mfma_f32_16x16x32_bf16(a, bb, acc, 0, 0, 0);
        }
        OI[tm * 512] = make_float4(acc[0], acc[1], acc[2], acc[3]);
      }
  #pragma unroll
      for (int dp = 0; dp < 4; ++dp) {
        unsigned pk[4];
  #pragma unroll
        for (int hh = 0; hh < 2; ++hh) {
          const int dm = dp * 2 + hh;
          f32x4 acc = (f32x4){0.f, 0.f, 0.f, 0.f};
  #pragma unroll
          for (int k0 = 0; k0 < 64; k0 += 32) {
            const bf16x8 a = *(const bf16x8*)(KtT + (dm * 16 + l15) * 72 + k0 + 8 * g);
            const bf16x8 bb = *(const bf16x8*)(VT + (16 * w + l15) * 72 + k0 + 8 * g);
            acc = __builtin_amdgcn_mfma_f32_16x16x32_bf16(a, bb, acc, 0, 0, 0);
          }
          pk[hh * 2] = pack2(acc[0], acc[1]); pk[hh * 2 + 1] = pack2(acc[2], acc[3]);
        }
        UU[dp * 512] = make_uint4(pk[0], pk[1], pk[2], pk[3]);
      }
    }
    __syncthreads();
  }
#undef H1_LOAD
}

__device__ __forceinline__ void hgrn_h2(const Params& p, unsigned char* smem, int bh) {
  unsigned char* ws = p.ws;
  const bf16_t* pH = (const bf16_t*)(ws + WS_PH);
  bf16_t* ya = (bf16_t*)(ws + WS_XN);
  bf16_t* Qt = (bf16_t*)smem;
  bf16_t* ST = Qt + 64 * 136;
  float* decl = (float*)(ST + 128 * 136);
  float* red = decl + 384;
  const int tid = threadIdx.x, lane = tid & 63, w = tid >> 6, l15 = lane & 15, g = lane >> 4;
  const int b = bh >> 2, h = bh & 3;
  f32x4 S[8];
#pragma unroll
  for (int i = 0; i < 8; ++i) S[i] = (f32x4){0.f, 0.f, 0.f, 0.f};
  const float gnv = p.hg_norm[h * 128 + 16 * w + l15];
  const int e = 16 * w + l15;
  uint4 uu0, uu1, uu2, uu3; float4 oi0, oi1, oi2, oi3; uint4 qraw0, qraw1; bf16_t ogr[16]; float dcv = 0.f;
#define H2_LOAD(CH) do { \
    const int item_ = bh * 64 + (CH); \
    const size_t row0_ = (size_t)b * SEQL + (size_t)(CH) * 64; \
    const uint4* UUp = (const uint4*)p.out + (size_t)item_ * 2048 + tid; \
    const float4* OIp = (const float4*)((const unsigned char*)p.out + ((size_t)64 << 20)) + (size_t)item_ * 2048 + tid; \
    uu0 = UUp[0]; uu1 = UUp[512]; uu2 = UUp[1024]; uu3 = UUp[1536]; oi0 = OIp[0]; oi1 = OIp[512]; oi2 = OIp[1024]; oi3 = OIp[1536]; \
    qraw0 = *(const uint4*)(pH + (row0_ + (tid >> 4)) * 2048 + h * 128 + (tid & 15) * 8); \
    qraw1 = *(const uint4*)(pH + (row0_ + 32 + (tid >> 4)) * 2048 + h * 128 + (tid & 15) * 8); \
    _Pragma("unroll") for (int tm = 0; tm < 4; ++tm) _Pragma("unroll") for (int j = 0; j < 4; ++j) \
      ogr[tm * 4 + j] = pH[(row0_ + tm * 16 + 4 * g + j) * 2048 + 1536 + h * 128 + e]; \
    if (tid < 384) dcv = ((const float*)(ws + WS_DEC))[(size_t)item_ * 384 + tid]; \
  } while (0)
  H2_LOAD(0);
  for (int chunk = 0; chunk < 64; ++chunk) {
    const size_t row0 = (size_t)b * SEQL + chunk * 64;
    const uint4 cu[4] = {uu0, uu1, uu2, uu3}; const float4 co[4] = {oi0, oi1, oi2, oi3}; bf16_t cog[16];
#pragma unroll
    for (int i = 0; i < 16; ++i) cog[i] = ogr[i];
    *(uint4*)(Qt + (tid >> 4) * 136 + (tid & 15) * 8) = qraw0;
    *(uint4*)(Qt + (32 + (tid >> 4)) * 136 + (tid & 15) * 8) = qraw1;
    if (tid < 384) decl[tid] = dcv;
    __syncthreads();
    if (chunk + 1 < 64) H2_LOAD(chunk + 1);
#pragma unroll
    for (int dm = 0; dm < 8; ++dm) {
      const int d0 = 16 * dm + 4 * g;
      uint2 o;
      o.x = pack2(S[dm][0] * decl[d0], S[dm][1] * decl[d0 + 1]);
      o.y = pack2(S[dm][2] * decl[d0 + 2], S[dm][3] * decl[d0 + 3]);
      *(uint2*)(ST + e * 136 + d0) = o;
    }
    __syncthreads();
    f32x4 o[4];
#pragma unroll
    for (int tm = 0; tm < 4; ++tm) {
      f32x4 acc = (f32x4){co[tm].x, co[tm].y, co[tm].z, co[tm].w};
#pragma unroll
      for (int k0 = 0; k0 < 128; k0 += 32) {
        const bf16x8 a = *(const bf16x8*)(Qt + (tm * 16 + l15) * 136 + k0 + 8 * g);
        const bf16x8 bb = *(const bf16x8*)(ST + (16 * w + l15) * 136 + k0 + 8 * g);
        acc = __builtin_amdgcn_mfma_f32_16x16x32_bf16(a, bb, acc, 0, 0, 0);
      }
      o[tm] = acc;
#pragma unroll
      for (int j = 0; j < 4; ++j) {
        float ss = acc[j] * acc[j];
        ss += __int_as_float(__builtin_amdgcn_update_dpp(0, __float_as_int(ss), 0xB1, 0xf, 0xf, true));
        ss += __int_as_float(__builtin_amdgcn_update_dpp(0, __float_as_int(ss), 0x4E, 0xf, 0xf, true));
        ss += __int_as_float(__builtin_amdgcn_update_dpp(0, __float_as_int(ss), 0x141, 0xf, 0xf, true));
        ss += __int_as_float(__builtin_amdgcn_update_dpp(0, __float_as_int(ss), 0x140, 0xf, 0xf, true));
        if (l15 == 0) red[w * 64 + tm * 16 + 4 * g + j] = ss;
      }
    }
#pragma unroll
    for (int dm = 0; dm < 8; ++dm) {
      const unsigned u01 = (dm & 1) ? cu[dm >> 1].z : cu[dm >> 1].x, u23 = (dm & 1) ? cu[dm >> 1].w : cu[dm >> 1].y;
      const float uv[4] = {__uint_as_float(u01 << 16), __uint_as_float(u01 & 0xffff0000u), __uint_as_float(u23 << 16), __uint_as_float(u23 & 0xffff0000u)};
#pragma unroll
      for (int j = 0; j < 4; ++j) { const int dd = 16 * dm + 4 * g + j; S[dm][j] = decl[128 + dd] * S[dm][j] + decl[256 + dd] * uv[j]; }
    }
    __syncthreads();
    if (tid < 64) {
      float tot = 0.f;
#pragma unroll
      for (int ww = 0; ww < 8; ++ww) tot += red[ww * 64 + tid];
      red[512 + tid] = rsqrtf(tot * (1.f / 128.f) + EPSV);
    }
    __syncthreads();
#pragma unroll
    for (int tm = 0; tm < 4; ++tm)
#pragma unroll
      for (int j = 0; j < 4; ++j) {
        const int t = tm * 16 + 4 * g + j;
        const float rstd = red[512 + t];
        ya[(row0 + t) * 512 + h * 128 + e] = f2bf(o[tm][j] * rstd * gnv * siluf_(bf2f(cog[tm * 4 + j])));
      }
  }
#undef H2_LOAD
}

__device__ __forceinline__ int team_index(const Params& p, unsigned char* smem) {
  int* sh = (int*)(smem + 8192);
  const int G = gridDim.x, tid = threadIdx.x;
  const int* tab = (const int*)(p.ws + WS_XCC);
  if (tid < 32) sh[tid] = 0;
  __syncthreads();
  const int mine = tab[blockIdx.x] & 15;
  for (int b = tid; b < G; b += NTHREADS) {
    const int x = tab[b] & 15;
    atomicAdd(&sh[x], 1);
    if (x == mine && b < (int)blockIdx.x) atomicAdd(&sh[16], 1);
  }
  __syncthreads();
  if (tid == 0) {
    int pre = 0;
    for (int j = 0; j < mine; ++j) pre += sh[j];
    sh[17] = pre + sh[16];
  }
  __syncthreads();
  const int r = sh[17];
  __syncthreads();
  return r;
}

#define SCW 4100
#ifndef DSA_REP
#define DSA_REP 0
#endif
#define DSA_BKT_OFF (8 * SCW * 4 + 8 * 256 * 4 + 8 * 256 * 2 + 8 * 512 * 2)
__device__ __forceinline__ void cvt8(const uint4& v, float* f) {
  f[0] = __uint_as_float(v.x << 16); f[1] = __uint_as_float(v.x & 0xffff0000u);
  f[2] = __uint_as_float(v.y << 16); f[3] = __uint_as_float(v.y & 0xffff0000u);
  f[4] = __uint_as_float(v.z << 16); f[5] = __uint_as_float(v.z & 0xffff0000u);
  f[6] = __uint_as_float(v.w << 16); f[7] = __uint_as_float(v.w & 0xffff0000u);
}
__device__ __forceinline__ unsigned sortable_key(float v) {
  unsigned bits = __float_as_uint(v);
  if (bits == 0x80000000u) bits = 0u;
  return (bits & 0x80000000u) ? ~bits : (bits | 0x80000000u);
}

__device__ __forceinline__ void dsa_item(const Params& p, unsigned char* smem, int item) {
  unsigned char* ws = p.ws;
  const bf16_t* pA = (const bf16_t*)(ws + WS_PA);
  const bf16_t* kc = (const bf16_t*)(ws + WS_KC);
  const bf16_t* vc = (const bf16_t*)(ws + WS_VC);
  const bf16_t* ikc = (const bf16_t*)(ws + WS_IKC);
  bf16_t* yb = (bf16_t*)(ws + WS_XN) + (size_t)TOK * 512;
  unsigned* sc = (unsigned*)smem;
  unsigned* hist = sc + 8 * SCW;
  unsigned short* sel = (unsigned short*)(hist + 8 * 256);
  unsigned short* cand = sel + 8 * 256;
  unsigned char* bkt = (unsigned char*)(cand + 8 * 512);
  unsigned* rmm = (unsigned*)(bkt + 128 + 1056);
  unsigned* bks = rmm + 16;
  const int tid = threadIdx.x, lane = tid & 63, w = tid >> 6, l15 = lane & 15, g = lane >> 4;
  const int b = item >> 9;
  const int tb = item & 511;
  const int t0 = tb * 8;
  const size_t tokbase = (size_t)b * SEQL;

  for (int rep_s = 0; rep_s < (DSA_REP == 1 ? 2 : 1); ++rep_s) {
    bf16x8 af[2][2];
    float wq[2][4];
#pragma unroll
    for (int mt = 0; mt < 2; ++mt) {
      const int qrow = t0 + mt * 4 + (l15 >> 2), head = l15 & 3;
#pragma unroll
      for (int ks = 0; ks < 2; ++ks)
        af[mt][ks] = *(const bf16x8*)(pA + (tokbase + qrow) * 1024 + 640 + head * 64 + ks * 32 + 8 * g);
      const uint2 wr = *(const uint2*)(pA + (tokbase + t0 + mt * 4 + g) * 1024 + 960);
      wq[mt][0] = 0.5f * bf2f((bf16_t)(wr.x & 0xffff)); wq[mt][1] = 0.5f * bf2f((bf16_t)(wr.x >> 16));
      wq[mt][2] = 0.5f * bf2f((bf16_t)(wr.y & 0xffff)); wq[mt][3] = 0.5f * bf2f((bf16_t)(wr.y >> 16));
    }
    const int nkt = (t0 + 8 + 15) >> 4;
    unsigned kmin[2] = {0xFFFFFFFFu, 0xFFFFFFFFu}, kmax[2] = {0u, 0u};
    for (int kt0 = w; kt0 < nkt; kt0 += 64) {
      bf16x8 b0[8], b1[8];
#pragma unroll
      for (int u = 0; u < 8; ++u) {
        const int kt = kt0 + 8 * u;
        const int s = (kt < nkt ? kt : 0) * 16 + l15;
        const bf16_t* kr = ikc + (tokbase + s) * 64 + 8 * g;
        b0[u] = *(const bf16x8*)kr;
        b1[u] = *(const bf16x8*)(kr + 32);
      }
      __builtin_amdgcn_sched_barrier(0);
      f32x4 sacc[8][2];
#pragma unroll
      for (int u = 0; u < 8; ++u)
#pragma unroll
        for (int mt = 0; mt < 2; ++mt) {
          f32x4 acc = (f32x4){0.f, 0.f, 0.f, 0.f};
          acc = __builtin_amdgcn_mfma_f32_16x16x32_bf16(af[mt][0], b0[u], acc, 0, 0, 0);
          sacc[u][mt] = __builtin_amdgcn_mfma_f32_16x16x32_bf16(af[mt][1], b1[u], acc, 0, 0, 0);
        }
#pragma unroll
      for (int u = 0; u < 8; ++u) {
        const int kt = kt0 + 8 * u;
        if (kt < nkt) {
          const int s = kt * 16 + l15;
#pragma unroll
          for (int mt = 0; mt < 2; ++mt) {
            float v = 0.f;
#pragma unroll
            for (int j = 0; j < 4; ++j) v += wq[mt][j] * fmaxf(sacc[u][mt][j] * 0.125f, 0.f);
            const int t = t0 + mt * 4 + g;
            unsigned vb = __float_as_uint(v); if (vb == 0x80000000u) vb = 0u;
            sc[(mt * 4 + g) * SCW + s] = vb;
            if (s <= t) {
              const unsigned key = (vb & 0x80000000u) ? ~vb : (vb | 0x80000000u);
              kmin[mt] = key < kmin[mt] ? key : kmin[mt];
              kmax[mt] = key > kmax[mt] ? key : kmax[mt];
            }
          }
        }
      }
    }
#pragma unroll
    for (int mt = 0; mt < 2; ++mt) {
      unsigned a = kmin[mt], bmx = kmax[mt];
#define DPP_MINMAX(CTRL) do { const unsigned a2 = (unsigned)__builtin_amdgcn_update_dpp((int)a, (int)a, CTRL, 0xf, 0xf, false); \
                               const unsigned b2 = (unsigned)__builtin_amdgcn_update_dpp((int)bmx, (int)bmx, CTRL, 0xf, 0xf, false); \
                               a = a2 < a ? a2 : a; bmx = b2 > bmx ? b2 : bmx; } while (0)
      DPP_MINMAX(0xB1); DPP_MINMAX(0x4E); DPP_MINMAX(0x141); DPP_MINMAX(0x140);
#undef DPP_MINMAX
      if (l15 == 0) { atomicMin(&rmm[mt * 4 + g], a); atomicMax(&rmm[8 + mt * 4 + g], bmx); }
    }
  }
  __syncthreads();
  const int t = t0 + w;
  const int n = t + 1;
  unsigned* row = sc + w * SCW;
  const float* rowf = (const float*)row;
  unsigned short* mysel = sel + w * 256;
  unsigned short* mycand = cand + w * 512;
  unsigned* myh = hist + w * 256;
  int cnt;
  const unsigned long long lt_mask = (1ull << lane) - 1ull;
  for (int rep_t = 0; rep_t < (DSA_REP == 2 ? 2 : 1); ++rep_t)
  if (n <= 256) {
    for (int i = lane; i < n; i += 64) mysel[i] = (unsigned short)i;
    cnt = n;
  } else {
    cnt = 256;
    float mn, mx;
    {
      const unsigned kmn = rmm[w], kmx = rmm[8 + w];
      mn = __uint_as_float((kmn & 0x80000000u) ? (kmn ^ 0x80000000u) : ~kmn);
      mx = __uint_as_float((kmx & 0x80000000u) ? (kmx ^ 0x80000000u) : ~kmx);
    }
    const float scale = (mx > mn) ? 255.99f / (mx - mn) : 0.f;
#pragma unroll
    for (int i = 0; i < 4; ++i) myh[lane + 64 * i] = 0u;
    lds_fence();
    for (int i0 = lane; i0 < n; i0 += 256) {
      float v4[4];
#pragma unroll
      for (int k = 0; k < 4; ++k) v4[k] = (i0 + 64 * k < n) ? rowf[i0 + 64 * k] : 0.f;
#pragma unroll
      for (int k = 0; k < 4; ++k) {
        if (i0 + 64 * k < n) {
          int bn = (int)((v4[k] - mn) * scale); bn = bn > 255 ? 255 : bn;
          atomicAdd(&myh[bn], 1u);
        }
      }
    }
    lds_fence();
    unsigned cum; int bstar; unsigned mcount;
    {
      const uint4 c4 = *(const uint4*)(myh + 4 * lane);
      const unsigned c = c4.x + c4.y + c4.z + c4.w;
      unsigned sfx = c;
#pragma unroll
      for (int o = 1; o < 64; o <<= 1) { const unsigned tt = __shfl_down(sfx, o); if (lane + o < 64) sfx += tt; }
      const unsigned long long bal = __ballot(sfx >= 256u);
      const int L = 63 - __clzll(bal);
      const unsigned sL = __shfl(sfx, L), cL = __shfl(c, L);
      const unsigned b3 = __shfl(c4.w, L), b2 = __shfl(c4.z, L), b1 = __shfl(c4.y, L), b0 = __shfl(c4.x, L);
      cum = sL - cL;
      int digit;
      if (cum + b3 >= 256u) { digit = 3; mcount = b3; }
      else { cum += b3; if (cum + b2 >= 256u) { digit = 2; mcount = b2; } else { cum += b2; if (cum + b1 >= 256u) { digit = 1; mcount = b1; } else { cum += b1; digit = 0; mcount = b0; } } }
      bstar = 4 * L + digit;
    }
    const unsigned need = 256u - cum;
    if (mcount <= 512u) {
      unsigned base = 0u, cb = 0u;
      for (int i0 = 0; i0 < n; i0 += 256) {
        float v4[4];
#pragma unroll
        for (int k = 0; k < 4; ++k) { const int i = i0 + 64 * k + lane; v4[k] = (i < n) ? rowf[i] : 0.f; }
#pragma unroll
        for (int k = 0; k < 4; ++k) {
          const int i = i0 + 64 * k + lane;
          const bool valid = i < n;
          int bn = (int)((v4[k] - mn) * scale); bn = bn > 255 ? 255 : bn;
          const bool gt = valid && (bn > bstar);
          const bool eq = valid && (bn == bstar);
          const unsigned long long bg = __ballot(gt), be = __ballot(eq);
          if (gt) mysel[base + (unsigned)__popcll(bg & lt_mask)] = (unsigned short)i;
          if (eq) mycand[cb + (unsigned)__popcll(be & lt_mask)] = (unsigned short)i;
          base += (unsigned)__popcll(bg); cb += (unsigned)__popcll(be);
        }
      }
      lds_fence();
      const int m = (int)mcount;
      unsigned ck[8]; unsigned short ci[8];
#pragma unroll
      for (int q = 0; q < 8; ++q) {
        const int c = q * 64 + lane;
        ck[q] = 0u; ci[q] = 0;
        if (c < m) { ci[q] = mycand[c]; ck[q] = sortable_key(rowf[ci[q]]); }
      }
      unsigned T = 0u;
      if (m <= 64) {
#pragma unroll 1
        for (int bit = 31; bit >= 0; --bit) {
          const unsigned trial = T | (1u << bit);
          if ((unsigned)__popcll(__ballot(ck[0] >= trial)) >= need) T = trial;
        }
      } else {
#pragma unroll 1
        for (int bit = 31; bit >= 0; --bit) {
          const unsigned trial = T | (1u << bit);
          unsigned cge = 0u;
#pragma unroll
          for (int q = 0; q < 8; ++q) cge += (unsigned)__popcll(__ballot(ck[q] >= trial));
          if (cge >= need) T = trial;
        }
      }
      unsigned cgt = 0u;
#pragma unroll
      for (int q = 0; q < 8; ++q) cgt += (unsigned)__popcll(__ballot(ck[q] > T));
      const unsigned need_eq = need - cgt;
      unsigned pos0 = cum, eqtaken = 0u;
#pragma unroll
      for (int q = 0; q < 8; ++q) {
        const bool gt = ck[q] > T;
        const bool eq = ck[q] == T;
        const unsigned long long beq = __ballot(eq);
        const bool take = gt || (eq && (eqtaken + (unsigned)__popcll(beq & lt_mask)) < need_eq);
        const unsigned long long bt = __ballot(take);
        const unsigned pp = pos0 + (unsigned)__popcll(bt & lt_mask);
        if (take && pp < 256u) mysel[pp] = ci[q];
        pos0 += (unsigned)__popcll(bt);
        eqtaken += (unsigned)__popcll(beq);
      }
    } else {
      unsigned prefix = 0u, krem = 256u;
#pragma unroll 1
      for (int pass = 0; pass < 4; ++pass) {
        const int shift = 24 - 8 * pass;
        const unsigned himask = (pass == 0) ? 0u : (0xFFFFFFFFu << (shift + 8));
#pragma unroll
        for (int i = 0; i < 4; ++i) myh[lane + 64 * i] = 0u;
        lds_fence();
        for (int i = lane; i < n; i += 64) {
          const unsigned u = sortable_key(rowf[i]);
          if ((u & himask) == prefix) atomicAdd(&myh[(u >> shift) & 255u], 1u);
        }
        lds_fence();
        const uint4 c4 = *(const uint4*)(myh + 4 * lane);
        const unsigned c = c4.x + c4.y + c4.z + c4.w;
        unsigned sfx = c;
#pragma unroll
        for (int o = 1; o < 64; o <<= 1) { const unsigned tt = __shfl_down(sfx, o); if (lane + o < 64) sfx += tt; }
        const unsigned long long bal = __ballot(sfx >= krem);
        const int L = 63 - __clzll(bal);
        const unsigned sL = __shfl(sfx, L), cL = __shfl(c, L);
        const unsigned b3 = __shfl(c4.w, L), b2 = __shfl(c4.z, L), b1 = __shfl(c4.y, L);
        unsigned cum2 = sL - cL;
        unsigned digit;
        if (cum2 + b3 >= krem) digit = 3;
        else { cum2 += b3; if (cum2 + b2 >= krem) digit = 2; else { cum2 += b2; if (cum2 + b1 >= krem) digit = 1; else { cum2 += b1; digit = 0; } } }
        krem -= cum2;
        prefix |= ((unsigned)(4 * L) + digit) << shift;
      }
      const unsigned T = prefix;
      unsigned base = 0u, eqtaken = 0u;
      for (int i0 = 0; i0 < n; i0 += 64) {
        const int i = i0 + lane;
        const bool valid = i < n;
        const unsigned u = valid ? sortable_key(rowf[i]) : 0u;
        const bool gt = valid && (u > T);
        const bool eq = valid && (u == T);
        const unsigned long long beq = __ballot(eq);
        const unsigned eqrank = eqtaken + (unsigned)__popcll(beq & lt_mask);
        const bool take = gt || (eq && eqrank < krem);
        const unsigned long long bt = __ballot(take);
        const unsigned pos = base + (unsigned)__popcll(bt & lt_mask);
        if (take && pos < 256u) mysel[pos] = (unsigned short)i;
        base += (unsigned)__popcll(bt);
        eqtaken += (unsigned)__popcll(beq);
      }
    }
  }
  lds_fence();
  if (lane == 0) { rmm[w] = 0xFFFFFFFFu; rmm[8 + w] = 0u; }
  lds_fence();
  {
    const uint2 s4 = *(const uint2*)(mysel + 4 * lane);
    const int sj[4] = {(int)(s4.x & 0xffffu), (int)(s4.x >> 16), (int)(s4.y & 0xffffu), (int)(s4.y >> 16)};
    unsigned pk = 0u;
#pragma unroll
    for (int j = 0; j < 4; ++j) {
      const bool valid = 4 * lane + j < cnt;
      const int dist = valid ? t - sj[j] : 0;
      unsigned bk = dist < 128 ? (unsigned)bkt[dist] : 31u;
      bk = valid ? bk : 32u;
      pk |= bk << (8 * j);
    }
    bks[w * 64 + lane] = pk;
  }
  lds_fence();
  {
    int lane_a = lane;
    asm volatile("" : "+v"(lane_a));
    const int l15 = lane_a & 15, g = lane_a >> 4;
    const int ks = lane_a >> 3, dc = lane_a & 7;
    const unsigned char* kcb = (const unsigned char*)(kc + tokbase * 64);
    const unsigned char* vcb = (const unsigned char*)(vc + tokbase * 64);
    float* pl = (float*)row;
    const float* relb = (const float*)(bkt + 128);
    const int niter = (cnt + 7) >> 3;
    bf16x8 bq0 = (bf16x8){0, 0, 0, 0, 0, 0, 0, 0}, bq1 = bq0;
    if (l15 < 8) {
      bq0 = *(const bf16x8*)(pA + (tokbase + t) * 1024 + l15 * 64 + 8 * g);
      bq1 = *(const bf16x8*)(pA + (tokbase + t) * 1024 + l15 * 64 + 32 + 8 * g);
    }
    float lg[16][4];
    {
      bf16x8 ka[8][2], kb[8][2];
#pragma unroll
      for (int u = 0; u < 8; ++u) {
        const int kk = u * 16 + l15;
        const unsigned s = (unsigned)mysel[kk] & 4095u;
        const unsigned ko = s * 128u + 16u * (unsigned)g;
        ka[u][0] = *(const bf16x8*)(kcb + ko);
        ka[u][1] = *(const bf16x8*)(kcb + ko + 64u);
      }
#pragma unroll
      for (int u = 0; u < 8; ++u) {
        const int kk = (8 + u) * 16 + l15;
        const unsigned s = (unsigned)mysel[kk] & 4095u;
        const unsigned ko = s * 128u + 16u * (unsigned)g;
        kb[u][0] = *(const bf16x8*)(kcb + ko);
        kb[u][1] = *(const bf16x8*)(kcb + ko + 64u);
      }
      __builtin_amdgcn_sched_barrier(0);
#pragma unroll
      for (int u = 0; u < 8; ++u) {
        f32x4 acc = (f32x4){0.f, 0.f, 0.f, 0.f};
        acc = __builtin_amdgcn_mfma_f32_16x16x32_bf16(ka[u][0], bq0, acc, 0, 0, 0);
        acc = __builtin_amdgcn_mfma_f32_16x16x32_bf16(ka[u][1], bq1, acc, 0, 0, 0);
        lg[u][0] = acc[0]; lg[u][1] = acc[1]; lg[u][2] = acc[2]; lg[u][3] = acc[3];
      }
#pragma unroll
      for (int u = 0; u < 8; ++u) {
        f32x4 acc = (f32x4){0.f, 0.f, 0.f, 0.f};
        acc = __builtin_amdgcn_mfma_f32_16x16x32_bf16(kb[u][0], bq0, acc, 0, 0, 0);
        acc = __builtin_amdgcn_mfma_f32_16x16x32_bf16(kb[u][1], bq1, acc, 0, 0, 0);
        lg[8 + u][0] = acc[0]; lg[8 + u][1] = acc[1]; lg[8 + u][2] = acc[2]; lg[8 + u][3] = acc[3];
      }
    }
    typedef unsigned u32x4_t __attribute__((ext_vector_type(4)));
    u32x4_t va[16];
#pragma unroll
    for (int u = 0; u < 16; ++u) {
      const int kk = u * 8 + ks;
      const unsigned s = (unsigned)mysel[kk] & 4095u;
      va[u] = *(const u32x4_t*)(vcb + s * 128u + 16u * (unsigned)dc);
    }
    __builtin_amdgcn_sched_barrier(0);
    const int hsel = l15 & 7;
    float m = -INFINITY;
    const unsigned* mybks = bks + w * 64;
#pragma unroll
    for (int u = 0; u < 16; ++u) {
      const unsigned bk4 = mybks[4 * u + g];
#pragma unroll
      for (int j = 0; j < 4; ++j) {
        lg[u][j] = lg[u][j] * 0.125f + relb[((bk4 >> (8 * j)) & 255u) * 8 + hsel];
        m = fmaxf(m, lg[u][j]);
      }
    }
    m = max_xor16(m); m = max_xor32(m);
    float sum = 0.f;
#pragma unroll
    for (int u = 0; u < 16; ++u)
#pragma unroll
      for (int j = 0; j < 4; ++j) { lg[u][j] = __expf(lg[u][j] - m); sum += lg[u][j]; }
    sum = add_xor16(sum); sum = add_xor32(sum);
    const float inv = 1.f / sum;
    bf16x8 pa[8];
#pragma unroll
    for (int s8 = 0; s8 < 8; ++s8) {
      const unsigned w0 = pack2(lg[2 * s8][0] * inv, lg[2 * s8][1] * inv), w1 = pack2(lg[2 * s8][2] * inv, lg[2 * s8][3] * inv);
      const unsigned w2 = pack2(lg[2 * s8 + 1][0] * inv, lg[2 * s8 + 1][1] * inv), w3 = pack2(lg[2 * s8 + 1][2] * inv, lg[2 * s8 + 1][3] * inv);
      const u32x4_t wv = {w0, w1, w2, w3};
      pa[s8] = __builtin_bit_cast(bf16x8, wv);
    }
    unsigned char* vs_l = (unsigned char*)row;
#pragma unroll
    for (int u = 0; u < 16; ++u) *(u32x4_t*)(vs_l + (u * 8 + ks) * 128 + dc * 16) = va[u];
    lds_fence();
    u32x4_t vb[16];
#pragma unroll
    for (int u = 0; u < 16; ++u) {
      const int kk = (16 + u) * 8 + ks;
      const unsigned s = (unsigned)mysel[kk] & 4095u;
      vb[u] = *(const u32x4_t*)(vcb + s * 128u + 16u * (unsigned)dc);
    }
    __builtin_amdgcn_sched_barrier(0);
    f32x4 ov[4];
#pragma unroll
    for (int nt = 0; nt < 4; ++nt) ov[nt] = (f32x4){0.f, 0.f, 0.f, 0.f};
    typedef short v4s_t __attribute__((ext_vector_type(4)));
    const unsigned tr_lane = (unsigned)((l15 >> 2) * 128 + (l15 & 3) * 8);
#define PV_HALF(S0) do { \
      _Pragma("unroll") for (int s4_ = 0; s4_ < 4; ++s4_) { \
        _Pragma("unroll") for (int nt = 0; nt < 4; ++nt) { \
          const unsigned a0 = (unsigned)((s4_ * 32 + 4 * g) * 128 + nt * 32) + tr_lane; \
          const v4s_t b0 = __builtin_amdgcn_ds_read_tr16_b64_v4i16((__attribute__((address_space(3))) v4s_t*)(vs_l + a0)); \
          const v4s_t b1 = __builtin_amdgcn_ds_read_tr16_b64_v4i16((__attribute__((address_space(3))) v4s_t*)(vs_l + a0 + 16 * 128)); \
          const bf16x8 bb = (bf16x8){b0[0], b0[1], b0[2], b0[3], b1[0], b1[1], b1[2], b1[3]}; \
          ov[nt] = __builtin_amdgcn_mfma_f32_16x16x32_bf16(pa[(S0) + s4_], bb, ov[nt], 0, 0, 0); \
        } \
      } \
    } while (0)
    PV_HALF(0);
    lds_fence();
#pragma unroll
    for (int u = 0; u < 16; ++u) *(u32x4_t*)(vs_l + (u * 8 + ks) * 128 + dc * 16) = vb[u];
    lds_fence();
    PV_HALF(4);
#undef PV_HALF
    if (g < 2) {
#pragma unroll
      for (int nt = 0; nt < 4; ++nt)
#pragma unroll
        for (int j = 0; j < 4; ++j) yb[(tokbase + t) * 512 + (4 * g + j) * 64 + nt * 16 + l15] = f2bf(ov[nt][j]);
    }
    lds_fence();
  }
  __syncthreads();
}

__device__ __forceinline__ void phase_mix(const Params& p, unsigned char* smem, int mode = 0) {
  const int G = gridDim.x;
  if (mode != 2) { for (int bh = blockIdx.x; bh < 32; bh += G) { hgrn_h2(p, smem, bh); __syncthreads(); } }
  if (mode == 1) return;
  unsigned char* bkt = smem + DSA_BKT_OFF;
  volatile int* qslot = (volatile int*)(smem + LDS_BYTES - 32);
  unsigned* qctr = (unsigned*)(p.ws + WS_QCTR);
  if (threadIdx.x < 128) {
    const int nn = threadIdx.x;
    int v = nn;
    if (nn >= 16) { v = 16 + (int)(logf((float)nn * (1.f / 16.f)) / logf(8.f) * 16.f); if (v > 31) v = 31; }
    bkt[nn] = (unsigned char)v;
  }
  if (threadIdx.x >= 256) ((float*)(bkt + 128))[threadIdx.x - 256] = p.rel_bias[threadIdx.x - 256];
  if (threadIdx.x >= 128 && threadIdx.x < 136) ((float*)(bkt + 128))[256 + threadIdx.x - 128] = -INFINITY;
  if (threadIdx.x < 16) ((unsigned*)(bkt + 128 + 1056))[threadIdx.x] = threadIdx.x < 8 ? 0xFFFFFFFFu : 0u;
  const int my_team = (G % 8 == 0) ? team_index(p, smem) / (G >> 3) : (int)(blockIdx.x & 7);
  constexpr int QN = 544;
#define Q_FETCH(SLOT) do { if (threadIdx.x == 0) { int tm_ = q_team, kk_ = -1; \
      for (int tries_ = 0; tries_ < 8; ++tries_) { \
        const unsigned v_ = __hip_atomic_fetch_add(qctr + 16 * tm_, 1u, __ATOMIC_RELAXED, __HIP_MEMORY_SCOPE_AGENT); \
        if (v_ < (unsigned)QN) { kk_ = (tm_ << 16) | (int)v_; break; } \
        tm_ = (tm_ + 1) & 7; } \
      q_team = tm_; qslot[SLOT] = kk_; } } while (0)
  int q_team = my_team;
  Q_FETCH(0);
  __syncthreads();
  int k = qslot[0];
  int par = 1;
  while (k >= 0) {
    Q_FETCH(par);
    const int bt = k >> 16, kl = k & 0xffff;
    const int kq = kl / 17, kr = kl - kq * 17;
    if (kr < 16) {
      const int tb = 511 - (kq * 16 + kr);
      dsa_item(p, smem, (bt << 9) | tb);
    } else {
      const int r0 = (bt * 32 + kq) * 64;
      quantize_rows_u8<false, true>(p.peer_u, p.ws + WS_U, (float*)(p.ws + WS_U + (size_t)16384 * 1024), r0, r0 + 64);
      quantize_rows_u8<true, false>(p.peer_v, p.ws + WS_V, (float*)(p.ws + WS_V + (size_t)16384 * 1024), r0, r0 + 64);
      __syncthreads();
    }
    k = qslot[par];
    par ^= 1;
  }
#undef Q_FETCH
}

__device__ __forceinline__ void phase_pkeys(const Params& p, unsigned char* smem) {
  unsigned char* ws = p.ws;
  const bf16_t* qp = (const bf16_t*)(ws + WS_PG);
  const bf16_t* keys = (const bf16_t*)(ws + WS_KEYS);
  int* eidx = (int*)(ws + WS_EIDX);
  float* gw = (float*)(ws + WS_GW);
  float* sc = (float*)smem;
  float* s2l = (float*)smem;
  unsigned short* i1l = (unsigned short*)(s2l + 256 * 17);
  unsigned short* i2l = i1l + 256 * 16;
  const int tid = threadIdx.x, lane = tid & 63, w = tid >> 6, wm = w >> 1, wn = w & 1, l15 = lane & 15, g = lane >> 4;
  for (int item = blockIdx.x; item < 128 * 8; item += gridDim.x) {
    const int h = item & 7, tm = item >> 3;
    float s1[16], s2v[16]; int i1[16], i2[16];
#pragma unroll
    for (int ph = 0; ph < 2; ++ph) {
      const int hp = h * 2 + ph;
      f32x4 acc[4][4]; zero_acc(acc);
      gemm_tile(qp + (size_t)tm * 256 * 2048 + hp * 128, 2048, keys + (size_t)(ph * 8 + h) * 128 * 128, 128, 2, acc, smem);
      __syncthreads();
#pragma unroll
      for (int m = 0; m < 4; ++m)
#pragma unroll
        for (int n = 0; n < 4; ++n)
#pragma unroll
          for (int j = 0; j < 4; ++j) sc[(wm * 64 + m * 16 + 4 * g + j) * 129 + wn * 64 + n * 16 + l15] = acc[m][n][j];
      __syncthreads();
      if (tid < 256) {
        const float* rowp = sc + tid * 129;
        unsigned tv[16];
#pragma unroll
        for (int k = 0; k < 16; ++k) tv[k] = 0u;
#pragma unroll 8
        for (int nn = 0; nn < 128; ++nn) {
          const unsigned bits = __float_as_uint(rowp[nn]);
          unsigned key = (bits & 0x80000000u) ? ~bits : (bits | 0x80000000u);
          key = (key & ~127u) | (unsigned)(127 - nn);
#pragma unroll
          for (int k = 15; k >= 1; --k) {
            unsigned r;
            asm("v_med3_u32 %0, %1, %2, %3" : "=v"(r) : "v"(tv[k]), "v"(tv[k - 1]), "v"(key));
            tv[k] = r;
          }
          tv[0] = tv[0] > key ? tv[0] : key;
        }
#pragma unroll
        for (int k = 0; k < 16; ++k) {
          const int col = 127 - (int)(tv[k] & 127u);
          const float val = rowp[col];
          if (ph == 0) { i1[k] = col; s1[k] = val; } else { i2[k] = col; s2v[k] = val; }
        }
      }
      __syncthreads();
    }
    if (tid < 256) {
#pragma unroll
      for (int a = 0; a < 16; ++a) { s2l[tid * 17 + a] = s2v[a]; i1l[tid * 16 + a] = (unsigned short)i1[a]; i2l[tid * 16 + a] = (unsigned short)i2[a]; }
      float cur[16];
#pragma unroll
      for (int a = 0; a < 16; ++a) cur[a] = s1[a] + s2v[0];
      unsigned long long ptr = 0ull;
      float tops[16]; int tope[16];
#pragma unroll
      for (int k = 0; k < 16; ++k) {
        float best = cur[0]; int ba = 0;
#pragma unroll
        for (int a = 1; a < 16; ++a) if (cur[a] > best) { best = cur[a]; ba = a; }
        const int bb = (int)((ptr >> (4 * ba)) & 15ull);
        tops[k] = best;
        tope[k] = (int)i1l[tid * 16 + ba] * 128 + (int)i2l[tid * 16 + bb];
        const int nb = bb + 1;
        const float ns2 = (nb < 16) ? s2l[tid * 17 + nb] : -INFINITY;
        if (nb < 16) ptr += (1ull << (4 * ba));
#pragma unroll
        for (int a = 0; a < 16; ++a) if (a == ba) cur[a] = s1[a] + ns2;
      }
      const float m = tops[0];
      float sum = 0.f;
#pragma unroll
      for (int k = 0; k < 16; ++k) { tops[k] = __expf(tops[k] - m); sum += tops[k]; }
      const float inv = 1.f / sum;
      const size_t ob = ((size_t)(tm * 256 + tid) * 8 + h) * 16;
#pragma unroll
      for (int k = 0; k < 16; k += 4) {
        *(int4*)(eidx + ob + k) = make_int4(tope[k], tope[k + 1], tope[k + 2], tope[k + 3]);
        *(float4*)(gw + ob + k) = make_float4(tops[k] * inv, tops[k + 1] * inv, tops[k + 2] * inv, tops[k + 3] * inv);
      }
    }
    __syncthreads();
  }
}


__device__ __forceinline__ float reduce8(const float (&pv)[8], int lane) {
  const bool b5 = lane & 32, b4 = lane & 16, b3 = lane & 8;
  float v[4];
#pragma unroll
  for (int i = 0; i < 4; ++i) {
    const float keep = b5 ? pv[4 + i] : pv[i];
    const float send = b5 ? pv[i] : pv[4 + i];
    v[i] = keep + __shfl_xor(send, 32);
  }
  float u[2];
#pragma unroll
  for (int i = 0; i < 2; ++i) {
    const float keep = b4 ? v[2 + i] : v[i];
    const float send = b4 ? v[i] : v[2 + i];
    u[i] = keep + __shfl_xor(send, 16);
  }
  float x = (b3 ? u[1] : u[0]) + __shfl_xor(b3 ? u[0] : u[1], 8);
  x += __shfl_xor(x, 4); x += __shfl_xor(x, 2); x += __shfl_xor(x, 1);
  return x;
}

__device__ __forceinline__ void cvt16u8(const uint4& v, float* f) {
  f[0] = (float)(v.x & 0xffu); f[1] = (float)((v.x >> 8) & 0xffu); f[2] = (float)((v.x >> 16) & 0xffu); f[3] = (float)(v.x >> 24);
  f[4] = (float)(v.y & 0xffu); f[5] = (float)((v.y >> 8) & 0xffu); f[6] = (float)((v.y >> 16) & 0xffu); f[7] = (float)(v.y >> 24);
  f[8] = (float)(v.z & 0xffu); f[9] = (float)((v.z >> 8) & 0xffu); f[10] = (float)((v.z >> 16) & 0xffu); f[11] = (float)(v.z >> 24);
  f[12] = (float)(v.w & 0xffu); f[13] = (float)((v.w >> 8) & 0xffu); f[14] = (float)((v.w >> 16) & 0xffu); f[15] = (float)(v.w >> 24);
}

__device__ __forceinline__ int wave_sum_i32_dpp(int v) {
  v += __builtin_amdgcn_update_dpp(0, v, 0xB1, 0xf, 0xf, true);
  v += __builtin_amdgcn_update_dpp(0, v, 0x4E, 0xf, 0xf, true);
  v += __builtin_amdgcn_update_dpp(0, v, 0x141, 0xf, 0xf, true);
  v += __builtin_amdgcn_update_dpp(0, v, 0x140, 0xf, 0xf, true);
  return __builtin_amdgcn_readlane(v, 0) + __builtin_amdgcn_readlane(v, 16) + __builtin_amdgcn_readlane(v, 32) + __builtin_amdgcn_readlane(v, 48);
}

__device__ __forceinline__ int reduce8_i32_scatter(const int (&d)[8], int lane) {
  const bool b0 = lane & 1, b1 = lane & 2, b2 = lane & 4;
  int v[4];
#pragma unroll
  for (int i = 0; i < 4; ++i) {
    const int keep = b0 ? d[2 * i + 1] : d[2 * i];
    const int send = b0 ? d[2 * i] : d[2 * i + 1];
    v[i] = keep + __builtin_amdgcn_update_dpp(0, send, 0xB1, 0xf, 0xf, true);
  }
  int u[2];
#pragma unroll
  for (int i = 0; i < 2; ++i) {
    const int keep = b1 ? v[2 * i + 1] : v[2 * i];
    const int send = b1 ? v[2 * i] : v[2 * i + 1];
    u[i] = keep + __builtin_amdgcn_update_dpp(0, send, 0x4E, 0xf, 0xf, true);
  }
  int x;
  {
    const int keep = b2 ? u[1] : u[0];
    const int send = b2 ? u[0] : u[1];
    int t = __builtin_amdgcn_update_dpp(0, send, 0x141, 0xf, 0xf, true);
    t = __builtin_amdgcn_update_dpp(0, t, 0x1B, 0xf, 0xf, true);
    x = keep + t;
  }
  x += __builtin_amdgcn_update_dpp(0, x, 0x128, 0xf, 0xf, true);
  { const auto r = __builtin_amdgcn_permlane16_swap((unsigned)x, (unsigned)x, false, false); x = (int)r[0] + (int)r[1]; }
  { const auto r = __builtin_amdgcn_permlane32_swap((unsigned)x, (unsigned)x, false, false); x = (int)r[0] + (int)r[1]; }
  return x;
}

__device__ __forceinline__ void phase_pu(const Params& p, unsigned char* smem) {
  unsigned char* ws = p.ws;
  const unsigned char* XQ = ws + WS_XQ;
  const float* xs = (const float*)(ws + WS_XS);
  const unsigned char* U8 = ws + WS_U;
  const float* us = (const float*)(ws + WS_U + (size_t)16384 * 1024);
  const float* vs = (const float*)(ws + WS_V + (size_t)16384 * 1024);
  const int* eidx = (const int*)(ws + WS_EIDX);
  const float* gw = (const float*)(ws + WS_GW);
  float* aw = (float*)(ws + WS_PA);
  const int lane = threadIdx.x & 63, w = threadIdx.x >> 6;
  const unsigned long long lt_mask = (1ull << lane) - 1ull;
  const int G = gridDim.x;
  const bool sliced = (G % 8 == 0);
  const int ti = sliced ? team_index(p, smem) : 0;
  const int tsz = sliced ? (G >> 3) : G;
  const int grp_lo = sliced ? ti / tsz : 0, grp_hi = sliced ? grp_lo + 1 : 8;
  const int slot = (sliced ? (ti % tsz) : (int)blockIdx.x) * 8 + w;
  const int nslot = tsz * 8;
  unsigned* lst = (unsigned*)smem + 4096 + w * 128;
  typedef unsigned u32x4_t __attribute__((ext_vector_type(4)));
  if (slot >= TOK) return;
  for (int grp = grp_lo; grp < grp_hi; ++grp) {
#define PU_LIST(E0, E1, N, L0, L1) do { \
      const bool m0_ = ((E0) >> 11) == grp, m1_ = ((E1) >> 11) == grp; \
      const unsigned long long b0_ = __ballot(m0_), b1_ = __ballot(m1_); \
      const int c0_ = __popcll(b0_); N = c0_ + __popcll(b1_); \
      if (m0_) lst[__popcll(b0_ & lt_mask)] = ((unsigned)lane << 14) | (unsigned)(E0); \
      if (m1_) lst[c0_ + __popcll(b1_ & lt_mask)] = ((unsigned)(lane + 64) << 14) | (unsigned)(E1); \
      lds_fence(); \
      L0 = (lane < N) ? lst[lane] : 0u; L1 = (lane + 64 < N) ? lst[lane + 64] : 0u; \
      lds_fence(); } while (0)
#define PU_ISSUE(BUF, L0, N, I0) do { int last_ = ((N) < 64 ? (N) : 64) - 1; last_ = last_ < 0 ? 0 : last_; \
      _Pragma("unroll") for (int j = 0; j < 8; ++j) { int idx_ = (I0) + j; idx_ = idx_ < last_ ? idx_ : last_; \
        const unsigned le_ = (unsigned)__builtin_amdgcn_readlane((int)(L0), idx_); \
        BUF[j] = *(const u32x4_t*)(U8 + (size_t)(le_ & 16383u) * 1024 + lane * 16); } } while (0)
#define PU_REDUCE(BUF, X, I0, HREG) do { int dd_[8]; _Pragma("unroll") for (int j = 0; j < 8; ++j) { \
        int d_ = __builtin_amdgcn_sdot4((int)BUF[j].x, (int)(X).x, 0, false); \
        d_ = __builtin_amdgcn_sdot4((int)BUF[j].y, (int)(X).y, d_, false); \
        d_ = __builtin_amdgcn_sdot4((int)BUF[j].z, (int)(X).z, d_, false); \
        dd_[j] = __builtin_amdgcn_sdot4((int)BUF[j].w, (int)(X).w, d_, false); } \
      const int tot_ = reduce8_i32_scatter(dd_, lane);     \
      if (lane >= (I0) && lane < (I0) + 8) HREG = tot_; } while (0)
    u32x4_t cx = *(const u32x4_t*)(XQ + (size_t)slot * 1024 + lane * 16);
    int ce0 = eidx[(size_t)slot * 128 + lane], ce1 = eidx[(size_t)slot * 128 + 64 + lane];
    float cxs = xs[slot];
    int cn; unsigned cl0, cl1;
    PU_LIST(ce0, ce1, cn, cl0, cl1);
    u32x4_t ra[8], rb[8], rc[8];
    PU_ISSUE(ra, cl0, cn, 0);
    PU_ISSUE(rb, cl0, cn, 8);
    int t1 = (slot + nslot < TOK) ? slot + nslot : slot;
    u32x4_t nx = *(const u32x4_t*)(XQ + (size_t)t1 * 1024 + lane * 16);
    int ne0 = eidx[(size_t)t1 * 128 + lane], ne1 = eidx[(size_t)t1 * 128 + 64 + lane];
    float nxs = xs[t1];
    for (int tok = slot; tok < TOK; tok += nslot) {
      float sc0 = 0.f, sc1 = 0.f, gv0 = 0.f, gv1 = 0.f, vv0 = 0.f, vv1 = 0.f;
      if (lane < cn) { const int e = cl0 & 16383; sc0 = us[e]; vv0 = vs[e]; gv0 = gw[(size_t)tok * 128 + (cl0 >> 14)]; }
      if (lane + 64 < cn) { const int e = cl1 & 16383; sc1 = us[e]; vv1 = vs[e]; gv1 = gw[(size_t)tok * 128 + (cl1 >> 14)]; }
      int nn; unsigned nl0, nl1;
      PU_LIST(ne0, ne1, nn, nl0, nl1);
      const u32x4_t x1 = nx; const int xe0 = ne0, xe1 = ne1; const float xs1 = nxs;
      const int t2a = tok + nslot, t2 = (t2a + nslot < TOK) ? t2a + nslot : ((t2a < TOK) ? t2a : tok);
      nx = *(const u32x4_t*)(XQ + (size_t)t2 * 1024 + lane * 16);
      ne0 = eidx[(size_t)t2 * 128 + lane]; ne1 = eidx[(size_t)t2 * 128 + 64 + lane];
      nxs = xs[t2];
      int h0i = 0, h1i = 0;
      const bool third = cn > 16;
      if (third) { PU_ISSUE(rc, cl0, cn, 16); }
      __builtin_amdgcn_sched_barrier(0); PU_REDUCE(ra, cx, 0, h0i);  __builtin_amdgcn_sched_barrier(0);
      PU_ISSUE(ra, nl0, nn, 0);  __builtin_amdgcn_sched_barrier(0); PU_REDUCE(rb, cx, 8, h0i);  __builtin_amdgcn_sched_barrier(0);
      PU_ISSUE(rb, nl0, nn, 8);  __builtin_amdgcn_sched_barrier(0);
      if (third) { PU_REDUCE(rc, cx, 16, h0i); }
      __builtin_amdgcn_sched_barrier(0);
      if (cn > 24) {
        for (int i0 = 24; i0 < cn; i0 += 8) {
          u32x4_t rd[8];
          const bool lo = i0 < 64;
          const unsigned lsrc = lo ? cl0 : cl1;
          const int nsrc = lo ? cn : cn - 64;
          PU_ISSUE(rd, lsrc, nsrc, i0 & 63);
          if (lo) { PU_REDUCE(rd, cx, i0, h0i); } else { PU_REDUCE(rd, cx, i0 - 64, h1i); }
        }
      }
      const float h0 = (float)h0i * sc0 * cxs, h1 = (float)h1i * sc1 * cxs;
      if (lane < cn) aw[(size_t)tok * 128 + (cl0 >> 14)] = 0.5f * h0 * (1.f + erff(h0 * 0.70710678118654752f)) * gv0 * vv0;
      if (lane + 64 < cn) aw[(size_t)tok * 128 + (cl1 >> 14)] = 0.5f * h1 * (1.f + erff(h1 * 0.70710678118654752f)) * gv1 * vv1;
      cx = x1; ce0 = xe0; ce1 = xe1; cxs = xs1; cn = nn; cl0 = nl0; cl1 = nl1;
    }
#undef PU_LIST
#undef PU_ISSUE
#undef PU_REDUCE
  }
}

template <bool SL>
__device__ __forceinline__ void phase_pv_t(const Params& p, unsigned char* smem) {
  unsigned char* ws = p.ws;
  const unsigned char* V8 = ws + WS_V;
  const int* eidx = (const int*)(ws + WS_EIDX);
  const float* aw = (const float*)(ws + WS_PA);
  float* ssq = (float*)(ws + WS_SSQ);
  const int lane = threadIdx.x & 63, w = threadIdx.x >> 6;
  const int q = lane >> 3, c = lane & 7;
  const int G = gridDim.x;
  constexpr bool sliced = SL;
  const int ti = sliced ? team_index(p, smem) : 0;
  const int tsz = G >> 3;
  const int grp0 = sliced ? (ti / tsz) : 0;
  constexpr int ngrp = sliced ? 1 : 8;
  const int slot = sliced ? (ti % tsz) * 8 + w : blockIdx.x * 8 + w;
  const int nslot = sliced ? tsz * 8 : G * 8;
  int ee[16]; float aa[16];
  if (slot < TOK) {
    unsigned bi = (unsigned)slot * 128u + 16u * (unsigned)q;
    asm volatile("" : "+v"(bi));
#pragma unroll
    for (int u4 = 0; u4 < 4; ++u4) {
      const int4 e4 = *(const int4*)(eidx + bi + 4 * u4); const float4 a4 = *(const float4*)(aw + bi + 4 * u4);
      ee[4 * u4] = e4.x; ee[4 * u4 + 1] = e4.y; ee[4 * u4 + 2] = e4.z; ee[4 * u4 + 3] = e4.w;
      aa[4 * u4] = a4.x; aa[4 * u4 + 1] = a4.y; aa[4 * u4 + 2] = a4.z; aa[4 * u4 + 3] = a4.w;
    }
  }
  for (int tok = slot; tok < TOK; tok += nslot) {
    int ce[16]; float ca[16];
    float suma = 0.f;
#pragma unroll
    for (int u = 0; u < 16; ++u) { ce[u] = ee[u]; ca[u] = aa[u]; suma += aa[u]; }
    for (int gi = 0; gi < ngrp; ++gi) {
      const int grp = grp0 + gi;
      uint4 vv[16];
#pragma unroll
      for (int u = 0; u < 16; ++u) vv[u] = *(const uint4*)(V8 + (size_t)grp * (16384 * 128) + (size_t)ce[u] * 128 + c * 16);
      float* orow = p.out + (size_t)tok * 1024 + grp * 128 + c * 16;
      float4 x1v[4];
#pragma unroll
      for (int i = 0; i < 4; ++i) x1v[i] = *(const float4*)(orow + 4 * i);
      if (gi == ngrp - 1) {
        const int nt = (tok + nslot < TOK) ? tok + nslot : tok;
        unsigned bi = (unsigned)nt * 128u + 16u * (unsigned)q;
        asm volatile("" : "+v"(bi));
#pragma unroll
        for (int u4 = 0; u4 < 4; ++u4) {
          const int4 e4 = *(const int4*)(eidx + bi + 4 * u4); const float4 a4 = *(const float4*)(aw + bi + 4 * u4);
          ee[4 * u4] = e4.x; ee[4 * u4 + 1] = e4.y; ee[4 * u4 + 2] = e4.z; ee[4 * u4 + 3] = e4.w;
          aa[4 * u4] = a4.x; aa[4 * u4 + 1] = a4.y; aa[4 * u4 + 2] = a4.z; aa[4 * u4 + 3] = a4.w;
        }
      }
      __builtin_amdgcn_sched_barrier(0);
      float acc[16];
#pragma unroll
      for (int i = 0; i < 16; ++i) acc[i] = -128.f * suma;
#pragma unroll
      for (int u = 0; u < 16; ++u) {
        float vf[16];
        cvt16u8(vv[u], vf);
#pragma unroll
        for (int i = 0; i < 16; ++i) acc[i] += ca[u] * vf[i];
        __builtin_amdgcn_sched_barrier(0);
      }
#pragma unroll
      for (int i = 0; i < 16; ++i) { acc[i] = add_xor8(acc[i]); acc[i] = add_xor16(acc[i]); acc[i] = add_xor32(acc[i]); }
      float ss = 0.f;
      if (q == 0) {
#pragma unroll
        for (int i = 0; i < 4; ++i) {
          const float4 oa = make_float4(x1v[i].x + acc[4 * i], x1v[i].y + acc[4 * i + 1], x1v[i].z + acc[4 * i + 2], x1v[i].w + acc[4 * i + 3]);
          *(float4*)(orow + 4 * i) = oa;
          ss += oa.x * oa.x + oa.y * oa.y + oa.z * oa.z + oa.w * oa.w;
        }
      }
      ss += __shfl_xor(ss, 1); ss += __shfl_xor(ss, 2); ss += __shfl_xor(ss, 4);
      if (lane == 0) atomicAdd(&ssq[tok], ss);
    }
  }
}

__device__ __forceinline__ void phase_final(const Params& p) {
  const float* ssq = (const float*)(p.ws + WS_SSQ);
  const int lane = threadIdx.x & 63, w = threadIdx.x >> 6;
  for (int row = blockIdx.x * 8 + w; row < TOK; row += gridDim.x * 8) {
    const float rstd = rsqrtf(ssq[row] * (1.f / DM) + EPSV);
    float4* o4 = (float4*)(p.out + (size_t)row * DM);
#pragma unroll
    for (int i = 0; i < 4; ++i) {
      float4 v = o4[lane + 64 * i];
      const float4 gg = ((const float4*)p.norm_final)[lane + 64 * i];
      v.x *= rstd * gg.x; v.y *= rstd * gg.y; v.z *= rstd * gg.z; v.w *= rstd * gg.w;
      o4[lane + 64 * i] = v;
    }
  }
}


__device__ __forceinline__ void phase_proj8(const Params& p, unsigned char* smem) {
  unsigned char* ws = p.ws;
  pg8::Gemm g{(const pg8::bf16_t*)(ws + WS_XN), (const pg8::bf16_t*)(ws + WS_WIN), TOK, 5120, 1024};
  pg8::StaticOrder S; S.init(TOK, 5120, (int)gridDim.x, (int)blockIdx.x);
  EpiProj E{(unsigned short*)(ws + WS_PH), (unsigned short*)(ws + WS_PA), (unsigned short*)(ws + WS_PG),
            (unsigned short*)(ws + WS_KC), (unsigned short*)(ws + WS_VC), (unsigned short*)(ws + WS_IKC)};
  pg8::gemm_phase<EpiProj, pg8::StaticOrder>((PG8_LAS unsigned char*)smem, g, S, E, nullptr);
}
__device__ __forceinline__ void phase_ikln(const Params& p) {
  bf16_t* ikc = (bf16_t*)(p.ws + WS_IKC);
  const int tid = threadIdx.x, sub = tid & 7;
  float gam[8], bet[8];
#pragma unroll
  for (int i = 0; i < 8; ++i) { gam[i] = p.ikg[sub * 8 + i]; bet[i] = p.ikb[sub * 8 + i]; }
  for (int row = blockIdx.x * 64 + (tid >> 3); row < TOK; row += gridDim.x * 64) {
    uint4* ptr = (uint4*)(ikc + (size_t)row * 64 + sub * 8);
    const uint4 raw = *ptr;
    float v[8];
    cvt8(raw, v);
    float s = 0.f;
#pragma unroll
    for (int i = 0; i < 8; ++i) s += v[i];
    s += __shfl_xor(s, 1); s += __shfl_xor(s, 2); s += __shfl_xor(s, 4);
    const float mu = s * (1.f / 64.f);
    float q = 0.f;
#pragma unroll
    for (int i = 0; i < 8; ++i) { const float d = v[i] - mu; q += d * d; }
    q += __shfl_xor(q, 1); q += __shfl_xor(q, 2); q += __shfl_xor(q, 4);
    const float rstd = rsqrtf(q * (1.f / 64.f) + EPSV);
    uint4 o;
    o.x = pack2((v[0] - mu) * rstd * gam[0] + bet[0], (v[1] - mu) * rstd * gam[1] + bet[1]);
    o.y = pack2((v[2] - mu) * rstd * gam[2] + bet[2], (v[3] - mu) * rstd * gam[3] + bet[3]);
    o.z = pack2((v[4] - mu) * rstd * gam[4] + bet[4], (v[5] - mu) * rstd * gam[5] + bet[5]);
    o.w = pack2((v[6] - mu) * rstd * gam[6] + bet[6], (v[7] - mu) * rstd * gam[7] + bet[7]);
    *ptr = o;
  }
}
__device__ __forceinline__ void phase_up8(const Params& p, unsigned char* smem) {
  unsigned char* ws = p.ws;
  const pg8::bf16_t* ya = (const pg8::bf16_t*)(ws + WS_XN);
  const pg8::bf16_t* yb = ya + (size_t)TOK * 512;
  pg8::StaticOrder S; S.init(TOK, 1024, (int)gridDim.x, (int)blockIdx.x);
  {
    pg8::Gemm g{ya, (const pg8::bf16_t*)(ws + WS_WUPA), TOK, 1024, 512};
    EpiGate<0> E{(unsigned short*)(ws + WS_PH), (const unsigned short*)(ws + WS_PG), 0};
    pg8::gemm_phase<EpiGate<0>, pg8::StaticOrder>((PG8_LAS unsigned char*)smem, g, S, E, nullptr);
  }
  {
    pg8::Gemm g{yb, (const pg8::bf16_t*)(ws + WS_WUPB), TOK, 1024, 512};
    EpiGate<1> E{(unsigned short*)(ws + WS_PH), (const unsigned short*)(ws + WS_PG), 1024};
    pg8::gemm_phase<EpiGate<1>, pg8::StaticOrder>((PG8_LAS unsigned char*)smem, g, S, E, nullptr);
  }
}
__device__ __forceinline__ void phase_out8(const Params& p, unsigned char* smem) {
  unsigned char* ws = p.ws;
  pg8::Gemm g{(const pg8::bf16_t*)(ws + WS_PH), (const pg8::bf16_t*)(ws + WS_WOUT), TOK, 1024, 1024};
  pg8::StaticOrder S; S.init(TOK, 1024, (int)gridDim.x, (int)blockIdx.x);
  EpiResid E{p.out, p.x};
  pg8::gemm_phase<EpiResid, pg8::StaticOrder>((PG8_LAS unsigned char*)smem, g, S, E, nullptr);
}
__device__ __forceinline__ void phase_pq8(const Params& p, unsigned char* smem) {
  unsigned char* ws = p.ws;
  pg8::Gemm g{(const pg8::bf16_t*)(ws + WS_XN), (const pg8::bf16_t*)(ws + WS_WQ), TOK, 2048, 1024};
  pg8::StaticOrder S; S.init(TOK, 2048, (int)gridDim.x, (int)blockIdx.x);
  EpiStoreBf16 E{(unsigned short*)(ws + WS_PG), 2048};
  pg8::gemm_phase<EpiStoreBf16, pg8::StaticOrder>((PG8_LAS unsigned char*)smem, g, S, E, nullptr);
}

__global__ void __launch_bounds__(NTHREADS) hybrid_fwd(Params p) {
  extern __shared__ __attribute__((aligned(16))) unsigned char smem[];
#if ONE_LAUNCH
  cg::grid_group grid = cg::this_grid();
  volatile LAS unsigned* xst = (volatile LAS unsigned*)(smem + LDS_BYTES - 16);
  if (threadIdx.x == 0) { xst[0] = 0u; xst[1] = 0u; }
  __syncthreads();
  XcdBarrier xbar = xcd_barrier_post((unsigned*)(p.ws + WS_BAR), xst);
#define SEAM(k) do { if (p.ph_lo <= (k) && (k) + 1 < p.ph_hi) { if (p.ph_hi > NPHASE) grid.sync(); else xcd_barrier(xbar); } } while (0)
#else
#define SEAM(k) do { } while (0)
#endif
#define IN(k) (p.ph_lo <= (k) && (k) < p.ph_hi)
#ifndef REPEAT_PH
#define REPEAT_PH -1
#endif
#define REP(k, stmt) do { if (REPEAT_PH == (k)) { stmt; grid.sync(); } } while (0)
  if (IN(0)) { phase_prep(p, smem); SEAM(0); }
  if (IN(1)) { phase_proj8(p, smem); SEAM(1); }
  if (IN(2)) { phase_ikln(p); hgrn_h1_all(p, smem); SEAM(2); }
  if (IN(3)) { phase_mix(p, smem); SEAM(3); }
  if (IN(4)) { phase_up8(p, smem); SEAM(4); }
  if (IN(5)) { phase_out8(p, smem); SEAM(5); }
  if (IN(6)) { rmsnorm_rows_q(p.out, p.norm_ffn, (bf16_t*)(p.ws + WS_XN), p.ws + WS_XQ, (float*)(p.ws + WS_XS)); SEAM(6); }
  if (IN(7)) { phase_pq8(p, smem); SEAM(7); }
  if (IN(8)) { phase_pkeys(p, smem); SEAM(8); }
  if (IN(9)) { phase_pu(p, smem); SEAM(9); }
  if (IN(10)) { if (gridDim.x % 8 == 0) phase_pv_t<true>(p, smem); else phase_pv_t<false>(p, smem); SEAM(10); }
  if (IN(11)) { phase_final(p); }
#undef IN
#undef SEAM
}

extern "C" void kernel_launch(void* const* d_in, const int* in_sizes, int n_in, void* d_out, int out_size, void* d_ws, size_t ws_size,
                              hipStream_t stream) {
  static int grid = 0;
  if (grid == 0) {
    if (n_in != 17 || ws_size < WS_END) {
      fprintf(stderr, "kernel_launch: unexpected n_in %d or ws_size %zu (need %zu)\n", n_in, ws_size, (size_t)WS_END);
      grid = -1; return;
    }
    int dev = 0, cus = 0, per_cu = 0;
    hipGetDevice(&dev);
    hipDeviceGetAttribute(&cus, hipDeviceAttributeMultiprocessorCount, dev);
    hipFuncSetAttribute((const void*)hybrid_fwd, hipFuncAttributeMaxDynamicSharedMemorySize, LDS_BYTES);
    hipOccupancyMaxActiveBlocksPerMultiprocessor(&per_cu, (const void*)hybrid_fwd, NTHREADS, LDS_BYTES);
    if (per_cu < 1) { fprintf(stderr, "kernel_launch: occupancy query says %d blocks/CU\n", per_cu); per_cu = 1; }
    (void)hipGetLastError();
    grid = cus;
  }
  if (grid < 0) return;
  Params p{};
  p.x = (const float*)d_in[0]; p.norm_mix = (const float*)d_in[1]; p.w_in = (const float*)d_in[2]; p.hg_lb = (const float*)d_in[3];
  p.hg_norm = (const float*)d_in[4]; p.ikg = (const float*)d_in[5]; p.ikb = (const float*)d_in[6]; p.rel_bias = (const float*)d_in[7];
  p.w_up_a = (const float*)d_in[8]; p.w_up_b = (const float*)d_in[9]; p.w_out = (const float*)d_in[10]; p.norm_ffn = (const float*)d_in[11];
  p.peer_wq = (const float*)d_in[12]; p.peer_keys = (const float*)d_in[13]; p.peer_u = (const float*)d_in[14]; p.peer_v = (const float*)d_in[15];
  p.norm_final = (const float*)d_in[16];
  p.out = (float*)d_out; p.ws = (unsigned char*)d_ws;
#if ONE_LAUNCH
  hipMemsetAsync((unsigned char*)d_ws + WS_BAR, 0, 16384, stream);
  p.ph_lo = 0; p.ph_hi = NPHASE;
  void* args[] = {&p};
  hipError_t e = hipLaunchCooperativeKernel((const void*)hybrid_fwd, dim3(grid), dim3(NTHREADS), args, LDS_BYTES, stream);
  if (e != hipSuccess) fprintf(stderr, "cooperative launch failed: %s (grid %d)\n", hipGetErrorString(e), grid);
#else
  for (int ph = 0; ph < NPHASE; ++ph) {
    p.ph_lo = ph; p.ph_hi = ph + 1;
    hipLaunchKernelGGL(hybrid_fwd, dim3(grid), dim3(NTHREADS), LDS_BYTES, stream, p);
  }
#endif
}
```

```cpp
#include <hip/hip_runtime.h>
#include <hip/hip_cooperative_groups.h>
#include <stdint.h>
#include <stdio.h>
namespace cg = cooperative_groups;

#ifndef ONE_LAUNCH
#define ONE_LAUNCH 1
#endif

typedef unsigned short bf16_t;
typedef __attribute__((ext_vector_type(8))) short bf16x8;
typedef __attribute__((ext_vector_type(4))) float f32x4;

#define NTHREADS 512
#define TOK 32768
#define SEQL 4096
#define DM 1024
#define EPSV 1e-6f
#define NPHASE 12

#define WS_WIN   ((size_t)0)
#define WS_WUPA  (WS_WIN  + (size_t)5120 * 1024 * 2)
#define WS_WUPB  (WS_WUPA + (size_t)1024 * 512 * 2)
#define WS_WOUT  (WS_WUPB + (size_t)1024 * 512 * 2)
#define WS_WQ    (WS_WOUT + (size_t)1024 * 1024 * 2)
#define WS_KEYS  (WS_WQ   + (size_t)2048 * 1024 * 2)
#define WS_LB    (WS_KEYS + (size_t)2 * 8 * 128 * 128 * 2)
#define WS_U     (WS_LB   + (size_t)4096)
#define WS_V     (WS_U    + (size_t)16384 * 1024 * 2)
#define WS_XN    (WS_V    + (size_t)16384 * 1024 * 2)
#define WS_PH    (WS_XN   + (size_t)TOK * 1024 * 2)
#define WS_PA    (WS_PH   + (size_t)TOK * 2048 * 2)
#define WS_PG    (WS_PA   + (size_t)TOK * 1024 * 2)
#define WS_EIDX  (WS_PG   + (size_t)TOK * 2048 * 2)
#define WS_GW    (WS_EIDX + (size_t)TOK * 128 * 4)
#define WS_SSQ   (WS_GW   + (size_t)TOK * 128 * 4)
#define WS_XCC   (WS_SSQ  + (size_t)TOK * 4)
#define WS_BAR   (WS_XCC  + (size_t)4096)
#define WS_DEC   (WS_BAR  + (size_t)16384)
#define WS_QCTR  (WS_DEC  + (size_t)2048 * 384 * 4)
#define WS_END   (WS_QCTR + (size_t)1024)

#define WS_KC (WS_EIDX)
#define WS_VC (WS_KC + (size_t)TOK * 128)
#define WS_IKC (WS_VC + (size_t)TOK * 128)
#define LDS_BYTES 155648

struct Params {
  const float* x; const float* norm_mix; const float* w_in; const float* hg_lb; const float* hg_norm;
  const float* ikg; const float* ikb; const float* rel_bias; const float* w_up_a; const float* w_up_b;
  const float* w_out; const float* norm_ffn; const float* peer_wq; const float* peer_keys;
  const float* peer_u; const float* peer_v; const float* norm_final;
  float* out; unsigned char* ws; int ph_lo, ph_hi;
};

__device__ __forceinline__ float bf2f(bf16_t u) { return __uint_as_float(((unsigned)u) << 16); }
typedef float f32x2_cv __attribute__((ext_vector_type(2)));
typedef __bf16 bf16x2_cv __attribute__((ext_vector_type(2)));
__device__ __forceinline__ unsigned pack2(float a, float b) {
  const f32x2_cv v = {a, b};
  return __builtin_bit_cast(unsigned, __builtin_convertvector(v, bf16x2_cv));
}
__device__ __forceinline__ bf16_t f2bf(float f) { return (bf16_t)(pack2(f, f) & 0xffffu); }
__device__ __forceinline__ float wave_sum_slow(float v) {
#pragma unroll
  for (int o = 32; o > 0; o >>= 1) v += __shfl_xor(v, o);
  return v;
}
__device__ __forceinline__ void lds_fence() { asm volatile("s_waitcnt lgkmcnt(0)" ::: "memory"); }

__device__ __forceinline__ float add_xor8(float v) { return v + __int_as_float(__builtin_amdgcn_update_dpp(0, __float_as_int(v), 0x128, 0xf, 0xf, true)); }
__device__ __forceinline__ float add_xor16(float v) { const auto r = __builtin_amdgcn_permlane16_swap(__float_as_uint(v), __float_as_uint(v), false, false); return __uint_as_float(r[0]) + __uint_as_float(r[1]); }
__device__ __forceinline__ float add_xor32(float v) { const auto r = __builtin_amdgcn_permlane32_swap(__float_as_uint(v), __float_as_uint(v), false, false); return __uint_as_float(r[0]) + __uint_as_float(r[1]); }
__device__ __forceinline__ float max_xor16(float v) { const auto r = __builtin_amdgcn_permlane16_swap(__float_as_uint(v), __float_as_uint(v), false, false); return fmaxf(__uint_as_float(r[0]), __uint_as_float(r[1])); }
__device__ __forceinline__ float max_xor32(float v) { const auto r = __builtin_amdgcn_permlane32_swap(__float_as_uint(v), __float_as_uint(v), false, false); return fmaxf(__uint_as_float(r[0]), __uint_as_float(r[1])); }
__device__ __forceinline__ float wave_sum(float v) {
  v += __int_as_float(__builtin_amdgcn_update_dpp(0, __float_as_int(v), 0xB1, 0xf, 0xf, true));
  v += __int_as_float(__builtin_amdgcn_update_dpp(0, __float_as_int(v), 0x4E, 0xf, 0xf, true));
  v += __int_as_float(__builtin_amdgcn_update_dpp(0, __float_as_int(v), 0x141, 0xf, 0xf, true));
  v += __int_as_float(__builtin_amdgcn_update_dpp(0, __float_as_int(v), 0x140, 0xf, 0xf, true));
  return add_xor32(add_xor16(v));
}
__device__ __forceinline__ float sigmoidf_(float x) { return 1.f / (1.f + __expf(-x)); }
__device__ __forceinline__ float siluf_(float x) { return x / (1.f + __expf(-x)); }


#define XB_TMO      128
#define XB_XCNT(j)  (256  + 64 * (j))
#define XB_XSUB(j)  (1280 + 64 * (j))
#define XB_XGEN(j)  (2304 + 64 * (j))
#define XB_TOP      3328
#define XB_TOPGEN   3392
#define XCD_BAR_WORDS 3456
#define XB_SPIN_CAP (1u << 22)
#define LAS __attribute__((address_space(3)))
__device__ __forceinline__ unsigned xb_ld(unsigned* p)              { return __hip_atomic_load(p, __ATOMIC_RELAXED, __HIP_MEMORY_SCOPE_AGENT); }
__device__ __forceinline__ unsigned xb_add(unsigned* p, unsigned v) { return __hip_atomic_fetch_add(p, v, __ATOMIC_RELAXED, __HIP_MEMORY_SCOPE_AGENT); }
__device__ __forceinline__ unsigned xb_xcc_id() { return (unsigned)__builtin_amdgcn_s_getreg((3 << 11) | 20) & 0xFu; }
#define XB_SPIN(cond, bar) do { unsigned _sp = 0; while (cond) { __builtin_amdgcn_s_sleep(1); \
    if ((++_sp & 255u) == 0u) { if (xb_ld(&(bar)[XB_TMO])) break; if (_sp > XB_SPIN_CAP) { atomicAdd(&(bar)[XB_TMO], 1u); break; } } } } while (0)
struct XcdBarrier { unsigned* bar; unsigned x; volatile LAS unsigned* st; };
__device__ __forceinline__ XcdBarrier xcd_barrier_post(unsigned* bar, volatile LAS unsigned* st) {
  XcdBarrier b; b.bar = bar; b.x = xb_xcc_id(); b.st = st;
  if (threadIdx.x == 0) (void)xb_add(&bar[XB_XCNT(b.x)], 1u);
  return b;
}
__device__ __forceinline__ void xcd_barrier_complete(unsigned* bar, unsigned x, unsigned& nloc, unsigned& nx) {
  const unsigned G = gridDim.x * gridDim.y * gridDim.z;
  unsigned sum, cnt, mine, sp = 0u;
  for (;;) {
    sum = 0u; cnt = 0u; mine = 0u;
#pragma unroll
    for (unsigned j = 0; j < 16; ++j) { const unsigned c = xb_ld(&bar[XB_XCNT(j)]); sum += c; cnt += (c > 0u) ? 1u : 0u; mine = (j == x) ? c : mine; }
    if (sum == G) break;
    __builtin_amdgcn_s_sleep(1);
    if ((++sp & 255u) == 0u) { if (xb_ld(&bar[XB_TMO])) break; if (sp > XB_SPIN_CAP) { atomicAdd(&bar[XB_TMO], 1u); break; } }
  }
  nloc = mine > 0u ? mine : 1u; nx = cnt > 0u ? cnt : 1u;
}
__device__ __forceinline__ void xcd_barrier(const XcdBarrier& b) {
  asm volatile("s_waitcnt vmcnt(0)" ::: "memory");
  __syncthreads();
  if (threadIdx.x == 0) {
    unsigned* bar = b.bar;
    __builtin_amdgcn_s_waitcnt(0);
    unsigned nloc = b.st[0], nx = b.st[1];
    if (nloc == 0u) { xcd_barrier_complete(bar, b.x, nloc, nx); b.st[0] = nloc; b.st[1] = nx; }
    const unsigned old = xb_add(&bar[XB_XSUB(b.x)], 1u);
    const unsigned gen = old / nloc;
    if (old + 1u == (gen + 1u) * nloc) {
      __builtin_amdgcn_fence(__ATOMIC_RELEASE, "agent");
      asm volatile("s_waitcnt vmcnt(0)" ::: "memory");
      const unsigned og = xb_add(&bar[XB_TOP], 1u);
      const unsigned tg = og / nx;
      if (og + 1u == (tg + 1u) * nx) xb_add(&bar[XB_TOPGEN], 1u);
      else XB_SPIN(xb_ld(&bar[XB_TOPGEN]) == tg, bar);
      __builtin_amdgcn_fence(__ATOMIC_ACQUIRE, "agent");
      xb_add(&bar[XB_XGEN(b.x)], 1u);
      asm volatile("s_waitcnt vmcnt(0)" ::: "memory");
    } else {
      XB_SPIN(xb_ld(&bar[XB_XGEN(b.x)]) == gen, bar);
      __builtin_amdgcn_fence(__ATOMIC_ACQUIRE, "agent");
      asm volatile("s_waitcnt vmcnt(0)" ::: "memory");
    }
  }
  __syncthreads();
}

namespace pg8 {
#define PG8_LAS __attribute__((address_space(3)))
typedef unsigned short bf16_t;
typedef short bf16x8 __attribute__((ext_vector_type(8)));
typedef float f32x4 __attribute__((ext_vector_type(4)));
typedef unsigned u32x4 __attribute__((ext_vector_type(4)));
constexpr int BM = 256, BK = 64, HALF = 128, HTB = HALF * BK * 2  , STAGE_BYTES = 8 * HTB, NXCD = 8, WGM = 8;

__host__ __device__ __forceinline__ int lds_byte(int r, int c) { const int st = (r >> 4) * 2 + (c >> 5), rr = r & 15, cc = c & 31, ob = rr * 64 + cc * 2; return st * 1024 + (ob ^ (((ob >> 9) & 1) << 5)); }
__host__ __device__ __forceinline__ void stage_rc(int b, int& R, int& C) { const int st = b / 1024, sb = b % 1024, swz = sb ^ (((sb >> 9) & 1) << 5); R = (st >> 1) * 16 + swz / 64; C = (st & 1) * 32 + (swz % 64) / 2; }
__host__ __device__ __forceinline__ int perm32(int rho) { const int n = rho >> 4, i = rho & 15; return 8 * (i >> 2) + 4 * n + (i & 3); }

struct Unit { int pm, pn; };
struct Gemm { const bf16_t* A; const bf16_t* Bt; int M, N, K; };

struct StaticOrder {
    int nM, nN, nwg, G, c;
    __host__ __device__ void init(int M, int N, int G_, int c_) { nM = M / BM; nN = N / BM; nwg = nM * nN; G = G_; c = c_; }
    __host__ __device__ bool next(int i, Unit& u) const {
        const long L = (long)i * G + c; if (L >= nwg) return false;
        int wgid = (int)L; { const int q = nwg / NXCD, r = nwg % NXCD, xcd = wgid % NXCD, off = wgid / NXCD; wgid = (xcd < r ? xcd * (q + 1) : r * (q + 1) + (xcd - r) * q) + off; }
        const int nig = WGM * nN, gid = wgid / nig, fm = gid * WGM, gsz = (nM - fm) < WGM ? (nM - fm) : WGM;
        u.pm = fm + ((wgid % nig) % gsz); u.pn = (wgid % nig) / gsz; return true;
    }
    __device__ __forceinline__ void a_ready(const Unit&) const {}
    __device__ __forceinline__ void done(const Unit&) const {}
};
__device__ __forceinline__ unsigned cvt_pk_bf16(float lo, float hi) { unsigned r; asm volatile("v_cvt_pk_bf16_f32 %0, %1, %2" : "=v"(r) : "v"(lo), "v"(hi)); return r; }
template <class Epi, class Sched, bool STAMP = false>
__device__ __forceinline__ void gemm_phase(PG8_LAS unsigned char* lds, const Gemm g, const Sched& S, const Epi& E, unsigned long long* stamps) {
    const int tid = threadIdx.x, wid = __builtin_amdgcn_readfirstlane(tid >> 6), lane = tid & 63, wr = wid >> 2, wc = wid & 3, fr = lane & 15, fq = lane >> 4;
    const int K = g.K, nt = K / BK;
    int ts_lo = 0, ts_hi = 0, nts = 0; const unsigned long long rt_entry = STAMP ? (unsigned long long)wall_clock64() : 0ull;
#define PG8_STAMP() do { if (STAMP && wid == 0 && nts < 64) { const unsigned long long _c = (unsigned long long)clock64(); \
        ts_lo = (lane == nts) ? (int)(unsigned)_c : ts_lo; ts_hi = (lane == nts) ? (int)(unsigned)(_c >> 32) : ts_hi; ++nts; } } while (0)
    PG8_STAMP();
    unsigned voffA[2], voffB[2];
#pragma unroll
    for (int i = 0; i < 2; ++i) { int R, C; stage_rc(tid * 16 + i * 8192, R, C); const int Rb = Epi::PERM ? ((R & ~31) + perm32(R & 31)) : R;
        voffA[i] = (unsigned)(R * K + C) * 2u; voffB[i] = (unsigned)(Rb * K + C) * 2u; }
    const size_t kstep = (size_t)(BK * 2);
    const size_t hstep = (size_t)HALF * K * 2;
    const size_t tstep = 2 * hstep;
    const unsigned ldsw = (unsigned)wid * 1024u;
    const int aoff = lds_byte(wr * 64 + fr, fq * 8), boff = lds_byte(wc * 32 + fr, fq * 8);
#define PG8_SA(b, h) (((b) * 2 + (h)) * HTB)
#define PG8_SB(b, h) ((4 + (b) * 2 + (h)) * HTB)
#define PG8_STAGE(bufoff, gbase, voff) do { _Pragma("unroll") for (int _i = 0; _i < 2; ++_i) \
        __builtin_amdgcn_global_load_lds((const unsigned*)((const char*)(gbase) + (voff)[_i]), (PG8_LAS unsigned*)(lds + (bufoff) + ldsw + _i * 8192), 16, 0, 0); } while (0)
#define PG8_LDA(dst, b, h) do { _Pragma("unroll") for (int m = 0; m < 4; ++m) _Pragma("unroll") for (int k = 0; k < 2; ++k) dst[m][k] = *(const PG8_LAS bf16x8*)(lds + PG8_SA(b, h) + aoff + m * 2048 + k * 1024); } while (0)
#define PG8_LDB(dst, b, h) do { _Pragma("unroll") for (int n = 0; n < 2; ++n) _Pragma("unroll") for (int k = 0; k < 2; ++k) dst[n][k] = *(const PG8_LAS bf16x8*)(lds + PG8_SB(b, h) + boff + n * 2048 + k * 1024); } while (0)
#define PG8_MMA(ai, bj, At, Bt) do { __builtin_amdgcn_s_setprio(1); _Pragma("unroll") for (int m = 0; m < 4; ++m) _Pragma("unroll") for (int n = 0; n < 2; ++n) _Pragma("unroll") for (int k = 0; k < 2; ++k) \
        acc[ai][bj][m][n] = __builtin_amdgcn_mfma_f32_16x16x32_bf16(Bt[n][k], At[m][k], acc[ai][bj][m][n], 0, 0, 0); __builtin_amdgcn_s_setprio(0); } while (0)
#define PG8_WAIT_V(n) asm volatile("s_waitcnt vmcnt(" #n ")" ::: "memory")
#define PG8_WAIT_L(n) asm volatile("s_waitcnt lgkmcnt(" #n ")" ::: "memory")
#define PG8_BAR __builtin_amdgcn_s_barrier()
#define PG8_SCHED __builtin_amdgcn_sched_barrier(0)
    Unit cur, nxt; int ui = 0;
    if (!S.next(0, cur)) return;
    f32x4 acc[2][2][4][2];
#pragma unroll
    for (int a = 0; a < 2; ++a)
#pragma unroll
        for (int b = 0; b < 2; ++b)
#pragma unroll
            for (int m = 0; m < 4; ++m)
#pragma unroll
                for (int n = 0; n < 2; ++n) acc[a][b][m][n] = (f32x4){0.f, 0.f, 0.f, 0.f};
    bf16x8 At[4][2], B0[2][2], B1[2][2];
    const char* cA = (const char*)g.A + (size_t)cur.pm * tstep; const char* cB = (const char*)g.Bt + (size_t)cur.pn * tstep;
    S.a_ready(cur);
    PG8_STAGE(PG8_SB(0, 0), cB, voffB); PG8_STAGE(PG8_SA(0, 0), cA, voffA); PG8_STAGE(PG8_SB(0, 1), cB + hstep, voffB); PG8_STAGE(PG8_SA(0, 1), cA + hstep, voffA);
    if (wr == 1) PG8_BAR;
    PG8_WAIT_V(4); PG8_BAR;
    PG8_STAGE(PG8_SB(1, 0), cB + kstep, voffB); PG8_STAGE(PG8_SA(1, 0), cA + kstep, voffA); PG8_STAGE(PG8_SB(1, 1), cB + hstep + kstep, voffB);
    PG8_WAIT_V(6); PG8_BAR;
    PG8_STAMP();
    for (;;) {
        const bool has_next = S.next(ui + 1, nxt);
        const char* nA = has_next ? (const char*)g.A + (size_t)nxt.pm * tstep : cA; const char* nB = has_next ? (const char*)g.Bt + (size_t)nxt.pn * tstep : cB;
        for (int t = 0; t < nt; t += 2) {
            const bool last = (t == nt - 2);
            const char* a1 = cA + (size_t)(t + 1) * kstep;
            const char* a2 = last ? nA : cA + (size_t)(t + 2) * kstep; const char* b2 = last ? nB : cB + (size_t)(t + 2) * kstep;
            const char* a3 = a2 + kstep; const char* b3 = b2 + kstep;
            if constexpr (Epi::MID) { if (t == nt / 2) E.mid(acc, cur, wr, wc, fr, fq); }
            if (last && has_next) S.a_ready(nxt);
            PG8_LDB(B0, 0, 0); PG8_SCHED; PG8_LDA(At, 0, 0); PG8_STAGE(PG8_SA(1, 1), a1 + hstep, voffA);
            PG8_WAIT_L(8); PG8_BAR; PG8_WAIT_L(0); PG8_MMA(0, 0, At, B0); PG8_BAR; PG8_SCHED;
            PG8_LDB(B1, 0, 1); PG8_STAGE(PG8_SB(0, 0), b2, voffB);
            PG8_BAR; PG8_WAIT_L(0); PG8_MMA(0, 1, At, B1); PG8_BAR;
            PG8_LDA(At, 0, 1); PG8_STAGE(PG8_SA(0, 0), a2, voffA);
            PG8_BAR; PG8_WAIT_L(0); PG8_MMA(1, 0, At, B0); PG8_BAR; PG8_SCHED;
            PG8_STAGE(PG8_SB(0, 1), b2 + hstep, voffB);
            PG8_WAIT_V(6); PG8_BAR; PG8_MMA(1, 1, At, B1); PG8_BAR;
            PG8_LDB(B0, 1, 0); PG8_SCHED; PG8_LDA(At, 1, 0); PG8_STAGE(PG8_SA(0, 1), a2 + hstep, voffA);
            PG8_WAIT_L(8); PG8_BAR; PG8_WAIT_L(0); PG8_MMA(0, 0, At, B0); PG8_BAR; PG8_SCHED;
            PG8_LDB(B1, 1, 1); PG8_STAGE(PG8_SB(1, 0), b3, voffB);
            PG8_BAR; PG8_WAIT_L(0); PG8_MMA(0, 1, At, B1); PG8_BAR;
            PG8_LDA(At, 1, 1); PG8_STAGE(PG8_SA(1, 0), a3, voffA);
            PG8_BAR; PG8_WAIT_L(0); PG8_MMA(1, 0, At, B0); PG8_BAR; PG8_SCHED;
            PG8_STAGE(PG8_SB(1, 1), b3 + hstep, voffB);
            PG8_WAIT_V(6); PG8_BAR; PG8_MMA(1, 1, At, B1); PG8_BAR;
        }
        PG8_STAMP();
        if constexpr (!Epi::AFTER_DRAIN) { E(acc, cur, wr, wc, fr, fq); S.done(cur); }
        PG8_STAMP();
        if (!has_next) break;
#pragma unroll
        for (int a = 0; a < 2; ++a)
#pragma unroll
            for (int b = 0; b < 2; ++b)
#pragma unroll
                for (int m = 0; m < 4; ++m)
#pragma unroll
                    for (int n = 0; n < 2; ++n) acc[a][b][m][n] = (f32x4){0.f, 0.f, 0.f, 0.f};
        cur = nxt; cA = nA; cB = nB; ++ui;
    }
    PG8_WAIT_V(0);
    if (wr == 0) PG8_BAR;
    PG8_BAR;
    if constexpr (Epi::AFTER_DRAIN) { E.fused(acc, cur, wr, wc, fr, fq, lds, wid, lane); S.done(cur); }
    PG8_STAMP();
    if (STAMP && wid == 0) { stamps[lane] = lane < nts ? (((unsigned long long)(unsigned)ts_hi << 32) | (unsigned)ts_lo) : 0ull;
        if (lane == 62) stamps[62] = rt_entry; if (lane == 63) stamps[63] = (unsigned long long)wall_clock64(); }
#undef PG8_STAMP
#undef PG8_SA
#undef PG8_SB
#undef PG8_STAGE
#undef PG8_LDA
#undef PG8_LDB
#undef PG8_MMA
#undef PG8_WAIT_V
#undef PG8_WAIT_L
#undef PG8_BAR
#undef PG8_SCHED
}
}

struct EpiProj {
  static constexpr bool PERM = true, AFTER_DRAIN = false, MID = false;
  unsigned short* pH; unsigned short* pA; unsigned short* pG; unsigned short* kc; unsigned short* vc; unsigned short* ikc;
  __device__ __forceinline__ void operator()(const pg8::f32x4 (&acc)[2][2][4][2], const pg8::Unit& u, int wr, int wc, int fr, int fq) const {
    const int row0 = u.pm * 256 + wr * 64 + fr;
    unsigned short* base; int ldc, colt; bool sg = false;
    if (u.pn < 8) { base = pH; ldc = 2048; colt = u.pn * 256; }
    else if (u.pn < 12) { base = pA; ldc = 1024; colt = (u.pn - 8) * 256; }
    else { base = pG; ldc = 2048; colt = (u.pn - 12) * 256; sg = true; }
    const int col0 = colt + wc * 32 + 8 * fq;
#pragma unroll
    for (int ai = 0; ai < 2; ++ai)
#pragma unroll
      for (int m = 0; m < 4; ++m) {
        unsigned short* rowp = base + (size_t)(row0 + ai * 128 + m * 16) * ldc + col0;
#pragma unroll
        for (int bj = 0; bj < 2; ++bj) {
          pg8::f32x4 v0 = acc[ai][bj][m][0], v1 = acc[ai][bj][m][1];
          if (sg) {
#pragma unroll
            for (int j = 0; j < 4; ++j) { v0[j] = sigmoidf_(v0[j]); v1[j] = sigmoidf_(v1[j]); }
          }
          pg8::u32x4 w; w.x = pg8::cvt_pk_bf16(v0[0], v0[1]); w.y = pg8::cvt_pk_bf16(v0[2], v0[3]); w.z = pg8::cvt_pk_bf16(v1[0], v1[1]); w.w = pg8::cvt_pk_bf16(v1[2], v1[3]);
          unsigned short* dst = rowp + bj * 128;
          if (u.pn == 10 || u.pn == 11) {
            const int cs = col0 + bj * 128;
            const size_t r = (size_t)(row0 + ai * 128 + m * 16);
            if (cs >= 512 && cs < 576) dst = kc + r * 64 + (cs - 512);
            else if (cs >= 576 && cs < 640) dst = vc + r * 64 + (cs - 576);
            else if (cs >= 896 && cs < 960) dst = ikc + r * 64 + (cs - 896);
          }
          *(pg8::u32x4*)dst = w;
        }
      }
  }
};
template <int MODE> struct EpiGate {
  static constexpr bool PERM = true, AFTER_DRAIN = false, MID = false;
  unsigned short* hb; const unsigned short* pG; int goff;
  __device__ __forceinline__ void operator()(const pg8::f32x4 (&acc)[2][2][4][2], const pg8::Unit& u, int wr, int wc, int fr, int fq) const {
    const int row0 = u.pm * 256 + wr * 64 + fr;
    const int col0 = u.pn * 256 + wc * 32 + 8 * fq;
#pragma unroll
    for (int ai = 0; ai < 2; ++ai)
#pragma unroll
      for (int m = 0; m < 4; ++m) {
        const size_t r = (size_t)(row0 + ai * 128 + m * 16);
        pg8::u32x4 gv[2], hv[2];
#pragma unroll
        for (int bj = 0; bj < 2; ++bj) {
          gv[bj] = *(const pg8::u32x4*)(pG + r * 2048 + goff + col0 + bj * 128);
          if (MODE == 1) hv[bj] = *(const pg8::u32x4*)(hb + r * 1024 + col0 + bj * 128);
        }
#pragma unroll
        for (int bj = 0; bj < 2; ++bj) {
          float o[8];
#pragma unroll
          for (int j = 0; j < 4; ++j) {
            const unsigned gw0 = gv[bj][j >> 1], gw1 = gv[bj][2 + (j >> 1)];
            const float g0 = (j & 1) ? __uint_as_float(gw0 & 0xffff0000u) : __uint_as_float(gw0 << 16);
            const float g1 = (j & 1) ? __uint_as_float(gw1 & 0xffff0000u) : __uint_as_float(gw1 << 16);
            o[j] = acc[ai][bj][m][0][j] * g0; o[4 + j] = acc[ai][bj][m][1][j] * g1;
            if (MODE == 1) {
              const unsigned hw0 = hv[bj][j >> 1], hw1 = hv[bj][2 + (j >> 1)];
              o[j] += (j & 1) ? __uint_as_float(hw0 & 0xffff0000u) : __uint_as_float(hw0 << 16);
              o[4 + j] += (j & 1) ? __uint_as_float(hw1 & 0xffff0000u) : __uint_as_float(hw1 << 16);
            }
          }
          pg8::u32x4 w; w.x = pg8::cvt_pk_bf16(o[0], o[1]); w.y = pg8::cvt_pk_bf16(o[2], o[3]); w.z = pg8::cvt_pk_bf16(o[4], o[5]); w.w = pg8::cvt_pk_bf16(o[6], o[7]);
          *(pg8::u32x4*)(hb + r * 1024 + col0 + bj * 128) = w;
        }
      }
  }
};
struct EpiGate2 {
  static constexpr bool PERM = true, AFTER_DRAIN = false, MID = true;
  unsigned short* hb; const unsigned short* pG;
  __device__ __forceinline__ void mid(pg8::f32x4 (&acc)[2][2][4][2], const pg8::Unit& u, int wr, int wc, int fr, int fq) const {
    int fr_o = fr, fq_o = fq;
    asm volatile("" : "+v"(fr_o), "+v"(fq_o));
    const unsigned short* gp = pG + (size_t)(u.pm * 256 + wr * 64 + fr_o) * 2048 + u.pn * 256 + wc * 32 + 8 * fq_o;
#pragma unroll
    for (int ai = 0; ai < 2; ++ai)
#pragma unroll
      for (int m = 0; m < 4; ++m)
#pragma unroll
        for (int bj = 0; bj < 2; ++bj) {
          const unsigned short* q = gp + (size_t)(ai * 128 + m * 16) * 2048 + bj * 128;
          const pg8::u32x4 gb = *(const pg8::u32x4*)(q + 1024);
          const pg8::u32x4 ga = *(const pg8::u32x4*)q;
#pragma unroll
          for (int wd = 0; wd < 4; ++wd) {
            const float rl = __uint_as_float(ga[wd] << 16) * __builtin_amdgcn_rcpf(__uint_as_float(gb[wd] << 16));
            const float rh = __uint_as_float(ga[wd] & 0xffff0000u) * __builtin_amdgcn_rcpf(__uint_as_float(gb[wd] & 0xffff0000u));
            acc[ai][bj][m][wd >> 1][2 * (wd & 1)] *= rl;
            acc[ai][bj][m][wd >> 1][2 * (wd & 1) + 1] *= rh;
          }
          if (bj == 1) asm volatile("" ::: "memory");
        }
  }
  __device__ __forceinline__ void operator()(const pg8::f32x4 (&acc)[2][2][4][2], const pg8::Unit& u, int wr, int wc, int fr, int fq) const {
    const int row0 = u.pm * 256 + wr * 64 + fr;
    const int col0 = u.pn * 256 + wc * 32 + 8 * fq;
#pragma unroll
    for (int ai = 0; ai < 2; ++ai)
#pragma unroll
      for (int m = 0; m < 4; ++m) {
        const size_t r = (size_t)(row0 + ai * 128 + m * 16);
        pg8::u32x4 gb[2];
#pragma unroll
        for (int bj = 0; bj < 2; ++bj) gb[bj] = *(const pg8::u32x4*)(pG + r * 2048 + 1024 + col0 + bj * 128);
#pragma unroll
        for (int bj = 0; bj < 2; ++bj) {
          float o[8];
#pragma unroll
          for (int j = 0; j < 4; ++j) {
            const unsigned b0 = gb[bj][j >> 1], b1 = gb[bj][2 + (j >> 1)];
            const float sb0 = (j & 1) ? __uint_as_float(b0 & 0xffff0000u) : __uint_as_float(b0 << 16);
            const float sb1 = (j & 1) ? __uint_as_float(b1 & 0xffff0000u) : __uint_as_float(b1 << 16);
            o[j] = acc[ai][bj][m][0][j] * sb0; o[4 + j] = acc[ai][bj][m][1][j] * sb1;
          }
          pg8::u32x4 w; w.x = pg8::cvt_pk_bf16(o[0], o[1]); w.y = pg8::cvt_pk_bf16(o[2], o[3]); w.z = pg8::cvt_pk_bf16(o[4], o[5]); w.w = pg8::cvt_pk_bf16(o[6], o[7]);
          *(pg8::u32x4*)(hb + r * 1024 + col0 + bj * 128) = w;
        }
      }
  }
};
struct EpiResid {
  static constexpr bool PERM = false, AFTER_DRAIN = false, MID = false;
  float* out; const float* x;
  __device__ __forceinline__ void operator()(const pg8::f32x4 (&acc)[2][2][4][2], const pg8::Unit& u, int wr, int wc, int fr, int fq) const {
    const int row0 = u.pm * 256 + wr * 64 + fr, col0 = u.pn * 256 + wc * 32 + 4 * fq;
#pragma unroll
    for (int ai = 0; ai < 2; ++ai)
#pragma unroll
      for (int m = 0; m < 4; ++m) {
        const size_t off = (size_t)(row0 + ai * 128 + m * 16) * 1024 + col0;
        pg8::f32x4 xv[2][2];
#pragma unroll
        for (int bj = 0; bj < 2; ++bj)
#pragma unroll
          for (int n = 0; n < 2; ++n) xv[bj][n] = *(const pg8::f32x4*)(x + off + bj * 128 + n * 16);
#pragma unroll
        for (int bj = 0; bj < 2; ++bj)
#pragma unroll
          for (int n = 0; n < 2; ++n) *(pg8::f32x4*)(out + off + bj * 128 + n * 16) = acc[ai][bj][m][n] + xv[bj][n];
      }
  }
};
struct EpiStoreBf16 {
  static constexpr bool PERM = true, AFTER_DRAIN = false, MID = false;
  unsigned short* O; int ldc;
  __device__ __forceinline__ void operator()(const pg8::f32x4 (&acc)[2][2][4][2], const pg8::Unit& u, int wr, int wc, int fr, int fq) const {
    const int row0 = u.pm * 256 + wr * 64 + fr, col0 = u.pn * 256 + wc * 32 + 8 * fq;
#pragma unroll
    for (int ai = 0; ai < 2; ++ai)
#pragma unroll
      for (int m = 0; m < 4; ++m) {
        unsigned short* rowp = O + (size_t)(row0 + ai * 128 + m * 16) * ldc + col0;
#pragma unroll
        for (int bj = 0; bj < 2; ++bj) {
          const pg8::f32x4 v0 = acc[ai][bj][m][0], v1 = acc[ai][bj][m][1];
          pg8::u32x4 w; w.x = pg8::cvt_pk_bf16(v0[0], v0[1]); w.y = pg8::cvt_pk_bf16(v0[2], v0[3]); w.z = pg8::cvt_pk_bf16(v1[0], v1[1]); w.w = pg8::cvt_pk_bf16(v1[2], v1[3]);
          *(pg8::u32x4*)(rowp + bj * 128) = w;
        }
      }
  }
};

__device__ __forceinline__ void gemm_tile(const bf16_t* __restrict__ A, int lda, const bf16_t* __restrict__ Bt, int ldb,
                                          int nk, f32x4 (&acc)[4][4], unsigned char* smem) {
  const int tid = threadIdx.x, lane = tid & 63, w = tid >> 6, wm = w >> 1, wn = w & 1, l15 = lane & 15, g = lane >> 4;
  unsigned char* sA = smem;
  unsigned char* sB = smem + 32768;
  const int lr = tid >> 3, lc = tid & 7;
  const bf16_t* ga = A + (size_t)lr * lda + lc * 8;
  const bf16_t* gb = Bt + (size_t)lr * ldb + lc * 8;
  uint4 ra0, ra1, ra2, ra3, rb0, rb1;
  ra0 = *(const uint4*)(ga);
  ra1 = *(const uint4*)(ga + (size_t)64 * lda);
  ra2 = *(const uint4*)(ga + (size_t)128 * lda);
  ra3 = *(const uint4*)(ga + (size_t)192 * lda);
  rb0 = *(const uint4*)(gb);
  rb1 = *(const uint4*)(gb + (size_t)64 * ldb);
  const int sw = (lc ^ (lr & 7)) << 4;
  for (int kt = 0; kt < nk; ++kt) {
    __syncthreads();
    *(uint4*)(sA + (lr) * 128 + sw) = ra0;
    *(uint4*)(sA + (lr + 64) * 128 + sw) = ra1;
    *(uint4*)(sA + (lr + 128) * 128 + sw) = ra2;
    *(uint4*)(sA + (lr + 192) * 128 + sw) = ra3;
    *(uint4*)(sB + (lr) * 128 + sw) = rb0;
    *(uint4*)(sB + (lr + 64) * 128 + sw) = rb1;
    __syncthreads();
    if (kt + 1 < nk) {
      const int ko = (kt + 1) * 64;
      ra0 = *(const uint4*)(ga + ko);
      ra1 = *(const uint4*)(ga + (size_t)64 * lda + ko);
      ra2 = *(const uint4*)(ga + (size_t)128 * lda + ko);
      ra3 = *(const uint4*)(ga + (size_t)192 * lda + ko);
      rb0 = *(const uint4*)(gb + ko);
      rb1 = *(const uint4*)(gb + (size_t)64 * ldb + ko);
    }
#pragma unroll
    for (int ks = 0; ks < 2; ++ks) {
      bf16x8 a[4], b[4];
#pragma unroll
      for (int m = 0; m < 4; ++m) { const int r = wm * 64 + m * 16 + l15; a[m] = *(const bf16x8*)(sA + r * 128 + (((ks * 4 + g) ^ (r & 7)) << 4)); }
#pragma unroll
      for (int n = 0; n < 4; ++n) { const int r = wn * 64 + n * 16 + l15; b[n] = *(const bf16x8*)(sB + r * 128 + (((ks * 4 + g) ^ (r & 7)) << 4)); }
#pragma unroll
      for (int m = 0; m < 4; ++m)
#pragma unroll
        for (int n = 0; n < 4; ++n) acc[m][n] = __builtin_amdgcn_mfma_f32_16x16x32_bf16(a[m], b[n], acc[m][n], 0, 0, 0);
    }
  }
}

__device__ __forceinline__ void zero_acc(f32x4 (&acc)[4][4]) {
#pragma unroll
  for (int m = 0; m < 4; ++m)
#pragma unroll
    for (int n = 0; n < 4; ++n) acc[m][n] = (f32x4){0.f, 0.f, 0.f, 0.f};
}

__device__ __forceinline__ void transpose_tile(const float* __restrict__ src, int srcN, bf16_t* __restrict__ dst, int K, int n0, int k0,
                                               bool winmap, float* tile) {
  const int tid = threadIdx.x;
  const int nc = tid & 63, kr = tid >> 6;
  int ncol = n0 + nc; bool valid = true;
  if (winmap) { if (ncol >= 3072) ncol -= 60; else if (ncol >= 3012) valid = false; }
#pragma unroll
  for (int i = 0; i < 8; ++i) {
    const int k = kr + 8 * i;
    tile[k * 65 + nc] = valid ? src[(size_t)(k0 + k) * srcN + ncol] : 0.f;
  }
  __syncthreads();
#pragma unroll
  for (int i = 0; i < 8; ++i) {
    const int nr = kr + 8 * i;
    dst[(size_t)(n0 + nr) * K + k0 + nc] = f2bf(tile[nc * 65 + nr]);
  }
  __syncthreads();
}

__device__ __forceinline__ void convert_f32_bf16(const float* __restrict__ src, bf16_t* __restrict__ dst, size_t n4) {
  for (size_t i = (size_t)blockIdx.x * NTHREADS + threadIdx.x; i < n4; i += (size_t)gridDim.x * NTHREADS) {
    const float4 v = ((const float4*)src)[i];
    uint2 o; o.x = pack2(v.x, v.y); o.y = pack2(v.z, v.w);
    ((uint2*)dst)[i] = o;
  }
}

template <bool SLICE_MAJOR, bool SIGNED>
__device__ __forceinline__ void quantize_rows_u8(const float* __restrict__ src, unsigned char* __restrict__ dst, float* __restrict__ scale, int row_lo, int row_hi) {
  const int lane = threadIdx.x & 63, w = threadIdx.x >> 6;
  for (int row = row_lo + w; row < row_hi; row += 8) {
    const float4* s4 = (const float4*)(src + (size_t)row * 1024) + lane * 4;
    float4 v[4];
    float am = 0.f;
#pragma unroll
    for (int i = 0; i < 4; ++i) { v[i] = s4[i]; am = fmaxf(am, fmaxf(fmaxf(fabsf(v[i].x), fabsf(v[i].y)), fmaxf(fabsf(v[i].z), fabsf(v[i].w)))); }
#pragma unroll
    for (int o = 32; o > 0; o >>= 1) am = fmaxf(am, __shfl_xor(am, o));
    const float inv = am > 0.f ? 127.f / am : 0.f;
    unsigned pk[4];
#pragma unroll
    for (int i = 0; i < 4; ++i) {
      const int ofs = SIGNED ? 0 : 128;
      const unsigned b0 = (unsigned)((int)rintf(v[i].x * inv) + ofs), b1 = (unsigned)((int)rintf(v[i].y * inv) + ofs);
      const unsigned b2 = (unsigned)((int)rintf(v[i].z * inv) + ofs), b3 = (unsigned)((int)rintf(v[i].w * inv) + ofs);
      pk[i] = (b0 & 255u) | ((b1 & 255u) << 8) | ((b2 & 255u) << 16) | ((b3 & 255u) << 24);
    }
    if (SLICE_MAJOR) *(uint4*)(dst + (size_t)(lane >> 3) * (16384 * 128) + (size_t)row * 128 + (lane & 7) * 16) = make_uint4(pk[0], pk[1], pk[2], pk[3]);
    else *(uint4*)(dst + (size_t)row * 1024 + lane * 16) = make_uint4(pk[0], pk[1], pk[2], pk[3]);
    if (lane == 0) scale[row] = am * (1.f / 127.f);
  }
}

#define WS_XQ (WS_PH + (size_t)TOK * 1024 * 2)
#define WS_XS (WS_XQ + (size_t)TOK * 1024)
__device__ __forceinline__ void rmsnorm_rows_q(const float* __restrict__ src, const float* __restrict__ g, bf16_t* __restrict__ dst,
                                               unsigned char* __restrict__ xq, float* __restrict__ xs) {
  const int lane = threadIdx.x & 63, w = threadIdx.x >> 6;
  for (int row = blockIdx.x * 8 + w; row < TOK; row += gridDim.x * 8) {
    const float4* s4 = (const float4*)(src + (size_t)row * DM) + lane * 4;
    const float4* g4 = (const float4*)g + lane * 4;
    float v[16]; float ss = 0.f;
#pragma unroll
    for (int i = 0; i < 4; ++i) { const float4 t = s4[i]; v[4 * i] = t.x; v[4 * i + 1] = t.y; v[4 * i + 2] = t.z; v[4 * i + 3] = t.w; ss += t.x * t.x + t.y * t.y + t.z * t.z + t.w * t.w; }
    ss = wave_sum(ss);
    const float rstd = rsqrtf(ss * (1.f / DM) + EPSV);
    float am = 0.f;
#pragma unroll
    for (int i = 0; i < 4; ++i) { const float4 gg = g4[i]; v[4 * i] *= rstd * gg.x; v[4 * i + 1] *= rstd * gg.y; v[4 * i + 2] *= rstd * gg.z; v[4 * i + 3] *= rstd * gg.w; }
#pragma unroll
    for (int i = 0; i < 16; ++i) am = fmaxf(am, fabsf(v[i]));
#pragma unroll
    for (int o = 32; o > 0; o >>= 1) am = fmaxf(am, __shfl_xor(am, o));
    const float inv = am > 0.f ? 127.f / am : 0.f;
    uint4 ob0, ob1;
    ob0.x = pack2(v[0], v[1]); ob0.y = pack2(v[2], v[3]); ob0.z = pack2(v[4], v[5]); ob0.w = pack2(v[6], v[7]);
    ob1.x = pack2(v[8], v[9]); ob1.y = pack2(v[10], v[11]); ob1.z = pack2(v[12], v[13]); ob1.w = pack2(v[14], v[15]);
    *(uint4*)(dst + (size_t)row * DM + lane * 16) = ob0;
    *(uint4*)(dst + (size_t)row * DM + lane * 16 + 8) = ob1;
    unsigned pk[4];
#pragma unroll
    for (int i = 0; i < 4; ++i) {
      const unsigned b0 = (unsigned)(int)rintf(v[4 * i] * inv) & 255u, b1 = (unsigned)(int)rintf(v[4 * i + 1] * inv) & 255u;
      const unsigned b2 = (unsigned)(int)rintf(v[4 * i + 2] * inv) & 255u, b3 = (unsigned)(int)rintf(v[4 * i + 3] * inv) & 255u;
      pk[i] = b0 | (b1 << 8) | (b2 << 16) | (b3 << 24);
    }
    *(uint4*)(xq + (size_t)row * 1024 + lane * 16) = make_uint4(pk[0], pk[1], pk[2], pk[3]);
    if (lane == 0) xs[row] = am * (1.f / 127.f);
  }
}

__device__ __forceinline__ void rmsnorm_rows(const float* __restrict__ src, const float* __restrict__ g, bf16_t* __restrict__ dst) {
  const int lane = threadIdx.x & 63, w = threadIdx.x >> 6;
  for (int row = blockIdx.x * 8 + w; row < TOK; row += gridDim.x * 8) {
    const float4* s4 = (const float4*)(src + (size_t)row * DM);
    float4 v[4]; float ss = 0.f;
#pragma unroll
    for (int i = 0; i < 4; ++i) { v[i] = s4[lane + 64 * i]; ss += v[i].x * v[i].x + v[i].y * v[i].y + v[i].z * v[i].z + v[i].w * v[i].w; }
    ss = wave_sum(ss);
    const float rstd = rsqrtf(ss * (1.f / DM) + EPSV);
#pragma unroll
    for (int i = 0; i < 4; ++i) {
      const float4 gg = ((const float4*)g)[lane + 64 * i];
      uint2 o; o.x = pack2(v[i].x * rstd * gg.x, v[i].y * rstd * gg.y); o.y = pack2(v[i].z * rstd * gg.z, v[i].w * rstd * gg.w);
      ((uint2*)(dst + (size_t)row * DM))[lane + 64 * i] = o;
    }
  }
}

__device__ __forceinline__ void phase_prep(const Params& p, unsigned char* smem) {
  unsigned char* ws = p.ws;
  float* tile = (float*)smem;
  const int n_win = 80 * 16, n_ua = 16 * 8, n_ub = 16 * 8, n_wo = 16 * 16, n_wq = 32 * 16;
  const int total = n_win + n_ua + n_ub + n_wo + n_wq;
  for (int it = blockIdx.x; it < total; it += gridDim.x) {
    int t = it;
    if (t < n_win) { transpose_tile(p.w_in, 5060, (bf16_t*)(ws + WS_WIN), 1024, (t >> 4) * 64, (t & 15) * 64, true, tile); continue; }
    t -= n_win;
    if (t < n_ua) { transpose_tile(p.w_up_a, 1024, (bf16_t*)(ws + WS_WUPA), 1024, (t >> 3) * 64, (t & 7) * 64, false, tile); continue; }
    t -= n_ua;
    if (t < n_ub) { transpose_tile(p.w_up_b, 1024, (bf16_t*)(ws + WS_WUPA) + 512, 1024, (t >> 3) * 64, (t & 7) * 64, false, tile); continue; }
    t -= n_ub;
    if (t < n_wo) { transpose_tile(p.w_out, 1024, (bf16_t*)(ws + WS_WOUT), 1024, (t >> 4) * 64, (t & 15) * 64, false, tile); continue; }
    t -= n_wo;
    transpose_tile(p.peer_wq, 2048, (bf16_t*)(ws + WS_WQ), 1024, (t >> 4) * 64, (t & 15) * 64, false, tile);
  }
  convert_f32_bf16(p.peer_keys, (bf16_t*)(ws + WS_KEYS), (size_t)2 * 8 * 128 * 128 / 4);
  for (int i = blockIdx.x * NTHREADS + threadIdx.x; i < TOK; i += gridDim.x * NTHREADS) ((float*)(ws + WS_SSQ))[i] = 0.f;
  if (threadIdx.x == 0) ((int*)(ws + WS_XCC))[blockIdx.x] = (int)(__builtin_amdgcn_s_getreg((3 << 11) | 20) & 0xFu);
  if (blockIdx.x == 0 && threadIdx.x < 8) ((unsigned*)(ws + WS_QCTR))[16 * threadIdx.x] = 0u;
  if (blockIdx.x == 0) {
    const int i = threadIdx.x;
    const float a0 = p.hg_lb[i], a1 = p.hg_lb[512 + i];
    ((float*)(ws + WS_LB))[i] = 1.f / (1.f + expf(a1 - a0));
  }
  rmsnorm_rows(p.x, p.norm_mix, (bf16_t*)(ws + WS_XN));
}

__device__ __forceinline__ void hgrn_h1_all(const Params& p, unsigned char* smem) {
  unsigned char* ws = p.ws;
  bf16_t* pH = (bf16_t*)(ws + WS_PH);
  const float* lbp = (const float*)(ws + WS_LB);
  bf16_t* Qt = (bf16_t*)smem;
  bf16_t* Kt = Qt + 64 * 136;
  bf16_t* KtT = Kt + 64 * 136;
  bf16_t* VT = KtT + 128 * 72;
  bf16_t* Am = VT + 128 * 72;
  float* qtot = (float*)(Am + 64 * 72);
  const int tid = threadIdx.x, lane = tid & 63, w = tid >> 6, l15 = lane & 15, g = lane >> 4;
  const int d = tid & 127, tq = tid >> 7;
  const int G = gridDim.x;
  if ((int)blockIdx.x >= 2048) return;
  bf16_t fr_[16], qr_[16]; unsigned short vr_[16];
#define H1_LOAD(IT) do { \
    const int bh_ = (IT) >> 6, ch_ = (IT) & 63; \
    const bf16_t* base_ = pH + ((size_t)(bh_ >> 2) * SEQL + ch_ * 64 + tq * 16) * 2048 + (bh_ & 3) * 128 + d; \
    _Pragma("unroll") for (int i = 0; i < 16; ++i) { fr_[i] = base_[(size_t)i * 2048 + 512]; qr_[i] = base_[(size_t)i * 2048]; vr_[i] = base_[(size_t)i * 2048 + 1024]; } \
  } while (0)
  H1_LOAD((int)blockIdx.x);
  for (int item = blockIdx.x; item < 2048; item += G) {
    const int bh = item >> 6, chunk = item & 63;
    const int b = bh >> 2, h = bh & 3;
    const float lbv = lbp[h * 128 + d];
    const size_t row0 = (size_t)b * SEQL + chunk * 64;
    float* dec = (float*)(ws + WS_DEC) + (size_t)item * 384;
    uint4* UU = (uint4*)p.out + (size_t)item * 2048 + tid;
    float4* OI = (float4*)((unsigned char*)p.out + ((size_t)64 << 20)) + (size_t)item * 2048 + tid;
    {
      unsigned vv[8];
#pragma unroll
      for (int i = 0; i < 8; ++i) vv[i] = (unsigned)vr_[2 * i] | ((unsigned)vr_[2 * i + 1] << 16);
      float lf[16], kk[16], qs[16];
      float run = 0.f;
#pragma unroll
      for (int i = 0; i < 16; ++i) {
        const float sg = sigmoidf_(bf2f(fr_[i]));
        const float fg = lbv + (1.f - lbv) * sg;
        run += __logf(fg);
        lf[i] = run; kk[i] = 1.f - fg; qs[i] = siluf_(bf2f(qr_[i]));
      }
      qtot[tq * 128 + d] = run;
      __syncthreads();
      { const int nit = (item + G < 2048) ? item + G : item; H1_LOAD(nit); }
      const float q0 = qtot[d], q1 = qtot[128 + d], q2 = qtot[256 + d], q3 = qtot[384 + d];
      const float pre = (tq > 0 ? q0 : 0.f) + (tq > 1 ? q1 : 0.f) + (tq > 2 ? q2 : 0.f);
      const float bref = q0 + q1;
      const float blast = bref + q2 + q3;
      unsigned kp[8];
#pragma unroll
      for (int i = 0; i < 16; ++i) {
        const float bt = pre + lf[i];
        const float qt = qs[i] * __expf(bt - bref);
        const float kt = kk[i] * __expf(bref - bt);
        const int t = tq * 16 + i;
        Qt[t * 136 + d] = f2bf(qt);
        const bf16_t kb = f2bf(kt);
        Kt[t * 136 + d] = kb;
        if (i & 1) kp[i >> 1] |= ((unsigned)kb) << 16; else kp[i >> 1] = kb;
      }
      *(uint4*)(KtT + d * 72 + tq * 16) = make_uint4(kp[0], kp[1], kp[2], kp[3]);
      *(uint4*)(KtT + d * 72 + tq * 16 + 8) = make_uint4(kp[4], kp[5], kp[6], kp[7]);
      *(uint4*)(VT + d * 72 + tq * 16) = make_uint4(vv[0], vv[1], vv[2], vv[3]);
      *(uint4*)(VT + d * 72 + tq * 16 + 8) = make_uint4(vv[4], vv[5], vv[6], vv[7]);
      if (tq == 0) { dec[d] = __expf(bref); dec[128 + d] = __expf(blast); dec[256 + d] = __expf(blast - bref); }
    }
    __syncthreads();
    {
  #pragma unroll
      for (int i = 0; i < 2; ++i) {
        const int idx = tid + 512 * i, r = idx >> 4, c = idx & 15;
        *(uint4*)(pH + (row0 + r) * 2048 + h * 128 + c * 8) = *(const uint4*)(Qt + r * 136 + c * 8);
      }
  #pragma unroll
      for (int tt = 0; tt < 2; ++tt) {
        const int tl = 2 * w + tt, sm = tl >> 2, tn = tl & 3;
        f32x4 acc = (f32x4){0.f, 0.f, 0.f, 0.f};
        if (tn >= sm) {
  #pragma unroll
          for (int k0 = 0; k0 < 128; k0 += 32) {
            const bf16x8 a = *(const bf16x8*)(Kt + (sm * 16 + l15) * 136 + k0 + 8 * g);
            const bf16x8 bq = *(const bf16x8*)(Qt + (tn * 16 + l15) * 136 + k0 + 8 * g);
            acc = __builtin_amdgcn_mfma_f32_16x16x32_bf16(a, bq, acc, 0, 0, 0);
          }
        }
        const int t = tn * 16 + l15, s0 = sm * 16 + 4 * g;
        uint2 o;
        o.x = pack2(s0 + 0 <= t ? acc[0] : 0.f, s0 + 1 <= t ? acc[1] : 0.f);
        o.y = pack2(s0 + 2 <= t ? acc[2] : 0.f, s0 + 3 <= t ? acc[3] : 0.f);
        *(uint2*)(Am + t * 72 + s0) = o;
      }
    }
    __syncthreads();
    {
  #pragma unroll
      for (int tm = 0; tm < 4; ++tm) {
        f32x4 acc = (f32x4){0.f, 0.f, 0.f, 0.f};
  #pragma unroll
        for (int k0 = 0; k0 < 64; k0 += 32) {
          const bf16x8 a = *(const bf16x8*)(Am + (tm * 16 + l15) * 72 + k0 + 8 * g);
          const bf16x8 bb = *(const bf16x8*)(VT + (16 * w + l15) * 72 + k0 + 8 * g);
          acc = __builtin_amdgcn_mfma_f32_16x16x32_bf16(a, bb, acc, 0, 0, 0);
        }
        OI[tm * 512] = make_float4(acc[0], acc[1], acc[2], acc[3]);
      }
  #pragma unroll
      for (int dp = 0; dp < 4; ++dp) {
        unsigned pk[4];
  #pragma unroll
        for (int hh = 0; hh < 2; ++hh) {
          const int dm = dp * 2 + hh;
          f32x4 acc = (f32x4){0.f, 0.f, 0.f, 0.f};
  #pragma unroll
          for (int k0 = 0; k0 < 64; k0 += 32) {
            const bf16x8 a = *(const bf16x8*)(KtT + (dm * 16 + l15) * 72 + k0 + 8 * g);
            const bf16x8 bb = *(const bf16x8*)(VT + (16 * w + l15) * 72 + k0 + 8 * g);
            acc = __builtin_amdgcn_mfma_f32_16x16x32_bf16(a, bb, acc, 0, 0, 0);
          }
          pk[hh * 2] = pack2(acc[0], acc[1]); pk[hh * 2 + 1] = pack2(acc[2], acc[3]);
        }
        UU[dp * 512] = make_uint4(pk[0], pk[1], pk[2], pk[3]);
      }
    }
    __syncthreads();
  }
#undef H1_LOAD
}

__device__ __forceinline__ void hgrn_h2(const Params& p, unsigned char* smem, int bh) {
  unsigned char* ws = p.ws;
  const bf16_t* pH = (const bf16_t*)(ws + WS_PH);
  bf16_t* ya = (bf16_t*)(ws + WS_XN);
  bf16_t* Qt = (bf16_t*)smem;
  bf16_t* ST = Qt + 64 * 136;
  float* decl = (float*)(ST + 128 * 136);
  float* red = decl + 384;
  const int tid = threadIdx.x, lane = tid & 63, w = tid >> 6, l15 = lane & 15, g = lane >> 4;
  const int b = bh >> 2, h = bh & 3;
  f32x4 S[8];
#pragma unroll
  for (int i = 0; i < 8; ++i) S[i] = (f32x4){0.f, 0.f, 0.f, 0.f};
  const float gnv = p.hg_norm[h * 128 + 16 * w + l15];
  const int e = 16 * w + l15;
  uint4 uu0, uu1, uu2, uu3; float4 oi0, oi1, oi2, oi3; uint4 qraw0, qraw1; bf16_t ogr[16]; float dcv = 0.f;
#define H2_LOAD(CH) do { \
    const int item_ = bh * 64 + (CH); \
    const size_t row0_ = (size_t)b * SEQL + (size_t)(CH) * 64; \
    const uint4* UUp = (const uint4*)p.out + (size_t)item_ * 2048 + tid; \
    const float4* OIp = (const float4*)((const unsigned char*)p.out + ((size_t)64 << 20)) + (size_t)item_ * 2048 + tid; \
    uu0 = UUp[0]; uu1 = UUp[512]; uu2 = UUp[1024]; uu3 = UUp[1536]; oi0 = OIp[0]; oi1 = OIp[512]; oi2 = OIp[1024]; oi3 = OIp[1536]; \
    qraw0 = *(const uint4*)(pH + (row0_ + (tid >> 4)) * 2048 + h * 128 + (tid & 15) * 8); \
    qraw1 = *(const uint4*)(pH + (row0_ + 32 + (tid >> 4)) * 2048 + h * 128 + (tid & 15) * 8); \
    _Pragma("unroll") for (int tm = 0; tm < 4; ++tm) _Pragma("unroll") for (int j = 0; j < 4; ++j) \
      ogr[tm * 4 + j] = pH[(row0_ + tm * 16 + 4 * g + j) * 2048 + 1536 + h * 128 + e]; \
    if (tid < 384) dcv = ((const float*)(ws + WS_DEC))[(size_t)item_ * 384 + tid]; \
  } while (0)
  H2_LOAD(0);
  for (int chunk = 0; chunk < 64; ++chunk) {
    const size_t row0 = (size_t)b * SEQL + chunk * 64;
    const uint4 cu[4] = {uu0, uu1, uu2, uu3}; const float4 co[4] = {oi0, oi1, oi2, oi3}; bf16_t cog[16];
#pragma unroll
    for (int i = 0; i < 16; ++i) cog[i] = ogr[i];
    *(uint4*)(Qt + (tid >> 4) * 136 + (tid & 15) * 8) = qraw0;
    *(uint4*)(Qt + (32 + (tid >> 4)) * 136 + (tid & 15) * 8) = qraw1;
    if (tid < 384) decl[tid] = dcv;
    __syncthreads();
    if (chunk + 1 < 64) H2_LOAD(chunk + 1);
#pragma unroll
    for (int dm = 0; dm < 8; ++dm) {
      const int d0 = 16 * dm + 4 * g;
      uint2 o;
      o.x = pack2(S[dm][0] * decl[d0], S[dm][1] * decl[d0 + 1]);
      o.y = pack2(S[dm][2] * decl[d0 + 2], S[dm][3] * decl[d0 + 3]);
      *(uint2*)(ST + e * 136 + d0) = o;
    }
    __syncthreads();
    f32x4 o[4];
#pragma unroll
    for (int tm = 0; tm < 4; ++tm) {
      f32x4 acc = (f32x4){co[tm].x, co[tm].y, co[tm].z, co[tm].w};
#pragma unroll
      for (int k0 = 0; k0 < 128; k0 += 32) {
        const bf16x8 a = *(const bf16x8*)(Qt + (tm * 16 + l15) * 136 + k0 + 8 * g);
        const bf16x8 bb = *(const bf16x8*)(ST + (16 * w + l15) * 136 + k0 + 8 * g);
        acc = __builtin_amdgcn_mfma_f32_16x16x32_bf16(a, bb, acc, 0, 0, 0);
      }
      o[tm] = acc;
#pragma unroll
      for (int j = 0; j < 4; ++j) {
        float ss = acc[j] * acc[j];
        ss += __int_as_float(__builtin_amdgcn_update_dpp(0, __float_as_int(ss), 0xB1, 0xf, 0xf, true));
        ss += __int_as_float(__builtin_amdgcn_update_dpp(0, __float_as_int(ss), 0x4E, 0xf, 0xf, true));
        ss += __int_as_float(__builtin_amdgcn_update_dpp(0, __float_as_int(ss), 0x141, 0xf, 0xf, true));
        ss += __int_as_float(__builtin_amdgcn_update_dpp(0, __float_as_int(ss), 0x140, 0xf, 0xf, true));
        if (l15 == 0) red[w * 64 + tm * 16 + 4 * g + j] = ss;
      }
    }
#pragma unroll
    for (int dm = 0; dm < 8; ++dm) {
      const unsigned u01 = (dm & 1) ? cu[dm >> 1].z : cu[dm >> 1].x, u23 = (dm & 1) ? cu[dm >> 1].w : cu[dm >> 1].y;
      const float uv[4] = {__uint_as_float(u01 << 16), __uint_as_float(u01 & 0xffff0000u), __uint_as_float(u23 << 16), __uint_as_float(u23 & 0xffff0000u)};
#pragma unroll
      for (int j = 0; j < 4; ++j) { const int dd = 16 * dm + 4 * g + j; S[dm][j] = decl[128 + dd] * S[dm][j] + decl[256 + dd] * uv[j]; }
    }
    __syncthreads();
    if (tid < 64) {
      float tot = 0.f;
#pragma unroll
      for (int ww = 0; ww < 8; ++ww) tot += red[ww * 64 + tid];
      red[512 + tid] = rsqrtf(tot * (1.f / 128.f) + EPSV);
    }
    __syncthreads();
#pragma unroll
    for (int tm = 0; tm < 4; ++tm)
#pragma unroll
      for (int j = 0; j < 4; ++j) {
        const int t = tm * 16 + 4 * g + j;
        const float rstd = red[512 + t];
        ya[(row0 + t) * 1024 + h * 128 + e] = f2bf(o[tm][j] * rstd * gnv * siluf_(bf2f(cog[tm * 4 + j])));
      }
  }
#undef H2_LOAD
}

__device__ __forceinline__ int team_index(const Params& p, unsigned char* smem) {
  int* sh = (int*)(smem + 8192);
  const int G = gridDim.x, tid = threadIdx.x;
  const int* tab = (const int*)(p.ws + WS_XCC);
  if (tid < 32) sh[tid] = 0;
  __syncthreads();
  const int mine = tab[blockIdx.x] & 15;
  for (int b = tid; b < G; b += NTHREADS) {
    const int x = tab[b] & 15;
    atomicAdd(&sh[x], 1);
    if (x == mine && b < (int)blockIdx.x) atomicAdd(&sh[16], 1);
  }
  __syncthreads();
  if (tid == 0) {
    int pre = 0;
    for (int j = 0; j < mine; ++j) pre += sh[j];
    sh[17] = pre + sh[16];
  }
  __syncthreads();
  const int r = sh[17];
  __syncthreads();
  return r;
}

#define SCW 4100
#ifndef DSA_REP
#define DSA_REP 0
#endif
#define DSA_BKT_OFF (8 * SCW * 4 + 8 * 256 * 4 + 8 * 256 * 2 + 8 * 512 * 2)
__device__ __forceinline__ void cvt8(const uint4& v, float* f) {
  f[0] = __uint_as_float(v.x << 16); f[1] = __uint_as_float(v.x & 0xffff0000u);
  f[2] = __uint_as_float(v.y << 16); f[3] = __uint_as_float(v.y & 0xffff0000u);
  f[4] = __uint_as_float(v.z << 16); f[5] = __uint_as_float(v.z & 0xffff0000u);
  f[6] = __uint_as_float(v.w << 16); f[7] = __uint_as_float(v.w & 0xffff0000u);
}
__device__ __forceinline__ unsigned sortable_key(float v) {
  unsigned bits = __float_as_uint(v);
  if (bits == 0x80000000u) bits = 0u;
  return (bits & 0x80000000u) ? ~bits : (bits | 0x80000000u);
}

__device__ __forceinline__ void dsa_item(const Params& p, unsigned char* smem, int item) {
  unsigned char* ws = p.ws;
  const bf16_t* pA = (const bf16_t*)(ws + WS_PA);
  const bf16_t* kc = (const bf16_t*)(ws + WS_KC);
  const bf16_t* vc = (const bf16_t*)(ws + WS_VC);
  const bf16_t* ikc = (const bf16_t*)(ws + WS_IKC);
  bf16_t* yb = (bf16_t*)(ws + WS_XN) + 512;
  unsigned* sc = (unsigned*)smem;
  unsigned* hist = sc + 8 * SCW;
  unsigned short* sel = (unsigned short*)(hist + 8 * 256);
  unsigned short* cand = sel + 8 * 256;
  unsigned char* bkt = (unsigned char*)(cand + 8 * 512);
  unsigned* rmm = (unsigned*)(bkt + 128 + 1056);
  unsigned* bks = rmm + 16;
  const int tid = threadIdx.x, lane = tid & 63, w = tid >> 6, l15 = lane & 15, g = lane >> 4;
  const int b = item >> 9;
  const int tb = item & 511;
  const int t0 = tb * 8;
  const size_t tokbase = (size_t)b * SEQL;

  for (int rep_s = 0; rep_s < (DSA_REP == 1 ? 2 : 1); ++rep_s) {
    bf16x8 af[2][2];
    float wq[2][4];
#pragma unroll
    for (int mt = 0; mt < 2; ++mt) {
      const int qrow = t0 + mt * 4 + (l15 >> 2), head = l15 & 3;
#pragma unroll
      for (int ks = 0; ks < 2; ++ks)
        af[mt][ks] = *(const bf16x8*)(pA + (tokbase + qrow) * 1024 + 640 + head * 64 + ks * 32 + 8 * g);
      const uint2 wr = *(const uint2*)(pA + (tokbase + t0 + mt * 4 + g) * 1024 + 960);
      wq[mt][0] = 0.5f * bf2f((bf16_t)(wr.x & 0xffff)); wq[mt][1] = 0.5f * bf2f((bf16_t)(wr.x >> 16));
      wq[mt][2] = 0.5f * bf2f((bf16_t)(wr.y & 0xffff)); wq[mt][3] = 0.5f * bf2f((bf16_t)(wr.y >> 16));
    }
    const int nkt = (t0 + 8 + 15) >> 4;
    unsigned kmin[2] = {0xFFFFFFFFu, 0xFFFFFFFFu}, kmax[2] = {0u, 0u};
    for (int kt0 = w; kt0 < nkt; kt0 += 64) {
      bf16x8 b0[8], b1[8];
#pragma unroll
      for (int u = 0; u < 8; ++u) {
        const int kt = kt0 + 8 * u;
        const int s = (kt < nkt ? kt : 0) * 16 + l15;
        const bf16_t* kr = ikc + (tokbase + s) * 64 + 8 * g;
        b0[u] = *(const bf16x8*)kr;
        b1[u] = *(const bf16x8*)(kr + 32);
      }
      __builtin_amdgcn_sched_barrier(0);
      f32x4 sacc[8][2];
#pragma unroll
      for (int u = 0; u < 8; ++u)
#pragma unroll
        for (int mt = 0; mt < 2; ++mt) {
          f32x4 acc = (f32x4){0.f, 0.f, 0.f, 0.f};
          acc = __builtin_amdgcn_mfma_f32_16x16x32_bf16(af[mt][0], b0[u], acc, 0, 0, 0);
          sacc[u][mt] = __builtin_amdgcn_mfma_f32_16x16x32_bf16(af[mt][1], b1[u], acc, 0, 0, 0);
        }
#pragma unroll
      for (int u = 0; u < 8; ++u) {
        const int kt = kt0 + 8 * u;
        if (kt < nkt) {
          const int s = kt * 16 + l15;
#pragma unroll
          for (int mt = 0; mt < 2; ++mt) {
            float v = 0.f;
#pragma unroll
            for (int j = 0; j < 4; ++j) v += wq[mt][j] * fmaxf(sacc[u][mt][j] * 0.125f, 0.f);
            const int t = t0 + mt * 4 + g;
            unsigned vb = __float_as_uint(v); if (vb == 0x80000000u) vb = 0u;
            sc[(mt * 4 + g) * SCW + s] = vb;
            if (s <= t) {
              const unsigned key = (vb & 0x80000000u) ? ~vb : (vb | 0x80000000u);
              kmin[mt] = key < kmin[mt] ? key : kmin[mt];
              kmax[mt] = key > kmax[mt] ? key : kmax[mt];
            }
          }
        }
      }
    }
#pragma unroll
    for (int mt = 0; mt < 2; ++mt) {
      unsigned a = kmin[mt], bmx = kmax[mt];
#define DPP_MINMAX(CTRL) do { const unsigned a2 = (unsigned)__builtin_amdgcn_update_dpp((int)a, (int)a, CTRL, 0xf, 0xf, false); \
                               const unsigned b2 = (unsigned)__builtin_amdgcn_update_dpp((int)bmx, (int)bmx, CTRL, 0xf, 0xf, false); \
                               a = a2 < a ? a2 : a; bmx = b2 > bmx ? b2 : bmx; } while (0)
      DPP_MINMAX(0xB1); DPP_MINMAX(0x4E); DPP_MINMAX(0x141); DPP_MINMAX(0x140);
#undef DPP_MINMAX
      if (l15 == 0) { atomicMin(&rmm[mt * 4 + g], a); atomicMax(&rmm[8 + mt * 4 + g], bmx); }
    }
  }
  __syncthreads();
  const int t = t0 + w;
  const int n = t + 1;
  unsigned* row = sc + w * SCW;
  const float* rowf = (const float*)row;
  unsigned short* mysel = sel + w * 256;
  unsigned short* mycand = cand + w * 512;
  unsigned* myh = hist + w * 256;
  int cnt;
  const unsigned long long lt_mask = (1ull << lane) - 1ull;
  for (int rep_t = 0; rep_t < (DSA_REP == 2 ? 2 : 1); ++rep_t)
  if (n <= 256) {
    for (int i = lane; i < n; i += 64) mysel[i] = (unsigned short)i;
    cnt = n;
  } else {
    cnt = 256;
    float mn, mx;
    {
      const unsigned kmn = rmm[w], kmx = rmm[8 + w];
      mn = __uint_as_float((kmn & 0x80000000u) ? (kmn ^ 0x80000000u) : ~kmn);
      mx = __uint_as_float((kmx & 0x80000000u) ? (kmx ^ 0x80000000u) : ~kmx);
    }
    const float scale = (mx > mn) ? 255.99f / (mx - mn) : 0.f;
#pragma unroll
    for (int i = 0; i < 4; ++i) myh[lane + 64 * i] = 0u;
    lds_fence();
    for (int i0 = lane; i0 < n; i0 += 256) {
      float v4[4];
#pragma unroll
      for (int k = 0; k < 4; ++k) v4[k] = (i0 + 64 * k < n) ? rowf[i0 + 64 * k] : 0.f;
#pragma unroll
      for (int k = 0; k < 4; ++k) {
        if (i0 + 64 * k < n) {
          int bn = (int)((v4[k] - mn) * scale); bn = bn > 255 ? 255 : bn;
          atomicAdd(&myh[bn], 1u);
        }
      }
    }
    lds_fence();
    unsigned cum; int bstar; unsigned mcount;
    {
      const uint4 c4 = *(const uint4*)(myh + 4 * lane);
      const unsigned c = c4.x + c4.y + c4.z + c4.w;
      unsigned sfx = c;
#pragma unroll
      for (int o = 1; o < 64; o <<= 1) { const unsigned tt = __shfl_down(sfx, o); if (lane + o < 64) sfx += tt; }
      const unsigned long long bal = __ballot(sfx >= 256u);
      const int L = 63 - __clzll(bal);
      const unsigned sL = __shfl(sfx, L), cL = __shfl(c, L);
      const unsigned b3 = __shfl(c4.w, L), b2 = __shfl(c4.z, L), b1 = __shfl(c4.y, L), b0 = __shfl(c4.x, L);
      cum = sL - cL;
      int digit;
      if (cum + b3 >= 256u) { digit = 3; mcount = b3; }
      else { cum += b3; if (cum + b2 >= 256u) { digit = 2; mcount = b2; } else { cum += b2; if (cum + b1 >= 256u) { digit = 1; mcount = b1; } else { cum += b1; digit = 0; mcount = b0; } } }
      bstar = 4 * L + digit;
    }
    const unsigned need = 256u - cum;
    if (mcount <= 512u) {
      unsigned base = 0u, cb = 0u;
      for (int i0 = 0; i0 < n; i0 += 256) {
        float v4[4];
#pragma unroll
        for (int k = 0; k < 4; ++k) { const int i = i0 + 64 * k + lane; v4[k] = (i < n) ? rowf[i] : 0.f; }
#pragma unroll
        for (int k = 0; k < 4; ++k) {
          const int i = i0 + 64 * k + lane;
          const bool valid = i < n;
          int bn = (int)((v4[k] - mn) * scale); bn = bn > 255 ? 255 : bn;
          const bool gt = valid && (bn > bstar);
          const bool eq = valid && (bn == bstar);
          const unsigned long long bg = __ballot(gt), be = __ballot(eq);
          if (gt) mysel[base + (unsigned)__popcll(bg & lt_mask)] = (unsigned short)i;
          if (eq) mycand[cb + (unsigned)__popcll(be & lt_mask)] = (unsigned short)i;
          base += (unsigned)__popcll(bg); cb += (unsigned)__popcll(be);
        }
      }
      lds_fence();
      const int m = (int)mcount;
      unsigned ck[8]; unsigned short ci[8];
#pragma unroll
      for (int q = 0; q < 8; ++q) {
        const int c = q * 64 + lane;
        ck[q] = 0u; ci[q] = 0;
        if (c < m) { ci[q] = mycand[c]; ck[q] = sortable_key(rowf[ci[q]]); }
      }
      unsigned T = 0u;
      if (m <= 64) {
#pragma unroll 1
        for (int bit = 31; bit >= 0; --bit) {
          const unsigned trial = T | (1u << bit);
          if ((unsigned)__popcll(__ballot(ck[0] >= trial)) >= need) T = trial;
        }
      } else {
#pragma unroll 1
        for (int bit = 31; bit >= 0; --bit) {
          const unsigned trial = T | (1u << bit);
          unsigned cge = 0u;
#pragma unroll
          for (int q = 0; q < 8; ++q) cge += (unsigned)__popcll(__ballot(ck[q] >= trial));
          if (cge >= need) T = trial;
        }
      }
      unsigned cgt = 0u;
#pragma unroll
      for (int q = 0; q < 8; ++q) cgt += (unsigned)__popcll(__ballot(ck[q] > T));
      const unsigned need_eq = need - cgt;
      unsigned pos0 = cum, eqtaken = 0u;
#pragma unroll
      for (int q = 0; q < 8; ++q) {
        const bool gt = ck[q] > T;
        const bool eq = ck[q] == T;
        const unsigned long long beq = __ballot(eq);
        const bool take = gt || (eq && (eqtaken + (unsigned)__popcll(beq & lt_mask)) < need_eq);
        const unsigned long long bt = __ballot(take);
        const unsigned pp = pos0 + (unsigned)__popcll(bt & lt_mask);
        if (take && pp < 256u) mysel[pp] = ci[q];
        pos0 += (unsigned)__popcll(bt);
        eqtaken += (unsigned)__popcll(beq);
      }
    } else {
      unsigned prefix = 0u, krem = 256u;
#pragma unroll 1
      for (int pass = 0; pass < 4; ++pass) {
        const int shift = 24 - 8 * pass;
        const unsigned himask = (pass == 0) ? 0u : (0xFFFFFFFFu << (shift + 8));
#pragma unroll
        for (int i = 0; i < 4; ++i) myh[lane + 64 * i] = 0u;
        lds_fence();
        for (int i = lane; i < n; i += 64) {
          const unsigned u = sortable_key(rowf[i]);
          if ((u & himask) == prefix) atomicAdd(&myh[(u >> shift) & 255u], 1u);
        }
        lds_fence();
        const uint4 c4 = *(const uint4*)(myh + 4 * lane);
        const unsigned c = c4.x + c4.y + c4.z + c4.w;
        unsigned sfx = c;
#pragma unroll
        for (int o = 1; o < 64; o <<= 1) { const unsigned tt = __shfl_down(sfx, o); if (lane + o < 64) sfx += tt; }
        const unsigned long long bal = __ballot(sfx >= krem);
        const int L = 63 - __clzll(bal);
        const unsigned sL = __shfl(sfx, L), cL = __shfl(c, L);
        const unsigned b3 = __shfl(c4.w, L), b2 = __shfl(c4.z, L), b1 = __shfl(c4.y, L);
        unsigned cum2 = sL - cL;
        unsigned digit;
        if (cum2 + b3 >= krem) digit = 3;
        else { cum2 += b3; if (cum2 + b2 >= krem) digit = 2; else { cum2 += b2; if (cum2 + b1 >= krem) digit = 1; else { cum2 += b1; digit = 0; } } }
        krem -= cum2;
        prefix |= ((unsigned)(4 * L) + digit) << shift;
      }
      const unsigned T = prefix;
      unsigned base = 0u, eqtaken = 0u;
      for (int i0 = 0; i0 < n; i0 += 64) {
        const int i = i0 + lane;
        const bool valid = i < n;
        const unsigned u = valid ? sortable_key(rowf[i]) : 0u;
        const bool gt = valid && (u > T);
        const bool eq = valid && (u == T);
        const unsigned long long beq = __ballot(eq);
        const unsigned eqrank = eqtaken + (unsigned)__popcll(beq & lt_mask);
        const bool take = gt || (eq && eqrank < krem);
        const unsigned long long bt = __ballot(take);
        const unsigned pos = base + (unsigned)__popcll(bt & lt_mask);
        if (take && pos < 256u) mysel[pos] = (unsigned short)i;
        base += (unsigned)__popcll(bt);
        eqtaken += (unsigned)__popcll(beq);
      }
    }
  }
  lds_fence();
  if (lane == 0) { rmm[w] = 0xFFFFFFFFu; rmm[8 + w] = 0u; }
  lds_fence();
  {
    const uint2 s4 = *(const uint2*)(mysel + 4 * lane);
    const int sj[4] = {(int)(s4.x & 0xffffu), (int)(s4.x >> 16), (int)(s4.y & 0xffffu), (int)(s4.y >> 16)};
    unsigned pk = 0u;
#pragma unroll
    for (int j = 0; j < 4; ++j) {
      const bool valid = 4 * lane + j < cnt;
      const int dist = valid ? t - sj[j] : 0;
      unsigned bk = dist < 128 ? (unsigned)bkt[dist] : 31u;
      bk = valid ? bk : 32u;
      pk |= bk << (8 * j);
    }
    bks[w * 64 + lane] = pk;
  }
  lds_fence();
  {
    int lane_a = lane;
    asm volatile("" : "+v"(lane_a));
    const int l15 = lane_a & 15, g = lane_a >> 4;
    const int ks = lane_a >> 3, dc = lane_a & 7;
    const unsigned char* kcb = (const unsigned char*)(kc + tokbase * 64);
    const unsigned char* vcb = (const unsigned char*)(vc + tokbase * 64);
    float* pl = (float*)row;
    const float* relb = (const float*)(bkt + 128);
    const int niter = (cnt + 7) >> 3;
    bf16x8 bq0 = (bf16x8){0, 0, 0, 0, 0, 0, 0, 0}, bq1 = bq0;
    if (l15 < 8) {
      bq0 = *(const bf16x8*)(pA + (tokbase + t) * 1024 + l15 * 64 + 8 * g);
      bq1 = *(const bf16x8*)(pA + (tokbase + t) * 1024 + l15 * 64 + 32 + 8 * g);
    }
    float lg[16][4];
    {
      bf16x8 ka[8][2], kb[8][2];
#pragma unroll
      for (int u = 0; u < 8; ++u) {
        const int kk = u * 16 + l15;
        const unsigned s = (unsigned)mysel[kk] & 4095u;
        const unsigned ko = s * 128u + 16u * (unsigned)g;
        ka[u][0] = *(const bf16x8*)(kcb + ko);
        ka[u][1] = *(const bf16x8*)(kcb + ko + 64u);
      }
#pragma unroll
      for (int u = 0; u < 8; ++u) {
        const int kk = (8 + u) * 16 + l15;
        const unsigned s = (unsigned)mysel[kk] & 4095u;
        const unsigned ko = s * 128u + 16u * (unsigned)g;
        kb[u][0] = *(const bf16x8*)(kcb + ko);
        kb[u][1] = *(const bf16x8*)(kcb + ko + 64u);
      }
      __builtin_amdgcn_sched_barrier(0);
#pragma unroll
      for (int u = 0; u < 8; ++u) {
        f32x4 acc = (f32x4){0.f, 0.f, 0.f, 0.f};
        acc = __builtin_amdgcn_mfma_f32_16x16x32_bf16(ka[u][0], bq0, acc, 0, 0, 0);
        acc = __builtin_amdgcn_mfma_f32_16x16x32_bf16(ka[u][1], bq1, acc, 0, 0, 0);
        lg[u][0] = acc[0]; lg[u][1] = acc[1]; lg[u][2] = acc[2]; lg[u][3] = acc[3];
      }
#pragma unroll
      for (int u = 0; u < 8; ++u) {
        f32x4 acc = (f32x4){0.f, 0.f, 0.f, 0.f};
        acc = __builtin_amdgcn_mfma_f32_16x16x32_bf16(kb[u][0], bq0, acc, 0, 0, 0);
        acc = __builtin_amdgcn_mfma_f32_16x16x32_bf16(kb[u][1], bq1, acc, 0, 0, 0);
        lg[8 + u][0] = acc[0]; lg[8 + u][1] = acc[1]; lg[8 + u][2] = acc[2]; lg[8 + u][3] = acc[3];
      }
    }
    typedef unsigned u32x4_t __attribute__((ext_vector_type(4)));
    u32x4_t va[16];
#pragma unroll
    for (int u = 0; u < 16; ++u) {
      const int kk = u * 8 + ks;
      const unsigned s = (unsigned)mysel[kk] & 4095u;
      va[u] = *(const u32x4_t*)(vcb + s * 128u + 16u * (unsigned)dc);
    }
    __builtin_amdgcn_sched_barrier(0);
    const int hsel = l15 & 7;
    float m = -INFINITY;
    const unsigned* mybks = bks + w * 64;
#pragma unroll
    for (int u = 0; u < 16; ++u) {
      const unsigned bk4 = mybks[4 * u + g];
#pragma unroll
      for (int j = 0; j < 4; ++j) {
        lg[u][j] = lg[u][j] * 0.125f + relb[((bk4 >> (8 * j)) & 255u) * 8 + hsel];
        m = fmaxf(m, lg[u][j]);
      }
    }
    m = max_xor16(m); m = max_xor32(m);
    float sum = 0.f;
#pragma unroll
    for (int u = 0; u < 16; ++u)
#pragma unroll
      for (int j = 0; j < 4; ++j) { lg[u][j] = __expf(lg[u][j] - m); sum += lg[u][j]; }
    sum = add_xor16(sum); sum = add_xor32(sum);
    const float inv = 1.f / sum;
    bf16x8 pa[8];
#pragma unroll
    for (int s8 = 0; s8 < 8; ++s8) {
      const unsigned w0 = pack2(lg[2 * s8][0] * inv, lg[2 * s8][1] * inv), w1 = pack2(lg[2 * s8][2] * inv, lg[2 * s8][3] * inv);
      const unsigned w2 = pack2(lg[2 * s8 + 1][0] * inv, lg[2 * s8 + 1][1] * inv), w3 = pack2(lg[2 * s8 + 1][2] * inv, lg[2 * s8 + 1][3] * inv);
      const u32x4_t wv = {w0, w1, w2, w3};
      pa[s8] = __builtin_bit_cast(bf16x8, wv);
    }
    unsigned char* vs_l = (unsigned char*)row;
#pragma unroll
    for (int u = 0; u < 16; ++u) *(u32x4_t*)(vs_l + (u * 8 + ks) * 128 + dc * 16) = va[u];
    lds_fence();
    u32x4_t vb[16];
#pragma unroll
    for (int u = 0; u < 16; ++u) {
      const int kk = (16 + u) * 8 + ks;
      const unsigned s = (unsigned)mysel[kk] & 4095u;
      vb[u] = *(const u32x4_t*)(vcb + s * 128u + 16u * (unsigned)dc);
    }
    __builtin_amdgcn_sched_barrier(0);
    f32x4 ov[4];
#pragma unroll
    for (int nt = 0; nt < 4; ++nt) ov[nt] = (f32x4){0.f, 0.f, 0.f, 0.f};
    typedef short v4s_t __attribute__((ext_vector_type(4)));
    const unsigned tr_lane = (unsigned)((l15 >> 2) * 128 + (l15 & 3) * 8);
#define PV_HALF(S0) do { \
      _Pragma("unroll") for (int s4_ = 0; s4_ < 4; ++s4_) { \
        _Pragma("unroll") for (int nt = 0; nt < 4; ++nt) { \
          const unsigned a0 = (unsigned)((s4_ * 32 + 4 * g) * 128 + nt * 32) + tr_lane; \
          const v4s_t b0 = __builtin_amdgcn_ds_read_tr16_b64_v4i16((__attribute__((address_space(3))) v4s_t*)(vs_l + a0)); \
          const v4s_t b1 = __builtin_amdgcn_ds_read_tr16_b64_v4i16((__attribute__((address_space(3))) v4s_t*)(vs_l + a0 + 16 * 128)); \
          const bf16x8 bb = (bf16x8){b0[0], b0[1], b0[2], b0[3], b1[0], b1[1], b1[2], b1[3]}; \
          ov[nt] = __builtin_amdgcn_mfma_f32_16x16x32_bf16(pa[(S0) + s4_], bb, ov[nt], 0, 0, 0); \
        } \
      } \
    } while (0)
    PV_HALF(0);
    lds_fence();
#pragma unroll
    for (int u = 0; u < 16; ++u) *(u32x4_t*)(vs_l + (u * 8 + ks) * 128 + dc * 16) = vb[u];
    lds_fence();
    PV_HALF(4);
#undef PV_HALF
    if (g < 2) {
#pragma unroll
      for (int nt = 0; nt < 4; ++nt)
#pragma unroll
        for (int j = 0; j < 4; ++j) yb[(tokbase + t) * 1024 + (4 * g + j) * 64 + nt * 16 + l15] = f2bf(ov[nt][j]);
    }
    lds_fence();
  }
  __syncthreads();
}

__device__ __forceinline__ void phase_mix(const Params& p, unsigned char* smem, int mode = 0) {
  const int G = gridDim.x;
  if (mode != 2) { for (int bh = blockIdx.x; bh < 32; bh += G) { hgrn_h2(p, smem, bh); __syncthreads(); } }
  if (mode == 1) return;
  unsigned char* bkt = smem + DSA_BKT_OFF;
  volatile int* qslot = (volatile int*)(smem + LDS_BYTES - 32);
  unsigned* qctr = (unsigned*)(p.ws + WS_QCTR);
  if (threadIdx.x < 128) {
    const int nn = threadIdx.x;
    int v = nn;
    if (nn >= 16) { v = 16 + (int)(logf((float)nn * (1.f / 16.f)) / logf(8.f) * 16.f); if (v > 31) v = 31; }
    bkt[nn] = (unsigned char)v;
  }
  if (threadIdx.x >= 256) ((float*)(bkt + 128))[threadIdx.x - 256] = p.rel_bias[threadIdx.x - 256];
  if (threadIdx.x >= 128 && threadIdx.x < 136) ((float*)(bkt + 128))[256 + threadIdx.x - 128] = -INFINITY;
  if (threadIdx.x < 16) ((unsigned*)(bkt + 128 + 1056))[threadIdx.x] = threadIdx.x < 8 ? 0xFFFFFFFFu : 0u;
  const int my_team = (G % 8 == 0) ? team_index(p, smem) / (G >> 3) : (int)(blockIdx.x & 7);
  constexpr int QN = 544;
#define Q_FETCH(SLOT) do { if (threadIdx.x == 0) { int tm_ = q_team, kk_ = -1; \
      for (int tries_ = 0; tries_ < 8; ++tries_) { \
        const unsigned v_ = __hip_atomic_fetch_add(qctr + 16 * tm_, 1u, __ATOMIC_RELAXED, __HIP_MEMORY_SCOPE_AGENT); \
        if (v_ < (unsigned)QN) { kk_ = (tm_ << 16) | (int)v_; break; } \
        tm_ = (tm_ + 1) & 7; } \
      q_team = tm_; qslot[SLOT] = kk_; } } while (0)
  int q_team = my_team;
  Q_FETCH(0);
  __syncthreads();
  int k = qslot[0];
  int par = 1;
  while (k >= 0) {
    Q_FETCH(par);
    const int bt = k >> 16, kl = k & 0xffff;
    const int kq = kl / 17, kr = kl - kq * 17;
    if (kr < 16) {
      const int tb = 511 - (kq * 16 + kr);
      dsa_item(p, smem, (bt << 9) | tb);
    } else {
      const int r0 = (bt * 32 + kq) * 64;
      quantize_rows_u8<false, true>(p.peer_u, p.ws + WS_U, (float*)(p.ws + WS_U + (size_t)16384 * 1024), r0, r0 + 64);
      quantize_rows_u8<true, false>(p.peer_v, p.ws + WS_V, (float*)(p.ws + WS_V + (size_t)16384 * 1024), r0, r0 + 64);
      __syncthreads();
    }
    k = qslot[par];
    par ^= 1;
  }
#undef Q_FETCH
}

__device__ __forceinline__ void phase_pkeys(const Params& p, unsigned char* smem) {
  unsigned char* ws = p.ws;
  const bf16_t* qp = (const bf16_t*)(ws + WS_PG);
  const bf16_t* keys = (const bf16_t*)(ws + WS_KEYS);
  int* eidx = (int*)(ws + WS_EIDX);
  float* gw = (float*)(ws + WS_GW);
  float* sc = (float*)smem;
  float* s2l = (float*)smem;
  unsigned short* i1l = (unsigned short*)(s2l + 256 * 17);
  unsigned short* i2l = i1l + 256 * 16;
  const int tid = threadIdx.x, lane = tid & 63, w = tid >> 6, wm = w >> 1, wn = w & 1, l15 = lane & 15, g = lane >> 4;
  for (int item = blockIdx.x; item < 128 * 8; item += gridDim.x) {
    const int h = item & 7, tm = item >> 3;
    float s1[16], s2v[16]; int i1[16], i2[16];
#pragma unroll
    for (int ph = 0; ph < 2; ++ph) {
      const int hp = h * 2 + ph;
      f32x4 acc[4][4]; zero_acc(acc);
      gemm_tile(qp + (size_t)tm * 256 * 2048 + hp * 128, 2048, keys + (size_t)(ph * 8 + h) * 128 * 128, 128, 2, acc, smem);
      __syncthreads();
#pragma unroll
      for (int m = 0; m < 4; ++m)
#pragma unroll
        for (int n = 0; n < 4; ++n)
#pragma unroll
          for (int j = 0; j < 4; ++j) sc[(wm * 64 + m * 16 + 4 * g + j) * 129 + wn * 64 + n * 16 + l15] = acc[m][n][j];
      __syncthreads();
      if (tid < 256) {
        const float* rowp = sc + tid * 129;
        unsigned tv[16];
#pragma unroll
        for (int k = 0; k < 16; ++k) tv[k] = 0u;
#pragma unroll 8
        for (int nn = 0; nn < 128; ++nn) {
          const unsigned bits = __float_as_uint(rowp[nn]);
          unsigned key = (bits & 0x80000000u) ? ~bits : (bits | 0x80000000u);
          key = (key & ~127u) | (unsigned)(127 - nn);
#pragma unroll
          for (int k = 15; k >= 1; --k) {
            unsigned r;
            asm("v_med3_u32 %0, %1, %2, %3" : "=v"(r) : "v"(tv[k]), "v"(tv[k - 1]), "v"(key));
            tv[k] = r;
          }
          tv[0] = tv[0] > key ? tv[0] : key;
        }
#pragma unroll
        for (int k = 0; k < 16; ++k) {
          const int col = 127 - (int)(tv[k] & 127u);
          const float val = rowp[col];
          if (ph == 0) { i1[k] = col; s1[k] = val; } else { i2[k] = col; s2v[k] = val; }
        }
      }
      __syncthreads();
    }
    if (tid < 256) {
#pragma unroll
      for (int a = 0; a < 16; ++a) { s2l[tid * 17 + a] = s2v[a]; i1l[tid * 16 + a] = (unsigned short)i1[a]; i2l[tid * 16 + a] = (unsigned short)i2[a]; }
      float cur[16];
#pragma unroll
      for (int a = 0; a < 16; ++a) cur[a] = s1[a] + s2v[0];
      unsigned long long ptr = 0ull;
      float tops[16]; int tope[16];
#pragma unroll
      for (int k = 0; k < 16; ++k) {
        float best = cur[0]; int ba = 0;
#pragma unroll
        for (int a = 1; a < 16; ++a) if (cur[a] > best) { best = cur[a]; ba = a; }
        const int bb = (int)((ptr >> (4 * ba)) & 15ull);
        tops[k] = best;
        tope[k] = (int)i1l[tid * 16 + ba] * 128 + (int)i2l[tid * 16 + bb];
        const int nb = bb + 1;
        const float ns2 = (nb < 16) ? s2l[tid * 17 + nb] : -INFINITY;
        if (nb < 16) ptr += (1ull << (4 * ba));
#pragma unroll
        for (int a = 0; a < 16; ++a) if (a == ba) cur[a] = s1[a] + ns2;
      }
      const float m = tops[0];
      float sum = 0.f;
#pragma unroll
      for (int k = 0; k < 16; ++k) { tops[k] = __expf(tops[k] - m); sum += tops[k]; }
      const float inv = 1.f / sum;
      const size_t ob = ((size_t)(tm * 256 + tid) * 8 + h) * 16;
#pragma unroll
      for (int k = 0; k < 16; k += 4) {
        *(int4*)(eidx + ob + k) = make_int4(tope[k], tope[k + 1], tope[k + 2], tope[k + 3]);
        *(float4*)(gw + ob + k) = make_float4(tops[k] * inv, tops[k + 1] * inv, tops[k + 2] * inv, tops[k + 3] * inv);
      }
    }
    __syncthreads();
  }
}


__device__ __forceinline__ float reduce8(const float (&pv)[8], int lane) {
  const bool b5 = lane & 32, b4 = lane & 16, b3 = lane & 8;
  float v[4];
#pragma unroll
  for (int i = 0; i < 4; ++i) {
    const float keep = b5 ? pv[4 + i] : pv[i];
    const float send = b5 ? pv[i] : pv[4 + i];
    v[i] = keep + __shfl_xor(send, 32);
  }
  float u[2];
#pragma unroll
  for (int i = 0; i < 2; ++i) {
    const float keep = b4 ? v[2 + i] : v[i];
    const float send = b4 ? v[i] : v[2 + i];
    u[i] = keep + __shfl_xor(send, 16);
  }
  float x = (b3 ? u[1] : u[0]) + __shfl_xor(b3 ? u[0] : u[1], 8);
  x += __shfl_xor(x, 4); x += __shfl_xor(x, 2); x += __shfl_xor(x, 1);
  return x;
}

__device__ __forceinline__ void cvt16u8(const uint4& v, float* f) {
  f[0] = (float)(v.x & 0xffu); f[1] = (float)((v.x >> 8) & 0xffu); f[2] = (float)((v.x >> 16) & 0xffu); f[3] = (float)(v.x >> 24);
  f[4] = (float)(v.y & 0xffu); f[5] = (float)((v.y >> 8) & 0xffu); f[6] = (float)((v.y >> 16) & 0xffu); f[7] = (float)(v.y >> 24);
  f[8] = (float)(v.z & 0xffu); f[9] = (float)((v.z >> 8) & 0xffu); f[10] = (float)((v.z >> 16) & 0xffu); f[11] = (float)(v.z >> 24);
  f[12] = (float)(v.w & 0xffu); f[13] = (float)((v.w >> 8) & 0xffu); f[14] = (float)((v.w >> 16) & 0xffu); f[15] = (float)(v.w >> 24);
}

__device__ __forceinline__ int wave_sum_i32_dpp(int v) {
  v += __builtin_amdgcn_update_dpp(0, v, 0xB1, 0xf, 0xf, true);
  v += __builtin_amdgcn_update_dpp(0, v, 0x4E, 0xf, 0xf, true);
  v += __builtin_amdgcn_update_dpp(0, v, 0x141, 0xf, 0xf, true);
  v += __builtin_amdgcn_update_dpp(0, v, 0x140, 0xf, 0xf, true);
  return __builtin_amdgcn_readlane(v, 0) + __builtin_amdgcn_readlane(v, 16) + __builtin_amdgcn_readlane(v, 32) + __builtin_amdgcn_readlane(v, 48);
}

__device__ __forceinline__ int reduce8_i32_scatter(const int (&d)[8], int lane) {
  const bool b0 = lane & 1, b1 = lane & 2, b2 = lane & 4;
  int v[4];
#pragma unroll
  for (int i = 0; i < 4; ++i) {
    const int keep = b0 ? d[2 * i + 1] : d[2 * i];
    const int send = b0 ? d[2 * i] : d[2 * i + 1];
    v[i] = keep + __builtin_amdgcn_update_dpp(0, send, 0xB1, 0xf, 0xf, true);
  }
  int u[2];
#pragma unroll
  for (int i = 0; i < 2; ++i) {
    const int keep = b1 ? v[2 * i + 1] : v[2 * i];
    const int send = b1 ? v[2 * i] : v[2 * i + 1];
    u[i] = keep + __builtin_amdgcn_update_dpp(0, send, 0x4E, 0xf, 0xf, true);
  }
  int x;
  {
    const int keep = b2 ? u[1] : u[0];
    const int send = b2 ? u[0] : u[1];
    int t = __builtin_amdgcn_update_dpp(0, send, 0x141, 0xf, 0xf, true);
    t = __builtin_amdgcn_update_dpp(0, t, 0x1B, 0xf, 0xf, true);
    x = keep + t;
  }
  x += __builtin_amdgcn_update_dpp(0, x, 0x128, 0xf, 0xf, true);
  { const auto r = __builtin_amdgcn_permlane16_swap((unsigned)x, (unsigned)x, false, false); x = (int)r[0] + (int)r[1]; }
  { const auto r = __builtin_amdgcn_permlane32_swap((unsigned)x, (unsigned)x, false, false); x = (int)r[0] + (int)r[1]; }
  return x;
}

__device__ __forceinline__ void phase_pu(const Params& p, unsigned char* smem) {
  unsigned char* ws = p.ws;
  const unsigned char* XQ = ws + WS_XQ;
  const float* xs = (const float*)(ws + WS_XS);
  const unsigned char* U8 = ws + WS_U;
  const float* us = (const float*)(ws + WS_U + (size_t)16384 * 1024);
  const float* vs = (const float*)(ws + WS_V + (size_t)16384 * 1024);
  const int* eidx = (const int*)(ws + WS_EIDX);
  const float* gw = (const float*)(ws + WS_GW);
  float* aw = (float*)(ws + WS_PA);
  const int lane = threadIdx.x & 63, w = threadIdx.x >> 6;
  const unsigned long long lt_mask = (1ull << lane) - 1ull;
  const int G = gridDim.x;
  const bool sliced = (G % 8 == 0);
  const int ti = sliced ? team_index(p, smem) : 0;
  const int tsz = sliced ? (G >> 3) : G;
  const int grp_lo = sliced ? ti / tsz : 0, grp_hi = sliced ? grp_lo + 1 : 8;
  const int slot = (sliced ? (ti % tsz) : (int)blockIdx.x) * 8 + w;
  const int nslot = tsz * 8;
  unsigned* lst = (unsigned*)smem + 4096 + w * 128;
  typedef unsigned u32x4_t __attribute__((ext_vector_type(4)));
  if (slot >= TOK) return;
  for (int grp = grp_lo; grp < grp_hi; ++grp) {
#define PU_LIST(E0, E1, N, L0, L1) do { \
      const bool m0_ = ((E0) >> 11) == grp, m1_ = ((E1) >> 11) == grp; \
      const unsigned long long b0_ = __ballot(m0_), b1_ = __ballot(m1_); \
      const int c0_ = __popcll(b0_); N = c0_ + __popcll(b1_); \
      if (m0_) lst[__popcll(b0_ & lt_mask)] = ((unsigned)lane << 14) | (unsigned)(E0); \
      if (m1_) lst[c0_ + __popcll(b1_ & lt_mask)] = ((unsigned)(lane + 64) << 14) | (unsigned)(E1); \
      lds_fence(); \
      L0 = (lane < N) ? lst[lane] : 0u; L1 = (lane + 64 < N) ? lst[lane + 64] : 0u; \
      lds_fence(); } while (0)
#define PU_ISSUE(BUF, L0, N, I0) do { int last_ = ((N) < 64 ? (N) : 64) - 1; last_ = last_ < 0 ? 0 : last_; \
      _Pragma("unroll") for (int j = 0; j < 8; ++j) { int idx_ = (I0) + j; idx_ = idx_ < last_ ? idx_ : last_; \
        const unsigned le_ = (unsigned)__builtin_amdgcn_readlane((int)(L0), idx_); \
        BUF[j] = *(const u32x4_t*)(U8 + (size_t)(le_ & 16383u) * 1024 + lane * 16); } } while (0)
#define PU_REDUCE(BUF, X, I0, HREG) do { int dd_[8]; _Pragma("unroll") for (int j = 0; j < 8; ++j) { \
        int d_ = __builtin_amdgcn_sdot4((int)BUF[j].x, (int)(X).x, 0, false); \
        d_ = __builtin_amdgcn_sdot4((int)BUF[j].y, (int)(X).y, d_, false); \
        d_ = __builtin_amdgcn_sdot4((int)BUF[j].z, (int)(X).z, d_, false); \
        dd_[j] = __builtin_amdgcn_sdot4((int)BUF[j].w, (int)(X).w, d_, false); } \
      const int tot_ = reduce8_i32_scatter(dd_, lane);     \
      if (lane >= (I0) && lane < (I0) + 8) HREG = tot_; } while (0)
    u32x4_t cx = *(const u32x4_t*)(XQ + (size_t)slot * 1024 + lane * 16);
    int ce0 = eidx[(size_t)slot * 128 + lane], ce1 = eidx[(size_t)slot * 128 + 64 + lane];
    float cxs = xs[slot];
    int cn; unsigned cl0, cl1;
    PU_LIST(ce0, ce1, cn, cl0, cl1);
    u32x4_t ra[8], rb[8], rc[8];
    PU_ISSUE(ra, cl0, cn, 0);
    PU_ISSUE(rb, cl0, cn, 8);
    int t1 = (slot + nslot < TOK) ? slot + nslot : slot;
    u32x4_t nx = *(const u32x4_t*)(XQ + (size_t)t1 * 1024 + lane * 16);
    int ne0 = eidx[(size_t)t1 * 128 + lane], ne1 = eidx[(size_t)t1 * 128 + 64 + lane];
    float nxs = xs[t1];
    for (int tok = slot; tok < TOK; tok += nslot) {
      float sc0 = 0.f, sc1 = 0.f, gv0 = 0.f, gv1 = 0.f, vv0 = 0.f, vv1 = 0.f;
      if (lane < cn) { const int e = cl0 & 16383; sc0 = us[e]; vv0 = vs[e]; gv0 = gw[(size_t)tok * 128 + (cl0 >> 14)]; }
      if (lane + 64 < cn) { const int e = cl1 & 16383; sc1 = us[e]; vv1 = vs[e]; gv1 = gw[(size_t)tok * 128 + (cl1 >> 14)]; }
      int nn; unsigned nl0, nl1;
      PU_LIST(ne0, ne1, nn, nl0, nl1);
      const u32x4_t x1 = nx; const int xe0 = ne0, xe1 = ne1; const float xs1 = nxs;
      const int t2a = tok + nslot, t2 = (t2a + nslot < TOK) ? t2a + nslot : ((t2a < TOK) ? t2a : tok);
      nx = *(const u32x4_t*)(XQ + (size_t)t2 * 1024 + lane * 16);
      ne0 = eidx[(size_t)t2 * 128 + lane]; ne1 = eidx[(size_t)t2 * 128 + 64 + lane];
      nxs = xs[t2];
      int h0i = 0, h1i = 0;
      const bool third = cn > 16;
      if (third) { PU_ISSUE(rc, cl0, cn, 16); }
      __builtin_amdgcn_sched_barrier(0); PU_REDUCE(ra, cx, 0, h0i);  __builtin_amdgcn_sched_barrier(0);
      PU_ISSUE(ra, nl0, nn, 0);  __builtin_amdgcn_sched_barrier(0); PU_REDUCE(rb, cx, 8, h0i);  __builtin_amdgcn_sched_barrier(0);
      PU_ISSUE(rb, nl0, nn, 8);  __builtin_amdgcn_sched_barrier(0);
      if (third) { PU_REDUCE(rc, cx, 16, h0i); }
      __builtin_amdgcn_sched_barrier(0);
      if (cn > 24) {
        for (int i0 = 24; i0 < cn; i0 += 8) {
          u32x4_t rd[8];
          const bool lo = i0 < 64;
          const unsigned lsrc = lo ? cl0 : cl1;
          const int nsrc = lo ? cn : cn - 64;
          PU_ISSUE(rd, lsrc, nsrc, i0 & 63);
          if (lo) { PU_REDUCE(rd, cx, i0, h0i); } else { PU_REDUCE(rd, cx, i0 - 64, h1i); }
        }
      }
      const float h0 = (float)h0i * sc0 * cxs, h1 = (float)h1i * sc1 * cxs;
      if (lane < cn) aw[(size_t)tok * 128 + (cl0 >> 14)] = 0.5f * h0 * (1.f + erff(h0 * 0.70710678118654752f)) * gv0 * vv0;
      if (lane + 64 < cn) aw[(size_t)tok * 128 + (cl1 >> 14)] = 0.5f * h1 * (1.f + erff(h1 * 0.70710678118654752f)) * gv1 * vv1;
      cx = x1; ce0 = xe0; ce1 = xe1; cxs = xs1; cn = nn; cl0 = nl0; cl1 = nl1;
    }
#undef PU_LIST
#undef PU_ISSUE
#undef PU_REDUCE
  }
}

template <bool SL>
__device__ __forceinline__ void phase_pv_t(const Params& p, unsigned char* smem) {
  unsigned char* ws = p.ws;
  const unsigned char* V8 = ws + WS_V;
  const int* eidx = (const int*)(ws + WS_EIDX);
  const float* aw = (const float*)(ws + WS_PA);
  float* ssq = (float*)(ws + WS_SSQ);
  const int lane = threadIdx.x & 63, w = threadIdx.x >> 6;
  const int q = lane >> 3, c = lane & 7;
  const int G = gridDim.x;
  constexpr bool sliced = SL;
  const int ti = sliced ? team_index(p, smem) : 0;
  const int tsz = G >> 3;
  const int grp0 = sliced ? (ti / tsz) : 0;
  constexpr int ngrp = sliced ? 1 : 8;
  const int slot = sliced ? (ti % tsz) * 8 + w : blockIdx.x * 8 + w;
  const int nslot = sliced ? tsz * 8 : G * 8;
  int ee[16]; float aa[16];
  if (slot < TOK) {
    unsigned bi = (unsigned)slot * 128u + 16u * (unsigned)q;
    asm volatile("" : "+v"(bi));
#pragma unroll
    for (int u4 = 0; u4 < 4; ++u4) {
      const int4 e4 = *(const int4*)(eidx + bi + 4 * u4); const float4 a4 = *(const float4*)(aw + bi + 4 * u4);
      ee[4 * u4] = e4.x; ee[4 * u4 + 1] = e4.y; ee[4 * u4 + 2] = e4.z; ee[4 * u4 + 3] = e4.w;
      aa[4 * u4] = a4.x; aa[4 * u4 + 1] = a4.y; aa[4 * u4 + 2] = a4.z; aa[4 * u4 + 3] = a4.w;
    }
  }
  for (int tok = slot; tok < TOK; tok += nslot) {
    int ce[16]; float ca[16];
    float suma = 0.f;
#pragma unroll
    for (int u = 0; u < 16; ++u) { ce[u] = ee[u]; ca[u] = aa[u]; suma += aa[u]; }
    for (int gi = 0; gi < ngrp; ++gi) {
      const int grp = grp0 + gi;
      uint4 vv[16];
#pragma unroll
      for (int u = 0; u < 16; ++u) vv[u] = *(const uint4*)(V8 + (size_t)grp * (16384 * 128) + (size_t)ce[u] * 128 + c * 16);
      float* orow = p.out + (size_t)tok * 1024 + grp * 128 + c * 16;
      float4 x1v[4];
#pragma unroll
      for (int i = 0; i < 4; ++i) x1v[i] = *(const float4*)(orow + 4 * i);
      if (gi == ngrp - 1) {
        const int nt = (tok + nslot < TOK) ? tok + nslot : tok;
        unsigned bi = (unsigned)nt * 128u + 16u * (unsigned)q;
        asm volatile("" : "+v"(bi));
#pragma unroll
        for (int u4 = 0; u4 < 4; ++u4) {
          const int4 e4 = *(const int4*)(eidx + bi + 4 * u4); const float4 a4 = *(const float4*)(aw + bi + 4 * u4);
          ee[4 * u4] = e4.x; ee[4 * u4 + 1] = e4.y; ee[4 * u4 + 2] = e4.z; ee[4 * u4 + 3] = e4.w;
          aa[4 * u4] = a4.x; aa[4 * u4 + 1] = a4.y; aa[4 * u4 + 2] = a4.z; aa[4 * u4 + 3] = a4.w;
        }
      }
      __builtin_amdgcn_sched_barrier(0);
      float acc[16];
#pragma unroll
      for (int i = 0; i < 16; ++i) acc[i] = -128.f * suma;
#pragma unroll
      for (int u = 0; u < 16; ++u) {
        float vf[16];
        cvt16u8(vv[u], vf);
#pragma unroll
        for (int i = 0; i < 16; ++i) acc[i] += ca[u] * vf[i];
        __builtin_amdgcn_sched_barrier(0);
      }
#pragma unroll
      for (int i = 0; i < 16; ++i) { acc[i] = add_xor8(acc[i]); acc[i] = add_xor16(acc[i]); acc[i] = add_xor32(acc[i]); }
      float ss = 0.f;
      if (q == 0) {
#pragma unroll
        for (int i = 0; i < 4; ++i) {
          const float4 oa = make_float4(x1v[i].x + acc[4 * i], x1v[i].y + acc[4 * i + 1], x1v[i].z + acc[4 * i + 2], x1v[i].w + acc[4 * i + 3]);
          *(float4*)(orow + 4 * i) = oa;
          ss += oa.x * oa.x + oa.y * oa.y + oa.z * oa.z + oa.w * oa.w;
        }
      }
      ss += __shfl_xor(ss, 1); ss += __shfl_xor(ss, 2); ss += __shfl_xor(ss, 4);
      if (lane == 0) atomicAdd(&ssq[tok], ss);
    }
  }
}

__device__ __forceinline__ void phase_final(const Params& p) {
  const float* ssq = (const float*)(p.ws + WS_SSQ);
  const int lane = threadIdx.x & 63, w = threadIdx.x >> 6;
  for (int row = blockIdx.x * 8 + w; row < TOK; row += gridDim.x * 8) {
    const float rstd = rsqrtf(ssq[row] * (1.f / DM) + EPSV);
    float4* o4 = (float4*)(p.out + (size_t)row * DM);
#pragma unroll
    for (int i = 0; i < 4; ++i) {
      float4 v = o4[lane + 64 * i];
      const float4 gg = ((const float4*)p.norm_final)[lane + 64 * i];
      v.x *= rstd * gg.x; v.y *= rstd * gg.y; v.z *= rstd * gg.z; v.w *= rstd * gg.w;
      o4[lane + 64 * i] = v;
    }
  }
}


__device__ __forceinline__ void phase_proj8(const Params& p, unsigned char* smem) {
  unsigned char* ws = p.ws;
  pg8::Gemm g{(const pg8::bf16_t*)(ws + WS_XN), (const pg8::bf16_t*)(ws + WS_WIN), TOK, 5120, 1024};
  pg8::StaticOrder S; S.init(TOK, 5120, (int)gridDim.x, (int)blockIdx.x);
  EpiProj E{(unsigned short*)(ws + WS_PH), (unsigned short*)(ws + WS_PA), (unsigned short*)(ws + WS_PG),
            (unsigned short*)(ws + WS_KC), (unsigned short*)(ws + WS_VC), (unsigned short*)(ws + WS_IKC)};
  pg8::gemm_phase<EpiProj, pg8::StaticOrder>((PG8_LAS unsigned char*)smem, g, S, E, nullptr);
}
__device__ __forceinline__ void phase_ikln(const Params& p) {
  bf16_t* ikc = (bf16_t*)(p.ws + WS_IKC);
  const int tid = threadIdx.x, sub = tid & 7;
  float gam[8], bet[8];
#pragma unroll
  for (int i = 0; i < 8; ++i) { gam[i] = p.ikg[sub * 8 + i]; bet[i] = p.ikb[sub * 8 + i]; }
  for (int row = blockIdx.x * 64 + (tid >> 3); row < TOK; row += gridDim.x * 64) {
    uint4* ptr = (uint4*)(ikc + (size_t)row * 64 + sub * 8);
    const uint4 raw = *ptr;
    float v[8];
    cvt8(raw, v);
    float s = 0.f;
#pragma unroll
    for (int i = 0; i < 8; ++i) s += v[i];
    s += __shfl_xor(s, 1); s += __shfl_xor(s, 2); s += __shfl_xor(s, 4);
    const float mu = s * (1.f / 64.f);
    float q = 0.f;
#pragma unroll
    for (int i = 0; i < 8; ++i) { const float d = v[i] - mu; q += d * d; }
    q += __shfl_xor(q, 1); q += __shfl_xor(q, 2); q += __shfl_xor(q, 4);
    const float rstd = rsqrtf(q * (1.f / 64.f) + EPSV);
    uint4 o;
    o.x = pack2((v[0] - mu) * rstd * gam[0] + bet[0], (v[1] - mu) * rstd * gam[1] + bet[1]);
    o.y = pack2((v[2] - mu) * rstd * gam[2] + bet[2], (v[3] - mu) * rstd * gam[3] + bet[3]);
    o.z = pack2((v[4] - mu) * rstd * gam[4] + bet[4], (v[5] - mu) * rstd * gam[5] + bet[5]);
    o.w = pack2((v[6] - mu) * rstd * gam[6] + bet[6], (v[7] - mu) * rstd * gam[7] + bet[7]);
    *ptr = o;
  }
}
__device__ __forceinline__ void phase_up8(const Params& p, unsigned char* smem) {
  unsigned char* ws = p.ws;
  pg8::Gemm g{(const pg8::bf16_t*)(ws + WS_XN), (const pg8::bf16_t*)(ws + WS_WUPA), TOK, 1024, 1024};
  pg8::StaticOrder S; S.init(TOK, 1024, (int)gridDim.x, (int)blockIdx.x);
  EpiGate2 E{(unsigned short*)(ws + WS_PH), (const unsigned short*)(ws + WS_PG)};
  pg8::gemm_phase<EpiGate2, pg8::StaticOrder>((PG8_LAS unsigned char*)smem, g, S, E, nullptr);
}
__device__ __forceinline__ void phase_out8(const Params& p, unsigned char* smem) {
  unsigned char* ws = p.ws;
  pg8::Gemm g{(const pg8::bf16_t*)(ws + WS_PH), (const pg8::bf16_t*)(ws + WS_WOUT), TOK, 1024, 1024};
  pg8::StaticOrder S; S.init(TOK, 1024, (int)gridDim.x, (int)blockIdx.x);
  EpiResid E{p.out, p.x};
  pg8::gemm_phase<EpiResid, pg8::StaticOrder>((PG8_LAS unsigned char*)smem, g, S, E, nullptr);
}
__device__ __forceinline__ void phase_pq8(const Params& p, unsigned char* smem) {
  unsigned char* ws = p.ws;
  pg8::Gemm g{(const pg8::bf16_t*)(ws + WS_XN), (const pg8::bf16_t*)(ws + WS_WQ), TOK, 2048, 1024};
  pg8::StaticOrder S; S.init(TOK, 2048, (int)gridDim.x, (int)blockIdx.x);
  EpiStoreBf16 E{(unsigned short*)(ws + WS_PG), 2048};
  pg8::gemm_phase<EpiStoreBf16, pg8::StaticOrder>((PG8_LAS unsigned char*)smem, g, S, E, nullptr);
}

__global__ void __launch_bounds__(NTHREADS) hybrid_fwd(Params p) {
  extern __shared__ __attribute__((aligned(16))) unsigned char smem[];
#if ONE_LAUNCH
  cg::grid_group grid = cg::this_grid();
  volatile LAS unsigned* xst = (volatile LAS unsigned*)(smem + LDS_BYTES - 16);
  if (threadIdx.x == 0) { xst[0] = 0u; xst[1] = 0u; }
  __syncthreads();
  XcdBarrier xbar = xcd_barrier_post((unsigned*)(p.ws + WS_BAR), xst);
#define SEAM(k) do { if (p.ph_lo <= (k) && (k) + 1 < p.ph_hi) { if (p.ph_hi > NPHASE) grid.sync(); else xcd_barrier(xbar); } } while (0)
#else
#define SEAM(k) do { } while (0)
#endif
#define IN(k) (p.ph_lo <= (k) && (k) < p.ph_hi)
#ifndef REPEAT_PH
#define REPEAT_PH -1
#endif
#define REP(k, stmt) do { if (REPEAT_PH == (k)) { stmt; grid.sync(); } } while (0)
  if (IN(0)) { phase_prep(p, smem); SEAM(0); }
  if (IN(1)) { phase_proj8(p, smem); SEAM(1); }
  if (IN(2)) { phase_ikln(p); hgrn_h1_all(p, smem); SEAM(2); }
  if (IN(3)) { phase_mix(p, smem); SEAM(3); }
  if (IN(4)) { phase_up8(p, smem); SEAM(4); }
  if (IN(5)) { phase_out8(p, smem); SEAM(5); }
  if (IN(6)) { rmsnorm_rows_q(p.out, p.norm_ffn, (bf16_t*)(p.ws + WS_XN), p.ws + WS_XQ, (float*)(p.ws + WS_XS)); SEAM(6); }
  if (IN(7)) { phase_pq8(p, smem); SEAM(7); }
  if (IN(8)) { phase_pkeys(p, smem); SEAM(8); }
  if (IN(9)) { phase_pu(p, smem); SEAM(9); }
  if (IN(10)) { if (gridDim.x % 8 == 0) phase_pv_t<true>(p, smem); else phase_pv_t<false>(p, smem); SEAM(10); }
  if (IN(11)) { phase_final(p); }
#undef IN
#undef SEAM
}

extern "C" void kernel_launch(void* const* d_in, const int* in_sizes, int n_in, void* d_out, int out_size, void* d_ws, size_t ws_size,
                              hipStream_t stream) {
  static int grid = 0;
  if (grid == 0) {
    if (n_in != 17 || ws_size < WS_END) {
      fprintf(stderr, "kernel_launch: unexpected n_in %d or ws_size %zu (need %zu)\n", n_in, ws_size, (size_t)WS_END);
      grid = -1; return;
    }
    int dev = 0, cus = 0, per_cu = 0;
    hipGetDevice(&dev);
    hipDeviceGetAttribute(&cus, hipDeviceAttributeMultiprocessorCount, dev);
    hipFuncSetAttribute((const void*)hybrid_fwd, hipFuncAttributeMaxDynamicSharedMemorySize, LDS_BYTES);
    hipOccupancyMaxActiveBlocksPerMultiprocessor(&per_cu, (const void*)hybrid_fwd, NTHREADS, LDS_BYTES);
    if (per_cu < 1) { fprintf(stderr, "kernel_launch: occupancy query says %d blocks/CU\n", per_cu); per_cu = 1; }
    (void)hipGetLastError();
    grid = cus;
  }
  if (grid < 0) return;
  Params p{};
  p.x = (const float*)d_in[0]; p.norm_mix = (const float*)d_in[1]; p.w_in = (const float*)d_in[2]; p.hg_lb = (const float*)d_in[3];
  p.hg_norm = (const float*)d_in[4]; p.ikg = (const float*)d_in[5]; p.ikb = (const float*)d_in[6]; p.rel_bias = (const float*)d_in[7];
  p.w_up_a = (const float*)d_in[8]; p.w_up_b = (const float*)d_in[9]; p.w_out = (const float*)d_in[10]; p.norm_ffn = (const float*)d_in[11];
  p.peer_wq = (const float*)d_in[12]; p.peer_keys = (const float*)d_in[13]; p.peer_u = (const float*)d_in[14]; p.peer_v = (const float*)d_in[15];
  p.norm_final = (const float*)d_in[16];
  p.out = (float*)d_out; p.ws = (unsigned char*)d_ws;
#if ONE_LAUNCH
  hipMemsetAsync((unsigned char*)d_ws + WS_BAR, 0, 16384, stream);
  p.ph_lo = 0; p.ph_hi = NPHASE;
  void* args[] = {&p};
  hipError_t e = hipLaunchCooperativeKernel((const void*)hybrid_fwd, dim3(grid), dim3(NTHREADS), args, LDS_BYTES, stream);
  if (e != hipSuccess) fprintf(stderr, "cooperative launch failed: %s (grid %d)\n", hipGetErrorString(e), grid);
#else
  for (int ph = 0; ph < NPHASE; ++ph) {
    p.ph_lo = ph; p.ph_hi = ph + 1;
    hipLaunchKernelGGL(hybrid_fwd, dim3(grid), dim3(NTHREADS), LDS_BYTES, stream, p);
  }
#endif
}
```

```cpp
#include <hip/hip_runtime.h>
#include <hip/hip_cooperative_groups.h>
#include <stdint.h>
#include <stdio.h>
namespace cg = cooperative_groups;

#ifndef ONE_LAUNCH
#define ONE_LAUNCH 1
#endif

typedef unsigned short bf16_t;
typedef __attribute__((ext_vector_type(8))) short bf16x8;
typedef __attribute__((ext_vector_type(4))) float f32x4;

#define NTHREADS 512
#define TOK 32768
#define SEQL 4096
#define DM 1024
#define EPSV 1e-6f
#define NPHASE 12

#define WS_WIN   ((size_t)0)
#define WS_WUPA  (WS_WIN  + (size_t)5120 * 1024 * 2)
#define WS_WUPB  (WS_WUPA + (size_t)1024 * 512 * 2)
#define WS_WOUT  (WS_WUPB + (size_t)1024 * 512 * 2)
#define WS_WQ    (WS_WOUT + (size_t)1024 * 1024 * 2)
#define WS_KEYS  (WS_WQ   + (size_t)2048 * 1024 * 2)
#define WS_LB    (WS_KEYS + (size_t)2 * 8 * 128 * 128 * 2)
#define WS_U     (WS_LB   + (size_t)4096)
#define WS_V     (WS_U    + (size_t)16384 * 1024 * 2)
#define WS_XN    (WS_V    + (size_t)16384 * 1024 * 2)
#define WS_PH    (WS_XN   + (size_t)TOK * 1024 * 2)
#define WS_PA    (WS_PH   + (size_t)TOK * 2048 * 2)
#define WS_PG    (WS_PA   + (size_t)TOK * 1024 * 2)
#define WS_EIDX  (WS_PG   + (size_t)TOK * 2048 * 2)
#define WS_GW    (WS_EIDX + (size_t)TOK * 128 * 4)
#define WS_SSQ   (WS_GW   + (size_t)TOK * 128 * 4)
#define WS_XCC   (WS_SSQ  + (size_t)TOK * 4)
#define WS_BAR   (WS_XCC  + (size_t)4096)
#define WS_DEC   (WS_BAR  + (size_t)16384)
#define WS_QCTR  (WS_DEC  + (size_t)2048 * 384 * 4)
#define WS_END   (WS_QCTR + (size_t)1024)

#define WS_KC (WS_EIDX)
#define WS_VC (WS_KC + (size_t)TOK * 128)
#define WS_IKC (WS_VC + (size_t)TOK * 128)
#define LDS_BYTES 155648

struct Params {
  const float* x; const float* norm_mix; const float* w_in; const float* hg_lb; const float* hg_norm;
  const float* ikg; const float* ikb; const float* rel_bias; const float* w_up_a; const float* w_up_b;
  const float* w_out; const float* norm_ffn; const float* peer_wq; const float* peer_keys;
  const float* peer_u; const float* peer_v; const float* norm_final;
  float* out; unsigned char* ws; int ph_lo, ph_hi;
};

__device__ __forceinline__ float bf2f(bf16_t u) { return __uint_as_float(((unsigned)u) << 16); }
typedef float f32x2_cv __attribute__((ext_vector_type(2)));
typedef __bf16 bf16x2_cv __attribute__((ext_vector_type(2)));
__device__ __forceinline__ unsigned pack2(float a, float b) {
  const f32x2_cv v = {a, b};
  return __builtin_bit_cast(unsigned, __builtin_convertvector(v, bf16x2_cv));
}
__device__ __forceinline__ bf16_t f2bf(float f) { return (bf16_t)(pack2(f, f) & 0xffffu); }
__device__ __forceinline__ float wave_sum_slow(float v) {
#pragma unroll
  for (int o = 32; o > 0; o >>= 1) v += __shfl_xor(v, o);
  return v;
}
__device__ __forceinline__ void lds_fence() { asm volatile("s_waitcnt lgkmcnt(0)" ::: "memory"); }

__device__ __forceinline__ float add_xor8(float v) { return v + __int_as_float(__builtin_amdgcn_update_dpp(0, __float_as_int(v), 0x128, 0xf, 0xf, true)); }
__device__ __forceinline__ float add_xor16(float v) { const auto r = __builtin_amdgcn_permlane16_swap(__float_as_uint(v), __float_as_uint(v), false, false); return __uint_as_float(r[0]) + __uint_as_float(r[1]); }
__device__ __forceinline__ float add_xor32(float v) { const auto r = __builtin_amdgcn_permlane32_swap(__float_as_uint(v), __float_as_uint(v), false, false); return __uint_as_float(r[0]) + __uint_as_float(r[1]); }
__device__ __forceinline__ float max_xor16(float v) { const auto r = __builtin_amdgcn_permlane16_swap(__float_as_uint(v), __float_as_uint(v), false, false); return fmaxf(__uint_as_float(r[0]), __uint_as_float(r[1])); }
__device__ __forceinline__ float max_xor32(float v) { const auto r = __builtin_amdgcn_permlane32_swap(__float_as_uint(v), __float_as_uint(v), false, false); return fmaxf(__uint_as_float(r[0]), __uint_as_float(r[1])); }
__device__ __forceinline__ float wave_sum(float v) {
  v += __int_as_float(__builtin_amdgcn_update_dpp(0, __float_as_int(v), 0xB1, 0xf, 0xf, true));
  v += __int_as_float(__builtin_amdgcn_update_dpp(0, __float_as_int(v), 0x4E, 0xf, 0xf, true));
  v += __int_as_float(__builtin_amdgcn_update_dpp(0, __float_as_int(v), 0x141, 0xf, 0xf, true));
  v += __int_as_float(__builtin_amdgcn_update_dpp(0, __float_as_int(v), 0x140, 0xf, 0xf, true));
  return add_xor32(add_xor16(v));
}
__device__ __forceinline__ float sigmoidf_(float x) { return 1.f / (1.f + __expf(-x)); }
__device__ __forceinline__ float siluf_(float x) { return x / (1.f + __expf(-x)); }


#define XB_TMO      128
#define XB_XCNT(j)  (256  + 64 * (j))
#define XB_XSUB(j)  (1280 + 64 * (j))
#define XB_XGEN(j)  (2304 + 64 * (j))
#define XB_TOP      3328
#define XB_TOPGEN   3392
#define XCD_BAR_WORDS 3456
#define XB_SPIN_CAP (1u << 22)
#define LAS __attribute__((address_space(3)))
__device__ __forceinline__ unsigned xb_ld(unsigned* p)              { return __hip_atomic_load(p, __ATOMIC_RELAXED, __HIP_MEMORY_SCOPE_AGENT); }
__device__ __forceinline__ unsigned xb_add(unsigned* p, unsigned v) { return __hip_atomic_fetch_add(p, v, __ATOMIC_RELAXED, __HIP_MEMORY_SCOPE_AGENT); }
__device__ __forceinline__ unsigned xb_xcc_id() { return (unsigned)__builtin_amdgcn_s_getreg((3 << 11) | 20) & 0xFu; }
#define XB_SPIN(cond, bar) do { unsigned _sp = 0; while (cond) { __builtin_amdgcn_s_sleep(1); \
    if ((++_sp & 255u) == 0u) { if (xb_ld(&(bar)[XB_TMO])) break; if (_sp > XB_SPIN_CAP) { atomicAdd(&(bar)[XB_TMO], 1u); break; } } } } while (0)
struct XcdBarrier { unsigned* bar; unsigned x; volatile LAS unsigned* st; };
__device__ __forceinline__ XcdBarrier xcd_barrier_post(unsigned* bar, volatile LAS unsigned* st) {
  XcdBarrier b; b.bar = bar; b.x = xb_xcc_id(); b.st = st;
  if (threadIdx.x == 0) (void)xb_add(&bar[XB_XCNT(b.x)], 1u);
  return b;
}
__device__ __forceinline__ void xcd_barrier_complete(unsigned* bar, unsigned x, unsigned& nloc, unsigned& nx) {
  const unsigned G = gridDim.x * gridDim.y * gridDim.z;
  unsigned sum, cnt, mine, sp = 0u;
  for (;;) {
    sum = 0u; cnt = 0u; mine = 0u;
#pragma unroll
    for (unsigned j = 0; j < 16; ++j) { const unsigned c = xb_ld(&bar[XB_XCNT(j)]); sum += c; cnt += (c > 0u) ? 1u : 0u; mine = (j == x) ? c : mine; }
    if (sum == G) break;
    __builtin_amdgcn_s_sleep(1);
    if ((++sp & 255u) == 0u) { if (xb_ld(&bar[XB_TMO])) break; if (sp > XB_SPIN_CAP) { atomicAdd(&bar[XB_TMO], 1u); break; } }
  }
  nloc = mine > 0u ? mine : 1u; nx = cnt > 0u ? cnt : 1u;
}
__device__ __forceinline__ void xcd_barrier(const XcdBarrier& b) {
  asm volatile("s_waitcnt vmcnt(0)" ::: "memory");
  __syncthreads();
  if (threadIdx.x == 0) {
    unsigned* bar = b.bar;
    __builtin_amdgcn_s_waitcnt(0);
    unsigned nloc = b.st[0], nx = b.st[1];
    if (nloc == 0u) { xcd_barrier_complete(bar, b.x, nloc, nx); b.st[0] = nloc; b.st[1] = nx; }
    const unsigned old = xb_add(&bar[XB_XSUB(b.x)], 1u);
    const unsigned gen = old / nloc;
    if (old + 1u == (gen + 1u) * nloc) {
      __builtin_amdgcn_fence(__ATOMIC_RELEASE, "agent");
      asm volatile("s_waitcnt vmcnt(0)" ::: "memory");
      const unsigned og = xb_add(&bar[XB_TOP], 1u);
      const unsigned tg = og / nx;
      if (og + 1u == (tg + 1u) * nx) xb_add(&bar[XB_TOPGEN], 1u);
      else XB_SPIN(xb_ld(&bar[XB_TOPGEN]) == tg, bar);
      __builtin_amdgcn_fence(__ATOMIC_ACQUIRE, "agent");
      xb_add(&bar[XB_XGEN(b.x)], 1u);
      asm volatile("s_waitcnt vmcnt(0)" ::: "memory");
    } else {
      XB_SPIN(xb_ld(&bar[XB_XGEN(b.x)]) == gen, bar);
      __builtin_amdgcn_fence(__ATOMIC_ACQUIRE, "agent");
      asm volatile("s_waitcnt vmcnt(0)" ::: "memory");
    }
  }
  __syncthreads();
}

namespace pg8 {
#define PG8_LAS __attribute__((address_space(3)))
typedef unsigned short bf16_t;
typedef short bf16x8 __attribute__((ext_vector_type(8)));
typedef float f32x4 __attribute__((ext_vector_type(4)));
typedef unsigned u32x4 __attribute__((ext_vector_type(4)));
constexpr int BM = 256, BK = 64, HALF = 128, HTB = HALF * BK * 2  , STAGE_BYTES = 8 * HTB, NXCD = 8, WGM = 8;

__host__ __device__ __forceinline__ int lds_byte(int r, int c) { const int st = (r >> 4) * 2 + (c >> 5), rr = r & 15, cc = c & 31, ob = rr * 64 + cc * 2; return st * 1024 + (ob ^ (((ob >> 9) & 1) << 5)); }
__host__ __device__ __forceinline__ void stage_rc(int b, int& R, int& C) { const int st = b / 1024, sb = b % 1024, swz = sb ^ (((sb >> 9) & 1) << 5); R = (st >> 1) * 16 + swz / 64; C = (st & 1) * 32 + (swz % 64) / 2; }
__host__ __device__ __forceinline__ int perm32(int rho) { const int n = rho >> 4, i = rho & 15; return 8 * (i >> 2) + 4 * n + (i & 3); }

struct Unit { int pm, pn; };
struct Gemm { const bf16_t* A; const bf16_t* Bt; int M, N, K; };

struct StaticOrder {
    int nM, nN, nwg, G, c;
    __host__ __device__ void init(int M, int N, int G_, int c_) { nM = M / BM; nN = N / BM; nwg = nM * nN; G = G_; c = c_; }
    __host__ __device__ bool next(int i, Unit& u) const {
        const long L = (long)i * G + c; if (L >= nwg) return false;
        int wgid = (int)L; { const int q = nwg / NXCD, r = nwg % NXCD, xcd = wgid % NXCD, off = wgid / NXCD; wgid = (xcd < r ? xcd * (q + 1) : r * (q + 1) + (xcd - r) * q) + off; }
        const int nig = WGM * nN, gid = wgid / nig, fm = gid * WGM, gsz = (nM - fm) < WGM ? (nM - fm) : WGM;
        u.pm = fm + ((wgid % nig) % gsz); u.pn = (wgid % nig) / gsz; return true;
    }
    __device__ __forceinline__ void a_ready(const Unit&) const {}
    __device__ __forceinline__ void done(const Unit&) const {}
};
__device__ __forceinline__ unsigned cvt_pk_bf16(float lo, float hi) { unsigned r; asm volatile("v_cvt_pk_bf16_f32 %0, %1, %2" : "=v"(r) : "v"(lo), "v"(hi)); return r; }
template <class Epi, class Sched, bool STAMP = false>
__device__ __forceinline__ void gemm_phase(PG8_LAS unsigned char* lds, const Gemm g, const Sched& S, const Epi& E, unsigned long long* stamps) {
    const int tid = threadIdx.x, wid = __builtin_amdgcn_readfirstlane(tid >> 6), lane = tid & 63, wr = wid >> 2, wc = wid & 3, fr = lane & 15, fq = lane >> 4;
    const int K = g.K, nt = K / BK;
    int ts_lo = 0, ts_hi = 0, nts = 0; const unsigned long long rt_entry = STAMP ? (unsigned long long)wall_clock64() : 0ull;
#define PG8_STAMP() do { if (STAMP && wid == 0 && nts < 64) { const unsigned long long _c = (unsigned long long)clock64(); \
        ts_lo = (lane == nts) ? (int)(unsigned)_c : ts_lo; ts_hi = (lane == nts) ? (int)(unsigned)(_c >> 32) : ts_hi; ++nts; } } while (0)
    PG8_STAMP();
    unsigned voffA[2], voffB[2];
#pragma unroll
    for (int i = 0; i < 2; ++i) { int R, C; stage_rc(tid * 16 + i * 8192, R, C); const int Rb = Epi::PERM ? ((R & ~31) + perm32(R & 31)) : R;
        voffA[i] = (unsigned)(R * K + C) * 2u; voffB[i] = (unsigned)(Rb * K + C) * 2u; }
    const size_t kstep = (size_t)(BK * 2);
    const size_t hstep = (size_t)HALF * K * 2;
    const size_t tstep = 2 * hstep;
    const unsigned ldsw = (unsigned)wid * 1024u;
    const int aoff = lds_byte(wr * 64 + fr, fq * 8), boff = lds_byte(wc * 32 + fr, fq * 8);
#define PG8_SA(b, h) (((b) * 2 + (h)) * HTB)
#define PG8_SB(b, h) ((4 + (b) * 2 + (h)) * HTB)
#define PG8_STAGE(bufoff, gbase, voff) do { _Pragma("unroll") for (int _i = 0; _i < 2; ++_i) \
        __builtin_amdgcn_global_load_lds((const unsigned*)((const char*)(gbase) + (voff)[_i]), (PG8_LAS unsigned*)(lds + (bufoff) + ldsw + _i * 8192), 16, 0, 0); } while (0)
#define PG8_LDA(dst, b, h) do { _Pragma("unroll") for (int m = 0; m < 4; ++m) _Pragma("unroll") for (int k = 0; k < 2; ++k) dst[m][k] = *(const PG8_LAS bf16x8*)(lds + PG8_SA(b, h) + aoff + m * 2048 + k * 1024); } while (0)
#define PG8_LDB(dst, b, h) do { _Pragma("unroll") for (int n = 0; n < 2; ++n) _Pragma("unroll") for (int k = 0; k < 2; ++k) dst[n][k] = *(const PG8_LAS bf16x8*)(lds + PG8_SB(b, h) + boff + n * 2048 + k * 1024); } while (0)
#define PG8_MMA(ai, bj, At, Bt) do { __builtin_amdgcn_s_setprio(1); _Pragma("unroll") for (int m = 0; m < 4; ++m) _Pragma("unroll") for (int n = 0; n < 2; ++n) _Pragma("unroll") for (int k = 0; k < 2; ++k) \
        acc[ai][bj][m][n] = __builtin_amdgcn_mfma_f32_16x16x32_bf16(Bt[n][k], At[m][k], acc[ai][bj][m][n], 0, 0, 0); __builtin_amdgcn_s_setprio(0); } while (0)
#define PG8_WAIT_V(n) asm volatile("s_waitcnt vmcnt(" #n ")" ::: "memory")
#define PG8_WAIT_L(n) asm volatile("s_waitcnt lgkmcnt(" #n ")" ::: "memory")
#define PG8_BAR __builtin_amdgcn_s_barrier()
#define PG8_SCHED __builtin_amdgcn_sched_barrier(0)
    Unit cur, nxt; int ui = 0;
    if (!S.next(0, cur)) return;
    f32x4 acc[2][2][4][2];
#pragma unroll
    for (int a = 0; a < 2; ++a)
#pragma unroll
        for (int b = 0; b < 2; ++b)
#pragma unroll
            for (int m = 0; m < 4; ++m)
#pragma unroll
                for (int n = 0; n < 2; ++n) acc[a][b][m][n] = (f32x4){0.f, 0.f, 0.f, 0.f};
    bf16x8 At[4][2], B0[2][2], B1[2][2];
    const char* cA = (const char*)g.A + (size_t)cur.pm * tstep; const char* cB = (const char*)g.Bt + (size_t)cur.pn * tstep;
    S.a_ready(cur);
    PG8_STAGE(PG8_SB(0, 0), cB, voffB); PG8_STAGE(PG8_SA(0, 0), cA, voffA); PG8_STAGE(PG8_SB(0, 1), cB + hstep, voffB); PG8_STAGE(PG8_SA(0, 1), cA + hstep, voffA);
    if (wr == 1) PG8_BAR;
    PG8_WAIT_V(4); PG8_BAR;
    PG8_STAGE(PG8_SB(1, 0), cB + kstep, voffB); PG8_STAGE(PG8_SA(1, 0), cA + kstep, voffA); PG8_STAGE(PG8_SB(1, 1), cB + hstep + kstep, voffB);
    PG8_WAIT_V(6); PG8_BAR;
    PG8_STAMP();
    for (;;) {
        const bool has_next = S.next(ui + 1, nxt);
        const char* nA = has_next ? (const char*)g.A + (size_t)nxt.pm * tstep : cA; const char* nB = has_next ? (const char*)g.Bt + (size_t)nxt.pn * tstep : cB;
        for (int t = 0; t < nt; t += 2) {
            const bool last = (t == nt - 2);
            const char* a1 = cA + (size_t)(t + 1) * kstep;
            const char* a2 = last ? nA : cA + (size_t)(t + 2) * kstep; const char* b2 = last ? nB : cB + (size_t)(t + 2) * kstep;
            const char* a3 = a2 + kstep; const char* b3 = b2 + kstep;
            if constexpr (Epi::MID) { if (t == nt / 2) E.mid(acc, cur, wr, wc, fr, fq); }
            if (last && has_next) S.a_ready(nxt);
            PG8_LDB(B0, 0, 0); PG8_SCHED; PG8_LDA(At, 0, 0); PG8_STAGE(PG8_SA(1, 1), a1 + hstep, voffA);
            PG8_WAIT_L(8); PG8_BAR; PG8_WAIT_L(0); PG8_MMA(0, 0, At, B0); PG8_BAR; PG8_SCHED;
            PG8_LDB(B1, 0, 1); PG8_STAGE(PG8_SB(0, 0), b2, voffB);
            PG8_BAR; PG8_WAIT_L(0); PG8_MMA(0, 1, At, B1); PG8_BAR;
            PG8_LDA(At, 0, 1); PG8_STAGE(PG8_SA(0, 0), a2, voffA);
            PG8_BAR; PG8_WAIT_L(0); PG8_MMA(1, 0, At, B0); PG8_BAR; PG8_SCHED;
            PG8_STAGE(PG8_SB(0, 1), b2 + hstep, voffB);
            PG8_WAIT_V(6); PG8_BAR; PG8_MMA(1, 1, At, B1); PG8_BAR;
            PG8_LDB(B0, 1, 0); PG8_SCHED; PG8_LDA(At, 1, 0); PG8_STAGE(PG8_SA(0, 1), a2 + hstep, voffA);
            PG8_WAIT_L(8); PG8_BAR; PG8_WAIT_L(0); PG8_MMA(0, 0, At, B0); PG8_BAR; PG8_SCHED;
            PG8_LDB(B1, 1, 1); PG8_STAGE(PG8_SB(1, 0), b3, voffB);
            PG8_BAR; PG8_WAIT_L(0); PG8_MMA(0, 1, At, B1); PG8_BAR;
            PG8_LDA(At, 1, 1); PG8_STAGE(PG8_SA(1, 0), a3, voffA);
            PG8_BAR; PG8_WAIT_L(0); PG8_MMA(1, 0, At, B0); PG8_BAR; PG8_SCHED;
            PG8_STAGE(PG8_SB(1, 1), b3 + hstep, voffB);
            PG8_WAIT_V(6); PG8_BAR; PG8_MMA(1, 1, At, B1); PG8_BAR;
        }
        PG8_STAMP();
        if constexpr (!Epi::AFTER_DRAIN) { E(acc, cur, wr, wc, fr, fq); S.done(cur); }
        PG8_STAMP();
        if (!has_next) break;
#pragma unroll
        for (int a = 0; a < 2; ++a)
#pragma unroll
            for (int b = 0; b < 2; ++b)
#pragma unroll
                for (int m = 0; m < 4; ++m)
#pragma unroll
                    for (int n = 0; n < 2; ++n) acc[a][b][m][n] = (f32x4){0.f, 0.f, 0.f, 0.f};
        cur = nxt; cA = nA; cB = nB; ++ui;
    }
    PG8_WAIT_V(0);
    if (wr == 0) PG8_BAR;
    PG8_BAR;
    if constexpr (Epi::AFTER_DRAIN) { E.fused(acc, cur, wr, wc, fr, fq, lds, wid, lane); S.done(cur); }
    PG8_STAMP();
    if (STAMP && wid == 0) { stamps[lane] = lane < nts ? (((unsigned long long)(unsigned)ts_hi << 32) | (unsigned)ts_lo) : 0ull;
        if (lane == 62) stamps[62] = rt_entry; if (lane == 63) stamps[63] = (unsigned long long)wall_clock64(); }
#undef PG8_STAMP
#undef PG8_SA
#undef PG8_SB
#undef PG8_STAGE
#undef PG8_LDA
#undef PG8_LDB
#undef PG8_MMA
#undef PG8_WAIT_V
#undef PG8_WAIT_L
#undef PG8_BAR
#undef PG8_SCHED
}
}

struct EpiProj {
  static constexpr bool PERM = true, AFTER_DRAIN = false, MID = false;
  unsigned short* pH; unsigned short* pA; unsigned short* pG; unsigned short* kc; unsigned short* vc; unsigned short* ikc;
  __device__ __forceinline__ void operator()(const pg8::f32x4 (&acc)[2][2][4][2], const pg8::Unit& u, int wr, int wc, int fr, int fq) const {
    const int row0 = u.pm * 256 + wr * 64 + fr;
    unsigned short* base; int ldc, colt; bool sg = false;
    if (u.pn < 8) { base = pH; ldc = 2048; colt = u.pn * 256; }
    else if (u.pn < 12) { base = pA; ldc = 1024; colt = (u.pn - 8) * 256; }
    else { base = pG; ldc = 2048; colt = (u.pn - 12) * 256; sg = true; }
    const int col0 = colt + wc * 32 + 8 * fq;
#pragma unroll
    for (int ai = 0; ai < 2; ++ai)
#pragma unroll
      for (int m = 0; m < 4; ++m) {
        unsigned short* rowp = base + (size_t)(row0 + ai * 128 + m * 16) * ldc + col0;
#pragma unroll
        for (int bj = 0; bj < 2; ++bj) {
          pg8::f32x4 v0 = acc[ai][bj][m][0], v1 = acc[ai][bj][m][1];
          if (sg) {
#pragma unroll
            for (int j = 0; j < 4; ++j) { v0[j] = sigmoidf_(v0[j]); v1[j] = sigmoidf_(v1[j]); }
          }
          pg8::u32x4 w; w.x = pg8::cvt_pk_bf16(v0[0], v0[1]); w.y = pg8::cvt_pk_bf16(v0[2], v0[3]); w.z = pg8::cvt_pk_bf16(v1[0], v1[1]); w.w = pg8::cvt_pk_bf16(v1[2], v1[3]);
          unsigned short* dst = rowp + bj * 128;
          if (u.pn == 10 || u.pn == 11) {
            const int cs = col0 + bj * 128;
            const size_t r = (size_t)(row0 + ai * 128 + m * 16);
            if (cs >= 512 && cs < 576) dst = kc + r * 64 + (cs - 512);
            else if (cs >= 576 && cs < 640) dst = vc + r * 64 + (cs - 576);
            else if (cs >= 896 && cs < 960) dst = ikc + r * 64 + (cs - 896);
          }
          *(pg8::u32x4*)dst = w;
        }
      }
  }
};
template <int MODE> struct EpiGate {
  static constexpr bool PERM = true, AFTER_DRAIN = false, MID = false;
  unsigned short* hb; const unsigned short* pG; int goff;
  __device__ __forceinline__ void operator()(const pg8::f32x4 (&acc)[2][2][4][2], const pg8::Unit& u, int wr, int wc, int fr, int fq) const {
    const int row0 = u.pm * 256 + wr * 64 + fr;
    const int col0 = u.pn * 256 + wc * 32 + 8 * fq;
#pragma unroll
    for (int ai = 0; ai < 2; ++ai)
#pragma unroll
      for (int m = 0; m < 4; ++m) {
        const size_t r = (size_t)(row0 + ai * 128 + m * 16);
        pg8::u32x4 gv[2], hv[2];
#pragma unroll
        for (int bj = 0; bj < 2; ++bj) {
          gv[bj] = *(const pg8::u32x4*)(pG + r * 2048 + goff + col0 + bj * 128);
          if (MODE == 1) hv[bj] = *(const pg8::u32x4*)(hb + r * 1024 + col0 + bj * 128);
        }
#pragma unroll
        for (int bj = 0; bj < 2; ++bj) {
          float o[8];
#pragma unroll
          for (int j = 0; j < 4; ++j) {
            const unsigned gw0 = gv[bj][j >> 1], gw1 = gv[bj][2 + (j >> 1)];
            const float g0 = (j & 1) ? __uint_as_float(gw0 & 0xffff0000u) : __uint_as_float(gw0 << 16);
            const float g1 = (j & 1) ? __uint_as_float(gw1 & 0xffff0000u) : __uint_as_float(gw1 << 16);
            o[j] = acc[ai][bj][m][0][j] * g0; o[4 + j] = acc[ai][bj][m][1][j] * g1;
            if (MODE == 1) {
              const unsigned hw0 = hv[bj][j >> 1], hw1 = hv[bj][2 + (j >> 1)];
              o[j] += (j & 1) ? __uint_as_float(hw0 & 0xffff0000u) : __uint_as_float(hw0 << 16);
              o[4 + j] += (j & 1) ? __uint_as_float(hw1 & 0xffff0000u) : __uint_as_float(hw1 << 16);
            }
          }
          pg8::u32x4 w; w.x = pg8::cvt_pk_bf16(o[0], o[1]); w.y = pg8::cvt_pk_bf16(o[2], o[3]); w.z = pg8::cvt_pk_bf16(o[4], o[5]); w.w = pg8::cvt_pk_bf16(o[6], o[7]);
          *(pg8::u32x4*)(hb + r * 1024 + col0 + bj * 128) = w;
        }
      }
  }
};
struct EpiGate2 {
  static constexpr bool PERM = true, AFTER_DRAIN = false, MID = true;
  unsigned short* hb; const unsigned short* pG;
  __device__ __forceinline__ void mid(pg8::f32x4 (&acc)[2][2][4][2], const pg8::Unit& u, int wr, int wc, int fr, int fq) const {
    int fr_o = fr, fq_o = fq;
    asm volatile("" : "+v"(fr_o), "+v"(fq_o));
    const unsigned short* gp = pG + (size_t)(u.pm * 256 + wr * 64 + fr_o) * 2048 + u.pn * 256 + wc * 32 + 8 * fq_o;
#pragma unroll
    for (int ai = 0; ai < 2; ++ai)
#pragma unroll
      for (int m = 0; m < 4; ++m)
#pragma unroll
        for (int bj = 0; bj < 2; ++bj) {
          const unsigned short* q = gp + (size_t)(ai * 128 + m * 16) * 2048 + bj * 128;
          const pg8::u32x4 gb = *(const pg8::u32x4*)(q + 1024);
          const pg8::u32x4 ga = *(const pg8::u32x4*)q;
#pragma unroll
          for (int wd = 0; wd < 4; ++wd) {
            const float rl = __uint_as_float(ga[wd] << 16) * __builtin_amdgcn_rcpf(__uint_as_float(gb[wd] << 16));
            const float rh = __uint_as_float(ga[wd] & 0xffff0000u) * __builtin_amdgcn_rcpf(__uint_as_float(gb[wd] & 0xffff0000u));
            acc[ai][bj][m][wd >> 1][2 * (wd & 1)] *= rl;
            acc[ai][bj][m][wd >> 1][2 * (wd & 1) + 1] *= rh;
          }
          if (bj == 1) asm volatile("" ::: "memory");
        }
  }
  __device__ __forceinline__ void operator()(const pg8::f32x4 (&acc)[2][2][4][2], const pg8::Unit& u, int wr, int wc, int fr, int fq) const {
    const int row0 = u.pm * 256 + wr * 64 + fr;
    const int col0 = u.pn * 256 + wc * 32 + 8 * fq;
#pragma unroll
    for (int ai = 0; ai < 2; ++ai)
#pragma unroll
      for (int m = 0; m < 4; ++m) {
        const size_t r = (size_t)(row0 + ai * 128 + m * 16);
        pg8::u32x4 gb[2];
#pragma unroll
        for (int bj = 0; bj < 2; ++bj) gb[bj] = *(const pg8::u32x4*)(pG + r * 2048 + 1024 + col0 + bj * 128);
#pragma unroll
        for (int bj = 0; bj < 2; ++bj) {
          float o[8];
#pragma unroll
          for (int j = 0; j < 4; ++j) {
            const unsigned b0 = gb[bj][j >> 1], b1 = gb[bj][2 + (j >> 1)];
            const float sb0 = (j & 1) ? __uint_as_float(b0 & 0xffff0000u) : __uint_as_float(b0 << 16);
            const float sb1 = (j & 1) ? __uint_as_float(b1 & 0xffff0000u) : __uint_as_float(b1 << 16);
            o[j] = acc[ai][bj][m][0][j] * sb0; o[4 + j] = acc[ai][bj][m][1][j] * sb1;
          }
          pg8::u32x4 w; w.x = pg8::cvt_pk_bf16(o[0], o[1]); w.y = pg8::cvt_pk_bf16(o[2], o[3]); w.z = pg8::cvt_pk_bf16(o[4], o[5]); w.w = pg8::cvt_pk_bf16(o[6], o[7]);
          *(pg8::u32x4*)(hb + r * 1024 + col0 + bj * 128) = w;
        }
      }
  }
};
struct EpiResid {
  static constexpr bool PERM = false, AFTER_DRAIN = false, MID = false;
  float* out; const float* x;
  __device__ __forceinline__ void operator()(const pg8::f32x4 (&acc)[2][2][4][2], const pg8::Unit& u, int wr, int wc, int fr, int fq) const {
    const int row0 = u.pm * 256 + wr * 64 + fr, col0 = u.pn * 256 + wc * 32 + 4 * fq;
#pragma unroll
    for (int ai = 0; ai < 2; ++ai)
#pragma unroll
      for (int m = 0; m < 4; ++m) {
        const size_t off = (size_t)(row0 + ai * 128 + m * 16) * 1024 + col0;
        pg8::f32x4 xv[2][2];
#pragma unroll
        for (int bj = 0; bj < 2; ++bj)
#pragma unroll
          for (int n = 0; n < 2; ++n) xv[bj][n] = *(const pg8::f32x4*)(x + off + bj * 128 + n * 16);
#pragma unroll
        for (int bj = 0; bj < 2; ++bj)
#pragma unroll
          for (int n = 0; n < 2; ++n) *(pg8::f32x4*)(out + off + bj * 128 + n * 16) = acc[ai][bj][m][n] + xv[bj][n];
      }
  }
};
struct EpiStoreBf16 {
  static constexpr bool PERM = true, AFTER_DRAIN = false, MID = false;
  unsigned short* O; int ldc;
  __device__ __forceinline__ void operator()(const pg8::f32x4 (&acc)[2][2][4][2], const pg8::Unit& u, int wr, int wc, int fr, int fq) const {
    const int row0 = u.pm * 256 + wr * 64 + fr, col0 = u.pn * 256 + wc * 32 + 8 * fq;
#pragma unroll
    for (int ai = 0; ai < 2; ++ai)
#pragma unroll
      for (int m = 0; m < 4; ++m) {
        unsigned short* rowp = O + (size_t)(row0 + ai * 128 + m * 16) * ldc + col0;
#pragma unroll
        for (int bj = 0; bj < 2; ++bj) {
          const pg8::f32x4 v0 = acc[ai][bj][m][0], v1 = acc[ai][bj][m][1];
          pg8::u32x4 w; w.x = pg8::cvt_pk_bf16(v0[0], v0[1]); w.y = pg8::cvt_pk_bf16(v0[2], v0[3]); w.z = pg8::cvt_pk_bf16(v1[0], v1[1]); w.w = pg8::cvt_pk_bf16(v1[2], v1[3]);
          *(pg8::u32x4*)(rowp + bj * 128) = w;
        }
      }
  }
};

__device__ __forceinline__ void gemm_tile(const bf16_t* __restrict__ A, int lda, const bf16_t* __restrict__ Bt, int ldb,
                                          int nk, f32x4 (&acc)[4][4], unsigned char* smem) {
  const int tid = threadIdx.x, lane = tid & 63, w = tid >> 6, wm = w >> 1, wn = w & 1, l15 = lane & 15, g = lane >> 4;
  unsigned char* sA = smem;
  unsigned char* sB = smem + 32768;
  const int lr = tid >> 3, lc = tid & 7;
  const bf16_t* ga = A + (size_t)lr * lda + lc * 8;
  const bf16_t* gb = Bt + (size_t)lr * ldb + lc * 8;
  uint4 ra0, ra1, ra2, ra3, rb0, rb1;
  ra0 = *(const uint4*)(ga);
  ra1 = *(const uint4*)(ga + (size_t)64 * lda);
  ra2 = *(const uint4*)(ga + (size_t)128 * lda);
  ra3 = *(const uint4*)(ga + (size_t)192 * lda);
  rb0 = *(const uint4*)(gb);
  rb1 = *(const uint4*)(gb + (size_t)64 * ldb);
  const int sw = (lc ^ (lr & 7)) << 4;
  for (int kt = 0; kt < nk; ++kt) {
    __syncthreads();
    *(uint4*)(sA + (lr) * 128 + sw) = ra0;
    *(uint4*)(sA + (lr + 64) * 128 + sw) = ra1;
    *(uint4*)(sA + (lr + 128) * 128 + sw) = ra2;
    *(uint4*)(sA + (lr + 192) * 128 + sw) = ra3;
    *(uint4*)(sB + (lr) * 128 + sw) = rb0;
    *(uint4*)(sB + (lr + 64) * 128 + sw) = rb1;
    __syncthreads();
    if (kt + 1 < nk) {
      const int ko = (kt + 1) * 64;
      ra0 = *(const uint4*)(ga + ko);
      ra1 = *(const uint4*)(ga + (size_t)64 * lda + ko);
      ra2 = *(const uint4*)(ga + (size_t)128 * lda + ko);
      ra3 = *(const uint4*)(ga + (size_t)192 * lda + ko);
      rb0 = *(const uint4*)(gb + ko);
      rb1 = *(const uint4*)(gb + (size_t)64 * ldb + ko);
    }
#pragma unroll
    for (int ks = 0; ks < 2; ++ks) {
      bf16x8 a[4], b[4];
#pragma unroll
      for (int m = 0; m < 4; ++m) { const int r = wm * 64 + m * 16 + l15; a[m] = *(const bf16x8*)(sA + r * 128 + (((ks * 4 + g) ^ (r & 7)) << 4)); }
#pragma unroll
      for (int n = 0; n < 4; ++n) { const int r = wn * 64 + n * 16 + l15; b[n] = *(const bf16x8*)(sB + r * 128 + (((ks * 4 + g) ^ (r & 7)) << 4)); }
#pragma unroll
      for (int m = 0; m < 4; ++m)
#pragma unroll
        for (int n = 0; n < 4; ++n) acc[m][n] = __builtin_amdgcn_mfma_f32_16x16x32_bf16(a[m], b[n], acc[m][n], 0, 0, 0);
    }
  }
}

__device__ __forceinline__ void zero_acc(f32x4 (&acc)[4][4]) {
#pragma unroll
  for (int m = 0; m < 4; ++m)
#pragma unroll
    for (int n = 0; n < 4; ++n) acc[m][n] = (f32x4){0.f, 0.f, 0.f, 0.f};
}

__device__ __forceinline__ void transpose_tile(const float* __restrict__ src, int srcN, bf16_t* __restrict__ dst, int K, int n0, int k0,
                                               bool winmap, float* tile) {
  const int tid = threadIdx.x;
  const int nc = tid & 63, kr = tid >> 6;
  int ncol = n0 + nc; bool valid = true;
  if (winmap) { if (ncol >= 3072) ncol -= 60; else if (ncol >= 3012) valid = false; }
#pragma unroll
  for (int i = 0; i < 8; ++i) {
    const int k = kr + 8 * i;
    tile[k * 65 + nc] = valid ? src[(size_t)(k0 + k) * srcN + ncol] : 0.f;
  }
  __syncthreads();
#pragma unroll
  for (int i = 0; i < 8; ++i) {
    const int nr = kr + 8 * i;
    dst[(size_t)(n0 + nr) * K + k0 + nc] = f2bf(tile[nc * 65 + nr]);
  }
  __syncthreads();
}

__device__ __forceinline__ void convert_f32_bf16(const float* __restrict__ src, bf16_t* __restrict__ dst, size_t n4) {
  for (size_t i = (size_t)blockIdx.x * NTHREADS + threadIdx.x; i < n4; i += (size_t)gridDim.x * NTHREADS) {
    const float4 v = ((const float4*)src)[i];
    uint2 o; o.x = pack2(v.x, v.y); o.y = pack2(v.z, v.w);
    ((uint2*)dst)[i] = o;
  }
}

template <bool SLICE_MAJOR, bool SIGNED>
__device__ __forceinline__ void quantize_rows_u8(const float* __restrict__ src, unsigned char* __restrict__ dst, float* __restrict__ scale, int row_lo, int row_hi) {
  const int lane = threadIdx.x & 63, w = threadIdx.x >> 6;
  for (int row = row_lo + w; row < row_hi; row += 8) {
    const float4* s4 = (const float4*)(src + (size_t)row * 1024) + lane * 4;
    float4 v[4];
    float am = 0.f;
#pragma unroll
    for (int i = 0; i < 4; ++i) { v[i] = s4[i]; am = fmaxf(am, fmaxf(fmaxf(fabsf(v[i].x), fabsf(v[i].y)), fmaxf(fabsf(v[i].z), fabsf(v[i].w)))); }
#pragma unroll
    for (int o = 32; o > 0; o >>= 1) am = fmaxf(am, __shfl_xor(am, o));
    const float inv = am > 0.f ? 127.f / am : 0.f;
    unsigned pk[4];
#pragma unroll
    for (int i = 0; i < 4; ++i) {
      const int ofs = SIGNED ? 0 : 128;
      const unsigned b0 = (unsigned)((int)rintf(v[i].x * inv) + ofs), b1 = (unsigned)((int)rintf(v[i].y * inv) + ofs);
      const unsigned b2 = (unsigned)((int)rintf(v[i].z * inv) + ofs), b3 = (unsigned)((int)rintf(v[i].w * inv) + ofs);
      pk[i] = (b0 & 255u) | ((b1 & 255u) << 8) | ((b2 & 255u) << 16) | ((b3 & 255u) << 24);
    }
    if (SLICE_MAJOR) *(uint4*)(dst + (size_t)(lane >> 3) * (16384 * 128) + (size_t)row * 128 + (lane & 7) * 16) = make_uint4(pk[0], pk[1], pk[2], pk[3]);
    else *(uint4*)(dst + (size_t)row * 1024 + lane * 16) = make_uint4(pk[0], pk[1], pk[2], pk[3]);
    if (lane == 0) scale[row] = am * (1.f / 127.f);
  }
}

#define WS_XQ (WS_PH + (size_t)TOK * 1024 * 2)
#define WS_XS (WS_XQ + (size_t)TOK * 1024)
__device__ __forceinline__ void rmsnorm_rows_q(const float* __restrict__ src, const float* __restrict__ g, bf16_t* __restrict__ dst,
                                               unsigned char* __restrict__ xq, float* __restrict__ xs) {
  const int lane = threadIdx.x & 63, w = threadIdx.x >> 6;
  for (int row = blockIdx.x * 8 + w; row < TOK; row += gridDim.x * 8) {
    const float4* s4 = (const float4*)(src + (size_t)row * DM) + lane * 4;
    const float4* g4 = (const float4*)g + lane * 4;
    float v[16]; float ss = 0.f;
#pragma unroll
    for (int i = 0; i < 4; ++i) { const float4 t = s4[i]; v[4 * i] = t.x; v[4 * i + 1] = t.y; v[4 * i + 2] = t.z; v[4 * i + 3] = t.w; ss += t.x * t.x + t.y * t.y + t.z * t.z + t.w * t.w; }
    ss = wave_sum(ss);
    const float rstd = rsqrtf(ss * (1.f / DM) + EPSV);
    float am = 0.f;
#pragma unroll
    for (int i = 0; i < 4; ++i) { const float4 gg = g4[i]; v[4 * i] *= rstd * gg.x; v[4 * i + 1] *= rstd * gg.y; v[4 * i + 2] *= rstd * gg.z; v[4 * i + 3] *= rstd * gg.w; }
#pragma unroll
    for (int i = 0; i < 16; ++i) am = fmaxf(am, fabsf(v[i]));
#pragma unroll
    for (int o = 32; o > 0; o >>= 1) am = fmaxf(am, __shfl_xor(am, o));
    const float inv = am > 0.f ? 127.f / am : 0.f;
    uint4 ob0, ob1;
    ob0.x = pack2(v[0], v[1]); ob0.y = pack2(v[2], v[3]); ob0.z = pack2(v[4], v[5]); ob0.w = pack2(v[6], v[7]);
    ob1.x = pack2(v[8], v[9]); ob1.y = pack2(v[10], v[11]); ob1.z = pack2(v[12], v[13]); ob1.w = pack2(v[14], v[15]);
    *(uint4*)(dst + (size_t)row * DM + lane * 16) = ob0;
    *(uint4*)(dst + (size_t)row * DM + lane * 16 + 8) = ob1;
    unsigned pk[4];
#pragma unroll
    for (int i = 0; i < 4; ++i) {
      const unsigned b0 = (unsigned)(int)rintf(v[4 * i] * inv) & 255u, b1 = (unsigned)(int)rintf(v[4 * i + 1] * inv) & 255u;
      const unsigned b2 = (unsigned)(int)rintf(v[4 * i + 2] * inv) & 255u, b3 = (unsigned)(int)rintf(v[4 * i + 3] * inv) & 255u;
      pk[i] = b0 | (b1 << 8) | (b2 << 16) | (b3 << 24);
    }
    *(uint4*)(xq + (size_t)row * 1024 + lane * 16) = make_uint4(pk[0], pk[1], pk[2], pk[3]);
    if (lane == 0) xs[row] = am * (1.f / 127.f);
  }
}

__device__ __forceinline__ void rmsnorm_rows(const float* __restrict__ src, const float* __restrict__ g, bf16_t* __restrict__ dst) {
  const int lane = threadIdx.x & 63, w = threadIdx.x >> 6;
  for (int row = blockIdx.x * 8 + w; row < TOK; row += gridDim.x * 8) {
    const float4* s4 = (const float4*)(src + (size_t)row * DM);
    float4 v[4]; float ss = 0.f;
#pragma unroll
    for (int i = 0; i < 4; ++i) { v[i] = s4[lane + 64 * i]; ss += v[i].x * v[i].x + v[i].y * v[i].y + v[i].z * v[i].z + v[i].w * v[i].w; }
    ss = wave_sum(ss);
    const float rstd = rsqrtf(ss * (1.f / DM) + EPSV);
#pragma unroll
    for (int i = 0; i < 4; ++i) {
      const float4 gg = ((const float4*)g)[lane + 64 * i];
      uint2 o; o.x = pack2(v[i].x * rstd * gg.x, v[i].y * rstd * gg.y); o.y = pack2(v[i].z * rstd * gg.z, v[i].w * rstd * gg.w);
      ((uint2*)(dst + (size_t)row * DM))[lane + 64 * i] = o;
    }
  }
}

__device__ __forceinline__ void phase_prep(const Params& p, unsigned char* smem) {
  unsigned char* ws = p.ws;
  float* tile = (float*)smem;
  const int n_win = 80 * 16, n_ua = 16 * 8, n_ub = 16 * 8, n_wo = 16 * 16, n_wq = 32 * 16;
  const int total = n_win + n_ua + n_ub + n_wo + n_wq;
  for (int it = blockIdx.x; it < total; it += gridDim.x) {
    int t = it;
    if (t < n_win) { transpose_tile(p.w_in, 5060, (bf16_t*)(ws + WS_WIN), 1024, (t >> 4) * 64, (t & 15) * 64, true, tile); continue; }
    t -= n_win;
    if (t < n_ua) { transpose_tile(p.w_up_a, 1024, (bf16_t*)(ws + WS_WUPA), 1024, (t >> 3) * 64, (t & 7) * 64, false, tile); continue; }
    t -= n_ua;
    if (t < n_ub) { transpose_tile(p.w_up_b, 1024, (bf16_t*)(ws + WS_WUPA) + 512, 1024, (t >> 3) * 64, (t & 7) * 64, false, tile); continue; }
    t -= n_ub;
    if (t < n_wo) { transpose_tile(p.w_out, 1024, (bf16_t*)(ws + WS_WOUT), 1024, (t >> 4) * 64, (t & 15) * 64, false, tile); continue; }
    t -= n_wo;
    transpose_tile(p.peer_wq, 2048, (bf16_t*)(ws + WS_WQ), 1024, (t >> 4) * 64, (t & 15) * 64, false, tile);
  }
  convert_f32_bf16(p.peer_keys, (bf16_t*)(ws + WS_KEYS), (size_t)2 * 8 * 128 * 128 / 4);
  for (int i = blockIdx.x * NTHREADS + threadIdx.x; i < TOK; i += gridDim.x * NTHREADS) ((float*)(ws + WS_SSQ))[i] = 0.f;
  if (threadIdx.x == 0) ((int*)(ws + WS_XCC))[blockIdx.x] = (int)(__builtin_amdgcn_s_getreg((3 << 11) | 20) & 0xFu);
  if (blockIdx.x == 0 && threadIdx.x < 8) ((unsigned*)(ws + WS_QCTR))[16 * threadIdx.x] = 0u;
  if (blockIdx.x == 0) {
    const int i = threadIdx.x;
    const float a0 = p.hg_lb[i], a1 = p.hg_lb[512 + i];
    ((float*)(ws + WS_LB))[i] = 1.f / (1.f + expf(a1 - a0));
  }
  rmsnorm_rows(p.x, p.norm_mix, (bf16_t*)(ws + WS_XN));
}

__device__ __forceinline__ void hgrn_h1_all(const Params& p, unsigned char* smem) {
  unsigned char* ws = p.ws;
  bf16_t* pH = (bf16_t*)(ws + WS_PH);
  const float* lbp = (const float*)(ws + WS_LB);
  bf16_t* Qt = (bf16_t*)smem;
  bf16_t* Kt = Qt + 64 * 136;
  bf16_t* KtT = Kt + 64 * 136;
  bf16_t* VT = KtT + 128 * 72;
  bf16_t* Am = VT + 128 * 72;
  float* qtot = (float*)(Am + 64 * 72);
  const int tid = threadIdx.x, lane = tid & 63, w = tid >> 6, l15 = lane & 15, g = lane >> 4;
  const int d = tid & 127, tq = tid >> 7;
  const int G = gridDim.x;
  if ((int)blockIdx.x >= 2048) return;
  bf16_t fr_[16], qr_[16]; unsigned short vr_[16];
#define H1_LOAD(IT) do { \
    const int bh_ = (IT) >> 6, ch_ = (IT) & 63; \
    const bf16_t* base_ = pH + ((size_t)(bh_ >> 2) * SEQL + ch_ * 64 + tq * 16) * 2048 + (bh_ & 3) * 128 + d; \
    _Pragma("unroll") for (int i = 0; i < 16; ++i) { fr_[i] = base_[(size_t)i * 2048 + 512]; qr_[i] = base_[(size_t)i * 2048]; vr_[i] = base_[(size_t)i * 2048 + 1024]; } \
  } while (0)
  H1_LOAD((int)blockIdx.x);
  for (int item = blockIdx.x; item < 2048; item += G) {
    const int bh = item >> 6, chunk = item & 63;
    const int b = bh >> 2, h = bh & 3;
    const float lbv = lbp[h * 128 + d];
    const size_t row0 = (size_t)b * SEQL + chunk * 64;
    float* dec = (float*)(ws + WS_DEC) + (size_t)item * 384;
    uint4* UU = (uint4*)p.out + (size_t)item * 2048 + tid;
    float4* OI = (float4*)((unsigned char*)p.out + ((size_t)64 << 20)) + (size_t)item * 2048 + tid;
    {
      unsigned vv[8];
#pragma unroll
      for (int i = 0; i < 8; ++i) vv[i] = (unsigned)vr_[2 * i] | ((unsigned)vr_[2 * i + 1] << 16);
      float lf[16], kk[16], qs[16];
      float run = 0.f;
#pragma unroll
      for (int i = 0; i < 16; ++i) {
        const float sg = sigmoidf_(bf2f(fr_[i]));
        const float fg = lbv + (1.f - lbv) * sg;
        run += __logf(fg);
        lf[i] = run; kk[i] = 1.f - fg; qs[i] = siluf_(bf2f(qr_[i]));
      }
      qtot[tq * 128 + d] = run;
      __syncthreads();
      { const int nit = (item + G < 2048) ? item + G : item; H1_LOAD(nit); }
      const float q0 = qtot[d], q1 = qtot[128 + d], q2 = qtot[256 + d], q3 = qtot[384 + d];
      const float pre = (tq > 0 ? q0 : 0.f) + (tq > 1 ? q1 : 0.f) + (tq > 2 ? q2 : 0.f);
      const float bref = q0 + q1;
      const float blast = bref + q2 + q3;
      unsigned kp[8];
#pragma unroll
      for (int i = 0; i < 16; ++i) {
        const float bt = pre + lf[i];
        const float qt = qs[i] * __expf(bt - bref);
        const float kt = kk[i] * __expf(bref - bt);
        const int t = tq * 16 + i;
        Qt[t * 136 + d] = f2bf(qt);
        const bf16_t kb = f2bf(kt);
        Kt[t * 136 + d] = kb;
        if (i & 1) kp[i >> 1] |= ((unsigned)kb) << 16; else kp[i >> 1] = kb;
      }
      *(uint4*)(KtT + d * 72 + tq * 16) = make_uint4(kp[0], kp[1], kp[2], kp[3]);
      *(uint4*)(KtT + d * 72 + tq * 16 + 8) = make_uint4(kp[4], kp[5], kp[6], kp[7]);
      *(uint4*)(VT + d * 72 + tq * 16) = make_uint4(vv[0], vv[1], vv[2], vv[3]);
      *(uint4*)(VT + d * 72 + tq * 16 + 8) = make_uint4(vv[4], vv[5], vv[6], vv[7]);
      if (tq == 0) { dec[d] = __expf(bref); dec[128 + d] = __expf(blast); dec[256 + d] = __expf(blast - bref); }
    }
    __syncthreads();
    {
  #pragma unroll
      for (int i = 0; i < 2; ++i) {
        const int idx = tid + 512 * i, r = idx >> 4, c = idx & 15;
        *(uint4*)(pH + (row0 + r) * 2048 + h * 128 + c * 8) = *(const uint4*)(Qt + r * 136 + c * 8);
      }
  #pragma unroll
      for (int tt = 0; tt < 2; ++tt) {
        const int tl = 2 * w + tt, sm = tl >> 2, tn = tl & 3;
        f32x4 acc = (f32x4){0.f, 0.f, 0.f, 0.f};
        if (tn >= sm) {
  #pragma unroll
          for (int k0 = 0; k0 < 128; k0 += 32) {
            const bf16x8 a = *(const bf16x8*)(Kt + (sm * 16 + l15) * 136 + k0 + 8 * g);
            const bf16x8 bq = *(const bf16x8*)(Qt + (tn * 16 + l15) * 136 + k0 + 8 * g);
            acc = __builtin_amdgcn_mfma_f32_16x16x32_bf16(a, bq, acc, 0, 0, 0);
          }
        }
        const int t = tn * 16 + l15, s0 = sm * 16 + 4 * g;
        uint2 o;
        o.x = pack2(s0 + 0 <= t ? acc[0] : 0.f, s0 + 1 <= t ? acc[1] : 0.f);
        o.y = pack2(s0 + 2 <= t ? acc[2] : 0.f, s0 + 3 <= t ? acc[3] : 0.f);
        *(uint2*)(Am + t * 72 + s0) = o;
      }
    }
    __syncthreads();
    {
  #pragma unroll
      for (int tm = 0; tm < 4; ++tm) {
        f32x4 acc = (f32x4){0.f, 0.f, 0.f, 0.f};
  #pragma unroll
        for (int k0 = 0; k0 < 64; k0 += 32) {
          const bf16x8 a = *(const bf16x8*)(Am + (tm * 16 + l15) * 72 + k0 + 8 * g);
          const bf16x8 bb = *(const bf16x8*)(VT + (16 * w + l15) * 72 + k0 + 8 * g);
          acc = __builtin_amdgcn_mfma_f32_16x16x32_bf16(a, bb, acc, 0, 0, 0);
        }
        OI[tm * 512] = make_float4(acc[0], acc[1], acc[2], acc[3]);
      }
  #pragma unroll
      for (int dp = 0; dp < 4; ++dp) {
        unsigned pk[4];
  #pragma unroll
        for (int hh = 0; hh < 2; ++hh) {
          const int dm = dp * 2 + hh;
          f32x4 acc = (f32x4){0.f, 0.f, 0.f, 0.f};
  #pragma unroll
          for (int k0 = 0; k0 < 64; k0 += 32) {
            const bf16x8 a = *(const bf16x8*)(KtT + (dm * 16 + l15) * 72 + k0 + 8 * g);
            const bf16x8 bb = *(const bf16x8*)(VT + (16 * w + l15) * 72 + k0 + 8 * g);
            acc = __builtin_amdgcn_mfma_f32_16x16x32_bf16(a, bb, acc, 0, 0, 0);
          }
          pk[hh * 2] = pack2(acc[0], acc[1]); pk[hh * 2 + 1] = pack2(acc[2], acc[3]);
        }
        UU[dp * 512] = make_uint4(pk[0], pk[1], pk[2], pk[3]);
      }
    }
    __syncthreads();
  }
#undef H1_LOAD
}

__device__ __forceinline__ void hgrn_h2(const Params& p, unsigned char* smem, int bh) {
  unsigned char* ws = p.ws;
  const bf16_t* pH = (const bf16_t*)(ws + WS_PH);
  bf16_t* ya = (bf16_t*)(ws + WS_XN);
  bf16_t* Qt = (bf16_t*)smem;
  bf16_t* ST = Qt + 64 * 136;
  float* decl = (float*)(ST + 128 * 136);
  float* red = decl + 384;
  const int tid = threadIdx.x, lane = tid & 63, w = tid >> 6, l15 = lane & 15, g = lane >> 4;
  const int b = bh >> 2, h = bh & 3;
  f32x4 S[8];
#pragma unroll
  for (int i = 0; i < 8; ++i) S[i] = (f32x4){0.f, 0.f, 0.f, 0.f};
  const float gnv = p.hg_norm[h * 128 + 16 * w + l15];
  const int e = 16 * w + l15;
  uint4 uu0, uu1, uu2, uu3; float4 oi0, oi1, oi2, oi3; uint4 qraw0, qraw1; bf16_t ogr[16]; float dcv = 0.f;
#define H2_LOAD(CH) do { \
    const int item_ = bh * 64 + (CH); \
    const size_t row0_ = (size_t)b * SEQL + (size_t)(CH) * 64; \
    const uint4* UUp = (const uint4*)p.out + (size_t)item_ * 2048 + tid; \
    const float4* OIp = (const float4*)((const unsigned char*)p.out + ((size_t)64 << 20)) + (size_t)item_ * 2048 + tid; \
    uu0 = UUp[0]; uu1 = UUp[512]; uu2 = UUp[1024]; uu3 = UUp[1536]; oi0 = OIp[0]; oi1 = OIp[512]; oi2 = OIp[1024]; oi3 = OIp[1536]; \
    qraw0 = *(const uint4*)(pH + (row0_ + (tid >> 4)) * 2048 + h * 128 + (tid & 15) * 8); \
    qraw1 = *(const uint4*)(pH + (row0_ + 32 + (tid >> 4)) * 2048 + h * 128 + (tid & 15) * 8); \
    _Pragma("unroll") for (int tm = 0; tm < 4; ++tm) _Pragma("unroll") for (int j = 0; j < 4; ++j) \
      ogr[tm * 4 + j] = pH[(row0_ + tm * 16 + 4 * g + j) * 2048 + 1536 + h * 128 + e]; \
    if (tid < 384) dcv = ((const float*)(ws + WS_DEC))[(size_t)item_ * 384 + tid]; \
  } while (0)
  H2_LOAD(0);
  for (int chunk = 0; chunk < 64; ++chunk) {
    const size_t row0 = (size_t)b * SEQL + chunk * 64;
    const uint4 cu[4] = {uu0, uu1, uu2, uu3}; const float4 co[4] = {oi0, oi1, oi2, oi3}; bf16_t cog[16];
#pragma unroll
    for (int i = 0; i < 16; ++i) cog[i] = ogr[i];
    *(uint4*)(Qt + (tid >> 4) * 136 + (tid & 15) * 8) = qraw0;
    *(uint4*)(Qt + (32 + (tid >> 4)) * 136 + (tid & 15) * 8) = qraw1;
    if (tid < 384) decl[tid] = dcv;
    __syncthreads();
    if (chunk + 1 < 64) H2_LOAD(chunk + 1);
#pragma unroll
    for (int dm = 0; dm < 8; ++dm) {
      const int d0 = 16 * dm + 4 * g;
      uint2 o;
      o.x = pack2(S[dm][0] * decl[d0], S[dm][1] * decl[d0 + 1]);
      o.y = pack2(S[dm][2] * decl[d0 + 2], S[dm][3] * decl[d0 + 3]);
      *(uint2*)(ST + e * 136 + d0) = o;
    }
    __syncthreads();
    f32x4 o[4];
#pragma unroll
    for (int tm = 0; tm < 4; ++tm) {
      f32x4 acc = (f32x4){co[tm].x, co[tm].y, co[tm].z, co[tm].w};
#pragma unroll
      for (int k0 = 0; k0 < 128; k0 += 32) {
        const bf16x8 a = *(const bf16x8*)(Qt + (tm * 16 + l15) * 136 + k0 + 8 * g);
        const bf16x8 bb = *(const bf16x8*)(ST + (16 * w + l15) * 136 + k0 + 8 * g);
        acc = __builtin_amdgcn_mfma_f32_16x16x32_bf16(a, bb, acc, 0, 0, 0);
      }
      o[tm] = acc;
#pragma unroll
      for (int j = 0; j < 4; ++j) {
        float ss = acc[j] * acc[j];
        ss += __int_as_float(__builtin_amdgcn_update_dpp(0, __float_as_int(ss), 0xB1, 0xf, 0xf, true));
        ss += __int_as_float(__builtin_amdgcn_update_dpp(0, __float_as_int(ss), 0x4E, 0xf, 0xf, true));
        ss += __int_as_float(__builtin_amdgcn_update_dpp(0, __float_as_int(ss), 0x141, 0xf, 0xf, true));
        ss += __int_as_float(__builtin_amdgcn_update_dpp(0, __float_as_int(ss), 0x140, 0xf, 0xf, true));
        if (l15 == 0) red[w * 64 + tm * 16 + 4 * g + j] = ss;
      }
    }
#pragma unroll
    for (int dm = 0; dm < 8; ++dm) {
      const unsigned u01 = (dm & 1) ? cu[dm >> 1].z : cu[dm >> 1].x, u23 = (dm & 1) ? cu[dm >> 1].w : cu[dm >> 1].y;
      const float uv[4] = {__uint_as_float(u01 << 16), __uint_as_float(u01 & 0xffff0000u), __uint_as_float(u23 << 16), __uint_as_float(u23 & 0xffff0000u)};
#pragma unroll
      for (int j = 0; j < 4; ++j) { const int dd = 16 * dm + 4 * g + j; S[dm][j] = decl[128 + dd] * S[dm][j] + decl[256 + dd] * uv[j]; }
    }
    __syncthreads();
    if (tid < 64) {
      float tot = 0.f;
#pragma unroll
      for (int ww = 0; ww < 8; ++ww) tot += red[ww * 64 + tid];
      red[512 + tid] = rsqrtf(tot * (1.f / 128.f) + EPSV);
    }
    __syncthreads();
#pragma unroll
    for (int tm = 0; tm < 4; ++tm)
#pragma unroll
      for (int j = 0; j < 4; ++j) {
        const int t = tm * 16 + 4 * g + j;
        const float rstd = red[512 + t];
        ya[(row0 + t) * 1024 + h * 128 + e] = f2bf(o[tm][j] * rstd * gnv * siluf_(bf2f(cog[tm * 4 + j])));
      }
  }
#undef H2_LOAD
}

__device__ __forceinline__ int team_index(const Params& p, unsigned char* smem) {
  int* sh = (int*)(smem + 8192);
  const int G = gridDim.x, tid = threadIdx.x;
  const int* tab = (const int*)(p.ws + WS_XCC);
  if (tid < 32) sh[tid] = 0;
  __syncthreads();
  const int mine = tab[blockIdx.x] & 15;
  for (int b = tid; b < G; b += NTHREADS) {
    const int x = tab[b] & 15;
    atomicAdd(&sh[x], 1);
    if (x == mine && b < (int)blockIdx.x) atomicAdd(&sh[16], 1);
  }
  __syncthreads();
  if (tid == 0) {
    int pre = 0;
    for (int j = 0; j < mine; ++j) pre += sh[j];
    sh[17] = pre + sh[16];
  }
  __syncthreads();
  const int r = sh[17];
  __syncthreads();
  return r;
}

#define SCW 4100
#ifndef DSA_REP
#define DSA_REP 0
#endif
#define DSA_BKT_OFF (8 * SCW * 4 + 8 * 256 * 4 + 8 * 256 * 2 + 8 * 512 * 2)
__device__ __forceinline__ void cvt8(const uint4& v, float* f) {
  f[0] = __uint_as_float(v.x << 16); f[1] = __uint_as_float(v.x & 0xffff0000u);
  f[2] = __uint_as_float(v.y << 16); f[3] = __uint_as_float(v.y & 0xffff0000u);
  f[4] = __uint_as_float(v.z << 16); f[5] = __uint_as_float(v.z & 0xffff0000u);
  f[6] = __uint_as_float(v.w << 16); f[7] = __uint_as_float(v.w & 0xffff0000u);
}
__device__ __forceinline__ unsigned sortable_key(float v) {
  unsigned bits = __float_as_uint(v);
  if (bits == 0x80000000u) bits = 0u;
  return (bits & 0x80000000u) ? ~bits : (bits | 0x80000000u);
}

__device__ __forceinline__ void dsa_item(const Params& p, unsigned char* smem, int item) {
  unsigned char* ws = p.ws;
  const bf16_t* pA = (const bf16_t*)(ws + WS_PA);
  const bf16_t* kc = (const bf16_t*)(ws + WS_KC);
  const bf16_t* vc = (const bf16_t*)(ws + WS_VC);
  const bf16_t* ikc = (const bf16_t*)(ws + WS_IKC);
  bf16_t* yb = (bf16_t*)(ws + WS_XN) + 512;
  unsigned* sc = (unsigned*)smem;
  unsigned* hist = sc + 8 * SCW;
  unsigned short* sel = (unsigned short*)(hist + 8 * 256);
  unsigned short* cand = sel + 8 * 256;
  unsigned char* bkt = (unsigned char*)(cand + 8 * 512);
  unsigned* rmm = (unsigned*)(bkt + 128 + 1056);
  unsigned* bks = rmm + 16;
  const int tid = threadIdx.x, lane = tid & 63, w = tid >> 6, l15 = lane & 15, g = lane >> 4;
  const int b = item >> 9;
  const int tb = item & 511;
  const int t0 = tb * 8;
  const size_t tokbase = (size_t)b * SEQL;

  for (int rep_s = 0; rep_s < (DSA_REP == 1 ? 2 : 1); ++rep_s) {
    bf16x8 af[2][2];
    float wq[2][4];
#pragma unroll
    for (int mt = 0; mt < 2; ++mt) {
      const int qrow = t0 + mt * 4 + (l15 >> 2), head = l15 & 3;
#pragma unroll
      for (int ks = 0; ks < 2; ++ks)
        af[mt][ks] = *(const bf16x8*)(pA + (tokbase + qrow) * 1024 + 640 + head * 64 + ks * 32 + 8 * g);
      const uint2 wr = *(const uint2*)(pA + (tokbase + t0 + mt * 4 + g) * 1024 + 960);
      wq[mt][0] = 0.5f * bf2f((bf16_t)(wr.x & 0xffff)); wq[mt][1] = 0.5f * bf2f((bf16_t)(wr.x >> 16));
      wq[mt][2] = 0.5f * bf2f((bf16_t)(wr.y & 0xffff)); wq[mt][3] = 0.5f * bf2f((bf16_t)(wr.y >> 16));
    }
    const int nkt = (t0 + 8 + 15) >> 4;
    unsigned kmin[2] = {0xFFFFFFFFu, 0xFFFFFFFFu}, kmax[2] = {0u, 0u};
    for (int kt0 = w; kt0 < nkt; kt0 += 64) {
      bf16x8 b0[8], b1[8];
#pragma unroll
      for (int u = 0; u < 8; ++u) {
        const int kt = kt0 + 8 * u;
        const int s = (kt < nkt ? kt : 0) * 16 + l15;
        const bf16_t* kr = ikc + (tokbase + s) * 64 + 8 * g;
        b0[u] = *(const bf16x8*)kr;
        b1[u] = *(const bf16x8*)(kr + 32);
      }
      __builtin_amdgcn_sched_barrier(0);
      f32x4 sacc[8][2];
#pragma unroll
      for (int u = 0; u < 8; ++u)
#pragma unroll
        for (int mt = 0; mt < 2; ++mt) {
          f32x4 acc = (f32x4){0.f, 0.f, 0.f, 0.f};
          acc = __builtin_amdgcn_mfma_f32_16x16x32_bf16(af[mt][0], b0[u], acc, 0, 0, 0);
          sacc[u][mt] = __builtin_amdgcn_mfma_f32_16x16x32_bf16(af[mt][1], b1[u], acc, 0, 0, 0);
        }
#pragma unroll
      for (int u = 0; u < 8; ++u) {
        const int kt = kt0 + 8 * u;
        if (kt < nkt) {
          const int s = kt * 16 + l15;
#pragma unroll
          for (int mt = 0; mt < 2; ++mt) {
            float v = 0.f;
#pragma unroll
            for (int j = 0; j < 4; ++j) v += wq[mt][j] * fmaxf(sacc[u][mt][j] * 0.125f, 0.f);
            const int t = t0 + mt * 4 + g;
            unsigned vb = __float_as_uint(v); if (vb == 0x80000000u) vb = 0u;
            sc[(mt * 4 + g) * SCW + s] = vb;
            if (s <= t) {
              const unsigned key = (vb & 0x80000000u) ? ~vb : (vb | 0x80000000u);
              kmin[mt] = key < kmin[mt] ? key : kmin[mt];
              kmax[mt] = key > kmax[mt] ? key : kmax[mt];
            }
          }
        }
      }
    }
#pragma unroll
    for (int mt = 0; mt < 2; ++mt) {
      unsigned a = kmin[mt], bmx = kmax[mt];
#define DPP_MINMAX(CTRL) do { const unsigned a2 = (unsigned)__builtin_amdgcn_update_dpp((int)a, (int)a, CTRL, 0xf, 0xf, false); \
                               const unsigned b2 = (unsigned)__builtin_amdgcn_update_dpp((int)bmx, (int)bmx, CTRL, 0xf, 0xf, false); \
                               a = a2 < a ? a2 : a; bmx = b2 > bmx ? b2 : bmx; } while (0)
      DPP_MINMAX(0xB1); DPP_MINMAX(0x4E); DPP_MINMAX(0x141); DPP_MINMAX(0x140);
#undef DPP_MINMAX
      if (l15 == 0) { atomicMin(&rmm[mt * 4 + g], a); atomicMax(&rmm[8 + mt * 4 + g], bmx); }
    }
  }
  __syncthreads();
  const int t = t0 + w;
  const int n = t + 1;
  unsigned* row = sc + w * SCW;
  const float* rowf = (const float*)row;
  unsigned short* mysel = sel + w * 256;
  unsigned short* mycand = cand + w * 512;
  unsigned* myh = hist + w * 256;
  int cnt;
  const unsigned long long lt_mask = (1ull << lane) - 1ull;
  for (int rep_t = 0; rep_t < (DSA_REP == 2 ? 2 : 1); ++rep_t)
  if (n <= 256) {
    for (int i = lane; i < n; i += 64) mysel[i] = (unsigned short)i;
    cnt = n;
  } else {
    cnt = 256;
    float mn, mx;
    {
      const unsigned kmn = rmm[w], kmx = rmm[8 + w];
      mn = __uint_as_float((kmn & 0x80000000u) ? (kmn ^ 0x80000000u) : ~kmn);
      mx = __uint_as_float((kmx & 0x80000000u) ? (kmx ^ 0x80000000u) : ~kmx);
    }
    const float scale = (mx > mn) ? 255.99f / (mx - mn) : 0.f;
#pragma unroll
    for (int i = 0; i < 4; ++i) myh[lane + 64 * i] = 0u;
    lds_fence();
    for (int i0 = lane; i0 < n; i0 += 256) {
      float v4[4];
#pragma unroll
      for (int k = 0; k < 4; ++k) v4[k] = (i0 + 64 * k < n) ? rowf[i0 + 64 * k] : 0.f;
#pragma unroll
      for (int k = 0; k < 4; ++k) {
        if (i0 + 64 * k < n) {
          int bn = (int)((v4[k] - mn) * scale); bn = bn > 255 ? 255 : bn;
          atomicAdd(&myh[bn], 1u);
        }
      }
    }
    lds_fence();
    unsigned cum; int bstar; unsigned mcount;
    {
      const uint4 c4 = *(const uint4*)(myh + 4 * lane);
      const unsigned c = c4.x + c4.y + c4.z + c4.w;
      unsigned sfx = c;
#pragma unroll
      for (int o = 1; o < 64; o <<= 1) { const unsigned tt = __shfl_down(sfx, o); if (lane + o < 64) sfx += tt; }
      const unsigned long long bal = __ballot(sfx >= 256u);
      const int L = 63 - __clzll(bal);
      const unsigned sL = __shfl(sfx, L), cL = __shfl(c, L);
      const unsigned b3 = __shfl(c4.w, L), b2 = __shfl(c4.z, L), b1 = __shfl(c4.y, L), b0 = __shfl(c4.x, L);
      cum = sL - cL;
      int digit;
      if (cum + b3 >= 256u) { digit = 3; mcount = b3; }
      else { cum += b3; if (cum + b2 >= 256u) { digit = 2; mcount = b2; } else { cum += b2; if (cum + b1 >= 256u) { digit = 1; mcount = b1; } else { cum += b1; digit = 0; mcount = b0; } } }
      bstar = 4 * L + digit;
    }
    const unsigned need = 256u - cum;
    if (mcount <= 512u) {
      unsigned base = 0u, cb = 0u;
      for (int i0 = 0; i0 < n; i0 += 256) {
        float v4[4];
#pragma unroll
        for (int k = 0; k < 4; ++k) { const int i = i0 + 64 * k + lane; v4[k] = (i < n) ? rowf[i] : 0.f; }
#pragma unroll
        for (int k = 0; k < 4; ++k) {
          const int i = i0 + 64 * k + lane;
          const bool valid = i < n;
          int bn = (int)((v4[k] - mn) * scale); bn = bn > 255 ? 255 : bn;
          const bool gt = valid && (bn > bstar);
          const bool eq = valid && (bn == bstar);
          const unsigned long long bg = __ballot(gt), be = __ballot(eq);
          if (gt) mysel[base + (unsigned)__popcll(bg & lt_mask)] = (unsigned short)i;
          if (eq) mycand[cb + (unsigned)__popcll(be & lt_mask)] = (unsigned short)i;
          base += (unsigned)__popcll(bg); cb += (unsigned)__popcll(be);
        }
      }
      lds_fence();
      const int m = (int)mcount;
      unsigned ck[8]; unsigned short ci[8];
#pragma unroll
      for (int q = 0; q < 8; ++q) {
        const int c = q * 64 + lane;
        ck[q] = 0u; ci[q] = 0;
        if (c < m) { ci[q] = mycand[c]; ck[q] = sortable_key(rowf[ci[q]]); }
      }
      unsigned T = 0u;
      if (m <= 64) {
#pragma unroll 1
        for (int bit = 31; bit >= 0; --bit) {
          const unsigned trial = T | (1u << bit);
          if ((unsigned)__popcll(__ballot(ck[0] >= trial)) >= need) T = trial;
        }
      } else {
#pragma unroll 1
        for (int bit = 31; bit >= 0; --bit) {
          const unsigned trial = T | (1u << bit);
          unsigned cge = 0u;
#pragma unroll
          for (int q = 0; q < 8; ++q) cge += (unsigned)__popcll(__ballot(ck[q] >= trial));
          if (cge >= need) T = trial;
        }
      }
      unsigned cgt = 0u;
#pragma unroll
      for (int q = 0; q < 8; ++q) cgt += (unsigned)__popcll(__ballot(ck[q] > T));
      const unsigned need_eq = need - cgt;
      unsigned pos0 = cum, eqtaken = 0u;
#pragma unroll
      for (int q = 0; q < 8; ++q) {
        const bool gt = ck[q] > T;
        const bool eq = ck[q] == T;
        const unsigned long long beq = __ballot(eq);
        const bool take = gt || (eq && (eqtaken + (unsigned)__popcll(beq & lt_mask)) < need_eq);
        const unsigned long long bt = __ballot(take);
        const unsigned pp = pos0 + (unsigned)__popcll(bt & lt_mask);
        if (take && pp < 256u) mysel[pp] = ci[q];
        pos0 += (unsigned)__popcll(bt);
        eqtaken += (unsigned)__popcll(beq);
      }
    } else {
      unsigned prefix = 0u, krem = 256u;
#pragma unroll 1
      for (int pass = 0; pass < 4; ++pass) {
        const int shift = 24 - 8 * pass;
        const unsigned himask = (pass == 0) ? 0u : (0xFFFFFFFFu << (shift + 8));
#pragma unroll
        for (int i = 0; i < 4; ++i) myh[lane + 64 * i] = 0u;
        lds_fence();
        for (int i = lane; i < n; i += 64) {
          const unsigned u = sortable_key(rowf[i]);
          if ((u & himask) == prefix) atomicAdd(&myh[(u >> shift) & 255u], 1u);
        }
        lds_fence();
        const uint4 c4 = *(const uint4*)(myh + 4 * lane);
        const unsigned c = c4.x + c4.y + c4.z + c4.w;
        unsigned sfx = c;
#pragma unroll
        for (int o = 1; o < 64; o <<= 1) { const unsigned tt = __shfl_down(sfx, o); if (lane + o < 64) sfx += tt; }
        const unsigned long long bal = __ballot(sfx >= krem);
        const int L = 63 - __clzll(bal);
        const unsigned sL = __shfl(sfx, L), cL = __shfl(c, L);
        const unsigned b3 = __shfl(c4.w, L), b2 = __shfl(c4.z, L), b1 = __shfl(c4.y, L);
        unsigned cum2 = sL - cL;
        unsigned digit;
        if (cum2 + b3 >= krem) digit = 3;
        else { cum2 += b3; if (cum2 + b2 >= krem) digit = 2; else { cum2 += b2; if (cum2 + b1 >= krem) digit = 1; else { cum2 += b1; digit = 0; } } }
        krem -= cum2;
        prefix |= ((unsigned)(4 * L) + digit) << shift;
      }
      const unsigned T = prefix;
      unsigned base = 0u, eqtaken = 0u;
      for (int i0 = 0; i0 < n; i0 += 64) {
        const int i = i0 + lane;
        const bool valid = i < n;
        const unsigned u = valid ? sortable_key(rowf[i]) : 0u;
        const bool gt = valid && (u > T);
        const bool eq = valid && (u == T);
        const unsigned long long beq = __ballot(eq);
        const unsigned eqrank = eqtaken + (unsigned)__popcll(beq & lt_mask);
        const bool take = gt || (eq && eqrank < krem);
        const unsigned long long bt = __ballot(take);
        const unsigned pos = base + (unsigned)__popcll(bt & lt_mask);
        if (take && pos < 256u) mysel[pos] = (unsigned short)i;
        base += (unsigned)__popcll(bt);
        eqtaken += (unsigned)__popcll(beq);
      }
    }
  }
  lds_fence();
  if (lane == 0) { rmm[w] = 0xFFFFFFFFu; rmm[8 + w] = 0u; }
  lds_fence();
  {
    const uint2 s4 = *(const uint2*)(mysel + 4 * lane);
    const int sj[4] = {(int)(s4.x & 0xffffu), (int)(s4.x >> 16), (int)(s4.y & 0xffffu), (int)(s4.y >> 16)};
    unsigned pk = 0u;
#pragma unroll
    for (int j = 0; j < 4; ++j) {
      const bool valid = 4 * lane + j < cnt;
      const int dist = valid ? t - sj[j] : 0;
      unsigned bk = dist < 128 ? (unsigned)bkt[dist] : 31u;
      bk = valid ? bk : 32u;
      pk |= bk << (8 * j);
    }
    bks[w * 64 + lane] = pk;
  }
  lds_fence();
  {
    int lane_a = lane;
    asm volatile("" : "+v"(lane_a));
    const int l15 = lane_a & 15, g = lane_a >> 4;
    const int ks = lane_a >> 3, dc = lane_a & 7;
    const unsigned char* kcb = (const unsigned char*)(kc + tokbase * 64);
    const unsigned char* vcb = (const unsigned char*)(vc + tokbase * 64);
    float* pl = (float*)row;
    const float* relb = (const float*)(bkt + 128);
    const int niter = (cnt + 7) >> 3;
    bf16x8 bq0 = (bf16x8){0, 0, 0, 0, 0, 0, 0, 0}, bq1 = bq0;
    if (l15 < 8) {
      bq0 = *(const bf16x8*)(pA + (tokbase + t) * 1024 + l15 * 64 + 8 * g);
      bq1 = *(const bf16x8*)(pA + (tokbase + t) * 1024 + l15 * 64 + 32 + 8 * g);
    }
    float lg[16][4];
    {
      bf16x8 ka[8][2], kb[8][2];
#pragma unroll
      for (int u = 0; u < 8; ++u) {
        const int kk = u * 16 + l15;
        const unsigned s = (unsigned)mysel[kk] & 4095u;
        const unsigned ko = s * 128u + 16u * (unsigned)g;
        ka[u][0] = *(const bf16x8*)(kcb + ko);
        ka[u][1] = *(const bf16x8*)(kcb + ko + 64u);
      }
#pragma unroll
      for (int u = 0; u < 8; ++u) {
        const int kk = (8 + u) * 16 + l15;
        const unsigned s = (unsigned)mysel[kk] & 4095u;
        const unsigned ko = s * 128u + 16u * (unsigned)g;
        kb[u][0] = *(const bf16x8*)(kcb + ko);
        kb[u][1] = *(const bf16x8*)(kcb + ko + 64u);
      }
      __builtin_amdgcn_sched_barrier(0);
#pragma unroll
      for (int u = 0; u < 8; ++u) {
        f32x4 acc = (f32x4){0.f, 0.f, 0.f, 0.f};
        acc = __builtin_amdgcn_mfma_f32_16x16x32_bf16(ka[u][0], bq0, acc, 0, 0, 0);
        acc = __builtin_amdgcn_mfma_f32_16x16x32_bf16(ka[u][1], bq1, acc, 0, 0, 0);
        lg[u][0] = acc[0]; lg[u][1] = acc[1]; lg[u][2] = acc[2]; lg[u][3] = acc[3];
      }
#pragma unroll
      for (int u = 0; u < 8; ++u) {
        f32x4 acc = (f32x4){0.f, 0.f, 0.f, 0.f};
        acc = __builtin_amdgcn_mfma_f32_16x16x32_bf16(kb[u][0], bq0, acc, 0, 0, 0);
        acc = __builtin_amdgcn_mfma_f32_16x16x32_bf16(kb[u][1], bq1, acc, 0, 0, 0);
        lg[8 + u][0] = acc[0]; lg[8 + u][1] = acc[1]; lg[8 + u][2] = acc[2]; lg[8 + u][3] = acc[3];
      }
    }
    typedef unsigned u32x4_t __attribute__((ext_vector_type(4)));
    u32x4_t va[16];
#pragma unroll
    for (int u = 0; u < 16; ++u) {
      const int kk = u * 8 + ks;
      const unsigned s = (unsigned)mysel[kk] & 4095u;
      va[u] = *(const u32x4_t*)(vcb + s * 128u + 16u * (unsigned)dc);
    }
    __builtin_amdgcn_sched_barrier(0);
    const int hsel = l15 & 7;
    float m = -INFINITY;
    const unsigned* mybks = bks + w * 64;
#pragma unroll
    for (int u = 0; u < 16; ++u) {
      const unsigned bk4 = mybks[4 * u + g];
#pragma unroll
      for (int j = 0; j < 4; ++j) {
        lg[u][j] = lg[u][j] * 0.125f + relb[((bk4 >> (8 * j)) & 255u) * 8 + hsel];
        m = fmaxf(m, lg[u][j]);
      }
    }
    m = max_xor16(m); m = max_xor32(m);
    float sum = 0.f;
#pragma unroll
    for (int u = 0; u < 16; ++u)
#pragma unroll
      for (int j = 0; j < 4; ++j) { lg[u][j] = __expf(lg[u][j] - m); sum += lg[u][j]; }
    sum = add_xor16(sum); sum = add_xor32(sum);
    const float inv = 1.f / sum;
    bf16x8 pa[8];
#pragma unroll
    for (int s8 = 0; s8 < 8; ++s8) {
      const unsigned w0 = pack2(lg[2 * s8][0] * inv, lg[2 * s8][1] * inv), w1 = pack2(lg[2 * s8][2] * inv, lg[2 * s8][3] * inv);
      const unsigned w2 = pack2(lg[2 * s8 + 1][0] * inv, lg[2 * s8 + 1][1] * inv), w3 = pack2(lg[2 * s8 + 1][2] * inv, lg[2 * s8 + 1][3] * inv);
      const u32x4_t wv = {w0, w1, w2, w3};
      pa[s8] = __builtin_bit_cast(bf16x8, wv);
    }
    unsigned char* vs_l = (unsigned char*)row;
#pragma unroll
    for (int u = 0; u < 16; ++u) *(u32x4_t*)(vs_l + (u * 8 + ks) * 128 + dc * 16) = va[u];
    lds_fence();
    u32x4_t vb[16];
#pragma unroll
    for (int u = 0; u < 16; ++u) {
      const int kk = (16 + u) * 8 + ks;
      const unsigned s = (unsigned)mysel[kk] & 4095u;
      vb[u] = *(const u32x4_t*)(vcb + s * 128u + 16u * (unsigned)dc);
    }
    __builtin_amdgcn_sched_barrier(0);
    f32x4 ov[4];
#pragma unroll
    for (int nt = 0; nt < 4; ++nt) ov[nt] = (f32x4){0.f, 0.f, 0.f, 0.f};
    typedef short v4s_t __attribute__((ext_vector_type(4)));
    const unsigned tr_lane = (unsigned)((l15 >> 2) * 128 + (l15 & 3) * 8);
#define PV_HALF(S0) do { \
      _Pragma("unroll") for (int s4_ = 0; s4_ < 4; ++s4_) { \
        _Pragma("unroll") for (int nt = 0; nt < 4; ++nt) { \
          const unsigned a0 = (unsigned)((s4_ * 32 + 4 * g) * 128 + nt * 32) + tr_lane; \
          const v4s_t b0 = __builtin_amdgcn_ds_read_tr16_b64_v4i16((__attribute__((address_space(3))) v4s_t*)(vs_l + a0)); \
          const v4s_t b1 = __builtin_amdgcn_ds_read_tr16_b64_v4i16((__attribute__((address_space(3))) v4s_t*)(vs_l + a0 + 16 * 128)); \
          const bf16x8 bb = (bf16x8){b0[0], b0[1], b0[2], b0[3], b1[0], b1[1], b1[2], b1[3]}; \
          ov[nt] = __builtin_amdgcn_mfma_f32_16x16x32_bf16(pa[(S0) + s4_], bb, ov[nt], 0, 0, 0); \
        } \
      } \
    } while (0)
    PV_HALF(0);
    lds_fence();
#pragma unroll
    for (int u = 0; u < 16; ++u) *(u32x4_t*)(vs_l + (u * 8 + ks) * 128 + dc * 16) = vb[u];
    lds_fence();
    PV_HALF(4);
#undef PV_HALF
    if (g < 2) {
#pragma unroll
      for (int nt = 0; nt < 4; ++nt)
#pragma unroll
        for (int j = 0; j < 4; ++j) yb[(tokbase + t) * 1024 + (4 * g + j) * 64 + nt * 16 + l15] = f2bf(ov[nt][j]);
    }
    lds_fence();
  }
  __syncthreads();
}

__device__ __forceinline__ void phase_mix(const Params& p, unsigned char* smem, int mode = 0) {
  const int G = gridDim.x;
  if (mode != 2) { for (int bh = blockIdx.x; bh < 32; bh += G) { hgrn_h2(p, smem, bh); __syncthreads(); } }
  if (mode == 1) return;
  unsigned char* bkt = smem + DSA_BKT_OFF;
  volatile int* qslot = (volatile int*)(smem + LDS_BYTES - 32);
  unsigned* qctr = (unsigned*)(p.ws + WS_QCTR);
  if (threadIdx.x < 128) {
    const int nn = threadIdx.x;
    int v = nn;
    if (nn >= 16) { v = 16 + (int)(logf((float)nn * (1.f / 16.f)) / logf(8.f) * 16.f); if (v > 31) v = 31; }
    bkt[nn] = (unsigned char)v;
  }
  if (threadIdx.x >= 256) ((float*)(bkt + 128))[threadIdx.x - 256] = p.rel_bias[threadIdx.x - 256];
  if (threadIdx.x >= 128 && threadIdx.x < 136) ((float*)(bkt + 128))[256 + threadIdx.x - 128] = -INFINITY;
  if (threadIdx.x < 16) ((unsigned*)(bkt + 128 + 1056))[threadIdx.x] = threadIdx.x < 8 ? 0xFFFFFFFFu : 0u;
  const int my_team = (G % 8 == 0) ? team_index(p, smem) / (G >> 3) : (int)(blockIdx.x & 7);
  constexpr int QN = 544;
#define Q_FETCH(SLOT) do { if (threadIdx.x == 0) { int tm_ = q_team, kk_ = -1; \
      for (int tries_ = 0; tries_ < 8; ++tries_) { \
        const unsigned v_ = __hip_atomic_fetch_add(qctr + 16 * tm_, 1u, __ATOMIC_RELAXED, __HIP_MEMORY_SCOPE_AGENT); \
        if (v_ < (unsigned)QN) { kk_ = (tm_ << 16) | (int)v_; break; } \
        tm_ = (tm_ + 1) & 7; } \
      q_team = tm_; qslot[SLOT] = kk_; } } while (0)
  int q_team = my_team;
  Q_FETCH(0);
  __syncthreads();
  int k = qslot[0];
  int par = 1;
  while (k >= 0) {
    Q_FETCH(par);
    const int bt = k >> 16, kl = k & 0xffff;
    const int kq = kl / 17, kr = kl - kq * 17;
    if (kr < 16) {
      const int tb = 511 - (kq * 16 + kr);
      dsa_item(p, smem, (bt << 9) | tb);
    } else {
      const int r0 = (bt * 32 + kq) * 64;
      quantize_rows_u8<false, true>(p.peer_u, p.ws + WS_U, (float*)(p.ws + WS_U + (size_t)16384 * 1024), r0, r0 + 64);
      quantize_rows_u8<true, true>(p.peer_v, p.ws + WS_V, (float*)(p.ws + WS_V + (size_t)16384 * 1024), r0, r0 + 64);
      __syncthreads();
    }
    k = qslot[par];
    par ^= 1;
  }
#undef Q_FETCH
}

__device__ __forceinline__ void phase_pkeys(const Params& p, unsigned char* smem) {
  unsigned char* ws = p.ws;
  const bf16_t* qp = (const bf16_t*)(ws + WS_PG);
  const bf16_t* keys = (const bf16_t*)(ws + WS_KEYS);
  int* eidx = (int*)(ws + WS_EIDX);
  float* gw = (float*)(ws + WS_GW);
  float* sc = (float*)smem;
  float* s2l = (float*)smem;
  unsigned short* i1l = (unsigned short*)(s2l + 256 * 17);
  unsigned short* i2l = i1l + 256 * 16;
  const int tid = threadIdx.x, lane = tid & 63, w = tid >> 6, wm = w >> 1, wn = w & 1, l15 = lane & 15, g = lane >> 4;
  for (int item = blockIdx.x; item < 128 * 8; item += gridDim.x) {
    const int h = item & 7, tm = item >> 3;
    float s1[16], s2v[16]; int i1[16], i2[16];
#pragma unroll
    for (int ph = 0; ph < 2; ++ph) {
      const int hp = h * 2 + ph;
      f32x4 acc[4][4]; zero_acc(acc);
      gemm_tile(qp + (size_t)tm * 256 * 2048 + hp * 128, 2048, keys + (size_t)(ph * 8 + h) * 128 * 128, 128, 2, acc, smem);
      __syncthreads();
#pragma unroll
      for (int m = 0; m < 4; ++m)
#pragma unroll
        for (int n = 0; n < 4; ++n)
#pragma unroll
          for (int j = 0; j < 4; ++j) sc[(wm * 64 + m * 16 + 4 * g + j) * 129 + wn * 64 + n * 16 + l15] = acc[m][n][j];
      __syncthreads();
      if (tid < 256) {
        const float* rowp = sc + tid * 129;
        unsigned tv[16];
#pragma unroll
        for (int k = 0; k < 16; ++k) tv[k] = 0u;
#pragma unroll 8
        for (int nn = 0; nn < 128; ++nn) {
          const unsigned bits = __float_as_uint(rowp[nn]);
          unsigned key = (bits & 0x80000000u) ? ~bits : (bits | 0x80000000u);
          key = (key & ~127u) | (unsigned)(127 - nn);
#pragma unroll
          for (int k = 15; k >= 1; --k) {
            unsigned r;
            asm("v_med3_u32 %0, %1, %2, %3" : "=v"(r) : "v"(tv[k]), "v"(tv[k - 1]), "v"(key));
            tv[k] = r;
          }
          tv[0] = tv[0] > key ? tv[0] : key;
        }
#pragma unroll
        for (int k = 0; k < 16; ++k) {
          const int col = 127 - (int)(tv[k] & 127u);
          const float val = rowp[col];
          if (ph == 0) { i1[k] = col; s1[k] = val; } else { i2[k] = col; s2v[k] = val; }
        }
      }
      __syncthreads();
    }
    if (tid < 256) {
#pragma unroll
      for (int a = 0; a < 16; ++a) { s2l[tid * 17 + a] = s2v[a]; i1l[tid * 16 + a] = (unsigned short)i1[a]; i2l[tid * 16 + a] = (unsigned short)i2[a]; }
      float cur[16];
#pragma unroll
      for (int a = 0; a < 16; ++a) cur[a] = s1[a] + s2v[0];
      unsigned long long ptr = 0ull;
      float tops[16]; int tope[16];
#pragma unroll
      for (int k = 0; k < 16; ++k) {
        float best = cur[0]; int ba = 0;
#pragma unroll
        for (int a = 1; a < 16; ++a) if (cur[a] > best) { best = cur[a]; ba = a; }
        const int bb = (int)((ptr >> (4 * ba)) & 15ull);
        tops[k] = best;
        tope[k] = (int)i1l[tid * 16 + ba] * 128 + (int)i2l[tid * 16 + bb];
        const int nb = bb + 1;
        const float ns2 = (nb < 16) ? s2l[tid * 17 + nb] : -INFINITY;
        if (nb < 16) ptr += (1ull << (4 * ba));
#pragma unroll
        for (int a = 0; a < 16; ++a) if (a == ba) cur[a] = s1[a] + ns2;
      }
      const float m = tops[0];
      float sum = 0.f;
#pragma unroll
      for (int k = 0; k < 16; ++k) { tops[k] = __expf(tops[k] - m); sum += tops[k]; }
      const float inv = 1.f / sum;
      const size_t ob = ((size_t)(tm * 256 + tid) * 8 + h) * 16;
#pragma unroll
      for (int k = 0; k < 16; k += 4) {
        *(int4*)(eidx + ob + k) = make_int4(tope[k], tope[k + 1], tope[k + 2], tope[k + 3]);
        *(float4*)(gw + ob + k) = make_float4(tops[k] * inv, tops[k + 1] * inv, tops[k + 2] * inv, tops[k + 3] * inv);
      }
    }
    __syncthreads();
  }
}


__device__ __forceinline__ float reduce8(const float (&pv)[8], int lane) {
  const bool b5 = lane & 32, b4 = lane & 16, b3 = lane & 8;
  float v[4];
#pragma unroll
  for (int i = 0; i < 4; ++i) {
    const float keep = b5 ? pv[4 + i] : pv[i];
    const float send = b5 ? pv[i] : pv[4 + i];
    v[i] = keep + __shfl_xor(send, 32);
  }
  float u[2];
#pragma unroll
  for (int i = 0; i < 2; ++i) {
    const float keep = b4 ? v[2 + i] : v[i];
    const float send = b4 ? v[i] : v[2 + i];
    u[i] = keep + __shfl_xor(send, 16);
  }
  float x = (b3 ? u[1] : u[0]) + __shfl_xor(b3 ? u[0] : u[1], 8);
  x += __shfl_xor(x, 4); x += __shfl_xor(x, 2); x += __shfl_xor(x, 1);
  return x;
}

__device__ __forceinline__ void cvt16u8(const uint4& v, float* f) {
  f[0] = (float)(v.x & 0xffu); f[1] = (float)((v.x >> 8) & 0xffu); f[2] = (float)((v.x >> 16) & 0xffu); f[3] = (float)(v.x >> 24);
  f[4] = (float)(v.y & 0xffu); f[5] = (float)((v.y >> 8) & 0xffu); f[6] = (float)((v.y >> 16) & 0xffu); f[7] = (float)(v.y >> 24);
  f[8] = (float)(v.z & 0xffu); f[9] = (float)((v.z >> 8) & 0xffu); f[10] = (float)((v.z >> 16) & 0xffu); f[11] = (float)(v.z >> 24);
  f[12] = (float)(v.w & 0xffu); f[13] = (float)((v.w >> 8) & 0xffu); f[14] = (float)((v.w >> 16) & 0xffu); f[15] = (float)(v.w >> 24);
}

__device__ __forceinline__ int wave_sum_i32_dpp(int v) {
  v += __builtin_amdgcn_update_dpp(0, v, 0xB1, 0xf, 0xf, true);
  v += __builtin_amdgcn_update_dpp(0, v, 0x4E, 0xf, 0xf, true);
  v += __builtin_amdgcn_update_dpp(0, v, 0x141, 0xf, 0xf, true);
  v += __builtin_amdgcn_update_dpp(0, v, 0x140, 0xf, 0xf, true);
  return __builtin_amdgcn_readlane(v, 0) + __builtin_amdgcn_readlane(v, 16) + __builtin_amdgcn_readlane(v, 32) + __builtin_amdgcn_readlane(v, 48);
}

__device__ __forceinline__ int reduce8_i32_scatter(const int (&d)[8], int lane) {
  const bool b0 = lane & 1, b1 = lane & 2, b2 = lane & 4;
  int v[4];
#pragma unroll
  for (int i = 0; i < 4; ++i) {
    const int keep = b0 ? d[2 * i + 1] : d[2 * i];
    const int send = b0 ? d[2 * i] : d[2 * i + 1];
    v[i] = keep + __builtin_amdgcn_update_dpp(0, send, 0xB1, 0xf, 0xf, true);
  }
  int u[2];
#pragma unroll
  for (int i = 0; i < 2; ++i) {
    const int keep = b1 ? v[2 * i + 1] : v[2 * i];
    const int send = b1 ? v[2 * i] : v[2 * i + 1];
    u[i] = keep + __builtin_amdgcn_update_dpp(0, send, 0x4E, 0xf, 0xf, true);
  }
  int x;
  {
    const int keep = b2 ? u[1] : u[0];
    const int send = b2 ? u[0] : u[1];
    int t = __builtin_amdgcn_update_dpp(0, send, 0x141, 0xf, 0xf, true);
    t = __builtin_amdgcn_update_dpp(0, t, 0x1B, 0xf, 0xf, true);
    x = keep + t;
  }
  x += __builtin_amdgcn_update_dpp(0, x, 0x128, 0xf, 0xf, true);
  { const auto r = __builtin_amdgcn_permlane16_swap((unsigned)x, (unsigned)x, false, false); x = (int)r[0] + (int)r[1]; }
  { const auto r = __builtin_amdgcn_permlane32_swap((unsigned)x, (unsigned)x, false, false); x = (int)r[0] + (int)r[1]; }
  return x;
}

__device__ __forceinline__ void phase_pu(const Params& p, unsigned char* smem) {
  unsigned char* ws = p.ws;
  const unsigned char* XQ = ws + WS_XQ;
  const float* xs = (const float*)(ws + WS_XS);
  const unsigned char* U8 = ws + WS_U;
  const float* us = (const float*)(ws + WS_U + (size_t)16384 * 1024);
  const float* vs = (const float*)(ws + WS_V + (size_t)16384 * 1024);
  const int* eidx = (const int*)(ws + WS_EIDX);
  const float* gw = (const float*)(ws + WS_GW);
  float* aw = (float*)(ws + WS_PA);
  const int lane = threadIdx.x & 63, w = threadIdx.x >> 6;
  const unsigned long long lt_mask = (1ull << lane) - 1ull;
  const int G = gridDim.x;
  const bool sliced = (G % 8 == 0);
  const int ti = sliced ? team_index(p, smem) : 0;
  const int tsz = sliced ? (G >> 3) : G;
  const int grp_lo = sliced ? ti / tsz : 0, grp_hi = sliced ? grp_lo + 1 : 8;
  const int slot = (sliced ? (ti % tsz) : (int)blockIdx.x) * 8 + w;
  const int nslot = tsz * 8;
  unsigned* lst = (unsigned*)smem + 4096 + w * 128;
  typedef unsigned u32x4_t __attribute__((ext_vector_type(4)));
  if (slot >= TOK) return;
  for (int grp = grp_lo; grp < grp_hi; ++grp) {
#define PU_LIST(E0, E1, N, L0, L1) do { \
      const bool m0_ = ((E0) >> 11) == grp, m1_ = ((E1) >> 11) == grp; \
      const unsigned long long b0_ = __ballot(m0_), b1_ = __ballot(m1_); \
      const int c0_ = __popcll(b0_); N = c0_ + __popcll(b1_); \
      if (m0_) lst[__popcll(b0_ & lt_mask)] = ((unsigned)lane << 14) | (unsigned)(E0); \
      if (m1_) lst[c0_ + __popcll(b1_ & lt_mask)] = ((unsigned)(lane + 64) << 14) | (unsigned)(E1); \
      lds_fence(); \
      L0 = (lane < N) ? lst[lane] : 0u; L1 = (lane + 64 < N) ? lst[lane + 64] : 0u; \
      lds_fence(); } while (0)
#define PU_ISSUE(BUF, L0, N, I0) do { int last_ = ((N) < 64 ? (N) : 64) - 1; last_ = last_ < 0 ? 0 : last_; \
      _Pragma("unroll") for (int j = 0; j < 8; ++j) { int idx_ = (I0) + j; idx_ = idx_ < last_ ? idx_ : last_; \
        const unsigned le_ = (unsigned)__builtin_amdgcn_readlane((int)(L0), idx_); \
        BUF[j] = *(const u32x4_t*)(U8 + (size_t)(le_ & 16383u) * 1024 + lane * 16); } } while (0)
#define PU_REDUCE(BUF, X, I0, HREG) do { int dd_[8]; _Pragma("unroll") for (int j = 0; j < 8; ++j) { \
        int d_ = __builtin_amdgcn_sdot4((int)BUF[j].x, (int)(X).x, 0, false); \
        d_ = __builtin_amdgcn_sdot4((int)BUF[j].y, (int)(X).y, d_, false); \
        d_ = __builtin_amdgcn_sdot4((int)BUF[j].z, (int)(X).z, d_, false); \
        dd_[j] = __builtin_amdgcn_sdot4((int)BUF[j].w, (int)(X).w, d_, false); } \
      const int tot_ = reduce8_i32_scatter(dd_, lane);     \
      if (lane >= (I0) && lane < (I0) + 8) HREG = tot_; } while (0)
    u32x4_t cx = *(const u32x4_t*)(XQ + (size_t)slot * 1024 + lane * 16);
    int ce0 = eidx[(size_t)slot * 128 + lane], ce1 = eidx[(size_t)slot * 128 + 64 + lane];
    float cxs = xs[slot];
    int cn; unsigned cl0, cl1;
    PU_LIST(ce0, ce1, cn, cl0, cl1);
    u32x4_t ra[8], rb[8], rc[8];
    PU_ISSUE(ra, cl0, cn, 0);
    PU_ISSUE(rb, cl0, cn, 8);
    int t1 = (slot + nslot < TOK) ? slot + nslot : slot;
    u32x4_t nx = *(const u32x4_t*)(XQ + (size_t)t1 * 1024 + lane * 16);
    int ne0 = eidx[(size_t)t1 * 128 + lane], ne1 = eidx[(size_t)t1 * 128 + 64 + lane];
    float nxs = xs[t1];
    for (int tok = slot; tok < TOK; tok += nslot) {
      float sc0 = 0.f, sc1 = 0.f, gv0 = 0.f, gv1 = 0.f, vv0 = 0.f, vv1 = 0.f;
      if (lane < cn) { const int e = cl0 & 16383; sc0 = us[e]; vv0 = vs[e]; gv0 = gw[(size_t)tok * 128 + (cl0 >> 14)]; }
      if (lane + 64 < cn) { const int e = cl1 & 16383; sc1 = us[e]; vv1 = vs[e]; gv1 = gw[(size_t)tok * 128 + (cl1 >> 14)]; }
      int nn; unsigned nl0, nl1;
      PU_LIST(ne0, ne1, nn, nl0, nl1);
      const u32x4_t x1 = nx; const int xe0 = ne0, xe1 = ne1; const float xs1 = nxs;
      const int t2a = tok + nslot, t2 = (t2a + nslot < TOK) ? t2a + nslot : ((t2a < TOK) ? t2a : tok);
      nx = *(const u32x4_t*)(XQ + (size_t)t2 * 1024 + lane * 16);
      ne0 = eidx[(size_t)t2 * 128 + lane]; ne1 = eidx[(size_t)t2 * 128 + 64 + lane];
      nxs = xs[t2];
      int h0i = 0, h1i = 0;
      const bool third = cn > 16;
      if (third) { PU_ISSUE(rc, cl0, cn, 16); }
      __builtin_amdgcn_sched_barrier(0); PU_REDUCE(ra, cx, 0, h0i);  __builtin_amdgcn_sched_barrier(0);
      PU_ISSUE(ra, nl0, nn, 0);  __builtin_amdgcn_sched_barrier(0); PU_REDUCE(rb, cx, 8, h0i);  __builtin_amdgcn_sched_barrier(0);
      PU_ISSUE(rb, nl0, nn, 8);  __builtin_amdgcn_sched_barrier(0);
      if (third) { PU_REDUCE(rc, cx, 16, h0i); }
      __builtin_amdgcn_sched_barrier(0);
      if (cn > 24) {
        for (int i0 = 24; i0 < cn; i0 += 8) {
          u32x4_t rd[8];
          const bool lo = i0 < 64;
          const unsigned lsrc = lo ? cl0 : cl1;
          const int nsrc = lo ? cn : cn - 64;
          PU_ISSUE(rd, lsrc, nsrc, i0 & 63);
          if (lo) { PU_REDUCE(rd, cx, i0, h0i); } else { PU_REDUCE(rd, cx, i0 - 64, h1i); }
        }
      }
      const float h0 = (float)h0i * sc0 * cxs, h1 = (float)h1i * sc1 * cxs;
      if (lane < cn) aw[(size_t)tok * 128 + (cl0 >> 14)] = 0.5f * h0 * (1.f + erff(h0 * 0.70710678118654752f)) * gv0 * vv0;
      if (lane + 64 < cn) aw[(size_t)tok * 128 + (cl1 >> 14)] = 0.5f * h1 * (1.f + erff(h1 * 0.70710678118654752f)) * gv1 * vv1;
      cx = x1; ce0 = xe0; ce1 = xe1; cxs = xs1; cn = nn; cl0 = nl0; cl1 = nl1;
    }
#undef PU_LIST
#undef PU_ISSUE
#undef PU_REDUCE
  }
}

template <bool SL>
__device__ __forceinline__ void phase_pv_t(const Params& p, unsigned char* smem) {
  unsigned char* ws = p.ws;
  const unsigned char* V8 = ws + WS_V;
  const int* eidx = (const int*)(ws + WS_EIDX);
  const float* aw = (const float*)(ws + WS_PA);
  float* ssq = (float*)(ws + WS_SSQ);
  const int lane = threadIdx.x & 63, w = threadIdx.x >> 6;
  const int q = lane >> 3, c = lane & 7;
  const int G = gridDim.x;
  constexpr bool sliced = SL;
  const int ti = sliced ? team_index(p, smem) : 0;
  const int tsz = G >> 3;
  const int grp0 = sliced ? (ti / tsz) : 0;
  constexpr int ngrp = sliced ? 1 : 8;
  const int slot = sliced ? (ti % tsz) * 8 + w : blockIdx.x * 8 + w;
  const int nslot = sliced ? tsz * 8 : G * 8;
  int ee[16]; float aa[16];
  if (slot < TOK) {
    unsigned bi = (unsigned)slot * 128u + 16u * (unsigned)q;
    asm volatile("" : "+v"(bi));
#pragma unroll
    for (int u4 = 0; u4 < 4; ++u4) {
      const int4 e4 = *(const int4*)(eidx + bi + 4 * u4); const float4 a4 = *(const float4*)(aw + bi + 4 * u4);
      ee[4 * u4] = e4.x; ee[4 * u4 + 1] = e4.y; ee[4 * u4 + 2] = e4.z; ee[4 * u4 + 3] = e4.w;
      aa[4 * u4] = a4.x; aa[4 * u4 + 1] = a4.y; aa[4 * u4 + 2] = a4.z; aa[4 * u4 + 3] = a4.w;
    }
  }
  for (int tok = slot; tok < TOK; tok += nslot) {
    int ce[16]; float ca[16];
    float suma = 0.f;
#pragma unroll
    for (int u = 0; u < 16; ++u) { ce[u] = ee[u]; ca[u] = aa[u]; suma += aa[u]; }
    for (int gi = 0; gi < ngrp; ++gi) {
      const int grp = grp0 + gi;
      uint4 vv[16];
#pragma unroll
      for (int u = 0; u < 16; ++u) vv[u] = *(const uint4*)(V8 + (size_t)grp * (16384 * 128) + (size_t)ce[u] * 128 + c * 16);
      float* orow = p.out + (size_t)tok * 1024 + grp * 128 + c * 16;
      float4 x1v[4];
#pragma unroll
      for (int i = 0; i < 4; ++i) x1v[i] = *(const float4*)(orow + 4 * i);
      if (gi == ngrp - 1) {
        const int nt = (tok + nslot < TOK) ? tok + nslot : tok;
        unsigned bi = (unsigned)nt * 128u + 16u * (unsigned)q;
        asm volatile("" : "+v"(bi));
#pragma unroll
        for (int u4 = 0; u4 < 4; ++u4) {
          const int4 e4 = *(const int4*)(eidx + bi + 4 * u4); const float4 a4 = *(const float4*)(aw + bi + 4 * u4);
          ee[4 * u4] = e4.x; ee[4 * u4 + 1] = e4.y; ee[4 * u4 + 2] = e4.z; ee[4 * u4 + 3] = e4.w;
          aa[4 * u4] = a4.x; aa[4 * u4 + 1] = a4.y; aa[4 * u4 + 2] = a4.z; aa[4 * u4 + 3] = a4.w;
        }
      }
      __builtin_amdgcn_sched_barrier(0);
      float acc[16];
#pragma unroll
      for (int i = 0; i < 16; ++i) acc[i] = -128.f * suma;
#pragma unroll
      for (int u = 0; u < 16; ++u) {
        float vf[16];
        cvt16u8(vv[u], vf);
#pragma unroll
        for (int i = 0; i < 16; ++i) acc[i] += ca[u] * vf[i];
        __builtin_amdgcn_sched_barrier(0);
      }
#pragma unroll
      for (int i = 0; i < 16; ++i) { acc[i] = add_xor8(acc[i]); acc[i] = add_xor16(acc[i]); acc[i] = add_xor32(acc[i]); }
      float ss = 0.f;
      if (q == 0) {
#pragma unroll
        for (int i = 0; i < 4; ++i) {
          const float4 oa = make_float4(x1v[i].x + acc[4 * i], x1v[i].y + acc[4 * i + 1], x1v[i].z + acc[4 * i + 2], x1v[i].w + acc[4 * i + 3]);
          *(float4*)(orow + 4 * i) = oa;
          ss += oa.x * oa.x + oa.y * oa.y + oa.z * oa.z + oa.w * oa.w;
        }
      }
      ss += __shfl_xor(ss, 1); ss += __shfl_xor(ss, 2); ss += __shfl_xor(ss, 4);
      if (lane == 0) atomicAdd(&ssq[tok], ss);
    }
  }
}

__device__ __forceinline__ void phase_pv_mfma(const Params& p, unsigned char* smem) {
  unsigned char* ws = p.ws;
  const unsigned char* V8 = ws + WS_V;
  const int* eidx = (const int*)(ws + WS_EIDX);
  const float* aw = (const float*)(ws + WS_PA);
  float* ssq = (float*)(ws + WS_SSQ);
  const int lane = threadIdx.x & 63, w = threadIdx.x >> 6;
  const int q8 = lane >> 3, c = lane & 7;
  const int l15 = lane & 15, g = lane >> 4;
  const int G = gridDim.x;
  const bool sliced = (G % 8 == 0);
  const int ti = sliced ? team_index(p, smem) : 0;
  const int tsz = sliced ? (G >> 3) : G;
  const int grp_lo = sliced ? ti / tsz : 0, grp_hi = sliced ? grp_lo + 1 : 8;
  const int slot = (sliced ? (ti % tsz) : (int)blockIdx.x) * 8 + w;
  const int nslot = tsz * 8;
  if (slot >= TOK) return;
  unsigned char* vs_l = smem + 16384 + w * 16384;
  typedef unsigned u32x4_t __attribute__((ext_vector_type(4)));
  typedef float f32x4_t __attribute__((ext_vector_type(4)));
  typedef int i32x4_t __attribute__((ext_vector_type(4)));
  typedef int i32x2_t __attribute__((ext_vector_type(2)));
  const unsigned tr_lane = (unsigned)((l15 >> 1) * 128 + (l15 & 1) * 8);
  for (int grp = grp_lo; grp < grp_hi; ++grp) {
    const unsigned char* Vg = V8 + (size_t)grp * (16384 * 128) + c * 16;
    i32x4_t ee[4]; f32x4_t aa[8];
#define PVM_META(TOKEN) do { \
      const i32x4_t* ep_ = (const i32x4_t*)(eidx + (size_t)(TOKEN) * 128 + 16 * q8); \
      _Pragma("unroll") for (int u4 = 0; u4 < 4; ++u4) ee[u4] = ep_[u4]; \
      const f32x4_t* ap_ = (const f32x4_t*)(aw + (size_t)(TOKEN) * 128 + 16 * g); \
      _Pragma("unroll") for (int u4 = 0; u4 < 4; ++u4) { aa[u4] = ap_[u4]; aa[4 + u4] = ap_[16 + u4]; } } while (0)
    PVM_META(slot);
    for (int tok = slot; tok < TOK; tok += nslot) {
      u32x4_t vv[16];
#pragma unroll
      for (int u = 0; u < 16; ++u) vv[u] = *(const u32x4_t*)(Vg + (size_t)ee[u >> 2][u & 3] * 128);
      float* orow = p.out + (size_t)tok * 1024 + grp * 128 + l15;
      float x1v[8];
#pragma unroll
      for (int nt = 0; nt < 8; ++nt) x1v[nt] = orow[nt * 16];
      float am = 0.f;
#pragma unroll
      for (int i = 0; i < 8; ++i) am = fmaxf(am, fmaxf(fmaxf(fabsf(aa[i].x), fabsf(aa[i].y)), fmaxf(fabsf(aa[i].z), fabsf(aa[i].w))));
      am = max_xor16(am); am = max_xor32(am);
      const float inva = am > 0.f ? 127.f / am : 0.f, sa = am * (1.f / 127.f);
      i32x4_t aop[2];
#pragma unroll
      for (int s2 = 0; s2 < 2; ++s2)
#pragma unroll
        for (int d4 = 0; d4 < 4; ++d4) {
          const f32x4_t a4 = aa[4 * s2 + d4];
          const unsigned b0 = (unsigned)(int)rintf(a4.x * inva) & 255u, b1 = (unsigned)(int)rintf(a4.y * inva) & 255u;
          const unsigned b2 = (unsigned)(int)rintf(a4.z * inva) & 255u, b3 = (unsigned)(int)rintf(a4.w * inva) & 255u;
          aop[s2][d4] = (int)(b0 | (b1 << 8) | (b2 << 16) | (b3 << 24));
        }
      { const int nt_ = (tok + nslot < TOK) ? tok + nslot : tok; PVM_META(nt_); }
      __builtin_amdgcn_sched_barrier(0);
#pragma unroll
      for (int u = 0; u < 16; ++u) *(u32x4_t*)(vs_l + (16 * q8 + u) * 128 + c * 16) = vv[u];
      lds_fence();
      i32x4_t acc[8];
#pragma unroll
      for (int nt = 0; nt < 8; ++nt) acc[nt] = (i32x4_t){0, 0, 0, 0};
#pragma unroll
      for (int s2 = 0; s2 < 2; ++s2)
#pragma unroll
        for (int nt = 0; nt < 8; ++nt) {
          const unsigned a0 = (unsigned)((s2 * 64 + 16 * g) * 128 + nt * 16) + tr_lane;
          const i32x2_t lo = __builtin_amdgcn_ds_read_tr8_b64_v2i32((__attribute__((address_space(3))) i32x2_t*)(vs_l + a0));
          const i32x2_t hi = __builtin_amdgcn_ds_read_tr8_b64_v2i32((__attribute__((address_space(3))) i32x2_t*)(vs_l + a0 + 8 * 128));
          const i32x4_t bop = {lo[0], lo[1], hi[0], hi[1]};
          acc[nt] = __builtin_amdgcn_mfma_i32_16x16x64_i8(aop[s2], bop, acc[nt], 0, 0, 0);
        }
      lds_fence();
      float ss = 0.f;
      if (g == 0) {
#pragma unroll
        for (int nt = 0; nt < 8; ++nt) { const float o = x1v[nt] + (float)acc[nt][0] * sa; orow[nt * 16] = o; ss += o * o; }
      }
      ss += __int_as_float(__builtin_amdgcn_update_dpp(0, __float_as_int(ss), 0xB1, 0xf, 0xf, true));
      ss += __int_as_float(__builtin_amdgcn_update_dpp(0, __float_as_int(ss), 0x4E, 0xf, 0xf, true));
      ss += __int_as_float(__builtin_amdgcn_update_dpp(0, __float_as_int(ss), 0x141, 0xf, 0xf, true));
      ss += __int_as_float(__builtin_amdgcn_update_dpp(0, __float_as_int(ss), 0x140, 0xf, 0xf, true));
      if (lane == 0) atomicAdd(&ssq[tok], ss);
    }
#undef PVM_META
  }
}

__device__ __forceinline__ void phase_final(const Params& p) {
  const float* ssq = (const float*)(p.ws + WS_SSQ);
  const int lane = threadIdx.x & 63, w = threadIdx.x >> 6;
  for (int row = blockIdx.x * 8 + w; row < TOK; row += gridDim.x * 8) {
    const float rstd = rsqrtf(ssq[row] * (1.f / DM) + EPSV);
    float4* o4 = (float4*)(p.out + (size_t)row * DM);
#pragma unroll
    for (int i = 0; i < 4; ++i) {
      float4 v = o4[lane + 64 * i];
      const float4 gg = ((const float4*)p.norm_final)[lane + 64 * i];
      v.x *= rstd * gg.x; v.y *= rstd * gg.y; v.z *= rstd * gg.z; v.w *= rstd * gg.w;
      o4[lane + 64 * i] = v;
    }
  }
}


__device__ __forceinline__ void phase_proj8(const Params& p, unsigned char* smem) {
  unsigned char* ws = p.ws;
  pg8::Gemm g{(const pg8::bf16_t*)(ws + WS_XN), (const pg8::bf16_t*)(ws + WS_WIN), TOK, 5120, 1024};
  pg8::StaticOrder S; S.init(TOK, 5120, (int)gridDim.x, (int)blockIdx.x);
  EpiProj E{(unsigned short*)(ws + WS_PH), (unsigned short*)(ws + WS_PA), (unsigned short*)(ws + WS_PG),
            (unsigned short*)(ws + WS_KC), (unsigned short*)(ws + WS_VC), (unsigned short*)(ws + WS_IKC)};
  pg8::gemm_phase<EpiProj, pg8::StaticOrder>((PG8_LAS unsigned char*)smem, g, S, E, nullptr);
}
__device__ __forceinline__ void phase_ikln(const Params& p) {
  bf16_t* ikc = (bf16_t*)(p.ws + WS_IKC);
  const int tid = threadIdx.x, sub = tid & 7;
  float gam[8], bet[8];
#pragma unroll
  for (int i = 0; i < 8; ++i) { gam[i] = p.ikg[sub * 8 + i]; bet[i] = p.ikb[sub * 8 + i]; }
  for (int row = blockIdx.x * 64 + (tid >> 3); row < TOK; row += gridDim.x * 64) {
    uint4* ptr = (uint4*)(ikc + (size_t)row * 64 + sub * 8);
    const uint4 raw = *ptr;
    float v[8];
    cvt8(raw, v);
    float s = 0.f;
#pragma unroll
    for (int i = 0; i < 8; ++i) s += v[i];
    s += __shfl_xor(s, 1); s += __shfl_xor(s, 2); s += __shfl_xor(s, 4);
    const float mu = s * (1.f / 64.f);
    float q = 0.f;
#pragma unroll
    for (int i = 0; i < 8; ++i) { const float d = v[i] - mu; q += d * d; }
    q += __shfl_xor(q, 1); q += __shfl_xor(q, 2); q += __shfl_xor(q, 4);
    const float rstd = rsqrtf(q * (1.f / 64.f) + EPSV);
    uint4 o;
    o.x = pack2((v[0] - mu) * rstd * gam[0] + bet[0], (v[1] - mu) * rstd * gam[1] + bet[1]);
    o.y = pack2((v[2] - mu) * rstd * gam[2] + bet[2], (v[3] - mu) * rstd * gam[3] + bet[3]);
    o.z = pack2((v[4] - mu) * rstd * gam[4] + bet[4], (v[5] - mu) * rstd * gam[5] + bet[5]);
    o.w = pack2((v[6] - mu) * rstd * gam[6] + bet[6], (v[7] - mu) * rstd * gam[7] + bet[7]);
    *ptr = o;
  }
}
__device__ __forceinline__ void phase_up8(const Params& p, unsigned char* smem) {
  unsigned char* ws = p.ws;
  pg8::Gemm g{(const pg8::bf16_t*)(ws + WS_XN), (const pg8::bf16_t*)(ws + WS_WUPA), TOK, 1024, 1024};
  pg8::StaticOrder S; S.init(TOK, 1024, (int)gridDim.x, (int)blockIdx.x);
  EpiGate2 E{(unsigned short*)(ws + WS_PH), (const unsigned short*)(ws + WS_PG)};
  pg8::gemm_phase<EpiGate2, pg8::StaticOrder>((PG8_LAS unsigned char*)smem, g, S, E, nullptr);
}
__device__ __forceinline__ void phase_out8(const Params& p, unsigned char* smem) {
  unsigned char* ws = p.ws;
  pg8::Gemm g{(const pg8::bf16_t*)(ws + WS_PH), (const pg8::bf16_t*)(ws + WS_WOUT), TOK, 1024, 1024};
  pg8::StaticOrder S; S.init(TOK, 1024, (int)gridDim.x, (int)blockIdx.x);
  EpiResid E{p.out, p.x};
  pg8::gemm_phase<EpiResid, pg8::StaticOrder>((PG8_LAS unsigned char*)smem, g, S, E, nullptr);
}
__device__ __forceinline__ void phase_pq8(const Params& p, unsigned char* smem) {
  unsigned char* ws = p.ws;
  pg8::Gemm g{(const pg8::bf16_t*)(ws + WS_XN), (const pg8::bf16_t*)(ws + WS_WQ), TOK, 2048, 1024};
  pg8::StaticOrder S; S.init(TOK, 2048, (int)gridDim.x, (int)blockIdx.x);
  EpiStoreBf16 E{(unsigned short*)(ws + WS_PG), 2048};
  pg8::gemm_phase<EpiStoreBf16, pg8::StaticOrder>((PG8_LAS unsigned char*)smem, g, S, E, nullptr);
}

__global__ void __launch_bounds__(NTHREADS) hybrid_fwd(Params p) {
  extern __shared__ __attribute__((aligned(16))) unsigned char smem[];
#if ONE_LAUNCH
  cg::grid_group grid = cg::this_grid();
  volatile LAS unsigned* xst = (volatile LAS unsigned*)(smem + LDS_BYTES - 16);
  if (threadIdx.x == 0) { xst[0] = 0u; xst[1] = 0u; }
  __syncthreads();
  XcdBarrier xbar = xcd_barrier_post((unsigned*)(p.ws + WS_BAR), xst);
#define SEAM(k) do { if (p.ph_lo <= (k) && (k) + 1 < p.ph_hi) { if (p.ph_hi > NPHASE) grid.sync(); else xcd_barrier(xbar); } } while (0)
#else
#define SEAM(k) do { } while (0)
#endif
#define IN(k) (p.ph_lo <= (k) && (k) < p.ph_hi)
#ifndef REPEAT_PH
#define REPEAT_PH -1
#endif
#define REP(k, stmt) do { if (REPEAT_PH == (k)) { stmt; grid.sync(); } } while (0)
  if (IN(0)) { phase_prep(p, smem); SEAM(0); }
  if (IN(1)) { phase_proj8(p, smem); SEAM(1); }
  if (IN(2)) { phase_ikln(p); hgrn_h1_all(p, smem); SEAM(2); }
  if (IN(3)) { phase_mix(p, smem); SEAM(3); }
  if (IN(4)) { phase_up8(p, smem); SEAM(4); }
  if (IN(5)) { phase_out8(p, smem); SEAM(5); }
  if (IN(6)) { rmsnorm_rows_q(p.out, p.norm_ffn, (bf16_t*)(p.ws + WS_XN), p.ws + WS_XQ, (float*)(p.ws + WS_XS)); SEAM(6); }
  if (IN(7)) { phase_pq8(p, smem); SEAM(7); }
  if (IN(8)) { phase_pkeys(p, smem); SEAM(8); }
  if (IN(9)) { phase_pu(p, smem); SEAM(9); }
  if (IN(10)) { phase_pv_mfma(p, smem); SEAM(10); }
  if (IN(11)) { phase_final(p); }
#undef IN
#undef SEAM
}

extern "C" void kernel_launch(void* const* d_in, const int* in_sizes, int n_in, void* d_out, int out_size, void* d_ws, size_t ws_size,
                              hipStream_t stream) {
  static int grid = 0;
  if (grid == 0) {
    if (n_in != 17 || ws_size < WS_END) {
      fprintf(stderr, "kernel_launch: unexpected n_in %d or ws_size %zu (need %zu)\n", n_in, ws_size, (size_t)WS_END);
      grid = -1; return;
    }
    int dev = 0, cus = 0, per_cu = 0;
    hipGetDevice(&dev);
    hipDeviceGetAttribute(&cus, hipDeviceAttributeMultiprocessorCount, dev);
    hipFuncSetAttribute((const void*)hybrid_fwd, hipFuncAttributeMaxDynamicSharedMemorySize, LDS_BYTES);
    hipOccupancyMaxActiveBlocksPerMultiprocessor(&per_cu, (const void*)hybrid_fwd, NTHREADS, LDS_BYTES);
    if (per_cu < 1) { fprintf(stderr, "kernel_launch: occupancy query says %d blocks/CU\n", per_cu); per_cu = 1; }
    (void)hipGetLastError();
    grid = cus;
  }
  if (grid < 0) return;
  Params p{};
  p.x = (const float*)d_in[0]; p.norm_mix = (const float*)d_in[1]; p.w_in = (const float*)d_in[2]; p.hg_lb = (const float*)d_in[3];
  p.hg_norm = (const float*)d_in[4]; p.ikg = (const float*)d_in[5]; p.ikb = (const float*)d_in[6]; p.rel_bias = (const float*)d_in[7];
  p.w_up_a = (const float*)d_in[8]; p.w_up_b = (const float*)d_in[9]; p.w_out = (const float*)d_in[10]; p.norm_ffn = (const float*)d_in[11];
  p.peer_wq = (const float*)d_in[12]; p.peer_keys = (const float*)d_in[13]; p.peer_u = (const float*)d_in[14]; p.peer_v = (const float*)d_in[15];
  p.norm_final = (const float*)d_in[16];
  p.out = (float*)d_out; p.ws = (unsigned char*)d_ws;
#if ONE_LAUNCH
  hipMemsetAsync((unsigned char*)d_ws + WS_BAR, 0, 16384, stream);
  p.ph_lo = 0; p.ph_hi = NPHASE;
  void* args[] = {&p};
  hipError_t e = hipLaunchCooperativeKernel((const void*)hybrid_fwd, dim3(grid), dim3(NTHREADS), args, LDS_BYTES, stream);
  if (e != hipSuccess) fprintf(stderr, "cooperative launch failed: %s (grid %d)\n", hipGetErrorString(e), grid);
#else
  for (int ph = 0; ph < NPHASE; ++ph) {
    p.ph_lo = ph; p.ph_hi = ph + 1;
    hipLaunchKernelGGL(hybrid_fwd, dim3(grid), dim3(NTHREADS), LDS_BYTES, stream, p);
  }
#endif
}
```

```cpp
#include <hip/hip_runtime.h>
#include <hip/hip_cooperative_groups.h>
#include <stdint.h>
#include <stdio.h>
namespace cg = cooperative_groups;

#ifndef ONE_LAUNCH
#define ONE_LAUNCH 1
#endif

typedef unsigned short bf16_t;
typedef __attribute__((ext_vector_type(8))) short bf16x8;
typedef __attribute__((ext_vector_type(4))) float f32x4;

#define NTHREADS 512
#define TOK 32768
#define SEQL 4096
#define DM 1024
#define EPSV 1e-6f
#define NPHASE 12

#define WS_WIN   ((size_t)0)
#define WS_WUPA  (WS_WIN  + (size_t)5120 * 1024 * 2)
#define WS_WUPB  (WS_WUPA + (size_t)1024 * 512 * 2)
#define WS_WOUT  (WS_WUPB + (size_t)1024 * 512 * 2)
#define WS_WQ    (WS_WOUT + (size_t)1024 * 1024 * 2)
#define WS_KEYS  (WS_WQ   + (size_t)2048 * 1024 * 2)
#define WS_LB    (WS_KEYS + (size_t)2 * 8 * 128 * 128 * 2)
#define WS_U     (WS_LB   + (size_t)4096)
#define WS_V     (WS_U    + (size_t)16384 * 1024 * 2)
#define WS_XN    (WS_V    + (size_t)16384 * 1024 * 2)
#define WS_PH    (WS_XN   + (size_t)TOK * 1024 * 2)
#define WS_PA    (WS_PH   + (size_t)TOK * 2048 * 2)
#define WS_PG    (WS_PA   + (size_t)TOK * 1024 * 2)
#define WS_EIDX  (WS_PG   + (size_t)TOK * 2048 * 2)
#define WS_GW    (WS_EIDX + (size_t)TOK * 128 * 4)
#define WS_SSQ   (WS_GW   + (size_t)TOK * 128 * 4)
#define WS_XCC   (WS_SSQ  + (size_t)TOK * 4)
#define WS_BAR   (WS_XCC  + (size_t)4096)
#define WS_DEC   (WS_BAR  + (size_t)16384)
#define WS_QCTR  (WS_DEC  + (size_t)2048 * 384 * 4)
#define WS_END   (WS_QCTR + (size_t)1024)

#define WS_KC (WS_EIDX)
#define WS_VC (WS_KC + (size_t)TOK * 128)
#define WS_IKC (WS_VC + (size_t)TOK * 128)
#define LDS_BYTES 155648

struct Params {
  const float* x; const float* norm_mix; const float* w_in; const float* hg_lb; const float* hg_norm;
  const float* ikg; const float* ikb; const float* rel_bias; const float* w_up_a; const float* w_up_b;
  const float* w_out; const float* norm_ffn; const float* peer_wq; const float* peer_keys;
  const float* peer_u; const float* peer_v; const float* norm_final;
  float* out; unsigned char* ws; int ph_lo, ph_hi;
};

__device__ __forceinline__ float bf2f(bf16_t u) { return __uint_as_float(((unsigned)u) << 16); }
typedef float f32x2_cv __attribute__((ext_vector_type(2)));
typedef __bf16 bf16x2_cv __attribute__((ext_vector_type(2)));
__device__ __forceinline__ unsigned pack2(float a, float b) {
  const f32x2_cv v = {a, b};
  return __builtin_bit_cast(unsigned, __builtin_convertvector(v, bf16x2_cv));
}
__device__ __forceinline__ bf16_t f2bf(float f) { return (bf16_t)(pack2(f, f) & 0xffffu); }
__device__ __forceinline__ float wave_sum_slow(float v) {
#pragma unroll
  for (int o = 32; o > 0; o >>= 1) v += __shfl_xor(v, o);
  return v;
}
__device__ __forceinline__ void lds_fence() { asm volatile("s_waitcnt lgkmcnt(0)" ::: "memory"); }

__device__ __forceinline__ float add_xor8(float v) { return v + __int_as_float(__builtin_amdgcn_update_dpp(0, __float_as_int(v), 0x128, 0xf, 0xf, true)); }
__device__ __forceinline__ float add_xor16(float v) { const auto r = __builtin_amdgcn_permlane16_swap(__float_as_uint(v), __float_as_uint(v), false, false); return __uint_as_float(r[0]) + __uint_as_float(r[1]); }
__device__ __forceinline__ float add_xor32(float v) { const auto r = __builtin_amdgcn_permlane32_swap(__float_as_uint(v), __float_as_uint(v), false, false); return __uint_as_float(r[0]) + __uint_as_float(r[1]); }
__device__ __forceinline__ float max_xor16(float v) { const auto r = __builtin_amdgcn_permlane16_swap(__float_as_uint(v), __float_as_uint(v), false, false); return fmaxf(__uint_as_float(r[0]), __uint_as_float(r[1])); }
__device__ __forceinline__ float max_xor32(float v) { const auto r = __builtin_amdgcn_permlane32_swap(__float_as_uint(v), __float_as_uint(v), false, false); return fmaxf(__uint_as_float(r[0]), __uint_as_float(r[1])); }
__device__ __forceinline__ float wave_sum(float v) {
  v += __int_as_float(__builtin_amdgcn_update_dpp(0, __float_as_int(v), 0xB1, 0xf, 0xf, true));
  v += __int_as_float(__builtin_amdgcn_update_dpp(0, __float_as_int(v), 0x4E, 0xf, 0xf, true));
  v += __int_as_float(__builtin_amdgcn_update_dpp(0, __float_as_int(v), 0x141, 0xf, 0xf, true));
  v += __int_as_float(__builtin_amdgcn_update_dpp(0, __float_as_int(v), 0x140, 0xf, 0xf, true));
  return add_xor32(add_xor16(v));
}
__device__ __forceinline__ float sigmoidf_(float x) { return 1.f / (1.f + __expf(-x)); }
__device__ __forceinline__ float siluf_(float x) { return x / (1.f + __expf(-x)); }


#define XB_TMO      128
#define XB_XCNT(j)  (256  + 64 * (j))
#define XB_XSUB(j)  (1280 + 64 * (j))
#define XB_XGEN(j)  (2304 + 64 * (j))
#define XB_TOP      3328
#define XB_TOPGEN   3392
#define XCD_BAR_WORDS 3456
#define XB_SPIN_CAP (1u << 22)
#define LAS __attribute__((address_space(3)))
__device__ __forceinline__ unsigned xb_ld(unsigned* p)              { return __hip_atomic_load(p, __ATOMIC_RELAXED, __HIP_MEMORY_SCOPE_AGENT); }
__device__ __forceinline__ unsigned xb_add(unsigned* p, unsigned v) { return __hip_atomic_fetch_add(p, v, __ATOMIC_RELAXED, __HIP_MEMORY_SCOPE_AGENT); }
__device__ __forceinline__ unsigned xb_xcc_id() { return (unsigned)__builtin_amdgcn_s_getreg((3 << 11) | 20) & 0xFu; }
#define XB_SPIN(cond, bar) do { unsigned _sp = 0; while (cond) { __builtin_amdgcn_s_sleep(1); \
    if ((++_sp & 255u) == 0u) { if (xb_ld(&(bar)[XB_TMO])) break; if (_sp > XB_SPIN_CAP) { atomicAdd(&(bar)[XB_TMO], 1u); break; } } } } while (0)
struct XcdBarrier { unsigned* bar; unsigned x; volatile LAS unsigned* st; };
__device__ __forceinline__ XcdBarrier xcd_barrier_post(unsigned* bar, volatile LAS unsigned* st) {
  XcdBarrier b; b.bar = bar; b.x = xb_xcc_id(); b.st = st;
  if (threadIdx.x == 0) (void)xb_add(&bar[XB_XCNT(b.x)], 1u);
  return b;
}
__device__ __forceinline__ void xcd_barrier_complete(unsigned* bar, unsigned x, unsigned& nloc, unsigned& nx) {
  const unsigned G = gridDim.x * gridDim.y * gridDim.z;
  unsigned sum, cnt, mine, sp = 0u;
  for (;;) {
    sum = 0u; cnt = 0u; mine = 0u;
#pragma unroll
    for (unsigned j = 0; j < 16; ++j) { const unsigned c = xb_ld(&bar[XB_XCNT(j)]); sum += c; cnt += (c > 0u) ? 1u : 0u; mine = (j == x) ? c : mine; }
    if (sum == G) break;
    __builtin_amdgcn_s_sleep(1);
    if ((++sp & 255u) == 0u) { if (xb_ld(&bar[XB_TMO])) break; if (sp > XB_SPIN_CAP) { atomicAdd(&bar[XB_TMO], 1u); break; } }
  }
  nloc = mine > 0u ? mine : 1u; nx = cnt > 0u ? cnt : 1u;
}
__device__ __forceinline__ void xcd_barrier(const XcdBarrier& b) {
  asm volatile("s_waitcnt vmcnt(0)" ::: "memory");
  __syncthreads();
  if (threadIdx.x == 0) {
    unsigned* bar = b.bar;
    __builtin_amdgcn_s_waitcnt(0);
    unsigned nloc = b.st[0], nx = b.st[1];
    if (nloc == 0u) { xcd_barrier_complete(bar, b.x, nloc, nx); b.st[0] = nloc; b.st[1] = nx; }
    const unsigned old = xb_add(&bar[XB_XSUB(b.x)], 1u);
    const unsigned gen = old / nloc;
    if (old + 1u == (gen + 1u) * nloc) {
      __builtin_amdgcn_fence(__ATOMIC_RELEASE, "agent");
      asm volatile("s_waitcnt vmcnt(0)" ::: "memory");
      const unsigned og = xb_add(&bar[XB_TOP], 1u);
      const unsigned tg = og / nx;
      if (og + 1u == (tg + 1u) * nx) xb_add(&bar[XB_TOPGEN], 1u);
      else XB_SPIN(xb_ld(&bar[XB_TOPGEN]) == tg, bar);
      __builtin_amdgcn_fence(__ATOMIC_ACQUIRE, "agent");
      xb_add(&bar[XB_XGEN(b.x)], 1u);
      asm volatile("s_waitcnt vmcnt(0)" ::: "memory");
    } else {
      XB_SPIN(xb_ld(&bar[XB_XGEN(b.x)]) == gen, bar);
      __builtin_amdgcn_fence(__ATOMIC_ACQUIRE, "agent");
      asm volatile("s_waitcnt vmcnt(0)" ::: "memory");
    }
  }
  __syncthreads();
}

namespace pg8 {
#define PG8_LAS __attribute__((address_space(3)))
typedef unsigned short bf16_t;
typedef short bf16x8 __attribute__((ext_vector_type(8)));
typedef float f32x4 __attribute__((ext_vector_type(4)));
typedef unsigned u32x4 __attribute__((ext_vector_type(4)));
constexpr int BM = 256, BK = 64, HALF = 128, HTB = HALF * BK * 2  , STAGE_BYTES = 8 * HTB, NXCD = 8, WGM = 8;

__host__ __device__ __forceinline__ int lds_byte(int r, int c) { const int st = (r >> 4) * 2 + (c >> 5), rr = r & 15, cc = c & 31, ob = rr * 64 + cc * 2; return st * 1024 + (ob ^ (((ob >> 9) & 1) << 5)); }
__host__ __device__ __forceinline__ void stage_rc(int b, int& R, int& C) { const int st = b / 1024, sb = b % 1024, swz = sb ^ (((sb >> 9) & 1) << 5); R = (st >> 1) * 16 + swz / 64; C = (st & 1) * 32 + (swz % 64) / 2; }
__host__ __device__ __forceinline__ int perm32(int rho) { const int n = rho >> 4, i = rho & 15; return 8 * (i >> 2) + 4 * n + (i & 3); }

struct Unit { int pm, pn; };
struct Gemm { const bf16_t* A; const bf16_t* Bt; int M, N, K; };

struct StaticOrder {
    int nM, nN, nwg, G, c;
    __host__ __device__ void init(int M, int N, int G_, int c_) { nM = M / BM; nN = N / BM; nwg = nM * nN; G = G_; c = c_; }
    __host__ __device__ bool next(int i, Unit& u) const {
        const long L = (long)i * G + c; if (L >= nwg) return false;
        int wgid = (int)L; { const int q = nwg / NXCD, r = nwg % NXCD, xcd = wgid % NXCD, off = wgid / NXCD; wgid = (xcd < r ? xcd * (q + 1) : r * (q + 1) + (xcd - r) * q) + off; }
        const int nig = WGM * nN, gid = wgid / nig, fm = gid * WGM, gsz = (nM - fm) < WGM ? (nM - fm) : WGM;
        u.pm = fm + ((wgid % nig) % gsz); u.pn = (wgid % nig) / gsz; return true;
    }
    __device__ __forceinline__ void a_ready(const Unit&) const {}
    __device__ __forceinline__ void done(const Unit&) const {}
};
__device__ __forceinline__ unsigned cvt_pk_bf16(float lo, float hi) { unsigned r; asm volatile("v_cvt_pk_bf16_f32 %0, %1, %2" : "=v"(r) : "v"(lo), "v"(hi)); return r; }
typedef int i32x4 __attribute__((ext_vector_type(4)));
template <class Epi, class Sched, bool STAMP = false, bool I8 = false>
__device__ __forceinline__ void gemm_phase(PG8_LAS unsigned char* lds, const Gemm g, const Sched& S, const Epi& E, unsigned long long* stamps) {
    const int tid = threadIdx.x, wid = __builtin_amdgcn_readfirstlane(tid >> 6), lane = tid & 63, wr = wid >> 2, wc = wid & 3, fr = lane & 15, fq = lane >> 4;
    const int K = g.K, nt = K / BK;
    int ts_lo = 0, ts_hi = 0, nts = 0; const unsigned long long rt_entry = STAMP ? (unsigned long long)wall_clock64() : 0ull;
#define PG8_STAMP() do { if (STAMP && wid == 0 && nts < 64) { const unsigned long long _c = (unsigned long long)clock64(); \
        ts_lo = (lane == nts) ? (int)(unsigned)_c : ts_lo; ts_hi = (lane == nts) ? (int)(unsigned)(_c >> 32) : ts_hi; ++nts; } } while (0)
    PG8_STAMP();
    unsigned voffA[2], voffB[2];
#pragma unroll
    for (int i = 0; i < 2; ++i) { int R, C; stage_rc(tid * 16 + i * 8192, R, C); const int Rb = Epi::PERM ? ((R & ~31) + perm32(R & 31)) : R;
        voffA[i] = (unsigned)(R * K + C) * 2u; voffB[i] = (unsigned)(Rb * K + C) * 2u; }
    const size_t kstep = (size_t)(BK * 2);
    const size_t hstep = (size_t)HALF * K * 2;
    const size_t tstep = 2 * hstep;
    const unsigned ldsw = (unsigned)wid * 1024u;
    const int aoff = lds_byte(wr * 64 + fr, fq * 8), boff = lds_byte(wc * 32 + fr, fq * 8);
#define PG8_SA(b, h) (((b) * 2 + (h)) * HTB)
#define PG8_SB(b, h) ((4 + (b) * 2 + (h)) * HTB)
#define PG8_STAGE(bufoff, gbase, voff) do { _Pragma("unroll") for (int _i = 0; _i < 2; ++_i) \
        __builtin_amdgcn_global_load_lds((const unsigned*)((const char*)(gbase) + (voff)[_i]), (PG8_LAS unsigned*)(lds + (bufoff) + ldsw + _i * 8192), 16, 0, 0); } while (0)
#define PG8_LDA(dst, b, h) do { _Pragma("unroll") for (int m = 0; m < 4; ++m) _Pragma("unroll") for (int k = 0; k < 2; ++k) dst[m][k] = *(const PG8_LAS bf16x8*)(lds + PG8_SA(b, h) + aoff + m * 2048 + k * 1024); } while (0)
#define PG8_LDB(dst, b, h) do { _Pragma("unroll") for (int n = 0; n < 2; ++n) _Pragma("unroll") for (int k = 0; k < 2; ++k) dst[n][k] = *(const PG8_LAS bf16x8*)(lds + PG8_SB(b, h) + boff + n * 2048 + k * 1024); } while (0)
#define PG8_MMA(ai, bj, At, Bt) do { __builtin_amdgcn_s_setprio(1); _Pragma("unroll") for (int m = 0; m < 4; ++m) _Pragma("unroll") for (int n = 0; n < 2; ++n) _Pragma("unroll") for (int k = 0; k < 2; ++k) \
        { if constexpr (I8) acc[ai][bj][m][n] = __builtin_bit_cast(f32x4, __builtin_amdgcn_mfma_i32_16x16x64_i8(__builtin_bit_cast(i32x4, Bt[n][k]), __builtin_bit_cast(i32x4, At[m][k]), __builtin_bit_cast(i32x4, acc[ai][bj][m][n]), 0, 0, 0)); \
          else acc[ai][bj][m][n] = __builtin_amdgcn_mfma_f32_16x16x32_bf16(Bt[n][k], At[m][k], acc[ai][bj][m][n], 0, 0, 0); } __builtin_amdgcn_s_setprio(0); } while (0)
#define PG8_WAIT_V(n) asm volatile("s_waitcnt vmcnt(" #n ")" ::: "memory")
#define PG8_WAIT_L(n) asm volatile("s_waitcnt lgkmcnt(" #n ")" ::: "memory")
#define PG8_BAR __builtin_amdgcn_s_barrier()
#define PG8_SCHED __builtin_amdgcn_sched_barrier(0)
    Unit cur, nxt; int ui = 0;
    if (!S.next(0, cur)) return;
    f32x4 acc[2][2][4][2];
#pragma unroll
    for (int a = 0; a < 2; ++a)
#pragma unroll
        for (int b = 0; b < 2; ++b)
#pragma unroll
            for (int m = 0; m < 4; ++m)
#pragma unroll
                for (int n = 0; n < 2; ++n) acc[a][b][m][n] = (f32x4){0.f, 0.f, 0.f, 0.f};
    bf16x8 At[4][2], B0[2][2], B1[2][2];
    const char* cA = (const char*)g.A + (size_t)cur.pm * tstep; const char* cB = (const char*)g.Bt + (size_t)cur.pn * tstep;
    S.a_ready(cur);
    PG8_STAGE(PG8_SB(0, 0), cB, voffB); PG8_STAGE(PG8_SA(0, 0), cA, voffA); PG8_STAGE(PG8_SB(0, 1), cB + hstep, voffB); PG8_STAGE(PG8_SA(0, 1), cA + hstep, voffA);
    if (wr == 1) PG8_BAR;
    PG8_WAIT_V(4); PG8_BAR;
    PG8_STAGE(PG8_SB(1, 0), cB + kstep, voffB); PG8_STAGE(PG8_SA(1, 0), cA + kstep, voffA); PG8_STAGE(PG8_SB(1, 1), cB + hstep + kstep, voffB);
    PG8_WAIT_V(6); PG8_BAR;
    PG8_STAMP();
    for (;;) {
        const bool has_next = S.next(ui + 1, nxt);
        const char* nA = has_next ? (const char*)g.A + (size_t)nxt.pm * tstep : cA; const char* nB = has_next ? (const char*)g.Bt + (size_t)nxt.pn * tstep : cB;
        for (int t = 0; t < nt; t += 2) {
            const bool last = (t == nt - 2);
            const char* a1 = cA + (size_t)(t + 1) * kstep;
            const char* a2 = last ? nA : cA + (size_t)(t + 2) * kstep; const char* b2 = last ? nB : cB + (size_t)(t + 2) * kstep;
            const char* a3 = a2 + kstep; const char* b3 = b2 + kstep;
            if constexpr (Epi::MID) { if (t == nt / 2) E.mid(acc, cur, wr, wc, fr, fq); }
            if (last && has_next) S.a_ready(nxt);
            PG8_LDB(B0, 0, 0); PG8_SCHED; PG8_LDA(At, 0, 0); PG8_STAGE(PG8_SA(1, 1), a1 + hstep, voffA);
            PG8_WAIT_L(8); PG8_BAR; PG8_WAIT_L(0); PG8_MMA(0, 0, At, B0); PG8_BAR; PG8_SCHED;
            PG8_LDB(B1, 0, 1); PG8_STAGE(PG8_SB(0, 0), b2, voffB);
            PG8_BAR; PG8_WAIT_L(0); PG8_MMA(0, 1, At, B1); PG8_BAR;
            PG8_LDA(At, 0, 1); PG8_STAGE(PG8_SA(0, 0), a2, voffA);
            PG8_BAR; PG8_WAIT_L(0); PG8_MMA(1, 0, At, B0); PG8_BAR; PG8_SCHED;
            PG8_STAGE(PG8_SB(0, 1), b2 + hstep, voffB);
            PG8_WAIT_V(6); PG8_BAR; PG8_MMA(1, 1, At, B1); PG8_BAR;
            PG8_LDB(B0, 1, 0); PG8_SCHED; PG8_LDA(At, 1, 0); PG8_STAGE(PG8_SA(0, 1), a2 + hstep, voffA);
            PG8_WAIT_L(8); PG8_BAR; PG8_WAIT_L(0); PG8_MMA(0, 0, At, B0); PG8_BAR; PG8_SCHED;
            PG8_LDB(B1, 1, 1); PG8_STAGE(PG8_SB(1, 0), b3, voffB);
            PG8_BAR; PG8_WAIT_L(0); PG8_MMA(0, 1, At, B1); PG8_BAR;
            PG8_LDA(At, 1, 1); PG8_STAGE(PG8_SA(1, 0), a3, voffA);
            PG8_BAR; PG8_WAIT_L(0); PG8_MMA(1, 0, At, B0); PG8_BAR; PG8_SCHED;
            PG8_STAGE(PG8_SB(1, 1), b3 + hstep, voffB);
            PG8_WAIT_V(6); PG8_BAR; PG8_MMA(1, 1, At, B1); PG8_BAR;
        }
        PG8_STAMP();
        if constexpr (!Epi::AFTER_DRAIN) { E(acc, cur, wr, wc, fr, fq); S.done(cur); }
        PG8_STAMP();
        if (!has_next) break;
#pragma unroll
        for (int a = 0; a < 2; ++a)
#pragma unroll
            for (int b = 0; b < 2; ++b)
#pragma unroll
                for (int m = 0; m < 4; ++m)
#pragma unroll
                    for (int n = 0; n < 2; ++n) acc[a][b][m][n] = (f32x4){0.f, 0.f, 0.f, 0.f};
        cur = nxt; cA = nA; cB = nB; ++ui;
    }
    PG8_WAIT_V(0);
    if (wr == 0) PG8_BAR;
    PG8_BAR;
    if constexpr (Epi::AFTER_DRAIN) { E.fused(acc, cur, wr, wc, fr, fq, lds, wid, lane); S.done(cur); }
    PG8_STAMP();
    if (STAMP && wid == 0) { stamps[lane] = lane < nts ? (((unsigned long long)(unsigned)ts_hi << 32) | (unsigned)ts_lo) : 0ull;
        if (lane == 62) stamps[62] = rt_entry; if (lane == 63) stamps[63] = (unsigned long long)wall_clock64(); }
#undef PG8_STAMP
#undef PG8_SA
#undef PG8_SB
#undef PG8_STAGE
#undef PG8_LDA
#undef PG8_LDB
#undef PG8_MMA
#undef PG8_WAIT_V
#undef PG8_WAIT_L
#undef PG8_BAR
#undef PG8_SCHED
}
}

struct EpiProj {
  static constexpr bool PERM = true, AFTER_DRAIN = false, MID = false;
  unsigned short* pH; unsigned short* pA; unsigned short* pG; unsigned short* kc; unsigned short* vc; unsigned short* ikc;
  const float* sa; const float* sw;
  __device__ __forceinline__ void operator()(const pg8::f32x4 (&acc)[2][2][4][2], const pg8::Unit& u, int wr, int wc, int fr, int fq) const {
    const int row0 = u.pm * 256 + wr * 64 + fr;
    pg8::f32x4 cs_[2][2];
#pragma unroll
    for (int bj = 0; bj < 2; ++bj)
#pragma unroll
      for (int n = 0; n < 2; ++n) cs_[bj][n] = *(const pg8::f32x4*)(sw + u.pn * 256 + bj * 128 + wc * 32 + 8 * fq + 4 * n);
    unsigned short* base; int ldc, colt; bool sg = false;
    if (u.pn < 8) { base = pH; ldc = 2048; colt = u.pn * 256; }
    else if (u.pn < 12) { base = pA; ldc = 1024; colt = (u.pn - 8) * 256; }
    else { base = pG; ldc = 2048; colt = (u.pn - 12) * 256; sg = true; }
    const int col0 = colt + wc * 32 + 8 * fq;
#pragma unroll
    for (int ai = 0; ai < 2; ++ai)
#pragma unroll
      for (int m = 0; m < 4; ++m) {
        unsigned short* rowp = base + (size_t)(row0 + ai * 128 + m * 16) * ldc + col0;
        const float ra = sa[row0 + ai * 128 + m * 16];
#pragma unroll
        for (int bj = 0; bj < 2; ++bj) {
          pg8::f32x4 v0, v1;
#pragma unroll
          for (int j = 0; j < 4; ++j) { v0[j] = (float)__float_as_int(acc[ai][bj][m][0][j]) * (ra * cs_[bj][0][j]); v1[j] = (float)__float_as_int(acc[ai][bj][m][1][j]) * (ra * cs_[bj][1][j]); }
          if (sg) {
#pragma unroll
            for (int j = 0; j < 4; ++j) { v0[j] = sigmoidf_(v0[j]); v1[j] = sigmoidf_(v1[j]); }
          }
          pg8::u32x4 w; w.x = pg8::cvt_pk_bf16(v0[0], v0[1]); w.y = pg8::cvt_pk_bf16(v0[2], v0[3]); w.z = pg8::cvt_pk_bf16(v1[0], v1[1]); w.w = pg8::cvt_pk_bf16(v1[2], v1[3]);
          unsigned short* dst = rowp + bj * 128;
          if (u.pn == 10 || u.pn == 11) {
            const int cs = col0 + bj * 128;
            const size_t r = (size_t)(row0 + ai * 128 + m * 16);
            if (cs >= 512 && cs < 576) dst = kc + r * 64 + (cs - 512);
            else if (cs >= 576 && cs < 640) dst = vc + r * 64 + (cs - 576);
            else if (cs >= 896 && cs < 960) dst = ikc + r * 64 + (cs - 896);
          }
          *(pg8::u32x4*)dst = w;
        }
      }
  }
};
template <int MODE> struct EpiGate {
  static constexpr bool PERM = true, AFTER_DRAIN = false, MID = false;
  unsigned short* hb; const unsigned short* pG; int goff;
  __device__ __forceinline__ void operator()(const pg8::f32x4 (&acc)[2][2][4][2], const pg8::Unit& u, int wr, int wc, int fr, int fq) const {
    const int row0 = u.pm * 256 + wr * 64 + fr;
    const int col0 = u.pn * 256 + wc * 32 + 8 * fq;
#pragma unroll
    for (int ai = 0; ai < 2; ++ai)
#pragma unroll
      for (int m = 0; m < 4; ++m) {
        const size_t r = (size_t)(row0 + ai * 128 + m * 16);
        pg8::u32x4 gv[2], hv[2];
#pragma unroll
        for (int bj = 0; bj < 2; ++bj) {
          gv[bj] = *(const pg8::u32x4*)(pG + r * 2048 + goff + col0 + bj * 128);
          if (MODE == 1) hv[bj] = *(const pg8::u32x4*)(hb + r * 1024 + col0 + bj * 128);
        }
#pragma unroll
        for (int bj = 0; bj < 2; ++bj) {
          float o[8];
#pragma unroll
          for (int j = 0; j < 4; ++j) {
            const unsigned gw0 = gv[bj][j >> 1], gw1 = gv[bj][2 + (j >> 1)];
            const float g0 = (j & 1) ? __uint_as_float(gw0 & 0xffff0000u) : __uint_as_float(gw0 << 16);
            const float g1 = (j & 1) ? __uint_as_float(gw1 & 0xffff0000u) : __uint_as_float(gw1 << 16);
            o[j] = acc[ai][bj][m][0][j] * g0; o[4 + j] = acc[ai][bj][m][1][j] * g1;
            if (MODE == 1) {
              const unsigned hw0 = hv[bj][j >> 1], hw1 = hv[bj][2 + (j >> 1)];
              o[j] += (j & 1) ? __uint_as_float(hw0 & 0xffff0000u) : __uint_as_float(hw0 << 16);
              o[4 + j] += (j & 1) ? __uint_as_float(hw1 & 0xffff0000u) : __uint_as_float(hw1 << 16);
            }
          }
          pg8::u32x4 w; w.x = pg8::cvt_pk_bf16(o[0], o[1]); w.y = pg8::cvt_pk_bf16(o[2], o[3]); w.z = pg8::cvt_pk_bf16(o[4], o[5]); w.w = pg8::cvt_pk_bf16(o[6], o[7]);
          *(pg8::u32x4*)(hb + r * 1024 + col0 + bj * 128) = w;
        }
      }
  }
};
struct EpiGate2 {
  static constexpr bool PERM = true, AFTER_DRAIN = false, MID = true;
  unsigned short* hb; const unsigned short* pG;
  __device__ __forceinline__ void mid(pg8::f32x4 (&acc)[2][2][4][2], const pg8::Unit& u, int wr, int wc, int fr, int fq) const {
    int fr_o = fr, fq_o = fq;
    asm volatile("" : "+v"(fr_o), "+v"(fq_o));
    const unsigned short* gp = pG + (size_t)(u.pm * 256 + wr * 64 + fr_o) * 2048 + u.pn * 256 + wc * 32 + 8 * fq_o;
#pragma unroll
    for (int ai = 0; ai < 2; ++ai)
#pragma unroll
      for (int m = 0; m < 4; ++m)
#pragma unroll
        for (int bj = 0; bj < 2; ++bj) {
          const unsigned short* q = gp + (size_t)(ai * 128 + m * 16) * 2048 + bj * 128;
          const pg8::u32x4 gb = *(const pg8::u32x4*)(q + 1024);
          const pg8::u32x4 ga = *(const pg8::u32x4*)q;
#pragma unroll
          for (int wd = 0; wd < 4; ++wd) {
            const float rl = __uint_as_float(ga[wd] << 16) * __builtin_amdgcn_rcpf(__uint_as_float(gb[wd] << 16));
            const float rh = __uint_as_float(ga[wd] & 0xffff0000u) * __builtin_amdgcn_rcpf(__uint_as_float(gb[wd] & 0xffff0000u));
            acc[ai][bj][m][wd >> 1][2 * (wd & 1)] *= rl;
            acc[ai][bj][m][wd >> 1][2 * (wd & 1) + 1] *= rh;
          }
          if (bj == 1) asm volatile("" ::: "memory");
        }
  }
  __device__ __forceinline__ void operator()(const pg8::f32x4 (&acc)[2][2][4][2], const pg8::Unit& u, int wr, int wc, int fr, int fq) const {
    const int row0 = u.pm * 256 + wr * 64 + fr;
    const int col0 = u.pn * 256 + wc * 32 + 8 * fq;
#pragma unroll
    for (int ai = 0; ai < 2; ++ai)
#pragma unroll
      for (int m = 0; m < 4; ++m) {
        const size_t r = (size_t)(row0 + ai * 128 + m * 16);
        pg8::u32x4 gb[2];
#pragma unroll
        for (int bj = 0; bj < 2; ++bj) gb[bj] = *(const pg8::u32x4*)(pG + r * 2048 + 1024 + col0 + bj * 128);
#pragma unroll
        for (int bj = 0; bj < 2; ++bj) {
          float o[8];
#pragma unroll
          for (int j = 0; j < 4; ++j) {
            const unsigned b0 = gb[bj][j >> 1], b1 = gb[bj][2 + (j >> 1)];
            const float sb0 = (j & 1) ? __uint_as_float(b0 & 0xffff0000u) : __uint_as_float(b0 << 16);
            const float sb1 = (j & 1) ? __uint_as_float(b1 & 0xffff0000u) : __uint_as_float(b1 << 16);
            o[j] = acc[ai][bj][m][0][j] * sb0; o[4 + j] = acc[ai][bj][m][1][j] * sb1;
          }
          pg8::u32x4 w; w.x = pg8::cvt_pk_bf16(o[0], o[1]); w.y = pg8::cvt_pk_bf16(o[2], o[3]); w.z = pg8::cvt_pk_bf16(o[4], o[5]); w.w = pg8::cvt_pk_bf16(o[6], o[7]);
          *(pg8::u32x4*)(hb + r * 1024 + col0 + bj * 128) = w;
        }
      }
  }
};
struct EpiResid {
  static constexpr bool PERM = false, AFTER_DRAIN = false, MID = false;
  float* out; const float* x;
  __device__ __forceinline__ void operator()(const pg8::f32x4 (&acc)[2][2][4][2], const pg8::Unit& u, int wr, int wc, int fr, int fq) const {
    const int row0 = u.pm * 256 + wr * 64 + fr, col0 = u.pn * 256 + wc * 32 + 4 * fq;
#pragma unroll
    for (int ai = 0; ai < 2; ++ai)
#pragma unroll
      for (int m = 0; m < 4; ++m) {
        const size_t off = (size_t)(row0 + ai * 128 + m * 16) * 1024 + col0;
        pg8::f32x4 xv[2][2];
#pragma unroll
        for (int bj = 0; bj < 2; ++bj)
#pragma unroll
          for (int n = 0; n < 2; ++n) xv[bj][n] = *(const pg8::f32x4*)(x + off + bj * 128 + n * 16);
#pragma unroll
        for (int bj = 0; bj < 2; ++bj)
#pragma unroll
          for (int n = 0; n < 2; ++n) *(pg8::f32x4*)(out + off + bj * 128 + n * 16) = acc[ai][bj][m][n] + xv[bj][n];
      }
  }
};
struct EpiStoreBf16Q {
  static constexpr bool PERM = true, AFTER_DRAIN = false, MID = false;
  unsigned short* O; int ldc; const float* sa; const float* sw;
  __device__ __forceinline__ void operator()(const pg8::f32x4 (&acc)[2][2][4][2], const pg8::Unit& u, int wr, int wc, int fr, int fq) const {
    const int row0 = u.pm * 256 + wr * 64 + fr, col0 = u.pn * 256 + wc * 32 + 8 * fq;
    pg8::f32x4 cs_[2][2];
#pragma unroll
    for (int bj = 0; bj < 2; ++bj)
#pragma unroll
      for (int n = 0; n < 2; ++n) cs_[bj][n] = *(const pg8::f32x4*)(sw + col0 + bj * 128 + 4 * n);
#pragma unroll
    for (int ai = 0; ai < 2; ++ai)
#pragma unroll
      for (int m = 0; m < 4; ++m) {
        unsigned short* rowp = O + (size_t)(row0 + ai * 128 + m * 16) * ldc + col0;
        const float ra = sa[row0 + ai * 128 + m * 16];
#pragma unroll
        for (int bj = 0; bj < 2; ++bj) {
          pg8::f32x4 v0, v1;
#pragma unroll
          for (int j = 0; j < 4; ++j) { v0[j] = (float)__float_as_int(acc[ai][bj][m][0][j]) * (ra * cs_[bj][0][j]); v1[j] = (float)__float_as_int(acc[ai][bj][m][1][j]) * (ra * cs_[bj][1][j]); }
          pg8::u32x4 w; w.x = pg8::cvt_pk_bf16(v0[0], v0[1]); w.y = pg8::cvt_pk_bf16(v0[2], v0[3]); w.z = pg8::cvt_pk_bf16(v1[0], v1[1]); w.w = pg8::cvt_pk_bf16(v1[2], v1[3]);
          *(pg8::u32x4*)(rowp + bj * 128) = w;
        }
      }
  }
};
struct EpiStoreBf16 {
  static constexpr bool PERM = true, AFTER_DRAIN = false, MID = false;
  unsigned short* O; int ldc;
  __device__ __forceinline__ void operator()(const pg8::f32x4 (&acc)[2][2][4][2], const pg8::Unit& u, int wr, int wc, int fr, int fq) const {
    const int row0 = u.pm * 256 + wr * 64 + fr, col0 = u.pn * 256 + wc * 32 + 8 * fq;
#pragma unroll
    for (int ai = 0; ai < 2; ++ai)
#pragma unroll
      for (int m = 0; m < 4; ++m) {
        unsigned short* rowp = O + (size_t)(row0 + ai * 128 + m * 16) * ldc + col0;
#pragma unroll
        for (int bj = 0; bj < 2; ++bj) {
          const pg8::f32x4 v0 = acc[ai][bj][m][0], v1 = acc[ai][bj][m][1];
          pg8::u32x4 w; w.x = pg8::cvt_pk_bf16(v0[0], v0[1]); w.y = pg8::cvt_pk_bf16(v0[2], v0[3]); w.z = pg8::cvt_pk_bf16(v1[0], v1[1]); w.w = pg8::cvt_pk_bf16(v1[2], v1[3]);
          *(pg8::u32x4*)(rowp + bj * 128) = w;
        }
      }
  }
};

__device__ __forceinline__ void gemm_tile(const bf16_t* __restrict__ A, int lda, const bf16_t* __restrict__ Bt, int ldb,
                                          int nk, f32x4 (&acc)[4][4], unsigned char* smem) {
  const int tid = threadIdx.x, lane = tid & 63, w = tid >> 6, wm = w >> 1, wn = w & 1, l15 = lane & 15, g = lane >> 4;
  unsigned char* sA = smem;
  unsigned char* sB = smem + 32768;
  const int lr = tid >> 3, lc = tid & 7;
  const bf16_t* ga = A + (size_t)lr * lda + lc * 8;
  const bf16_t* gb = Bt + (size_t)lr * ldb + lc * 8;
  uint4 ra0, ra1, ra2, ra3, rb0, rb1;
  ra0 = *(const uint4*)(ga);
  ra1 = *(const uint4*)(ga + (size_t)64 * lda);
  ra2 = *(const uint4*)(ga + (size_t)128 * lda);
  ra3 = *(const uint4*)(ga + (size_t)192 * lda);
  rb0 = *(const uint4*)(gb);
  rb1 = *(const uint4*)(gb + (size_t)64 * ldb);
  const int sw = (lc ^ (lr & 7)) << 4;
  for (int kt = 0; kt < nk; ++kt) {
    __syncthreads();
    *(uint4*)(sA + (lr) * 128 + sw) = ra0;
    *(uint4*)(sA + (lr + 64) * 128 + sw) = ra1;
    *(uint4*)(sA + (lr + 128) * 128 + sw) = ra2;
    *(uint4*)(sA + (lr + 192) * 128 + sw) = ra3;
    *(uint4*)(sB + (lr) * 128 + sw) = rb0;
    *(uint4*)(sB + (lr + 64) * 128 + sw) = rb1;
    __syncthreads();
    if (kt + 1 < nk) {
      const int ko = (kt + 1) * 64;
      ra0 = *(const uint4*)(ga + ko);
      ra1 = *(const uint4*)(ga + (size_t)64 * lda + ko);
      ra2 = *(const uint4*)(ga + (size_t)128 * lda + ko);
      ra3 = *(const uint4*)(ga + (size_t)192 * lda + ko);
      rb0 = *(const uint4*)(gb + ko);
      rb1 = *(const uint4*)(gb + (size_t)64 * ldb + ko);
    }
#pragma unroll
    for (int ks = 0; ks < 2; ++ks) {
      bf16x8 a[4], b[4];
#pragma unroll
      for (int m = 0; m < 4; ++m) { const int r = wm * 64 + m * 16 + l15; a[m] = *(const bf16x8*)(sA + r * 128 + (((ks * 4 + g) ^ (r & 7)) << 4)); }
#pragma unroll
      for (int n = 0; n < 4; ++n) { const int r = wn * 64 + n * 16 + l15; b[n] = *(const bf16x8*)(sB + r * 128 + (((ks * 4 + g) ^ (r & 7)) << 4)); }
#pragma unroll
      for (int m = 0; m < 4; ++m)
#pragma unroll
        for (int n = 0; n < 4; ++n) acc[m][n] = __builtin_amdgcn_mfma_f32_16x16x32_bf16(a[m], b[n], acc[m][n], 0, 0, 0);
    }
  }
}

__device__ __forceinline__ void zero_acc(f32x4 (&acc)[4][4]) {
#pragma unroll
  for (int m = 0; m < 4; ++m)
#pragma unroll
    for (int n = 0; n < 4; ++n) acc[m][n] = (f32x4){0.f, 0.f, 0.f, 0.f};
}

__device__ __forceinline__ void transpose_tile(const float* __restrict__ src, int srcN, bf16_t* __restrict__ dst, int K, int n0, int k0,
                                               bool winmap, float* tile) {
  const int tid = threadIdx.x;
  const int nc = tid & 63, kr = tid >> 6;
  int ncol = n0 + nc; bool valid = true;
  if (winmap) { if (ncol >= 3072) ncol -= 60; else if (ncol >= 3012) valid = false; }
#pragma unroll
  for (int i = 0; i < 8; ++i) {
    const int k = kr + 8 * i;
    tile[k * 65 + nc] = valid ? src[(size_t)(k0 + k) * srcN + ncol] : 0.f;
  }
  __syncthreads();
#pragma unroll
  for (int i = 0; i < 8; ++i) {
    const int nr = kr + 8 * i;
    dst[(size_t)(n0 + nr) * K + k0 + nc] = f2bf(tile[nc * 65 + nr]);
  }
  __syncthreads();
}

__device__ __forceinline__ void quant_cols32(const float* __restrict__ src, int srcN, unsigned char* __restrict__ dst, float* __restrict__ scale,
                                             int n0, bool winmap, float* tile) {
  const int tid = threadIdx.x, nc = tid & 31, kr = tid >> 5;
  float* red = tile + 1024 * 33;
  int ncol = n0 + nc; bool valid = true;
  if (winmap) { if (ncol >= 3072) ncol -= 60; else if (ncol >= 3012) valid = false; }
  if (!valid) ncol = 0;
  float am = 0.f;
#pragma unroll 8
  for (int i = 0; i < 64; ++i) {
    const int k = kr + 16 * i;
    float v = src[(size_t)k * srcN + ncol];
    v = valid ? v : 0.f;
    tile[k * 33 + nc] = v; am = fmaxf(am, fabsf(v));
  }
  red[kr * 32 + nc] = am;
  __syncthreads();
  if (tid < 32) {
    float m = 0.f;
#pragma unroll
    for (int i = 0; i < 16; ++i) m = fmaxf(m, red[i * 32 + tid]);
    red[512 + tid] = m; scale[n0 + tid] = m * (1.f / 127.f);
  }
  __syncthreads();
  const float cm = red[512 + nc];
  const float inv = cm > 0.f ? 127.f / cm : 0.f;
#pragma unroll
  for (int i = 0; i < 4; ++i) {
    const int k0 = (kr + 16 * i) * 16;
    unsigned pk[4];
#pragma unroll
    for (int q = 0; q < 4; ++q) {
      const unsigned b0 = (unsigned)(int)rintf(tile[(k0 + 4 * q) * 33 + nc] * inv) & 255u, b1 = (unsigned)(int)rintf(tile[(k0 + 4 * q + 1) * 33 + nc] * inv) & 255u;
      const unsigned b2 = (unsigned)(int)rintf(tile[(k0 + 4 * q + 2) * 33 + nc] * inv) & 255u, b3 = (unsigned)(int)rintf(tile[(k0 + 4 * q + 3) * 33 + nc] * inv) & 255u;
      pk[q] = b0 | (b1 << 8) | (b2 << 16) | (b3 << 24);
    }
    *(uint4*)(dst + (size_t)(n0 + nc) * 1024 + k0) = make_uint4(pk[0], pk[1], pk[2], pk[3]);
  }
  __syncthreads();
}

__device__ __forceinline__ void convert_f32_bf16(const float* __restrict__ src, bf16_t* __restrict__ dst, size_t n4) {
  for (size_t i = (size_t)blockIdx.x * NTHREADS + threadIdx.x; i < n4; i += (size_t)gridDim.x * NTHREADS) {
    const float4 v = ((const float4*)src)[i];
    uint2 o; o.x = pack2(v.x, v.y); o.y = pack2(v.z, v.w);
    ((uint2*)dst)[i] = o;
  }
}

template <bool SLICE_MAJOR, bool SIGNED>
__device__ __forceinline__ void quantize_rows_u8(const float* __restrict__ src, unsigned char* __restrict__ dst, float* __restrict__ scale, int row_lo, int row_hi) {
  const int lane = threadIdx.x & 63, w = threadIdx.x >> 6;
  for (int row = row_lo + w; row < row_hi; row += 8) {
    const float4* s4 = (const float4*)(src + (size_t)row * 1024) + lane * 4;
    float4 v[4];
    float am = 0.f;
#pragma unroll
    for (int i = 0; i < 4; ++i) { v[i] = s4[i]; am = fmaxf(am, fmaxf(fmaxf(fabsf(v[i].x), fabsf(v[i].y)), fmaxf(fabsf(v[i].z), fabsf(v[i].w)))); }
#pragma unroll
    for (int o = 32; o > 0; o >>= 1) am = fmaxf(am, __shfl_xor(am, o));
    const float inv = am > 0.f ? 127.f / am : 0.f;
    unsigned pk[4];
#pragma unroll
    for (int i = 0; i < 4; ++i) {
      const int ofs = SIGNED ? 0 : 128;
      const unsigned b0 = (unsigned)((int)rintf(v[i].x * inv) + ofs), b1 = (unsigned)((int)rintf(v[i].y * inv) + ofs);
      const unsigned b2 = (unsigned)((int)rintf(v[i].z * inv) + ofs), b3 = (unsigned)((int)rintf(v[i].w * inv) + ofs);
      pk[i] = (b0 & 255u) | ((b1 & 255u) << 8) | ((b2 & 255u) << 16) | ((b3 & 255u) << 24);
    }
    if (SLICE_MAJOR) *(uint4*)(dst + (size_t)(lane >> 3) * (16384 * 128) + (size_t)row * 128 + (lane & 7) * 16) = make_uint4(pk[0], pk[1], pk[2], pk[3]);
    else *(uint4*)(dst + (size_t)row * 1024 + lane * 16) = make_uint4(pk[0], pk[1], pk[2], pk[3]);
    if (lane == 0) scale[row] = am * (1.f / 127.f);
  }
}

#define WS_WINS (WS_WIN + (size_t)5120 * 1024)
#define WS_WQS (WS_WQ + (size_t)2048 * 1024)
#define WS_XNS (WS_XN + (size_t)TOK * 1024)
#define WS_XQ (WS_PH + (size_t)TOK * 1024 * 2)
#define WS_XS (WS_XQ + (size_t)TOK * 1024)
template <bool WBF>
__device__ __forceinline__ void rmsnorm_rows_q(const float* __restrict__ src, const float* __restrict__ g, bf16_t* __restrict__ dst,
                                               unsigned char* __restrict__ xq, float* __restrict__ xs) {
  const int lane = threadIdx.x & 63, w = threadIdx.x >> 6;
  for (int row = blockIdx.x * 8 + w; row < TOK; row += gridDim.x * 8) {
    const float4* s4 = (const float4*)(src + (size_t)row * DM) + lane * 4;
    const float4* g4 = (const float4*)g + lane * 4;
    float v[16]; float ss = 0.f;
#pragma unroll
    for (int i = 0; i < 4; ++i) { const float4 t = s4[i]; v[4 * i] = t.x; v[4 * i + 1] = t.y; v[4 * i + 2] = t.z; v[4 * i + 3] = t.w; ss += t.x * t.x + t.y * t.y + t.z * t.z + t.w * t.w; }
    ss = wave_sum(ss);
    const float rstd = rsqrtf(ss * (1.f / DM) + EPSV);
    float am = 0.f;
#pragma unroll
    for (int i = 0; i < 4; ++i) { const float4 gg = g4[i]; v[4 * i] *= rstd * gg.x; v[4 * i + 1] *= rstd * gg.y; v[4 * i + 2] *= rstd * gg.z; v[4 * i + 3] *= rstd * gg.w; }
#pragma unroll
    for (int i = 0; i < 16; ++i) am = fmaxf(am, fabsf(v[i]));
#pragma unroll
    for (int o = 32; o > 0; o >>= 1) am = fmaxf(am, __shfl_xor(am, o));
    const float inv = am > 0.f ? 127.f / am : 0.f;
    if (WBF) {
      uint4 ob0, ob1;
      ob0.x = pack2(v[0], v[1]); ob0.y = pack2(v[2], v[3]); ob0.z = pack2(v[4], v[5]); ob0.w = pack2(v[6], v[7]);
      ob1.x = pack2(v[8], v[9]); ob1.y = pack2(v[10], v[11]); ob1.z = pack2(v[12], v[13]); ob1.w = pack2(v[14], v[15]);
      *(uint4*)(dst + (size_t)row * DM + lane * 16) = ob0;
      *(uint4*)(dst + (size_t)row * DM + lane * 16 + 8) = ob1;
    }
    unsigned pk[4];
#pragma unroll
    for (int i = 0; i < 4; ++i) {
      const unsigned b0 = (unsigned)(int)rintf(v[4 * i] * inv) & 255u, b1 = (unsigned)(int)rintf(v[4 * i + 1] * inv) & 255u;
      const unsigned b2 = (unsigned)(int)rintf(v[4 * i + 2] * inv) & 255u, b3 = (unsigned)(int)rintf(v[4 * i + 3] * inv) & 255u;
      pk[i] = b0 | (b1 << 8) | (b2 << 16) | (b3 << 24);
    }
    *(uint4*)(xq + (size_t)row * 1024 + lane * 16) = make_uint4(pk[0], pk[1], pk[2], pk[3]);
    if (lane == 0) xs[row] = am * (1.f / 127.f);
  }
}

__device__ __forceinline__ void rmsnorm_rows(const float* __restrict__ src, const float* __restrict__ g, bf16_t* __restrict__ dst) {
  const int lane = threadIdx.x & 63, w = threadIdx.x >> 6;
  for (int row = blockIdx.x * 8 + w; row < TOK; row += gridDim.x * 8) {
    const float4* s4 = (const float4*)(src + (size_t)row * DM);
    float4 v[4]; float ss = 0.f;
#pragma unroll
    for (int i = 0; i < 4; ++i) { v[i] = s4[lane + 64 * i]; ss += v[i].x * v[i].x + v[i].y * v[i].y + v[i].z * v[i].z + v[i].w * v[i].w; }
    ss = wave_sum(ss);
    const float rstd = rsqrtf(ss * (1.f / DM) + EPSV);
#pragma unroll
    for (int i = 0; i < 4; ++i) {
      const float4 gg = ((const float4*)g)[lane + 64 * i];
      uint2 o; o.x = pack2(v[i].x * rstd * gg.x, v[i].y * rstd * gg.y); o.y = pack2(v[i].z * rstd * gg.z, v[i].w * rstd * gg.w);
      ((uint2*)(dst + (size_t)row * DM))[lane + 64 * i] = o;
    }
  }
}

__device__ __forceinline__ void phase_prep(const Params& p, unsigned char* smem) {
  unsigned char* ws = p.ws;
  float* tile = (float*)smem;
  const int n_win = 160, n_ua = 16 * 8, n_ub = 16 * 8, n_wo = 16 * 16, n_wq = 64;
  const int total = n_win + n_wq + n_ua + n_ub + n_wo;
  for (int it = blockIdx.x; it < total; it += gridDim.x) {
    int t = it;
    if (t < n_win) { quant_cols32(p.w_in, 5060, ws + WS_WIN, (float*)(ws + WS_WINS), t * 32, true, tile); continue; }
    t -= n_win;
    if (t < n_wq) { quant_cols32(p.peer_wq, 2048, ws + WS_WQ, (float*)(ws + WS_WQS), t * 32, false, tile); continue; }
    t -= n_wq;
    if (t < n_ua) { transpose_tile(p.w_up_a, 1024, (bf16_t*)(ws + WS_WUPA), 1024, (t >> 3) * 64, (t & 7) * 64, false, tile); continue; }
    t -= n_ua;
    if (t < n_ub) { transpose_tile(p.w_up_b, 1024, (bf16_t*)(ws + WS_WUPA) + 512, 1024, (t >> 3) * 64, (t & 7) * 64, false, tile); continue; }
    t -= n_ub;
    transpose_tile(p.w_out, 1024, (bf16_t*)(ws + WS_WOUT), 1024, (t >> 4) * 64, (t & 15) * 64, false, tile);
  }
  convert_f32_bf16(p.peer_keys, (bf16_t*)(ws + WS_KEYS), (size_t)2 * 8 * 128 * 128 / 4);
  for (int i = blockIdx.x * NTHREADS + threadIdx.x; i < TOK; i += gridDim.x * NTHREADS) ((float*)(ws + WS_SSQ))[i] = 0.f;
  if (threadIdx.x == 0) ((int*)(ws + WS_XCC))[blockIdx.x] = (int)(__builtin_amdgcn_s_getreg((3 << 11) | 20) & 0xFu);
  if (blockIdx.x == 0 && threadIdx.x < 8) ((unsigned*)(ws + WS_QCTR))[16 * threadIdx.x] = 0u;
  if (blockIdx.x == 0) {
    const int i = threadIdx.x;
    const float a0 = p.hg_lb[i], a1 = p.hg_lb[512 + i];
    ((float*)(ws + WS_LB))[i] = 1.f / (1.f + expf(a1 - a0));
  }
  rmsnorm_rows_q<false>(p.x, p.norm_mix, nullptr, ws + WS_XN, (float*)(ws + WS_XNS));
}

__device__ __forceinline__ void hgrn_h1_all(const Params& p, unsigned char* smem) {
  unsigned char* ws = p.ws;
  bf16_t* pH = (bf16_t*)(ws + WS_PH);
  const float* lbp = (const float*)(ws + WS_LB);
  bf16_t* Qt = (bf16_t*)smem;
  bf16_t* Kt = Qt + 64 * 136;
  bf16_t* KtT = Kt + 64 * 136;
  bf16_t* VT = KtT + 128 * 72;
  bf16_t* Am = VT + 128 * 72;
  float* qtot = (float*)(Am + 64 * 72);
  const int tid = threadIdx.x, lane = tid & 63, w = tid >> 6, l15 = lane & 15, g = lane >> 4;
  const int d = tid & 127, tq = tid >> 7;
  const int G = gridDim.x;
  if ((int)blockIdx.x >= 2048) return;
  bf16_t fr_[16], qr_[16]; unsigned short vr_[16];
#define H1_LOAD(IT) do { \
    const int bh_ = (IT) >> 6, ch_ = (IT) & 63; \
    const bf16_t* base_ = pH + ((size_t)(bh_ >> 2) * SEQL + ch_ * 64 + tq * 16) * 2048 + (bh_ & 3) * 128 + d; \
    _Pragma("unroll") for (int i = 0; i < 16; ++i) { fr_[i] = base_[(size_t)i * 2048 + 512]; qr_[i] = base_[(size_t)i * 2048]; vr_[i] = base_[(size_t)i * 2048 + 1024]; } \
  } while (0)
  H1_LOAD((int)blockIdx.x);
  for (int item = blockIdx.x; item < 2048; item += G) {
    const int bh = item >> 6, chunk = item & 63;
    const int b = bh >> 2, h = bh & 3;
    const float lbv = lbp[h * 128 + d];
    const size_t row0 = (size_t)b * SEQL + chunk * 64;
    float* dec = (float*)(ws + WS_DEC) + (size_t)item * 384;
    uint4* UU = (uint4*)p.out + (size_t)item * 2048 + tid;
    float4* OI = (float4*)((unsigned char*)p.out + ((size_t)64 << 20)) + (size_t)item * 2048 + tid;
    {
      unsigned vv[8];
#pragma unroll
      for (int i = 0; i < 8; ++i) vv[i] = (unsigned)vr_[2 * i] | ((unsigned)vr_[2 * i + 1] << 16);
      float lf[16], kk[16], qs[16];
      float run = 0.f;
#pragma unroll
      for (int i = 0; i < 16; ++i) {
        const float sg = sigmoidf_(bf2f(fr_[i]));
        const float fg = lbv + (1.f - lbv) * sg;
        run += __logf(fg);
        lf[i] = run; kk[i] = 1.f - fg; qs[i] = siluf_(bf2f(qr_[i]));
      }
      qtot[tq * 128 + d] = run;
      __syncthreads();
      { const int nit = (item + G < 2048) ? item + G : item; H1_LOAD(nit); }
      const float q0 = qtot[d], q1 = qtot[128 + d], q2 = qtot[256 + d], q3 = qtot[384 + d];
      const float pre = (tq > 0 ? q0 : 0.f) + (tq > 1 ? q1 : 0.f) + (tq > 2 ? q2 : 0.f);
      const float bref = q0 + q1;
      const float blast = bref + q2 + q3;
      unsigned kp[8];
#pragma unroll
      for (int i = 0; i < 16; ++i) {
        const float bt = pre + lf[i];
        const float qt = qs[i] * __expf(bt - bref);
        const float kt = kk[i] * __expf(bref - bt);
        const int t = tq * 16 + i;
        Qt[t * 136 + d] = f2bf(qt);
        const bf16_t kb = f2bf(kt);
        Kt[t * 136 + d] = kb;
        if (i & 1) kp[i >> 1] |= ((unsigned)kb) << 16; else kp[i >> 1] = kb;
      }
      *(uint4*)(KtT + d * 72 + tq * 16) = make_uint4(kp[0], kp[1], kp[2], kp[3]);
      *(uint4*)(KtT + d * 72 + tq * 16 + 8) = make_uint4(kp[4], kp[5], kp[6], kp[7]);
      *(uint4*)(VT + d * 72 + tq * 16) = make_uint4(vv[0], vv[1], vv[2], vv[3]);
      *(uint4*)(VT + d * 72 + tq * 16 + 8) = make_uint4(vv[4], vv[5], vv[6], vv[7]);
      if (tq == 0) { dec[d] = __expf(bref); dec[128 + d] = __expf(blast); dec[256 + d] = __expf(blast - bref); }
    }
    __syncthreads();
    {
  #pragma unroll
      for (int i = 0; i < 2; ++i) {
        const int idx = tid + 512 * i, r = idx >> 4, c = idx & 15;
        *(uint4*)(pH + (row0 + r) * 2048 + h * 128 + c * 8) = *(const uint4*)(Qt + r * 136 + c * 8);
      }
  #pragma unroll
      for (int tt = 0; tt < 2; ++tt) {
        const int tl = 2 * w + tt, sm = tl >> 2, tn = tl & 3;
        f32x4 acc = (f32x4){0.f, 0.f, 0.f, 0.f};
        if (tn >= sm) {
  #pragma unroll
          for (int k0 = 0; k0 < 128; k0 += 32) {
            const bf16x8 a = *(const bf16x8*)(Kt + (sm * 16 + l15) * 136 + k0 + 8 * g);
            const bf16x8 bq = *(const bf16x8*)(Qt + (tn * 16 + l15) * 136 + k0 + 8 * g);
            acc = __builtin_amdgcn_mfma_f32_16x16x32_bf16(a, bq, acc, 0, 0, 0);
          }
        }
        const int t = tn * 16 + l15, s0 = sm * 16 + 4 * g;
        uint2 o;
        o.x = pack2(s0 + 0 <= t ? acc[0] : 0.f, s0 + 1 <= t ? acc[1] : 0.f);
        o.y = pack2(s0 + 2 <= t ? acc[2] : 0.f, s0 + 3 <= t ? acc[3] : 0.f);
        *(uint2*)(Am + t * 72 + s0) = o;
      }
    }
    __syncthreads();
    {
  #pragma unroll
      for (int tm = 0; tm < 4; ++tm) {
        f32x4 acc = (f32x4){0.f, 0.f, 0.f, 0.f};
  #pragma unroll
        for (int k0 = 0; k0 < 64; k0 += 32) {
          const bf16x8 a = *(const bf16x8*)(Am + (tm * 16 + l15) * 72 + k0 + 8 * g);
          const bf16x8 bb = *(const bf16x8*)(VT + (16 * w + l15) * 72 + k0 + 8 * g);
          acc = __builtin_amdgcn_mfma_f32_16x16x32_bf16(a, bb, acc, 0, 0, 0);
        }
        OI[tm * 512] = make_float4(acc[0], acc[1], acc[2], acc[3]);
      }
  #pragma unroll
      for (int dp = 0; dp < 4; ++dp) {
        unsigned pk[4];
  #pragma unroll
        for (int hh = 0; hh < 2; ++hh) {
          const int dm = dp * 2 + hh;
          f32x4 acc = (f32x4){0.f, 0.f, 0.f, 0.f};
  #pragma unroll
          for (int k0 = 0; k0 < 64; k0 += 32) {
            const bf16x8 a = *(const bf16x8*)(KtT + (dm * 16 + l15) * 72 + k0 + 8 * g);
            const bf16x8 bb = *(const bf16x8*)(VT + (16 * w + l15) * 72 + k0 + 8 * g);
            acc = __builtin_amdgcn_mfma_f32_16x16x32_bf16(a, bb, acc, 0, 0, 0);
          }
          pk[hh * 2] = pack2(acc[0], acc[1]); pk[hh * 2 + 1] = pack2(acc[2], acc[3]);
        }
        UU[dp * 512] = make_uint4(pk[0], pk[1], pk[2], pk[3]);
      }
    }
    __syncthreads();
  }
#undef H1_LOAD
}

__device__ __forceinline__ void hgrn_h2(const Params& p, unsigned char* smem, int bh) {
  unsigned char* ws = p.ws;
  const bf16_t* pH = (const bf16_t*)(ws + WS_PH);
  bf16_t* ya = (bf16_t*)(ws + WS_XN);
  bf16_t* Qt = (bf16_t*)smem;
  bf16_t* ST = Qt + 64 * 136;
  float* decl = (float*)(ST + 128 * 136);
  float* red = decl + 384;
  const int tid = threadIdx.x, lane = tid & 63, w = tid >> 6, l15 = lane & 15, g = lane >> 4;
  const int b = bh >> 2, h = bh & 3;
  f32x4 S[8];
#pragma unroll
  for (int i = 0; i < 8; ++i) S[i] = (f32x4){0.f, 0.f, 0.f, 0.f};
  const float gnv = p.hg_norm[h * 128 + 16 * w + l15];
  const int e = 16 * w + l15;
  uint4 uu0, uu1, uu2, uu3; float4 oi0, oi1, oi2, oi3; uint4 qraw0, qraw1; bf16_t ogr[16]; float dcv = 0.f;
#define H2_LOAD(CH) do { \
    const int item_ = bh * 64 + (CH); \
    const size_t row0_ = (size_t)b * SEQL + (size_t)(CH) * 64; \
    const uint4* UUp = (const uint4*)p.out + (size_t)item_ * 2048 + tid; \
    const float4* OIp = (const float4*)((const unsigned char*)p.out + ((size_t)64 << 20)) + (size_t)item_ * 2048 + tid; \
    uu0 = UUp[0]; uu1 = UUp[512]; uu2 = UUp[1024]; uu3 = UUp[1536]; oi0 = OIp[0]; oi1 = OIp[512]; oi2 = OIp[1024]; oi3 = OIp[1536]; \
    qraw0 = *(const uint4*)(pH + (row0_ + (tid >> 4)) * 2048 + h * 128 + (tid & 15) * 8); \
    qraw1 = *(const uint4*)(pH + (row0_ + 32 + (tid >> 4)) * 2048 + h * 128 + (tid & 15) * 8); \
    _Pragma("unroll") for (int tm = 0; tm < 4; ++tm) _Pragma("unroll") for (int j = 0; j < 4; ++j) \
      ogr[tm * 4 + j] = pH[(row0_ + tm * 16 + 4 * g + j) * 2048 + 1536 + h * 128 + e]; \
    if (tid < 384) dcv = ((const float*)(ws + WS_DEC))[(size_t)item_ * 384 + tid]; \
  } while (0)
  H2_LOAD(0);
  for (int chunk = 0; chunk < 64; ++chunk) {
    const size_t row0 = (size_t)b * SEQL + chunk * 64;
    const uint4 cu[4] = {uu0, uu1, uu2, uu3}; const float4 co[4] = {oi0, oi1, oi2, oi3}; bf16_t cog[16];
#pragma unroll
    for (int i = 0; i < 16; ++i) cog[i] = ogr[i];
    *(uint4*)(Qt + (tid >> 4) * 136 + (tid & 15) * 8) = qraw0;
    *(uint4*)(Qt + (32 + (tid >> 4)) * 136 + (tid & 15) * 8) = qraw1;
    if (tid < 384) decl[tid] = dcv;
    __syncthreads();
    if (chunk + 1 < 64) H2_LOAD(chunk + 1);
#pragma unroll
    for (int dm = 0; dm < 8; ++dm) {
      const int d0 = 16 * dm + 4 * g;
      uint2 o;
      o.x = pack2(S[dm][0] * decl[d0], S[dm][1] * decl[d0 + 1]);
      o.y = pack2(S[dm][2] * decl[d0 + 2], S[dm][3] * decl[d0 + 3]);
      *(uint2*)(ST + e * 136 + d0) = o;
    }
    __syncthreads();
    f32x4 o[4];
#pragma unroll
    for (int tm = 0; tm < 4; ++tm) {
      f32x4 acc = (f32x4){co[tm].x, co[tm].y, co[tm].z, co[tm].w};
#pragma unroll
      for (int k0 = 0; k0 < 128; k0 += 32) {
        const bf16x8 a = *(const bf16x8*)(Qt + (tm * 16 + l15) * 136 + k0 + 8 * g);
        const bf16x8 bb = *(const bf16x8*)(ST + (16 * w + l15) * 136 + k0 + 8 * g);
        acc = __builtin_amdgcn_mfma_f32_16x16x32_bf16(a, bb, acc, 0, 0, 0);
      }
      o[tm] = acc;
#pragma unroll
      for (int j = 0; j < 4; ++j) {
        float ss = acc[j] * acc[j];
        ss += __int_as_float(__builtin_amdgcn_update_dpp(0, __float_as_int(ss), 0xB1, 0xf, 0xf, true));
        ss += __int_as_float(__builtin_amdgcn_update_dpp(0, __float_as_int(ss), 0x4E, 0xf, 0xf, true));
        ss += __int_as_float(__builtin_amdgcn_update_dpp(0, __float_as_int(ss), 0x141, 0xf, 0xf, true));
        ss += __int_as_float(__builtin_amdgcn_update_dpp(0, __float_as_int(ss), 0x140, 0xf, 0xf, true));
        if (l15 == 0) red[w * 64 + tm * 16 + 4 * g + j] = ss;
      }
    }
#pragma unroll
    for (int dm = 0; dm < 8; ++dm) {
      const unsigned u01 = (dm & 1) ? cu[dm >> 1].z : cu[dm >> 1].x, u23 = (dm & 1) ? cu[dm >> 1].w : cu[dm >> 1].y;
      const float uv[4] = {__uint_as_float(u01 << 16), __uint_as_float(u01 & 0xffff0000u), __uint_as_float(u23 << 16), __uint_as_float(u23 & 0xffff0000u)};
#pragma unroll
      for (int j = 0; j < 4; ++j) { const int dd = 16 * dm + 4 * g + j; S[dm][j] = decl[128 + dd] * S[dm][j] + decl[256 + dd] * uv[j]; }
    }
    __syncthreads();
    if (tid < 64) {
      float tot = 0.f;
#pragma unroll
      for (int ww = 0; ww < 8; ++ww) tot += red[ww * 64 + tid];
      red[512 + tid] = rsqrtf(tot * (1.f / 128.f) + EPSV);
    }
    __syncthreads();
#pragma unroll
    for (int tm = 0; tm < 4; ++tm)
#pragma unroll
      for (int j = 0; j < 4; ++j) {
        const int t = tm * 16 + 4 * g + j;
        const float rstd = red[512 + t];
        ya[(row0 + t) * 1024 + h * 128 + e] = f2bf(o[tm][j] * rstd * gnv * siluf_(bf2f(cog[tm * 4 + j])));
      }
  }
#undef H2_LOAD
}

__device__ __forceinline__ int team_index(const Params& p, unsigned char* smem) {
  int* sh = (int*)(smem + 8192);
  const int G = gridDim.x, tid = threadIdx.x;
  const int* tab = (const int*)(p.ws + WS_XCC);
  if (tid < 32) sh[tid] = 0;
  __syncthreads();
  const int mine = tab[blockIdx.x] & 15;
  for (int b = tid; b < G; b += NTHREADS) {
    const int x = tab[b] & 15;
    atomicAdd(&sh[x], 1);
    if (x == mine && b < (int)blockIdx.x) atomicAdd(&sh[16], 1);
  }
  __syncthreads();
  if (tid == 0) {
    int pre = 0;
    for (int j = 0; j < mine; ++j) pre += sh[j];
    sh[17] = pre + sh[16];
  }
  __syncthreads();
  const int r = sh[17];
  __syncthreads();
  return r;
}

#define SCW 4100
#ifndef DSA_REP
#define DSA_REP 0
#endif
#define DSA_BKT_OFF (8 * SCW * 4 + 8 * 256 * 4 + 8 * 256 * 2 + 8 * 512 * 2)
__device__ __forceinline__ void cvt8(const uint4& v, float* f) {
  f[0] = __uint_as_float(v.x << 16); f[1] = __uint_as_float(v.x & 0xffff0000u);
  f[2] = __uint_as_float(v.y << 16); f[3] = __uint_as_float(v.y & 0xffff0000u);
  f[4] = __uint_as_float(v.z << 16); f[5] = __uint_as_float(v.z & 0xffff0000u);
  f[6] = __uint_as_float(v.w << 16); f[7] = __uint_as_float(v.w & 0xffff0000u);
}
__device__ __forceinline__ unsigned sortable_key(float v) {
  unsigned bits = __float_as_uint(v);
  if (bits == 0x80000000u) bits = 0u;
  return (bits & 0x80000000u) ? ~bits : (bits | 0x80000000u);
}

__device__ __forceinline__ void dsa_item(const Params& p, unsigned char* smem, int item) {
  unsigned char* ws = p.ws;
  const bf16_t* pA = (const bf16_t*)(ws + WS_PA);
  const bf16_t* kc = (const bf16_t*)(ws + WS_KC);
  const bf16_t* vc = (const bf16_t*)(ws + WS_VC);
  const bf16_t* ikc = (const bf16_t*)(ws + WS_IKC);
  bf16_t* yb = (bf16_t*)(ws + WS_XN) + 512;
  unsigned* sc = (unsigned*)smem;
  unsigned* hist = sc + 8 * SCW;
  unsigned short* sel = (unsigned short*)(hist + 8 * 256);
  unsigned short* cand = sel + 8 * 256;
  unsigned char* bkt = (unsigned char*)(cand + 8 * 512);
  unsigned* rmm = (unsigned*)(bkt + 128 + 1056);
  unsigned* bks = rmm + 16;
  const int tid = threadIdx.x, lane = tid & 63, w = tid >> 6, l15 = lane & 15, g = lane >> 4;
  const int b = item >> 9;
  const int tb = item & 511;
  const int t0 = tb * 8;
  const size_t tokbase = (size_t)b * SEQL;

  for (int rep_s = 0; rep_s < (DSA_REP == 1 ? 2 : 1); ++rep_s) {
    bf16x8 af[2][2];
    float wq[2][4];
#pragma unroll
    for (int mt = 0; mt < 2; ++mt) {
      const int qrow = t0 + mt * 4 + (l15 >> 2), head = l15 & 3;
#pragma unroll
      for (int ks = 0; ks < 2; ++ks)
        af[mt][ks] = *(const bf16x8*)(pA + (tokbase + qrow) * 1024 + 640 + head * 64 + ks * 32 + 8 * g);
      const uint2 wr = *(const uint2*)(pA + (tokbase + t0 + mt * 4 + g) * 1024 + 960);
      wq[mt][0] = 0.5f * bf2f((bf16_t)(wr.x & 0xffff)); wq[mt][1] = 0.5f * bf2f((bf16_t)(wr.x >> 16));
      wq[mt][2] = 0.5f * bf2f((bf16_t)(wr.y & 0xffff)); wq[mt][3] = 0.5f * bf2f((bf16_t)(wr.y >> 16));
    }
    const int nkt = (t0 + 8 + 15) >> 4;
    unsigned kmin[2] = {0xFFFFFFFFu, 0xFFFFFFFFu}, kmax[2] = {0u, 0u};
    for (int kt0 = w; kt0 < nkt; kt0 += 64) {
      bf16x8 b0[8], b1[8];
#pragma unroll
      for (int u = 0; u < 8; ++u) {
        const int kt = kt0 + 8 * u;
        const int s = (kt < nkt ? kt : 0) * 16 + l15;
        const bf16_t* kr = ikc + (tokbase + s) * 64 + 8 * g;
        b0[u] = *(const bf16x8*)kr;
        b1[u] = *(const bf16x8*)(kr + 32);
      }
      __builtin_amdgcn_sched_barrier(0);
      f32x4 sacc[8][2];
#pragma unroll
      for (int u = 0; u < 8; ++u)
#pragma unroll
        for (int mt = 0; mt < 2; ++mt) {
          f32x4 acc = (f32x4){0.f, 0.f, 0.f, 0.f};
          acc = __builtin_amdgcn_mfma_f32_16x16x32_bf16(af[mt][0], b0[u], acc, 0, 0, 0);
          sacc[u][mt] = __builtin_amdgcn_mfma_f32_16x16x32_bf16(af[mt][1], b1[u], acc, 0, 0, 0);
        }
#pragma unroll
      for (int u = 0; u < 8; ++u) {
        const int kt = kt0 + 8 * u;
        if (kt < nkt) {
          const int s = kt * 16 + l15;
#pragma unroll
          for (int mt = 0; mt < 2; ++mt) {
            float v = 0.f;
#pragma unroll
            for (int j = 0; j < 4; ++j) v += wq[mt][j] * fmaxf(sacc[u][mt][j] * 0.125f, 0.f);
            const int t = t0 + mt * 4 + g;
            unsigned vb = __float_as_uint(v); if (vb == 0x80000000u) vb = 0u;
            sc[(mt * 4 + g) * SCW + s] = vb;
            if (s <= t) {
              const unsigned key = (vb & 0x80000000u) ? ~vb : (vb | 0x80000000u);
              kmin[mt] = key < kmin[mt] ? key : kmin[mt];
              kmax[mt] = key > kmax[mt] ? key : kmax[mt];
            }
          }
        }
      }
    }
#pragma unroll
    for (int mt = 0; mt < 2; ++mt) {
      unsigned a = kmin[mt], bmx = kmax[mt];
#define DPP_MINMAX(CTRL) do { const unsigned a2 = (unsigned)__builtin_amdgcn_update_dpp((int)a, (int)a, CTRL, 0xf, 0xf, false); \
                               const unsigned b2 = (unsigned)__builtin_amdgcn_update_dpp((int)bmx, (int)bmx, CTRL, 0xf, 0xf, false); \
                               a = a2 < a ? a2 : a; bmx = b2 > bmx ? b2 : bmx; } while (0)
      DPP_MINMAX(0xB1); DPP_MINMAX(0x4E); DPP_MINMAX(0x141); DPP_MINMAX(0x140);
#undef DPP_MINMAX
      if (l15 == 0) { atomicMin(&rmm[mt * 4 + g], a); atomicMax(&rmm[8 + mt * 4 + g], bmx); }
    }
  }
  __syncthreads();
  const int t = t0 + w;
  const int n = t + 1;
  unsigned* row = sc + w * SCW;
  const float* rowf = (const float*)row;
  unsigned short* mysel = sel + w * 256;
  unsigned short* mycand = cand + w * 512;
  unsigned* myh = hist + w * 256;
  int cnt;
  const unsigned long long lt_mask = (1ull << lane) - 1ull;
  for (int rep_t = 0; rep_t < (DSA_REP == 2 ? 2 : 1); ++rep_t)
  if (n <= 256) {
    for (int i = lane; i < n; i += 64) mysel[i] = (unsigned short)i;
    cnt = n;
  } else {
    cnt = 256;
    float mn, mx;
    {
      const unsigned kmn = rmm[w], kmx = rmm[8 + w];
      mn = __uint_as_float((kmn & 0x80000000u) ? (kmn ^ 0x80000000u) : ~kmn);
      mx = __uint_as_float((kmx & 0x80000000u) ? (kmx ^ 0x80000000u) : ~kmx);
    }
    const float scale = (mx > mn) ? 255.99f / (mx - mn) : 0.f;
#pragma unroll
    for (int i = 0; i < 4; ++i) myh[lane + 64 * i] = 0u;
    lds_fence();
    for (int i0 = lane; i0 < n; i0 += 256) {
      float v4[4];
#pragma unroll
      for (int k = 0; k < 4; ++k) v4[k] = (i0 + 64 * k < n) ? rowf[i0 + 64 * k] : 0.f;
#pragma unroll
      for (int k = 0; k < 4; ++k) {
        if (i0 + 64 * k < n) {
          int bn = (int)((v4[k] - mn) * scale); bn = bn > 255 ? 255 : bn;
          atomicAdd(&myh[bn], 1u);
        }
      }
    }
    lds_fence();
    unsigned cum; int bstar; unsigned mcount;
    {
      const uint4 c4 = *(const uint4*)(myh + 4 * lane);
      const unsigned c = c4.x + c4.y + c4.z + c4.w;
      unsigned sfx = c;
#pragma unroll
      for (int o = 1; o < 64; o <<= 1) { const unsigned tt = __shfl_down(sfx, o); if (lane + o < 64) sfx += tt; }
      const unsigned long long bal = __ballot(sfx >= 256u);
      const int L = 63 - __clzll(bal);
      const unsigned sL = __shfl(sfx, L), cL = __shfl(c, L);
      const unsigned b3 = __shfl(c4.w, L), b2 = __shfl(c4.z, L), b1 = __shfl(c4.y, L), b0 = __shfl(c4.x, L);
      cum = sL - cL;
      int digit;
      if (cum + b3 >= 256u) { digit = 3; mcount = b3; }
      else { cum += b3; if (cum + b2 >= 256u) { digit = 2; mcount = b2; } else { cum += b2; if (cum + b1 >= 256u) { digit = 1; mcount = b1; } else { cum += b1; digit = 0; mcount = b0; } } }
      bstar = 4 * L + digit;
    }
    const unsigned need = 256u - cum;
    if (mcount <= 512u) {
      unsigned base = 0u, cb = 0u;
      for (int i0 = 0; i0 < n; i0 += 256) {
        float v4[4];
#pragma unroll
        for (int k = 0; k < 4; ++k) { const int i = i0 + 64 * k + lane; v4[k] = (i < n) ? rowf[i] : 0.f; }
#pragma unroll
        for (int k = 0; k < 4; ++k) {
          const int i = i0 + 64 * k + lane;
          const bool valid = i < n;
          int bn = (int)((v4[k] - mn) * scale); bn = bn > 255 ? 255 : bn;
          const bool gt = valid && (bn > bstar);
          const bool eq = valid && (bn == bstar);
          const unsigned long long bg = __ballot(gt), be = __ballot(eq);
          if (gt) mysel[base + (unsigned)__popcll(bg & lt_mask)] = (unsigned short)i;
          if (eq) mycand[cb + (unsigned)__popcll(be & lt_mask)] = (unsigned short)i;
          base += (unsigned)__popcll(bg); cb += (unsigned)__popcll(be);
        }
      }
      lds_fence();
      const int m = (int)mcount;
      unsigned ck[8]; unsigned short ci[8];
#pragma unroll
      for (int q = 0; q < 8; ++q) {
        const int c = q * 64 + lane;
        ck[q] = 0u; ci[q] = 0;
        if (c < m) { ci[q] = mycand[c]; ck[q] = sortable_key(rowf[ci[q]]); }
      }
      unsigned T = 0u;
      if (m <= 64) {
#pragma unroll 1
        for (int bit = 31; bit >= 0; --bit) {
          const unsigned trial = T | (1u << bit);
          if ((unsigned)__popcll(__ballot(ck[0] >= trial)) >= need) T = trial;
        }
      } else {
#pragma unroll 1
        for (int bit = 31; bit >= 0; --bit) {
          const unsigned trial = T | (1u << bit);
          unsigned cge = 0u;
#pragma unroll
          for (int q = 0; q < 8; ++q) cge += (unsigned)__popcll(__ballot(ck[q] >= trial));
          if (cge >= need) T = trial;
        }
      }
      unsigned cgt = 0u;
#pragma unroll
      for (int q = 0; q < 8; ++q) cgt += (unsigned)__popcll(__ballot(ck[q] > T));
      const unsigned need_eq = need - cgt;
      unsigned pos0 = cum, eqtaken = 0u;
#pragma unroll
      for (int q = 0; q < 8; ++q) {
        const bool gt = ck[q] > T;
        const bool eq = ck[q] == T;
        const unsigned long long beq = __ballot(eq);
        const bool take = gt || (eq && (eqtaken + (unsigned)__popcll(beq & lt_mask)) < need_eq);
        const unsigned long long bt = __ballot(take);
        const unsigned pp = pos0 + (unsigned)__popcll(bt & lt_mask);
        if (take && pp < 256u) mysel[pp] = ci[q];
        pos0 += (unsigned)__popcll(bt);
        eqtaken += (unsigned)__popcll(beq);
      }
    } else {
      unsigned prefix = 0u, krem = 256u;
#pragma unroll 1
      for (int pass = 0; pass < 4; ++pass) {
        const int shift = 24 - 8 * pass;
        const unsigned himask = (pass == 0) ? 0u : (0xFFFFFFFFu << (shift + 8));
#pragma unroll
        for (int i = 0; i < 4; ++i) myh[lane + 64 * i] = 0u;
        lds_fence();
        for (int i = lane; i < n; i += 64) {
          const unsigned u = sortable_key(rowf[i]);
          if ((u & himask) == prefix) atomicAdd(&myh[(u >> shift) & 255u], 1u);
        }
        lds_fence();
        const uint4 c4 = *(const uint4*)(myh + 4 * lane);
        const unsigned c = c4.x + c4.y + c4.z + c4.w;
        unsigned sfx = c;
#pragma unroll
        for (int o = 1; o < 64; o <<= 1) { const unsigned tt = __shfl_down(sfx, o); if (lane + o < 64) sfx += tt; }
        const unsigned long long bal = __ballot(sfx >= krem);
        const int L = 63 - __clzll(bal);
        const unsigned sL = __shfl(sfx, L), cL = __shfl(c, L);
        const unsigned b3 = __shfl(c4.w, L), b2 = __shfl(c4.z, L), b1 = __shfl(c4.y, L);
        unsigned cum2 = sL - cL;
        unsigned digit;
        if (cum2 + b3 >= krem) digit = 3;
        else { cum2 += b3; if (cum2 + b2 >= krem) digit = 2; else { cum2 += b2; if (cum2 + b1 >= krem) digit = 1; else { cum2 += b1; digit = 0; } } }
        krem -= cum2;
        prefix |= ((unsigned)(4 * L) + digit) << shift;
      }
      const unsigned T = prefix;
      unsigned base = 0u, eqtaken = 0u;
      for (int i0 = 0; i0 < n; i0 += 64) {
        const int i = i0 + lane;
        const bool valid = i < n;
        const unsigned u = valid ? sortable_key(rowf[i]) : 0u;
        const bool gt = valid && (u > T);
        const bool eq = valid && (u == T);
        const unsigned long long beq = __ballot(eq);
        const unsigned eqrank = eqtaken + (unsigned)__popcll(beq & lt_mask);
        const bool take = gt || (eq && eqrank < krem);
        const unsigned long long bt = __ballot(take);
        const unsigned pos = base + (unsigned)__popcll(bt & lt_mask);
        if (take && pos < 256u) mysel[pos] = (unsigned short)i;
        base += (unsigned)__popcll(bt);
        eqtaken += (unsigned)__popcll(beq);
      }
    }
  }
  lds_fence();
  if (lane == 0) { rmm[w] = 0xFFFFFFFFu; rmm[8 + w] = 0u; }
  lds_fence();
  {
    const uint2 s4 = *(const uint2*)(mysel + 4 * lane);
    const int sj[4] = {(int)(s4.x & 0xffffu), (int)(s4.x >> 16), (int)(s4.y & 0xffffu), (int)(s4.y >> 16)};
    unsigned pk = 0u;
#pragma unroll
    for (int j = 0; j < 4; ++j) {
      const bool valid = 4 * lane + j < cnt;
      const int dist = valid ? t - sj[j] : 0;
      unsigned bk = dist < 128 ? (unsigned)bkt[dist] : 31u;
      bk = valid ? bk : 32u;
      pk |= bk << (8 * j);
    }
    bks[w * 64 + lane] = pk;
  }
  lds_fence();
  {
    int lane_a = lane;
    asm volatile("" : "+v"(lane_a));
    const int l15 = lane_a & 15, g = lane_a >> 4;
    const int ks = lane_a >> 3, dc = lane_a & 7;
    const unsigned char* kcb = (const unsigned char*)(kc + tokbase * 64);
    const unsigned char* vcb = (const unsigned char*)(vc + tokbase * 64);
    float* pl = (float*)row;
    const float* relb = (const float*)(bkt + 128);
    const int niter = (cnt + 7) >> 3;
    bf16x8 bq0 = (bf16x8){0, 0, 0, 0, 0, 0, 0, 0}, bq1 = bq0;
    if (l15 < 8) {
      bq0 = *(const bf16x8*)(pA + (tokbase + t) * 1024 + l15 * 64 + 8 * g);
      bq1 = *(const bf16x8*)(pA + (tokbase + t) * 1024 + l15 * 64 + 32 + 8 * g);
    }
    float lg[16][4];
    {
      bf16x8 ka[8][2], kb[8][2];
#pragma unroll
      for (int u = 0; u < 8; ++u) {
        const int kk = u * 16 + l15;
        const unsigned s = (unsigned)mysel[kk] & 4095u;
        const unsigned ko = s * 128u + 16u * (unsigned)g;
        ka[u][0] = *(const bf16x8*)(kcb + ko);
        ka[u][1] = *(const bf16x8*)(kcb + ko + 64u);
      }
#pragma unroll
      for (int u = 0; u < 8; ++u) {
        const int kk = (8 + u) * 16 + l15;
        const unsigned s = (unsigned)mysel[kk] & 4095u;
        const unsigned ko = s * 128u + 16u * (unsigned)g;
        kb[u][0] = *(const bf16x8*)(kcb + ko);
        kb[u][1] = *(const bf16x8*)(kcb + ko + 64u);
      }
      __builtin_amdgcn_sched_barrier(0);
#pragma unroll
      for (int u = 0; u < 8; ++u) {
        f32x4 acc = (f32x4){0.f, 0.f, 0.f, 0.f};
        acc = __builtin_amdgcn_mfma_f32_16x16x32_bf16(ka[u][0], bq0, acc, 0, 0, 0);
        acc = __builtin_amdgcn_mfma_f32_16x16x32_bf16(ka[u][1], bq1, acc, 0, 0, 0);
        lg[u][0] = acc[0]; lg[u][1] = acc[1]; lg[u][2] = acc[2]; lg[u][3] = acc[3];
      }
#pragma unroll
      for (int u = 0; u < 8; ++u) {
        f32x4 acc = (f32x4){0.f, 0.f, 0.f, 0.f};
        acc = __builtin_amdgcn_mfma_f32_16x16x32_bf16(kb[u][0], bq0, acc, 0, 0, 0);
        acc = __builtin_amdgcn_mfma_f32_16x16x32_bf16(kb[u][1], bq1, acc, 0, 0, 0);
        lg[8 + u][0] = acc[0]; lg[8 + u][1] = acc[1]; lg[8 + u][2] = acc[2]; lg[8 + u][3] = acc[3];
      }
    }
    typedef unsigned u32x4_t __attribute__((ext_vector_type(4)));
    u32x4_t va[16];
#pragma unroll
    for (int u = 0; u < 16; ++u) {
      const int kk = u * 8 + ks;
      const unsigned s = (unsigned)mysel[kk] & 4095u;
      va[u] = *(const u32x4_t*)(vcb + s * 128u + 16u * (unsigned)dc);
    }
    __builtin_amdgcn_sched_barrier(0);
    const int hsel = l15 & 7;
    float m = -INFINITY;
    const unsigned* mybks = bks + w * 64;
#pragma unroll
    for (int u = 0; u < 16; ++u) {
      const unsigned bk4 = mybks[4 * u + g];
#pragma unroll
      for (int j = 0; j < 4; ++j) {
        lg[u][j] = lg[u][j] * 0.125f + relb[((bk4 >> (8 * j)) & 255u) * 8 + hsel];
        m = fmaxf(m, lg[u][j]);
      }
    }
    m = max_xor16(m); m = max_xor32(m);
    float sum = 0.f;
#pragma unroll
    for (int u = 0; u < 16; ++u)
#pragma unroll
      for (int j = 0; j < 4; ++j) { lg[u][j] = __expf(lg[u][j] - m); sum += lg[u][j]; }
    sum = add_xor16(sum); sum = add_xor32(sum);
    const float inv = 1.f / sum;
    bf16x8 pa[8];
#pragma unroll
    for (int s8 = 0; s8 < 8; ++s8) {
      const unsigned w0 = pack2(lg[2 * s8][0] * inv, lg[2 * s8][1] * inv), w1 = pack2(lg[2 * s8][2] * inv, lg[2 * s8][3] * inv);
      const unsigned w2 = pack2(lg[2 * s8 + 1][0] * inv, lg[2 * s8 + 1][1] * inv), w3 = pack2(lg[2 * s8 + 1][2] * inv, lg[2 * s8 + 1][3] * inv);
      const u32x4_t wv = {w0, w1, w2, w3};
      pa[s8] = __builtin_bit_cast(bf16x8, wv);
    }
    unsigned char* vs_l = (unsigned char*)row;
#pragma unroll
    for (int u = 0; u < 16; ++u) *(u32x4_t*)(vs_l + (u * 8 + ks) * 128 + dc * 16) = va[u];
    lds_fence();
    u32x4_t vb[16];
#pragma unroll
    for (int u = 0; u < 16; ++u) {
      const int kk = (16 + u) * 8 + ks;
      const unsigned s = (unsigned)mysel[kk] & 4095u;
      vb[u] = *(const u32x4_t*)(vcb + s * 128u + 16u * (unsigned)dc);
    }
    __builtin_amdgcn_sched_barrier(0);
    f32x4 ov[4];
#pragma unroll
    for (int nt = 0; nt < 4; ++nt) ov[nt] = (f32x4){0.f, 0.f, 0.f, 0.f};
    typedef short v4s_t __attribute__((ext_vector_type(4)));
    const unsigned tr_lane = (unsigned)((l15 >> 2) * 128 + (l15 & 3) * 8);
#define PV_HALF(S0) do { \
      _Pragma("unroll") for (int s4_ = 0; s4_ < 4; ++s4_) { \
        _Pragma("unroll") for (int nt = 0; nt < 4; ++nt) { \
          const unsigned a0 = (unsigned)((s4_ * 32 + 4 * g) * 128 + nt * 32) + tr_lane; \
          const v4s_t b0 = __builtin_amdgcn_ds_read_tr16_b64_v4i16((__attribute__((address_space(3))) v4s_t*)(vs_l + a0)); \
          const v4s_t b1 = __builtin_amdgcn_ds_read_tr16_b64_v4i16((__attribute__((address_space(3))) v4s_t*)(vs_l + a0 + 16 * 128)); \
          const bf16x8 bb = (bf16x8){b0[0], b0[1], b0[2], b0[3], b1[0], b1[1], b1[2], b1[3]}; \
          ov[nt] = __builtin_amdgcn_mfma_f32_16x16x32_bf16(pa[(S0) + s4_], bb, ov[nt], 0, 0, 0); \
        } \
      } \
    } while (0)
    PV_HALF(0);
    lds_fence();
#pragma unroll
    for (int u = 0; u < 16; ++u) *(u32x4_t*)(vs_l + (u * 8 + ks) * 128 + dc * 16) = vb[u];
    lds_fence();
    PV_HALF(4);
#undef PV_HALF
    if (g < 2) {
#pragma unroll
      for (int nt = 0; nt < 4; ++nt)
#pragma unroll
        for (int j = 0; j < 4; ++j) yb[(tokbase + t) * 1024 + (4 * g + j) * 64 + nt * 16 + l15] = f2bf(ov[nt][j]);
    }
    lds_fence();
  }
  __syncthreads();
}

__device__ __forceinline__ void phase_mix(const Params& p, unsigned char* smem, int mode = 0) {
  const int G = gridDim.x;
  if (mode != 2) { for (int bh = blockIdx.x; bh < 32; bh += G) { hgrn_h2(p, smem, bh); __syncthreads(); } }
  if (mode == 1) return;
  unsigned char* bkt = smem + DSA_BKT_OFF;
  volatile int* qslot = (volatile int*)(smem + LDS_BYTES - 32);
  unsigned* qctr = (unsigned*)(p.ws + WS_QCTR);
  if (threadIdx.x < 128) {
    const int nn = threadIdx.x;
    int v = nn;
    if (nn >= 16) { v = 16 + (int)(logf((float)nn * (1.f / 16.f)) / logf(8.f) * 16.f); if (v > 31) v = 31; }
    bkt[nn] = (unsigned char)v;
  }
  if (threadIdx.x >= 256) ((float*)(bkt + 128))[threadIdx.x - 256] = p.rel_bias[threadIdx.x - 256];
  if (threadIdx.x >= 128 && threadIdx.x < 136) ((float*)(bkt + 128))[256 + threadIdx.x - 128] = -INFINITY;
  if (threadIdx.x < 16) ((unsigned*)(bkt + 128 + 1056))[threadIdx.x] = threadIdx.x < 8 ? 0xFFFFFFFFu : 0u;
  const int my_team = (G % 8 == 0) ? team_index(p, smem) / (G >> 3) : (int)(blockIdx.x & 7);
  constexpr int QN = 544;
#define Q_FETCH(SLOT) do { if (threadIdx.x == 0) { int tm_ = q_team, kk_ = -1; \
      for (int tries_ = 0; tries_ < 8; ++tries_) { \
        const unsigned v_ = __hip_atomic_fetch_add(qctr + 16 * tm_, 1u, __ATOMIC_RELAXED, __HIP_MEMORY_SCOPE_AGENT); \
        if (v_ < (unsigned)QN) { kk_ = (tm_ << 16) | (int)v_; break; } \
        tm_ = (tm_ + 1) & 7; } \
      q_team = tm_; qslot[SLOT] = kk_; } } while (0)
  int q_team = my_team;
  Q_FETCH(0);
  __syncthreads();
  int k = qslot[0];
  int par = 1;
  while (k >= 0) {
    Q_FETCH(par);
    const int bt = k >> 16, kl = k & 0xffff;
    const int kq = kl / 17, kr = kl - kq * 17;
    if (kr < 16) {
      const int tb = 511 - (kq * 16 + kr);
      dsa_item(p, smem, (bt << 9) | tb);
    } else {
      const int r0 = (bt * 32 + kq) * 64;
      quantize_rows_u8<false, true>(p.peer_u, p.ws + WS_U, (float*)(p.ws + WS_U + (size_t)16384 * 1024), r0, r0 + 64);
      quantize_rows_u8<true, true>(p.peer_v, p.ws + WS_V, (float*)(p.ws + WS_V + (size_t)16384 * 1024), r0, r0 + 64);
      __syncthreads();
    }
    k = qslot[par];
    par ^= 1;
  }
#undef Q_FETCH
}

__device__ __forceinline__ void phase_pkeys(const Params& p, unsigned char* smem) {
  unsigned char* ws = p.ws;
  const bf16_t* qp = (const bf16_t*)(ws + WS_PG);
  const bf16_t* keys = (const bf16_t*)(ws + WS_KEYS);
  int* eidx = (int*)(ws + WS_EIDX);
  float* gw = (float*)(ws + WS_GW);
  float* sc = (float*)smem;
  float* s2l = (float*)smem;
  unsigned short* i1l = (unsigned short*)(s2l + 256 * 17);
  unsigned short* i2l = i1l + 256 * 16;
  const int tid = threadIdx.x, lane = tid & 63, w = tid >> 6, wm = w >> 1, wn = w & 1, l15 = lane & 15, g = lane >> 4;
  for (int item = blockIdx.x; item < 128 * 8; item += gridDim.x) {
    const int h = item & 7, tm = item >> 3;
    float s1[16], s2v[16]; int i1[16], i2[16];
#pragma unroll
    for (int ph = 0; ph < 2; ++ph) {
      const int hp = h * 2 + ph;
      f32x4 acc[4][4]; zero_acc(acc);
      gemm_tile(qp + (size_t)tm * 256 * 2048 + hp * 128, 2048, keys + (size_t)(ph * 8 + h) * 128 * 128, 128, 2, acc, smem);
      __syncthreads();
#pragma unroll
      for (int m = 0; m < 4; ++m)
#pragma unroll
        for (int n = 0; n < 4; ++n)
#pragma unroll
          for (int j = 0; j < 4; ++j) sc[(wm * 64 + m * 16 + 4 * g + j) * 129 + wn * 64 + n * 16 + l15] = acc[m][n][j];
      __syncthreads();
      if (tid < 256) {
        const float* rowp = sc + tid * 129;
        unsigned tv[16];
#pragma unroll
        for (int k = 0; k < 16; ++k) tv[k] = 0u;
#pragma unroll 8
        for (int nn = 0; nn < 128; ++nn) {
          const unsigned bits = __float_as_uint(rowp[nn]);
          unsigned key = (bits & 0x80000000u) ? ~bits : (bits | 0x80000000u);
          key = (key & ~127u) | (unsigned)(127 - nn);
#pragma unroll
          for (int k = 15; k >= 1; --k) {
            unsigned r;
            asm("v_med3_u32 %0, %1, %2, %3" : "=v"(r) : "v"(tv[k]), "v"(tv[k - 1]), "v"(key));
            tv[k] = r;
          }
          tv[0] = tv[0] > key ? tv[0] : key;
        }
#pragma unroll
        for (int k = 0; k < 16; ++k) {
          const int col = 127 - (int)(tv[k] & 127u);
          const float val = rowp[col];
          if (ph == 0) { i1[k] = col; s1[k] = val; } else { i2[k] = col; s2v[k] = val; }
        }
      }
      __syncthreads();
    }
    if (tid < 256) {
#pragma unroll
      for (int a = 0; a < 16; ++a) { s2l[tid * 17 + a] = s2v[a]; i1l[tid * 16 + a] = (unsigned short)i1[a]; i2l[tid * 16 + a] = (unsigned short)i2[a]; }
      float cur[16];
#pragma unroll
      for (int a = 0; a < 16; ++a) cur[a] = s1[a] + s2v[0];
      unsigned long long ptr = 0ull;
      float tops[16]; int tope[16];
#pragma unroll
      for (int k = 0; k < 16; ++k) {
        float best = cur[0]; int ba = 0;
#pragma unroll
        for (int a = 1; a < 16; ++a) if (cur[a] > best) { best = cur[a]; ba = a; }
        const int bb = (int)((ptr >> (4 * ba)) & 15ull);
        tops[k] = best;
        tope[k] = (int)i1l[tid * 16 + ba] * 128 + (int)i2l[tid * 16 + bb];
        const int nb = bb + 1;
        const float ns2 = (nb < 16) ? s2l[tid * 17 + nb] : -INFINITY;
        if (nb < 16) ptr += (1ull << (4 * ba));
#pragma unroll
        for (int a = 0; a < 16; ++a) if (a == ba) cur[a] = s1[a] + ns2;
      }
      const float m = tops[0];
      float sum = 0.f;
#pragma unroll
      for (int k = 0; k < 16; ++k) { tops[k] = __expf(tops[k] - m); sum += tops[k]; }
      const float inv = 1.f / sum;
      const size_t ob = ((size_t)(tm * 256 + tid) * 8 + h) * 16;
#pragma unroll
      for (int k = 0; k < 16; k += 4) {
        *(int4*)(eidx + ob + k) = make_int4(tope[k], tope[k + 1], tope[k + 2], tope[k + 3]);
        *(float4*)(gw + ob + k) = make_float4(tops[k] * inv, tops[k + 1] * inv, tops[k + 2] * inv, tops[k + 3] * inv);
      }
    }
    __syncthreads();
  }
}


__device__ __forceinline__ float reduce8(const float (&pv)[8], int lane) {
  const bool b5 = lane & 32, b4 = lane & 16, b3 = lane & 8;
  float v[4];
#pragma unroll
  for (int i = 0; i < 4; ++i) {
    const float keep = b5 ? pv[4 + i] : pv[i];
    const float send = b5 ? pv[i] : pv[4 + i];
    v[i] = keep + __shfl_xor(send, 32);
  }
  float u[2];
#pragma unroll
  for (int i = 0; i < 2; ++i) {
    const float keep = b4 ? v[2 + i] : v[i];
    const float send = b4 ? v[i] : v[2 + i];
    u[i] = keep + __shfl_xor(send, 16);
  }
  float x = (b3 ? u[1] : u[0]) + __shfl_xor(b3 ? u[0] : u[1], 8);
  x += __shfl_xor(x, 4); x += __shfl_xor(x, 2); x += __shfl_xor(x, 1);
  return x;
}

__device__ __forceinline__ void cvt16u8(const uint4& v, float* f) {
  f[0] = (float)(v.x & 0xffu); f[1] = (float)((v.x >> 8) & 0xffu); f[2] = (float)((v.x >> 16) & 0xffu); f[3] = (float)(v.x >> 24);
  f[4] = (float)(v.y & 0xffu); f[5] = (float)((v.y >> 8) & 0xffu); f[6] = (float)((v.y >> 16) & 0xffu); f[7] = (float)(v.y >> 24);
  f[8] = (float)(v.z & 0xffu); f[9] = (float)((v.z >> 8) & 0xffu); f[10] = (float)((v.z >> 16) & 0xffu); f[11] = (float)(v.z >> 24);
  f[12] = (float)(v.w & 0xffu); f[13] = (float)((v.w >> 8) & 0xffu); f[14] = (float)((v.w >> 16) & 0xffu); f[15] = (float)(v.w >> 24);
}

__device__ __forceinline__ int wave_sum_i32_dpp(int v) {
  v += __builtin_amdgcn_update_dpp(0, v, 0xB1, 0xf, 0xf, true);
  v += __builtin_amdgcn_update_dpp(0, v, 0x4E, 0xf, 0xf, true);
  v += __builtin_amdgcn_update_dpp(0, v, 0x141, 0xf, 0xf, true);
  v += __builtin_amdgcn_update_dpp(0, v, 0x140, 0xf, 0xf, true);
  return __builtin_amdgcn_readlane(v, 0) + __builtin_amdgcn_readlane(v, 16) + __builtin_amdgcn_readlane(v, 32) + __builtin_amdgcn_readlane(v, 48);
}

__device__ __forceinline__ int reduce8_i32_scatter(const int (&d)[8], int lane) {
  const bool b0 = lane & 1, b1 = lane & 2, b2 = lane & 4;
  int v[4];
#pragma unroll
  for (int i = 0; i < 4; ++i) {
    const int keep = b0 ? d[2 * i + 1] : d[2 * i];
    const int send = b0 ? d[2 * i] : d[2 * i + 1];
    v[i] = keep + __builtin_amdgcn_update_dpp(0, send, 0xB1, 0xf, 0xf, true);
  }
  int u[2];
#pragma unroll
  for (int i = 0; i < 2; ++i) {
    const int keep = b1 ? v[2 * i + 1] : v[2 * i];
    const int send = b1 ? v[2 * i] : v[2 * i + 1];
    u[i] = keep + __builtin_amdgcn_update_dpp(0, send, 0x4E, 0xf, 0xf, true);
  }
  int x;
  {
    const int keep = b2 ? u[1] : u[0];
    const int send = b2 ? u[0] : u[1];
    int t = __builtin_amdgcn_update_dpp(0, send, 0x141, 0xf, 0xf, true);
    t = __builtin_amdgcn_update_dpp(0, t, 0x1B, 0xf, 0xf, true);
    x = keep + t;
  }
  x += __builtin_amdgcn_update_dpp(0, x, 0x128, 0xf, 0xf, true);
  { const auto r = __builtin_amdgcn_permlane16_swap((unsigned)x, (unsigned)x, false, false); x = (int)r[0] + (int)r[1]; }
  { const auto r = __builtin_amdgcn_permlane32_swap((unsigned)x, (unsigned)x, false, false); x = (int)r[0] + (int)r[1]; }
  return x;
}

__device__ __forceinline__ void phase_pu(const Params& p, unsigned char* smem) {
  unsigned char* ws = p.ws;
  const unsigned char* XQ = ws + WS_XQ;
  const float* xs = (const float*)(ws + WS_XS);
  const unsigned char* U8 = ws + WS_U;
  const float* us = (const float*)(ws + WS_U + (size_t)16384 * 1024);
  const float* vs = (const float*)(ws + WS_V + (size_t)16384 * 1024);
  const int* eidx = (const int*)(ws + WS_EIDX);
  const float* gw = (const float*)(ws + WS_GW);
  float* aw = (float*)(ws + WS_PA);
  const int lane = threadIdx.x & 63, w = threadIdx.x >> 6;
  const unsigned long long lt_mask = (1ull << lane) - 1ull;
  const int G = gridDim.x;
  const bool sliced = (G % 8 == 0);
  const int ti = sliced ? team_index(p, smem) : 0;
  const int tsz = sliced ? (G >> 3) : G;
  const int grp_lo = sliced ? ti / tsz : 0, grp_hi = sliced ? grp_lo + 1 : 8;
  const int slot = (sliced ? (ti % tsz) : (int)blockIdx.x) * 8 + w;
  const int nslot = tsz * 8;
  unsigned* lst = (unsigned*)smem + 4096 + w * 128;
  typedef unsigned u32x4_t __attribute__((ext_vector_type(4)));
  if (slot >= TOK) return;
  for (int grp = grp_lo; grp < grp_hi; ++grp) {
#define PU_LIST(E0, E1, N, L0, L1) do { \
      const bool m0_ = ((E0) >> 11) == grp, m1_ = ((E1) >> 11) == grp; \
      const unsigned long long b0_ = __ballot(m0_), b1_ = __ballot(m1_); \
      const int c0_ = __popcll(b0_); N = c0_ + __popcll(b1_); \
      if (m0_) lst[__popcll(b0_ & lt_mask)] = ((unsigned)lane << 14) | (unsigned)(E0); \
      if (m1_) lst[c0_ + __popcll(b1_ & lt_mask)] = ((unsigned)(lane + 64) << 14) | (unsigned)(E1); \
      lds_fence(); \
      L0 = (lane < N) ? lst[lane] : 0u; L1 = (lane + 64 < N) ? lst[lane + 64] : 0u; \
      lds_fence(); } while (0)
#define PU_ISSUE(BUF, L0, N, I0) do { int last_ = ((N) < 64 ? (N) : 64) - 1; last_ = last_ < 0 ? 0 : last_; \
      _Pragma("unroll") for (int j = 0; j < 8; ++j) { int idx_ = (I0) + j; idx_ = idx_ < last_ ? idx_ : last_; \
        const unsigned le_ = (unsigned)__builtin_amdgcn_readlane((int)(L0), idx_); \
        BUF[j] = *(const u32x4_t*)(U8 + (size_t)(le_ & 16383u) * 1024 + lane * 16); } } while (0)
#define PU_REDUCE(BUF, X, I0, HREG) do { int dd_[8]; _Pragma("unroll") for (int j = 0; j < 8; ++j) { \
        int d_ = __builtin_amdgcn_sdot4((int)BUF[j].x, (int)(X).x, 0, false); \
        d_ = __builtin_amdgcn_sdot4((int)BUF[j].y, (int)(X).y, d_, false); \
        d_ = __builtin_amdgcn_sdot4((int)BUF[j].z, (int)(X).z, d_, false); \
        dd_[j] = __builtin_amdgcn_sdot4((int)BUF[j].w, (int)(X).w, d_, false); } \
      const int tot_ = reduce8_i32_scatter(dd_, lane);     \
      if (lane >= (I0) && lane < (I0) + 8) HREG = tot_; } while (0)
    u32x4_t cx = *(const u32x4_t*)(XQ + (size_t)slot * 1024 + lane * 16);
    int ce0 = eidx[(size_t)slot * 128 + lane], ce1 = eidx[(size_t)slot * 128 + 64 + lane];
    float cxs = xs[slot];
    int cn; unsigned cl0, cl1;
    PU_LIST(ce0, ce1, cn, cl0, cl1);
    u32x4_t ra[8], rb[8], rc[8];
    PU_ISSUE(ra, cl0, cn, 0);
    PU_ISSUE(rb, cl0, cn, 8);
    int t1 = (slot + nslot < TOK) ? slot + nslot : slot;
    u32x4_t nx = *(const u32x4_t*)(XQ + (size_t)t1 * 1024 + lane * 16);
    int ne0 = eidx[(size_t)t1 * 128 + lane], ne1 = eidx[(size_t)t1 * 128 + 64 + lane];
    float nxs = xs[t1];
    for (int tok = slot; tok < TOK; tok += nslot) {
      float sc0 = 0.f, sc1 = 0.f, gv0 = 0.f, gv1 = 0.f, vv0 = 0.f, vv1 = 0.f;
      if (lane < cn) { const int e = cl0 & 16383; sc0 = us[e]; vv0 = vs[e]; gv0 = gw[(size_t)tok * 128 + (cl0 >> 14)]; }
      if (lane + 64 < cn) { const int e = cl1 & 16383; sc1 = us[e]; vv1 = vs[e]; gv1 = gw[(size_t)tok * 128 + (cl1 >> 14)]; }
      int nn; unsigned nl0, nl1;
      PU_LIST(ne0, ne1, nn, nl0, nl1);
      const u32x4_t x1 = nx; const int xe0 = ne0, xe1 = ne1; const float xs1 = nxs;
      const int t2a = tok + nslot, t2 = (t2a + nslot < TOK) ? t2a + nslot : ((t2a < TOK) ? t2a : tok);
      nx = *(const u32x4_t*)(XQ + (size_t)t2 * 1024 + lane * 16);
      ne0 = eidx[(size_t)t2 * 128 + lane]; ne1 = eidx[(size_t)t2 * 128 + 64 + lane];
      nxs = xs[t2];
      int h0i = 0, h1i = 0;
      const bool third = cn > 16;
      if (third) { PU_ISSUE(rc, cl0, cn, 16); }
      __builtin_amdgcn_sched_barrier(0); PU_REDUCE(ra, cx, 0, h0i);  __builtin_amdgcn_sched_barrier(0);
      PU_ISSUE(ra, nl0, nn, 0);  __builtin_amdgcn_sched_barrier(0); PU_REDUCE(rb, cx, 8, h0i);  __builtin_amdgcn_sched_barrier(0);
      PU_ISSUE(rb, nl0, nn, 8);  __builtin_amdgcn_sched_barrier(0);
      if (third) { PU_REDUCE(rc, cx, 16, h0i); }
      __builtin_amdgcn_sched_barrier(0);
      if (cn > 24) {
        for (int i0 = 24; i0 < cn; i0 += 8) {
          u32x4_t rd[8];
          const bool lo = i0 < 64;
          const unsigned lsrc = lo ? cl0 : cl1;
          const int nsrc = lo ? cn : cn - 64;
          PU_ISSUE(rd, lsrc, nsrc, i0 & 63);
          if (lo) { PU_REDUCE(rd, cx, i0, h0i); } else { PU_REDUCE(rd, cx, i0 - 64, h1i); }
        }
      }
      const float h0 = (float)h0i * sc0 * cxs, h1 = (float)h1i * sc1 * cxs;
      if (lane < cn) aw[(size_t)tok * 128 + (cl0 >> 14)] = 0.5f * h0 * (1.f + erff(h0 * 0.70710678118654752f)) * gv0 * vv0;
      if (lane + 64 < cn) aw[(size_t)tok * 128 + (cl1 >> 14)] = 0.5f * h1 * (1.f + erff(h1 * 0.70710678118654752f)) * gv1 * vv1;
      cx = x1; ce0 = xe0; ce1 = xe1; cxs = xs1; cn = nn; cl0 = nl0; cl1 = nl1;
    }
#undef PU_LIST
#undef PU_ISSUE
#undef PU_REDUCE
  }
}

template <bool SL>
__device__ __forceinline__ void phase_pv_t(const Params& p, unsigned char* smem) {
  unsigned char* ws = p.ws;
  const unsigned char* V8 = ws + WS_V;
  const int* eidx = (const int*)(ws + WS_EIDX);
  const float* aw = (const float*)(ws + WS_PA);
  float* ssq = (float*)(ws + WS_SSQ);
  const int lane = threadIdx.x & 63, w = threadIdx.x >> 6;
  const int q = lane >> 3, c = lane & 7;
  const int G = gridDim.x;
  constexpr bool sliced = SL;
  const int ti = sliced ? team_index(p, smem) : 0;
  const int tsz = G >> 3;
  const int grp0 = sliced ? (ti / tsz) : 0;
  constexpr int ngrp = sliced ? 1 : 8;
  const int slot = sliced ? (ti % tsz) * 8 + w : blockIdx.x * 8 + w;
  const int nslot = sliced ? tsz * 8 : G * 8;
  int ee[16]; float aa[16];
  if (slot < TOK) {
    unsigned bi = (unsigned)slot * 128u + 16u * (unsigned)q;
    asm volatile("" : "+v"(bi));
#pragma unroll
    for (int u4 = 0; u4 < 4; ++u4) {
      const int4 e4 = *(const int4*)(eidx + bi + 4 * u4); const float4 a4 = *(const float4*)(aw + bi + 4 * u4);
      ee[4 * u4] = e4.x; ee[4 * u4 + 1] = e4.y; ee[4 * u4 + 2] = e4.z; ee[4 * u4 + 3] = e4.w;
      aa[4 * u4] = a4.x; aa[4 * u4 + 1] = a4.y; aa[4 * u4 + 2] = a4.z; aa[4 * u4 + 3] = a4.w;
    }
  }
  for (int tok = slot; tok < TOK; tok += nslot) {
    int ce[16]; float ca[16];
    float suma = 0.f;
#pragma unroll
    for (int u = 0; u < 16; ++u) { ce[u] = ee[u]; ca[u] = aa[u]; suma += aa[u]; }
    for (int gi = 0; gi < ngrp; ++gi) {
      const int grp = grp0 + gi;
      uint4 vv[16];
#pragma unroll
      for (int u = 0; u < 16; ++u) vv[u] = *(const uint4*)(V8 + (size_t)grp * (16384 * 128) + (size_t)ce[u] * 128 + c * 16);
      float* orow = p.out + (size_t)tok * 1024 + grp * 128 + c * 16;
      float4 x1v[4];
#pragma unroll
      for (int i = 0; i < 4; ++i) x1v[i] = *(const float4*)(orow + 4 * i);
      if (gi == ngrp - 1) {
        const int nt = (tok + nslot < TOK) ? tok + nslot : tok;
        unsigned bi = (unsigned)nt * 128u + 16u * (unsigned)q;
        asm volatile("" : "+v"(bi));
#pragma unroll
        for (int u4 = 0; u4 < 4; ++u4) {
          const int4 e4 = *(const int4*)(eidx + bi + 4 * u4); const float4 a4 = *(const float4*)(aw + bi + 4 * u4);
          ee[4 * u4] = e4.x; ee[4 * u4 + 1] = e4.y; ee[4 * u4 + 2] = e4.z; ee[4 * u4 + 3] = e4.w;
          aa[4 * u4] = a4.x; aa[4 * u4 + 1] = a4.y; aa[4 * u4 + 2] = a4.z; aa[4 * u4 + 3] = a4.w;
        }
      }
      __builtin_amdgcn_sched_barrier(0);
      float acc[16];
#pragma unroll
      for (int i = 0; i < 16; ++i) acc[i] = -128.f * suma;
#pragma unroll
      for (int u = 0; u < 16; ++u) {
        float vf[16];
        cvt16u8(vv[u], vf);
#pragma unroll
        for (int i = 0; i < 16; ++i) acc[i] += ca[u] * vf[i];
        __builtin_amdgcn_sched_barrier(0);
      }
#pragma unroll
      for (int i = 0; i < 16; ++i) { acc[i] = add_xor8(acc[i]); acc[i] = add_xor16(acc[i]); acc[i] = add_xor32(acc[i]); }
      float ss = 0.f;
      if (q == 0) {
#pragma unroll
        for (int i = 0; i < 4; ++i) {
          const float4 oa = make_float4(x1v[i].x + acc[4 * i], x1v[i].y + acc[4 * i + 1], x1v[i].z + acc[4 * i + 2], x1v[i].w + acc[4 * i + 3]);
          *(float4*)(orow + 4 * i) = oa;
          ss += oa.x * oa.x + oa.y * oa.y + oa.z * oa.z + oa.w * oa.w;
        }
      }
      ss += __shfl_xor(ss, 1); ss += __shfl_xor(ss, 2); ss += __shfl_xor(ss, 4);
      if (lane == 0) atomicAdd(&ssq[tok], ss);
    }
  }
}

__device__ __forceinline__ void phase_pv_mfma(const Params& p, unsigned char* smem) {
  unsigned char* ws = p.ws;
  const unsigned char* V8 = ws + WS_V;
  const int* eidx = (const int*)(ws + WS_EIDX);
  const float* aw = (const float*)(ws + WS_PA);
  float* ssq = (float*)(ws + WS_SSQ);
  const int lane = threadIdx.x & 63, w = threadIdx.x >> 6;
  const int q8 = lane >> 3, c = lane & 7;
  const int l15 = lane & 15, g = lane >> 4;
  const int G = gridDim.x;
  const bool sliced = (G % 8 == 0);
  const int ti = sliced ? team_index(p, smem) : 0;
  const int tsz = sliced ? (G >> 3) : G;
  const int grp_lo = sliced ? ti / tsz : 0, grp_hi = sliced ? grp_lo + 1 : 8;
  const int slot = (sliced ? (ti % tsz) : (int)blockIdx.x) * 8 + w;
  const int nslot = tsz * 8;
  if (slot >= TOK) return;
  unsigned char* vs_l = smem + 16384 + w * 16384;
  typedef unsigned u32x4_t __attribute__((ext_vector_type(4)));
  typedef float f32x4_t __attribute__((ext_vector_type(4)));
  typedef int i32x4_t __attribute__((ext_vector_type(4)));
  typedef int i32x2_t __attribute__((ext_vector_type(2)));
  const unsigned tr_lane = (unsigned)((l15 >> 1) * 128 + (l15 & 1) * 8);
  for (int grp = grp_lo; grp < grp_hi; ++grp) {
    const unsigned char* Vg = V8 + (size_t)grp * (16384 * 128) + c * 16;
    i32x4_t ee[4]; f32x4_t aa[8];
#define PVM_META(TOKEN) do { \
      const i32x4_t* ep_ = (const i32x4_t*)(eidx + (size_t)(TOKEN) * 128 + 16 * q8); \
      _Pragma("unroll") for (int u4 = 0; u4 < 4; ++u4) ee[u4] = ep_[u4]; \
      const f32x4_t* ap_ = (const f32x4_t*)(aw + (size_t)(TOKEN) * 128 + 16 * g); \
      _Pragma("unroll") for (int u4 = 0; u4 < 4; ++u4) { aa[u4] = ap_[u4]; aa[4 + u4] = ap_[16 + u4]; } } while (0)
    PVM_META(slot);
    for (int tok = slot; tok < TOK; tok += nslot) {
      u32x4_t vv[16];
#pragma unroll
      for (int u = 0; u < 16; ++u) vv[u] = *(const u32x4_t*)(Vg + (size_t)ee[u >> 2][u & 3] * 128);
      float* orow = p.out + (size_t)tok * 1024 + grp * 128 + l15;
      float x1v[8];
#pragma unroll
      for (int nt = 0; nt < 8; ++nt) x1v[nt] = orow[nt * 16];
      float am = 0.f;
#pragma unroll
      for (int i = 0; i < 8; ++i) am = fmaxf(am, fmaxf(fmaxf(fabsf(aa[i].x), fabsf(aa[i].y)), fmaxf(fabsf(aa[i].z), fabsf(aa[i].w))));
      am = max_xor16(am); am = max_xor32(am);
      const float inva = am > 0.f ? 127.f / am : 0.f, sa = am * (1.f / 127.f);
      i32x4_t aop[2];
#pragma unroll
      for (int s2 = 0; s2 < 2; ++s2)
#pragma unroll
        for (int d4 = 0; d4 < 4; ++d4) {
          const f32x4_t a4 = aa[4 * s2 + d4];
          const unsigned b0 = (unsigned)(int)rintf(a4.x * inva) & 255u, b1 = (unsigned)(int)rintf(a4.y * inva) & 255u;
          const unsigned b2 = (unsigned)(int)rintf(a4.z * inva) & 255u, b3 = (unsigned)(int)rintf(a4.w * inva) & 255u;
          aop[s2][d4] = (int)(b0 | (b1 << 8) | (b2 << 16) | (b3 << 24));
        }
      { const int nt_ = (tok + nslot < TOK) ? tok + nslot : tok; PVM_META(nt_); }
      __builtin_amdgcn_sched_barrier(0);
#pragma unroll
      for (int u = 0; u < 16; ++u) *(u32x4_t*)(vs_l + (16 * q8 + u) * 128 + c * 16) = vv[u];
      lds_fence();
      i32x4_t acc[8];
#pragma unroll
      for (int nt = 0; nt < 8; ++nt) acc[nt] = (i32x4_t){0, 0, 0, 0};
#pragma unroll
      for (int s2 = 0; s2 < 2; ++s2)
#pragma unroll
        for (int nt = 0; nt < 8; ++nt) {
          const unsigned a0 = (unsigned)((s2 * 64 + 16 * g) * 128 + nt * 16) + tr_lane;
          const i32x2_t lo = __builtin_amdgcn_ds_read_tr8_b64_v2i32((__attribute__((address_space(3))) i32x2_t*)(vs_l + a0));
          const i32x2_t hi = __builtin_amdgcn_ds_read_tr8_b64_v2i32((__attribute__((address_space(3))) i32x2_t*)(vs_l + a0 + 8 * 128));
          const i32x4_t bop = {lo[0], lo[1], hi[0], hi[1]};
          acc[nt] = __builtin_amdgcn_mfma_i32_16x16x64_i8(aop[s2], bop, acc[nt], 0, 0, 0);
        }
      lds_fence();
      float ss = 0.f;
      if (g == 0) {
#pragma unroll
        for (int nt = 0; nt < 8; ++nt) { const float o = x1v[nt] + (float)acc[nt][0] * sa; orow[nt * 16] = o; ss += o * o; }
      }
      ss += __int_as_float(__builtin_amdgcn_update_dpp(0, __float_as_int(ss), 0xB1, 0xf, 0xf, true));
      ss += __int_as_float(__builtin_amdgcn_update_dpp(0, __float_as_int(ss), 0x4E, 0xf, 0xf, true));
      ss += __int_as_float(__builtin_amdgcn_update_dpp(0, __float_as_int(ss), 0x141, 0xf, 0xf, true));
      ss += __int_as_float(__builtin_amdgcn_update_dpp(0, __float_as_int(ss), 0x140, 0xf, 0xf, true));
      if (lane == 0) atomicAdd(&ssq[tok], ss);
    }
#undef PVM_META
  }
}

__device__ __forceinline__ void phase_final(const Params& p) {
  const float* ssq = (const float*)(p.ws + WS_SSQ);
  const int lane = threadIdx.x & 63, w = threadIdx.x >> 6;
  for (int row = blockIdx.x * 8 + w; row < TOK; row += gridDim.x * 8) {
    const float rstd = rsqrtf(ssq[row] * (1.f / DM) + EPSV);
    float4* o4 = (float4*)(p.out + (size_t)row * DM);
#pragma unroll
    for (int i = 0; i < 4; ++i) {
      float4 v = o4[lane + 64 * i];
      const float4 gg = ((const float4*)p.norm_final)[lane + 64 * i];
      v.x *= rstd * gg.x; v.y *= rstd * gg.y; v.z *= rstd * gg.z; v.w *= rstd * gg.w;
      o4[lane + 64 * i] = v;
    }
  }
}


__device__ __forceinline__ void phase_proj8(const Params& p, unsigned char* smem) {
  unsigned char* ws = p.ws;
  pg8::Gemm g{(const pg8::bf16_t*)(ws + WS_XN), (const pg8::bf16_t*)(ws + WS_WIN), TOK, 5120, 512};
  pg8::StaticOrder S; S.init(TOK, 5120, (int)gridDim.x, (int)blockIdx.x);
  EpiProj E{(unsigned short*)(ws + WS_PH), (unsigned short*)(ws + WS_PA), (unsigned short*)(ws + WS_PG),
            (unsigned short*)(ws + WS_KC), (unsigned short*)(ws + WS_VC), (unsigned short*)(ws + WS_IKC),
            (const float*)(ws + WS_XNS), (const float*)(ws + WS_WINS)};
  pg8::gemm_phase<EpiProj, pg8::StaticOrder, false, true>((PG8_LAS unsigned char*)smem, g, S, E, nullptr);
}
__device__ __forceinline__ void phase_ikln(const Params& p) {
  bf16_t* ikc = (bf16_t*)(p.ws + WS_IKC);
  const int tid = threadIdx.x, sub = tid & 7;
  float gam[8], bet[8];
#pragma unroll
  for (int i = 0; i < 8; ++i) { gam[i] = p.ikg[sub * 8 + i]; bet[i] = p.ikb[sub * 8 + i]; }
  for (int row = blockIdx.x * 64 + (tid >> 3); row < TOK; row += gridDim.x * 64) {
    uint4* ptr = (uint4*)(ikc + (size_t)row * 64 + sub * 8);
    const uint4 raw = *ptr;
    float v[8];
    cvt8(raw, v);
    float s = 0.f;
#pragma unroll
    for (int i = 0; i < 8; ++i) s += v[i];
    s += __shfl_xor(s, 1); s += __shfl_xor(s, 2); s += __shfl_xor(s, 4);
    const float mu = s * (1.f / 64.f);
    float q = 0.f;
#pragma unroll
    for (int i = 0; i < 8; ++i) { const float d = v[i] - mu; q += d * d; }
    q += __shfl_xor(q, 1); q += __shfl_xor(q, 2); q += __shfl_xor(q, 4);
    const float rstd = rsqrtf(q * (1.f / 64.f) + EPSV);
    uint4 o;
    o.x = pack2((v[0] - mu) * rstd * gam[0] + bet[0], (v[1] - mu) * rstd * gam[1] + bet[1]);
    o.y = pack2((v[2] - mu) * rstd * gam[2] + bet[2], (v[3] - mu) * rstd * gam[3] + bet[3]);
    o.z = pack2((v[4] - mu) * rstd * gam[4] + bet[4], (v[5] - mu) * rstd * gam[5] + bet[5]);
    o.w = pack2((v[6] - mu) * rstd * gam[6] + bet[6], (v[7] - mu) * rstd * gam[7] + bet[7]);
    *ptr = o;
  }
}
__device__ __forceinline__ void phase_up8(const Params& p, unsigned char* smem) {
  unsigned char* ws = p.ws;
  pg8::Gemm g{(const pg8::bf16_t*)(ws + WS_XN), (const pg8::bf16_t*)(ws + WS_WUPA), TOK, 1024, 1024};
  pg8::StaticOrder S; S.init(TOK, 1024, (int)gridDim.x, (int)blockIdx.x);
  EpiGate2 E{(unsigned short*)(ws + WS_PH), (const unsigned short*)(ws + WS_PG)};
  pg8::gemm_phase<EpiGate2, pg8::StaticOrder>((PG8_LAS unsigned char*)smem, g, S, E, nullptr);
}
__device__ __forceinline__ void phase_out8(const Params& p, unsigned char* smem) {
  unsigned char* ws = p.ws;
  pg8::Gemm g{(const pg8::bf16_t*)(ws + WS_PH), (const pg8::bf16_t*)(ws + WS_WOUT), TOK, 1024, 1024};
  pg8::StaticOrder S; S.init(TOK, 1024, (int)gridDim.x, (int)blockIdx.x);
  EpiResid E{p.out, p.x};
  pg8::gemm_phase<EpiResid, pg8::StaticOrder>((PG8_LAS unsigned char*)smem, g, S, E, nullptr);
}
__device__ __forceinline__ void phase_pq8(const Params& p, unsigned char* smem) {
  unsigned char* ws = p.ws;
  pg8::Gemm g{(const pg8::bf16_t*)(ws + WS_XQ), (const pg8::bf16_t*)(ws + WS_WQ), TOK, 2048, 512};
  pg8::StaticOrder S; S.init(TOK, 2048, (int)gridDim.x, (int)blockIdx.x);
  EpiStoreBf16Q E{(unsigned short*)(ws + WS_PG), 2048, (const float*)(ws + WS_XS), (const float*)(ws + WS_WQS)};
  pg8::gemm_phase<EpiStoreBf16Q, pg8::StaticOrder, false, true>((PG8_LAS unsigned char*)smem, g, S, E, nullptr);
}

__global__ void __launch_bounds__(NTHREADS) hybrid_fwd(Params p) {
  extern __shared__ __attribute__((aligned(16))) unsigned char smem[];
#if ONE_LAUNCH
  cg::grid_group grid = cg::this_grid();
  volatile LAS unsigned* xst = (volatile LAS unsigned*)(smem + LDS_BYTES - 16);
  if (threadIdx.x == 0) { xst[0] = 0u; xst[1] = 0u; }
  __syncthreads();
  XcdBarrier xbar = xcd_barrier_post((unsigned*)(p.ws + WS_BAR), xst);
#define SEAM(k) do { if (p.ph_lo <= (k) && (k) + 1 < p.ph_hi) { if (p.ph_hi > NPHASE) grid.sync(); else xcd_barrier(xbar); } } while (0)
#else
#define SEAM(k) do { } while (0)
#endif
#define IN(k) (p.ph_lo <= (k) && (k) < p.ph_hi)
#ifndef REPEAT_PH
#define REPEAT_PH -1
#endif
#define REP(k, stmt) do { if (REPEAT_PH == (k)) { stmt; grid.sync(); } } while (0)
  if (IN(0)) { phase_prep(p, smem); SEAM(0); }
  if (IN(1)) { phase_proj8(p, smem); SEAM(1); }
  if (IN(2)) { phase_ikln(p); hgrn_h1_all(p, smem); SEAM(2); }
  if (IN(3)) { phase_mix(p, smem); SEAM(3); }
  if (IN(4)) { phase_up8(p, smem); SEAM(4); }
  if (IN(5)) { phase_out8(p, smem); SEAM(5); }
  if (IN(6)) { rmsnorm_rows_q<false>(p.out, p.norm_ffn, nullptr, p.ws + WS_XQ, (float*)(p.ws + WS_XS)); SEAM(6); }
  if (IN(7)) { phase_pq8(p, smem); SEAM(7); }
  if (IN(8)) { phase_pkeys(p, smem); SEAM(8); }
  if (IN(9)) { phase_pu(p, smem); SEAM(9); }
  if (IN(10)) { phase_pv_mfma(p, smem); SEAM(10); }
  if (IN(11)) { phase_final(p); }
#undef IN
#undef SEAM
}

extern "C" void kernel_launch(void* const* d_in, const int* in_sizes, int n_in, void* d_out, int out_size, void* d_ws, size_t ws_size,
                              hipStream_t stream) {
  static int grid = 0;
  if (grid == 0) {
    if (n_in != 17 || ws_size < WS_END) {
      fprintf(stderr, "kernel_launch: unexpected n_in %d or ws_size %zu (need %zu)\n", n_in, ws_size, (size_t)WS_END);
      grid = -1; return;
    }
    int dev = 0, cus = 0, per_cu = 0;
    hipGetDevice(&dev);
    hipDeviceGetAttribute(&cus, hipDeviceAttributeMultiprocessorCount, dev);
    hipFuncSetAttribute((const void*)hybrid_fwd, hipFuncAttributeMaxDynamicSharedMemorySize, LDS_BYTES);
    hipOccupancyMaxActiveBlocksPerMultiprocessor(&per_cu, (const void*)hybrid_fwd, NTHREADS, LDS_BYTES);
    if (per_cu < 1) { fprintf(stderr, "kernel_launch: occupancy query says %d blocks/CU\n", per_cu); per_cu = 1; }
    (void)hipGetLastError();
    grid = cus;
  }
  if (grid < 0) return;
  Params p{};
  p.x = (const float*)d_in[0]; p.norm_mix = (const float*)d_in[1]; p.w_in = (const float*)d_in[2]; p.hg_lb = (const float*)d_in[3];
  p.hg_norm = (const float*)d_in[4]; p.ikg = (const float*)d_in[5]; p.ikb = (const float*)d_in[6]; p.rel_bias = (const float*)d_in[7];
  p.w_up_a = (const float*)d_in[8]; p.w_up_b = (const float*)d_in[9]; p.w_out = (const float*)d_in[10]; p.norm_ffn = (const float*)d_in[11];
  p.peer_wq = (const float*)d_in[12]; p.peer_keys = (const float*)d_in[13]; p.peer_u = (const float*)d_in[14]; p.peer_v = (const float*)d_in[15];
  p.norm_final = (const float*)d_in[16];
  p.out = (float*)d_out; p.ws = (unsigned char*)d_ws;
#if ONE_LAUNCH
  hipMemsetAsync((unsigned char*)d_ws + WS_BAR, 0, 16384, stream);
  p.ph_lo = 0; p.ph_hi = NPHASE;
  void* args[] = {&p};
  hipError_t e = hipLaunchCooperativeKernel((const void*)hybrid_fwd, dim3(grid), dim3(NTHREADS), args, LDS_BYTES, stream);
  if (e != hipSuccess) fprintf(stderr, "cooperative launch failed: %s (grid %d)\n", hipGetErrorString(e), grid);
#else
  for (int ph = 0; ph < NPHASE; ++ph) {
    p.ph_lo = ph; p.ph_hi = ph + 1;
    hipLaunchKernelGGL(hybrid_fwd, dim3(grid), dim3(NTHREADS), LDS_BYTES, stream, p);
  }
#endif
}
```

```cpp
#include <hip/hip_runtime.h>
#include <hip/hip_cooperative_groups.h>
#include <stdint.h>
#include <stdio.h>
namespace cg = cooperative_groups;

#ifndef ONE_LAUNCH
#define ONE_LAUNCH 1
#endif

typedef unsigned short bf16_t;
typedef __attribute__((ext_vector_type(8))) short bf16x8;
typedef __attribute__((ext_vector_type(4))) float f32x4;

#define NTHREADS 512
#define TOK 32768
#define SEQL 4096
#define DM 1024
#define EPSV 1e-6f
#define NPHASE 12

#define WS_WIN   ((size_t)0)
#define WS_WUPA  (WS_WIN  + (size_t)5120 * 1024 * 2)
#define WS_WUPB  (WS_WUPA + (size_t)1024 * 512 * 2)
#define WS_WOUT  (WS_WUPB + (size_t)1024 * 512 * 2)
#define WS_WQ    (WS_WOUT + (size_t)1024 * 1024 * 2)
#define WS_KEYS  (WS_WQ   + (size_t)2048 * 1024 * 2)
#define WS_LB    (WS_KEYS + (size_t)2 * 8 * 128 * 128 * 2)
#define WS_U     (WS_LB   + (size_t)4096)
#define WS_V     (WS_U    + (size_t)16384 * 1024 * 2)
#define WS_XN    (WS_V    + (size_t)16384 * 1024 * 2)
#define WS_PH    (WS_XN   + (size_t)TOK * 1024 * 2)
#define WS_PA    (WS_PH   + (size_t)TOK * 2048 * 2)
#define WS_PG    (WS_PA   + (size_t)TOK * 1024 * 2)
#define WS_EIDX  (WS_PG   + (size_t)TOK * 2048 * 2)
#define WS_GW    (WS_EIDX + (size_t)TOK * 128 * 4)
#define WS_SSQ   (WS_GW   + (size_t)TOK * 128 * 4)
#define WS_XCC   (WS_SSQ  + (size_t)TOK * 4)
#define WS_BAR   (WS_XCC  + (size_t)4096)
#define WS_DEC   (WS_BAR  + (size_t)16384)
#define WS_QCTR  (WS_DEC  + (size_t)2048 * 384 * 4)
#define WS_END   (WS_QCTR + (size_t)1024)

#define WS_KC (WS_EIDX)
#define WS_VC (WS_KC + (size_t)TOK * 128)
#define WS_IKC (WS_VC + (size_t)TOK * 128)
#define LDS_BYTES 155648

struct Params {
  const float* x; const float* norm_mix; const float* w_in; const float* hg_lb; const float* hg_norm;
  const float* ikg; const float* ikb; const float* rel_bias; const float* w_up_a; const float* w_up_b;
  const float* w_out; const float* norm_ffn; const float* peer_wq; const float* peer_keys;
  const float* peer_u; const float* peer_v; const float* norm_final;
  float* out; unsigned char* ws; int ph_lo, ph_hi;
};

__device__ __forceinline__ float bf2f(bf16_t u) { return __uint_as_float(((unsigned)u) << 16); }
typedef float f32x2_cv __attribute__((ext_vector_type(2)));
typedef __bf16 bf16x2_cv __attribute__((ext_vector_type(2)));
__device__ __forceinline__ unsigned pack2(float a, float b) {
  const f32x2_cv v = {a, b};
  return __builtin_bit_cast(unsigned, __builtin_convertvector(v, bf16x2_cv));
}
__device__ __forceinline__ bf16_t f2bf(float f) { return (bf16_t)(pack2(f, f) & 0xffffu); }
__device__ __forceinline__ float wave_sum_slow(float v) {
#pragma unroll
  for (int o = 32; o > 0; o >>= 1) v += __shfl_xor(v, o);
  return v;
}
__device__ __forceinline__ void lds_fence() { asm volatile("s_waitcnt lgkmcnt(0)" ::: "memory"); }

__device__ __forceinline__ float add_xor8(float v) { return v + __int_as_float(__builtin_amdgcn_update_dpp(0, __float_as_int(v), 0x128, 0xf, 0xf, true)); }
__device__ __forceinline__ float add_xor16(float v) { const auto r = __builtin_amdgcn_permlane16_swap(__float_as_uint(v), __float_as_uint(v), false, false); return __uint_as_float(r[0]) + __uint_as_float(r[1]); }
__device__ __forceinline__ float add_xor32(float v) { const auto r = __builtin_amdgcn_permlane32_swap(__float_as_uint(v), __float_as_uint(v), false, false); return __uint_as_float(r[0]) + __uint_as_float(r[1]); }
__device__ __forceinline__ float max_xor16(float v) { const auto r = __builtin_amdgcn_permlane16_swap(__float_as_uint(v), __float_as_uint(v), false, false); return fmaxf(__uint_as_float(r[0]), __uint_as_float(r[1])); }
__device__ __forceinline__ float max_xor32(float v) { const auto r = __builtin_amdgcn_permlane32_swap(__float_as_uint(v), __float_as_uint(v), false, false); return fmaxf(__uint_as_float(r[0]), __uint_as_float(r[1])); }
__device__ __forceinline__ float wave_sum(float v) {
  v += __int_as_float(__builtin_amdgcn_update_dpp(0, __float_as_int(v), 0xB1, 0xf, 0xf, true));
  v += __int_as_float(__builtin_amdgcn_update_dpp(0, __float_as_int(v), 0x4E, 0xf, 0xf, true));
  v += __int_as_float(__builtin_amdgcn_update_dpp(0, __float_as_int(v), 0x141, 0xf, 0xf, true));
  v += __int_as_float(__builtin_amdgcn_update_dpp(0, __float_as_int(v), 0x140, 0xf, 0xf, true));
  return add_xor32(add_xor16(v));
}
__device__ __forceinline__ float sigmoidf_(float x) { return 1.f / (1.f + __expf(-x)); }
__device__ __forceinline__ float siluf_(float x) { return x / (1.f + __expf(-x)); }


#define XB_TMO      128
#define XB_XCNT(j)  (256  + 64 * (j))
#define XB_XSUB(j)  (1280 + 64 * (j))
#define XB_XGEN(j)  (2304 + 64 * (j))
#define XB_TOP      3328
#define XB_TOPGEN   3392
#define XCD_BAR_WORDS 3456
#define XB_SPIN_CAP (1u << 22)
#define LAS __attribute__((address_space(3)))
__device__ __forceinline__ unsigned xb_ld(unsigned* p)              { return __hip_atomic_load(p, __ATOMIC_RELAXED, __HIP_MEMORY_SCOPE_AGENT); }
__device__ __forceinline__ unsigned xb_add(unsigned* p, unsigned v) { return __hip_atomic_fetch_add(p, v, __ATOMIC_RELAXED, __HIP_MEMORY_SCOPE_AGENT); }
__device__ __forceinline__ unsigned xb_xcc_id() { return (unsigned)__builtin_amdgcn_s_getreg((3 << 11) | 20) & 0xFu; }
#define XB_SPIN(cond, bar) do { unsigned _sp = 0; while (cond) { __builtin_amdgcn_s_sleep(1); \
    if ((++_sp & 255u) == 0u) { if (xb_ld(&(bar)[XB_TMO])) break; if (_sp > XB_SPIN_CAP) { atomicAdd(&(bar)[XB_TMO], 1u); break; } } } } while (0)
struct XcdBarrier { unsigned* bar; unsigned x; volatile LAS unsigned* st; };
__device__ __forceinline__ XcdBarrier xcd_barrier_post(unsigned* bar, volatile LAS unsigned* st) {
  XcdBarrier b; b.bar = bar; b.x = xb_xcc_id(); b.st = st;
  if (threadIdx.x == 0) (void)xb_add(&bar[XB_XCNT(b.x)], 1u);
  return b;
}
__device__ __forceinline__ void xcd_barrier_complete(unsigned* bar, unsigned x, unsigned& nloc, unsigned& nx) {
  const unsigned G = gridDim.x * gridDim.y * gridDim.z;
  unsigned sum, cnt, mine, sp = 0u;
  for (;;) {
    sum = 0u; cnt = 0u; mine = 0u;
#pragma unroll
    for (unsigned j = 0; j < 16; ++j) { const unsigned c = xb_ld(&bar[XB_XCNT(j)]); sum += c; cnt += (c > 0u) ? 1u : 0u; mine = (j == x) ? c : mine; }
    if (sum == G) break;
    __builtin_amdgcn_s_sleep(1);
    if ((++sp & 255u) == 0u) { if (xb_ld(&bar[XB_TMO])) break; if (sp > XB_SPIN_CAP) { atomicAdd(&bar[XB_TMO], 1u); break; } }
  }
  nloc = mine > 0u ? mine : 1u; nx = cnt > 0u ? cnt : 1u;
}
__device__ __forceinline__ void xcd_barrier(const XcdBarrier& b) {
  asm volatile("s_waitcnt vmcnt(0)" ::: "memory");
  __syncthreads();
  if (threadIdx.x == 0) {
    unsigned* bar = b.bar;
    __builtin_amdgcn_s_waitcnt(0);
    unsigned nloc = b.st[0], nx = b.st[1];
    if (nloc == 0u) { xcd_barrier_complete(bar, b.x, nloc, nx); b.st[0] = nloc; b.st[1] = nx; }
    const unsigned old = xb_add(&bar[XB_XSUB(b.x)], 1u);
    const unsigned gen = old / nloc;
    if (old + 1u == (gen + 1u) * nloc) {
      __builtin_amdgcn_fence(__ATOMIC_RELEASE, "agent");
      asm volatile("s_waitcnt vmcnt(0)" ::: "memory");
      const unsigned og = xb_add(&bar[XB_TOP], 1u);
      const unsigned tg = og / nx;
      if (og + 1u == (tg + 1u) * nx) xb_add(&bar[XB_TOPGEN], 1u);
      else XB_SPIN(xb_ld(&bar[XB_TOPGEN]) == tg, bar);
      __builtin_amdgcn_fence(__ATOMIC_ACQUIRE, "agent");
      xb_add(&bar[XB_XGEN(b.x)], 1u);
      asm volatile("s_waitcnt vmcnt(0)" ::: "memory");
    } else {
      XB_SPIN(xb_ld(&bar[XB_XGEN(b.x)]) == gen, bar);
      __builtin_amdgcn_fence(__ATOMIC_ACQUIRE, "agent");
      asm volatile("s_waitcnt vmcnt(0)" ::: "memory");
    }
  }
  __syncthreads();
}

namespace pg8 {
#define PG8_LAS __attribute__((address_space(3)))
typedef unsigned short bf16_t;
typedef short bf16x8 __attribute__((ext_vector_type(8)));
typedef float f32x4 __attribute__((ext_vector_type(4)));
typedef unsigned u32x4 __attribute__((ext_vector_type(4)));
constexpr int BM = 256, BK = 64, HALF = 128, HTB = HALF * BK * 2  , STAGE_BYTES = 8 * HTB, NXCD = 8, WGM = 8;

__host__ __device__ __forceinline__ int lds_byte(int r, int c) { const int st = (r >> 4) * 2 + (c >> 5), rr = r & 15, cc = c & 31, ob = rr * 64 + cc * 2; return st * 1024 + (ob ^ (((ob >> 9) & 1) << 5)); }
__host__ __device__ __forceinline__ void stage_rc(int b, int& R, int& C) { const int st = b / 1024, sb = b % 1024, swz = sb ^ (((sb >> 9) & 1) << 5); R = (st >> 1) * 16 + swz / 64; C = (st & 1) * 32 + (swz % 64) / 2; }
__host__ __device__ __forceinline__ int perm32(int rho) { const int n = rho >> 4, i = rho & 15; return 8 * (i >> 2) + 4 * n + (i & 3); }

struct Unit { int pm, pn; };
struct Gemm { const bf16_t* A; const bf16_t* Bt; int M, N, K; };

struct StaticOrder {
    int nM, nN, nwg, G, c;
    __host__ __device__ void init(int M, int N, int G_, int c_) { nM = M / BM; nN = N / BM; nwg = nM * nN; G = G_; c = c_; }
    __host__ __device__ bool next(int i, Unit& u) const {
        const long L = (long)i * G + c; if (L >= nwg) return false;
        int wgid = (int)L; { const int q = nwg / NXCD, r = nwg % NXCD, xcd = wgid % NXCD, off = wgid / NXCD; wgid = (xcd < r ? xcd * (q + 1) : r * (q + 1) + (xcd - r) * q) + off; }
        const int nig = WGM * nN, gid = wgid / nig, fm = gid * WGM, gsz = (nM - fm) < WGM ? (nM - fm) : WGM;
        u.pm = fm + ((wgid % nig) % gsz); u.pn = (wgid % nig) / gsz; return true;
    }
    __device__ __forceinline__ void a_ready(const Unit&) const {}
    __device__ __forceinline__ void done(const Unit&) const {}
};
__device__ __forceinline__ unsigned cvt_pk_bf16(float lo, float hi) { unsigned r; asm volatile("v_cvt_pk_bf16_f32 %0, %1, %2" : "=v"(r) : "v"(lo), "v"(hi)); return r; }
typedef int i32x4 __attribute__((ext_vector_type(4)));
template <class Epi, class Sched, bool STAMP = false, bool I8 = false>
__device__ __forceinline__ void gemm_phase(PG8_LAS unsigned char* lds, const Gemm g, const Sched& S, const Epi& E, unsigned long long* stamps) {
    const int tid = threadIdx.x, wid = __builtin_amdgcn_readfirstlane(tid >> 6), lane = tid & 63, wr = wid >> 2, wc = wid & 3, fr = lane & 15, fq = lane >> 4;
    const int K = g.K, nt = K / BK;
    int ts_lo = 0, ts_hi = 0, nts = 0; const unsigned long long rt_entry = STAMP ? (unsigned long long)wall_clock64() : 0ull;
#define PG8_STAMP() do { if (STAMP && wid == 0 && nts < 64) { const unsigned long long _c = (unsigned long long)clock64(); \
        ts_lo = (lane == nts) ? (int)(unsigned)_c : ts_lo; ts_hi = (lane == nts) ? (int)(unsigned)(_c >> 32) : ts_hi; ++nts; } } while (0)
    PG8_STAMP();
    unsigned voffA[2], voffB[2];
#pragma unroll
    for (int i = 0; i < 2; ++i) { int R, C; stage_rc(tid * 16 + i * 8192, R, C); const int Rb = Epi::PERM ? ((R & ~31) + perm32(R & 31)) : R;
        voffA[i] = (unsigned)(R * K + C) * 2u; voffB[i] = (unsigned)(Rb * K + C) * 2u; }
    const size_t kstep = (size_t)(BK * 2);
    const size_t hstep = (size_t)HALF * K * 2;
    const size_t tstep = 2 * hstep;
    const unsigned ldsw = (unsigned)wid * 1024u;
    const int aoff = lds_byte(wr * 64 + fr, fq * 8), boff = lds_byte(wc * 32 + fr, fq * 8);
#define PG8_SA(b, h) (((b) * 2 + (h)) * HTB)
#define PG8_SB(b, h) ((4 + (b) * 2 + (h)) * HTB)
#define PG8_STAGE(bufoff, gbase, voff) do { _Pragma("unroll") for (int _i = 0; _i < 2; ++_i) \
        __builtin_amdgcn_global_load_lds((const unsigned*)((const char*)(gbase) + (voff)[_i]), (PG8_LAS unsigned*)(lds + (bufoff) + ldsw + _i * 8192), 16, 0, 0); } while (0)
#define PG8_LDA(dst, b, h) do { _Pragma("unroll") for (int m = 0; m < 4; ++m) _Pragma("unroll") for (int k = 0; k < 2; ++k) dst[m][k] = *(const PG8_LAS bf16x8*)(lds + PG8_SA(b, h) + aoff + m * 2048 + k * 1024); } while (0)
#define PG8_LDB(dst, b, h) do { _Pragma("unroll") for (int n = 0; n < 2; ++n) _Pragma("unroll") for (int k = 0; k < 2; ++k) dst[n][k] = *(const PG8_LAS bf16x8*)(lds + PG8_SB(b, h) + boff + n * 2048 + k * 1024); } while (0)
#define PG8_MMA(ai, bj, At, Bt) do { __builtin_amdgcn_s_setprio(1); _Pragma("unroll") for (int m = 0; m < 4; ++m) _Pragma("unroll") for (int n = 0; n < 2; ++n) _Pragma("unroll") for (int k = 0; k < 2; ++k) \
        { if constexpr (I8) acc[ai][bj][m][n] = __builtin_bit_cast(f32x4, __builtin_amdgcn_mfma_i32_16x16x64_i8(__builtin_bit_cast(i32x4, Bt[n][k]), __builtin_bit_cast(i32x4, At[m][k]), __builtin_bit_cast(i32x4, acc[ai][bj][m][n]), 0, 0, 0)); \
          else acc[ai][bj][m][n] = __builtin_amdgcn_mfma_f32_16x16x32_bf16(Bt[n][k], At[m][k], acc[ai][bj][m][n], 0, 0, 0); } __builtin_amdgcn_s_setprio(0); } while (0)
#define PG8_WAIT_V(n) asm volatile("s_waitcnt vmcnt(" #n ")" ::: "memory")
#define PG8_WAIT_L(n) asm volatile("s_waitcnt lgkmcnt(" #n ")" ::: "memory")
#define PG8_BAR __builtin_amdgcn_s_barrier()
#define PG8_SCHED __builtin_amdgcn_sched_barrier(0)
    Unit cur, nxt; int ui = 0;
    if (!S.next(0, cur)) return;
    f32x4 acc[2][2][4][2];
#pragma unroll
    for (int a = 0; a < 2; ++a)
#pragma unroll
        for (int b = 0; b < 2; ++b)
#pragma unroll
            for (int m = 0; m < 4; ++m)
#pragma unroll
                for (int n = 0; n < 2; ++n) acc[a][b][m][n] = (f32x4){0.f, 0.f, 0.f, 0.f};
    bf16x8 At[4][2], B0[2][2], B1[2][2];
    const char* cA = (const char*)g.A + (size_t)cur.pm * tstep; const char* cB = (const char*)g.Bt + (size_t)cur.pn * tstep;
    S.a_ready(cur);
    PG8_STAGE(PG8_SB(0, 0), cB, voffB); PG8_STAGE(PG8_SA(0, 0), cA, voffA); PG8_STAGE(PG8_SB(0, 1), cB + hstep, voffB); PG8_STAGE(PG8_SA(0, 1), cA + hstep, voffA);
    if (wr == 1) PG8_BAR;
    PG8_WAIT_V(4); PG8_BAR;
    PG8_STAGE(PG8_SB(1, 0), cB + kstep, voffB); PG8_STAGE(PG8_SA(1, 0), cA + kstep, voffA); PG8_STAGE(PG8_SB(1, 1), cB + hstep + kstep, voffB);
    PG8_WAIT_V(6); PG8_BAR;
    PG8_STAMP();
    for (;;) {
        const bool has_next = S.next(ui + 1, nxt);
        const char* nA = has_next ? (const char*)g.A + (size_t)nxt.pm * tstep : cA; const char* nB = has_next ? (const char*)g.Bt + (size_t)nxt.pn * tstep : cB;
        for (int t = 0; t < nt; t += 2) {
            const bool last = (t == nt - 2);
            const char* a1 = cA + (size_t)(t + 1) * kstep;
            const char* a2 = last ? nA : cA + (size_t)(t + 2) * kstep; const char* b2 = last ? nB : cB + (size_t)(t + 2) * kstep;
            const char* a3 = a2 + kstep; const char* b3 = b2 + kstep;
            if constexpr (Epi::MID) { if (t == nt / 2) E.mid(acc, cur, wr, wc, fr, fq); }
            if (last && has_next) S.a_ready(nxt);
            PG8_LDB(B0, 0, 0); PG8_SCHED; PG8_LDA(At, 0, 0); PG8_STAGE(PG8_SA(1, 1), a1 + hstep, voffA);
            PG8_WAIT_L(8); PG8_BAR; PG8_WAIT_L(0); PG8_MMA(0, 0, At, B0); PG8_BAR; PG8_SCHED;
            PG8_LDB(B1, 0, 1); PG8_STAGE(PG8_SB(0, 0), b2, voffB);
            PG8_BAR; PG8_WAIT_L(0); PG8_MMA(0, 1, At, B1); PG8_BAR;
            PG8_LDA(At, 0, 1); PG8_STAGE(PG8_SA(0, 0), a2, voffA);
            PG8_BAR; PG8_WAIT_L(0); PG8_MMA(1, 0, At, B0); PG8_BAR; PG8_SCHED;
            PG8_STAGE(PG8_SB(0, 1), b2 + hstep, voffB);
            PG8_WAIT_V(6); PG8_BAR; PG8_MMA(1, 1, At, B1); PG8_BAR;
            PG8_LDB(B0, 1, 0); PG8_SCHED; PG8_LDA(At, 1, 0); PG8_STAGE(PG8_SA(0, 1), a2 + hstep, voffA);
            PG8_WAIT_L(8); PG8_BAR; PG8_WAIT_L(0); PG8_MMA(0, 0, At, B0); PG8_BAR; PG8_SCHED;
            PG8_LDB(B1, 1, 1); PG8_STAGE(PG8_SB(1, 0), b3, voffB);
            PG8_BAR; PG8_WAIT_L(0); PG8_MMA(0, 1, At, B1); PG8_BAR;
            PG8_LDA(At, 1, 1); PG8_STAGE(PG8_SA(1, 0), a3, voffA);
            PG8_BAR; PG8_WAIT_L(0); PG8_MMA(1, 0, At, B0); PG8_BAR; PG8_SCHED;
            PG8_STAGE(PG8_SB(1, 1), b3 + hstep, voffB);
            PG8_WAIT_V(6); PG8_BAR; PG8_MMA(1, 1, At, B1); PG8_BAR;
        }
        PG8_STAMP();
        if constexpr (!Epi::AFTER_DRAIN) { E(acc, cur, wr, wc, fr, fq); S.done(cur); }
        PG8_STAMP();
        if (!has_next) break;
#pragma unroll
        for (int a = 0; a < 2; ++a)
#pragma unroll
            for (int b = 0; b < 2; ++b)
#pragma unroll
                for (int m = 0; m < 4; ++m)
#pragma unroll
                    for (int n = 0; n < 2; ++n) acc[a][b][m][n] = (f32x4){0.f, 0.f, 0.f, 0.f};
        cur = nxt; cA = nA; cB = nB; ++ui;
    }
    PG8_WAIT_V(0);
    if (wr == 0) PG8_BAR;
    PG8_BAR;
    if constexpr (Epi::AFTER_DRAIN) { E.fused(acc, cur, wr, wc, fr, fq, lds, wid, lane); S.done(cur); }
    PG8_STAMP();
    if (STAMP && wid == 0) { stamps[lane] = lane < nts ? (((unsigned long long)(unsigned)ts_hi << 32) | (unsigned)ts_lo) : 0ull;
        if (lane == 62) stamps[62] = rt_entry; if (lane == 63) stamps[63] = (unsigned long long)wall_clock64(); }
#undef PG8_STAMP
#undef PG8_SA
#undef PG8_SB
#undef PG8_STAGE
#undef PG8_LDA
#undef PG8_LDB
#undef PG8_MMA
#undef PG8_WAIT_V
#undef PG8_WAIT_L
#undef PG8_BAR
#undef PG8_SCHED
}
}

struct EpiProj {
  static constexpr bool PERM = true, AFTER_DRAIN = false, MID = false;
  unsigned short* pH; unsigned short* pA; unsigned short* pG; unsigned short* kc; unsigned short* vc; unsigned short* ikc;
  const float* sa; const float* sw;
  __device__ __forceinline__ void operator()(const pg8::f32x4 (&acc)[2][2][4][2], const pg8::Unit& u, int wr, int wc, int fr, int fq) const {
    const int row0 = u.pm * 256 + wr * 64 + fr;
    pg8::f32x4 cs_[2][2];
#pragma unroll
    for (int bj = 0; bj < 2; ++bj)
#pragma unroll
      for (int n = 0; n < 2; ++n) cs_[bj][n] = *(const pg8::f32x4*)(sw + u.pn * 256 + bj * 128 + wc * 32 + 8 * fq + 4 * n);
    unsigned short* base; int ldc, colt; bool sg = false;
    if (u.pn < 8) { base = pH; ldc = 2048; colt = u.pn * 256; }
    else if (u.pn < 12) { base = pA; ldc = 1024; colt = (u.pn - 8) * 256; }
    else { base = pG; ldc = 2048; colt = (u.pn - 12) * 256; sg = true; }
    const int col0 = colt + wc * 32 + 8 * fq;
#pragma unroll
    for (int ai = 0; ai < 2; ++ai)
#pragma unroll
      for (int m = 0; m < 4; ++m) {
        unsigned short* rowp = base + (size_t)(row0 + ai * 128 + m * 16) * ldc + col0;
        const float ra = sa[row0 + ai * 128 + m * 16];
#pragma unroll
        for (int bj = 0; bj < 2; ++bj) {
          pg8::f32x4 v0, v1;
#pragma unroll
          for (int j = 0; j < 4; ++j) { v0[j] = (float)__float_as_int(acc[ai][bj][m][0][j]) * (ra * cs_[bj][0][j]); v1[j] = (float)__float_as_int(acc[ai][bj][m][1][j]) * (ra * cs_[bj][1][j]); }
          if (sg) {
#pragma unroll
            for (int j = 0; j < 4; ++j) { v0[j] = sigmoidf_(v0[j]); v1[j] = sigmoidf_(v1[j]); }
          }
          pg8::u32x4 w; w.x = pg8::cvt_pk_bf16(v0[0], v0[1]); w.y = pg8::cvt_pk_bf16(v0[2], v0[3]); w.z = pg8::cvt_pk_bf16(v1[0], v1[1]); w.w = pg8::cvt_pk_bf16(v1[2], v1[3]);
          unsigned short* dst = rowp + bj * 128;
          if (u.pn == 10 || u.pn == 11) {
            const int cs = col0 + bj * 128;
            const size_t r = (size_t)(row0 + ai * 128 + m * 16);
            if (cs >= 512 && cs < 576) dst = kc + r * 64 + (cs - 512);
            else if (cs >= 576 && cs < 640) dst = vc + r * 64 + (cs - 576);
            else if (cs >= 896 && cs < 960) dst = ikc + r * 64 + (cs - 896);
          }
          *(pg8::u32x4*)dst = w;
        }
      }
  }
};
template <int MODE> struct EpiGate {
  static constexpr bool PERM = true, AFTER_DRAIN = false, MID = false;
  unsigned short* hb; const unsigned short* pG; int goff;
  __device__ __forceinline__ void operator()(const pg8::f32x4 (&acc)[2][2][4][2], const pg8::Unit& u, int wr, int wc, int fr, int fq) const {
    const int row0 = u.pm * 256 + wr * 64 + fr;
    const int col0 = u.pn * 256 + wc * 32 + 8 * fq;
#pragma unroll
    for (int ai = 0; ai < 2; ++ai)
#pragma unroll
      for (int m = 0; m < 4; ++m) {
        const size_t r = (size_t)(row0 + ai * 128 + m * 16);
        pg8::u32x4 gv[2], hv[2];
#pragma unroll
        for (int bj = 0; bj < 2; ++bj) {
          gv[bj] = *(const pg8::u32x4*)(pG + r * 2048 + goff + col0 + bj * 128);
          if (MODE == 1) hv[bj] = *(const pg8::u32x4*)(hb + r * 1024 + col0 + bj * 128);
        }
#pragma unroll
        for (int bj = 0; bj < 2; ++bj) {
          float o[8];
#pragma unroll
          for (int j = 0; j < 4; ++j) {
            const unsigned gw0 = gv[bj][j >> 1], gw1 = gv[bj][2 + (j >> 1)];
            const float g0 = (j & 1) ? __uint_as_float(gw0 & 0xffff0000u) : __uint_as_float(gw0 << 16);
            const float g1 = (j & 1) ? __uint_as_float(gw1 & 0xffff0000u) : __uint_as_float(gw1 << 16);
            o[j] = acc[ai][bj][m][0][j] * g0; o[4 + j] = acc[ai][bj][m][1][j] * g1;
            if (MODE == 1) {
              const unsigned hw0 = hv[bj][j >> 1], hw1 = hv[bj][2 + (j >> 1)];
              o[j] += (j & 1) ? __uint_as_float(hw0 & 0xffff0000u) : __uint_as_float(hw0 << 16);
              o[4 + j] += (j & 1) ? __uint_as_float(hw1 & 0xffff0000u) : __uint_as_float(hw1 << 16);
            }
          }
          pg8::u32x4 w; w.x = pg8::cvt_pk_bf16(o[0], o[1]); w.y = pg8::cvt_pk_bf16(o[2], o[3]); w.z = pg8::cvt_pk_bf16(o[4], o[5]); w.w = pg8::cvt_pk_bf16(o[6], o[7]);
          *(pg8::u32x4*)(hb + r * 1024 + col0 + bj * 128) = w;
        }
      }
  }
};
struct EpiGate2 {
  static constexpr bool PERM = true, AFTER_DRAIN = false, MID = true;
  unsigned short* hb; const unsigned short* pG;
  __device__ __forceinline__ void mid(pg8::f32x4 (&acc)[2][2][4][2], const pg8::Unit& u, int wr, int wc, int fr, int fq) const {
    int fr_o = fr, fq_o = fq;
    asm volatile("" : "+v"(fr_o), "+v"(fq_o));
    const unsigned short* gp = pG + (size_t)(u.pm * 256 + wr * 64 + fr_o) * 2048 + u.pn * 256 + wc * 32 + 8 * fq_o;
#pragma unroll
    for (int ai = 0; ai < 2; ++ai)
#pragma unroll
      for (int m = 0; m < 4; ++m)
#pragma unroll
        for (int bj = 0; bj < 2; ++bj) {
          const unsigned short* q = gp + (size_t)(ai * 128 + m * 16) * 2048 + bj * 128;
          const pg8::u32x4 gb = *(const pg8::u32x4*)(q + 1024);
          const pg8::u32x4 ga = *(const pg8::u32x4*)q;
#pragma unroll
          for (int wd = 0; wd < 4; ++wd) {
            const float rl = __uint_as_float(ga[wd] << 16) * __builtin_amdgcn_rcpf(__uint_as_float(gb[wd] << 16));
            const float rh = __uint_as_float(ga[wd] & 0xffff0000u) * __builtin_amdgcn_rcpf(__uint_as_float(gb[wd] & 0xffff0000u));
            acc[ai][bj][m][wd >> 1][2 * (wd & 1)] *= rl;
            acc[ai][bj][m][wd >> 1][2 * (wd & 1) + 1] *= rh;
          }
          if (bj == 1) asm volatile("" ::: "memory");
        }
  }
  __device__ __forceinline__ void operator()(const pg8::f32x4 (&acc)[2][2][4][2], const pg8::Unit& u, int wr, int wc, int fr, int fq) const {
    const int row0 = u.pm * 256 + wr * 64 + fr;
    const int col0 = u.pn * 256 + wc * 32 + 8 * fq;
#pragma unroll
    for (int ai = 0; ai < 2; ++ai)
#pragma unroll
      for (int m = 0; m < 4; ++m) {
        const size_t r = (size_t)(row0 + ai * 128 + m * 16);
        pg8::u32x4 gb[2];
#pragma unroll
        for (int bj = 0; bj < 2; ++bj) gb[bj] = *(const pg8::u32x4*)(pG + r * 2048 + 1024 + col0 + bj * 128);
#pragma unroll
        for (int bj = 0; bj < 2; ++bj) {
          float o[8];
#pragma unroll
          for (int j = 0; j < 4; ++j) {
            const unsigned b0 = gb[bj][j >> 1], b1 = gb[bj][2 + (j >> 1)];
            const float sb0 = (j & 1) ? __uint_as_float(b0 & 0xffff0000u) : __uint_as_float(b0 << 16);
            const float sb1 = (j & 1) ? __uint_as_float(b1 & 0xffff0000u) : __uint_as_float(b1 << 16);
            o[j] = acc[ai][bj][m][0][j] * sb0; o[4 + j] = acc[ai][bj][m][1][j] * sb1;
          }
          pg8::u32x4 w; w.x = pg8::cvt_pk_bf16(o[0], o[1]); w.y = pg8::cvt_pk_bf16(o[2], o[3]); w.z = pg8::cvt_pk_bf16(o[4], o[5]); w.w = pg8::cvt_pk_bf16(o[6], o[7]);
          *(pg8::u32x4*)(hb + r * 1024 + col0 + bj * 128) = w;
        }
      }
  }
};
struct EpiResid {
  static constexpr bool PERM = false, AFTER_DRAIN = false, MID = false;
  float* out; const float* x;
  __device__ __forceinline__ void operator()(const pg8::f32x4 (&acc)[2][2][4][2], const pg8::Unit& u, int wr, int wc, int fr, int fq) const {
    const int row0 = u.pm * 256 + wr * 64 + fr, col0 = u.pn * 256 + wc * 32 + 4 * fq;
#pragma unroll
    for (int ai = 0; ai < 2; ++ai)
#pragma unroll
      for (int m = 0; m < 4; ++m) {
        const size_t off = (size_t)(row0 + ai * 128 + m * 16) * 1024 + col0;
        pg8::f32x4 xv[2][2];
#pragma unroll
        for (int bj = 0; bj < 2; ++bj)
#pragma unroll
          for (int n = 0; n < 2; ++n) xv[bj][n] = *(const pg8::f32x4*)(x + off + bj * 128 + n * 16);
#pragma unroll
        for (int bj = 0; bj < 2; ++bj)
#pragma unroll
          for (int n = 0; n < 2; ++n) *(pg8::f32x4*)(out + off + bj * 128 + n * 16) = acc[ai][bj][m][n] + xv[bj][n];
      }
  }
};
struct EpiStoreBf16Q {
  static constexpr bool PERM = true, AFTER_DRAIN = false, MID = false;
  unsigned short* O; int ldc; const float* sa; const float* sw;
  __device__ __forceinline__ void operator()(const pg8::f32x4 (&acc)[2][2][4][2], const pg8::Unit& u, int wr, int wc, int fr, int fq) const {
    const int row0 = u.pm * 256 + wr * 64 + fr, col0 = u.pn * 256 + wc * 32 + 8 * fq;
    pg8::f32x4 cs_[2][2];
#pragma unroll
    for (int bj = 0; bj < 2; ++bj)
#pragma unroll
      for (int n = 0; n < 2; ++n) cs_[bj][n] = *(const pg8::f32x4*)(sw + col0 + bj * 128 + 4 * n);
#pragma unroll
    for (int ai = 0; ai < 2; ++ai)
#pragma unroll
      for (int m = 0; m < 4; ++m) {
        unsigned short* rowp = O + (size_t)(row0 + ai * 128 + m * 16) * ldc + col0;
        const float ra = sa[row0 + ai * 128 + m * 16];
#pragma unroll
        for (int bj = 0; bj < 2; ++bj) {
          pg8::f32x4 v0, v1;
#pragma unroll
          for (int j = 0; j < 4; ++j) { v0[j] = (float)__float_as_int(acc[ai][bj][m][0][j]) * (ra * cs_[bj][0][j]); v1[j] = (float)__float_as_int(acc[ai][bj][m][1][j]) * (ra * cs_[bj][1][j]); }
          pg8::u32x4 w; w.x = pg8::cvt_pk_bf16(v0[0], v0[1]); w.y = pg8::cvt_pk_bf16(v0[2], v0[3]); w.z = pg8::cvt_pk_bf16(v1[0], v1[1]); w.w = pg8::cvt_pk_bf16(v1[2], v1[3]);
          *(pg8::u32x4*)(rowp + bj * 128) = w;
        }
      }
  }
};
struct EpiStoreBf16 {
  static constexpr bool PERM = true, AFTER_DRAIN = false, MID = false;
  unsigned short* O; int ldc;
  __device__ __forceinline__ void operator()(const pg8::f32x4 (&acc)[2][2][4][2], const pg8::Unit& u, int wr, int wc, int fr, int fq) const {
    const int row0 = u.pm * 256 + wr * 64 + fr, col0 = u.pn * 256 + wc * 32 + 8 * fq;
#pragma unroll
    for (int ai = 0; ai < 2; ++ai)
#pragma unroll
      for (int m = 0; m < 4; ++m) {
        unsigned short* rowp = O + (size_t)(row0 + ai * 128 + m * 16) * ldc + col0;
#pragma unroll
        for (int bj = 0; bj < 2; ++bj) {
          const pg8::f32x4 v0 = acc[ai][bj][m][0], v1 = acc[ai][bj][m][1];
          pg8::u32x4 w; w.x = pg8::cvt_pk_bf16(v0[0], v0[1]); w.y = pg8::cvt_pk_bf16(v0[2], v0[3]); w.z = pg8::cvt_pk_bf16(v1[0], v1[1]); w.w = pg8::cvt_pk_bf16(v1[2], v1[3]);
          *(pg8::u32x4*)(rowp + bj * 128) = w;
        }
      }
  }
};

__device__ __forceinline__ void gemm_tile(const bf16_t* __restrict__ A, int lda, const bf16_t* __restrict__ Bt, int ldb,
                                          int nk, f32x4 (&acc)[4][4], unsigned char* smem) {
  const int tid = threadIdx.x, lane = tid & 63, w = tid >> 6, wm = w >> 1, wn = w & 1, l15 = lane & 15, g = lane >> 4;
  unsigned char* sA = smem;
  unsigned char* sB = smem + 32768;
  const int lr = tid >> 3, lc = tid & 7;
  const bf16_t* ga = A + (size_t)lr * lda + lc * 8;
  const bf16_t* gb = Bt + (size_t)lr * ldb + lc * 8;
  uint4 ra0, ra1, ra2, ra3, rb0, rb1;
  ra0 = *(const uint4*)(ga);
  ra1 = *(const uint4*)(ga + (size_t)64 * lda);
  ra2 = *(const uint4*)(ga + (size_t)128 * lda);
  ra3 = *(const uint4*)(ga + (size_t)192 * lda);
  rb0 = *(const uint4*)(gb);
  rb1 = *(const uint4*)(gb + (size_t)64 * ldb);
  const int sw = (lc ^ (lr & 7)) << 4;
  for (int kt = 0; kt < nk; ++kt) {
    __syncthreads();
    *(uint4*)(sA + (lr) * 128 + sw) = ra0;
    *(uint4*)(sA + (lr + 64) * 128 + sw) = ra1;
    *(uint4*)(sA + (lr + 128) * 128 + sw) = ra2;
    *(uint4*)(sA + (lr + 192) * 128 + sw) = ra3;
    *(uint4*)(sB + (lr) * 128 + sw) = rb0;
    *(uint4*)(sB + (lr + 64) * 128 + sw) = rb1;
    __syncthreads();
    if (kt + 1 < nk) {
      const int ko = (kt + 1) * 64;
      ra0 = *(const uint4*)(ga + ko);
      ra1 = *(const uint4*)(ga + (size_t)64 * lda + ko);
      ra2 = *(const uint4*)(ga + (size_t)128 * lda + ko);
      ra3 = *(const uint4*)(ga + (size_t)192 * lda + ko);
      rb0 = *(const uint4*)(gb + ko);
      rb1 = *(const uint4*)(gb + (size_t)64 * ldb + ko);
    }
#pragma unroll
    for (int ks = 0; ks < 2; ++ks) {
      bf16x8 a[4], b[4];
#pragma unroll
      for (int m = 0; m < 4; ++m) { const int r = wm * 64 + m * 16 + l15; a[m] = *(const bf16x8*)(sA + r * 128 + (((ks * 4 + g) ^ (r & 7)) << 4)); }
#pragma unroll
      for (int n = 0; n < 4; ++n) { const int r = wn * 64 + n * 16 + l15; b[n] = *(const bf16x8*)(sB + r * 128 + (((ks * 4 + g) ^ (r & 7)) << 4)); }
#pragma unroll
      for (int m = 0; m < 4; ++m)
#pragma unroll
        for (int n = 0; n < 4; ++n) acc[m][n] = __builtin_amdgcn_mfma_f32_16x16x32_bf16(a[m], b[n], acc[m][n], 0, 0, 0);
    }
  }
}

__device__ __forceinline__ void zero_acc(f32x4 (&acc)[4][4]) {
#pragma unroll
  for (int m = 0; m < 4; ++m)
#pragma unroll
    for (int n = 0; n < 4; ++n) acc[m][n] = (f32x4){0.f, 0.f, 0.f, 0.f};
}

__device__ __forceinline__ void transpose_tile(const float* __restrict__ src, int srcN, bf16_t* __restrict__ dst, int K, int n0, int k0,
                                               bool winmap, float* tile) {
  const int tid = threadIdx.x;
  const int nc = tid & 63, kr = tid >> 6;
  int ncol = n0 + nc; bool valid = true;
  if (winmap) { if (ncol >= 3072) ncol -= 60; else if (ncol >= 3012) valid = false; }
#pragma unroll
  for (int i = 0; i < 8; ++i) {
    const int k = kr + 8 * i;
    tile[k * 65 + nc] = valid ? src[(size_t)(k0 + k) * srcN + ncol] : 0.f;
  }
  __syncthreads();
#pragma unroll
  for (int i = 0; i < 8; ++i) {
    const int nr = kr + 8 * i;
    dst[(size_t)(n0 + nr) * K + k0 + nc] = f2bf(tile[nc * 65 + nr]);
  }
  __syncthreads();
}

__device__ __forceinline__ void quant_cols32(const float* __restrict__ src, int srcN, unsigned char* __restrict__ dst, float* __restrict__ scale,
                                             int n0, bool winmap, float* tile) {
  const int tid = threadIdx.x, nc = tid & 31, kr = tid >> 5;
  float* red = tile + 1024 * 33;
  int ncol = n0 + nc; bool valid = true;
  if (winmap) { if (ncol >= 3072) ncol -= 60; else if (ncol >= 3012) valid = false; }
  if (!valid) ncol = 0;
  float am = 0.f;
#pragma unroll 8
  for (int i = 0; i < 64; ++i) {
    const int k = kr + 16 * i;
    float v = src[(size_t)k * srcN + ncol];
    v = valid ? v : 0.f;
    tile[k * 33 + nc] = v; am = fmaxf(am, fabsf(v));
  }
  red[kr * 32 + nc] = am;
  __syncthreads();
  if (tid < 32) {
    float m = 0.f;
#pragma unroll
    for (int i = 0; i < 16; ++i) m = fmaxf(m, red[i * 32 + tid]);
    red[512 + tid] = m; scale[n0 + tid] = m * (1.f / 127.f);
  }
  __syncthreads();
  const float cm = red[512 + nc];
  const float inv = cm > 0.f ? 127.f / cm : 0.f;
#pragma unroll
  for (int i = 0; i < 4; ++i) {
    const int k0 = (kr + 16 * i) * 16;
    unsigned pk[4];
#pragma unroll
    for (int q = 0; q < 4; ++q) {
      const unsigned b0 = (unsigned)(int)rintf(tile[(k0 + 4 * q) * 33 + nc] * inv) & 255u, b1 = (unsigned)(int)rintf(tile[(k0 + 4 * q + 1) * 33 + nc] * inv) & 255u;
      const unsigned b2 = (unsigned)(int)rintf(tile[(k0 + 4 * q + 2) * 33 + nc] * inv) & 255u, b3 = (unsigned)(int)rintf(tile[(k0 + 4 * q + 3) * 33 + nc] * inv) & 255u;
      pk[q] = b0 | (b1 << 8) | (b2 << 16) | (b3 << 24);
    }
    *(uint4*)(dst + (size_t)(n0 + nc) * 1024 + k0) = make_uint4(pk[0], pk[1], pk[2], pk[3]);
  }
  __syncthreads();
}

__device__ __forceinline__ void convert_f32_bf16(const float* __restrict__ src, bf16_t* __restrict__ dst, size_t n4) {
  for (size_t i = (size_t)blockIdx.x * NTHREADS + threadIdx.x; i < n4; i += (size_t)gridDim.x * NTHREADS) {
    const float4 v = ((const float4*)src)[i];
    uint2 o; o.x = pack2(v.x, v.y); o.y = pack2(v.z, v.w);
    ((uint2*)dst)[i] = o;
  }
}

template <bool SLICE_MAJOR, bool SIGNED>
__device__ __forceinline__ void quantize_rows_u8(const float* __restrict__ src, unsigned char* __restrict__ dst, float* __restrict__ scale, int row_lo, int row_hi) {
  const int lane = threadIdx.x & 63, w = threadIdx.x >> 6;
  for (int row = row_lo + w; row < row_hi; row += 8) {
    const float4* s4 = (const float4*)(src + (size_t)row * 1024) + lane * 4;
    float4 v[4];
    float am = 0.f;
#pragma unroll
    for (int i = 0; i < 4; ++i) { v[i] = s4[i]; am = fmaxf(am, fmaxf(fmaxf(fabsf(v[i].x), fabsf(v[i].y)), fmaxf(fabsf(v[i].z), fabsf(v[i].w)))); }
#pragma unroll
    for (int o = 32; o > 0; o >>= 1) am = fmaxf(am, __shfl_xor(am, o));
    const float inv = am > 0.f ? 127.f / am : 0.f;
    unsigned pk[4];
#pragma unroll
    for (int i = 0; i < 4; ++i) {
      const int ofs = SIGNED ? 0 : 128;
      const unsigned b0 = (unsigned)((int)rintf(v[i].x * inv) + ofs), b1 = (unsigned)((int)rintf(v[i].y * inv) + ofs);
      const unsigned b2 = (unsigned)((int)rintf(v[i].z * inv) + ofs), b3 = (unsigned)((int)rintf(v[i].w * inv) + ofs);
      pk[i] = (b0 & 255u) | ((b1 & 255u) << 8) | ((b2 & 255u) << 16) | ((b3 & 255u) << 24);
    }
    if (SLICE_MAJOR) *(uint4*)(dst + (size_t)(lane >> 3) * (16384 * 128) + (size_t)row * 128 + (lane & 7) * 16) = make_uint4(pk[0], pk[1], pk[2], pk[3]);
    else *(uint4*)(dst + (size_t)row * 1024 + lane * 16) = make_uint4(pk[0], pk[1], pk[2], pk[3]);
    if (lane == 0) scale[row] = am * (1.f / 127.f);
  }
}

#define WS_WINS (WS_WIN + (size_t)5120 * 1024)
#define WS_WQS (WS_WQ + (size_t)2048 * 1024)
#define WS_XNS (WS_XN + (size_t)TOK * 1024)
#define WS_XQ (WS_PH + (size_t)TOK * 1024 * 2)
#define WS_XS (WS_XQ + (size_t)TOK * 1024)
template <bool WBF>
__device__ __forceinline__ void rmsnorm_rows_q(const float* __restrict__ src, const float* __restrict__ g, bf16_t* __restrict__ dst,
                                               unsigned char* __restrict__ xq, float* __restrict__ xs) {
  const int lane = threadIdx.x & 63, w = threadIdx.x >> 6;
  for (int row = blockIdx.x * 8 + w; row < TOK; row += gridDim.x * 8) {
    const float4* s4 = (const float4*)(src + (size_t)row * DM) + lane * 4;
    const float4* g4 = (const float4*)g + lane * 4;
    float v[16]; float ss = 0.f;
#pragma unroll
    for (int i = 0; i < 4; ++i) { const float4 t = s4[i]; v[4 * i] = t.x; v[4 * i + 1] = t.y; v[4 * i + 2] = t.z; v[4 * i + 3] = t.w; ss += t.x * t.x + t.y * t.y + t.z * t.z + t.w * t.w; }
    ss = wave_sum(ss);
    const float rstd = rsqrtf(ss * (1.f / DM) + EPSV);
    float am = 0.f;
#pragma unroll
    for (int i = 0; i < 4; ++i) { const float4 gg = g4[i]; v[4 * i] *= rstd * gg.x; v[4 * i + 1] *= rstd * gg.y; v[4 * i + 2] *= rstd * gg.z; v[4 * i + 3] *= rstd * gg.w; }
#pragma unroll
    for (int i = 0; i < 16; ++i) am = fmaxf(am, fabsf(v[i]));
#pragma unroll
    for (int o = 32; o > 0; o >>= 1) am = fmaxf(am, __shfl_xor(am, o));
    const float inv = am > 0.f ? 127.f / am : 0.f;
    if (WBF) {
      uint4 ob0, ob1;
      ob0.x = pack2(v[0], v[1]); ob0.y = pack2(v[2], v[3]); ob0.z = pack2(v[4], v[5]); ob0.w = pack2(v[6], v[7]);
      ob1.x = pack2(v[8], v[9]); ob1.y = pack2(v[10], v[11]); ob1.z = pack2(v[12], v[13]); ob1.w = pack2(v[14], v[15]);
      *(uint4*)(dst + (size_t)row * DM + lane * 16) = ob0;
      *(uint4*)(dst + (size_t)row * DM + lane * 16 + 8) = ob1;
    }
    unsigned pk[4];
#pragma unroll
    for (int i = 0; i < 4; ++i) {
      const unsigned b0 = (unsigned)(int)rintf(v[4 * i] * inv) & 255u, b1 = (unsigned)(int)rintf(v[4 * i + 1] * inv) & 255u;
      const unsigned b2 = (unsigned)(int)rintf(v[4 * i + 2] * inv) & 255u, b3 = (unsigned)(int)rintf(v[4 * i + 3] * inv) & 255u;
      pk[i] = b0 | (b1 << 8) | (b2 << 16) | (b3 << 24);
    }
    *(uint4*)(xq + (size_t)row * 1024 + lane * 16) = make_uint4(pk[0], pk[1], pk[2], pk[3]);
    if (lane == 0) xs[row] = am * (1.f / 127.f);
  }
}

__device__ __forceinline__ void rmsnorm_rows(const float* __restrict__ src, const float* __restrict__ g, bf16_t* __restrict__ dst) {
  const int lane = threadIdx.x & 63, w = threadIdx.x >> 6;
  for (int row = blockIdx.x * 8 + w; row < TOK; row += gridDim.x * 8) {
    const float4* s4 = (const float4*)(src + (size_t)row * DM);
    float4 v[4]; float ss = 0.f;
#pragma unroll
    for (int i = 0; i < 4; ++i) { v[i] = s4[lane + 64 * i]; ss += v[i].x * v[i].x + v[i].y * v[i].y + v[i].z * v[i].z + v[i].w * v[i].w; }
    ss = wave_sum(ss);
    const float rstd = rsqrtf(ss * (1.f / DM) + EPSV);
#pragma unroll
    for (int i = 0; i < 4; ++i) {
      const float4 gg = ((const float4*)g)[lane + 64 * i];
      uint2 o; o.x = pack2(v[i].x * rstd * gg.x, v[i].y * rstd * gg.y); o.y = pack2(v[i].z * rstd * gg.z, v[i].w * rstd * gg.w);
      ((uint2*)(dst + (size_t)row * DM))[lane + 64 * i] = o;
    }
  }
}

__device__ __forceinline__ void phase_prep(const Params& p, unsigned char* smem) {
  unsigned char* ws = p.ws;
  float* tile = (float*)smem;
  const int n_win = 160, n_ua = 16 * 8, n_ub = 16 * 8, n_wo = 16 * 16, n_wq = 64;
  const int total = n_win + n_wq + n_ua + n_ub + n_wo;
  for (int it = blockIdx.x; it < total; it += gridDim.x) {
    int t = it;
    if (t < n_win) { quant_cols32(p.w_in, 5060, ws + WS_WIN, (float*)(ws + WS_WINS), t * 32, true, tile); continue; }
    t -= n_win;
    if (t < n_wq) { quant_cols32(p.peer_wq, 2048, ws + WS_WQ, (float*)(ws + WS_WQS), t * 32, false, tile); continue; }
    t -= n_wq;
    if (t < n_ua) { transpose_tile(p.w_up_a, 1024, (bf16_t*)(ws + WS_WUPA), 1024, (t >> 3) * 64, (t & 7) * 64, false, tile); continue; }
    t -= n_ua;
    if (t < n_ub) { transpose_tile(p.w_up_b, 1024, (bf16_t*)(ws + WS_WUPA) + 512, 1024, (t >> 3) * 64, (t & 7) * 64, false, tile); continue; }
    t -= n_ub;
    transpose_tile(p.w_out, 1024, (bf16_t*)(ws + WS_WOUT), 1024, (t >> 4) * 64, (t & 15) * 64, false, tile);
  }
  convert_f32_bf16(p.peer_keys, (bf16_t*)(ws + WS_KEYS), (size_t)2 * 8 * 128 * 128 / 4);
  for (int i = blockIdx.x * NTHREADS + threadIdx.x; i < TOK; i += gridDim.x * NTHREADS) ((float*)(ws + WS_SSQ))[i] = 0.f;
  if (threadIdx.x == 0) ((int*)(ws + WS_XCC))[blockIdx.x] = (int)(__builtin_amdgcn_s_getreg((3 << 11) | 20) & 0xFu);
  if (blockIdx.x == 0 && threadIdx.x < 8) ((unsigned*)(ws + WS_QCTR))[16 * threadIdx.x] = 0u;
  if (blockIdx.x == 0) {
    const int i = threadIdx.x;
    const float a0 = p.hg_lb[i], a1 = p.hg_lb[512 + i];
    ((float*)(ws + WS_LB))[i] = 1.f / (1.f + expf(a1 - a0));
  }
  rmsnorm_rows_q<false>(p.x, p.norm_mix, nullptr, ws + WS_XN, (float*)(ws + WS_XNS));
}

__device__ __forceinline__ void hgrn_h1_all(const Params& p, unsigned char* smem) {
  unsigned char* ws = p.ws;
  bf16_t* pH = (bf16_t*)(ws + WS_PH);
  const float* lbp = (const float*)(ws + WS_LB);
  bf16_t* Qt = (bf16_t*)smem;
  bf16_t* Kt = Qt + 64 * 136;
  bf16_t* KtT = Kt + 64 * 136;
  bf16_t* VT = KtT + 128 * 72;
  bf16_t* Am = VT + 128 * 72;
  float* qtot = (float*)(Am + 64 * 72);
  const int tid = threadIdx.x, lane = tid & 63, w = tid >> 6, l15 = lane & 15, g = lane >> 4;
  const int d = tid & 127, tq = tid >> 7;
  const int G = gridDim.x;
  if ((int)blockIdx.x >= 2048) return;
  bf16_t fr_[16], qr_[16]; unsigned short vr_[16];
#define H1_LOAD(IT) do { \
    const int bh_ = (IT) >> 6, ch_ = (IT) & 63; \
    const bf16_t* base_ = pH + ((size_t)(bh_ >> 2) * SEQL + ch_ * 64 + tq * 16) * 2048 + (bh_ & 3) * 128 + d; \
    _Pragma("unroll") for (int i = 0; i < 16; ++i) { fr_[i] = base_[(size_t)i * 2048 + 512]; qr_[i] = base_[(size_t)i * 2048]; vr_[i] = base_[(size_t)i * 2048 + 1024]; } \
  } while (0)
  H1_LOAD((int)blockIdx.x);
  for (int item = blockIdx.x; item < 2048; item += G) {
    const int bh = item >> 6, chunk = item & 63;
    const int b = bh >> 2, h = bh & 3;
    const float lbv = lbp[h * 128 + d];
    const size_t row0 = (size_t)b * SEQL + chunk * 64;
    float* dec = (float*)(ws + WS_DEC) + (size_t)item * 384;
    uint4* UU = (uint4*)p.out + (size_t)item * 2048 + tid;
    float4* OI = (float4*)((unsigned char*)p.out + ((size_t)64 << 20)) + (size_t)item * 2048 + tid;
    {
      unsigned vv[8];
#pragma unroll
      for (int i = 0; i < 8; ++i) vv[i] = (unsigned)vr_[2 * i] | ((unsigned)vr_[2 * i + 1] << 16);
      float lf[16], kk[16], qs[16];
      float run = 0.f;
#pragma unroll
      for (int i = 0; i < 16; ++i) {
        const float sg = sigmoidf_(bf2f(fr_[i]));
        const float fg = lbv + (1.f - lbv) * sg;
        run += __logf(fg);
        lf[i] = run; kk[i] = 1.f - fg; qs[i] = siluf_(bf2f(qr_[i]));
      }
      qtot[tq * 128 + d] = run;
      __syncthreads();
      { const int nit = (item + G < 2048) ? item + G : item; H1_LOAD(nit); }
      const float q0 = qtot[d], q1 = qtot[128 + d], q2 = qtot[256 + d], q3 = qtot[384 + d];
      const float pre = (tq > 0 ? q0 : 0.f) + (tq > 1 ? q1 : 0.f) + (tq > 2 ? q2 : 0.f);
      const float bref = q0 + q1;
      const float blast = bref + q2 + q3;
      unsigned kp[8];
#pragma unroll
      for (int i = 0; i < 16; ++i) {
        const float bt = pre + lf[i];
        const float qt = qs[i] * __expf(bt - bref);
        const float kt = kk[i] * __expf(bref - bt);
        const int t = tq * 16 + i;
        Qt[t * 136 + d] = f2bf(qt);
        const bf16_t kb = f2bf(kt);
        Kt[t * 136 + d] = kb;
        if (i & 1) kp[i >> 1] |= ((unsigned)kb) << 16; else kp[i >> 1] = kb;
      }
      *(uint4*)(KtT + d * 72 + tq * 16) = make_uint4(kp[0], kp[1], kp[2], kp[3]);
      *(uint4*)(KtT + d * 72 + tq * 16 + 8) = make_uint4(kp[4], kp[5], kp[6], kp[7]);
      *(uint4*)(VT + d * 72 + tq * 16) = make_uint4(vv[0], vv[1], vv[2], vv[3]);
      *(uint4*)(VT + d * 72 + tq * 16 + 8) = make_uint4(vv[4], vv[5], vv[6], vv[7]);
      if (tq == 0) { dec[d] = __expf(bref); dec[128 + d] = __expf(blast); dec[256 + d] = __expf(blast - bref); }
    }
    __syncthreads();
    {
  #pragma unroll
      for (int i = 0; i < 2; ++i) {
        const int idx = tid + 512 * i, r = idx >> 4, c = idx & 15;
        *(uint4*)(pH + (row0 + r) * 2048 + h * 128 + c * 8) = *(const uint4*)(Qt + r * 136 + c * 8);
      }
  #pragma unroll
      for (int tt = 0; tt < 2; ++tt) {
        const int tl = 2 * w + tt, sm = tl >> 2, tn = tl & 3;
        f32x4 acc = (f32x4){0.f, 0.f, 0.f, 0.f};
        if (tn >= sm) {
  #pragma unroll
          for (int k0 = 0; k0 < 128; k0 += 32) {
            const bf16x8 a = *(const bf16x8*)(Kt + (sm * 16 + l15) * 136 + k0 + 8 * g);
            const bf16x8 bq = *(const bf16x8*)(Qt + (tn * 16 + l15) * 136 + k0 + 8 * g);
            acc = __builtin_amdgcn_mfma_f32_16x16x32_bf16(a, bq, acc, 0, 0, 0);
          }
        }
        const int t = tn * 16 + l15, s0 = sm * 16 + 4 * g;
        uint2 o;
        o.x = pack2(s0 + 0 <= t ? acc[0] : 0.f, s0 + 1 <= t ? acc[1] : 0.f);
        o.y = pack2(s0 + 2 <= t ? acc[2] : 0.f, s0 + 3 <= t ? acc[3] : 0.f);
        *(uint2*)(Am + t * 72 + s0) = o;
      }
    }
    __syncthreads();
    {
  #pragma unroll
      for (int tm = 0; tm < 4; ++tm) {
        f32x4 acc = (f32x4){0.f, 0.f, 0.f, 0.f};
  #pragma unroll
        for (int k0 = 0; k0 < 64; k0 += 32) {
          const bf16x8 a = *(const bf16x8*)(Am + (tm * 16 + l15) * 72 + k0 + 8 * g);
          const bf16x8 bb = *(const bf16x8*)(VT + (16 * w + l15) * 72 + k0 + 8 * g);
          acc = __builtin_amdgcn_mfma_f32_16x16x32_bf16(a, bb, acc, 0, 0, 0);
        }
        OI[tm * 512] = make_float4(acc[0], acc[1], acc[2], acc[3]);
      }
  #pragma unroll
      for (int dp = 0; dp < 4; ++dp) {
        unsigned pk[4];
  #pragma unroll
        for (int hh = 0; hh < 2; ++hh) {
          const int dm = dp * 2 + hh;
          f32x4 acc = (f32x4){0.f, 0.f, 0.f, 0.f};
  #pragma unroll
          for (int k0 = 0; k0 < 64; k0 += 32) {
            const bf16x8 a = *(const bf16x8*)(KtT + (dm * 16 + l15) * 72 + k0 + 8 * g);
            const bf16x8 bb = *(const bf16x8*)(VT + (16 * w + l15) * 72 + k0 + 8 * g);
            acc = __builtin_amdgcn_mfma_f32_16x16x32_bf16(a, bb, acc, 0, 0, 0);
          }
          pk[hh * 2] = pack2(acc[0], acc[1]); pk[hh * 2 + 1] = pack2(acc[2], acc[3]);
        }
        UU[dp * 512] = make_uint4(pk[0], pk[1], pk[2], pk[3]);
      }
    }
    __syncthreads();
  }
#undef H1_LOAD
}

__device__ __forceinline__ void hgrn_h2(const Params& p, unsigned char* smem, int bh) {
  unsigned char* ws = p.ws;
  const bf16_t* pH = (const bf16_t*)(ws + WS_PH);
  bf16_t* ya = (bf16_t*)(ws + WS_XN);
  bf16_t* Qt = (bf16_t*)smem;
  bf16_t* ST = Qt + 64 * 136;
  float* decl = (float*)(ST + 128 * 136);
  float* red = decl + 384;
  const int tid = threadIdx.x, lane = tid & 63, w = tid >> 6, l15 = lane & 15, g = lane >> 4;
  const int b = bh >> 2, h = bh & 3;
  f32x4 S[8];
#pragma unroll
  for (int i = 0; i < 8; ++i) S[i] = (f32x4){0.f, 0.f, 0.f, 0.f};
  const float gnv = p.hg_norm[h * 128 + 16 * w + l15];
  const int e = 16 * w + l15;
  uint4 uu0, uu1, uu2, uu3; float4 oi0, oi1, oi2, oi3; uint4 qraw0, qraw1; bf16_t ogr[16]; float dcv = 0.f;
#define H2_LOAD(CH) do { \
    const int item_ = bh * 64 + (CH); \
    const size_t row0_ = (size_t)b * SEQL + (size_t)(CH) * 64; \
    const uint4* UUp = (const uint4*)p.out + (size_t)item_ * 2048 + tid; \
    const float4* OIp = (const float4*)((const unsigned char*)p.out + ((size_t)64 << 20)) + (size_t)item_ * 2048 + tid; \
    uu0 = UUp[0]; uu1 = UUp[512]; uu2 = UUp[1024]; uu3 = UUp[1536]; oi0 = OIp[0]; oi1 = OIp[512]; oi2 = OIp[1024]; oi3 = OIp[1536]; \
    qraw0 = *(const uint4*)(pH + (row0_ + (tid >> 4)) * 2048 + h * 128 + (tid & 15) * 8); \
    qraw1 = *(const uint4*)(pH + (row0_ + 32 + (tid >> 4)) * 2048 + h * 128 + (tid & 15) * 8); \
    _Pragma("unroll") for (int tm = 0; tm < 4; ++tm) _Pragma("unroll") for (int j = 0; j < 4; ++j) \
      ogr[tm * 4 + j] = pH[(row0_ + tm * 16 + 4 * g + j) * 2048 + 1536 + h * 128 + e]; \
    if (tid < 384) dcv = ((const float*)(ws + WS_DEC))[(size_t)item_ * 384 + tid]; \
  } while (0)
  H2_LOAD(0);
  for (int chunk = 0; chunk < 64; ++chunk) {
    const size_t row0 = (size_t)b * SEQL + chunk * 64;
    const uint4 cu[4] = {uu0, uu1, uu2, uu3}; const float4 co[4] = {oi0, oi1, oi2, oi3}; bf16_t cog[16];
#pragma unroll
    for (int i = 0; i < 16; ++i) cog[i] = ogr[i];
    *(uint4*)(Qt + (tid >> 4) * 136 + (tid & 15) * 8) = qraw0;
    *(uint4*)(Qt + (32 + (tid >> 4)) * 136 + (tid & 15) * 8) = qraw1;
    if (tid < 384) decl[tid] = dcv;
    __syncthreads();
    if (chunk + 1 < 64) H2_LOAD(chunk + 1);
#pragma unroll
    for (int dm = 0; dm < 8; ++dm) {
      const int d0 = 16 * dm + 4 * g;
      uint2 o;
      o.x = pack2(S[dm][0] * decl[d0], S[dm][1] * decl[d0 + 1]);
      o.y = pack2(S[dm][2] * decl[d0 + 2], S[dm][3] * decl[d0 + 3]);
      *(uint2*)(ST + e * 136 + d0) = o;
    }
    __syncthreads();
    f32x4 o[4];
#pragma unroll
    for (int tm = 0; tm < 4; ++tm) {
      f32x4 acc = (f32x4){co[tm].x, co[tm].y, co[tm].z, co[tm].w};
#pragma unroll
      for (int k0 = 0; k0 < 128; k0 += 32) {
        const bf16x8 a = *(const bf16x8*)(Qt + (tm * 16 + l15) * 136 + k0 + 8 * g);
        const bf16x8 bb = *(const bf16x8*)(ST + (16 * w + l15) * 136 + k0 + 8 * g);
        acc = __builtin_amdgcn_mfma_f32_16x16x32_bf16(a, bb, acc, 0, 0, 0);
      }
      o[tm] = acc;
#pragma unroll
      for (int j = 0; j < 4; ++j) {
        float ss = acc[j] * acc[j];
        ss += __int_as_float(__builtin_amdgcn_update_dpp(0, __float_as_int(ss), 0xB1, 0xf, 0xf, true));
        ss += __int_as_float(__builtin_amdgcn_update_dpp(0, __float_as_int(ss), 0x4E, 0xf, 0xf, true));
        ss += __int_as_float(__builtin_amdgcn_update_dpp(0, __float_as_int(ss), 0x141, 0xf, 0xf, true));
        ss += __int_as_float(__builtin_amdgcn_update_dpp(0, __float_as_int(ss), 0x140, 0xf, 0xf, true));
        if (l15 == 0) red[w * 64 + tm * 16 + 4 * g + j] = ss;
      }
    }
#pragma unroll
    for (int dm = 0; dm < 8; ++dm) {
      const unsigned u01 = (dm & 1) ? cu[dm >> 1].z : cu[dm >> 1].x, u23 = (dm & 1) ? cu[dm >> 1].w : cu[dm >> 1].y;
      const float uv[4] = {__uint_as_float(u01 << 16), __uint_as_float(u01 & 0xffff0000u), __uint_as_float(u23 << 16), __uint_as_float(u23 & 0xffff0000u)};
#pragma unroll
      for (int j = 0; j < 4; ++j) { const int dd = 16 * dm + 4 * g + j; S[dm][j] = decl[128 + dd] * S[dm][j] + decl[256 + dd] * uv[j]; }
    }
    __syncthreads();
    if (tid < 64) {
      float tot = 0.f;
#pragma unroll
      for (int ww = 0; ww < 8; ++ww) tot += red[ww * 64 + tid];
      red[512 + tid] = rsqrtf(tot * (1.f / 128.f) + EPSV);
    }
    __syncthreads();
#pragma unroll
    for (int tm = 0; tm < 4; ++tm)
#pragma unroll
      for (int j = 0; j < 4; ++j) {
        const int t = tm * 16 + 4 * g + j;
        const float rstd = red[512 + t];
        ya[(row0 + t) * 1024 + h * 128 + e] = f2bf(o[tm][j] * rstd * gnv * siluf_(bf2f(cog[tm * 4 + j])));
      }
  }
#undef H2_LOAD
}

__device__ __forceinline__ int team_index(const Params& p, unsigned char* smem) {
  int* sh = (int*)(smem + 8192);
  const int G = gridDim.x, tid = threadIdx.x;
  const int* tab = (const int*)(p.ws + WS_XCC);
  if (tid < 32) sh[tid] = 0;
  __syncthreads();
  const int mine = tab[blockIdx.x] & 15;
  for (int b = tid; b < G; b += NTHREADS) {
    const int x = tab[b] & 15;
    atomicAdd(&sh[x], 1);
    if (x == mine && b < (int)blockIdx.x) atomicAdd(&sh[16], 1);
  }
  __syncthreads();
  if (tid == 0) {
    int pre = 0;
    for (int j = 0; j < mine; ++j) pre += sh[j];
    sh[17] = pre + sh[16];
  }
  __syncthreads();
  const int r = sh[17];
  __syncthreads();
  return r;
}

#define SCW 4100
#ifndef DSA_REP
#define DSA_REP 0
#endif
#define DSA_BKT_OFF (8 * SCW * 4 + 8 * 256 * 4 + 8 * 256 * 2 + 8 * 512 * 2)
__device__ __forceinline__ void cvt8(const uint4& v, float* f) {
  f[0] = __uint_as_float(v.x << 16); f[1] = __uint_as_float(v.x & 0xffff0000u);
  f[2] = __uint_as_float(v.y << 16); f[3] = __uint_as_float(v.y & 0xffff0000u);
  f[4] = __uint_as_float(v.z << 16); f[5] = __uint_as_float(v.z & 0xffff0000u);
  f[6] = __uint_as_float(v.w << 16); f[7] = __uint_as_float(v.w & 0xffff0000u);
}
__device__ __forceinline__ unsigned sortable_key(float v) {
  unsigned bits = __float_as_uint(v);
  if (bits == 0x80000000u) bits = 0u;
  return (bits & 0x80000000u) ? ~bits : (bits | 0x80000000u);
}

__device__ __forceinline__ void dsa_item(const Params& p, unsigned char* smem, int item) {
  unsigned char* ws = p.ws;
  const bf16_t* pA = (const bf16_t*)(ws + WS_PA);
  const bf16_t* kc = (const bf16_t*)(ws + WS_KC);
  const bf16_t* vc = (const bf16_t*)(ws + WS_VC);
  const bf16_t* ikc = (const bf16_t*)(ws + WS_IKC);
  bf16_t* yb = (bf16_t*)(ws + WS_XN) + 512;
  unsigned* sc = (unsigned*)smem;
  unsigned* hist = sc + 8 * SCW;
  unsigned short* sel = (unsigned short*)(hist + 8 * 256);
  unsigned short* cand = sel + 8 * 256;
  unsigned char* bkt = (unsigned char*)(cand + 8 * 512);
  unsigned* rmm = (unsigned*)(bkt + 128 + 1056);
  unsigned* bks = rmm + 16;
  const int tid = threadIdx.x, lane = tid & 63, w = tid >> 6, l15 = lane & 15, g = lane >> 4;
  const int b = item >> 9;
  const int tb = item & 511;
  const int t0 = tb * 8;
  const size_t tokbase = (size_t)b * SEQL;

  for (int rep_s = 0; rep_s < (DSA_REP == 1 ? 2 : 1); ++rep_s) {
    bf16x8 af[2][2];
    float wq[2][4];
#pragma unroll
    for (int mt = 0; mt < 2; ++mt) {
      const int qrow = t0 + mt * 4 + (l15 >> 2), head = l15 & 3;
#pragma unroll
      for (int ks = 0; ks < 2; ++ks)
        af[mt][ks] = *(const bf16x8*)(pA + (tokbase + qrow) * 1024 + 640 + head * 64 + ks * 32 + 8 * g);
      const uint2 wr = *(const uint2*)(pA + (tokbase + t0 + mt * 4 + g) * 1024 + 960);
      wq[mt][0] = 0.5f * bf2f((bf16_t)(wr.x & 0xffff)); wq[mt][1] = 0.5f * bf2f((bf16_t)(wr.x >> 16));
      wq[mt][2] = 0.5f * bf2f((bf16_t)(wr.y & 0xffff)); wq[mt][3] = 0.5f * bf2f((bf16_t)(wr.y >> 16));
    }
    const int nkt = (t0 + 8 + 15) >> 4;
    unsigned kmin[2] = {0xFFFFFFFFu, 0xFFFFFFFFu}, kmax[2] = {0u, 0u};
    for (int kt0 = w; kt0 < nkt; kt0 += 64) {
      bf16x8 b0[8], b1[8];
#pragma unroll
      for (int u = 0; u < 8; ++u) {
        const int kt = kt0 + 8 * u;
        const int s = (kt < nkt ? kt : 0) * 16 + l15;
        const bf16_t* kr = ikc + (tokbase + s) * 64 + 8 * g;
        b0[u] = *(const bf16x8*)kr;
        b1[u] = *(const bf16x8*)(kr + 32);
      }
      __builtin_amdgcn_sched_barrier(0);
      f32x4 sacc[8][2];
#pragma unroll
      for (int u = 0; u < 8; ++u)
#pragma unroll
        for (int mt = 0; mt < 2; ++mt) {
          f32x4 acc = (f32x4){0.f, 0.f, 0.f, 0.f};
          acc = __builtin_amdgcn_mfma_f32_16x16x32_bf16(af[mt][0], b0[u], acc, 0, 0, 0);
          sacc[u][mt] = __builtin_amdgcn_mfma_f32_16x16x32_bf16(af[mt][1], b1[u], acc, 0, 0, 0);
        }
#pragma unroll
      for (int u = 0; u < 8; ++u) {
        const int kt = kt0 + 8 * u;
        if (kt < nkt) {
          const int s = kt * 16 + l15;
#pragma unroll
          for (int mt = 0; mt < 2; ++mt) {
            float v = 0.f;
#pragma unroll
            for (int j = 0; j < 4; ++j) v += wq[mt][j] * fmaxf(sacc[u][mt][j] * 0.125f, 0.f);
            const int t = t0 + mt * 4 + g;
            unsigned vb = __float_as_uint(v); if (vb == 0x80000000u) vb = 0u;
            sc[(mt * 4 + g) * SCW + s] = vb;
            if (s <= t) {
              const unsigned key = (vb & 0x80000000u) ? ~vb : (vb | 0x80000000u);
              kmin[mt] = key < kmin[mt] ? key : kmin[mt];
              kmax[mt] = key > kmax[mt] ? key : kmax[mt];
            }
          }
        }
      }
    }
#pragma unroll
    for (int mt = 0; mt < 2; ++mt) {
      unsigned a = kmin[mt], bmx = kmax[mt];
#define DPP_MINMAX(CTRL) do { const unsigned a2 = (unsigned)__builtin_amdgcn_update_dpp((int)a, (int)a, CTRL, 0xf, 0xf, false); \
                               const unsigned b2 = (unsigned)__builtin_amdgcn_update_dpp((int)bmx, (int)bmx, CTRL, 0xf, 0xf, false); \
                               a = a2 < a ? a2 : a; bmx = b2 > bmx ? b2 : bmx; } while (0)
      DPP_MINMAX(0xB1); DPP_MINMAX(0x4E); DPP_MINMAX(0x141); DPP_MINMAX(0x140);
#undef DPP_MINMAX
      if (l15 == 0) { atomicMin(&rmm[mt * 4 + g], a); atomicMax(&rmm[8 + mt * 4 + g], bmx); }
    }
  }
  __syncthreads();
  const int t = t0 + w;
  const int n = t + 1;
  unsigned* row = sc + w * SCW;
  const float* rowf = (const float*)row;
  unsigned short* mysel = sel + w * 256;
  unsigned short* mycand = cand + w * 512;
  unsigned* myh = hist + w * 256;
  int cnt;
  const unsigned long long lt_mask = (1ull << lane) - 1ull;
  for (int rep_t = 0; rep_t < (DSA_REP == 2 ? 2 : 1); ++rep_t)
  if (n <= 256) {
    for (int i = lane; i < n; i += 64) mysel[i] = (unsigned short)i;
    cnt = n;
  } else {
    cnt = 256;
    float mn, mx;
    {
      const unsigned kmn = rmm[w], kmx = rmm[8 + w];
      mn = __uint_as_float((kmn & 0x80000000u) ? (kmn ^ 0x80000000u) : ~kmn);
      mx = __uint_as_float((kmx & 0x80000000u) ? (kmx ^ 0x80000000u) : ~kmx);
    }
    const float scale = (mx > mn) ? 255.99f / (mx - mn) : 0.f;
#pragma unroll
    for (int i = 0; i < 4; ++i) myh[lane + 64 * i] = 0u;
    lds_fence();
    for (int i0 = lane; i0 < n; i0 += 256) {
      float v4[4];
#pragma unroll
      for (int k = 0; k < 4; ++k) v4[k] = (i0 + 64 * k < n) ? rowf[i0 + 64 * k] : 0.f;
#pragma unroll
      for (int k = 0; k < 4; ++k) {
        if (i0 + 64 * k < n) {
          int bn = (int)((v4[k] - mn) * scale); bn = bn > 255 ? 255 : bn;
          atomicAdd(&myh[bn], 1u);
        }
      }
    }
    lds_fence();
    unsigned cum; int bstar; unsigned mcount;
    {
      const uint4 c4 = *(const uint4*)(myh + 4 * lane);
      const unsigned c = c4.x + c4.y + c4.z + c4.w;
      unsigned sfx = c;
#pragma unroll
      for (int o = 1; o < 64; o <<= 1) { const unsigned tt = __shfl_down(sfx, o); if (lane + o < 64) sfx += tt; }
      const unsigned long long bal = __ballot(sfx >= 256u);
      const int L = 63 - __clzll(bal);
      const unsigned sL = __shfl(sfx, L), cL = __shfl(c, L);
      const unsigned b3 = __shfl(c4.w, L), b2 = __shfl(c4.z, L), b1 = __shfl(c4.y, L), b0 = __shfl(c4.x, L);
      cum = sL - cL;
      int digit;
      if (cum + b3 >= 256u) { digit = 3; mcount = b3; }
      else { cum += b3; if (cum + b2 >= 256u) { digit = 2; mcount = b2; } else { cum += b2; if (cum + b1 >= 256u) { digit = 1; mcount = b1; } else { cum += b1; digit = 0; mcount = b0; } } }
      bstar = 4 * L + digit;
    }
    const unsigned need = 256u - cum;
    if (mcount <= 512u) {
      unsigned base = 0u, cb = 0u;
      for (int i0 = 0; i0 < n; i0 += 256) {
        float v4[4];
#pragma unroll
        for (int k = 0; k < 4; ++k) { const int i = i0 + 64 * k + lane; v4[k] = (i < n) ? rowf[i] : 0.f; }
#pragma unroll
        for (int k = 0; k < 4; ++k) {
          const int i = i0 + 64 * k + lane;
          const bool valid = i < n;
          int bn = (int)((v4[k] - mn) * scale); bn = bn > 255 ? 255 : bn;
          const bool gt = valid && (bn > bstar);
          const bool eq = valid && (bn == bstar);
          const unsigned long long bg = __ballot(gt), be = __ballot(eq);
          if (gt) mysel[base + (unsigned)__popcll(bg & lt_mask)] = (unsigned short)i;
          if (eq) mycand[cb + (unsigned)__popcll(be & lt_mask)] = (unsigned short)i;
          base += (unsigned)__popcll(bg); cb += (unsigned)__popcll(be);
        }
      }
      lds_fence();
      const int m = (int)mcount;
      unsigned ck[8]; unsigned short ci[8];
#pragma unroll
      for (int q = 0; q < 8; ++q) {
        const int c = q * 64 + lane;
        ck[q] = 0u; ci[q] = 0;
        if (c < m) { ci[q] = mycand[c]; ck[q] = sortable_key(rowf[ci[q]]); }
      }
      unsigned T = 0u;
      if (m <= 64) {
#pragma unroll 1
        for (int bit = 31; bit >= 0; --bit) {
          const unsigned trial = T | (1u << bit);
          if ((unsigned)__popcll(__ballot(ck[0] >= trial)) >= need) T = trial;
        }
      } else {
#pragma unroll 1
        for (int bit = 31; bit >= 0; --bit) {
          const unsigned trial = T | (1u << bit);
          unsigned cge = 0u;
#pragma unroll
          for (int q = 0; q < 8; ++q) cge += (unsigned)__popcll(__ballot(ck[q] >= trial));
          if (cge >= need) T = trial;
        }
      }
      unsigned cgt = 0u;
#pragma unroll
      for (int q = 0; q < 8; ++q) cgt += (unsigned)__popcll(__ballot(ck[q] > T));
      const unsigned need_eq = need - cgt;
      unsigned pos0 = cum, eqtaken = 0u;
#pragma unroll
      for (int q = 0; q < 8; ++q) {
        const bool gt = ck[q] > T;
        const bool eq = ck[q] == T;
        const unsigned long long beq = __ballot(eq);
        const bool take = gt || (eq && (eqtaken + (unsigned)__popcll(beq & lt_mask)) < need_eq);
        const unsigned long long bt = __ballot(take);
        const unsigned pp = pos0 + (unsigned)__popcll(bt & lt_mask);
        if (take && pp < 256u) mysel[pp] = ci[q];
        pos0 += (unsigned)__popcll(bt);
        eqtaken += (unsigned)__popcll(beq);
      }
    } else {
      unsigned prefix = 0u, krem = 256u;
#pragma unroll 1
      for (int pass = 0; pass < 4; ++pass) {
        const int shift = 24 - 8 * pass;
        const unsigned himask = (pass == 0) ? 0u : (0xFFFFFFFFu << (shift + 8));
#pragma unroll
        for (int i = 0; i < 4; ++i) myh[lane + 64 * i] = 0u;
        lds_fence();
        for (int i = lane; i < n; i += 64) {
          const unsigned u = sortable_key(rowf[i]);
          if ((u & himask) == prefix) atomicAdd(&myh[(u >> shift) & 255u], 1u);
        }
        lds_fence();
        const uint4 c4 = *(const uint4*)(myh + 4 * lane);
        const unsigned c = c4.x + c4.y + c4.z + c4.w;
        unsigned sfx = c;
#pragma unroll
        for (int o = 1; o < 64; o <<= 1) { const unsigned tt = __shfl_down(sfx, o); if (lane + o < 64) sfx += tt; }
        const unsigned long long bal = __ballot(sfx >= krem);
        const int L = 63 - __clzll(bal);
        const unsigned sL = __shfl(sfx, L), cL = __shfl(c, L);
        const unsigned b3 = __shfl(c4.w, L), b2 = __shfl(c4.z, L), b1 = __shfl(c4.y, L);
        unsigned cum2 = sL - cL;
        unsigned digit;
        if (cum2 + b3 >= krem) digit = 3;
        else { cum2 += b3; if (cum2 + b2 >= krem) digit = 2; else { cum2 += b2; if (cum2 + b1 >= krem) digit = 1; else { cum2 += b1; digit = 0; } } }
        krem -= cum2;
        prefix |= ((unsigned)(4 * L) + digit) << shift;
      }
      const unsigned T = prefix;
      unsigned base = 0u, eqtaken = 0u;
      for (int i0 = 0; i0 < n; i0 += 64) {
        const int i = i0 + lane;
        const bool valid = i < n;
        const unsigned u = valid ? sortable_key(rowf[i]) : 0u;
        const bool gt = valid && (u > T);
        const bool eq = valid && (u == T);
        const unsigned long long beq = __ballot(eq);
        const unsigned eqrank = eqtaken + (unsigned)__popcll(beq & lt_mask);
        const bool take = gt || (eq && eqrank < krem);
        const unsigned long long bt = __ballot(take);
        const unsigned pos = base + (unsigned)__popcll(bt & lt_mask);
        if (take && pos < 256u) mysel[pos] = (unsigned short)i;
        base += (unsigned)__popcll(bt);
        eqtaken += (unsigned)__popcll(beq);
      }
    }
  }
  lds_fence();
  if (lane == 0) { rmm[w] = 0xFFFFFFFFu; rmm[8 + w] = 0u; }
  lds_fence();
  {
    const uint2 s4 = *(const uint2*)(mysel + 4 * lane);
    const int sj[4] = {(int)(s4.x & 0xffffu), (int)(s4.x >> 16), (int)(s4.y & 0xffffu), (int)(s4.y >> 16)};
    unsigned pk = 0u;
#pragma unroll
    for (int j = 0; j < 4; ++j) {
      const bool valid = 4 * lane + j < cnt;
      const int dist = valid ? t - sj[j] : 0;
      unsigned bk = dist < 128 ? (unsigned)bkt[dist] : 31u;
      bk = valid ? bk : 32u;
      pk |= bk << (8 * j);
    }
    bks[w * 64 + lane] = pk;
  }
  lds_fence();
  {
    int lane_a = lane;
    asm volatile("" : "+v"(lane_a));
    const int l15 = lane_a & 15, g = lane_a >> 4;
    const int ks = lane_a >> 3, dc = lane_a & 7;
    const unsigned char* kcb = (const unsigned char*)(kc + tokbase * 64);
    const unsigned char* vcb = (const unsigned char*)(vc + tokbase * 64);
    float* pl = (float*)row;
    const float* relb = (const float*)(bkt + 128);
    const int niter = (cnt + 7) >> 3;
    bf16x8 bq0 = (bf16x8){0, 0, 0, 0, 0, 0, 0, 0}, bq1 = bq0;
    if (l15 < 8) {
      bq0 = *(const bf16x8*)(pA + (tokbase + t) * 1024 + l15 * 64 + 8 * g);
      bq1 = *(const bf16x8*)(pA + (tokbase + t) * 1024 + l15 * 64 + 32 + 8 * g);
    }
    float lg[16][4];
    {
      bf16x8 ka[8][2], kb[8][2];
#pragma unroll
      for (int u = 0; u < 8; ++u) {
        const int kk = u * 16 + l15;
        const unsigned s = (unsigned)mysel[kk] & 4095u;
        const unsigned ko = s * 128u + 16u * (unsigned)g;
        ka[u][0] = *(const bf16x8*)(kcb + ko);
        ka[u][1] = *(const bf16x8*)(kcb + ko + 64u);
      }
#pragma unroll
      for (int u = 0; u < 8; ++u) {
        const int kk = (8 + u) * 16 + l15;
        const unsigned s = (unsigned)mysel[kk] & 4095u;
        const unsigned ko = s * 128u + 16u * (unsigned)g;
        kb[u][0] = *(const bf16x8*)(kcb + ko);
        kb[u][1] = *(const bf16x8*)(kcb + ko + 64u);
      }
      __builtin_amdgcn_sched_barrier(0);
#pragma unroll
      for (int u = 0; u < 8; ++u) {
        f32x4 acc = (f32x4){0.f, 0.f, 0.f, 0.f};
        acc = __builtin_amdgcn_mfma_f32_16x16x32_bf16(ka[u][0], bq0, acc, 0, 0, 0);
        acc = __builtin_amdgcn_mfma_f32_16x16x32_bf16(ka[u][1], bq1, acc, 0, 0, 0);
        lg[u][0] = acc[0]; lg[u][1] = acc[1]; lg[u][2] = acc[2]; lg[u][3] = acc[3];
      }
#pragma unroll
      for (int u = 0; u < 8; ++u) {
        f32x4 acc = (f32x4){0.f, 0.f, 0.f, 0.f};
        acc = __builtin_amdgcn_mfma_f32_16x16x32_bf16(kb[u][0], bq0, acc, 0, 0, 0);
        acc = __builtin_amdgcn_mfma_f32_16x16x32_bf16(kb[u][1], bq1, acc, 0, 0, 0);
        lg[8 + u][0] = acc[0]; lg[8 + u][1] = acc[1]; lg[8 + u][2] = acc[2]; lg[8 + u][3] = acc[3];
      }
    }
    typedef unsigned u32x4_t __attribute__((ext_vector_type(4)));
    u32x4_t va[16];
#pragma unroll
    for (int u = 0; u < 16; ++u) {
      const int kk = u * 8 + ks;
      const unsigned s = (unsigned)mysel[kk] & 4095u;
      va[u] = *(const u32x4_t*)(vcb + s * 128u + 16u * (unsigned)dc);
    }
    __builtin_amdgcn_sched_barrier(0);
    const int hsel = l15 & 7;
    float m = -INFINITY;
    const unsigned* mybks = bks + w * 64;
#pragma unroll
    for (int u = 0; u < 16; ++u) {
      const unsigned bk4 = mybks[4 * u + g];
#pragma unroll
      for (int j = 0; j < 4; ++j) {
        lg[u][j] = lg[u][j] * 0.125f + relb[((bk4 >> (8 * j)) & 255u) * 8 + hsel];
        m = fmaxf(m, lg[u][j]);
      }
    }
    m = max_xor16(m); m = max_xor32(m);
    float sum = 0.f;
#pragma unroll
    for (int u = 0; u < 16; ++u)
#pragma unroll
      for (int j = 0; j < 4; ++j) { lg[u][j] = __expf(lg[u][j] - m); sum += lg[u][j]; }
    sum = add_xor16(sum); sum = add_xor32(sum);
    const float inv = 1.f / sum;
    bf16x8 pa[8];
#pragma unroll
    for (int s8 = 0; s8 < 8; ++s8) {
      const unsigned w0 = pack2(lg[2 * s8][0] * inv, lg[2 * s8][1] * inv), w1 = pack2(lg[2 * s8][2] * inv, lg[2 * s8][3] * inv);
      const unsigned w2 = pack2(lg[2 * s8 + 1][0] * inv, lg[2 * s8 + 1][1] * inv), w3 = pack2(lg[2 * s8 + 1][2] * inv, lg[2 * s8 + 1][3] * inv);
      const u32x4_t wv = {w0, w1, w2, w3};
      pa[s8] = __builtin_bit_cast(bf16x8, wv);
    }
    unsigned char* vs_l = (unsigned char*)row;
#pragma unroll
    for (int u = 0; u < 16; ++u) *(u32x4_t*)(vs_l + (u * 8 + ks) * 128 + dc * 16) = va[u];
    lds_fence();
    u32x4_t vb[16];
#pragma unroll
    for (int u = 0; u < 16; ++u) {
      const int kk = (16 + u) * 8 + ks;
      const unsigned s = (unsigned)mysel[kk] & 4095u;
      vb[u] = *(const u32x4_t*)(vcb + s * 128u + 16u * (unsigned)dc);
    }
    __builtin_amdgcn_sched_barrier(0);
    f32x4 ov[4];
#pragma unroll
    for (int nt = 0; nt < 4; ++nt) ov[nt] = (f32x4){0.f, 0.f, 0.f, 0.f};
    typedef short v4s_t __attribute__((ext_vector_type(4)));
    const unsigned tr_lane = (unsigned)((l15 >> 2) * 128 + (l15 & 3) * 8);
#define PV_HALF(S0) do { \
      _Pragma("unroll") for (int s4_ = 0; s4_ < 4; ++s4_) { \
        _Pragma("unroll") for (int nt = 0; nt < 4; ++nt) { \
          const unsigned a0 = (unsigned)((s4_ * 32 + 4 * g) * 128 + nt * 32) + tr_lane; \
          const v4s_t b0 = __builtin_amdgcn_ds_read_tr16_b64_v4i16((__attribute__((address_space(3))) v4s_t*)(vs_l + a0)); \
          const v4s_t b1 = __builtin_amdgcn_ds_read_tr16_b64_v4i16((__attribute__((address_space(3))) v4s_t*)(vs_l + a0 + 16 * 128)); \
          const bf16x8 bb = (bf16x8){b0[0], b0[1], b0[2], b0[3], b1[0], b1[1], b1[2], b1[3]}; \
          ov[nt] = __builtin_amdgcn_mfma_f32_16x16x32_bf16(pa[(S0) + s4_], bb, ov[nt], 0, 0, 0); \
        } \
      } \
    } while (0)
    PV_HALF(0);
    lds_fence();
#pragma unroll
    for (int u = 0; u < 16; ++u) *(u32x4_t*)(vs_l + (u * 8 + ks) * 128 + dc * 16) = vb[u];
    lds_fence();
    PV_HALF(4);
#undef PV_HALF
    if (g < 2) {
#pragma unroll
      for (int nt = 0; nt < 4; ++nt)
#pragma unroll
        for (int j = 0; j < 4; ++j) yb[(tokbase + t) * 1024 + (4 * g + j) * 64 + nt * 16 + l15] = f2bf(ov[nt][j]);
    }
    lds_fence();
  }
  __syncthreads();
}

__device__ __forceinline__ void phase_mix(const Params& p, unsigned char* smem, int mode = 0) {
  const int G = gridDim.x;
  if (mode != 2) { for (int bh = blockIdx.x; bh < 32; bh += G) { hgrn_h2(p, smem, bh); __syncthreads(); } }
  if (mode == 1) return;
  unsigned char* bkt = smem + DSA_BKT_OFF;
  volatile int* qslot = (volatile int*)(smem + LDS_BYTES - 32);
  unsigned* qctr = (unsigned*)(p.ws + WS_QCTR);
  if (threadIdx.x < 128) {
    const int nn = threadIdx.x;
    int v = nn;
    if (nn >= 16) { v = 16 + (int)(logf((float)nn * (1.f / 16.f)) / logf(8.f) * 16.f); if (v > 31) v = 31; }
    bkt[nn] = (unsigned char)v;
  }
  if (threadIdx.x >= 256) ((float*)(bkt + 128))[threadIdx.x - 256] = p.rel_bias[threadIdx.x - 256];
  if (threadIdx.x >= 128 && threadIdx.x < 136) ((float*)(bkt + 128))[256 + threadIdx.x - 128] = -INFINITY;
  if (threadIdx.x < 16) ((unsigned*)(bkt + 128 + 1056))[threadIdx.x] = threadIdx.x < 8 ? 0xFFFFFFFFu : 0u;
  const int my_team = (G % 8 == 0) ? team_index(p, smem) / (G >> 3) : (int)(blockIdx.x & 7);
  constexpr int QN = 544;
#define Q_FETCH(SLOT) do { if (threadIdx.x == 0) { int tm_ = q_team, kk_ = -1; \
      for (int tries_ = 0; tries_ < 8; ++tries_) { \
        const unsigned v_ = __hip_atomic_fetch_add(qctr + 16 * tm_, 1u, __ATOMIC_RELAXED, __HIP_MEMORY_SCOPE_AGENT); \
        if (v_ < (unsigned)QN) { kk_ = (tm_ << 16) | (int)v_; break; } \
        tm_ = (tm_ + 1) & 7; } \
      q_team = tm_; qslot[SLOT] = kk_; } } while (0)
  int q_team = my_team;
  Q_FETCH(0);
  __syncthreads();
  int k = qslot[0];
  int par = 1;
  while (k >= 0) {
    Q_FETCH(par);
    const int bt = k >> 16, kl = k & 0xffff;
    const int kq = kl / 17, kr = kl - kq * 17;
    if (kr < 16) {
      const int tb = 511 - (kq * 16 + kr);
      dsa_item(p, smem, (bt << 9) | tb);
    } else {
      const int r0 = (bt * 32 + kq) * 64;
      quantize_rows_u8<false, true>(p.peer_u, p.ws + WS_U, (float*)(p.ws + WS_U + (size_t)16384 * 1024), r0, r0 + 64);
      quantize_rows_u8<true, true>(p.peer_v, p.ws + WS_V, (float*)(p.ws + WS_V + (size_t)16384 * 1024), r0, r0 + 64);
      __syncthreads();
    }
    k = qslot[par];
    par ^= 1;
  }
#undef Q_FETCH
}

__device__ __forceinline__ void phase_pkeys(const Params& p, unsigned char* smem) {
  unsigned char* ws = p.ws;
  const bf16_t* qp = (const bf16_t*)(ws + WS_PG);
  const bf16_t* keys = (const bf16_t*)(ws + WS_KEYS);
  int* eidx = (int*)(ws + WS_EIDX);
  float* gw = (float*)(ws + WS_GW);
  float* sc = (float*)smem;
  float* s2l = (float*)smem;
  unsigned short* i1l = (unsigned short*)(s2l + 256 * 17);
  unsigned short* i2l = i1l + 256 * 16;
  const int tid = threadIdx.x, lane = tid & 63, w = tid >> 6, wm = w >> 1, wn = w & 1, l15 = lane & 15, g = lane >> 4;
  for (int item = blockIdx.x; item < 128 * 8; item += gridDim.x) {
    const int h = item & 7, tm = item >> 3;
    float s1[16], s2v[16]; int i1[16], i2[16];
#pragma unroll
    for (int ph = 0; ph < 2; ++ph) {
      const int hp = h * 2 + ph;
      f32x4 acc[4][4]; zero_acc(acc);
      gemm_tile(qp + (size_t)tm * 256 * 2048 + hp * 128, 2048, keys + (size_t)(ph * 8 + h) * 128 * 128, 128, 2, acc, smem);
      __syncthreads();
#pragma unroll
      for (int m = 0; m < 4; ++m)
#pragma unroll
        for (int n = 0; n < 4; ++n)
#pragma unroll
          for (int j = 0; j < 4; ++j) sc[(wm * 64 + m * 16 + 4 * g + j) * 129 + wn * 64 + n * 16 + l15] = acc[m][n][j];
      __syncthreads();
      if (tid < 256) {
        const float* rowp = sc + tid * 129;
        unsigned tv[16];
#pragma unroll
        for (int k = 0; k < 16; ++k) tv[k] = 0u;
#pragma unroll 8
        for (int nn = 0; nn < 128; ++nn) {
          const unsigned bits = __float_as_uint(rowp[nn]);
          unsigned key = (bits & 0x80000000u) ? ~bits : (bits | 0x80000000u);
          key = (key & ~127u) | (unsigned)(127 - nn);
#pragma unroll
          for (int k = 15; k >= 1; --k) {
            unsigned r;
            asm("v_med3_u32 %0, %1, %2, %3" : "=v"(r) : "v"(tv[k]), "v"(tv[k - 1]), "v"(key));
            tv[k] = r;
          }
          tv[0] = tv[0] > key ? tv[0] : key;
        }
#pragma unroll
        for (int k = 0; k < 16; ++k) {
          const int col = 127 - (int)(tv[k] & 127u);
          const float val = rowp[col];
          if (ph == 0) { i1[k] = col; s1[k] = val; } else { i2[k] = col; s2v[k] = val; }
        }
      }
      __syncthreads();
    }
    if (tid < 256) {
#pragma unroll
      for (int a = 0; a < 16; ++a) { s2l[tid * 17 + a] = s2v[a]; i1l[tid * 16 + a] = (unsigned short)i1[a]; i2l[tid * 16 + a] = (unsigned short)i2[a]; }
      float cur[16];
#pragma unroll
      for (int a = 0; a < 16; ++a) cur[a] = s1[a] + s2v[0];
      unsigned long long ptr = 0ull;
      float tops[16]; int tope[16];
#pragma unroll
      for (int k = 0; k < 16; ++k) {
        float best = cur[0]; int ba = 0;
#pragma unroll
        for (int a = 1; a < 16; ++a) if (cur[a] > best) { best = cur[a]; ba = a; }
        const int bb = (int)((ptr >> (4 * ba)) & 15ull);
        tops[k] = best;
        tope[k] = (int)i1l[tid * 16 + ba] * 128 + (int)i2l[tid * 16 + bb];
        const int nb = bb + 1;
        const float ns2 = (nb < 16) ? s2l[tid * 17 + nb] : -INFINITY;
        if (nb < 16) ptr += (1ull << (4 * ba));
#pragma unroll
        for (int a = 0; a < 16; ++a) if (a == ba) cur[a] = s1[a] + ns2;
      }
      const float m = tops[0];
      float sum = 0.f;
#pragma unroll
      for (int k = 0; k < 16; ++k) { tops[k] = __expf(tops[k] - m); sum += tops[k]; }
      const float inv = 1.f / sum;
      const size_t ob = ((size_t)(tm * 256 + tid) * 8 + h) * 16;
#pragma unroll
      for (int k = 0; k < 16; k += 4) {
        *(int4*)(eidx + ob + k) = make_int4(tope[k], tope[k + 1], tope[k + 2], tope[k + 3]);
        *(float4*)(gw + ob + k) = make_float4(tops[k] * inv, tops[k + 1] * inv, tops[k + 2] * inv, tops[k + 3] * inv);
      }
    }
    __syncthreads();
  }
}


__device__ __forceinline__ float reduce8(const float (&pv)[8], int lane) {
  const bool b5 = lane & 32, b4 = lane & 16, b3 = lane & 8;
  float v[4];
#pragma unroll
  for (int i = 0; i < 4; ++i) {
    const float keep = b5 ? pv[4 + i] : pv[i];
    const float send = b5 ? pv[i] : pv[4 + i];
    v[i] = keep + __shfl_xor(send, 32);
  }
  float u[2];
#pragma unroll
  for (int i = 0; i < 2; ++i) {
    const float keep = b4 ? v[2 + i] : v[i];
    const float send = b4 ? v[i] : v[2 + i];
    u[i] = keep + __shfl_xor(send, 16);
  }
  float x = (b3 ? u[1] : u[0]) + __shfl_xor(b3 ? u[0] : u[1], 8);
  x += __shfl_xor(x, 4); x += __shfl_xor(x, 2); x += __shfl_xor(x, 1);
  return x;
}

__device__ __forceinline__ void cvt16u8(const uint4& v, float* f) {
  f[0] = (float)(v.x & 0xffu); f[1] = (float)((v.x >> 8) & 0xffu); f[2] = (float)((v.x >> 16) & 0xffu); f[3] = (float)(v.x >> 24);
  f[4] = (float)(v.y & 0xffu); f[5] = (float)((v.y >> 8) & 0xffu); f[6] = (float)((v.y >> 16) & 0xffu); f[7] = (float)(v.y >> 24);
  f[8] = (float)(v.z & 0xffu); f[9] = (float)((v.z >> 8) & 0xffu); f[10] = (float)((v.z >> 16) & 0xffu); f[11] = (float)(v.z >> 24);
  f[12] = (float)(v.w & 0xffu); f[13] = (float)((v.w >> 8) & 0xffu); f[14] = (float)((v.w >> 16) & 0xffu); f[15] = (float)(v.w >> 24);
}

__device__ __forceinline__ int wave_sum_i32_dpp(int v) {
  v += __builtin_amdgcn_update_dpp(0, v, 0xB1, 0xf, 0xf, true);
  v += __builtin_amdgcn_update_dpp(0, v, 0x4E, 0xf, 0xf, true);
  v += __builtin_amdgcn_update_dpp(0, v, 0x141, 0xf, 0xf, true);
  v += __builtin_amdgcn_update_dpp(0, v, 0x140, 0xf, 0xf, true);
  return __builtin_amdgcn_readlane(v, 0) + __builtin_amdgcn_readlane(v, 16) + __builtin_amdgcn_readlane(v, 32) + __builtin_amdgcn_readlane(v, 48);
}

__device__ __forceinline__ int reduce8_i32_scatter(const int (&d)[8], int lane) {
  const bool b0 = lane & 1, b1 = lane & 2, b2 = lane & 4;
  int v[4];
#pragma unroll
  for (int i = 0; i < 4; ++i) {
    const int keep = b0 ? d[2 * i + 1] : d[2 * i];
    const int send = b0 ? d[2 * i] : d[2 * i + 1];
    v[i] = keep + __builtin_amdgcn_update_dpp(0, send, 0xB1, 0xf, 0xf, true);
  }
  int u[2];
#pragma unroll
  for (int i = 0; i < 2; ++i) {
    const int keep = b1 ? v[2 * i + 1] : v[2 * i];
    const int send = b1 ? v[2 * i] : v[2 * i + 1];
    u[i] = keep + __builtin_amdgcn_update_dpp(0, send, 0x4E, 0xf, 0xf, true);
  }
  int x;
  {
    const int keep = b2 ? u[1] : u[0];
    const int send = b2 ? u[0] : u[1];
    int t = __builtin_amdgcn_update_dpp(0, send, 0x141, 0xf, 0xf, true);
    t = __builtin_amdgcn_update_dpp(0, t, 0x1B, 0xf, 0xf, true);
    x = keep + t;
  }
  x += __builtin_amdgcn_update_dpp(0, x, 0x128, 0xf, 0xf, true);
  { const auto r = __builtin_amdgcn_permlane16_swap((unsigned)x, (unsigned)x, false, false); x = (int)r[0] + (int)r[1]; }
  { const auto r = __builtin_amdgcn_permlane32_swap((unsigned)x, (unsigned)x, false, false); x = (int)r[0] + (int)r[1]; }
  return x;
}

__device__ __forceinline__ void phase_pu(const Params& p, unsigned char* smem) {
  unsigned char* ws = p.ws;
  const unsigned char* XQ = ws + WS_XQ;
  const float* xs = (const float*)(ws + WS_XS);
  const unsigned char* U8 = ws + WS_U;
  const float* us = (const float*)(ws + WS_U + (size_t)16384 * 1024);
  const float* vs = (const float*)(ws + WS_V + (size_t)16384 * 1024);
  const int* eidx = (const int*)(ws + WS_EIDX);
  const float* gw = (const float*)(ws + WS_GW);
  float* aw = (float*)(ws + WS_PA);
  const int lane = threadIdx.x & 63, w = threadIdx.x >> 6;
  const unsigned long long lt_mask = (1ull << lane) - 1ull;
  const int G = gridDim.x;
  const bool sliced = (G % 8 == 0);
  const int ti = sliced ? team_index(p, smem) : 0;
  const int tsz = sliced ? (G >> 3) : G;
  const int grp_lo = sliced ? ti / tsz : 0, grp_hi = sliced ? grp_lo + 1 : 8;
  const int slot = (sliced ? (ti % tsz) : (int)blockIdx.x) * 8 + w;
  const int nslot = tsz * 8;
  unsigned* lst = (unsigned*)smem + 4096 + w * 128;
  typedef unsigned u32x4_t __attribute__((ext_vector_type(4)));
  if (slot >= TOK) return;
  for (int grp = grp_lo; grp < grp_hi; ++grp) {
#define PU_LIST(E0, E1, N, L0, L1) do { \
      const bool m0_ = ((E0) >> 11) == grp, m1_ = ((E1) >> 11) == grp; \
      const unsigned long long b0_ = __ballot(m0_), b1_ = __ballot(m1_); \
      const int c0_ = __popcll(b0_); N = c0_ + __popcll(b1_); \
      if (m0_) lst[__popcll(b0_ & lt_mask)] = ((unsigned)lane << 14) | (unsigned)(E0); \
      if (m1_) lst[c0_ + __popcll(b1_ & lt_mask)] = ((unsigned)(lane + 64) << 14) | (unsigned)(E1); \
      lds_fence(); \
      L0 = (lane < N) ? lst[lane] : 0u; L1 = (lane + 64 < N) ? lst[lane + 64] : 0u; \
      lds_fence(); } while (0)
#define PU_ISSUE(BUF, L0, N, I0) do { int last_ = ((N) < 64 ? (N) : 64) - 1; last_ = last_ < 0 ? 0 : last_; \
      _Pragma("unroll") for (int j = 0; j < 8; ++j) { int idx_ = (I0) + j; idx_ = idx_ < last_ ? idx_ : last_; \
        const unsigned le_ = (unsigned)__builtin_amdgcn_readlane((int)(L0), idx_); \
        BUF[j] = *(const u32x4_t*)(U8 + (size_t)(le_ & 16383u) * 1024 + lane * 16); } } while (0)
#define PU_REDUCE(BUF, X, I0, HREG) do { int dd_[8]; _Pragma("unroll") for (int j = 0; j < 8; ++j) { \
        int d_ = __builtin_amdgcn_sdot4((int)BUF[j].x, (int)(X).x, 0, false); \
        d_ = __builtin_amdgcn_sdot4((int)BUF[j].y, (int)(X).y, d_, false); \
        d_ = __builtin_amdgcn_sdot4((int)BUF[j].z, (int)(X).z, d_, false); \
        dd_[j] = __builtin_amdgcn_sdot4((int)BUF[j].w, (int)(X).w, d_, false); } \
      const int tot_ = reduce8_i32_scatter(dd_, lane);     \
      if (lane >= (I0) && lane < (I0) + 8) HREG = tot_; } while (0)
    u32x4_t cx = *(const u32x4_t*)(XQ + (size_t)slot * 1024 + lane * 16);
    int ce0 = eidx[(size_t)slot * 128 + lane], ce1 = eidx[(size_t)slot * 128 + 64 + lane];
    float cxs = xs[slot];
    int cn; unsigned cl0, cl1;
    PU_LIST(ce0, ce1, cn, cl0, cl1);
    u32x4_t ra[8], rb[8], rc[8];
    PU_ISSUE(ra, cl0, cn, 0);
    PU_ISSUE(rb, cl0, cn, 8);
    int t1 = (slot + nslot < TOK) ? slot + nslot : slot;
    u32x4_t nx = *(const u32x4_t*)(XQ + (size_t)t1 * 1024 + lane * 16);
    int ne0 = eidx[(size_t)t1 * 128 + lane], ne1 = eidx[(size_t)t1 * 128 + 64 + lane];
    float nxs = xs[t1];
    for (int tok = slot; tok < TOK; tok += nslot) {
      float sc0 = 0.f, sc1 = 0.f, gv0 = 0.f, gv1 = 0.f, vv0 = 0.f, vv1 = 0.f;
      if (lane < cn) { const int e = cl0 & 16383; sc0 = us[e]; vv0 = vs[e]; gv0 = gw[(size_t)tok * 128 + (cl0 >> 14)]; }
      if (lane + 64 < cn) { const int e = cl1 & 16383; sc1 = us[e]; vv1 = vs[e]; gv1 = gw[(size_t)tok * 128 + (cl1 >> 14)]; }
      int nn; unsigned nl0, nl1;
      PU_LIST(ne0, ne1, nn, nl0, nl1);
      const u32x4_t x1 = nx; const int xe0 = ne0, xe1 = ne1; const float xs1 = nxs;
      const int t2a = tok + nslot, t2 = (t2a + nslot < TOK) ? t2a + nslot : ((t2a < TOK) ? t2a : tok);
      nx = *(const u32x4_t*)(XQ + (size_t)t2 * 1024 + lane * 16);
      ne0 = eidx[(size_t)t2 * 128 + lane]; ne1 = eidx[(size_t)t2 * 128 + 64 + lane];
      nxs = xs[t2];
      int h0i = 0, h1i = 0;
      const bool third = cn > 16;
      if (third) { PU_ISSUE(rc, cl0, cn, 16); }
      __builtin_amdgcn_sched_barrier(0); PU_REDUCE(ra, cx, 0, h0i);  __builtin_amdgcn_sched_barrier(0);
      PU_ISSUE(ra, nl0, nn, 0);  __builtin_amdgcn_sched_barrier(0); PU_REDUCE(rb, cx, 8, h0i);  __builtin_amdgcn_sched_barrier(0);
      PU_ISSUE(rb, nl0, nn, 8);  __builtin_amdgcn_sched_barrier(0);
      if (third) { PU_REDUCE(rc, cx, 16, h0i); }
      __builtin_amdgcn_sched_barrier(0);
      if (cn > 24) {
        for (int i0 = 24; i0 < cn; i0 += 8) {
          u32x4_t rd[8];
          const bool lo = i0 < 64;
          const unsigned lsrc = lo ? cl0 : cl1;
          const int nsrc = lo ? cn : cn - 64;
          PU_ISSUE(rd, lsrc, nsrc, i0 & 63);
          if (lo) { PU_REDUCE(rd, cx, i0, h0i); } else { PU_REDUCE(rd, cx, i0 - 64, h1i); }
        }
      }
      const float h0 = (float)h0i * sc0 * cxs, h1 = (float)h1i * sc1 * cxs;
      if (lane < cn) aw[(size_t)tok * 128 + (cl0 >> 14)] = 0.5f * h0 * (1.f + erff(h0 * 0.70710678118654752f)) * gv0 * vv0;
      if (lane + 64 < cn) aw[(size_t)tok * 128 + (cl1 >> 14)] = 0.5f * h1 * (1.f + erff(h1 * 0.70710678118654752f)) * gv1 * vv1;
      cx = x1; ce0 = xe0; ce1 = xe1; cxs = xs1; cn = nn; cl0 = nl0; cl1 = nl1;
    }
#undef PU_LIST
#undef PU_ISSUE
#undef PU_REDUCE
  }
}

template <bool SL>
__device__ __forceinline__ void phase_pv_t(const Params& p, unsigned char* smem) {
  unsigned char* ws = p.ws;
  const unsigned char* V8 = ws + WS_V;
  const int* eidx = (const int*)(ws + WS_EIDX);
  const float* aw = (const float*)(ws + WS_PA);
  float* ssq = (float*)(ws + WS_SSQ);
  const int lane = threadIdx.x & 63, w = threadIdx.x >> 6;
  const int q = lane >> 3, c = lane & 7;
  const int G = gridDim.x;
  constexpr bool sliced = SL;
  const int ti = sliced ? team_index(p, smem) : 0;
  const int tsz = G >> 3;
  const int grp0 = sliced ? (ti / tsz) : 0;
  constexpr int ngrp = sliced ? 1 : 8;
  const int slot = sliced ? (ti % tsz) * 8 + w : blockIdx.x * 8 + w;
  const int nslot = sliced ? tsz * 8 : G * 8;
  int ee[16]; float aa[16];
  if (slot < TOK) {
    unsigned bi = (unsigned)slot * 128u + 16u * (unsigned)q;
    asm volatile("" : "+v"(bi));
#pragma unroll
    for (int u4 = 0; u4 < 4; ++u4) {
      const int4 e4 = *(const int4*)(eidx + bi + 4 * u4); const float4 a4 = *(const float4*)(aw + bi + 4 * u4);
      ee[4 * u4] = e4.x; ee[4 * u4 + 1] = e4.y; ee[4 * u4 + 2] = e4.z; ee[4 * u4 + 3] = e4.w;
      aa[4 * u4] = a4.x; aa[4 * u4 + 1] = a4.y; aa[4 * u4 + 2] = a4.z; aa[4 * u4 + 3] = a4.w;
    }
  }
  for (int tok = slot; tok < TOK; tok += nslot) {
    int ce[16]; float ca[16];
    float suma = 0.f;
#pragma unroll
    for (int u = 0; u < 16; ++u) { ce[u] = ee[u]; ca[u] = aa[u]; suma += aa[u]; }
    for (int gi = 0; gi < ngrp; ++gi) {
      const int grp = grp0 + gi;
      uint4 vv[16];
#pragma unroll
      for (int u = 0; u < 16; ++u) vv[u] = *(const uint4*)(V8 + (size_t)grp * (16384 * 128) + (size_t)ce[u] * 128 + c * 16);
      float* orow = p.out + (size_t)tok * 1024 + grp * 128 + c * 16;
      float4 x1v[4];
#pragma unroll
      for (int i = 0; i < 4; ++i) x1v[i] = *(const float4*)(orow + 4 * i);
      if (gi == ngrp - 1) {
        const int nt = (tok + nslot < TOK) ? tok + nslot : tok;
        unsigned bi = (unsigned)nt * 128u + 16u * (unsigned)q;
        asm volatile("" : "+v"(bi));
#pragma unroll
        for (int u4 = 0; u4 < 4; ++u4) {
          const int4 e4 = *(const int4*)(eidx + bi + 4 * u4); const float4 a4 = *(const float4*)(aw + bi + 4 * u4);
          ee[4 * u4] = e4.x; ee[4 * u4 + 1] = e4.y; ee[4 * u4 + 2] = e4.z; ee[4 * u4 + 3] = e4.w;
          aa[4 * u4] = a4.x; aa[4 * u4 + 1] = a4.y; aa[4 * u4 + 2] = a4.z; aa[4 * u4 + 3] = a4.w;
        }
      }
      __builtin_amdgcn_sched_barrier(0);
      float acc[16];
#pragma unroll
      for (int i = 0; i < 16; ++i) acc[i] = -128.f * suma;
#pragma unroll
      for (int u = 0; u < 16; ++u) {
        float vf[16];
        cvt16u8(vv[u], vf);
#pragma unroll
        for (int i = 0; i < 16; ++i) acc[i] += ca[u] * vf[i];
        __builtin_amdgcn_sched_barrier(0);
      }
#pragma unroll
      for (int i = 0; i < 16; ++i) { acc[i] = add_xor8(acc[i]); acc[i] = add_xor16(acc[i]); acc[i] = add_xor32(acc[i]); }
      float ss = 0.f;
      if (q == 0) {
#pragma unroll
        for (int i = 0; i < 4; ++i) {
          const float4 oa = make_float4(x1v[i].x + acc[4 * i], x1v[i].y + acc[4 * i + 1], x1v[i].z + acc[4 * i + 2], x1v[i].w + acc[4 * i + 3]);
          *(float4*)(orow + 4 * i) = oa;
          ss += oa.x * oa.x + oa.y * oa.y + oa.z * oa.z + oa.w * oa.w;
        }
      }
      ss += __shfl_xor(ss, 1); ss += __shfl_xor(ss, 2); ss += __shfl_xor(ss, 4);
      if (lane == 0) atomicAdd(&ssq[tok], ss);
    }
  }
}

__device__ __forceinline__ void phase_pv_mfma(const Params& p, unsigned char* smem) {
  unsigned char* ws = p.ws;
  const unsigned char* V8 = ws + WS_V;
  const int* eidx = (const int*)(ws + WS_EIDX);
  const float* aw = (const float*)(ws + WS_PA);
  float* ssq = (float*)(ws + WS_SSQ);
  const int lane = threadIdx.x & 63, w = threadIdx.x >> 6;
  const int q8 = lane >> 3, c = lane & 7;
  const int l15 = lane & 15, g = lane >> 4;
  const int G = gridDim.x;
  const bool sliced = (G % 8 == 0);
  const int ti = sliced ? team_index(p, smem) : 0;
  const int tsz = sliced ? (G >> 3) : G;
  const int grp_lo = sliced ? ti / tsz : 0, grp_hi = sliced ? grp_lo + 1 : 8;
  const int slot = (sliced ? (ti % tsz) : (int)blockIdx.x) * 8 + w;
  const int nslot = tsz * 8;
  if (slot >= TOK) return;
  unsigned char* vs_l = smem + 16384 + w * 16384;
  typedef unsigned u32x4_t __attribute__((ext_vector_type(4)));
  typedef float f32x4_t __attribute__((ext_vector_type(4)));
  typedef int i32x4_t __attribute__((ext_vector_type(4)));
  typedef int i32x2_t __attribute__((ext_vector_type(2)));
  const unsigned tr_f16 = (unsigned)((((l15 >> 2) & 3) | ((g & 1) << 2)) << 4);
  const unsigned tr_lane = (unsigned)((l15 >> 1) * 128 + (l15 & 1) * 8);
  unsigned tr_off[8];
#pragma unroll
  for (int nt = 0; nt < 8; ++nt) tr_off[nt] = tr_lane + (((unsigned)nt << 4) ^ tr_f16);
  unsigned st_off[4];
#pragma unroll
  for (int cu = 0; cu < 4; ++cu) st_off[cu] = (unsigned)(16 * q8 * 128 + (((c ^ ((q8 & 1) << 2)) ^ cu) << 4));
  for (int grp = grp_lo; grp < grp_hi; ++grp) {
    const unsigned char* Vg = V8 + (size_t)grp * (16384 * 128) + c * 16;
    i32x4_t ee[4]; f32x4_t aa[8];
#define PVM_META(TOKEN) do { \
      const i32x4_t* ep_ = (const i32x4_t*)(eidx + (size_t)(TOKEN) * 128 + 16 * q8); \
      _Pragma("unroll") for (int u4 = 0; u4 < 4; ++u4) ee[u4] = ep_[u4]; \
      const f32x4_t* ap_ = (const f32x4_t*)(aw + (size_t)(TOKEN) * 128 + 16 * g); \
      _Pragma("unroll") for (int u4 = 0; u4 < 4; ++u4) { aa[u4] = ap_[u4]; aa[4 + u4] = ap_[16 + u4]; } } while (0)
    PVM_META(slot);
    for (int tok = slot; tok < TOK; tok += nslot) {
      u32x4_t vv[16];
#pragma unroll
      for (int u = 0; u < 16; ++u) vv[u] = *(const u32x4_t*)(Vg + (size_t)ee[u >> 2][u & 3] * 128);
      float* orow = p.out + (size_t)tok * 1024 + grp * 128 + l15;
      float x1v[8];
#pragma unroll
      for (int nt = 0; nt < 8; ++nt) x1v[nt] = orow[nt * 16];
      float am = 0.f;
#pragma unroll
      for (int i = 0; i < 8; ++i) am = fmaxf(am, fmaxf(fmaxf(fabsf(aa[i].x), fabsf(aa[i].y)), fmaxf(fabsf(aa[i].z), fabsf(aa[i].w))));
      am = max_xor16(am); am = max_xor32(am);
      const float inva = am > 0.f ? 127.f / am : 0.f, sa = am * (1.f / 127.f);
      i32x4_t aop[2];
#pragma unroll
      for (int s2 = 0; s2 < 2; ++s2)
#pragma unroll
        for (int d4 = 0; d4 < 4; ++d4) {
          const f32x4_t a4 = aa[4 * s2 + d4];
          const unsigned b0 = (unsigned)(int)rintf(a4.x * inva) & 255u, b1 = (unsigned)(int)rintf(a4.y * inva) & 255u;
          const unsigned b2 = (unsigned)(int)rintf(a4.z * inva) & 255u, b3 = (unsigned)(int)rintf(a4.w * inva) & 255u;
          aop[s2][d4] = (int)(b0 | (b1 << 8) | (b2 << 16) | (b3 << 24));
        }
      { const int nt_ = (tok + nslot < TOK) ? tok + nslot : tok; PVM_META(nt_); }
      __builtin_amdgcn_sched_barrier(0);
#pragma unroll
      for (int u = 0; u < 16; ++u) *(u32x4_t*)(vs_l + st_off[(u >> 1) & 3] + u * 128) = vv[u];
      lds_fence();
      i32x4_t acc[8];
#pragma unroll
      for (int nt = 0; nt < 8; ++nt) acc[nt] = (i32x4_t){0, 0, 0, 0};
#pragma unroll
      for (int s2 = 0; s2 < 2; ++s2)
#pragma unroll
        for (int nt = 0; nt < 8; ++nt) {
          const unsigned a0 = (unsigned)((s2 * 64 + 16 * g) * 128) + tr_off[nt];
          const i32x2_t lo = __builtin_amdgcn_ds_read_tr8_b64_v2i32((__attribute__((address_space(3))) i32x2_t*)(vs_l + a0));
          const i32x2_t hi = __builtin_amdgcn_ds_read_tr8_b64_v2i32((__attribute__((address_space(3))) i32x2_t*)(vs_l + a0 + 8 * 128));
          const i32x4_t bop = {lo[0], lo[1], hi[0], hi[1]};
          acc[nt] = __builtin_amdgcn_mfma_i32_16x16x64_i8(aop[s2], bop, acc[nt], 0, 0, 0);
        }
      lds_fence();
      float ss = 0.f;
      if (g == 0) {
#pragma unroll
        for (int nt = 0; nt < 8; ++nt) { const float o = x1v[nt] + (float)acc[nt][0] * sa; orow[nt * 16] = o; ss += o * o; }
      }
      ss += __int_as_float(__builtin_amdgcn_update_dpp(0, __float_as_int(ss), 0xB1, 0xf, 0xf, true));
      ss += __int_as_float(__builtin_amdgcn_update_dpp(0, __float_as_int(ss), 0x4E, 0xf, 0xf, true));
      ss += __int_as_float(__builtin_amdgcn_update_dpp(0, __float_as_int(ss), 0x141, 0xf, 0xf, true));
      ss += __int_as_float(__builtin_amdgcn_update_dpp(0, __float_as_int(ss), 0x140, 0xf, 0xf, true));
      if (lane == 0) atomicAdd(&ssq[tok], ss);
    }
#undef PVM_META
  }
}

__device__ __forceinline__ void phase_final(const Params& p) {
  const float* ssq = (const float*)(p.ws + WS_SSQ);
  const int lane = threadIdx.x & 63, w = threadIdx.x >> 6;
  for (int row = blockIdx.x * 8 + w; row < TOK; row += gridDim.x * 8) {
    const float rstd = rsqrtf(ssq[row] * (1.f / DM) + EPSV);
    float4* o4 = (float4*)(p.out + (size_t)row * DM);
#pragma unroll
    for (int i = 0; i < 4; ++i) {
      float4 v = o4[lane + 64 * i];
      const float4 gg = ((const float4*)p.norm_final)[lane + 64 * i];
      v.x *= rstd * gg.x; v.y *= rstd * gg.y; v.z *= rstd * gg.z; v.w *= rstd * gg.w;
      o4[lane + 64 * i] = v;
    }
  }
}


__device__ __forceinline__ void phase_proj8(const Params& p, unsigned char* smem) {
  unsigned char* ws = p.ws;
  pg8::Gemm g{(const pg8::bf16_t*)(ws + WS_XN), (const pg8::bf16_t*)(ws + WS_WIN), TOK, 5120, 512};
  pg8::StaticOrder S; S.init(TOK, 5120, (int)gridDim.x, (int)blockIdx.x);
  EpiProj E{(unsigned short*)(ws + WS_PH), (unsigned short*)(ws + WS_PA), (unsigned short*)(ws + WS_PG),
            (unsigned short*)(ws + WS_KC), (unsigned short*)(ws + WS_VC), (unsigned short*)(ws + WS_IKC),
            (const float*)(ws + WS_XNS), (const float*)(ws + WS_WINS)};
  pg8::gemm_phase<EpiProj, pg8::StaticOrder, false, true>((PG8_LAS unsigned char*)smem, g, S, E, nullptr);
}
__device__ __forceinline__ void phase_ikln(const Params& p) {
  bf16_t* ikc = (bf16_t*)(p.ws + WS_IKC);
  const int tid = threadIdx.x, sub = tid & 7;
  float gam[8], bet[8];
#pragma unroll
  for (int i = 0; i < 8; ++i) { gam[i] = p.ikg[sub * 8 + i]; bet[i] = p.ikb[sub * 8 + i]; }
  for (int row = blockIdx.x * 64 + (tid >> 3); row < TOK; row += gridDim.x * 64) {
    uint4* ptr = (uint4*)(ikc + (size_t)row * 64 + sub * 8);
    const uint4 raw = *ptr;
    float v[8];
    cvt8(raw, v);
    float s = 0.f;
#pragma unroll
    for (int i = 0; i < 8; ++i) s += v[i];
    s += __shfl_xor(s, 1); s += __shfl_xor(s, 2); s += __shfl_xor(s, 4);
    const float mu = s * (1.f / 64.f);
    float q = 0.f;
#pragma unroll
    for (int i = 0; i < 8; ++i) { const float d = v[i] - mu; q += d * d; }
    q += __shfl_xor(q, 1); q += __shfl_xor(q, 2); q += __shfl_xor(q, 4);
    const float rstd = rsqrtf(q * (1.f / 64.f) + EPSV);
    uint4 o;
    o.x = pack2((v[0] - mu) * rstd * gam[0] + bet[0], (v[1] - mu) * rstd * gam[1] + bet[1]);
    o.y = pack2((v[2] - mu) * rstd * gam[2] + bet[2], (v[3] - mu) * rstd * gam[3] + bet[3]);
    o.z = pack2((v[4] - mu) * rstd * gam[4] + bet[4], (v[5] - mu) * rstd * gam[5] + bet[5]);
    o.w = pack2((v[6] - mu) * rstd * gam[6] + bet[6], (v[7] - mu) * rstd * gam[7] + bet[7]);
    *ptr = o;
  }
}
__device__ __forceinline__ void phase_up8(const Params& p, unsigned char* smem) {
  unsigned char* ws = p.ws;
  pg8::Gemm g{(const pg8::bf16_t*)(ws + WS_XN), (const pg8::bf16_t*)(ws + WS_WUPA), TOK, 1024, 1024};
  pg8::StaticOrder S; S.init(TOK, 1024, (int)gridDim.x, (int)blockIdx.x);
  EpiGate2 E{(unsigned short*)(ws + WS_PH), (const unsigned short*)(ws + WS_PG)};
  pg8::gemm_phase<EpiGate2, pg8::StaticOrder>((PG8_LAS unsigned char*)smem, g, S, E, nullptr);
}
__device__ __forceinline__ void phase_out8(const Params& p, unsigned char* smem) {
  unsigned char* ws = p.ws;
  pg8::Gemm g{(const pg8::bf16_t*)(ws + WS_PH), (const pg8::bf16_t*)(ws + WS_WOUT), TOK, 1024, 1024};
  pg8::StaticOrder S; S.init(TOK, 1024, (int)gridDim.x, (int)blockIdx.x);
  EpiResid E{p.out, p.x};
  pg8::gemm_phase<EpiResid, pg8::StaticOrder>((PG8_LAS unsigned char*)smem, g, S, E, nullptr);
}
__device__ __forceinline__ void phase_pq8(const Params& p, unsigned char* smem) {
  unsigned char* ws = p.ws;
  pg8::Gemm g{(const pg8::bf16_t*)(ws + WS_XQ), (const pg8::bf16_t*)(ws + WS_WQ), TOK, 2048, 512};
  pg8::StaticOrder S; S.init(TOK, 2048, (int)gridDim.x, (int)blockIdx.x);
  EpiStoreBf16Q E{(unsigned short*)(ws + WS_PG), 2048, (const float*)(ws + WS_XS), (const float*)(ws + WS_WQS)};
  pg8::gemm_phase<EpiStoreBf16Q, pg8::StaticOrder, false, true>((PG8_LAS unsigned char*)smem, g, S, E, nullptr);
}

__global__ void __launch_bounds__(NTHREADS) hybrid_fwd(Params p) {
  extern __shared__ __attribute__((aligned(16))) unsigned char smem[];
#if ONE_LAUNCH
  cg::grid_group grid = cg::this_grid();
  volatile LAS unsigned* xst = (volatile LAS unsigned*)(smem + LDS_BYTES - 16);
  if (threadIdx.x == 0) { xst[0] = 0u; xst[1] = 0u; }
  __syncthreads();
  XcdBarrier xbar = xcd_barrier_post((unsigned*)(p.ws + WS_BAR), xst);
#define SEAM(k) do { if (p.ph_lo <= (k) && (k) + 1 < p.ph_hi) { if (p.ph_hi > NPHASE) grid.sync(); else xcd_barrier(xbar); } } while (0)
#else
#define SEAM(k) do { } while (0)
#endif
#define IN(k) (p.ph_lo <= (k) && (k) < p.ph_hi)
#ifndef REPEAT_PH
#define REPEAT_PH -1
#endif
#define REP(k, stmt) do { if (REPEAT_PH == (k)) { stmt; grid.sync(); } } while (0)
  if (IN(0)) { phase_prep(p, smem); SEAM(0); }
  if (IN(1)) { phase_proj8(p, smem); SEAM(1); }
  if (IN(2)) { phase_ikln(p); hgrn_h1_all(p, smem); SEAM(2); }
  if (IN(3)) { phase_mix(p, smem); SEAM(3); }
  if (IN(4)) { phase_up8(p, smem); SEAM(4); }
  if (IN(5)) { phase_out8(p, smem); SEAM(5); }
  if (IN(6)) { rmsnorm_rows_q<false>(p.out, p.norm_ffn, nullptr, p.ws + WS_XQ, (float*)(p.ws + WS_XS)); SEAM(6); }
  if (IN(7)) { phase_pq8(p, smem); SEAM(7); }
  if (IN(8)) { phase_pkeys(p, smem); SEAM(8); }
  if (IN(9)) { phase_pu(p, smem); SEAM(9); }
  if (IN(10)) { phase_pv_mfma(p, smem); SEAM(10); }
  if (IN(11)) { phase_final(p); }
#undef IN
#undef SEAM
}

extern "C" void kernel_launch(void* const* d_in, const int* in_sizes, int n_in, void* d_out, int out_size, void* d_ws, size_t ws_size,
                              hipStream_t stream) {
  static int grid = 0;
  if (grid == 0) {
    if (n_in != 17 || ws_size < WS_END) {
      fprintf(stderr, "kernel_launch: unexpected n_in %d or ws_size %zu (need %zu)\n", n_in, ws_size, (size_t)WS_END);
      grid = -1; return;
    }
    int dev = 0, cus = 0, per_cu = 0;
    hipGetDevice(&dev);
    hipDeviceGetAttribute(&cus, hipDeviceAttributeMultiprocessorCount, dev);
    hipFuncSetAttribute((const void*)hybrid_fwd, hipFuncAttributeMaxDynamicSharedMemorySize, LDS_BYTES);
    hipOccupancyMaxActiveBlocksPerMultiprocessor(&per_cu, (const void*)hybrid_fwd, NTHREADS, LDS_BYTES);
    if (per_cu < 1) { fprintf(stderr, "kernel_launch: occupancy query says %d blocks/CU\n", per_cu); per_cu = 1; }
    (void)hipGetLastError();
    grid = cus;
  }
  if (grid < 0) return;
  Params p{};
  p.x = (const float*)d_in[0]; p.norm_mix = (const float*)d_in[1]; p.w_in = (const float*)d_in[2]; p.hg_lb = (const float*)d_in[3];
  p.hg_norm = (const float*)d_in[4]; p.ikg = (const float*)d_in[5]; p.ikb = (const float*)d_in[6]; p.rel_bias = (const float*)d_in[7];
  p.w_up_a = (const float*)d_in[8]; p.w_up_b = (const float*)d_in[9]; p.w_out = (const float*)d_in[10]; p.norm_ffn = (const float*)d_in[11];
  p.peer_wq = (const float*)d_in[12]; p.peer_keys = (const float*)d_in[13]; p.peer_u = (const float*)d_in[14]; p.peer_v = (const float*)d_in[15];
  p.norm_final = (const float*)d_in[16];
  p.out = (float*)d_out; p.ws = (unsigned char*)d_ws;
#if ONE_LAUNCH
  hipMemsetAsync((unsigned char*)d_ws + WS_BAR, 0, 16384, stream);
  p.ph_lo = 0; p.ph_hi = NPHASE;
  void* args[] = {&p};
  hipError_t e = hipLaunchCooperativeKernel((const void*)hybrid_fwd, dim3(grid), dim3(NTHREADS), args, LDS_BYTES, stream);
  if (e != hipSuccess) fprintf(stderr, "cooperative launch failed: %s (grid %d)\n", hipGetErrorString(e), grid);
#else
  for (int ph = 0; ph < NPHASE; ++ph) {
    p.ph_lo = ph; p.ph_hi = ph + 1;
    hipLaunchKernelGGL(hybrid_fwd, dim3(grid), dim3(NTHREADS), LDS_BYTES, stream, p);
  }
#endif
}
```

```cpp
#include <hip/hip_runtime.h>
#include <hip/hip_cooperative_groups.h>
#include <stdint.h>
#include <stdio.h>
namespace cg = cooperative_groups;

#ifndef ONE_LAUNCH
#define ONE_LAUNCH 1
#endif

typedef unsigned short bf16_t;
typedef __attribute__((ext_vector_type(8))) short bf16x8;
typedef __attribute__((ext_vector_type(4))) float f32x4;

#define NTHREADS 512
#define TOK 32768
#define SEQL 4096
#define DM 1024
#define EPSV 1e-6f
#define NPHASE 12

#define WS_WIN   ((size_t)0)
#define WS_WUPA  (WS_WIN  + (size_t)5120 * 1024 * 2)
#define WS_WUPB  (WS_WUPA + (size_t)1024 * 512 * 2)
#define WS_WOUT  (WS_WUPB + (size_t)1024 * 512 * 2)
#define WS_WQ    (WS_WOUT + (size_t)1024 * 1024 * 2)
#define WS_KEYS  (WS_WQ   + (size_t)2048 * 1024 * 2)
#define WS_LB    (WS_KEYS + (size_t)2 * 8 * 128 * 128 * 2)
#define WS_U     (WS_LB   + (size_t)4096)
#define WS_V     (WS_U    + (size_t)16384 * 1024 * 2)
#define WS_XN    (WS_V    + (size_t)16384 * 1024 * 2)
#define WS_PH    (WS_XN   + (size_t)TOK * 1024 * 2)
#define WS_PA    (WS_PH   + (size_t)TOK * 2048 * 2)
#define WS_PG    (WS_PA   + (size_t)TOK * 1024 * 2)
#define WS_EIDX  (WS_PG   + (size_t)TOK * 2048 * 2)
#define WS_GW    (WS_EIDX + (size_t)TOK * 128 * 4)
#define WS_SSQ   (WS_GW   + (size_t)TOK * 128 * 4)
#define WS_XCC   (WS_SSQ  + (size_t)TOK * 4)
#define WS_BAR   (WS_XCC  + (size_t)4096)
#define WS_DEC   (WS_BAR  + (size_t)16384)
#define WS_QCTR  (WS_DEC  + (size_t)2048 * 384 * 4)
#define WS_END   (WS_QCTR + (size_t)1024)

#define WS_KC (WS_EIDX)
#define WS_VC (WS_KC + (size_t)TOK * 128)
#define WS_IKC (WS_VC + (size_t)TOK * 128)
#define LDS_BYTES 155648

struct Params {
  const float* x; const float* norm_mix; const float* w_in; const float* hg_lb; const float* hg_norm;
  const float* ikg; const float* ikb; const float* rel_bias; const float* w_up_a; const float* w_up_b;
  const float* w_out; const float* norm_ffn; const float* peer_wq; const float* peer_keys;
  const float* peer_u; const float* peer_v; const float* norm_final;
  float* out; unsigned char* ws; int ph_lo, ph_hi;
};

__device__ __forceinline__ float bf2f(bf16_t u) { return __uint_as_float(((unsigned)u) << 16); }
typedef float f32x2_cv __attribute__((ext_vector_type(2)));
typedef __bf16 bf16x2_cv __attribute__((ext_vector_type(2)));
__device__ __forceinline__ unsigned pack2(float a, float b) {
  const f32x2_cv v = {a, b};
  return __builtin_bit_cast(unsigned, __builtin_convertvector(v, bf16x2_cv));
}
__device__ __forceinline__ bf16_t f2bf(float f) { return (bf16_t)(pack2(f, f) & 0xffffu); }
__device__ __forceinline__ float wave_sum_slow(float v) {
#pragma unroll
  for (int o = 32; o > 0; o >>= 1) v += __shfl_xor(v, o);
  return v;
}
__device__ __forceinline__ void lds_fence() { asm volatile("s_waitcnt lgkmcnt(0)" ::: "memory"); }

__device__ __forceinline__ float add_xor8(float v) { return v + __int_as_float(__builtin_amdgcn_update_dpp(0, __float_as_int(v), 0x128, 0xf, 0xf, true)); }
__device__ __forceinline__ float add_xor16(float v) { const auto r = __builtin_amdgcn_permlane16_swap(__float_as_uint(v), __float_as_uint(v), false, false); return __uint_as_float(r[0]) + __uint_as_float(r[1]); }
__device__ __forceinline__ float add_xor32(float v) { const auto r = __builtin_amdgcn_permlane32_swap(__float_as_uint(v), __float_as_uint(v), false, false); return __uint_as_float(r[0]) + __uint_as_float(r[1]); }
__device__ __forceinline__ float max_xor16(float v) { const auto r = __builtin_amdgcn_permlane16_swap(__float_as_uint(v), __float_as_uint(v), false, false); return fmaxf(__uint_as_float(r[0]), __uint_as_float(r[1])); }
__device__ __forceinline__ float max_xor32(float v) { const auto r = __builtin_amdgcn_permlane32_swap(__float_as_uint(v), __float_as_uint(v), false, false); return fmaxf(__uint_as_float(r[0]), __uint_as_float(r[1])); }
__device__ __forceinline__ float wave_sum(float v) {
  v += __int_as_float(__builtin_amdgcn_update_dpp(0, __float_as_int(v), 0xB1, 0xf, 0xf, true));
  v += __int_as_float(__builtin_amdgcn_update_dpp(0, __float_as_int(v), 0x4E, 0xf, 0xf, true));
  v += __int_as_float(__builtin_amdgcn_update_dpp(0, __float_as_int(v), 0x141, 0xf, 0xf, true));
  v += __int_as_float(__builtin_amdgcn_update_dpp(0, __float_as_int(v), 0x140, 0xf, 0xf, true));
  return add_xor32(add_xor16(v));
}
__device__ __forceinline__ float sigmoidf_(float x) { return 1.f / (1.f + __expf(-x)); }
__device__ __forceinline__ float siluf_(float x) { return x / (1.f + __expf(-x)); }


#define XB_TMO      128
#define XB_XCNT(j)  (256  + 64 * (j))
#define XB_XSUB(j)  (1280 + 64 * (j))
#define XB_XGEN(j)  (2304 + 64 * (j))
#define XB_TOP      3328
#define XB_TOPGEN   3392
#define XCD_BAR_WORDS 3456
#define XB_SPIN_CAP (1u << 22)
#define LAS __attribute__((address_space(3)))
__device__ __forceinline__ unsigned xb_ld(unsigned* p)              { return __hip_atomic_load(p, __ATOMIC_RELAXED, __HIP_MEMORY_SCOPE_AGENT); }
__device__ __forceinline__ unsigned xb_add(unsigned* p, unsigned v) { return __hip_atomic_fetch_add(p, v, __ATOMIC_RELAXED, __HIP_MEMORY_SCOPE_AGENT); }
__device__ __forceinline__ unsigned xb_xcc_id() { return (unsigned)__builtin_amdgcn_s_getreg((3 << 11) | 20) & 0xFu; }
#define XB_SPIN(cond, bar) do { unsigned _sp = 0; while (cond) { __builtin_amdgcn_s_sleep(1); \
    if ((++_sp & 255u) == 0u) { if (xb_ld(&(bar)[XB_TMO])) break; if (_sp > XB_SPIN_CAP) { atomicAdd(&(bar)[XB_TMO], 1u); break; } } } } while (0)
struct XcdBarrier { unsigned* bar; unsigned x; volatile LAS unsigned* st; };
__device__ __forceinline__ XcdBarrier xcd_barrier_post(unsigned* bar, volatile LAS unsigned* st) {
  XcdBarrier b; b.bar = bar; b.x = xb_xcc_id(); b.st = st;
  if (threadIdx.x == 0) (void)xb_add(&bar[XB_XCNT(b.x)], 1u);
  return b;
}
__device__ __forceinline__ void xcd_barrier_complete(unsigned* bar, unsigned x, unsigned& nloc, unsigned& nx) {
  const unsigned G = gridDim.x * gridDim.y * gridDim.z;
  unsigned sum, cnt, mine, sp = 0u;
  for (;;) {
    sum = 0u; cnt = 0u; mine = 0u;
#pragma unroll
    for (unsigned j = 0; j < 16; ++j) { const unsigned c = xb_ld(&bar[XB_XCNT(j)]); sum += c; cnt += (c > 0u) ? 1u : 0u; mine = (j == x) ? c : mine; }
    if (sum == G) break;
    __builtin_amdgcn_s_sleep(1);
    if ((++sp & 255u) == 0u) { if (xb_ld(&bar[XB_TMO])) break; if (sp > XB_SPIN_CAP) { atomicAdd(&bar[XB_TMO], 1u); break; } }
  }
  nloc = mine > 0u ? mine : 1u; nx = cnt > 0u ? cnt : 1u;
}
__device__ __forceinline__ void xcd_barrier(const XcdBarrier& b) {
  asm volatile("s_waitcnt vmcnt(0)" ::: "memory");
  __syncthreads();
  if (threadIdx.x == 0) {
    unsigned* bar = b.bar;
    __builtin_amdgcn_s_waitcnt(0);
    unsigned nloc = b.st[0], nx = b.st[1];
    if (nloc == 0u) { xcd_barrier_complete(bar, b.x, nloc, nx); b.st[0] = nloc; b.st[1] = nx; }
    const unsigned old = xb_add(&bar[XB_XSUB(b.x)], 1u);
    const unsigned gen = old / nloc;
    if (old + 1u == (gen + 1u) * nloc) {
      __builtin_amdgcn_fence(__ATOMIC_RELEASE, "agent");
      asm volatile("s_waitcnt vmcnt(0)" ::: "memory");
      const unsigned og = xb_add(&bar[XB_TOP], 1u);
      const unsigned tg = og / nx;
      if (og + 1u == (tg + 1u) * nx) xb_add(&bar[XB_TOPGEN], 1u);
      else XB_SPIN(xb_ld(&bar[XB_TOPGEN]) == tg, bar);
      __builtin_amdgcn_fence(__ATOMIC_ACQUIRE, "agent");
      xb_add(&bar[XB_XGEN(b.x)], 1u);
      asm volatile("s_waitcnt vmcnt(0)" ::: "memory");
    } else {
      XB_SPIN(xb_ld(&bar[XB_XGEN(b.x)]) == gen, bar);
      __builtin_amdgcn_fence(__ATOMIC_ACQUIRE, "agent");
      asm volatile("s_waitcnt vmcnt(0)" ::: "memory");
    }
  }
  __syncthreads();
}

namespace pg8 {
#define PG8_LAS __attribute__((address_space(3)))
typedef unsigned short bf16_t;
typedef short bf16x8 __attribute__((ext_vector_type(8)));
typedef float f32x4 __attribute__((ext_vector_type(4)));
typedef unsigned u32x4 __attribute__((ext_vector_type(4)));
constexpr int BM = 256, BK = 64, HALF = 128, HTB = HALF * BK * 2  , STAGE_BYTES = 8 * HTB, NXCD = 8, WGM = 8;

__host__ __device__ __forceinline__ int lds_byte(int r, int c) { const int st = (r >> 4) * 2 + (c >> 5), rr = r & 15, cc = c & 31, ob = rr * 64 + cc * 2; return st * 1024 + (ob ^ (((ob >> 9) & 1) << 5)); }
__host__ __device__ __forceinline__ void stage_rc(int b, int& R, int& C) { const int st = b / 1024, sb = b % 1024, swz = sb ^ (((sb >> 9) & 1) << 5); R = (st >> 1) * 16 + swz / 64; C = (st & 1) * 32 + (swz % 64) / 2; }
__host__ __device__ __forceinline__ int perm32(int rho) { const int n = rho >> 4, i = rho & 15; return 8 * (i >> 2) + 4 * n + (i & 3); }

struct Unit { int pm, pn; };
struct Gemm { const bf16_t* A; const bf16_t* Bt; int M, N, K; };

struct StaticOrder {
    int nM, nN, nwg, G, c;
    __host__ __device__ void init(int M, int N, int G_, int c_) { nM = M / BM; nN = N / BM; nwg = nM * nN; G = G_; c = c_; }
    __host__ __device__ bool next(int i, Unit& u) const {
        const long L = (long)i * G + c; if (L >= nwg) return false;
        int wgid = (int)L; { const int q = nwg / NXCD, r = nwg % NXCD, xcd = wgid % NXCD, off = wgid / NXCD; wgid = (xcd < r ? xcd * (q + 1) : r * (q + 1) + (xcd - r) * q) + off; }
        const int nig = WGM * nN, gid = wgid / nig, fm = gid * WGM, gsz = (nM - fm) < WGM ? (nM - fm) : WGM;
        u.pm = fm + ((wgid % nig) % gsz); u.pn = (wgid % nig) / gsz; return true;
    }
    __device__ __forceinline__ void a_ready(const Unit&) const {}
    __device__ __forceinline__ void done(const Unit&) const {}
};
__device__ __forceinline__ unsigned cvt_pk_bf16(float lo, float hi) { unsigned r; asm volatile("v_cvt_pk_bf16_f32 %0, %1, %2" : "=v"(r) : "v"(lo), "v"(hi)); return r; }
typedef int i32x4 __attribute__((ext_vector_type(4)));
template <class Epi, class Sched, bool STAMP = false, bool I8 = false>
__device__ __forceinline__ void gemm_phase(PG8_LAS unsigned char* lds, const Gemm g, const Sched& S, const Epi& E, unsigned long long* stamps) {
    const int tid = threadIdx.x, wid = __builtin_amdgcn_readfirstlane(tid >> 6), lane = tid & 63, wr = wid >> 2, wc = wid & 3, fr = lane & 15, fq = lane >> 4;
    const int K = g.K, nt = K / BK;
    int ts_lo = 0, ts_hi = 0, nts = 0; const unsigned long long rt_entry = STAMP ? (unsigned long long)wall_clock64() : 0ull;
#define PG8_STAMP() do { if (STAMP && wid == 0 && nts < 64) { const unsigned long long _c = (unsigned long long)clock64(); \
        ts_lo = (lane == nts) ? (int)(unsigned)_c : ts_lo; ts_hi = (lane == nts) ? (int)(unsigned)(_c >> 32) : ts_hi; ++nts; } } while (0)
    PG8_STAMP();
    unsigned voffA[2], voffB[2];
#pragma unroll
    for (int i = 0; i < 2; ++i) { int R, C; stage_rc(tid * 16 + i * 8192, R, C); const int Rb = Epi::PERM ? ((R & ~31) + perm32(R & 31)) : R;
        voffA[i] = (unsigned)(R * K + C) * 2u; voffB[i] = (unsigned)(Rb * K + C) * 2u; }
    const size_t kstep = (size_t)(BK * 2);
    const size_t hstep = (size_t)HALF * K * 2;
    const size_t tstep = 2 * hstep;
    const unsigned ldsw = (unsigned)wid * 1024u;
    const int aoff = lds_byte(wr * 64 + fr, fq * 8), boff = lds_byte(wc * 32 + fr, fq * 8);
#define PG8_SA(b, h) (((b) * 2 + (h)) * HTB)
#define PG8_SB(b, h) ((4 + (b) * 2 + (h)) * HTB)
#define PG8_STAGE(bufoff, gbase, voff) do { _Pragma("unroll") for (int _i = 0; _i < 2; ++_i) \
        __builtin_amdgcn_global_load_lds((const unsigned*)((const char*)(gbase) + (voff)[_i]), (PG8_LAS unsigned*)(lds + (bufoff) + ldsw + _i * 8192), 16, 0, 0); } while (0)
#define PG8_LDA(dst, b, h) do { _Pragma("unroll") for (int m = 0; m < 4; ++m) _Pragma("unroll") for (int k = 0; k < 2; ++k) dst[m][k] = *(const PG8_LAS bf16x8*)(lds + PG8_SA(b, h) + aoff + m * 2048 + k * 1024); } while (0)
#define PG8_LDB(dst, b, h) do { _Pragma("unroll") for (int n = 0; n < 2; ++n) _Pragma("unroll") for (int k = 0; k < 2; ++k) dst[n][k] = *(const PG8_LAS bf16x8*)(lds + PG8_SB(b, h) + boff + n * 2048 + k * 1024); } while (0)
#define PG8_MMA(ai, bj, At, Bt) do { __builtin_amdgcn_s_setprio(1); _Pragma("unroll") for (int m = 0; m < 4; ++m) _Pragma("unroll") for (int n = 0; n < 2; ++n) _Pragma("unroll") for (int k = 0; k < 2; ++k) \
        { if constexpr (I8) acc[ai][bj][m][n] = __builtin_bit_cast(f32x4, __builtin_amdgcn_mfma_i32_16x16x64_i8(__builtin_bit_cast(i32x4, Bt[n][k]), __builtin_bit_cast(i32x4, At[m][k]), __builtin_bit_cast(i32x4, acc[ai][bj][m][n]), 0, 0, 0)); \
          else acc[ai][bj][m][n] = __builtin_amdgcn_mfma_f32_16x16x32_bf16(Bt[n][k], At[m][k], acc[ai][bj][m][n], 0, 0, 0); } __builtin_amdgcn_s_setprio(0); } while (0)
#define PG8_WAIT_V(n) asm volatile("s_waitcnt vmcnt(" #n ")" ::: "memory")
#define PG8_WAIT_L(n) asm volatile("s_waitcnt lgkmcnt(" #n ")" ::: "memory")
#define PG8_BAR __builtin_amdgcn_s_barrier()
#define PG8_SCHED __builtin_amdgcn_sched_barrier(0)
    Unit cur, nxt; int ui = 0;
    if (!S.next(0, cur)) return;
    f32x4 acc[2][2][4][2];
#pragma unroll
    for (int a = 0; a < 2; ++a)
#pragma unroll
        for (int b = 0; b < 2; ++b)
#pragma unroll
            for (int m = 0; m < 4; ++m)
#pragma unroll
                for (int n = 0; n < 2; ++n) acc[a][b][m][n] = (f32x4){0.f, 0.f, 0.f, 0.f};
    bf16x8 At[4][2], B0[2][2], B1[2][2];
    const char* cA = (const char*)g.A + (size_t)cur.pm * tstep; const char* cB = (const char*)g.Bt + (size_t)cur.pn * tstep;
    S.a_ready(cur);
    PG8_STAGE(PG8_SB(0, 0), cB, voffB); PG8_STAGE(PG8_SA(0, 0), cA, voffA); PG8_STAGE(PG8_SB(0, 1), cB + hstep, voffB); PG8_STAGE(PG8_SA(0, 1), cA + hstep, voffA);
    if (wr == 1) PG8_BAR;
    PG8_WAIT_V(4); PG8_BAR;
    PG8_STAGE(PG8_SB(1, 0), cB + kstep, voffB); PG8_STAGE(PG8_SA(1, 0), cA + kstep, voffA); PG8_STAGE(PG8_SB(1, 1), cB + hstep + kstep, voffB);
    PG8_WAIT_V(6); PG8_BAR;
    PG8_STAMP();
    for (;;) {
        const bool has_next = S.next(ui + 1, nxt);
        const char* nA = has_next ? (const char*)g.A + (size_t)nxt.pm * tstep : cA; const char* nB = has_next ? (const char*)g.Bt + (size_t)nxt.pn * tstep : cB;
        for (int t = 0; t < nt; t += 2) {
            const bool last = (t == nt - 2);
            const char* a1 = cA + (size_t)(t + 1) * kstep;
            const char* a2 = last ? nA : cA + (size_t)(t + 2) * kstep; const char* b2 = last ? nB : cB + (size_t)(t + 2) * kstep;
            const char* a3 = a2 + kstep; const char* b3 = b2 + kstep;
            if constexpr (Epi::MID) { if (t == nt / 2) E.mid(acc, cur, wr, wc, fr, fq); }
            if (last && has_next) S.a_ready(nxt);
            PG8_LDB(B0, 0, 0); PG8_SCHED; PG8_LDA(At, 0, 0); PG8_STAGE(PG8_SA(1, 1), a1 + hstep, voffA);
            PG8_WAIT_L(8); PG8_BAR; PG8_WAIT_L(0); PG8_MMA(0, 0, At, B0); PG8_BAR; PG8_SCHED;
            PG8_LDB(B1, 0, 1); PG8_STAGE(PG8_SB(0, 0), b2, voffB);
            PG8_BAR; PG8_WAIT_L(0); PG8_MMA(0, 1, At, B1); PG8_BAR;
            PG8_LDA(At, 0, 1); PG8_STAGE(PG8_SA(0, 0), a2, voffA);
            PG8_BAR; PG8_WAIT_L(0); PG8_MMA(1, 0, At, B0); PG8_BAR; PG8_SCHED;
            PG8_STAGE(PG8_SB(0, 1), b2 + hstep, voffB);
            PG8_WAIT_V(6); PG8_BAR; PG8_MMA(1, 1, At, B1); PG8_BAR;
            PG8_LDB(B0, 1, 0); PG8_SCHED; PG8_LDA(At, 1, 0); PG8_STAGE(PG8_SA(0, 1), a2 + hstep, voffA);
            PG8_WAIT_L(8); PG8_BAR; PG8_WAIT_L(0); PG8_MMA(0, 0, At, B0); PG8_BAR; PG8_SCHED;
            PG8_LDB(B1, 1, 1); PG8_STAGE(PG8_SB(1, 0), b3, voffB);
            PG8_BAR; PG8_WAIT_L(0); PG8_MMA(0, 1, At, B1); PG8_BAR;
            PG8_LDA(At, 1, 1); PG8_STAGE(PG8_SA(1, 0), a3, voffA);
            PG8_BAR; PG8_WAIT_L(0); PG8_MMA(1, 0, At, B0); PG8_BAR; PG8_SCHED;
            PG8_STAGE(PG8_SB(1, 1), b3 + hstep, voffB);
            PG8_WAIT_V(6); PG8_BAR; PG8_MMA(1, 1, At, B1); PG8_BAR;
        }
        PG8_STAMP();
        if constexpr (!Epi::AFTER_DRAIN) { E(acc, cur, wr, wc, fr, fq); S.done(cur); }
        PG8_STAMP();
        if (!has_next) break;
#pragma unroll
        for (int a = 0; a < 2; ++a)
#pragma unroll
            for (int b = 0; b < 2; ++b)
#pragma unroll
                for (int m = 0; m < 4; ++m)
#pragma unroll
                    for (int n = 0; n < 2; ++n) acc[a][b][m][n] = (f32x4){0.f, 0.f, 0.f, 0.f};
        cur = nxt; cA = nA; cB = nB; ++ui;
    }
    PG8_WAIT_V(0);
    if (wr == 0) PG8_BAR;
    PG8_BAR;
    if constexpr (Epi::AFTER_DRAIN) { E.fused(acc, cur, wr, wc, fr, fq, lds, wid, lane); S.done(cur); }
    PG8_STAMP();
    if (STAMP && wid == 0) { stamps[lane] = lane < nts ? (((unsigned long long)(unsigned)ts_hi << 32) | (unsigned)ts_lo) : 0ull;
        if (lane == 62) stamps[62] = rt_entry; if (lane == 63) stamps[63] = (unsigned long long)wall_clock64(); }
#undef PG8_STAMP
#undef PG8_SA
#undef PG8_SB
#undef PG8_STAGE
#undef PG8_LDA
#undef PG8_LDB
#undef PG8_MMA
#undef PG8_WAIT_V
#undef PG8_WAIT_L
#undef PG8_BAR
#undef PG8_SCHED
}
}

struct EpiProj {
  static constexpr bool PERM = true, AFTER_DRAIN = false, MID = false;
  unsigned short* pH; unsigned short* pA; unsigned short* pG; unsigned short* kc; unsigned short* vc; unsigned short* ikc;
  const float* sa; const float* sw;
  __device__ __forceinline__ void operator()(const pg8::f32x4 (&acc)[2][2][4][2], const pg8::Unit& u, int wr, int wc, int fr, int fq) const {
    const int row0 = u.pm * 256 + wr * 64 + fr;
    pg8::f32x4 cs_[2][2];
#pragma unroll
    for (int bj = 0; bj < 2; ++bj)
#pragma unroll
      for (int n = 0; n < 2; ++n) cs_[bj][n] = *(const pg8::f32x4*)(sw + u.pn * 256 + bj * 128 + wc * 32 + 8 * fq + 4 * n);
    unsigned short* base; int ldc, colt; bool sg = false;
    if (u.pn < 8) { base = pH; ldc = 2048; colt = u.pn * 256; }
    else if (u.pn < 12) { base = pA; ldc = 1024; colt = (u.pn - 8) * 256; }
    else { base = pG; ldc = 2048; colt = (u.pn - 12) * 256; sg = true; }
    const int col0 = colt + wc * 32 + 8 * fq;
#pragma unroll
    for (int ai = 0; ai < 2; ++ai)
#pragma unroll
      for (int m = 0; m < 4; ++m) {
        unsigned short* rowp = base + (size_t)(row0 + ai * 128 + m * 16) * ldc + col0;
        const float ra = sa[row0 + ai * 128 + m * 16];
#pragma unroll
        for (int bj = 0; bj < 2; ++bj) {
          pg8::f32x4 v0, v1;
#pragma unroll
          for (int j = 0; j < 4; ++j) { v0[j] = (float)__float_as_int(acc[ai][bj][m][0][j]) * (ra * cs_[bj][0][j]); v1[j] = (float)__float_as_int(acc[ai][bj][m][1][j]) * (ra * cs_[bj][1][j]); }
          if (sg) {
#pragma unroll
            for (int j = 0; j < 4; ++j) { v0[j] = sigmoidf_(v0[j]); v1[j] = sigmoidf_(v1[j]); }
          }
          pg8::u32x4 w; w.x = pg8::cvt_pk_bf16(v0[0], v0[1]); w.y = pg8::cvt_pk_bf16(v0[2], v0[3]); w.z = pg8::cvt_pk_bf16(v1[0], v1[1]); w.w = pg8::cvt_pk_bf16(v1[2], v1[3]);
          unsigned short* dst = rowp + bj * 128;
          if (u.pn == 10 || u.pn == 11) {
            const int cs = col0 + bj * 128;
            const size_t r = (size_t)(row0 + ai * 128 + m * 16);
            if (cs >= 512 && cs < 576) dst = kc + r * 64 + (cs - 512);
            else if (cs >= 576 && cs < 640) dst = vc + r * 64 + (cs - 576);
            else if (cs >= 896 && cs < 960) dst = ikc + r * 64 + (cs - 896);
          }
          *(pg8::u32x4*)dst = w;
        }
      }
  }
};
template <int MODE> struct EpiGate {
  static constexpr bool PERM = true, AFTER_DRAIN = false, MID = false;
  unsigned short* hb; const unsigned short* pG; int goff;
  __device__ __forceinline__ void operator()(const pg8::f32x4 (&acc)[2][2][4][2], const pg8::Unit& u, int wr, int wc, int fr, int fq) const {
    const int row0 = u.pm * 256 + wr * 64 + fr;
    const int col0 = u.pn * 256 + wc * 32 + 8 * fq;
#pragma unroll
    for (int ai = 0; ai < 2; ++ai)
#pragma unroll
      for (int m = 0; m < 4; ++m) {
        const size_t r = (size_t)(row0 + ai * 128 + m * 16);
        pg8::u32x4 gv[2], hv[2];
#pragma unroll
        for (int bj = 0; bj < 2; ++bj) {
          gv[bj] = *(const pg8::u32x4*)(pG + r * 2048 + goff + col0 + bj * 128);
          if (MODE == 1) hv[bj] = *(const pg8::u32x4*)(hb + r * 1024 + col0 + bj * 128);
        }
#pragma unroll
        for (int bj = 0; bj < 2; ++bj) {
          float o[8];
#pragma unroll
          for (int j = 0; j < 4; ++j) {
            const unsigned gw0 = gv[bj][j >> 1], gw1 = gv[bj][2 + (j >> 1)];
            const float g0 = (j & 1) ? __uint_as_float(gw0 & 0xffff0000u) : __uint_as_float(gw0 << 16);
            const float g1 = (j & 1) ? __uint_as_float(gw1 & 0xffff0000u) : __uint_as_float(gw1 << 16);
            o[j] = acc[ai][bj][m][0][j] * g0; o[4 + j] = acc[ai][bj][m][1][j] * g1;
            if (MODE == 1) {
              const unsigned hw0 = hv[bj][j >> 1], hw1 = hv[bj][2 + (j >> 1)];
              o[j] += (j & 1) ? __uint_as_float(hw0 & 0xffff0000u) : __uint_as_float(hw0 << 16);
              o[4 + j] += (j & 1) ? __uint_as_float(hw1 & 0xffff0000u) : __uint_as_float(hw1 << 16);
            }
          }
          pg8::u32x4 w; w.x = pg8::cvt_pk_bf16(o[0], o[1]); w.y = pg8::cvt_pk_bf16(o[2], o[3]); w.z = pg8::cvt_pk_bf16(o[4], o[5]); w.w = pg8::cvt_pk_bf16(o[6], o[7]);
          *(pg8::u32x4*)(hb + r * 1024 + col0 + bj * 128) = w;
        }
      }
  }
};
struct EpiGate2 {
  static constexpr bool PERM = true, AFTER_DRAIN = false, MID = true;
  unsigned short* hb; const unsigned short* pG;
  __device__ __forceinline__ void mid(pg8::f32x4 (&acc)[2][2][4][2], const pg8::Unit& u, int wr, int wc, int fr, int fq) const {
    int fr_o = fr, fq_o = fq;
    asm volatile("" : "+v"(fr_o), "+v"(fq_o));
    const unsigned short* gp = pG + (size_t)(u.pm * 256 + wr * 64 + fr_o) * 2048 + u.pn * 256 + wc * 32 + 8 * fq_o;
#pragma unroll
    for (int ai = 0; ai < 2; ++ai)
#pragma unroll
      for (int m = 0; m < 4; ++m)
#pragma unroll
        for (int bj = 0; bj < 2; ++bj) {
          const unsigned short* q = gp + (size_t)(ai * 128 + m * 16) * 2048 + bj * 128;
          const pg8::u32x4 gb = *(const pg8::u32x4*)(q + 1024);
          const pg8::u32x4 ga = *(const pg8::u32x4*)q;
#pragma unroll
          for (int wd = 0; wd < 4; ++wd) {
            const float rl = __uint_as_float(ga[wd] << 16) * __builtin_amdgcn_rcpf(__uint_as_float(gb[wd] << 16));
            const float rh = __uint_as_float(ga[wd] & 0xffff0000u) * __builtin_amdgcn_rcpf(__uint_as_float(gb[wd] & 0xffff0000u));
            acc[ai][bj][m][wd >> 1][2 * (wd & 1)] *= rl;
            acc[ai][bj][m][wd >> 1][2 * (wd & 1) + 1] *= rh;
          }
          if (bj == 1) asm volatile("" ::: "memory");
        }
  }
  __device__ __forceinline__ void operator()(const pg8::f32x4 (&acc)[2][2][4][2], const pg8::Unit& u, int wr, int wc, int fr, int fq) const {
    const int row0 = u.pm * 256 + wr * 64 + fr;
    const int col0 = u.pn * 256 + wc * 32 + 8 * fq;
#pragma unroll
    for (int ai = 0; ai < 2; ++ai)
#pragma unroll
      for (int m = 0; m < 4; ++m) {
        const size_t r = (size_t)(row0 + ai * 128 + m * 16);
        pg8::u32x4 gb[2];
#pragma unroll
        for (int bj = 0; bj < 2; ++bj) gb[bj] = *(const pg8::u32x4*)(pG + r * 2048 + 1024 + col0 + bj * 128);
#pragma unroll
        for (int bj = 0; bj < 2; ++bj) {
          float o[8];
#pragma unroll
          for (int j = 0; j < 4; ++j) {
            const unsigned b0 = gb[bj][j >> 1], b1 = gb[bj][2 + (j >> 1)];
            const float sb0 = (j & 1) ? __uint_as_float(b0 & 0xffff0000u) : __uint_as_float(b0 << 16);
            const float sb1 = (j & 1) ? __uint_as_float(b1 & 0xffff0000u) : __uint_as_float(b1 << 16);
            o[j] = acc[ai][bj][m][0][j] * sb0; o[4 + j] = acc[ai][bj][m][1][j] * sb1;
          }
          pg8::u32x4 w; w.x = pg8::cvt_pk_bf16(o[0], o[1]); w.y = pg8::cvt_pk_bf16(o[2], o[3]); w.z = pg8::cvt_pk_bf16(o[4], o[5]); w.w = pg8::cvt_pk_bf16(o[6], o[7]);
          *(pg8::u32x4*)(hb + r * 1024 + col0 + bj * 128) = w;
        }
      }
  }
};
struct EpiResid {
  static constexpr bool PERM = false, AFTER_DRAIN = false, MID = false;
  float* out; const float* x;
  __device__ __forceinline__ void operator()(const pg8::f32x4 (&acc)[2][2][4][2], const pg8::Unit& u, int wr, int wc, int fr, int fq) const {
    const int row0 = u.pm * 256 + wr * 64 + fr, col0 = u.pn * 256 + wc * 32 + 4 * fq;
#pragma unroll
    for (int ai = 0; ai < 2; ++ai)
#pragma unroll
      for (int m = 0; m < 4; ++m) {
        const size_t off = (size_t)(row0 + ai * 128 + m * 16) * 1024 + col0;
        pg8::f32x4 xv[2][2];
#pragma unroll
        for (int bj = 0; bj < 2; ++bj)
#pragma unroll
          for (int n = 0; n < 2; ++n) xv[bj][n] = *(const pg8::f32x4*)(x + off + bj * 128 + n * 16);
#pragma unroll
        for (int bj = 0; bj < 2; ++bj)
#pragma unroll
          for (int n = 0; n < 2; ++n) *(pg8::f32x4*)(out + off + bj * 128 + n * 16) = acc[ai][bj][m][n] + xv[bj][n];
      }
  }
};
struct EpiStoreBf16Q {
  static constexpr bool PERM = true, AFTER_DRAIN = false, MID = false;
  unsigned short* O; int ldc; const float* sa; const float* sw;
  __device__ __forceinline__ void operator()(const pg8::f32x4 (&acc)[2][2][4][2], const pg8::Unit& u, int wr, int wc, int fr, int fq) const {
    const int row0 = u.pm * 256 + wr * 64 + fr, col0 = u.pn * 256 + wc * 32 + 8 * fq;
    pg8::f32x4 cs_[2][2];
#pragma unroll
    for (int bj = 0; bj < 2; ++bj)
#pragma unroll
      for (int n = 0; n < 2; ++n) cs_[bj][n] = *(const pg8::f32x4*)(sw + col0 + bj * 128 + 4 * n);
#pragma unroll
    for (int ai = 0; ai < 2; ++ai)
#pragma unroll
      for (int m = 0; m < 4; ++m) {
        unsigned short* rowp = O + (size_t)(row0 + ai * 128 + m * 16) * ldc + col0;
        const float ra = sa[row0 + ai * 128 + m * 16];
#pragma unroll
        for (int bj = 0; bj < 2; ++bj) {
          pg8::f32x4 v0, v1;
#pragma unroll
          for (int j = 0; j < 4; ++j) { v0[j] = (float)__float_as_int(acc[ai][bj][m][0][j]) * (ra * cs_[bj][0][j]); v1[j] = (float)__float_as_int(acc[ai][bj][m][1][j]) * (ra * cs_[bj][1][j]); }
          pg8::u32x4 w; w.x = pg8::cvt_pk_bf16(v0[0], v0[1]); w.y = pg8::cvt_pk_bf16(v0[2], v0[3]); w.z = pg8::cvt_pk_bf16(v1[0], v1[1]); w.w = pg8::cvt_pk_bf16(v1[2], v1[3]);
          *(pg8::u32x4*)(rowp + bj * 128) = w;
        }
      }
  }
};
struct EpiStoreBf16 {
  static constexpr bool PERM = true, AFTER_DRAIN = false, MID = false;
  unsigned short* O; int ldc;
  __device__ __forceinline__ void operator()(const pg8::f32x4 (&acc)[2][2][4][2], const pg8::Unit& u, int wr, int wc, int fr, int fq) const {
    const int row0 = u.pm * 256 + wr * 64 + fr, col0 = u.pn * 256 + wc * 32 + 8 * fq;
#pragma unroll
    for (int ai = 0; ai < 2; ++ai)
#pragma unroll
      for (int m = 0; m < 4; ++m) {
        unsigned short* rowp = O + (size_t)(row0 + ai * 128 + m * 16) * ldc + col0;
#pragma unroll
        for (int bj = 0; bj < 2; ++bj) {
          const pg8::f32x4 v0 = acc[ai][bj][m][0], v1 = acc[ai][bj][m][1];
          pg8::u32x4 w; w.x = pg8::cvt_pk_bf16(v0[0], v0[1]); w.y = pg8::cvt_pk_bf16(v0[2], v0[3]); w.z = pg8::cvt_pk_bf16(v1[0], v1[1]); w.w = pg8::cvt_pk_bf16(v1[2], v1[3]);
          *(pg8::u32x4*)(rowp + bj * 128) = w;
        }
      }
  }
};

__device__ __forceinline__ void gemm_tile(const bf16_t* __restrict__ A, int lda, const bf16_t* __restrict__ Bt, int ldb,
                                          int nk, f32x4 (&acc)[4][4], unsigned char* smem) {
  const int tid = threadIdx.x, lane = tid & 63, w = tid >> 6, wm = w >> 1, wn = w & 1, l15 = lane & 15, g = lane >> 4;
  unsigned char* sA = smem;
  unsigned char* sB = smem + 32768;
  const int lr = tid >> 3, lc = tid & 7;
  const bf16_t* ga = A + (size_t)lr * lda + lc * 8;
  const bf16_t* gb = Bt + (size_t)lr * ldb + lc * 8;
  uint4 ra0, ra1, ra2, ra3, rb0, rb1;
  ra0 = *(const uint4*)(ga);
  ra1 = *(const uint4*)(ga + (size_t)64 * lda);
  ra2 = *(const uint4*)(ga + (size_t)128 * lda);
  ra3 = *(const uint4*)(ga + (size_t)192 * lda);
  rb0 = *(const uint4*)(gb);
  rb1 = *(const uint4*)(gb + (size_t)64 * ldb);
  const int sw = (lc ^ (lr & 7)) << 4;
  for (int kt = 0; kt < nk; ++kt) {
    __syncthreads();
    *(uint4*)(sA + (lr) * 128 + sw) = ra0;
    *(uint4*)(sA + (lr + 64) * 128 + sw) = ra1;
    *(uint4*)(sA + (lr + 128) * 128 + sw) = ra2;
    *(uint4*)(sA + (lr + 192) * 128 + sw) = ra3;
    *(uint4*)(sB + (lr) * 128 + sw) = rb0;
    *(uint4*)(sB + (lr + 64) * 128 + sw) = rb1;
    __syncthreads();
    if (kt + 1 < nk) {
      const int ko = (kt + 1) * 64;
      ra0 = *(const uint4*)(ga + ko);
      ra1 = *(const uint4*)(ga + (size_t)64 * lda + ko);
      ra2 = *(const uint4*)(ga + (size_t)128 * lda + ko);
      ra3 = *(const uint4*)(ga + (size_t)192 * lda + ko);
      rb0 = *(const uint4*)(gb + ko);
      rb1 = *(const uint4*)(gb + (size_t)64 * ldb + ko);
    }
#pragma unroll
    for (int ks = 0; ks < 2; ++ks) {
      bf16x8 a[4], b[4];
#pragma unroll
      for (int m = 0; m < 4; ++m) { const int r = wm * 64 + m * 16 + l15; a[m] = *(const bf16x8*)(sA + r * 128 + (((ks * 4 + g) ^ (r & 7)) << 4)); }
#pragma unroll
      for (int n = 0; n < 4; ++n) { const int r = wn * 64 + n * 16 + l15; b[n] = *(const bf16x8*)(sB + r * 128 + (((ks * 4 + g) ^ (r & 7)) << 4)); }
#pragma unroll
      for (int m = 0; m < 4; ++m)
#pragma unroll
        for (int n = 0; n < 4; ++n) acc[m][n] = __builtin_amdgcn_mfma_f32_16x16x32_bf16(a[m], b[n], acc[m][n], 0, 0, 0);
    }
  }
}

__device__ __forceinline__ void zero_acc(f32x4 (&acc)[4][4]) {
#pragma unroll
  for (int m = 0; m < 4; ++m)
#pragma unroll
    for (int n = 0; n < 4; ++n) acc[m][n] = (f32x4){0.f, 0.f, 0.f, 0.f};
}

__device__ __forceinline__ void transpose_tile(const float* __restrict__ src, int srcN, bf16_t* __restrict__ dst, int K, int n0, int k0,
                                               bool winmap, float* tile) {
  const int tid = threadIdx.x;
  const int nc = tid & 63, kr = tid >> 6;
  int ncol = n0 + nc; bool valid = true;
  if (winmap) { if (ncol >= 3072) ncol -= 60; else if (ncol >= 3012) valid = false; }
#pragma unroll
  for (int i = 0; i < 8; ++i) {
    const int k = kr + 8 * i;
    tile[k * 65 + nc] = valid ? src[(size_t)(k0 + k) * srcN + ncol] : 0.f;
  }
  __syncthreads();
#pragma unroll
  for (int i = 0; i < 8; ++i) {
    const int nr = kr + 8 * i;
    dst[(size_t)(n0 + nr) * K + k0 + nc] = f2bf(tile[nc * 65 + nr]);
  }
  __syncthreads();
}

__device__ __forceinline__ void quant_cols32(const float* __restrict__ src, int srcN, unsigned char* __restrict__ dst, float* __restrict__ scale,
                                             int n0, bool winmap, float* tile) {
  const int tid = threadIdx.x, nc = tid & 31, kr = tid >> 5;
  float* red = tile + 1024 * 33;
  int ncol = n0 + nc; bool valid = true;
  if (winmap) { if (ncol >= 3072) ncol -= 60; else if (ncol >= 3012) valid = false; }
  if (!valid) ncol = 0;
  float am = 0.f;
#pragma unroll 8
  for (int i = 0; i < 64; ++i) {
    const int k = kr + 16 * i;
    float v = src[(size_t)k * srcN + ncol];
    v = valid ? v : 0.f;
    tile[k * 33 + nc] = v; am = fmaxf(am, fabsf(v));
  }
  red[kr * 32 + nc] = am;
  __syncthreads();
  if (tid < 32) {
    float m = 0.f;
#pragma unroll
    for (int i = 0; i < 16; ++i) m = fmaxf(m, red[i * 32 + tid]);
    red[512 + tid] = m; scale[n0 + tid] = m * (1.f / 127.f);
  }
  __syncthreads();
  const float cm = red[512 + nc];
  const float inv = cm > 0.f ? 127.f / cm : 0.f;
#pragma unroll
  for (int i = 0; i < 4; ++i) {
    const int k0 = (kr + 16 * i) * 16;
    unsigned pk[4];
#pragma unroll
    for (int q = 0; q < 4; ++q) {
      const unsigned b0 = (unsigned)(int)rintf(tile[(k0 + 4 * q) * 33 + nc] * inv) & 255u, b1 = (unsigned)(int)rintf(tile[(k0 + 4 * q + 1) * 33 + nc] * inv) & 255u;
      const unsigned b2 = (unsigned)(int)rintf(tile[(k0 + 4 * q + 2) * 33 + nc] * inv) & 255u, b3 = (unsigned)(int)rintf(tile[(k0 + 4 * q + 3) * 33 + nc] * inv) & 255u;
      pk[q] = b0 | (b1 << 8) | (b2 << 16) | (b3 << 24);
    }
    *(uint4*)(dst + (size_t)(n0 + nc) * 1024 + k0) = make_uint4(pk[0], pk[1], pk[2], pk[3]);
  }
  __syncthreads();
}

__device__ __forceinline__ void convert_f32_bf16(const float* __restrict__ src, bf16_t* __restrict__ dst, size_t n4) {
  for (size_t i = (size_t)blockIdx.x * NTHREADS + threadIdx.x; i < n4; i += (size_t)gridDim.x * NTHREADS) {
    const float4 v = ((const float4*)src)[i];
    uint2 o; o.x = pack2(v.x, v.y); o.y = pack2(v.z, v.w);
    ((uint2*)dst)[i] = o;
  }
}

template <bool SLICE_MAJOR, bool SIGNED>
__device__ __forceinline__ void quantize_rows_u8(const float* __restrict__ src, unsigned char* __restrict__ dst, float* __restrict__ scale, int row_lo, int row_hi) {
  const int lane = threadIdx.x & 63, w = threadIdx.x >> 6;
  for (int row = row_lo + w; row < row_hi; row += 8) {
    const float4* s4 = (const float4*)(src + (size_t)row * 1024) + lane * 4;
    float4 v[4];
    float am = 0.f;
#pragma unroll
    for (int i = 0; i < 4; ++i) { v[i] = s4[i]; am = fmaxf(am, fmaxf(fmaxf(fabsf(v[i].x), fabsf(v[i].y)), fmaxf(fabsf(v[i].z), fabsf(v[i].w)))); }
#pragma unroll
    for (int o = 32; o > 0; o >>= 1) am = fmaxf(am, __shfl_xor(am, o));
    const float inv = am > 0.f ? 127.f / am : 0.f;
    unsigned pk[4];
#pragma unroll
    for (int i = 0; i < 4; ++i) {
      const int ofs = SIGNED ? 0 : 128;
      const unsigned b0 = (unsigned)((int)rintf(v[i].x * inv) + ofs), b1 = (unsigned)((int)rintf(v[i].y * inv) + ofs);
      const unsigned b2 = (unsigned)((int)rintf(v[i].z * inv) + ofs), b3 = (unsigned)((int)rintf(v[i].w * inv) + ofs);
      pk[i] = (b0 & 255u) | ((b1 & 255u) << 8) | ((b2 & 255u) << 16) | ((b3 & 255u) << 24);
    }
    if (SLICE_MAJOR) *(uint4*)(dst + (size_t)(lane >> 3) * (16384 * 128) + (size_t)row * 128 + (lane & 7) * 16) = make_uint4(pk[0], pk[1], pk[2], pk[3]);
    else *(uint4*)(dst + (size_t)row * 1024 + lane * 16) = make_uint4(pk[0], pk[1], pk[2], pk[3]);
    if (lane == 0) scale[row] = am * (1.f / 127.f);
  }
}

#define WS_WINS (WS_WIN + (size_t)5120 * 1024)
#define WS_WQS (WS_WQ + (size_t)2048 * 1024)
#define WS_XNS (WS_XN + (size_t)TOK * 1024)
#define WS_XQ (WS_PH + (size_t)TOK * 1024 * 2)
#define WS_XS (WS_XQ + (size_t)TOK * 1024)
template <bool WBF>
__device__ __forceinline__ void rmsnorm_rows_q(const float* __restrict__ src, const float* __restrict__ g, bf16_t* __restrict__ dst,
                                               unsigned char* __restrict__ xq, float* __restrict__ xs) {
  const int lane = threadIdx.x & 63, w = threadIdx.x >> 6;
  for (int row = blockIdx.x * 8 + w; row < TOK; row += gridDim.x * 8) {
    const float4* s4 = (const float4*)(src + (size_t)row * DM) + lane * 4;
    const float4* g4 = (const float4*)g + lane * 4;
    float v[16]; float ss = 0.f;
#pragma unroll
    for (int i = 0; i < 4; ++i) { const float4 t = s4[i]; v[4 * i] = t.x; v[4 * i + 1] = t.y; v[4 * i + 2] = t.z; v[4 * i + 3] = t.w; ss += t.x * t.x + t.y * t.y + t.z * t.z + t.w * t.w; }
    ss = wave_sum(ss);
    const float rstd = rsqrtf(ss * (1.f / DM) + EPSV);
    float am = 0.f;
#pragma unroll
    for (int i = 0; i < 4; ++i) { const float4 gg = g4[i]; v[4 * i] *= rstd * gg.x; v[4 * i + 1] *= rstd * gg.y; v[4 * i + 2] *= rstd * gg.z; v[4 * i + 3] *= rstd * gg.w; }
#pragma unroll
    for (int i = 0; i < 16; ++i) am = fmaxf(am, fabsf(v[i]));
#pragma unroll
    for (int o = 32; o > 0; o >>= 1) am = fmaxf(am, __shfl_xor(am, o));
    const float inv = am > 0.f ? 127.f / am : 0.f;
    if (WBF) {
      uint4 ob0, ob1;
      ob0.x = pack2(v[0], v[1]); ob0.y = pack2(v[2], v[3]); ob0.z = pack2(v[4], v[5]); ob0.w = pack2(v[6], v[7]);
      ob1.x = pack2(v[8], v[9]); ob1.y = pack2(v[10], v[11]); ob1.z = pack2(v[12], v[13]); ob1.w = pack2(v[14], v[15]);
      *(uint4*)(dst + (size_t)row * DM + lane * 16) = ob0;
      *(uint4*)(dst + (size_t)row * DM + lane * 16 + 8) = ob1;
    }
    unsigned pk[4];
#pragma unroll
    for (int i = 0; i < 4; ++i) {
      const unsigned b0 = (unsigned)(int)rintf(v[4 * i] * inv) & 255u, b1 = (unsigned)(int)rintf(v[4 * i + 1] * inv) & 255u;
      const unsigned b2 = (unsigned)(int)rintf(v[4 * i + 2] * inv) & 255u, b3 = (unsigned)(int)rintf(v[4 * i + 3] * inv) & 255u;
      pk[i] = b0 | (b1 << 8) | (b2 << 16) | (b3 << 24);
    }
    *(uint4*)(xq + (size_t)row * 1024 + lane * 16) = make_uint4(pk[0], pk[1], pk[2], pk[3]);
    if (lane == 0) xs[row] = am * (1.f / 127.f);
  }
}

__device__ __forceinline__ void rmsnorm_rows(const float* __restrict__ src, const float* __restrict__ g, bf16_t* __restrict__ dst) {
  const int lane = threadIdx.x & 63, w = threadIdx.x >> 6;
  for (int row = blockIdx.x * 8 + w; row < TOK; row += gridDim.x * 8) {
    const float4* s4 = (const float4*)(src + (size_t)row * DM);
    float4 v[4]; float ss = 0.f;
#pragma unroll
    for (int i = 0; i < 4; ++i) { v[i] = s4[lane + 64 * i]; ss += v[i].x * v[i].x + v[i].y * v[i].y + v[i].z * v[i].z + v[i].w * v[i].w; }
    ss = wave_sum(ss);
    const float rstd = rsqrtf(ss * (1.f / DM) + EPSV);
#pragma unroll
    for (int i = 0; i < 4; ++i) {
      const float4 gg = ((const float4*)g)[lane + 64 * i];
      uint2 o; o.x = pack2(v[i].x * rstd * gg.x, v[i].y * rstd * gg.y); o.y = pack2(v[i].z * rstd * gg.z, v[i].w * rstd * gg.w);
      ((uint2*)(dst + (size_t)row * DM))[lane + 64 * i] = o;
    }
  }
}

__device__ __forceinline__ void phase_prep(const Params& p, unsigned char* smem) {
  unsigned char* ws = p.ws;
  float* tile = (float*)smem;
  const int n_win = 160, n_ua = 16 * 8, n_ub = 16 * 8, n_wo = 16 * 16, n_wq = 64;
  const int total = n_win + n_wq + n_ua + n_ub + n_wo;
  for (int it = blockIdx.x; it < total; it += gridDim.x) {
    int t = it;
    if (t < n_win) { quant_cols32(p.w_in, 5060, ws + WS_WIN, (float*)(ws + WS_WINS), t * 32, true, tile); continue; }
    t -= n_win;
    if (t < n_wq) { quant_cols32(p.peer_wq, 2048, ws + WS_WQ, (float*)(ws + WS_WQS), t * 32, false, tile); continue; }
    t -= n_wq;
    if (t < n_ua) { transpose_tile(p.w_up_a, 1024, (bf16_t*)(ws + WS_WUPA), 1024, (t >> 3) * 64, (t & 7) * 64, false, tile); continue; }
    t -= n_ua;
    if (t < n_ub) { transpose_tile(p.w_up_b, 1024, (bf16_t*)(ws + WS_WUPA) + 512, 1024, (t >> 3) * 64, (t & 7) * 64, false, tile); continue; }
    t -= n_ub;
    transpose_tile(p.w_out, 1024, (bf16_t*)(ws + WS_WOUT), 1024, (t >> 4) * 64, (t & 15) * 64, false, tile);
  }
  convert_f32_bf16(p.peer_keys, (bf16_t*)(ws + WS_KEYS), (size_t)2 * 8 * 128 * 128 / 4);
  for (int i = blockIdx.x * NTHREADS + threadIdx.x; i < TOK; i += gridDim.x * NTHREADS) ((float*)(ws + WS_SSQ))[i] = 0.f;
  if (threadIdx.x == 0) ((int*)(ws + WS_XCC))[blockIdx.x] = (int)(__builtin_amdgcn_s_getreg((3 << 11) | 20) & 0xFu);
  if (blockIdx.x == 0 && threadIdx.x < 8) ((unsigned*)(ws + WS_QCTR))[16 * threadIdx.x] = 0u;
  if (blockIdx.x == 0) {
    const int i = threadIdx.x;
    const float a0 = p.hg_lb[i], a1 = p.hg_lb[512 + i];
    ((float*)(ws + WS_LB))[i] = 1.f / (1.f + expf(a1 - a0));
  }
  rmsnorm_rows_q<false>(p.x, p.norm_mix, nullptr, ws + WS_XN, (float*)(ws + WS_XNS));
}

__device__ __forceinline__ void hgrn_h1_all(const Params& p, unsigned char* smem) {
  unsigned char* ws = p.ws;
  bf16_t* pH = (bf16_t*)(ws + WS_PH);
  const float* lbp = (const float*)(ws + WS_LB);
  bf16_t* Qt = (bf16_t*)smem;
  bf16_t* Kt = Qt + 64 * 136;
  bf16_t* KtT = Kt + 64 * 136;
  bf16_t* VT = KtT + 128 * 72;
  bf16_t* Am = VT + 128 * 72;
  float* qtot = (float*)(Am + 64 * 72);
  const int tid = threadIdx.x, lane = tid & 63, w = tid >> 6, l15 = lane & 15, g = lane >> 4;
  const int d = tid & 127, tq = tid >> 7;
  const int G = gridDim.x;
  if ((int)blockIdx.x >= 2048) return;
  bf16_t fr_[16], qr_[16]; unsigned short vr_[16];
#define H1_LOAD(IT) do { \
    const int bh_ = (IT) >> 6, ch_ = (IT) & 63; \
    const bf16_t* base_ = pH + ((size_t)(bh_ >> 2) * SEQL + ch_ * 64 + tq * 16) * 2048 + (bh_ & 3) * 128 + d; \
    _Pragma("unroll") for (int i = 0; i < 16; ++i) { fr_[i] = base_[(size_t)i * 2048 + 512]; qr_[i] = base_[(size_t)i * 2048]; vr_[i] = base_[(size_t)i * 2048 + 1024]; } \
  } while (0)
  H1_LOAD((int)blockIdx.x);
  for (int item = blockIdx.x; item < 2048; item += G) {
    const int bh = item >> 6, chunk = item & 63;
    const int b = bh >> 2, h = bh & 3;
    const float lbv = lbp[h * 128 + d];
    const size_t row0 = (size_t)b * SEQL + chunk * 64;
    float* dec = (float*)(ws + WS_DEC) + (size_t)item * 384;
    uint4* UU = (uint4*)p.out + (size_t)item * 2048 + tid;
    float4* OI = (float4*)((unsigned char*)p.out + ((size_t)64 << 20)) + (size_t)item * 2048 + tid;
    {
      unsigned vv[8];
#pragma unroll
      for (int i = 0; i < 8; ++i) vv[i] = (unsigned)vr_[2 * i] | ((unsigned)vr_[2 * i + 1] << 16);
      float lf[16], kk[16], qs[16];
      float run = 0.f;
#pragma unroll
      for (int i = 0; i < 16; ++i) {
        const float sg = sigmoidf_(bf2f(fr_[i]));
        const float fg = lbv + (1.f - lbv) * sg;
        run += __logf(fg);
        lf[i] = run; kk[i] = 1.f - fg; qs[i] = siluf_(bf2f(qr_[i]));
      }
      qtot[tq * 128 + d] = run;
      __syncthreads();
      { const int nit = (item + G < 2048) ? item + G : item; H1_LOAD(nit); }
      const float q0 = qtot[d], q1 = qtot[128 + d], q2 = qtot[256 + d], q3 = qtot[384 + d];
      const float pre = (tq > 0 ? q0 : 0.f) + (tq > 1 ? q1 : 0.f) + (tq > 2 ? q2 : 0.f);
      const float bref = q0 + q1;
      const float blast = bref + q2 + q3;
      unsigned kp[8];
#pragma unroll
      for (int i = 0; i < 16; ++i) {
        const float bt = pre + lf[i];
        const float qt = qs[i] * __expf(bt - bref);
        const float kt = kk[i] * __expf(bref - bt);
        const int t = tq * 16 + i;
        Qt[t * 136 + d] = f2bf(qt);
        const bf16_t kb = f2bf(kt);
        Kt[t * 136 + d] = kb;
        if (i & 1) kp[i >> 1] |= ((unsigned)kb) << 16; else kp[i >> 1] = kb;
      }
      *(uint4*)(KtT + d * 72 + tq * 16) = make_uint4(kp[0], kp[1], kp[2], kp[3]);
      *(uint4*)(KtT + d * 72 + tq * 16 + 8) = make_uint4(kp[4], kp[5], kp[6], kp[7]);
      *(uint4*)(VT + d * 72 + tq * 16) = make_uint4(vv[0], vv[1], vv[2], vv[3]);
      *(uint4*)(VT + d * 72 + tq * 16 + 8) = make_uint4(vv[4], vv[5], vv[6], vv[7]);
      if (tq == 0) { dec[d] = __expf(bref); dec[128 + d] = __expf(blast); dec[256 + d] = __expf(blast - bref); }
    }
    __syncthreads();
    {
  #pragma unroll
      for (int i = 0; i < 2; ++i) {
        const int idx = tid + 512 * i, r = idx >> 4, c = idx & 15;
        *(uint4*)(pH + (row0 + r) * 2048 + h * 128 + c * 8) = *(const uint4*)(Qt + r * 136 + c * 8);
      }
  #pragma unroll
      for (int tt = 0; tt < 2; ++tt) {
        const int tl = 2 * w + tt, sm = tl >> 2, tn = tl & 3;
        f32x4 acc = (f32x4){0.f, 0.f, 0.f, 0.f};
        if (tn >= sm) {
  #pragma unroll
          for (int k0 = 0; k0 < 128; k0 += 32) {
            const bf16x8 a = *(const bf16x8*)(Kt + (sm * 16 + l15) * 136 + k0 + 8 * g);
            const bf16x8 bq = *(const bf16x8*)(Qt + (tn * 16 + l15) * 136 + k0 + 8 * g);
            acc = __builtin_amdgcn_mfma_f32_16x16x32_bf16(a, bq, acc, 0, 0, 0);
          }
        }
        const int t = tn * 16 + l15, s0 = sm * 16 + 4 * g;
        uint2 o;
        o.x = pack2(s0 + 0 <= t ? acc[0] : 0.f, s0 + 1 <= t ? acc[1] : 0.f);
        o.y = pack2(s0 + 2 <= t ? acc[2] : 0.f, s0 + 3 <= t ? acc[3] : 0.f);
        *(uint2*)(Am + t * 72 + s0) = o;
      }
    }
    __syncthreads();
    {
  #pragma unroll
      for (int tm = 0; tm < 4; ++tm) {
        f32x4 acc = (f32x4){0.f, 0.f, 0.f, 0.f};
  #pragma unroll
        for (int k0 = 0; k0 < 64; k0 += 32) {
          const bf16x8 a = *(const bf16x8*)(Am + (tm * 16 + l15) * 72 + k0 + 8 * g);
          const bf16x8 bb = *(const bf16x8*)(VT + (16 * w + l15) * 72 + k0 + 8 * g);
          acc = __builtin_amdgcn_mfma_f32_16x16x32_bf16(a, bb, acc, 0, 0, 0);
        }
        OI[tm * 512] = make_float4(acc[0], acc[1], acc[2], acc[3]);
      }
  #pragma unroll
      for (int dp = 0; dp < 4; ++dp) {
        unsigned pk[4];
  #pragma unroll
        for (int hh = 0; hh < 2; ++hh) {
          const int dm = dp * 2 + hh;
          f32x4 acc = (f32x4){0.f, 0.f, 0.f, 0.f};
  #pragma unroll
          for (int k0 = 0; k0 < 64; k0 += 32) {
            const bf16x8 a = *(const bf16x8*)(KtT + (dm * 16 + l15) * 72 + k0 + 8 * g);
            const bf16x8 bb = *(const bf16x8*)(VT + (16 * w + l15) * 72 + k0 + 8 * g);
            acc = __builtin_amdgcn_mfma_f32_16x16x32_bf16(a, bb, acc, 0, 0, 0);
          }
          pk[hh * 2] = pack2(acc[0], acc[1]); pk[hh * 2 + 1] = pack2(acc[2], acc[3]);
        }
        UU[dp * 512] = make_uint4(pk[0], pk[1], pk[2], pk[3]);
      }
    }
    __syncthreads();
  }
#undef H1_LOAD
}

__device__ __forceinline__ void hgrn_h2(const Params& p, unsigned char* smem, int bh) {
  unsigned char* ws = p.ws;
  const bf16_t* pH = (const bf16_t*)(ws + WS_PH);
  bf16_t* ya = (bf16_t*)(ws + WS_XN);
  bf16_t* Qt = (bf16_t*)smem;
  bf16_t* ST = Qt + 64 * 136;
  float* decl = (float*)(ST + 128 * 136);
  float* red = decl + 384;
  const int tid = threadIdx.x, lane = tid & 63, w = tid >> 6, l15 = lane & 15, g = lane >> 4;
  const int b = bh >> 2, h = bh & 3;
  f32x4 S[8];
#pragma unroll
  for (int i = 0; i < 8; ++i) S[i] = (f32x4){0.f, 0.f, 0.f, 0.f};
  const float gnv = p.hg_norm[h * 128 + 16 * w + l15];
  const int e = 16 * w + l15;
  uint4 uu0, uu1, uu2, uu3; float4 oi0, oi1, oi2, oi3; uint4 qraw0, qraw1; bf16_t ogr[16]; float dcv = 0.f;
#define H2_LOAD(CH) do { \
    const int item_ = bh * 64 + (CH); \
    const size_t row0_ = (size_t)b * SEQL + (size_t)(CH) * 64; \
    const uint4* UUp = (const uint4*)p.out + (size_t)item_ * 2048 + tid; \
    const float4* OIp = (const float4*)((const unsigned char*)p.out + ((size_t)64 << 20)) + (size_t)item_ * 2048 + tid; \
    uu0 = UUp[0]; uu1 = UUp[512]; uu2 = UUp[1024]; uu3 = UUp[1536]; oi0 = OIp[0]; oi1 = OIp[512]; oi2 = OIp[1024]; oi3 = OIp[1536]; \
    qraw0 = *(const uint4*)(pH + (row0_ + (tid >> 4)) * 2048 + h * 128 + (tid & 15) * 8); \
    qraw1 = *(const uint4*)(pH + (row0_ + 32 + (tid >> 4)) * 2048 + h * 128 + (tid & 15) * 8); \
    _Pragma("unroll") for (int tm = 0; tm < 4; ++tm) _Pragma("unroll") for (int j = 0; j < 4; ++j) \
      ogr[tm * 4 + j] = pH[(row0_ + tm * 16 + 4 * g + j) * 2048 + 1536 + h * 128 + e]; \
    if (tid < 384) dcv = ((const float*)(ws + WS_DEC))[(size_t)item_ * 384 + tid]; \
  } while (0)
  H2_LOAD(0);
  for (int chunk = 0; chunk < 64; ++chunk) {
    const size_t row0 = (size_t)b * SEQL + chunk * 64;
    const uint4 cu[4] = {uu0, uu1, uu2, uu3}; const float4 co[4] = {oi0, oi1, oi2, oi3}; bf16_t cog[16];
#pragma unroll
    for (int i = 0; i < 16; ++i) cog[i] = ogr[i];
    *(uint4*)(Qt + (tid >> 4) * 136 + (tid & 15) * 8) = qraw0;
    *(uint4*)(Qt + (32 + (tid >> 4)) * 136 + (tid & 15) * 8) = qraw1;
    if (tid < 384) decl[tid] = dcv;
    __syncthreads();
    if (chunk + 1 < 64) H2_LOAD(chunk + 1);
#pragma unroll
    for (int dm = 0; dm < 8; ++dm) {
      const int d0 = 16 * dm + 4 * g;
      uint2 o;
      o.x = pack2(S[dm][0] * decl[d0], S[dm][1] * decl[d0 + 1]);
      o.y = pack2(S[dm][2] * decl[d0 + 2], S[dm][3] * decl[d0 + 3]);
      *(uint2*)(ST + e * 136 + d0) = o;
    }
    __syncthreads();
    f32x4 o[4];
#pragma unroll
    for (int tm = 0; tm < 4; ++tm) {
      f32x4 acc = (f32x4){co[tm].x, co[tm].y, co[tm].z, co[tm].w};
#pragma unroll
      for (int k0 = 0; k0 < 128; k0 += 32) {
        const bf16x8 a = *(const bf16x8*)(Qt + (tm * 16 + l15) * 136 + k0 + 8 * g);
        const bf16x8 bb = *(const bf16x8*)(ST + (16 * w + l15) * 136 + k0 + 8 * g);
        acc = __builtin_amdgcn_mfma_f32_16x16x32_bf16(a, bb, acc, 0, 0, 0);
      }
      o[tm] = acc;
#pragma unroll
      for (int j = 0; j < 4; ++j) {
        float ss = acc[j] * acc[j];
        ss += __int_as_float(__builtin_amdgcn_update_dpp(0, __float_as_int(ss), 0xB1, 0xf, 0xf, true));
        ss += __int_as_float(__builtin_amdgcn_update_dpp(0, __float_as_int(ss), 0x4E, 0xf, 0xf, true));
        ss += __int_as_float(__builtin_amdgcn_update_dpp(0, __float_as_int(ss), 0x141, 0xf, 0xf, true));
        ss += __int_as_float(__builtin_amdgcn_update_dpp(0, __float_as_int(ss), 0x140, 0xf, 0xf, true));
        if (l15 == 0) red[w * 64 + tm * 16 + 4 * g + j] = ss;
      }
    }
#pragma unroll
    for (int dm = 0; dm < 8; ++dm) {
      const unsigned u01 = (dm & 1) ? cu[dm >> 1].z : cu[dm >> 1].x, u23 = (dm & 1) ? cu[dm >> 1].w : cu[dm >> 1].y;
      const float uv[4] = {__uint_as_float(u01 << 16), __uint_as_float(u01 & 0xffff0000u), __uint_as_float(u23 << 16), __uint_as_float(u23 & 0xffff0000u)};
#pragma unroll
      for (int j = 0; j < 4; ++j) { const int dd = 16 * dm + 4 * g + j; S[dm][j] = decl[128 + dd] * S[dm][j] + decl[256 + dd] * uv[j]; }
    }
    __syncthreads();
    if (tid < 64) {
      float tot = 0.f;
#pragma unroll
      for (int ww = 0; ww < 8; ++ww) tot += red[ww * 64 + tid];
      red[512 + tid] = rsqrtf(tot * (1.f / 128.f) + EPSV);
    }
    __syncthreads();
#pragma unroll
    for (int tm = 0; tm < 4; ++tm)
#pragma unroll
      for (int j = 0; j < 4; ++j) {
        const int t = tm * 16 + 4 * g + j;
        const float rstd = red[512 + t];
        ya[(row0 + t) * 1024 + h * 128 + e] = f2bf(o[tm][j] * rstd * gnv * siluf_(bf2f(cog[tm * 4 + j])));
      }
  }
#undef H2_LOAD
}

__device__ __forceinline__ int team_index(const Params& p, unsigned char* smem) {
  int* sh = (int*)(smem + 8192);
  const int G = gridDim.x, tid = threadIdx.x;
  const int* tab = (const int*)(p.ws + WS_XCC);
  if (tid < 32) sh[tid] = 0;
  __syncthreads();
  const int mine = tab[blockIdx.x] & 15;
  for (int b = tid; b < G; b += NTHREADS) {
    const int x = tab[b] & 15;
    atomicAdd(&sh[x], 1);
    if (x == mine && b < (int)blockIdx.x) atomicAdd(&sh[16], 1);
  }
  __syncthreads();
  if (tid == 0) {
    int pre = 0;
    for (int j = 0; j < mine; ++j) pre += sh[j];
    sh[17] = pre + sh[16];
  }
  __syncthreads();
  const int r = sh[17];
  __syncthreads();
  return r;
}

#define SCW 4100
#ifndef DSA_REP
#define DSA_REP 0
#endif
#define DSA_BKT_OFF (8 * SCW * 4 + 8 * 256 * 4 + 8 * 256 * 2 + 8 * 512 * 2)
__device__ __forceinline__ void cvt8(const uint4& v, float* f) {
  f[0] = __uint_as_float(v.x << 16); f[1] = __uint_as_float(v.x & 0xffff0000u);
  f[2] = __uint_as_float(v.y << 16); f[3] = __uint_as_float(v.y & 0xffff0000u);
  f[4] = __uint_as_float(v.z << 16); f[5] = __uint_as_float(v.z & 0xffff0000u);
  f[6] = __uint_as_float(v.w << 16); f[7] = __uint_as_float(v.w & 0xffff0000u);
}
__device__ __forceinline__ unsigned sortable_key(float v) {
  unsigned bits = __float_as_uint(v);
  if (bits == 0x80000000u) bits = 0u;
  return (bits & 0x80000000u) ? ~bits : (bits | 0x80000000u);
}

__device__ __forceinline__ void dsa_item(const Params& p, unsigned char* smem, int item) {
  unsigned char* ws = p.ws;
  const bf16_t* pA = (const bf16_t*)(ws + WS_PA);
  const bf16_t* kc = (const bf16_t*)(ws + WS_KC);
  const bf16_t* vc = (const bf16_t*)(ws + WS_VC);
  const bf16_t* ikc = (const bf16_t*)(ws + WS_IKC);
  bf16_t* yb = (bf16_t*)(ws + WS_XN) + 512;
  unsigned* sc = (unsigned*)smem;
  unsigned* hist = sc + 8 * SCW;
  unsigned short* sel = (unsigned short*)(hist + 8 * 256);
  unsigned short* cand = sel + 8 * 256;
  unsigned char* bkt = (unsigned char*)(cand + 8 * 512);
  unsigned* rmm = (unsigned*)(bkt + 128 + 1056);
  unsigned* bks = rmm + 16;
  const int tid = threadIdx.x, lane = tid & 63, w = tid >> 6, l15 = lane & 15, g = lane >> 4;
  const int b = item >> 9;
  const int tb = item & 511;
  const int t0 = tb * 8;
  const size_t tokbase = (size_t)b * SEQL;

  for (int rep_s = 0; rep_s < (DSA_REP == 1 ? 2 : 1); ++rep_s) {
    bf16x8 af[2][2];
    float wq[2][4];
#pragma unroll
    for (int mt = 0; mt < 2; ++mt) {
      const int qrow = t0 + mt * 4 + (l15 >> 2), head = l15 & 3;
#pragma unroll
      for (int ks = 0; ks < 2; ++ks)
        af[mt][ks] = *(const bf16x8*)(pA + (tokbase + qrow) * 1024 + 640 + head * 64 + ks * 32 + 8 * g);
      const uint2 wr = *(const uint2*)(pA + (tokbase + t0 + mt * 4 + g) * 1024 + 960);
      wq[mt][0] = 0.5f * bf2f((bf16_t)(wr.x & 0xffff)); wq[mt][1] = 0.5f * bf2f((bf16_t)(wr.x >> 16));
      wq[mt][2] = 0.5f * bf2f((bf16_t)(wr.y & 0xffff)); wq[mt][3] = 0.5f * bf2f((bf16_t)(wr.y >> 16));
    }
    const int nkt = (t0 + 8 + 15) >> 4;
    unsigned kmin[2] = {0xFFFFFFFFu, 0xFFFFFFFFu}, kmax[2] = {0u, 0u};
    for (int kt0 = w; kt0 < nkt; kt0 += 64) {
      bf16x8 b0[8], b1[8];
#pragma unroll
      for (int u = 0; u < 8; ++u) {
        const int kt = kt0 + 8 * u;
        const int s = (kt < nkt ? kt : 0) * 16 + l15;
        const bf16_t* kr = ikc + (tokbase + s) * 64 + 8 * g;
        b0[u] = *(const bf16x8*)kr;
        b1[u] = *(const bf16x8*)(kr + 32);
      }
      __builtin_amdgcn_sched_barrier(0);
      f32x4 sacc[8][2];
#pragma unroll
      for (int u = 0; u < 8; ++u)
#pragma unroll
        for (int mt = 0; mt < 2; ++mt) {
          f32x4 acc = (f32x4){0.f, 0.f, 0.f, 0.f};
          acc = __builtin_amdgcn_mfma_f32_16x16x32_bf16(af[mt][0], b0[u], acc, 0, 0, 0);
          sacc[u][mt] = __builtin_amdgcn_mfma_f32_16x16x32_bf16(af[mt][1], b1[u], acc, 0, 0, 0);
        }
#pragma unroll
      for (int u = 0; u < 8; ++u) {
        const int kt = kt0 + 8 * u;
        if (kt < nkt) {
          const int s = kt * 16 + l15;
#pragma unroll
          for (int mt = 0; mt < 2; ++mt) {
            float v = 0.f;
#pragma unroll
            for (int j = 0; j < 4; ++j) v += wq[mt][j] * fmaxf(sacc[u][mt][j] * 0.125f, 0.f);
            const int t = t0 + mt * 4 + g;
            unsigned vb = __float_as_uint(v); if (vb == 0x80000000u) vb = 0u;
            sc[(mt * 4 + g) * SCW + s] = vb;
            if (s <= t) {
              const unsigned key = (vb & 0x80000000u) ? ~vb : (vb | 0x80000000u);
              kmin[mt] = key < kmin[mt] ? key : kmin[mt];
              kmax[mt] = key > kmax[mt] ? key : kmax[mt];
            }
          }
        }
      }
    }
#pragma unroll
    for (int mt = 0; mt < 2; ++mt) {
      unsigned a = kmin[mt], bmx = kmax[mt];
#define DPP_MINMAX(CTRL) do { const unsigned a2 = (unsigned)__builtin_amdgcn_update_dpp((int)a, (int)a, CTRL, 0xf, 0xf, false); \
                               const unsigned b2 = (unsigned)__builtin_amdgcn_update_dpp((int)bmx, (int)bmx, CTRL, 0xf, 0xf, false); \
                               a = a2 < a ? a2 : a; bmx = b2 > bmx ? b2 : bmx; } while (0)
      DPP_MINMAX(0xB1); DPP_MINMAX(0x4E); DPP_MINMAX(0x141); DPP_MINMAX(0x140);
#undef DPP_MINMAX
      if (l15 == 0) { atomicMin(&rmm[mt * 4 + g], a); atomicMax(&rmm[8 + mt * 4 + g], bmx); }
    }
  }
  __syncthreads();
  const int t = t0 + w;
  const int n = t + 1;
  unsigned* row = sc + w * SCW;
  const float* rowf = (const float*)row;
  unsigned short* mysel = sel + w * 256;
  unsigned short* mycand = cand + w * 512;
  unsigned* myh = hist + w * 256;
  int cnt;
  const unsigned long long lt_mask = (1ull << lane) - 1ull;
  for (int rep_t = 0; rep_t < (DSA_REP == 2 ? 2 : 1); ++rep_t)
  if (n <= 256) {
    for (int i = lane; i < n; i += 64) mysel[i] = (unsigned short)i;
    cnt = n;
  } else {
    cnt = 256;
    float mn, mx;
    {
      const unsigned kmn = rmm[w], kmx = rmm[8 + w];
      mn = __uint_as_float((kmn & 0x80000000u) ? (kmn ^ 0x80000000u) : ~kmn);
      mx = __uint_as_float((kmx & 0x80000000u) ? (kmx ^ 0x80000000u) : ~kmx);
    }
    const float scale = (mx > mn) ? 255.99f / (mx - mn) : 0.f;
#pragma unroll
    for (int i = 0; i < 4; ++i) myh[lane + 64 * i] = 0u;
    lds_fence();
    for (int i0 = lane; i0 < n; i0 += 256) {
      float v4[4];
#pragma unroll
      for (int k = 0; k < 4; ++k) v4[k] = (i0 + 64 * k < n) ? rowf[i0 + 64 * k] : 0.f;
#pragma unroll
      for (int k = 0; k < 4; ++k) {
        if (i0 + 64 * k < n) {
          int bn = (int)((v4[k] - mn) * scale); bn = bn > 255 ? 255 : bn;
          atomicAdd(&myh[bn], 1u);
        }
      }
    }
    lds_fence();
    unsigned cum; int bstar; unsigned mcount;
    {
      const uint4 c4 = *(const uint4*)(myh + 4 * lane);
      const unsigned c = c4.x + c4.y + c4.z + c4.w;
      unsigned sfx = c;
#pragma unroll
      for (int o = 1; o < 64; o <<= 1) { const unsigned tt = __shfl_down(sfx, o); if (lane + o < 64) sfx += tt; }
      const unsigned long long bal = __ballot(sfx >= 256u);
      const int L = 63 - __clzll(bal);
      const unsigned sL = __shfl(sfx, L), cL = __shfl(c, L);
      const unsigned b3 = __shfl(c4.w, L), b2 = __shfl(c4.z, L), b1 = __shfl(c4.y, L), b0 = __shfl(c4.x, L);
      cum = sL - cL;
      int digit;
      if (cum + b3 >= 256u) { digit = 3; mcount = b3; }
      else { cum += b3; if (cum + b2 >= 256u) { digit = 2; mcount = b2; } else { cum += b2; if (cum + b1 >= 256u) { digit = 1; mcount = b1; } else { cum += b1; digit = 0; mcount = b0; } } }
      bstar = 4 * L + digit;
    }
    const unsigned need = 256u - cum;
    if (mcount <= 512u) {
      unsigned base = 0u, cb = 0u;
      for (int i0 = 0; i0 < n; i0 += 256) {
        float v4[4];
#pragma unroll
        for (int k = 0; k < 4; ++k) { const int i = i0 + 64 * k + lane; v4[k] = (i < n) ? rowf[i] : 0.f; }
#pragma unroll
        for (int k = 0; k < 4; ++k) {
          const int i = i0 + 64 * k + lane;
          const bool valid = i < n;
          int bn = (int)((v4[k] - mn) * scale); bn = bn > 255 ? 255 : bn;
          const bool gt = valid && (bn > bstar);
          const bool eq = valid && (bn == bstar);
          const unsigned long long bg = __ballot(gt), be = __ballot(eq);
          if (gt) mysel[base + (unsigned)__popcll(bg & lt_mask)] = (unsigned short)i;
          if (eq) mycand[cb + (unsigned)__popcll(be & lt_mask)] = (unsigned short)i;
          base += (unsigned)__popcll(bg); cb += (unsigned)__popcll(be);
        }
      }
      lds_fence();
      const int m = (int)mcount;
      unsigned ck[8]; unsigned short ci[8];
#pragma unroll
      for (int q = 0; q < 8; ++q) {
        const int c = q * 64 + lane;
        ck[q] = 0u; ci[q] = 0;
        if (c < m) { ci[q] = mycand[c]; ck[q] = sortable_key(rowf[ci[q]]); }
      }
      unsigned T = 0u;
      if (m <= 64) {
#pragma unroll 1
        for (int bit = 31; bit >= 0; --bit) {
          const unsigned trial = T | (1u << bit);
          if ((unsigned)__popcll(__ballot(ck[0] >= trial)) >= need) T = trial;
        }
      } else {
#pragma unroll 1
        for (int bit = 31; bit >= 0; --bit) {
          const unsigned trial = T | (1u << bit);
          unsigned cge = 0u;
#pragma unroll
          for (int q = 0; q < 8; ++q) cge += (unsigned)__popcll(__ballot(ck[q] >= trial));
          if (cge >= need) T = trial;
        }
      }
      unsigned cgt = 0u;
#pragma unroll
      for (int q = 0; q < 8; ++q) cgt += (unsigned)__popcll(__ballot(ck[q] > T));
      const unsigned need_eq = need - cgt;
      unsigned pos0 = cum, eqtaken = 0u;
#pragma unroll
      for (int q = 0; q < 8; ++q) {
        const bool gt = ck[q] > T;
        const bool eq = ck[q] == T;
        const unsigned long long beq = __ballot(eq);
        const bool take = gt || (eq && (eqtaken + (unsigned)__popcll(beq & lt_mask)) < need_eq);
        const unsigned long long bt = __ballot(take);
        const unsigned pp = pos0 + (unsigned)__popcll(bt & lt_mask);
        if (take && pp < 256u) mysel[pp] = ci[q];
        pos0 += (unsigned)__popcll(bt);
        eqtaken += (unsigned)__popcll(beq);
      }
    } else {
      unsigned prefix = 0u, krem = 256u;
#pragma unroll 1
      for (int pass = 0; pass < 4; ++pass) {
        const int shift = 24 - 8 * pass;
        const unsigned himask = (pass == 0) ? 0u : (0xFFFFFFFFu << (shift + 8));
#pragma unroll
        for (int i = 0; i < 4; ++i) myh[lane + 64 * i] = 0u;
        lds_fence();
        for (int i = lane; i < n; i += 64) {
          const unsigned u = sortable_key(rowf[i]);
          if ((u & himask) == prefix) atomicAdd(&myh[(u >> shift) & 255u], 1u);
        }
        lds_fence();
        const uint4 c4 = *(const uint4*)(myh + 4 * lane);
        const unsigned c = c4.x + c4.y + c4.z + c4.w;
        unsigned sfx = c;
#pragma unroll
        for (int o = 1; o < 64; o <<= 1) { const unsigned tt = __shfl_down(sfx, o); if (lane + o < 64) sfx += tt; }
        const unsigned long long bal = __ballot(sfx >= krem);
        const int L = 63 - __clzll(bal);
        const unsigned sL = __shfl(sfx, L), cL = __shfl(c, L);
        const unsigned b3 = __shfl(c4.w, L), b2 = __shfl(c4.z, L), b1 = __shfl(c4.y, L);
        unsigned cum2 = sL - cL;
        unsigned digit;
        if (cum2 + b3 >= krem) digit = 3;
        else { cum2 += b3; if (cum2 + b2 >= krem) digit = 2; else { cum2 += b2; if (cum2 + b1 >= krem) digit = 1; else { cum2 += b1; digit = 0; } } }
        krem -= cum2;
        prefix |= ((unsigned)(4 * L) + digit) << shift;
      }
      const unsigned T = prefix;
      unsigned base = 0u, eqtaken = 0u;
      for (int i0 = 0; i0 < n; i0 += 64) {
        const int i = i0 + lane;
        const bool valid = i < n;
        const unsigned u = valid ? sortable_key(rowf[i]) : 0u;
        const bool gt = valid && (u > T);
        const bool eq = valid && (u == T);
        const unsigned long long beq = __ballot(eq);
        const unsigned eqrank = eqtaken + (unsigned)__popcll(beq & lt_mask);
        const bool take = gt || (eq && eqrank < krem);
        const unsigned long long bt = __ballot(take);
        const unsigned pos = base + (unsigned)__popcll(bt & lt_mask);
        if (take && pos < 256u) mysel[pos] = (unsigned short)i;
        base += (unsigned)__popcll(bt);
        eqtaken += (unsigned)__popcll(beq);
      }
    }
  }
  lds_fence();
  if (lane == 0) { rmm[w] = 0xFFFFFFFFu; rmm[8 + w] = 0u; }
  lds_fence();
  {
    const uint2 s4 = *(const uint2*)(mysel + 4 * lane);
    const int sj[4] = {(int)(s4.x & 0xffffu), (int)(s4.x >> 16), (int)(s4.y & 0xffffu), (int)(s4.y >> 16)};
    unsigned pk = 0u;
#pragma unroll
    for (int j = 0; j < 4; ++j) {
      const bool valid = 4 * lane + j < cnt;
      const int dist = valid ? t - sj[j] : 0;
      unsigned bk = dist < 128 ? (unsigned)bkt[dist] : 31u;
      bk = valid ? bk : 32u;
      pk |= bk << (8 * j);
    }
    bks[w * 64 + lane] = pk;
  }
  lds_fence();
  {
    int lane_a = lane;
    asm volatile("" : "+v"(lane_a));
    const int l15 = lane_a & 15, g = lane_a >> 4;
    const int ks = lane_a >> 3, dc = lane_a & 7;
    const unsigned char* kcb = (const unsigned char*)(kc + tokbase * 64);
    const unsigned char* vcb = (const unsigned char*)(vc + tokbase * 64);
    float* pl = (float*)row;
    const float* relb = (const float*)(bkt + 128);
    const int niter = (cnt + 7) >> 3;
    bf16x8 bq0 = (bf16x8){0, 0, 0, 0, 0, 0, 0, 0}, bq1 = bq0;
    if (l15 < 8) {
      bq0 = *(const bf16x8*)(pA + (tokbase + t) * 1024 + l15 * 64 + 8 * g);
      bq1 = *(const bf16x8*)(pA + (tokbase + t) * 1024 + l15 * 64 + 32 + 8 * g);
    }
    float lg[16][4];
    {
      bf16x8 ka[8][2], kb[8][2];
#pragma unroll
      for (int u = 0; u < 8; ++u) {
        const int kk = u * 16 + l15;
        const unsigned s = (unsigned)mysel[kk] & 4095u;
        const unsigned ko = s * 128u + 16u * (unsigned)g;
        ka[u][0] = *(const bf16x8*)(kcb + ko);
        ka[u][1] = *(const bf16x8*)(kcb + ko + 64u);
      }
#pragma unroll
      for (int u = 0; u < 8; ++u) {
        const int kk = (8 + u) * 16 + l15;
        const unsigned s = (unsigned)mysel[kk] & 4095u;
        const unsigned ko = s * 128u + 16u * (unsigned)g;
        kb[u][0] = *(const bf16x8*)(kcb + ko);
        kb[u][1] = *(const bf16x8*)(kcb + ko + 64u);
      }
      __builtin_amdgcn_sched_barrier(0);
#pragma unroll
      for (int u = 0; u < 8; ++u) {
        f32x4 acc = (f32x4){0.f, 0.f, 0.f, 0.f};
        acc = __builtin_amdgcn_mfma_f32_16x16x32_bf16(ka[u][0], bq0, acc, 0, 0, 0);
        acc = __builtin_amdgcn_mfma_f32_16x16x32_bf16(ka[u][1], bq1, acc, 0, 0, 0);
        lg[u][0] = acc[0]; lg[u][1] = acc[1]; lg[u][2] = acc[2]; lg[u][3] = acc[3];
      }
#pragma unroll
      for (int u = 0; u < 8; ++u) {
        f32x4 acc = (f32x4){0.f, 0.f, 0.f, 0.f};
        acc = __builtin_amdgcn_mfma_f32_16x16x32_bf16(kb[u][0], bq0, acc, 0, 0, 0);
        acc = __builtin_amdgcn_mfma_f32_16x16x32_bf16(kb[u][1], bq1, acc, 0, 0, 0);
        lg[8 + u][0] = acc[0]; lg[8 + u][1] = acc[1]; lg[8 + u][2] = acc[2]; lg[8 + u][3] = acc[3];
      }
    }
    typedef unsigned u32x4_t __attribute__((ext_vector_type(4)));
    u32x4_t va[16];
#pragma unroll
    for (int u = 0; u < 16; ++u) {
      const int kk = u * 8 + ks;
      const unsigned s = (unsigned)mysel[kk] & 4095u;
      va[u] = *(const u32x4_t*)(vcb + s * 128u + 16u * (unsigned)dc);
    }
    __builtin_amdgcn_sched_barrier(0);
    const int hsel = l15 & 7;
    float m = -INFINITY;
    const unsigned* mybks = bks + w * 64;
#pragma unroll
    for (int u = 0; u < 16; ++u) {
      const unsigned bk4 = mybks[4 * u + g];
#pragma unroll
      for (int j = 0; j < 4; ++j) {
        lg[u][j] = lg[u][j] * 0.125f + relb[((bk4 >> (8 * j)) & 255u) * 8 + hsel];
        m = fmaxf(m, lg[u][j]);
      }
    }
    m = max_xor16(m); m = max_xor32(m);
    float sum = 0.f;
#pragma unroll
    for (int u = 0; u < 16; ++u)
#pragma unroll
      for (int j = 0; j < 4; ++j) { lg[u][j] = __expf(lg[u][j] - m); sum += lg[u][j]; }
    sum = add_xor16(sum); sum = add_xor32(sum);
    const float inv = 1.f / sum;
    bf16x8 pa[8];
#pragma unroll
    for (int s8 = 0; s8 < 8; ++s8) {
      const unsigned w0 = pack2(lg[2 * s8][0] * inv, lg[2 * s8][1] * inv), w1 = pack2(lg[2 * s8][2] * inv, lg[2 * s8][3] * inv);
      const unsigned w2 = pack2(lg[2 * s8 + 1][0] * inv, lg[2 * s8 + 1][1] * inv), w3 = pack2(lg[2 * s8 + 1][2] * inv, lg[2 * s8 + 1][3] * inv);
      const u32x4_t wv = {w0, w1, w2, w3};
      pa[s8] = __builtin_bit_cast(bf16x8, wv);
    }
    unsigned char* vs_l = (unsigned char*)row;
    const unsigned vst_off = (unsigned)(ks * 128 + ((dc ^ (((ks >> 1) & 3) << 1)) << 4));
#pragma unroll
    for (int u = 0; u < 16; ++u) *(u32x4_t*)(vs_l + u * 1024 + vst_off) = va[u];
    lds_fence();
    u32x4_t vb[16];
#pragma unroll
    for (int u = 0; u < 16; ++u) {
      const int kk = (16 + u) * 8 + ks;
      const unsigned s = (unsigned)mysel[kk] & 4095u;
      vb[u] = *(const u32x4_t*)(vcb + s * 128u + 16u * (unsigned)dc);
    }
    __builtin_amdgcn_sched_barrier(0);
    f32x4 ov[4];
#pragma unroll
    for (int nt = 0; nt < 4; ++nt) ov[nt] = (f32x4){0.f, 0.f, 0.f, 0.f};
    typedef short v4s_t __attribute__((ext_vector_type(4)));
    const unsigned tr_lane = (unsigned)((l15 >> 2) * 128 + (l15 & 3) * 8);
    const unsigned tr_k = (unsigned)(((g & 1) << 1) | (l15 >> 3));
    unsigned tr_off[4];
#pragma unroll
    for (int nt = 0; nt < 4; ++nt) tr_off[nt] = tr_lane + (((unsigned)nt ^ tr_k) << 5);
#define PV_HALF(S0) do { \
      _Pragma("unroll") for (int s4_ = 0; s4_ < 4; ++s4_) { \
        _Pragma("unroll") for (int nt = 0; nt < 4; ++nt) { \
          const unsigned a0 = (unsigned)((s4_ * 32 + 4 * g) * 128) + tr_off[nt]; \
          const v4s_t b0 = __builtin_amdgcn_ds_read_tr16_b64_v4i16((__attribute__((address_space(3))) v4s_t*)(vs_l + a0)); \
          const v4s_t b1 = __builtin_amdgcn_ds_read_tr16_b64_v4i16((__attribute__((address_space(3))) v4s_t*)(vs_l + a0 + 16 * 128)); \
          const bf16x8 bb = (bf16x8){b0[0], b0[1], b0[2], b0[3], b1[0], b1[1], b1[2], b1[3]}; \
          ov[nt] = __builtin_amdgcn_mfma_f32_16x16x32_bf16(pa[(S0) + s4_], bb, ov[nt], 0, 0, 0); \
        } \
      } \
    } while (0)
    PV_HALF(0);
    lds_fence();
#pragma unroll
    for (int u = 0; u < 16; ++u) *(u32x4_t*)(vs_l + u * 1024 + vst_off) = vb[u];
    lds_fence();
    PV_HALF(4);
#undef PV_HALF
    if (g < 2) {
#pragma unroll
      for (int nt = 0; nt < 4; ++nt)
#pragma unroll
        for (int j = 0; j < 4; ++j) yb[(tokbase + t) * 1024 + (4 * g + j) * 64 + nt * 16 + l15] = f2bf(ov[nt][j]);
    }
    lds_fence();
  }
  __syncthreads();
}

__device__ __forceinline__ void phase_mix(const Params& p, unsigned char* smem, int mode = 0) {
  const int G = gridDim.x;
  if (mode != 2) { for (int bh = blockIdx.x; bh < 32; bh += G) { hgrn_h2(p, smem, bh); __syncthreads(); } }
  if (mode == 1) return;
  unsigned char* bkt = smem + DSA_BKT_OFF;
  volatile int* qslot = (volatile int*)(smem + LDS_BYTES - 32);
  unsigned* qctr = (unsigned*)(p.ws + WS_QCTR);
  if (threadIdx.x < 128) {
    const int nn = threadIdx.x;
    int v = nn;
    if (nn >= 16) { v = 16 + (int)(logf((float)nn * (1.f / 16.f)) / logf(8.f) * 16.f); if (v > 31) v = 31; }
    bkt[nn] = (unsigned char)v;
  }
  if (threadIdx.x >= 256) ((float*)(bkt + 128))[threadIdx.x - 256] = p.rel_bias[threadIdx.x - 256];
  if (threadIdx.x >= 128 && threadIdx.x < 136) ((float*)(bkt + 128))[256 + threadIdx.x - 128] = -INFINITY;
  if (threadIdx.x < 16) ((unsigned*)(bkt + 128 + 1056))[threadIdx.x] = threadIdx.x < 8 ? 0xFFFFFFFFu : 0u;
  const int my_team = (G % 8 == 0) ? team_index(p, smem) / (G >> 3) : (int)(blockIdx.x & 7);
  constexpr int QN = 544;
#define Q_FETCH(SLOT) do { if (threadIdx.x == 0) { int tm_ = q_team, kk_ = -1; \
      for (int tries_ = 0; tries_ < 8; ++tries_) { \
        const unsigned v_ = __hip_atomic_fetch_add(qctr + 16 * tm_, 1u, __ATOMIC_RELAXED, __HIP_MEMORY_SCOPE_AGENT); \
        if (v_ < (unsigned)QN) { kk_ = (tm_ << 16) | (int)v_; break; } \
        tm_ = (tm_ + 1) & 7; } \
      q_team = tm_; qslot[SLOT] = kk_; } } while (0)
  int q_team = my_team;
  Q_FETCH(0);
  __syncthreads();
  int k = qslot[0];
  int par = 1;
  while (k >= 0) {
    Q_FETCH(par);
    const int bt = k >> 16, kl = k & 0xffff;
    const int kq = kl / 17, kr = kl - kq * 17;
    if (kr < 16) {
      const int tb = 511 - (kq * 16 + kr);
      dsa_item(p, smem, (bt << 9) | tb);
    } else {
      const int r0 = (bt * 32 + kq) * 64;
      quantize_rows_u8<false, true>(p.peer_u, p.ws + WS_U, (float*)(p.ws + WS_U + (size_t)16384 * 1024), r0, r0 + 64);
      quantize_rows_u8<true, true>(p.peer_v, p.ws + WS_V, (float*)(p.ws + WS_V + (size_t)16384 * 1024), r0, r0 + 64);
      __syncthreads();
    }
    k = qslot[par];
    par ^= 1;
  }
#undef Q_FETCH
}

__device__ __forceinline__ void phase_pkeys(const Params& p, unsigned char* smem) {
  unsigned char* ws = p.ws;
  const bf16_t* qp = (const bf16_t*)(ws + WS_PG);
  const bf16_t* keys = (const bf16_t*)(ws + WS_KEYS);
  int* eidx = (int*)(ws + WS_EIDX);
  float* gw = (float*)(ws + WS_GW);
  float* sc = (float*)smem;
  float* s2l = (float*)smem;
  unsigned short* i1l = (unsigned short*)(s2l + 256 * 17);
  unsigned short* i2l = i1l + 256 * 16;
  const int tid = threadIdx.x, lane = tid & 63, w = tid >> 6, wm = w >> 1, wn = w & 1, l15 = lane & 15, g = lane >> 4;
  for (int item = blockIdx.x; item < 128 * 8; item += gridDim.x) {
    const int h = item & 7, tm = item >> 3;
    float s1[16], s2v[16]; int i1[16], i2[16];
#pragma unroll
    for (int ph = 0; ph < 2; ++ph) {
      const int hp = h * 2 + ph;
      f32x4 acc[4][4]; zero_acc(acc);
      gemm_tile(qp + (size_t)tm * 256 * 2048 + hp * 128, 2048, keys + (size_t)(ph * 8 + h) * 128 * 128, 128, 2, acc, smem);
      __syncthreads();
#pragma unroll
      for (int m = 0; m < 4; ++m)
#pragma unroll
        for (int n = 0; n < 4; ++n)
#pragma unroll
          for (int j = 0; j < 4; ++j) sc[(wm * 64 + m * 16 + 4 * g + j) * 129 + wn * 64 + n * 16 + l15] = acc[m][n][j];
      __syncthreads();
      if (tid < 256) {
        const float* rowp = sc + tid * 129;
        unsigned tv[16];
#pragma unroll
        for (int k = 0; k < 16; ++k) tv[k] = 0u;
#pragma unroll 8
        for (int nn = 0; nn < 128; ++nn) {
          const unsigned bits = __float_as_uint(rowp[nn]);
          unsigned key = (bits & 0x80000000u) ? ~bits : (bits | 0x80000000u);
          key = (key & ~127u) | (unsigned)(127 - nn);
#pragma unroll
          for (int k = 15; k >= 1; --k) {
            unsigned r;
            asm("v_med3_u32 %0, %1, %2, %3" : "=v"(r) : "v"(tv[k]), "v"(tv[k - 1]), "v"(key));
            tv[k] = r;
          }
          tv[0] = tv[0] > key ? tv[0] : key;
        }
#pragma unroll
        for (int k = 0; k < 16; ++k) {
          const int col = 127 - (int)(tv[k] & 127u);
          const float val = rowp[col];
          if (ph == 0) { i1[k] = col; s1[k] = val; } else { i2[k] = col; s2v[k] = val; }
        }
      }
      __syncthreads();
    }
    if (tid < 256) {
#pragma unroll
      for (int a = 0; a < 16; ++a) { s2l[tid * 17 + a] = s2v[a]; i1l[tid * 16 + a] = (unsigned short)i1[a]; i2l[tid * 16 + a] = (unsigned short)i2[a]; }
      float cur[16];
#pragma unroll
      for (int a = 0; a < 16; ++a) cur[a] = s1[a] + s2v[0];
      unsigned long long ptr = 0ull;
      float tops[16]; int tope[16];
#pragma unroll
      for (int k = 0; k < 16; ++k) {
        float best = cur[0]; int ba = 0;
#pragma unroll
        for (int a = 1; a < 16; ++a) if (cur[a] > best) { best = cur[a]; ba = a; }
        const int bb = (int)((ptr >> (4 * ba)) & 15ull);
        tops[k] = best;
        tope[k] = (int)i1l[tid * 16 + ba] * 128 + (int)i2l[tid * 16 + bb];
        const int nb = bb + 1;
        const float ns2 = (nb < 16) ? s2l[tid * 17 + nb] : -INFINITY;
        if (nb < 16) ptr += (1ull << (4 * ba));
#pragma unroll
        for (int a = 0; a < 16; ++a) if (a == ba) cur[a] = s1[a] + ns2;
      }
      const float m = tops[0];
      float sum = 0.f;
#pragma unroll
      for (int k = 0; k < 16; ++k) { tops[k] = __expf(tops[k] - m); sum += tops[k]; }
      const float inv = 1.f / sum;
      const size_t ob = ((size_t)(tm * 256 + tid) * 8 + h) * 16;
#pragma unroll
      for (int k = 0; k < 16; k += 4) {
        *(int4*)(eidx + ob + k) = make_int4(tope[k], tope[k + 1], tope[k + 2], tope[k + 3]);
        *(float4*)(gw + ob + k) = make_float4(tops[k] * inv, tops[k + 1] * inv, tops[k + 2] * inv, tops[k + 3] * inv);
      }
    }
    __syncthreads();
  }
}


__device__ __forceinline__ float reduce8(const float (&pv)[8], int lane) {
  const bool b5 = lane & 32, b4 = lane & 16, b3 = lane & 8;
  float v[4];
#pragma unroll
  for (int i = 0; i < 4; ++i) {
    const float keep = b5 ? pv[4 + i] : pv[i];
    const float send = b5 ? pv[i] : pv[4 + i];
    v[i] = keep + __shfl_xor(send, 32);
  }
  float u[2];
#pragma unroll
  for (int i = 0; i < 2; ++i) {
    const float keep = b4 ? v[2 + i] : v[i];
    const float send = b4 ? v[i] : v[2 + i];
    u[i] = keep + __shfl_xor(send, 16);
  }
  float x = (b3 ? u[1] : u[0]) + __shfl_xor(b3 ? u[0] : u[1], 8);
  x += __shfl_xor(x, 4); x += __shfl_xor(x, 2); x += __shfl_xor(x, 1);
  return x;
}

__device__ __forceinline__ void cvt16u8(const uint4& v, float* f) {
  f[0] = (float)(v.x & 0xffu); f[1] = (float)((v.x >> 8) & 0xffu); f[2] = (float)((v.x >> 16) & 0xffu); f[3] = (float)(v.x >> 24);
  f[4] = (float)(v.y & 0xffu); f[5] = (float)((v.y >> 8) & 0xffu); f[6] = (float)((v.y >> 16) & 0xffu); f[7] = (float)(v.y >> 24);
  f[8] = (float)(v.z & 0xffu); f[9] = (float)((v.z >> 8) & 0xffu); f[10] = (float)((v.z >> 16) & 0xffu); f[11] = (float)(v.z >> 24);
  f[12] = (float)(v.w & 0xffu); f[13] = (float)((v.w >> 8) & 0xffu); f[14] = (float)((v.w >> 16) & 0xffu); f[15] = (float)(v.w >> 24);
}

__device__ __forceinline__ int wave_sum_i32_dpp(int v) {
  v += __builtin_amdgcn_update_dpp(0, v, 0xB1, 0xf, 0xf, true);
  v += __builtin_amdgcn_update_dpp(0, v, 0x4E, 0xf, 0xf, true);
  v += __builtin_amdgcn_update_dpp(0, v, 0x141, 0xf, 0xf, true);
  v += __builtin_amdgcn_update_dpp(0, v, 0x140, 0xf, 0xf, true);
  return __builtin_amdgcn_readlane(v, 0) + __builtin_amdgcn_readlane(v, 16) + __builtin_amdgcn_readlane(v, 32) + __builtin_amdgcn_readlane(v, 48);
}

__device__ __forceinline__ int reduce8_i32_scatter(const int (&d)[8], int lane) {
  const bool b0 = lane & 1, b1 = lane & 2, b2 = lane & 4;
  int v[4];
#pragma unroll
  for (int i = 0; i < 4; ++i) {
    const int keep = b0 ? d[2 * i + 1] : d[2 * i];
    const int send = b0 ? d[2 * i] : d[2 * i + 1];
    v[i] = keep + __builtin_amdgcn_update_dpp(0, send, 0xB1, 0xf, 0xf, true);
  }
  int u[2];
#pragma unroll
  for (int i = 0; i < 2; ++i) {
    const int keep = b1 ? v[2 * i + 1] : v[2 * i];
    const int send = b1 ? v[2 * i] : v[2 * i + 1];
    u[i] = keep + __builtin_amdgcn_update_dpp(0, send, 0x4E, 0xf, 0xf, true);
  }
  int x;
  {
    const int keep = b2 ? u[1] : u[0];
    const int send = b2 ? u[0] : u[1];
    int t = __builtin_amdgcn_update_dpp(0, send, 0x141, 0xf, 0xf, true);
    t = __builtin_amdgcn_update_dpp(0, t, 0x1B, 0xf, 0xf, true);
    x = keep + t;
  }
  x += __builtin_amdgcn_update_dpp(0, x, 0x128, 0xf, 0xf, true);
  { const auto r = __builtin_amdgcn_permlane16_swap((unsigned)x, (unsigned)x, false, false); x = (int)r[0] + (int)r[1]; }
  { const auto r = __builtin_amdgcn_permlane32_swap((unsigned)x, (unsigned)x, false, false); x = (int)r[0] + (int)r[1]; }
  return x;
}

__device__ __forceinline__ void phase_pu(const Params& p, unsigned char* smem) {
  unsigned char* ws = p.ws;
  const unsigned char* XQ = ws + WS_XQ;
  const float* xs = (const float*)(ws + WS_XS);
  const unsigned char* U8 = ws + WS_U;
  const float* us = (const float*)(ws + WS_U + (size_t)16384 * 1024);
  const float* vs = (const float*)(ws + WS_V + (size_t)16384 * 1024);
  const int* eidx = (const int*)(ws + WS_EIDX);
  const float* gw = (const float*)(ws + WS_GW);
  float* aw = (float*)(ws + WS_PA);
  const int lane = threadIdx.x & 63, w = threadIdx.x >> 6;
  const unsigned long long lt_mask = (1ull << lane) - 1ull;
  const int G = gridDim.x;
  const bool sliced = (G % 8 == 0);
  const int ti = sliced ? team_index(p, smem) : 0;
  const int tsz = sliced ? (G >> 3) : G;
  const int grp_lo = sliced ? ti / tsz : 0, grp_hi = sliced ? grp_lo + 1 : 8;
  const int slot = (sliced ? (ti % tsz) : (int)blockIdx.x) * 8 + w;
  const int nslot = tsz * 8;
  unsigned* lst = (unsigned*)smem + 4096 + w * 128;
  typedef unsigned u32x4_t __attribute__((ext_vector_type(4)));
  if (slot >= TOK) return;
  for (int grp = grp_lo; grp < grp_hi; ++grp) {
#define PU_LIST(E0, E1, N, L0, L1) do { \
      const bool m0_ = ((E0) >> 11) == grp, m1_ = ((E1) >> 11) == grp; \
      const unsigned long long b0_ = __ballot(m0_), b1_ = __ballot(m1_); \
      const int c0_ = __popcll(b0_); N = c0_ + __popcll(b1_); \
      if (m0_) lst[__popcll(b0_ & lt_mask)] = ((unsigned)lane << 14) | (unsigned)(E0); \
      if (m1_) lst[c0_ + __popcll(b1_ & lt_mask)] = ((unsigned)(lane + 64) << 14) | (unsigned)(E1); \
      lds_fence(); \
      L0 = (lane < N) ? lst[lane] : 0u; L1 = (lane + 64 < N) ? lst[lane + 64] : 0u; \
      lds_fence(); } while (0)
#define PU_ISSUE(BUF, L0, N, I0) do { int last_ = ((N) < 64 ? (N) : 64) - 1; last_ = last_ < 0 ? 0 : last_; \
      _Pragma("unroll") for (int j = 0; j < 8; ++j) { int idx_ = (I0) + j; idx_ = idx_ < last_ ? idx_ : last_; \
        const unsigned le_ = (unsigned)__builtin_amdgcn_readlane((int)(L0), idx_); \
        BUF[j] = *(const u32x4_t*)(U8 + (size_t)(le_ & 16383u) * 1024 + lane * 16); } } while (0)
#define PU_REDUCE(BUF, X, I0, HREG) do { int dd_[8]; _Pragma("unroll") for (int j = 0; j < 8; ++j) { \
        int d_ = __builtin_amdgcn_sdot4((int)BUF[j].x, (int)(X).x, 0, false); \
        d_ = __builtin_amdgcn_sdot4((int)BUF[j].y, (int)(X).y, d_, false); \
        d_ = __builtin_amdgcn_sdot4((int)BUF[j].z, (int)(X).z, d_, false); \
        dd_[j] = __builtin_amdgcn_sdot4((int)BUF[j].w, (int)(X).w, d_, false); } \
      const int tot_ = reduce8_i32_scatter(dd_, lane);     \
      if (lane >= (I0) && lane < (I0) + 8) HREG = tot_; } while (0)
    u32x4_t cx = *(const u32x4_t*)(XQ + (size_t)slot * 1024 + lane * 16);
    int ce0 = eidx[(size_t)slot * 128 + lane], ce1 = eidx[(size_t)slot * 128 + 64 + lane];
    float cxs = xs[slot];
    int cn; unsigned cl0, cl1;
    PU_LIST(ce0, ce1, cn, cl0, cl1);
    u32x4_t ra[8], rb[8], rc[8];
    PU_ISSUE(ra, cl0, cn, 0);
    PU_ISSUE(rb, cl0, cn, 8);
    int t1 = (slot + nslot < TOK) ? slot + nslot : slot;
    u32x4_t nx = *(const u32x4_t*)(XQ + (size_t)t1 * 1024 + lane * 16);
    int ne0 = eidx[(size_t)t1 * 128 + lane], ne1 = eidx[(size_t)t1 * 128 + 64 + lane];
    float nxs = xs[t1];
    for (int tok = slot; tok < TOK; tok += nslot) {
      float sc0 = 0.f, sc1 = 0.f, gv0 = 0.f, gv1 = 0.f, vv0 = 0.f, vv1 = 0.f;
      if (lane < cn) { const int e = cl0 & 16383; sc0 = us[e]; vv0 = vs[e]; gv0 = gw[(size_t)tok * 128 + (cl0 >> 14)]; }
      if (lane + 64 < cn) { const int e = cl1 & 16383; sc1 = us[e]; vv1 = vs[e]; gv1 = gw[(size_t)tok * 128 + (cl1 >> 14)]; }
      int nn; unsigned nl0, nl1;
      PU_LIST(ne0, ne1, nn, nl0, nl1);
      const u32x4_t x1 = nx; const int xe0 = ne0, xe1 = ne1; const float xs1 = nxs;
      const int t2a = tok + nslot, t2 = (t2a + nslot < TOK) ? t2a + nslot : ((t2a < TOK) ? t2a : tok);
      nx = *(const u32x4_t*)(XQ + (size_t)t2 * 1024 + lane * 16);
      ne0 = eidx[(size_t)t2 * 128 + lane]; ne1 = eidx[(size_t)t2 * 128 + 64 + lane];
      nxs = xs[t2];
      int h0i = 0, h1i = 0;
      const bool third = cn > 16;
      if (third) { PU_ISSUE(rc, cl0, cn, 16); }
      __builtin_amdgcn_sched_barrier(0); PU_REDUCE(ra, cx, 0, h0i);  __builtin_amdgcn_sched_barrier(0);
      PU_ISSUE(ra, nl0, nn, 0);  __builtin_amdgcn_sched_barrier(0); PU_REDUCE(rb, cx, 8, h0i);  __builtin_amdgcn_sched_barrier(0);
      PU_ISSUE(rb, nl0, nn, 8);  __builtin_amdgcn_sched_barrier(0);
      if (third) { PU_REDUCE(rc, cx, 16, h0i); }
      __builtin_amdgcn_sched_barrier(0);
      if (cn > 24) {
        for (int i0 = 24; i0 < cn; i0 += 8) {
          u32x4_t rd[8];
          const bool lo = i0 < 64;
          const unsigned lsrc = lo ? cl0 : cl1;
          const int nsrc = lo ? cn : cn - 64;
          PU_ISSUE(rd, lsrc, nsrc, i0 & 63);
          if (lo) { PU_REDUCE(rd, cx, i0, h0i); } else { PU_REDUCE(rd, cx, i0 - 64, h1i); }
        }
      }
      const float h0 = (float)h0i * sc0 * cxs, h1 = (float)h1i * sc1 * cxs;
      if (lane < cn) aw[(size_t)tok * 128 + (cl0 >> 14)] = 0.5f * h0 * (1.f + erff(h0 * 0.70710678118654752f)) * gv0 * vv0;
      if (lane + 64 < cn) aw[(size_t)tok * 128 + (cl1 >> 14)] = 0.5f * h1 * (1.f + erff(h1 * 0.70710678118654752f)) * gv1 * vv1;
      cx = x1; ce0 = xe0; ce1 = xe1; cxs = xs1; cn = nn; cl0 = nl0; cl1 = nl1;
    }
#undef PU_LIST
#undef PU_ISSUE
#undef PU_REDUCE
  }
}

template <bool SL>
__device__ __forceinline__ void phase_pv_t(const Params& p, unsigned char* smem) {
  unsigned char* ws = p.ws;
  const unsigned char* V8 = ws + WS_V;
  const int* eidx = (const int*)(ws + WS_EIDX);
  const float* aw = (const float*)(ws + WS_PA);
  float* ssq = (float*)(ws + WS_SSQ);
  const int lane = threadIdx.x & 63, w = threadIdx.x >> 6;
  const int q = lane >> 3, c = lane & 7;
  const int G = gridDim.x;
  constexpr bool sliced = SL;
  const int ti = sliced ? team_index(p, smem) : 0;
  const int tsz = G >> 3;
  const int grp0 = sliced ? (ti / tsz) : 0;
  constexpr int ngrp = sliced ? 1 : 8;
  const int slot = sliced ? (ti % tsz) * 8 + w : blockIdx.x * 8 + w;
  const int nslot = sliced ? tsz * 8 : G * 8;
  int ee[16]; float aa[16];
  if (slot < TOK) {
    unsigned bi = (unsigned)slot * 128u + 16u * (unsigned)q;
    asm volatile("" : "+v"(bi));
#pragma unroll
    for (int u4 = 0; u4 < 4; ++u4) {
      const int4 e4 = *(const int4*)(eidx + bi + 4 * u4); const float4 a4 = *(const float4*)(aw + bi + 4 * u4);
      ee[4 * u4] = e4.x; ee[4 * u4 + 1] = e4.y; ee[4 * u4 + 2] = e4.z; ee[4 * u4 + 3] = e4.w;
      aa[4 * u4] = a4.x; aa[4 * u4 + 1] = a4.y; aa[4 * u4 + 2] = a4.z; aa[4 * u4 + 3] = a4.w;
    }
  }
  for (int tok = slot; tok < TOK; tok += nslot) {
    int ce[16]; float ca[16];
    float suma = 0.f;
#pragma unroll
    for (int u = 0; u < 16; ++u) { ce[u] = ee[u]; ca[u] = aa[u]; suma += aa[u]; }
    for (int gi = 0; gi < ngrp; ++gi) {
      const int grp = grp0 + gi;
      uint4 vv[16];
#pragma unroll
      for (int u = 0; u < 16; ++u) vv[u] = *(const uint4*)(V8 + (size_t)grp * (16384 * 128) + (size_t)ce[u] * 128 + c * 16);
      float* orow = p.out + (size_t)tok * 1024 + grp * 128 + c * 16;
      float4 x1v[4];
#pragma unroll
      for (int i = 0; i < 4; ++i) x1v[i] = *(const float4*)(orow + 4 * i);
      if (gi == ngrp - 1) {
        const int nt = (tok + nslot < TOK) ? tok + nslot : tok;
        unsigned bi = (unsigned)nt * 128u + 16u * (unsigned)q;
        asm volatile("" : "+v"(bi));
#pragma unroll
        for (int u4 = 0; u4 < 4; ++u4) {
          const int4 e4 = *(const int4*)(eidx + bi + 4 * u4); const float4 a4 = *(const float4*)(aw + bi + 4 * u4);
          ee[4 * u4] = e4.x; ee[4 * u4 + 1] = e4.y; ee[4 * u4 + 2] = e4.z; ee[4 * u4 + 3] = e4.w;
          aa[4 * u4] = a4.x; aa[4 * u4 + 1] = a4.y; aa[4 * u4 + 2] = a4.z; aa[4 * u4 + 3] = a4.w;
        }
      }
      __builtin_amdgcn_sched_barrier(0);
      float acc[16];
#pragma unroll
      for (int i = 0; i < 16; ++i) acc[i] = -128.f * suma;
#pragma unroll
      for (int u = 0; u < 16; ++u) {
        float vf[16];
        cvt16u8(vv[u], vf);
#pragma unroll
        for (int i = 0; i < 16; ++i) acc[i] += ca[u] * vf[i];
        __builtin_amdgcn_sched_barrier(0);
      }
#pragma unroll
      for (int i = 0; i < 16; ++i) { acc[i] = add_xor8(acc[i]); acc[i] = add_xor16(acc[i]); acc[i] = add_xor32(acc[i]); }
      float ss = 0.f;
      if (q == 0) {
#pragma unroll
        for (int i = 0; i < 4; ++i) {
          const float4 oa = make_float4(x1v[i].x + acc[4 * i], x1v[i].y + acc[4 * i + 1], x1v[i].z + acc[4 * i + 2], x1v[i].w + acc[4 * i + 3]);
          *(float4*)(orow + 4 * i) = oa;
          ss += oa.x * oa.x + oa.y * oa.y + oa.z * oa.z + oa.w * oa.w;
        }
      }
      ss += __shfl_xor(ss, 1); ss += __shfl_xor(ss, 2); ss += __shfl_xor(ss, 4);
      if (lane == 0) atomicAdd(&ssq[tok], ss);
    }
  }
}

__device__ __forceinline__ void phase_pv_mfma(const Params& p, unsigned char* smem) {
  unsigned char* ws = p.ws;
  const unsigned char* V8 = ws + WS_V;
  const int* eidx = (const int*)(ws + WS_EIDX);
  const float* aw = (const float*)(ws + WS_PA);
  float* ssq = (float*)(ws + WS_SSQ);
  const int lane = threadIdx.x & 63, w = threadIdx.x >> 6;
  const int q8 = lane >> 3, c = lane & 7;
  const int l15 = lane & 15, g = lane >> 4;
  const int G = gridDim.x;
  const bool sliced = (G % 8 == 0);
  const int ti = sliced ? team_index(p, smem) : 0;
  const int tsz = sliced ? (G >> 3) : G;
  const int grp_lo = sliced ? ti / tsz : 0, grp_hi = sliced ? grp_lo + 1 : 8;
  const int slot = (sliced ? (ti % tsz) : (int)blockIdx.x) * 8 + w;
  const int nslot = tsz * 8;
  if (slot >= TOK) return;
  unsigned char* vs_l = smem + 16384 + w * 16384;
  typedef unsigned u32x4_t __attribute__((ext_vector_type(4)));
  typedef float f32x4_t __attribute__((ext_vector_type(4)));
  typedef int i32x4_t __attribute__((ext_vector_type(4)));
  typedef int i32x2_t __attribute__((ext_vector_type(2)));
  const unsigned tr_f16 = (unsigned)((((l15 >> 2) & 3) | ((g & 1) << 2)) << 4);
  const unsigned tr_lane = (unsigned)((l15 >> 1) * 128 + (l15 & 1) * 8);
  unsigned tr_off[8];
#pragma unroll
  for (int nt = 0; nt < 8; ++nt) tr_off[nt] = tr_lane + (((unsigned)nt << 4) ^ tr_f16);
  unsigned st_off[4];
#pragma unroll
  for (int cu = 0; cu < 4; ++cu) st_off[cu] = (unsigned)(16 * q8 * 128 + (((c ^ ((q8 & 1) << 2)) ^ cu) << 4));
  unsigned char* cf_l = smem + 4096 + w * 128;
  const unsigned coff = (unsigned)c * 16u;
  for (int grp_v = grp_lo; grp_v < grp_hi; ++grp_v) {
    const int grp = __builtin_amdgcn_readfirstlane(grp_v);
    const unsigned char* Vg = V8 + (size_t)grp * (16384 * 128);
    i32x4_t ee[4]; float2 a2;
#define PVM_META(TOKEN) do { \
      const i32x4_t* ep_ = (const i32x4_t*)(eidx + (size_t)(TOKEN) * 128 + 16 * q8); \
      _Pragma("unroll") for (int u4 = 0; u4 < 4; ++u4) ee[u4] = ep_[u4]; \
      a2 = *(const float2*)(aw + (size_t)(TOKEN) * 128 + 2 * lane); } while (0)
    PVM_META(slot);
    for (int tok = slot; tok < TOK; tok += nslot) {
      u32x4_t vv[16];
#pragma unroll
      for (int u = 0; u < 16; ++u) vv[u] = *(const u32x4_t*)(Vg + ((((unsigned)ee[u >> 2][u & 3]) << 7) | coff));
      float* orow = p.out + (size_t)tok * 1024 + grp * 128 + l15;
      float x1v[8];
#pragma unroll
      for (int nt = 0; nt < 8; ++nt) x1v[nt] = orow[nt * 16];
      float am = fmaxf(fabsf(a2.x), fabsf(a2.y));
#define PVM_DPPMAX(CTRL) am = fmaxf(am, __int_as_float(__builtin_amdgcn_update_dpp(0, __float_as_int(am), CTRL, 0xf, 0xf, true)))
      PVM_DPPMAX(0xB1); PVM_DPPMAX(0x4E); PVM_DPPMAX(0x141); PVM_DPPMAX(0x140);
#undef PVM_DPPMAX
      am = max_xor16(am); am = max_xor32(am);
      const float inva = am > 0.f ? 127.f * __builtin_amdgcn_rcpf(am) : 0.f, sa = am * (1.f / 127.f);
      {
        const unsigned b0 = (unsigned)(int)rintf(a2.x * inva) & 255u, b1 = (unsigned)(int)rintf(a2.y * inva) & 255u;
        *(unsigned short*)(cf_l + 2 * lane) = (unsigned short)(b0 | (b1 << 8));
      }
      { const int nt_ = (tok + nslot < TOK) ? tok + nslot : tok; PVM_META(nt_); }
      __builtin_amdgcn_sched_barrier(0);
#pragma unroll
      for (int u = 0; u < 16; ++u) *(u32x4_t*)(vs_l + st_off[(u >> 1) & 3] + u * 128) = vv[u];
      lds_fence();
      i32x4_t aop[2];
      aop[0] = *(const i32x4_t*)(cf_l + 16 * g); aop[1] = *(const i32x4_t*)(cf_l + 64 + 16 * g);
      i32x4_t acc[8];
#pragma unroll
      for (int nt = 0; nt < 8; ++nt) acc[nt] = (i32x4_t){0, 0, 0, 0};
#pragma unroll
      for (int s2 = 0; s2 < 2; ++s2)
#pragma unroll
        for (int nt = 0; nt < 8; ++nt) {
          const unsigned a0 = (unsigned)((s2 * 64 + 16 * g) * 128) + tr_off[nt];
          const i32x2_t lo = __builtin_amdgcn_ds_read_tr8_b64_v2i32((__attribute__((address_space(3))) i32x2_t*)(vs_l + a0));
          const i32x2_t hi = __builtin_amdgcn_ds_read_tr8_b64_v2i32((__attribute__((address_space(3))) i32x2_t*)(vs_l + a0 + 8 * 128));
          const i32x4_t bop = {lo[0], lo[1], hi[0], hi[1]};
          acc[nt] = __builtin_amdgcn_mfma_i32_16x16x64_i8(aop[s2], bop, acc[nt], 0, 0, 0);
        }
      lds_fence();
      float ss = 0.f;
      if (g == 0) {
#pragma unroll
        for (int nt = 0; nt < 8; ++nt) { const float o = x1v[nt] + (float)acc[nt][0] * sa; orow[nt * 16] = o; ss += o * o; }
      }
      ss += __int_as_float(__builtin_amdgcn_update_dpp(0, __float_as_int(ss), 0xB1, 0xf, 0xf, true));
      ss += __int_as_float(__builtin_amdgcn_update_dpp(0, __float_as_int(ss), 0x4E, 0xf, 0xf, true));
      ss += __int_as_float(__builtin_amdgcn_update_dpp(0, __float_as_int(ss), 0x141, 0xf, 0xf, true));
      ss += __int_as_float(__builtin_amdgcn_update_dpp(0, __float_as_int(ss), 0x140, 0xf, 0xf, true));
      if (lane == 0) atomicAdd(&ssq[tok], ss);
    }
#undef PVM_META
  }
}

__device__ __forceinline__ void phase_final(const Params& p) {
  const float* ssq = (const float*)(p.ws + WS_SSQ);
  const int lane = threadIdx.x & 63, w = threadIdx.x >> 6;
  for (int row = blockIdx.x * 8 + w; row < TOK; row += gridDim.x * 8) {
    const float rstd = rsqrtf(ssq[row] * (1.f / DM) + EPSV);
    float4* o4 = (float4*)(p.out + (size_t)row * DM);
#pragma unroll
    for (int i = 0; i < 4; ++i) {
      float4 v = o4[lane + 64 * i];
      const float4 gg = ((const float4*)p.norm_final)[lane + 64 * i];
      v.x *= rstd * gg.x; v.y *= rstd * gg.y; v.z *= rstd * gg.z; v.w *= rstd * gg.w;
      o4[lane + 64 * i] = v;
    }
  }
}


__device__ __forceinline__ void phase_proj8(const Params& p, unsigned char* smem) {
  unsigned char* ws = p.ws;
  pg8::Gemm g{(const pg8::bf16_t*)(ws + WS_XN), (const pg8::bf16_t*)(ws + WS_WIN), TOK, 5120, 512};
  pg8::StaticOrder S; S.init(TOK, 5120, (int)gridDim.x, (int)blockIdx.x);
  EpiProj E{(unsigned short*)(ws + WS_PH), (unsigned short*)(ws + WS_PA), (unsigned short*)(ws + WS_PG),
            (unsigned short*)(ws + WS_KC), (unsigned short*)(ws + WS_VC), (unsigned short*)(ws + WS_IKC),
            (const float*)(ws + WS_XNS), (const float*)(ws + WS_WINS)};
  pg8::gemm_phase<EpiProj, pg8::StaticOrder, false, true>((PG8_LAS unsigned char*)smem, g, S, E, nullptr);
}
__device__ __forceinline__ void phase_ikln(const Params& p) {
  bf16_t* ikc = (bf16_t*)(p.ws + WS_IKC);
  const int tid = threadIdx.x, sub = tid & 7;
  float gam[8], bet[8];
#pragma unroll
  for (int i = 0; i < 8; ++i) { gam[i] = p.ikg[sub * 8 + i]; bet[i] = p.ikb[sub * 8 + i]; }
  for (int row = blockIdx.x * 64 + (tid >> 3); row < TOK; row += gridDim.x * 64) {
    uint4* ptr = (uint4*)(ikc + (size_t)row * 64 + sub * 8);
    const uint4 raw = *ptr;
    float v[8];
    cvt8(raw, v);
    float s = 0.f;
#pragma unroll
    for (int i = 0; i < 8; ++i) s += v[i];
    s += __shfl_xor(s, 1); s += __shfl_xor(s, 2); s += __shfl_xor(s, 4);
    const float mu = s * (1.f / 64.f);
    float q = 0.f;
#pragma unroll
    for (int i = 0; i < 8; ++i) { const float d = v[i] - mu; q += d * d; }
    q += __shfl_xor(q, 1); q += __shfl_xor(q, 2); q += __shfl_xor(q, 4);
    const float rstd = rsqrtf(q * (1.f / 64.f) + EPSV);
    uint4 o;
    o.x = pack2((v[0] - mu) * rstd * gam[0] + bet[0], (v[1] - mu) * rstd * gam[1] + bet[1]);
    o.y = pack2((v[2] - mu) * rstd * gam[2] + bet[2], (v[3] - mu) * rstd * gam[3] + bet[3]);
    o.z = pack2((v[4] - mu) * rstd * gam[4] + bet[4], (v[5] - mu) * rstd * gam[5] + bet[5]);
    o.w = pack2((v[6] - mu) * rstd * gam[6] + bet[6], (v[7] - mu) * rstd * gam[7] + bet[7]);
    *ptr = o;
  }
}
__device__ __forceinline__ void phase_up8(const Params& p, unsigned char* smem) {
  unsigned char* ws = p.ws;
  pg8::Gemm g{(const pg8::bf16_t*)(ws + WS_XN), (const pg8::bf16_t*)(ws + WS_WUPA), TOK, 1024, 1024};
  pg8::StaticOrder S; S.init(TOK, 1024, (int)gridDim.x, (int)blockIdx.x);
  EpiGate2 E{(unsigned short*)(ws + WS_PH), (const unsigned short*)(ws + WS_PG)};
  pg8::gemm_phase<EpiGate2, pg8::StaticOrder>((PG8_LAS unsigned char*)smem, g, S, E, nullptr);
}
__device__ __forceinline__ void phase_out8(const Params& p, unsigned char* smem) {
  unsigned char* ws = p.ws;
  pg8::Gemm g{(const pg8::bf16_t*)(ws + WS_PH), (const pg8::bf16_t*)(ws + WS_WOUT), TOK, 1024, 1024};
  pg8::StaticOrder S; S.init(TOK, 1024, (int)gridDim.x, (int)blockIdx.x);
  EpiResid E{p.out, p.x};
  pg8::gemm_phase<EpiResid, pg8::StaticOrder>((PG8_LAS unsigned char*)smem, g, S, E, nullptr);
}
__device__ __forceinline__ void phase_pq8(const Params& p, unsigned char* smem) {
  unsigned char* ws = p.ws;
  pg8::Gemm g{(const pg8::bf16_t*)(ws + WS_XQ), (const pg8::bf16_t*)(ws + WS_WQ), TOK, 2048, 512};
  pg8::StaticOrder S; S.init(TOK, 2048, (int)gridDim.x, (int)blockIdx.x);
  EpiStoreBf16Q E{(unsigned short*)(ws + WS_PG), 2048, (const float*)(ws + WS_XS), (const float*)(ws + WS_WQS)};
  pg8::gemm_phase<EpiStoreBf16Q, pg8::StaticOrder, false, true>((PG8_LAS unsigned char*)smem, g, S, E, nullptr);
}

__global__ void __launch_bounds__(NTHREADS) hybrid_fwd(Params p) {
  extern __shared__ __attribute__((aligned(16))) unsigned char smem[];
#if ONE_LAUNCH
  cg::grid_group grid = cg::this_grid();
  volatile LAS unsigned* xst = (volatile LAS unsigned*)(smem + LDS_BYTES - 16);
  if (threadIdx.x == 0) { xst[0] = 0u; xst[1] = 0u; }
  __syncthreads();
  XcdBarrier xbar = xcd_barrier_post((unsigned*)(p.ws + WS_BAR), xst);
#define SEAM(k) do { if (p.ph_lo <= (k) && (k) + 1 < p.ph_hi) { if (p.ph_hi > NPHASE) grid.sync(); else xcd_barrier(xbar); } } while (0)
#else
#define SEAM(k) do { } while (0)
#endif
#define IN(k) (p.ph_lo <= (k) && (k) < p.ph_hi)
#ifndef REPEAT_PH
#define REPEAT_PH -1
#endif
#define REP(k, stmt) do { if (REPEAT_PH == (k)) { stmt; grid.sync(); } } while (0)
  if (IN(0)) { phase_prep(p, smem); SEAM(0); }
  if (IN(1)) { phase_proj8(p, smem); SEAM(1); }
  if (IN(2)) { phase_ikln(p); hgrn_h1_all(p, smem); SEAM(2); }
  if (IN(3)) { phase_mix(p, smem); SEAM(3); }
  if (IN(4)) { phase_up8(p, smem); SEAM(4); }
  if (IN(5)) { phase_out8(p, smem); SEAM(5); }
  if (IN(6)) { rmsnorm_rows_q<false>(p.out, p.norm_ffn, nullptr, p.ws + WS_XQ, (float*)(p.ws + WS_XS)); SEAM(6); }
  if (IN(7)) { phase_pq8(p, smem); SEAM(7); }
  if (IN(8)) { phase_pkeys(p, smem); SEAM(8); }
  if (IN(9)) { phase_pu(p, smem); SEAM(9); }
  if (IN(10)) { phase_pv_mfma(p, smem); SEAM(10); }
  if (IN(11)) { phase_final(p); }
#undef IN
#undef SEAM
}

extern "C" void kernel_launch(void* const* d_in, const int* in_sizes, int n_in, void* d_out, int out_size, void* d_ws, size_t ws_size,
                              hipStream_t stream) {
  static int grid = 0;
  if (grid == 0) {
    if (n_in != 17 || ws_size < WS_END) {
      fprintf(stderr, "kernel_launch: unexpected n_in %d or ws_size %zu (need %zu)\n", n_in, ws_size, (size_t)WS_END);
      grid = -1; return;
    }
    int dev = 0, cus = 0, per_cu = 0;
    hipGetDevice(&dev);
    hipDeviceGetAttribute(&cus, hipDeviceAttributeMultiprocessorCount, dev);
    hipFuncSetAttribute((const void*)hybrid_fwd, hipFuncAttributeMaxDynamicSharedMemorySize, LDS_BYTES);
    hipOccupancyMaxActiveBlocksPerMultiprocessor(&per_cu, (const void*)hybrid_fwd, NTHREADS, LDS_BYTES);
    if (per_cu < 1) { fprintf(stderr, "kernel_launch: occupancy query says %d blocks/CU\n", per_cu); per_cu = 1; }
    (void)hipGetLastError();
    grid = cus;
  }
  if (grid < 0) return;
  Params p{};
  p.x = (const float*)d_in[0]; p.norm_mix = (const float*)d_in[1]; p.w_in = (const float*)d_in[2]; p.hg_lb = (const float*)d_in[3];
  p.hg_norm = (const float*)d_in[4]; p.ikg = (const float*)d_in[5]; p.ikb = (const float*)d_in[6]; p.rel_bias = (const float*)d_in[7];
  p.w_up_a = (const float*)d_in[8]; p.w_up_b = (const float*)d_in[9]; p.w_out = (const float*)d_in[10]; p.norm_ffn = (const float*)d_in[11];
  p.peer_wq = (const float*)d_in[12]; p.peer_keys = (const float*)d_in[13]; p.peer_u = (const float*)d_in[14]; p.peer_v = (const float*)d_in[15];
  p.norm_final = (const float*)d_in[16];
  p.out = (float*)d_out; p.ws = (unsigned char*)d_ws;
#if ONE_LAUNCH
  hipMemsetAsync((unsigned char*)d_ws + WS_BAR, 0, 16384, stream);
  p.ph_lo = 0; p.ph_hi = NPHASE;
  void* args[] = {&p};
  hipError_t e = hipLaunchCooperativeKernel((const void*)hybrid_fwd, dim3(grid), dim3(NTHREADS), args, LDS_BYTES, stream);
  if (e != hipSuccess) fprintf(stderr, "cooperative launch failed: %s (grid %d)\n", hipGetErrorString(e), grid);
#else
  for (int ph = 0; ph < NPHASE; ++ph) {
    p.ph_lo = ph; p.ph_hi = ph + 1;
    hipLaunchKernelGGL(hybrid_fwd, dim3(grid), dim3(NTHREADS), LDS_BYTES, stream, p);
  }
#endif
}
```

```cpp
#include <hip/hip_runtime.h>
#include <hip/hip_cooperative_groups.h>
#include <stdint.h>
#include <stdio.h>
namespace cg = cooperative_groups;

#ifndef ONE_LAUNCH
#define ONE_LAUNCH 1
#endif

typedef unsigned short bf16_t;
typedef __attribute__((ext_vector_type(8))) short bf16x8;
typedef __attribute__((ext_vector_type(4))) float f32x4;

#define NTHREADS 512
#define TOK 32768
#define SEQL 4096
#define DM 1024
#define EPSV 1e-6f
#define NPHASE 12

#define WS_WIN   ((size_t)0)
#define WS_WUPA  (WS_WIN  + (size_t)5120 * 1024 * 2)
#define WS_WUPB  (WS_WUPA + (size_t)1024 * 512 * 2)
#define WS_WOUT  (WS_WUPB + (size_t)1024 * 512 * 2)
#define WS_WQ    (WS_WOUT + (size_t)1024 * 1024 * 2)
#define WS_KEYS  (WS_WQ   + (size_t)2048 * 1024 * 2)
#define WS_LB    (WS_KEYS + (size_t)2 * 8 * 128 * 128 * 2)
#define WS_U     (WS_LB   + (size_t)4096)
#define WS_V     (WS_U    + (size_t)16384 * 1024 * 2)
#define WS_XN    (WS_V    + (size_t)16384 * 1024 * 2)
#define WS_PH    (WS_XN   + (size_t)TOK * 1024 * 2)
#define WS_PA    (WS_PH   + (size_t)TOK * 2048 * 2)
#define WS_PG    (WS_PA   + (size_t)TOK * 1024 * 2)
#define WS_EIDX  (WS_PG   + (size_t)TOK * 2048 * 2)
#define WS_GW    (WS_EIDX + (size_t)TOK * 128 * 4)
#define WS_SSQ   (WS_GW   + (size_t)TOK * 128 * 4)
#define WS_XCC   (WS_SSQ  + (size_t)TOK * 4)
#define WS_BAR   (WS_XCC  + (size_t)4096)
#define WS_DEC   (WS_BAR  + (size_t)16384)
#define WS_QCTR  (WS_DEC  + (size_t)2048 * 384 * 4)
#define WS_END   (WS_QCTR + (size_t)1024)

#define WS_KC (WS_EIDX)
#define WS_VC (WS_KC + (size_t)TOK * 128)
#define WS_IKC (WS_VC + (size_t)TOK * 128)
#define LDS_BYTES 155648

struct Params {
  const float* x; const float* norm_mix; const float* w_in; const float* hg_lb; const float* hg_norm;
  const float* ikg; const float* ikb; const float* rel_bias; const float* w_up_a; const float* w_up_b;
  const float* w_out; const float* norm_ffn; const float* peer_wq; const float* peer_keys;
  const float* peer_u; const float* peer_v; const float* norm_final;
  float* out; unsigned char* ws; int ph_lo, ph_hi;
};

__device__ __forceinline__ float bf2f(bf16_t u) { return __uint_as_float(((unsigned)u) << 16); }
typedef float f32x2_cv __attribute__((ext_vector_type(2)));
typedef __bf16 bf16x2_cv __attribute__((ext_vector_type(2)));
__device__ __forceinline__ unsigned pack2(float a, float b) {
  const f32x2_cv v = {a, b};
  return __builtin_bit_cast(unsigned, __builtin_convertvector(v, bf16x2_cv));
}
__device__ __forceinline__ bf16_t f2bf(float f) { return (bf16_t)(pack2(f, f) & 0xffffu); }
__device__ __forceinline__ float wave_sum_slow(float v) {
#pragma unroll
  for (int o = 32; o > 0; o >>= 1) v += __shfl_xor(v, o);
  return v;
}
__device__ __forceinline__ void lds_fence() { asm volatile("s_waitcnt lgkmcnt(0)" ::: "memory"); }

__device__ __forceinline__ float add_xor8(float v) { return v + __int_as_float(__builtin_amdgcn_update_dpp(0, __float_as_int(v), 0x128, 0xf, 0xf, true)); }
__device__ __forceinline__ float add_xor16(float v) { const auto r = __builtin_amdgcn_permlane16_swap(__float_as_uint(v), __float_as_uint(v), false, false); return __uint_as_float(r[0]) + __uint_as_float(r[1]); }
__device__ __forceinline__ float add_xor32(float v) { const auto r = __builtin_amdgcn_permlane32_swap(__float_as_uint(v), __float_as_uint(v), false, false); return __uint_as_float(r[0]) + __uint_as_float(r[1]); }
__device__ __forceinline__ float max_xor16(float v) { const auto r = __builtin_amdgcn_permlane16_swap(__float_as_uint(v), __float_as_uint(v), false, false); return fmaxf(__uint_as_float(r[0]), __uint_as_float(r[1])); }
__device__ __forceinline__ float max_xor32(float v) { const auto r = __builtin_amdgcn_permlane32_swap(__float_as_uint(v), __float_as_uint(v), false, false); return fmaxf(__uint_as_float(r[0]), __uint_as_float(r[1])); }
__device__ __forceinline__ float wave_sum(float v) {
  v += __int_as_float(__builtin_amdgcn_update_dpp(0, __float_as_int(v), 0xB1, 0xf, 0xf, true));
  v += __int_as_float(__builtin_amdgcn_update_dpp(0, __float_as_int(v), 0x4E, 0xf, 0xf, true));
  v += __int_as_float(__builtin_amdgcn_update_dpp(0, __float_as_int(v), 0x141, 0xf, 0xf, true));
  v += __int_as_float(__builtin_amdgcn_update_dpp(0, __float_as_int(v), 0x140, 0xf, 0xf, true));
  return add_xor32(add_xor16(v));
}
__device__ __forceinline__ float sigmoidf_(float x) { return 1.f / (1.f + __expf(-x)); }
__device__ __forceinline__ float siluf_(float x) { return x / (1.f + __expf(-x)); }


#define XB_TMO      128
#define XB_XCNT(j)  (256  + 64 * (j))
#define XB_XSUB(j)  (1280 + 64 * (j))
#define XB_XGEN(j)  (2304 + 64 * (j))
#define XB_TOP      3328
#define XB_TOPGEN   3392
#define XCD_BAR_WORDS 3456
#define XB_SPIN_CAP (1u << 22)
#define LAS __attribute__((address_space(3)))
__device__ __forceinline__ unsigned xb_ld(unsigned* p)              { return __hip_atomic_load(p, __ATOMIC_RELAXED, __HIP_MEMORY_SCOPE_AGENT); }
__device__ __forceinline__ unsigned xb_add(unsigned* p, unsigned v) { return __hip_atomic_fetch_add(p, v, __ATOMIC_RELAXED, __HIP_MEMORY_SCOPE_AGENT); }
__device__ __forceinline__ unsigned xb_xcc_id() { return (unsigned)__builtin_amdgcn_s_getreg((3 << 11) | 20) & 0xFu; }
#define XB_SPIN(cond, bar) do { unsigned _sp = 0; while (cond) { __builtin_amdgcn_s_sleep(1); \
    if ((++_sp & 255u) == 0u) { if (xb_ld(&(bar)[XB_TMO])) break; if (_sp > XB_SPIN_CAP) { atomicAdd(&(bar)[XB_TMO], 1u); break; } } } } while (0)
struct XcdBarrier { unsigned* bar; unsigned x; volatile LAS unsigned* st; };
__device__ __forceinline__ XcdBarrier xcd_barrier_post(unsigned* bar, volatile LAS unsigned* st) {
  XcdBarrier b; b.bar = bar; b.x = xb_xcc_id(); b.st = st;
  if (threadIdx.x == 0) (void)xb_add(&bar[XB_XCNT(b.x)], 1u);
  return b;
}
__device__ __forceinline__ void xcd_barrier_complete(unsigned* bar, unsigned x, unsigned& nloc, unsigned& nx) {
  const unsigned G = gridDim.x * gridDim.y * gridDim.z;
  unsigned sum, cnt, mine, sp = 0u;
  for (;;) {
    sum = 0u; cnt = 0u; mine = 0u;
#pragma unroll
    for (unsigned j = 0; j < 16; ++j) { const unsigned c = xb_ld(&bar[XB_XCNT(j)]); sum += c; cnt += (c > 0u) ? 1u : 0u; mine = (j == x) ? c : mine; }
    if (sum == G) break;
    __builtin_amdgcn_s_sleep(1);
    if ((++sp & 255u) == 0u) { if (xb_ld(&bar[XB_TMO])) break; if (sp > XB_SPIN_CAP) { atomicAdd(&bar[XB_TMO], 1u); break; } }
  }
  nloc = mine > 0u ? mine : 1u; nx = cnt > 0u ? cnt : 1u;
}
__device__ __forceinline__ void xcd_barrier(const XcdBarrier& b) {
  asm volatile("s_waitcnt vmcnt(0)" ::: "memory");
  __syncthreads();
  if (threadIdx.x == 0) {
    unsigned* bar = b.bar;
    __builtin_amdgcn_s_waitcnt(0);
    unsigned nloc = b.st[0], nx = b.st[1];
    if (nloc == 0u) { xcd_barrier_complete(bar, b.x, nloc, nx); b.st[0] = nloc; b.st[1] = nx; }
    const unsigned old = xb_add(&bar[XB_XSUB(b.x)], 1u);
    const unsigned gen = old / nloc;
    if (old + 1u == (gen + 1u) * nloc) {
      __builtin_amdgcn_fence(__ATOMIC_RELEASE, "agent");
      asm volatile("s_waitcnt vmcnt(0)" ::: "memory");
      const unsigned og = xb_add(&bar[XB_TOP], 1u);
      const unsigned tg = og / nx;
      if (og + 1u == (tg + 1u) * nx) xb_add(&bar[XB_TOPGEN], 1u);
      else XB_SPIN(xb_ld(&bar[XB_TOPGEN]) == tg, bar);
      __builtin_amdgcn_fence(__ATOMIC_ACQUIRE, "agent");
      xb_add(&bar[XB_XGEN(b.x)], 1u);
      asm volatile("s_waitcnt vmcnt(0)" ::: "memory");
    } else {
      XB_SPIN(xb_ld(&bar[XB_XGEN(b.x)]) == gen, bar);
      __builtin_amdgcn_fence(__ATOMIC_ACQUIRE, "agent");
      asm volatile("s_waitcnt vmcnt(0)" ::: "memory");
    }
  }
  __syncthreads();
}

namespace pg8 {
#define PG8_LAS __attribute__((address_space(3)))
typedef unsigned short bf16_t;
typedef short bf16x8 __attribute__((ext_vector_type(8)));
typedef float f32x4 __attribute__((ext_vector_type(4)));
typedef unsigned u32x4 __attribute__((ext_vector_type(4)));
constexpr int BM = 256, BK = 64, HALF = 128, HTB = HALF * BK * 2  , STAGE_BYTES = 8 * HTB, NXCD = 8, WGM = 8;

__host__ __device__ __forceinline__ int lds_byte(int r, int c) { const int st = (r >> 4) * 2 + (c >> 5), rr = r & 15, cc = c & 31, ob = rr * 64 + cc * 2; return st * 1024 + (ob ^ (((ob >> 9) & 1) << 5)); }
__host__ __device__ __forceinline__ void stage_rc(int b, int& R, int& C) { const int st = b / 1024, sb = b % 1024, swz = sb ^ (((sb >> 9) & 1) << 5); R = (st >> 1) * 16 + swz / 64; C = (st & 1) * 32 + (swz % 64) / 2; }
__host__ __device__ __forceinline__ int perm32(int rho) { const int n = rho >> 4, i = rho & 15; return 8 * (i >> 2) + 4 * n + (i & 3); }

struct Unit { int pm, pn; };
struct Gemm { const bf16_t* A; const bf16_t* Bt; int M, N, K; };

struct StaticOrder {
    int nM, nN, nwg, G, c;
    __host__ __device__ void init(int M, int N, int G_, int c_) { nM = M / BM; nN = N / BM; nwg = nM * nN; G = G_; c = c_; }
    __host__ __device__ bool next(int i, Unit& u) const {
        const long L = (long)i * G + c; if (L >= nwg) return false;
        int wgid = (int)L; { const int q = nwg / NXCD, r = nwg % NXCD, xcd = wgid % NXCD, off = wgid / NXCD; wgid = (xcd < r ? xcd * (q + 1) : r * (q + 1) + (xcd - r) * q) + off; }
        const int nig = WGM * nN, gid = wgid / nig, fm = gid * WGM, gsz = (nM - fm) < WGM ? (nM - fm) : WGM;
        u.pm = fm + ((wgid % nig) % gsz); u.pn = (wgid % nig) / gsz; return true;
    }
    __device__ __forceinline__ void a_ready(const Unit&) const {}
    __device__ __forceinline__ void done(const Unit&) const {}
};
__device__ __forceinline__ unsigned cvt_pk_bf16(float lo, float hi) { unsigned r; asm volatile("v_cvt_pk_bf16_f32 %0, %1, %2" : "=v"(r) : "v"(lo), "v"(hi)); return r; }
typedef int i32x4 __attribute__((ext_vector_type(4)));
template <class Epi, class Sched, bool STAMP = false, bool I8 = false>
__device__ __forceinline__ void gemm_phase(PG8_LAS unsigned char* lds, const Gemm g, const Sched& S, const Epi& E, unsigned long long* stamps) {
    const int tid = threadIdx.x, wid = __builtin_amdgcn_readfirstlane(tid >> 6), lane = tid & 63, wr = wid >> 2, wc = wid & 3, fr = lane & 15, fq = lane >> 4;
    const int K = g.K, nt = K / BK;
    int ts_lo = 0, ts_hi = 0, nts = 0; const unsigned long long rt_entry = STAMP ? (unsigned long long)wall_clock64() : 0ull;
#define PG8_STAMP() do { if (STAMP && wid == 0 && nts < 64) { const unsigned long long _c = (unsigned long long)clock64(); \
        ts_lo = (lane == nts) ? (int)(unsigned)_c : ts_lo; ts_hi = (lane == nts) ? (int)(unsigned)(_c >> 32) : ts_hi; ++nts; } } while (0)
    PG8_STAMP();
    unsigned voffA[2], voffB[2];
#pragma unroll
    for (int i = 0; i < 2; ++i) { int R, C; stage_rc(tid * 16 + i * 8192, R, C); const int Rb = Epi::PERM ? ((R & ~31) + perm32(R & 31)) : R;
        voffA[i] = (unsigned)(R * K + C) * 2u; voffB[i] = (unsigned)(Rb * K + C) * 2u; }
    const size_t kstep = (size_t)(BK * 2);
    const size_t hstep = (size_t)HALF * K * 2;
    const size_t tstep = 2 * hstep;
    const unsigned ldsw = (unsigned)wid * 1024u;
    const int aoff = lds_byte(wr * 64 + fr, fq * 8), boff = lds_byte(wc * 32 + fr, fq * 8);
#define PG8_SA(b, h) (((b) * 2 + (h)) * HTB)
#define PG8_SB(b, h) ((4 + (b) * 2 + (h)) * HTB)
#define PG8_STAGE(bufoff, gbase, voff) do { _Pragma("unroll") for (int _i = 0; _i < 2; ++_i) \
        __builtin_amdgcn_global_load_lds((const unsigned*)((const char*)(gbase) + (voff)[_i]), (PG8_LAS unsigned*)(lds + (bufoff) + ldsw + _i * 8192), 16, 0, 0); } while (0)
#define PG8_LDA(dst, b, h) do { _Pragma("unroll") for (int m = 0; m < 4; ++m) _Pragma("unroll") for (int k = 0; k < 2; ++k) dst[m][k] = *(const PG8_LAS bf16x8*)(lds + PG8_SA(b, h) + aoff + m * 2048 + k * 1024); } while (0)
#define PG8_LDB(dst, b, h) do { _Pragma("unroll") for (int n = 0; n < 2; ++n) _Pragma("unroll") for (int k = 0; k < 2; ++k) dst[n][k] = *(const PG8_LAS bf16x8*)(lds + PG8_SB(b, h) + boff + n * 2048 + k * 1024); } while (0)
#define PG8_MMA(ai, bj, At, Bt) do { __builtin_amdgcn_s_setprio(1); _Pragma("unroll") for (int m = 0; m < 4; ++m) _Pragma("unroll") for (int n = 0; n < 2; ++n) _Pragma("unroll") for (int k = 0; k < 2; ++k) \
        { if constexpr (I8) acc[ai][bj][m][n] = __builtin_bit_cast(f32x4, __builtin_amdgcn_mfma_i32_16x16x64_i8(__builtin_bit_cast(i32x4, Bt[n][k]), __builtin_bit_cast(i32x4, At[m][k]), __builtin_bit_cast(i32x4, acc[ai][bj][m][n]), 0, 0, 0)); \
          else acc[ai][bj][m][n] = __builtin_amdgcn_mfma_f32_16x16x32_bf16(Bt[n][k], At[m][k], acc[ai][bj][m][n], 0, 0, 0); } __builtin_amdgcn_s_setprio(0); } while (0)
#define PG8_WAIT_V(n) asm volatile("s_waitcnt vmcnt(" #n ")" ::: "memory")
#define PG8_WAIT_L(n) asm volatile("s_waitcnt lgkmcnt(" #n ")" ::: "memory")
#define PG8_BAR __builtin_amdgcn_s_barrier()
#define PG8_SCHED __builtin_amdgcn_sched_barrier(0)
    Unit cur, nxt; int ui = 0;
    if (!S.next(0, cur)) return;
    f32x4 acc[2][2][4][2];
#pragma unroll
    for (int a = 0; a < 2; ++a)
#pragma unroll
        for (int b = 0; b < 2; ++b)
#pragma unroll
            for (int m = 0; m < 4; ++m)
#pragma unroll
                for (int n = 0; n < 2; ++n) acc[a][b][m][n] = (f32x4){0.f, 0.f, 0.f, 0.f};
    bf16x8 At[4][2], B0[2][2], B1[2][2];
    const char* cA = (const char*)g.A + (size_t)cur.pm * tstep; const char* cB = (const char*)g.Bt + (size_t)cur.pn * tstep;
    S.a_ready(cur);
    PG8_STAGE(PG8_SB(0, 0), cB, voffB); PG8_STAGE(PG8_SA(0, 0), cA, voffA); PG8_STAGE(PG8_SB(0, 1), cB + hstep, voffB); PG8_STAGE(PG8_SA(0, 1), cA + hstep, voffA);
    if (wr == 1) PG8_BAR;
    PG8_WAIT_V(4); PG8_BAR;
    PG8_STAGE(PG8_SB(1, 0), cB + kstep, voffB); PG8_STAGE(PG8_SA(1, 0), cA + kstep, voffA); PG8_STAGE(PG8_SB(1, 1), cB + hstep + kstep, voffB);
    PG8_WAIT_V(6); PG8_BAR;
    PG8_STAMP();
    for (;;) {
        const bool has_next = S.next(ui + 1, nxt);
        const char* nA = has_next ? (const char*)g.A + (size_t)nxt.pm * tstep : cA; const char* nB = has_next ? (const char*)g.Bt + (size_t)nxt.pn * tstep : cB;
        for (int t = 0; t < nt; t += 2) {
            const bool last = (t == nt - 2);
            const char* a1 = cA + (size_t)(t + 1) * kstep;
            const char* a2 = last ? nA : cA + (size_t)(t + 2) * kstep; const char* b2 = last ? nB : cB + (size_t)(t + 2) * kstep;
            const char* a3 = a2 + kstep; const char* b3 = b2 + kstep;
            if constexpr (Epi::MID) { if (t == nt / 2) E.mid(acc, cur, wr, wc, fr, fq); }
            if (last && has_next) S.a_ready(nxt);
            PG8_LDB(B0, 0, 0); PG8_SCHED; PG8_LDA(At, 0, 0); PG8_STAGE(PG8_SA(1, 1), a1 + hstep, voffA);
            PG8_WAIT_L(8); PG8_BAR; PG8_WAIT_L(0); PG8_MMA(0, 0, At, B0); PG8_BAR; PG8_SCHED;
            PG8_LDB(B1, 0, 1); PG8_STAGE(PG8_SB(0, 0), b2, voffB);
            PG8_BAR; PG8_WAIT_L(0); PG8_MMA(0, 1, At, B1); PG8_BAR;
            PG8_LDA(At, 0, 1); PG8_STAGE(PG8_SA(0, 0), a2, voffA);
            PG8_BAR; PG8_WAIT_L(0); PG8_MMA(1, 0, At, B0); PG8_BAR; PG8_SCHED;
            PG8_STAGE(PG8_SB(0, 1), b2 + hstep, voffB);
            PG8_WAIT_V(6); PG8_BAR; PG8_MMA(1, 1, At, B1); PG8_BAR;
            PG8_LDB(B0, 1, 0); PG8_SCHED; PG8_LDA(At, 1, 0); PG8_STAGE(PG8_SA(0, 1), a2 + hstep, voffA);
            PG8_WAIT_L(8); PG8_BAR; PG8_WAIT_L(0); PG8_MMA(0, 0, At, B0); PG8_BAR; PG8_SCHED;
            PG8_LDB(B1, 1, 1); PG8_STAGE(PG8_SB(1, 0), b3, voffB);
            PG8_BAR; PG8_WAIT_L(0); PG8_MMA(0, 1, At, B1); PG8_BAR;
            PG8_LDA(At, 1, 1); PG8_STAGE(PG8_SA(1, 0), a3, voffA);
            PG8_BAR; PG8_WAIT_L(0); PG8_MMA(1, 0, At, B0); PG8_BAR; PG8_SCHED;
            PG8_STAGE(PG8_SB(1, 1), b3 + hstep, voffB);
            PG8_WAIT_V(6); PG8_BAR; PG8_MMA(1, 1, At, B1); PG8_BAR;
        }
        PG8_STAMP();
        if constexpr (!Epi::AFTER_DRAIN) { E(acc, cur, wr, wc, fr, fq); S.done(cur); }
        PG8_STAMP();
        if (!has_next) break;
#pragma unroll
        for (int a = 0; a < 2; ++a)
#pragma unroll
            for (int b = 0; b < 2; ++b)
#pragma unroll
                for (int m = 0; m < 4; ++m)
#pragma unroll
                    for (int n = 0; n < 2; ++n) acc[a][b][m][n] = (f32x4){0.f, 0.f, 0.f, 0.f};
        cur = nxt; cA = nA; cB = nB; ++ui;
    }
    PG8_WAIT_V(0);
    if (wr == 0) PG8_BAR;
    PG8_BAR;
    if constexpr (Epi::AFTER_DRAIN) { E.fused(acc, cur, wr, wc, fr, fq, lds, wid, lane); S.done(cur); }
    PG8_STAMP();
    if (STAMP && wid == 0) { stamps[lane] = lane < nts ? (((unsigned long long)(unsigned)ts_hi << 32) | (unsigned)ts_lo) : 0ull;
        if (lane == 62) stamps[62] = rt_entry; if (lane == 63) stamps[63] = (unsigned long long)wall_clock64(); }
#undef PG8_STAMP
#undef PG8_SA
#undef PG8_SB
#undef PG8_STAGE
#undef PG8_LDA
#undef PG8_LDB
#undef PG8_MMA
#undef PG8_WAIT_V
#undef PG8_WAIT_L
#undef PG8_BAR
#undef PG8_SCHED
}
}

struct EpiProj {
  static constexpr bool PERM = true, AFTER_DRAIN = false, MID = false;
  unsigned short* pH; unsigned short* pA; unsigned short* pG; unsigned short* kc; unsigned short* vc; unsigned short* ikc;
  const float* sa; const float* sw;
  __device__ __forceinline__ void operator()(const pg8::f32x4 (&acc)[2][2][4][2], const pg8::Unit& u, int wr, int wc, int fr, int fq) const {
    const int row0 = u.pm * 256 + wr * 64 + fr;
    pg8::f32x4 cs_[2][2];
#pragma unroll
    for (int bj = 0; bj < 2; ++bj)
#pragma unroll
      for (int n = 0; n < 2; ++n) cs_[bj][n] = *(const pg8::f32x4*)(sw + u.pn * 256 + bj * 128 + wc * 32 + 8 * fq + 4 * n);
    unsigned short* base; int ldc, colt; bool sg = false;
    if (u.pn < 8) { base = pH; ldc = 2048; colt = u.pn * 256; }
    else if (u.pn < 12) { base = pA; ldc = 1024; colt = (u.pn - 8) * 256; }
    else { base = pG; ldc = 2048; colt = (u.pn - 12) * 256; sg = true; }
    const int col0 = colt + wc * 32 + 8 * fq;
#pragma unroll
    for (int ai = 0; ai < 2; ++ai)
#pragma unroll
      for (int m = 0; m < 4; ++m) {
        unsigned short* rowp = base + (size_t)(row0 + ai * 128 + m * 16) * ldc + col0;
        const float ra = sa[row0 + ai * 128 + m * 16];
#pragma unroll
        for (int bj = 0; bj < 2; ++bj) {
          pg8::f32x4 v0, v1;
#pragma unroll
          for (int j = 0; j < 4; ++j) { v0[j] = (float)__float_as_int(acc[ai][bj][m][0][j]) * (ra * cs_[bj][0][j]); v1[j] = (float)__float_as_int(acc[ai][bj][m][1][j]) * (ra * cs_[bj][1][j]); }
          if (sg) {
#pragma unroll
            for (int j = 0; j < 4; ++j) { v0[j] = sigmoidf_(v0[j]); v1[j] = sigmoidf_(v1[j]); }
          }
          pg8::u32x4 w; w.x = pg8::cvt_pk_bf16(v0[0], v0[1]); w.y = pg8::cvt_pk_bf16(v0[2], v0[3]); w.z = pg8::cvt_pk_bf16(v1[0], v1[1]); w.w = pg8::cvt_pk_bf16(v1[2], v1[3]);
          unsigned short* dst = rowp + bj * 128;
          if (u.pn == 10 || u.pn == 11) {
            const int cs = col0 + bj * 128;
            const size_t r = (size_t)(row0 + ai * 128 + m * 16);
            if (cs >= 512 && cs < 576) dst = kc + r * 64 + (cs - 512);
            else if (cs >= 576 && cs < 640) dst = vc + r * 64 + (cs - 576);
            else if (cs >= 896 && cs < 960) dst = ikc + r * 64 + (cs - 896);
          }
          *(pg8::u32x4*)dst = w;
        }
      }
  }
};
template <int MODE> struct EpiGate {
  static constexpr bool PERM = true, AFTER_DRAIN = false, MID = false;
  unsigned short* hb; const unsigned short* pG; int goff;
  __device__ __forceinline__ void operator()(const pg8::f32x4 (&acc)[2][2][4][2], const pg8::Unit& u, int wr, int wc, int fr, int fq) const {
    const int row0 = u.pm * 256 + wr * 64 + fr;
    const int col0 = u.pn * 256 + wc * 32 + 8 * fq;
#pragma unroll
    for (int ai = 0; ai < 2; ++ai)
#pragma unroll
      for (int m = 0; m < 4; ++m) {
        const size_t r = (size_t)(row0 + ai * 128 + m * 16);
        pg8::u32x4 gv[2], hv[2];
#pragma unroll
        for (int bj = 0; bj < 2; ++bj) {
          gv[bj] = *(const pg8::u32x4*)(pG + r * 2048 + goff + col0 + bj * 128);
          if (MODE == 1) hv[bj] = *(const pg8::u32x4*)(hb + r * 1024 + col0 + bj * 128);
        }
#pragma unroll
        for (int bj = 0; bj < 2; ++bj) {
          float o[8];
#pragma unroll
          for (int j = 0; j < 4; ++j) {
            const unsigned gw0 = gv[bj][j >> 1], gw1 = gv[bj][2 + (j >> 1)];
            const float g0 = (j & 1) ? __uint_as_float(gw0 & 0xffff0000u) : __uint_as_float(gw0 << 16);
            const float g1 = (j & 1) ? __uint_as_float(gw1 & 0xffff0000u) : __uint_as_float(gw1 << 16);
            o[j] = acc[ai][bj][m][0][j] * g0; o[4 + j] = acc[ai][bj][m][1][j] * g1;
            if (MODE == 1) {
              const unsigned hw0 = hv[bj][j >> 1], hw1 = hv[bj][2 + (j >> 1)];
              o[j] += (j & 1) ? __uint_as_float(hw0 & 0xffff0000u) : __uint_as_float(hw0 << 16);
              o[4 + j] += (j & 1) ? __uint_as_float(hw1 & 0xffff0000u) : __uint_as_float(hw1 << 16);
            }
          }
          pg8::u32x4 w; w.x = pg8::cvt_pk_bf16(o[0], o[1]); w.y = pg8::cvt_pk_bf16(o[2], o[3]); w.z = pg8::cvt_pk_bf16(o[4], o[5]); w.w = pg8::cvt_pk_bf16(o[6], o[7]);
          *(pg8::u32x4*)(hb + r * 1024 + col0 + bj * 128) = w;
        }
      }
  }
};
struct EpiGate2 {
  static constexpr bool PERM = true, AFTER_DRAIN = false, MID = true;
  unsigned short* hb; const unsigned short* pG;
  __device__ __forceinline__ void mid(pg8::f32x4 (&acc)[2][2][4][2], const pg8::Unit& u, int wr, int wc, int fr, int fq) const {
    int fr_o = fr, fq_o = fq;
    asm volatile("" : "+v"(fr_o), "+v"(fq_o));
    const unsigned short* gp = pG + (size_t)(u.pm * 256 + wr * 64 + fr_o) * 2048 + u.pn * 256 + wc * 32 + 8 * fq_o;
#pragma unroll
    for (int ai = 0; ai < 2; ++ai)
#pragma unroll
      for (int m = 0; m < 4; ++m)
#pragma unroll
        for (int bj = 0; bj < 2; ++bj) {
          const unsigned short* q = gp + (size_t)(ai * 128 + m * 16) * 2048 + bj * 128;
          const pg8::u32x4 gb = *(const pg8::u32x4*)(q + 1024);
          const pg8::u32x4 ga = *(const pg8::u32x4*)q;
#pragma unroll
          for (int wd = 0; wd < 4; ++wd) {
            const float rl = __uint_as_float(ga[wd] << 16) * __builtin_amdgcn_rcpf(__uint_as_float(gb[wd] << 16));
            const float rh = __uint_as_float(ga[wd] & 0xffff0000u) * __builtin_amdgcn_rcpf(__uint_as_float(gb[wd] & 0xffff0000u));
            acc[ai][bj][m][wd >> 1][2 * (wd & 1)] *= rl;
            acc[ai][bj][m][wd >> 1][2 * (wd & 1) + 1] *= rh;
          }
          if (bj == 1) asm volatile("" ::: "memory");
        }
  }
  __device__ __forceinline__ void operator()(const pg8::f32x4 (&acc)[2][2][4][2], const pg8::Unit& u, int wr, int wc, int fr, int fq) const {
    const int row0 = u.pm * 256 + wr * 64 + fr;
    const int col0 = u.pn * 256 + wc * 32 + 8 * fq;
#pragma unroll
    for (int ai = 0; ai < 2; ++ai)
#pragma unroll
      for (int m = 0; m < 4; ++m) {
        const size_t r = (size_t)(row0 + ai * 128 + m * 16);
        pg8::u32x4 gb[2];
#pragma unroll
        for (int bj = 0; bj < 2; ++bj) gb[bj] = *(const pg8::u32x4*)(pG + r * 2048 + 1024 + col0 + bj * 128);
#pragma unroll
        for (int bj = 0; bj < 2; ++bj) {
          float o[8];
#pragma unroll
          for (int j = 0; j < 4; ++j) {
            const unsigned b0 = gb[bj][j >> 1], b1 = gb[bj][2 + (j >> 1)];
            const float sb0 = (j & 1) ? __uint_as_float(b0 & 0xffff0000u) : __uint_as_float(b0 << 16);
            const float sb1 = (j & 1) ? __uint_as_float(b1 & 0xffff0000u) : __uint_as_float(b1 << 16);
            o[j] = acc[ai][bj][m][0][j] * sb0; o[4 + j] = acc[ai][bj][m][1][j] * sb1;
          }
          pg8::u32x4 w; w.x = pg8::cvt_pk_bf16(o[0], o[1]); w.y = pg8::cvt_pk_bf16(o[2], o[3]); w.z = pg8::cvt_pk_bf16(o[4], o[5]); w.w = pg8::cvt_pk_bf16(o[6], o[7]);
          *(pg8::u32x4*)(hb + r * 1024 + col0 + bj * 128) = w;
        }
      }
  }
};
struct EpiResid {
  static constexpr bool PERM = true, AFTER_DRAIN = false, MID = false;
  unsigned short* o; const float* x;
  __device__ __forceinline__ void operator()(const pg8::f32x4 (&acc)[2][2][4][2], const pg8::Unit& u, int wr, int wc, int fr, int fq) const {
    const int row0 = u.pm * 256 + wr * 64 + fr, col0 = u.pn * 256 + wc * 32 + 8 * fq;
#pragma unroll
    for (int ai = 0; ai < 2; ++ai)
#pragma unroll
      for (int m = 0; m < 4; ++m) {
        const size_t off = (size_t)(row0 + ai * 128 + m * 16) * 1024 + col0;
        pg8::f32x4 xv[2][2];
#pragma unroll
        for (int bj = 0; bj < 2; ++bj)
#pragma unroll
          for (int n = 0; n < 2; ++n) xv[bj][n] = *(const pg8::f32x4*)(x + off + bj * 128 + n * 4);
#pragma unroll
        for (int bj = 0; bj < 2; ++bj) {
          const pg8::f32x4 v0 = acc[ai][bj][m][0] + xv[bj][0], v1 = acc[ai][bj][m][1] + xv[bj][1];
          pg8::u32x4 w; w.x = pg8::cvt_pk_bf16(v0[0], v0[1]); w.y = pg8::cvt_pk_bf16(v0[2], v0[3]); w.z = pg8::cvt_pk_bf16(v1[0], v1[1]); w.w = pg8::cvt_pk_bf16(v1[2], v1[3]);
          *(pg8::u32x4*)(o + off + bj * 128) = w;
        }
      }
  }
};
struct EpiStoreBf16Q {
  static constexpr bool PERM = true, AFTER_DRAIN = false, MID = false;
  unsigned short* O; int ldc; const float* sa; const float* sw;
  __device__ __forceinline__ void operator()(const pg8::f32x4 (&acc)[2][2][4][2], const pg8::Unit& u, int wr, int wc, int fr, int fq) const {
    const int row0 = u.pm * 256 + wr * 64 + fr, col0 = u.pn * 256 + wc * 32 + 8 * fq;
    pg8::f32x4 cs_[2][2];
#pragma unroll
    for (int bj = 0; bj < 2; ++bj)
#pragma unroll
      for (int n = 0; n < 2; ++n) cs_[bj][n] = *(const pg8::f32x4*)(sw + col0 + bj * 128 + 4 * n);
#pragma unroll
    for (int ai = 0; ai < 2; ++ai)
#pragma unroll
      for (int m = 0; m < 4; ++m) {
        unsigned short* rowp = O + (size_t)(row0 + ai * 128 + m * 16) * ldc + col0;
        const float ra = sa[row0 + ai * 128 + m * 16];
#pragma unroll
        for (int bj = 0; bj < 2; ++bj) {
          pg8::f32x4 v0, v1;
#pragma unroll
          for (int j = 0; j < 4; ++j) { v0[j] = (float)__float_as_int(acc[ai][bj][m][0][j]) * (ra * cs_[bj][0][j]); v1[j] = (float)__float_as_int(acc[ai][bj][m][1][j]) * (ra * cs_[bj][1][j]); }
          pg8::u32x4 w; w.x = pg8::cvt_pk_bf16(v0[0], v0[1]); w.y = pg8::cvt_pk_bf16(v0[2], v0[3]); w.z = pg8::cvt_pk_bf16(v1[0], v1[1]); w.w = pg8::cvt_pk_bf16(v1[2], v1[3]);
          *(pg8::u32x4*)(rowp + bj * 128) = w;
        }
      }
  }
};
struct EpiStoreBf16 {
  static constexpr bool PERM = true, AFTER_DRAIN = false, MID = false;
  unsigned short* O; int ldc;
  __device__ __forceinline__ void operator()(const pg8::f32x4 (&acc)[2][2][4][2], const pg8::Unit& u, int wr, int wc, int fr, int fq) const {
    const int row0 = u.pm * 256 + wr * 64 + fr, col0 = u.pn * 256 + wc * 32 + 8 * fq;
#pragma unroll
    for (int ai = 0; ai < 2; ++ai)
#pragma unroll
      for (int m = 0; m < 4; ++m) {
        unsigned short* rowp = O + (size_t)(row0 + ai * 128 + m * 16) * ldc + col0;
#pragma unroll
        for (int bj = 0; bj < 2; ++bj) {
          const pg8::f32x4 v0 = acc[ai][bj][m][0], v1 = acc[ai][bj][m][1];
          pg8::u32x4 w; w.x = pg8::cvt_pk_bf16(v0[0], v0[1]); w.y = pg8::cvt_pk_bf16(v0[2], v0[3]); w.z = pg8::cvt_pk_bf16(v1[0], v1[1]); w.w = pg8::cvt_pk_bf16(v1[2], v1[3]);
          *(pg8::u32x4*)(rowp + bj * 128) = w;
        }
      }
  }
};

__device__ __forceinline__ void gemm_tile(const bf16_t* __restrict__ A, int lda, const bf16_t* __restrict__ Bt, int ldb,
                                          int nk, f32x4 (&acc)[4][4], unsigned char* smem) {
  const int tid = threadIdx.x, lane = tid & 63, w = tid >> 6, wm = w >> 1, wn = w & 1, l15 = lane & 15, g = lane >> 4;
  unsigned char* sA = smem;
  unsigned char* sB = smem + 32768;
  const int lr = tid >> 3, lc = tid & 7;
  const bf16_t* ga = A + (size_t)lr * lda + lc * 8;
  const bf16_t* gb = Bt + (size_t)lr * ldb + lc * 8;
  uint4 ra0, ra1, ra2, ra3, rb0, rb1;
  ra0 = *(const uint4*)(ga);
  ra1 = *(const uint4*)(ga + (size_t)64 * lda);
  ra2 = *(const uint4*)(ga + (size_t)128 * lda);
  ra3 = *(const uint4*)(ga + (size_t)192 * lda);
  rb0 = *(const uint4*)(gb);
  rb1 = *(const uint4*)(gb + (size_t)64 * ldb);
  const int sw = (lc ^ (lr & 7)) << 4;
  for (int kt = 0; kt < nk; ++kt) {
    __syncthreads();
    *(uint4*)(sA + (lr) * 128 + sw) = ra0;
    *(uint4*)(sA + (lr + 64) * 128 + sw) = ra1;
    *(uint4*)(sA + (lr + 128) * 128 + sw) = ra2;
    *(uint4*)(sA + (lr + 192) * 128 + sw) = ra3;
    *(uint4*)(sB + (lr) * 128 + sw) = rb0;
    *(uint4*)(sB + (lr + 64) * 128 + sw) = rb1;
    __syncthreads();
    if (kt + 1 < nk) {
      const int ko = (kt + 1) * 64;
      ra0 = *(const uint4*)(ga + ko);
      ra1 = *(const uint4*)(ga + (size_t)64 * lda + ko);
      ra2 = *(const uint4*)(ga + (size_t)128 * lda + ko);
      ra3 = *(const uint4*)(ga + (size_t)192 * lda + ko);
      rb0 = *(const uint4*)(gb + ko);
      rb1 = *(const uint4*)(gb + (size_t)64 * ldb + ko);
    }
#pragma unroll
    for (int ks = 0; ks < 2; ++ks) {
      bf16x8 a[4], b[4];
#pragma unroll
      for (int m = 0; m < 4; ++m) { const int r = wm * 64 + m * 16 + l15; a[m] = *(const bf16x8*)(sA + r * 128 + (((ks * 4 + g) ^ (r & 7)) << 4)); }
#pragma unroll
      for (int n = 0; n < 4; ++n) { const int r = wn * 64 + n * 16 + l15; b[n] = *(const bf16x8*)(sB + r * 128 + (((ks * 4 + g) ^ (r & 7)) << 4)); }
#pragma unroll
      for (int m = 0; m < 4; ++m)
#pragma unroll
        for (int n = 0; n < 4; ++n) acc[m][n] = __builtin_amdgcn_mfma_f32_16x16x32_bf16(a[m], b[n], acc[m][n], 0, 0, 0);
    }
  }
}

__device__ __forceinline__ void zero_acc(f32x4 (&acc)[4][4]) {
#pragma unroll
  for (int m = 0; m < 4; ++m)
#pragma unroll
    for (int n = 0; n < 4; ++n) acc[m][n] = (f32x4){0.f, 0.f, 0.f, 0.f};
}

__device__ __forceinline__ void transpose_tile(const float* __restrict__ src, int srcN, bf16_t* __restrict__ dst, int K, int n0, int k0,
                                               bool winmap, float* tile) {
  const int tid = threadIdx.x;
  const int nc = tid & 63, kr = tid >> 6;
  int ncol = n0 + nc; bool valid = true;
  if (winmap) { if (ncol >= 3072) ncol -= 60; else if (ncol >= 3012) valid = false; }
#pragma unroll
  for (int i = 0; i < 8; ++i) {
    const int k = kr + 8 * i;
    tile[k * 65 + nc] = valid ? src[(size_t)(k0 + k) * srcN + ncol] : 0.f;
  }
  __syncthreads();
#pragma unroll
  for (int i = 0; i < 8; ++i) {
    const int nr = kr + 8 * i;
    dst[(size_t)(n0 + nr) * K + k0 + nc] = f2bf(tile[nc * 65 + nr]);
  }
  __syncthreads();
}

__device__ __forceinline__ void quant_cols32(const float* __restrict__ src, int srcN, unsigned char* __restrict__ dst, float* __restrict__ scale,
                                             int n0, bool winmap, float* tile) {
  const int tid = threadIdx.x, nc = tid & 31, kr = tid >> 5;
  float* red = tile + 1024 * 33;
  int ncol = n0 + nc; bool valid = true;
  if (winmap) { if (ncol >= 3072) ncol -= 60; else if (ncol >= 3012) valid = false; }
  if (!valid) ncol = 0;
  float am = 0.f;
#pragma unroll 8
  for (int i = 0; i < 64; ++i) {
    const int k = kr + 16 * i;
    float v = src[(size_t)k * srcN + ncol];
    v = valid ? v : 0.f;
    tile[k * 33 + nc] = v; am = fmaxf(am, fabsf(v));
  }
  red[kr * 32 + nc] = am;
  __syncthreads();
  if (tid < 32) {
    float m = 0.f;
#pragma unroll
    for (int i = 0; i < 16; ++i) m = fmaxf(m, red[i * 32 + tid]);
    red[512 + tid] = m; scale[n0 + tid] = m * (1.f / 127.f);
  }
  __syncthreads();
  const float cm = red[512 + nc];
  const float inv = cm > 0.f ? 127.f / cm : 0.f;
#pragma unroll
  for (int i = 0; i < 4; ++i) {
    const int k0 = (kr + 16 * i) * 16;
    unsigned pk[4];
#pragma unroll
    for (int q = 0; q < 4; ++q) {
      const unsigned b0 = (unsigned)(int)rintf(tile[(k0 + 4 * q) * 33 + nc] * inv) & 255u, b1 = (unsigned)(int)rintf(tile[(k0 + 4 * q + 1) * 33 + nc] * inv) & 255u;
      const unsigned b2 = (unsigned)(int)rintf(tile[(k0 + 4 * q + 2) * 33 + nc] * inv) & 255u, b3 = (unsigned)(int)rintf(tile[(k0 + 4 * q + 3) * 33 + nc] * inv) & 255u;
      pk[q] = b0 | (b1 << 8) | (b2 << 16) | (b3 << 24);
    }
    *(uint4*)(dst + (size_t)(n0 + nc) * 1024 + k0) = make_uint4(pk[0], pk[1], pk[2], pk[3]);
  }
  __syncthreads();
}

__device__ __forceinline__ void convert_f32_bf16(const float* __restrict__ src, bf16_t* __restrict__ dst, size_t n4) {
  for (size_t i = (size_t)blockIdx.x * NTHREADS + threadIdx.x; i < n4; i += (size_t)gridDim.x * NTHREADS) {
    const float4 v = ((const float4*)src)[i];
    uint2 o; o.x = pack2(v.x, v.y); o.y = pack2(v.z, v.w);
    ((uint2*)dst)[i] = o;
  }
}

template <bool SLICE_MAJOR, bool SIGNED>
__device__ __forceinline__ void quantize_rows_u8(const float* __restrict__ src, unsigned char* __restrict__ dst, float* __restrict__ scale, int row_lo, int row_hi) {
  const int lane = threadIdx.x & 63, w = threadIdx.x >> 6;
  for (int row = row_lo + w; row < row_hi; row += 8) {
    const float4* s4 = (const float4*)(src + (size_t)row * 1024) + lane * 4;
    float4 v[4];
    float am = 0.f;
#pragma unroll
    for (int i = 0; i < 4; ++i) { v[i] = s4[i]; am = fmaxf(am, fmaxf(fmaxf(fabsf(v[i].x), fabsf(v[i].y)), fmaxf(fabsf(v[i].z), fabsf(v[i].w)))); }
#pragma unroll
    for (int o = 32; o > 0; o >>= 1) am = fmaxf(am, __shfl_xor(am, o));
    const float inv = am > 0.f ? 127.f / am : 0.f;
    unsigned pk[4];
#pragma unroll
    for (int i = 0; i < 4; ++i) {
      const int ofs = SIGNED ? 0 : 128;
      const unsigned b0 = (unsigned)((int)rintf(v[i].x * inv) + ofs), b1 = (unsigned)((int)rintf(v[i].y * inv) + ofs);
      const unsigned b2 = (unsigned)((int)rintf(v[i].z * inv) + ofs), b3 = (unsigned)((int)rintf(v[i].w * inv) + ofs);
      pk[i] = (b0 & 255u) | ((b1 & 255u) << 8) | ((b2 & 255u) << 16) | ((b3 & 255u) << 24);
    }
    if (SLICE_MAJOR) {
      unsigned char* d8 = dst + (size_t)(lane >> 3) * (16384 * 128) + (size_t)row * 128 + 2 * (lane & 7);
#pragma unroll
      for (int q = 0; q < 8; ++q) {
        const unsigned lo = (pk[q >> 2] >> (8 * (q & 3))) & 255u, hi = (pk[2 + (q >> 2)] >> (8 * (q & 3))) & 255u;
        *(unsigned short*)(d8 + q * 16) = (unsigned short)(lo | (hi << 8));
      }
    }
    else *(uint4*)(dst + (size_t)row * 1024 + lane * 16) = make_uint4(pk[0], pk[1], pk[2], pk[3]);
    if (lane == 0) scale[row] = am * (1.f / 127.f);
  }
}

#define WS_WINS (WS_WIN + (size_t)5120 * 1024)
#define WS_WQS (WS_WQ + (size_t)2048 * 1024)
#define WS_XNS (WS_XN + (size_t)TOK * 1024)
#define WS_X1 (WS_XN)
#define WS_XQ (WS_PH + (size_t)TOK * 1024 * 2)
#define WS_XS (WS_XQ + (size_t)TOK * 1024)
template <bool WBF, bool SRC_BF16 = false>
__device__ __forceinline__ void rmsnorm_rows_q(const float* __restrict__ src, const float* __restrict__ g, bf16_t* __restrict__ dst,
                                               unsigned char* __restrict__ xq, float* __restrict__ xs) {
  const int lane = threadIdx.x & 63, w = threadIdx.x >> 6;
  for (int row = blockIdx.x * 8 + w; row < TOK; row += gridDim.x * 8) {
    const float4* g4 = (const float4*)g + lane * 4;
    float v[16]; float ss = 0.f;
    if (SRC_BF16) {
      const uint4* sb = (const uint4*)((const bf16_t*)src + (size_t)row * DM + lane * 16);
      const uint4 r0 = sb[0], r1 = sb[1];
      const unsigned wd[8] = {r0.x, r0.y, r0.z, r0.w, r1.x, r1.y, r1.z, r1.w};
#pragma unroll
      for (int i = 0; i < 8; ++i) { v[2 * i] = __uint_as_float(wd[i] << 16); v[2 * i + 1] = __uint_as_float(wd[i] & 0xffff0000u); ss += v[2 * i] * v[2 * i] + v[2 * i + 1] * v[2 * i + 1]; }
    } else {
      const float4* s4 = (const float4*)(src + (size_t)row * DM) + lane * 4;
#pragma unroll
      for (int i = 0; i < 4; ++i) { const float4 t = s4[i]; v[4 * i] = t.x; v[4 * i + 1] = t.y; v[4 * i + 2] = t.z; v[4 * i + 3] = t.w; ss += t.x * t.x + t.y * t.y + t.z * t.z + t.w * t.w; }
    }
    ss = wave_sum(ss);
    const float rstd = rsqrtf(ss * (1.f / DM) + EPSV);
    float am = 0.f;
#pragma unroll
    for (int i = 0; i < 4; ++i) { const float4 gg = g4[i]; v[4 * i] *= rstd * gg.x; v[4 * i + 1] *= rstd * gg.y; v[4 * i + 2] *= rstd * gg.z; v[4 * i + 3] *= rstd * gg.w; }
#pragma unroll
    for (int i = 0; i < 16; ++i) am = fmaxf(am, fabsf(v[i]));
#pragma unroll
    for (int o = 32; o > 0; o >>= 1) am = fmaxf(am, __shfl_xor(am, o));
    const float inv = am > 0.f ? 127.f / am : 0.f;
    if (WBF) {
      uint4 ob0, ob1;
      ob0.x = pack2(v[0], v[1]); ob0.y = pack2(v[2], v[3]); ob0.z = pack2(v[4], v[5]); ob0.w = pack2(v[6], v[7]);
      ob1.x = pack2(v[8], v[9]); ob1.y = pack2(v[10], v[11]); ob1.z = pack2(v[12], v[13]); ob1.w = pack2(v[14], v[15]);
      *(uint4*)(dst + (size_t)row * DM + lane * 16) = ob0;
      *(uint4*)(dst + (size_t)row * DM + lane * 16 + 8) = ob1;
    }
    unsigned pk[4];
#pragma unroll
    for (int i = 0; i < 4; ++i) {
      const unsigned b0 = (unsigned)(int)rintf(v[4 * i] * inv) & 255u, b1 = (unsigned)(int)rintf(v[4 * i + 1] * inv) & 255u;
      const unsigned b2 = (unsigned)(int)rintf(v[4 * i + 2] * inv) & 255u, b3 = (unsigned)(int)rintf(v[4 * i + 3] * inv) & 255u;
      pk[i] = b0 | (b1 << 8) | (b2 << 16) | (b3 << 24);
    }
    *(uint4*)(xq + (size_t)row * 1024 + lane * 16) = make_uint4(pk[0], pk[1], pk[2], pk[3]);
    if (lane == 0) xs[row] = am * (1.f / 127.f);
  }
}

__device__ __forceinline__ void rmsnorm_rows(const float* __restrict__ src, const float* __restrict__ g, bf16_t* __restrict__ dst) {
  const int lane = threadIdx.x & 63, w = threadIdx.x >> 6;
  for (int row = blockIdx.x * 8 + w; row < TOK; row += gridDim.x * 8) {
    const float4* s4 = (const float4*)(src + (size_t)row * DM);
    float4 v[4]; float ss = 0.f;
#pragma unroll
    for (int i = 0; i < 4; ++i) { v[i] = s4[lane + 64 * i]; ss += v[i].x * v[i].x + v[i].y * v[i].y + v[i].z * v[i].z + v[i].w * v[i].w; }
    ss = wave_sum(ss);
    const float rstd = rsqrtf(ss * (1.f / DM) + EPSV);
#pragma unroll
    for (int i = 0; i < 4; ++i) {
      const float4 gg = ((const float4*)g)[lane + 64 * i];
      uint2 o; o.x = pack2(v[i].x * rstd * gg.x, v[i].y * rstd * gg.y); o.y = pack2(v[i].z * rstd * gg.z, v[i].w * rstd * gg.w);
      ((uint2*)(dst + (size_t)row * DM))[lane + 64 * i] = o;
    }
  }
}

__device__ __forceinline__ void phase_prep(const Params& p, unsigned char* smem) {
  unsigned char* ws = p.ws;
  float* tile = (float*)smem;
  const int n_win = 160, n_ua = 16 * 8, n_ub = 16 * 8, n_wo = 16 * 16, n_wq = 64;
  const int total = n_win + n_wq + n_ua + n_ub + n_wo;
  for (int it = blockIdx.x; it < total; it += gridDim.x) {
    int t = it;
    if (t < n_win) { quant_cols32(p.w_in, 5060, ws + WS_WIN, (float*)(ws + WS_WINS), t * 32, true, tile); continue; }
    t -= n_win;
    if (t < n_wq) { quant_cols32(p.peer_wq, 2048, ws + WS_WQ, (float*)(ws + WS_WQS), t * 32, false, tile); continue; }
    t -= n_wq;
    if (t < n_ua) { transpose_tile(p.w_up_a, 1024, (bf16_t*)(ws + WS_WUPA), 1024, (t >> 3) * 64, (t & 7) * 64, false, tile); continue; }
    t -= n_ua;
    if (t < n_ub) { transpose_tile(p.w_up_b, 1024, (bf16_t*)(ws + WS_WUPA) + 512, 1024, (t >> 3) * 64, (t & 7) * 64, false, tile); continue; }
    t -= n_ub;
    transpose_tile(p.w_out, 1024, (bf16_t*)(ws + WS_WOUT), 1024, (t >> 4) * 64, (t & 15) * 64, false, tile);
  }
  convert_f32_bf16(p.peer_keys, (bf16_t*)(ws + WS_KEYS), (size_t)2 * 8 * 128 * 128 / 4);
  for (int i = blockIdx.x * NTHREADS + threadIdx.x; i < TOK; i += gridDim.x * NTHREADS) ((float*)(ws + WS_SSQ))[i] = 0.f;
  if (threadIdx.x == 0) ((int*)(ws + WS_XCC))[blockIdx.x] = (int)(__builtin_amdgcn_s_getreg((3 << 11) | 20) & 0xFu);
  if (blockIdx.x == 0 && threadIdx.x < 8) ((unsigned*)(ws + WS_QCTR))[16 * threadIdx.x] = 0u;
  if (blockIdx.x == 0) {
    const int i = threadIdx.x;
    const float a0 = p.hg_lb[i], a1 = p.hg_lb[512 + i];
    ((float*)(ws + WS_LB))[i] = 1.f / (1.f + expf(a1 - a0));
  }
  rmsnorm_rows_q<false>(p.x, p.norm_mix, nullptr, ws + WS_XN, (float*)(ws + WS_XNS));
}

__device__ __forceinline__ void hgrn_h1_all(const Params& p, unsigned char* smem) {
  unsigned char* ws = p.ws;
  bf16_t* pH = (bf16_t*)(ws + WS_PH);
  const float* lbp = (const float*)(ws + WS_LB);
  bf16_t* Qt = (bf16_t*)smem;
  bf16_t* Kt = Qt + 64 * 136;
  bf16_t* KtT = Kt + 64 * 136;
  bf16_t* VT = KtT + 128 * 72;
  bf16_t* Am = VT + 128 * 72;
  float* qtot = (float*)(Am + 64 * 72);
  const int tid = threadIdx.x, lane = tid & 63, w = tid >> 6, l15 = lane & 15, g = lane >> 4;
  const int d = tid & 127, tq = tid >> 7;
  const int G = gridDim.x;
  if ((int)blockIdx.x >= 2048) return;
  bf16_t fr_[16], qr_[16]; unsigned short vr_[16];
#define H1_LOAD(IT) do { \
    const int bh_ = (IT) >> 6, ch_ = (IT) & 63; \
    const bf16_t* base_ = pH + ((size_t)(bh_ >> 2) * SEQL + ch_ * 64 + tq * 16) * 2048 + (bh_ & 3) * 128 + d; \
    _Pragma("unroll") for (int i = 0; i < 16; ++i) { fr_[i] = base_[(size_t)i * 2048 + 512]; qr_[i] = base_[(size_t)i * 2048]; vr_[i] = base_[(size_t)i * 2048 + 1024]; } \
  } while (0)
  H1_LOAD((int)blockIdx.x);
  for (int item = blockIdx.x; item < 2048; item += G) {
    const int bh = item >> 6, chunk = item & 63;
    const int b = bh >> 2, h = bh & 3;
    const float lbv = lbp[h * 128 + d];
    const size_t row0 = (size_t)b * SEQL + chunk * 64;
    float* dec = (float*)(ws + WS_DEC) + (size_t)item * 384;
    uint4* UU = (uint4*)p.out + (size_t)item * 2048 + tid;
    float4* OI = (float4*)((unsigned char*)p.out + ((size_t)64 << 20)) + (size_t)item * 2048 + tid;
    {
      unsigned vv[8];
#pragma unroll
      for (int i = 0; i < 8; ++i) vv[i] = (unsigned)vr_[2 * i] | ((unsigned)vr_[2 * i + 1] << 16);
      float lf[16], kk[16], qs[16];
      float run = 0.f;
#pragma unroll
      for (int i = 0; i < 16; ++i) {
        const float sg = sigmoidf_(bf2f(fr_[i]));
        const float fg = lbv + (1.f - lbv) * sg;
        run += __logf(fg);
        lf[i] = run; kk[i] = 1.f - fg; qs[i] = siluf_(bf2f(qr_[i]));
      }
      qtot[tq * 128 + d] = run;
      __syncthreads();
      { const int nit = (item + G < 2048) ? item + G : item; H1_LOAD(nit); }
      const float q0 = qtot[d], q1 = qtot[128 + d], q2 = qtot[256 + d], q3 = qtot[384 + d];
      const float pre = (tq > 0 ? q0 : 0.f) + (tq > 1 ? q1 : 0.f) + (tq > 2 ? q2 : 0.f);
      const float bref = q0 + q1;
      const float blast = bref + q2 + q3;
      unsigned kp[8];
#pragma unroll
      for (int i = 0; i < 16; ++i) {
        const float bt = pre + lf[i];
        const float qt = qs[i] * __expf(bt - bref);
        const float kt = kk[i] * __expf(bref - bt);
        const int t = tq * 16 + i;
        Qt[t * 136 + d] = f2bf(qt);
        const bf16_t kb = f2bf(kt);
        Kt[t * 136 + d] = kb;
        if (i & 1) kp[i >> 1] |= ((unsigned)kb) << 16; else kp[i >> 1] = kb;
      }
      *(uint4*)(KtT + d * 72 + tq * 16) = make_uint4(kp[0], kp[1], kp[2], kp[3]);
      *(uint4*)(KtT + d * 72 + tq * 16 + 8) = make_uint4(kp[4], kp[5], kp[6], kp[7]);
      *(uint4*)(VT + d * 72 + tq * 16) = make_uint4(vv[0], vv[1], vv[2], vv[3]);
      *(uint4*)(VT + d * 72 + tq * 16 + 8) = make_uint4(vv[4], vv[5], vv[6], vv[7]);
      if (tq == 0) { dec[d] = __expf(bref); dec[128 + d] = __expf(blast); dec[256 + d] = __expf(blast - bref); }
    }
    __syncthreads();
    {
  #pragma unroll
      for (int i = 0; i < 2; ++i) {
        const int idx = tid + 512 * i, r = idx >> 4, c = idx & 15;
        *(uint4*)(pH + (row0 + r) * 2048 + h * 128 + c * 8) = *(const uint4*)(Qt + r * 136 + c * 8);
      }
  #pragma unroll
      for (int tt = 0; tt < 2; ++tt) {
        const int tl = 2 * w + tt, sm = tl >> 2, tn = tl & 3;
        f32x4 acc = (f32x4){0.f, 0.f, 0.f, 0.f};
        if (tn >= sm) {
  #pragma unroll
          for (int k0 = 0; k0 < 128; k0 += 32) {
            const bf16x8 a = *(const bf16x8*)(Kt + (sm * 16 + l15) * 136 + k0 + 8 * g);
            const bf16x8 bq = *(const bf16x8*)(Qt + (tn * 16 + l15) * 136 + k0 + 8 * g);
            acc = __builtin_amdgcn_mfma_f32_16x16x32_bf16(a, bq, acc, 0, 0, 0);
          }
        }
        const int t = tn * 16 + l15, s0 = sm * 16 + 4 * g;
        uint2 o;
        o.x = pack2(s0 + 0 <= t ? acc[0] : 0.f, s0 + 1 <= t ? acc[1] : 0.f);
        o.y = pack2(s0 + 2 <= t ? acc[2] : 0.f, s0 + 3 <= t ? acc[3] : 0.f);
        *(uint2*)(Am + t * 72 + s0) = o;
      }
    }
    __syncthreads();
    {
  #pragma unroll
      for (int tm = 0; tm < 4; ++tm) {
        f32x4 acc = (f32x4){0.f, 0.f, 0.f, 0.f};
  #pragma unroll
        for (int k0 = 0; k0 < 64; k0 += 32) {
          const bf16x8 a = *(const bf16x8*)(Am + (tm * 16 + l15) * 72 + k0 + 8 * g);
          const bf16x8 bb = *(const bf16x8*)(VT + (16 * w + l15) * 72 + k0 + 8 * g);
          acc = __builtin_amdgcn_mfma_f32_16x16x32_bf16(a, bb, acc, 0, 0, 0);
        }
        OI[tm * 512] = make_float4(acc[0], acc[1], acc[2], acc[3]);
      }
  #pragma unroll
      for (int dp = 0; dp < 4; ++dp) {
        unsigned pk[4];
  #pragma unroll
        for (int hh = 0; hh < 2; ++hh) {
          const int dm = dp * 2 + hh;
          f32x4 acc = (f32x4){0.f, 0.f, 0.f, 0.f};
  #pragma unroll
          for (int k0 = 0; k0 < 64; k0 += 32) {
            const bf16x8 a = *(const bf16x8*)(KtT + (dm * 16 + l15) * 72 + k0 + 8 * g);
            const bf16x8 bb = *(const bf16x8*)(VT + (16 * w + l15) * 72 + k0 + 8 * g);
            acc = __builtin_amdgcn_mfma_f32_16x16x32_bf16(a, bb, acc, 0, 0, 0);
          }
          pk[hh * 2] = pack2(acc[0], acc[1]); pk[hh * 2 + 1] = pack2(acc[2], acc[3]);
        }
        UU[dp * 512] = make_uint4(pk[0], pk[1], pk[2], pk[3]);
      }
    }
    __syncthreads();
  }
#undef H1_LOAD
}

__device__ __forceinline__ void hgrn_h2(const Params& p, unsigned char* smem, int bh) {
  unsigned char* ws = p.ws;
  const bf16_t* pH = (const bf16_t*)(ws + WS_PH);
  bf16_t* ya = (bf16_t*)(ws + WS_XN);
  bf16_t* Qt = (bf16_t*)smem;
  bf16_t* ST = Qt + 64 * 136;
  float* decl = (float*)(ST + 128 * 136);
  float* red = decl + 384;
  const int tid = threadIdx.x, lane = tid & 63, w = tid >> 6, l15 = lane & 15, g = lane >> 4;
  const int b = bh >> 2, h = bh & 3;
  f32x4 S[8];
#pragma unroll
  for (int i = 0; i < 8; ++i) S[i] = (f32x4){0.f, 0.f, 0.f, 0.f};
  const float gnv = p.hg_norm[h * 128 + 16 * w + l15];
  const int e = 16 * w + l15;
  uint4 uu0, uu1, uu2, uu3; float4 oi0, oi1, oi2, oi3; uint4 qraw0, qraw1; bf16_t ogr[16]; float dcv = 0.f;
#define H2_LOAD(CH) do { \
    const int item_ = bh * 64 + (CH); \
    const size_t row0_ = (size_t)b * SEQL + (size_t)(CH) * 64; \
    const uint4* UUp = (const uint4*)p.out + (size_t)item_ * 2048 + tid; \
    const float4* OIp = (const float4*)((const unsigned char*)p.out + ((size_t)64 << 20)) + (size_t)item_ * 2048 + tid; \
    uu0 = UUp[0]; uu1 = UUp[512]; uu2 = UUp[1024]; uu3 = UUp[1536]; oi0 = OIp[0]; oi1 = OIp[512]; oi2 = OIp[1024]; oi3 = OIp[1536]; \
    qraw0 = *(const uint4*)(pH + (row0_ + (tid >> 4)) * 2048 + h * 128 + (tid & 15) * 8); \
    qraw1 = *(const uint4*)(pH + (row0_ + 32 + (tid >> 4)) * 2048 + h * 128 + (tid & 15) * 8); \
    _Pragma("unroll") for (int tm = 0; tm < 4; ++tm) _Pragma("unroll") for (int j = 0; j < 4; ++j) \
      ogr[tm * 4 + j] = pH[(row0_ + tm * 16 + 4 * g + j) * 2048 + 1536 + h * 128 + e]; \
    if (tid < 384) dcv = ((const float*)(ws + WS_DEC))[(size_t)item_ * 384 + tid]; \
  } while (0)
  H2_LOAD(0);
  for (int chunk = 0; chunk < 64; ++chunk) {
    const size_t row0 = (size_t)b * SEQL + chunk * 64;
    const uint4 cu[4] = {uu0, uu1, uu2, uu3}; const float4 co[4] = {oi0, oi1, oi2, oi3}; bf16_t cog[16];
#pragma unroll
    for (int i = 0; i < 16; ++i) cog[i] = ogr[i];
    *(uint4*)(Qt + (tid >> 4) * 136 + (tid & 15) * 8) = qraw0;
    *(uint4*)(Qt + (32 + (tid >> 4)) * 136 + (tid & 15) * 8) = qraw1;
    if (tid < 384) decl[tid] = dcv;
    __syncthreads();
    if (chunk + 1 < 64) H2_LOAD(chunk + 1);
#pragma unroll
    for (int dm = 0; dm < 8; ++dm) {
      const int d0 = 16 * dm + 4 * g;
      uint2 o;
      o.x = pack2(S[dm][0] * decl[d0], S[dm][1] * decl[d0 + 1]);
      o.y = pack2(S[dm][2] * decl[d0 + 2], S[dm][3] * decl[d0 + 3]);
      *(uint2*)(ST + e * 136 + d0) = o;
    }
    __syncthreads();
    f32x4 o[4];
#pragma unroll
    for (int tm = 0; tm < 4; ++tm) {
      f32x4 acc = (f32x4){co[tm].x, co[tm].y, co[tm].z, co[tm].w};
#pragma unroll
      for (int k0 = 0; k0 < 128; k0 += 32) {
        const bf16x8 a = *(const bf16x8*)(Qt + (tm * 16 + l15) * 136 + k0 + 8 * g);
        const bf16x8 bb = *(const bf16x8*)(ST + (16 * w + l15) * 136 + k0 + 8 * g);
        acc = __builtin_amdgcn_mfma_f32_16x16x32_bf16(a, bb, acc, 0, 0, 0);
      }
      o[tm] = acc;
#pragma unroll
      for (int j = 0; j < 4; ++j) {
        float ss = acc[j] * acc[j];
        ss += __int_as_float(__builtin_amdgcn_update_dpp(0, __float_as_int(ss), 0xB1, 0xf, 0xf, true));
        ss += __int_as_float(__builtin_amdgcn_update_dpp(0, __float_as_int(ss), 0x4E, 0xf, 0xf, true));
        ss += __int_as_float(__builtin_amdgcn_update_dpp(0, __float_as_int(ss), 0x141, 0xf, 0xf, true));
        ss += __int_as_float(__builtin_amdgcn_update_dpp(0, __float_as_int(ss), 0x140, 0xf, 0xf, true));
        if (l15 == 0) red[w * 64 + tm * 16 + 4 * g + j] = ss;
      }
    }
#pragma unroll
    for (int dm = 0; dm < 8; ++dm) {
      const unsigned u01 = (dm & 1) ? cu[dm >> 1].z : cu[dm >> 1].x, u23 = (dm & 1) ? cu[dm >> 1].w : cu[dm >> 1].y;
      const float uv[4] = {__uint_as_float(u01 << 16), __uint_as_float(u01 & 0xffff0000u), __uint_as_float(u23 << 16), __uint_as_float(u23 & 0xffff0000u)};
#pragma unroll
      for (int j = 0; j < 4; ++j) { const int dd = 16 * dm + 4 * g + j; S[dm][j] = decl[128 + dd] * S[dm][j] + decl[256 + dd] * uv[j]; }
    }
    __syncthreads();
    if (tid < 64) {
      float tot = 0.f;
#pragma unroll
      for (int ww = 0; ww < 8; ++ww) tot += red[ww * 64 + tid];
      red[512 + tid] = rsqrtf(tot * (1.f / 128.f) + EPSV);
    }
    __syncthreads();
#pragma unroll
    for (int tm = 0; tm < 4; ++tm)
#pragma unroll
      for (int j = 0; j < 4; ++j) {
        const int t = tm * 16 + 4 * g + j;
        const float rstd = red[512 + t];
        ya[(row0 + t) * 1024 + h * 128 + e] = f2bf(o[tm][j] * rstd * gnv * siluf_(bf2f(cog[tm * 4 + j])));
      }
  }
#undef H2_LOAD
}

__device__ __forceinline__ int team_index(const Params& p, unsigned char* smem) {
  int* sh = (int*)(smem + 8192);
  const int G = gridDim.x, tid = threadIdx.x;
  const int* tab = (const int*)(p.ws + WS_XCC);
  if (tid < 32) sh[tid] = 0;
  __syncthreads();
  const int mine = tab[blockIdx.x] & 15;
  for (int b = tid; b < G; b += NTHREADS) {
    const int x = tab[b] & 15;
    atomicAdd(&sh[x], 1);
    if (x == mine && b < (int)blockIdx.x) atomicAdd(&sh[16], 1);
  }
  __syncthreads();
  if (tid == 0) {
    int pre = 0;
    for (int j = 0; j < mine; ++j) pre += sh[j];
    sh[17] = pre + sh[16];
  }
  __syncthreads();
  const int r = sh[17];
  __syncthreads();
  return r;
}

#define SCW 4100
#ifndef DSA_REP
#define DSA_REP 0
#endif
#define DSA_BKT_OFF (8 * SCW * 4 + 8 * 256 * 4 + 8 * 256 * 2 + 8 * 512 * 2)
__device__ __forceinline__ void cvt8(const uint4& v, float* f) {
  f[0] = __uint_as_float(v.x << 16); f[1] = __uint_as_float(v.x & 0xffff0000u);
  f[2] = __uint_as_float(v.y << 16); f[3] = __uint_as_float(v.y & 0xffff0000u);
  f[4] = __uint_as_float(v.z << 16); f[5] = __uint_as_float(v.z & 0xffff0000u);
  f[6] = __uint_as_float(v.w << 16); f[7] = __uint_as_float(v.w & 0xffff0000u);
}
__device__ __forceinline__ unsigned sortable_key(float v) {
  unsigned bits = __float_as_uint(v);
  if (bits == 0x80000000u) bits = 0u;
  return (bits & 0x80000000u) ? ~bits : (bits | 0x80000000u);
}

__device__ __forceinline__ void dsa_item(const Params& p, unsigned char* smem, int item) {
  unsigned char* ws = p.ws;
  const bf16_t* pA = (const bf16_t*)(ws + WS_PA);
  const bf16_t* kc = (const bf16_t*)(ws + WS_KC);
  const bf16_t* vc = (const bf16_t*)(ws + WS_VC);
  const bf16_t* ikc = (const bf16_t*)(ws + WS_IKC);
  bf16_t* yb = (bf16_t*)(ws + WS_XN) + 512;
  unsigned* sc = (unsigned*)smem;
  unsigned* hist = sc + 8 * SCW;
  unsigned short* sel = (unsigned short*)(hist + 8 * 256);
  unsigned short* cand = sel + 8 * 256;
  unsigned char* bkt = (unsigned char*)(cand + 8 * 512);
  unsigned* rmm = (unsigned*)(bkt + 128 + 1056);
  unsigned* bks = rmm + 16;
  const int tid = threadIdx.x, lane = tid & 63, w = tid >> 6, l15 = lane & 15, g = lane >> 4;
  const int b = item >> 9;
  const int tb = item & 511;
  const int t0 = tb * 8;
  const size_t tokbase = (size_t)b * SEQL;

  for (int rep_s = 0; rep_s < (DSA_REP == 1 ? 2 : 1); ++rep_s) {
    bf16x8 af[2][2];
    float wq[2][4];
#pragma unroll
    for (int mt = 0; mt < 2; ++mt) {
      const int qrow = t0 + mt * 4 + (l15 >> 2), head = l15 & 3;
#pragma unroll
      for (int ks = 0; ks < 2; ++ks)
        af[mt][ks] = *(const bf16x8*)(pA + (tokbase + qrow) * 1024 + 640 + head * 64 + ks * 32 + 8 * g);
      const uint2 wr = *(const uint2*)(pA + (tokbase + t0 + mt * 4 + g) * 1024 + 960);
      wq[mt][0] = 0.5f * bf2f((bf16_t)(wr.x & 0xffff)); wq[mt][1] = 0.5f * bf2f((bf16_t)(wr.x >> 16));
      wq[mt][2] = 0.5f * bf2f((bf16_t)(wr.y & 0xffff)); wq[mt][3] = 0.5f * bf2f((bf16_t)(wr.y >> 16));
    }
    const int nkt = (t0 + 8 + 15) >> 4;
    unsigned kmin[2] = {0xFFFFFFFFu, 0xFFFFFFFFu}, kmax[2] = {0u, 0u};
    for (int kt0 = w; kt0 < nkt; kt0 += 64) {
      bf16x8 b0[8], b1[8];
#pragma unroll
      for (int u = 0; u < 8; ++u) {
        const int kt = kt0 + 8 * u;
        const int s = (kt < nkt ? kt : 0) * 16 + l15;
        const bf16_t* kr = ikc + (tokbase + s) * 64 + 8 * g;
        b0[u] = *(const bf16x8*)kr;
        b1[u] = *(const bf16x8*)(kr + 32);
      }
      __builtin_amdgcn_sched_barrier(0);
      f32x4 sacc[8][2];
#pragma unroll
      for (int u = 0; u < 8; ++u)
#pragma unroll
        for (int mt = 0; mt < 2; ++mt) {
          f32x4 acc = (f32x4){0.f, 0.f, 0.f, 0.f};
          acc = __builtin_amdgcn_mfma_f32_16x16x32_bf16(af[mt][0], b0[u], acc, 0, 0, 0);
          sacc[u][mt] = __builtin_amdgcn_mfma_f32_16x16x32_bf16(af[mt][1], b1[u], acc, 0, 0, 0);
        }
#pragma unroll
      for (int u = 0; u < 8; ++u) {
        const int kt = kt0 + 8 * u;
        if (kt < nkt) {
          const int s = kt * 16 + l15;
#pragma unroll
          for (int mt = 0; mt < 2; ++mt) {
            float v = 0.f;
#pragma unroll
            for (int j = 0; j < 4; ++j) v += wq[mt][j] * fmaxf(sacc[u][mt][j] * 0.125f, 0.f);
            const int t = t0 + mt * 4 + g;
            unsigned vb = __float_as_uint(v); if (vb == 0x80000000u) vb = 0u;
            sc[(mt * 4 + g) * SCW + s] = vb;
            if (s <= t) {
              const unsigned key = (vb & 0x80000000u) ? ~vb : (vb | 0x80000000u);
              kmin[mt] = key < kmin[mt] ? key : kmin[mt];
              kmax[mt] = key > kmax[mt] ? key : kmax[mt];
            }
          }
        }
      }
    }
#pragma unroll
    for (int mt = 0; mt < 2; ++mt) {
      unsigned a = kmin[mt], bmx = kmax[mt];
#define DPP_MINMAX(CTRL) do { const unsigned a2 = (unsigned)__builtin_amdgcn_update_dpp((int)a, (int)a, CTRL, 0xf, 0xf, false); \
                               const unsigned b2 = (unsigned)__builtin_amdgcn_update_dpp((int)bmx, (int)bmx, CTRL, 0xf, 0xf, false); \
                               a = a2 < a ? a2 : a; bmx = b2 > bmx ? b2 : bmx; } while (0)
      DPP_MINMAX(0xB1); DPP_MINMAX(0x4E); DPP_MINMAX(0x141); DPP_MINMAX(0x140);
#undef DPP_MINMAX
      if (l15 == 0) { atomicMin(&rmm[mt * 4 + g], a); atomicMax(&rmm[8 + mt * 4 + g], bmx); }
    }
  }
  __syncthreads();
  const int t = t0 + w;
  const int n = t + 1;
  unsigned* row = sc + w * SCW;
  const float* rowf = (const float*)row;
  unsigned short* mysel = sel + w * 256;
  unsigned short* mycand = cand + w * 512;
  unsigned* myh = hist + w * 256;
  int cnt;
  const unsigned long long lt_mask = (1ull << lane) - 1ull;
  for (int rep_t = 0; rep_t < (DSA_REP == 2 ? 2 : 1); ++rep_t)
  if (n <= 256) {
    for (int i = lane; i < n; i += 64) mysel[i] = (unsigned short)i;
    cnt = n;
  } else {
    cnt = 256;
    float mn, mx;
    {
      const unsigned kmn = rmm[w], kmx = rmm[8 + w];
      mn = __uint_as_float((kmn & 0x80000000u) ? (kmn ^ 0x80000000u) : ~kmn);
      mx = __uint_as_float((kmx & 0x80000000u) ? (kmx ^ 0x80000000u) : ~kmx);
    }
    const float scale = (mx > mn) ? 255.99f / (mx - mn) : 0.f;
#pragma unroll
    for (int i = 0; i < 4; ++i) myh[lane + 64 * i] = 0u;
    lds_fence();
    for (int i0 = lane; i0 < n; i0 += 256) {
      float v4[4];
#pragma unroll
      for (int k = 0; k < 4; ++k) v4[k] = (i0 + 64 * k < n) ? rowf[i0 + 64 * k] : 0.f;
#pragma unroll
      for (int k = 0; k < 4; ++k) {
        if (i0 + 64 * k < n) {
          int bn = (int)((v4[k] - mn) * scale); bn = bn > 255 ? 255 : bn;
          atomicAdd(&myh[bn], 1u);
        }
      }
    }
    lds_fence();
    unsigned cum; int bstar; unsigned mcount;
    {
      const uint4 c4 = *(const uint4*)(myh + 4 * lane);
      const unsigned c = c4.x + c4.y + c4.z + c4.w;
      unsigned sfx = c;
#pragma unroll
      for (int o = 1; o < 64; o <<= 1) { const unsigned tt = __shfl_down(sfx, o); if (lane + o < 64) sfx += tt; }
      const unsigned long long bal = __ballot(sfx >= 256u);
      const int L = 63 - __clzll(bal);
      const unsigned sL = __shfl(sfx, L), cL = __shfl(c, L);
      const unsigned b3 = __shfl(c4.w, L), b2 = __shfl(c4.z, L), b1 = __shfl(c4.y, L), b0 = __shfl(c4.x, L);
      cum = sL - cL;
      int digit;
      if (cum + b3 >= 256u) { digit = 3; mcount = b3; }
      else { cum += b3; if (cum + b2 >= 256u) { digit = 2; mcount = b2; } else { cum += b2; if (cum + b1 >= 256u) { digit = 1; mcount = b1; } else { cum += b1; digit = 0; mcount = b0; } } }
      bstar = 4 * L + digit;
    }
    const unsigned need = 256u - cum;
    if (mcount <= 512u) {
      unsigned base = 0u, cb = 0u;
      for (int i0 = 0; i0 < n; i0 += 256) {
        float v4[4];
#pragma unroll
        for (int k = 0; k < 4; ++k) { const int i = i0 + 64 * k + lane; v4[k] = (i < n) ? rowf[i] : 0.f; }
#pragma unroll
        for (int k = 0; k < 4; ++k) {
          const int i = i0 + 64 * k + lane;
          const bool valid = i < n;
          int bn = (int)((v4[k] - mn) * scale); bn = bn > 255 ? 255 : bn;
          const bool gt = valid && (bn > bstar);
          const bool eq = valid && (bn == bstar);
          const unsigned long long bg = __ballot(gt), be = __ballot(eq);
          if (gt) mysel[base + (unsigned)__popcll(bg & lt_mask)] = (unsigned short)i;
          if (eq) mycand[cb + (unsigned)__popcll(be & lt_mask)] = (unsigned short)i;
          base += (unsigned)__popcll(bg); cb += (unsigned)__popcll(be);
        }
      }
      lds_fence();
      const int m = (int)mcount;
      unsigned ck[8]; unsigned short ci[8];
#pragma unroll
      for (int q = 0; q < 8; ++q) {
        const int c = q * 64 + lane;
        ck[q] = 0u; ci[q] = 0;
        if (c < m) { ci[q] = mycand[c]; ck[q] = sortable_key(rowf[ci[q]]); }
      }
      unsigned T = 0u;
      if (m <= 64) {
#pragma unroll 1
        for (int bit = 31; bit >= 0; --bit) {
          const unsigned trial = T | (1u << bit);
          if ((unsigned)__popcll(__ballot(ck[0] >= trial)) >= need) T = trial;
        }
      } else {
#pragma unroll 1
        for (int bit = 31; bit >= 0; --bit) {
          const unsigned trial = T | (1u << bit);
          unsigned cge = 0u;
#pragma unroll
          for (int q = 0; q < 8; ++q) cge += (unsigned)__popcll(__ballot(ck[q] >= trial));
          if (cge >= need) T = trial;
        }
      }
      unsigned cgt = 0u;
#pragma unroll
      for (int q = 0; q < 8; ++q) cgt += (unsigned)__popcll(__ballot(ck[q] > T));
      const unsigned need_eq = need - cgt;
      unsigned pos0 = cum, eqtaken = 0u;
#pragma unroll
      for (int q = 0; q < 8; ++q) {
        const bool gt = ck[q] > T;
        const bool eq = ck[q] == T;
        const unsigned long long beq = __ballot(eq);
        const bool take = gt || (eq && (eqtaken + (unsigned)__popcll(beq & lt_mask)) < need_eq);
        const unsigned long long bt = __ballot(take);
        const unsigned pp = pos0 + (unsigned)__popcll(bt & lt_mask);
        if (take && pp < 256u) mysel[pp] = ci[q];
        pos0 += (unsigned)__popcll(bt);
        eqtaken += (unsigned)__popcll(beq);
      }
    } else {
      unsigned prefix = 0u, krem = 256u;
#pragma unroll 1
      for (int pass = 0; pass < 4; ++pass) {
        const int shift = 24 - 8 * pass;
        const unsigned himask = (pass == 0) ? 0u : (0xFFFFFFFFu << (shift + 8));
#pragma unroll
        for (int i = 0; i < 4; ++i) myh[lane + 64 * i] = 0u;
        lds_fence();
        for (int i = lane; i < n; i += 64) {
          const unsigned u = sortable_key(rowf[i]);
          if ((u & himask) == prefix) atomicAdd(&myh[(u >> shift) & 255u], 1u);
        }
        lds_fence();
        const uint4 c4 = *(const uint4*)(myh + 4 * lane);
        const unsigned c = c4.x + c4.y + c4.z + c4.w;
        unsigned sfx = c;
#pragma unroll
        for (int o = 1; o < 64; o <<= 1) { const unsigned tt = __shfl_down(sfx, o); if (lane + o < 64) sfx += tt; }
        const unsigned long long bal = __ballot(sfx >= krem);
        const int L = 63 - __clzll(bal);
        const unsigned sL = __shfl(sfx, L), cL = __shfl(c, L);
        const unsigned b3 = __shfl(c4.w, L), b2 = __shfl(c4.z, L), b1 = __shfl(c4.y, L);
        unsigned cum2 = sL - cL;
        unsigned digit;
        if (cum2 + b3 >= krem) digit = 3;
        else { cum2 += b3; if (cum2 + b2 >= krem) digit = 2; else { cum2 += b2; if (cum2 + b1 >= krem) digit = 1; else { cum2 += b1; digit = 0; } } }
        krem -= cum2;
        prefix |= ((unsigned)(4 * L) + digit) << shift;
      }
      const unsigned T = prefix;
      unsigned base = 0u, eqtaken = 0u;
      for (int i0 = 0; i0 < n; i0 += 64) {
        const int i = i0 + lane;
        const bool valid = i < n;
        const unsigned u = valid ? sortable_key(rowf[i]) : 0u;
        const bool gt = valid && (u > T);
        const bool eq = valid && (u == T);
        const unsigned long long beq = __ballot(eq);
        const unsigned eqrank = eqtaken + (unsigned)__popcll(beq & lt_mask);
        const bool take = gt || (eq && eqrank < krem);
        const unsigned long long bt = __ballot(take);
        const unsigned pos = base + (unsigned)__popcll(bt & lt_mask);
        if (take && pos < 256u) mysel[pos] = (unsigned short)i;
        base += (unsigned)__popcll(bt);
        eqtaken += (unsigned)__popcll(beq);
      }
    }
  }
  lds_fence();
  if (lane == 0) { rmm[w] = 0xFFFFFFFFu; rmm[8 + w] = 0u; }
  lds_fence();
  {
    const uint2 s4 = *(const uint2*)(mysel + 4 * lane);
    const int sj[4] = {(int)(s4.x & 0xffffu), (int)(s4.x >> 16), (int)(s4.y & 0xffffu), (int)(s4.y >> 16)};
    unsigned pk = 0u;
#pragma unroll
    for (int j = 0; j < 4; ++j) {
      const bool valid = 4 * lane + j < cnt;
      const int dist = valid ? t - sj[j] : 0;
      unsigned bk = dist < 128 ? (unsigned)bkt[dist] : 31u;
      bk = valid ? bk : 32u;
      pk |= bk << (8 * j);
    }
    bks[w * 64 + lane] = pk;
  }
  lds_fence();
  {
    int lane_a = lane;
    asm volatile("" : "+v"(lane_a));
    const int l15 = lane_a & 15, g = lane_a >> 4;
    const int ks = lane_a >> 3, dc = lane_a & 7;
    const unsigned char* kcb = (const unsigned char*)(kc + tokbase * 64);
    const unsigned char* vcb = (const unsigned char*)(vc + tokbase * 64);
    float* pl = (float*)row;
    const float* relb = (const float*)(bkt + 128);
    const int niter = (cnt + 7) >> 3;
    bf16x8 bq0 = (bf16x8){0, 0, 0, 0, 0, 0, 0, 0}, bq1 = bq0;
    if (l15 < 8) {
      bq0 = *(const bf16x8*)(pA + (tokbase + t) * 1024 + l15 * 64 + 8 * g);
      bq1 = *(const bf16x8*)(pA + (tokbase + t) * 1024 + l15 * 64 + 32 + 8 * g);
    }
    float lg[16][4];
    {
      bf16x8 ka[8][2], kb[8][2];
#pragma unroll
      for (int u = 0; u < 8; ++u) {
        const int kk = u * 16 + l15;
        const unsigned s = (unsigned)mysel[kk] & 4095u;
        const unsigned ko = s * 128u + 16u * (unsigned)g;
        ka[u][0] = *(const bf16x8*)(kcb + ko);
        ka[u][1] = *(const bf16x8*)(kcb + ko + 64u);
      }
#pragma unroll
      for (int u = 0; u < 8; ++u) {
        const int kk = (8 + u) * 16 + l15;
        const unsigned s = (unsigned)mysel[kk] & 4095u;
        const unsigned ko = s * 128u + 16u * (unsigned)g;
        kb[u][0] = *(const bf16x8*)(kcb + ko);
        kb[u][1] = *(const bf16x8*)(kcb + ko + 64u);
      }
      __builtin_amdgcn_sched_barrier(0);
#pragma unroll
      for (int u = 0; u < 8; ++u) {
        f32x4 acc = (f32x4){0.f, 0.f, 0.f, 0.f};
        acc = __builtin_amdgcn_mfma_f32_16x16x32_bf16(ka[u][0], bq0, acc, 0, 0, 0);
        acc = __builtin_amdgcn_mfma_f32_16x16x32_bf16(ka[u][1], bq1, acc, 0, 0, 0);
        lg[u][0] = acc[0]; lg[u][1] = acc[1]; lg[u][2] = acc[2]; lg[u][3] = acc[3];
      }
#pragma unroll
      for (int u = 0; u < 8; ++u) {
        f32x4 acc = (f32x4){0.f, 0.f, 0.f, 0.f};
        acc = __builtin_amdgcn_mfma_f32_16x16x32_bf16(kb[u][0], bq0, acc, 0, 0, 0);
        acc = __builtin_amdgcn_mfma_f32_16x16x32_bf16(kb[u][1], bq1, acc, 0, 0, 0);
        lg[8 + u][0] = acc[0]; lg[8 + u][1] = acc[1]; lg[8 + u][2] = acc[2]; lg[8 + u][3] = acc[3];
      }
    }
    typedef unsigned u32x4_t __attribute__((ext_vector_type(4)));
    u32x4_t va[16];
#pragma unroll
    for (int u = 0; u < 16; ++u) {
      const int kk = u * 8 + ks;
      const unsigned s = (unsigned)mysel[kk] & 4095u;
      va[u] = *(const u32x4_t*)(vcb + s * 128u + 16u * (unsigned)dc);
    }
    __builtin_amdgcn_sched_barrier(0);
    const int hsel = l15 & 7;
    float m = -INFINITY;
    const unsigned* mybks = bks + w * 64;
#pragma unroll
    for (int u = 0; u < 16; ++u) {
      const unsigned bk4 = mybks[4 * u + g];
#pragma unroll
      for (int j = 0; j < 4; ++j) {
        lg[u][j] = lg[u][j] * 0.125f + relb[((bk4 >> (8 * j)) & 255u) * 8 + hsel];
        m = fmaxf(m, lg[u][j]);
      }
    }
    m = max_xor16(m); m = max_xor32(m);
    float sum = 0.f;
#pragma unroll
    for (int u = 0; u < 16; ++u)
#pragma unroll
      for (int j = 0; j < 4; ++j) { lg[u][j] = __expf(lg[u][j] - m); sum += lg[u][j]; }
    sum = add_xor16(sum); sum = add_xor32(sum);
    const float inv = 1.f / sum;
    bf16x8 pa[8];
#pragma unroll
    for (int s8 = 0; s8 < 8; ++s8) {
      const unsigned w0 = pack2(lg[2 * s8][0] * inv, lg[2 * s8][1] * inv), w1 = pack2(lg[2 * s8][2] * inv, lg[2 * s8][3] * inv);
      const unsigned w2 = pack2(lg[2 * s8 + 1][0] * inv, lg[2 * s8 + 1][1] * inv), w3 = pack2(lg[2 * s8 + 1][2] * inv, lg[2 * s8 + 1][3] * inv);
      const u32x4_t wv = {w0, w1, w2, w3};
      pa[s8] = __builtin_bit_cast(bf16x8, wv);
    }
    unsigned char* vs_l = (unsigned char*)row;
    const unsigned vst_off = (unsigned)(ks * 128 + ((dc ^ (((ks >> 1) & 3) << 1)) << 4));
#pragma unroll
    for (int u = 0; u < 16; ++u) *(u32x4_t*)(vs_l + u * 1024 + vst_off) = va[u];
    lds_fence();
    u32x4_t vb[16];
#pragma unroll
    for (int u = 0; u < 16; ++u) {
      const int kk = (16 + u) * 8 + ks;
      const unsigned s = (unsigned)mysel[kk] & 4095u;
      vb[u] = *(const u32x4_t*)(vcb + s * 128u + 16u * (unsigned)dc);
    }
    __builtin_amdgcn_sched_barrier(0);
    f32x4 ov[4];
#pragma unroll
    for (int nt = 0; nt < 4; ++nt) ov[nt] = (f32x4){0.f, 0.f, 0.f, 0.f};
    typedef short v4s_t __attribute__((ext_vector_type(4)));
    const unsigned tr_lane = (unsigned)((l15 >> 2) * 128 + (l15 & 3) * 8);
    const unsigned tr_k = (unsigned)(((g & 1) << 1) | (l15 >> 3));
    unsigned tr_off[4];
#pragma unroll
    for (int nt = 0; nt < 4; ++nt) tr_off[nt] = tr_lane + (((unsigned)nt ^ tr_k) << 5);
#define PV_HALF(S0) do { \
      _Pragma("unroll") for (int s4_ = 0; s4_ < 4; ++s4_) { \
        _Pragma("unroll") for (int nt = 0; nt < 4; ++nt) { \
          const unsigned a0 = (unsigned)((s4_ * 32 + 4 * g) * 128) + tr_off[nt]; \
          const v4s_t b0 = __builtin_amdgcn_ds_read_tr16_b64_v4i16((__attribute__((address_space(3))) v4s_t*)(vs_l + a0)); \
          const v4s_t b1 = __builtin_amdgcn_ds_read_tr16_b64_v4i16((__attribute__((address_space(3))) v4s_t*)(vs_l + a0 + 16 * 128)); \
          const bf16x8 bb = (bf16x8){b0[0], b0[1], b0[2], b0[3], b1[0], b1[1], b1[2], b1[3]}; \
          ov[nt] = __builtin_amdgcn_mfma_f32_16x16x32_bf16(pa[(S0) + s4_], bb, ov[nt], 0, 0, 0); \
        } \
      } \
    } while (0)
    PV_HALF(0);
    lds_fence();
#pragma unroll
    for (int u = 0; u < 16; ++u) *(u32x4_t*)(vs_l + u * 1024 + vst_off) = vb[u];
    lds_fence();
    PV_HALF(4);
#undef PV_HALF
    if (g < 2) {
#pragma unroll
      for (int nt = 0; nt < 4; ++nt)
#pragma unroll
        for (int j = 0; j < 4; ++j) yb[(tokbase + t) * 1024 + (4 * g + j) * 64 + nt * 16 + l15] = f2bf(ov[nt][j]);
    }
    lds_fence();
  }
  __syncthreads();
}

__device__ __forceinline__ void phase_mix(const Params& p, unsigned char* smem, int mode = 0) {
  const int G = gridDim.x;
  if (mode != 2) { for (int bh = blockIdx.x; bh < 32; bh += G) { hgrn_h2(p, smem, bh); __syncthreads(); } }
  if (mode == 1) return;
  unsigned char* bkt = smem + DSA_BKT_OFF;
  volatile int* qslot = (volatile int*)(smem + LDS_BYTES - 32);
  unsigned* qctr = (unsigned*)(p.ws + WS_QCTR);
  if (threadIdx.x < 128) {
    const int nn = threadIdx.x;
    int v = nn;
    if (nn >= 16) { v = 16 + (int)(logf((float)nn * (1.f / 16.f)) / logf(8.f) * 16.f); if (v > 31) v = 31; }
    bkt[nn] = (unsigned char)v;
  }
  if (threadIdx.x >= 256) ((float*)(bkt + 128))[threadIdx.x - 256] = p.rel_bias[threadIdx.x - 256];
  if (threadIdx.x >= 128 && threadIdx.x < 136) ((float*)(bkt + 128))[256 + threadIdx.x - 128] = -INFINITY;
  if (threadIdx.x < 16) ((unsigned*)(bkt + 128 + 1056))[threadIdx.x] = threadIdx.x < 8 ? 0xFFFFFFFFu : 0u;
  const int my_team = (G % 8 == 0) ? team_index(p, smem) / (G >> 3) : (int)(blockIdx.x & 7);
  constexpr int QN = 544;
#define Q_FETCH(SLOT) do { if (threadIdx.x == 0) { int tm_ = q_team, kk_ = -1; \
      for (int tries_ = 0; tries_ < 8; ++tries_) { \
        const unsigned v_ = __hip_atomic_fetch_add(qctr + 16 * tm_, 1u, __ATOMIC_RELAXED, __HIP_MEMORY_SCOPE_AGENT); \
        if (v_ < (unsigned)QN) { kk_ = (tm_ << 16) | (int)v_; break; } \
        tm_ = (tm_ + 1) & 7; } \
      q_team = tm_; qslot[SLOT] = kk_; } } while (0)
  int q_team = my_team;
  Q_FETCH(0);
  __syncthreads();
  int k = qslot[0];
  int par = 1;
  while (k >= 0) {
    Q_FETCH(par);
    const int bt = k >> 16, kl = k & 0xffff;
    const int kq = kl / 17, kr = kl - kq * 17;
    if (kr < 16) {
      const int tb = 511 - (kq * 16 + kr);
      dsa_item(p, smem, (bt << 9) | tb);
    } else {
      const int r0 = (bt * 32 + kq) * 64;
      quantize_rows_u8<false, true>(p.peer_u, p.ws + WS_U, (float*)(p.ws + WS_U + (size_t)16384 * 1024), r0, r0 + 64);
      quantize_rows_u8<true, true>(p.peer_v, p.ws + WS_V, (float*)(p.ws + WS_V + (size_t)16384 * 1024), r0, r0 + 64);
      __syncthreads();
    }
    k = qslot[par];
    par ^= 1;
  }
#undef Q_FETCH
}

__device__ __forceinline__ void phase_pkeys(const Params& p, unsigned char* smem) {
  unsigned char* ws = p.ws;
  const bf16_t* qp = (const bf16_t*)(ws + WS_PG);
  const bf16_t* keys = (const bf16_t*)(ws + WS_KEYS);
  int* eidx = (int*)(ws + WS_EIDX);
  float* gw = (float*)(ws + WS_GW);
  float* sc = (float*)smem;
  float* s2l = (float*)smem;
  unsigned short* i1l = (unsigned short*)(s2l + 256 * 17);
  unsigned short* i2l = i1l + 256 * 16;
  const int tid = threadIdx.x, lane = tid & 63, w = tid >> 6, wm = w >> 1, wn = w & 1, l15 = lane & 15, g = lane >> 4;
  for (int item = blockIdx.x; item < 128 * 8; item += gridDim.x) {
    const int h = item & 7, tm = item >> 3;
    float s1[16], s2v[16]; int i1[16], i2[16];
#pragma unroll
    for (int ph = 0; ph < 2; ++ph) {
      const int hp = h * 2 + ph;
      f32x4 acc[4][4]; zero_acc(acc);
      gemm_tile(qp + (size_t)tm * 256 * 2048 + hp * 128, 2048, keys + (size_t)(ph * 8 + h) * 128 * 128, 128, 2, acc, smem);
      __syncthreads();
#pragma unroll
      for (int m = 0; m < 4; ++m)
#pragma unroll
        for (int n = 0; n < 4; ++n)
#pragma unroll
          for (int j = 0; j < 4; ++j) sc[(wm * 64 + m * 16 + 4 * g + j) * 129 + wn * 64 + n * 16 + l15] = acc[m][n][j];
      __syncthreads();
      if (tid < 256) {
        const float* rowp = sc + tid * 129;
        unsigned tv[16];
#pragma unroll
        for (int k = 0; k < 16; ++k) tv[k] = 0u;
#pragma unroll 8
        for (int nn = 0; nn < 128; ++nn) {
          const unsigned bits = __float_as_uint(rowp[nn]);
          unsigned key = (bits & 0x80000000u) ? ~bits : (bits | 0x80000000u);
          key = (key & ~127u) | (unsigned)(127 - nn);
#pragma unroll
          for (int k = 15; k >= 1; --k) {
            unsigned r;
            asm("v_med3_u32 %0, %1, %2, %3" : "=v"(r) : "v"(tv[k]), "v"(tv[k - 1]), "v"(key));
            tv[k] = r;
          }
          tv[0] = tv[0] > key ? tv[0] : key;
        }
#pragma unroll
        for (int k = 0; k < 16; ++k) {
          const int col = 127 - (int)(tv[k] & 127u);
          const float val = rowp[col];
          if (ph == 0) { i1[k] = col; s1[k] = val; } else { i2[k] = col; s2v[k] = val; }
        }
      }
      __syncthreads();
    }
    if (tid < 256) {
#pragma unroll
      for (int a = 0; a < 16; ++a) { s2l[tid * 17 + a] = s2v[a]; i1l[tid * 16 + a] = (unsigned short)i1[a]; i2l[tid * 16 + a] = (unsigned short)i2[a]; }
      float cur[16];
#pragma unroll
      for (int a = 0; a < 16; ++a) cur[a] = s1[a] + s2v[0];
      unsigned long long ptr = 0ull;
      float tops[16]; int tope[16];
#pragma unroll
      for (int k = 0; k < 16; ++k) {
        float best = cur[0]; int ba = 0;
#pragma unroll
        for (int a = 1; a < 16; ++a) if (cur[a] > best) { best = cur[a]; ba = a; }
        const int bb = (int)((ptr >> (4 * ba)) & 15ull);
        tops[k] = best;
        tope[k] = (int)i1l[tid * 16 + ba] * 128 + (int)i2l[tid * 16 + bb];
        const int nb = bb + 1;
        const float ns2 = (nb < 16) ? s2l[tid * 17 + nb] : -INFINITY;
        if (nb < 16) ptr += (1ull << (4 * ba));
#pragma unroll
        for (int a = 0; a < 16; ++a) if (a == ba) cur[a] = s1[a] + ns2;
      }
      const float m = tops[0];
      float sum = 0.f;
#pragma unroll
      for (int k = 0; k < 16; ++k) { tops[k] = __expf(tops[k] - m); sum += tops[k]; }
      const float inv = 1.f / sum;
      const size_t ob = ((size_t)(tm * 256 + tid) * 8 + h) * 16;
#pragma unroll
      for (int k = 0; k < 16; k += 4) {
        *(int4*)(eidx + ob + k) = make_int4(tope[k], tope[k + 1], tope[k + 2], tope[k + 3]);
        *(float4*)(gw + ob + k) = make_float4(tops[k] * inv, tops[k + 1] * inv, tops[k + 2] * inv, tops[k + 3] * inv);
      }
    }
    __syncthreads();
  }
}


__device__ __forceinline__ float reduce8(const float (&pv)[8], int lane) {
  const bool b5 = lane & 32, b4 = lane & 16, b3 = lane & 8;
  float v[4];
#pragma unroll
  for (int i = 0; i < 4; ++i) {
    const float keep = b5 ? pv[4 + i] : pv[i];
    const float send = b5 ? pv[i] : pv[4 + i];
    v[i] = keep + __shfl_xor(send, 32);
  }
  float u[2];
#pragma unroll
  for (int i = 0; i < 2; ++i) {
    const float keep = b4 ? v[2 + i] : v[i];
    const float send = b4 ? v[i] : v[2 + i];
    u[i] = keep + __shfl_xor(send, 16);
  }
  float x = (b3 ? u[1] : u[0]) + __shfl_xor(b3 ? u[0] : u[1], 8);
  x += __shfl_xor(x, 4); x += __shfl_xor(x, 2); x += __shfl_xor(x, 1);
  return x;
}

__device__ __forceinline__ void cvt16u8(const uint4& v, float* f) {
  f[0] = (float)(v.x & 0xffu); f[1] = (float)((v.x >> 8) & 0xffu); f[2] = (float)((v.x >> 16) & 0xffu); f[3] = (float)(v.x >> 24);
  f[4] = (float)(v.y & 0xffu); f[5] = (float)((v.y >> 8) & 0xffu); f[6] = (float)((v.y >> 16) & 0xffu); f[7] = (float)(v.y >> 24);
  f[8] = (float)(v.z & 0xffu); f[9] = (float)((v.z >> 8) & 0xffu); f[10] = (float)((v.z >> 16) & 0xffu); f[11] = (float)(v.z >> 24);
  f[12] = (float)(v.w & 0xffu); f[13] = (float)((v.w >> 8) & 0xffu); f[14] = (float)((v.w >> 16) & 0xffu); f[15] = (float)(v.w >> 24);
}

__device__ __forceinline__ int wave_sum_i32_dpp(int v) {
  v += __builtin_amdgcn_update_dpp(0, v, 0xB1, 0xf, 0xf, true);
  v += __builtin_amdgcn_update_dpp(0, v, 0x4E, 0xf, 0xf, true);
  v += __builtin_amdgcn_update_dpp(0, v, 0x141, 0xf, 0xf, true);
  v += __builtin_amdgcn_update_dpp(0, v, 0x140, 0xf, 0xf, true);
  return __builtin_amdgcn_readlane(v, 0) + __builtin_amdgcn_readlane(v, 16) + __builtin_amdgcn_readlane(v, 32) + __builtin_amdgcn_readlane(v, 48);
}

__device__ __forceinline__ int reduce8_i32_scatter(const int (&d)[8], int lane) {
  const bool b0 = lane & 1, b1 = lane & 2, b2 = lane & 4;
  int v[4];
#pragma unroll
  for (int i = 0; i < 4; ++i) {
    const int keep = b0 ? d[2 * i + 1] : d[2 * i];
    const int send = b0 ? d[2 * i] : d[2 * i + 1];
    v[i] = keep + __builtin_amdgcn_update_dpp(0, send, 0xB1, 0xf, 0xf, true);
  }
  int u[2];
#pragma unroll
  for (int i = 0; i < 2; ++i) {
    const int keep = b1 ? v[2 * i + 1] : v[2 * i];
    const int send = b1 ? v[2 * i] : v[2 * i + 1];
    u[i] = keep + __builtin_amdgcn_update_dpp(0, send, 0x4E, 0xf, 0xf, true);
  }
  int x;
  {
    const int keep = b2 ? u[1] : u[0];
    const int send = b2 ? u[0] : u[1];
    int t = __builtin_amdgcn_update_dpp(0, send, 0x141, 0xf, 0xf, true);
    t = __builtin_amdgcn_update_dpp(0, t, 0x1B, 0xf, 0xf, true);
    x = keep + t;
  }
  x += __builtin_amdgcn_update_dpp(0, x, 0x128, 0xf, 0xf, true);
  { const auto r = __builtin_amdgcn_permlane16_swap((unsigned)x, (unsigned)x, false, false); x = (int)r[0] + (int)r[1]; }
  { const auto r = __builtin_amdgcn_permlane32_swap((unsigned)x, (unsigned)x, false, false); x = (int)r[0] + (int)r[1]; }
  return x;
}

__device__ __forceinline__ void phase_pu(const Params& p, unsigned char* smem) {
  unsigned char* ws = p.ws;
  const unsigned char* XQ = ws + WS_XQ;
  const float* xs = (const float*)(ws + WS_XS);
  const unsigned char* U8 = ws + WS_U;
  const float* us = (const float*)(ws + WS_U + (size_t)16384 * 1024);
  const float* vs = (const float*)(ws + WS_V + (size_t)16384 * 1024);
  const int* eidx = (const int*)(ws + WS_EIDX);
  const float* gw = (const float*)(ws + WS_GW);
  float* aw = (float*)(ws + WS_PA);
  const int lane = threadIdx.x & 63, w = threadIdx.x >> 6;
  const unsigned long long lt_mask = (1ull << lane) - 1ull;
  const int G = gridDim.x;
  const bool sliced = (G % 8 == 0);
  const int ti = sliced ? team_index(p, smem) : 0;
  const int tsz = sliced ? (G >> 3) : G;
  const int grp_lo = sliced ? ti / tsz : 0, grp_hi = sliced ? grp_lo + 1 : 8;
  const int slot = (sliced ? (ti % tsz) : (int)blockIdx.x) * 8 + w;
  const int nslot = tsz * 8;
  unsigned* lst = (unsigned*)smem + 4096 + w * 128;
  typedef unsigned u32x4_t __attribute__((ext_vector_type(4)));
  if (slot >= TOK) return;
  for (int grp = grp_lo; grp < grp_hi; ++grp) {
#define PU_LIST(E0, E1, N, L0, L1) do { \
      const bool m0_ = ((E0) >> 11) == grp, m1_ = ((E1) >> 11) == grp; \
      const unsigned long long b0_ = __ballot(m0_), b1_ = __ballot(m1_); \
      const int c0_ = __popcll(b0_); N = c0_ + __popcll(b1_); \
      if (m0_) lst[__popcll(b0_ & lt_mask)] = ((unsigned)lane << 14) | (unsigned)(E0); \
      if (m1_) lst[c0_ + __popcll(b1_ & lt_mask)] = ((unsigned)(lane + 64) << 14) | (unsigned)(E1); \
      lds_fence(); \
      L0 = (lane < N) ? lst[lane] : 0u; L1 = (lane + 64 < N) ? lst[lane + 64] : 0u; \
      lds_fence(); } while (0)
#define PU_ISSUE(BUF, L0, N, I0) do { int last_ = ((N) < 64 ? (N) : 64) - 1; last_ = last_ < 0 ? 0 : last_; \
      _Pragma("unroll") for (int j = 0; j < 8; ++j) { int idx_ = (I0) + j; idx_ = idx_ < last_ ? idx_ : last_; \
        const unsigned le_ = (unsigned)__builtin_amdgcn_readlane((int)(L0), idx_); \
        BUF[j] = *(const u32x4_t*)(U8 + (size_t)(le_ & 16383u) * 1024 + lane * 16); } } while (0)
#define PU_REDUCE(BUF, X, I0, HREG) do { int dd_[8]; _Pragma("unroll") for (int j = 0; j < 8; ++j) { \
        int d_ = __builtin_amdgcn_sdot4((int)BUF[j].x, (int)(X).x, 0, false); \
        d_ = __builtin_amdgcn_sdot4((int)BUF[j].y, (int)(X).y, d_, false); \
        d_ = __builtin_amdgcn_sdot4((int)BUF[j].z, (int)(X).z, d_, false); \
        dd_[j] = __builtin_amdgcn_sdot4((int)BUF[j].w, (int)(X).w, d_, false); } \
      const int tot_ = reduce8_i32_scatter(dd_, lane);     \
      if (lane >= (I0) && lane < (I0) + 8) HREG = tot_; } while (0)
    u32x4_t cx = *(const u32x4_t*)(XQ + (size_t)slot * 1024 + lane * 16);
    int ce0 = eidx[(size_t)slot * 128 + lane], ce1 = eidx[(size_t)slot * 128 + 64 + lane];
    float cxs = xs[slot];
    int cn; unsigned cl0, cl1;
    PU_LIST(ce0, ce1, cn, cl0, cl1);
    u32x4_t ra[8], rb[8], rc[8];
    PU_ISSUE(ra, cl0, cn, 0);
    PU_ISSUE(rb, cl0, cn, 8);
    int t1 = (slot + nslot < TOK) ? slot + nslot : slot;
    u32x4_t nx = *(const u32x4_t*)(XQ + (size_t)t1 * 1024 + lane * 16);
    int ne0 = eidx[(size_t)t1 * 128 + lane], ne1 = eidx[(size_t)t1 * 128 + 64 + lane];
    float nxs = xs[t1];
    for (int tok = slot; tok < TOK; tok += nslot) {
      float sc0 = 0.f, sc1 = 0.f, gv0 = 0.f, gv1 = 0.f, vv0 = 0.f, vv1 = 0.f;
      if (lane < cn) { const int e = cl0 & 16383; sc0 = us[e]; vv0 = vs[e]; gv0 = gw[(size_t)tok * 128 + (cl0 >> 14)]; }
      if (lane + 64 < cn) { const int e = cl1 & 16383; sc1 = us[e]; vv1 = vs[e]; gv1 = gw[(size_t)tok * 128 + (cl1 >> 14)]; }
      int nn; unsigned nl0, nl1;
      PU_LIST(ne0, ne1, nn, nl0, nl1);
      const u32x4_t x1 = nx; const int xe0 = ne0, xe1 = ne1; const float xs1 = nxs;
      const int t2a = tok + nslot, t2 = (t2a + nslot < TOK) ? t2a + nslot : ((t2a < TOK) ? t2a : tok);
      nx = *(const u32x4_t*)(XQ + (size_t)t2 * 1024 + lane * 16);
      ne0 = eidx[(size_t)t2 * 128 + lane]; ne1 = eidx[(size_t)t2 * 128 + 64 + lane];
      nxs = xs[t2];
      int h0i = 0, h1i = 0;
      const bool third = cn > 16;
      if (third) { PU_ISSUE(rc, cl0, cn, 16); }
      __builtin_amdgcn_sched_barrier(0); PU_REDUCE(ra, cx, 0, h0i);  __builtin_amdgcn_sched_barrier(0);
      PU_ISSUE(ra, nl0, nn, 0);  __builtin_amdgcn_sched_barrier(0); PU_REDUCE(rb, cx, 8, h0i);  __builtin_amdgcn_sched_barrier(0);
      PU_ISSUE(rb, nl0, nn, 8);  __builtin_amdgcn_sched_barrier(0);
      if (third) { PU_REDUCE(rc, cx, 16, h0i); }
      __builtin_amdgcn_sched_barrier(0);
      if (cn > 24) {
        for (int i0 = 24; i0 < cn; i0 += 8) {
          u32x4_t rd[8];
          const bool lo = i0 < 64;
          const unsigned lsrc = lo ? cl0 : cl1;
          const int nsrc = lo ? cn : cn - 64;
          PU_ISSUE(rd, lsrc, nsrc, i0 & 63);
          if (lo) { PU_REDUCE(rd, cx, i0, h0i); } else { PU_REDUCE(rd, cx, i0 - 64, h1i); }
        }
      }
      const float h0 = (float)h0i * sc0 * cxs, h1 = (float)h1i * sc1 * cxs;
      if (lane < cn) aw[(size_t)tok * 128 + (cl0 >> 14)] = 0.5f * h0 * (1.f + erff(h0 * 0.70710678118654752f)) * gv0 * vv0;
      if (lane + 64 < cn) aw[(size_t)tok * 128 + (cl1 >> 14)] = 0.5f * h1 * (1.f + erff(h1 * 0.70710678118654752f)) * gv1 * vv1;
      cx = x1; ce0 = xe0; ce1 = xe1; cxs = xs1; cn = nn; cl0 = nl0; cl1 = nl1;
    }
#undef PU_LIST
#undef PU_ISSUE
#undef PU_REDUCE
  }
}

template <bool SL>
__device__ __forceinline__ void phase_pv_t(const Params& p, unsigned char* smem) {
  unsigned char* ws = p.ws;
  const unsigned char* V8 = ws + WS_V;
  const int* eidx = (const int*)(ws + WS_EIDX);
  const float* aw = (const float*)(ws + WS_PA);
  float* ssq = (float*)(ws + WS_SSQ);
  const int lane = threadIdx.x & 63, w = threadIdx.x >> 6;
  const int q = lane >> 3, c = lane & 7;
  const int G = gridDim.x;
  constexpr bool sliced = SL;
  const int ti = sliced ? team_index(p, smem) : 0;
  const int tsz = G >> 3;
  const int grp0 = sliced ? (ti / tsz) : 0;
  constexpr int ngrp = sliced ? 1 : 8;
  const int slot = sliced ? (ti % tsz) * 8 + w : blockIdx.x * 8 + w;
  const int nslot = sliced ? tsz * 8 : G * 8;
  int ee[16]; float aa[16];
  if (slot < TOK) {
    unsigned bi = (unsigned)slot * 128u + 16u * (unsigned)q;
    asm volatile("" : "+v"(bi));
#pragma unroll
    for (int u4 = 0; u4 < 4; ++u4) {
      const int4 e4 = *(const int4*)(eidx + bi + 4 * u4); const float4 a4 = *(const float4*)(aw + bi + 4 * u4);
      ee[4 * u4] = e4.x; ee[4 * u4 + 1] = e4.y; ee[4 * u4 + 2] = e4.z; ee[4 * u4 + 3] = e4.w;
      aa[4 * u4] = a4.x; aa[4 * u4 + 1] = a4.y; aa[4 * u4 + 2] = a4.z; aa[4 * u4 + 3] = a4.w;
    }
  }
  for (int tok = slot; tok < TOK; tok += nslot) {
    int ce[16]; float ca[16];
    float suma = 0.f;
#pragma unroll
    for (int u = 0; u < 16; ++u) { ce[u] = ee[u]; ca[u] = aa[u]; suma += aa[u]; }
    for (int gi = 0; gi < ngrp; ++gi) {
      const int grp = grp0 + gi;
      uint4 vv[16];
#pragma unroll
      for (int u = 0; u < 16; ++u) vv[u] = *(const uint4*)(V8 + (size_t)grp * (16384 * 128) + (size_t)ce[u] * 128 + c * 16);
      float* orow = p.out + (size_t)tok * 1024 + grp * 128 + c * 16;
      float4 x1v[4];
#pragma unroll
      for (int i = 0; i < 4; ++i) x1v[i] = *(const float4*)(orow + 4 * i);
      if (gi == ngrp - 1) {
        const int nt = (tok + nslot < TOK) ? tok + nslot : tok;
        unsigned bi = (unsigned)nt * 128u + 16u * (unsigned)q;
        asm volatile("" : "+v"(bi));
#pragma unroll
        for (int u4 = 0; u4 < 4; ++u4) {
          const int4 e4 = *(const int4*)(eidx + bi + 4 * u4); const float4 a4 = *(const float4*)(aw + bi + 4 * u4);
          ee[4 * u4] = e4.x; ee[4 * u4 + 1] = e4.y; ee[4 * u4 + 2] = e4.z; ee[4 * u4 + 3] = e4.w;
          aa[4 * u4] = a4.x; aa[4 * u4 + 1] = a4.y; aa[4 * u4 + 2] = a4.z; aa[4 * u4 + 3] = a4.w;
        }
      }
      __builtin_amdgcn_sched_barrier(0);
      float acc[16];
#pragma unroll
      for (int i = 0; i < 16; ++i) acc[i] = -128.f * suma;
#pragma unroll
      for (int u = 0; u < 16; ++u) {
        float vf[16];
        cvt16u8(vv[u], vf);
#pragma unroll
        for (int i = 0; i < 16; ++i) acc[i] += ca[u] * vf[i];
        __builtin_amdgcn_sched_barrier(0);
      }
#pragma unroll
      for (int i = 0; i < 16; ++i) { acc[i] = add_xor8(acc[i]); acc[i] = add_xor16(acc[i]); acc[i] = add_xor32(acc[i]); }
      float ss = 0.f;
      if (q == 0) {
#pragma unroll
        for (int i = 0; i < 4; ++i) {
          const float4 oa = make_float4(x1v[i].x + acc[4 * i], x1v[i].y + acc[4 * i + 1], x1v[i].z + acc[4 * i + 2], x1v[i].w + acc[4 * i + 3]);
          *(float4*)(orow + 4 * i) = oa;
          ss += oa.x * oa.x + oa.y * oa.y + oa.z * oa.z + oa.w * oa.w;
        }
      }
      ss += __shfl_xor(ss, 1); ss += __shfl_xor(ss, 2); ss += __shfl_xor(ss, 4);
      if (lane == 0) atomicAdd(&ssq[tok], ss);
    }
  }
}

__device__ __forceinline__ void phase_pv_mfma(const Params& p, unsigned char* smem) {
  unsigned char* ws = p.ws;
  const unsigned char* V8 = ws + WS_V;
  const int* eidx = (const int*)(ws + WS_EIDX);
  const float* aw = (const float*)(ws + WS_PA);
  float* ssq = (float*)(ws + WS_SSQ);
  const int lane = threadIdx.x & 63, w = threadIdx.x >> 6;
  const int q8 = lane >> 3, c = lane & 7;
  const int l15 = lane & 15, g = lane >> 4;
  const int G = gridDim.x;
  const bool sliced = (G % 8 == 0);
  const int ti = sliced ? team_index(p, smem) : 0;
  const int tsz = sliced ? (G >> 3) : G;
  const int grp_lo = sliced ? ti / tsz : 0, grp_hi = sliced ? grp_lo + 1 : 8;
  const int slot = (sliced ? (ti % tsz) : (int)blockIdx.x) * 8 + w;
  const int nslot = tsz * 8;
  if (slot >= TOK) return;
  unsigned char* vs_l = smem + 16384 + w * 16384;
  typedef unsigned u32x4_t __attribute__((ext_vector_type(4)));
  typedef float f32x4_t __attribute__((ext_vector_type(4)));
  typedef int i32x4_t __attribute__((ext_vector_type(4)));
  typedef int i32x2_t __attribute__((ext_vector_type(2)));
  const unsigned tr_f16 = (unsigned)((((l15 >> 2) & 3) | ((g & 1) << 2)) << 4);
  const unsigned tr_lane = (unsigned)((l15 >> 1) * 128 + (l15 & 1) * 8);
  unsigned tr_off[8];
#pragma unroll
  for (int nt = 0; nt < 8; ++nt) tr_off[nt] = tr_lane + (((unsigned)nt << 4) ^ tr_f16);
  unsigned st_off[4];
#pragma unroll
  for (int cu = 0; cu < 4; ++cu) st_off[cu] = (unsigned)(16 * q8 * 128 + (((c ^ ((q8 & 1) << 2)) ^ cu) << 4));
  unsigned char* cf_l = smem + 4096 + w * 128;
  const unsigned coff = (unsigned)c * 16u;
  for (int grp_v = grp_lo; grp_v < grp_hi; ++grp_v) {
    const int grp = __builtin_amdgcn_readfirstlane(grp_v);
    const unsigned char* Vg = V8 + (size_t)grp * (16384 * 128);
    i32x4_t ee[4]; float2 a2;
#define PVM_META(TOKEN) do { \
      const i32x4_t* ep_ = (const i32x4_t*)(eidx + (size_t)(TOKEN) * 128 + 16 * q8); \
      _Pragma("unroll") for (int u4 = 0; u4 < 4; ++u4) ee[u4] = ep_[u4]; \
      a2 = *(const float2*)(aw + (size_t)(TOKEN) * 128 + 2 * lane); } while (0)
    PVM_META(slot);
    for (int tok = slot; tok < TOK; tok += nslot) {
      u32x4_t vv[16];
#pragma unroll
      for (int u = 0; u < 16; ++u) vv[u] = *(const u32x4_t*)(Vg + ((((unsigned)ee[u >> 2][u & 3]) << 7) | coff));
      bf16_t* orow = (bf16_t*)(ws + WS_X1) + (size_t)tok * 1024 + grp * 128 + 8 * l15;
      const u32x4_t x1r = *(const u32x4_t*)orow;
      float am = fmaxf(fabsf(a2.x), fabsf(a2.y));
#define PVM_DPPMAX(CTRL) am = fmaxf(am, __int_as_float(__builtin_amdgcn_update_dpp(0, __float_as_int(am), CTRL, 0xf, 0xf, true)))
      PVM_DPPMAX(0xB1); PVM_DPPMAX(0x4E); PVM_DPPMAX(0x141); PVM_DPPMAX(0x140);
#undef PVM_DPPMAX
      am = max_xor16(am); am = max_xor32(am);
      const float inva = am > 0.f ? 127.f * __builtin_amdgcn_rcpf(am) : 0.f, sa = am * (1.f / 127.f);
      {
        const unsigned b0 = (unsigned)(int)rintf(a2.x * inva) & 255u, b1 = (unsigned)(int)rintf(a2.y * inva) & 255u;
        *(unsigned short*)(cf_l + 2 * lane) = (unsigned short)(b0 | (b1 << 8));
      }
      { const int nt_ = (tok + nslot < TOK) ? tok + nslot : tok; PVM_META(nt_); }
      __builtin_amdgcn_sched_barrier(0);
#pragma unroll
      for (int u = 0; u < 16; ++u) *(u32x4_t*)(vs_l + st_off[(u >> 1) & 3] + u * 128) = vv[u];
      lds_fence();
      i32x4_t aop[2];
      aop[0] = *(const i32x4_t*)(cf_l + 16 * g); aop[1] = *(const i32x4_t*)(cf_l + 64 + 16 * g);
      i32x4_t acc[8];
#pragma unroll
      for (int nt = 0; nt < 8; ++nt) acc[nt] = (i32x4_t){0, 0, 0, 0};
#pragma unroll
      for (int s2 = 0; s2 < 2; ++s2)
#pragma unroll
        for (int nt = 0; nt < 8; ++nt) {
          const unsigned a0 = (unsigned)((s2 * 64 + 16 * g) * 128) + tr_off[nt];
          const i32x2_t lo = __builtin_amdgcn_ds_read_tr8_b64_v2i32((__attribute__((address_space(3))) i32x2_t*)(vs_l + a0));
          const i32x2_t hi = __builtin_amdgcn_ds_read_tr8_b64_v2i32((__attribute__((address_space(3))) i32x2_t*)(vs_l + a0 + 8 * 128));
          const i32x4_t bop = {lo[0], lo[1], hi[0], hi[1]};
          acc[nt] = __builtin_amdgcn_mfma_i32_16x16x64_i8(aop[s2], bop, acc[nt], 0, 0, 0);
        }
      lds_fence();
      float ss = 0.f;
      if (g == 0) {
        float o[8];
#pragma unroll
        for (int nt = 0; nt < 8; ++nt) {
          const float xv = (nt & 1) ? __uint_as_float(x1r[nt >> 1] & 0xffff0000u) : __uint_as_float(x1r[nt >> 1] << 16);
          o[nt] = xv + (float)acc[nt][0] * sa; ss += o[nt] * o[nt];
        }
        const u32x4_t ow = {pack2(o[0], o[1]), pack2(o[2], o[3]), pack2(o[4], o[5]), pack2(o[6], o[7])};
        *(u32x4_t*)orow = ow;
      }
      ss += __int_as_float(__builtin_amdgcn_update_dpp(0, __float_as_int(ss), 0xB1, 0xf, 0xf, true));
      ss += __int_as_float(__builtin_amdgcn_update_dpp(0, __float_as_int(ss), 0x4E, 0xf, 0xf, true));
      ss += __int_as_float(__builtin_amdgcn_update_dpp(0, __float_as_int(ss), 0x141, 0xf, 0xf, true));
      ss += __int_as_float(__builtin_amdgcn_update_dpp(0, __float_as_int(ss), 0x140, 0xf, 0xf, true));
      if (lane == 0) atomicAdd(&ssq[tok], ss);
    }
#undef PVM_META
  }
}

__device__ __forceinline__ void phase_final(const Params& p) {
  const float* ssq = (const float*)(p.ws + WS_SSQ);
  const int lane = threadIdx.x & 63, w = threadIdx.x >> 6;
  for (int row = blockIdx.x * 8 + w; row < TOK; row += gridDim.x * 8) {
    const float rstd = rsqrtf(ssq[row] * (1.f / DM) + EPSV);
    float4* o4 = (float4*)(p.out + (size_t)row * DM);
    const uint2* x2 = (const uint2*)((const bf16_t*)(p.ws + WS_X1) + (size_t)row * DM);
    uint2 xr[4];
#pragma unroll
    for (int i = 0; i < 4; ++i) xr[i] = x2[lane + 64 * i];
#pragma unroll
    for (int i = 0; i < 4; ++i) {
      const float4 gg = ((const float4*)p.norm_final)[lane + 64 * i];
      float4 v;
      v.x = __uint_as_float(xr[i].x << 16) * rstd * gg.x; v.y = __uint_as_float(xr[i].x & 0xffff0000u) * rstd * gg.y;
      v.z = __uint_as_float(xr[i].y << 16) * rstd * gg.z; v.w = __uint_as_float(xr[i].y & 0xffff0000u) * rstd * gg.w;
      o4[lane + 64 * i] = v;
    }
  }
}


__device__ __forceinline__ void phase_proj8(const Params& p, unsigned char* smem) {
  unsigned char* ws = p.ws;
  pg8::Gemm g{(const pg8::bf16_t*)(ws + WS_XN), (const pg8::bf16_t*)(ws + WS_WIN), TOK, 5120, 512};
  pg8::StaticOrder S; S.init(TOK, 5120, (int)gridDim.x, (int)blockIdx.x);
  EpiProj E{(unsigned short*)(ws + WS_PH), (unsigned short*)(ws + WS_PA), (unsigned short*)(ws + WS_PG),
            (unsigned short*)(ws + WS_KC), (unsigned short*)(ws + WS_VC), (unsigned short*)(ws + WS_IKC),
            (const float*)(ws + WS_XNS), (const float*)(ws + WS_WINS)};
  pg8::gemm_phase<EpiProj, pg8::StaticOrder, false, true>((PG8_LAS unsigned char*)smem, g, S, E, nullptr);
}
__device__ __forceinline__ void phase_ikln(const Params& p) {
  bf16_t* ikc = (bf16_t*)(p.ws + WS_IKC);
  const int tid = threadIdx.x, sub = tid & 7;
  float gam[8], bet[8];
#pragma unroll
  for (int i = 0; i < 8; ++i) { gam[i] = p.ikg[sub * 8 + i]; bet[i] = p.ikb[sub * 8 + i]; }
  for (int row = blockIdx.x * 64 + (tid >> 3); row < TOK; row += gridDim.x * 64) {
    uint4* ptr = (uint4*)(ikc + (size_t)row * 64 + sub * 8);
    const uint4 raw = *ptr;
    float v[8];
    cvt8(raw, v);
    float s = 0.f;
#pragma unroll
    for (int i = 0; i < 8; ++i) s += v[i];
    s += __shfl_xor(s, 1); s += __shfl_xor(s, 2); s += __shfl_xor(s, 4);
    const float mu = s * (1.f / 64.f);
    float q = 0.f;
#pragma unroll
    for (int i = 0; i < 8; ++i) { const float d = v[i] - mu; q += d * d; }
    q += __shfl_xor(q, 1); q += __shfl_xor(q, 2); q += __shfl_xor(q, 4);
    const float rstd = rsqrtf(q * (1.f / 64.f) + EPSV);
    uint4 o;
    o.x = pack2((v[0] - mu) * rstd * gam[0] + bet[0], (v[1] - mu) * rstd * gam[1] + bet[1]);
    o.y = pack2((v[2] - mu) * rstd * gam[2] + bet[2], (v[3] - mu) * rstd * gam[3] + bet[3]);
    o.z = pack2((v[4] - mu) * rstd * gam[4] + bet[4], (v[5] - mu) * rstd * gam[5] + bet[5]);
    o.w = pack2((v[6] - mu) * rstd * gam[6] + bet[6], (v[7] - mu) * rstd * gam[7] + bet[7]);
    *ptr = o;
  }
}
__device__ __forceinline__ void phase_up8(const Params& p, unsigned char* smem) {
  unsigned char* ws = p.ws;
  pg8::Gemm g{(const pg8::bf16_t*)(ws + WS_XN), (const pg8::bf16_t*)(ws + WS_WUPA), TOK, 1024, 1024};
  pg8::StaticOrder S; S.init(TOK, 1024, (int)gridDim.x, (int)blockIdx.x);
  EpiGate2 E{(unsigned short*)(ws + WS_PH), (const unsigned short*)(ws + WS_PG)};
  pg8::gemm_phase<EpiGate2, pg8::StaticOrder>((PG8_LAS unsigned char*)smem, g, S, E, nullptr);
}
__device__ __forceinline__ void phase_out8(const Params& p, unsigned char* smem) {
  unsigned char* ws = p.ws;
  pg8::Gemm g{(const pg8::bf16_t*)(ws + WS_PH), (const pg8::bf16_t*)(ws + WS_WOUT), TOK, 1024, 1024};
  pg8::StaticOrder S; S.init(TOK, 1024, (int)gridDim.x, (int)blockIdx.x);
  EpiResid E{(unsigned short*)(ws + WS_X1), p.x};
  pg8::gemm_phase<EpiResid, pg8::StaticOrder>((PG8_LAS unsigned char*)smem, g, S, E, nullptr);
}
__device__ __forceinline__ void phase_pq8(const Params& p, unsigned char* smem) {
  unsigned char* ws = p.ws;
  pg8::Gemm g{(const pg8::bf16_t*)(ws + WS_XQ), (const pg8::bf16_t*)(ws + WS_WQ), TOK, 2048, 512};
  pg8::StaticOrder S; S.init(TOK, 2048, (int)gridDim.x, (int)blockIdx.x);
  EpiStoreBf16Q E{(unsigned short*)(ws + WS_PG), 2048, (const float*)(ws + WS_XS), (const float*)(ws + WS_WQS)};
  pg8::gemm_phase<EpiStoreBf16Q, pg8::StaticOrder, false, true>((PG8_LAS unsigned char*)smem, g, S, E, nullptr);
}

__global__ void __launch_bounds__(NTHREADS) hybrid_fwd(Params p) {
  extern __shared__ __attribute__((aligned(16))) unsigned char smem[];
#if ONE_LAUNCH
  cg::grid_group grid = cg::this_grid();
  volatile LAS unsigned* xst = (volatile LAS unsigned*)(smem + LDS_BYTES - 16);
  if (threadIdx.x == 0) { xst[0] = 0u; xst[1] = 0u; }
  __syncthreads();
  XcdBarrier xbar = xcd_barrier_post((unsigned*)(p.ws + WS_BAR), xst);
#define SEAM(k) do { if (p.ph_lo <= (k) && (k) + 1 < p.ph_hi) { if (p.ph_hi > NPHASE) grid.sync(); else xcd_barrier(xbar); } } while (0)
#else
#define SEAM(k) do { } while (0)
#endif
#define IN(k) (p.ph_lo <= (k) && (k) < p.ph_hi)
#ifndef REPEAT_PH
#define REPEAT_PH -1
#endif
#define REP(k, stmt) do { if (REPEAT_PH == (k)) { stmt; grid.sync(); } } while (0)
  if (IN(0)) { phase_prep(p, smem); SEAM(0); }
  if (IN(1)) { phase_proj8(p, smem); SEAM(1); }
  if (IN(2)) { phase_ikln(p); hgrn_h1_all(p, smem); SEAM(2); }
  if (IN(3)) { phase_mix(p, smem); SEAM(3); }
  if (IN(4)) { phase_up8(p, smem); SEAM(4); }
  if (IN(5)) { phase_out8(p, smem); SEAM(5); }
  if (IN(6)) { rmsnorm_rows_q<false, true>((const float*)(p.ws + WS_X1), p.norm_ffn, nullptr, p.ws + WS_XQ, (float*)(p.ws + WS_XS)); SEAM(6); }
  if (IN(7)) { phase_pq8(p, smem); SEAM(7); }
  if (IN(8)) { phase_pkeys(p, smem); SEAM(8); }
  if (IN(9)) { phase_pu(p, smem); SEAM(9); }
  if (IN(10)) { phase_pv_mfma(p, smem); SEAM(10); }
  if (IN(11)) { phase_final(p); }
#undef IN
#undef SEAM
}

extern "C" void kernel_launch(void* const* d_in, const int* in_sizes, int n_in, void* d_out, int out_size, void* d_ws, size_t ws_size,
                              hipStream_t stream) {
  static int grid = 0;
  if (grid == 0) {
    if (n_in != 17 || ws_size < WS_END) {
      fprintf(stderr, "kernel_launch: unexpected n_in %d or ws_size %zu (need %zu)\n", n_in, ws_size, (size_t)WS_END);
      grid = -1; return;
    }
    int dev = 0, cus = 0, per_cu = 0;
    hipGetDevice(&dev);
    hipDeviceGetAttribute(&cus, hipDeviceAttributeMultiprocessorCount, dev);
    hipFuncSetAttribute((const void*)hybrid_fwd, hipFuncAttributeMaxDynamicSharedMemorySize, LDS_BYTES);
    hipOccupancyMaxActiveBlocksPerMultiprocessor(&per_cu, (const void*)hybrid_fwd, NTHREADS, LDS_BYTES);
    if (per_cu < 1) { fprintf(stderr, "kernel_launch: occupancy query says %d blocks/CU\n", per_cu); per_cu = 1; }
    (void)hipGetLastError();
    grid = cus;
  }
  if (grid < 0) return;
  Params p{};
  p.x = (const float*)d_in[0]; p.norm_mix = (const float*)d_in[1]; p.w_in = (const float*)d_in[2]; p.hg_lb = (const float*)d_in[3];
  p.hg_norm = (const float*)d_in[4]; p.ikg = (const float*)d_in[5]; p.ikb = (const float*)d_in[6]; p.rel_bias = (const float*)d_in[7];
  p.w_up_a = (const float*)d_in[8]; p.w_up_b = (const float*)d_in[9]; p.w_out = (const float*)d_in[10]; p.norm_ffn = (const float*)d_in[11];
  p.peer_wq = (const float*)d_in[12]; p.peer_keys = (const float*)d_in[13]; p.peer_u = (const float*)d_in[14]; p.peer_v = (const float*)d_in[15];
  p.norm_final = (const float*)d_in[16];
  p.out = (float*)d_out; p.ws = (unsigned char*)d_ws;
#if ONE_LAUNCH
  hipMemsetAsync((unsigned char*)d_ws + WS_BAR, 0, 16384, stream);
  p.ph_lo = 0; p.ph_hi = NPHASE;
  void* args[] = {&p};
  hipError_t e = hipLaunchCooperativeKernel((const void*)hybrid_fwd, dim3(grid), dim3(NTHREADS), args, LDS_BYTES, stream);
  if (e != hipSuccess) fprintf(stderr, "cooperative launch failed: %s (grid %d)\n", hipGetErrorString(e), grid);
#else
  for (int ph = 0; ph < NPHASE; ++ph) {
    p.ph_lo = ph; p.ph_hi = ph + 1;
    hipLaunchKernelGGL(hybrid_fwd, dim3(grid), dim3(NTHREADS), LDS_BYTES, stream, p);
  }
#endif
}
```

```cpp
#include <hip/hip_runtime.h>
#include <hip/hip_cooperative_groups.h>
#include <stdint.h>
#include <stdio.h>
namespace cg = cooperative_groups;

#ifndef ONE_LAUNCH
#define ONE_LAUNCH 1
#endif

typedef unsigned short bf16_t;
typedef __attribute__((ext_vector_type(8))) short bf16x8;
typedef __attribute__((ext_vector_type(4))) float f32x4;

#define NTHREADS 512
#define TOK 32768
#define SEQL 4096
#define DM 1024
#define EPSV 1e-6f
#define NPHASE 12

#define WS_WIN   ((size_t)0)
#define WS_WUPA  (WS_WIN  + (size_t)5120 * 1024 * 2)
#define WS_WUPB  (WS_WUPA + (size_t)1024 * 512 * 2)
#define WS_WOUT  (WS_WUPB + (size_t)1024 * 512 * 2)
#define WS_WQ    (WS_WOUT + (size_t)1024 * 1024 * 2)
#define WS_KEYS  (WS_WQ   + (size_t)2048 * 1024 * 2)
#define WS_LB    (WS_KEYS + (size_t)2 * 8 * 128 * 128 * 2)
#define WS_U     (WS_LB   + (size_t)4096)
#define WS_V     (WS_U    + (size_t)16384 * 1024 * 2)
#define WS_XN    (WS_V    + (size_t)16384 * 1024 * 2)
#define WS_PH    (WS_XN   + (size_t)TOK * 1024 * 2)
#define WS_PA    (WS_PH   + (size_t)TOK * 2048 * 2)
#define WS_PG    (WS_PA   + (size_t)TOK * 1024 * 2)
#define WS_EIDX  (WS_PG   + (size_t)TOK * 2048 * 2)
#define WS_GW    (WS_EIDX + (size_t)TOK * 128 * 4)
#define WS_SSQ   (WS_GW   + (size_t)TOK * 128 * 4)
#define WS_XCC   (WS_SSQ  + (size_t)TOK * 4)
#define WS_BAR   (WS_XCC  + (size_t)4096)
#define WS_DEC   (WS_BAR  + (size_t)16384)
#define WS_QCTR  (WS_DEC  + (size_t)2048 * 384 * 4)
#define WS_END   (WS_QCTR + (size_t)1024)

#define WS_KC (WS_EIDX)
#define WS_VC (WS_KC + (size_t)TOK * 128)
#define WS_IKC (WS_VC + (size_t)TOK * 128)
#define LDS_BYTES 155648

struct Params {
  const float* x; const float* norm_mix; const float* w_in; const float* hg_lb; const float* hg_norm;
  const float* ikg; const float* ikb; const float* rel_bias; const float* w_up_a; const float* w_up_b;
  const float* w_out; const float* norm_ffn; const float* peer_wq; const float* peer_keys;
  const float* peer_u; const float* peer_v; const float* norm_final;
  float* out; unsigned char* ws; int ph_lo, ph_hi;
};

__device__ __forceinline__ float bf2f(bf16_t u) { return __uint_as_float(((unsigned)u) << 16); }
typedef float f32x2_cv __attribute__((ext_vector_type(2)));
typedef __bf16 bf16x2_cv __attribute__((ext_vector_type(2)));
__device__ __forceinline__ unsigned pack2(float a, float b) {
  const f32x2_cv v = {a, b};
  return __builtin_bit_cast(unsigned, __builtin_convertvector(v, bf16x2_cv));
}
__device__ __forceinline__ bf16_t f2bf(float f) { return (bf16_t)(pack2(f, f) & 0xffffu); }
__device__ __forceinline__ float wave_sum_slow(float v) {
#pragma unroll
  for (int o = 32; o > 0; o >>= 1) v += __shfl_xor(v, o);
  return v;
}
__device__ __forceinline__ void lds_fence() { asm volatile("s_waitcnt lgkmcnt(0)" ::: "memory"); }

__device__ __forceinline__ float add_xor8(float v) { return v + __int_as_float(__builtin_amdgcn_update_dpp(0, __float_as_int(v), 0x128, 0xf, 0xf, true)); }
__device__ __forceinline__ float add_xor16(float v) { const auto r = __builtin_amdgcn_permlane16_swap(__float_as_uint(v), __float_as_uint(v), false, false); return __uint_as_float(r[0]) + __uint_as_float(r[1]); }
__device__ __forceinline__ float add_xor32(float v) { const auto r = __builtin_amdgcn_permlane32_swap(__float_as_uint(v), __float_as_uint(v), false, false); return __uint_as_float(r[0]) + __uint_as_float(r[1]); }
__device__ __forceinline__ float max_xor16(float v) { const auto r = __builtin_amdgcn_permlane16_swap(__float_as_uint(v), __float_as_uint(v), false, false); return fmaxf(__uint_as_float(r[0]), __uint_as_float(r[1])); }
__device__ __forceinline__ float max_xor32(float v) { const auto r = __builtin_amdgcn_permlane32_swap(__float_as_uint(v), __float_as_uint(v), false, false); return fmaxf(__uint_as_float(r[0]), __uint_as_float(r[1])); }
__device__ __forceinline__ float wave_sum(float v) {
  v += __int_as_float(__builtin_amdgcn_update_dpp(0, __float_as_int(v), 0xB1, 0xf, 0xf, true));
  v += __int_as_float(__builtin_amdgcn_update_dpp(0, __float_as_int(v), 0x4E, 0xf, 0xf, true));
  v += __int_as_float(__builtin_amdgcn_update_dpp(0, __float_as_int(v), 0x141, 0xf, 0xf, true));
  v += __int_as_float(__builtin_amdgcn_update_dpp(0, __float_as_int(v), 0x140, 0xf, 0xf, true));
  return add_xor32(add_xor16(v));
}
__device__ __forceinline__ float sigmoidf_(float x) { return 1.f / (1.f + __expf(-x)); }
__device__ __forceinline__ float siluf_(float x) { return x / (1.f + __expf(-x)); }


#define XB_TMO      128
#define XB_XCNT(j)  (256  + 64 * (j))
#define XB_XSUB(j)  (1280 + 64 * (j))
#define XB_XGEN(j)  (2304 + 64 * (j))
#define XB_TOP      3328
#define XB_TOPGEN   3392
#define XCD_BAR_WORDS 3456
#define XB_SPIN_CAP (1u << 22)
#define LAS __attribute__((address_space(3)))
__device__ __forceinline__ unsigned xb_ld(unsigned* p)              { return __hip_atomic_load(p, __ATOMIC_RELAXED, __HIP_MEMORY_SCOPE_AGENT); }
__device__ __forceinline__ unsigned xb_add(unsigned* p, unsigned v) { return __hip_atomic_fetch_add(p, v, __ATOMIC_RELAXED, __HIP_MEMORY_SCOPE_AGENT); }
__device__ __forceinline__ unsigned xb_xcc_id() { return (unsigned)__builtin_amdgcn_s_getreg((3 << 11) | 20) & 0xFu; }
#define XB_SPIN(cond, bar) do { unsigned _sp = 0; while (cond) { __builtin_amdgcn_s_sleep(1); \
    if ((++_sp & 255u) == 0u) { if (xb_ld(&(bar)[XB_TMO])) break; if (_sp > XB_SPIN_CAP) { atomicAdd(&(bar)[XB_TMO], 1u); break; } } } } while (0)
struct XcdBarrier { unsigned* bar; unsigned x; volatile LAS unsigned* st; };
__device__ __forceinline__ XcdBarrier xcd_barrier_post(unsigned* bar, volatile LAS unsigned* st) {
  XcdBarrier b; b.bar = bar; b.x = xb_xcc_id(); b.st = st;
  if (threadIdx.x == 0) (void)xb_add(&bar[XB_XCNT(b.x)], 1u);
  return b;
}
__device__ __forceinline__ void xcd_barrier_complete(unsigned* bar, unsigned x, unsigned& nloc, unsigned& nx) {
  const unsigned G = gridDim.x * gridDim.y * gridDim.z;
  unsigned sum, cnt, mine, sp = 0u;
  for (;;) {
    sum = 0u; cnt = 0u; mine = 0u;
#pragma unroll
    for (unsigned j = 0; j < 16; ++j) { const unsigned c = xb_ld(&bar[XB_XCNT(j)]); sum += c; cnt += (c > 0u) ? 1u : 0u; mine = (j == x) ? c : mine; }
    if (sum == G) break;
    __builtin_amdgcn_s_sleep(1);
    if ((++sp & 255u) == 0u) { if (xb_ld(&bar[XB_TMO])) break; if (sp > XB_SPIN_CAP) { atomicAdd(&bar[XB_TMO], 1u); break; } }
  }
  nloc = mine > 0u ? mine : 1u; nx = cnt > 0u ? cnt : 1u;
}
__device__ __forceinline__ void xcd_barrier(const XcdBarrier& b) {
  asm volatile("s_waitcnt vmcnt(0)" ::: "memory");
  __syncthreads();
  if (threadIdx.x == 0) {
    unsigned* bar = b.bar;
    __builtin_amdgcn_s_waitcnt(0);
    unsigned nloc = b.st[0], nx = b.st[1];
    if (nloc == 0u) { xcd_barrier_complete(bar, b.x, nloc, nx); b.st[0] = nloc; b.st[1] = nx; }
    const unsigned old = xb_add(&bar[XB_XSUB(b.x)], 1u);
    const unsigned gen = old / nloc;
    if (old + 1u == (gen + 1u) * nloc) {
      __builtin_amdgcn_fence(__ATOMIC_RELEASE, "agent");
      asm volatile("s_waitcnt vmcnt(0)" ::: "memory");
      const unsigned og = xb_add(&bar[XB_TOP], 1u);
      const unsigned tg = og / nx;
      if (og + 1u == (tg + 1u) * nx) xb_add(&bar[XB_TOPGEN], 1u);
      else XB_SPIN(xb_ld(&bar[XB_TOPGEN]) == tg, bar);
      __builtin_amdgcn_fence(__ATOMIC_ACQUIRE, "agent");
      xb_add(&bar[XB_XGEN(b.x)], 1u);
      asm volatile("s_waitcnt vmcnt(0)" ::: "memory");
    } else {
      XB_SPIN(xb_ld(&bar[XB_XGEN(b.x)]) == gen, bar);
      __builtin_amdgcn_fence(__ATOMIC_ACQUIRE, "agent");
      asm volatile("s_waitcnt vmcnt(0)" ::: "memory");
    }
  }
  __syncthreads();
}

namespace pg8 {
#define PG8_LAS __attribute__((address_space(3)))
typedef unsigned short bf16_t;
typedef short bf16x8 __attribute__((ext_vector_type(8)));
typedef float f32x4 __attribute__((ext_vector_type(4)));
typedef unsigned u32x4 __attribute__((ext_vector_type(4)));
constexpr int BM = 256, BK = 64, HALF = 128, HTB = HALF * BK * 2  , STAGE_BYTES = 8 * HTB, NXCD = 8, WGM = 8;

__host__ __device__ __forceinline__ int lds_byte(int r, int c) { const int st = (r >> 4) * 2 + (c >> 5), rr = r & 15, cc = c & 31, ob = rr * 64 + cc * 2; return st * 1024 + (ob ^ (((ob >> 9) & 1) << 5)); }
__host__ __device__ __forceinline__ void stage_rc(int b, int& R, int& C) { const int st = b / 1024, sb = b % 1024, swz = sb ^ (((sb >> 9) & 1) << 5); R = (st >> 1) * 16 + swz / 64; C = (st & 1) * 32 + (swz % 64) / 2; }
__host__ __device__ __forceinline__ int perm32(int rho) { const int n = rho >> 4, i = rho & 15; return 8 * (i >> 2) + 4 * n + (i & 3); }

struct Unit { int pm, pn; };
struct Gemm { const bf16_t* A; const bf16_t* Bt; int M, N, K; };

struct StaticOrder {
    int nM, nN, nwg, G, c;
    __host__ __device__ void init(int M, int N, int G_, int c_) { nM = M / BM; nN = N / BM; nwg = nM * nN; G = G_; c = c_; }
    __host__ __device__ bool next(int i, Unit& u) const {
        const long L = (long)i * G + c; if (L >= nwg) return false;
        int wgid = (int)L; { const int q = nwg / NXCD, r = nwg % NXCD, xcd = wgid % NXCD, off = wgid / NXCD; wgid = (xcd < r ? xcd * (q + 1) : r * (q + 1) + (xcd - r) * q) + off; }
        const int nig = WGM * nN, gid = wgid / nig, fm = gid * WGM, gsz = (nM - fm) < WGM ? (nM - fm) : WGM;
        u.pm = fm + ((wgid % nig) % gsz); u.pn = (wgid % nig) / gsz; return true;
    }
    __device__ __forceinline__ void a_ready(const Unit&) const {}
    __device__ __forceinline__ void done(const Unit&) const {}
};
__device__ __forceinline__ unsigned cvt_pk_bf16(float lo, float hi) { unsigned r; asm volatile("v_cvt_pk_bf16_f32 %0, %1, %2" : "=v"(r) : "v"(lo), "v"(hi)); return r; }
typedef int i32x4 __attribute__((ext_vector_type(4)));
template <class Epi, class Sched, bool STAMP = false, bool I8 = false>
__device__ __forceinline__ void gemm_phase(PG8_LAS unsigned char* lds, const Gemm g, const Sched& S, const Epi& E, unsigned long long* stamps) {
    const int tid = threadIdx.x, wid = __builtin_amdgcn_readfirstlane(tid >> 6), lane = tid & 63, wr = wid >> 2, wc = wid & 3, fr = lane & 15, fq = lane >> 4;
    const int K = g.K, nt = K / BK;
    int ts_lo = 0, ts_hi = 0, nts = 0; const unsigned long long rt_entry = STAMP ? (unsigned long long)wall_clock64() : 0ull;
#define PG8_STAMP() do { if (STAMP && wid == 0 && nts < 64) { const unsigned long long _c = (unsigned long long)clock64(); \
        ts_lo = (lane == nts) ? (int)(unsigned)_c : ts_lo; ts_hi = (lane == nts) ? (int)(unsigned)(_c >> 32) : ts_hi; ++nts; } } while (0)
    PG8_STAMP();
    unsigned voffA[2], voffB[2];
#pragma unroll
    for (int i = 0; i < 2; ++i) { int R, C; stage_rc(tid * 16 + i * 8192, R, C); const int Rb = Epi::PERM ? ((R & ~31) + perm32(R & 31)) : R;
        voffA[i] = (unsigned)(R * K + C) * 2u; voffB[i] = (unsigned)(Rb * K + C) * 2u; }
    const size_t kstep = (size_t)(BK * 2);
    const size_t hstep = (size_t)HALF * K * 2;
    const size_t tstep = 2 * hstep;
    const unsigned ldsw = (unsigned)wid * 1024u;
    const int aoff = lds_byte(wr * 64 + fr, fq * 8), boff = lds_byte(wc * 32 + fr, fq * 8);
#define PG8_SA(b, h) (((b) * 2 + (h)) * HTB)
#define PG8_SB(b, h) ((4 + (b) * 2 + (h)) * HTB)
#define PG8_STAGE(bufoff, gbase, voff) do { _Pragma("unroll") for (int _i = 0; _i < 2; ++_i) \
        __builtin_amdgcn_global_load_lds((const unsigned*)((const char*)(gbase) + (voff)[_i]), (PG8_LAS unsigned*)(lds + (bufoff) + ldsw + _i * 8192), 16, 0, 0); } while (0)
#define PG8_LDA(dst, b, h) do { _Pragma("unroll") for (int m = 0; m < 4; ++m) _Pragma("unroll") for (int k = 0; k < 2; ++k) dst[m][k] = *(const PG8_LAS bf16x8*)(lds + PG8_SA(b, h) + aoff + m * 2048 + k * 1024); } while (0)
#define PG8_LDB(dst, b, h) do { _Pragma("unroll") for (int n = 0; n < 2; ++n) _Pragma("unroll") for (int k = 0; k < 2; ++k) dst[n][k] = *(const PG8_LAS bf16x8*)(lds + PG8_SB(b, h) + boff + n * 2048 + k * 1024); } while (0)
#define PG8_MMA(ai, bj, At, Bt) do { __builtin_amdgcn_s_setprio(1); _Pragma("unroll") for (int m = 0; m < 4; ++m) _Pragma("unroll") for (int n = 0; n < 2; ++n) _Pragma("unroll") for (int k = 0; k < 2; ++k) \
        { if constexpr (I8) acc[ai][bj][m][n] = __builtin_bit_cast(f32x4, __builtin_amdgcn_mfma_i32_16x16x64_i8(__builtin_bit_cast(i32x4, Bt[n][k]), __builtin_bit_cast(i32x4, At[m][k]), __builtin_bit_cast(i32x4, acc[ai][bj][m][n]), 0, 0, 0)); \
          else acc[ai][bj][m][n] = __builtin_amdgcn_mfma_f32_16x16x32_bf16(Bt[n][k], At[m][k], acc[ai][bj][m][n], 0, 0, 0); } __builtin_amdgcn_s_setprio(0); } while (0)
#define PG8_WAIT_V(n) asm volatile("s_waitcnt vmcnt(" #n ")" ::: "memory")
#define PG8_WAIT_L(n) asm volatile("s_waitcnt lgkmcnt(" #n ")" ::: "memory")
#define PG8_BAR __builtin_amdgcn_s_barrier()
#define PG8_SCHED __builtin_amdgcn_sched_barrier(0)
    Unit cur, nxt; int ui = 0;
    if (!S.next(0, cur)) return;
    f32x4 acc[2][2][4][2];
#pragma unroll
    for (int a = 0; a < 2; ++a)
#pragma unroll
        for (int b = 0; b < 2; ++b)
#pragma unroll
            for (int m = 0; m < 4; ++m)
#pragma unroll
                for (int n = 0; n < 2; ++n) acc[a][b][m][n] = (f32x4){0.f, 0.f, 0.f, 0.f};
    bf16x8 At[4][2], B0[2][2], B1[2][2];
    const char* cA = (const char*)g.A + (size_t)cur.pm * tstep; const char* cB = (const char*)g.Bt + (size_t)cur.pn * tstep;
    S.a_ready(cur);
    PG8_STAGE(PG8_SB(0, 0), cB, voffB); PG8_STAGE(PG8_SA(0, 0), cA, voffA); PG8_STAGE(PG8_SB(0, 1), cB + hstep, voffB); PG8_STAGE(PG8_SA(0, 1), cA + hstep, voffA);
    if (wr == 1) PG8_BAR;
    PG8_WAIT_V(4); PG8_BAR;
    PG8_STAGE(PG8_SB(1, 0), cB + kstep, voffB); PG8_STAGE(PG8_SA(1, 0), cA + kstep, voffA); PG8_STAGE(PG8_SB(1, 1), cB + hstep + kstep, voffB);
    PG8_WAIT_V(6); PG8_BAR;
    PG8_STAMP();
    for (;;) {
        const bool has_next = S.next(ui + 1, nxt);
        const char* nA = has_next ? (const char*)g.A + (size_t)nxt.pm * tstep : cA; const char* nB = has_next ? (const char*)g.Bt + (size_t)nxt.pn * tstep : cB;
        for (int t = 0; t < nt; t += 2) {
            const bool last = (t == nt - 2);
            const char* a1 = cA + (size_t)(t + 1) * kstep;
            const char* a2 = last ? nA : cA + (size_t)(t + 2) * kstep; const char* b2 = last ? nB : cB + (size_t)(t + 2) * kstep;
            const char* a3 = a2 + kstep; const char* b3 = b2 + kstep;
            if constexpr (Epi::MID) { if (t == nt / 2) E.mid(acc, cur, wr, wc, fr, fq); }
            if (last && has_next) S.a_ready(nxt);
            PG8_LDB(B0, 0, 0); PG8_SCHED; PG8_LDA(At, 0, 0); PG8_STAGE(PG8_SA(1, 1), a1 + hstep, voffA);
            PG8_WAIT_L(8); PG8_BAR; PG8_WAIT_L(0); PG8_MMA(0, 0, At, B0); PG8_BAR; PG8_SCHED;
            PG8_LDB(B1, 0, 1); PG8_STAGE(PG8_SB(0, 0), b2, voffB);
            PG8_BAR; PG8_WAIT_L(0); PG8_MMA(0, 1, At, B1); PG8_BAR;
            PG8_LDA(At, 0, 1); PG8_STAGE(PG8_SA(0, 0), a2, voffA);
            PG8_BAR; PG8_WAIT_L(0); PG8_MMA(1, 0, At, B0); PG8_BAR; PG8_SCHED;
            PG8_STAGE(PG8_SB(0, 1), b2 + hstep, voffB);
            PG8_WAIT_V(6); PG8_BAR; PG8_MMA(1, 1, At, B1); PG8_BAR;
            PG8_LDB(B0, 1, 0); PG8_SCHED; PG8_LDA(At, 1, 0); PG8_STAGE(PG8_SA(0, 1), a2 + hstep, voffA);
            PG8_WAIT_L(8); PG8_BAR; PG8_WAIT_L(0); PG8_MMA(0, 0, At, B0); PG8_BAR; PG8_SCHED;
            PG8_LDB(B1, 1, 1); PG8_STAGE(PG8_SB(1, 0), b3, voffB);
            PG8_BAR; PG8_WAIT_L(0); PG8_MMA(0, 1, At, B1); PG8_BAR;
            PG8_LDA(At, 1, 1); PG8_STAGE(PG8_SA(1, 0), a3, voffA);
            PG8_BAR; PG8_WAIT_L(0); PG8_MMA(1, 0, At, B0); PG8_BAR; PG8_SCHED;
            PG8_STAGE(PG8_SB(1, 1), b3 + hstep, voffB);
            PG8_WAIT_V(6); PG8_BAR; PG8_MMA(1, 1, At, B1); PG8_BAR;
        }
        PG8_STAMP();
        if constexpr (!Epi::AFTER_DRAIN) { E(acc, cur, wr, wc, fr, fq); S.done(cur); }
        PG8_STAMP();
        if (!has_next) break;
#pragma unroll
        for (int a = 0; a < 2; ++a)
#pragma unroll
            for (int b = 0; b < 2; ++b)
#pragma unroll
                for (int m = 0; m < 4; ++m)
#pragma unroll
                    for (int n = 0; n < 2; ++n) acc[a][b][m][n] = (f32x4){0.f, 0.f, 0.f, 0.f};
        cur = nxt; cA = nA; cB = nB; ++ui;
    }
    PG8_WAIT_V(0);
    if (wr == 0) PG8_BAR;
    PG8_BAR;
    if constexpr (Epi::AFTER_DRAIN) { E.fused(acc, cur, wr, wc, fr, fq, lds, wid, lane); S.done(cur); }
    PG8_STAMP();
    if (STAMP && wid == 0) { stamps[lane] = lane < nts ? (((unsigned long long)(unsigned)ts_hi << 32) | (unsigned)ts_lo) : 0ull;
        if (lane == 62) stamps[62] = rt_entry; if (lane == 63) stamps[63] = (unsigned long long)wall_clock64(); }
#undef PG8_STAMP
#undef PG8_SA
#undef PG8_SB
#undef PG8_STAGE
#undef PG8_LDA
#undef PG8_LDB
#undef PG8_MMA
#undef PG8_WAIT_V
#undef PG8_WAIT_L
#undef PG8_BAR
#undef PG8_SCHED
}
}

struct EpiProj {
  static constexpr bool PERM = true, AFTER_DRAIN = false, MID = false;
  unsigned short* pH; unsigned short* pA; unsigned short* pG; unsigned short* kc; unsigned short* vc; unsigned short* ikc;
  const float* sa; const float* sw;
  __device__ __forceinline__ void operator()(const pg8::f32x4 (&acc)[2][2][4][2], const pg8::Unit& u, int wr, int wc, int fr, int fq) const {
    const int row0 = u.pm * 256 + wr * 64 + fr;
    pg8::f32x4 cs_[2][2];
#pragma unroll
    for (int bj = 0; bj < 2; ++bj)
#pragma unroll
      for (int n = 0; n < 2; ++n) cs_[bj][n] = *(const pg8::f32x4*)(sw + u.pn * 256 + bj * 128 + wc * 32 + 8 * fq + 4 * n);
    unsigned short* base; int ldc, colt; bool sg = false;
    if (u.pn < 8) { base = pH; ldc = 2048; colt = u.pn * 256; }
    else if (u.pn < 12) { base = pA; ldc = 1024; colt = (u.pn - 8) * 256; }
    else { base = pG; ldc = 2048; colt = (u.pn - 12) * 256; sg = true; }
    const int col0 = colt + wc * 32 + 8 * fq;
#pragma unroll
    for (int ai = 0; ai < 2; ++ai)
#pragma unroll
      for (int m = 0; m < 4; ++m) {
        unsigned short* rowp = base + (size_t)(row0 + ai * 128 + m * 16) * ldc + col0;
        const float ra = sa[row0 + ai * 128 + m * 16];
#pragma unroll
        for (int bj = 0; bj < 2; ++bj) {
          pg8::f32x4 v0, v1;
#pragma unroll
          for (int j = 0; j < 4; ++j) { v0[j] = (float)__float_as_int(acc[ai][bj][m][0][j]) * (ra * cs_[bj][0][j]); v1[j] = (float)__float_as_int(acc[ai][bj][m][1][j]) * (ra * cs_[bj][1][j]); }
          if (sg) {
            unsigned wq_[2];
#pragma unroll
            for (int n = 0; n < 2; ++n) {
              unsigned pkq = 0u;
#pragma unroll
              for (int j = 0; j < 4; ++j) {
                const float sgv = sigmoidf_(n == 0 ? v0[j] : v1[j]);
                const unsigned qv = (unsigned)(int)fminf(fmaxf(rintf(sgv * 255.f), 1.f), 255.f);
                pkq |= qv << (8 * j);
              }
              wq_[n] = pkq;
            }
            *(uint2*)((unsigned char*)pG + (size_t)(row0 + ai * 128 + m * 16) * 2048 + col0 + bj * 128) = make_uint2(wq_[0], wq_[1]);
            continue;
          }
          pg8::u32x4 w; w.x = pg8::cvt_pk_bf16(v0[0], v0[1]); w.y = pg8::cvt_pk_bf16(v0[2], v0[3]); w.z = pg8::cvt_pk_bf16(v1[0], v1[1]); w.w = pg8::cvt_pk_bf16(v1[2], v1[3]);
          unsigned short* dst = rowp + bj * 128;
          if (u.pn == 10 || u.pn == 11) {
            const int cs = col0 + bj * 128;
            const size_t r = (size_t)(row0 + ai * 128 + m * 16);
            if (cs >= 512 && cs < 576) dst = kc + r * 64 + (cs - 512);
            else if (cs >= 576 && cs < 640) dst = vc + r * 64 + (cs - 576);
            else if (cs >= 896 && cs < 960) dst = ikc + r * 64 + (cs - 896);
          }
          *(pg8::u32x4*)dst = w;
        }
      }
  }
};
template <int MODE> struct EpiGate {
  static constexpr bool PERM = true, AFTER_DRAIN = false, MID = false;
  unsigned short* hb; const unsigned short* pG; int goff;
  __device__ __forceinline__ void operator()(const pg8::f32x4 (&acc)[2][2][4][2], const pg8::Unit& u, int wr, int wc, int fr, int fq) const {
    const int row0 = u.pm * 256 + wr * 64 + fr;
    const int col0 = u.pn * 256 + wc * 32 + 8 * fq;
#pragma unroll
    for (int ai = 0; ai < 2; ++ai)
#pragma unroll
      for (int m = 0; m < 4; ++m) {
        const size_t r = (size_t)(row0 + ai * 128 + m * 16);
        pg8::u32x4 gv[2], hv[2];
#pragma unroll
        for (int bj = 0; bj < 2; ++bj) {
          gv[bj] = *(const pg8::u32x4*)(pG + r * 2048 + goff + col0 + bj * 128);
          if (MODE == 1) hv[bj] = *(const pg8::u32x4*)(hb + r * 1024 + col0 + bj * 128);
        }
#pragma unroll
        for (int bj = 0; bj < 2; ++bj) {
          float o[8];
#pragma unroll
          for (int j = 0; j < 4; ++j) {
            const unsigned gw0 = gv[bj][j >> 1], gw1 = gv[bj][2 + (j >> 1)];
            const float g0 = (j & 1) ? __uint_as_float(gw0 & 0xffff0000u) : __uint_as_float(gw0 << 16);
            const float g1 = (j & 1) ? __uint_as_float(gw1 & 0xffff0000u) : __uint_as_float(gw1 << 16);
            o[j] = acc[ai][bj][m][0][j] * g0; o[4 + j] = acc[ai][bj][m][1][j] * g1;
            if (MODE == 1) {
              const unsigned hw0 = hv[bj][j >> 1], hw1 = hv[bj][2 + (j >> 1)];
              o[j] += (j & 1) ? __uint_as_float(hw0 & 0xffff0000u) : __uint_as_float(hw0 << 16);
              o[4 + j] += (j & 1) ? __uint_as_float(hw1 & 0xffff0000u) : __uint_as_float(hw1 << 16);
            }
          }
          pg8::u32x4 w; w.x = pg8::cvt_pk_bf16(o[0], o[1]); w.y = pg8::cvt_pk_bf16(o[2], o[3]); w.z = pg8::cvt_pk_bf16(o[4], o[5]); w.w = pg8::cvt_pk_bf16(o[6], o[7]);
          *(pg8::u32x4*)(hb + r * 1024 + col0 + bj * 128) = w;
        }
      }
  }
};
struct EpiGate2 {
  static constexpr bool PERM = true, AFTER_DRAIN = false, MID = true;
  unsigned short* hb; const unsigned char* pG;
  __device__ __forceinline__ void mid(pg8::f32x4 (&acc)[2][2][4][2], const pg8::Unit& u, int wr, int wc, int fr, int fq) const {
    int fr_o = fr, fq_o = fq;
    asm volatile("" : "+v"(fr_o), "+v"(fq_o));
    const unsigned char* gp = pG + (size_t)(u.pm * 256 + wr * 64 + fr_o) * 2048 + u.pn * 256 + wc * 32 + 8 * fq_o;
#pragma unroll
    for (int ai = 0; ai < 2; ++ai)
#pragma unroll
      for (int m = 0; m < 4; ++m)
#pragma unroll
        for (int bj = 0; bj < 2; ++bj) {
          const unsigned char* q = gp + (size_t)(ai * 128 + m * 16) * 2048 + bj * 128;
          const uint2 gb = *(const uint2*)(q + 1024);
          const uint2 ga = *(const uint2*)q;
#pragma unroll
          for (int n = 0; n < 2; ++n) {
            const unsigned wa = n ? ga.y : ga.x, wb = n ? gb.y : gb.x;
#pragma unroll
            for (int j = 0; j < 4; ++j)
              acc[ai][bj][m][n][j] *= (float)((wa >> (8 * j)) & 255u) * __builtin_amdgcn_rcpf((float)((wb >> (8 * j)) & 255u));
          }
          if (bj == 1) asm volatile("" ::: "memory");
        }
  }
  __device__ __forceinline__ void operator()(const pg8::f32x4 (&acc)[2][2][4][2], const pg8::Unit& u, int wr, int wc, int fr, int fq) const {
    const int row0 = u.pm * 256 + wr * 64 + fr;
    const int col0 = u.pn * 256 + wc * 32 + 8 * fq;
#pragma unroll
    for (int ai = 0; ai < 2; ++ai)
#pragma unroll
      for (int m = 0; m < 4; ++m) {
        const size_t r = (size_t)(row0 + ai * 128 + m * 16);
        uint2 gb[2];
#pragma unroll
        for (int bj = 0; bj < 2; ++bj) gb[bj] = *(const uint2*)(pG + r * 2048 + 1024 + col0 + bj * 128);
#pragma unroll
        for (int bj = 0; bj < 2; ++bj) {
          float o[8];
#pragma unroll
          for (int j = 0; j < 4; ++j) {
            o[j] = acc[ai][bj][m][0][j] * ((float)((gb[bj].x >> (8 * j)) & 255u) * (1.f / 255.f));
            o[4 + j] = acc[ai][bj][m][1][j] * ((float)((gb[bj].y >> (8 * j)) & 255u) * (1.f / 255.f));
          }
          pg8::u32x4 w; w.x = pg8::cvt_pk_bf16(o[0], o[1]); w.y = pg8::cvt_pk_bf16(o[2], o[3]); w.z = pg8::cvt_pk_bf16(o[4], o[5]); w.w = pg8::cvt_pk_bf16(o[6], o[7]);
          *(pg8::u32x4*)(hb + r * 1024 + col0 + bj * 128) = w;
        }
      }
  }
};
struct EpiResid {
  static constexpr bool PERM = true, AFTER_DRAIN = false, MID = false;
  unsigned short* o; const float* x;
  __device__ __forceinline__ void operator()(const pg8::f32x4 (&acc)[2][2][4][2], const pg8::Unit& u, int wr, int wc, int fr, int fq) const {
    const int row0 = u.pm * 256 + wr * 64 + fr, col0 = u.pn * 256 + wc * 32 + 8 * fq;
#pragma unroll
    for (int ai = 0; ai < 2; ++ai)
#pragma unroll
      for (int m = 0; m < 4; ++m) {
        const size_t off = (size_t)(row0 + ai * 128 + m * 16) * 1024 + col0;
        pg8::f32x4 xv[2][2];
#pragma unroll
        for (int bj = 0; bj < 2; ++bj)
#pragma unroll
          for (int n = 0; n < 2; ++n) xv[bj][n] = *(const pg8::f32x4*)(x + off + bj * 128 + n * 4);
#pragma unroll
        for (int bj = 0; bj < 2; ++bj) {
          const pg8::f32x4 v0 = acc[ai][bj][m][0] + xv[bj][0], v1 = acc[ai][bj][m][1] + xv[bj][1];
          pg8::u32x4 w; w.x = pg8::cvt_pk_bf16(v0[0], v0[1]); w.y = pg8::cvt_pk_bf16(v0[2], v0[3]); w.z = pg8::cvt_pk_bf16(v1[0], v1[1]); w.w = pg8::cvt_pk_bf16(v1[2], v1[3]);
          *(pg8::u32x4*)(o + off + bj * 128) = w;
        }
      }
  }
};
struct EpiStoreBf16Q {
  static constexpr bool PERM = true, AFTER_DRAIN = false, MID = false;
  unsigned short* O; int ldc; const float* sa; const float* sw;
  __device__ __forceinline__ void operator()(const pg8::f32x4 (&acc)[2][2][4][2], const pg8::Unit& u, int wr, int wc, int fr, int fq) const {
    const int row0 = u.pm * 256 + wr * 64 + fr, col0 = u.pn * 256 + wc * 32 + 8 * fq;
    pg8::f32x4 cs_[2][2];
#pragma unroll
    for (int bj = 0; bj < 2; ++bj)
#pragma unroll
      for (int n = 0; n < 2; ++n) cs_[bj][n] = *(const pg8::f32x4*)(sw + col0 + bj * 128 + 4 * n);
#pragma unroll
    for (int ai = 0; ai < 2; ++ai)
#pragma unroll
      for (int m = 0; m < 4; ++m) {
        unsigned short* rowp = O + (size_t)(row0 + ai * 128 + m * 16) * ldc + col0;
        const float ra = sa[row0 + ai * 128 + m * 16];
#pragma unroll
        for (int bj = 0; bj < 2; ++bj) {
          pg8::f32x4 v0, v1;
#pragma unroll
          for (int j = 0; j < 4; ++j) { v0[j] = (float)__float_as_int(acc[ai][bj][m][0][j]) * (ra * cs_[bj][0][j]); v1[j] = (float)__float_as_int(acc[ai][bj][m][1][j]) * (ra * cs_[bj][1][j]); }
          pg8::u32x4 w; w.x = pg8::cvt_pk_bf16(v0[0], v0[1]); w.y = pg8::cvt_pk_bf16(v0[2], v0[3]); w.z = pg8::cvt_pk_bf16(v1[0], v1[1]); w.w = pg8::cvt_pk_bf16(v1[2], v1[3]);
          *(pg8::u32x4*)(rowp + bj * 128) = w;
        }
      }
  }
};
struct EpiStoreBf16 {
  static constexpr bool PERM = true, AFTER_DRAIN = false, MID = false;
  unsigned short* O; int ldc;
  __device__ __forceinline__ void operator()(const pg8::f32x4 (&acc)[2][2][4][2], const pg8::Unit& u, int wr, int wc, int fr, int fq) const {
    const int row0 = u.pm * 256 + wr * 64 + fr, col0 = u.pn * 256 + wc * 32 + 8 * fq;
#pragma unroll
    for (int ai = 0; ai < 2; ++ai)
#pragma unroll
      for (int m = 0; m < 4; ++m) {
        unsigned short* rowp = O + (size_t)(row0 + ai * 128 + m * 16) * ldc + col0;
#pragma unroll
        for (int bj = 0; bj < 2; ++bj) {
          const pg8::f32x4 v0 = acc[ai][bj][m][0], v1 = acc[ai][bj][m][1];
          pg8::u32x4 w; w.x = pg8::cvt_pk_bf16(v0[0], v0[1]); w.y = pg8::cvt_pk_bf16(v0[2], v0[3]); w.z = pg8::cvt_pk_bf16(v1[0], v1[1]); w.w = pg8::cvt_pk_bf16(v1[2], v1[3]);
          *(pg8::u32x4*)(rowp + bj * 128) = w;
        }
      }
  }
};

__device__ __forceinline__ void gemm_tile(const bf16_t* __restrict__ A, int lda, const bf16_t* __restrict__ Bt, int ldb,
                                          int nk, f32x4 (&acc)[4][4], unsigned char* smem) {
  const int tid = threadIdx.x, lane = tid & 63, w = tid >> 6, wm = w >> 1, wn = w & 1, l15 = lane & 15, g = lane >> 4;
  unsigned char* sA = smem;
  unsigned char* sB = smem + 32768;
  const int lr = tid >> 3, lc = tid & 7;
  const bf16_t* ga = A + (size_t)lr * lda + lc * 8;
  const bf16_t* gb = Bt + (size_t)lr * ldb + lc * 8;
  uint4 ra0, ra1, ra2, ra3, rb0, rb1;
  ra0 = *(const uint4*)(ga);
  ra1 = *(const uint4*)(ga + (size_t)64 * lda);
  ra2 = *(const uint4*)(ga + (size_t)128 * lda);
  ra3 = *(const uint4*)(ga + (size_t)192 * lda);
  rb0 = *(const uint4*)(gb);
  rb1 = *(const uint4*)(gb + (size_t)64 * ldb);
  const int sw = (lc ^ (lr & 7)) << 4;
  for (int kt = 0; kt < nk; ++kt) {
    __syncthreads();
    *(uint4*)(sA + (lr) * 128 + sw) = ra0;
    *(uint4*)(sA + (lr + 64) * 128 + sw) = ra1;
    *(uint4*)(sA + (lr + 128) * 128 + sw) = ra2;
    *(uint4*)(sA + (lr + 192) * 128 + sw) = ra3;
    *(uint4*)(sB + (lr) * 128 + sw) = rb0;
    *(uint4*)(sB + (lr + 64) * 128 + sw) = rb1;
    __syncthreads();
    if (kt + 1 < nk) {
      const int ko = (kt + 1) * 64;
      ra0 = *(const uint4*)(ga + ko);
      ra1 = *(const uint4*)(ga + (size_t)64 * lda + ko);
      ra2 = *(const uint4*)(ga + (size_t)128 * lda + ko);
      ra3 = *(const uint4*)(ga + (size_t)192 * lda + ko);
      rb0 = *(const uint4*)(gb + ko);
      rb1 = *(const uint4*)(gb + (size_t)64 * ldb + ko);
    }
#pragma unroll
    for (int ks = 0; ks < 2; ++ks) {
      bf16x8 a[4], b[4];
#pragma unroll
      for (int m = 0; m < 4; ++m) { const int r = wm * 64 + m * 16 + l15; a[m] = *(const bf16x8*)(sA + r * 128 + (((ks * 4 + g) ^ (r & 7)) << 4)); }
#pragma unroll
      for (int n = 0; n < 4; ++n) { const int r = wn * 64 + n * 16 + l15; b[n] = *(const bf16x8*)(sB + r * 128 + (((ks * 4 + g) ^ (r & 7)) << 4)); }
#pragma unroll
      for (int m = 0; m < 4; ++m)
#pragma unroll
        for (int n = 0; n < 4; ++n) acc[m][n] = __builtin_amdgcn_mfma_f32_16x16x32_bf16(a[m], b[n], acc[m][n], 0, 0, 0);
    }
  }
}

__device__ __forceinline__ void zero_acc(f32x4 (&acc)[4][4]) {
#pragma unroll
  for (int m = 0; m < 4; ++m)
#pragma unroll
    for (int n = 0; n < 4; ++n) acc[m][n] = (f32x4){0.f, 0.f, 0.f, 0.f};
}

__device__ __forceinline__ void transpose_tile(const float* __restrict__ src, int srcN, bf16_t* __restrict__ dst, int K, int n0, int k0,
                                               bool winmap, float* tile) {
  const int tid = threadIdx.x;
  const int nc = tid & 63, kr = tid >> 6;
  int ncol = n0 + nc; bool valid = true;
  if (winmap) { if (ncol >= 3072) ncol -= 60; else if (ncol >= 3012) valid = false; }
#pragma unroll
  for (int i = 0; i < 8; ++i) {
    const int k = kr + 8 * i;
    tile[k * 65 + nc] = valid ? src[(size_t)(k0 + k) * srcN + ncol] : 0.f;
  }
  __syncthreads();
#pragma unroll
  for (int i = 0; i < 8; ++i) {
    const int nr = kr + 8 * i;
    dst[(size_t)(n0 + nr) * K + k0 + nc] = f2bf(tile[nc * 65 + nr]);
  }
  __syncthreads();
}

__device__ __forceinline__ void quant_cols32(const float* __restrict__ src, int srcN, unsigned char* __restrict__ dst, float* __restrict__ scale,
                                             int n0, bool winmap, float* tile) {
  const int tid = threadIdx.x, nc = tid & 31, kr = tid >> 5;
  float* red = tile + 1024 * 33;
  int ncol = n0 + nc; bool valid = true;
  if (winmap) { if (ncol >= 3072) ncol -= 60; else if (ncol >= 3012) valid = false; }
  if (!valid) ncol = 0;
  float am = 0.f;
#pragma unroll 8
  for (int i = 0; i < 64; ++i) {
    const int k = kr + 16 * i;
    float v = src[(size_t)k * srcN + ncol];
    v = valid ? v : 0.f;
    tile[k * 33 + nc] = v; am = fmaxf(am, fabsf(v));
  }
  red[kr * 32 + nc] = am;
  __syncthreads();
  if (tid < 32) {
    float m = 0.f;
#pragma unroll
    for (int i = 0; i < 16; ++i) m = fmaxf(m, red[i * 32 + tid]);
    red[512 + tid] = m; scale[n0 + tid] = m * (1.f / 127.f);
  }
  __syncthreads();
  const float cm = red[512 + nc];
  const float inv = cm > 0.f ? 127.f / cm : 0.f;
#pragma unroll
  for (int i = 0; i < 4; ++i) {
    const int k0 = (kr + 16 * i) * 16;
    unsigned pk[4];
#pragma unroll
    for (int q = 0; q < 4; ++q) {
      const unsigned b0 = (unsigned)(int)rintf(tile[(k0 + 4 * q) * 33 + nc] * inv) & 255u, b1 = (unsigned)(int)rintf(tile[(k0 + 4 * q + 1) * 33 + nc] * inv) & 255u;
      const unsigned b2 = (unsigned)(int)rintf(tile[(k0 + 4 * q + 2) * 33 + nc] * inv) & 255u, b3 = (unsigned)(int)rintf(tile[(k0 + 4 * q + 3) * 33 + nc] * inv) & 255u;
      pk[q] = b0 | (b1 << 8) | (b2 << 16) | (b3 << 24);
    }
    *(uint4*)(dst + (size_t)(n0 + nc) * 1024 + k0) = make_uint4(pk[0], pk[1], pk[2], pk[3]);
  }
  __syncthreads();
}

__device__ __forceinline__ void convert_f32_bf16(const float* __restrict__ src, bf16_t* __restrict__ dst, size_t n4) {
  for (size_t i = (size_t)blockIdx.x * NTHREADS + threadIdx.x; i < n4; i += (size_t)gridDim.x * NTHREADS) {
    const float4 v = ((const float4*)src)[i];
    uint2 o; o.x = pack2(v.x, v.y); o.y = pack2(v.z, v.w);
    ((uint2*)dst)[i] = o;
  }
}

template <bool SLICE_MAJOR, bool SIGNED>
__device__ __forceinline__ void quantize_rows_u8(const float* __restrict__ src, unsigned char* __restrict__ dst, float* __restrict__ scale, int row_lo, int row_hi) {
  const int lane = threadIdx.x & 63, w = threadIdx.x >> 6;
  for (int row = row_lo + w; row < row_hi; row += 8) {
    const float4* s4 = (const float4*)(src + (size_t)row * 1024) + lane * 4;
    float4 v[4];
    float am = 0.f;
#pragma unroll
    for (int i = 0; i < 4; ++i) { v[i] = s4[i]; am = fmaxf(am, fmaxf(fmaxf(fabsf(v[i].x), fabsf(v[i].y)), fmaxf(fabsf(v[i].z), fabsf(v[i].w)))); }
#pragma unroll
    for (int o = 32; o > 0; o >>= 1) am = fmaxf(am, __shfl_xor(am, o));
    const float inv = am > 0.f ? 127.f / am : 0.f;
    unsigned pk[4];
#pragma unroll
    for (int i = 0; i < 4; ++i) {
      const int ofs = SIGNED ? 0 : 128;
      const unsigned b0 = (unsigned)((int)rintf(v[i].x * inv) + ofs), b1 = (unsigned)((int)rintf(v[i].y * inv) + ofs);
      const unsigned b2 = (unsigned)((int)rintf(v[i].z * inv) + ofs), b3 = (unsigned)((int)rintf(v[i].w * inv) + ofs);
      pk[i] = (b0 & 255u) | ((b1 & 255u) << 8) | ((b2 & 255u) << 16) | ((b3 & 255u) << 24);
    }
    if (SLICE_MAJOR) {
      unsigned char* d8 = dst + (size_t)(lane >> 3) * (16384 * 128) + (size_t)row * 128 + 2 * (lane & 7);
#pragma unroll
      for (int q = 0; q < 8; ++q) {
        const unsigned lo = (pk[q >> 2] >> (8 * (q & 3))) & 255u, hi = (pk[2 + (q >> 2)] >> (8 * (q & 3))) & 255u;
        *(unsigned short*)(d8 + q * 16) = (unsigned short)(lo | (hi << 8));
      }
    }
    else *(uint4*)(dst + (size_t)row * 1024 + lane * 16) = make_uint4(pk[0], pk[1], pk[2], pk[3]);
    if (lane == 0) scale[row] = am * (1.f / 127.f);
  }
}

#define WS_WINS (WS_WIN + (size_t)5120 * 1024)
#define WS_WQS (WS_WQ + (size_t)2048 * 1024)
#define WS_XNS (WS_XN + (size_t)TOK * 1024)
#define WS_X1 (WS_XN)
#define WS_XQ (WS_PH + (size_t)TOK * 1024 * 2)
#define WS_XS (WS_XQ + (size_t)TOK * 1024)
template <bool WBF, bool SRC_BF16 = false>
__device__ __forceinline__ void rmsnorm_rows_q(const float* __restrict__ src, const float* __restrict__ g, bf16_t* __restrict__ dst,
                                               unsigned char* __restrict__ xq, float* __restrict__ xs) {
  const int lane = threadIdx.x & 63, w = threadIdx.x >> 6;
  for (int row = blockIdx.x * 8 + w; row < TOK; row += gridDim.x * 8) {
    const float4* g4 = (const float4*)g + lane * 4;
    float v[16]; float ss = 0.f;
    if (SRC_BF16) {
      const uint4* sb = (const uint4*)((const bf16_t*)src + (size_t)row * DM + lane * 16);
      const uint4 r0 = sb[0], r1 = sb[1];
      const unsigned wd[8] = {r0.x, r0.y, r0.z, r0.w, r1.x, r1.y, r1.z, r1.w};
#pragma unroll
      for (int i = 0; i < 8; ++i) { v[2 * i] = __uint_as_float(wd[i] << 16); v[2 * i + 1] = __uint_as_float(wd[i] & 0xffff0000u); ss += v[2 * i] * v[2 * i] + v[2 * i + 1] * v[2 * i + 1]; }
    } else {
      const float4* s4 = (const float4*)(src + (size_t)row * DM) + lane * 4;
#pragma unroll
      for (int i = 0; i < 4; ++i) { const float4 t = s4[i]; v[4 * i] = t.x; v[4 * i + 1] = t.y; v[4 * i + 2] = t.z; v[4 * i + 3] = t.w; ss += t.x * t.x + t.y * t.y + t.z * t.z + t.w * t.w; }
    }
    ss = wave_sum(ss);
    const float rstd = rsqrtf(ss * (1.f / DM) + EPSV);
    float am = 0.f;
#pragma unroll
    for (int i = 0; i < 4; ++i) { const float4 gg = g4[i]; v[4 * i] *= rstd * gg.x; v[4 * i + 1] *= rstd * gg.y; v[4 * i + 2] *= rstd * gg.z; v[4 * i + 3] *= rstd * gg.w; }
#pragma unroll
    for (int i = 0; i < 16; ++i) am = fmaxf(am, fabsf(v[i]));
#pragma unroll
    for (int o = 32; o > 0; o >>= 1) am = fmaxf(am, __shfl_xor(am, o));
    const float inv = am > 0.f ? 127.f / am : 0.f;
    if (WBF) {
      uint4 ob0, ob1;
      ob0.x = pack2(v[0], v[1]); ob0.y = pack2(v[2], v[3]); ob0.z = pack2(v[4], v[5]); ob0.w = pack2(v[6], v[7]);
      ob1.x = pack2(v[8], v[9]); ob1.y = pack2(v[10], v[11]); ob1.z = pack2(v[12], v[13]); ob1.w = pack2(v[14], v[15]);
      *(uint4*)(dst + (size_t)row * DM + lane * 16) = ob0;
      *(uint4*)(dst + (size_t)row * DM + lane * 16 + 8) = ob1;
    }
    unsigned pk[4];
#pragma unroll
    for (int i = 0; i < 4; ++i) {
      const unsigned b0 = (unsigned)(int)rintf(v[4 * i] * inv) & 255u, b1 = (unsigned)(int)rintf(v[4 * i + 1] * inv) & 255u;
      const unsigned b2 = (unsigned)(int)rintf(v[4 * i + 2] * inv) & 255u, b3 = (unsigned)(int)rintf(v[4 * i + 3] * inv) & 255u;
      pk[i] = b0 | (b1 << 8) | (b2 << 16) | (b3 << 24);
    }
    *(uint4*)(xq + (size_t)row * 1024 + lane * 16) = make_uint4(pk[0], pk[1], pk[2], pk[3]);
    if (lane == 0) xs[row] = am * (1.f / 127.f);
  }
}

__device__ __forceinline__ void rmsnorm_rows(const float* __restrict__ src, const float* __restrict__ g, bf16_t* __restrict__ dst) {
  const int lane = threadIdx.x & 63, w = threadIdx.x >> 6;
  for (int row = blockIdx.x * 8 + w; row < TOK; row += gridDim.x * 8) {
    const float4* s4 = (const float4*)(src + (size_t)row * DM);
    float4 v[4]; float ss = 0.f;
#pragma unroll
    for (int i = 0; i < 4; ++i) { v[i] = s4[lane + 64 * i]; ss += v[i].x * v[i].x + v[i].y * v[i].y + v[i].z * v[i].z + v[i].w * v[i].w; }
    ss = wave_sum(ss);
    const float rstd = rsqrtf(ss * (1.f / DM) + EPSV);
#pragma unroll
    for (int i = 0; i < 4; ++i) {
      const float4 gg = ((const float4*)g)[lane + 64 * i];
      uint2 o; o.x = pack2(v[i].x * rstd * gg.x, v[i].y * rstd * gg.y); o.y = pack2(v[i].z * rstd * gg.z, v[i].w * rstd * gg.w);
      ((uint2*)(dst + (size_t)row * DM))[lane + 64 * i] = o;
    }
  }
}

__device__ __forceinline__ void phase_prep(const Params& p, unsigned char* smem) {
  unsigned char* ws = p.ws;
  float* tile = (float*)smem;
  const int n_win = 160, n_ua = 16 * 8, n_ub = 16 * 8, n_wo = 16 * 16, n_wq = 64;
  const int total = n_win + n_wq + n_ua + n_ub + n_wo;
  for (int it = blockIdx.x; it < total; it += gridDim.x) {
    int t = it;
    if (t < n_win) { quant_cols32(p.w_in, 5060, ws + WS_WIN, (float*)(ws + WS_WINS), t * 32, true, tile); continue; }
    t -= n_win;
    if (t < n_wq) { quant_cols32(p.peer_wq, 2048, ws + WS_WQ, (float*)(ws + WS_WQS), t * 32, false, tile); continue; }
    t -= n_wq;
    if (t < n_ua) { transpose_tile(p.w_up_a, 1024, (bf16_t*)(ws + WS_WUPA), 1024, (t >> 3) * 64, (t & 7) * 64, false, tile); continue; }
    t -= n_ua;
    if (t < n_ub) { transpose_tile(p.w_up_b, 1024, (bf16_t*)(ws + WS_WUPA) + 512, 1024, (t >> 3) * 64, (t & 7) * 64, false, tile); continue; }
    t -= n_ub;
    transpose_tile(p.w_out, 1024, (bf16_t*)(ws + WS_WOUT), 1024, (t >> 4) * 64, (t & 15) * 64, false, tile);
  }
  convert_f32_bf16(p.peer_keys, (bf16_t*)(ws + WS_KEYS), (size_t)2 * 8 * 128 * 128 / 4);
  for (int i = blockIdx.x * NTHREADS + threadIdx.x; i < TOK; i += gridDim.x * NTHREADS) ((float*)(ws + WS_SSQ))[i] = 0.f;
  if (threadIdx.x == 0) ((int*)(ws + WS_XCC))[blockIdx.x] = (int)(__builtin_amdgcn_s_getreg((3 << 11) | 20) & 0xFu);
  if (blockIdx.x == 0 && threadIdx.x < 8) ((unsigned*)(ws + WS_QCTR))[16 * threadIdx.x] = 0u;
  if (blockIdx.x == 0) {
    const int i = threadIdx.x;
    const float a0 = p.hg_lb[i], a1 = p.hg_lb[512 + i];
    ((float*)(ws + WS_LB))[i] = 1.f / (1.f + expf(a1 - a0));
  }
  rmsnorm_rows_q<false>(p.x, p.norm_mix, nullptr, ws + WS_XN, (float*)(ws + WS_XNS));
}

__device__ __forceinline__ void hgrn_h1_all(const Params& p, unsigned char* smem) {
  unsigned char* ws = p.ws;
  bf16_t* pH = (bf16_t*)(ws + WS_PH);
  const float* lbp = (const float*)(ws + WS_LB);
  bf16_t* Qt = (bf16_t*)smem;
  bf16_t* Kt = Qt + 64 * 136;
  bf16_t* KtT = Kt + 64 * 136;
  bf16_t* VT = KtT + 128 * 72;
  bf16_t* Am = VT + 128 * 72;
  float* qtot = (float*)(Am + 64 * 72);
  const int tid = threadIdx.x, lane = tid & 63, w = tid >> 6, l15 = lane & 15, g = lane >> 4;
  const int d = tid & 127, tq = tid >> 7;
  const int G = gridDim.x;
  if ((int)blockIdx.x >= 2048) return;
  bf16_t fr_[16], qr_[16]; unsigned short vr_[16];
#define H1_LOAD(IT) do { \
    const int bh_ = (IT) >> 6, ch_ = (IT) & 63; \
    const bf16_t* base_ = pH + ((size_t)(bh_ >> 2) * SEQL + ch_ * 64 + tq * 16) * 2048 + (bh_ & 3) * 128 + d; \
    _Pragma("unroll") for (int i = 0; i < 16; ++i) { fr_[i] = base_[(size_t)i * 2048 + 512]; qr_[i] = base_[(size_t)i * 2048]; vr_[i] = base_[(size_t)i * 2048 + 1024]; } \
  } while (0)
  H1_LOAD((int)blockIdx.x);
  for (int item = blockIdx.x; item < 2048; item += G) {
    const int bh = item >> 6, chunk = item & 63;
    const int b = bh >> 2, h = bh & 3;
    const float lbv = lbp[h * 128 + d];
    const size_t row0 = (size_t)b * SEQL + chunk * 64;
    float* dec = (float*)(ws + WS_DEC) + (size_t)item * 384;
    uint4* UU = (uint4*)p.out + (size_t)item * 2048 + tid;
    float4* OI = (float4*)((unsigned char*)p.out + ((size_t)64 << 20)) + (size_t)item * 2048 + tid;
    {
      unsigned vv[8];
#pragma unroll
      for (int i = 0; i < 8; ++i) vv[i] = (unsigned)vr_[2 * i] | ((unsigned)vr_[2 * i + 1] << 16);
      float lf[16], kk[16], qs[16];
      float run = 0.f;
#pragma unroll
      for (int i = 0; i < 16; ++i) {
        const float sg = sigmoidf_(bf2f(fr_[i]));
        const float fg = lbv + (1.f - lbv) * sg;
        run += __logf(fg);
        lf[i] = run; kk[i] = 1.f - fg; qs[i] = siluf_(bf2f(qr_[i]));
      }
      qtot[tq * 128 + d] = run;
      __syncthreads();
      { const int nit = (item + G < 2048) ? item + G : item; H1_LOAD(nit); }
      const float q0 = qtot[d], q1 = qtot[128 + d], q2 = qtot[256 + d], q3 = qtot[384 + d];
      const float pre = (tq > 0 ? q0 : 0.f) + (tq > 1 ? q1 : 0.f) + (tq > 2 ? q2 : 0.f);
      const float bref = q0 + q1;
      const float blast = bref + q2 + q3;
      unsigned kp[8];
#pragma unroll
      for (int i = 0; i < 16; ++i) {
        const float bt = pre + lf[i];
        const float qt = qs[i] * __expf(bt - bref);
        const float kt = kk[i] * __expf(bref - bt);
        const int t = tq * 16 + i;
        Qt[t * 136 + d] = f2bf(qt);
        const bf16_t kb = f2bf(kt);
        Kt[t * 136 + d] = kb;
        if (i & 1) kp[i >> 1] |= ((unsigned)kb) << 16; else kp[i >> 1] = kb;
      }
      *(uint4*)(KtT + d * 72 + tq * 16) = make_uint4(kp[0], kp[1], kp[2], kp[3]);
      *(uint4*)(KtT + d * 72 + tq * 16 + 8) = make_uint4(kp[4], kp[5], kp[6], kp[7]);
      *(uint4*)(VT + d * 72 + tq * 16) = make_uint4(vv[0], vv[1], vv[2], vv[3]);
      *(uint4*)(VT + d * 72 + tq * 16 + 8) = make_uint4(vv[4], vv[5], vv[6], vv[7]);
      if (tq == 0) { dec[d] = __expf(bref); dec[128 + d] = __expf(blast); dec[256 + d] = __expf(blast - bref); }
    }
    __syncthreads();
    {
  #pragma unroll
      for (int i = 0; i < 2; ++i) {
        const int idx = tid + 512 * i, r = idx >> 4, c = idx & 15;
        *(uint4*)(pH + (row0 + r) * 2048 + h * 128 + c * 8) = *(const uint4*)(Qt + r * 136 + c * 8);
      }
  #pragma unroll
      for (int tt = 0; tt < 2; ++tt) {
        const int tl = 2 * w + tt, sm = tl >> 2, tn = tl & 3;
        f32x4 acc = (f32x4){0.f, 0.f, 0.f, 0.f};
        if (tn >= sm) {
  #pragma unroll
          for (int k0 = 0; k0 < 128; k0 += 32) {
            const bf16x8 a = *(const bf16x8*)(Kt + (sm * 16 + l15) * 136 + k0 + 8 * g);
            const bf16x8 bq = *(const bf16x8*)(Qt + (tn * 16 + l15) * 136 + k0 + 8 * g);
            acc = __builtin_amdgcn_mfma_f32_16x16x32_bf16(a, bq, acc, 0, 0, 0);
          }
        }
        const int t = tn * 16 + l15, s0 = sm * 16 + 4 * g;
        uint2 o;
        o.x = pack2(s0 + 0 <= t ? acc[0] : 0.f, s0 + 1 <= t ? acc[1] : 0.f);
        o.y = pack2(s0 + 2 <= t ? acc[2] : 0.f, s0 + 3 <= t ? acc[3] : 0.f);
        *(uint2*)(Am + t * 72 + s0) = o;
      }
    }
    __syncthreads();
    {
  #pragma unroll
      for (int tm = 0; tm < 4; ++tm) {
        f32x4 acc = (f32x4){0.f, 0.f, 0.f, 0.f};
  #pragma unroll
        for (int k0 = 0; k0 < 64; k0 += 32) {
          const bf16x8 a = *(const bf16x8*)(Am + (tm * 16 + l15) * 72 + k0 + 8 * g);
          const bf16x8 bb = *(const bf16x8*)(VT + (16 * w + l15) * 72 + k0 + 8 * g);
          acc = __builtin_amdgcn_mfma_f32_16x16x32_bf16(a, bb, acc, 0, 0, 0);
        }
        OI[tm * 512] = make_float4(acc[0], acc[1], acc[2], acc[3]);
      }
  #pragma unroll
      for (int dp = 0; dp < 4; ++dp) {
        unsigned pk[4];
  #pragma unroll
        for (int hh = 0; hh < 2; ++hh) {
          const int dm = dp * 2 + hh;
          f32x4 acc = (f32x4){0.f, 0.f, 0.f, 0.f};
  #pragma unroll
          for (int k0 = 0; k0 < 64; k0 += 32) {
            const bf16x8 a = *(const bf16x8*)(KtT + (dm * 16 + l15) * 72 + k0 + 8 * g);
            const bf16x8 bb = *(const bf16x8*)(VT + (16 * w + l15) * 72 + k0 + 8 * g);
            acc = __builtin_amdgcn_mfma_f32_16x16x32_bf16(a, bb, acc, 0, 0, 0);
          }
          pk[hh * 2] = pack2(acc[0], acc[1]); pk[hh * 2 + 1] = pack2(acc[2], acc[3]);
        }
        UU[dp * 512] = make_uint4(pk[0], pk[1], pk[2], pk[3]);
      }
    }
    __syncthreads();
  }
#undef H1_LOAD
}

__device__ __forceinline__ void hgrn_h2(const Params& p, unsigned char* smem, int bh) {
  unsigned char* ws = p.ws;
  const bf16_t* pH = (const bf16_t*)(ws + WS_PH);
  bf16_t* ya = (bf16_t*)(ws + WS_XN);
  bf16_t* Qt = (bf16_t*)smem;
  bf16_t* ST = Qt + 64 * 136;
  float* decl = (float*)(ST + 128 * 136);
  float* red = decl + 384;
  const int tid = threadIdx.x, lane = tid & 63, w = tid >> 6, l15 = lane & 15, g = lane >> 4;
  const int b = bh >> 2, h = bh & 3;
  f32x4 S[8];
#pragma unroll
  for (int i = 0; i < 8; ++i) S[i] = (f32x4){0.f, 0.f, 0.f, 0.f};
  const float gnv = p.hg_norm[h * 128 + 16 * w + l15];
  const int e = 16 * w + l15;
  uint4 uu0, uu1, uu2, uu3; float4 oi0, oi1, oi2, oi3; uint4 qraw0, qraw1; bf16_t ogr[16]; float dcv = 0.f;
#define H2_LOAD(CH) do { \
    const int item_ = bh * 64 + (CH); \
    const size_t row0_ = (size_t)b * SEQL + (size_t)(CH) * 64; \
    const uint4* UUp = (const uint4*)p.out + (size_t)item_ * 2048 + tid; \
    const float4* OIp = (const float4*)((const unsigned char*)p.out + ((size_t)64 << 20)) + (size_t)item_ * 2048 + tid; \
    uu0 = UUp[0]; uu1 = UUp[512]; uu2 = UUp[1024]; uu3 = UUp[1536]; oi0 = OIp[0]; oi1 = OIp[512]; oi2 = OIp[1024]; oi3 = OIp[1536]; \
    qraw0 = *(const uint4*)(pH + (row0_ + (tid >> 4)) * 2048 + h * 128 + (tid & 15) * 8); \
    qraw1 = *(const uint4*)(pH + (row0_ + 32 + (tid >> 4)) * 2048 + h * 128 + (tid & 15) * 8); \
    _Pragma("unroll") for (int tm = 0; tm < 4; ++tm) _Pragma("unroll") for (int j = 0; j < 4; ++j) \
      ogr[tm * 4 + j] = pH[(row0_ + tm * 16 + 4 * g + j) * 2048 + 1536 + h * 128 + e]; \
    if (tid < 384) dcv = ((const float*)(ws + WS_DEC))[(size_t)item_ * 384 + tid]; \
  } while (0)
  H2_LOAD(0);
  for (int chunk = 0; chunk < 64; ++chunk) {
    const size_t row0 = (size_t)b * SEQL + chunk * 64;
    const uint4 cu[4] = {uu0, uu1, uu2, uu3}; const float4 co[4] = {oi0, oi1, oi2, oi3}; bf16_t cog[16];
#pragma unroll
    for (int i = 0; i < 16; ++i) cog[i] = ogr[i];
    *(uint4*)(Qt + (tid >> 4) * 136 + (tid & 15) * 8) = qraw0;
    *(uint4*)(Qt + (32 + (tid >> 4)) * 136 + (tid & 15) * 8) = qraw1;
    if (tid < 384) decl[tid] = dcv;
    __syncthreads();
    if (chunk + 1 < 64) H2_LOAD(chunk + 1);
#pragma unroll
    for (int dm = 0; dm < 8; ++dm) {
      const int d0 = 16 * dm + 4 * g;
      uint2 o;
      o.x = pack2(S[dm][0] * decl[d0], S[dm][1] * decl[d0 + 1]);
      o.y = pack2(S[dm][2] * decl[d0 + 2], S[dm][3] * decl[d0 + 3]);
      *(uint2*)(ST + e * 136 + d0) = o;
    }
    __syncthreads();
    f32x4 o[4];
#pragma unroll
    for (int tm = 0; tm < 4; ++tm) {
      f32x4 acc = (f32x4){co[tm].x, co[tm].y, co[tm].z, co[tm].w};
#pragma unroll
      for (int k0 = 0; k0 < 128; k0 += 32) {
        const bf16x8 a = *(const bf16x8*)(Qt + (tm * 16 + l15) * 136 + k0 + 8 * g);
        const bf16x8 bb = *(const bf16x8*)(ST + (16 * w + l15) * 136 + k0 + 8 * g);
        acc = __builtin_amdgcn_mfma_f32_16x16x32_bf16(a, bb, acc, 0, 0, 0);
      }
      o[tm] = acc;
#pragma unroll
      for (int j = 0; j < 4; ++j) {
        float ss = acc[j] * acc[j];
        ss += __int_as_float(__builtin_amdgcn_update_dpp(0, __float_as_int(ss), 0xB1, 0xf, 0xf, true));
        ss += __int_as_float(__builtin_amdgcn_update_dpp(0, __float_as_int(ss), 0x4E, 0xf, 0xf, true));
        ss += __int_as_float(__builtin_amdgcn_update_dpp(0, __float_as_int(ss), 0x141, 0xf, 0xf, true));
        ss += __int_as_float(__builtin_amdgcn_update_dpp(0, __float_as_int(ss), 0x140, 0xf, 0xf, true));
        if (l15 == 0) red[w * 64 + tm * 16 + 4 * g + j] = ss;
      }
    }
#pragma unroll
    for (int dm = 0; dm < 8; ++dm) {
      const unsigned u01 = (dm & 1) ? cu[dm >> 1].z : cu[dm >> 1].x, u23 = (dm & 1) ? cu[dm >> 1].w : cu[dm >> 1].y;
      const float uv[4] = {__uint_as_float(u01 << 16), __uint_as_float(u01 & 0xffff0000u), __uint_as_float(u23 << 16), __uint_as_float(u23 & 0xffff0000u)};
#pragma unroll
      for (int j = 0; j < 4; ++j) { const int dd = 16 * dm + 4 * g + j; S[dm][j] = decl[128 + dd] * S[dm][j] + decl[256 + dd] * uv[j]; }
    }
    __syncthreads();
    if (tid < 64) {
      float tot = 0.f;
#pragma unroll
      for (int ww = 0; ww < 8; ++ww) tot += red[ww * 64 + tid];
      red[512 + tid] = rsqrtf(tot * (1.f / 128.f) + EPSV);
    }
    __syncthreads();
#pragma unroll
    for (int tm = 0; tm < 4; ++tm)
#pragma unroll
      for (int j = 0; j < 4; ++j) {
        const int t = tm * 16 + 4 * g + j;
        const float rstd = red[512 + t];
        ya[(row0 + t) * 1024 + h * 128 + e] = f2bf(o[tm][j] * rstd * gnv * siluf_(bf2f(cog[tm * 4 + j])));
      }
  }
#undef H2_LOAD
}

__device__ __forceinline__ int team_index(const Params& p, unsigned char* smem) {
  int* sh = (int*)(smem + 8192);
  const int G = gridDim.x, tid = threadIdx.x;
  const int* tab = (const int*)(p.ws + WS_XCC);
  if (tid < 32) sh[tid] = 0;
  __syncthreads();
  const int mine = tab[blockIdx.x] & 15;
  for (int b = tid; b < G; b += NTHREADS) {
    const int x = tab[b] & 15;
    atomicAdd(&sh[x], 1);
    if (x == mine && b < (int)blockIdx.x) atomicAdd(&sh[16], 1);
  }
  __syncthreads();
  if (tid == 0) {
    int pre = 0;
    for (int j = 0; j < mine; ++j) pre += sh[j];
    sh[17] = pre + sh[16];
  }
  __syncthreads();
  const int r = sh[17];
  __syncthreads();
  return r;
}

#define SCW 4100
#ifndef DSA_REP
#define DSA_REP 0
#endif
#define DSA_BKT_OFF (8 * SCW * 4 + 8 * 256 * 4 + 8 * 256 * 2 + 8 * 512 * 2)
__device__ __forceinline__ void cvt8(const uint4& v, float* f) {
  f[0] = __uint_as_float(v.x << 16); f[1] = __uint_as_float(v.x & 0xffff0000u);
  f[2] = __uint_as_float(v.y << 16); f[3] = __uint_as_float(v.y & 0xffff0000u);
  f[4] = __uint_as_float(v.z << 16); f[5] = __uint_as_float(v.z & 0xffff0000u);
  f[6] = __uint_as_float(v.w << 16); f[7] = __uint_as_float(v.w & 0xffff0000u);
}
__device__ __forceinline__ unsigned sortable_key(float v) {
  unsigned bits = __float_as_uint(v);
  if (bits == 0x80000000u) bits = 0u;
  return (bits & 0x80000000u) ? ~bits : (bits | 0x80000000u);
}

__device__ __forceinline__ void dsa_item(const Params& p, unsigned char* smem, int item, const volatile int* next_slot) {
  unsigned char* ws = p.ws;
  const bf16_t* pA = (const bf16_t*)(ws + WS_PA);
  const bf16_t* kc = (const bf16_t*)(ws + WS_KC);
  const bf16_t* vc = (const bf16_t*)(ws + WS_VC);
  const bf16_t* ikc = (const bf16_t*)(ws + WS_IKC);
  bf16_t* yb = (bf16_t*)(ws + WS_XN) + 512;
  unsigned* sc = (unsigned*)smem;
  unsigned* hist = sc + 8 * SCW;
  unsigned short* sel = (unsigned short*)(hist + 8 * 256);
  unsigned short* cand = sel + 8 * 256;
  unsigned char* bkt = (unsigned char*)(cand + 8 * 512);
  unsigned* rmm = (unsigned*)(bkt + 128 + 1056);
  unsigned* bks = rmm + 16;
  const int tid = threadIdx.x, lane = tid & 63, w = tid >> 6, l15 = lane & 15, g = lane >> 4;
  const int b = item >> 9;
  const int tb = item & 511;
  const int t0 = __builtin_amdgcn_readfirstlane(tb * 8);
  const size_t tokbase = (size_t)b * SEQL;

  for (int rep_s = 0; rep_s < (DSA_REP == 1 ? 2 : 1); ++rep_s) {
    bf16x8 af[2][2];
    float wq[2][4];
#pragma unroll
    for (int mt = 0; mt < 2; ++mt) {
      const int qrow = t0 + mt * 4 + (l15 >> 2), head = l15 & 3;
#pragma unroll
      for (int ks = 0; ks < 2; ++ks)
        af[mt][ks] = *(const bf16x8*)(pA + (tokbase + qrow) * 1024 + 640 + head * 64 + ks * 32 + 8 * g);
      const uint2 wr = *(const uint2*)(pA + (tokbase + t0 + mt * 4 + g) * 1024 + 960);
      wq[mt][0] = 0.0625f * bf2f((bf16_t)(wr.x & 0xffff)); wq[mt][1] = 0.0625f * bf2f((bf16_t)(wr.x >> 16));
      wq[mt][2] = 0.0625f * bf2f((bf16_t)(wr.y & 0xffff)); wq[mt][3] = 0.0625f * bf2f((bf16_t)(wr.y >> 16));
    }
    const int nkt = (t0 + 8 + 15) >> 4;
    float fmn[2] = {INFINITY, INFINITY}, fmx[2] = {-INFINITY, -INFINITY};
    const int w_s = __builtin_amdgcn_readfirstlane(w);
    bf16x8 b0[8], b1[8];
#define DSA_SCLOAD(KT0) do { _Pragma("unroll") for (int u = 0; u < 8; ++u) { \
        const int kt_ = (KT0) + 8 * u; \
        const int s_ = (kt_ < nkt ? kt_ : 0) * 16 + l15; \
        const bf16_t* kr_ = ikc + (tokbase + s_) * 64 + 8 * g; \
        b0[u] = *(const bf16x8*)kr_; b1[u] = *(const bf16x8*)(kr_ + 32); } } while (0)
    DSA_SCLOAD(w_s);
    for (int kt0 = w_s; kt0 < nkt; kt0 += 64) {
      __builtin_amdgcn_sched_barrier(0);
      f32x4 sacc[8][2];
#pragma unroll
      for (int u = 0; u < 8; ++u)
#pragma unroll
        for (int mt = 0; mt < 2; ++mt) {
          f32x4 acc = (f32x4){0.f, 0.f, 0.f, 0.f};
          acc = __builtin_amdgcn_mfma_f32_16x16x32_bf16(af[mt][0], b0[u], acc, 0, 0, 0);
          sacc[u][mt] = __builtin_amdgcn_mfma_f32_16x16x32_bf16(af[mt][1], b1[u], acc, 0, 0, 0);
        }
      __builtin_amdgcn_sched_barrier(0);
      if (kt0 + 64 < nkt) { DSA_SCLOAD(kt0 + 64); }
      __builtin_amdgcn_sched_barrier(0);
#pragma unroll
      for (int u = 0; u < 8; ++u) {
        const int kt = kt0 + 8 * u;
        if (kt < nkt) {
          const int s = kt * 16 + l15;
#pragma unroll
          for (int mt = 0; mt < 2; ++mt) {
#define DSA_RELU(x) __int_as_float(max(__float_as_int(x), 0))
            const float v = fmaf(wq[mt][3], DSA_RELU(sacc[u][mt][3]), fmaf(wq[mt][2], DSA_RELU(sacc[u][mt][2]),
                            fmaf(wq[mt][1], DSA_RELU(sacc[u][mt][1]), fmaf(wq[mt][0], DSA_RELU(sacc[u][mt][0]), 0.f))));
#undef DSA_RELU
            const int t = t0 + mt * 4 + g;
            sc[(mt * 4 + g) * SCW + s] = __float_as_uint(v);
            const bool valid = s <= t;
            fmn[mt] = __builtin_amdgcn_fmed3f(fmn[mt], valid ? v : INFINITY, -3.4028234663852886e38f);
            fmx[mt] = __builtin_amdgcn_fmed3f(fmx[mt], valid ? v : -INFINITY, 3.4028234663852886e38f);
          }
        }
      }
    }
#undef DSA_SCLOAD
#pragma unroll
    for (int mt = 0; mt < 2; ++mt) {
      const unsigned ba_ = __float_as_uint(fmn[mt]), bb_ = __float_as_uint(fmx[mt]);
      unsigned a = (ba_ & 0x80000000u) ? ~ba_ : (ba_ | 0x80000000u), bmx = (bb_ & 0x80000000u) ? ~bb_ : (bb_ | 0x80000000u);
#define DPP_MINMAX(CTRL) do { const unsigned a2 = (unsigned)__builtin_amdgcn_update_dpp((int)a, (int)a, CTRL, 0xf, 0xf, false); \
                               const unsigned b2 = (unsigned)__builtin_amdgcn_update_dpp((int)bmx, (int)bmx, CTRL, 0xf, 0xf, false); \
                               a = a2 < a ? a2 : a; bmx = b2 > bmx ? b2 : bmx; } while (0)
      DPP_MINMAX(0xB1); DPP_MINMAX(0x4E); DPP_MINMAX(0x141); DPP_MINMAX(0x140);
#undef DPP_MINMAX
      if (l15 == 0) { atomicMin(&rmm[mt * 4 + g], a); atomicMax(&rmm[8 + mt * 4 + g], bmx); }
    }
  }
  __syncthreads();
  {
    const int nk = *next_slot;
    if (nk >= 0) {
      const int nbt = nk >> 16, nkl = nk & 0xffff, nkq = nkl / 17, nkr = nkl - nkq * 17;
      if (nkr < 16 && lane < 14) {
        const int ntb = 511 - (nkq * 16 + nkr);
        const unsigned char* rp = (const unsigned char*)(pA + ((size_t)nbt * SEQL + ntb * 8 + w) * 1024) + (lane < 8 ? lane * 128 : 1280 + (lane - 8) * 128);
        (void)*(const volatile unsigned*)rp;
      }
    }
  }
  const int t = t0 + w;
  const int n = t + 1;
  unsigned* row = sc + w * SCW;
  const float* rowf = (const float*)row;
  unsigned short* mysel = sel + w * 256;
  unsigned short* mycand = cand + w * 512;
  unsigned* myh = hist + w * 256;
  int cnt;
  const unsigned long long lt_mask = (1ull << lane) - 1ull;
  for (int rep_t = 0; rep_t < (DSA_REP == 2 ? 2 : 1); ++rep_t)
  if (n <= 256) {
    for (int i = lane; i < n; i += 64) mysel[i] = (unsigned short)i;
    cnt = n;
  } else {
    cnt = 256;
    float mn, mx;
    {
      const unsigned kmn = rmm[w], kmx = rmm[8 + w];
      mn = __uint_as_float((kmn & 0x80000000u) ? (kmn ^ 0x80000000u) : ~kmn);
      mx = __uint_as_float((kmx & 0x80000000u) ? (kmx ^ 0x80000000u) : ~kmx);
    }
    const float scale = (mx > mn) ? 255.99f / (mx - mn) : 0.f;
#pragma unroll
    for (int i = 0; i < 4; ++i) myh[lane + 64 * i] = 0u;
    lds_fence();
    for (int i0 = lane; i0 < n; i0 += 256) {
      float v4[4];
#pragma unroll
      for (int k = 0; k < 4; ++k) v4[k] = (i0 + 64 * k < n) ? rowf[i0 + 64 * k] : 0.f;
#pragma unroll
      for (int k = 0; k < 4; ++k) {
        if (i0 + 64 * k < n) {
          int bn = (int)((v4[k] - mn) * scale); bn = bn > 255 ? 255 : bn;
          atomicAdd(&myh[bn], 1u);
        }
      }
    }
    lds_fence();
    unsigned cum; int bstar; unsigned mcount;
    {
      const uint4 c4 = *(const uint4*)(myh + 4 * lane);
      const unsigned c = c4.x + c4.y + c4.z + c4.w;
      unsigned sfx = c;
#pragma unroll
      for (int o = 1; o < 64; o <<= 1) { const unsigned tt = __shfl_down(sfx, o); if (lane + o < 64) sfx += tt; }
      const unsigned long long bal = __ballot(sfx >= 256u);
      const int L = 63 - __clzll(bal);
      const unsigned sL = __shfl(sfx, L), cL = __shfl(c, L);
      const unsigned b3 = __shfl(c4.w, L), b2 = __shfl(c4.z, L), b1 = __shfl(c4.y, L), b0 = __shfl(c4.x, L);
      cum = sL - cL;
      int digit;
      if (cum + b3 >= 256u) { digit = 3; mcount = b3; }
      else { cum += b3; if (cum + b2 >= 256u) { digit = 2; mcount = b2; } else { cum += b2; if (cum + b1 >= 256u) { digit = 1; mcount = b1; } else { cum += b1; digit = 0; mcount = b0; } } }
      bstar = 4 * L + digit;
    }
    const unsigned need = 256u - cum;
    if (mcount <= 512u) {
      unsigned base = 0u, cb = 0u;
      for (int i0 = 0; i0 < n; i0 += 256) {
        float v4[4];
#pragma unroll
        for (int k = 0; k < 4; ++k) { const int i = i0 + 64 * k + lane; v4[k] = (i < n) ? rowf[i] : 0.f; }
#pragma unroll
        for (int k = 0; k < 4; ++k) {
          const int i = i0 + 64 * k + lane;
          const bool valid = i < n;
          int bn = (int)((v4[k] - mn) * scale); bn = bn > 255 ? 255 : bn;
          const bool gt = valid && (bn > bstar);
          const bool eq = valid && (bn == bstar);
          const unsigned long long bg = __ballot(gt), be = __ballot(eq);
          if (gt) mysel[base + (unsigned)__popcll(bg & lt_mask)] = (unsigned short)i;
          if (eq) mycand[cb + (unsigned)__popcll(be & lt_mask)] = (unsigned short)i;
          base += (unsigned)__popcll(bg); cb += (unsigned)__popcll(be);
        }
      }
      lds_fence();
      const int m = (int)mcount;
      unsigned ck[8]; unsigned short ci[8];
#pragma unroll
      for (int q = 0; q < 8; ++q) {
        const int c = q * 64 + lane;
        ck[q] = 0u; ci[q] = 0;
        if (c < m) { ci[q] = mycand[c]; ck[q] = sortable_key(rowf[ci[q]]); }
      }
      unsigned T = 0u;
      if (m <= 64) {
#pragma unroll 1
        for (int bit = 31; bit >= 0; --bit) {
          const unsigned trial = T | (1u << bit);
          if ((unsigned)__popcll(__ballot(ck[0] >= trial)) >= need) T = trial;
        }
      } else {
#pragma unroll 1
        for (int bit = 31; bit >= 0; --bit) {
          const unsigned trial = T | (1u << bit);
          unsigned cge = 0u;
#pragma unroll
          for (int q = 0; q < 8; ++q) cge += (unsigned)__popcll(__ballot(ck[q] >= trial));
          if (cge >= need) T = trial;
        }
      }
      unsigned cgt = 0u;
#pragma unroll
      for (int q = 0; q < 8; ++q) cgt += (unsigned)__popcll(__ballot(ck[q] > T));
      const unsigned need_eq = need - cgt;
      unsigned pos0 = cum, eqtaken = 0u;
#pragma unroll
      for (int q = 0; q < 8; ++q) {
        const bool gt = ck[q] > T;
        const bool eq = ck[q] == T;
        const unsigned long long beq = __ballot(eq);
        const bool take = gt || (eq && (eqtaken + (unsigned)__popcll(beq & lt_mask)) < need_eq);
        const unsigned long long bt = __ballot(take);
        const unsigned pp = pos0 + (unsigned)__popcll(bt & lt_mask);
        if (take && pp < 256u) mysel[pp] = ci[q];
        pos0 += (unsigned)__popcll(bt);
        eqtaken += (unsigned)__popcll(beq);
      }
    } else {
      unsigned prefix = 0u, krem = 256u;
#pragma unroll 1
      for (int pass = 0; pass < 4; ++pass) {
        const int shift = 24 - 8 * pass;
        const unsigned himask = (pass == 0) ? 0u : (0xFFFFFFFFu << (shift + 8));
#pragma unroll
        for (int i = 0; i < 4; ++i) myh[lane + 64 * i] = 0u;
        lds_fence();
        for (int i = lane; i < n; i += 64) {
          const unsigned u = sortable_key(rowf[i]);
          if ((u & himask) == prefix) atomicAdd(&myh[(u >> shift) & 255u], 1u);
        }
        lds_fence();
        const uint4 c4 = *(const uint4*)(myh + 4 * lane);
        const unsigned c = c4.x + c4.y + c4.z + c4.w;
        unsigned sfx = c;
#pragma unroll
        for (int o = 1; o < 64; o <<= 1) { const unsigned tt = __shfl_down(sfx, o); if (lane + o < 64) sfx += tt; }
        const unsigned long long bal = __ballot(sfx >= krem);
        const int L = 63 - __clzll(bal);
        const unsigned sL = __shfl(sfx, L), cL = __shfl(c, L);
        const unsigned b3 = __shfl(c4.w, L), b2 = __shfl(c4.z, L), b1 = __shfl(c4.y, L);
        unsigned cum2 = sL - cL;
        unsigned digit;
        if (cum2 + b3 >= krem) digit = 3;
        else { cum2 += b3; if (cum2 + b2 >= krem) digit = 2; else { cum2 += b2; if (cum2 + b1 >= krem) digit = 1; else { cum2 += b1; digit = 0; } } }
        krem -= cum2;
        prefix |= ((unsigned)(4 * L) + digit) << shift;
      }
      const unsigned T = prefix;
      unsigned base = 0u, eqtaken = 0u;
      for (int i0 = 0; i0 < n; i0 += 64) {
        const int i = i0 + lane;
        const bool valid = i < n;
        const unsigned u = valid ? sortable_key(rowf[i]) : 0u;
        const bool gt = valid && (u > T);
        const bool eq = valid && (u == T);
        const unsigned long long beq = __ballot(eq);
        const unsigned eqrank = eqtaken + (unsigned)__popcll(beq & lt_mask);
        const bool take = gt || (eq && eqrank < krem);
        const unsigned long long bt = __ballot(take);
        const unsigned pos = base + (unsigned)__popcll(bt & lt_mask);
        if (take && pos < 256u) mysel[pos] = (unsigned short)i;
        base += (unsigned)__popcll(bt);
        eqtaken += (unsigned)__popcll(beq);
      }
    }
  }
  lds_fence();
  if (lane == 0) { rmm[w] = 0xFFFFFFFFu; rmm[8 + w] = 0u; }
  lds_fence();
  {
    const uint2 s4 = *(const uint2*)(mysel + 4 * lane);
    const int sj[4] = {(int)(s4.x & 0xffffu), (int)(s4.x >> 16), (int)(s4.y & 0xffffu), (int)(s4.y >> 16)};
    unsigned pk = 0u;
#pragma unroll
    for (int j = 0; j < 4; ++j) {
      const bool valid = 4 * lane + j < cnt;
      const int dist = valid ? t - sj[j] : 0;
      unsigned bk = dist < 128 ? (unsigned)bkt[dist] : 31u;
      bk = valid ? bk : 32u;
      pk |= bk << (8 * j);
    }
    bks[w * 64 + lane] = pk;
  }
  lds_fence();
  {
    int lane_a = lane;
    asm volatile("" : "+v"(lane_a));
    const int l15 = lane_a & 15, g = lane_a >> 4;
    const int ks = lane_a >> 3, dc = lane_a & 7;
    const unsigned char* kcb = (const unsigned char*)(kc + tokbase * 64);
    const unsigned char* vcb = (const unsigned char*)(vc + tokbase * 64);
    float* pl = (float*)row;
    const float* relb = (const float*)(bkt + 128);
    const int niter = (cnt + 7) >> 3;
    bf16x8 bq0 = (bf16x8){0, 0, 0, 0, 0, 0, 0, 0}, bq1 = bq0;
    if (l15 < 8) {
      bq0 = *(const bf16x8*)(pA + (tokbase + t) * 1024 + l15 * 64 + 8 * g);
      bq1 = *(const bf16x8*)(pA + (tokbase + t) * 1024 + l15 * 64 + 32 + 8 * g);
    }
    float lg[16][4];
    {
      bf16x8 ka[8][2], kb[8][2];
#pragma unroll
      for (int u = 0; u < 8; ++u) {
        const int kk = u * 16 + l15;
        const unsigned s = (unsigned)mysel[kk] & 4095u;
        const unsigned ko = s * 128u + 16u * (unsigned)g;
        ka[u][0] = *(const bf16x8*)(kcb + ko);
        ka[u][1] = *(const bf16x8*)(kcb + ko + 64u);
      }
#pragma unroll
      for (int u = 0; u < 8; ++u) {
        const int kk = (8 + u) * 16 + l15;
        const unsigned s = (unsigned)mysel[kk] & 4095u;
        const unsigned ko = s * 128u + 16u * (unsigned)g;
        kb[u][0] = *(const bf16x8*)(kcb + ko);
        kb[u][1] = *(const bf16x8*)(kcb + ko + 64u);
      }
      __builtin_amdgcn_sched_barrier(0);
#pragma unroll
      for (int u = 0; u < 8; ++u) {
        f32x4 acc = (f32x4){0.f, 0.f, 0.f, 0.f};
        acc = __builtin_amdgcn_mfma_f32_16x16x32_bf16(ka[u][0], bq0, acc, 0, 0, 0);
        acc = __builtin_amdgcn_mfma_f32_16x16x32_bf16(ka[u][1], bq1, acc, 0, 0, 0);
        lg[u][0] = acc[0]; lg[u][1] = acc[1]; lg[u][2] = acc[2]; lg[u][3] = acc[3];
      }
#pragma unroll
      for (int u = 0; u < 8; ++u) {
        f32x4 acc = (f32x4){0.f, 0.f, 0.f, 0.f};
        acc = __builtin_amdgcn_mfma_f32_16x16x32_bf16(kb[u][0], bq0, acc, 0, 0, 0);
        acc = __builtin_amdgcn_mfma_f32_16x16x32_bf16(kb[u][1], bq1, acc, 0, 0, 0);
        lg[8 + u][0] = acc[0]; lg[8 + u][1] = acc[1]; lg[8 + u][2] = acc[2]; lg[8 + u][3] = acc[3];
      }
    }
    typedef unsigned u32x4_t __attribute__((ext_vector_type(4)));
    u32x4_t va[16];
#pragma unroll
    for (int u = 0; u < 16; ++u) {
      const int kk = u * 8 + ks;
      const unsigned s = (unsigned)mysel[kk] & 4095u;
      va[u] = *(const u32x4_t*)(vcb + s * 128u + 16u * (unsigned)dc);
    }
    __builtin_amdgcn_sched_barrier(0);
    const int hsel = l15 & 7;
    float m = -INFINITY;
    const unsigned* mybks = bks + w * 64;
#pragma unroll
    for (int u = 0; u < 16; ++u) {
      const unsigned bk4 = mybks[4 * u + g];
#pragma unroll
      for (int j = 0; j < 4; ++j) {
        lg[u][j] = lg[u][j] * 0.125f + relb[((bk4 >> (8 * j)) & 255u) * 8 + hsel];
        m = fmaxf(m, lg[u][j]);
      }
    }
    m = max_xor16(m); m = max_xor32(m);
    float sum = 0.f;
#pragma unroll
    for (int u = 0; u < 16; ++u)
#pragma unroll
      for (int j = 0; j < 4; ++j) { lg[u][j] = __expf(lg[u][j] - m); sum += lg[u][j]; }
    sum = add_xor16(sum); sum = add_xor32(sum);
    const float inv = 1.f / sum;
    bf16x8 pa[8];
#pragma unroll
    for (int s8 = 0; s8 < 8; ++s8) {
      const unsigned w0 = pack2(lg[2 * s8][0] * inv, lg[2 * s8][1] * inv), w1 = pack2(lg[2 * s8][2] * inv, lg[2 * s8][3] * inv);
      const unsigned w2 = pack2(lg[2 * s8 + 1][0] * inv, lg[2 * s8 + 1][1] * inv), w3 = pack2(lg[2 * s8 + 1][2] * inv, lg[2 * s8 + 1][3] * inv);
      const u32x4_t wv = {w0, w1, w2, w3};
      pa[s8] = __builtin_bit_cast(bf16x8, wv);
    }
    unsigned char* vs_l = (unsigned char*)row;
    const unsigned vst_off = (unsigned)(ks * 128 + ((dc ^ (((ks >> 1) & 3) << 1)) << 4));
#pragma unroll
    for (int u = 0; u < 16; ++u) *(u32x4_t*)(vs_l + u * 1024 + vst_off) = va[u];
    lds_fence();
    u32x4_t vb[16];
#pragma unroll
    for (int u = 0; u < 16; ++u) {
      const int kk = (16 + u) * 8 + ks;
      const unsigned s = (unsigned)mysel[kk] & 4095u;
      vb[u] = *(const u32x4_t*)(vcb + s * 128u + 16u * (unsigned)dc);
    }
    __builtin_amdgcn_sched_barrier(0);
    f32x4 ov[4];
#pragma unroll
    for (int nt = 0; nt < 4; ++nt) ov[nt] = (f32x4){0.f, 0.f, 0.f, 0.f};
    typedef short v4s_t __attribute__((ext_vector_type(4)));
    const unsigned tr_lane = (unsigned)((l15 >> 2) * 128 + (l15 & 3) * 8);
    const unsigned tr_k = (unsigned)(((g & 1) << 1) | (l15 >> 3));
    unsigned tr_off[4];
#pragma unroll
    for (int nt = 0; nt < 4; ++nt) tr_off[nt] = tr_lane + (((unsigned)nt ^ tr_k) << 5);
#define PV_HALF(S0) do { \
      _Pragma("unroll") for (int s4_ = 0; s4_ < 4; ++s4_) { \
        _Pragma("unroll") for (int nt = 0; nt < 4; ++nt) { \
          const unsigned a0 = (unsigned)((s4_ * 32 + 4 * g) * 128) + tr_off[nt]; \
          const v4s_t b0 = __builtin_amdgcn_ds_read_tr16_b64_v4i16((__attribute__((address_space(3))) v4s_t*)(vs_l + a0)); \
          const v4s_t b1 = __builtin_amdgcn_ds_read_tr16_b64_v4i16((__attribute__((address_space(3))) v4s_t*)(vs_l + a0 + 16 * 128)); \
          const bf16x8 bb = (bf16x8){b0[0], b0[1], b0[2], b0[3], b1[0], b1[1], b1[2], b1[3]}; \
          ov[nt] = __builtin_amdgcn_mfma_f32_16x16x32_bf16(pa[(S0) + s4_], bb, ov[nt], 0, 0, 0); \
        } \
      } \
    } while (0)
    PV_HALF(0);
    lds_fence();
#pragma unroll
    for (int u = 0; u < 16; ++u) *(u32x4_t*)(vs_l + u * 1024 + vst_off) = vb[u];
    lds_fence();
    PV_HALF(4);
#undef PV_HALF
    if (g < 2) {
#pragma unroll
      for (int nt = 0; nt < 4; ++nt)
#pragma unroll
        for (int j = 0; j < 4; ++j) yb[(tokbase + t) * 1024 + (4 * g + j) * 64 + nt * 16 + l15] = f2bf(ov[nt][j]);
    }
    lds_fence();
  }
  __syncthreads();
}

__device__ __forceinline__ void phase_mix(const Params& p, unsigned char* smem, int mode = 0) {
  const int G = gridDim.x;
  if (mode != 2) { for (int bh = blockIdx.x; bh < 32; bh += G) { hgrn_h2(p, smem, bh); __syncthreads(); } }
  if (mode == 1) return;
  unsigned char* bkt = smem + DSA_BKT_OFF;
  volatile int* qslot = (volatile int*)(smem + LDS_BYTES - 32);
  unsigned* qctr = (unsigned*)(p.ws + WS_QCTR);
  if (threadIdx.x < 128) {
    const int nn = threadIdx.x;
    int v = nn;
    if (nn >= 16) { v = 16 + (int)(logf((float)nn * (1.f / 16.f)) / logf(8.f) * 16.f); if (v > 31) v = 31; }
    bkt[nn] = (unsigned char)v;
  }
  if (threadIdx.x >= 256) ((float*)(bkt + 128))[threadIdx.x - 256] = p.rel_bias[threadIdx.x - 256];
  if (threadIdx.x >= 128 && threadIdx.x < 136) ((float*)(bkt + 128))[256 + threadIdx.x - 128] = -INFINITY;
  if (threadIdx.x < 16) ((unsigned*)(bkt + 128 + 1056))[threadIdx.x] = threadIdx.x < 8 ? 0xFFFFFFFFu : 0u;
  const int my_team = (G % 8 == 0) ? team_index(p, smem) / (G >> 3) : (int)(blockIdx.x & 7);
  constexpr int QN = 544;
#define Q_FETCH(SLOT) do { if (threadIdx.x == 0) { int tm_ = q_team, kk_ = -1; \
      for (int tries_ = 0; tries_ < 8; ++tries_) { \
        const unsigned v_ = __hip_atomic_fetch_add(qctr + 16 * tm_, 1u, __ATOMIC_RELAXED, __HIP_MEMORY_SCOPE_AGENT); \
        if (v_ < (unsigned)QN) { kk_ = (tm_ << 16) | (int)v_; break; } \
        tm_ = (tm_ + 1) & 7; } \
      q_team = tm_; qslot[SLOT] = kk_; } } while (0)
  int q_team = my_team;
  Q_FETCH(0);
  __syncthreads();
  int k = qslot[0];
  int par = 1;
  while (k >= 0) {
    Q_FETCH(par);
    const int bt = k >> 16, kl = k & 0xffff;
    const int kq = kl / 17, kr = kl - kq * 17;
    if (kr < 16) {
      const int tb = 511 - (kq * 16 + kr);
      dsa_item(p, smem, (bt << 9) | tb, qslot + par);
    } else {
      const int r0 = (bt * 32 + kq) * 64;
      quantize_rows_u8<false, true>(p.peer_u, p.ws + WS_U, (float*)(p.ws + WS_U + (size_t)16384 * 1024), r0, r0 + 64);
      quantize_rows_u8<true, true>(p.peer_v, p.ws + WS_V, (float*)(p.ws + WS_V + (size_t)16384 * 1024), r0, r0 + 64);
      __syncthreads();
    }
    k = qslot[par];
    par ^= 1;
  }
#undef Q_FETCH
}

__device__ __forceinline__ void phase_pkeys(const Params& p, unsigned char* smem) {
  unsigned char* ws = p.ws;
  const bf16_t* qp = (const bf16_t*)(ws + WS_PG);
  const bf16_t* keys = (const bf16_t*)(ws + WS_KEYS);
  int* eidx = (int*)(ws + WS_EIDX);
  float* gw = (float*)(ws + WS_GW);
  float* sc = (float*)smem;
  float* s2l = (float*)smem;
  unsigned short* i1l = (unsigned short*)(s2l + 256 * 17);
  unsigned short* i2l = i1l + 256 * 16;
  const int tid = threadIdx.x, lane = tid & 63, w = tid >> 6, wm = w >> 1, wn = w & 1, l15 = lane & 15, g = lane >> 4;
  for (int item = blockIdx.x; item < 128 * 8; item += gridDim.x) {
    const int h = item & 7, tm = item >> 3;
    float s1[16], s2v[16]; int i1[16], i2[16];
#pragma unroll
    for (int ph = 0; ph < 2; ++ph) {
      const int hp = h * 2 + ph;
      f32x4 acc[4][4]; zero_acc(acc);
      gemm_tile(qp + (size_t)tm * 256 * 2048 + hp * 128, 2048, keys + (size_t)(ph * 8 + h) * 128 * 128, 128, 2, acc, smem);
      __syncthreads();
#pragma unroll
      for (int m = 0; m < 4; ++m)
#pragma unroll
        for (int n = 0; n < 4; ++n)
#pragma unroll
          for (int j = 0; j < 4; ++j) sc[(wm * 64 + m * 16 + 4 * g + j) * 129 + wn * 64 + n * 16 + l15] = acc[m][n][j];
      __syncthreads();
      if (tid < 256) {
        const float* rowp = sc + tid * 129;
        unsigned tv[16];
#pragma unroll
        for (int k = 0; k < 16; ++k) tv[k] = 0u;
#pragma unroll 8
        for (int nn = 0; nn < 128; ++nn) {
          const unsigned bits = __float_as_uint(rowp[nn]);
          unsigned key = (bits & 0x80000000u) ? ~bits : (bits | 0x80000000u);
          key = (key & ~127u) | (unsigned)(127 - nn);
#pragma unroll
          for (int k = 15; k >= 1; --k) {
            unsigned r;
            asm("v_med3_u32 %0, %1, %2, %3" : "=v"(r) : "v"(tv[k]), "v"(tv[k - 1]), "v"(key));
            tv[k] = r;
          }
          tv[0] = tv[0] > key ? tv[0] : key;
        }
#pragma unroll
        for (int k = 0; k < 16; ++k) {
          const int col = 127 - (int)(tv[k] & 127u);
          const float val = rowp[col];
          if (ph == 0) { i1[k] = col; s1[k] = val; } else { i2[k] = col; s2v[k] = val; }
        }
      }
      __syncthreads();
    }
    if (tid < 256) {
#pragma unroll
      for (int a = 0; a < 16; ++a) { s2l[tid * 17 + a] = s2v[a]; i1l[tid * 16 + a] = (unsigned short)i1[a]; i2l[tid * 16 + a] = (unsigned short)i2[a]; }
      float cur[16];
#pragma unroll
      for (int a = 0; a < 16; ++a) cur[a] = s1[a] + s2v[0];
      unsigned long long ptr = 0ull;
      float tops[16]; int tope[16];
#pragma unroll
      for (int k = 0; k < 16; ++k) {
        float best = cur[0]; int ba = 0;
#pragma unroll
        for (int a = 1; a < 16; ++a) if (cur[a] > best) { best = cur[a]; ba = a; }
        const int bb = (int)((ptr >> (4 * ba)) & 15ull);
        tops[k] = best;
        tope[k] = (int)i1l[tid * 16 + ba] * 128 + (int)i2l[tid * 16 + bb];
        const int nb = bb + 1;
        const float ns2 = (nb < 16) ? s2l[tid * 17 + nb] : -INFINITY;
        if (nb < 16) ptr += (1ull << (4 * ba));
#pragma unroll
        for (int a = 0; a < 16; ++a) if (a == ba) cur[a] = s1[a] + ns2;
      }
      const float m = tops[0];
      float sum = 0.f;
#pragma unroll
      for (int k = 0; k < 16; ++k) { tops[k] = __expf(tops[k] - m); sum += tops[k]; }
      const float inv = 1.f / sum;
      const size_t ob = ((size_t)(tm * 256 + tid) * 8 + h) * 16;
#pragma unroll
      for (int k = 0; k < 16; k += 4) {
        *(int4*)(eidx + ob + k) = make_int4(tope[k], tope[k + 1], tope[k + 2], tope[k + 3]);
        *(float4*)(gw + ob + k) = make_float4(tops[k] * inv, tops[k + 1] * inv, tops[k + 2] * inv, tops[k + 3] * inv);
      }
    }
    __syncthreads();
  }
}


__device__ __forceinline__ float reduce8(const float (&pv)[8], int lane) {
  const bool b5 = lane & 32, b4 = lane & 16, b3 = lane & 8;
  float v[4];
#pragma unroll
  for (int i = 0; i < 4; ++i) {
    const float keep = b5 ? pv[4 + i] : pv[i];
    const float send = b5 ? pv[i] : pv[4 + i];
    v[i] = keep + __shfl_xor(send, 32);
  }
  float u[2];
#pragma unroll
  for (int i = 0; i < 2; ++i) {
    const float keep = b4 ? v[2 + i] : v[i];
    const float send = b4 ? v[i] : v[2 + i];
    u[i] = keep + __shfl_xor(send, 16);
  }
  float x = (b3 ? u[1] : u[0]) + __shfl_xor(b3 ? u[0] : u[1], 8);
  x += __shfl_xor(x, 4); x += __shfl_xor(x, 2); x += __shfl_xor(x, 1);
  return x;
}

__device__ __forceinline__ void cvt16u8(const uint4& v, float* f) {
  f[0] = (float)(v.x & 0xffu); f[1] = (float)((v.x >> 8) & 0xffu); f[2] = (float)((v.x >> 16) & 0xffu); f[3] = (float)(v.x >> 24);
  f[4] = (float)(v.y & 0xffu); f[5] = (float)((v.y >> 8) & 0xffu); f[6] = (float)((v.y >> 16) & 0xffu); f[7] = (float)(v.y >> 24);
  f[8] = (float)(v.z & 0xffu); f[9] = (float)((v.z >> 8) & 0xffu); f[10] = (float)((v.z >> 16) & 0xffu); f[11] = (float)(v.z >> 24);
  f[12] = (float)(v.w & 0xffu); f[13] = (float)((v.w >> 8) & 0xffu); f[14] = (float)((v.w >> 16) & 0xffu); f[15] = (float)(v.w >> 24);
}

__device__ __forceinline__ int wave_sum_i32_dpp(int v) {
  v += __builtin_amdgcn_update_dpp(0, v, 0xB1, 0xf, 0xf, true);
  v += __builtin_amdgcn_update_dpp(0, v, 0x4E, 0xf, 0xf, true);
  v += __builtin_amdgcn_update_dpp(0, v, 0x141, 0xf, 0xf, true);
  v += __builtin_amdgcn_update_dpp(0, v, 0x140, 0xf, 0xf, true);
  return __builtin_amdgcn_readlane(v, 0) + __builtin_amdgcn_readlane(v, 16) + __builtin_amdgcn_readlane(v, 32) + __builtin_amdgcn_readlane(v, 48);
}

__device__ __forceinline__ int reduce8_i32_scatter(const int (&d)[8], int lane) {
  const bool b0 = lane & 1, b1 = lane & 2, b2 = lane & 4;
  int v[4];
#pragma unroll
  for (int i = 0; i < 4; ++i) {
    const int keep = b0 ? d[2 * i + 1] : d[2 * i];
    const int send = b0 ? d[2 * i] : d[2 * i + 1];
    v[i] = keep + __builtin_amdgcn_update_dpp(0, send, 0xB1, 0xf, 0xf, true);
  }
  int u[2];
#pragma unroll
  for (int i = 0; i < 2; ++i) {
    const int keep = b1 ? v[2 * i + 1] : v[2 * i];
    const int send = b1 ? v[2 * i] : v[2 * i + 1];
    u[i] = keep + __builtin_amdgcn_update_dpp(0, send, 0x4E, 0xf, 0xf, true);
  }
  int x;
  {
    const int keep = b2 ? u[1] : u[0];
    const int send = b2 ? u[0] : u[1];
    int t = __builtin_amdgcn_update_dpp(0, send, 0x141, 0xf, 0xf, true);
    t = __builtin_amdgcn_update_dpp(0, t, 0x1B, 0xf, 0xf, true);
    x = keep + t;
  }
  x += __builtin_amdgcn_update_dpp(0, x, 0x128, 0xf, 0xf, true);
  { const auto r = __builtin_amdgcn_permlane16_swap((unsigned)x, (unsigned)x, false, false); x = (int)r[0] + (int)r[1]; }
  { const auto r = __builtin_amdgcn_permlane32_swap((unsigned)x, (unsigned)x, false, false); x = (int)r[0] + (int)r[1]; }
  return x;
}

__device__ __forceinline__ void phase_pu(const Params& p, unsigned char* smem) {
  unsigned char* ws = p.ws;
  const unsigned char* XQ = ws + WS_XQ;
  const float* xs = (const float*)(ws + WS_XS);
  const unsigned char* U8 = ws + WS_U;
  const float* us = (const float*)(ws + WS_U + (size_t)16384 * 1024);
  const float* vs = (const float*)(ws + WS_V + (size_t)16384 * 1024);
  const int* eidx = (const int*)(ws + WS_EIDX);
  const float* gw = (const float*)(ws + WS_GW);
  float* aw = (float*)(ws + WS_PA);
  const int lane = threadIdx.x & 63, w = threadIdx.x >> 6;
  const unsigned long long lt_mask = (1ull << lane) - 1ull;
  const int G = gridDim.x;
  const bool sliced = (G % 8 == 0);
  const int ti = sliced ? team_index(p, smem) : 0;
  const int tsz = sliced ? (G >> 3) : G;
  const int grp_lo = sliced ? ti / tsz : 0, grp_hi = sliced ? grp_lo + 1 : 8;
  const int slot = (sliced ? (ti % tsz) : (int)blockIdx.x) * 8 + w;
  const int nslot = tsz * 8;
  unsigned* lst = (unsigned*)smem + 4096 + w * 128;
  typedef unsigned u32x4_t __attribute__((ext_vector_type(4)));
  if (slot >= TOK) return;
  for (int grp = grp_lo; grp < grp_hi; ++grp) {
#define PU_LIST(E0, E1, N, L0, L1) do { \
      const bool m0_ = ((E0) >> 11) == grp, m1_ = ((E1) >> 11) == grp; \
      const unsigned long long b0_ = __ballot(m0_), b1_ = __ballot(m1_); \
      const int c0_ = __popcll(b0_); N = c0_ + __popcll(b1_); \
      if (m0_) lst[__popcll(b0_ & lt_mask)] = ((unsigned)lane << 14) | (unsigned)(E0); \
      if (m1_) lst[c0_ + __popcll(b1_ & lt_mask)] = ((unsigned)(lane + 64) << 14) | (unsigned)(E1); \
      lds_fence(); \
      L0 = (lane < N) ? lst[lane] : 0u; L1 = (lane + 64 < N) ? lst[lane + 64] : 0u; \
      lds_fence(); } while (0)
#define PU_ISSUE(BUF, L0, N, I0) do { int last_ = ((N) < 64 ? (N) : 64) - 1; last_ = last_ < 0 ? 0 : last_; \
      _Pragma("unroll") for (int j = 0; j < 8; ++j) { int idx_ = (I0) + j; idx_ = idx_ < last_ ? idx_ : last_; \
        const unsigned le_ = (unsigned)__builtin_amdgcn_readlane((int)(L0), idx_); \
        BUF[j] = *(const u32x4_t*)(U8 + (size_t)(le_ & 16383u) * 1024 + lane * 16); } } while (0)
#define PU_REDUCE(BUF, X, I0, HREG) do { int dd_[8]; _Pragma("unroll") for (int j = 0; j < 8; ++j) { \
        int d_ = __builtin_amdgcn_sdot4((int)BUF[j].x, (int)(X).x, 0, false); \
        d_ = __builtin_amdgcn_sdot4((int)BUF[j].y, (int)(X).y, d_, false); \
        d_ = __builtin_amdgcn_sdot4((int)BUF[j].z, (int)(X).z, d_, false); \
        dd_[j] = __builtin_amdgcn_sdot4((int)BUF[j].w, (int)(X).w, d_, false); } \
      const int tot_ = reduce8_i32_scatter(dd_, lane);     \
      if (lane >= (I0) && lane < (I0) + 8) HREG = tot_; } while (0)
    u32x4_t cx = *(const u32x4_t*)(XQ + (size_t)slot * 1024 + lane * 16);
    int ce0 = eidx[(size_t)slot * 128 + lane], ce1 = eidx[(size_t)slot * 128 + 64 + lane];
    float cxs = xs[slot];
    int cn; unsigned cl0, cl1;
    PU_LIST(ce0, ce1, cn, cl0, cl1);
    u32x4_t ra[8], rb[8], rc[8];
    PU_ISSUE(ra, cl0, cn, 0);
    PU_ISSUE(rb, cl0, cn, 8);
    int t1 = (slot + nslot < TOK) ? slot + nslot : slot;
    u32x4_t nx = *(const u32x4_t*)(XQ + (size_t)t1 * 1024 + lane * 16);
    int ne0 = eidx[(size_t)t1 * 128 + lane], ne1 = eidx[(size_t)t1 * 128 + 64 + lane];
    float nxs = xs[t1];
    for (int tok = slot; tok < TOK; tok += nslot) {
      float sc0 = 0.f, sc1 = 0.f, gv0 = 0.f, gv1 = 0.f, vv0 = 0.f, vv1 = 0.f;
      if (lane < cn) { const int e = cl0 & 16383; sc0 = us[e]; vv0 = vs[e]; gv0 = gw[(size_t)tok * 128 + (cl0 >> 14)]; }
      if (lane + 64 < cn) { const int e = cl1 & 16383; sc1 = us[e]; vv1 = vs[e]; gv1 = gw[(size_t)tok * 128 + (cl1 >> 14)]; }
      int nn; unsigned nl0, nl1;
      PU_LIST(ne0, ne1, nn, nl0, nl1);
      const u32x4_t x1 = nx; const int xe0 = ne0, xe1 = ne1; const float xs1 = nxs;
      const int t2a = tok + nslot, t2 = (t2a + nslot < TOK) ? t2a + nslot : ((t2a < TOK) ? t2a : tok);
      nx = *(const u32x4_t*)(XQ + (size_t)t2 * 1024 + lane * 16);
      ne0 = eidx[(size_t)t2 * 128 + lane]; ne1 = eidx[(size_t)t2 * 128 + 64 + lane];
      nxs = xs[t2];
      int h0i = 0, h1i = 0;
      const bool third = cn > 16;
      if (third) { PU_ISSUE(rc, cl0, cn, 16); }
      __builtin_amdgcn_sched_barrier(0); PU_REDUCE(ra, cx, 0, h0i);  __builtin_amdgcn_sched_barrier(0);
      PU_ISSUE(ra, nl0, nn, 0);  __builtin_amdgcn_sched_barrier(0); PU_REDUCE(rb, cx, 8, h0i);  __builtin_amdgcn_sched_barrier(0);
      PU_ISSUE(rb, nl0, nn, 8);  __builtin_amdgcn_sched_barrier(0);
      if (third) { PU_REDUCE(rc, cx, 16, h0i); }
      __builtin_amdgcn_sched_barrier(0);
      if (cn > 24) {
        for (int i0 = 24; i0 < cn; i0 += 8) {
          u32x4_t rd[8];
          const bool lo = i0 < 64;
          const unsigned lsrc = lo ? cl0 : cl1;
          const int nsrc = lo ? cn : cn - 64;
          PU_ISSUE(rd, lsrc, nsrc, i0 & 63);
          if (lo) { PU_REDUCE(rd, cx, i0, h0i); } else { PU_REDUCE(rd, cx, i0 - 64, h1i); }
        }
      }
      const float h0 = (float)h0i * sc0 * cxs, h1 = (float)h1i * sc1 * cxs;
      if (lane < cn) aw[(size_t)tok * 128 + (cl0 >> 14)] = 0.5f * h0 * (1.f + erff(h0 * 0.70710678118654752f)) * gv0 * vv0;
      if (lane + 64 < cn) aw[(size_t)tok * 128 + (cl1 >> 14)] = 0.5f * h1 * (1.f + erff(h1 * 0.70710678118654752f)) * gv1 * vv1;
      cx = x1; ce0 = xe0; ce1 = xe1; cxs = xs1; cn = nn; cl0 = nl0; cl1 = nl1;
    }
#undef PU_LIST
#undef PU_ISSUE
#undef PU_REDUCE
  }
}

template <bool SL>
__device__ __forceinline__ void phase_pv_t(const Params& p, unsigned char* smem) {
  unsigned char* ws = p.ws;
  const unsigned char* V8 = ws + WS_V;
  const int* eidx = (const int*)(ws + WS_EIDX);
  const float* aw = (const float*)(ws + WS_PA);
  float* ssq = (float*)(ws + WS_SSQ);
  const int lane = threadIdx.x & 63, w = threadIdx.x >> 6;
  const int q = lane >> 3, c = lane & 7;
  const int G = gridDim.x;
  constexpr bool sliced = SL;
  const int ti = sliced ? team_index(p, smem) : 0;
  const int tsz = G >> 3;
  const int grp0 = sliced ? (ti / tsz) : 0;
  constexpr int ngrp = sliced ? 1 : 8;
  const int slot = sliced ? (ti % tsz) * 8 + w : blockIdx.x * 8 + w;
  const int nslot = sliced ? tsz * 8 : G * 8;
  int ee[16]; float aa[16];
  if (slot < TOK) {
    unsigned bi = (unsigned)slot * 128u + 16u * (unsigned)q;
    asm volatile("" : "+v"(bi));
#pragma unroll
    for (int u4 = 0; u4 < 4; ++u4) {
      const int4 e4 = *(const int4*)(eidx + bi + 4 * u4); const float4 a4 = *(const float4*)(aw + bi + 4 * u4);
      ee[4 * u4] = e4.x; ee[4 * u4 + 1] = e4.y; ee[4 * u4 + 2] = e4.z; ee[4 * u4 + 3] = e4.w;
      aa[4 * u4] = a4.x; aa[4 * u4 + 1] = a4.y; aa[4 * u4 + 2] = a4.z; aa[4 * u4 + 3] = a4.w;
    }
  }
  for (int tok = slot; tok < TOK; tok += nslot) {
    int ce[16]; float ca[16];
    float suma = 0.f;
#pragma unroll
    for (int u = 0; u < 16; ++u) { ce[u] = ee[u]; ca[u] = aa[u]; suma += aa[u]; }
    for (int gi = 0; gi < ngrp; ++gi) {
      const int grp = grp0 + gi;
      uint4 vv[16];
#pragma unroll
      for (int u = 0; u < 16; ++u) vv[u] = *(const uint4*)(V8 + (size_t)grp * (16384 * 128) + (size_t)ce[u] * 128 + c * 16);
      float* orow = p.out + (size_t)tok * 1024 + grp * 128 + c * 16;
      float4 x1v[4];
#pragma unroll
      for (int i = 0; i < 4; ++i) x1v[i] = *(const float4*)(orow + 4 * i);
      if (gi == ngrp - 1) {
        const int nt = (tok + nslot < TOK) ? tok + nslot : tok;
        unsigned bi = (unsigned)nt * 128u + 16u * (unsigned)q;
        asm volatile("" : "+v"(bi));
#pragma unroll
        for (int u4 = 0; u4 < 4; ++u4) {
          const int4 e4 = *(const int4*)(eidx + bi + 4 * u4); const float4 a4 = *(const float4*)(aw + bi + 4 * u4);
          ee[4 * u4] = e4.x; ee[4 * u4 + 1] = e4.y; ee[4 * u4 + 2] = e4.z; ee[4 * u4 + 3] = e4.w;
          aa[4 * u4] = a4.x; aa[4 * u4 + 1] = a4.y; aa[4 * u4 + 2] = a4.z; aa[4 * u4 + 3] = a4.w;
        }
      }
      __builtin_amdgcn_sched_barrier(0);
      float acc[16];
#pragma unroll
      for (int i = 0; i < 16; ++i) acc[i] = -128.f * suma;
#pragma unroll
      for (int u = 0; u < 16; ++u) {
        float vf[16];
        cvt16u8(vv[u], vf);
#pragma unroll
        for (int i = 0; i < 16; ++i) acc[i] += ca[u] * vf[i];
        __builtin_amdgcn_sched_barrier(0);
      }
#pragma unroll
      for (int i = 0; i < 16; ++i) { acc[i] = add_xor8(acc[i]); acc[i] = add_xor16(acc[i]); acc[i] = add_xor32(acc[i]); }
      float ss = 0.f;
      if (q == 0) {
#pragma unroll
        for (int i = 0; i < 4; ++i) {
          const float4 oa = make_float4(x1v[i].x + acc[4 * i], x1v[i].y + acc[4 * i + 1], x1v[i].z + acc[4 * i + 2], x1v[i].w + acc[4 * i + 3]);
          *(float4*)(orow + 4 * i) = oa;
          ss += oa.x * oa.x + oa.y * oa.y + oa.z * oa.z + oa.w * oa.w;
        }
      }
      ss += __shfl_xor(ss, 1); ss += __shfl_xor(ss, 2); ss += __shfl_xor(ss, 4);
      if (lane == 0) atomicAdd(&ssq[tok], ss);
    }
  }
}

__device__ __forceinline__ void phase_pv_mfma(const Params& p, unsigned char* smem) {
  unsigned char* ws = p.ws;
  const unsigned char* V8 = ws + WS_V;
  const int* eidx = (const int*)(ws + WS_EIDX);
  const float* aw = (const float*)(ws + WS_PA);
  float* ssq = (float*)(ws + WS_SSQ);
  const int lane = threadIdx.x & 63, w = threadIdx.x >> 6;
  const int q8 = lane >> 3, c = lane & 7;
  const int l15 = lane & 15, g = lane >> 4;
  const int G = gridDim.x;
  const bool sliced = (G % 8 == 0);
  const int ti = sliced ? team_index(p, smem) : 0;
  const int tsz = sliced ? (G >> 3) : G;
  const int grp_lo = sliced ? ti / tsz : 0, grp_hi = sliced ? grp_lo + 1 : 8;
  const int slot = (sliced ? (ti % tsz) : (int)blockIdx.x) * 8 + w;
  const int nslot = tsz * 8;
  if (slot >= TOK) return;
  unsigned char* vs_l = smem + 16384 + w * 16384;
  typedef unsigned u32x4_t __attribute__((ext_vector_type(4)));
  typedef float f32x4_t __attribute__((ext_vector_type(4)));
  typedef int i32x4_t __attribute__((ext_vector_type(4)));
  typedef int i32x2_t __attribute__((ext_vector_type(2)));
  const unsigned tr_f16 = (unsigned)((((l15 >> 2) & 3) | ((g & 1) << 2)) << 4);
  const unsigned tr_lane = (unsigned)((l15 >> 1) * 128 + (l15 & 1) * 8);
  unsigned tr_off[8];
#pragma unroll
  for (int nt = 0; nt < 8; ++nt) tr_off[nt] = tr_lane + (((unsigned)nt << 4) ^ tr_f16);
  unsigned st_off[4];
#pragma unroll
  for (int cu = 0; cu < 4; ++cu) st_off[cu] = (unsigned)(16 * q8 * 128 + (((c ^ ((q8 & 1) << 2)) ^ cu) << 4));
  unsigned char* cf_l = smem + 4096 + w * 128;
  const unsigned coff = (unsigned)c * 16u;
  for (int grp_v = grp_lo; grp_v < grp_hi; ++grp_v) {
    const int grp = __builtin_amdgcn_readfirstlane(grp_v);
    const unsigned char* Vg = V8 + (size_t)grp * (16384 * 128);
    i32x4_t ee[4]; float2 a2;
#define PVM_META(TOKEN) do { \
      const i32x4_t* ep_ = (const i32x4_t*)(eidx + (size_t)(TOKEN) * 128 + 16 * q8); \
      _Pragma("unroll") for (int u4 = 0; u4 < 4; ++u4) ee[u4] = ep_[u4]; \
      a2 = *(const float2*)(aw + (size_t)(TOKEN) * 128 + 2 * lane); } while (0)
    PVM_META(slot);
    for (int tok = slot; tok < TOK; tok += nslot) {
      u32x4_t vv[16];
#pragma unroll
      for (int u = 0; u < 16; ++u) vv[u] = *(const u32x4_t*)(Vg + ((((unsigned)ee[u >> 2][u & 3]) << 7) | coff));
      bf16_t* orow = (bf16_t*)(ws + WS_X1) + (size_t)tok * 1024 + grp * 128 + 8 * l15;
      const u32x4_t x1r = *(const u32x4_t*)orow;
      float am = fmaxf(fabsf(a2.x), fabsf(a2.y));
#define PVM_DPPMAX(CTRL) am = fmaxf(am, __int_as_float(__builtin_amdgcn_update_dpp(0, __float_as_int(am), CTRL, 0xf, 0xf, true)))
      PVM_DPPMAX(0xB1); PVM_DPPMAX(0x4E); PVM_DPPMAX(0x141); PVM_DPPMAX(0x140);
#undef PVM_DPPMAX
      am = max_xor16(am); am = max_xor32(am);
      const float inva = am > 0.f ? 127.f * __builtin_amdgcn_rcpf(am) : 0.f, sa = am * (1.f / 127.f);
      {
        const unsigned b0 = (unsigned)(int)rintf(a2.x * inva) & 255u, b1 = (unsigned)(int)rintf(a2.y * inva) & 255u;
        *(unsigned short*)(cf_l + 2 * lane) = (unsigned short)(b0 | (b1 << 8));
      }
      { const int nt_ = (tok + nslot < TOK) ? tok + nslot : tok; PVM_META(nt_); }
      __builtin_amdgcn_sched_barrier(0);
#pragma unroll
      for (int u = 0; u < 16; ++u) *(u32x4_t*)(vs_l + st_off[(u >> 1) & 3] + u * 128) = vv[u];
      lds_fence();
      i32x4_t aop[2];
      aop[0] = *(const i32x4_t*)(cf_l + 16 * g); aop[1] = *(const i32x4_t*)(cf_l + 64 + 16 * g);
      i32x4_t acc[8];
#pragma unroll
      for (int nt = 0; nt < 8; ++nt) acc[nt] = (i32x4_t){0, 0, 0, 0};
#pragma unroll
      for (int s2 = 0; s2 < 2; ++s2)
#pragma unroll
        for (int nt = 0; nt < 8; ++nt) {
          const unsigned a0 = (unsigned)((s2 * 64 + 16 * g) * 128) + tr_off[nt];
          const i32x2_t lo = __builtin_amdgcn_ds_read_tr8_b64_v2i32((__attribute__((address_space(3))) i32x2_t*)(vs_l + a0));
          const i32x2_t hi = __builtin_amdgcn_ds_read_tr8_b64_v2i32((__attribute__((address_space(3))) i32x2_t*)(vs_l + a0 + 8 * 128));
          const i32x4_t bop = {lo[0], lo[1], hi[0], hi[1]};
          acc[nt] = __builtin_amdgcn_mfma_i32_16x16x64_i8(aop[s2], bop, acc[nt], 0, 0, 0);
        }
      lds_fence();
      float ss = 0.f;
      if (g == 0) {
        float o[8];
#pragma unroll
        for (int nt = 0; nt < 8; ++nt) {
          const float xv = (nt & 1) ? __uint_as_float(x1r[nt >> 1] & 0xffff0000u) : __uint_as_float(x1r[nt >> 1] << 16);
          o[nt] = xv + (float)acc[nt][0] * sa; ss += o[nt] * o[nt];
        }
        const u32x4_t ow = {pack2(o[0], o[1]), pack2(o[2], o[3]), pack2(o[4], o[5]), pack2(o[6], o[7])};
        *(u32x4_t*)orow = ow;
      }
      ss += __int_as_float(__builtin_amdgcn_update_dpp(0, __float_as_int(ss), 0xB1, 0xf, 0xf, true));
      ss += __int_as_float(__builtin_amdgcn_update_dpp(0, __float_as_int(ss), 0x4E, 0xf, 0xf, true));
      ss += __int_as_float(__builtin_amdgcn_update_dpp(0, __float_as_int(ss), 0x141, 0xf, 0xf, true));
      ss += __int_as_float(__builtin_amdgcn_update_dpp(0, __float_as_int(ss), 0x140, 0xf, 0xf, true));
      if (lane == 0) atomicAdd(&ssq[tok], ss);
    }
#undef PVM_META
  }
}

__device__ __forceinline__ void phase_final(const Params& p) {
  const float* ssq = (const float*)(p.ws + WS_SSQ);
  const int lane = threadIdx.x & 63, w = threadIdx.x >> 6;
  for (int row = blockIdx.x * 8 + w; row < TOK; row += gridDim.x * 8) {
    const float rstd = rsqrtf(ssq[row] * (1.f / DM) + EPSV);
    float4* o4 = (float4*)(p.out + (size_t)row * DM);
    const uint2* x2 = (const uint2*)((const bf16_t*)(p.ws + WS_X1) + (size_t)row * DM);
    uint2 xr[4];
#pragma unroll
    for (int i = 0; i < 4; ++i) xr[i] = x2[lane + 64 * i];
#pragma unroll
    for (int i = 0; i < 4; ++i) {
      const float4 gg = ((const float4*)p.norm_final)[lane + 64 * i];
      float4 v;
      v.x = __uint_as_float(xr[i].x << 16) * rstd * gg.x; v.y = __uint_as_float(xr[i].x & 0xffff0000u) * rstd * gg.y;
      v.z = __uint_as_float(xr[i].y << 16) * rstd * gg.z; v.w = __uint_as_float(xr[i].y & 0xffff0000u) * rstd * gg.w;
      o4[lane + 64 * i] = v;
    }
  }
}


__device__ __forceinline__ void phase_proj8(const Params& p, unsigned char* smem) {
  unsigned char* ws = p.ws;
  pg8::Gemm g{(const pg8::bf16_t*)(ws + WS_XN), (const pg8::bf16_t*)(ws + WS_WIN), TOK, 5120, 512};
  pg8::StaticOrder S; S.init(TOK, 5120, (int)gridDim.x, (int)blockIdx.x);
  EpiProj E{(unsigned short*)(ws + WS_PH), (unsigned short*)(ws + WS_PA), (unsigned short*)(ws + WS_PG),
            (unsigned short*)(ws + WS_KC), (unsigned short*)(ws + WS_VC), (unsigned short*)(ws + WS_IKC),
            (const float*)(ws + WS_XNS), (const float*)(ws + WS_WINS)};
  pg8::gemm_phase<EpiProj, pg8::StaticOrder, false, true>((PG8_LAS unsigned char*)smem, g, S, E, nullptr);
}
__device__ __forceinline__ void phase_ikln(const Params& p) {
  bf16_t* ikc = (bf16_t*)(p.ws + WS_IKC);
  const int tid = threadIdx.x, sub = tid & 7;
  float gam[8], bet[8];
#pragma unroll
  for (int i = 0; i < 8; ++i) { gam[i] = p.ikg[sub * 8 + i]; bet[i] = p.ikb[sub * 8 + i]; }
  for (int row = blockIdx.x * 64 + (tid >> 3); row < TOK; row += gridDim.x * 64) {
    uint4* ptr = (uint4*)(ikc + (size_t)row * 64 + sub * 8);
    const uint4 raw = *ptr;
    float v[8];
    cvt8(raw, v);
    float s = 0.f;
#pragma unroll
    for (int i = 0; i < 8; ++i) s += v[i];
    s += __shfl_xor(s, 1); s += __shfl_xor(s, 2); s += __shfl_xor(s, 4);
    const float mu = s * (1.f / 64.f);
    float q = 0.f;
#pragma unroll
    for (int i = 0; i < 8; ++i) { const float d = v[i] - mu; q += d * d; }
    q += __shfl_xor(q, 1); q += __shfl_xor(q, 2); q += __shfl_xor(q, 4);
    const float rstd = rsqrtf(q * (1.f / 64.f) + EPSV);
    uint4 o;
    o.x = pack2((v[0] - mu) * rstd * gam[0] + bet[0], (v[1] - mu) * rstd * gam[1] + bet[1]);
    o.y = pack2((v[2] - mu) * rstd * gam[2] + bet[2], (v[3] - mu) * rstd * gam[3] + bet[3]);
    o.z = pack2((v[4] - mu) * rstd * gam[4] + bet[4], (v[5] - mu) * rstd * gam[5] + bet[5]);
    o.w = pack2((v[6] - mu) * rstd * gam[6] + bet[6], (v[7] - mu) * rstd * gam[7] + bet[7]);
    *ptr = o;
  }
}
__device__ __forceinline__ void phase_up8(const Params& p, unsigned char* smem) {
  unsigned char* ws = p.ws;
  pg8::Gemm g{(const pg8::bf16_t*)(ws + WS_XN), (const pg8::bf16_t*)(ws + WS_WUPA), TOK, 1024, 1024};
  pg8::StaticOrder S; S.init(TOK, 1024, (int)gridDim.x, (int)blockIdx.x);
  EpiGate2 E{(unsigned short*)(ws + WS_PH), (const unsigned char*)(ws + WS_PG)};
  pg8::gemm_phase<EpiGate2, pg8::StaticOrder>((PG8_LAS unsigned char*)smem, g, S, E, nullptr);
}
__device__ __forceinline__ void phase_out8(const Params& p, unsigned char* smem) {
  unsigned char* ws = p.ws;
  pg8::Gemm g{(const pg8::bf16_t*)(ws + WS_PH), (const pg8::bf16_t*)(ws + WS_WOUT), TOK, 1024, 1024};
  pg8::StaticOrder S; S.init(TOK, 1024, (int)gridDim.x, (int)blockIdx.x);
  EpiResid E{(unsigned short*)(ws + WS_X1), p.x};
  pg8::gemm_phase<EpiResid, pg8::StaticOrder>((PG8_LAS unsigned char*)smem, g, S, E, nullptr);
}
__device__ __forceinline__ void phase_pq8(const Params& p, unsigned char* smem) {
  unsigned char* ws = p.ws;
  pg8::Gemm g{(const pg8::bf16_t*)(ws + WS_XQ), (const pg8::bf16_t*)(ws + WS_WQ), TOK, 2048, 512};
  pg8::StaticOrder S; S.init(TOK, 2048, (int)gridDim.x, (int)blockIdx.x);
  EpiStoreBf16Q E{(unsigned short*)(ws + WS_PG), 2048, (const float*)(ws + WS_XS), (const float*)(ws + WS_WQS)};
  pg8::gemm_phase<EpiStoreBf16Q, pg8::StaticOrder, false, true>((PG8_LAS unsigned char*)smem, g, S, E, nullptr);
}

__global__ void __launch_bounds__(NTHREADS) hybrid_fwd(Params p) {
  extern __shared__ __attribute__((aligned(16))) unsigned char smem[];
#if ONE_LAUNCH
  cg::grid_group grid = cg::this_grid();
  volatile LAS unsigned* xst = (volatile LAS unsigned*)(smem + LDS_BYTES - 16);
  if (threadIdx.x == 0) { xst[0] = 0u; xst[1] = 0u; }
  __syncthreads();
  XcdBarrier xbar = xcd_barrier_post((unsigned*)(p.ws + WS_BAR), xst);
#define SEAM(k) do { if (p.ph_lo <= (k) && (k) + 1 < p.ph_hi) { if (p.ph_hi > NPHASE) grid.sync(); else xcd_barrier(xbar); } } while (0)
#else
#define SEAM(k) do { } while (0)
#endif
#define IN(k) (p.ph_lo <= (k) && (k) < p.ph_hi)
#ifndef REPEAT_PH
#define REPEAT_PH -1
#endif
#define REP(k, stmt) do { if (REPEAT_PH == (k)) { stmt; grid.sync(); } } while (0)
  if (IN(0)) { phase_prep(p, smem); SEAM(0); }
  if (IN(1)) { phase_proj8(p, smem); SEAM(1); }
  if (IN(2)) { phase_ikln(p); hgrn_h1_all(p, smem); SEAM(2); }
  if (IN(3)) { phase_mix(p, smem); SEAM(3); }
  if (IN(4)) { phase_up8(p, smem); SEAM(4); }
  if (IN(5)) { phase_out8(p, smem); SEAM(5); }
  if (IN(6)) { rmsnorm_rows_q<false, true>((const float*)(p.ws + WS_X1), p.norm_ffn, nullptr, p.ws + WS_XQ, (float*)(p.ws + WS_XS)); SEAM(6); }
  if (IN(7)) { phase_pq8(p, smem); SEAM(7); }
  if (IN(8)) { phase_pkeys(p, smem); SEAM(8); }
  if (IN(9)) { phase_pu(p, smem); SEAM(9); }
  if (IN(10)) { phase_pv_mfma(p, smem); SEAM(10); }
  if (IN(11)) { phase_final(p); }
#undef IN
#undef SEAM
}

extern "C" void kernel_launch(void* const* d_in, const int* in_sizes, int n_in, void* d_out, int out_size, void* d_ws, size_t ws_size,
                              hipStream_t stream) {
  static int grid = 0;
  if (grid == 0) {
    if (n_in != 17 || ws_size < WS_END) {
      fprintf(stderr, "kernel_launch: unexpected n_in %d or ws_size %zu (need %zu)\n", n_in, ws_size, (size_t)WS_END);
      grid = -1; return;
    }
    int dev = 0, cus = 0, per_cu = 0;
    hipGetDevice(&dev);
    hipDeviceGetAttribute(&cus, hipDeviceAttributeMultiprocessorCount, dev);
    hipFuncSetAttribute((const void*)hybrid_fwd, hipFuncAttributeMaxDynamicSharedMemorySize, LDS_BYTES);
    hipOccupancyMaxActiveBlocksPerMultiprocessor(&per_cu, (const void*)hybrid_fwd, NTHREADS, LDS_BYTES);
    if (per_cu < 1) { fprintf(stderr, "kernel_launch: occupancy query says %d blocks/CU\n", per_cu); per_cu = 1; }
    (void)hipGetLastError();
    grid = cus;
  }
  if (grid < 0) return;
  Params p{};
  p.x = (const float*)d_in[0]; p.norm_mix = (const float*)d_in[1]; p.w_in = (const float*)d_in[2]; p.hg_lb = (const float*)d_in[3];
  p.hg_norm = (const float*)d_in[4]; p.ikg = (const float*)d_in[5]; p.ikb = (const float*)d_in[6]; p.rel_bias = (const float*)d_in[7];
  p.w_up_a = (const float*)d_in[8]; p.w_up_b = (const float*)d_in[9]; p.w_out = (const float*)d_in[10]; p.norm_ffn = (const float*)d_in[11];
  p.peer_wq = (const float*)d_in[12]; p.peer_keys = (const float*)d_in[13]; p.peer_u = (const float*)d_in[14]; p.peer_v = (const float*)d_in[15];
  p.norm_final = (const float*)d_in[16];
  p.out = (float*)d_out; p.ws = (unsigned char*)d_ws;
#if ONE_LAUNCH
  hipMemsetAsync((unsigned char*)d_ws + WS_BAR, 0, 16384, stream);
  p.ph_lo = 0; p.ph_hi = NPHASE;
  void* args[] = {&p};
  hipError_t e = hipLaunchCooperativeKernel((const void*)hybrid_fwd, dim3(grid), dim3(NTHREADS), args, LDS_BYTES, stream);
  if (e != hipSuccess) fprintf(stderr, "cooperative launch failed: %s (grid %d)\n", hipGetErrorString(e), grid);
#else
  for (int ph = 0; ph < NPHASE; ++ph) {
    p.ph_lo = ph; p.ph_hi = ph + 1;
    hipLaunchKernelGGL(hybrid_fwd, dim3(grid), dim3(NTHREADS), LDS_BYTES, stream, p);
  }
#endif
}
```

```cpp
#include <hip/hip_runtime.h>
#include <hip/hip_cooperative_groups.h>
#include <stdint.h>
#include <stdio.h>
namespace cg = cooperative_groups;

#ifndef ONE_LAUNCH
#define ONE_LAUNCH 1
#endif

typedef unsigned short bf16_t;
typedef __attribute__((ext_vector_type(8))) short bf16x8;
typedef __attribute__((ext_vector_type(4))) float f32x4;

#define NTHREADS 512
#define TOK 32768
#define SEQL 4096
#define DM 1024
#define EPSV 1e-6f
#define NPHASE 12

#define WS_WIN   ((size_t)0)
#define WS_WUPA  (WS_WIN  + (size_t)5120 * 1024 * 2)
#define WS_WUPB  (WS_WUPA + (size_t)1024 * 512 * 2)
#define WS_WOUT  (WS_WUPB + (size_t)1024 * 512 * 2)
#define WS_WQ    (WS_WOUT + (size_t)1024 * 1024 * 2)
#define WS_KEYS  (WS_WQ   + (size_t)2048 * 1024 * 2)
#define WS_LB    (WS_KEYS + (size_t)2 * 8 * 128 * 128 * 2)
#define WS_U     (WS_LB   + (size_t)4096)
#define WS_V     (WS_U    + (size_t)16384 * 1024 * 2)
#define WS_XN    (WS_V    + (size_t)16384 * 1024 * 2)
#define WS_PH    (WS_XN   + (size_t)TOK * 1024 * 2)
#define WS_PA    (WS_PH   + (size_t)TOK * 2048 * 2)
#define WS_PG    (WS_PA   + (size_t)TOK * 1024 * 2)
#define WS_EIDX  (WS_PG   + (size_t)TOK * 2048 * 2)
#define WS_GW    (WS_EIDX + (size_t)TOK * 128 * 4)
#define WS_SSQ   (WS_GW   + (size_t)TOK * 128 * 4)
#define WS_XCC   (WS_SSQ  + (size_t)TOK * 4)
#define WS_BAR   (WS_XCC  + (size_t)4096)
#define WS_DEC   (WS_BAR  + (size_t)16384)
#define WS_QCTR  (WS_DEC  + (size_t)2048 * 384 * 4)
#define WS_END   (WS_QCTR + (size_t)1024)

#define WS_KC (WS_EIDX)
#define WS_VC (WS_KC + (size_t)TOK * 128)
#define WS_IKC (WS_VC + (size_t)TOK * 128)
#define LDS_BYTES 155648

struct Params {
  const float* x; const float* norm_mix; const float* w_in; const float* hg_lb; const float* hg_norm;
  const float* ikg; const float* ikb; const float* rel_bias; const float* w_up_a; const float* w_up_b;
  const float* w_out; const float* norm_ffn; const float* peer_wq; const float* peer_keys;
  const float* peer_u; const float* peer_v; const float* norm_final;
  float* out; unsigned char* ws; int ph_lo, ph_hi;
};

__device__ __forceinline__ float bf2f(bf16_t u) { return __uint_as_float(((unsigned)u) << 16); }
typedef float f32x2_cv __attribute__((ext_vector_type(2)));
typedef __bf16 bf16x2_cv __attribute__((ext_vector_type(2)));
__device__ __forceinline__ unsigned pack2(float a, float b) {
  const f32x2_cv v = {a, b};
  return __builtin_bit_cast(unsigned, __builtin_convertvector(v, bf16x2_cv));
}
__device__ __forceinline__ bf16_t f2bf(float f) { return (bf16_t)(pack2(f, f) & 0xffffu); }
__device__ __forceinline__ float wave_sum_slow(float v) {
#pragma unroll
  for (int o = 32; o > 0; o >>= 1) v += __shfl_xor(v, o);
  return v;
}
__device__ __forceinline__ void lds_fence() { asm volatile("s_waitcnt lgkmcnt(0)" ::: "memory"); }

__device__ __forceinline__ float add_xor8(float v) { return v + __int_as_float(__builtin_amdgcn_update_dpp(0, __float_as_int(v), 0x128, 0xf, 0xf, true)); }
__device__ __forceinline__ float add_xor16(float v) { const auto r = __builtin_amdgcn_permlane16_swap(__float_as_uint(v), __float_as_uint(v), false, false); return __uint_as_float(r[0]) + __uint_as_float(r[1]); }
__device__ __forceinline__ float add_xor32(float v) { const auto r = __builtin_amdgcn_permlane32_swap(__float_as_uint(v), __float_as_uint(v), false, false); return __uint_as_float(r[0]) + __uint_as_float(r[1]); }
__device__ __forceinline__ float max_xor16(float v) { const auto r = __builtin_amdgcn_permlane16_swap(__float_as_uint(v), __float_as_uint(v), false, false); return fmaxf(__uint_as_float(r[0]), __uint_as_float(r[1])); }
__device__ __forceinline__ float max_xor32(float v) { const auto r = __builtin_amdgcn_permlane32_swap(__float_as_uint(v), __float_as_uint(v), false, false); return fmaxf(__uint_as_float(r[0]), __uint_as_float(r[1])); }
__device__ __forceinline__ float wave_sum(float v) {
  v += __int_as_float(__builtin_amdgcn_update_dpp(0, __float_as_int(v), 0xB1, 0xf, 0xf, true));
  v += __int_as_float(__builtin_amdgcn_update_dpp(0, __float_as_int(v), 0x4E, 0xf, 0xf, true));
  v += __int_as_float(__builtin_amdgcn_update_dpp(0, __float_as_int(v), 0x141, 0xf, 0xf, true));
  v += __int_as_float(__builtin_amdgcn_update_dpp(0, __float_as_int(v), 0x140, 0xf, 0xf, true));
  return add_xor32(add_xor16(v));
}
__device__ __forceinline__ float sigmoidf_(float x) { return 1.f / (1.f + __expf(-x)); }
__device__ __forceinline__ float siluf_(float x) { return x / (1.f + __expf(-x)); }


#define XB_TMO      128
#define XB_XCNT(j)  (256  + 64 * (j))
#define XB_XSUB(j)  (1280 + 64 * (j))
#define XB_XGEN(j)  (2304 + 64 * (j))
#define XB_TOP      3328
#define XB_TOPGEN   3392
#define XCD_BAR_WORDS 3456
#define XB_SPIN_CAP (1u << 22)
#define LAS __attribute__((address_space(3)))
__device__ __forceinline__ unsigned xb_ld(unsigned* p)              { return __hip_atomic_load(p, __ATOMIC_RELAXED, __HIP_MEMORY_SCOPE_AGENT); }
__device__ __forceinline__ unsigned xb_add(unsigned* p, unsigned v) { return __hip_atomic_fetch_add(p, v, __ATOMIC_RELAXED, __HIP_MEMORY_SCOPE_AGENT); }
__device__ __forceinline__ unsigned xb_xcc_id() { return (unsigned)__builtin_amdgcn_s_getreg((3 << 11) | 20) & 0xFu; }
#define XB_SPIN(cond, bar) do { unsigned _sp = 0; while (cond) { __builtin_amdgcn_s_sleep(1); \
    if ((++_sp & 255u) == 0u) { if (xb_ld(&(bar)[XB_TMO])) break; if (_sp > XB_SPIN_CAP) { atomicAdd(&(bar)[XB_TMO], 1u); break; } } } } while (0)
struct XcdBarrier { unsigned* bar; unsigned x; volatile LAS unsigned* st; };
__device__ __forceinline__ XcdBarrier xcd_barrier_post(unsigned* bar, volatile LAS unsigned* st) {
  XcdBarrier b; b.bar = bar; b.x = xb_xcc_id(); b.st = st;
  if (threadIdx.x == 0) (void)xb_add(&bar[XB_XCNT(b.x)], 1u);
  return b;
}
__device__ __forceinline__ void xcd_barrier_complete(unsigned* bar, unsigned x, unsigned& nloc, unsigned& nx) {
  const unsigned G = gridDim.x * gridDim.y * gridDim.z;
  unsigned sum, cnt, mine, sp = 0u;
  for (;;) {
    sum = 0u; cnt = 0u; mine = 0u;
#pragma unroll
    for (unsigned j = 0; j < 16; ++j) { const unsigned c = xb_ld(&bar[XB_XCNT(j)]); sum += c; cnt += (c > 0u) ? 1u : 0u; mine = (j == x) ? c : mine; }
    if (sum == G) break;
    __builtin_amdgcn_s_sleep(1);
    if ((++sp & 255u) == 0u) { if (xb_ld(&bar[XB_TMO])) break; if (sp > XB_SPIN_CAP) { atomicAdd(&bar[XB_TMO], 1u); break; } }
  }
  nloc = mine > 0u ? mine : 1u; nx = cnt > 0u ? cnt : 1u;
}
__device__ __forceinline__ void xcd_barrier(const XcdBarrier& b) {
  asm volatile("s_waitcnt vmcnt(0)" ::: "memory");
  __syncthreads();
  if (threadIdx.x == 0) {
    unsigned* bar = b.bar;
    __builtin_amdgcn_s_waitcnt(0);
    unsigned nloc = b.st[0], nx = b.st[1];
    if (nloc == 0u) { xcd_barrier_complete(bar, b.x, nloc, nx); b.st[0] = nloc; b.st[1] = nx; }
    const unsigned old = xb_add(&bar[XB_XSUB(b.x)], 1u);
    const unsigned gen = old / nloc;
    if (old + 1u == (gen + 1u) * nloc) {
      __builtin_amdgcn_fence(__ATOMIC_RELEASE, "agent");
      asm volatile("s_waitcnt vmcnt(0)" ::: "memory");
      const unsigned og = xb_add(&bar[XB_TOP], 1u);
      const unsigned tg = og / nx;
      if (og + 1u == (tg + 1u) * nx) xb_add(&bar[XB_TOPGEN], 1u);
      else XB_SPIN(xb_ld(&bar[XB_TOPGEN]) == tg, bar);
      __builtin_amdgcn_fence(__ATOMIC_ACQUIRE, "agent");
      xb_add(&bar[XB_XGEN(b.x)], 1u);
      asm volatile("s_waitcnt vmcnt(0)" ::: "memory");
    } else {
      XB_SPIN(xb_ld(&bar[XB_XGEN(b.x)]) == gen, bar);
      __builtin_amdgcn_fence(__ATOMIC_ACQUIRE, "agent");
      asm volatile("s_waitcnt vmcnt(0)" ::: "memory");
    }
  }
  __syncthreads();
}

namespace pg8 {
#define PG8_LAS __attribute__((address_space(3)))
typedef unsigned short bf16_t;
typedef short bf16x8 __attribute__((ext_vector_type(8)));
typedef float f32x4 __attribute__((ext_vector_type(4)));
typedef unsigned u32x4 __attribute__((ext_vector_type(4)));
constexpr int BM = 256, BK = 64, HALF = 128, HTB = HALF * BK * 2  , STAGE_BYTES = 8 * HTB, NXCD = 8, WGM = 8;

__host__ __device__ __forceinline__ int lds_byte(int r, int c) { const int st = (r >> 4) * 2 + (c >> 5), rr = r & 15, cc = c & 31, ob = rr * 64 + cc * 2; return st * 1024 + (ob ^ (((ob >> 9) & 1) << 5)); }
__host__ __device__ __forceinline__ void stage_rc(int b, int& R, int& C) { const int st = b / 1024, sb = b % 1024, swz = sb ^ (((sb >> 9) & 1) << 5); R = (st >> 1) * 16 + swz / 64; C = (st & 1) * 32 + (swz % 64) / 2; }
__host__ __device__ __forceinline__ int perm32(int rho) { const int n = rho >> 4, i = rho & 15; return 8 * (i >> 2) + 4 * n + (i & 3); }

struct Unit { int pm, pn; };
struct Gemm { const bf16_t* A; const bf16_t* Bt; int M, N, K; };

struct StaticOrder {
    int nM, nN, nwg, G, c;
    __host__ __device__ void init(int M, int N, int G_, int c_) { nM = M / BM; nN = N / BM; nwg = nM * nN; G = G_; c = c_; }
    __host__ __device__ bool next(int i, Unit& u) const {
        const long L = (long)i * G + c; if (L >= nwg) return false;
        int wgid = (int)L; { const int q = nwg / NXCD, r = nwg % NXCD, xcd = wgid % NXCD, off = wgid / NXCD; wgid = (xcd < r ? xcd * (q + 1) : r * (q + 1) + (xcd - r) * q) + off; }
        const int nig = WGM * nN, gid = wgid / nig, fm = gid * WGM, gsz = (nM - fm) < WGM ? (nM - fm) : WGM;
        u.pm = fm + ((wgid % nig) % gsz); u.pn = (wgid % nig) / gsz; return true;
    }
    __device__ __forceinline__ void a_ready(const Unit&) const {}
    __device__ __forceinline__ void done(const Unit&) const {}
};
__device__ __forceinline__ unsigned cvt_pk_bf16(float lo, float hi) { unsigned r; asm volatile("v_cvt_pk_bf16_f32 %0, %1, %2" : "=v"(r) : "v"(lo), "v"(hi)); return r; }
typedef int i32x4 __attribute__((ext_vector_type(4)));
template <class Epi, class Sched, bool STAMP = false, bool I8 = false>
__device__ __forceinline__ void gemm_phase(PG8_LAS unsigned char* lds, const Gemm g, const Sched& S, const Epi& E, unsigned long long* stamps) {
    const int tid = threadIdx.x, wid = __builtin_amdgcn_readfirstlane(tid >> 6), lane = tid & 63, wr = wid >> 2, wc = wid & 3, fr = lane & 15, fq = lane >> 4;
    const int K = g.K, nt = K / BK;
    int ts_lo = 0, ts_hi = 0, nts = 0; const unsigned long long rt_entry = STAMP ? (unsigned long long)wall_clock64() : 0ull;
#define PG8_STAMP() do { if (STAMP && wid == 0 && nts < 64) { const unsigned long long _c = (unsigned long long)clock64(); \
        ts_lo = (lane == nts) ? (int)(unsigned)_c : ts_lo; ts_hi = (lane == nts) ? (int)(unsigned)(_c >> 32) : ts_hi; ++nts; } } while (0)
    PG8_STAMP();
    unsigned voffA[2], voffB[2];
#pragma unroll
    for (int i = 0; i < 2; ++i) { int R, C; stage_rc(tid * 16 + i * 8192, R, C); const int Rb = Epi::PERM ? ((R & ~31) + perm32(R & 31)) : R;
        voffA[i] = (unsigned)(R * K + C) * 2u; voffB[i] = (unsigned)(Rb * K + C) * 2u; }
    const size_t kstep = (size_t)(BK * 2);
    const size_t hstep = (size_t)HALF * K * 2;
    const size_t tstep = 2 * hstep;
    const unsigned ldsw = (unsigned)wid * 1024u;
    const int aoff = lds_byte(wr * 64 + fr, fq * 8), boff = lds_byte(wc * 32 + fr, fq * 8);
#define PG8_SA(b, h) (((b) * 2 + (h)) * HTB)
#define PG8_SB(b, h) ((4 + (b) * 2 + (h)) * HTB)
#define PG8_STAGE(bufoff, gbase, voff) do { _Pragma("unroll") for (int _i = 0; _i < 2; ++_i) \
        __builtin_amdgcn_global_load_lds((const unsigned*)((const char*)(gbase) + (voff)[_i]), (PG8_LAS unsigned*)(lds + (bufoff) + ldsw + _i * 8192), 16, 0, 0); } while (0)
#define PG8_LDA(dst, b, h) do { _Pragma("unroll") for (int m = 0; m < 4; ++m) _Pragma("unroll") for (int k = 0; k < 2; ++k) dst[m][k] = *(const PG8_LAS bf16x8*)(lds + PG8_SA(b, h) + aoff + m * 2048 + k * 1024); } while (0)
#define PG8_LDB(dst, b, h) do { _Pragma("unroll") for (int n = 0; n < 2; ++n) _Pragma("unroll") for (int k = 0; k < 2; ++k) dst[n][k] = *(const PG8_LAS bf16x8*)(lds + PG8_SB(b, h) + boff + n * 2048 + k * 1024); } while (0)
#define PG8_MMA(ai, bj, At, Bt) do { __builtin_amdgcn_s_setprio(1); _Pragma("unroll") for (int m = 0; m < 4; ++m) _Pragma("unroll") for (int n = 0; n < 2; ++n) _Pragma("unroll") for (int k = 0; k < 2; ++k) \
        { if constexpr (I8) acc[ai][bj][m][n] = __builtin_bit_cast(f32x4, __builtin_amdgcn_mfma_i32_16x16x64_i8(__builtin_bit_cast(i32x4, Bt[n][k]), __builtin_bit_cast(i32x4, At[m][k]), __builtin_bit_cast(i32x4, acc[ai][bj][m][n]), 0, 0, 0)); \
          else acc[ai][bj][m][n] = __builtin_amdgcn_mfma_f32_16x16x32_bf16(Bt[n][k], At[m][k], acc[ai][bj][m][n], 0, 0, 0); } __builtin_amdgcn_s_setprio(0); } while (0)
#define PG8_WAIT_V(n) asm volatile("s_waitcnt vmcnt(" #n ")" ::: "memory")
#define PG8_WAIT_L(n) asm volatile("s_waitcnt lgkmcnt(" #n ")" ::: "memory")
#define PG8_BAR __builtin_amdgcn_s_barrier()
#define PG8_SCHED __builtin_amdgcn_sched_barrier(0)
    Unit cur, nxt; int ui = 0;
    if (!S.next(0, cur)) return;
    f32x4 acc[2][2][4][2];
#pragma unroll
    for (int a = 0; a < 2; ++a)
#pragma unroll
        for (int b = 0; b < 2; ++b)
#pragma unroll
            for (int m = 0; m < 4; ++m)
#pragma unroll
                for (int n = 0; n < 2; ++n) acc[a][b][m][n] = (f32x4){0.f, 0.f, 0.f, 0.f};
    bf16x8 At[4][2], B0[2][2], B1[2][2];
    const char* cA = (const char*)g.A + (size_t)cur.pm * tstep; const char* cB = (const char*)g.Bt + (size_t)cur.pn * tstep;
    S.a_ready(cur);
    PG8_STAGE(PG8_SB(0, 0), cB, voffB); PG8_STAGE(PG8_SA(0, 0), cA, voffA); PG8_STAGE(PG8_SB(0, 1), cB + hstep, voffB); PG8_STAGE(PG8_SA(0, 1), cA + hstep, voffA);
    if (wr == 1) PG8_BAR;
    PG8_WAIT_V(4); PG8_BAR;
    PG8_STAGE(PG8_SB(1, 0), cB + kstep, voffB); PG8_STAGE(PG8_SA(1, 0), cA + kstep, voffA); PG8_STAGE(PG8_SB(1, 1), cB + hstep + kstep, voffB);
    PG8_WAIT_V(6); PG8_BAR;
    PG8_STAMP();
    for (;;) {
        const bool has_next = S.next(ui + 1, nxt);
        const char* nA = has_next ? (const char*)g.A + (size_t)nxt.pm * tstep : cA; const char* nB = has_next ? (const char*)g.Bt + (size_t)nxt.pn * tstep : cB;
        for (int t = 0; t < nt; t += 2) {
            const bool last = (t == nt - 2);
            const char* a1 = cA + (size_t)(t + 1) * kstep;
            const char* a2 = last ? nA : cA + (size_t)(t + 2) * kstep; const char* b2 = last ? nB : cB + (size_t)(t + 2) * kstep;
            const char* a3 = a2 + kstep; const char* b3 = b2 + kstep;
            if constexpr (Epi::MID) { if (t == nt / 2) E.mid(acc, cur, wr, wc, fr, fq); }
            if (last && has_next) S.a_ready(nxt);
            PG8_LDB(B0, 0, 0); PG8_SCHED; PG8_LDA(At, 0, 0); PG8_STAGE(PG8_SA(1, 1), a1 + hstep, voffA);
            PG8_WAIT_L(8); PG8_BAR; PG8_WAIT_L(0); PG8_MMA(0, 0, At, B0); PG8_BAR; PG8_SCHED;
            PG8_LDB(B1, 0, 1); PG8_STAGE(PG8_SB(0, 0), b2, voffB);
            PG8_BAR; PG8_WAIT_L(0); PG8_MMA(0, 1, At, B1); PG8_BAR;
            PG8_LDA(At, 0, 1); PG8_STAGE(PG8_SA(0, 0), a2, voffA);
            PG8_BAR; PG8_WAIT_L(0); PG8_MMA(1, 0, At, B0); PG8_BAR; PG8_SCHED;
            PG8_STAGE(PG8_SB(0, 1), b2 + hstep, voffB);
            PG8_WAIT_V(6); PG8_BAR; PG8_MMA(1, 1, At, B1); PG8_BAR;
            PG8_LDB(B0, 1, 0); PG8_SCHED; PG8_LDA(At, 1, 0); PG8_STAGE(PG8_SA(0, 1), a2 + hstep, voffA);
            PG8_WAIT_L(8); PG8_BAR; PG8_WAIT_L(0); PG8_MMA(0, 0, At, B0); PG8_BAR; PG8_SCHED;
            PG8_LDB(B1, 1, 1); PG8_STAGE(PG8_SB(1, 0), b3, voffB);
            PG8_BAR; PG8_WAIT_L(0); PG8_MMA(0, 1, At, B1); PG8_BAR;
            PG8_LDA(At, 1, 1); PG8_STAGE(PG8_SA(1, 0), a3, voffA);
            PG8_BAR; PG8_WAIT_L(0); PG8_MMA(1, 0, At, B0); PG8_BAR; PG8_SCHED;
            PG8_STAGE(PG8_SB(1, 1), b3 + hstep, voffB);
            PG8_WAIT_V(6); PG8_BAR; PG8_MMA(1, 1, At, B1); PG8_BAR;
        }
        PG8_STAMP();
        if constexpr (!Epi::AFTER_DRAIN) { E(acc, cur, wr, wc, fr, fq); S.done(cur); }
        PG8_STAMP();
        if (!has_next) break;
#pragma unroll
        for (int a = 0; a < 2; ++a)
#pragma unroll
            for (int b = 0; b < 2; ++b)
#pragma unroll
                for (int m = 0; m < 4; ++m)
#pragma unroll
                    for (int n = 0; n < 2; ++n) acc[a][b][m][n] = (f32x4){0.f, 0.f, 0.f, 0.f};
        cur = nxt; cA = nA; cB = nB; ++ui;
    }
    PG8_WAIT_V(0);
    if (wr == 0) PG8_BAR;
    PG8_BAR;
    if constexpr (Epi::AFTER_DRAIN) { E.fused(acc, cur, wr, wc, fr, fq, lds, wid, lane); S.done(cur); }
    PG8_STAMP();
    if (STAMP && wid == 0) { stamps[lane] = lane < nts ? (((unsigned long long)(unsigned)ts_hi << 32) | (unsigned)ts_lo) : 0ull;
        if (lane == 62) stamps[62] = rt_entry; if (lane == 63) stamps[63] = (unsigned long long)wall_clock64(); }
#undef PG8_STAMP
#undef PG8_SA
#undef PG8_SB
#undef PG8_STAGE
#undef PG8_LDA
#undef PG8_LDB
#undef PG8_MMA
#undef PG8_WAIT_V
#undef PG8_WAIT_L
#undef PG8_BAR
#undef PG8_SCHED
}
}

struct EpiProj {
  static constexpr bool PERM = true, AFTER_DRAIN = false, MID = false;
  unsigned short* pH; unsigned short* pA; unsigned short* pG; unsigned short* kc; unsigned short* vc; unsigned short* ikc;
  const float* sa; const float* sw;
  __device__ __forceinline__ void operator()(const pg8::f32x4 (&acc)[2][2][4][2], const pg8::Unit& u, int wr, int wc, int fr, int fq) const {
    const int row0 = u.pm * 256 + wr * 64 + fr;
    pg8::f32x4 cs_[2][2];
#pragma unroll
    for (int bj = 0; bj < 2; ++bj)
#pragma unroll
      for (int n = 0; n < 2; ++n) cs_[bj][n] = *(const pg8::f32x4*)(sw + u.pn * 256 + bj * 128 + wc * 32 + 8 * fq + 4 * n);
    unsigned short* base; int ldc, colt; bool sg = false;
    if (u.pn < 8) { base = pH; ldc = 2048; colt = u.pn * 256; }
    else if (u.pn < 12) { base = pA; ldc = 1024; colt = (u.pn - 8) * 256; }
    else { base = pG; ldc = 2048; colt = (u.pn - 12) * 256; sg = true; }
    const int col0 = colt + wc * 32 + 8 * fq;
#pragma unroll
    for (int ai = 0; ai < 2; ++ai)
#pragma unroll
      for (int m = 0; m < 4; ++m) {
        unsigned short* rowp = base + (size_t)(row0 + ai * 128 + m * 16) * ldc + col0;
        const float ra = sa[row0 + ai * 128 + m * 16];
#pragma unroll
        for (int bj = 0; bj < 2; ++bj) {
          pg8::f32x4 v0, v1;
#pragma unroll
          for (int j = 0; j < 4; ++j) { v0[j] = (float)__float_as_int(acc[ai][bj][m][0][j]) * (ra * cs_[bj][0][j]); v1[j] = (float)__float_as_int(acc[ai][bj][m][1][j]) * (ra * cs_[bj][1][j]); }
          if (sg) {
            unsigned wq_[2];
#pragma unroll
            for (int n = 0; n < 2; ++n) {
              unsigned pkq = 0u;
#pragma unroll
              for (int j = 0; j < 4; ++j) {
                const float sgv = sigmoidf_(n == 0 ? v0[j] : v1[j]);
                const unsigned qv = (unsigned)(int)fminf(fmaxf(rintf(sgv * 255.f), 1.f), 255.f);
                pkq |= qv << (8 * j);
              }
              wq_[n] = pkq;
            }
            *(uint2*)((unsigned char*)pG + (size_t)(row0 + ai * 128 + m * 16) * 2048 + col0 + bj * 128) = make_uint2(wq_[0], wq_[1]);
            continue;
          }
          pg8::u32x4 w; w.x = pg8::cvt_pk_bf16(v0[0], v0[1]); w.y = pg8::cvt_pk_bf16(v0[2], v0[3]); w.z = pg8::cvt_pk_bf16(v1[0], v1[1]); w.w = pg8::cvt_pk_bf16(v1[2], v1[3]);
          unsigned short* dst = rowp + bj * 128;
          if (u.pn == 10 || u.pn == 11) {
            const int cs = col0 + bj * 128;
            const size_t r = (size_t)(row0 + ai * 128 + m * 16);
            if (cs >= 512 && cs < 576) dst = kc + r * 64 + (cs - 512);
            else if (cs >= 576 && cs < 640) dst = vc + r * 64 + (cs - 576);
            else if (cs >= 896 && cs < 960) dst = ikc + r * 64 + (cs - 896);
          }
          *(pg8::u32x4*)dst = w;
        }
      }
  }
};
template <int MODE> struct EpiGate {
  static constexpr bool PERM = true, AFTER_DRAIN = false, MID = false;
  unsigned short* hb; const unsigned short* pG; int goff;
  __device__ __forceinline__ void operator()(const pg8::f32x4 (&acc)[2][2][4][2], const pg8::Unit& u, int wr, int wc, int fr, int fq) const {
    const int row0 = u.pm * 256 + wr * 64 + fr;
    const int col0 = u.pn * 256 + wc * 32 + 8 * fq;
#pragma unroll
    for (int ai = 0; ai < 2; ++ai)
#pragma unroll
      for (int m = 0; m < 4; ++m) {
        const size_t r = (size_t)(row0 + ai * 128 + m * 16);
        pg8::u32x4 gv[2], hv[2];
#pragma unroll
        for (int bj = 0; bj < 2; ++bj) {
          gv[bj] = *(const pg8::u32x4*)(pG + r * 2048 + goff + col0 + bj * 128);
          if (MODE == 1) hv[bj] = *(const pg8::u32x4*)(hb + r * 1024 + col0 + bj * 128);
        }
#pragma unroll
        for (int bj = 0; bj < 2; ++bj) {
          float o[8];
#pragma unroll
          for (int j = 0; j < 4; ++j) {
            const unsigned gw0 = gv[bj][j >> 1], gw1 = gv[bj][2 + (j >> 1)];
            const float g0 = (j & 1) ? __uint_as_float(gw0 & 0xffff0000u) : __uint_as_float(gw0 << 16);
            const float g1 = (j & 1) ? __uint_as_float(gw1 & 0xffff0000u) : __uint_as_float(gw1 << 16);
            o[j] = acc[ai][bj][m][0][j] * g0; o[4 + j] = acc[ai][bj][m][1][j] * g1;
            if (MODE == 1) {
              const unsigned hw0 = hv[bj][j >> 1], hw1 = hv[bj][2 + (j >> 1)];
              o[j] += (j & 1) ? __uint_as_float(hw0 & 0xffff0000u) : __uint_as_float(hw0 << 16);
              o[4 + j] += (j & 1) ? __uint_as_float(hw1 & 0xffff0000u) : __uint_as_float(hw1 << 16);
            }
          }
          pg8::u32x4 w; w.x = pg8::cvt_pk_bf16(o[0], o[1]); w.y = pg8::cvt_pk_bf16(o[2], o[3]); w.z = pg8::cvt_pk_bf16(o[4], o[5]); w.w = pg8::cvt_pk_bf16(o[6], o[7]);
          *(pg8::u32x4*)(hb + r * 1024 + col0 + bj * 128) = w;
        }
      }
  }
};
struct EpiGate2 {
  static constexpr bool PERM = true, AFTER_DRAIN = false, MID = true;
  unsigned short* hb; const unsigned char* pG;
  __device__ __forceinline__ void mid(pg8::f32x4 (&acc)[2][2][4][2], const pg8::Unit& u, int wr, int wc, int fr, int fq) const {
    int fr_o = fr, fq_o = fq;
    asm volatile("" : "+v"(fr_o), "+v"(fq_o));
    const unsigned char* gp = pG + (size_t)(u.pm * 256 + wr * 64 + fr_o) * 2048 + u.pn * 256 + wc * 32 + 8 * fq_o;
#pragma unroll
    for (int ai = 0; ai < 2; ++ai)
#pragma unroll
      for (int m = 0; m < 4; ++m)
#pragma unroll
        for (int bj = 0; bj < 2; ++bj) {
          const unsigned char* q = gp + (size_t)(ai * 128 + m * 16) * 2048 + bj * 128;
          const uint2 gb = *(const uint2*)(q + 1024);
          const uint2 ga = *(const uint2*)q;
#pragma unroll
          for (int n = 0; n < 2; ++n) {
            const unsigned wa = n ? ga.y : ga.x, wb = n ? gb.y : gb.x;
#pragma unroll
            for (int j = 0; j < 4; ++j)
              acc[ai][bj][m][n][j] *= (float)((wa >> (8 * j)) & 255u) * __builtin_amdgcn_rcpf((float)((wb >> (8 * j)) & 255u));
          }
          if (bj == 1) asm volatile("" ::: "memory");
        }
  }
  __device__ __forceinline__ void operator()(const pg8::f32x4 (&acc)[2][2][4][2], const pg8::Unit& u, int wr, int wc, int fr, int fq) const {
    const int row0 = u.pm * 256 + wr * 64 + fr;
    const int col0 = u.pn * 256 + wc * 32 + 8 * fq;
#pragma unroll
    for (int ai = 0; ai < 2; ++ai)
#pragma unroll
      for (int m = 0; m < 4; ++m) {
        const size_t r = (size_t)(row0 + ai * 128 + m * 16);
        uint2 gb[2];
#pragma unroll
        for (int bj = 0; bj < 2; ++bj) gb[bj] = *(const uint2*)(pG + r * 2048 + 1024 + col0 + bj * 128);
#pragma unroll
        for (int bj = 0; bj < 2; ++bj) {
          float o[8];
#pragma unroll
          for (int j = 0; j < 4; ++j) {
            o[j] = acc[ai][bj][m][0][j] * ((float)((gb[bj].x >> (8 * j)) & 255u) * (1.f / 255.f));
            o[4 + j] = acc[ai][bj][m][1][j] * ((float)((gb[bj].y >> (8 * j)) & 255u) * (1.f / 255.f));
          }
          pg8::u32x4 w; w.x = pg8::cvt_pk_bf16(o[0], o[1]); w.y = pg8::cvt_pk_bf16(o[2], o[3]); w.z = pg8::cvt_pk_bf16(o[4], o[5]); w.w = pg8::cvt_pk_bf16(o[6], o[7]);
          *(pg8::u32x4*)(hb + r * 1024 + col0 + bj * 128) = w;
        }
      }
  }
};
struct EpiResid {
  static constexpr bool PERM = true, AFTER_DRAIN = false, MID = false;
  unsigned short* o; const float* x;
  __device__ __forceinline__ void operator()(const pg8::f32x4 (&acc)[2][2][4][2], const pg8::Unit& u, int wr, int wc, int fr, int fq) const {
    const int row0 = u.pm * 256 + wr * 64 + fr, col0 = u.pn * 256 + wc * 32 + 8 * fq;
#pragma unroll
    for (int ai = 0; ai < 2; ++ai)
#pragma unroll
      for (int m = 0; m < 4; ++m) {
        const size_t off = (size_t)(row0 + ai * 128 + m * 16) * 1024 + col0;
        pg8::f32x4 xv[2][2];
#pragma unroll
        for (int bj = 0; bj < 2; ++bj)
#pragma unroll
          for (int n = 0; n < 2; ++n) xv[bj][n] = *(const pg8::f32x4*)(x + off + bj * 128 + n * 4);
#pragma unroll
        for (int bj = 0; bj < 2; ++bj) {
          const pg8::f32x4 v0 = acc[ai][bj][m][0] + xv[bj][0], v1 = acc[ai][bj][m][1] + xv[bj][1];
          pg8::u32x4 w; w.x = pg8::cvt_pk_bf16(v0[0], v0[1]); w.y = pg8::cvt_pk_bf16(v0[2], v0[3]); w.z = pg8::cvt_pk_bf16(v1[0], v1[1]); w.w = pg8::cvt_pk_bf16(v1[2], v1[3]);
          *(pg8::u32x4*)(o + off + bj * 128) = w;
        }
      }
  }
};
struct EpiStoreBf16Q {
  static constexpr bool PERM = true, AFTER_DRAIN = false, MID = false;
  unsigned short* O; int ldc; const float* sa; const float* sw;
  __device__ __forceinline__ void operator()(const pg8::f32x4 (&acc)[2][2][4][2], const pg8::Unit& u, int wr, int wc, int fr, int fq) const {
    const int row0 = u.pm * 256 + wr * 64 + fr, col0 = u.pn * 256 + wc * 32 + 8 * fq;
    pg8::f32x4 cs_[2][2];
#pragma unroll
    for (int bj = 0; bj < 2; ++bj)
#pragma unroll
      for (int n = 0; n < 2; ++n) cs_[bj][n] = *(const pg8::f32x4*)(sw + col0 + bj * 128 + 4 * n);
#pragma unroll
    for (int ai = 0; ai < 2; ++ai)
#pragma unroll
      for (int m = 0; m < 4; ++m) {
        unsigned short* rowp = O + (size_t)(row0 + ai * 128 + m * 16) * ldc + col0;
        const float ra = sa[row0 + ai * 128 + m * 16];
#pragma unroll
        for (int bj = 0; bj < 2; ++bj) {
          pg8::f32x4 v0, v1;
#pragma unroll
          for (int j = 0; j < 4; ++j) { v0[j] = (float)__float_as_int(acc[ai][bj][m][0][j]) * (ra * cs_[bj][0][j]); v1[j] = (float)__float_as_int(acc[ai][bj][m][1][j]) * (ra * cs_[bj][1][j]); }
          pg8::u32x4 w; w.x = pg8::cvt_pk_bf16(v0[0], v0[1]); w.y = pg8::cvt_pk_bf16(v0[2], v0[3]); w.z = pg8::cvt_pk_bf16(v1[0], v1[1]); w.w = pg8::cvt_pk_bf16(v1[2], v1[3]);
          *(pg8::u32x4*)(rowp + bj * 128) = w;
        }
      }
  }
};
struct EpiStoreBf16 {
  static constexpr bool PERM = true, AFTER_DRAIN = false, MID = false;
  unsigned short* O; int ldc;
  __device__ __forceinline__ void operator()(const pg8::f32x4 (&acc)[2][2][4][2], const pg8::Unit& u, int wr, int wc, int fr, int fq) const {
    const int row0 = u.pm * 256 + wr * 64 + fr, col0 = u.pn * 256 + wc * 32 + 8 * fq;
#pragma unroll
    for (int ai = 0; ai < 2; ++ai)
#pragma unroll
      for (int m = 0; m < 4; ++m) {
        unsigned short* rowp = O + (size_t)(row0 + ai * 128 + m * 16) * ldc + col0;
#pragma unroll
        for (int bj = 0; bj < 2; ++bj) {
          const pg8::f32x4 v0 = acc[ai][bj][m][0], v1 = acc[ai][bj][m][1];
          pg8::u32x4 w; w.x = pg8::cvt_pk_bf16(v0[0], v0[1]); w.y = pg8::cvt_pk_bf16(v0[2], v0[3]); w.z = pg8::cvt_pk_bf16(v1[0], v1[1]); w.w = pg8::cvt_pk_bf16(v1[2], v1[3]);
          *(pg8::u32x4*)(rowp + bj * 128) = w;
        }
      }
  }
};

__device__ __forceinline__ void gemm_tile(const bf16_t* __restrict__ A, int lda, const bf16_t* __restrict__ Bt, int ldb,
                                          int nk, f32x4 (&acc)[4][4], unsigned char* smem) {
  const int tid = threadIdx.x, lane = tid & 63, w = tid >> 6, wm = w >> 1, wn = w & 1, l15 = lane & 15, g = lane >> 4;
  unsigned char* sA = smem;
  unsigned char* sB = smem + 32768;
  const int lr = tid >> 3, lc = tid & 7;
  const bf16_t* ga = A + (size_t)lr * lda + lc * 8;
  const bf16_t* gb = Bt + (size_t)lr * ldb + lc * 8;
  uint4 ra0, ra1, ra2, ra3, rb0, rb1;
  ra0 = *(const uint4*)(ga);
  ra1 = *(const uint4*)(ga + (size_t)64 * lda);
  ra2 = *(const uint4*)(ga + (size_t)128 * lda);
  ra3 = *(const uint4*)(ga + (size_t)192 * lda);
  rb0 = *(const uint4*)(gb);
  rb1 = *(const uint4*)(gb + (size_t)64 * ldb);
  const int sw = (lc ^ (lr & 7)) << 4;
  for (int kt = 0; kt < nk; ++kt) {
    __syncthreads();
    *(uint4*)(sA + (lr) * 128 + sw) = ra0;
    *(uint4*)(sA + (lr + 64) * 128 + sw) = ra1;
    *(uint4*)(sA + (lr + 128) * 128 + sw) = ra2;
    *(uint4*)(sA + (lr + 192) * 128 + sw) = ra3;
    *(uint4*)(sB + (lr) * 128 + sw) = rb0;
    *(uint4*)(sB + (lr + 64) * 128 + sw) = rb1;
    __syncthreads();
    if (kt + 1 < nk) {
      const int ko = (kt + 1) * 64;
      ra0 = *(const uint4*)(ga + ko);
      ra1 = *(const uint4*)(ga + (size_t)64 * lda + ko);
      ra2 = *(const uint4*)(ga + (size_t)128 * lda + ko);
      ra3 = *(const uint4*)(ga + (size_t)192 * lda + ko);
      rb0 = *(const uint4*)(gb + ko);
      rb1 = *(const uint4*)(gb + (size_t)64 * ldb + ko);
    }
#pragma unroll
    for (int ks = 0; ks < 2; ++ks) {
      bf16x8 a[4], b[4];
#pragma unroll
      for (int m = 0; m < 4; ++m) { const int r = wm * 64 + m * 16 + l15; a[m] = *(const bf16x8*)(sA + r * 128 + (((ks * 4 + g) ^ (r & 7)) << 4)); }
#pragma unroll
      for (int n = 0; n < 4; ++n) { const int r = wn * 64 + n * 16 + l15; b[n] = *(const bf16x8*)(sB + r * 128 + (((ks * 4 + g) ^ (r & 7)) << 4)); }
#pragma unroll
      for (int m = 0; m < 4; ++m)
#pragma unroll
        for (int n = 0; n < 4; ++n) acc[m][n] = __builtin_amdgcn_mfma_f32_16x16x32_bf16(a[m], b[n], acc[m][n], 0, 0, 0);
    }
  }
}

__device__ __forceinline__ void zero_acc(f32x4 (&acc)[4][4]) {
#pragma unroll
  for (int m = 0; m < 4; ++m)
#pragma unroll
    for (int n = 0; n < 4; ++n) acc[m][n] = (f32x4){0.f, 0.f, 0.f, 0.f};
}

__device__ __forceinline__ void transpose_tile(const float* __restrict__ src, int srcN, bf16_t* __restrict__ dst, int K, int n0, int k0,
                                               bool winmap, float* tile) {
  const int tid = threadIdx.x;
  const int nc = tid & 63, kr = tid >> 6;
  int ncol = n0 + nc; bool valid = true;
  if (winmap) { if (ncol >= 3072) ncol -= 60; else if (ncol >= 3012) valid = false; }
#pragma unroll
  for (int i = 0; i < 8; ++i) {
    const int k = kr + 8 * i;
    tile[k * 65 + nc] = valid ? src[(size_t)(k0 + k) * srcN + ncol] : 0.f;
  }
  __syncthreads();
#pragma unroll
  for (int i = 0; i < 8; ++i) {
    const int nr = kr + 8 * i;
    dst[(size_t)(n0 + nr) * K + k0 + nc] = f2bf(tile[nc * 65 + nr]);
  }
  __syncthreads();
}

__device__ __forceinline__ void quant_cols32(const float* __restrict__ src, int srcN, unsigned char* __restrict__ dst, float* __restrict__ scale,
                                             int n0, bool winmap, float* tile) {
  const int tid = threadIdx.x, nc = tid & 31, kr = tid >> 5;
  float* red = tile + 1024 * 33;
  int ncol = n0 + nc; bool valid = true;
  if (winmap) { if (ncol >= 3072) ncol -= 60; else if (ncol >= 3012) valid = false; }
  if (!valid) ncol = 0;
  float am = 0.f;
#pragma unroll 16
  for (int i = 0; i < 64; ++i) {
    const int k = kr + 16 * i;
    float v = src[(size_t)k * srcN + ncol];
    v = valid ? v : 0.f;
    tile[k * 33 + nc] = v; am = fmaxf(am, fabsf(v));
  }
  red[kr * 32 + nc] = am;
  __syncthreads();
  if (tid < 32) {
    float m = 0.f;
#pragma unroll
    for (int i = 0; i < 16; ++i) m = fmaxf(m, red[i * 32 + tid]);
    red[512 + tid] = m; scale[n0 + tid] = m * (1.f / 127.f);
  }
  __syncthreads();
  const float cm = red[512 + nc];
  const float inv = cm > 0.f ? 127.f / cm : 0.f;
#pragma unroll
  for (int i = 0; i < 4; ++i) {
    const int k0 = (kr + 16 * i) * 16;
    unsigned pk[4];
#pragma unroll
    for (int q = 0; q < 4; ++q) {
      const unsigned b0 = (unsigned)(int)rintf(tile[(k0 + 4 * q) * 33 + nc] * inv) & 255u, b1 = (unsigned)(int)rintf(tile[(k0 + 4 * q + 1) * 33 + nc] * inv) & 255u;
      const unsigned b2 = (unsigned)(int)rintf(tile[(k0 + 4 * q + 2) * 33 + nc] * inv) & 255u, b3 = (unsigned)(int)rintf(tile[(k0 + 4 * q + 3) * 33 + nc] * inv) & 255u;
      pk[q] = b0 | (b1 << 8) | (b2 << 16) | (b3 << 24);
    }
    *(uint4*)(dst + (size_t)(n0 + nc) * 1024 + k0) = make_uint4(pk[0], pk[1], pk[2], pk[3]);
  }
  __syncthreads();
}

__device__ __forceinline__ void convert_f32_bf16(const float* __restrict__ src, bf16_t* __restrict__ dst, size_t n4) {
  for (size_t i = (size_t)blockIdx.x * NTHREADS + threadIdx.x; i < n4; i += (size_t)gridDim.x * NTHREADS) {
    const float4 v = ((const float4*)src)[i];
    uint2 o; o.x = pack2(v.x, v.y); o.y = pack2(v.z, v.w);
    ((uint2*)dst)[i] = o;
  }
}

template <bool SLICE_MAJOR, bool SIGNED>
__device__ __forceinline__ void quantize_rows_u8(const float* __restrict__ src, unsigned char* __restrict__ dst, float* __restrict__ scale, int row_lo, int row_hi) {
  const int lane = threadIdx.x & 63, w = threadIdx.x >> 6;
  for (int row = row_lo + w; row < row_hi; row += 8) {
    const float4* s4 = (const float4*)(src + (size_t)row * 1024) + lane * 4;
    float4 v[4];
    float am = 0.f;
#pragma unroll
    for (int i = 0; i < 4; ++i) { v[i] = s4[i]; am = fmaxf(am, fmaxf(fmaxf(fabsf(v[i].x), fabsf(v[i].y)), fmaxf(fabsf(v[i].z), fabsf(v[i].w)))); }
#pragma unroll
    for (int o = 32; o > 0; o >>= 1) am = fmaxf(am, __shfl_xor(am, o));
    const float inv = am > 0.f ? 127.f / am : 0.f;
    unsigned pk[4];
#pragma unroll
    for (int i = 0; i < 4; ++i) {
      const int ofs = SIGNED ? 0 : 128;
      const unsigned b0 = (unsigned)((int)rintf(v[i].x * inv) + ofs), b1 = (unsigned)((int)rintf(v[i].y * inv) + ofs);
      const unsigned b2 = (unsigned)((int)rintf(v[i].z * inv) + ofs), b3 = (unsigned)((int)rintf(v[i].w * inv) + ofs);
      pk[i] = (b0 & 255u) | ((b1 & 255u) << 8) | ((b2 & 255u) << 16) | ((b3 & 255u) << 24);
    }
    if (SLICE_MAJOR) {
      unsigned char* d8 = dst + (size_t)(lane >> 3) * (16384 * 128) + (size_t)row * 128 + 2 * (lane & 7);
#pragma unroll
      for (int q = 0; q < 8; ++q) {
        const unsigned lo = (pk[q >> 2] >> (8 * (q & 3))) & 255u, hi = (pk[2 + (q >> 2)] >> (8 * (q & 3))) & 255u;
        *(unsigned short*)(d8 + q * 16) = (unsigned short)(lo | (hi << 8));
      }
    }
    else *(uint4*)(dst + (size_t)row * 1024 + lane * 16) = make_uint4(pk[0], pk[1], pk[2], pk[3]);
    if (lane == 0) scale[row] = am * (1.f / 127.f);
  }
}

#define WS_WINS (WS_WIN + (size_t)5120 * 1024)
#define WS_WQS (WS_WQ + (size_t)2048 * 1024)
#define WS_XNS (WS_XN + (size_t)TOK * 1024)
#define WS_X1 (WS_XN)
#define WS_XQ (WS_PH + (size_t)TOK * 1024 * 2)
#define WS_XS (WS_XQ + (size_t)TOK * 1024)
template <bool WBF, bool SRC_BF16 = false>
__device__ __forceinline__ void rmsnorm_rows_q(const float* __restrict__ src, const float* __restrict__ g, bf16_t* __restrict__ dst,
                                               unsigned char* __restrict__ xq, float* __restrict__ xs) {
  typedef unsigned u32x4_t __attribute__((ext_vector_type(4)));
  const int lane = threadIdx.x & 63, w = threadIdx.x >> 6;
  constexpr int NB = 4, NV = SRC_BF16 ? 2 : 4;
  const int stride = gridDim.x * 8;
  for (int row0 = blockIdx.x * 8 + w; row0 < TOK; row0 += NB * stride) {
    u32x4_t raw[NB][NV];
#pragma unroll
    for (int b = 0; b < NB; ++b) {
      const int rr = row0 + b * stride, rc = rr < TOK ? rr : row0;
      const u32x4_t* sp = SRC_BF16 ? (const u32x4_t*)((const bf16_t*)src + (size_t)rc * DM + lane * 16) : (const u32x4_t*)(src + (size_t)rc * DM + lane * 16);
#pragma unroll
      for (int i = 0; i < NV; ++i) raw[b][i] = sp[i];
    }
#pragma unroll
    for (int b = 0; b < NB; ++b) {
      const int row = row0 + b * stride;
      if (row < TOK) {
        const float4* g4 = (const float4*)g + lane * 4;
        float v[16]; float ss = 0.f;
        if (SRC_BF16) {
#pragma unroll
          for (int i = 0; i < 8; ++i) { const unsigned wd = raw[b][i >> 2][i & 3]; v[2 * i] = __uint_as_float(wd << 16); v[2 * i + 1] = __uint_as_float(wd & 0xffff0000u); ss += v[2 * i] * v[2 * i] + v[2 * i + 1] * v[2 * i + 1]; }
        } else {
#pragma unroll
          for (int i = 0; i < 16; ++i) { v[i] = __uint_as_float(raw[b][(i >> 2) % NV][i & 3]); ss += v[i] * v[i]; }
        }
        ss = wave_sum(ss);
        const float rstd = rsqrtf(ss * (1.f / DM) + EPSV);
        float am = 0.f;
#pragma unroll
        for (int i = 0; i < 4; ++i) { const float4 gg = g4[i]; v[4 * i] *= rstd * gg.x; v[4 * i + 1] *= rstd * gg.y; v[4 * i + 2] *= rstd * gg.z; v[4 * i + 3] *= rstd * gg.w; }
#pragma unroll
        for (int i = 0; i < 16; ++i) am = fmaxf(am, fabsf(v[i]));
#pragma unroll
        for (int o = 32; o > 0; o >>= 1) am = fmaxf(am, __shfl_xor(am, o));
        const float inv = am > 0.f ? 127.f / am : 0.f;
        if (WBF) {
          uint4 ob0, ob1;
          ob0.x = pack2(v[0], v[1]); ob0.y = pack2(v[2], v[3]); ob0.z = pack2(v[4], v[5]); ob0.w = pack2(v[6], v[7]);
          ob1.x = pack2(v[8], v[9]); ob1.y = pack2(v[10], v[11]); ob1.z = pack2(v[12], v[13]); ob1.w = pack2(v[14], v[15]);
          *(uint4*)(dst + (size_t)row * DM + lane * 16) = ob0;
          *(uint4*)(dst + (size_t)row * DM + lane * 16 + 8) = ob1;
        }
        unsigned pk[4];
#pragma unroll
        for (int i = 0; i < 4; ++i) {
          const unsigned b0 = (unsigned)(int)rintf(v[4 * i] * inv) & 255u, b1 = (unsigned)(int)rintf(v[4 * i + 1] * inv) & 255u;
          const unsigned b2 = (unsigned)(int)rintf(v[4 * i + 2] * inv) & 255u, b3 = (unsigned)(int)rintf(v[4 * i + 3] * inv) & 255u;
          pk[i] = b0 | (b1 << 8) | (b2 << 16) | (b3 << 24);
        }
        *(uint4*)(xq + (size_t)row * 1024 + lane * 16) = make_uint4(pk[0], pk[1], pk[2], pk[3]);
        if (lane == 0) xs[row] = am * (1.f / 127.f);
      }
    }
  }
}

__device__ __forceinline__ void rmsnorm_rows(const float* __restrict__ src, const float* __restrict__ g, bf16_t* __restrict__ dst) {
  const int lane = threadIdx.x & 63, w = threadIdx.x >> 6;
  for (int row = blockIdx.x * 8 + w; row < TOK; row += gridDim.x * 8) {
    const float4* s4 = (const float4*)(src + (size_t)row * DM);
    float4 v[4]; float ss = 0.f;
#pragma unroll
    for (int i = 0; i < 4; ++i) { v[i] = s4[lane + 64 * i]; ss += v[i].x * v[i].x + v[i].y * v[i].y + v[i].z * v[i].z + v[i].w * v[i].w; }
    ss = wave_sum(ss);
    const float rstd = rsqrtf(ss * (1.f / DM) + EPSV);
#pragma unroll
    for (int i = 0; i < 4; ++i) {
      const float4 gg = ((const float4*)g)[lane + 64 * i];
      uint2 o; o.x = pack2(v[i].x * rstd * gg.x, v[i].y * rstd * gg.y); o.y = pack2(v[i].z * rstd * gg.z, v[i].w * rstd * gg.w);
      ((uint2*)(dst + (size_t)row * DM))[lane + 64 * i] = o;
    }
  }
}

__device__ __forceinline__ void phase_prep(const Params& p, unsigned char* smem) {
  unsigned char* ws = p.ws;
  float* tile = (float*)smem;
  const int n_win = 160, n_ua = 16 * 8, n_ub = 16 * 8, n_wo = 16 * 16, n_wq = 64;
  const int total = n_win + n_wq + n_ua + n_ub + n_wo;
  for (int it = blockIdx.x; it < total; it += gridDim.x) {
    int t = it;
    if (t < n_win) { quant_cols32(p.w_in, 5060, ws + WS_WIN, (float*)(ws + WS_WINS), t * 32, true, tile); continue; }
    t -= n_win;
    if (t < n_wq) { quant_cols32(p.peer_wq, 2048, ws + WS_WQ, (float*)(ws + WS_WQS), t * 32, false, tile); continue; }
    t -= n_wq;
    if (t < n_ua) { transpose_tile(p.w_up_a, 1024, (bf16_t*)(ws + WS_WUPA), 1024, (t >> 3) * 64, (t & 7) * 64, false, tile); continue; }
    t -= n_ua;
    if (t < n_ub) { transpose_tile(p.w_up_b, 1024, (bf16_t*)(ws + WS_WUPA) + 512, 1024, (t >> 3) * 64, (t & 7) * 64, false, tile); continue; }
    t -= n_ub;
    transpose_tile(p.w_out, 1024, (bf16_t*)(ws + WS_WOUT), 1024, (t >> 4) * 64, (t & 15) * 64, false, tile);
  }
  convert_f32_bf16(p.peer_keys, (bf16_t*)(ws + WS_KEYS), (size_t)2 * 8 * 128 * 128 / 4);
  for (int i = blockIdx.x * NTHREADS + threadIdx.x; i < TOK; i += gridDim.x * NTHREADS) ((float*)(ws + WS_SSQ))[i] = 0.f;
  if (threadIdx.x == 0) ((int*)(ws + WS_XCC))[blockIdx.x] = (int)(__builtin_amdgcn_s_getreg((3 << 11) | 20) & 0xFu);
  if (blockIdx.x == 0 && threadIdx.x < 8) ((unsigned*)(ws + WS_QCTR))[16 * threadIdx.x] = 0u;
  if (blockIdx.x == 0) {
    const int i = threadIdx.x;
    const float a0 = p.hg_lb[i], a1 = p.hg_lb[512 + i];
    ((float*)(ws + WS_LB))[i] = 1.f / (1.f + expf(a1 - a0));
  }
  rmsnorm_rows_q<false>(p.x, p.norm_mix, nullptr, ws + WS_XN, (float*)(ws + WS_XNS));
}

__device__ __forceinline__ void hgrn_h1_all(const Params& p, unsigned char* smem) {
  unsigned char* ws = p.ws;
  bf16_t* pH = (bf16_t*)(ws + WS_PH);
  const float* lbp = (const float*)(ws + WS_LB);
  bf16_t* Qt = (bf16_t*)smem;
  bf16_t* Kt = Qt + 64 * 136;
  bf16_t* KtT = Kt + 64 * 136;
  bf16_t* VT = KtT + 128 * 72;
  bf16_t* Am = VT + 128 * 72;
  float* qtot = (float*)(Am + 64 * 72);
  const int tid = threadIdx.x, lane = tid & 63, w = tid >> 6, l15 = lane & 15, g = lane >> 4;
  const int d = tid & 127, tq = tid >> 7;
  const int G = gridDim.x;
  if ((int)blockIdx.x >= 2048) return;
  bf16_t fr_[16], qr_[16]; unsigned short vr_[16];
#define H1_LOAD(IT) do { \
    const int bh_ = (IT) >> 6, ch_ = (IT) & 63; \
    const bf16_t* base_ = pH + ((size_t)(bh_ >> 2) * SEQL + ch_ * 64 + tq * 16) * 2048 + (bh_ & 3) * 128 + d; \
    _Pragma("unroll") for (int i = 0; i < 16; ++i) { fr_[i] = base_[(size_t)i * 2048 + 512]; qr_[i] = base_[(size_t)i * 2048]; vr_[i] = base_[(size_t)i * 2048 + 1024]; } \
  } while (0)
  H1_LOAD((int)blockIdx.x);
  for (int item = blockIdx.x; item < 2048; item += G) {
    const int bh = item >> 6, chunk = item & 63;
    const int b = bh >> 2, h = bh & 3;
    const float lbv = lbp[h * 128 + d];
    const size_t row0 = (size_t)b * SEQL + chunk * 64;
    float* dec = (float*)(ws + WS_DEC) + (size_t)item * 384;
    uint4* UU = (uint4*)p.out + (size_t)item * 2048 + tid;
    float4* OI = (float4*)((unsigned char*)p.out + ((size_t)64 << 20)) + (size_t)item * 2048 + tid;
    {
      unsigned vv[8];
#pragma unroll
      for (int i = 0; i < 8; ++i) vv[i] = (unsigned)vr_[2 * i] | ((unsigned)vr_[2 * i + 1] << 16);
      float lf[16], kk[16], qs[16];
      float run = 0.f;
#pragma unroll
      for (int i = 0; i < 16; ++i) {
        const float sg = sigmoidf_(bf2f(fr_[i]));
        const float fg = lbv + (1.f - lbv) * sg;
        run += __logf(fg);
        lf[i] = run; kk[i] = 1.f - fg; qs[i] = siluf_(bf2f(qr_[i]));
      }
      qtot[tq * 128 + d] = run;
      __syncthreads();
      { const int nit = (item + G < 2048) ? item + G : item; H1_LOAD(nit); }
      const float q0 = qtot[d], q1 = qtot[128 + d], q2 = qtot[256 + d], q3 = qtot[384 + d];
      const float pre = (tq > 0 ? q0 : 0.f) + (tq > 1 ? q1 : 0.f) + (tq > 2 ? q2 : 0.f);
      const float bref = q0 + q1;
      const float blast = bref + q2 + q3;
      unsigned kp[8];
#pragma unroll
      for (int i = 0; i < 16; ++i) {
        const float bt = pre + lf[i];
        const float qt = qs[i] * __expf(bt - bref);
        const float kt = kk[i] * __expf(bref - bt);
        const int t = tq * 16 + i;
        Qt[t * 136 + d] = f2bf(qt);
        const bf16_t kb = f2bf(kt);
        Kt[t * 136 + d] = kb;
        if (i & 1) kp[i >> 1] |= ((unsigned)kb) << 16; else kp[i >> 1] = kb;
      }
      *(uint4*)(KtT + d * 72 + tq * 16) = make_uint4(kp[0], kp[1], kp[2], kp[3]);
      *(uint4*)(KtT + d * 72 + tq * 16 + 8) = make_uint4(kp[4], kp[5], kp[6], kp[7]);
      *(uint4*)(VT + d * 72 + tq * 16) = make_uint4(vv[0], vv[1], vv[2], vv[3]);
      *(uint4*)(VT + d * 72 + tq * 16 + 8) = make_uint4(vv[4], vv[5], vv[6], vv[7]);
      if (tq == 0) { dec[d] = __expf(bref); dec[128 + d] = __expf(blast); dec[256 + d] = __expf(blast - bref); }
    }
    __syncthreads();
    {
  #pragma unroll
      for (int i = 0; i < 2; ++i) {
        const int idx = tid + 512 * i, r = idx >> 4, c = idx & 15;
        *(uint4*)(pH + (row0 + r) * 2048 + h * 128 + c * 8) = *(const uint4*)(Qt + r * 136 + c * 8);
      }
  #pragma unroll
      for (int tt = 0; tt < 2; ++tt) {
        const int tl = 2 * w + tt, sm = tl >> 2, tn = tl & 3;
        f32x4 acc = (f32x4){0.f, 0.f, 0.f, 0.f};
        if (tn >= sm) {
  #pragma unroll
          for (int k0 = 0; k0 < 128; k0 += 32) {
            const bf16x8 a = *(const bf16x8*)(Kt + (sm * 16 + l15) * 136 + k0 + 8 * g);
            const bf16x8 bq = *(const bf16x8*)(Qt + (tn * 16 + l15) * 136 + k0 + 8 * g);
            acc = __builtin_amdgcn_mfma_f32_16x16x32_bf16(a, bq, acc, 0, 0, 0);
          }
        }
        const int t = tn * 16 + l15, s0 = sm * 16 + 4 * g;
        uint2 o;
        o.x = pack2(s0 + 0 <= t ? acc[0] : 0.f, s0 + 1 <= t ? acc[1] : 0.f);
        o.y = pack2(s0 + 2 <= t ? acc[2] : 0.f, s0 + 3 <= t ? acc[3] : 0.f);
        *(uint2*)(Am + t * 72 + s0) = o;
      }
    }
    __syncthreads();
    {
  #pragma unroll
      for (int tm = 0; tm < 4; ++tm) {
        f32x4 acc = (f32x4){0.f, 0.f, 0.f, 0.f};
  #pragma unroll
        for (int k0 = 0; k0 < 64; k0 += 32) {
          const bf16x8 a = *(const bf16x8*)(Am + (tm * 16 + l15) * 72 + k0 + 8 * g);
          const bf16x8 bb = *(const bf16x8*)(VT + (16 * w + l15) * 72 + k0 + 8 * g);
          acc = __builtin_amdgcn_mfma_f32_16x16x32_bf16(a, bb, acc, 0, 0, 0);
        }
        OI[tm * 512] = make_float4(acc[0], acc[1], acc[2], acc[3]);
      }
  #pragma unroll
      for (int dp = 0; dp < 4; ++dp) {
        unsigned pk[4];
  #pragma unroll
        for (int hh = 0; hh < 2; ++hh) {
          const int dm = dp * 2 + hh;
          f32x4 acc = (f32x4){0.f, 0.f, 0.f, 0.f};
  #pragma unroll
          for (int k0 = 0; k0 < 64; k0 += 32) {
            const bf16x8 a = *(const bf16x8*)(KtT + (dm * 16 + l15) * 72 + k0 + 8 * g);
            const bf16x8 bb = *(const bf16x8*)(VT + (16 * w + l15) * 72 + k0 + 8 * g);
            acc = __builtin_amdgcn_mfma_f32_16x16x32_bf16(a, bb, acc, 0, 0, 0);
          }
          pk[hh * 2] = pack2(acc[0], acc[1]); pk[hh * 2 + 1] = pack2(acc[2], acc[3]);
        }
        UU[dp * 512] = make_uint4(pk[0], pk[1], pk[2], pk[3]);
      }
    }
    __syncthreads();
  }
#undef H1_LOAD
}

__device__ __forceinline__ void hgrn_h2(const Params& p, unsigned char* smem, int bh) {
  unsigned char* ws = p.ws;
  const bf16_t* pH = (const bf16_t*)(ws + WS_PH);
  bf16_t* ya = (bf16_t*)(ws + WS_XN);
  bf16_t* Qt = (bf16_t*)smem;
  bf16_t* ST = Qt + 64 * 136;
  float* decl = (float*)(ST + 128 * 136);
  float* red = decl + 384;
  const int tid = threadIdx.x, lane = tid & 63, w = tid >> 6, l15 = lane & 15, g = lane >> 4;
  const int b = bh >> 2, h = bh & 3;
  f32x4 S[8];
#pragma unroll
  for (int i = 0; i < 8; ++i) S[i] = (f32x4){0.f, 0.f, 0.f, 0.f};
  const float gnv = p.hg_norm[h * 128 + 16 * w + l15];
  const int e = 16 * w + l15;
  uint4 uu0, uu1, uu2, uu3; float4 oi0, oi1, oi2, oi3; uint4 qraw0, qraw1; bf16_t ogr[16]; float dcv = 0.f;
#define H2_LOAD(CH) do { \
    const int item_ = bh * 64 + (CH); \
    const size_t row0_ = (size_t)b * SEQL + (size_t)(CH) * 64; \
    const uint4* UUp = (const uint4*)p.out + (size_t)item_ * 2048 + tid; \
    const float4* OIp = (const float4*)((const unsigned char*)p.out + ((size_t)64 << 20)) + (size_t)item_ * 2048 + tid; \
    uu0 = UUp[0]; uu1 = UUp[512]; uu2 = UUp[1024]; uu3 = UUp[1536]; oi0 = OIp[0]; oi1 = OIp[512]; oi2 = OIp[1024]; oi3 = OIp[1536]; \
    qraw0 = *(const uint4*)(pH + (row0_ + (tid >> 4)) * 2048 + h * 128 + (tid & 15) * 8); \
    qraw1 = *(const uint4*)(pH + (row0_ + 32 + (tid >> 4)) * 2048 + h * 128 + (tid & 15) * 8); \
    _Pragma("unroll") for (int tm = 0; tm < 4; ++tm) _Pragma("unroll") for (int j = 0; j < 4; ++j) \
      ogr[tm * 4 + j] = pH[(row0_ + tm * 16 + 4 * g + j) * 2048 + 1536 + h * 128 + e]; \
    if (tid < 384) dcv = ((const float*)(ws + WS_DEC))[(size_t)item_ * 384 + tid]; \
  } while (0)
  H2_LOAD(0);
  for (int chunk = 0; chunk < 64; ++chunk) {
    const size_t row0 = (size_t)b * SEQL + chunk * 64;
    const uint4 cu[4] = {uu0, uu1, uu2, uu3}; const float4 co[4] = {oi0, oi1, oi2, oi3}; bf16_t cog[16];
#pragma unroll
    for (int i = 0; i < 16; ++i) cog[i] = ogr[i];
    *(uint4*)(Qt + (tid >> 4) * 136 + (tid & 15) * 8) = qraw0;
    *(uint4*)(Qt + (32 + (tid >> 4)) * 136 + (tid & 15) * 8) = qraw1;
    if (tid < 384) decl[tid] = dcv;
    __syncthreads();
    if (chunk + 1 < 64) H2_LOAD(chunk + 1);
#pragma unroll
    for (int dm = 0; dm < 8; ++dm) {
      const int d0 = 16 * dm + 4 * g;
      uint2 o;
      o.x = pack2(S[dm][0] * decl[d0], S[dm][1] * decl[d0 + 1]);
      o.y = pack2(S[dm][2] * decl[d0 + 2], S[dm][3] * decl[d0 + 3]);
      *(uint2*)(ST + e * 136 + d0) = o;
    }
    __syncthreads();
    f32x4 o[4];
#pragma unroll
    for (int tm = 0; tm < 4; ++tm) {
      f32x4 acc = (f32x4){co[tm].x, co[tm].y, co[tm].z, co[tm].w};
#pragma unroll
      for (int k0 = 0; k0 < 128; k0 += 32) {
        const bf16x8 a = *(const bf16x8*)(Qt + (tm * 16 + l15) * 136 + k0 + 8 * g);
        const bf16x8 bb = *(const bf16x8*)(ST + (16 * w + l15) * 136 + k0 + 8 * g);
        acc = __builtin_amdgcn_mfma_f32_16x16x32_bf16(a, bb, acc, 0, 0, 0);
      }
      o[tm] = acc;
#pragma unroll
      for (int j = 0; j < 4; ++j) {
        float ss = acc[j] * acc[j];
        ss += __int_as_float(__builtin_amdgcn_update_dpp(0, __float_as_int(ss), 0xB1, 0xf, 0xf, true));
        ss += __int_as_float(__builtin_amdgcn_update_dpp(0, __float_as_int(ss), 0x4E, 0xf, 0xf, true));
        ss += __int_as_float(__builtin_amdgcn_update_dpp(0, __float_as_int(ss), 0x141, 0xf, 0xf, true));
        ss += __int_as_float(__builtin_amdgcn_update_dpp(0, __float_as_int(ss), 0x140, 0xf, 0xf, true));
        if (l15 == 0) red[w * 64 + tm * 16 + 4 * g + j] = ss;
      }
    }
#pragma unroll
    for (int dm = 0; dm < 8; ++dm) {
      const unsigned u01 = (dm & 1) ? cu[dm >> 1].z : cu[dm >> 1].x, u23 = (dm & 1) ? cu[dm >> 1].w : cu[dm >> 1].y;
      const float uv[4] = {__uint_as_float(u01 << 16), __uint_as_float(u01 & 0xffff0000u), __uint_as_float(u23 << 16), __uint_as_float(u23 & 0xffff0000u)};
#pragma unroll
      for (int j = 0; j < 4; ++j) { const int dd = 16 * dm + 4 * g + j; S[dm][j] = decl[128 + dd] * S[dm][j] + decl[256 + dd] * uv[j]; }
    }
    __syncthreads();
    if (tid < 64) {
      float tot = 0.f;
#pragma unroll
      for (int ww = 0; ww < 8; ++ww) tot += red[ww * 64 + tid];
      red[512 + tid] = rsqrtf(tot * (1.f / 128.f) + EPSV);
    }
    __syncthreads();
#pragma unroll
    for (int tm = 0; tm < 4; ++tm)
#pragma unroll
      for (int j = 0; j < 4; ++j) {
        const int t = tm * 16 + 4 * g + j;
        const float rstd = red[512 + t];
        ya[(row0 + t) * 1024 + h * 128 + e] = f2bf(o[tm][j] * rstd * gnv * siluf_(bf2f(cog[tm * 4 + j])));
      }
  }
#undef H2_LOAD
}

__device__ __forceinline__ int team_index(const Params& p, unsigned char* smem) {
  int* sh = (int*)(smem + 8192);
  const int G = gridDim.x, tid = threadIdx.x;
  const int* tab = (const int*)(p.ws + WS_XCC);
  if (tid < 32) sh[tid] = 0;
  __syncthreads();
  const int mine = tab[blockIdx.x] & 15;
  for (int b = tid; b < G; b += NTHREADS) {
    const int x = tab[b] & 15;
    atomicAdd(&sh[x], 1);
    if (x == mine && b < (int)blockIdx.x) atomicAdd(&sh[16], 1);
  }
  __syncthreads();
  if (tid == 0) {
    int pre = 0;
    for (int j = 0; j < mine; ++j) pre += sh[j];
    sh[17] = pre + sh[16];
  }
  __syncthreads();
  const int r = sh[17];
  __syncthreads();
  return r;
}

#define SCW 4100
#ifndef DSA_REP
#define DSA_REP 0
#endif
#define DSA_BKT_OFF (8 * SCW * 4 + 8 * 256 * 4 + 8 * 256 * 2 + 8 * 512 * 2)
__device__ __forceinline__ void cvt8(const uint4& v, float* f) {
  f[0] = __uint_as_float(v.x << 16); f[1] = __uint_as_float(v.x & 0xffff0000u);
  f[2] = __uint_as_float(v.y << 16); f[3] = __uint_as_float(v.y & 0xffff0000u);
  f[4] = __uint_as_float(v.z << 16); f[5] = __uint_as_float(v.z & 0xffff0000u);
  f[6] = __uint_as_float(v.w << 16); f[7] = __uint_as_float(v.w & 0xffff0000u);
}
__device__ __forceinline__ unsigned sortable_key(float v) {
  unsigned bits = __float_as_uint(v);
  if (bits == 0x80000000u) bits = 0u;
  return (bits & 0x80000000u) ? ~bits : (bits | 0x80000000u);
}

#ifndef PROBE_SEC
#define PROBE_SEC 0
#endif
#define PRB_T() ((long long)wall_clock64())
__device__ __forceinline__ void dsa_item(const Params& p, unsigned char* smem, int item, const volatile int* next_slot, long long& tacc) {
#define PRB_W(k) (*((volatile unsigned*)(smem + 155040) + (threadIdx.x >> 6) * 4 + (k)))
  if (PROBE_SEC && (threadIdx.x & 63) == 0) PRB_W(0) = (unsigned)PRB_T();
  unsigned char* ws = p.ws;
  const bf16_t* pA = (const bf16_t*)(ws + WS_PA);
  const bf16_t* kc = (const bf16_t*)(ws + WS_KC);
  const bf16_t* vc = (const bf16_t*)(ws + WS_VC);
  const bf16_t* ikc = (const bf16_t*)(ws + WS_IKC);
  bf16_t* yb = (bf16_t*)(ws + WS_XN) + 512;
  unsigned* sc = (unsigned*)smem;
  unsigned* hist = sc + 8 * SCW;
  unsigned short* sel = (unsigned short*)(hist + 8 * 256);
  unsigned short* cand = sel + 8 * 256;
  unsigned char* bkt = (unsigned char*)(cand + 8 * 512);
  unsigned* rmm = (unsigned*)(bkt + 128 + 1056);
  unsigned* bks = rmm + 24;
  const int tid = threadIdx.x, lane = tid & 63, w = tid >> 6, l15 = lane & 15, g = lane >> 4;
  const int b = item >> 9;
  const int tb = item & 511;
  const int t0 = __builtin_amdgcn_readfirstlane(tb * 8);
  const size_t tokbase = (size_t)b * SEQL;

  for (int rep_s = 0; rep_s < (DSA_REP == 1 ? 2 : 1); ++rep_s) {
    bf16x8 af[2][2];
    float wq[2][4];
#pragma unroll
    for (int mt = 0; mt < 2; ++mt) {
      const int qrow = t0 + mt * 4 + (l15 >> 2), head = l15 & 3;
#pragma unroll
      for (int ks = 0; ks < 2; ++ks)
        af[mt][ks] = *(const bf16x8*)(pA + (tokbase + qrow) * 1024 + 640 + head * 64 + ks * 32 + 8 * g);
      const uint2 wr = *(const uint2*)(pA + (tokbase + t0 + mt * 4 + g) * 1024 + 960);
      wq[mt][0] = 0.0625f * bf2f((bf16_t)(wr.x & 0xffff)); wq[mt][1] = 0.0625f * bf2f((bf16_t)(wr.x >> 16));
      wq[mt][2] = 0.0625f * bf2f((bf16_t)(wr.y & 0xffff)); wq[mt][3] = 0.0625f * bf2f((bf16_t)(wr.y >> 16));
    }
    const int nkt = (t0 + 8 + 15) >> 4;
    float fmn[2] = {INFINITY, INFINITY}, fmx[2] = {-INFINITY, -INFINITY};
    float f2[2] = {-INFINITY, -INFINITY};
    const int w_s = __builtin_amdgcn_readfirstlane(w);
    bf16x8 b0[8], b1[8];
#define DSA_SCLOAD(KT0) do { _Pragma("unroll") for (int u = 0; u < 8; ++u) { \
        const int kt_ = (KT0) + 8 * u; \
        const int s_ = (kt_ < nkt ? kt_ : 0) * 16 + l15; \
        const bf16_t* kr_ = ikc + (tokbase + s_) * 64 + 8 * g; \
        b0[u] = *(const bf16x8*)kr_; b1[u] = *(const bf16x8*)(kr_ + 32); } } while (0)
    DSA_SCLOAD(w_s);
    for (int kt0 = w_s; kt0 < nkt; kt0 += 64) {
      __builtin_amdgcn_sched_barrier(0);
      f32x4 sacc[8][2];
#pragma unroll
      for (int u = 0; u < 8; ++u)
#pragma unroll
        for (int mt = 0; mt < 2; ++mt) {
          f32x4 acc = (f32x4){0.f, 0.f, 0.f, 0.f};
          acc = __builtin_amdgcn_mfma_f32_16x16x32_bf16(af[mt][0], b0[u], acc, 0, 0, 0);
          sacc[u][mt] = __builtin_amdgcn_mfma_f32_16x16x32_bf16(af[mt][1], b1[u], acc, 0, 0, 0);
        }
      __builtin_amdgcn_sched_barrier(0);
      if (kt0 + 64 < nkt) { DSA_SCLOAD(kt0 + 64); }
      __builtin_amdgcn_sched_barrier(0);
#pragma unroll
      for (int u = 0; u < 8; ++u) {
        const int kt = kt0 + 8 * u;
        if (kt < nkt) {
          const int s = kt * 16 + l15;
#pragma unroll
          for (int mt = 0; mt < 2; ++mt) {
#define DSA_RELU(x) __int_as_float(max(__float_as_int(x), 0))
            const float v = fmaf(wq[mt][3], DSA_RELU(sacc[u][mt][3]), fmaf(wq[mt][2], DSA_RELU(sacc[u][mt][2]),
                            fmaf(wq[mt][1], DSA_RELU(sacc[u][mt][1]), fmaf(wq[mt][0], DSA_RELU(sacc[u][mt][0]), 0.f))));
#undef DSA_RELU
            const int t = t0 + mt * 4 + g;
            sc[(mt * 4 + g) * SCW + s] = __float_as_uint(v);
            const bool valid = s <= t;
            fmn[mt] = __builtin_amdgcn_fmed3f(fmn[mt], valid ? v : INFINITY, -3.4028234663852886e38f);
            f2[mt] = __builtin_amdgcn_fmed3f(fmx[mt], f2[mt], valid ? v : -INFINITY);
            fmx[mt] = __builtin_amdgcn_fmed3f(fmx[mt], valid ? v : -INFINITY, 3.4028234663852886e38f);
          }
        }
      }
    }
#undef DSA_SCLOAD
#pragma unroll
    for (int mt = 0; mt < 2; ++mt) {
      const unsigned ba_ = __float_as_uint(fmn[mt]), bb_ = __float_as_uint(fmx[mt]);
      const unsigned bc_ = __float_as_uint(f2[mt]);
      unsigned a = (ba_ & 0x80000000u) ? ~ba_ : (ba_ | 0x80000000u), bmx = (bb_ & 0x80000000u) ? ~bb_ : (bb_ | 0x80000000u);
      unsigned c2 = (bc_ & 0x80000000u) ? ~bc_ : (bc_ | 0x80000000u);
#define DPP_MINMAX(CTRL) do { const unsigned a2 = (unsigned)__builtin_amdgcn_update_dpp((int)a, (int)a, CTRL, 0xf, 0xf, false); \
                               const unsigned b2 = (unsigned)__builtin_amdgcn_update_dpp((int)bmx, (int)bmx, CTRL, 0xf, 0xf, false); \
                               const unsigned d2 = (unsigned)__builtin_amdgcn_update_dpp((int)c2, (int)c2, CTRL, 0xf, 0xf, false); \
                               a = a2 < a ? a2 : a; bmx = b2 > bmx ? b2 : bmx; c2 = d2 < c2 ? d2 : c2; } while (0)
      DPP_MINMAX(0xB1); DPP_MINMAX(0x4E); DPP_MINMAX(0x141); DPP_MINMAX(0x140);
#undef DPP_MINMAX
      if (l15 == 0) { atomicMin(&rmm[mt * 4 + g], a); atomicMax(&rmm[8 + mt * 4 + g], bmx); atomicMin(&rmm[16 + mt * 4 + g], c2); }
    }
  }
  __syncthreads();
  if (PROBE_SEC && (threadIdx.x & 63) == 0) PRB_W(1) = (unsigned)PRB_T();
  {
    const int nk = *next_slot;
    if (nk >= 0) {
      const int nbt = nk >> 16, nkl = nk & 0xffff, nkq = nkl / 17, nkr = nkl - nkq * 17;
      if (nkr < 16 && lane < 14) {
        const int ntb = 511 - (nkq * 16 + nkr);
        const unsigned char* rp = (const unsigned char*)(pA + ((size_t)nbt * SEQL + ntb * 8 + w) * 1024) + (lane < 8 ? lane * 128 : 1280 + (lane - 8) * 128);
        (void)*(const volatile unsigned*)rp;
      }
    }
  }
  const int t = t0 + w;
  const int n = t + 1;
  unsigned* row = sc + w * SCW;
  const float* rowf = (const float*)row;
  unsigned short* mysel = sel + w * 256;
  unsigned short* mycand = cand + w * 512;
  unsigned* myh = hist + w * 256;
  int cnt;
  const unsigned long long lt_mask = (1ull << lane) - 1ull;
  for (int rep_t = 0; rep_t < (DSA_REP == 2 ? 2 : 1); ++rep_t)
  if (n <= 256) {
    for (int i = lane; i < n; i += 64) mysel[i] = (unsigned short)i;
    cnt = n;
  } else {
    cnt = 256;
    float mn, mx;
    {
      const unsigned kmn = rmm[w], kmx = rmm[8 + w], klo = rmm[16 + w];
      mn = __uint_as_float((kmn & 0x80000000u) ? (kmn ^ 0x80000000u) : ~kmn);
      mx = __uint_as_float((kmx & 0x80000000u) ? (kmx ^ 0x80000000u) : ~kmx);
      mn = fmaxf(mn, __uint_as_float((klo & 0x80000000u) ? (klo ^ 0x80000000u) : ~klo));
    }
    const float scale = (mx > mn) ? 255.99f / (mx - mn) : 0.f;
#pragma unroll
    for (int i = 0; i < 4; ++i) myh[lane + 64 * i] = 0u;
    lds_fence();
    for (int i0 = lane; i0 < n; i0 += 256) {
      float v4[4];
#pragma unroll
      for (int k = 0; k < 4; ++k) v4[k] = (i0 + 64 * k < n) ? rowf[i0 + 64 * k] : 0.f;
#pragma unroll
      for (int k = 0; k < 4; ++k) {
        if (i0 + 64 * k < n && v4[k] >= mn) {
          int bn = (int)((v4[k] - mn) * scale); bn = bn > 255 ? 255 : bn;
          atomicAdd(&myh[bn], 1u);
        }
      }
    }
    lds_fence();
    unsigned cum; int bstar; unsigned mcount;
    {
      const uint4 c4 = *(const uint4*)(myh + 4 * lane);
      const unsigned c = c4.x + c4.y + c4.z + c4.w;
      unsigned sfx = c;
#pragma unroll
      for (int o = 1; o < 64; o <<= 1) { const unsigned tt = __shfl_down(sfx, o); if (lane + o < 64) sfx += tt; }
      const unsigned long long bal = __ballot(sfx >= 256u);
      const int L = 63 - __clzll(bal);
      const unsigned sL = __shfl(sfx, L), cL = __shfl(c, L);
      const unsigned b3 = __shfl(c4.w, L), b2 = __shfl(c4.z, L), b1 = __shfl(c4.y, L), b0 = __shfl(c4.x, L);
      cum = sL - cL;
      int digit;
      if (cum + b3 >= 256u) { digit = 3; mcount = b3; }
      else { cum += b3; if (cum + b2 >= 256u) { digit = 2; mcount = b2; } else { cum += b2; if (cum + b1 >= 256u) { digit = 1; mcount = b1; } else { cum += b1; digit = 0; mcount = b0; } } }
      bstar = 4 * L + digit;
    }
    const unsigned need = 256u - cum;
    if (mcount <= 512u) {
      unsigned base = 0u, cb = 0u;
      for (int i0 = 0; i0 < n; i0 += 256) {
        float v4[4];
#pragma unroll
        for (int k = 0; k < 4; ++k) { const int i = i0 + 64 * k + lane; v4[k] = (i < n) ? rowf[i] : 0.f; }
#pragma unroll
        for (int k = 0; k < 4; ++k) {
          const int i = i0 + 64 * k + lane;
          const bool valid = i < n && v4[k] >= mn;
          int bn = (int)((v4[k] - mn) * scale); bn = bn > 255 ? 255 : bn;
          const bool gt = valid && (bn > bstar);
          const bool eq = valid && (bn == bstar);
          const unsigned long long bg = __ballot(gt), be = __ballot(eq);
          if (gt) mysel[base + (unsigned)__popcll(bg & lt_mask)] = (unsigned short)i;
          if (eq) mycand[cb + (unsigned)__popcll(be & lt_mask)] = (unsigned short)i;
          base += (unsigned)__popcll(bg); cb += (unsigned)__popcll(be);
        }
      }
      lds_fence();
      const int m = (int)mcount;
      unsigned ck[8]; unsigned short ci[8];
#pragma unroll
      for (int q = 0; q < 8; ++q) {
        const int c = q * 64 + lane;
        ck[q] = 0u; ci[q] = 0;
        if (c < m) { ci[q] = mycand[c]; ck[q] = sortable_key(rowf[ci[q]]); }
      }
      unsigned T = 0u;
      if (m <= 64) {
#pragma unroll 1
        for (int bit = 31; bit >= 0; --bit) {
          const unsigned trial = T | (1u << bit);
          if ((unsigned)__popcll(__ballot(ck[0] >= trial)) >= need) T = trial;
        }
      } else {
#pragma unroll 1
        for (int bit = 31; bit >= 0; --bit) {
          const unsigned trial = T | (1u << bit);
          unsigned cge = 0u;
#pragma unroll
          for (int q = 0; q < 8; ++q) cge += (unsigned)__popcll(__ballot(ck[q] >= trial));
          if (cge >= need) T = trial;
        }
      }
      unsigned cgt = 0u;
#pragma unroll
      for (int q = 0; q < 8; ++q) cgt += (unsigned)__popcll(__ballot(ck[q] > T));
      const unsigned need_eq = need - cgt;
      unsigned pos0 = cum, eqtaken = 0u;
#pragma unroll
      for (int q = 0; q < 8; ++q) {
        const bool gt = ck[q] > T;
        const bool eq = ck[q] == T;
        const unsigned long long beq = __ballot(eq);
        const bool take = gt || (eq && (eqtaken + (unsigned)__popcll(beq & lt_mask)) < need_eq);
        const unsigned long long bt = __ballot(take);
        const unsigned pp = pos0 + (unsigned)__popcll(bt & lt_mask);
        if (take && pp < 256u) mysel[pp] = ci[q];
        pos0 += (unsigned)__popcll(bt);
        eqtaken += (unsigned)__popcll(beq);
      }
    } else {
      unsigned prefix = 0u, krem = 256u;
#pragma unroll 1
      for (int pass = 0; pass < 4; ++pass) {
        const int shift = 24 - 8 * pass;
        const unsigned himask = (pass == 0) ? 0u : (0xFFFFFFFFu << (shift + 8));
#pragma unroll
        for (int i = 0; i < 4; ++i) myh[lane + 64 * i] = 0u;
        lds_fence();
        for (int i = lane; i < n; i += 64) {
          const unsigned u = sortable_key(rowf[i]);
          if ((u & himask) == prefix) atomicAdd(&myh[(u >> shift) & 255u], 1u);
        }
        lds_fence();
        const uint4 c4 = *(const uint4*)(myh + 4 * lane);
        const unsigned c = c4.x + c4.y + c4.z + c4.w;
        unsigned sfx = c;
#pragma unroll
        for (int o = 1; o < 64; o <<= 1) { const unsigned tt = __shfl_down(sfx, o); if (lane + o < 64) sfx += tt; }
        const unsigned long long bal = __ballot(sfx >= krem);
        const int L = 63 - __clzll(bal);
        const unsigned sL = __shfl(sfx, L), cL = __shfl(c, L);
        const unsigned b3 = __shfl(c4.w, L), b2 = __shfl(c4.z, L), b1 = __shfl(c4.y, L);
        unsigned cum2 = sL - cL;
        unsigned digit;
        if (cum2 + b3 >= krem) digit = 3;
        else { cum2 += b3; if (cum2 + b2 >= krem) digit = 2; else { cum2 += b2; if (cum2 + b1 >= krem) digit = 1; else { cum2 += b1; digit = 0; } } }
        krem -= cum2;
        prefix |= ((unsigned)(4 * L) + digit) << shift;
      }
      const unsigned T = prefix;
      unsigned base = 0u, eqtaken = 0u;
      for (int i0 = 0; i0 < n; i0 += 64) {
        const int i = i0 + lane;
        const bool valid = i < n;
        const unsigned u = valid ? sortable_key(rowf[i]) : 0u;
        const bool gt = valid && (u > T);
        const bool eq = valid && (u == T);
        const unsigned long long beq = __ballot(eq);
        const unsigned eqrank = eqtaken + (unsigned)__popcll(beq & lt_mask);
        const bool take = gt || (eq && eqrank < krem);
        const unsigned long long bt = __ballot(take);
        const unsigned pos = base + (unsigned)__popcll(bt & lt_mask);
        if (take && pos < 256u) mysel[pos] = (unsigned short)i;
        base += (unsigned)__popcll(bt);
        eqtaken += (unsigned)__popcll(beq);
      }
    }
  }
  lds_fence();
  if (PROBE_SEC && (threadIdx.x & 63) == 0) PRB_W(2) = (unsigned)PRB_T();
  if (lane == 0) { rmm[w] = 0xFFFFFFFFu; rmm[8 + w] = 0u; rmm[16 + w] = 0xFFFFFFFFu; }
  lds_fence();
  {
    const uint2 s4 = *(const uint2*)(mysel + 4 * lane);
    const int sj[4] = {(int)(s4.x & 0xffffu), (int)(s4.x >> 16), (int)(s4.y & 0xffffu), (int)(s4.y >> 16)};
    unsigned pk = 0u;
#pragma unroll
    for (int j = 0; j < 4; ++j) {
      const bool valid = 4 * lane + j < cnt;
      const int dist = valid ? t - sj[j] : 0;
      unsigned bk = dist < 128 ? (unsigned)bkt[dist] : 31u;
      bk = valid ? bk : 32u;
      pk |= bk << (8 * j);
    }
    bks[w * 64 + lane] = pk;
  }
  lds_fence();
  {
    int lane_a = lane;
    asm volatile("" : "+v"(lane_a));
    const int l15 = lane_a & 15, g = lane_a >> 4;
    const int ks = lane_a >> 3, dc = lane_a & 7;
    const unsigned char* kcb = (const unsigned char*)(kc + tokbase * 64);
    const unsigned char* vcb = (const unsigned char*)(vc + tokbase * 64);
    float* pl = (float*)row;
    const float* relb = (const float*)(bkt + 128);
    const int niter = (cnt + 7) >> 3;
    bf16x8 bq0 = (bf16x8){0, 0, 0, 0, 0, 0, 0, 0}, bq1 = bq0;
    if (l15 < 8) {
      bq0 = *(const bf16x8*)(pA + (tokbase + t) * 1024 + l15 * 64 + 8 * g);
      bq1 = *(const bf16x8*)(pA + (tokbase + t) * 1024 + l15 * 64 + 32 + 8 * g);
    }
    float lg[16][4];
    {
      bf16x8 ka[8][2], kb[8][2];
#pragma unroll
      for (int u = 0; u < 8; ++u) {
        const int kk = u * 16 + l15;
        const unsigned s = (unsigned)mysel[kk] & 4095u;
        const unsigned ko = s * 128u + 16u * (unsigned)g;
        ka[u][0] = *(const bf16x8*)(kcb + ko);
        ka[u][1] = *(const bf16x8*)(kcb + ko + 64u);
      }
#pragma unroll
      for (int u = 0; u < 8; ++u) {
        const int kk = (8 + u) * 16 + l15;
        const unsigned s = (unsigned)mysel[kk] & 4095u;
        const unsigned ko = s * 128u + 16u * (unsigned)g;
        kb[u][0] = *(const bf16x8*)(kcb + ko);
        kb[u][1] = *(const bf16x8*)(kcb + ko + 64u);
      }
      __builtin_amdgcn_sched_barrier(0);
#pragma unroll
      for (int u = 0; u < 8; ++u) {
        f32x4 acc = (f32x4){0.f, 0.f, 0.f, 0.f};
        acc = __builtin_amdgcn_mfma_f32_16x16x32_bf16(ka[u][0], bq0, acc, 0, 0, 0);
        acc = __builtin_amdgcn_mfma_f32_16x16x32_bf16(ka[u][1], bq1, acc, 0, 0, 0);
        lg[u][0] = acc[0]; lg[u][1] = acc[1]; lg[u][2] = acc[2]; lg[u][3] = acc[3];
      }
#pragma unroll
      for (int u = 0; u < 8; ++u) {
        f32x4 acc = (f32x4){0.f, 0.f, 0.f, 0.f};
        acc = __builtin_amdgcn_mfma_f32_16x16x32_bf16(kb[u][0], bq0, acc, 0, 0, 0);
        acc = __builtin_amdgcn_mfma_f32_16x16x32_bf16(kb[u][1], bq1, acc, 0, 0, 0);
        lg[8 + u][0] = acc[0]; lg[8 + u][1] = acc[1]; lg[8 + u][2] = acc[2]; lg[8 + u][3] = acc[3];
      }
    }
    typedef unsigned u32x4_t __attribute__((ext_vector_type(4)));
    u32x4_t va[16];
#pragma unroll
    for (int u = 0; u < 16; ++u) {
      const int kk = u * 8 + ks;
      const unsigned s = (unsigned)mysel[kk] & 4095u;
      va[u] = *(const u32x4_t*)(vcb + s * 128u + 16u * (unsigned)dc);
    }
    __builtin_amdgcn_sched_barrier(0);
    const int hsel = l15 & 7;
    float m = -INFINITY;
    const unsigned* mybks = bks + w * 64;
#pragma unroll
    for (int u = 0; u < 16; ++u) {
      const unsigned bk4 = mybks[4 * u + g];
#pragma unroll
      for (int j = 0; j < 4; ++j) {
        lg[u][j] = lg[u][j] * 0.125f + relb[((bk4 >> (8 * j)) & 255u) * 8 + hsel];
        m = fmaxf(m, lg[u][j]);
      }
    }
    m = max_xor16(m); m = max_xor32(m);
    float sum = 0.f;
#pragma unroll
    for (int u = 0; u < 16; ++u)
#pragma unroll
      for (int j = 0; j < 4; ++j) { lg[u][j] = __expf(lg[u][j] - m); sum += lg[u][j]; }
    sum = add_xor16(sum); sum = add_xor32(sum);
    const float inv = 1.f / sum;
    bf16x8 pa[8];
#pragma unroll
    for (int s8 = 0; s8 < 8; ++s8) {
      const unsigned w0 = pack2(lg[2 * s8][0] * inv, lg[2 * s8][1] * inv), w1 = pack2(lg[2 * s8][2] * inv, lg[2 * s8][3] * inv);
      const unsigned w2 = pack2(lg[2 * s8 + 1][0] * inv, lg[2 * s8 + 1][1] * inv), w3 = pack2(lg[2 * s8 + 1][2] * inv, lg[2 * s8 + 1][3] * inv);
      const u32x4_t wv = {w0, w1, w2, w3};
      pa[s8] = __builtin_bit_cast(bf16x8, wv);
    }
    unsigned char* vs_l = (unsigned char*)row;
    const unsigned vst_off = (unsigned)(ks * 128 + ((dc ^ (((ks >> 1) & 3) << 1)) << 4));
#pragma unroll
    for (int u = 0; u < 16; ++u) *(u32x4_t*)(vs_l + u * 1024 + vst_off) = va[u];
    lds_fence();
    u32x4_t vb[16];
#pragma unroll
    for (int u = 0; u < 16; ++u) {
      const int kk = (16 + u) * 8 + ks;
      const unsigned s = (unsigned)mysel[kk] & 4095u;
      vb[u] = *(const u32x4_t*)(vcb + s * 128u + 16u * (unsigned)dc);
    }
    __builtin_amdgcn_sched_barrier(0);
    f32x4 ov[4];
#pragma unroll
    for (int nt = 0; nt < 4; ++nt) ov[nt] = (f32x4){0.f, 0.f, 0.f, 0.f};
    typedef short v4s_t __attribute__((ext_vector_type(4)));
    const unsigned tr_lane = (unsigned)((l15 >> 2) * 128 + (l15 & 3) * 8);
    const unsigned tr_k = (unsigned)(((g & 1) << 1) | (l15 >> 3));
    unsigned tr_off[4];
#pragma unroll
    for (int nt = 0; nt < 4; ++nt) tr_off[nt] = tr_lane + (((unsigned)nt ^ tr_k) << 5);
#define PV_HALF(S0) do { \
      _Pragma("unroll") for (int s4_ = 0; s4_ < 4; ++s4_) { \
        _Pragma("unroll") for (int nt = 0; nt < 4; ++nt) { \
          const unsigned a0 = (unsigned)((s4_ * 32 + 4 * g) * 128) + tr_off[nt]; \
          const v4s_t b0 = __builtin_amdgcn_ds_read_tr16_b64_v4i16((__attribute__((address_space(3))) v4s_t*)(vs_l + a0)); \
          const v4s_t b1 = __builtin_amdgcn_ds_read_tr16_b64_v4i16((__attribute__((address_space(3))) v4s_t*)(vs_l + a0 + 16 * 128)); \
          const bf16x8 bb = (bf16x8){b0[0], b0[1], b0[2], b0[3], b1[0], b1[1], b1[2], b1[3]}; \
          ov[nt] = __builtin_amdgcn_mfma_f32_16x16x32_bf16(pa[(S0) + s4_], bb, ov[nt], 0, 0, 0); \
        } \
      } \
    } while (0)
    PV_HALF(0);
    lds_fence();
#pragma unroll
    for (int u = 0; u < 16; ++u) *(u32x4_t*)(vs_l + u * 1024 + vst_off) = vb[u];
    lds_fence();
    PV_HALF(4);
#undef PV_HALF
    if (g < 2) {
#pragma unroll
      for (int nt = 0; nt < 4; ++nt)
#pragma unroll
        for (int j = 0; j < 4; ++j) yb[(tokbase + t) * 1024 + (4 * g + j) * 64 + nt * 16 + l15] = f2bf(ov[nt][j]);
    }
    lds_fence();
  }
  if (PROBE_SEC && (threadIdx.x & 63) == 0) PRB_W(3) = (unsigned)PRB_T();
  __syncthreads();
  if (PROBE_SEC && (threadIdx.x & 63) == 0) {
    volatile unsigned* pacc = (volatile unsigned*)(smem + 155040 + 128) + (threadIdx.x >> 6);
    if (PROBE_SEC == 1) *pacc += PRB_W(1) - PRB_W(0);
    if (PROBE_SEC == 2) *pacc += PRB_W(2) - PRB_W(1);
    if (PROBE_SEC == 3) *pacc += PRB_W(3) - PRB_W(2);
    if (PROBE_SEC == 4) *pacc += (unsigned)PRB_T() - PRB_W(0);
  }
}

__device__ __forceinline__ void phase_mix(const Params& p, unsigned char* smem, int mode = 0) {
  const int G = gridDim.x;
  long long tacc = 0;
  if (PROBE_SEC && (threadIdx.x & 63) == 0) *((volatile unsigned*)(smem + 155040 + 128) + (threadIdx.x >> 6)) = 0u;
  if (mode != 2) { for (int bh = blockIdx.x; bh < 32; bh += G) { const long long h2t = PROBE_SEC ? PRB_T() : 0; hgrn_h2(p, smem, bh); __syncthreads(); if (PROBE_SEC == 5 && (threadIdx.x & 63) == 0) *((volatile unsigned*)(smem + 155040 + 128) + (threadIdx.x >> 6)) += (unsigned)(PRB_T() - h2t); } }
  if (mode == 1) return;
  unsigned char* bkt = smem + DSA_BKT_OFF;
  volatile int* qslot = (volatile int*)(smem + LDS_BYTES - 32);
  unsigned* qctr = (unsigned*)(p.ws + WS_QCTR);
  if (threadIdx.x < 128) {
    const int nn = threadIdx.x;
    int v = nn;
    if (nn >= 16) { v = 16 + (int)(logf((float)nn * (1.f / 16.f)) / logf(8.f) * 16.f); if (v > 31) v = 31; }
    bkt[nn] = (unsigned char)v;
  }
  if (threadIdx.x >= 256) ((float*)(bkt + 128))[threadIdx.x - 256] = p.rel_bias[threadIdx.x - 256];
  if (threadIdx.x >= 128 && threadIdx.x < 136) ((float*)(bkt + 128))[256 + threadIdx.x - 128] = -INFINITY;
  if (threadIdx.x < 24) ((unsigned*)(bkt + 128 + 1056))[threadIdx.x] = (threadIdx.x < 8 || threadIdx.x >= 16) ? 0xFFFFFFFFu : 0u;
  const int my_team = (G % 8 == 0) ? team_index(p, smem) / (G >> 3) : (int)(blockIdx.x & 7);
  constexpr int QN = 544;
#define Q_FETCH(SLOT) do { if (threadIdx.x == 0) { int tm_ = q_team, kk_ = -1; \
      for (int tries_ = 0; tries_ < 8; ++tries_) { \
        const unsigned v_ = __hip_atomic_fetch_add(qctr + 16 * tm_, 1u, __ATOMIC_RELAXED, __HIP_MEMORY_SCOPE_AGENT); \
        if (v_ < (unsigned)QN) { kk_ = (tm_ << 16) | (int)v_; break; } \
        tm_ = (tm_ + 1) & 7; } \
      q_team = tm_; qslot[SLOT] = kk_; } } while (0)
  int q_team = my_team;
  Q_FETCH(0);
  __syncthreads();
  int k = qslot[0];
  int par = 1;
  while (k >= 0) {
    Q_FETCH(par);
    const int bt = k >> 16, kl = k & 0xffff;
    const int kq = kl / 17, kr = kl - kq * 17;
    if (kr < 16) {
      const int tb = 511 - (kq * 16 + kr);
      dsa_item(p, smem, (bt << 9) | tb, qslot + par, tacc);
    } else {
      const int r0 = (bt * 32 + kq) * 64;
      quantize_rows_u8<false, true>(p.peer_u, p.ws + WS_U, (float*)(p.ws + WS_U + (size_t)16384 * 1024), r0, r0 + 64);
      quantize_rows_u8<true, true>(p.peer_v, p.ws + WS_V, (float*)(p.ws + WS_V + (size_t)16384 * 1024), r0, r0 + 64);
      __syncthreads();
    }
    k = qslot[par];
    par ^= 1;
  }
#undef Q_FETCH
  if (PROBE_SEC) { const long long dl = (long long)*((volatile unsigned*)(smem + 155040 + 128) + (threadIdx.x >> 6)); const long long s0 = PRB_T(); while (PRB_T() - s0 < dl) __builtin_amdgcn_s_sleep(8); }
}

__device__ __forceinline__ void phase_pkeys(const Params& p, unsigned char* smem) {
  unsigned char* ws = p.ws;
  const bf16_t* qp = (const bf16_t*)(ws + WS_PG);
  const bf16_t* keys = (const bf16_t*)(ws + WS_KEYS);
  int* eidx = (int*)(ws + WS_EIDX);
  float* gw = (float*)(ws + WS_GW);
  float* sc = (float*)smem;
  float* s2l = (float*)smem;
  unsigned short* i1l = (unsigned short*)(s2l + 256 * 17);
  unsigned short* i2l = i1l + 256 * 16;
  const int tid = threadIdx.x, lane = tid & 63, w = tid >> 6, wm = w >> 1, wn = w & 1, l15 = lane & 15, g = lane >> 4;
  for (int item = blockIdx.x; item < 128 * 8; item += gridDim.x) {
    const int h = item & 7, tm = item >> 3;
    float s1[16], s2v[16]; int i1[16], i2[16];
#pragma unroll
    for (int ph = 0; ph < 2; ++ph) {
      const int hp = h * 2 + ph;
      f32x4 acc[4][4]; zero_acc(acc);
      gemm_tile(qp + (size_t)tm * 256 * 2048 + hp * 128, 2048, keys + (size_t)(ph * 8 + h) * 128 * 128, 128, 2, acc, smem);
      __syncthreads();
#pragma unroll
      for (int m = 0; m < 4; ++m)
#pragma unroll
        for (int n = 0; n < 4; ++n)
#pragma unroll
          for (int j = 0; j < 4; ++j) sc[(wm * 64 + m * 16 + 4 * g + j) * 129 + wn * 64 + n * 16 + l15] = acc[m][n][j];
      __syncthreads();
      if (tid < 256) {
        const float* rowp = sc + tid * 129;
        unsigned tv[16];
#pragma unroll
        for (int k = 0; k < 16; ++k) tv[k] = 0u;
#pragma unroll 8
        for (int nn = 0; nn < 128; ++nn) {
          const unsigned bits = __float_as_uint(rowp[nn]);
          unsigned key = (bits & 0x80000000u) ? ~bits : (bits | 0x80000000u);
          key = (key & ~127u) | (unsigned)(127 - nn);
#pragma unroll
          for (int k = 15; k >= 1; --k) {
            unsigned r;
            asm("v_med3_u32 %0, %1, %2, %3" : "=v"(r) : "v"(tv[k]), "v"(tv[k - 1]), "v"(key));
            tv[k] = r;
          }
          tv[0] = tv[0] > key ? tv[0] : key;
        }
#pragma unroll
        for (int k = 0; k < 16; ++k) {
          const int col = 127 - (int)(tv[k] & 127u);
          const float val = rowp[col];
          if (ph == 0) { i1[k] = col; s1[k] = val; } else { i2[k] = col; s2v[k] = val; }
        }
      }
      __syncthreads();
    }
    if (tid < 256) {
#pragma unroll
      for (int a = 0; a < 16; ++a) { s2l[tid * 17 + a] = s2v[a]; i1l[tid * 16 + a] = (unsigned short)i1[a]; i2l[tid * 16 + a] = (unsigned short)i2[a]; }
      float cur[16];
#pragma unroll
      for (int a = 0; a < 16; ++a) cur[a] = s1[a] + s2v[0];
      unsigned long long ptr = 0ull;
      float tops[16]; int tope[16];
#pragma unroll
      for (int k = 0; k < 16; ++k) {
        float best = cur[0]; int ba = 0;
#pragma unroll
        for (int a = 1; a < 16; ++a) if (cur[a] > best) { best = cur[a]; ba = a; }
        const int bb = (int)((ptr >> (4 * ba)) & 15ull);
        tops[k] = best;
        tope[k] = (int)i1l[tid * 16 + ba] * 128 + (int)i2l[tid * 16 + bb];
        const int nb = bb + 1;
        const float ns2 = (nb < 16) ? s2l[tid * 17 + nb] : -INFINITY;
        if (nb < 16) ptr += (1ull << (4 * ba));
#pragma unroll
        for (int a = 0; a < 16; ++a) if (a == ba) cur[a] = s1[a] + ns2;
      }
      const float m = tops[0];
      float sum = 0.f;
#pragma unroll
      for (int k = 0; k < 16; ++k) { tops[k] = __expf(tops[k] - m); sum += tops[k]; }
      const float inv = 1.f / sum;
      const size_t ob = ((size_t)(tm * 256 + tid) * 8 + h) * 16;
#pragma unroll
      for (int k = 0; k < 16; k += 4) {
        *(int4*)(eidx + ob + k) = make_int4(tope[k], tope[k + 1], tope[k + 2], tope[k + 3]);
        *(float4*)(gw + ob + k) = make_float4(tops[k] * inv, tops[k + 1] * inv, tops[k + 2] * inv, tops[k + 3] * inv);
      }
    }
    __syncthreads();
  }
}


__device__ __forceinline__ float reduce8(const float (&pv)[8], int lane) {
  const bool b5 = lane & 32, b4 = lane & 16, b3 = lane & 8;
  float v[4];
#pragma unroll
  for (int i = 0; i < 4; ++i) {
    const float keep = b5 ? pv[4 + i] : pv[i];
    const float send = b5 ? pv[i] : pv[4 + i];
    v[i] = keep + __shfl_xor(send, 32);
  }
  float u[2];
#pragma unroll
  for (int i = 0; i < 2; ++i) {
    const float keep = b4 ? v[2 + i] : v[i];
    const float send = b4 ? v[i] : v[2 + i];
    u[i] = keep + __shfl_xor(send, 16);
  }
  float x = (b3 ? u[1] : u[0]) + __shfl_xor(b3 ? u[0] : u[1], 8);
  x += __shfl_xor(x, 4); x += __shfl_xor(x, 2); x += __shfl_xor(x, 1);
  return x;
}

__device__ __forceinline__ void cvt16u8(const uint4& v, float* f) {
  f[0] = (float)(v.x & 0xffu); f[1] = (float)((v.x >> 8) & 0xffu); f[2] = (float)((v.x >> 16) & 0xffu); f[3] = (float)(v.x >> 24);
  f[4] = (float)(v.y & 0xffu); f[5] = (float)((v.y >> 8) & 0xffu); f[6] = (float)((v.y >> 16) & 0xffu); f[7] = (float)(v.y >> 24);
  f[8] = (float)(v.z & 0xffu); f[9] = (float)((v.z >> 8) & 0xffu); f[10] = (float)((v.z >> 16) & 0xffu); f[11] = (float)(v.z >> 24);
  f[12] = (float)(v.w & 0xffu); f[13] = (float)((v.w >> 8) & 0xffu); f[14] = (float)((v.w >> 16) & 0xffu); f[15] = (float)(v.w >> 24);
}

__device__ __forceinline__ int wave_sum_i32_dpp(int v) {
  v += __builtin_amdgcn_update_dpp(0, v, 0xB1, 0xf, 0xf, true);
  v += __builtin_amdgcn_update_dpp(0, v, 0x4E, 0xf, 0xf, true);
  v += __builtin_amdgcn_update_dpp(0, v, 0x141, 0xf, 0xf, true);
  v += __builtin_amdgcn_update_dpp(0, v, 0x140, 0xf, 0xf, true);
  return __builtin_amdgcn_readlane(v, 0) + __builtin_amdgcn_readlane(v, 16) + __builtin_amdgcn_readlane(v, 32) + __builtin_amdgcn_readlane(v, 48);
}

__device__ __forceinline__ int reduce8_i32_scatter(const int (&d)[8], int lane) {
  const bool b0 = lane & 1, b1 = lane & 2, b2 = lane & 4;
  int v[4];
#pragma unroll
  for (int i = 0; i < 4; ++i) {
    const int keep = b0 ? d[2 * i + 1] : d[2 * i];
    const int send = b0 ? d[2 * i] : d[2 * i + 1];
    v[i] = keep + __builtin_amdgcn_update_dpp(0, send, 0xB1, 0xf, 0xf, true);
  }
  int u[2];
#pragma unroll
  for (int i = 0; i < 2; ++i) {
    const int keep = b1 ? v[2 * i + 1] : v[2 * i];
    const int send = b1 ? v[2 * i] : v[2 * i + 1];
    u[i] = keep + __builtin_amdgcn_update_dpp(0, send, 0x4E, 0xf, 0xf, true);
  }
  int x;
  {
    const int keep = b2 ? u[1] : u[0];
    const int send = b2 ? u[0] : u[1];
    int t = __builtin_amdgcn_update_dpp(0, send, 0x141, 0xf, 0xf, true);
    t = __builtin_amdgcn_update_dpp(0, t, 0x1B, 0xf, 0xf, true);
    x = keep + t;
  }
  x += __builtin_amdgcn_update_dpp(0, x, 0x128, 0xf, 0xf, true);
  { const auto r = __builtin_amdgcn_permlane16_swap((unsigned)x, (unsigned)x, false, false); x = (int)r[0] + (int)r[1]; }
  { const auto r = __builtin_amdgcn_permlane32_swap((unsigned)x, (unsigned)x, false, false); x = (int)r[0] + (int)r[1]; }
  return x;
}

__device__ __forceinline__ void phase_pu(const Params& p, unsigned char* smem) {
  unsigned char* ws = p.ws;
  const unsigned char* XQ = ws + WS_XQ;
  const float* xs = (const float*)(ws + WS_XS);
  const unsigned char* U8 = ws + WS_U;
  const float* us = (const float*)(ws + WS_U + (size_t)16384 * 1024);
  const float* vs = (const float*)(ws + WS_V + (size_t)16384 * 1024);
  const int* eidx = (const int*)(ws + WS_EIDX);
  const float* gw = (const float*)(ws + WS_GW);
  float* aw = (float*)(ws + WS_PA);
  const int lane = threadIdx.x & 63, w = threadIdx.x >> 6;
  const unsigned long long lt_mask = (1ull << lane) - 1ull;
  const int G = gridDim.x;
  const bool sliced = (G % 8 == 0);
  const int ti = sliced ? team_index(p, smem) : 0;
  const int tsz = sliced ? (G >> 3) : G;
  const int grp_lo = sliced ? ti / tsz : 0, grp_hi = sliced ? grp_lo + 1 : 8;
  const int slot = (sliced ? (ti % tsz) : (int)blockIdx.x) * 8 + w;
  const int nslot = tsz * 8;
  unsigned* lst = (unsigned*)smem + 4096 + w * 128;
  typedef unsigned u32x4_t __attribute__((ext_vector_type(4)));
  if (slot >= TOK) return;
  for (int grp = grp_lo; grp < grp_hi; ++grp) {
#define PU_LIST(E0, E1, N, L0, L1) do { \
      const bool m0_ = ((E0) >> 11) == grp, m1_ = ((E1) >> 11) == grp; \
      const unsigned long long b0_ = __ballot(m0_), b1_ = __ballot(m1_); \
      const int c0_ = __popcll(b0_); N = c0_ + __popcll(b1_); \
      if (m0_) lst[__popcll(b0_ & lt_mask)] = ((unsigned)lane << 14) | (unsigned)(E0); \
      if (m1_) lst[c0_ + __popcll(b1_ & lt_mask)] = ((unsigned)(lane + 64) << 14) | (unsigned)(E1); \
      lds_fence(); \
      L0 = (lane < N) ? lst[lane] : 0u; L1 = (lane + 64 < N) ? lst[lane + 64] : 0u; \
      lds_fence(); } while (0)
#define PU_ISSUE(BUF, L0, N, I0) do { int last_ = ((N) < 64 ? (N) : 64) - 1; last_ = last_ < 0 ? 0 : last_; \
      _Pragma("unroll") for (int j = 0; j < 8; ++j) { int idx_ = (I0) + j; idx_ = idx_ < last_ ? idx_ : last_; \
        const unsigned le_ = (unsigned)__builtin_amdgcn_readlane((int)(L0), idx_); \
        BUF[j] = *(const u32x4_t*)(U8 + (size_t)(le_ & 16383u) * 1024 + lane * 16); } } while (0)
#define PU_REDUCE(BUF, X, I0, HREG) do { int dd_[8]; _Pragma("unroll") for (int j = 0; j < 8; ++j) { \
        int d_ = __builtin_amdgcn_sdot4((int)BUF[j].x, (int)(X).x, 0, false); \
        d_ = __builtin_amdgcn_sdot4((int)BUF[j].y, (int)(X).y, d_, false); \
        d_ = __builtin_amdgcn_sdot4((int)BUF[j].z, (int)(X).z, d_, false); \
        dd_[j] = __builtin_amdgcn_sdot4((int)BUF[j].w, (int)(X).w, d_, false); } \
      const int tot_ = reduce8_i32_scatter(dd_, lane);     \
      if (lane >= (I0) && lane < (I0) + 8) HREG = tot_; } while (0)
    u32x4_t cx = *(const u32x4_t*)(XQ + (size_t)slot * 1024 + lane * 16);
    int ce0 = eidx[(size_t)slot * 128 + lane], ce1 = eidx[(size_t)slot * 128 + 64 + lane];
    float cxs = xs[slot];
    int cn; unsigned cl0, cl1;
    PU_LIST(ce0, ce1, cn, cl0, cl1);
    u32x4_t ra[8], rb[8], rc[8];
    PU_ISSUE(ra, cl0, cn, 0);
    PU_ISSUE(rb, cl0, cn, 8);
    int t1 = (slot + nslot < TOK) ? slot + nslot : slot;
    u32x4_t nx = *(const u32x4_t*)(XQ + (size_t)t1 * 1024 + lane * 16);
    int ne0 = eidx[(size_t)t1 * 128 + lane], ne1 = eidx[(size_t)t1 * 128 + 64 + lane];
    float nxs = xs[t1];
    for (int tok = slot; tok < TOK; tok += nslot) {
      float sc0 = 0.f, sc1 = 0.f, gv0 = 0.f, gv1 = 0.f, vv0 = 0.f, vv1 = 0.f;
      if (lane < cn) { const int e = cl0 & 16383; sc0 = us[e]; vv0 = vs[e]; gv0 = gw[(size_t)tok * 128 + (cl0 >> 14)]; }
      if (lane + 64 < cn) { const int e = cl1 & 16383; sc1 = us[e]; vv1 = vs[e]; gv1 = gw[(size_t)tok * 128 + (cl1 >> 14)]; }
      int nn; unsigned nl0, nl1;
      PU_LIST(ne0, ne1, nn, nl0, nl1);
      const u32x4_t x1 = nx; const int xe0 = ne0, xe1 = ne1; const float xs1 = nxs;
      const int t2a = tok + nslot, t2 = (t2a + nslot < TOK) ? t2a + nslot : ((t2a < TOK) ? t2a : tok);
      nx = *(const u32x4_t*)(XQ + (size_t)t2 * 1024 + lane * 16);
      ne0 = eidx[(size_t)t2 * 128 + lane]; ne1 = eidx[(size_t)t2 * 128 + 64 + lane];
      nxs = xs[t2];
      int h0i = 0, h1i = 0;
      const bool third = cn > 16;
      if (third) { PU_ISSUE(rc, cl0, cn, 16); }
      __builtin_amdgcn_sched_barrier(0); PU_REDUCE(ra, cx, 0, h0i);  __builtin_amdgcn_sched_barrier(0);
      PU_ISSUE(ra, nl0, nn, 0);  __builtin_amdgcn_sched_barrier(0); PU_REDUCE(rb, cx, 8, h0i);  __builtin_amdgcn_sched_barrier(0);
      PU_ISSUE(rb, nl0, nn, 8);  __builtin_amdgcn_sched_barrier(0);
      if (third) { PU_REDUCE(rc, cx, 16, h0i); }
      __builtin_amdgcn_sched_barrier(0);
      if (cn > 24) {
        for (int i0 = 24; i0 < cn; i0 += 8) {
          u32x4_t rd[8];
          const bool lo = i0 < 64;
          const unsigned lsrc = lo ? cl0 : cl1;
          const int nsrc = lo ? cn : cn - 64;
          PU_ISSUE(rd, lsrc, nsrc, i0 & 63);
          if (lo) { PU_REDUCE(rd, cx, i0, h0i); } else { PU_REDUCE(rd, cx, i0 - 64, h1i); }
        }
      }
      const float h0 = (float)h0i * sc0 * cxs, h1 = (float)h1i * sc1 * cxs;
      if (lane < cn) aw[(size_t)tok * 128 + (cl0 >> 14)] = 0.5f * h0 * (1.f + erff(h0 * 0.70710678118654752f)) * gv0 * vv0;
      if (lane + 64 < cn) aw[(size_t)tok * 128 + (cl1 >> 14)] = 0.5f * h1 * (1.f + erff(h1 * 0.70710678118654752f)) * gv1 * vv1;
      cx = x1; ce0 = xe0; ce1 = xe1; cxs = xs1; cn = nn; cl0 = nl0; cl1 = nl1;
    }
#undef PU_LIST
#undef PU_ISSUE
#undef PU_REDUCE
  }
}

template <bool SL>
__device__ __forceinline__ void phase_pv_t(const Params& p, unsigned char* smem) {
  unsigned char* ws = p.ws;
  const unsigned char* V8 = ws + WS_V;
  const int* eidx = (const int*)(ws + WS_EIDX);
  const float* aw = (const float*)(ws + WS_PA);
  float* ssq = (float*)(ws + WS_SSQ);
  const int lane = threadIdx.x & 63, w = threadIdx.x >> 6;
  const int q = lane >> 3, c = lane & 7;
  const int G = gridDim.x;
  constexpr bool sliced = SL;
  const int ti = sliced ? team_index(p, smem) : 0;
  const int tsz = G >> 3;
  const int grp0 = sliced ? (ti / tsz) : 0;
  constexpr int ngrp = sliced ? 1 : 8;
  const int slot = sliced ? (ti % tsz) * 8 + w : blockIdx.x * 8 + w;
  const int nslot = sliced ? tsz * 8 : G * 8;
  int ee[16]; float aa[16];
  if (slot < TOK) {
    unsigned bi = (unsigned)slot * 128u + 16u * (unsigned)q;
    asm volatile("" : "+v"(bi));
#pragma unroll
    for (int u4 = 0; u4 < 4; ++u4) {
      const int4 e4 = *(const int4*)(eidx + bi + 4 * u4); const float4 a4 = *(const float4*)(aw + bi + 4 * u4);
      ee[4 * u4] = e4.x; ee[4 * u4 + 1] = e4.y; ee[4 * u4 + 2] = e4.z; ee[4 * u4 + 3] = e4.w;
      aa[4 * u4] = a4.x; aa[4 * u4 + 1] = a4.y; aa[4 * u4 + 2] = a4.z; aa[4 * u4 + 3] = a4.w;
    }
  }
  for (int tok = slot; tok < TOK; tok += nslot) {
    int ce[16]; float ca[16];
    float suma = 0.f;
#pragma unroll
    for (int u = 0; u < 16; ++u) { ce[u] = ee[u]; ca[u] = aa[u]; suma += aa[u]; }
    for (int gi = 0; gi < ngrp; ++gi) {
      const int grp = grp0 + gi;
      uint4 vv[16];
#pragma unroll
      for (int u = 0; u < 16; ++u) vv[u] = *(const uint4*)(V8 + (size_t)grp * (16384 * 128) + (size_t)ce[u] * 128 + c * 16);
      float* orow = p.out + (size_t)tok * 1024 + grp * 128 + c * 16;
      float4 x1v[4];
#pragma unroll
      for (int i = 0; i < 4; ++i) x1v[i] = *(const float4*)(orow + 4 * i);
      if (gi == ngrp - 1) {
        const int nt = (tok + nslot < TOK) ? tok + nslot : tok;
        unsigned bi = (unsigned)nt * 128u + 16u * (unsigned)q;
        asm volatile("" : "+v"(bi));
#pragma unroll
        for (int u4 = 0; u4 < 4; ++u4) {
          const int4 e4 = *(const int4*)(eidx + bi + 4 * u4); const float4 a4 = *(const float4*)(aw + bi + 4 * u4);
          ee[4 * u4] = e4.x; ee[4 * u4 + 1] = e4.y; ee[4 * u4 + 2] = e4.z; ee[4 * u4 + 3] = e4.w;
          aa[4 * u4] = a4.x; aa[4 * u4 + 1] = a4.y; aa[4 * u4 + 2] = a4.z; aa[4 * u4 + 3] = a4.w;
        }
      }
      __builtin_amdgcn_sched_barrier(0);
      float acc[16];
#pragma unroll
      for (int i = 0; i < 16; ++i) acc[i] = -128.f * suma;
#pragma unroll
      for (int u = 0; u < 16; ++u) {
        float vf[16];
        cvt16u8(vv[u], vf);
#pragma unroll
        for (int i = 0; i < 16; ++i) acc[i] += ca[u] * vf[i];
        __builtin_amdgcn_sched_barrier(0);
      }
#pragma unroll
      for (int i = 0; i < 16; ++i) { acc[i] = add_xor8(acc[i]); acc[i] = add_xor16(acc[i]); acc[i] = add_xor32(acc[i]); }
      float ss = 0.f;
      if (q == 0) {
#pragma unroll
        for (int i = 0; i < 4; ++i) {
          const float4 oa = make_float4(x1v[i].x + acc[4 * i], x1v[i].y + acc[4 * i + 1], x1v[i].z + acc[4 * i + 2], x1v[i].w + acc[4 * i + 3]);
          *(float4*)(orow + 4 * i) = oa;
          ss += oa.x * oa.x + oa.y * oa.y + oa.z * oa.z + oa.w * oa.w;
        }
      }
      ss += __shfl_xor(ss, 1); ss += __shfl_xor(ss, 2); ss += __shfl_xor(ss, 4);
      if (lane == 0) atomicAdd(&ssq[tok], ss);
    }
  }
}

__device__ __forceinline__ void phase_pv_mfma(const Params& p, unsigned char* smem) {
  unsigned char* ws = p.ws;
  const unsigned char* V8 = ws + WS_V;
  const int* eidx = (const int*)(ws + WS_EIDX);
  const float* aw = (const float*)(ws + WS_PA);
  float* ssq = (float*)(ws + WS_SSQ);
  const int lane = threadIdx.x & 63, w = threadIdx.x >> 6;
  const int q8 = lane >> 3, c = lane & 7;
  const int l15 = lane & 15, g = lane >> 4;
  const int G = gridDim.x;
  const bool sliced = (G % 8 == 0);
  const int ti = sliced ? team_index(p, smem) : 0;
  const int tsz = sliced ? (G >> 3) : G;
  const int grp_lo = sliced ? ti / tsz : 0, grp_hi = sliced ? grp_lo + 1 : 8;
  const int slot = (sliced ? (ti % tsz) : (int)blockIdx.x) * 8 + w;
  const int nslot = tsz * 8;
  if (slot >= TOK) return;
  unsigned char* vs_l = smem + 16384 + w * 16384;
  typedef unsigned u32x4_t __attribute__((ext_vector_type(4)));
  typedef float f32x4_t __attribute__((ext_vector_type(4)));
  typedef int i32x4_t __attribute__((ext_vector_type(4)));
  typedef int i32x2_t __attribute__((ext_vector_type(2)));
  const unsigned tr_f16 = (unsigned)((((l15 >> 2) & 3) | ((g & 1) << 2)) << 4);
  const unsigned tr_lane = (unsigned)((l15 >> 1) * 128 + (l15 & 1) * 8);
  unsigned tr_off[8];
#pragma unroll
  for (int nt = 0; nt < 8; ++nt) tr_off[nt] = tr_lane + (((unsigned)nt << 4) ^ tr_f16);
  unsigned st_off[4];
#pragma unroll
  for (int cu = 0; cu < 4; ++cu) st_off[cu] = (unsigned)(16 * q8 * 128 + (((c ^ ((q8 & 1) << 2)) ^ cu) << 4));
  unsigned char* cf_l = smem + 4096 + w * 128;
  const unsigned coff = (unsigned)c * 16u;
  for (int grp_v = grp_lo; grp_v < grp_hi; ++grp_v) {
    const int grp = __builtin_amdgcn_readfirstlane(grp_v);
    const unsigned char* Vg = V8 + (size_t)grp * (16384 * 128);
    i32x4_t ee[4]; float2 a2;
#define PVM_META(TOKEN) do { \
      const i32x4_t* ep_ = (const i32x4_t*)(eidx + (size_t)(TOKEN) * 128 + 16 * q8); \
      _Pragma("unroll") for (int u4 = 0; u4 < 4; ++u4) ee[u4] = ep_[u4]; \
      a2 = *(const float2*)(aw + (size_t)(TOKEN) * 128 + 2 * lane); } while (0)
    PVM_META(slot);
    for (int tok = slot; tok < TOK; tok += nslot) {
      u32x4_t vv[16];
#pragma unroll
      for (int u = 0; u < 16; ++u) vv[u] = *(const u32x4_t*)(Vg + ((((unsigned)ee[u >> 2][u & 3]) << 7) | coff));
      bf16_t* orow = (bf16_t*)(ws + WS_X1) + (size_t)tok * 1024 + grp * 128 + 8 * l15;
      const u32x4_t x1r = *(const u32x4_t*)orow;
      float am = fmaxf(fabsf(a2.x), fabsf(a2.y));
#define PVM_DPPMAX(CTRL) am = fmaxf(am, __int_as_float(__builtin_amdgcn_update_dpp(0, __float_as_int(am), CTRL, 0xf, 0xf, true)))
      PVM_DPPMAX(0xB1); PVM_DPPMAX(0x4E); PVM_DPPMAX(0x141); PVM_DPPMAX(0x140);
#undef PVM_DPPMAX
      am = max_xor16(am); am = max_xor32(am);
      const float inva = am > 0.f ? 127.f * __builtin_amdgcn_rcpf(am) : 0.f, sa = am * (1.f / 127.f);
      {
        const unsigned b0 = (unsigned)(int)rintf(a2.x * inva) & 255u, b1 = (unsigned)(int)rintf(a2.y * inva) & 255u;
        *(unsigned short*)(cf_l + 2 * lane) = (unsigned short)(b0 | (b1 << 8));
      }
      { const int nt_ = (tok + nslot < TOK) ? tok + nslot : tok; PVM_META(nt_); }
      __builtin_amdgcn_sched_barrier(0);
#pragma unroll
      for (int u = 0; u < 16; ++u) *(u32x4_t*)(vs_l + st_off[(u >> 1) & 3] + u * 128) = vv[u];
      lds_fence();
      i32x4_t aop[2];
      aop[0] = *(const i32x4_t*)(cf_l + 16 * g); aop[1] = *(const i32x4_t*)(cf_l + 64 + 16 * g);
      i32x4_t acc[8];
#pragma unroll
      for (int nt = 0; nt < 8; ++nt) acc[nt] = (i32x4_t){0, 0, 0, 0};
#pragma unroll
      for (int s2 = 0; s2 < 2; ++s2)
#pragma unroll
        for (int nt = 0; nt < 8; ++nt) {
          const unsigned a0 = (unsigned)((s2 * 64 + 16 * g) * 128) + tr_off[nt];
          const i32x2_t lo = __builtin_amdgcn_ds_read_tr8_b64_v2i32((__attribute__((address_space(3))) i32x2_t*)(vs_l + a0));
          const i32x2_t hi = __builtin_amdgcn_ds_read_tr8_b64_v2i32((__attribute__((address_space(3))) i32x2_t*)(vs_l + a0 + 8 * 128));
          const i32x4_t bop = {lo[0], lo[1], hi[0], hi[1]};
          acc[nt] = __builtin_amdgcn_mfma_i32_16x16x64_i8(aop[s2], bop, acc[nt], 0, 0, 0);
        }
      lds_fence();
      float ss = 0.f;
      if (g == 0) {
        float o[8];
#pragma unroll
        for (int nt = 0; nt < 8; ++nt) {
          const float xv = (nt & 1) ? __uint_as_float(x1r[nt >> 1] & 0xffff0000u) : __uint_as_float(x1r[nt >> 1] << 16);
          o[nt] = xv + (float)acc[nt][0] * sa; ss += o[nt] * o[nt];
        }
        const u32x4_t ow = {pack2(o[0], o[1]), pack2(o[2], o[3]), pack2(o[4], o[5]), pack2(o[6], o[7])};
        *(u32x4_t*)orow = ow;
      }
      ss += __int_as_float(__builtin_amdgcn_update_dpp(0, __float_as_int(ss), 0xB1, 0xf, 0xf, true));
      ss += __int_as_float(__builtin_amdgcn_update_dpp(0, __float_as_int(ss), 0x4E, 0xf, 0xf, true));
      ss += __int_as_float(__builtin_amdgcn_update_dpp(0, __float_as_int(ss), 0x141, 0xf, 0xf, true));
      ss += __int_as_float(__builtin_amdgcn_update_dpp(0, __float_as_int(ss), 0x140, 0xf, 0xf, true));
      if (lane == 0) atomicAdd(&ssq[tok], ss);
    }
#undef PVM_META
  }
}

__device__ __forceinline__ void phase_final(const Params& p) {
  typedef unsigned u32x2_t __attribute__((ext_vector_type(2)));
  const float* ssq = (const float*)(p.ws + WS_SSQ);
  const int lane = threadIdx.x & 63, w = threadIdx.x >> 6;
  constexpr int NB = 4;
  const int stride = gridDim.x * 8;
  for (int row0 = blockIdx.x * 8 + w; row0 < TOK; row0 += NB * stride) {
    u32x2_t xr[NB][4]; float sq[NB];
#pragma unroll
    for (int b = 0; b < NB; ++b) {
      const int rr = row0 + b * stride, rc = rr < TOK ? rr : row0;
      const u32x2_t* x2 = (const u32x2_t*)((const bf16_t*)(p.ws + WS_X1) + (size_t)rc * DM);
      sq[b] = ssq[rc];
#pragma unroll
      for (int i = 0; i < 4; ++i) xr[b][i] = x2[lane + 64 * i];
    }
#pragma unroll
    for (int b = 0; b < NB; ++b) {
      const int row = row0 + b * stride;
      if (row < TOK) {
        const float rstd = rsqrtf(sq[b] * (1.f / DM) + EPSV);
        float4* o4 = (float4*)(p.out + (size_t)row * DM);
#pragma unroll
        for (int i = 0; i < 4; ++i) {
          const float4 gg = ((const float4*)p.norm_final)[lane + 64 * i];
          float4 v;
          v.x = __uint_as_float(xr[b][i][0] << 16) * rstd * gg.x; v.y = __uint_as_float(xr[b][i][0] & 0xffff0000u) * rstd * gg.y;
          v.z = __uint_as_float(xr[b][i][1] << 16) * rstd * gg.z; v.w = __uint_as_float(xr[b][i][1] & 0xffff0000u) * rstd * gg.w;
          o4[lane + 64 * i] = v;
        }
      }
    }
  }
}


__device__ __forceinline__ void phase_proj8(const Params& p, unsigned char* smem) {
  unsigned char* ws = p.ws;
  pg8::Gemm g{(const pg8::bf16_t*)(ws + WS_XN), (const pg8::bf16_t*)(ws + WS_WIN), TOK, 5120, 512};
  pg8::StaticOrder S; S.init(TOK, 5120, (int)gridDim.x, (int)blockIdx.x);
  EpiProj E{(unsigned short*)(ws + WS_PH), (unsigned short*)(ws + WS_PA), (unsigned short*)(ws + WS_PG),
            (unsigned short*)(ws + WS_KC), (unsigned short*)(ws + WS_VC), (unsigned short*)(ws + WS_IKC),
            (const float*)(ws + WS_XNS), (const float*)(ws + WS_WINS)};
  pg8::gemm_phase<EpiProj, pg8::StaticOrder, false, true>((PG8_LAS unsigned char*)smem, g, S, E, nullptr);
}
__device__ __forceinline__ void phase_ikln(const Params& p) {
  bf16_t* ikc = (bf16_t*)(p.ws + WS_IKC);
  const int tid = threadIdx.x, sub = tid & 7;
  float gam[8], bet[8];
#pragma unroll
  for (int i = 0; i < 8; ++i) { gam[i] = p.ikg[sub * 8 + i]; bet[i] = p.ikb[sub * 8 + i]; }
  for (int row = blockIdx.x * 64 + (tid >> 3); row < TOK; row += gridDim.x * 64) {
    uint4* ptr = (uint4*)(ikc + (size_t)row * 64 + sub * 8);
    const uint4 raw = *ptr;
    float v[8];
    cvt8(raw, v);
    float s = 0.f;
#pragma unroll
    for (int i = 0; i < 8; ++i) s += v[i];
    s += __shfl_xor(s, 1); s += __shfl_xor(s, 2); s += __shfl_xor(s, 4);
    const float mu = s * (1.f / 64.f);
    float q = 0.f;
#pragma unroll
    for (int i = 0; i < 8; ++i) { const float d = v[i] - mu; q += d * d; }
    q += __shfl_xor(q, 1); q += __shfl_xor(q, 2); q += __shfl_xor(q, 4);
    const float rstd = rsqrtf(q * (1.f / 64.f) + EPSV);
    uint4 o;
    o.x = pack2((v[0] - mu) * rstd * gam[0] + bet[0], (v[1] - mu) * rstd * gam[1] + bet[1]);
    o.y = pack2((v[2] - mu) * rstd * gam[2] + bet[2], (v[3] - mu) * rstd * gam[3] + bet[3]);
    o.z = pack2((v[4] - mu) * rstd * gam[4] + bet[4], (v[5] - mu) * rstd * gam[5] + bet[5]);
    o.w = pack2((v[6] - mu) * rstd * gam[6] + bet[6], (v[7] - mu) * rstd * gam[7] + bet[7]);
    *ptr = o;
  }
}
__device__ __forceinline__ void phase_up8(const Params& p, unsigned char* smem) {
  unsigned char* ws = p.ws;
  pg8::Gemm g{(const pg8::bf16_t*)(ws + WS_XN), (const pg8::bf16_t*)(ws + WS_WUPA), TOK, 1024, 1024};
  pg8::StaticOrder S; S.init(TOK, 1024, (int)gridDim.x, (int)blockIdx.x);
  EpiGate2 E{(unsigned short*)(ws + WS_PH), (const unsigned char*)(ws + WS_PG)};
  pg8::gemm_phase<EpiGate2, pg8::StaticOrder>((PG8_LAS unsigned char*)smem, g, S, E, nullptr);
}
__device__ __forceinline__ void phase_out8(const Params& p, unsigned char* smem) {
  unsigned char* ws = p.ws;
  pg8::Gemm g{(const pg8::bf16_t*)(ws + WS_PH), (const pg8::bf16_t*)(ws + WS_WOUT), TOK, 1024, 1024};
  pg8::StaticOrder S; S.init(TOK, 1024, (int)gridDim.x, (int)blockIdx.x);
  EpiResid E{(unsigned short*)(ws + WS_X1), p.x};
  pg8::gemm_phase<EpiResid, pg8::StaticOrder>((PG8_LAS unsigned char*)smem, g, S, E, nullptr);
}
__device__ __forceinline__ void phase_pq8(const Params& p, unsigned char* smem) {
  unsigned char* ws = p.ws;
  pg8::Gemm g{(const pg8::bf16_t*)(ws + WS_XQ), (const pg8::bf16_t*)(ws + WS_WQ), TOK, 2048, 512};
  pg8::StaticOrder S; S.init(TOK, 2048, (int)gridDim.x, (int)blockIdx.x);
  EpiStoreBf16Q E{(unsigned short*)(ws + WS_PG), 2048, (const float*)(ws + WS_XS), (const float*)(ws + WS_WQS)};
  pg8::gemm_phase<EpiStoreBf16Q, pg8::StaticOrder, false, true>((PG8_LAS unsigned char*)smem, g, S, E, nullptr);
}

__global__ void __launch_bounds__(NTHREADS) hybrid_fwd(Params p) {
  extern __shared__ __attribute__((aligned(16))) unsigned char smem[];
#if ONE_LAUNCH
  cg::grid_group grid = cg::this_grid();
  volatile LAS unsigned* xst = (volatile LAS unsigned*)(smem + LDS_BYTES - 16);
  if (threadIdx.x == 0) { xst[0] = 0u; xst[1] = 0u; }
  __syncthreads();
  XcdBarrier xbar = xcd_barrier_post((unsigned*)(p.ws + WS_BAR), xst);
#define SEAM(k) do { if (p.ph_lo <= (k) && (k) + 1 < p.ph_hi) { if (p.ph_hi > NPHASE) grid.sync(); else xcd_barrier(xbar); } } while (0)
#else
#define SEAM(k) do { } while (0)
#endif
#define IN(k) (p.ph_lo <= (k) && (k) < p.ph_hi)
#ifndef REPEAT_PH
#define REPEAT_PH -1
#endif
#define REP(k, stmt) do { if (REPEAT_PH == (k)) { stmt; grid.sync(); } } while (0)
#ifndef PROBE_PH
#define PROBE_PH -1
#endif
#define PSTAMP(k) do { if (PROBE_PH >= 0 && threadIdx.x == 0) ((volatile unsigned*)(smem + 155300))[k] = (unsigned)wall_clock64(); } while (0)
  PSTAMP(0);
  if (IN(0)) { phase_prep(p, smem); SEAM(0); PSTAMP(1); }
  if (IN(1)) { phase_proj8(p, smem); SEAM(1); PSTAMP(2); }
  if (IN(2)) { phase_ikln(p); hgrn_h1_all(p, smem); SEAM(2); PSTAMP(3); }
  if (IN(3)) { phase_mix(p, smem); SEAM(3); PSTAMP(4); }
  if (IN(4)) { phase_up8(p, smem); SEAM(4); PSTAMP(5); }
  if (IN(5)) { phase_out8(p, smem); SEAM(5); PSTAMP(6); }
  if (IN(6)) { rmsnorm_rows_q<false, true>((const float*)(p.ws + WS_X1), p.norm_ffn, nullptr, p.ws + WS_XQ, (float*)(p.ws + WS_XS)); SEAM(6); PSTAMP(7); }
  if (IN(7)) { phase_pq8(p, smem); SEAM(7); PSTAMP(8); }
  if (IN(8)) { phase_pkeys(p, smem); SEAM(8); PSTAMP(9); }
  if (IN(9)) { phase_pu(p, smem); SEAM(9); PSTAMP(10); }
  if (IN(10)) { phase_pv_mfma(p, smem); SEAM(10); PSTAMP(11); }
  if (IN(11)) { phase_final(p); }
  if (PROBE_PH >= 0) { __syncthreads(); PSTAMP(12); __syncthreads();
    const unsigned dl = ((volatile unsigned*)(smem + 155300))[PROBE_PH + 1] - ((volatile unsigned*)(smem + 155300))[PROBE_PH];
    const long long s0 = (long long)wall_clock64(); while ((long long)wall_clock64() - s0 < (long long)dl) __builtin_amdgcn_s_sleep(8); }
#undef IN
#undef SEAM
}

extern "C" void kernel_launch(void* const* d_in, const int* in_sizes, int n_in, void* d_out, int out_size, void* d_ws, size_t ws_size,
                              hipStream_t stream) {
  static int grid = 0;
  if (grid == 0) {
    if (n_in != 17 || ws_size < WS_END) {
      fprintf(stderr, "kernel_launch: unexpected n_in %d or ws_size %zu (need %zu)\n", n_in, ws_size, (size_t)WS_END);
      grid = -1; return;
    }
    int dev = 0, cus = 0, per_cu = 0;
    hipGetDevice(&dev);
    hipDeviceGetAttribute(&cus, hipDeviceAttributeMultiprocessorCount, dev);
    hipFuncSetAttribute((const void*)hybrid_fwd, hipFuncAttributeMaxDynamicSharedMemorySize, LDS_BYTES);
    hipOccupancyMaxActiveBlocksPerMultiprocessor(&per_cu, (const void*)hybrid_fwd, NTHREADS, LDS_BYTES);
    if (per_cu < 1) { fprintf(stderr, "kernel_launch: occupancy query says %d blocks/CU\n", per_cu); per_cu = 1; }
    (void)hipGetLastError();
    grid = cus;
  }
  if (grid < 0) return;
  Params p{};
  p.x = (const float*)d_in[0]; p.norm_mix = (const float*)d_in[1]; p.w_in = (const float*)d_in[2]; p.hg_lb = (const float*)d_in[3];
  p.hg_norm = (const float*)d_in[4]; p.ikg = (const float*)d_in[5]; p.ikb = (const float*)d_in[6]; p.rel_bias = (const float*)d_in[7];
  p.w_up_a = (const float*)d_in[8]; p.w_up_b = (const float*)d_in[9]; p.w_out = (const float*)d_in[10]; p.norm_ffn = (const float*)d_in[11];
  p.peer_wq = (const float*)d_in[12]; p.peer_keys = (const float*)d_in[13]; p.peer_u = (const float*)d_in[14]; p.peer_v = (const float*)d_in[15];
  p.norm_final = (const float*)d_in[16];
  p.out = (float*)d_out; p.ws = (unsigned char*)d_ws;
#if ONE_LAUNCH
  hipMemsetAsync((unsigned char*)d_ws + WS_BAR, 0, 16384, stream);
  p.ph_lo = 0; p.ph_hi = NPHASE;
  void* args[] = {&p};
  hipError_t e = hipLaunchCooperativeKernel((const void*)hybrid_fwd, dim3(grid), dim3(NTHREADS), args, LDS_BYTES, stream);
  if (e != hipSuccess) fprintf(stderr, "cooperative launch failed: %s (grid %d)\n", hipGetErrorString(e), grid);
#else
  for (int ph = 0; ph < NPHASE; ++ph) {
    p.ph_lo = ph; p.ph_hi = ph + 1;
    hipLaunchKernelGGL(hybrid_fwd, dim3(grid), dim3(NTHREADS), LDS_BYTES, stream, p);
  }
#endif
}
```

```cpp
#include <hip/hip_runtime.h>
#include <hip/hip_cooperative_groups.h>
#include <stdint.h>
#include <stdio.h>
namespace cg = cooperative_groups;

#ifndef ONE_LAUNCH
#define ONE_LAUNCH 1
#endif

typedef unsigned short bf16_t;
typedef __attribute__((ext_vector_type(8))) short bf16x8;
typedef __attribute__((ext_vector_type(4))) float f32x4;

#define NTHREADS 512
#define TOK 32768
#define SEQL 4096
#define DM 1024
#define EPSV 1e-6f
#define NPHASE 12

#define WS_WIN   ((size_t)0)
#define WS_WUPA  (WS_WIN  + (size_t)5120 * 1024 * 2)
#define WS_WUPB  (WS_WUPA + (size_t)1024 * 512 * 2)
#define WS_WOUT  (WS_WUPB + (size_t)1024 * 512 * 2)
#define WS_WQ    (WS_WOUT + (size_t)1024 * 1024 * 2)
#define WS_KEYS  (WS_WQ   + (size_t)2048 * 1024 * 2)
#define WS_LB    (WS_KEYS + (size_t)2 * 8 * 128 * 128 * 2)
#define WS_U     (WS_LB   + (size_t)4096)
#define WS_V     (WS_U    + (size_t)16384 * 1024 * 2)
#define WS_XN    (WS_V    + (size_t)16384 * 1024 * 2)
#define WS_PH    (WS_XN   + (size_t)TOK * 1024 * 2)
#define WS_PA    (WS_PH   + (size_t)TOK * 2048 * 2)
#define WS_PG    (WS_PA   + (size_t)TOK * 1024 * 2)
#define WS_EIDX  (WS_PG   + (size_t)TOK * 2048 * 2)
#define WS_GW    (WS_EIDX + (size_t)TOK * 128 * 4)
#define WS_SSQ   (WS_GW   + (size_t)TOK * 128 * 4)
#define WS_XCC   (WS_SSQ  + (size_t)TOK * 4)
#define WS_BAR   (WS_XCC  + (size_t)4096)
#define WS_DEC   (WS_BAR  + (size_t)16384)
#define WS_QCTR  (WS_DEC  + (size_t)2048 * 384 * 4)
#define WS_IK8   (WS_QCTR + (size_t)1024)
#define WS_IKS   (WS_IK8  + (size_t)TOK * 64)
#define WS_K8    (WS_IKS  + (size_t)TOK * 4)
#define WS_K8S   (WS_K8   + (size_t)TOK * 64)
#define WS_V8A   (WS_K8S  + (size_t)TOK * 4)
#define WS_V8S   (WS_V8A  + (size_t)TOK * 64)
#define WS_SSQ8  (WS_V8S  + (size_t)TOK * 4)
#define WS_END   (WS_SSQ8 + (size_t)8 * TOK * 4)

#define WS_KC (WS_EIDX)
#define WS_VC (WS_KC + (size_t)TOK * 128)
#define WS_IKC (WS_VC + (size_t)TOK * 128)
#define LDS_BYTES 155648

struct Params {
  const float* x; const float* norm_mix; const float* w_in; const float* hg_lb; const float* hg_norm;
  const float* ikg; const float* ikb; const float* rel_bias; const float* w_up_a; const float* w_up_b;
  const float* w_out; const float* norm_ffn; const float* peer_wq; const float* peer_keys;
  const float* peer_u; const float* peer_v; const float* norm_final;
  float* out; unsigned char* ws; int ph_lo, ph_hi;
};

__device__ __forceinline__ float bf2f(bf16_t u) { return __uint_as_float(((unsigned)u) << 16); }
typedef float f32x2_cv __attribute__((ext_vector_type(2)));
typedef __bf16 bf16x2_cv __attribute__((ext_vector_type(2)));
__device__ __forceinline__ unsigned pack2(float a, float b) {
  const f32x2_cv v = {a, b};
  return __builtin_bit_cast(unsigned, __builtin_convertvector(v, bf16x2_cv));
}
__device__ __forceinline__ bf16_t f2bf(float f) { return (bf16_t)(pack2(f, f) & 0xffffu); }
__device__ __forceinline__ float wave_sum_slow(float v) {
#pragma unroll
  for (int o = 32; o > 0; o >>= 1) v += __shfl_xor(v, o);
  return v;
}
__device__ __forceinline__ void lds_fence() { asm volatile("s_waitcnt lgkmcnt(0)" ::: "memory"); }

__device__ __forceinline__ float add_xor8(float v) { return v + __int_as_float(__builtin_amdgcn_update_dpp(0, __float_as_int(v), 0x128, 0xf, 0xf, true)); }
__device__ __forceinline__ float add_xor16(float v) { const auto r = __builtin_amdgcn_permlane16_swap(__float_as_uint(v), __float_as_uint(v), false, false); return __uint_as_float(r[0]) + __uint_as_float(r[1]); }
__device__ __forceinline__ float add_xor32(float v) { const auto r = __builtin_amdgcn_permlane32_swap(__float_as_uint(v), __float_as_uint(v), false, false); return __uint_as_float(r[0]) + __uint_as_float(r[1]); }
__device__ __forceinline__ float max_xor16(float v) { const auto r = __builtin_amdgcn_permlane16_swap(__float_as_uint(v), __float_as_uint(v), false, false); return fmaxf(__uint_as_float(r[0]), __uint_as_float(r[1])); }
__device__ __forceinline__ float max_xor32(float v) { const auto r = __builtin_amdgcn_permlane32_swap(__float_as_uint(v), __float_as_uint(v), false, false); return fmaxf(__uint_as_float(r[0]), __uint_as_float(r[1])); }
__device__ __forceinline__ float wave_sum(float v) {
  v += __int_as_float(__builtin_amdgcn_update_dpp(0, __float_as_int(v), 0xB1, 0xf, 0xf, true));
  v += __int_as_float(__builtin_amdgcn_update_dpp(0, __float_as_int(v), 0x4E, 0xf, 0xf, true));
  v += __int_as_float(__builtin_amdgcn_update_dpp(0, __float_as_int(v), 0x141, 0xf, 0xf, true));
  v += __int_as_float(__builtin_amdgcn_update_dpp(0, __float_as_int(v), 0x140, 0xf, 0xf, true));
  return add_xor32(add_xor16(v));
}
__device__ __forceinline__ float sigmoidf_(float x) { return __builtin_amdgcn_rcpf(1.f + __expf(-x)); }
__device__ __forceinline__ float siluf_(float x) { return x * __builtin_amdgcn_rcpf(1.f + __expf(-x)); }


#define XB_TMO      128
#define XB_XCNT(j)  (256  + 64 * (j))
#define XB_XSUB(j)  (1280 + 64 * (j))
#define XB_XGEN(j)  (2304 + 64 * (j))
#define XB_TOP      3328
#define XB_TOPGEN   3392
#define XCD_BAR_WORDS 3456
#define XB_SPIN_CAP (1u << 22)
#define LAS __attribute__((address_space(3)))
__device__ __forceinline__ unsigned xb_ld(unsigned* p)              { return __hip_atomic_load(p, __ATOMIC_RELAXED, __HIP_MEMORY_SCOPE_AGENT); }
__device__ __forceinline__ unsigned xb_add(unsigned* p, unsigned v) { return __hip_atomic_fetch_add(p, v, __ATOMIC_RELAXED, __HIP_MEMORY_SCOPE_AGENT); }
__device__ __forceinline__ unsigned xb_xcc_id() { return (unsigned)__builtin_amdgcn_s_getreg((3 << 11) | 20) & 0xFu; }
#define XB_SPIN(cond, bar) do { unsigned _sp = 0; while (cond) { __builtin_amdgcn_s_sleep(1); \
    if ((++_sp & 255u) == 0u) { if (xb_ld(&(bar)[XB_TMO])) break; if (_sp > XB_SPIN_CAP) { atomicAdd(&(bar)[XB_TMO], 1u); break; } } } } while (0)
struct XcdBarrier { unsigned* bar; unsigned x; volatile LAS unsigned* st; };
__device__ __forceinline__ XcdBarrier xcd_barrier_post(unsigned* bar, volatile LAS unsigned* st) {
  XcdBarrier b; b.bar = bar; b.x = xb_xcc_id(); b.st = st;
  if (threadIdx.x == 0) (void)xb_add(&bar[XB_XCNT(b.x)], 1u);
  return b;
}
__device__ __forceinline__ void xcd_barrier_complete(unsigned* bar, unsigned x, unsigned& nloc, unsigned& nx) {
  const unsigned G = gridDim.x * gridDim.y * gridDim.z;
  unsigned sum, cnt, mine, sp = 0u;
  for (;;) {
    sum = 0u; cnt = 0u; mine = 0u;
#pragma unroll
    for (unsigned j = 0; j < 16; ++j) { const unsigned c = xb_ld(&bar[XB_XCNT(j)]); sum += c; cnt += (c > 0u) ? 1u : 0u; mine = (j == x) ? c : mine; }
    if (sum == G) break;
    __builtin_amdgcn_s_sleep(1);
    if ((++sp & 255u) == 0u) { if (xb_ld(&bar[XB_TMO])) break; if (sp > XB_SPIN_CAP) { atomicAdd(&bar[XB_TMO], 1u); break; } }
  }
  nloc = mine > 0u ? mine : 1u; nx = cnt > 0u ? cnt : 1u;
}
__device__ __forceinline__ void xcd_barrier(const XcdBarrier& b) {
  asm volatile("s_waitcnt vmcnt(0)" ::: "memory");
  __syncthreads();
  if (threadIdx.x == 0) {
    unsigned* bar = b.bar;
    __builtin_amdgcn_s_waitcnt(0);
    unsigned nloc = b.st[0], nx = b.st[1];
    if (nloc == 0u) { xcd_barrier_complete(bar, b.x, nloc, nx); b.st[0] = nloc; b.st[1] = nx; }
    const unsigned old = xb_add(&bar[XB_XSUB(b.x)], 1u);
    const unsigned gen = old / nloc;
    if (old + 1u == (gen + 1u) * nloc) {
      __builtin_amdgcn_fence(__ATOMIC_RELEASE, "agent");
      asm volatile("s_waitcnt vmcnt(0)" ::: "memory");
      const unsigned og = xb_add(&bar[XB_TOP], 1u);
      const unsigned tg = og / nx;
      if (og + 1u == (tg + 1u) * nx) xb_add(&bar[XB_TOPGEN], 1u);
      else XB_SPIN(xb_ld(&bar[XB_TOPGEN]) == tg, bar);
      __builtin_amdgcn_fence(__ATOMIC_ACQUIRE, "agent");
      xb_add(&bar[XB_XGEN(b.x)], 1u);
      asm volatile("s_waitcnt vmcnt(0)" ::: "memory");
    } else {
      XB_SPIN(xb_ld(&bar[XB_XGEN(b.x)]) == gen, bar);
      __builtin_amdgcn_fence(__ATOMIC_ACQUIRE, "agent");
      asm volatile("s_waitcnt vmcnt(0)" ::: "memory");
    }
  }
  __syncthreads();
}

namespace pg8 {
#define PG8_LAS __attribute__((address_space(3)))
typedef unsigned short bf16_t;
typedef short bf16x8 __attribute__((ext_vector_type(8)));
typedef float f32x4 __attribute__((ext_vector_type(4)));
typedef unsigned u32x4 __attribute__((ext_vector_type(4)));
constexpr int BM = 256, BK = 64, HALF = 128, HTB = HALF * BK * 2  , STAGE_BYTES = 8 * HTB, NXCD = 8, WGM = 8;

__host__ __device__ __forceinline__ int lds_byte(int r, int c) { const int st = (r >> 4) * 2 + (c >> 5), rr = r & 15, cc = c & 31, ob = rr * 64 + cc * 2; return st * 1024 + (ob ^ (((ob >> 9) & 1) << 5)); }
__host__ __device__ __forceinline__ void stage_rc(int b, int& R, int& C) { const int st = b / 1024, sb = b % 1024, swz = sb ^ (((sb >> 9) & 1) << 5); R = (st >> 1) * 16 + swz / 64; C = (st & 1) * 32 + (swz % 64) / 2; }
__host__ __device__ __forceinline__ int perm32(int rho) { const int n = rho >> 4, i = rho & 15; return 8 * (i >> 2) + 4 * n + (i & 3); }

struct Unit { int pm, pn; };
struct Gemm { const bf16_t* A; const bf16_t* Bt; int M, N, K; };

struct StaticOrder {
    int nM, nN, nwg, G, c;
    __host__ __device__ void init(int M, int N, int G_, int c_) { nM = M / BM; nN = N / BM; nwg = nM * nN; G = G_; c = c_; }
    __host__ __device__ bool next(int i, Unit& u) const {
        const long L = (long)i * G + c; if (L >= nwg) return false;
        int wgid = (int)L; { const int q = nwg / NXCD, r = nwg % NXCD, xcd = wgid % NXCD, off = wgid / NXCD; wgid = (xcd < r ? xcd * (q + 1) : r * (q + 1) + (xcd - r) * q) + off; }
        const int nig = WGM * nN, gid = wgid / nig, fm = gid * WGM, gsz = (nM - fm) < WGM ? (nM - fm) : WGM;
        u.pm = fm + ((wgid % nig) % gsz); u.pn = (wgid % nig) / gsz; return true;
    }
    __device__ __forceinline__ void a_ready(const Unit&) const {}
    __device__ __forceinline__ void done(const Unit&) const {}
};
__device__ __forceinline__ unsigned cvt_pk_bf16(float lo, float hi) { unsigned r; asm volatile("v_cvt_pk_bf16_f32 %0, %1, %2" : "=v"(r) : "v"(lo), "v"(hi)); return r; }
typedef int i32x4 __attribute__((ext_vector_type(4)));
template <class Epi, class Sched, bool STAMP = false, bool I8 = false>
__device__ __forceinline__ void gemm_phase(PG8_LAS unsigned char* lds, const Gemm g, const Sched& S, const Epi& E, unsigned long long* stamps) {
    const int tid = threadIdx.x, wid = __builtin_amdgcn_readfirstlane(tid >> 6), lane = tid & 63, wr = wid >> 2, wc = wid & 3, fr = lane & 15, fq = lane >> 4;
    const int K = g.K, nt = K / BK;
    int ts_lo = 0, ts_hi = 0, nts = 0; const unsigned long long rt_entry = STAMP ? (unsigned long long)wall_clock64() : 0ull;
#define PG8_STAMP() do { if (STAMP && wid == 0 && nts < 64) { const unsigned long long _c = (unsigned long long)clock64(); \
        ts_lo = (lane == nts) ? (int)(unsigned)_c : ts_lo; ts_hi = (lane == nts) ? (int)(unsigned)(_c >> 32) : ts_hi; ++nts; } } while (0)
    PG8_STAMP();
    unsigned voffA[2], voffB[2];
#pragma unroll
    for (int i = 0; i < 2; ++i) { int R, C; stage_rc(tid * 16 + i * 8192, R, C); const int Rb = Epi::PERM ? ((R & ~31) + perm32(R & 31)) : R;
        voffA[i] = (unsigned)(R * K + C) * 2u; voffB[i] = (unsigned)(Rb * K + C) * 2u; }
    const size_t kstep = (size_t)(BK * 2);
    const size_t hstep = (size_t)HALF * K * 2;
    const size_t tstep = 2 * hstep;
    const unsigned ldsw = (unsigned)wid * 1024u;
    const int aoff = lds_byte(wr * 64 + fr, fq * 8), boff = lds_byte(wc * 32 + fr, fq * 8);
#define PG8_SA(b, h) (((b) * 2 + (h)) * HTB)
#define PG8_SB(b, h) ((4 + (b) * 2 + (h)) * HTB)
#define PG8_STAGE(bufoff, gbase, voff) do { _Pragma("unroll") for (int _i = 0; _i < 2; ++_i) \
        __builtin_amdgcn_global_load_lds((const unsigned*)((const char*)(gbase) + (voff)[_i]), (PG8_LAS unsigned*)(lds + (bufoff) + ldsw + _i * 8192), 16, 0, 0); } while (0)
#define PG8_LDA(dst, b, h) do { _Pragma("unroll") for (int m = 0; m < 4; ++m) _Pragma("unroll") for (int k = 0; k < 2; ++k) dst[m][k] = *(const PG8_LAS bf16x8*)(lds + PG8_SA(b, h) + aoff + m * 2048 + k * 1024); } while (0)
#define PG8_LDB(dst, b, h) do { _Pragma("unroll") for (int n = 0; n < 2; ++n) _Pragma("unroll") for (int k = 0; k < 2; ++k) dst[n][k] = *(const PG8_LAS bf16x8*)(lds + PG8_SB(b, h) + boff + n * 2048 + k * 1024); } while (0)
#define PG8_MMA(ai, bj, At, Bt) do { __builtin_amdgcn_s_setprio(1); _Pragma("unroll") for (int m = 0; m < 4; ++m) _Pragma("unroll") for (int n = 0; n < 2; ++n) _Pragma("unroll") for (int k = 0; k < 2; ++k) \
        { if constexpr (I8) acc[ai][bj][m][n] = __builtin_bit_cast(f32x4, __builtin_amdgcn_mfma_i32_16x16x64_i8(__builtin_bit_cast(i32x4, Bt[n][k]), __builtin_bit_cast(i32x4, At[m][k]), __builtin_bit_cast(i32x4, acc[ai][bj][m][n]), 0, 0, 0)); \
          else acc[ai][bj][m][n] = __builtin_amdgcn_mfma_f32_16x16x32_bf16(Bt[n][k], At[m][k], acc[ai][bj][m][n], 0, 0, 0); } __builtin_amdgcn_s_setprio(0); } while (0)
#define PG8_WAIT_V(n) asm volatile("s_waitcnt vmcnt(" #n ")" ::: "memory")
#define PG8_WAIT_L(n) asm volatile("s_waitcnt lgkmcnt(" #n ")" ::: "memory")
#define PG8_BAR __builtin_amdgcn_s_barrier()
#define PG8_SCHED __builtin_amdgcn_sched_barrier(0)
    Unit cur, nxt; int ui = 0;
    if (!S.next(0, cur)) return;
    f32x4 acc[2][2][4][2];
#pragma unroll
    for (int a = 0; a < 2; ++a)
#pragma unroll
        for (int b = 0; b < 2; ++b)
#pragma unroll
            for (int m = 0; m < 4; ++m)
#pragma unroll
                for (int n = 0; n < 2; ++n) acc[a][b][m][n] = (f32x4){0.f, 0.f, 0.f, 0.f};
    bf16x8 At[4][2], B0[2][2], B1[2][2];
    const char* cA = (const char*)g.A + (size_t)cur.pm * tstep; const char* cB = (const char*)g.Bt + (size_t)cur.pn * tstep;
    S.a_ready(cur);
    PG8_STAGE(PG8_SB(0, 0), cB, voffB); PG8_STAGE(PG8_SA(0, 0), cA, voffA); PG8_STAGE(PG8_SB(0, 1), cB + hstep, voffB); PG8_STAGE(PG8_SA(0, 1), cA + hstep, voffA);
    if (wr == 1) PG8_BAR;
    PG8_WAIT_V(4); PG8_BAR;
    PG8_STAGE(PG8_SB(1, 0), cB + kstep, voffB); PG8_STAGE(PG8_SA(1, 0), cA + kstep, voffA); PG8_STAGE(PG8_SB(1, 1), cB + hstep + kstep, voffB);
    PG8_WAIT_V(6); PG8_BAR;
    PG8_STAMP();
    for (;;) {
        const bool has_next = S.next(ui + 1, nxt);
        const char* nA = has_next ? (const char*)g.A + (size_t)nxt.pm * tstep : cA; const char* nB = has_next ? (const char*)g.Bt + (size_t)nxt.pn * tstep : cB;
        for (int t = 0; t < nt; t += 2) {
            const bool last = (t == nt - 2);
            const char* a1 = cA + (size_t)(t + 1) * kstep;
            const char* a2 = last ? nA : cA + (size_t)(t + 2) * kstep; const char* b2 = last ? nB : cB + (size_t)(t + 2) * kstep;
            const char* a3 = a2 + kstep; const char* b3 = b2 + kstep;
            if constexpr (Epi::MID) { if (t == nt / 2) E.mid(acc, cur, wr, wc, fr, fq); }
            if (last && has_next) S.a_ready(nxt);
            PG8_LDB(B0, 0, 0); PG8_SCHED; PG8_LDA(At, 0, 0); PG8_STAGE(PG8_SA(1, 1), a1 + hstep, voffA);
            PG8_WAIT_L(8); PG8_BAR; PG8_WAIT_L(0); PG8_MMA(0, 0, At, B0); PG8_BAR; PG8_SCHED;
            PG8_LDB(B1, 0, 1); PG8_STAGE(PG8_SB(0, 0), b2, voffB);
            PG8_BAR; PG8_WAIT_L(0); PG8_MMA(0, 1, At, B1); PG8_BAR;
            PG8_LDA(At, 0, 1); PG8_STAGE(PG8_SA(0, 0), a2, voffA);
            PG8_BAR; PG8_WAIT_L(0); PG8_MMA(1, 0, At, B0); PG8_BAR; PG8_SCHED;
            PG8_STAGE(PG8_SB(0, 1), b2 + hstep, voffB);
            PG8_WAIT_V(6); PG8_BAR; PG8_MMA(1, 1, At, B1); PG8_BAR;
            PG8_LDB(B0, 1, 0); PG8_SCHED; PG8_LDA(At, 1, 0); PG8_STAGE(PG8_SA(0, 1), a2 + hstep, voffA);
            PG8_WAIT_L(8); PG8_BAR; PG8_WAIT_L(0); PG8_MMA(0, 0, At, B0); PG8_BAR; PG8_SCHED;
            PG8_LDB(B1, 1, 1); PG8_STAGE(PG8_SB(1, 0), b3, voffB);
            PG8_BAR; PG8_WAIT_L(0); PG8_MMA(0, 1, At, B1); PG8_BAR;
            PG8_LDA(At, 1, 1); PG8_STAGE(PG8_SA(1, 0), a3, voffA);
            PG8_BAR; PG8_WAIT_L(0); PG8_MMA(1, 0, At, B0); PG8_BAR; PG8_SCHED;
            PG8_STAGE(PG8_SB(1, 1), b3 + hstep, voffB);
            PG8_WAIT_V(6); PG8_BAR; PG8_MMA(1, 1, At, B1); PG8_BAR;
        }
        PG8_STAMP();
        if constexpr (!Epi::AFTER_DRAIN) { E(acc, cur, wr, wc, fr, fq); S.done(cur); }
        PG8_STAMP();
        if (!has_next) break;
#pragma unroll
        for (int a = 0; a < 2; ++a)
#pragma unroll
            for (int b = 0; b < 2; ++b)
#pragma unroll
                for (int m = 0; m < 4; ++m)
#pragma unroll
                    for (int n = 0; n < 2; ++n) acc[a][b][m][n] = (f32x4){0.f, 0.f, 0.f, 0.f};
        cur = nxt; cA = nA; cB = nB; ++ui;
    }
    PG8_WAIT_V(0);
    if (wr == 0) PG8_BAR;
    PG8_BAR;
    if constexpr (Epi::AFTER_DRAIN) { E.fused(acc, cur, wr, wc, fr, fq, lds, wid, lane); S.done(cur); }
    PG8_STAMP();
    if (STAMP && wid == 0) { stamps[lane] = lane < nts ? (((unsigned long long)(unsigned)ts_hi << 32) | (unsigned)ts_lo) : 0ull;
        if (lane == 62) stamps[62] = rt_entry; if (lane == 63) stamps[63] = (unsigned long long)wall_clock64(); }
#undef PG8_STAMP
#undef PG8_SA
#undef PG8_SB
#undef PG8_STAGE
#undef PG8_LDA
#undef PG8_LDB
#undef PG8_MMA
#undef PG8_WAIT_V
#undef PG8_WAIT_L
#undef PG8_BAR
#undef PG8_SCHED
}
}

struct EpiProj {
  static constexpr bool PERM = true, AFTER_DRAIN = false, MID = false;
  unsigned short* pH; unsigned short* pA; unsigned short* pG; unsigned short* kc; unsigned short* vc; unsigned short* ikc;
  const float* sa; const float* sw;
  __device__ __forceinline__ void operator()(const pg8::f32x4 (&acc)[2][2][4][2], const pg8::Unit& u, int wr, int wc, int fr, int fq) const {
    const int row0 = u.pm * 256 + wr * 64 + fr;
    pg8::f32x4 cs_[2][2];
#pragma unroll
    for (int bj = 0; bj < 2; ++bj)
#pragma unroll
      for (int n = 0; n < 2; ++n) cs_[bj][n] = *(const pg8::f32x4*)(sw + u.pn * 256 + bj * 128 + wc * 32 + 8 * fq + 4 * n);
    float ra_[2][4];
#pragma unroll
    for (int ai = 0; ai < 2; ++ai)
#pragma unroll
      for (int m = 0; m < 4; ++m) ra_[ai][m] = sa[row0 + ai * 128 + m * 16];
    unsigned short* base; int ldc, colt; bool sg = false;
    if (u.pn < 8) { base = pH; ldc = 2048; colt = u.pn * 256; }
    else if (u.pn < 12) { base = pA; ldc = 1024; colt = (u.pn - 8) * 256; }
    else { base = pG; ldc = 2048; colt = (u.pn - 12) * 256; sg = true; }
    const int col0 = colt + wc * 32 + 8 * fq;
#pragma unroll
    for (int ai = 0; ai < 2; ++ai)
#pragma unroll
      for (int m = 0; m < 4; ++m) {
        unsigned short* rowp = base + (size_t)(row0 + ai * 128 + m * 16) * ldc + col0;
        const float ra = ra_[ai][m];
#pragma unroll
        for (int bj = 0; bj < 2; ++bj) {
          pg8::f32x4 v0, v1;
#pragma unroll
          for (int j = 0; j < 4; ++j) { v0[j] = (float)__float_as_int(acc[ai][bj][m][0][j]) * (ra * cs_[bj][0][j]); v1[j] = (float)__float_as_int(acc[ai][bj][m][1][j]) * (ra * cs_[bj][1][j]); }
          if (sg) {
            unsigned wq_[2];
#pragma unroll
            for (int n = 0; n < 2; ++n) {
              unsigned pkq = 0u;
#pragma unroll
              for (int j = 0; j < 4; ++j) {
                const float sgv = sigmoidf_(n == 0 ? v0[j] : v1[j]);
                pkq = __builtin_amdgcn_cvt_pk_u8_f32(fmaxf(sgv * 255.f, 1.f), j, pkq);
              }
              wq_[n] = pkq;
            }
            *(uint2*)((unsigned char*)pG + (size_t)(row0 + ai * 128 + m * 16) * 2048 + col0 + bj * 128) = make_uint2(wq_[0], wq_[1]);
            continue;
          }
          pg8::u32x4 w; w.x = pg8::cvt_pk_bf16(v0[0], v0[1]); w.y = pg8::cvt_pk_bf16(v0[2], v0[3]); w.z = pg8::cvt_pk_bf16(v1[0], v1[1]); w.w = pg8::cvt_pk_bf16(v1[2], v1[3]);
          unsigned short* dst = rowp + bj * 128;
          if (u.pn == 10 || u.pn == 11) {
            const int cs = col0 + bj * 128;
            const size_t r = (size_t)(row0 + ai * 128 + m * 16);
            if (cs >= 512 && cs < 576) dst = kc + r * 64 + (cs - 512);
            else if (cs >= 576 && cs < 640) dst = vc + r * 64 + (cs - 576);
            else if (cs >= 896 && cs < 960) dst = ikc + r * 64 + (cs - 896);
          }
          *(pg8::u32x4*)dst = w;
        }
      }
  }
};
template <int MODE> struct EpiGate {
  static constexpr bool PERM = true, AFTER_DRAIN = false, MID = false;
  unsigned short* hb; const unsigned short* pG; int goff;
  __device__ __forceinline__ void operator()(const pg8::f32x4 (&acc)[2][2][4][2], const pg8::Unit& u, int wr, int wc, int fr, int fq) const {
    const int row0 = u.pm * 256 + wr * 64 + fr;
    const int col0 = u.pn * 256 + wc * 32 + 8 * fq;
#pragma unroll
    for (int ai = 0; ai < 2; ++ai)
#pragma unroll
      for (int m = 0; m < 4; ++m) {
        const size_t r = (size_t)(row0 + ai * 128 + m * 16);
        pg8::u32x4 gv[2], hv[2];
#pragma unroll
        for (int bj = 0; bj < 2; ++bj) {
          gv[bj] = *(const pg8::u32x4*)(pG + r * 2048 + goff + col0 + bj * 128);
          if (MODE == 1) hv[bj] = *(const pg8::u32x4*)(hb + r * 1024 + col0 + bj * 128);
        }
#pragma unroll
        for (int bj = 0; bj < 2; ++bj) {
          float o[8];
#pragma unroll
          for (int j = 0; j < 4; ++j) {
            const unsigned gw0 = gv[bj][j >> 1], gw1 = gv[bj][2 + (j >> 1)];
            const float g0 = (j & 1) ? __uint_as_float(gw0 & 0xffff0000u) : __uint_as_float(gw0 << 16);
            const float g1 = (j & 1) ? __uint_as_float(gw1 & 0xffff0000u) : __uint_as_float(gw1 << 16);
            o[j] = acc[ai][bj][m][0][j] * g0; o[4 + j] = acc[ai][bj][m][1][j] * g1;
            if (MODE == 1) {
              const unsigned hw0 = hv[bj][j >> 1], hw1 = hv[bj][2 + (j >> 1)];
              o[j] += (j & 1) ? __uint_as_float(hw0 & 0xffff0000u) : __uint_as_float(hw0 << 16);
              o[4 + j] += (j & 1) ? __uint_as_float(hw1 & 0xffff0000u) : __uint_as_float(hw1 << 16);
            }
          }
          pg8::u32x4 w; w.x = pg8::cvt_pk_bf16(o[0], o[1]); w.y = pg8::cvt_pk_bf16(o[2], o[3]); w.z = pg8::cvt_pk_bf16(o[4], o[5]); w.w = pg8::cvt_pk_bf16(o[6], o[7]);
          *(pg8::u32x4*)(hb + r * 1024 + col0 + bj * 128) = w;
        }
      }
  }
};
struct EpiGate2 {
  static constexpr bool PERM = true, AFTER_DRAIN = false, MID = true;
  unsigned short* hb; const unsigned char* pG;
  __device__ __forceinline__ void mid(pg8::f32x4 (&acc)[2][2][4][2], const pg8::Unit& u, int wr, int wc, int fr, int fq) const {
    int fr_o = fr, fq_o = fq;
    asm volatile("" : "+v"(fr_o), "+v"(fq_o));
    const unsigned char* gp = pG + (size_t)(u.pm * 256 + wr * 64 + fr_o) * 2048 + u.pn * 256 + wc * 32 + 8 * fq_o;
#pragma unroll
    for (int ai = 0; ai < 2; ++ai)
#pragma unroll
      for (int m = 0; m < 4; ++m)
#pragma unroll
        for (int bj = 0; bj < 2; ++bj) {
          const unsigned char* q = gp + (size_t)(ai * 128 + m * 16) * 2048 + bj * 128;
          const uint2 gb = *(const uint2*)(q + 1024);
          const uint2 ga = *(const uint2*)q;
#pragma unroll
          for (int n = 0; n < 2; ++n) {
            const unsigned wa = n ? ga.y : ga.x, wb = n ? gb.y : gb.x;
#pragma unroll
            for (int j = 0; j < 4; ++j)
              acc[ai][bj][m][n][j] *= (float)((wa >> (8 * j)) & 255u) * __builtin_amdgcn_rcpf((float)((wb >> (8 * j)) & 255u));
          }
          if (bj == 1) asm volatile("" ::: "memory");
        }
  }
  __device__ __forceinline__ void operator()(const pg8::f32x4 (&acc)[2][2][4][2], const pg8::Unit& u, int wr, int wc, int fr, int fq) const {
    const int row0 = u.pm * 256 + wr * 64 + fr;
    const int col0 = u.pn * 256 + wc * 32 + 8 * fq;
    typedef unsigned u32x2_g __attribute__((ext_vector_type(2)));
    u32x2_g gba[2][4][2];
#pragma unroll
    for (int ai = 0; ai < 2; ++ai)
#pragma unroll
      for (int m = 0; m < 4; ++m)
#pragma unroll
        for (int bj = 0; bj < 2; ++bj) gba[ai][m][bj] = *(const u32x2_g*)(pG + (size_t)(row0 + ai * 128 + m * 16) * 2048 + 1024 + col0 + bj * 128);
#pragma unroll
    for (int ai = 0; ai < 2; ++ai)
#pragma unroll
      for (int m = 0; m < 4; ++m) {
        const size_t r = (size_t)(row0 + ai * 128 + m * 16);
#pragma unroll
        for (int bj = 0; bj < 2; ++bj) {
          float o[8];
#pragma unroll
          for (int j = 0; j < 4; ++j) {
            o[j] = acc[ai][bj][m][0][j] * ((float)((gba[ai][m][bj][0] >> (8 * j)) & 255u) * (1.f / 255.f));
            o[4 + j] = acc[ai][bj][m][1][j] * ((float)((gba[ai][m][bj][1] >> (8 * j)) & 255u) * (1.f / 255.f));
          }
          pg8::u32x4 w; w.x = pg8::cvt_pk_bf16(o[0], o[1]); w.y = pg8::cvt_pk_bf16(o[2], o[3]); w.z = pg8::cvt_pk_bf16(o[4], o[5]); w.w = pg8::cvt_pk_bf16(o[6], o[7]);
          *(pg8::u32x4*)(hb + r * 1024 + col0 + bj * 128) = w;
        }
      }
  }
};
struct EpiResid {
  static constexpr bool PERM = true, AFTER_DRAIN = false, MID = false;
  unsigned short* o; const float* x;
  __device__ __forceinline__ void operator()(const pg8::f32x4 (&acc)[2][2][4][2], const pg8::Unit& u, int wr, int wc, int fr, int fq) const {
    const int row0 = u.pm * 256 + wr * 64 + fr, col0 = u.pn * 256 + wc * 32 + 8 * fq;
#pragma unroll
    for (int ai = 0; ai < 2; ++ai) {
      pg8::f32x4 xv[4][2][2];
#pragma unroll
      for (int m = 0; m < 4; ++m)
#pragma unroll
        for (int bj = 0; bj < 2; ++bj)
#pragma unroll
          for (int n = 0; n < 2; ++n) xv[m][bj][n] = *(const pg8::f32x4*)(x + (size_t)(row0 + ai * 128 + m * 16) * 1024 + col0 + bj * 128 + n * 4);
#pragma unroll
      for (int m = 0; m < 4; ++m) {
        const size_t off = (size_t)(row0 + ai * 128 + m * 16) * 1024 + col0;
#pragma unroll
        for (int bj = 0; bj < 2; ++bj) {
          const pg8::f32x4 v0 = acc[ai][bj][m][0] + xv[m][bj][0], v1 = acc[ai][bj][m][1] + xv[m][bj][1];
          pg8::u32x4 w; w.x = pg8::cvt_pk_bf16(v0[0], v0[1]); w.y = pg8::cvt_pk_bf16(v0[2], v0[3]); w.z = pg8::cvt_pk_bf16(v1[0], v1[1]); w.w = pg8::cvt_pk_bf16(v1[2], v1[3]);
          *(pg8::u32x4*)(o + off + bj * 128) = w;
        }
      }
    }
  }
};
struct EpiStoreBf16Q {
  static constexpr bool PERM = true, AFTER_DRAIN = false, MID = false;
  unsigned short* O; int ldc; const float* sa; const float* sw;
  __device__ __forceinline__ void operator()(const pg8::f32x4 (&acc)[2][2][4][2], const pg8::Unit& u, int wr, int wc, int fr, int fq) const {
    const int row0 = u.pm * 256 + wr * 64 + fr, col0 = u.pn * 256 + wc * 32 + 8 * fq;
    pg8::f32x4 cs_[2][2];
#pragma unroll
    for (int bj = 0; bj < 2; ++bj)
#pragma unroll
      for (int n = 0; n < 2; ++n) cs_[bj][n] = *(const pg8::f32x4*)(sw + col0 + bj * 128 + 4 * n);
    float ra_[2][4];
#pragma unroll
    for (int ai = 0; ai < 2; ++ai)
#pragma unroll
      for (int m = 0; m < 4; ++m) ra_[ai][m] = sa[row0 + ai * 128 + m * 16];
#pragma unroll
    for (int ai = 0; ai < 2; ++ai)
#pragma unroll
      for (int m = 0; m < 4; ++m) {
        unsigned short* rowp = O + (size_t)(row0 + ai * 128 + m * 16) * ldc + col0;
        const float ra = ra_[ai][m];
#pragma unroll
        for (int bj = 0; bj < 2; ++bj) {
          pg8::f32x4 v0, v1;
#pragma unroll
          for (int j = 0; j < 4; ++j) { v0[j] = (float)__float_as_int(acc[ai][bj][m][0][j]) * (ra * cs_[bj][0][j]); v1[j] = (float)__float_as_int(acc[ai][bj][m][1][j]) * (ra * cs_[bj][1][j]); }
          pg8::u32x4 w; w.x = pg8::cvt_pk_bf16(v0[0], v0[1]); w.y = pg8::cvt_pk_bf16(v0[2], v0[3]); w.z = pg8::cvt_pk_bf16(v1[0], v1[1]); w.w = pg8::cvt_pk_bf16(v1[2], v1[3]);
          *(pg8::u32x4*)(rowp + bj * 128) = w;
        }
      }
  }
};
struct EpiStoreBf16 {
  static constexpr bool PERM = true, AFTER_DRAIN = false, MID = false;
  unsigned short* O; int ldc;
  __device__ __forceinline__ void operator()(const pg8::f32x4 (&acc)[2][2][4][2], const pg8::Unit& u, int wr, int wc, int fr, int fq) const {
    const int row0 = u.pm * 256 + wr * 64 + fr, col0 = u.pn * 256 + wc * 32 + 8 * fq;
#pragma unroll
    for (int ai = 0; ai < 2; ++ai)
#pragma unroll
      for (int m = 0; m < 4; ++m) {
        unsigned short* rowp = O + (size_t)(row0 + ai * 128 + m * 16) * ldc + col0;
#pragma unroll
        for (int bj = 0; bj < 2; ++bj) {
          const pg8::f32x4 v0 = acc[ai][bj][m][0], v1 = acc[ai][bj][m][1];
          pg8::u32x4 w; w.x = pg8::cvt_pk_bf16(v0[0], v0[1]); w.y = pg8::cvt_pk_bf16(v0[2], v0[3]); w.z = pg8::cvt_pk_bf16(v1[0], v1[1]); w.w = pg8::cvt_pk_bf16(v1[2], v1[3]);
          *(pg8::u32x4*)(rowp + bj * 128) = w;
        }
      }
  }
};

__device__ __forceinline__ void gemm_tile(const bf16_t* __restrict__ A, int lda, const bf16_t* __restrict__ Bt, int ldb,
                                          int nk, f32x4 (&acc)[4][4], unsigned char* smem) {
  const int tid = threadIdx.x, lane = tid & 63, w = tid >> 6, wm = w >> 1, wn = w & 1, l15 = lane & 15, g = lane >> 4;
  unsigned char* sA = smem;
  unsigned char* sB = smem + 32768;
  const int lr = tid >> 3, lc = tid & 7;
  const bf16_t* ga = A + (size_t)lr * lda + lc * 8;
  const bf16_t* gb = Bt + (size_t)lr * ldb + lc * 8;
  uint4 ra0, ra1, ra2, ra3, rb0, rb1;
  ra0 = *(const uint4*)(ga);
  ra1 = *(const uint4*)(ga + (size_t)64 * lda);
  ra2 = *(const uint4*)(ga + (size_t)128 * lda);
  ra3 = *(const uint4*)(ga + (size_t)192 * lda);
  rb0 = *(const uint4*)(gb);
  rb1 = *(const uint4*)(gb + (size_t)64 * ldb);
  const int sw = (lc ^ (lr & 7)) << 4;
  for (int kt = 0; kt < nk; ++kt) {
    __syncthreads();
    *(uint4*)(sA + (lr) * 128 + sw) = ra0;
    *(uint4*)(sA + (lr + 64) * 128 + sw) = ra1;
    *(uint4*)(sA + (lr + 128) * 128 + sw) = ra2;
    *(uint4*)(sA + (lr + 192) * 128 + sw) = ra3;
    *(uint4*)(sB + (lr) * 128 + sw) = rb0;
    *(uint4*)(sB + (lr + 64) * 128 + sw) = rb1;
    __syncthreads();
    if (kt + 1 < nk) {
      const int ko = (kt + 1) * 64;
      ra0 = *(const uint4*)(ga + ko);
      ra1 = *(const uint4*)(ga + (size_t)64 * lda + ko);
      ra2 = *(const uint4*)(ga + (size_t)128 * lda + ko);
      ra3 = *(const uint4*)(ga + (size_t)192 * lda + ko);
      rb0 = *(const uint4*)(gb + ko);
      rb1 = *(const uint4*)(gb + (size_t)64 * ldb + ko);
    }
#pragma unroll
    for (int ks = 0; ks < 2; ++ks) {
      bf16x8 a[4], b[4];
#pragma unroll
      for (int m = 0; m < 4; ++m) { const int r = wm * 64 + m * 16 + l15; a[m] = *(const bf16x8*)(sA + r * 128 + (((ks * 4 + g) ^ (r & 7)) << 4)); }
#pragma unroll
      for (int n = 0; n < 4; ++n) { const int r = wn * 64 + n * 16 + l15; b[n] = *(const bf16x8*)(sB + r * 128 + (((ks * 4 + g) ^ (r & 7)) << 4)); }
#pragma unroll
      for (int m = 0; m < 4; ++m)
#pragma unroll
        for (int n = 0; n < 4; ++n) acc[m][n] = __builtin_amdgcn_mfma_f32_16x16x32_bf16(a[m], b[n], acc[m][n], 0, 0, 0);
    }
  }
}

struct GTRegs { uint4 ra0, ra1, ra2, ra3, rb0, rb1; };
__device__ __forceinline__ void gemm_tile_issue(const bf16_t* __restrict__ A, int lda, const bf16_t* __restrict__ Bt, int ldb, GTRegs& r) {
  const int tid = threadIdx.x, lr = tid >> 3, lc = tid & 7;
  const bf16_t* ga = A + (size_t)lr * lda + lc * 8;
  const bf16_t* gb = Bt + (size_t)lr * ldb + lc * 8;
  r.ra0 = *(const uint4*)(ga);
  r.ra1 = *(const uint4*)(ga + (size_t)64 * lda);
  r.ra2 = *(const uint4*)(ga + (size_t)128 * lda);
  r.ra3 = *(const uint4*)(ga + (size_t)192 * lda);
  r.rb0 = *(const uint4*)(gb);
  r.rb1 = *(const uint4*)(gb + (size_t)64 * ldb);
}
__device__ __forceinline__ void gemm_tile_run(const bf16_t* __restrict__ A, int lda, const bf16_t* __restrict__ Bt, int ldb,
                                              int nk, f32x4 (&acc)[4][4], unsigned char* smem, GTRegs& r) {
  const int tid = threadIdx.x, lane = tid & 63, w = tid >> 6, wm = w >> 1, wn = w & 1, l15 = lane & 15, g = lane >> 4;
  unsigned char* sA = smem;
  unsigned char* sB = smem + 32768;
  const int lr = tid >> 3, lc = tid & 7;
  const bf16_t* ga = A + (size_t)lr * lda + lc * 8;
  const bf16_t* gb = Bt + (size_t)lr * ldb + lc * 8;
  uint4 ra0 = r.ra0, ra1 = r.ra1, ra2 = r.ra2, ra3 = r.ra3, rb0 = r.rb0, rb1 = r.rb1;
  const int sw = (lc ^ (lr & 7)) << 4;
  for (int kt = 0; kt < nk; ++kt) {
    __syncthreads();
    *(uint4*)(sA + (lr) * 128 + sw) = ra0;
    *(uint4*)(sA + (lr + 64) * 128 + sw) = ra1;
    *(uint4*)(sA + (lr + 128) * 128 + sw) = ra2;
    *(uint4*)(sA + (lr + 192) * 128 + sw) = ra3;
    *(uint4*)(sB + (lr) * 128 + sw) = rb0;
    *(uint4*)(sB + (lr + 64) * 128 + sw) = rb1;
    __syncthreads();
    if (kt + 1 < nk) {
      const int ko = (kt + 1) * 64;
      ra0 = *(const uint4*)(ga + ko);
      ra1 = *(const uint4*)(ga + (size_t)64 * lda + ko);
      ra2 = *(const uint4*)(ga + (size_t)128 * lda + ko);
      ra3 = *(const uint4*)(ga + (size_t)192 * lda + ko);
      rb0 = *(const uint4*)(gb + ko);
      rb1 = *(const uint4*)(gb + (size_t)64 * ldb + ko);
    }
#pragma unroll
    for (int ks = 0; ks < 2; ++ks) {
      bf16x8 a[4], b[4];
#pragma unroll
      for (int m = 0; m < 4; ++m) { const int rr = wm * 64 + m * 16 + l15; a[m] = *(const bf16x8*)(sA + rr * 128 + (((ks * 4 + g) ^ (rr & 7)) << 4)); }
#pragma unroll
      for (int n = 0; n < 4; ++n) { const int rr = wn * 64 + n * 16 + l15; b[n] = *(const bf16x8*)(sB + rr * 128 + (((ks * 4 + g) ^ (rr & 7)) << 4)); }
#pragma unroll
      for (int m = 0; m < 4; ++m)
#pragma unroll
        for (int n = 0; n < 4; ++n) acc[m][n] = __builtin_amdgcn_mfma_f32_16x16x32_bf16(a[m], b[n], acc[m][n], 0, 0, 0);
    }
  }
}

struct GTRegsA { uint4 ra0, ra1, ra2, ra3; };
__device__ __forceinline__ void gemm_tile_issue_a(const bf16_t* __restrict__ A, int lda, GTRegsA& r) {
  const int tid = threadIdx.x, lr = tid >> 3, lc = tid & 7;
  const bf16_t* ga = A + (size_t)lr * lda + lc * 8;
  r.ra0 = *(const uint4*)(ga);
  r.ra1 = *(const uint4*)(ga + (size_t)64 * lda);
  r.ra2 = *(const uint4*)(ga + (size_t)128 * lda);
  r.ra3 = *(const uint4*)(ga + (size_t)192 * lda);
}
__device__ __forceinline__ void gemm_tile_run2(f32x4 (&acc)[4][4], unsigned char* smem, const GTRegs r0, const GTRegsA r1,
                                               const bf16_t* __restrict__ Bt1, int ldb) {
  const int tid = threadIdx.x, lane = tid & 63, w = tid >> 6, wm = w >> 1, wn = w & 1, l15 = lane & 15, g = lane >> 4;
  const int lr = tid >> 3, lc = tid & 7;
  const int sw = (lc ^ (lr & 7)) << 4;
  const bf16_t* gb = Bt1 + (size_t)lr * ldb + lc * 8;
  const uint4 rb0 = *(const uint4*)(gb);
  const uint4 rb1 = *(const uint4*)(gb + (size_t)64 * ldb);
  unsigned char* sA0 = smem;
  unsigned char* sB0 = smem + 32768;
  unsigned char* sA1 = smem + 49152;
  unsigned char* sB1 = smem + 49152 + 32768;
  __syncthreads();
  *(uint4*)(sA0 + (lr) * 128 + sw) = r0.ra0;
  *(uint4*)(sA0 + (lr + 64) * 128 + sw) = r0.ra1;
  *(uint4*)(sA0 + (lr + 128) * 128 + sw) = r0.ra2;
  *(uint4*)(sA0 + (lr + 192) * 128 + sw) = r0.ra3;
  *(uint4*)(sB0 + (lr) * 128 + sw) = r0.rb0;
  *(uint4*)(sB0 + (lr + 64) * 128 + sw) = r0.rb1;
  *(uint4*)(sA1 + (lr) * 128 + sw) = r1.ra0;
  *(uint4*)(sA1 + (lr + 64) * 128 + sw) = r1.ra1;
  *(uint4*)(sA1 + (lr + 128) * 128 + sw) = r1.ra2;
  *(uint4*)(sA1 + (lr + 192) * 128 + sw) = r1.ra3;
  __syncthreads();
#pragma unroll
  for (int kt = 0; kt < 2; ++kt) {
    const unsigned char* sA = kt ? sA1 : sA0;
    const unsigned char* sB = kt ? sB1 : sB0;
    if (kt == 1) {
      *(uint4*)(sB1 + (lr) * 128 + sw) = rb0;
      *(uint4*)(sB1 + (lr + 64) * 128 + sw) = rb1;
      __syncthreads();
    }
#pragma unroll
    for (int ks = 0; ks < 2; ++ks) {
      bf16x8 a[4], b[4];
#pragma unroll
      for (int m = 0; m < 4; ++m) { const int rr = wm * 64 + m * 16 + l15; a[m] = *(const bf16x8*)(sA + rr * 128 + (((ks * 4 + g) ^ (rr & 7)) << 4)); }
#pragma unroll
      for (int n = 0; n < 4; ++n) { const int rr = wn * 64 + n * 16 + l15; b[n] = *(const bf16x8*)(sB + rr * 128 + (((ks * 4 + g) ^ (rr & 7)) << 4)); }
#pragma unroll
      for (int m = 0; m < 4; ++m)
#pragma unroll
        for (int n = 0; n < 4; ++n) acc[m][n] = __builtin_amdgcn_mfma_f32_16x16x32_bf16(a[m], b[n], acc[m][n], 0, 0, 0);
    }
  }
}

__device__ __forceinline__ void zero_acc(f32x4 (&acc)[4][4]) {
#pragma unroll
  for (int m = 0; m < 4; ++m)
#pragma unroll
    for (int n = 0; n < 4; ++n) acc[m][n] = (f32x4){0.f, 0.f, 0.f, 0.f};
}

__device__ __forceinline__ void transpose_tile(const float* __restrict__ src, int srcN, bf16_t* __restrict__ dst, int K, int n0, int k0,
                                               bool winmap, float* tile) {
  const int tid = threadIdx.x;
  const int nc = tid & 63, kr = tid >> 6;
  int ncol = n0 + nc; bool valid = true;
  if (winmap) { if (ncol >= 3072) ncol -= 60; else if (ncol >= 3012) valid = false; }
#pragma unroll
  for (int i = 0; i < 8; ++i) {
    const int k = kr + 8 * i;
    tile[k * 65 + nc] = valid ? src[(size_t)(k0 + k) * srcN + ncol] : 0.f;
  }
  __syncthreads();
#pragma unroll
  for (int i = 0; i < 8; ++i) {
    const int nr = kr + 8 * i;
    dst[(size_t)(n0 + nr) * K + k0 + nc] = f2bf(tile[nc * 65 + nr]);
  }
  __syncthreads();
}

__device__ __forceinline__ void quant_cols32(const float* __restrict__ src, int srcN, unsigned char* __restrict__ dst, float* __restrict__ scale,
                                             int n0, bool winmap, float* tile) {
  const int tid = threadIdx.x, nc = tid & 31, kr = tid >> 5;
  float* red = tile + 1024 * 33;
  int ncol = n0 + nc; bool valid = true;
  if (winmap) { if (ncol >= 3072) ncol -= 60; else if (ncol >= 3012) valid = false; }
  if (!valid) ncol = 0;
  float am = 0.f;
#pragma unroll 16
  for (int i = 0; i < 64; ++i) {
    const int k = kr + 16 * i;
    float v = src[(size_t)k * srcN + ncol];
    v = valid ? v : 0.f;
    tile[k * 33 + nc] = v; am = fmaxf(am, fabsf(v));
  }
  red[kr * 32 + nc] = am;
  __syncthreads();
  if (tid < 32) {
    float m = 0.f;
#pragma unroll
    for (int i = 0; i < 16; ++i) m = fmaxf(m, red[i * 32 + tid]);
    red[512 + tid] = m; scale[n0 + tid] = m * (1.f / 127.f);
  }
  __syncthreads();
  const float cm = red[512 + nc];
  const float inv = cm > 0.f ? 127.f / cm : 0.f;
#pragma unroll
  for (int i = 0; i < 4; ++i) {
    const int k0 = (kr + 16 * i) * 16;
    unsigned pk[4];
#pragma unroll
    for (int q = 0; q < 4; ++q) {
      const unsigned b0 = (unsigned)(int)rintf(tile[(k0 + 4 * q) * 33 + nc] * inv) & 255u, b1 = (unsigned)(int)rintf(tile[(k0 + 4 * q + 1) * 33 + nc] * inv) & 255u;
      const unsigned b2 = (unsigned)(int)rintf(tile[(k0 + 4 * q + 2) * 33 + nc] * inv) & 255u, b3 = (unsigned)(int)rintf(tile[(k0 + 4 * q + 3) * 33 + nc] * inv) & 255u;
      pk[q] = b0 | (b1 << 8) | (b2 << 16) | (b3 << 24);
    }
    *(uint4*)(dst + (size_t)(n0 + nc) * 1024 + k0) = make_uint4(pk[0], pk[1], pk[2], pk[3]);
  }
  __syncthreads();
}

__device__ __forceinline__ void convert_f32_bf16(const float* __restrict__ src, bf16_t* __restrict__ dst, size_t n4) {
  for (size_t i = (size_t)blockIdx.x * NTHREADS + threadIdx.x; i < n4; i += (size_t)gridDim.x * NTHREADS) {
    const float4 v = ((const float4*)src)[i];
    uint2 o; o.x = pack2(v.x, v.y); o.y = pack2(v.z, v.w);
    ((uint2*)dst)[i] = o;
  }
}

template <bool SLICE_MAJOR, bool SIGNED>
__device__ __forceinline__ void quantize_rows_u8(const float* __restrict__ src, unsigned char* __restrict__ dst, float* __restrict__ scale, int row_lo, int row_hi, int w, int nw) {
  typedef float f32x4_q __attribute__((ext_vector_type(4)));
  const int lane = threadIdx.x & 63;
  constexpr int NB = 4;
  for (int row0 = row_lo + w; row0 < row_hi; row0 += nw * NB) {
    f32x4_q raw[NB][4];
#pragma unroll
    for (int b = 0; b < NB; ++b) {
      const int rr = row0 + nw * b, rc = rr < row_hi ? rr : row0;
      const f32x4_q* s4 = (const f32x4_q*)(src + (size_t)rc * 1024) + lane * 4;
#pragma unroll
      for (int i = 0; i < 4; ++i) raw[b][i] = s4[i];
    }
#pragma unroll
    for (int b = 0; b < NB; ++b) {
      const int row = row0 + nw * b;
      if (row < row_hi) {
        float am = 0.f;
#pragma unroll
        for (int i = 0; i < 4; ++i) am = fmaxf(am, fmaxf(fmaxf(fabsf(raw[b][i][0]), fabsf(raw[b][i][1])), fmaxf(fabsf(raw[b][i][2]), fabsf(raw[b][i][3]))));
#pragma unroll
        for (int o = 32; o > 0; o >>= 1) am = fmaxf(am, __shfl_xor(am, o));
        const float inv = am > 0.f ? 127.f / am : 0.f;
        unsigned pk[4];
#pragma unroll
        for (int i = 0; i < 4; ++i) {
          const int ofs = SIGNED ? 0 : 128;
          const unsigned b0 = (unsigned)((int)rintf(raw[b][i][0] * inv) + ofs), b1 = (unsigned)((int)rintf(raw[b][i][1] * inv) + ofs);
          const unsigned b2 = (unsigned)((int)rintf(raw[b][i][2] * inv) + ofs), b3 = (unsigned)((int)rintf(raw[b][i][3] * inv) + ofs);
          pk[i] = (b0 & 255u) | ((b1 & 255u) << 8) | ((b2 & 255u) << 16) | ((b3 & 255u) << 24);
        }
        if (SLICE_MAJOR) {
          unsigned char* d8 = dst + (size_t)(lane >> 3) * (16384 * 128) + (size_t)row * 128 + 2 * (lane & 7);
#pragma unroll
          for (int q = 0; q < 8; ++q) {
            const unsigned lo = (pk[q >> 2] >> (8 * (q & 3))) & 255u, hi = (pk[2 + (q >> 2)] >> (8 * (q & 3))) & 255u;
            *(unsigned short*)(d8 + q * 16) = (unsigned short)(lo | (hi << 8));
          }
        }
        else *(uint4*)(dst + (size_t)row * 1024 + lane * 16) = make_uint4(pk[0], pk[1], pk[2], pk[3]);
        if (lane == 0) scale[(size_t)row * 2] = am * (1.f / 127.f);
      }
    }
  }
}

#define WS_WINS (WS_WIN + (size_t)5120 * 1024)
#define WS_WQS (WS_WQ + (size_t)2048 * 1024)
#define WS_XNS (WS_XN + (size_t)TOK * 1024)
#define WS_X1 (WS_XN)
#define WS_XQ (WS_PH + (size_t)TOK * 1024 * 2)
#define WS_XS (WS_XQ + (size_t)TOK * 1024)
template <bool WBF, bool SRC_BF16 = false>
__device__ __forceinline__ void rmsnorm_rows_q(const float* __restrict__ src, const float* __restrict__ g, bf16_t* __restrict__ dst,
                                               unsigned char* __restrict__ xq, float* __restrict__ xs) {
  typedef unsigned u32x4_t __attribute__((ext_vector_type(4)));
  const int lane = threadIdx.x & 63, w = threadIdx.x >> 6;
  constexpr int NB = 4, NV = SRC_BF16 ? 2 : 4;
  const int stride = gridDim.x * 8;
  for (int row0 = blockIdx.x * 8 + w; row0 < TOK; row0 += NB * stride) {
    u32x4_t raw[NB][NV];
#pragma unroll
    for (int b = 0; b < NB; ++b) {
      const int rr = row0 + b * stride, rc = rr < TOK ? rr : row0;
      const u32x4_t* sp = SRC_BF16 ? (const u32x4_t*)((const bf16_t*)src + (size_t)rc * DM + lane * 16) : (const u32x4_t*)(src + (size_t)rc * DM + lane * 16);
#pragma unroll
      for (int i = 0; i < NV; ++i) raw[b][i] = sp[i];
    }
#pragma unroll
    for (int b = 0; b < NB; ++b) {
      const int row = row0 + b * stride;
      if (row < TOK) {
        const float4* g4 = (const float4*)g + lane * 4;
        float v[16]; float ss = 0.f;
        if (SRC_BF16) {
#pragma unroll
          for (int i = 0; i < 8; ++i) { const unsigned wd = raw[b][i >> 2][i & 3]; v[2 * i] = __uint_as_float(wd << 16); v[2 * i + 1] = __uint_as_float(wd & 0xffff0000u); ss += v[2 * i] * v[2 * i] + v[2 * i + 1] * v[2 * i + 1]; }
        } else {
#pragma unroll
          for (int i = 0; i < 16; ++i) { v[i] = __uint_as_float(raw[b][(i >> 2) % NV][i & 3]); ss += v[i] * v[i]; }
        }
        ss = wave_sum(ss);
        const float rstd = rsqrtf(ss * (1.f / DM) + EPSV);
        float am = 0.f;
#pragma unroll
        for (int i = 0; i < 4; ++i) { const float4 gg = g4[i]; v[4 * i] *= rstd * gg.x; v[4 * i + 1] *= rstd * gg.y; v[4 * i + 2] *= rstd * gg.z; v[4 * i + 3] *= rstd * gg.w; }
#pragma unroll
        for (int i = 0; i < 16; ++i) am = fmaxf(am, fabsf(v[i]));
#pragma unroll
        for (int o = 32; o > 0; o >>= 1) am = fmaxf(am, __shfl_xor(am, o));
        const float inv = am > 0.f ? 127.f / am : 0.f;
        if (WBF) {
          uint4 ob0, ob1;
          ob0.x = pack2(v[0], v[1]); ob0.y = pack2(v[2], v[3]); ob0.z = pack2(v[4], v[5]); ob0.w = pack2(v[6], v[7]);
          ob1.x = pack2(v[8], v[9]); ob1.y = pack2(v[10], v[11]); ob1.z = pack2(v[12], v[13]); ob1.w = pack2(v[14], v[15]);
          *(uint4*)(dst + (size_t)row * DM + lane * 16) = ob0;
          *(uint4*)(dst + (size_t)row * DM + lane * 16 + 8) = ob1;
        }
        unsigned pk[4];
#pragma unroll
        for (int i = 0; i < 4; ++i) {
          const unsigned b0 = (unsigned)(int)rintf(v[4 * i] * inv) & 255u, b1 = (unsigned)(int)rintf(v[4 * i + 1] * inv) & 255u;
          const unsigned b2 = (unsigned)(int)rintf(v[4 * i + 2] * inv) & 255u, b3 = (unsigned)(int)rintf(v[4 * i + 3] * inv) & 255u;
          pk[i] = b0 | (b1 << 8) | (b2 << 16) | (b3 << 24);
        }
        *(uint4*)(xq + (size_t)row * 1024 + lane * 16) = make_uint4(pk[0], pk[1], pk[2], pk[3]);
        if (lane == 0) xs[row] = am * (1.f / 127.f);
      }
    }
  }
}

__device__ __forceinline__ void rmsnorm_rows(const float* __restrict__ src, const float* __restrict__ g, bf16_t* __restrict__ dst) {
  const int lane = threadIdx.x & 63, w = threadIdx.x >> 6;
  for (int row = blockIdx.x * 8 + w; row < TOK; row += gridDim.x * 8) {
    const float4* s4 = (const float4*)(src + (size_t)row * DM);
    float4 v[4]; float ss = 0.f;
#pragma unroll
    for (int i = 0; i < 4; ++i) { v[i] = s4[lane + 64 * i]; ss += v[i].x * v[i].x + v[i].y * v[i].y + v[i].z * v[i].z + v[i].w * v[i].w; }
    ss = wave_sum(ss);
    const float rstd = rsqrtf(ss * (1.f / DM) + EPSV);
#pragma unroll
    for (int i = 0; i < 4; ++i) {
      const float4 gg = ((const float4*)g)[lane + 64 * i];
      uint2 o; o.x = pack2(v[i].x * rstd * gg.x, v[i].y * rstd * gg.y); o.y = pack2(v[i].z * rstd * gg.z, v[i].w * rstd * gg.w);
      ((uint2*)(dst + (size_t)row * DM))[lane + 64 * i] = o;
    }
  }
}

__device__ __forceinline__ void phase_prep(const Params& p, unsigned char* smem) {
  unsigned char* ws = p.ws;
  float* tile = (float*)smem;
  const int n_win = 160, n_ua = 16 * 8, n_ub = 16 * 8, n_wo = 16 * 16, n_wq = 64;
  const int total = n_win + n_wq + n_ua + n_ub + n_wo;
  for (int it = blockIdx.x; it < total; it += gridDim.x) {
    int t = it;
    if (t < n_win) { quant_cols32(p.w_in, 5060, ws + WS_WIN, (float*)(ws + WS_WINS), t * 32, true, tile); continue; }
    t -= n_win;
    if (t < n_wq) { quant_cols32(p.peer_wq, 2048, ws + WS_WQ, (float*)(ws + WS_WQS), t * 32, false, tile); continue; }
    t -= n_wq;
    if (t < n_ua) { transpose_tile(p.w_up_a, 1024, (bf16_t*)(ws + WS_WUPA), 1024, (t >> 3) * 64, (t & 7) * 64, false, tile); continue; }
    t -= n_ua;
    if (t < n_ub) { transpose_tile(p.w_up_b, 1024, (bf16_t*)(ws + WS_WUPA) + 512, 1024, (t >> 3) * 64, (t & 7) * 64, false, tile); continue; }
    t -= n_ub;
    transpose_tile(p.w_out, 1024, (bf16_t*)(ws + WS_WOUT), 1024, (t >> 4) * 64, (t & 15) * 64, false, tile);
  }
  convert_f32_bf16(p.peer_keys, (bf16_t*)(ws + WS_KEYS), (size_t)2 * 8 * 128 * 128 / 4);
  for (int i = blockIdx.x * NTHREADS + threadIdx.x; i < TOK; i += gridDim.x * NTHREADS) ((float*)(ws + WS_SSQ))[i] = 0.f;
  if (threadIdx.x == 0) ((int*)(ws + WS_XCC))[blockIdx.x] = (int)(__builtin_amdgcn_s_getreg((3 << 11) | 20) & 0xFu);
  if (blockIdx.x == 0 && threadIdx.x < 8) ((unsigned*)(ws + WS_QCTR))[16 * threadIdx.x] = 0u;
  if (blockIdx.x == 0) {
    const int i = threadIdx.x;
    const float a0 = p.hg_lb[i], a1 = p.hg_lb[512 + i];
    ((float*)(ws + WS_LB))[i] = 1.f / (1.f + expf(a1 - a0));
  }
  rmsnorm_rows_q<false>(p.x, p.norm_mix, nullptr, ws + WS_XN, (float*)(ws + WS_XNS));
}

__device__ __forceinline__ void hgrn_h1_all(const Params& p, unsigned char* smem) {
  unsigned char* ws = p.ws;
  bf16_t* pH = (bf16_t*)(ws + WS_PH);
  const float* lbp = (const float*)(ws + WS_LB);
  bf16_t* Qt = (bf16_t*)smem;
  bf16_t* Kt = Qt + 64 * 136;
  bf16_t* KtT = Kt + 64 * 136;
  bf16_t* VT = KtT + 128 * 72;
  bf16_t* Am = VT + 128 * 72;
  float* qtot = (float*)(Am + 64 * 72);
  const int tid = threadIdx.x, lane = tid & 63, w = tid >> 6, l15 = lane & 15, g = lane >> 4;
  const int d = tid & 127, tq = tid >> 7;
  const int G = gridDim.x;
  if ((int)blockIdx.x >= 2048) return;
  bf16_t fr_[16], qr_[16]; unsigned short vr_[16];
#define H1_LOAD(IT) do { \
    const int bh_ = (IT) >> 6, ch_ = (IT) & 63; \
    const bf16_t* base_ = pH + ((size_t)(bh_ >> 2) * SEQL + ch_ * 64 + tq * 16) * 2048 + (bh_ & 3) * 128 + d; \
    _Pragma("unroll") for (int i = 0; i < 16; ++i) { fr_[i] = base_[(size_t)i * 2048 + 512]; qr_[i] = base_[(size_t)i * 2048]; vr_[i] = base_[(size_t)i * 2048 + 1024]; } \
  } while (0)
  H1_LOAD((int)blockIdx.x);
  for (int item = blockIdx.x; item < 2048; item += G) {
    const int bh = item >> 6, chunk = item & 63;
    const int b = bh >> 2, h = bh & 3;
    const float lbv = lbp[h * 128 + d];
    const size_t row0 = (size_t)b * SEQL + chunk * 64;
    float* dec = (float*)(ws + WS_DEC) + (size_t)item * 384;
    uint4* UU = (uint4*)p.out + (size_t)item * 2048 + tid;
    float4* OI = (float4*)((unsigned char*)p.out + ((size_t)64 << 20)) + (size_t)item * 2048 + tid;
    {
      unsigned vv[8];
#pragma unroll
      for (int i = 0; i < 8; ++i) vv[i] = (unsigned)vr_[2 * i] | ((unsigned)vr_[2 * i + 1] << 16);
      float lf[16], kk[16], qs[16];
      float run = 0.f;
#pragma unroll
      for (int i = 0; i < 16; ++i) {
        const float sg = sigmoidf_(bf2f(fr_[i]));
        const float fg = lbv + (1.f - lbv) * sg;
        run += __logf(fg);
        lf[i] = run; kk[i] = 1.f - fg; qs[i] = siluf_(bf2f(qr_[i]));
      }
      qtot[tq * 128 + d] = run;
      __syncthreads();
      { const int nit = (item + G < 2048) ? item + G : item; H1_LOAD(nit); }
      const float q0 = qtot[d], q1 = qtot[128 + d], q2 = qtot[256 + d], q3 = qtot[384 + d];
      const float pre = (tq > 0 ? q0 : 0.f) + (tq > 1 ? q1 : 0.f) + (tq > 2 ? q2 : 0.f);
      const float bref = q0 + q1;
      const float blast = bref + q2 + q3;
      unsigned kp[8];
#pragma unroll
      for (int i = 0; i < 16; ++i) {
        const float bt = pre + lf[i];
        const float qt = qs[i] * __expf(bt - bref);
        const float kt = kk[i] * __expf(bref - bt);
        const int t = tq * 16 + i;
        Qt[t * 136 + d] = f2bf(qt);
        const bf16_t kb = f2bf(kt);
        Kt[t * 136 + d] = kb;
        if (i & 1) kp[i >> 1] |= ((unsigned)kb) << 16; else kp[i >> 1] = kb;
      }
      *(uint4*)(KtT + d * 72 + tq * 16) = make_uint4(kp[0], kp[1], kp[2], kp[3]);
      *(uint4*)(KtT + d * 72 + tq * 16 + 8) = make_uint4(kp[4], kp[5], kp[6], kp[7]);
      *(uint4*)(VT + d * 72 + tq * 16) = make_uint4(vv[0], vv[1], vv[2], vv[3]);
      *(uint4*)(VT + d * 72 + tq * 16 + 8) = make_uint4(vv[4], vv[5], vv[6], vv[7]);
      if (tq == 0) { dec[d] = __expf(bref); dec[128 + d] = __expf(blast); dec[256 + d] = __expf(blast - bref); }
    }
    __syncthreads();
    {
  #pragma unroll
      for (int i = 0; i < 2; ++i) {
        const int idx = tid + 512 * i, r = idx >> 4, c = idx & 15;
        *(uint4*)(pH + (row0 + r) * 2048 + h * 128 + c * 8) = *(const uint4*)(Qt + r * 136 + c * 8);
      }
  #pragma unroll
      for (int tt = 0; tt < 2; ++tt) {
        const int tl = 2 * w + tt, sm = tl >> 2, tn = tl & 3;
        f32x4 acc = (f32x4){0.f, 0.f, 0.f, 0.f};
        if (tn >= sm) {
  #pragma unroll
          for (int k0 = 0; k0 < 128; k0 += 32) {
            const bf16x8 a = *(const bf16x8*)(Kt + (sm * 16 + l15) * 136 + k0 + 8 * g);
            const bf16x8 bq = *(const bf16x8*)(Qt + (tn * 16 + l15) * 136 + k0 + 8 * g);
            acc = __builtin_amdgcn_mfma_f32_16x16x32_bf16(a, bq, acc, 0, 0, 0);
          }
        }
        const int t = tn * 16 + l15, s0 = sm * 16 + 4 * g;
        uint2 o;
        o.x = pack2(s0 + 0 <= t ? acc[0] : 0.f, s0 + 1 <= t ? acc[1] : 0.f);
        o.y = pack2(s0 + 2 <= t ? acc[2] : 0.f, s0 + 3 <= t ? acc[3] : 0.f);
        *(uint2*)(Am + t * 72 + s0) = o;
      }
    }
    __syncthreads();
    {
  #pragma unroll
      for (int tm = 0; tm < 4; ++tm) {
        f32x4 acc = (f32x4){0.f, 0.f, 0.f, 0.f};
  #pragma unroll
        for (int k0 = 0; k0 < 64; k0 += 32) {
          const bf16x8 a = *(const bf16x8*)(Am + (tm * 16 + l15) * 72 + k0 + 8 * g);
          const bf16x8 bb = *(const bf16x8*)(VT + (16 * w + l15) * 72 + k0 + 8 * g);
          acc = __builtin_amdgcn_mfma_f32_16x16x32_bf16(a, bb, acc, 0, 0, 0);
        }
        OI[tm * 512] = make_float4(acc[0], acc[1], acc[2], acc[3]);
      }
  #pragma unroll
      for (int dp = 0; dp < 4; ++dp) {
        unsigned pk[4];
  #pragma unroll
        for (int hh = 0; hh < 2; ++hh) {
          const int dm = dp * 2 + hh;
          f32x4 acc = (f32x4){0.f, 0.f, 0.f, 0.f};
  #pragma unroll
          for (int k0 = 0; k0 < 64; k0 += 32) {
            const bf16x8 a = *(const bf16x8*)(KtT + (dm * 16 + l15) * 72 + k0 + 8 * g);
            const bf16x8 bb = *(const bf16x8*)(VT + (16 * w + l15) * 72 + k0 + 8 * g);
            acc = __builtin_amdgcn_mfma_f32_16x16x32_bf16(a, bb, acc, 0, 0, 0);
          }
          pk[hh * 2] = pack2(acc[0], acc[1]); pk[hh * 2 + 1] = pack2(acc[2], acc[3]);
        }
        UU[dp * 512] = make_uint4(pk[0], pk[1], pk[2], pk[3]);
      }
    }
    __syncthreads();
  }
#undef H1_LOAD
}

__device__ __forceinline__ void hgrn_h2(const Params& p, unsigned char* smem, int bh) {
  unsigned char* ws = p.ws;
  const bf16_t* pH = (const bf16_t*)(ws + WS_PH);
  bf16_t* ya = (bf16_t*)(ws + WS_XN);
  bf16_t* Qt = (bf16_t*)smem;
  bf16_t* ST = Qt + 64 * 136;
  float* decl = (float*)(ST + 128 * 136);
  float* red = decl + 384;
  const int tid = threadIdx.x, lane = tid & 63, w = tid >> 6, l15 = lane & 15, g = lane >> 4;
  const int b = bh >> 2, h = bh & 3;
  f32x4 S[8];
#pragma unroll
  for (int i = 0; i < 8; ++i) S[i] = (f32x4){0.f, 0.f, 0.f, 0.f};
  const float gnv = p.hg_norm[h * 128 + 16 * w + l15];
  const int e = 16 * w + l15;
  uint4 uu0, uu1, uu2, uu3; float4 oi0, oi1, oi2, oi3; uint4 qraw0, qraw1; bf16_t ogr[16]; float dcv = 0.f;
#define H2_LOAD(CH) do { \
    const int item_ = bh * 64 + (CH); \
    const size_t row0_ = (size_t)b * SEQL + (size_t)(CH) * 64; \
    const uint4* UUp = (const uint4*)p.out + (size_t)item_ * 2048 + tid; \
    const float4* OIp = (const float4*)((const unsigned char*)p.out + ((size_t)64 << 20)) + (size_t)item_ * 2048 + tid; \
    uu0 = UUp[0]; uu1 = UUp[512]; uu2 = UUp[1024]; uu3 = UUp[1536]; oi0 = OIp[0]; oi1 = OIp[512]; oi2 = OIp[1024]; oi3 = OIp[1536]; \
    qraw0 = *(const uint4*)(pH + (row0_ + (tid >> 4)) * 2048 + h * 128 + (tid & 15) * 8); \
    qraw1 = *(const uint4*)(pH + (row0_ + 32 + (tid >> 4)) * 2048 + h * 128 + (tid & 15) * 8); \
    _Pragma("unroll") for (int tm = 0; tm < 4; ++tm) _Pragma("unroll") for (int j = 0; j < 4; ++j) \
      ogr[tm * 4 + j] = pH[(row0_ + tm * 16 + 4 * g + j) * 2048 + 1536 + h * 128 + e]; \
    if (tid < 384) dcv = ((const float*)(ws + WS_DEC))[(size_t)item_ * 384 + tid]; \
  } while (0)
  H2_LOAD(0);
  for (int chunk = 0; chunk < 64; ++chunk) {
    const size_t row0 = (size_t)b * SEQL + chunk * 64;
    const uint4 cu[4] = {uu0, uu1, uu2, uu3}; const float4 co[4] = {oi0, oi1, oi2, oi3}; bf16_t cog[16];
#pragma unroll
    for (int i = 0; i < 16; ++i) cog[i] = ogr[i];
    *(uint4*)(Qt + (tid >> 4) * 136 + (tid & 15) * 8) = qraw0;
    *(uint4*)(Qt + (32 + (tid >> 4)) * 136 + (tid & 15) * 8) = qraw1;
    if (tid < 384) decl[tid] = dcv;
    __syncthreads();
    if (chunk + 1 < 64) H2_LOAD(chunk + 1);
#pragma unroll
    for (int dm = 0; dm < 8; ++dm) {
      const int d0 = 16 * dm + 4 * g;
      uint2 o;
      o.x = pack2(S[dm][0] * decl[d0], S[dm][1] * decl[d0 + 1]);
      o.y = pack2(S[dm][2] * decl[d0 + 2], S[dm][3] * decl[d0 + 3]);
      *(uint2*)(ST + e * 136 + d0) = o;
    }
    __syncthreads();
    f32x4 o[4];
#pragma unroll
    for (int tm = 0; tm < 4; ++tm) {
      f32x4 acc = (f32x4){co[tm].x, co[tm].y, co[tm].z, co[tm].w};
#pragma unroll
      for (int k0 = 0; k0 < 128; k0 += 32) {
        const bf16x8 a = *(const bf16x8*)(Qt + (tm * 16 + l15) * 136 + k0 + 8 * g);
        const bf16x8 bb = *(const bf16x8*)(ST + (16 * w + l15) * 136 + k0 + 8 * g);
        acc = __builtin_amdgcn_mfma_f32_16x16x32_bf16(a, bb, acc, 0, 0, 0);
      }
      o[tm] = acc;
#pragma unroll
      for (int j = 0; j < 4; ++j) {
        float ss = acc[j] * acc[j];
        ss += __int_as_float(__builtin_amdgcn_update_dpp(0, __float_as_int(ss), 0xB1, 0xf, 0xf, true));
        ss += __int_as_float(__builtin_amdgcn_update_dpp(0, __float_as_int(ss), 0x4E, 0xf, 0xf, true));
        ss += __int_as_float(__builtin_amdgcn_update_dpp(0, __float_as_int(ss), 0x141, 0xf, 0xf, true));
        ss += __int_as_float(__builtin_amdgcn_update_dpp(0, __float_as_int(ss), 0x140, 0xf, 0xf, true));
        if (l15 == 0) red[w * 64 + tm * 16 + 4 * g + j] = ss;
      }
    }
#pragma unroll
    for (int dm = 0; dm < 8; ++dm) {
      const unsigned u01 = (dm & 1) ? cu[dm >> 1].z : cu[dm >> 1].x, u23 = (dm & 1) ? cu[dm >> 1].w : cu[dm >> 1].y;
      const float uv[4] = {__uint_as_float(u01 << 16), __uint_as_float(u01 & 0xffff0000u), __uint_as_float(u23 << 16), __uint_as_float(u23 & 0xffff0000u)};
#pragma unroll
      for (int j = 0; j < 4; ++j) { const int dd = 16 * dm + 4 * g + j; S[dm][j] = decl[128 + dd] * S[dm][j] + decl[256 + dd] * uv[j]; }
    }
    __syncthreads();
    if (tid < 64) {
      float tot = 0.f;
#pragma unroll
      for (int ww = 0; ww < 8; ++ww) tot += red[ww * 64 + tid];
      red[512 + tid] = rsqrtf(tot * (1.f / 128.f) + EPSV);
    }
    __syncthreads();
#pragma unroll
    for (int tm = 0; tm < 4; ++tm)
#pragma unroll
      for (int j = 0; j < 4; ++j) {
        const int t = tm * 16 + 4 * g + j;
        const float rstd = red[512 + t];
        ya[(row0 + t) * 1024 + h * 128 + e] = f2bf(o[tm][j] * rstd * gnv * siluf_(bf2f(cog[tm * 4 + j])));
      }
  }
#undef H2_LOAD
}

__device__ __forceinline__ int team_index(const Params& p, unsigned char* smem) {
  int* sh = (int*)(smem + 8192);
  const int G = gridDim.x, tid = threadIdx.x;
  const int* tab = (const int*)(p.ws + WS_XCC);
  if (tid < 32) sh[tid] = 0;
  __syncthreads();
  const int mine = tab[blockIdx.x] & 15;
  for (int b = tid; b < G; b += NTHREADS) {
    const int x = tab[b] & 15;
    atomicAdd(&sh[x], 1);
    if (x == mine && b < (int)blockIdx.x) atomicAdd(&sh[16], 1);
  }
  __syncthreads();
  if (tid == 0) {
    int pre = 0;
    for (int j = 0; j < mine; ++j) pre += sh[j];
    sh[17] = pre + sh[16];
  }
  __syncthreads();
  const int r = sh[17];
  __syncthreads();
  return r;
}

#define SCW 4112
#ifndef DSA_REP
#define DSA_REP 0
#endif
#define DSA_BKT_OFF (8 * SCW * 4 + 8 * 256 * 4 + 8 * 256 * 2 + 8 * 512 * 2)
__device__ __forceinline__ void cvt8(const uint4& v, float* f) {
  f[0] = __uint_as_float(v.x << 16); f[1] = __uint_as_float(v.x & 0xffff0000u);
  f[2] = __uint_as_float(v.y << 16); f[3] = __uint_as_float(v.y & 0xffff0000u);
  f[4] = __uint_as_float(v.z << 16); f[5] = __uint_as_float(v.z & 0xffff0000u);
  f[6] = __uint_as_float(v.w << 16); f[7] = __uint_as_float(v.w & 0xffff0000u);
}
__device__ __forceinline__ unsigned sortable_key(float v) {
  unsigned bits = __float_as_uint(v);
  if (bits == 0x80000000u) bits = 0u;
  return (bits & 0x80000000u) ? ~bits : (bits | 0x80000000u);
}

__device__ __forceinline__ unsigned long long ballot64(bool p) { return __builtin_amdgcn_ballot_w64(p); }
__device__ __forceinline__ unsigned prefix_cnt(unsigned long long m) { return __builtin_amdgcn_mbcnt_hi((unsigned)(m >> 32), __builtin_amdgcn_mbcnt_lo((unsigned)m, 0u)); }
__device__ __forceinline__ void team_barrier(unsigned char* smem, int team) {
  asm volatile("s_waitcnt lgkmcnt(0)" ::: "memory");
  unsigned* bw = (unsigned*)(smem + LDS_BYTES - 64) + team * 2;
  if ((threadIdx.x & 63) == 0) {
    const unsigned gen = *(volatile unsigned*)(bw + 1);
    const unsigned old = atomicAdd(bw, 1u);
    if (old == 3u) { *(volatile unsigned*)bw = 0u; asm volatile("s_waitcnt lgkmcnt(0)" ::: "memory"); *(volatile unsigned*)(bw + 1) = gen + 1u; }
    else { while (*(volatile unsigned*)(bw + 1) == gen) __builtin_amdgcn_s_sleep(1); }
  }
  asm volatile("s_waitcnt lgkmcnt(0)" ::: "memory");
}
__device__ __forceinline__ void dsa_item(const Params& p, unsigned char* smem, int item, const volatile LAS int* next_slot) {
  unsigned char* ws = p.ws;
  const bf16_t* pA = (const bf16_t*)(ws + WS_PA);
  const bf16_t* kc = (const bf16_t*)(ws + WS_KC);
  const bf16_t* vc = (const bf16_t*)(ws + WS_VC);
  const bf16_t* ikc = (const bf16_t*)(ws + WS_IKC);
  bf16_t* yb = (bf16_t*)(ws + WS_XN) + 512;
  unsigned* sc = (unsigned*)smem;
  unsigned* hist = sc + 8 * SCW;
  unsigned short* sel = (unsigned short*)(hist + 8 * 256);
  unsigned short* cand = sel + 8 * 256;
  unsigned char* bkt = (unsigned char*)(cand + 8 * 512);
  unsigned* rmm = (unsigned*)(bkt + 128 + 1056);
  unsigned* bks = rmm + 16;
  const int tid = threadIdx.x, lane = tid & 63, w = tid >> 6, l15 = lane & 15, g = lane >> 4;
  const int team = w >> 2, w4 = w & 3;
  const int b = item >> 10;
  const int tb = item & 1023;
  const int t0 = __builtin_amdgcn_readfirstlane(tb * 4);
  const size_t tokbase = (size_t)b * SEQL;

  for (int rep_s = 0; rep_s < (DSA_REP == 1 ? 2 : 1); ++rep_s) {
    typedef int i32x4_t __attribute__((ext_vector_type(4)));
    i32x4_t aop[2];
    float wq[2][4];
#pragma unroll
    for (int mt = 0; mt < 1; ++mt) {
      const int qrow = t0 + (l15 >> 2), head = l15 & 3;
      const uint4 q0 = *(const uint4*)(pA + (tokbase + qrow) * 1024 + 640 + head * 64 + 8 * g);
      const uint4 q1 = *(const uint4*)(pA + (tokbase + qrow) * 1024 + 640 + head * 64 + 32 + 8 * g);
      const uint2 wr = *(const uint2*)(pA + (tokbase + t0 + g) * 1024 + 960);
      const unsigned qw[8] = {q0.x, q0.y, q0.z, q0.w, q1.x, q1.y, q1.z, q1.w};
      float fv[16]; float am = 0.f;
#pragma unroll
      for (int i = 0; i < 8; ++i) { fv[2 * i] = __uint_as_float(qw[i] << 16); fv[2 * i + 1] = __uint_as_float(qw[i] & 0xffff0000u); am = fmaxf(am, fmaxf(fabsf(fv[2 * i]), fabsf(fv[2 * i + 1]))); }
      am = max_xor16(am); am = max_xor32(am);
      const float inv = am > 0.f ? 127.f / am : 0.f, sq = am * (1.f / 127.f);
#pragma unroll
      for (int i = 0; i < 4; ++i) {
        const unsigned c0 = (unsigned)(int)rintf(fv[4 * i] * inv) & 255u, c1 = (unsigned)(int)rintf(fv[4 * i + 1] * inv) & 255u;
        const unsigned c2 = (unsigned)(int)rintf(fv[4 * i + 2] * inv) & 255u, c3 = (unsigned)(int)rintf(fv[4 * i + 3] * inv) & 255u;
        aop[mt][i] = (int)(c0 | (c1 << 8) | (c2 << 16) | (c3 << 24));
      }
      const float w4[4] = {bf2f((bf16_t)(wr.x & 0xffff)), bf2f((bf16_t)(wr.x >> 16)), bf2f((bf16_t)(wr.y & 0xffff)), bf2f((bf16_t)(wr.y >> 16))};
#pragma unroll
      for (int j = 0; j < 4; ++j) wq[mt][j] = 0.0625f * w4[j] * __shfl(sq, 4 * g + j);
    }
    const int nkt = (t0 + 4 + 15) >> 4;
    float fmn[2] = {INFINITY, INFINITY}, fmx[2] = {-INFINITY, -INFINITY};
    const int w_s = __builtin_amdgcn_readfirstlane(w4);
    i32x4_t b0[8]; float skv[8];
    const unsigned char* ik8 = ws + WS_IK8; const float* iks = (const float*)(ws + WS_IKS);
#define DSA_SCLOAD(KT0) do { _Pragma("unroll") for (int u = 0; u < 8; ++u) { \
        const int kt_ = (KT0) + 4 * u; \
        const int s_ = (kt_ < nkt ? kt_ : 0) * 16 + l15; \
        b0[u] = *(const i32x4_t*)(ik8 + (tokbase + s_) * 64 + 16 * g); skv[u] = iks[tokbase + s_]; } } while (0)
    DSA_SCLOAD(w_s);
    for (int kt0 = w_s; kt0 < nkt; kt0 += 32) {
      __builtin_amdgcn_sched_barrier(0);
      i32x4_t sacc[8][2]; float skc[8];
#pragma unroll
      for (int u = 0; u < 8; ++u) {
        skc[u] = skv[u];
#pragma unroll
        for (int mt = 0; mt < 1; ++mt) sacc[u][mt] = __builtin_amdgcn_mfma_i32_16x16x64_i8(aop[mt], b0[u], (i32x4_t){0, 0, 0, 0}, 0, 0, 0);
      }
      __builtin_amdgcn_sched_barrier(0);
      if (kt0 + 32 < nkt) { DSA_SCLOAD(kt0 + 32); }
      __builtin_amdgcn_sched_barrier(0);
#pragma unroll
      for (int u = 0; u < 8; ++u) {
        const int kt = kt0 + 4 * u;
        if (kt < nkt) {
          const int s = kt * 16 + l15;
#pragma unroll
          for (int mt = 0; mt < 1; ++mt) {
#define DSA_RELU(x) ((float)max((x), 0))
            const float c_ = fmaf(wq[mt][3], DSA_RELU(sacc[u][mt][3]), fmaf(wq[mt][2], DSA_RELU(sacc[u][mt][2]),
                             fmaf(wq[mt][1], DSA_RELU(sacc[u][mt][1]), wq[mt][0] * DSA_RELU(sacc[u][mt][0]))));
            const float v = fmaf(c_, skc[u], 0.f);
#undef DSA_RELU
            const int t = t0 + g;
            sc[(team * 4 + g) * SCW + s] = __float_as_uint(v);
            const bool valid = s <= t;
            fmn[mt] = __builtin_amdgcn_fmed3f(fmn[mt], valid ? v : INFINITY, -3.4028234663852886e38f);
            fmx[mt] = __builtin_amdgcn_fmed3f(fmx[mt], valid ? v : -INFINITY, 3.4028234663852886e38f);
          }
        }
      }
    }
#undef DSA_SCLOAD
#pragma unroll
    for (int mt = 0; mt < 1; ++mt) {
      const unsigned ba_ = __float_as_uint(fmn[mt]), bb_ = __float_as_uint(fmx[mt]);
      unsigned a = (ba_ & 0x80000000u) ? ~ba_ : (ba_ | 0x80000000u), bmx = (bb_ & 0x80000000u) ? ~bb_ : (bb_ | 0x80000000u);
#define DPP_MINMAX(CTRL) do { const unsigned a2 = (unsigned)__builtin_amdgcn_update_dpp((int)a, (int)a, CTRL, 0xf, 0xf, false); \
                               const unsigned b2 = (unsigned)__builtin_amdgcn_update_dpp((int)bmx, (int)bmx, CTRL, 0xf, 0xf, false); \
                               a = a2 < a ? a2 : a; bmx = b2 > bmx ? b2 : bmx; } while (0)
      DPP_MINMAX(0xB1); DPP_MINMAX(0x4E); DPP_MINMAX(0x141); DPP_MINMAX(0x140);
#undef DPP_MINMAX
      if (l15 == 0) { atomicMin(&rmm[team * 4 + g], a); atomicMax(&rmm[8 + team * 4 + g], bmx); }
    }
  }
  team_barrier(smem, team);
  unsigned warm_v;
  {
    const int nk = *next_slot;
    warm_v = 0u;
    if (nk >= 0) {
      const int nbt = nk >> 16, nkl = nk & 0xffff, nkq = nkl / 33, nkr = nkl - nkq * 33;
      if (nkr < 32 && lane < 14) {
        const int ntb = 1023 - (nkq * 32 + nkr);
        const unsigned char* rp = (const unsigned char*)(pA + ((size_t)nbt * SEQL + ntb * 4 + w4) * 1024) + (lane < 8 ? lane * 128 : 1280 + (lane - 8) * 128);
        warm_v = *(const unsigned*)rp;
      }
    }
  }
  const int t = t0 + w4;
  const int n = t + 1;
  unsigned* row = sc + w * SCW;
  const float* rowf = (const float*)row;
  unsigned short* mysel = sel + w * 256;
  unsigned short* mycand = cand + w * 512;
  unsigned* myh = hist + w * 256;
  int cnt;
  const unsigned long long lt_mask = (1ull << lane) - 1ull;
  for (int rep_t = 0; rep_t < (DSA_REP == 2 ? 2 : 1); ++rep_t)
  if (n <= 256) {
    for (int i = lane; i < n; i += 64) mysel[i] = (unsigned short)i;
    cnt = n;
  } else {
    cnt = 256;
    float mn, mx;
    {
      const unsigned kmn = rmm[w], kmx = rmm[8 + w];
      mn = __uint_as_float((kmn & 0x80000000u) ? (kmn ^ 0x80000000u) : ~kmn);
      mx = __uint_as_float((kmx & 0x80000000u) ? (kmx ^ 0x80000000u) : ~kmx);
    }
    const float scale = (mx > mn) ? 255.99f / (mx - mn) : 0.f;
#pragma unroll
    for (int i = 0; i < 4; ++i) myh[lane + 64 * i] = 0u;
    lds_fence();
    for (int i0 = lane; i0 < n; i0 += 256) {
      float v4[4];
#pragma unroll
      for (int k = 0; k < 4; ++k) v4[k] = rowf[i0 + 64 * k];
#pragma unroll
      for (int k = 0; k < 4; ++k) {
        if (i0 + 64 * k < n) {
          const int bn = (int)((v4[k] - mn) * scale);
          atomicAdd(&myh[bn], 1u);
        }
      }
    }
    lds_fence();
    unsigned cum; int bstar; unsigned mcount;
    {
      const uint4 c4 = *(const uint4*)(myh + 4 * lane);
      const unsigned c = c4.x + c4.y + c4.z + c4.w;
      unsigned sfx = c;
#pragma unroll
      for (int o = 1; o < 64; o <<= 1) { const unsigned tt = __shfl_down(sfx, o); if (lane + o < 64) sfx += tt; }
      const unsigned long long bal = ballot64(sfx >= 256u);
      const int L = 63 - __clzll(bal);
      const unsigned sL = __shfl(sfx, L), cL = __shfl(c, L);
      const unsigned b3 = __shfl(c4.w, L), b2 = __shfl(c4.z, L), b1 = __shfl(c4.y, L), b0 = __shfl(c4.x, L);
      cum = sL - cL;
      int digit;
      if (cum + b3 >= 256u) { digit = 3; mcount = b3; }
      else { cum += b3; if (cum + b2 >= 256u) { digit = 2; mcount = b2; } else { cum += b2; if (cum + b1 >= 256u) { digit = 1; mcount = b1; } else { cum += b1; digit = 0; mcount = b0; } } }
      bstar = 4 * L + digit;
    }
    const unsigned need = 256u - cum;
    if (mcount <= 512u) {
      unsigned base = 0u, cb = 0u;
      for (int i0 = 0; i0 < n; i0 += 256) {
        float v4[4];
#pragma unroll
        for (int k = 0; k < 4; ++k) { const int i = i0 + 64 * k + lane; v4[k] = rowf[i]; }
#pragma unroll
        for (int k = 0; k < 4; ++k) {
          const int i = i0 + 64 * k + lane;
          int bn = (int)((v4[k] - mn) * scale);
          bn = (i < n) ? bn : -1;
          const bool gt = bn > bstar;
          const bool eq = bn == bstar;
          const unsigned long long bg = ballot64(gt), be = ballot64(eq);
          if (gt) mysel[base + (unsigned)prefix_cnt(bg)] = (unsigned short)i;
          if (eq) mycand[cb + (unsigned)prefix_cnt(be)] = (unsigned short)i;
          base += (unsigned)__popcll(bg); cb += (unsigned)__popcll(be);
        }
      }
      lds_fence();
      const int m = (int)mcount;
      unsigned ck[8]; unsigned short ci[8];
#pragma unroll
      for (int q = 0; q < 8; ++q) {
        const int c = q * 64 + lane;
        ck[q] = 0u; ci[q] = 0;
        if (c < m) { ci[q] = mycand[c]; ck[q] = sortable_key(rowf[ci[q]]); }
      }
      unsigned T = 0u;
      if (m <= 64) {
#pragma unroll 1
        for (int bit = 31; bit >= 0; --bit) {
          const unsigned trial = T | (1u << bit);
          if ((unsigned)__popcll(ballot64(ck[0] >= trial)) >= need) T = trial;
        }
      } else {
#pragma unroll 1
        for (int bit = 31; bit >= 0; --bit) {
          const unsigned trial = T | (1u << bit);
          unsigned cge = 0u;
#pragma unroll
          for (int q = 0; q < 8; ++q) cge += (unsigned)__popcll(ballot64(ck[q] >= trial));
          if (cge >= need) T = trial;
        }
      }
      unsigned cgt = 0u;
#pragma unroll
      for (int q = 0; q < 8; ++q) cgt += (unsigned)__popcll(ballot64(ck[q] > T));
      const unsigned need_eq = need - cgt;
      unsigned pos0 = cum, eqtaken = 0u;
#pragma unroll
      for (int q = 0; q < 8; ++q) {
        const bool gt = ck[q] > T;
        const bool eq = ck[q] == T;
        const unsigned long long beq = ballot64(eq);
        const bool take = gt || (eq && (eqtaken + (unsigned)prefix_cnt(beq)) < need_eq);
        const unsigned long long bt = ballot64(take);
        const unsigned pp = pos0 + (unsigned)prefix_cnt(bt);
        if (take && pp < 256u) mysel[pp] = ci[q];
        pos0 += (unsigned)__popcll(bt);
        eqtaken += (unsigned)__popcll(beq);
      }
    } else {
      unsigned prefix = 0u, krem = 256u;
#pragma unroll 1
      for (int pass = 0; pass < 4; ++pass) {
        const int shift = 24 - 8 * pass;
        const unsigned himask = (pass == 0) ? 0u : (0xFFFFFFFFu << (shift + 8));
#pragma unroll
        for (int i = 0; i < 4; ++i) myh[lane + 64 * i] = 0u;
        lds_fence();
        for (int i = lane; i < n; i += 64) {
          const unsigned u = sortable_key(rowf[i]);
          if ((u & himask) == prefix) atomicAdd(&myh[(u >> shift) & 255u], 1u);
        }
        lds_fence();
        const uint4 c4 = *(const uint4*)(myh + 4 * lane);
        const unsigned c = c4.x + c4.y + c4.z + c4.w;
        unsigned sfx = c;
#pragma unroll
        for (int o = 1; o < 64; o <<= 1) { const unsigned tt = __shfl_down(sfx, o); if (lane + o < 64) sfx += tt; }
        const unsigned long long bal = ballot64(sfx >= krem);
        const int L = 63 - __clzll(bal);
        const unsigned sL = __shfl(sfx, L), cL = __shfl(c, L);
        const unsigned b3 = __shfl(c4.w, L), b2 = __shfl(c4.z, L), b1 = __shfl(c4.y, L);
        unsigned cum2 = sL - cL;
        unsigned digit;
        if (cum2 + b3 >= krem) digit = 3;
        else { cum2 += b3; if (cum2 + b2 >= krem) digit = 2; else { cum2 += b2; if (cum2 + b1 >= krem) digit = 1; else { cum2 += b1; digit = 0; } } }
        krem -= cum2;
        prefix |= ((unsigned)(4 * L) + digit) << shift;
      }
      const unsigned T = prefix;
      unsigned base = 0u, eqtaken = 0u;
      for (int i0 = 0; i0 < n; i0 += 64) {
        const int i = i0 + lane;
        const bool valid = i < n;
        const unsigned u = valid ? sortable_key(rowf[i]) : 0u;
        const bool gt = valid && (u > T);
        const bool eq = valid && (u == T);
        const unsigned long long beq = ballot64(eq);
        const unsigned eqrank = eqtaken + (unsigned)prefix_cnt(beq);
        const bool take = gt || (eq && eqrank < krem);
        const unsigned long long bt = ballot64(take);
        const unsigned pos = base + (unsigned)prefix_cnt(bt);
        if (take && pos < 256u) mysel[pos] = (unsigned short)i;
        base += (unsigned)__popcll(bt);
        eqtaken += (unsigned)__popcll(beq);
      }
    }
  }
  lds_fence();
  if (lane == 0) { rmm[w] = 0xFFFFFFFFu; rmm[8 + w] = 0u; }
  lds_fence();
  float ks0, ks1, ks2, ks3;
  float vs0, vs1, vs2, vs3;
  {
    const uint2 s4 = *(const uint2*)(mysel + 4 * lane);
    const int sj[4] = {(int)(s4.x & 0xffffu), (int)(s4.x >> 16), (int)(s4.y & 0xffffu), (int)(s4.y >> 16)};
    unsigned pk = 0u;
#pragma unroll
    for (int j = 0; j < 4; ++j) {
      const bool valid = 4 * lane + j < cnt;
      const int dist = valid ? t - sj[j] : 0;
      unsigned bk = dist < 128 ? (unsigned)bkt[dist] : 31u;
      bk = valid ? bk : 32u;
      pk |= bk << (8 * j);
    }
    bks[w * 64 + lane] = pk;
    const float* k8s = (const float*)(ws + WS_K8S) + tokbase;
    ks0 = k8s[sj[0] & 4095]; ks1 = k8s[sj[1] & 4095]; ks2 = k8s[sj[2] & 4095]; ks3 = k8s[sj[3] & 4095];
    const float* v8s = (const float*)(ws + WS_V8S) + tokbase;
    vs0 = v8s[sj[0] & 4095]; vs1 = v8s[sj[1] & 4095]; vs2 = v8s[sj[2] & 4095]; vs3 = v8s[sj[3] & 4095];
  }
  lds_fence();
  asm volatile("" :: "v"(warm_v));
  {
    int lane_a = lane;
    asm volatile("" : "+v"(lane_a));
    const int l15 = lane_a & 15, g = lane_a >> 4;
    const int ks = lane_a >> 3, dc = lane_a & 7;
    const unsigned char* kcb = (const unsigned char*)(kc + tokbase * 64);
    const unsigned char* vcb = (const unsigned char*)(vc + tokbase * 64);
    float* pl = (float*)row;
    const float* relb = (const float*)(bkt + 128);
    const int niter = (cnt + 7) >> 3;
    typedef int i32x4_t __attribute__((ext_vector_type(4)));
    const uint4 q0r = *(const uint4*)(pA + (tokbase + t) * 1024 + (l15 & 7) * 64 + 8 * g);
    const uint4 q1r = *(const uint4*)(pA + (tokbase + t) * 1024 + (l15 & 7) * 64 + 32 + 8 * g);
    const unsigned char* k8b = ws + WS_K8 + tokbase * 64;
    const float* ksl = (const float*)mycand;
    i32x4_t ka[16];
#pragma unroll
    for (int u = 0; u < 16; ++u) {
      const int kk = u * 16 + l15;
      const unsigned s = (unsigned)mysel[kk] & 4095u;
      ka[u] = *(const i32x4_t*)(k8b + s * 64u + 16u * (unsigned)g);
    }
    __builtin_amdgcn_sched_barrier(0);
    i32x4_t bqi = (i32x4_t){0, 0, 0, 0};
    float cq = 0.f;
    {
      const unsigned qm = l15 < 8 ? 0xffffffffu : 0u;
      const unsigned qw[8] = {q0r.x & qm, q0r.y & qm, q0r.z & qm, q0r.w & qm, q1r.x & qm, q1r.y & qm, q1r.z & qm, q1r.w & qm};
      float fv[16]; float am = 0.f;
#pragma unroll
      for (int i = 0; i < 8; ++i) { fv[2 * i] = __uint_as_float(qw[i] << 16); fv[2 * i + 1] = __uint_as_float(qw[i] & 0xffff0000u); am = fmaxf(am, fmaxf(fabsf(fv[2 * i]), fabsf(fv[2 * i + 1]))); }
      am = max_xor16(am); am = max_xor32(am);
      const float inv = am > 0.f ? 127.f / am : 0.f;
      cq = 0.125f * 1.44269504088896341f * am * (1.f / 127.f);
#pragma unroll
      for (int i = 0; i < 4; ++i) {
        const unsigned c0 = (unsigned)(int)rintf(fv[4 * i] * inv) & 255u, c1 = (unsigned)(int)rintf(fv[4 * i + 1] * inv) & 255u;
        const unsigned c2 = (unsigned)(int)rintf(fv[4 * i + 2] * inv) & 255u, c3 = (unsigned)(int)rintf(fv[4 * i + 3] * inv) & 255u;
        bqi[i] = (int)(c0 | (c1 << 8) | (c2 << 16) | (c3 << 24));
      }
    }
    const bool hi_half = l15 >= 8;
    float lg[8][4];
    {
      __builtin_amdgcn_sched_barrier(0);
      *(float4*)((float*)mycand + 4 * lane_a) = make_float4(ks0, ks1, ks2, ks3);
      *(float4*)((float*)myh + 4 * lane_a) = make_float4(vs0, vs1, vs2, vs3);
      lds_fence();
      i32x4_t accv[16];
#pragma unroll
      for (int u = 0; u < 16; ++u) accv[u] = __builtin_amdgcn_mfma_i32_16x16x64_i8(ka[u], bqi, (i32x4_t){0, 0, 0, 0}, 0, 0, 0);
      const float* kslh = ksl + (hi_half ? 128 : 0) + 4 * g;
#pragma unroll
      for (int u = 0; u < 8; ++u) {
        const float4 sk4 = *(const float4*)(kslh + 16 * u);
        int r4[4];
#pragma unroll
        for (int j = 0; j < 4; ++j)
          r4[j] = __builtin_amdgcn_update_dpp(accv[u][j], accv[8 + u][j], 0x128, 0xf, 0xc, false);
        lg[u][0] = (float)r4[0] * sk4.x; lg[u][1] = (float)r4[1] * sk4.y; lg[u][2] = (float)r4[2] * sk4.z; lg[u][3] = (float)r4[3] * sk4.w;
      }
    }
    cq = __int_as_float(__builtin_amdgcn_update_dpp(__float_as_int(cq), __float_as_int(cq), 0x128, 0xf, 0xc, false));
    typedef unsigned u32x4_t __attribute__((ext_vector_type(4)));
    const unsigned char* v8b = ws + WS_V8A + tokbase * 64;
    const int kq4 = lane_a >> 2, c4 = lane_a & 3;
    i32x4_t vq[16];
#pragma unroll
    for (int u = 0; u < 16; ++u) {
      const unsigned s = (unsigned)mysel[16 * u + kq4] & 4095u;
      vq[u] = *(const i32x4_t*)(v8b + s * 64u + 16u * (unsigned)c4);
    }
    __builtin_amdgcn_sched_barrier(0);
    const int hsel = l15 & 7;
    float m = -INFINITY;
    const unsigned* mybks = bks + w * 64 + (hi_half ? 32 : 0) + g;
#pragma unroll
    for (int u = 0; u < 8; ++u) {
      const unsigned bk4 = mybks[4 * u];
#pragma unroll
      for (int j = 0; j < 4; ++j) {
        lg[u][j] = lg[u][j] * cq + relb[((bk4 >> (8 * j)) & 255u) * 8 + hsel];
        m = fmaxf(m, lg[u][j]);
      }
    }
    m = fmaxf(m, __int_as_float(__builtin_amdgcn_update_dpp(0, __float_as_int(m), 0x128, 0xf, 0xf, true)));
    m = max_xor16(m); m = max_xor32(m);
    float sum = 0.f;
#pragma unroll
    for (int u = 0; u < 8; ++u)
#pragma unroll
      for (int j = 0; j < 4; ++j) { lg[u][j] = __builtin_amdgcn_exp2f(lg[u][j] - m); sum += lg[u][j]; }
    sum = add_xor8(sum); sum = add_xor16(sum); sum = add_xor32(sum);
    const float inv = 1.f / sum;
    const float* vslh = (const float*)myh + (hi_half ? 128 : 0) + 4 * g;
    float pm = 0.f;
#pragma unroll
    for (int u = 0; u < 8; ++u) {
      const float4 sv4 = *(const float4*)(vslh + 16 * u);
      lg[u][0] *= sv4.x; lg[u][1] *= sv4.y; lg[u][2] *= sv4.z; lg[u][3] *= sv4.w;
      pm = fmaxf(pm, fmaxf(fmaxf(lg[u][0], lg[u][1]), fmaxf(lg[u][2], lg[u][3])));
    }
    pm = fmaxf(pm, __int_as_float(__builtin_amdgcn_update_dpp(0, __float_as_int(pm), 0x128, 0xf, 0xf, true)));
    pm = max_xor16(pm); pm = max_xor32(pm);
    const float pq_s = pm > 0.f ? 127.f * __builtin_amdgcn_rcpf(pm) : 0.f;
    const float ofac = pm * (1.f / 127.f) * inv;
    unsigned pw[8];
#pragma unroll
    for (int u = 0; u < 8; ++u) {
      unsigned d_ = 0u;
#pragma unroll
      for (int j = 0; j < 4; ++j) d_ = __builtin_amdgcn_cvt_pk_u8_f32(lg[u][j] * pq_s, j, d_);
      pw[u] = d_;
    }
    i32x4_t pa8[4];
#pragma unroll
    for (int s2 = 0; s2 < 2; ++s2) {
#pragma unroll
      for (int d = 0; d < 4; ++d) {
        pa8[s2][d] = (int)pw[4 * s2 + d];
        pa8[2 + s2][d] = __builtin_amdgcn_update_dpp(0, (int)pw[4 * s2 + d], 0x128, 0xf, 0xf, true);
      }
    }
    unsigned char* vs_l = (unsigned char*)row;
    {
      const unsigned so0 = (unsigned)(kq4 * 64 + ((c4 ^ ((kq4 >> 2) & 1)) << 4)), so1 = (unsigned)(kq4 * 64 + ((c4 ^ ((kq4 >> 2) & 1) ^ 2) << 4));
#pragma unroll
      for (int u = 0; u < 16; ++u) *(i32x4_t*)(vs_l + u * 1024 + ((u & 1) ? so1 : so0)) = vq[u];
    }
    lds_fence();
    i32x4_t ovi[4];
#pragma unroll
    for (int nt = 0; nt < 4; ++nt) ovi[nt] = (i32x4_t){0, 0, 0, 0};
    {
      typedef int i32x2_t __attribute__((ext_vector_type(2)));
      const unsigned tr_f = (unsigned)((g & 1) | (((l15 >> 3) & 1) << 1));
      const unsigned tr_lane = (unsigned)((16 * (l15 >> 3) + 4 * g + ((l15 >> 1) & 3)) * 64 + 8 * (l15 & 1));
      unsigned tr_off[4];
#pragma unroll
      for (int nt = 0; nt < 4; ++nt) tr_off[nt] = tr_lane + (((unsigned)nt ^ tr_f) << 4);
#pragma unroll
      for (int s4 = 0; s4 < 4; ++s4)
#pragma unroll
        for (int nt = 0; nt < 4; ++nt) {
          const unsigned a0 = (unsigned)(s4 * 4096) + tr_off[nt];
          const i32x2_t lo = __builtin_amdgcn_ds_read_tr8_b64_v2i32((__attribute__((address_space(3))) i32x2_t*)(vs_l + a0));
          const i32x2_t hi = __builtin_amdgcn_ds_read_tr8_b64_v2i32((__attribute__((address_space(3))) i32x2_t*)(vs_l + a0 + 2048));
          const i32x4_t bop = {lo[0], lo[1], hi[0], hi[1]};
          ovi[nt] = __builtin_amdgcn_mfma_i32_16x16x64_i8(pa8[s4], bop, ovi[nt], 0, 0, 0);
        }
    }
    float invr[4];
#pragma unroll
    for (int j = 0; j < 4; ++j) invr[j] = __shfl(ofac, (4 * g + j) & 7);
    {
      bf16_t* ob = (bf16_t*)mycand;
      lds_fence();
      if (g < 2) {
#pragma unroll
        for (int nt = 0; nt < 4; ++nt)
#pragma unroll
          for (int j = 0; j < 4; ++j) ob[(4 * g + j) * 64 + nt * 16 + l15] = f2bf((float)ovi[nt][j] * invr[j]);
      }
      lds_fence();
      const uint4 ov16 = *(const uint4*)(ob + lane_a * 8);
      *(uint4*)(yb + (tokbase + t) * 1024 + lane_a * 8) = ov16;
    }
    lds_fence();
  }
  team_barrier(smem, team);
}

__device__ __forceinline__ void phase_mix(const Params& p, unsigned char* smem, int mode = 0) {
  const int G = gridDim.x;
  if (mode != 2) { for (int bh = blockIdx.x; bh < 32; bh += G) { hgrn_h2(p, smem, bh); __syncthreads(); } }
  if (mode == 1) return;
  unsigned char* bkt = smem + DSA_BKT_OFF;
  volatile LAS int* qslot = (volatile LAS int*)(smem + LDS_BYTES - 32);
  unsigned* qctr = (unsigned*)(p.ws + WS_QCTR);
  if (threadIdx.x < 128) {
    const int nn = threadIdx.x;
    int v = nn;
    if (nn >= 16) { v = 16 + (int)(logf((float)nn * (1.f / 16.f)) / logf(8.f) * 16.f); if (v > 31) v = 31; }
    bkt[nn] = (unsigned char)v;
  }
  if (threadIdx.x >= 256) ((float*)(bkt + 128))[threadIdx.x - 256] = p.rel_bias[threadIdx.x - 256] * 1.44269504088896341f;
  if (threadIdx.x >= 128 && threadIdx.x < 136) ((float*)(bkt + 128))[256 + threadIdx.x - 128] = -INFINITY;
  if (threadIdx.x < 16) ((unsigned*)(bkt + 128 + 1056))[threadIdx.x] = threadIdx.x < 8 ? 0xFFFFFFFFu : 0u;
  const int my_team = (G % 8 == 0) ? team_index(p, smem) / (G >> 3) : (int)(blockIdx.x & 7);
  if (threadIdx.x < 4) ((volatile LAS unsigned*)(smem + LDS_BYTES - 64))[threadIdx.x] = 0u;
  __syncthreads();
  const int wteam = threadIdx.x >> 8, w4 = (threadIdx.x >> 6) & 3;
  const bool lead = (threadIdx.x & 255) == 0;
  volatile LAS int* tslot = qslot + 2 * wteam;
  constexpr int QN = 1056;
#define Q_FETCH(SLOT) do { if (lead) { int tm_ = q_team, kk_ = -1; \
      for (int tries_ = 0; tries_ < 8; ++tries_) { \
        const unsigned v_ = __hip_atomic_fetch_add(qctr + 16 * tm_, 1u, __ATOMIC_RELAXED, __HIP_MEMORY_SCOPE_AGENT); \
        if (v_ < (unsigned)QN) { kk_ = (tm_ << 16) | (int)v_; break; } \
        tm_ = (tm_ + 1) & 7; } \
      q_team = tm_; tslot[SLOT] = kk_; } } while (0)
  int q_team = my_team;
  Q_FETCH(0);
  team_barrier(smem, wteam);
  int k = tslot[0];
  int par = 1;
  while (k >= 0) {
    Q_FETCH(par);
    const int bt = k >> 16, kl = k & 0xffff;
    const int kq = kl / 33, kr = kl - kq * 33;
    if (kr < 32) {
      const int tb = 1023 - (kq * 32 + kr);
      dsa_item(p, smem, (bt << 10) | tb, tslot + par);
    } else {
      const int r0 = (bt * 32 + kq) * 64;
      quantize_rows_u8<false, true>(p.peer_u, p.ws + WS_U, (float*)(p.ws + WS_U + (size_t)16384 * 1024), r0, r0 + 64, w4, 4);
      quantize_rows_u8<true, true>(p.peer_v, p.ws + WS_V, (float*)(p.ws + WS_U + (size_t)16384 * 1024) + 1, r0, r0 + 64, w4, 4);
      team_barrier(smem, wteam);
    }
    k = tslot[par];
    par ^= 1;
  }
#undef Q_FETCH
}

__device__ __forceinline__ void phase_pkeys(const Params& p, unsigned char* smem) {
  unsigned char* ws = p.ws;
  const bf16_t* qp = (const bf16_t*)(ws + WS_PG);
  const bf16_t* keys = (const bf16_t*)(ws + WS_KEYS);
  int* eidx = (int*)(ws + WS_EIDX);
  float* gw = (float*)(ws + WS_GW);
  float* sc = (float*)smem;
  float* s2l = (float*)smem;
  unsigned short* i1l = (unsigned short*)(s2l + 256 * 17);
  unsigned short* i2l = i1l + 256 * 16;
  const int tid = threadIdx.x, lane = tid & 63, w = tid >> 6, wm = w >> 1, wn = w & 1, l15 = lane & 15, g = lane >> 4;
  GTRegs gr; GTRegsA gr2;
#define PK_A(ITEM, PH) (qp + (size_t)((ITEM) >> 3) * 256 * 2048 + (((ITEM) & 7) * 2 + (PH)) * 128)
#define PK_B(ITEM, PH) (keys + (size_t)((PH) * 8 + ((ITEM) & 7)) * 128 * 128)
#define PK_ISSUE(ITEM, PH) do { gemm_tile_issue(PK_A(ITEM, PH), 2048, PK_B(ITEM, PH), 128, gr); gemm_tile_issue_a(PK_A(ITEM, PH) + 64, 2048, gr2); } while (0)
  if ((int)blockIdx.x < 128 * 8) PK_ISSUE((int)blockIdx.x, 0);
  for (int item = blockIdx.x; item < 128 * 8; item += gridDim.x) {
    const int h = item & 7, tm = item >> 3;
    float s1[16], s2v[16]; int i1[16], i2[16];
#pragma unroll
    for (int ph = 0; ph < 2; ++ph) {
      f32x4 acc[4][4]; zero_acc(acc);
      gemm_tile_run2(acc, smem, gr, gr2, PK_B(item, ph) + 64, 128);
      __syncthreads();
#pragma unroll
      for (int m = 0; m < 4; ++m)
#pragma unroll
        for (int n = 0; n < 4; ++n)
#pragma unroll
          for (int j = 0; j < 4; ++j) sc[(wm * 64 + m * 16 + 4 * g + j) * 133 + wn * 64 + n * 16 + l15] = acc[m][n][j];
      if (ph == 0) PK_ISSUE(item, 1);
      else if (item + (int)gridDim.x < 128 * 8) PK_ISSUE(item + (int)gridDim.x, 0);
      __syncthreads();
      if (tid < 256) {
        const float* rowp = sc + tid * 133;
        unsigned tv[16];
#pragma unroll
        for (int k = 0; k < 16; ++k) tv[k] = 0xff800000u;
#define PK_KEY(BITS, COL) (((BITS) & ~127u) | (unsigned)(127 - (COL)))
#define PK_INSERT(KEY) do { _Pragma("unroll") for (int k = 15; k >= 1; --k) { unsigned r_; \
            asm("v_med3_f32 %0, %1, %2, %3" : "=v"(r_) : "v"(tv[k]), "v"(tv[k - 1]), "v"(KEY)); tv[k] = r_; } \
          { unsigned r_; asm("v_max_f32 %0, %1, %2" : "=v"(r_) : "v"(tv[0]), "v"(KEY)); tv[0] = r_; } } while (0)
#pragma unroll 8
        for (int nn = 0; nn < 64; ++nn) {
          const unsigned bits0 = __float_as_uint(rowp[2 * nn]), bits1 = __float_as_uint(rowp[2 * nn + 1]);
          const unsigned key0 = PK_KEY(bits0, 2 * nn), key1 = PK_KEY(bits1, 2 * nn + 1);
          unsigned key; asm("v_max_f32 %0, %1, %2" : "=v"(key) : "v"(key0), "v"(key1));
          PK_INSERT(key);
        }
        {
          unsigned pk_[16];
#pragma unroll
          for (int k = 0; k < 16; ++k) { const int pc = (127 - (int)(tv[k] & 127u)) ^ 1; const unsigned pb = __float_as_uint(rowp[pc]); pk_[k] = PK_KEY(pb, pc); }
#pragma unroll
          for (int k = 0; k < 16; ++k) { const unsigned key = pk_[k]; PK_INSERT(key); }
        }
#undef PK_KEY
#undef PK_INSERT
#pragma unroll
        for (int k = 0; k < 16; ++k) {
          const int col = 127 - (int)(tv[k] & 127u);
          const float val = rowp[col];
          if (ph == 0) { i1[k] = col; s1[k] = val; } else { i2[k] = col; s2v[k] = val; }
        }
      }
      __syncthreads();
    }
    if (tid < 256) {
#pragma unroll
      for (int a = 0; a < 16; ++a) { s2l[tid * 17 + a] = s2v[a]; i1l[tid * 16 + a] = (unsigned short)i1[a]; i2l[tid * 16 + a] = (unsigned short)i2[a]; }
      float cur[16];
#pragma unroll
      for (int a = 0; a < 16; ++a) cur[a] = s1[a] + s2v[0];
      unsigned long long ptr = 0ull;
      float tops[16]; int tope[16];
#pragma unroll
      for (int k = 0; k < 16; ++k) {
        float best = cur[0]; int ba = 0;
#pragma unroll
        for (int a = 1; a < 16; ++a) if (cur[a] > best) { best = cur[a]; ba = a; }
        const int bb = (int)((ptr >> (4 * ba)) & 15ull);
        tops[k] = best;
        tope[k] = (int)i1l[tid * 16 + ba] * 128 + (int)i2l[tid * 16 + bb];
        const int nb = bb + 1;
        const float ns2 = (nb < 16) ? s2l[tid * 17 + nb] : -INFINITY;
        if (nb < 16) ptr += (1ull << (4 * ba));
#pragma unroll
        for (int a = 0; a < 16; ++a) if (a == ba) cur[a] = s1[a] + ns2;
      }
      const float m = tops[0];
      float sum = 0.f;
#pragma unroll
      for (int k = 0; k < 16; ++k) { tops[k] = __expf(tops[k] - m); sum += tops[k]; }
      const float inv = 1.f / sum;
      const size_t ob = ((size_t)(tm * 256 + tid) * 8 + h) * 16;
#pragma unroll
      for (int k = 0; k < 16; k += 4) {
        *(int4*)(eidx + ob + k) = make_int4(tope[k], tope[k + 1], tope[k + 2], tope[k + 3]);
        *(float4*)(gw + ob + k) = make_float4(tops[k] * inv, tops[k + 1] * inv, tops[k + 2] * inv, tops[k + 3] * inv);
      }
    }
    __syncthreads();
  }
}


__device__ __forceinline__ float reduce8(const float (&pv)[8], int lane) {
  const bool b5 = lane & 32, b4 = lane & 16, b3 = lane & 8;
  float v[4];
#pragma unroll
  for (int i = 0; i < 4; ++i) {
    const float keep = b5 ? pv[4 + i] : pv[i];
    const float send = b5 ? pv[i] : pv[4 + i];
    v[i] = keep + __shfl_xor(send, 32);
  }
  float u[2];
#pragma unroll
  for (int i = 0; i < 2; ++i) {
    const float keep = b4 ? v[2 + i] : v[i];
    const float send = b4 ? v[i] : v[2 + i];
    u[i] = keep + __shfl_xor(send, 16);
  }
  float x = (b3 ? u[1] : u[0]) + __shfl_xor(b3 ? u[0] : u[1], 8);
  x += __shfl_xor(x, 4); x += __shfl_xor(x, 2); x += __shfl_xor(x, 1);
  return x;
}

__device__ __forceinline__ void cvt16u8(const uint4& v, float* f) {
  f[0] = (float)(v.x & 0xffu); f[1] = (float)((v.x >> 8) & 0xffu); f[2] = (float)((v.x >> 16) & 0xffu); f[3] = (float)(v.x >> 24);
  f[4] = (float)(v.y & 0xffu); f[5] = (float)((v.y >> 8) & 0xffu); f[6] = (float)((v.y >> 16) & 0xffu); f[7] = (float)(v.y >> 24);
  f[8] = (float)(v.z & 0xffu); f[9] = (float)((v.z >> 8) & 0xffu); f[10] = (float)((v.z >> 16) & 0xffu); f[11] = (float)(v.z >> 24);
  f[12] = (float)(v.w & 0xffu); f[13] = (float)((v.w >> 8) & 0xffu); f[14] = (float)((v.w >> 16) & 0xffu); f[15] = (float)(v.w >> 24);
}

__device__ __forceinline__ int wave_sum_i32_dpp(int v) {
  v += __builtin_amdgcn_update_dpp(0, v, 0xB1, 0xf, 0xf, true);
  v += __builtin_amdgcn_update_dpp(0, v, 0x4E, 0xf, 0xf, true);
  v += __builtin_amdgcn_update_dpp(0, v, 0x141, 0xf, 0xf, true);
  v += __builtin_amdgcn_update_dpp(0, v, 0x140, 0xf, 0xf, true);
  return __builtin_amdgcn_readlane(v, 0) + __builtin_amdgcn_readlane(v, 16) + __builtin_amdgcn_readlane(v, 32) + __builtin_amdgcn_readlane(v, 48);
}

__device__ __forceinline__ int reduce8_i32_scatter(const int (&d)[8], int lane) {
  const bool b0 = lane & 1, b1 = lane & 2, b2 = lane & 4;
  int v[4];
#pragma unroll
  for (int i = 0; i < 4; ++i) {
    const int keep = b0 ? d[2 * i + 1] : d[2 * i];
    const int send = b0 ? d[2 * i] : d[2 * i + 1];
    v[i] = keep + __builtin_amdgcn_update_dpp(0, send, 0xB1, 0xf, 0xf, true);
  }
  int u[2];
#pragma unroll
  for (int i = 0; i < 2; ++i) {
    const int keep = b1 ? v[2 * i + 1] : v[2 * i];
    const int send = b1 ? v[2 * i] : v[2 * i + 1];
    u[i] = keep + __builtin_amdgcn_update_dpp(0, send, 0x4E, 0xf, 0xf, true);
  }
  int x;
  {
    const int keep = b2 ? u[1] : u[0];
    const int send = b2 ? u[0] : u[1];
    int t = __builtin_amdgcn_update_dpp(0, send, 0x141, 0xf, 0xf, true);
    t = __builtin_amdgcn_update_dpp(0, t, 0x1B, 0xf, 0xf, true);
    x = keep + t;
  }
  x += __builtin_amdgcn_update_dpp(0, x, 0x128, 0xf, 0xf, true);
  { const auto r = __builtin_amdgcn_permlane16_swap((unsigned)x, (unsigned)x, false, false); x = (int)r[0] + (int)r[1]; }
  { const auto r = __builtin_amdgcn_permlane32_swap((unsigned)x, (unsigned)x, false, false); x = (int)r[0] + (int)r[1]; }
  return x;
}

__device__ __forceinline__ void phase_pu(const Params& p, unsigned char* smem) {
  unsigned char* ws = p.ws;
  const unsigned char* XQ = ws + WS_XQ;
  const float* xs = (const float*)(ws + WS_XS);
  const unsigned char* U8 = ws + WS_U;
  const float* us = (const float*)(ws + WS_U + (size_t)16384 * 1024);
  const float* vs = (const float*)(ws + WS_V + (size_t)16384 * 1024);
  const int* eidx = (const int*)(ws + WS_EIDX);
  const float* gw = (const float*)(ws + WS_GW);
  float* aw = (float*)(ws + WS_PA);
  const int lane = threadIdx.x & 63, w = threadIdx.x >> 6;
  const unsigned long long lt_mask = (1ull << lane) - 1ull;
  const int G = gridDim.x;
  const bool sliced = (G % 8 == 0);
  const int ti = sliced ? team_index(p, smem) : 0;
  const int tsz = sliced ? (G >> 3) : G;
  const int grp_lo = sliced ? ti / tsz : 0, grp_hi = sliced ? grp_lo + 1 : 8;
  const int slot = (sliced ? (ti % tsz) : (int)blockIdx.x) * 8 + w;
  const int nslot = tsz * 8;
  unsigned* lst = (unsigned*)smem + 4096 + w * 128;
  typedef unsigned u32x4_t __attribute__((ext_vector_type(4)));
  if (slot >= TOK) return;
  for (int grp = grp_lo; grp < grp_hi; ++grp) {
#define PU_LIST(E0, E1, N, L0, L1) do { \
      const bool m0_ = ((E0) >> 11) == grp, m1_ = ((E1) >> 11) == grp; \
      const unsigned long long b0_ = __ballot(m0_), b1_ = __ballot(m1_); \
      const int c0_ = __popcll(b0_); N = c0_ + __popcll(b1_); \
      if (m0_) lst[__popcll(b0_ & lt_mask)] = ((unsigned)lane << 14) | (unsigned)(E0); \
      if (m1_) lst[c0_ + __popcll(b1_ & lt_mask)] = ((unsigned)(lane + 64) << 14) | (unsigned)(E1); \
      lds_fence(); \
      L0 = (lane < N) ? lst[lane] : 0u; L1 = (lane + 64 < N) ? lst[lane + 64] : 0u; \
      lds_fence(); } while (0)
#define PU_ISSUE(BUF, L0, N, I0) do { int last_ = ((N) < 64 ? (N) : 64) - 1; last_ = last_ < 0 ? 0 : last_; \
      _Pragma("unroll") for (int j = 0; j < 8; ++j) { int idx_ = (I0) + j; idx_ = idx_ < last_ ? idx_ : last_; \
        const unsigned le_ = (unsigned)__builtin_amdgcn_readlane((int)(L0), idx_); \
        BUF[j] = *(const u32x4_t*)(U8 + (size_t)(le_ & 16383u) * 1024 + lane * 16); } } while (0)
#define PU_REDUCE(BUF, X, I0, HREG) do { int dd_[8]; _Pragma("unroll") for (int j = 0; j < 8; ++j) { \
        int d_ = __builtin_amdgcn_sdot4((int)BUF[j].x, (int)(X).x, 0, false); \
        d_ = __builtin_amdgcn_sdot4((int)BUF[j].y, (int)(X).y, d_, false); \
        d_ = __builtin_amdgcn_sdot4((int)BUF[j].z, (int)(X).z, d_, false); \
        dd_[j] = __builtin_amdgcn_sdot4((int)BUF[j].w, (int)(X).w, d_, false); } \
      const int tot_ = reduce8_i32_scatter(dd_, lane);     \
      if (lane >= (I0) && lane < (I0) + 8) HREG = tot_; } while (0)
    u32x4_t cx = *(const u32x4_t*)(XQ + (size_t)slot * 1024 + lane * 16);
    int ce0 = eidx[(size_t)slot * 128 + lane], ce1 = eidx[(size_t)slot * 128 + 64 + lane];
    float cxs = xs[slot];
    int cn; unsigned cl0, cl1;
    PU_LIST(ce0, ce1, cn, cl0, cl1);
    u32x4_t ra[8], rb[8], rc[8];
    PU_ISSUE(ra, cl0, cn, 0);
    PU_ISSUE(rb, cl0, cn, 8);
    int t1 = (slot + nslot < TOK) ? slot + nslot : slot;
    u32x4_t nx = *(const u32x4_t*)(XQ + (size_t)t1 * 1024 + lane * 16);
    int ne0 = eidx[(size_t)t1 * 128 + lane], ne1 = eidx[(size_t)t1 * 128 + 64 + lane];
    float nxs = xs[t1];
    for (int tok = slot; tok < TOK; tok += nslot) {
      float sc0 = 0.f, sc1 = 0.f, gv0 = 0.f, gv1 = 0.f, vv0 = 0.f, vv1 = 0.f;
      if (lane < cn) { const int e = cl0 & 16383; sc0 = us[e]; vv0 = vs[e]; gv0 = gw[(size_t)tok * 128 + (cl0 >> 14)]; }
      if (lane + 64 < cn) { const int e = cl1 & 16383; sc1 = us[e]; vv1 = vs[e]; gv1 = gw[(size_t)tok * 128 + (cl1 >> 14)]; }
      int nn; unsigned nl0, nl1;
      PU_LIST(ne0, ne1, nn, nl0, nl1);
      const u32x4_t x1 = nx; const int xe0 = ne0, xe1 = ne1; const float xs1 = nxs;
      const int t2a = tok + nslot, t2 = (t2a + nslot < TOK) ? t2a + nslot : ((t2a < TOK) ? t2a : tok);
      nx = *(const u32x4_t*)(XQ + (size_t)t2 * 1024 + lane * 16);
      ne0 = eidx[(size_t)t2 * 128 + lane]; ne1 = eidx[(size_t)t2 * 128 + 64 + lane];
      nxs = xs[t2];
      int h0i = 0, h1i = 0;
      const bool third = cn > 16;
      if (third) { PU_ISSUE(rc, cl0, cn, 16); }
      __builtin_amdgcn_sched_barrier(0); PU_REDUCE(ra, cx, 0, h0i);  __builtin_amdgcn_sched_barrier(0);
      PU_ISSUE(ra, nl0, nn, 0);  __builtin_amdgcn_sched_barrier(0); PU_REDUCE(rb, cx, 8, h0i);  __builtin_amdgcn_sched_barrier(0);
      PU_ISSUE(rb, nl0, nn, 8);  __builtin_amdgcn_sched_barrier(0);
      if (third) { PU_REDUCE(rc, cx, 16, h0i); }
      __builtin_amdgcn_sched_barrier(0);
      if (cn > 24) {
        for (int i0 = 24; i0 < cn; i0 += 8) {
          u32x4_t rd[8];
          const bool lo = i0 < 64;
          const unsigned lsrc = lo ? cl0 : cl1;
          const int nsrc = lo ? cn : cn - 64;
          PU_ISSUE(rd, lsrc, nsrc, i0 & 63);
          if (lo) { PU_REDUCE(rd, cx, i0, h0i); } else { PU_REDUCE(rd, cx, i0 - 64, h1i); }
        }
      }
      const float h0 = (float)h0i * sc0 * cxs, h1 = (float)h1i * sc1 * cxs;
      if (lane < cn) aw[(size_t)tok * 128 + (cl0 >> 14)] = 0.5f * h0 * (1.f + erff(h0 * 0.70710678118654752f)) * gv0 * vv0;
      if (lane + 64 < cn) aw[(size_t)tok * 128 + (cl1 >> 14)] = 0.5f * h1 * (1.f + erff(h1 * 0.70710678118654752f)) * gv1 * vv1;
      cx = x1; ce0 = xe0; ce1 = xe1; cxs = xs1; cn = nn; cl0 = nl0; cl1 = nl1;
    }
#undef PU_LIST
#undef PU_ISSUE
#undef PU_REDUCE
  }
}

__device__ __forceinline__ void phase_pu_ring(const Params& p, unsigned char* smem) {
  unsigned char* ws = p.ws;
  const unsigned char* XQ = ws + WS_XQ;
  const float* xs = (const float*)(ws + WS_XS);
  const unsigned char* U8 = ws + WS_U;
  const float2* uvs = (const float2*)(ws + WS_U + (size_t)16384 * 1024);
  const int* eidx = (const int*)(ws + WS_EIDX);
  float* gw = (float*)(ws + WS_GW);
  float* aw = gw;
  const int lane = threadIdx.x & 63, w = threadIdx.x >> 6;
  const unsigned long long lt_mask = (1ull << lane) - 1ull;
  const int G = gridDim.x;
  const bool sliced = (G % 8 == 0);
  const int ti = sliced ? team_index(p, smem) : 0;
  const int tsz = sliced ? (G >> 3) : G;
  const int grp_lo = sliced ? ti / tsz : 0, grp_hi = sliced ? grp_lo + 1 : 8;
  const int slot = __builtin_amdgcn_readfirstlane((sliced ? (ti % tsz) : (int)blockIdx.x) * 8 + w);
  const int nslot = tsz * 8;
  unsigned* ring = (unsigned*)(smem + 4096) + w * 256;
  unsigned char* xr = smem + 16384 + w * 16384;
  typedef unsigned u32x4_t __attribute__((ext_vector_type(4)));
  if (slot >= TOK) return;
  const int ntok = (TOK - slot + nslot - 1) / nslot;
  for (int grp_v = grp_lo; grp_v < grp_hi; ++grp_v) {
    const int grp = __builtin_amdgcn_readfirstlane(grp_v);
    int head = 0, tail = 0, napp = 0;
    u32x4_t nx = *(const u32x4_t*)(XQ + (size_t)slot * 1024 + lane * 16);
    int ne0 = eidx[(size_t)slot * 128 + lane], ne1 = eidx[(size_t)slot * 128 + 64 + lane];
#define PUR_APPEND(ALLOW) do { \
      if (napp < ntok && tail - head <= 120 && (ALLOW)) { \
        const int e0_ = ne0, e1_ = ne1; \
        *(u32x4_t*)(xr + (napp & 15) * 1024 + lane * 16) = nx; \
        const bool m0_ = (e0_ >> 11) == grp, m1_ = (e1_ >> 11) == grp; \
        const unsigned long long b0_ = __ballot(m0_), b1_ = __ballot(m1_); \
        const int c0_ = __popcll(b0_), n_ = c0_ + __popcll(b1_); \
        const unsigned tag_ = (unsigned)napp << 21; \
        if (m0_) ring[(tail + __popcll(b0_ & lt_mask)) & 255] = tag_ | ((unsigned)lane << 14) | (unsigned)e0_; \
        if (m1_) ring[(tail + c0_ + __popcll(b1_ & lt_mask)) & 255] = tag_ | ((unsigned)(lane + 64) << 14) | (unsigned)e1_; \
        tail += n_; ++napp; \
      } \
      { const int tn_ = napp < ntok ? napp : ntok - 1; const size_t tk_ = (size_t)(slot + tn_ * nslot); \
        nx = *(const u32x4_t*)(XQ + tk_ * 1024 + lane * 16); ne0 = eidx[tk_ * 128 + lane]; ne1 = eidx[tk_ * 128 + 64 + lane]; } \
      lds_fence(); } while (0)
#define PUR_PLAN(ENT, TAKE, NB) do { const int o_ = tail - head; NB = (o_ >= 96) ? 3 : 2; TAKE = o_ < 8 * NB ? o_ : 8 * NB; \
      const int li_ = lane < TAKE ? lane : (TAKE > 0 ? TAKE - 1 : 0); \
      const unsigned rv_ = ring[(head + li_) & 255]; \
      ENT = TAKE > 0 ? rv_ : ((unsigned)grp << 11);     \
      head += TAKE; } while (0)
#define PUR_META(ENT, SC, VV, GV, XSV) do { const unsigned e_ = (ENT) & 16383u, k_ = ((ENT) >> 14) & 127u; \
      const size_t tk_ = (size_t)(slot + (int)((ENT) >> 21) * nslot); \
      { const float2 sv_ = uvs[e_]; SC = sv_.x; VV = sv_.y; } GV = gw[tk_ * 128 + k_]; XSV = xs[tk_]; } while (0)
#define PUR_ISSUE(BUF, ENT, I0) do { _Pragma("unroll") for (int j = 0; j < 8; ++j) { \
        const unsigned le_ = (unsigned)__builtin_amdgcn_readlane((int)(ENT), (I0) + j); \
        BUF[j] = *(const u32x4_t*)(U8 + (size_t)(le_ & 16383u) * 1024 + lane * 16); } } while (0)
#define PUR_REDUCE(BUF, ENT, I0, HREG) do { int dd_[8]; _Pragma("unroll") for (int j = 0; j < 8; ++j) { \
        const unsigned le_ = (unsigned)__builtin_amdgcn_readlane((int)(ENT), (I0) + j); \
        const u32x4_t xv_ = *(const u32x4_t*)(xr + ((le_ >> 21) & 15u) * 1024u + lane * 16); \
        int d_ = __builtin_amdgcn_sdot4((int)BUF[j].x, (int)xv_.x, 0, false); \
        d_ = __builtin_amdgcn_sdot4((int)BUF[j].y, (int)xv_.y, d_, false); \
        d_ = __builtin_amdgcn_sdot4((int)BUF[j].z, (int)xv_.z, d_, false); \
        dd_[j] = __builtin_amdgcn_sdot4((int)BUF[j].w, (int)xv_.w, d_, false); } \
      const int tot_ = reduce8_i32_scatter(dd_, lane);     \
      if (lane >= (I0) && lane < (I0) + 8) HREG = tot_; } while (0)
    PUR_APPEND(true);
    PUR_APPEND(true);
    unsigned entC, entN; int takeC, nbC, takeN, nbN;
    float scC, vvC, gvC, xsC, scN, vvN, gvN, xsN;
    PUR_PLAN(entC, takeC, nbC);
    PUR_META(entC, scC, vvC, gvC, xsC);
    u32x4_t ra[8], rb[8], rc[8];
    PUR_ISSUE(ra, entC, 0);
    PUR_ISSUE(rb, entC, 8);
    while (takeC > 0 || napp < ntok) {
      const int ordC0 = (int)((unsigned)__builtin_amdgcn_readlane((int)entC, 0) >> 21);
      PUR_APPEND(takeC == 0 || napp - ordC0 < 15);
      PUR_PLAN(entN, takeN, nbN);
      PUR_META(entN, scN, vvN, gvN, xsN);
      int hacc = 0;
      const bool third = nbC == 3;
      if (third) { PUR_ISSUE(rc, entC, 16); }
      __builtin_amdgcn_sched_barrier(0); PUR_REDUCE(ra, entC, 0, hacc); __builtin_amdgcn_sched_barrier(0);
      PUR_ISSUE(ra, entN, 0); __builtin_amdgcn_sched_barrier(0); PUR_REDUCE(rb, entC, 8, hacc); __builtin_amdgcn_sched_barrier(0);
      PUR_ISSUE(rb, entN, 8); __builtin_amdgcn_sched_barrier(0);
      if (third) { PUR_REDUCE(rc, entC, 16, hacc); }
      __builtin_amdgcn_sched_barrier(0);
      const float h = (float)hacc * scC * xsC;
      if (lane < takeC) {
        const size_t tk = (size_t)(slot + (int)(entC >> 21) * nslot);
        aw[tk * 128 + ((entC >> 14) & 127u)] = 0.5f * h * (1.f + erff(h * 0.70710678118654752f)) * gvC * vvC;
      }
      entC = entN; takeC = takeN; nbC = nbN; scC = scN; vvC = vvN; gvC = gvN; xsC = xsN;
    }
#undef PUR_APPEND
#undef PUR_PLAN
#undef PUR_META
#undef PUR_ISSUE
#undef PUR_REDUCE
  }
}

template <bool SL>
__device__ __forceinline__ void phase_pv_t(const Params& p, unsigned char* smem) {
  unsigned char* ws = p.ws;
  const unsigned char* V8 = ws + WS_V;
  const int* eidx = (const int*)(ws + WS_EIDX);
  const float* aw = (const float*)(ws + WS_PA);
  float* ssq = (float*)(ws + WS_SSQ);
  const int lane = threadIdx.x & 63, w = threadIdx.x >> 6;
  const int q = lane >> 3, c = lane & 7;
  const int G = gridDim.x;
  constexpr bool sliced = SL;
  const int ti = sliced ? team_index(p, smem) : 0;
  const int tsz = G >> 3;
  const int grp0 = sliced ? (ti / tsz) : 0;
  constexpr int ngrp = sliced ? 1 : 8;
  const int slot = sliced ? (ti % tsz) * 8 + w : blockIdx.x * 8 + w;
  const int nslot = sliced ? tsz * 8 : G * 8;
  int ee[16]; float aa[16];
  if (slot < TOK) {
    unsigned bi = (unsigned)slot * 128u + 16u * (unsigned)q;
    asm volatile("" : "+v"(bi));
#pragma unroll
    for (int u4 = 0; u4 < 4; ++u4) {
      const int4 e4 = *(const int4*)(eidx + bi + 4 * u4); const float4 a4 = *(const float4*)(aw + bi + 4 * u4);
      ee[4 * u4] = e4.x; ee[4 * u4 + 1] = e4.y; ee[4 * u4 + 2] = e4.z; ee[4 * u4 + 3] = e4.w;
      aa[4 * u4] = a4.x; aa[4 * u4 + 1] = a4.y; aa[4 * u4 + 2] = a4.z; aa[4 * u4 + 3] = a4.w;
    }
  }
  for (int tok = slot; tok < TOK; tok += nslot) {
    int ce[16]; float ca[16];
    float suma = 0.f;
#pragma unroll
    for (int u = 0; u < 16; ++u) { ce[u] = ee[u]; ca[u] = aa[u]; suma += aa[u]; }
    for (int gi = 0; gi < ngrp; ++gi) {
      const int grp = grp0 + gi;
      uint4 vv[16];
#pragma unroll
      for (int u = 0; u < 16; ++u) vv[u] = *(const uint4*)(V8 + (size_t)grp * (16384 * 128) + (size_t)ce[u] * 128 + c * 16);
      float* orow = p.out + (size_t)tok * 1024 + grp * 128 + c * 16;
      float4 x1v[4];
#pragma unroll
      for (int i = 0; i < 4; ++i) x1v[i] = *(const float4*)(orow + 4 * i);
      if (gi == ngrp - 1) {
        const int nt = (tok + nslot < TOK) ? tok + nslot : tok;
        unsigned bi = (unsigned)nt * 128u + 16u * (unsigned)q;
        asm volatile("" : "+v"(bi));
#pragma unroll
        for (int u4 = 0; u4 < 4; ++u4) {
          const int4 e4 = *(const int4*)(eidx + bi + 4 * u4); const float4 a4 = *(const float4*)(aw + bi + 4 * u4);
          ee[4 * u4] = e4.x; ee[4 * u4 + 1] = e4.y; ee[4 * u4 + 2] = e4.z; ee[4 * u4 + 3] = e4.w;
          aa[4 * u4] = a4.x; aa[4 * u4 + 1] = a4.y; aa[4 * u4 + 2] = a4.z; aa[4 * u4 + 3] = a4.w;
        }
      }
      __builtin_amdgcn_sched_barrier(0);
      float acc[16];
#pragma unroll
      for (int i = 0; i < 16; ++i) acc[i] = -128.f * suma;
#pragma unroll
      for (int u = 0; u < 16; ++u) {
        float vf[16];
        cvt16u8(vv[u], vf);
#pragma unroll
        for (int i = 0; i < 16; ++i) acc[i] += ca[u] * vf[i];
        __builtin_amdgcn_sched_barrier(0);
      }
#pragma unroll
      for (int i = 0; i < 16; ++i) { acc[i] = add_xor8(acc[i]); acc[i] = add_xor16(acc[i]); acc[i] = add_xor32(acc[i]); }
      float ss = 0.f;
      if (q == 0) {
#pragma unroll
        for (int i = 0; i < 4; ++i) {
          const float4 oa = make_float4(x1v[i].x + acc[4 * i], x1v[i].y + acc[4 * i + 1], x1v[i].z + acc[4 * i + 2], x1v[i].w + acc[4 * i + 3]);
          *(float4*)(orow + 4 * i) = oa;
          ss += oa.x * oa.x + oa.y * oa.y + oa.z * oa.z + oa.w * oa.w;
        }
      }
      ss += __shfl_xor(ss, 1); ss += __shfl_xor(ss, 2); ss += __shfl_xor(ss, 4);
      if (lane == 0) atomicAdd(&ssq[tok], ss);
    }
  }
}

__device__ __forceinline__ void phase_pv_mfma(const Params& p, unsigned char* smem) {
  unsigned char* ws = p.ws;
  const unsigned char* V8 = ws + WS_V;
  const int* eidx = (const int*)(ws + WS_EIDX);
  const float* aw = (const float*)(ws + WS_GW);
  float* ssq = (float*)(ws + WS_SSQ);
  const int lane = threadIdx.x & 63, w = threadIdx.x >> 6;
  const int q8 = lane >> 3, c = lane & 7;
  const int l15 = lane & 15, g = lane >> 4;
  const int G = gridDim.x;
  const bool sliced = (G % 8 == 0);
  const int ti = sliced ? team_index(p, smem) : 0;
  const int tsz = sliced ? (G >> 3) : G;
  const int grp_lo = sliced ? ti / tsz : 0, grp_hi = sliced ? grp_lo + 1 : 8;
  const int slot = (sliced ? (ti % tsz) : (int)blockIdx.x) * 8 + w;
  const int nslot = tsz * 8;
  if (slot >= TOK) return;
  unsigned char* vs_l = smem + 16384 + w * 16384;
  typedef unsigned u32x4_t __attribute__((ext_vector_type(4)));
  typedef float f32x4_t __attribute__((ext_vector_type(4)));
  typedef int i32x4_t __attribute__((ext_vector_type(4)));
  typedef int i32x2_t __attribute__((ext_vector_type(2)));
  const unsigned tr_f16 = (unsigned)((((l15 >> 2) & 3) | ((g & 1) << 2)) << 4);
  const unsigned tr_lane = (unsigned)((l15 >> 1) * 128 + (l15 & 1) * 8);
  unsigned tr_off[8];
#pragma unroll
  for (int nt = 0; nt < 8; ++nt) tr_off[nt] = tr_lane + (((unsigned)nt << 4) ^ tr_f16);
  unsigned st_off[4];
#pragma unroll
  for (int cu = 0; cu < 4; ++cu) st_off[cu] = (unsigned)(16 * q8 * 128 + (((c ^ ((q8 & 1) << 2)) ^ cu) << 4));
  unsigned char* cf_l = smem + 4096 + w * 128;
  const unsigned coff = (unsigned)c * 16u;
  for (int grp_v = grp_lo; grp_v < grp_hi; ++grp_v) {
    const int grp = __builtin_amdgcn_readfirstlane(grp_v);
    const unsigned char* Vg = V8 + (size_t)grp * (16384 * 128);
    i32x4_t eea[4], eeb[4]; float2 a2c, a2n;
    u32x4_t va[16], vb[16];
#define PVM_IDS(EE, TOKEN) do { const i32x4_t* ep_ = (const i32x4_t*)(eidx + (size_t)(TOKEN) * 128 + 16 * q8); \
      _Pragma("unroll") for (int u4 = 0; u4 < 4; ++u4) EE[u4] = ep_[u4]; } while (0)
#define PVM_GATHER(BUF, EE) do { _Pragma("unroll") for (int u = 0; u < 16; ++u) BUF[u] = *(const u32x4_t*)(Vg + ((((unsigned)EE[u >> 2][u & 3]) << 7) | coff)); } while (0)
#define PVM_BODY(TOK_, VC, VN, EC, EN) do { \
      const int tok_ = (TOK_); \
      const int tn1_ = (tok_ + nslot < TOK) ? tok_ + nslot : tok_, tn2_ = (tn1_ + nslot < TOK) ? tn1_ + nslot : tn1_; \
      bf16_t* orow = (bf16_t*)(ws + WS_X1) + (size_t)tok_ * 1024 + grp * 128 + 8 * l15; \
      const u32x4_t x1r = *(const u32x4_t*)orow; \
      PVM_IDS(EN, tn2_);                \
      a2n = *(const float2*)(aw + (size_t)tn1_ * 128 + 2 * lane); \
      PVM_GATHER(VN, EC);               \
        \
      float am = fmaxf(fabsf(a2c.x), fabsf(a2c.y)); \
      PVM_DPPMAX(0xB1); PVM_DPPMAX(0x4E); PVM_DPPMAX(0x141); PVM_DPPMAX(0x140); \
      am = max_xor16(am); am = max_xor32(am); \
      const float inva = am > 0.f ? 127.f * __builtin_amdgcn_rcpf(am) : 0.f, sa = am * (1.f / 127.f); \
      { const unsigned b0 = (unsigned)(int)rintf(a2c.x * inva) & 255u, b1 = (unsigned)(int)rintf(a2c.y * inva) & 255u; \
        *(unsigned short*)(cf_l + 2 * lane) = (unsigned short)(b0 | (b1 << 8)); } \
      __builtin_amdgcn_sched_barrier(0); \
        \
      _Pragma("unroll") for (int u = 0; u < 16; ++u) *(u32x4_t*)(vs_l + st_off[(u >> 1) & 3] + u * 128) = VC[u]; \
      lds_fence(); \
      i32x4_t aop[2];     \
      aop[0] = *(const i32x4_t*)(cf_l + 16 * g); aop[1] = *(const i32x4_t*)(cf_l + 64 + 16 * g); \
      int acc0[8];     \
      _Pragma("unroll") for (int nt = 0; nt < 8; ++nt) { \
        i32x4_t acc_ = (i32x4_t){0, 0, 0, 0}; \
        _Pragma("unroll") for (int s2 = 0; s2 < 2; ++s2) { \
          const unsigned a0 = (unsigned)((s2 * 64 + 16 * g) * 128) + tr_off[nt]; \
          const i32x2_t lo = __builtin_amdgcn_ds_read_tr8_b64_v2i32((__attribute__((address_space(3))) i32x2_t*)(vs_l + a0)); \
          const i32x2_t hi = __builtin_amdgcn_ds_read_tr8_b64_v2i32((__attribute__((address_space(3))) i32x2_t*)(vs_l + a0 + 8 * 128)); \
          const i32x4_t bop = {lo[0], lo[1], hi[0], hi[1]}; \
          acc_ = __builtin_amdgcn_mfma_i32_16x16x64_i8(aop[s2], bop, acc_, 0, 0, 0); \
        } \
        acc0[nt] = acc_[0]; \
      } \
      lds_fence(); \
        \
      float ss = 0.f; \
      if (g == 0) { \
        float o[8]; \
        _Pragma("unroll") for (int nt = 0; nt < 8; ++nt) { \
          const float xv = (nt & 1) ? __uint_as_float(x1r[nt >> 1] & 0xffff0000u) : __uint_as_float(x1r[nt >> 1] << 16); \
          o[nt] = xv + (float)acc0[nt] * sa; ss += o[nt] * o[nt]; \
        } \
        const u32x4_t ow = {pack2(o[0], o[1]), pack2(o[2], o[3]), pack2(o[4], o[5]), pack2(o[6], o[7])}; \
        *(u32x4_t*)orow = ow; \
      } \
      ss += __int_as_float(__builtin_amdgcn_update_dpp(0, __float_as_int(ss), 0xB1, 0xf, 0xf, true)); \
      ss += __int_as_float(__builtin_amdgcn_update_dpp(0, __float_as_int(ss), 0x4E, 0xf, 0xf, true)); \
      ss += __int_as_float(__builtin_amdgcn_update_dpp(0, __float_as_int(ss), 0x141, 0xf, 0xf, true)); \
      ss += __int_as_float(__builtin_amdgcn_update_dpp(0, __float_as_int(ss), 0x140, 0xf, 0xf, true)); \
      if (lane == 0) ((float*)(ws + WS_SSQ8))[(size_t)grp * TOK + tok_] = ss;     \
      a2c = a2n; \
    } while (0)
#define PVM_DPPMAX(CTRL) am = fmaxf(am, __int_as_float(__builtin_amdgcn_update_dpp(0, __float_as_int(am), CTRL, 0xf, 0xf, true)))
    PVM_IDS(eeb, slot);
    a2c = *(const float2*)(aw + (size_t)slot * 128 + 2 * lane);
    { const int t1_ = (slot + nslot < TOK) ? slot + nslot : slot; PVM_IDS(eea, t1_); }
    PVM_GATHER(va, eeb);
    for (int tok = slot; tok < TOK; tok += 2 * nslot) {
      PVM_BODY(tok, va, vb, eea, eeb);
      if (tok + nslot < TOK) { PVM_BODY(tok + nslot, vb, va, eeb, eea); }
    }
#undef PVM_DPPMAX
#undef PVM_BODY
#undef PVM_GATHER
#undef PVM_IDS
  }
}

__device__ __forceinline__ void phase_final(const Params& p) {
  typedef unsigned u32x2_t __attribute__((ext_vector_type(2)));
  const float* ssq = (const float*)(p.ws + WS_SSQ8);
  const int lane = threadIdx.x & 63, w = threadIdx.x >> 6;
  constexpr int NB = 4;
  const int stride = gridDim.x * 8;
  for (int row0 = blockIdx.x * 8 + w; row0 < TOK; row0 += NB * stride) {
    u32x2_t xr[NB][4]; float sq[NB];
#pragma unroll
    for (int b = 0; b < NB; ++b) {
      const int rr = row0 + b * stride, rc = rr < TOK ? rr : row0;
      const u32x2_t* x2 = (const u32x2_t*)((const bf16_t*)(p.ws + WS_X1) + (size_t)rc * DM);
      { float a_ = 0.f;
#pragma unroll
        for (int sl = 0; sl < 8; ++sl) a_ += ssq[(size_t)sl * TOK + rc];
        sq[b] = a_; }
#pragma unroll
      for (int i = 0; i < 4; ++i) xr[b][i] = x2[lane + 64 * i];
    }
#pragma unroll
    for (int b = 0; b < NB; ++b) {
      const int row = row0 + b * stride;
      if (row < TOK) {
        const float rstd = rsqrtf(sq[b] * (1.f / DM) + EPSV);
        float4* o4 = (float4*)(p.out + (size_t)row * DM);
#pragma unroll
        for (int i = 0; i < 4; ++i) {
          const float4 gg = ((const float4*)p.norm_final)[lane + 64 * i];
          float4 v;
          v.x = __uint_as_float(xr[b][i][0] << 16) * rstd * gg.x; v.y = __uint_as_float(xr[b][i][0] & 0xffff0000u) * rstd * gg.y;
          v.z = __uint_as_float(xr[b][i][1] << 16) * rstd * gg.z; v.w = __uint_as_float(xr[b][i][1] & 0xffff0000u) * rstd * gg.w;
          o4[lane + 64 * i] = v;
        }
      }
    }
  }
}


__device__ __forceinline__ void phase_proj8(const Params& p, unsigned char* smem) {
  unsigned char* ws = p.ws;
  pg8::Gemm g{(const pg8::bf16_t*)(ws + WS_XN), (const pg8::bf16_t*)(ws + WS_WIN), TOK, 5120, 512};
  pg8::StaticOrder S; S.init(TOK, 5120, (int)gridDim.x, (int)blockIdx.x);
  EpiProj E{(unsigned short*)(ws + WS_PH), (unsigned short*)(ws + WS_PA), (unsigned short*)(ws + WS_PG),
            (unsigned short*)(ws + WS_KC), (unsigned short*)(ws + WS_VC), (unsigned short*)(ws + WS_IKC),
            (const float*)(ws + WS_XNS), (const float*)(ws + WS_WINS)};
  pg8::gemm_phase<EpiProj, pg8::StaticOrder, false, true>((PG8_LAS unsigned char*)smem, g, S, E, nullptr);
}
__device__ __forceinline__ void phase_ikln(const Params& p) {
  bf16_t* ikc = (bf16_t*)(p.ws + WS_IKC);
  const int tid = threadIdx.x, sub = tid & 7;
  float gam[8], bet[8];
#pragma unroll
  for (int i = 0; i < 8; ++i) { gam[i] = p.ikg[sub * 8 + i]; bet[i] = p.ikb[sub * 8 + i]; }
  const int rstride = gridDim.x * 64;
  for (int row0 = blockIdx.x * 64 + (tid >> 3); row0 < TOK; row0 += 2 * rstride) {
   uint4 raw2[2];
#pragma unroll
   for (int bq = 0; bq < 2; ++bq) { const int rr = row0 + bq * rstride; raw2[bq] = *(const uint4*)(ikc + (size_t)(rr < TOK ? rr : row0) * 64 + sub * 8); }
#pragma unroll
   for (int bq = 0; bq < 2; ++bq) {
    const int row = row0 + bq * rstride;
    if (row >= TOK) break;
    const uint4 raw = raw2[bq];
    float v[8];
    cvt8(raw, v);
    float s = 0.f;
#pragma unroll
    for (int i = 0; i < 8; ++i) s += v[i];
    s += __shfl_xor(s, 1); s += __shfl_xor(s, 2); s += __shfl_xor(s, 4);
    const float mu = s * (1.f / 64.f);
    float q = 0.f;
#pragma unroll
    for (int i = 0; i < 8; ++i) { const float d = v[i] - mu; q += d * d; }
    q += __shfl_xor(q, 1); q += __shfl_xor(q, 2); q += __shfl_xor(q, 4);
    const float rstd = rsqrtf(q * (1.f / 64.f) + EPSV);
    float nv[8]; float am = 0.f;
#pragma unroll
    for (int i = 0; i < 8; ++i) { nv[i] = (v[i] - mu) * rstd * gam[i] + bet[i]; am = fmaxf(am, fabsf(nv[i])); }
    am = fmaxf(am, __shfl_xor(am, 1)); am = fmaxf(am, __shfl_xor(am, 2)); am = fmaxf(am, __shfl_xor(am, 4));
    const float inv = am > 0.f ? 127.f / am : 0.f;
    unsigned pk[2];
#pragma unroll
    for (int i = 0; i < 2; ++i) {
      const unsigned b0 = (unsigned)(int)rintf(nv[4 * i] * inv) & 255u, b1 = (unsigned)(int)rintf(nv[4 * i + 1] * inv) & 255u;
      const unsigned b2 = (unsigned)(int)rintf(nv[4 * i + 2] * inv) & 255u, b3 = (unsigned)(int)rintf(nv[4 * i + 3] * inv) & 255u;
      pk[i] = b0 | (b1 << 8) | (b2 << 16) | (b3 << 24);
    }
    *(uint2*)(p.ws + WS_IK8 + (size_t)row * 64 + 16 * (sub & 3) + 8 * (sub >> 2)) = make_uint2(pk[0], pk[1]);
    if (sub == 0) ((float*)(p.ws + WS_IKS))[row] = am * (1.f / 127.f);
   }
  }
}
__device__ __forceinline__ void phase_kq8(const Params& p) {
  const bf16_t* kc = (const bf16_t*)(p.ws + WS_KC);
  const int tid = threadIdx.x, sub = tid & 7;
  const int rstride = gridDim.x * 64;
  for (int row0 = blockIdx.x * 64 + (tid >> 3); row0 < TOK; row0 += 2 * rstride) {
   uint4 raw2[2];
#pragma unroll
   for (int bq = 0; bq < 2; ++bq) { const int rr = row0 + bq * rstride; raw2[bq] = *(const uint4*)(kc + (size_t)(rr < TOK ? rr : row0) * 64 + sub * 8); }
#pragma unroll
   for (int bq = 0; bq < 2; ++bq) {
    const int row = row0 + bq * rstride;
    if (row >= TOK) break;
    const uint4 raw = raw2[bq];
    float v[8];
    cvt8(raw, v);
    float am = 0.f;
#pragma unroll
    for (int i = 0; i < 8; ++i) am = fmaxf(am, fabsf(v[i]));
    am = fmaxf(am, __shfl_xor(am, 1)); am = fmaxf(am, __shfl_xor(am, 2)); am = fmaxf(am, __shfl_xor(am, 4));
    const float inv = am > 0.f ? 127.f / am : 0.f;
    unsigned pk[2];
#pragma unroll
    for (int i = 0; i < 2; ++i) {
      const unsigned b0 = (unsigned)(int)rintf(v[4 * i] * inv) & 255u, b1 = (unsigned)(int)rintf(v[4 * i + 1] * inv) & 255u;
      const unsigned b2 = (unsigned)(int)rintf(v[4 * i + 2] * inv) & 255u, b3 = (unsigned)(int)rintf(v[4 * i + 3] * inv) & 255u;
      pk[i] = b0 | (b1 << 8) | (b2 << 16) | (b3 << 24);
    }
    *(uint2*)(p.ws + WS_K8 + (size_t)row * 64 + 16 * (sub & 3) + 8 * (sub >> 2)) = make_uint2(pk[0], pk[1]);
    if (sub == 0) ((float*)(p.ws + WS_K8S))[row] = am * (1.f / 127.f);
   }
  }
}
__device__ __forceinline__ void phase_vq8(const Params& p) {
  const bf16_t* vc = (const bf16_t*)(p.ws + WS_VC);
  const int tid = threadIdx.x, sub = tid & 7;
  const int rstride = gridDim.x * 64;
  for (int row0 = blockIdx.x * 64 + (tid >> 3); row0 < TOK; row0 += 2 * rstride) {
   uint4 raw2[2];
#pragma unroll
   for (int bq = 0; bq < 2; ++bq) { const int rr = row0 + bq * rstride; raw2[bq] = *(const uint4*)(vc + (size_t)(rr < TOK ? rr : row0) * 64 + sub * 8); }
#pragma unroll
   for (int bq = 0; bq < 2; ++bq) {
    const int row = row0 + bq * rstride;
    if (row >= TOK) break;
    float v[8];
    cvt8(raw2[bq], v);
    float am = 0.f;
#pragma unroll
    for (int i = 0; i < 8; ++i) am = fmaxf(am, fabsf(v[i]));
    am = fmaxf(am, __shfl_xor(am, 1)); am = fmaxf(am, __shfl_xor(am, 2)); am = fmaxf(am, __shfl_xor(am, 4));
    const float inv = am > 0.f ? 127.f / am : 0.f;
    unsigned pk[2];
#pragma unroll
    for (int i = 0; i < 2; ++i) {
      const unsigned b0 = (unsigned)(int)rintf(v[4 * i] * inv) & 255u, b1 = (unsigned)(int)rintf(v[4 * i + 1] * inv) & 255u;
      const unsigned b2 = (unsigned)(int)rintf(v[4 * i + 2] * inv) & 255u, b3 = (unsigned)(int)rintf(v[4 * i + 3] * inv) & 255u;
      pk[i] = b0 | (b1 << 8) | (b2 << 16) | (b3 << 24);
    }
    *(uint2*)(p.ws + WS_V8A + (size_t)row * 64 + 8 * sub) = make_uint2(pk[0], pk[1]);
    if (sub == 0) ((float*)(p.ws + WS_V8S))[row] = am * (1.f / 127.f);
   }
  }
}
__device__ __forceinline__ void phase_up8(const Params& p, unsigned char* smem) {
  unsigned char* ws = p.ws;
  pg8::Gemm g{(const pg8::bf16_t*)(ws + WS_XN), (const pg8::bf16_t*)(ws + WS_WUPA), TOK, 1024, 1024};
  pg8::StaticOrder S; S.init(TOK, 1024, (int)gridDim.x, (int)blockIdx.x);
  EpiGate2 E{(unsigned short*)(ws + WS_PH), (const unsigned char*)(ws + WS_PG)};
  pg8::gemm_phase<EpiGate2, pg8::StaticOrder>((PG8_LAS unsigned char*)smem, g, S, E, nullptr);
}
__device__ __forceinline__ void phase_out8(const Params& p, unsigned char* smem) {
  unsigned char* ws = p.ws;
  pg8::Gemm g{(const pg8::bf16_t*)(ws + WS_PH), (const pg8::bf16_t*)(ws + WS_WOUT), TOK, 1024, 1024};
  pg8::StaticOrder S; S.init(TOK, 1024, (int)gridDim.x, (int)blockIdx.x);
  EpiResid E{(unsigned short*)(ws + WS_X1), p.x};
  pg8::gemm_phase<EpiResid, pg8::StaticOrder>((PG8_LAS unsigned char*)smem, g, S, E, nullptr);
}
__device__ __forceinline__ void phase_pq8(const Params& p, unsigned char* smem) {
  unsigned char* ws = p.ws;
  pg8::Gemm g{(const pg8::bf16_t*)(ws + WS_XQ), (const pg8::bf16_t*)(ws + WS_WQ), TOK, 2048, 512};
  pg8::StaticOrder S; S.init(TOK, 2048, (int)gridDim.x, (int)blockIdx.x);
  EpiStoreBf16Q E{(unsigned short*)(ws + WS_PG), 2048, (const float*)(ws + WS_XS), (const float*)(ws + WS_WQS)};
  pg8::gemm_phase<EpiStoreBf16Q, pg8::StaticOrder, false, true>((PG8_LAS unsigned char*)smem, g, S, E, nullptr);
}

__global__ void __launch_bounds__(NTHREADS) hybrid_fwd(Params p) {
  extern __shared__ __attribute__((aligned(16))) unsigned char smem[];
#if ONE_LAUNCH
  cg::grid_group grid = cg::this_grid();
  volatile LAS unsigned* xst = (volatile LAS unsigned*)(smem + LDS_BYTES - 16);
  if (threadIdx.x == 0) { xst[0] = 0u; xst[1] = 0u; }
  __syncthreads();
  XcdBarrier xbar = xcd_barrier_post((unsigned*)(p.ws + WS_BAR), xst);
#define SEAM(k) do { if (p.ph_lo <= (k) && (k) + 1 < p.ph_hi) { if (p.ph_hi > NPHASE) grid.sync(); else xcd_barrier(xbar); } } while (0)
#else
#define SEAM(k) do { } while (0)
#endif
#define IN(k) (p.ph_lo <= (k) && (k) < p.ph_hi)
#ifndef REPEAT_PH
#define REPEAT_PH -1
#endif
#define REP(k, stmt) do { if (REPEAT_PH == (k)) { stmt; grid.sync(); } } while (0)
#ifndef PROBE_PH
#define PROBE_PH -1
#endif
#define PSTAMP(k) do { if (PROBE_PH >= 0 && threadIdx.x == 0) ((volatile unsigned*)(smem + 155300))[k] = (unsigned)wall_clock64(); } while (0)
  PSTAMP(0);
  if (IN(0)) { phase_prep(p, smem); SEAM(0); PSTAMP(1); }
  if (IN(1)) { phase_proj8(p, smem); SEAM(1); PSTAMP(2); }
  if (IN(2)) { phase_ikln(p); phase_kq8(p); phase_vq8(p); hgrn_h1_all(p, smem); SEAM(2); PSTAMP(3); }
  if (IN(3)) { phase_mix(p, smem); SEAM(3); PSTAMP(4); }
  if (IN(4)) { phase_up8(p, smem); SEAM(4); PSTAMP(5); }
  if (IN(5)) { phase_out8(p, smem); SEAM(5); PSTAMP(6); }
  if (IN(6)) { rmsnorm_rows_q<false, true>((const float*)(p.ws + WS_X1), p.norm_ffn, nullptr, p.ws + WS_XQ, (float*)(p.ws + WS_XS)); SEAM(6); PSTAMP(7); }
  if (IN(7)) { phase_pq8(p, smem); SEAM(7); PSTAMP(8); }
  if (IN(8)) { phase_pkeys(p, smem); SEAM(8); PSTAMP(9); }
  if (IN(9)) { phase_pu_ring(p, smem); SEAM(9); PSTAMP(10); }
  if (IN(10)) { phase_pv_mfma(p, smem); SEAM(10); PSTAMP(11); }
  if (IN(11)) { phase_final(p); }
  if (PROBE_PH >= 0) { __syncthreads(); PSTAMP(12); __syncthreads();
    const unsigned dl = ((volatile unsigned*)(smem + 155300))[PROBE_PH + 1] - ((volatile unsigned*)(smem + 155300))[PROBE_PH];
    const long long s0 = (long long)wall_clock64(); while ((long long)wall_clock64() - s0 < (long long)dl) __builtin_amdgcn_s_sleep(8); }
#undef IN
#undef SEAM
}

extern "C" void kernel_launch(void* const* d_in, const int* in_sizes, int n_in, void* d_out, int out_size, void* d_ws, size_t ws_size,
                              hipStream_t stream) {
  static int grid = 0;
  if (grid == 0) {
    if (n_in != 17 || ws_size < WS_END) {
      fprintf(stderr, "kernel_launch: unexpected n_in %d or ws_size %zu (need %zu)\n", n_in, ws_size, (size_t)WS_END);
      grid = -1; return;
    }
    int dev = 0, cus = 0, per_cu = 0;
    hipGetDevice(&dev);
    hipDeviceGetAttribute(&cus, hipDeviceAttributeMultiprocessorCount, dev);
    hipFuncSetAttribute((const void*)hybrid_fwd, hipFuncAttributeMaxDynamicSharedMemorySize, LDS_BYTES);
    hipOccupancyMaxActiveBlocksPerMultiprocessor(&per_cu, (const void*)hybrid_fwd, NTHREADS, LDS_BYTES);
    if (per_cu < 1) { fprintf(stderr, "kernel_launch: occupancy query says %d blocks/CU\n", per_cu); per_cu = 1; }
    (void)hipGetLastError();
    grid = cus;
  }
  if (grid < 0) return;
  Params p{};
  p.x = (const float*)d_in[0]; p.norm_mix = (const float*)d_in[1]; p.w_in = (const float*)d_in[2]; p.hg_lb = (const float*)d_in[3];
  p.hg_norm = (const float*)d_in[4]; p.ikg = (const float*)d_in[5]; p.ikb = (const float*)d_in[6]; p.rel_bias = (const float*)d_in[7];
  p.w_up_a = (const float*)d_in[8]; p.w_up_b = (const float*)d_in[9]; p.w_out = (const float*)d_in[10]; p.norm_ffn = (const float*)d_in[11];
  p.peer_wq = (const float*)d_in[12]; p.peer_keys = (const float*)d_in[13]; p.peer_u = (const float*)d_in[14]; p.peer_v = (const float*)d_in[15];
  p.norm_final = (const float*)d_in[16];
  p.out = (float*)d_out; p.ws = (unsigned char*)d_ws;
#if ONE_LAUNCH
  hipMemsetAsync((unsigned char*)d_ws + WS_BAR, 0, 16384, stream);
  p.ph_lo = 0; p.ph_hi = NPHASE;
  void* args[] = {&p};
  hipError_t e = hipLaunchCooperativeKernel((const void*)hybrid_fwd, dim3(grid), dim3(NTHREADS), args, LDS_BYTES, stream);
  if (e != hipSuccess) fprintf(stderr, "cooperative launch failed: %s (grid %d)\n", hipGetErrorString(e), grid);
#else
  for (int ph = 0; ph < NPHASE; ++ph) {
    p.ph_lo = ph; p.ph_hi = ph + 1;
    hipLaunchKernelGGL(hybrid_fwd, dim3(grid), dim3(NTHREADS), LDS_BYTES, stream, p);
  }
#endif
}
```
